# Optimizing an MI355X kernel written in HIP

```python
import jax, jax.numpy as jnp
from jax import lax
import numpy as np

D_MODEL = 1024
BATCH = 4
SEQ = 4096
DEPTH = 1

NSA_HEADS = 8
NSA_KV_GROUPS = 2
NSA_HEADS_PER_GROUP = NSA_HEADS // NSA_KV_GROUPS
NSA_HEAD_DIM = 64
CMP_BLOCK = 32
CMP_STRIDE = 16
CMP_RATIO = CMP_BLOCK // CMP_STRIDE
CMP_HIDDEN = 256
SLC_BLOCK = 64
SLC_TOPK = 16
WINDOW = 512
Q_BLOCK = 128
GLA_HEADS = 4
GLA_KEY_DIM = 64
GLA_VAL_DIM = 128
GLA_RANK = 16
GLA_TAU = 16.0
GLA_CHUNK = 64
MOE_GROUPS = 4
MOE_EXPERTS_PER_GROUP = 8
MOE_N_EXPERTS = MOE_GROUPS * MOE_EXPERTS_PER_GROUP
MOE_TOPK = 2
MOE_D_FF = 512

ROPE_THETA = 10000.0
EPS = 1e-6
NEG_INF = -1e30
FORCED_SCORE = 1e4

NSA_Q_W = NSA_HEADS * NSA_HEAD_DIM
NSA_KV_W = NSA_KV_GROUPS * NSA_HEAD_DIM
GLA_QK_W = GLA_HEADS * GLA_KEY_DIM
GLA_V_W = GLA_HEADS * GLA_VAL_DIM
IN_SPLITS = (NSA_Q_W,) + (NSA_KV_W,) * 6 + (3 * NSA_HEADS, GLA_QK_W, GLA_QK_W, GLA_V_W, GLA_RANK, GLA_V_W, D_MODEL, D_MODEL)
IN_WIDTH = sum(IN_SPLITS)

kernel_name = "hybrid_nsa_gla_hmoe_block"


def rms_norm(x, g):
    xf = x.astype(jnp.float32)
    y = xf * lax.rsqrt(jnp.mean(xf * xf, axis=-1, keepdims=True) + EPS)
    return (y * g.astype(jnp.float32)).astype(x.dtype)


def rope(x, pos):
    half = x.shape[-1] // 2
    inv = 1.0 / (ROPE_THETA ** (jnp.arange(half, dtype=jnp.float32) / half))
    ang = pos.astype(jnp.float32)[..., None] * inv
    cos, sin = jnp.cos(ang), jnp.sin(ang)
    x1 = x[..., :half].astype(jnp.float32)
    x2 = x[..., half:].astype(jnp.float32)
    return jnp.concatenate([x1 * cos - x2 * sin, x2 * cos + x1 * sin], axis=-1).astype(x.dtype)


def _heads(t, n, dh):
    b, s, _ = t.shape
    return t.reshape(b, s, n, dh).transpose(0, 2, 1, 3)


def compress_blocks(t, pos_emb, w1, b1, w2, b2):
    bsz, g, seq, dh = t.shape
    chunks = t.reshape(bsz, g, seq // CMP_STRIDE, CMP_STRIDE, dh)
    n_cmp = seq // CMP_STRIDE - CMP_RATIO + 1
    blocks = jnp.concatenate([chunks[:, :, m:m + n_cmp] for m in range(CMP_RATIO)], axis=3)
    blocks = blocks + pos_emb
    flat = blocks.reshape(bsz, g, n_cmp, CMP_BLOCK * dh)
    return jax.nn.gelu(flat @ w1 + b1) @ w2 + b2


def cmp_to_slc_overlap(n_cmp, n_slc):
    c0 = CMP_STRIDE * jnp.arange(n_cmp)[:, None]
    s0 = SLC_BLOCK * jnp.arange(n_slc)[None, :]
    ov = jnp.clip(jnp.minimum(c0 + CMP_BLOCK, s0 + SLC_BLOCK) - jnp.maximum(c0, s0), 0, None)
    return ov.astype(jnp.float32) / CMP_BLOCK


def nsa_attention(q, k_c, v_c, k_s, v_s, k_w, v_w, gate_logits, positions,
                  cmp_pos_k, cmp_w1_k, cmp_b1_k, cmp_w2_k, cmp_b2_k,
                  cmp_pos_v, cmp_w1_v, cmp_b1_v, cmp_w2_v, cmp_b2_v):
    f32 = jnp.float32
    bsz, seq, _ = q.shape
    G, hpg, dh = NSA_KV_GROUPS, NSA_HEADS_PER_GROUP, NSA_HEAD_DIM
    pos_h = positions[:, None, :]
    q = (rope(_heads(q, NSA_HEADS, dh), pos_h) * dh ** -0.5).reshape(bsz, G, hpg, seq, dh)
    k_cmp = compress_blocks(_heads(k_c, G, dh), cmp_pos_k, cmp_w1_k, cmp_b1_k, cmp_w2_k, cmp_b2_k)
    v_cmp = compress_blocks(_heads(v_c, G, dh), cmp_pos_v, cmp_w1_v, cmp_b1_v, cmp_w2_v, cmp_b2_v)
    n_cmp = k_cmp.shape[2]
    cmp_end = CMP_STRIDE * jnp.arange(n_cmp) + CMP_BLOCK - 1
    k_cmp = rope(k_cmp, jnp.take(positions, cmp_end, axis=1)[:, None, :])
    n_slc = seq // SLC_BLOCK
    top_n = min(SLC_TOPK, n_slc)
    overlap = cmp_to_slc_overlap(n_cmp, n_slc)
    k_blocks = rope(_heads(k_s, G, dh), pos_h).reshape(bsz, G, n_slc, SLC_BLOCK, dh)
    v_blocks = _heads(v_s, G, dh).reshape(bsz, G, n_slc, SLC_BLOCK, dh)
    pad = ((0, 0), (0, 0), (WINDOW, 0), (0, 0))
    k_win = jnp.pad(rope(_heads(k_w, G, dh), pos_h), pad)
    v_win = jnp.pad(_heads(v_w, G, dh), pad)
    gates = jax.nn.sigmoid(gate_logits.astype(f32)).reshape(bsz, seq, NSA_HEADS, 3)
    gates = gates.transpose(0, 2, 1, 3).reshape(bsz, G, hpg, seq, 3)
    b_idx = jnp.arange(bsz)[:, None, None, None]
    g_idx = jnp.arange(G)[None, :, None, None]
    blk_ids = jnp.arange(n_slc)

    def query_block(c):
        q0 = c * Q_BLOCK
        t_idx = q0 + jnp.arange(Q_BLOCK)
        qc = lax.dynamic_slice_in_dim(q, q0, Q_BLOCK, axis=3)
        gc = lax.dynamic_slice_in_dim(gates, q0, Q_BLOCK, axis=3)
        s = jnp.einsum('bghqd,bgnd->bghqn', qc, k_cmp).astype(f32)
        cmp_ok = cmp_end[None, :] <= t_idx[:, None]
        p_cmp = jax.nn.softmax(jnp.where(cmp_ok, s, NEG_INF), axis=-1) * cmp_ok
        o_cmp = jnp.einsum('bghqn,bgnd->bghqd', p_cmp.astype(v_cmp.dtype), v_cmp)
        imp = jnp.einsum('bghqn,nj->bgqj', p_cmp, overlap)
        cur = t_idx // SLC_BLOCK
        forced = (blk_ids[None, :] == 0) | (blk_ids[None, :] == cur[:, None]) | (blk_ids[None, :] == cur[:, None] - 1)
        imp = jnp.where(forced, FORCED_SCORE, imp)
        imp = jnp.where(blk_ids[None, :] <= cur[:, None], imp, NEG_INF)
        _, sel = lax.top_k(imp, top_n)
        k_sel = k_blocks[b_idx, g_idx, sel].reshape(bsz, G, Q_BLOCK, top_n * SLC_BLOCK, dh)
        v_sel = v_blocks[b_idx, g_idx, sel].reshape(bsz, G, Q_BLOCK, top_n * SLC_BLOCK, dh)
        key_pos = (sel[..., None] * SLC_BLOCK + jnp.arange(SLC_BLOCK)).reshape(bsz, G, Q_BLOCK, top_n * SLC_BLOCK)
        sel_ok = (key_pos <= t_idx[:, None])[:, :, None]
        s = jnp.einsum('bghqd,bgqkd->bghqk', qc, k_sel).astype(f32)
        p = jax.nn.softmax(jnp.where(sel_ok, s, NEG_INF), axis=-1)
        o_slc = jnp.einsum('bghqk,bgqkd->bghqd', p.astype(v_sel.dtype), v_sel)
        kw = lax.dynamic_slice_in_dim(k_win, q0, Q_BLOCK + WINDOW, axis=2)
        vw = lax.dynamic_slice_in_dim(v_win, q0, Q_BLOCK + WINDOW, axis=2)
        kpos = q0 - WINDOW + jnp.arange(Q_BLOCK + WINDOW)
        win_ok = (kpos[None, :] >= 0) & (kpos[None, :] <= t_idx[:, None]) & (kpos[None, :] > t_idx[:, None] - WINDOW)
        s = jnp.einsum('bghqd,bgkd->bghqk', qc, kw).astype(f32)
        p = jax.nn.softmax(jnp.where(win_ok, s, NEG_INF), axis=-1)
        o_win = jnp.einsum('bghqk,bgkd->bghqd', p.astype(vw.dtype), vw)
        o = gc[..., 0:1] * o_cmp + gc[..., 1:2] * o_slc + gc[..., 2:3] * o_win
        return o.astype(q.dtype)

    out = lax.map(query_block, jnp.arange(seq // Q_BLOCK))
    return out.transpose(1, 0, 4, 2, 3, 5).reshape(bsz, seq, NSA_HEADS * dh)


def gla_attention(q, k, v, a_low, r, w_a2, b_a, norm_g):
    f32 = jnp.float32
    bsz, seq, _ = q.shape
    H, dk, dv, C = GLA_HEADS, GLA_KEY_DIM, GLA_VAL_DIM, GLA_CHUNK
    q = _heads(q, H, dk).astype(f32) * dk ** -0.5
    k = _heads(k, H, dk).astype(f32)
    v = _heads(v, H, dv).astype(f32)
    log_a = _heads(jax.nn.log_sigmoid((a_low @ w_a2 + b_a).astype(f32)) / GLA_TAU, H, dk)
    nc = seq // C

    def to_chunks(t):
        return t.reshape(bsz, H, nc, C, t.shape[-1]).transpose(2, 0, 1, 3, 4)

    causal = jnp.tril(jnp.ones((C, C), dtype=bool))[:, :, None]

    def step(state, xs):
        qc, kc, vc, lac = xs
        b = jnp.cumsum(lac, axis=2)
        o_inter = jnp.einsum('bhtd,bhde->bhte', qc * jnp.exp(b), state)
        diff = b[:, :, :, None, :] - b[:, :, None, :, :]
        decay = jnp.where(causal, jnp.exp(jnp.where(causal, diff, 0.0)), 0.0)
        attn = jnp.einsum('bhtd,bhsd,bhtsd->bhts', qc, kc, decay)
        o_intra = jnp.einsum('bhts,bhse->bhte', attn, vc)
        b_last = b[:, :, -1, :]
        k_dec = kc * jnp.exp(b_last[:, :, None, :] - b)
        state = jnp.exp(b_last)[..., None] * state + jnp.einsum('bhsd,bhse->bhde', k_dec, vc)
        return state, o_inter + o_intra

    state0 = jnp.zeros((bsz, H, dk, dv), f32)
    _, o = lax.scan(step, state0, (to_chunks(q), to_chunks(k), to_chunks(v), to_chunks(log_a)))
    o = o.transpose(1, 2, 0, 3, 4).reshape(bsz, H, seq, dv)
    o = o * lax.rsqrt(jnp.mean(o * o, axis=-1, keepdims=True) + EPS)
    o = o.transpose(0, 2, 1, 3).reshape(bsz, seq, H * dv) * norm_g.astype(f32)
    return (o * jax.nn.silu(r.astype(f32))).astype(r.dtype)


def hybrid_mixer(u, positions, w_in,
                 cmp_pos_k, cmp_w1_k, cmp_b1_k, cmp_w2_k, cmp_b2_k,
                 cmp_pos_v, cmp_w1_v, cmp_b1_v, cmp_w2_v, cmp_b2_v,
                 gla_w_a2, gla_b_a, gla_norm_g, w_proj_nsa, w_proj_gla, w_out):
    z = u @ w_in
    (nsa_q, k_c, v_c, k_s, v_s, k_w, v_w, nsa_g,
     g_q, g_k, g_v, g_a, g_r, m_a, m_b) = jnp.split(z, np.cumsum(IN_SPLITS)[:-1].tolist(), axis=-1)
    y_a = nsa_attention(nsa_q, k_c, v_c, k_s, v_s, k_w, v_w, nsa_g, positions,
                        cmp_pos_k, cmp_w1_k, cmp_b1_k, cmp_w2_k, cmp_b2_k,
                        cmp_pos_v, cmp_w1_v, cmp_b1_v, cmp_w2_v, cmp_b2_v) @ w_proj_nsa
    y_b = gla_attention(g_q, g_k, g_v, g_a, g_r, gla_w_a2, gla_b_a, gla_norm_g) @ w_proj_gla
    mixed = jax.nn.sigmoid(m_a) * y_a + jax.nn.sigmoid(m_b) * y_b
    return mixed @ w_out


def hier_moe(v, w_grp, b_grp, w_exp, b_exp, w_gate, w_up, w_down):
    f32 = jnp.float32
    bsz, seq, d = v.shape
    vt = v.reshape(-1, d)
    grp_prob = jax.nn.softmax((vt @ w_grp + b_grp).astype(f32), axis=-1)
    p_grp, g_sel = lax.top_k(grp_prob, 1)
    exp_logits = (vt @ w_exp + b_exp).astype(f32).reshape(-1, MOE_GROUPS, MOE_EXPERTS_PER_GROUP)
    in_grp = jnp.take_along_axis(exp_logits, g_sel[:, :, None], axis=1)[:, 0]
    p_in, e_sel = lax.top_k(jax.nn.softmax(in_grp, axis=-1), MOE_TOPK)
    w = p_grp * p_in / jnp.sum(p_in, axis=-1, keepdims=True)
    expert_id = g_sel * MOE_EXPERTS_PER_GROUP + e_sel
    combine = jnp.einsum('tk,tke->te', w, jax.nn.one_hot(expert_id, MOE_N_EXPERTS, dtype=f32))
    y = jnp.zeros(vt.shape, f32)
    for e in range(MOE_N_EXPERTS):
        hdn = jax.nn.silu(vt @ w_gate[e]) * (vt @ w_up[e])
        y = y + (combine[:, e:e + 1].astype(hdn.dtype) * hdn) @ w_down[e]
    return y.reshape(bsz, seq, d).astype(v.dtype)


def setup_inputs(seed: int = 0) -> dict:
    key = jax.random.key(seed)
    ks = jax.random.split(key, 32)
    f32 = jnp.float32
    L, D, dh = DEPTH, D_MODEL, NSA_HEAD_DIM

    def nrm(k, shape, scale):
        return jax.random.normal(k, shape, f32) * scale

    start = jax.random.randint(ks[1], (BATCH,), 0, 1024)
    positions = (start[:, None] + jnp.arange(SEQ)[None, :]).astype(jnp.int32)
    return {
        "x": nrm(ks[0], (BATCH, SEQ, D), 1.0),
        "positions": positions,
        "g_mix": 1.0 + nrm(ks[2], (L, D), 0.02),
        "w_in": nrm(ks[3], (L, D, IN_WIDTH), D ** -0.5),
        "cmp_pos_k": nrm(ks[4], (L, CMP_BLOCK, dh), 0.02),
        "cmp_w1_k": nrm(ks[5], (L, CMP_BLOCK * dh, CMP_HIDDEN), (CMP_BLOCK * dh) ** -0.5),
        "cmp_b1_k": nrm(ks[6], (L, CMP_HIDDEN), 0.01),
        "cmp_w2_k": nrm(ks[7], (L, CMP_HIDDEN, dh), CMP_HIDDEN ** -0.5),
        "cmp_b2_k": nrm(ks[8], (L, dh), 0.01),
        "cmp_pos_v": nrm(ks[9], (L, CMP_BLOCK, dh), 0.02),
        "cmp_w1_v": nrm(ks[10], (L, CMP_BLOCK * dh, CMP_HIDDEN), (CMP_BLOCK * dh) ** -0.5),
        "cmp_b1_v": nrm(ks[11], (L, CMP_HIDDEN), 0.01),
        "cmp_w2_v": nrm(ks[12], (L, CMP_HIDDEN, dh), CMP_HIDDEN ** -0.5),
        "cmp_b2_v": nrm(ks[13], (L, dh), 0.01),
        "gla_w_a2": nrm(ks[14], (L, GLA_RANK, GLA_QK_W), GLA_RANK ** -0.5),
        "gla_b_a": nrm(ks[15], (L, GLA_QK_W), 0.1),
        "gla_norm_g": 1.0 + nrm(ks[16], (L, GLA_V_W), 0.02),
        "w_proj_nsa": nrm(ks[17], (L, NSA_Q_W, D), NSA_Q_W ** -0.5),
        "w_proj_gla": nrm(ks[18], (L, GLA_V_W, D), GLA_V_W ** -0.5),
        "w_out": nrm(ks[19], (L, D, D), D ** -0.5),
        "g_ffn": 1.0 + nrm(ks[20], (L, D), 0.02),
        "w_grp": nrm(ks[21], (L, D, MOE_GROUPS), D ** -0.5),
        "b_grp": nrm(ks[22], (L, MOE_GROUPS), 0.01),
        "w_exp": nrm(ks[23], (L, D, MOE_N_EXPERTS), D ** -0.5),
        "b_exp": nrm(ks[24], (L, MOE_N_EXPERTS), 0.01),
        "w_gate": nrm(ks[25], (L, MOE_N_EXPERTS, D, MOE_D_FF), D ** -0.5),
        "w_up": nrm(ks[26], (L, MOE_N_EXPERTS, D, MOE_D_FF), D ** -0.5),
        "w_down": nrm(ks[27], (L, MOE_N_EXPERTS, MOE_D_FF, D), MOE_D_FF ** -0.5),
        "g_final": 1.0 + nrm(ks[28], (D,), 0.02),
    }


def reference(x, positions, g_mix, w_in,
              cmp_pos_k, cmp_w1_k, cmp_b1_k, cmp_w2_k, cmp_b2_k,
              cmp_pos_v, cmp_w1_v, cmp_b1_v, cmp_w2_v, cmp_b2_v,
              gla_w_a2, gla_b_a, gla_norm_g, w_proj_nsa, w_proj_gla, w_out,
              g_ffn, w_grp, b_grp, w_exp, b_exp, w_gate, w_up, w_down, g_final):
    h = x
    for layer in range(DEPTH):
        u = rms_norm(h, g_mix[layer])
        h = h + hybrid_mixer(u, positions, w_in[layer],
                             cmp_pos_k[layer], cmp_w1_k[layer], cmp_b1_k[layer], cmp_w2_k[layer], cmp_b2_k[layer],
                             cmp_pos_v[layer], cmp_w1_v[layer], cmp_b1_v[layer], cmp_w2_v[layer], cmp_b2_v[layer],
                             gla_w_a2[layer], gla_b_a[layer], gla_norm_g[layer],
                             w_proj_nsa[layer], w_proj_gla[layer], w_out[layer])
        h = h + hier_moe(rms_norm(h, g_ffn[layer]), w_grp[layer], b_grp[layer], w_exp[layer], b_exp[layer],
                         w_gate[layer], w_up[layer], w_down[layer])
    return rms_norm(h, g_final)
```

```cpp
#include <hip/hip_runtime.h>
#include <stdint.h>

typedef unsigned short bf16;
typedef unsigned long long u64;

__device__ __forceinline__ float bf2f(bf16 v) { return __uint_as_float(((unsigned)v) << 16); }
__device__ __forceinline__ bf16 f2bf(float f) { unsigned u = __float_as_uint(f); return (bf16)((u + 0x7fffu + ((u >> 16) & 1u)) >> 16); }
__device__ __forceinline__ float sigmoidf_(float x) { return 1.f / (1.f + __expf(-x)); }
__device__ __forceinline__ float siluf_(float x) { return x / (1.f + __expf(-x)); }
__device__ __forceinline__ float geluf_(float x) { const float u = 0.7978845608028654f * (x + 0.044715f * x * x * x); return 0.5f * x * (1.f + tanhf(u)); }

constexpr int NB = 4, S = 4096, D = 1024, T = NB * S;
constexpr int INW = 4904;
constexpr int OFF_Q = 0, OFF_KV = 512, OFF_NG = 1280, OFF_GQ = 1304, OFF_GK = 1560, OFF_GV = 1816, OFF_GA = 2328, OFF_GR = 2344, OFF_MA = 2856, OFF_MB = 3880;
constexpr int NEXP = 32;

struct P {
    const float* x; const int* pos; const float* g_mix; const float* w_in;
    const float *cpos_k, *cw1_k, *cb1_k, *cw2_k, *cb2_k, *cpos_v, *cw1_v, *cb1_v, *cw2_v, *cb2_v;
    const float *w_a2, *b_a, *norm_g, *w_pn, *w_pg, *w_out, *g_ffn, *w_grp, *b_grp, *w_exp, *b_exp, *w_gate, *w_up, *w_down, *g_final;
    float* out;
    unsigned* ctl;
    float* cs;
    bf16* u;
    bf16* q;
    bf16* kv6;
    float* gates;
    bf16 *gq, *gk, *gv;
    float* alow;
    bf16 *rs, *sa, *sb;
    float* hcmp;
    bf16 *kcmp, *vcmp;
    u64* sel;
    float* ocmp;
    bf16* onsa;
    float* ga;
    float* oraw;
    bf16* gla;
    bf16* mixed;
    float* h1;
    bf16* vb;
    int* list;
    int* tokslot;
    int* tokexp;
    float* tokw;
    bf16* H;
    bf16* Y;
};

__global__ void __launch_bounds__(256) k_rms_u(P p) {
    const int lane = threadIdx.x & 63, t = blockIdx.x * 4 + (threadIdx.x >> 6);
    const float4* xr = (const float4*)(p.x + (size_t)t * D);
    float4 v[4]; float ss = 0.f;
#pragma unroll
    for (int j = 0; j < 4; ++j) { v[j] = xr[lane + 64 * j]; ss += v[j].x * v[j].x + v[j].y * v[j].y + v[j].z * v[j].z + v[j].w * v[j].w; }
#pragma unroll
    for (int o = 1; o < 64; o <<= 1) ss += __shfl_xor(ss, o);
    const float rstd = rsqrtf(ss * (1.f / D) + 1e-6f);
#pragma unroll
    for (int j = 0; j < 4; ++j) {
        const float4 g = ((const float4*)p.g_mix)[lane + 64 * j];
        ushort4 o; o.x = f2bf(v[j].x * rstd * g.x); o.y = f2bf(v[j].y * rstd * g.y); o.z = f2bf(v[j].z * rstd * g.z); o.w = f2bf(v[j].w * rstd * g.w);
        ((ushort4*)(p.u + (size_t)t * D))[lane + 64 * j] = o;
    }
}
__global__ void __launch_bounds__(256) k_cs(P p) {
    const int idx = blockIdx.x * 256 + threadIdx.x; const int t = idx >> 5, i = idx & 31;
    const float inv = 1.0f / powf(10000.0f, (float)i / 32.0f);
    const float ang = (float)p.pos[t] * inv;
    const double a = (double)ang; const double k = rint(a * 0.15915494309189535); const float r = (float)(a - k * 6.283185307179586);
    p.cs[(size_t)t * 64 + i] = cosf(r); p.cs[(size_t)t * 64 + 32 + i] = sinf(r);
}

template <int K, bool TWO, bool SAMEA, class AF1, class AF2, class Epi>
__device__ __forceinline__ void ngemm(float* lds, int m0, const float* W1, int ldw1, int n1, const float* W2, int ldw2, int n2, AF1 a1, AF2 a2, Epi epi) {
    const int tid = threadIdx.x;
    for (int idx = tid; idx < 8 * K; idx += 256) { const int i = idx / K, k = idx % K; lds[idx] = a1(m0 + i, k); if (TWO && !SAMEA) lds[8 * K + idx] = a2(m0 + i, k); }
    __syncthreads();
    float acc1[8], acc2[8];
#pragma unroll
    for (int i = 0; i < 8; ++i) { acc1[i] = 0.f; acc2[i] = 0.f; }
    const float* w1 = W1 + n1; const float* w2 = TWO ? (W2 + n2) : w1;
    const float* l2 = (TWO && !SAMEA) ? lds + 8 * K : lds;
    for (int k = 0; k < K; k += 4) {
        float a[4], b[4];
#pragma unroll
        for (int kk = 0; kk < 4; ++kk) { a[kk] = w1[(size_t)(k + kk) * ldw1]; b[kk] = TWO ? w2[(size_t)(k + kk) * ldw2] : 0.f; }
#pragma unroll
        for (int i = 0; i < 8; ++i) {
            const float4 x1 = *(const float4*)(lds + i * K + k);
            acc1[i] += x1.x * a[0] + x1.y * a[1] + x1.z * a[2] + x1.w * a[3];
            if (TWO) { const float4 x2 = *(const float4*)(l2 + i * K + k); acc2[i] += x2.x * b[0] + x2.y * b[1] + x2.z * b[2] + x2.w * b[3]; }
        }
    }
#pragma unroll
    for (int i = 0; i < 8; ++i) epi(m0 + i, acc1[i], acc2[i]);
}

__device__ __forceinline__ void store_z(const P& p, int t, int j, float z, float zp) {
    const int b = t / S, s = t % S;
    if (j < OFF_KV) {
        const int d = j & 63, i = d & 31; const float c = p.cs[(size_t)t * 64 + i], sn = p.cs[(size_t)t * 64 + 32 + i];
        const float r = (d < 32) ? (z * c - zp * sn) : (z * c + zp * sn);
        p.q[(size_t)t * 512 + j] = f2bf(r * 0.125f);
    } else if (j < OFF_NG) {
        const int seg = (j - OFF_KV) >> 7, cc = (j - OFF_KV) & 127, g = cc >> 6, d = cc & 63; float r = z;
        if (seg == 2 || seg == 4) { const int i = d & 31; const float c = p.cs[(size_t)t * 64 + i], sn = p.cs[(size_t)t * 64 + 32 + i]; r = (d < 32) ? (z * c - zp * sn) : (z * c + zp * sn); }
        p.kv6[(size_t)seg * (8 * S * 64) + ((size_t)(b * 2 + g) * S + s) * 64 + d] = f2bf(r);
    } else if (j < OFF_GQ) { p.gates[(size_t)t * 24 + (j - OFF_NG)] = sigmoidf_(z);
    } else if (j < OFF_GK) { p.gq[(size_t)t * 256 + (j - OFF_GQ)] = f2bf(z * 0.125f);
    } else if (j < OFF_GV) { p.gk[(size_t)t * 256 + (j - OFF_GK)] = f2bf(z);
    } else if (j < OFF_GA) { p.gv[(size_t)t * 512 + (j - OFF_GV)] = f2bf(z);
    } else if (j < OFF_GR) { p.alow[(size_t)t * 16 + (j - OFF_GA)] = z;
    } else if (j < OFF_MA) { p.rs[(size_t)t * 512 + (j - OFF_GR)] = f2bf(siluf_(z));
    } else if (j < OFF_MB) { p.sa[(size_t)t * 1024 + (j - OFF_MA)] = f2bf(sigmoidf_(z));
    } else { p.sb[(size_t)t * 1024 + (j - OFF_MB)] = f2bf(sigmoidf_(z)); }
}
__device__ __forceinline__ int rope_partner(int j) {
    int base;
    if (j < OFF_KV) base = 0; else if (j >= 768 && j < 896) base = 768; else if (j >= 1024 && j < 1152) base = 1024; else return -1;
    const int d = (j - base) & 63; return d < 32 ? j + 32 : j - 32;
}
__global__ void __launch_bounds__(256) k_inproj_naive(P p) {
    extern __shared__ float lds[];
    const int jr = blockIdx.x * 256 + threadIdx.x; const bool jv = jr < INW; const int j = jv ? jr : INW - 1;
    int jp = rope_partner(j); if (jp < 0) jp = j;
    const int m0 = blockIdx.y * 8;
    ngemm<1024, true, true>(lds, m0, p.w_in, INW, j, p.w_in, INW, jp,
        [&](int m, int k) { return bf2f(p.u[(size_t)m * D + k]); }, [&](int m, int k) { return 0.f; },
        [&](int m, float z, float zp) { if (jv) store_z(p, m, j, z, zp); });
}

__global__ void __launch_bounds__(256) k_cmp1_naive(P p) {
    extern __shared__ float lds[];
    const int kv = blockIdx.z; const int n = threadIdx.x; const int m0 = blockIdx.y * 8;
    const bf16* src = p.kv6 + (size_t)kv * (8 * S * 64);
    const float* pe = kv ? p.cpos_v : p.cpos_k; const float* w1 = kv ? p.cw1_v : p.cw1_k; const float* b1 = kv ? p.cb1_v : p.cb1_k;
    float* dst = p.hcmp + (size_t)kv * 2048 * 256;
    ngemm<2048, false, true>(lds, m0, w1, 256, n, w1, 256, n,
        [&](int m, int k) { return bf2f(src[(size_t)m * 1024 + k]) + pe[k]; }, [&](int m, int k) { return 0.f; },
        [&](int m, float z, float) { dst[(size_t)m * 256 + n] = geluf_(z + b1[n]); });
}
__global__ void __launch_bounds__(256) k_cmp2_naive(P p) {
    const int idx = blockIdx.x * 256 + threadIdx.x;
    const int i = idx & 31, row = (idx >> 5) & 2047, kv = idx >> 16;
    const float* h = p.hcmp + ((size_t)kv * 2048 + row) * 256; const float* w2 = kv ? p.cw2_v : p.cw2_k; const float* b2 = kv ? p.cb2_v : p.cb2_k;
    float z1 = b2[i], z2 = b2[i + 32];
    for (int n = 0; n < 256; ++n) { const float hv = h[n]; z1 += hv * w2[n * 64 + i]; z2 += hv * w2[n * 64 + i + 32]; }
    bf16* dst = (kv ? p.vcmp : p.kcmp) + (size_t)row * 64;
    if (kv == 0) {
        const int bg = row >> 8, m = row & 255, b = bg >> 1; int sp = 16 * m + 31; if (sp > S - 1) sp = S - 1;
        const size_t t = (size_t)b * S + sp; const float c = p.cs[t * 64 + i], sn = p.cs[t * 64 + 32 + i];
        const float r1 = z1 * c - z2 * sn, r2 = z2 * c + z1 * sn; z1 = r1; z2 = r2;
    }
    dst[i] = f2bf(z1); dst[i + 32] = f2bf(z2);
}

__device__ __forceinline__ void load_row64(const bf16* r, float* f) {
    const uint4* p4 = (const uint4*)r;
#pragma unroll
    for (int c = 0; c < 8; ++c) { const uint4 v = p4[c]; const unsigned w[4] = {v.x, v.y, v.z, v.w};
#pragma unroll
        for (int e = 0; e < 4; ++e) { f[c * 8 + e * 2] = __uint_as_float(w[e] << 16); f[c * 8 + e * 2 + 1] = __uint_as_float(w[e] & 0xffff0000u); } }
}
__device__ __forceinline__ float dot64(const float* a, const bf16* r) {
    const uint4* p4 = (const uint4*)r; float s = 0.f;
#pragma unroll
    for (int c = 0; c < 8; ++c) { const uint4 v = p4[c]; const unsigned w[4] = {v.x, v.y, v.z, v.w};
#pragma unroll
        for (int e = 0; e < 4; ++e) { s += a[c * 8 + e * 2] * __uint_as_float(w[e] << 16); s += a[c * 8 + e * 2 + 1] * __uint_as_float(w[e] & 0xffff0000u); } }
    return s;
}
__device__ __forceinline__ void axpy64(float* o, float a, const bf16* r) {
    const uint4* p4 = (const uint4*)r;
#pragma unroll
    for (int c = 0; c < 8; ++c) { const uint4 v = p4[c]; const unsigned w[4] = {v.x, v.y, v.z, v.w};
#pragma unroll
        for (int e = 0; e < 4; ++e) { o[c * 8 + e * 2] += a * __uint_as_float(w[e] << 16); o[c * 8 + e * 2 + 1] += a * __uint_as_float(w[e] & 0xffff0000u); } }
}
__global__ void __launch_bounds__(64) k_nsa_cmp_naive(P p) {
    __shared__ float imp[64 * 65];
    const int tid = threadIdx.x, g = blockIdx.x & 1, t = (blockIdx.x >> 1) * 64 + tid;
    const int b = t / S, s = t % S; const int nv = s >= 31 ? (s - 31) / 16 + 1 : 0;
    float* my = imp + tid * 65;
    for (int j = 0; j < 64; ++j) my[j] = 0.f;
    const bf16* kc = p.kcmp + (size_t)(b * 2 + g) * 256 * 64; const bf16* vc = p.vcmp + (size_t)(b * 2 + g) * 256 * 64;
    for (int hh = 0; hh < 4; ++hh) {
        const int h = g * 4 + hh; float qv[64], o[64];
        load_row64(p.q + (size_t)t * 512 + h * 64, qv);
#pragma unroll
        for (int d = 0; d < 64; ++d) o[d] = 0.f;
        float m = -1e30f, l = 0.f;
        for (int n = 0; n < nv; ++n) { const float sc = dot64(qv, kc + n * 64); const float mn = fmaxf(m, sc); l = l * __expf(m - mn) + __expf(sc - mn); m = mn; }
        const float il = nv > 0 ? 1.f / l : 0.f;
        for (int n = 0; n < nv; ++n) {
            const float sc = dot64(qv, kc + n * 64); const float pn = __expf(sc - m) * il;
            axpy64(o, pn, vc + n * 64);
            const int j0 = n >> 2; if ((n & 3) != 3) my[j0] += pn; else { my[j0] += 0.5f * pn; my[j0 + 1] += 0.5f * pn; }
        }
#pragma unroll
        for (int d = 0; d < 64; ++d) p.ocmp[(size_t)t * 512 + h * 64 + d] = o[d];
    }
    const int cur = s >> 6; u64 mask = 0ull;
    for (int j = 0; j <= cur; ++j) {
        const float sj = (j == 0 || j == cur || j == cur - 1) ? 1e4f : my[j]; int rank = 0;
        for (int i = 0; i <= cur; ++i) { if (i == j) continue; const float si = (i == 0 || i == cur || i == cur - 1) ? 1e4f : my[i]; if (si > sj || (si == sj && i < j)) ++rank; }
        if (rank < 16) mask |= (1ull << j);
    }
    p.sel[(size_t)t * 2 + g] = mask;
}
__global__ void __launch_bounds__(64) k_nsa_attn_naive(P p) {
    const int tid = threadIdx.x, h = blockIdx.x & 7, t = (blockIdx.x >> 3) * 64 + tid, g = h >> 2;
    const int b = t / S, s = t % S, cur = s >> 6;
    const bf16* ks = p.kv6 + (size_t)2 * (8 * S * 64) + (size_t)(b * 2 + g) * S * 64; const bf16* vs = p.kv6 + (size_t)3 * (8 * S * 64) + (size_t)(b * 2 + g) * S * 64;
    const bf16* kw = p.kv6 + (size_t)4 * (8 * S * 64) + (size_t)(b * 2 + g) * S * 64; const bf16* vw = p.kv6 + (size_t)5 * (8 * S * 64) + (size_t)(b * 2 + g) * S * 64;
    float qv[64], o[64], acc[64];
    load_row64(p.q + (size_t)t * 512 + h * 64, qv);
    const float g0 = p.gates[(size_t)t * 24 + h * 3], g1 = p.gates[(size_t)t * 24 + h * 3 + 1], g2 = p.gates[(size_t)t * 24 + h * 3 + 2];
#pragma unroll
    for (int d = 0; d < 64; ++d) { acc[d] = g0 * p.ocmp[(size_t)t * 512 + h * 64 + d]; o[d] = 0.f; }
    const u64 mask = p.sel[(size_t)t * 2 + g];
    float m = -1e30f, l = 0.f;
    for (int j = 0; j <= cur; ++j) {
        if (!((mask >> j) & 1ull)) continue;
        for (int kk = 0; kk < 64; ++kk) {
            const int key = j * 64 + kk; if (key > s) break;
            const float sc = dot64(qv, ks + (size_t)key * 64);
            if (sc > m) { const float f = __expf(m - sc); l *= f;
#pragma unroll
                for (int d = 0; d < 64; ++d) o[d] *= f;
                m = sc; }
            const float pe = __expf(sc - m); l += pe; axpy64(o, pe, vs + (size_t)key * 64);
        }
    }
    { const float f = g1 / l;
#pragma unroll
        for (int d = 0; d < 64; ++d) { acc[d] += f * o[d]; o[d] = 0.f; } }
    m = -1e30f; l = 0.f;
    for (int key = (s >= 511 ? s - 511 : 0); key <= s; ++key) {
        const float sc = dot64(qv, kw + (size_t)key * 64);
        if (sc > m) { const float f = __expf(m - sc); l *= f;
#pragma unroll
            for (int d = 0; d < 64; ++d) o[d] *= f;
            m = sc; }
        const float pe = __expf(sc - m); l += pe; axpy64(o, pe, vw + (size_t)key * 64);
    }
    { const float f = g2 / l;
#pragma unroll
        for (int d = 0; d < 64; ++d) p.onsa[(size_t)t * 512 + h * 64 + d] = f2bf(acc[d] + f * o[d]); }
}

__global__ void __launch_bounds__(256) k_gla_a(P p) {
    const int c = threadIdx.x, t = blockIdx.x; float z = p.b_a[c];
#pragma unroll
    for (int r = 0; r < 16; ++r) z += p.alow[(size_t)t * 16 + r] * p.w_a2[r * 256 + c];
    const float ls = fminf(z, 0.f) - log1pf(__expf(-fabsf(z)));
    p.ga[(size_t)t * 256 + c] = __expf(ls * (1.f / 16.f));
}
__global__ void __launch_bounds__(128) k_gla_scan_naive(P p) {
    __shared__ float sq[32 * 64], sk[32 * 64], sg[32 * 64];
    const int b = blockIdx.x >> 2, h = blockIdx.x & 3, e = threadIdx.x;
    float St[64];
#pragma unroll
    for (int d = 0; d < 64; ++d) St[d] = 0.f;
    for (int s0 = 0; s0 < S; s0 += 32) {
        __syncthreads();
        for (int i = e; i < 32 * 64; i += 128) { const int ss = i >> 6, d = i & 63; const size_t t = (size_t)b * S + s0 + ss;
            sq[i] = bf2f(p.gq[t * 256 + h * 64 + d]); sk[i] = bf2f(p.gk[t * 256 + h * 64 + d]); sg[i] = p.ga[t * 256 + h * 64 + d]; }
        __syncthreads();
        for (int ss = 0; ss < 32; ++ss) {
            const size_t t = (size_t)b * S + s0 + ss; const float v = bf2f(p.gv[t * 512 + h * 128 + e]); float o = 0.f;
#pragma unroll
            for (int d = 0; d < 64; ++d) { St[d] = sg[ss * 64 + d] * St[d] + sk[ss * 64 + d] * v; o += sq[ss * 64 + d] * St[d]; }
            p.oraw[t * 512 + h * 128 + e] = o;
        }
    }
}
__global__ void __launch_bounds__(256) k_gla_norm(P p) {
    const int idx = blockIdx.x * 256 + threadIdx.x; const int t = idx >> 2, h = idx & 3;
    const float* o = p.oraw + (size_t)t * 512 + h * 128; float ss = 0.f;
    for (int e = 0; e < 128; ++e) ss += o[e] * o[e];
    const float r = rsqrtf(ss * (1.f / 128.f) + 1e-6f);
    for (int e = 0; e < 128; ++e) p.gla[(size_t)t * 512 + h * 128 + e] = f2bf(o[e] * r * p.norm_g[h * 128 + e] * bf2f(p.rs[(size_t)t * 512 + h * 128 + e]));
}

__global__ void __launch_bounds__(256) k_proj_naive(P p) {
    extern __shared__ float lds[];
    const int n = blockIdx.x * 256 + threadIdx.x, m0 = blockIdx.y * 8;
    ngemm<512, true, false>(lds, m0, p.w_pn, 1024, n, p.w_pg, 1024, n,
        [&](int m, int k) { return bf2f(p.onsa[(size_t)m * 512 + k]); }, [&](int m, int k) { return bf2f(p.gla[(size_t)m * 512 + k]); },
        [&](int m, float ya, float yb) { p.mixed[(size_t)m * 1024 + n] = f2bf(bf2f(p.sa[(size_t)m * 1024 + n]) * ya + bf2f(p.sb[(size_t)m * 1024 + n]) * yb); });
}
__global__ void __launch_bounds__(256) k_out_naive(P p) {
    extern __shared__ float lds[];
    const int n = blockIdx.x * 256 + threadIdx.x, m0 = blockIdx.y * 8;
    ngemm<1024, false, true>(lds, m0, p.w_out, 1024, n, p.w_out, 1024, n,
        [&](int m, int k) { return bf2f(p.mixed[(size_t)m * 1024 + k]); }, [&](int m, int k) { return 0.f; },
        [&](int m, float z, float) { p.h1[(size_t)m * 1024 + n] = p.x[(size_t)m * 1024 + n] + z; });
}

__global__ void __launch_bounds__(256) k_route(P p) {
    const int lane = threadIdx.x & 63, t = blockIdx.x * 4 + (threadIdx.x >> 6);
    const float4* hr = (const float4*)(p.h1 + (size_t)t * D);
    float v[16]; float ss = 0.f;
#pragma unroll
    for (int j = 0; j < 4; ++j) { const float4 a = hr[lane + 64 * j]; v[4 * j] = a.x; v[4 * j + 1] = a.y; v[4 * j + 2] = a.z; v[4 * j + 3] = a.w; ss += a.x * a.x + a.y * a.y + a.z * a.z + a.w * a.w; }
#pragma unroll
    for (int o = 1; o < 64; o <<= 1) ss += __shfl_xor(ss, o);
    const float rstd = rsqrtf(ss * (1.f / D) + 1e-6f);
#pragma unroll
    for (int j = 0; j < 4; ++j) {
        const float4 g = ((const float4*)p.g_ffn)[lane + 64 * j];
        v[4 * j] *= rstd * g.x; v[4 * j + 1] *= rstd * g.y; v[4 * j + 2] *= rstd * g.z; v[4 * j + 3] *= rstd * g.w;
        ushort4 o; o.x = f2bf(v[4 * j]); o.y = f2bf(v[4 * j + 1]); o.z = f2bf(v[4 * j + 2]); o.w = f2bf(v[4 * j + 3]);
        ((ushort4*)(p.vb + (size_t)t * D))[lane + 64 * j] = o;
    }
    __shared__ float slog[4][40];
    float* sl = slog[threadIdx.x >> 6];
    for (int o = 0; o < 4; ++o) { float a = 0.f;
#pragma unroll
        for (int j = 0; j < 4; ++j)
#pragma unroll
            for (int e = 0; e < 4; ++e) a += v[4 * j + e] * p.w_grp[(size_t)(4 * (lane + 64 * j) + e) * 4 + o];
#pragma unroll
        for (int x = 1; x < 64; x <<= 1) a += __shfl_xor(a, x);
        if (lane == 0) sl[o] = a + p.b_grp[o]; }
    for (int o = 0; o < 32; ++o) { float a = 0.f;
#pragma unroll
        for (int j = 0; j < 4; ++j)
#pragma unroll
            for (int e = 0; e < 4; ++e) a += v[4 * j + e] * p.w_exp[(size_t)(4 * (lane + 64 * j) + e) * 32 + o];
#pragma unroll
        for (int x = 1; x < 64; x <<= 1) a += __shfl_xor(a, x);
        if (lane == 0) sl[4 + o] = a + p.b_exp[o]; }
    if (lane == 0) {
        int gs = 0; float gm = sl[0];
        for (int o = 1; o < 4; ++o) if (sl[o] > gm) { gm = sl[o]; gs = o; }
        float gsum = 0.f;
        for (int o = 0; o < 4; ++o) gsum += __expf(sl[o] - gm);
        const float pg = 1.f / gsum;
        const float* li = sl + 4 + gs * 8;
        int e0 = 0; float m0 = li[0];
        for (int e = 1; e < 8; ++e) if (li[e] > m0) { m0 = li[e]; e0 = e; }
        int e1 = -1; float m1 = -3e38f;
        for (int e = 0; e < 8; ++e) if (e != e0 && li[e] > m1) { m1 = li[e]; e1 = e; }
        const float p0 = 1.f, p1 = __expf(m1 - m0);
        const float w0 = pg * p0 / (p0 + p1), w1 = pg * p1 / (p0 + p1);
        const int x0 = gs * 8 + e0, x1 = gs * 8 + e1;
        const int s0 = (int)atomicAdd(&p.ctl[x0], 1u), s1 = (int)atomicAdd(&p.ctl[x1], 1u);
        p.list[(size_t)x0 * T + s0] = t; p.list[(size_t)x1 * T + s1] = t;
        p.tokexp[t * 2] = x0; p.tokexp[t * 2 + 1] = x1; p.tokslot[t * 2] = s0; p.tokslot[t * 2 + 1] = s1; p.tokw[t * 2] = w0; p.tokw[t * 2 + 1] = w1;
    }
}

__device__ __forceinline__ void seg_bases(const unsigned* cnt, int* sbase) {
    if (threadIdx.x == 0) { int acc = 0; for (int e = 0; e < NEXP; ++e) { sbase[e] = acc; acc += ((int)cnt[e] + 255) & ~255; } sbase[NEXP] = acc; }
    __syncthreads();
}
__global__ void __launch_bounds__(256) k_moe1_naive(P p) {
    extern __shared__ float lds[];
    __shared__ int sbase[NEXP + 1]; __shared__ int stok[8];
    seg_bases(p.ctl, sbase);
    const int r0 = blockIdx.y * 8; if (r0 >= sbase[NEXP]) return;
    int e = 0; while (r0 >= sbase[e + 1]) ++e;
    const int cnt = (int)p.ctl[e];
    if (threadIdx.x < 8) { const int sl = r0 + threadIdx.x - sbase[e]; stok[threadIdx.x] = sl < cnt ? p.list[(size_t)e * T + sl] : 0; }
    __syncthreads();
    const int n = blockIdx.x * 256 + threadIdx.x;
    const float* wg = p.w_gate + (size_t)e * 1024 * 512; const float* wu = p.w_up + (size_t)e * 1024 * 512;
    ngemm<1024, true, true>(lds, 0, wg, 512, n, wu, 512, n,
        [&](int m, int k) { return bf2f(p.vb[(size_t)stok[m] * D + k]); }, [&](int m, int k) { return 0.f; },
        [&](int m, float zg, float zu) { p.H[(size_t)(r0 + m) * 512 + n] = f2bf(siluf_(zg) * zu); });
}
__global__ void __launch_bounds__(256) k_moe2_naive(P p) {
    extern __shared__ float lds[];
    __shared__ int sbase[NEXP + 1];
    seg_bases(p.ctl, sbase);
    const int r0 = blockIdx.y * 8; if (r0 >= sbase[NEXP]) return;
    int e = 0; while (r0 >= sbase[e + 1]) ++e;
    const int n = blockIdx.x * 256 + threadIdx.x;
    const float* wd = p.w_down + (size_t)e * 512 * 1024;
    ngemm<512, false, true>(lds, r0, wd, 1024, n, wd, 1024, n,
        [&](int m, int k) { return bf2f(p.H[(size_t)m * 512 + k]); }, [&](int m, int k) { return 0.f; },
        [&](int m, float z, float) { p.Y[(size_t)m * 1024 + n] = f2bf(z); });
}
__global__ void __launch_bounds__(256) k_final(P p) {
    __shared__ int sbase[NEXP + 1];
    seg_bases(p.ctl, sbase);
    const int lane = threadIdx.x & 63, t = blockIdx.x * 4 + (threadIdx.x >> 6);
    const int r0 = sbase[p.tokexp[t * 2]] + p.tokslot[t * 2], r1 = sbase[p.tokexp[t * 2 + 1]] + p.tokslot[t * 2 + 1];
    const float w0 = p.tokw[t * 2], w1 = p.tokw[t * 2 + 1];
    const float4* hr = (const float4*)(p.h1 + (size_t)t * D);
    float4 v[4]; float ss = 0.f;
#pragma unroll
    for (int j = 0; j < 4; ++j) {
        float4 a = hr[lane + 64 * j];
        const ushort4 y0 = ((const ushort4*)(p.Y + (size_t)r0 * D))[lane + 64 * j], y1 = ((const ushort4*)(p.Y + (size_t)r1 * D))[lane + 64 * j];
        a.x += w0 * bf2f(y0.x) + w1 * bf2f(y1.x); a.y += w0 * bf2f(y0.y) + w1 * bf2f(y1.y); a.z += w0 * bf2f(y0.z) + w1 * bf2f(y1.z); a.w += w0 * bf2f(y0.w) + w1 * bf2f(y1.w);
        v[j] = a; ss += a.x * a.x + a.y * a.y + a.z * a.z + a.w * a.w;
    }
#pragma unroll
    for (int o = 1; o < 64; o <<= 1) ss += __shfl_xor(ss, o);
    const float rstd = rsqrtf(ss * (1.f / D) + 1e-6f);
#pragma unroll
    for (int j = 0; j < 4; ++j) {
        const float4 g = ((const float4*)p.g_final)[lane + 64 * j];
        float4 o; o.x = v[j].x * rstd * g.x; o.y = v[j].y * rstd * g.y; o.z = v[j].z * rstd * g.z; o.w = v[j].w * rstd * g.w;
        ((float4*)(p.out + (size_t)t * D))[lane + 64 * j] = o;
    }
}

static P make_params(void* const* d_in, void* d_out, void* d_ws) {
    P p{};
    const float* const* in = (const float* const*)d_in;
    p.x = in[0]; p.pos = (const int*)d_in[1]; p.g_mix = in[2]; p.w_in = in[3];
    p.cpos_k = in[4]; p.cw1_k = in[5]; p.cb1_k = in[6]; p.cw2_k = in[7]; p.cb2_k = in[8];
    p.cpos_v = in[9]; p.cw1_v = in[10]; p.cb1_v = in[11]; p.cw2_v = in[12]; p.cb2_v = in[13];
    p.w_a2 = in[14]; p.b_a = in[15]; p.norm_g = in[16]; p.w_pn = in[17]; p.w_pg = in[18]; p.w_out = in[19];
    p.g_ffn = in[20]; p.w_grp = in[21]; p.b_grp = in[22]; p.w_exp = in[23]; p.b_exp = in[24]; p.w_gate = in[25]; p.w_up = in[26]; p.w_down = in[27]; p.g_final = in[28];
    p.out = (float*)d_out;
    char* ws = (char*)d_ws; const size_t MiB = 1u << 20;
    p.ctl = (unsigned*)ws;
    p.sel = (u64*)(ws + 64 * 1024);
    p.kcmp = (bf16*)(ws + 512 * 1024); p.vcmp = (bf16*)(ws + 768 * 1024);
    p.tokslot = (int*)(ws + 1 * MiB); p.tokexp = (int*)(ws + 1 * MiB + 128 * 1024); p.tokw = (float*)(ws + 1 * MiB + 256 * 1024);
    p.alow = (float*)(ws + 2 * MiB);
    p.gates = (float*)(ws + 3 * MiB);
    p.cs = (float*)(ws + 5 * MiB);
    p.hcmp = (float*)(ws + 9 * MiB);
    p.list = (int*)(ws + 13 * MiB);
    p.u = (bf16*)(ws + 16 * MiB); p.ocmp = (float*)(ws + 16 * MiB); p.mixed = (bf16*)(ws + 16 * MiB); p.vb = (bf16*)(ws + 16 * MiB);
    p.q = (bf16*)(ws + 48 * MiB);
    p.kv6 = (bf16*)(ws + 64 * MiB);
    p.gq = (bf16*)(ws + 89 * MiB); p.gk = (bf16*)(ws + 97 * MiB); p.gv = (bf16*)(ws + 105 * MiB); p.rs = (bf16*)(ws + 121 * MiB);
    p.H = (bf16*)(ws + 48 * MiB);
    p.sa = (bf16*)(ws + 139 * MiB); p.sb = (bf16*)(ws + 171 * MiB);
    p.onsa = (bf16*)(ws + 203 * MiB); p.gla = (bf16*)(ws + 219 * MiB);
    p.Y = (bf16*)(ws + 139 * MiB);
    p.ga = (float*)d_out; p.oraw = (float*)((char*)d_out + 16 * MiB);
    p.h1 = (float*)d_out;
    return p;
}

extern "C" void kernel_launch(void* const* d_in, const int* in_sizes, int n_in, void* d_out, int out_size, void* d_ws, size_t ws_size, hipStream_t stream) {
    P p = make_params(d_in, d_out, d_ws);
    hipMemsetAsync(d_ws, 0, 4096, stream);
    k_rms_u<<<T / 4, 256, 0, stream>>>(p);
    k_cs<<<T * 32 / 256, 256, 0, stream>>>(p);
    k_inproj_naive<<<dim3((INW + 255) / 256, T / 8), 256, 8 * 1024 * 4, stream>>>(p);
    k_cmp1_naive<<<dim3(1, 2048 / 8, 2), 256, 8 * 2048 * 4, stream>>>(p);
    k_cmp2_naive<<<2 * 2048 * 32 / 256, 256, 0, stream>>>(p);
    k_nsa_cmp_naive<<<T / 64 * 2, 64, 0, stream>>>(p);
    k_nsa_attn_naive<<<T / 64 * 8, 64, 0, stream>>>(p);
    k_gla_a<<<T, 256, 0, stream>>>(p);
    k_gla_scan_naive<<<16, 128, 0, stream>>>(p);
    k_gla_norm<<<T * 4 / 256, 256, 0, stream>>>(p);
    k_proj_naive<<<dim3(4, T / 8), 256, 2 * 8 * 512 * 4, stream>>>(p);
    k_out_naive<<<dim3(4, T / 8), 256, 8 * 1024 * 4, stream>>>(p);
    k_route<<<T / 4, 256, 0, stream>>>(p);
    k_moe1_naive<<<dim3(2, (2 * T + NEXP * 256) / 8), 256, 8 * 1024 * 4, stream>>>(p);
    k_moe2_naive<<<dim3(4, (2 * T + NEXP * 256) / 8), 256, 8 * 512 * 4, stream>>>(p);
    k_final<<<T / 4, 256, 0, stream>>>(p);
}
```

```cpp
#include <hip/hip_runtime.h>
#include <hip/hip_cooperative_groups.h>
#include <stdint.h>
namespace cg = cooperative_groups;

#ifndef MODE
#define MODE 1
#endif

typedef unsigned short bf16;
typedef unsigned long long u64;

__device__ __forceinline__ float bf2f(bf16 v) { return __uint_as_float(((unsigned)v) << 16); }
__device__ __forceinline__ bf16 f2bf(float f) { unsigned u = __float_as_uint(f); return (bf16)((u + 0x7fffu + ((u >> 16) & 1u)) >> 16); }
__device__ __forceinline__ float sigmoidf_(float x) { return 1.f / (1.f + __expf(-x)); }
__device__ __forceinline__ float siluf_(float x) { return x / (1.f + __expf(-x)); }
__device__ __forceinline__ float geluf_(float x) { const float u = 0.7978845608028654f * (x + 0.044715f * x * x * x); return 0.5f * x * (1.f + tanhf(u)); }

constexpr int NB = 4, S = 4096, D = 1024;
constexpr int NT = 512;
constexpr int LDS_BYTES = 144 * 1024;
constexpr int LDS_MISC = 136 * 1024;
constexpr int INW = 4904;
constexpr int OFF_Q = 0, OFF_KV = 512, OFF_NG = 1280, OFF_GQ = 1304, OFF_GK = 1560, OFF_GV = 1816, OFF_GA = 2328, OFF_GR = 2344, OFF_MA = 2856, OFF_MB = 3880;
constexpr int NEXP = 32;

struct P {
    const float* x; const int* pos; const float* g_mix; const float* w_in;
    const float *cpos_k, *cw1_k, *cb1_k, *cw2_k, *cb2_k, *cpos_v, *cw1_v, *cb1_v, *cw2_v, *cb2_v;
    const float *w_a2, *b_a, *norm_g, *w_pn, *w_pg, *w_out, *g_ffn, *w_grp, *b_grp, *w_exp, *b_exp, *w_gate, *w_up, *w_down, *g_final;
    float* out;
    unsigned* ctl;
    float* cs;
    bf16* u;
    bf16* q;
    bf16* kv6;
    float* gates;
    bf16 *gq, *gk, *gv;
    float* alow;
    bf16 *rs, *sa, *sb;
    float* hcmp;
    bf16 *kcmp, *vcmp;
    u64* sel;
    float* ocmp;
    bf16* onsa;
    float* ga;
    float* oraw;
    bf16* gla;
    bf16* mixed;
    float* h1;
    bf16* vb;
    int* list;
    int* tokslot;
    int* tokexp;
    float* tokw;
    bf16* H;
    bf16* Y;
    int nb, T;
};
__device__ __forceinline__ size_t kvseg(const P& p) { return (size_t)p.nb * 2 * S * 64; }

enum Stage { ST_RMS = 0, ST_CS, ST_INPROJ, ST_CMP1, ST_CMP2, ST_NSACMP, ST_NSAATT, ST_GLAA, ST_GLASCAN, ST_GLANORM, ST_PROJ, ST_OUT, ST_ROUTE, ST_MOE1, ST_MOE2, ST_FINAL, ST_COUNT };

__host__ __device__ inline int stage_nvb(int st, int T) {
    switch (st) {
        case ST_RMS: return T / 8;
        case ST_CS: return T * 32 / NT;
        case ST_INPROJ: return ((INW + NT - 1) / NT) * (T / 8);
        case ST_CMP1: return 2 * (T / S) * 2 * 256 / 8;
        case ST_CMP2: return 2 * (T / S) * 2 * 256 * 32 / NT;
        case ST_NSACMP: return T / 64 * 2 / 8;
        case ST_NSAATT: return T / 64 * 8 / 8;
        case ST_GLAA: return T / 2;
        case ST_GLASCAN: return (T / S) * 4 / 4;
        case ST_GLANORM: return T * 4 / NT;
        case ST_PROJ: return 2 * (T / 8);
        case ST_OUT: return 2 * (T / 8);
        case ST_ROUTE: return T / 8;
        case ST_MOE1: return (2 * T + NEXP * 256) / 8;
        case ST_MOE2: return 2 * ((2 * T + NEXP * 256) / 8);
        case ST_FINAL: return T / 8;
    }
    return 0;
}

__device__ __forceinline__ void body_rms(const P& p, int vb) {
    const int lane = threadIdx.x & 63, t = vb * 8 + (threadIdx.x >> 6);
    const float4* xr = (const float4*)(p.x + (size_t)t * D);
    float4 v[4]; float ss = 0.f;
#pragma unroll
    for (int j = 0; j < 4; ++j) { v[j] = xr[lane + 64 * j]; ss += v[j].x * v[j].x + v[j].y * v[j].y + v[j].z * v[j].z + v[j].w * v[j].w; }
#pragma unroll
    for (int o = 1; o < 64; o <<= 1) ss += __shfl_xor(ss, o);
    const float rstd = rsqrtf(ss * (1.f / D) + 1e-6f);
#pragma unroll
    for (int j = 0; j < 4; ++j) {
        const float4 g = ((const float4*)p.g_mix)[lane + 64 * j];
        ushort4 o; o.x = f2bf(v[j].x * rstd * g.x); o.y = f2bf(v[j].y * rstd * g.y); o.z = f2bf(v[j].z * rstd * g.z); o.w = f2bf(v[j].w * rstd * g.w);
        ((ushort4*)(p.u + (size_t)t * D))[lane + 64 * j] = o;
    }
}
__device__ __forceinline__ void body_cs(const P& p, int vb) {
    const int idx = vb * NT + threadIdx.x; const int t = idx >> 5, i = idx & 31;
    const float inv = 1.0f / powf(10000.0f, (float)i / 32.0f);
    const float ang = (float)p.pos[t] * inv;
    const double a = (double)ang; const double k = rint(a * 0.15915494309189535); const float r = (float)(a - k * 6.283185307179586);
    p.cs[(size_t)t * 64 + i] = cosf(r); p.cs[(size_t)t * 64 + 32 + i] = sinf(r);
}

template <int K, bool TWO, bool SAMEA, class AF1, class AF2, class Epi>
__device__ __forceinline__ void ngemm(float* lds, int m0, const float* W1, int ldw1, int n1, const float* W2, int ldw2, int n2, AF1 a1, AF2 a2, Epi epi) {
    const int tid = threadIdx.x;
    for (int idx = tid; idx < 8 * K; idx += NT) { const int i = idx / K, k = idx % K; lds[idx] = a1(m0 + i, k); if (TWO && !SAMEA) lds[8 * K + idx] = a2(m0 + i, k); }
    __syncthreads();
    float acc1[8], acc2[8];
#pragma unroll
    for (int i = 0; i < 8; ++i) { acc1[i] = 0.f; acc2[i] = 0.f; }
    const float* w1 = W1 + n1; const float* w2 = TWO ? (W2 + n2) : w1;
    const float* l2 = (TWO && !SAMEA) ? lds + 8 * K : lds;
    for (int k = 0; k < K; k += 4) {
        float a[4], b[4];
#pragma unroll
        for (int kk = 0; kk < 4; ++kk) { a[kk] = w1[(size_t)(k + kk) * ldw1]; b[kk] = TWO ? w2[(size_t)(k + kk) * ldw2] : 0.f; }
#pragma unroll
        for (int i = 0; i < 8; ++i) {
            const float4 x1 = *(const float4*)(lds + i * K + k);
            acc1[i] += x1.x * a[0] + x1.y * a[1] + x1.z * a[2] + x1.w * a[3];
            if (TWO) { const float4 x2 = *(const float4*)(l2 + i * K + k); acc2[i] += x2.x * b[0] + x2.y * b[1] + x2.z * b[2] + x2.w * b[3]; }
        }
    }
#pragma unroll
    for (int i = 0; i < 8; ++i) epi(m0 + i, acc1[i], acc2[i]);
    __syncthreads();
}

__device__ __forceinline__ void store_z(const P& p, int t, int j, float z, float zp) {
    const int b = t / S, s = t % S;
    if (j < OFF_KV) {
        const int d = j & 63, i = d & 31; const float c = p.cs[(size_t)t * 64 + i], sn = p.cs[(size_t)t * 64 + 32 + i];
        const float r = (d < 32) ? (z * c - zp * sn) : (z * c + zp * sn);
        p.q[(size_t)t * 512 + j] = f2bf(r * 0.125f);
    } else if (j < OFF_NG) {
        const int seg = (j - OFF_KV) >> 7, cc = (j - OFF_KV) & 127, g = cc >> 6, d = cc & 63; float r = z;
        if (seg == 2 || seg == 4) { const int i = d & 31; const float c = p.cs[(size_t)t * 64 + i], sn = p.cs[(size_t)t * 64 + 32 + i]; r = (d < 32) ? (z * c - zp * sn) : (z * c + zp * sn); }
        p.kv6[(size_t)seg * kvseg(p) + ((size_t)(b * 2 + g) * S + s) * 64 + d] = f2bf(r);
    } else if (j < OFF_GQ) { p.gates[(size_t)t * 24 + (j - OFF_NG)] = sigmoidf_(z);
    } else if (j < OFF_GK) { p.gq[(size_t)t * 256 + (j - OFF_GQ)] = f2bf(z * 0.125f);
    } else if (j < OFF_GV) { p.gk[(size_t)t * 256 + (j - OFF_GK)] = f2bf(z);
    } else if (j < OFF_GA) { p.gv[(size_t)t * 512 + (j - OFF_GV)] = f2bf(z);
    } else if (j < OFF_GR) { p.alow[(size_t)t * 16 + (j - OFF_GA)] = z;
    } else if (j < OFF_MA) { p.rs[(size_t)t * 512 + (j - OFF_GR)] = f2bf(siluf_(z));
    } else if (j < OFF_MB) { p.sa[(size_t)t * 1024 + (j - OFF_MA)] = f2bf(sigmoidf_(z));
    } else { p.sb[(size_t)t * 1024 + (j - OFF_MB)] = f2bf(sigmoidf_(z)); }
}
__device__ __forceinline__ int rope_partner(int j) {
    int base;
    if (j < OFF_KV) base = 0; else if (j >= 768 && j < 896) base = 768; else if (j >= 1024 && j < 1152) base = 1024; else return -1;
    const int d = (j - base) & 63; return d < 32 ? j + 32 : j - 32;
}
__device__ __forceinline__ void body_inproj(const P& p, int vb, char* smem) {
    constexpr int NCB = (INW + NT - 1) / NT;
    const int bx = vb % NCB, by = vb / NCB;
    const int jr = bx * NT + threadIdx.x; const bool jv = jr < INW; const int j = jv ? jr : INW - 1;
    int jp = rope_partner(j); if (jp < 0) jp = j;
    ngemm<1024, true, true>((float*)smem, by * 8, p.w_in, INW, j, p.w_in, INW, jp,
        [&](int m, int k) { return bf2f(p.u[(size_t)m * D + k]); }, [&](int m, int k) { return 0.f; },
        [&](int m, float z, float zp) { if (jv) store_z(p, m, j, z, zp); });
}

__device__ __forceinline__ void body_cmp1(const P& p, int vb, char* smem) {
    const int nrows = p.nb * 2 * 256, ng = nrows / 8;
    const int kv = vb / ng, m0 = (vb % ng) * 8; const int n = threadIdx.x & 255; const bool act = threadIdx.x < 256;
    const bf16* src = p.kv6 + (size_t)kv * kvseg(p);
    const float* pe = kv ? p.cpos_v : p.cpos_k; const float* w1 = kv ? p.cw1_v : p.cw1_k; const float* b1 = kv ? p.cb1_v : p.cb1_k;
    float* dst = p.hcmp + (size_t)kv * nrows * 256;
    ngemm<2048, false, true>((float*)smem, m0, w1, 256, n, w1, 256, n,
        [&](int m, int k) { return bf2f(src[(size_t)m * 1024 + k]) + pe[k]; }, [&](int m, int k) { return 0.f; },
        [&](int m, float z, float) { if (act) dst[(size_t)m * 256 + n] = geluf_(z + b1[n]); });
}
__device__ __forceinline__ void body_cmp2(const P& p, int vb) {
    const int nrows = p.nb * 2 * 256;
    const int idx = vb * NT + threadIdx.x;
    const int i = idx & 31, row = (idx >> 5) % nrows, kv = (idx >> 5) / nrows;
    const float* h = p.hcmp + ((size_t)kv * nrows + row) * 256; const float* w2 = kv ? p.cw2_v : p.cw2_k; const float* b2 = kv ? p.cb2_v : p.cb2_k;
    float z1 = b2[i], z2 = b2[i + 32];
    for (int n = 0; n < 256; ++n) { const float hv = h[n]; z1 += hv * w2[n * 64 + i]; z2 += hv * w2[n * 64 + i + 32]; }
    bf16* dst = (kv ? p.vcmp : p.kcmp) + (size_t)row * 64;
    if (kv == 0) {
        const int bg = row >> 8, m = row & 255, b = bg >> 1; int sp = 16 * m + 31; if (sp > S - 1) sp = S - 1;
        const size_t t = (size_t)b * S + sp; const float c = p.cs[t * 64 + i], sn = p.cs[t * 64 + 32 + i];
        const float r1 = z1 * c - z2 * sn, r2 = z2 * c + z1 * sn; z1 = r1; z2 = r2;
    }
    dst[i] = f2bf(z1); dst[i + 32] = f2bf(z2);
}

__device__ __forceinline__ void load_row64(const bf16* r, float* f) {
    const uint4* p4 = (const uint4*)r;
#pragma unroll
    for (int c = 0; c < 8; ++c) { const uint4 v = p4[c]; const unsigned w[4] = {v.x, v.y, v.z, v.w};
#pragma unroll
        for (int e = 0; e < 4; ++e) { f[c * 8 + e * 2] = __uint_as_float(w[e] << 16); f[c * 8 + e * 2 + 1] = __uint_as_float(w[e] & 0xffff0000u); } }
}
__device__ __forceinline__ float dot64(const float* a, const bf16* r) {
    const uint4* p4 = (const uint4*)r; float s = 0.f;
#pragma unroll
    for (int c = 0; c < 8; ++c) { const uint4 v = p4[c]; const unsigned w[4] = {v.x, v.y, v.z, v.w};
#pragma unroll
        for (int e = 0; e < 4; ++e) { s += a[c * 8 + e * 2] * __uint_as_float(w[e] << 16); s += a[c * 8 + e * 2 + 1] * __uint_as_float(w[e] & 0xffff0000u); } }
    return s;
}
__device__ __forceinline__ void axpy64(float* o, float a, const bf16* r) {
    const uint4* p4 = (const uint4*)r;
#pragma unroll
    for (int c = 0; c < 8; ++c) { const uint4 v = p4[c]; const unsigned w[4] = {v.x, v.y, v.z, v.w};
#pragma unroll
        for (int e = 0; e < 4; ++e) { o[c * 8 + e * 2] += a * __uint_as_float(w[e] << 16); o[c * 8 + e * 2 + 1] += a * __uint_as_float(w[e] & 0xffff0000u); } }
}
__device__ __forceinline__ void body_nsacmp(const P& p, int vb, char* smem) {
    const int wave = threadIdx.x >> 6, lane = threadIdx.x & 63, item = vb * 8 + wave;
    const int g = item & 1, t = (item >> 1) * 64 + lane;
    const int b = t / S, s = t % S; const int nv = s >= 31 ? (s - 31) / 16 + 1 : 0;
    float* my = (float*)smem + (size_t)wave * (64 * 65) + lane * 65;
    for (int j = 0; j < 64; ++j) my[j] = 0.f;
    const bf16* kc = p.kcmp + (size_t)(b * 2 + g) * 256 * 64; const bf16* vc = p.vcmp + (size_t)(b * 2 + g) * 256 * 64;
    for (int hh = 0; hh < 4; ++hh) {
        const int h = g * 4 + hh; float qv[64], o[64];
        load_row64(p.q + (size_t)t * 512 + h * 64, qv);
#pragma unroll
        for (int d = 0; d < 64; ++d) o[d] = 0.f;
        float m = -1e30f, l = 0.f;
        for (int n = 0; n < nv; ++n) { const float sc = dot64(qv, kc + n * 64); const float mn = fmaxf(m, sc); l = l * __expf(m - mn) + __expf(sc - mn); m = mn; }
        const float il = nv > 0 ? 1.f / l : 0.f;
        for (int n = 0; n < nv; ++n) {
            const float sc = dot64(qv, kc + n * 64); const float pn = __expf(sc - m) * il;
            axpy64(o, pn, vc + n * 64);
            const int j0 = n >> 2; if ((n & 3) != 3) my[j0] += pn; else { my[j0] += 0.5f * pn; my[j0 + 1] += 0.5f * pn; }
        }
#pragma unroll
        for (int d = 0; d < 64; ++d) p.ocmp[(size_t)t * 512 + h * 64 + d] = o[d];
    }
    const int cur = s >> 6; u64 mask = 0ull;
    for (int j = 0; j <= cur; ++j) {
        const float sj = (j == 0 || j == cur || j == cur - 1) ? 1e4f : my[j]; int rank = 0;
        for (int i = 0; i <= cur; ++i) { if (i == j) continue; const float si = (i == 0 || i == cur || i == cur - 1) ? 1e4f : my[i]; if (si > sj || (si == sj && i < j)) ++rank; }
        if (rank < 16) mask |= (1ull << j);
    }
    p.sel[(size_t)t * 2 + g] = mask;
}
__device__ __forceinline__ void body_nsaatt(const P& p, int vb) {
    const int wave = threadIdx.x >> 6, lane = threadIdx.x & 63, item = vb * 8 + wave;
    const int h = item & 7, t = (item >> 3) * 64 + lane, g = h >> 2;
    const int b = t / S, s = t % S, cur = s >> 6;
    const size_t seg = kvseg(p), ho = (size_t)(b * 2 + g) * S * 64;
    const bf16* ks = p.kv6 + 2 * seg + ho; const bf16* vs = p.kv6 + 3 * seg + ho; const bf16* kw = p.kv6 + 4 * seg + ho; const bf16* vw = p.kv6 + 5 * seg + ho;
    float qv[64], o[64];
    load_row64(p.q + (size_t)t * 512 + h * 64, qv);
    const float g0 = p.gates[(size_t)t * 24 + h * 3], g1 = p.gates[(size_t)t * 24 + h * 3 + 1], g2 = p.gates[(size_t)t * 24 + h * 3 + 2];
    float* accp = p.ocmp + (size_t)t * 512 + h * 64;
#pragma unroll
    for (int d = 0; d < 64; ++d) o[d] = 0.f;
    const u64 mask = p.sel[(size_t)t * 2 + g];
    float m = -1e30f, l = 0.f;
    for (int j = 0; j <= cur; ++j) {
        if (!((mask >> j) & 1ull)) continue;
        for (int kk = 0; kk < 64; ++kk) {
            const int key = j * 64 + kk; if (key > s) break;
            const float sc = dot64(qv, ks + (size_t)key * 64);
            if (sc > m) { const float f = __expf(m - sc); l *= f;
#pragma unroll
                for (int d = 0; d < 64; ++d) o[d] *= f;
                m = sc; }
            const float pe = __expf(sc - m); l += pe; axpy64(o, pe, vs + (size_t)key * 64);
        }
    }
    { const float f = g1 / l;
#pragma unroll
        for (int d = 0; d < 64; ++d) { accp[d] = g0 * accp[d] + f * o[d]; o[d] = 0.f; } }
    m = -1e30f; l = 0.f;
    for (int key = (s >= 511 ? s - 511 : 0); key <= s; ++key) {
        const float sc = dot64(qv, kw + (size_t)key * 64);
        if (sc > m) { const float f = __expf(m - sc); l *= f;
#pragma unroll
            for (int d = 0; d < 64; ++d) o[d] *= f;
            m = sc; }
        const float pe = __expf(sc - m); l += pe; axpy64(o, pe, vw + (size_t)key * 64);
    }
    { const float f = g2 / l;
#pragma unroll
        for (int d = 0; d < 64; ++d) p.onsa[(size_t)t * 512 + h * 64 + d] = f2bf(accp[d] + f * o[d]); }
}

__device__ __forceinline__ void body_glaa(const P& p, int vb) {
    const int c = threadIdx.x & 255, t = vb * 2 + (threadIdx.x >> 8); float z = p.b_a[c];
#pragma unroll
    for (int r = 0; r < 16; ++r) z += p.alow[(size_t)t * 16 + r] * p.w_a2[r * 256 + c];
    const float ls = fminf(z, 0.f) - log1pf(__expf(-fabsf(z)));
    p.ga[(size_t)t * 256 + c] = __expf(ls * (1.f / 16.f));
}
__device__ __forceinline__ void body_glascan(const P& p, int vb, char* smem) {
    const int sub = threadIdx.x >> 7, e = threadIdx.x & 127, bh = vb * 4 + sub, b = bh >> 2, h = bh & 3;
    float* sq = (float*)smem + sub * (3 * 32 * 64); float* sk = sq + 32 * 64; float* sg = sk + 32 * 64;
    float St[64];
#pragma unroll
    for (int d = 0; d < 64; ++d) St[d] = 0.f;
    for (int s0 = 0; s0 < S; s0 += 32) {
        __syncthreads();
        for (int i = e; i < 32 * 64; i += 128) { const int ss = i >> 6, d = i & 63; const size_t t = (size_t)b * S + s0 + ss;
            sq[i] = bf2f(p.gq[t * 256 + h * 64 + d]); sk[i] = bf2f(p.gk[t * 256 + h * 64 + d]); sg[i] = p.ga[t * 256 + h * 64 + d]; }
        __syncthreads();
        for (int ss = 0; ss < 32; ++ss) {
            const size_t t = (size_t)b * S + s0 + ss; const float v = bf2f(p.gv[t * 512 + h * 128 + e]); float o = 0.f;
#pragma unroll
            for (int d = 0; d < 64; ++d) { St[d] = sg[ss * 64 + d] * St[d] + sk[ss * 64 + d] * v; o += sq[ss * 64 + d] * St[d]; }
            p.oraw[t * 512 + h * 128 + e] = o;
        }
    }
    __syncthreads();
}
__device__ __forceinline__ void body_glanorm(const P& p, int vb) {
    const int idx = vb * NT + threadIdx.x; const int t = idx >> 2, h = idx & 3;
    const float* o = p.oraw + (size_t)t * 512 + h * 128; float ss = 0.f;
    for (int e = 0; e < 128; ++e) ss += o[e] * o[e];
    const float r = rsqrtf(ss * (1.f / 128.f) + 1e-6f);
    for (int e = 0; e < 128; ++e) p.gla[(size_t)t * 512 + h * 128 + e] = f2bf(o[e] * r * p.norm_g[h * 128 + e] * bf2f(p.rs[(size_t)t * 512 + h * 128 + e]));
}

__device__ __forceinline__ void body_proj(const P& p, int vb, char* smem) {
    const int n = (vb & 1) * NT + threadIdx.x, m0 = (vb >> 1) * 8;
    ngemm<512, true, false>((float*)smem, m0, p.w_pn, 1024, n, p.w_pg, 1024, n,
        [&](int m, int k) { return bf2f(p.onsa[(size_t)m * 512 + k]); }, [&](int m, int k) { return bf2f(p.gla[(size_t)m * 512 + k]); },
        [&](int m, float ya, float yb) { p.mixed[(size_t)m * 1024 + n] = f2bf(bf2f(p.sa[(size_t)m * 1024 + n]) * ya + bf2f(p.sb[(size_t)m * 1024 + n]) * yb); });
}
__device__ __forceinline__ void body_out(const P& p, int vb, char* smem) {
    const int n = (vb & 1) * NT + threadIdx.x, m0 = (vb >> 1) * 8;
    ngemm<1024, false, true>((float*)smem, m0, p.w_out, 1024, n, p.w_out, 1024, n,
        [&](int m, int k) { return bf2f(p.mixed[(size_t)m * 1024 + k]); }, [&](int m, int k) { return 0.f; },
        [&](int m, float z, float) { p.h1[(size_t)m * 1024 + n] = p.x[(size_t)m * 1024 + n] + z; });
}

__device__ __forceinline__ void body_route(const P& p, int vb, char* smem) {
    const int wave = threadIdx.x >> 6, lane = threadIdx.x & 63, t = vb * 8 + wave;
    const float4* hr = (const float4*)(p.h1 + (size_t)t * D);
    float v[16]; float ss = 0.f;
#pragma unroll
    for (int j = 0; j < 4; ++j) { const float4 a = hr[lane + 64 * j]; v[4 * j] = a.x; v[4 * j + 1] = a.y; v[4 * j + 2] = a.z; v[4 * j + 3] = a.w; ss += a.x * a.x + a.y * a.y + a.z * a.z + a.w * a.w; }
#pragma unroll
    for (int o = 1; o < 64; o <<= 1) ss += __shfl_xor(ss, o);
    const float rstd = rsqrtf(ss * (1.f / D) + 1e-6f);
#pragma unroll
    for (int j = 0; j < 4; ++j) {
        const float4 g = ((const float4*)p.g_ffn)[lane + 64 * j];
        v[4 * j] *= rstd * g.x; v[4 * j + 1] *= rstd * g.y; v[4 * j + 2] *= rstd * g.z; v[4 * j + 3] *= rstd * g.w;
        ushort4 o; o.x = f2bf(v[4 * j]); o.y = f2bf(v[4 * j + 1]); o.z = f2bf(v[4 * j + 2]); o.w = f2bf(v[4 * j + 3]);
        ((ushort4*)(p.vb + (size_t)t * D))[lane + 64 * j] = o;
    }
    float* sl = (float*)(smem + LDS_MISC) + wave * 40;
    for (int o = 0; o < 4; ++o) { float a = 0.f;
#pragma unroll
        for (int j = 0; j < 4; ++j)
#pragma unroll
            for (int e = 0; e < 4; ++e) a += v[4 * j + e] * p.w_grp[(size_t)(4 * (lane + 64 * j) + e) * 4 + o];
#pragma unroll
        for (int x = 1; x < 64; x <<= 1) a += __shfl_xor(a, x);
        if (lane == 0) sl[o] = a + p.b_grp[o]; }
    for (int o = 0; o < 32; ++o) { float a = 0.f;
#pragma unroll
        for (int j = 0; j < 4; ++j)
#pragma unroll
            for (int e = 0; e < 4; ++e) a += v[4 * j + e] * p.w_exp[(size_t)(4 * (lane + 64 * j) + e) * 32 + o];
#pragma unroll
        for (int x = 1; x < 64; x <<= 1) a += __shfl_xor(a, x);
        if (lane == 0) sl[4 + o] = a + p.b_exp[o]; }
    if (lane == 0) {
        int gs = 0; float gm = sl[0];
        for (int o = 1; o < 4; ++o) if (sl[o] > gm) { gm = sl[o]; gs = o; }
        float gsum = 0.f;
        for (int o = 0; o < 4; ++o) gsum += __expf(sl[o] - gm);
        const float pg = 1.f / gsum;
        const float* li = sl + 4 + gs * 8;
        int e0 = 0; float m0 = li[0];
        for (int e = 1; e < 8; ++e) if (li[e] > m0) { m0 = li[e]; e0 = e; }
        int e1 = -1; float m1 = -3e38f;
        for (int e = 0; e < 8; ++e) if (e != e0 && li[e] > m1) { m1 = li[e]; e1 = e; }
        const float p0 = 1.f, p1 = __expf(m1 - m0);
        const float w0 = pg * p0 / (p0 + p1), w1 = pg * p1 / (p0 + p1);
        const int x0 = gs * 8 + e0, x1 = gs * 8 + e1;
        const int s0 = (int)atomicAdd(&p.ctl[x0], 1u), s1 = (int)atomicAdd(&p.ctl[x1], 1u);
        p.list[(size_t)x0 * p.T + s0] = t; p.list[(size_t)x1 * p.T + s1] = t;
        p.tokexp[t * 2] = x0; p.tokexp[t * 2 + 1] = x1; p.tokslot[t * 2] = s0; p.tokslot[t * 2 + 1] = s1; p.tokw[t * 2] = w0; p.tokw[t * 2 + 1] = w1;
    }
}

__device__ __forceinline__ int* seg_bases(const P& p, char* smem) {
    int* sbase = (int*)(smem + LDS_MISC + 2048);
    __syncthreads();
    if (threadIdx.x == 0) { int acc = 0; for (int e = 0; e < NEXP; ++e) { sbase[e] = acc; acc += ((int)p.ctl[e] + 255) & ~255; } sbase[NEXP] = acc; }
    __syncthreads();
    return sbase;
}
__device__ __forceinline__ void body_moe1(const P& p, int vb, char* smem) {
    int* sbase = seg_bases(p, smem); int* stok = sbase + 40;
    const int r0 = vb * 8; if (r0 >= sbase[NEXP]) return;
    int e = 0; while (r0 >= sbase[e + 1]) ++e;
    const int cnt = (int)p.ctl[e];
    if (threadIdx.x < 8) { const int sl = r0 + threadIdx.x - sbase[e]; stok[threadIdx.x] = sl < cnt ? p.list[(size_t)e * p.T + sl] : 0; }
    __syncthreads();
    const int n = threadIdx.x;
    const float* wg = p.w_gate + (size_t)e * 1024 * 512; const float* wu = p.w_up + (size_t)e * 1024 * 512;
    ngemm<1024, true, true>((float*)smem, 0, wg, 512, n, wu, 512, n,
        [&](int m, int k) { return bf2f(p.vb[(size_t)stok[m] * D + k]); }, [&](int m, int k) { return 0.f; },
        [&](int m, float zg, float zu) { p.H[(size_t)(r0 + m) * 512 + n] = f2bf(siluf_(zg) * zu); });
}
__device__ __forceinline__ void body_moe2(const P& p, int vb, char* smem) {
    int* sbase = seg_bases(p, smem);
    const int r0 = (vb >> 1) * 8; if (r0 >= sbase[NEXP]) return;
    int e = 0; while (r0 >= sbase[e + 1]) ++e;
    const int n = (vb & 1) * NT + threadIdx.x;
    const float* wd = p.w_down + (size_t)e * 512 * 1024;
    ngemm<512, false, true>((float*)smem, r0, wd, 1024, n, wd, 1024, n,
        [&](int m, int k) { return bf2f(p.H[(size_t)m * 512 + k]); }, [&](int m, int k) { return 0.f; },
        [&](int m, float z, float) { p.Y[(size_t)m * 1024 + n] = f2bf(z); });
}
__device__ __forceinline__ void body_final(const P& p, int vb, char* smem) {
    int* sbase = seg_bases(p, smem);
    const int lane = threadIdx.x & 63, t = vb * 8 + (threadIdx.x >> 6);
    const int r0 = sbase[p.tokexp[t * 2]] + p.tokslot[t * 2], r1 = sbase[p.tokexp[t * 2 + 1]] + p.tokslot[t * 2 + 1];
    const float w0 = p.tokw[t * 2], w1 = p.tokw[t * 2 + 1];
    const float4* hr = (const float4*)(p.h1 + (size_t)t * D);
    float4 v[4]; float ss = 0.f;
#pragma unroll
    for (int j = 0; j < 4; ++j) {
        float4 a = hr[lane + 64 * j];
        const ushort4 y0 = ((const ushort4*)(p.Y + (size_t)r0 * D))[lane + 64 * j], y1 = ((const ushort4*)(p.Y + (size_t)r1 * D))[lane + 64 * j];
        a.x += w0 * bf2f(y0.x) + w1 * bf2f(y1.x); a.y += w0 * bf2f(y0.y) + w1 * bf2f(y1.y); a.z += w0 * bf2f(y0.z) + w1 * bf2f(y1.z); a.w += w0 * bf2f(y0.w) + w1 * bf2f(y1.w);
        v[j] = a; ss += a.x * a.x + a.y * a.y + a.z * a.z + a.w * a.w;
    }
#pragma unroll
    for (int o = 1; o < 64; o <<= 1) ss += __shfl_xor(ss, o);
    const float rstd = rsqrtf(ss * (1.f / D) + 1e-6f);
#pragma unroll
    for (int j = 0; j < 4; ++j) {
        const float4 g = ((const float4*)p.g_final)[lane + 64 * j];
        float4 o; o.x = v[j].x * rstd * g.x; o.y = v[j].y * rstd * g.y; o.z = v[j].z * rstd * g.z; o.w = v[j].w * rstd * g.w;
        ((float4*)(p.out + (size_t)t * D))[lane + 64 * j] = o;
    }
}

template <int ST> __device__ __forceinline__ void run_stage(const P& p, char* smem, int first, int stride) {
    const int nvb = stage_nvb(ST, p.T);
    for (int vb = first; vb < nvb; vb += stride) {
        if constexpr (ST == ST_RMS) body_rms(p, vb);
        else if constexpr (ST == ST_CS) body_cs(p, vb);
        else if constexpr (ST == ST_INPROJ) body_inproj(p, vb, smem);
        else if constexpr (ST == ST_CMP1) body_cmp1(p, vb, smem);
        else if constexpr (ST == ST_CMP2) body_cmp2(p, vb);
        else if constexpr (ST == ST_NSACMP) body_nsacmp(p, vb, smem);
        else if constexpr (ST == ST_NSAATT) body_nsaatt(p, vb);
        else if constexpr (ST == ST_GLAA) body_glaa(p, vb);
        else if constexpr (ST == ST_GLASCAN) body_glascan(p, vb, smem);
        else if constexpr (ST == ST_GLANORM) body_glanorm(p, vb);
        else if constexpr (ST == ST_PROJ) body_proj(p, vb, smem);
        else if constexpr (ST == ST_OUT) body_out(p, vb, smem);
        else if constexpr (ST == ST_ROUTE) body_route(p, vb, smem);
        else if constexpr (ST == ST_MOE1) body_moe1(p, vb, smem);
        else if constexpr (ST == ST_MOE2) body_moe2(p, vb, smem);
        else if constexpr (ST == ST_FINAL) body_final(p, vb, smem);
    }
}
template <int ST> __global__ void __launch_bounds__(NT) k_stage(P p) {
    extern __shared__ __attribute__((aligned(16))) char smem[];
    run_stage<ST>(p, smem, blockIdx.x, gridDim.x);
}
__global__ void __launch_bounds__(NT) k_mega(P p) {
    extern __shared__ __attribute__((aligned(16))) char smem[];
    cg::grid_group grid = cg::this_grid();
    const int b0 = blockIdx.x, G = gridDim.x;
    if (b0 == 0 && threadIdx.x < NEXP) p.ctl[threadIdx.x] = 0u;
    run_stage<ST_RMS>(p, smem, b0, G); run_stage<ST_CS>(p, smem, b0, G); grid.sync();
    run_stage<ST_INPROJ>(p, smem, b0, G); grid.sync();
    run_stage<ST_CMP1>(p, smem, b0, G); run_stage<ST_GLAA>(p, smem, b0, G); grid.sync();
    run_stage<ST_CMP2>(p, smem, b0, G); run_stage<ST_GLASCAN>(p, smem, G - 1 - b0, G); grid.sync();
    run_stage<ST_NSACMP>(p, smem, b0, G); run_stage<ST_GLANORM>(p, smem, b0, G); grid.sync();
    run_stage<ST_NSAATT>(p, smem, b0, G); grid.sync();
    run_stage<ST_PROJ>(p, smem, b0, G); grid.sync();
    run_stage<ST_OUT>(p, smem, b0, G); grid.sync();
    run_stage<ST_ROUTE>(p, smem, b0, G); grid.sync();
    run_stage<ST_MOE1>(p, smem, b0, G); grid.sync();
    run_stage<ST_MOE2>(p, smem, b0, G); grid.sync();
    run_stage<ST_FINAL>(p, smem, b0, G);
}

static P make_params(void* const* d_in, void* d_out, void* d_ws) {
    P p{};
    const float* const* in = (const float* const*)d_in;
    p.x = in[0]; p.pos = (const int*)d_in[1]; p.g_mix = in[2]; p.w_in = in[3];
    p.cpos_k = in[4]; p.cw1_k = in[5]; p.cb1_k = in[6]; p.cw2_k = in[7]; p.cb2_k = in[8];
    p.cpos_v = in[9]; p.cw1_v = in[10]; p.cb1_v = in[11]; p.cw2_v = in[12]; p.cb2_v = in[13];
    p.w_a2 = in[14]; p.b_a = in[15]; p.norm_g = in[16]; p.w_pn = in[17]; p.w_pg = in[18]; p.w_out = in[19];
    p.g_ffn = in[20]; p.w_grp = in[21]; p.b_grp = in[22]; p.w_exp = in[23]; p.b_exp = in[24]; p.w_gate = in[25]; p.w_up = in[26]; p.w_down = in[27]; p.g_final = in[28];
    p.out = (float*)d_out; p.nb = NB; p.T = NB * S;
    char* ws = (char*)d_ws; const size_t MiB = 1u << 20;
    p.ctl = (unsigned*)ws;
    p.sel = (u64*)(ws + 64 * 1024);
    p.kcmp = (bf16*)(ws + 512 * 1024); p.vcmp = (bf16*)(ws + 768 * 1024);
    p.tokslot = (int*)(ws + 1 * MiB); p.tokexp = (int*)(ws + 1 * MiB + 128 * 1024); p.tokw = (float*)(ws + 1 * MiB + 256 * 1024);
    p.alow = (float*)(ws + 2 * MiB);
    p.gates = (float*)(ws + 3 * MiB);
    p.cs = (float*)(ws + 5 * MiB);
    p.hcmp = (float*)(ws + 9 * MiB);
    p.list = (int*)(ws + 13 * MiB);
    p.u = (bf16*)(ws + 16 * MiB); p.ocmp = (float*)(ws + 16 * MiB); p.mixed = (bf16*)(ws + 16 * MiB); p.vb = (bf16*)(ws + 16 * MiB);
    p.q = (bf16*)(ws + 48 * MiB);
    p.kv6 = (bf16*)(ws + 64 * MiB);
    p.gq = (bf16*)(ws + 89 * MiB); p.gk = (bf16*)(ws + 97 * MiB); p.gv = (bf16*)(ws + 105 * MiB); p.rs = (bf16*)(ws + 121 * MiB);
    p.H = (bf16*)(ws + 48 * MiB);
    p.sa = (bf16*)(ws + 139 * MiB); p.sb = (bf16*)(ws + 171 * MiB);
    p.onsa = (bf16*)(ws + 203 * MiB); p.gla = (bf16*)(ws + 219 * MiB);
    p.Y = (bf16*)(ws + 139 * MiB);
    p.ga = (float*)d_out; p.oraw = (float*)((char*)d_out + 16 * MiB);
    p.h1 = (float*)d_out;
    return p;
}

template <int ST> static void launch_stage(const P& p, hipStream_t stream) {
    static bool attr = false;
    if (!attr) { (void)hipFuncSetAttribute((const void*)k_stage<ST>, hipFuncAttributeMaxDynamicSharedMemorySize, LDS_BYTES); attr = true; }
    int nvb = stage_nvb(ST, p.T); if (nvb > 16384) nvb = 16384;
    hipLaunchKernelGGL(k_stage<ST>, dim3(nvb), dim3(NT), LDS_BYTES, stream, p);
}

extern "C" void kernel_launch(void* const* d_in, const int* in_sizes, int n_in, void* d_out, int out_size, void* d_ws, size_t ws_size, hipStream_t stream) {
    P p = make_params(d_in, d_out, d_ws);
#if MODE == 0
    (void)hipMemsetAsync(d_ws, 0, 4096, stream);
    launch_stage<ST_RMS>(p, stream); launch_stage<ST_CS>(p, stream); launch_stage<ST_INPROJ>(p, stream);
    launch_stage<ST_CMP1>(p, stream); launch_stage<ST_CMP2>(p, stream); launch_stage<ST_NSACMP>(p, stream); launch_stage<ST_NSAATT>(p, stream);
    launch_stage<ST_GLAA>(p, stream); launch_stage<ST_GLASCAN>(p, stream); launch_stage<ST_GLANORM>(p, stream);
    launch_stage<ST_PROJ>(p, stream); launch_stage<ST_OUT>(p, stream); launch_stage<ST_ROUTE>(p, stream);
    launch_stage<ST_MOE1>(p, stream); launch_stage<ST_MOE2>(p, stream); launch_stage<ST_FINAL>(p, stream);
#else
    static int grid = 0;
    if (!grid) {
        int dev = 0, cus = 0, per_cu = 0;
        (void)hipGetDevice(&dev); (void)hipDeviceGetAttribute(&cus, hipDeviceAttributeMultiprocessorCount, dev);
        (void)hipFuncSetAttribute((const void*)k_mega, hipFuncAttributeMaxDynamicSharedMemorySize, LDS_BYTES);
        (void)hipOccupancyMaxActiveBlocksPerMultiprocessor(&per_cu, (const void*)k_mega, NT, LDS_BYTES);
        if (per_cu < 1) per_cu = 1;
        grid = cus * per_cu;
    }
    void* args[] = {(void*)&p};
    (void)hipLaunchCooperativeKernel((const void*)k_mega, dim3(grid), dim3(NT), args, LDS_BYTES, stream);
#endif
}
```

```cpp
#include <hip/hip_runtime.h>
#include <hip/hip_cooperative_groups.h>
#include <stdint.h>
namespace cg = cooperative_groups;

#ifndef MODE
#define MODE 1
#endif

typedef unsigned short bf16;
typedef unsigned long long u64;

__device__ __forceinline__ int TIDX() { int t = threadIdx.x; asm volatile("" : "+v"(t)); return t; }
__device__ __forceinline__ float bf2f(bf16 v) { return __uint_as_float(((unsigned)v) << 16); }
__device__ __forceinline__ bf16 f2bf(float f) { unsigned u = __float_as_uint(f); return (bf16)((u + 0x7fffu + ((u >> 16) & 1u)) >> 16); }
__device__ __forceinline__ float sigmoidf_(float x) { return 1.f / (1.f + __expf(-x)); }
__device__ __forceinline__ float siluf_(float x) { return x / (1.f + __expf(-x)); }
__device__ __forceinline__ float geluf_(float x) { const float u = 0.7978845608028654f * (x + 0.044715f * x * x * x); return 0.5f * x * (1.f + tanhf(u)); }

constexpr int NB = 4, S = 4096, D = 1024;
constexpr int NT = 512;
constexpr int LDS_BYTES = 144 * 1024;
constexpr int LDS_MISC = 136 * 1024;
constexpr int INW = 4904;
constexpr int OFF_Q = 0, OFF_KV = 512, OFF_NG = 1280, OFF_GQ = 1304, OFF_GK = 1560, OFF_GV = 1816, OFF_GA = 2328, OFF_GR = 2344, OFF_MA = 2856, OFF_MB = 3880;
constexpr int NEXP = 32;

struct P {
    const float* x; const int* pos; const float* g_mix; const float* w_in;
    const float *cpos_k, *cw1_k, *cb1_k, *cw2_k, *cb2_k, *cpos_v, *cw1_v, *cb1_v, *cw2_v, *cb2_v;
    const float *w_a2, *b_a, *norm_g, *w_pn, *w_pg, *w_out, *g_ffn, *w_grp, *b_grp, *w_exp, *b_exp, *w_gate, *w_up, *w_down, *g_final;
    float* out;
    unsigned* ctl;
    float* cs;
    bf16* u;
    bf16* q;
    bf16* kv6;
    float* gates;
    bf16 *gq, *gk, *gv;
    float* alow;
    bf16 *rs, *sa, *sb;
    float* hcmp;
    bf16 *kcmp, *vcmp;
    u64* sel;
    float* ocmp;
    bf16* onsa;
    float* ga;
    float* oraw;
    bf16* gla;
    bf16* mixed;
    float* h1;
    bf16* vb;
    int* list;
    int* tokslot;
    int* tokexp;
    float* tokw;
    bf16* H;
    bf16* Y;
    bf16 *Wt_in, *Wc1, *Wpn, *Wpg, *Wo, *Wgu, *Wd;
    int nb, T;
};
__device__ __forceinline__ size_t kvseg(const P& p) { return (size_t)p.nb * 2 * S * 64; }

enum Stage { ST_RMS = 0, ST_CS, ST_INPROJ, ST_CMP1, ST_CMP2, ST_NSACMP, ST_NSAATT, ST_GLAA, ST_GLASCAN, ST_GLANORM, ST_PROJ, ST_OUT, ST_ROUTE, ST_MOE1, ST_MOE2, ST_FINAL, ST_COUNT };

__host__ __device__ inline int stage_nvb(int st, int T) {
    switch (st) {
        case ST_RMS: return T / 8;
        case ST_CS: return T * 32 / NT;
        case ST_INPROJ: return ((INW + NT - 1) / NT) * (T / 8);
        case ST_CMP1: return 2 * (T / S) * 2 * 256 / 8;
        case ST_CMP2: return 2 * (T / S) * 2 * 256 * 32 / NT;
        case ST_NSACMP: return T / 64 * 2 / 8;
        case ST_NSAATT: return T / 64 * 8 / 8;
        case ST_GLAA: return T / 2;
        case ST_GLASCAN: return (T / S) * 4 / 4;
        case ST_GLANORM: return T * 4 / NT;
        case ST_PROJ: return 2 * (T / 8);
        case ST_OUT: return 2 * (T / 8);
        case ST_ROUTE: return T / 8;
        case ST_MOE1: return (2 * T + NEXP * 256) / 8;
        case ST_MOE2: return 2 * ((2 * T + NEXP * 256) / 8);
        case ST_FINAL: return T / 8;
    }
    return 0;
}

__device__ __forceinline__ void body_rms(const P& p, int vb) {
    const int lane = TIDX() & 63, t = vb * 8 + (TIDX() >> 6);
    const float4* xr = (const float4*)(p.x + (size_t)t * D);
    float4 v[4]; float ss = 0.f;
#pragma unroll
    for (int j = 0; j < 4; ++j) { v[j] = xr[lane + 64 * j]; ss += v[j].x * v[j].x + v[j].y * v[j].y + v[j].z * v[j].z + v[j].w * v[j].w; }
#pragma unroll
    for (int o = 1; o < 64; o <<= 1) ss += __shfl_xor(ss, o);
    const float rstd = rsqrtf(ss * (1.f / D) + 1e-6f);
#pragma unroll
    for (int j = 0; j < 4; ++j) {
        const float4 g = ((const float4*)p.g_mix)[lane + 64 * j];
        ushort4 o; o.x = f2bf(v[j].x * rstd * g.x); o.y = f2bf(v[j].y * rstd * g.y); o.z = f2bf(v[j].z * rstd * g.z); o.w = f2bf(v[j].w * rstd * g.w);
        ((ushort4*)(p.u + (size_t)t * D))[lane + 64 * j] = o;
    }
}
__device__ __forceinline__ void body_cs(const P& p, int vb) {
    const int idx = vb * NT + TIDX(); const int t = idx >> 5, i = idx & 31;
    const float inv = 1.0f / powf(10000.0f, (float)i / 32.0f);
    const float ang = (float)p.pos[t] * inv;
    const double a = (double)ang; const double k = rint(a * 0.15915494309189535); const float r = (float)(a - k * 6.283185307179586);
    p.cs[(size_t)t * 64 + i] = cosf(r); p.cs[(size_t)t * 64 + 32 + i] = sinf(r);
}

template <int K, bool TWO, bool SAMEA, class AF1, class AF2, class Epi>
__device__ __forceinline__ void ngemm(float* lds, int m0, const float* W1, int ldw1, int n1, const float* W2, int ldw2, int n2, AF1 a1, AF2 a2, Epi epi) {
    const int tid = TIDX();
    for (int idx = tid; idx < 8 * K; idx += NT) { const int i = idx / K, k = idx % K; lds[idx] = a1(m0 + i, k); if (TWO && !SAMEA) lds[8 * K + idx] = a2(m0 + i, k); }
    __syncthreads();
    float acc1[8], acc2[8];
#pragma unroll
    for (int i = 0; i < 8; ++i) { acc1[i] = 0.f; acc2[i] = 0.f; }
    const float* w1 = W1 + n1; const float* w2 = TWO ? (W2 + n2) : w1;
    const float* l2 = (TWO && !SAMEA) ? lds + 8 * K : lds;
    for (int k = 0; k < K; k += 4) {
        float a[4], b[4];
#pragma unroll
        for (int kk = 0; kk < 4; ++kk) { a[kk] = w1[(size_t)(k + kk) * ldw1]; b[kk] = TWO ? w2[(size_t)(k + kk) * ldw2] : 0.f; }
#pragma unroll
        for (int i = 0; i < 8; ++i) {
            const float4 x1 = *(const float4*)(lds + i * K + k);
            acc1[i] += x1.x * a[0] + x1.y * a[1] + x1.z * a[2] + x1.w * a[3];
            if (TWO) { const float4 x2 = *(const float4*)(l2 + i * K + k); acc2[i] += x2.x * b[0] + x2.y * b[1] + x2.z * b[2] + x2.w * b[3]; }
        }
    }
#pragma unroll
    for (int i = 0; i < 8; ++i) epi(m0 + i, acc1[i], acc2[i]);
    __syncthreads();
}

__device__ __forceinline__ void store_z(const P& p, int t, int j, float z, float zp) {
    const int b = t / S, s = t % S;
    if (j < OFF_KV) {
        const int d = j & 63, i = d & 31; const float c = p.cs[(size_t)t * 64 + i], sn = p.cs[(size_t)t * 64 + 32 + i];
        const float r = (d < 32) ? (z * c - zp * sn) : (z * c + zp * sn);
        p.q[(size_t)t * 512 + j] = f2bf(r * 0.125f);
    } else if (j < OFF_NG) {
        const int seg = (j - OFF_KV) >> 7, cc = (j - OFF_KV) & 127, g = cc >> 6, d = cc & 63; float r = z;
        if (seg == 2 || seg == 4) { const int i = d & 31; const float c = p.cs[(size_t)t * 64 + i], sn = p.cs[(size_t)t * 64 + 32 + i]; r = (d < 32) ? (z * c - zp * sn) : (z * c + zp * sn); }
        p.kv6[(size_t)seg * kvseg(p) + ((size_t)(b * 2 + g) * S + s) * 64 + d] = f2bf(r);
    } else if (j < OFF_GQ) { p.gates[(size_t)t * 24 + (j - OFF_NG)] = sigmoidf_(z);
    } else if (j < OFF_GK) { p.gq[(size_t)t * 256 + (j - OFF_GQ)] = f2bf(z * 0.125f);
    } else if (j < OFF_GV) { p.gk[(size_t)t * 256 + (j - OFF_GK)] = f2bf(z);
    } else if (j < OFF_GA) { p.gv[(size_t)t * 512 + (j - OFF_GV)] = f2bf(z);
    } else if (j < OFF_GR) { p.alow[(size_t)t * 16 + (j - OFF_GA)] = z;
    } else if (j < OFF_MA) { p.rs[(size_t)t * 512 + (j - OFF_GR)] = f2bf(siluf_(z));
    } else if (j < OFF_MB) { p.sa[(size_t)t * 1024 + (j - OFF_MA)] = f2bf(sigmoidf_(z));
    } else { p.sb[(size_t)t * 1024 + (j - OFF_MB)] = f2bf(sigmoidf_(z)); }
}
__device__ __forceinline__ int rope_partner(int j) {
    int base;
    if (j < OFF_KV) base = 0; else if (j >= 768 && j < 896) base = 768; else if (j >= 1024 && j < 1152) base = 1024; else return -1;
    const int d = (j - base) & 63; return d < 32 ? j + 32 : j - 32;
}
__device__ __forceinline__ void body_inproj(const P& p, int vb, char* smem) {
    constexpr int NCB = (INW + NT - 1) / NT;
    const int bx = vb % NCB, by = vb / NCB;
    const int jr = bx * NT + TIDX(); const bool jv = jr < INW; const int j = jv ? jr : INW - 1;
    int jp = rope_partner(j); if (jp < 0) jp = j;
    ngemm<1024, true, true>((float*)smem, by * 8, p.w_in, INW, j, p.w_in, INW, jp,
        [&](int m, int k) { return bf2f(p.u[(size_t)m * D + k]); }, [&](int m, int k) { return 0.f; },
        [&](int m, float z, float zp) { if (jv) store_z(p, m, j, z, zp); });
}

__device__ __forceinline__ void body_cmp1(const P& p, int vb, char* smem) {
    const int nrows = p.nb * 2 * 256, ng = nrows / 8;
    const int kv = vb / ng, m0 = (vb % ng) * 8; const int n = TIDX() & 255; const bool act = TIDX() < 256;
    const bf16* src = p.kv6 + (size_t)kv * kvseg(p);
    const float* pe = kv ? p.cpos_v : p.cpos_k; const float* w1 = kv ? p.cw1_v : p.cw1_k; const float* b1 = kv ? p.cb1_v : p.cb1_k;
    float* dst = p.hcmp + (size_t)kv * nrows * 256;
    ngemm<2048, false, true>((float*)smem, m0, w1, 256, n, w1, 256, n,
        [&](int m, int k) { return bf2f(src[(size_t)m * 1024 + k]) + pe[k]; }, [&](int m, int k) { return 0.f; },
        [&](int m, float z, float) { if (act) dst[(size_t)m * 256 + n] = geluf_(z + b1[n]); });
}
__device__ __forceinline__ void body_cmp2(const P& p, int vb) {
    const int nrows = p.nb * 2 * 256;
    const int idx = vb * NT + TIDX();
    const int i = idx & 31, row = (idx >> 5) % nrows, kv = (idx >> 5) / nrows;
    const float* h = p.hcmp + ((size_t)kv * nrows + row) * 256; const float* w2 = kv ? p.cw2_v : p.cw2_k; const float* b2 = kv ? p.cb2_v : p.cb2_k;
    float z1 = b2[i], z2 = b2[i + 32];
    for (int n = 0; n < 256; ++n) { const float hv = h[n]; z1 += hv * w2[n * 64 + i]; z2 += hv * w2[n * 64 + i + 32]; }
    bf16* dst = (kv ? p.vcmp : p.kcmp) + (size_t)row * 64;
    if (kv == 0) {
        const int bg = row >> 8, m = row & 255, b = bg >> 1; int sp = 16 * m + 31; if (sp > S - 1) sp = S - 1;
        const size_t t = (size_t)b * S + sp; const float c = p.cs[t * 64 + i], sn = p.cs[t * 64 + 32 + i];
        const float r1 = z1 * c - z2 * sn, r2 = z2 * c + z1 * sn; z1 = r1; z2 = r2;
    }
    dst[i] = f2bf(z1); dst[i + 32] = f2bf(z2);
}

__device__ __forceinline__ void load_row64(const bf16* r, float* f) {
    const uint4* p4 = (const uint4*)r;
#pragma unroll
    for (int c = 0; c < 8; ++c) { const uint4 v = p4[c]; const unsigned w[4] = {v.x, v.y, v.z, v.w};
#pragma unroll
        for (int e = 0; e < 4; ++e) { f[c * 8 + e * 2] = __uint_as_float(w[e] << 16); f[c * 8 + e * 2 + 1] = __uint_as_float(w[e] & 0xffff0000u); } }
}
__device__ __forceinline__ float dot64(const float* a, const bf16* r) {
    const uint4* p4 = (const uint4*)r; float s = 0.f;
#pragma unroll
    for (int c = 0; c < 8; ++c) { const uint4 v = p4[c]; const unsigned w[4] = {v.x, v.y, v.z, v.w};
#pragma unroll
        for (int e = 0; e < 4; ++e) { s += a[c * 8 + e * 2] * __uint_as_float(w[e] << 16); s += a[c * 8 + e * 2 + 1] * __uint_as_float(w[e] & 0xffff0000u); } }
    return s;
}
__device__ __forceinline__ void axpy64(float* o, float a, const bf16* r) {
    const uint4* p4 = (const uint4*)r;
#pragma unroll
    for (int c = 0; c < 8; ++c) { const uint4 v = p4[c]; const unsigned w[4] = {v.x, v.y, v.z, v.w};
#pragma unroll
        for (int e = 0; e < 4; ++e) { o[c * 8 + e * 2] += a * __uint_as_float(w[e] << 16); o[c * 8 + e * 2 + 1] += a * __uint_as_float(w[e] & 0xffff0000u); } }
}
__device__ __forceinline__ void body_nsacmp(const P& p, int vb, char* smem) {
    const int wave = TIDX() >> 6, lane = TIDX() & 63, item = vb * 8 + wave;
    const int g = item & 1, t = (item >> 1) * 64 + lane;
    const int b = t / S, s = t % S; const int nv = s >= 31 ? (s - 31) / 16 + 1 : 0;
    float* my = (float*)smem + (size_t)wave * (64 * 65) + lane * 65;
    for (int j = 0; j < 64; ++j) my[j] = 0.f;
    const bf16* kc = p.kcmp + (size_t)(b * 2 + g) * 256 * 64; const bf16* vc = p.vcmp + (size_t)(b * 2 + g) * 256 * 64;
    for (int hh = 0; hh < 4; ++hh) {
        const int h = g * 4 + hh; float qv[64], o[64];
        load_row64(p.q + (size_t)t * 512 + h * 64, qv);
#pragma unroll
        for (int d = 0; d < 64; ++d) o[d] = 0.f;
        float m = -1e30f, l = 0.f;
        for (int n = 0; n < nv; ++n) { const float sc = dot64(qv, kc + n * 64); const float mn = fmaxf(m, sc); l = l * __expf(m - mn) + __expf(sc - mn); m = mn; }
        const float il = nv > 0 ? 1.f / l : 0.f;
        for (int n = 0; n < nv; ++n) {
            const float sc = dot64(qv, kc + n * 64); const float pn = __expf(sc - m) * il;
            axpy64(o, pn, vc + n * 64);
            const int j0 = n >> 2; if ((n & 3) != 3) my[j0] += pn; else { my[j0] += 0.5f * pn; my[j0 + 1] += 0.5f * pn; }
        }
#pragma unroll
        for (int d = 0; d < 64; ++d) p.ocmp[(size_t)t * 512 + h * 64 + d] = o[d];
    }
    const int cur = s >> 6; u64 mask = 0ull;
    for (int j = 0; j <= cur; ++j) {
        const float sj = (j == 0 || j == cur || j == cur - 1) ? 1e4f : my[j]; int rank = 0;
        for (int i = 0; i <= cur; ++i) { if (i == j) continue; const float si = (i == 0 || i == cur || i == cur - 1) ? 1e4f : my[i]; if (si > sj || (si == sj && i < j)) ++rank; }
        if (rank < 16) mask |= (1ull << j);
    }
    p.sel[(size_t)t * 2 + g] = mask;
}
__device__ __forceinline__ void body_nsaatt(const P& p, int vb) {
    const int wave = TIDX() >> 6, lane = TIDX() & 63, item = vb * 8 + wave;
    const int h = item & 7, t = (item >> 3) * 64 + lane, g = h >> 2;
    const int b = t / S, s = t % S, cur = s >> 6;
    const size_t seg = kvseg(p), ho = (size_t)(b * 2 + g) * S * 64;
    const bf16* ks = p.kv6 + 2 * seg + ho; const bf16* vs = p.kv6 + 3 * seg + ho; const bf16* kw = p.kv6 + 4 * seg + ho; const bf16* vw = p.kv6 + 5 * seg + ho;
    float qv[64], o[64];
    load_row64(p.q + (size_t)t * 512 + h * 64, qv);
    const float g0 = p.gates[(size_t)t * 24 + h * 3], g1 = p.gates[(size_t)t * 24 + h * 3 + 1], g2 = p.gates[(size_t)t * 24 + h * 3 + 2];
    float* accp = p.ocmp + (size_t)t * 512 + h * 64;
#pragma unroll
    for (int d = 0; d < 64; ++d) o[d] = 0.f;
    const u64 mask = p.sel[(size_t)t * 2 + g];
    float m = -1e30f, l = 0.f;
    for (int j = 0; j <= cur; ++j) {
        if (!((mask >> j) & 1ull)) continue;
        for (int kk = 0; kk < 64; ++kk) {
            const int key = j * 64 + kk; if (key > s) break;
            const float sc = dot64(qv, ks + (size_t)key * 64);
            if (sc > m) { const float f = __expf(m - sc); l *= f;
#pragma unroll
                for (int d = 0; d < 64; ++d) o[d] *= f;
                m = sc; }
            const float pe = __expf(sc - m); l += pe; axpy64(o, pe, vs + (size_t)key * 64);
        }
    }
    { const float f = g1 / l;
#pragma unroll
        for (int d = 0; d < 64; ++d) { accp[d] = g0 * accp[d] + f * o[d]; o[d] = 0.f; } }
    m = -1e30f; l = 0.f;
    for (int key = (s >= 511 ? s - 511 : 0); key <= s; ++key) {
        const float sc = dot64(qv, kw + (size_t)key * 64);
        if (sc > m) { const float f = __expf(m - sc); l *= f;
#pragma unroll
            for (int d = 0; d < 64; ++d) o[d] *= f;
            m = sc; }
        const float pe = __expf(sc - m); l += pe; axpy64(o, pe, vw + (size_t)key * 64);
    }
    { const float f = g2 / l;
#pragma unroll
        for (int d = 0; d < 64; ++d) p.onsa[(size_t)t * 512 + h * 64 + d] = f2bf(accp[d] + f * o[d]); }
}

__device__ __forceinline__ void body_glaa(const P& p, int vb) {
    const int c = TIDX() & 255, t = vb * 2 + (TIDX() >> 8); float z = p.b_a[c];
#pragma unroll
    for (int r = 0; r < 16; ++r) z += p.alow[(size_t)t * 16 + r] * p.w_a2[r * 256 + c];
    const float ls = fminf(z, 0.f) - log1pf(__expf(-fabsf(z)));
    p.ga[(size_t)t * 256 + c] = __expf(ls * (1.f / 16.f));
}
__device__ __forceinline__ void body_glascan(const P& p, int vb, char* smem) {
    const int sub = TIDX() >> 7, e = TIDX() & 127, bh = vb * 4 + sub, b = bh >> 2, h = bh & 3;
    float* sq = (float*)smem + sub * (3 * 32 * 64); float* sk = sq + 32 * 64; float* sg = sk + 32 * 64;
    float St[64];
#pragma unroll
    for (int d = 0; d < 64; ++d) St[d] = 0.f;
    for (int s0 = 0; s0 < S; s0 += 32) {
        __syncthreads();
        for (int i = e; i < 32 * 64; i += 128) { const int ss = i >> 6, d = i & 63; const size_t t = (size_t)b * S + s0 + ss;
            sq[i] = bf2f(p.gq[t * 256 + h * 64 + d]); sk[i] = bf2f(p.gk[t * 256 + h * 64 + d]); sg[i] = p.ga[t * 256 + h * 64 + d]; }
        __syncthreads();
        for (int ss = 0; ss < 32; ++ss) {
            const size_t t = (size_t)b * S + s0 + ss; const float v = bf2f(p.gv[t * 512 + h * 128 + e]); float o = 0.f;
#pragma unroll
            for (int d = 0; d < 64; ++d) { St[d] = sg[ss * 64 + d] * St[d] + sk[ss * 64 + d] * v; o += sq[ss * 64 + d] * St[d]; }
            p.oraw[t * 512 + h * 128 + e] = o;
        }
    }
    __syncthreads();
}
__device__ __forceinline__ void body_glanorm(const P& p, int vb) {
    const int idx = vb * NT + TIDX(); const int t = idx >> 2, h = idx & 3;
    const float* o = p.oraw + (size_t)t * 512 + h * 128; float ss = 0.f;
    for (int e = 0; e < 128; ++e) ss += o[e] * o[e];
    const float r = rsqrtf(ss * (1.f / 128.f) + 1e-6f);
    for (int e = 0; e < 128; ++e) p.gla[(size_t)t * 512 + h * 128 + e] = f2bf(o[e] * r * p.norm_g[h * 128 + e] * bf2f(p.rs[(size_t)t * 512 + h * 128 + e]));
}

__device__ __forceinline__ void body_proj(const P& p, int vb, char* smem) {
    const int n = (vb & 1) * NT + TIDX(), m0 = (vb >> 1) * 8;
    ngemm<512, true, false>((float*)smem, m0, p.w_pn, 1024, n, p.w_pg, 1024, n,
        [&](int m, int k) { return bf2f(p.onsa[(size_t)m * 512 + k]); }, [&](int m, int k) { return bf2f(p.gla[(size_t)m * 512 + k]); },
        [&](int m, float ya, float yb) { p.mixed[(size_t)m * 1024 + n] = f2bf(bf2f(p.sa[(size_t)m * 1024 + n]) * ya + bf2f(p.sb[(size_t)m * 1024 + n]) * yb); });
}
__device__ __forceinline__ void body_out(const P& p, int vb, char* smem) {
    const int n = (vb & 1) * NT + TIDX(), m0 = (vb >> 1) * 8;
    ngemm<1024, false, true>((float*)smem, m0, p.w_out, 1024, n, p.w_out, 1024, n,
        [&](int m, int k) { return bf2f(p.mixed[(size_t)m * 1024 + k]); }, [&](int m, int k) { return 0.f; },
        [&](int m, float z, float) { p.h1[(size_t)m * 1024 + n] = p.x[(size_t)m * 1024 + n] + z; });
}

__device__ __forceinline__ void body_route(const P& p, int vb, char* smem) {
    const int wave = TIDX() >> 6, lane = TIDX() & 63, t = vb * 8 + wave;
    const float4* hr = (const float4*)(p.h1 + (size_t)t * D);
    float v[16]; float ss = 0.f;
#pragma unroll
    for (int j = 0; j < 4; ++j) { const float4 a = hr[lane + 64 * j]; v[4 * j] = a.x; v[4 * j + 1] = a.y; v[4 * j + 2] = a.z; v[4 * j + 3] = a.w; ss += a.x * a.x + a.y * a.y + a.z * a.z + a.w * a.w; }
#pragma unroll
    for (int o = 1; o < 64; o <<= 1) ss += __shfl_xor(ss, o);
    const float rstd = rsqrtf(ss * (1.f / D) + 1e-6f);
#pragma unroll
    for (int j = 0; j < 4; ++j) {
        const float4 g = ((const float4*)p.g_ffn)[lane + 64 * j];
        v[4 * j] *= rstd * g.x; v[4 * j + 1] *= rstd * g.y; v[4 * j + 2] *= rstd * g.z; v[4 * j + 3] *= rstd * g.w;
        ushort4 o; o.x = f2bf(v[4 * j]); o.y = f2bf(v[4 * j + 1]); o.z = f2bf(v[4 * j + 2]); o.w = f2bf(v[4 * j + 3]);
        ((ushort4*)(p.vb + (size_t)t * D))[lane + 64 * j] = o;
    }
    float* sl = (float*)(smem + LDS_MISC) + wave * 40;
    for (int o = 0; o < 4; ++o) { float a = 0.f;
#pragma unroll
        for (int j = 0; j < 4; ++j)
#pragma unroll
            for (int e = 0; e < 4; ++e) a += v[4 * j + e] * p.w_grp[(size_t)(4 * (lane + 64 * j) + e) * 4 + o];
#pragma unroll
        for (int x = 1; x < 64; x <<= 1) a += __shfl_xor(a, x);
        if (lane == 0) sl[o] = a + p.b_grp[o]; }
    for (int o = 0; o < 32; ++o) { float a = 0.f;
#pragma unroll
        for (int j = 0; j < 4; ++j)
#pragma unroll
            for (int e = 0; e < 4; ++e) a += v[4 * j + e] * p.w_exp[(size_t)(4 * (lane + 64 * j) + e) * 32 + o];
#pragma unroll
        for (int x = 1; x < 64; x <<= 1) a += __shfl_xor(a, x);
        if (lane == 0) sl[4 + o] = a + p.b_exp[o]; }
    if (lane == 0) {
        int gs = 0; float gm = sl[0];
        for (int o = 1; o < 4; ++o) if (sl[o] > gm) { gm = sl[o]; gs = o; }
        float gsum = 0.f;
        for (int o = 0; o < 4; ++o) gsum += __expf(sl[o] - gm);
        const float pg = 1.f / gsum;
        const float* li = sl + 4 + gs * 8;
        int e0 = 0; float m0 = li[0];
        for (int e = 1; e < 8; ++e) if (li[e] > m0) { m0 = li[e]; e0 = e; }
        int e1 = -1; float m1 = -3e38f;
        for (int e = 0; e < 8; ++e) if (e != e0 && li[e] > m1) { m1 = li[e]; e1 = e; }
        const float p0 = 1.f, p1 = __expf(m1 - m0);
        const float w0 = pg * p0 / (p0 + p1), w1 = pg * p1 / (p0 + p1);
        const int x0 = gs * 8 + e0, x1 = gs * 8 + e1;
        const int s0 = (int)atomicAdd(&p.ctl[x0], 1u), s1 = (int)atomicAdd(&p.ctl[x1], 1u);
        p.list[(size_t)x0 * p.T + s0] = t; p.list[(size_t)x1 * p.T + s1] = t;
        p.tokexp[t * 2] = x0; p.tokexp[t * 2 + 1] = x1; p.tokslot[t * 2] = s0; p.tokslot[t * 2 + 1] = s1; p.tokw[t * 2] = w0; p.tokw[t * 2 + 1] = w1;
    }
}

__device__ __forceinline__ int* seg_bases(const P& p, char* smem) {
    int* sbase = (int*)(smem + LDS_MISC + 2048);
    __syncthreads();
    if (TIDX() == 0) { int acc = 0; for (int e = 0; e < NEXP; ++e) { sbase[e] = acc; acc += ((int)p.ctl[e] + 255) & ~255; } sbase[NEXP] = acc; }
    __syncthreads();
    return sbase;
}
__device__ __forceinline__ void body_moe1(const P& p, int vb, char* smem) {
    int* sbase = seg_bases(p, smem); int* stok = sbase + 40;
    const int r0 = vb * 8; if (r0 >= sbase[NEXP]) return;
    int e = 0; while (r0 >= sbase[e + 1]) ++e;
    const int cnt = (int)p.ctl[e];
    if (TIDX() < 8) { const int sl = r0 + TIDX() - sbase[e]; stok[TIDX()] = p.list[(size_t)e * p.T + (sl < cnt ? sl : 0)]; }
    __syncthreads();
    const int n = TIDX();
    const float* wg = p.w_gate + (size_t)e * 1024 * 512; const float* wu = p.w_up + (size_t)e * 1024 * 512;
    ngemm<1024, true, true>((float*)smem, 0, wg, 512, n, wu, 512, n,
        [&](int m, int k) { return bf2f(p.vb[(size_t)stok[m] * D + k]); }, [&](int m, int k) { return 0.f; },
        [&](int m, float zg, float zu) { p.H[(size_t)(r0 + m) * 512 + n] = f2bf(siluf_(zg) * zu); });
}
__device__ __forceinline__ void body_moe2(const P& p, int vb, char* smem) {
    int* sbase = seg_bases(p, smem);
    const int r0 = (vb >> 1) * 8; if (r0 >= sbase[NEXP]) return;
    int e = 0; while (r0 >= sbase[e + 1]) ++e;
    const int n = (vb & 1) * NT + TIDX();
    const float* wd = p.w_down + (size_t)e * 512 * 1024;
    ngemm<512, false, true>((float*)smem, r0, wd, 1024, n, wd, 1024, n,
        [&](int m, int k) { return bf2f(p.H[(size_t)m * 512 + k]); }, [&](int m, int k) { return 0.f; },
        [&](int m, float z, float) { p.Y[(size_t)m * 1024 + n] = f2bf(z); });
}
__device__ __forceinline__ void body_final(const P& p, int vb, char* smem) {
    int* sbase = seg_bases(p, smem);
    const int lane = TIDX() & 63, t = vb * 8 + (TIDX() >> 6);
    const int r0 = sbase[p.tokexp[t * 2]] + p.tokslot[t * 2], r1 = sbase[p.tokexp[t * 2 + 1]] + p.tokslot[t * 2 + 1];
    const float w0 = p.tokw[t * 2], w1 = p.tokw[t * 2 + 1];
    const float4* hr = (const float4*)(p.h1 + (size_t)t * D);
    float4 v[4]; float ss = 0.f;
#pragma unroll
    for (int j = 0; j < 4; ++j) {
        float4 a = hr[lane + 64 * j];
        const ushort4 y0 = ((const ushort4*)(p.Y + (size_t)r0 * D))[lane + 64 * j], y1 = ((const ushort4*)(p.Y + (size_t)r1 * D))[lane + 64 * j];
        a.x += w0 * bf2f(y0.x) + w1 * bf2f(y1.x); a.y += w0 * bf2f(y0.y) + w1 * bf2f(y1.y); a.z += w0 * bf2f(y0.z) + w1 * bf2f(y1.z); a.w += w0 * bf2f(y0.w) + w1 * bf2f(y1.w);
        v[j] = a; ss += a.x * a.x + a.y * a.y + a.z * a.z + a.w * a.w;
    }
#pragma unroll
    for (int o = 1; o < 64; o <<= 1) ss += __shfl_xor(ss, o);
    const float rstd = rsqrtf(ss * (1.f / D) + 1e-6f);
#pragma unroll
    for (int j = 0; j < 4; ++j) {
        const float4 g = ((const float4*)p.g_final)[lane + 64 * j];
        float4 o; o.x = v[j].x * rstd * g.x; o.y = v[j].y * rstd * g.y; o.z = v[j].z * rstd * g.z; o.w = v[j].w * rstd * g.w;
        ((float4*)(p.out + (size_t)t * D))[lane + 64 * j] = o;
    }
}

namespace pg8 {
#define PG8_LAS __attribute__((address_space(3)))
typedef short bf16x8 __attribute__((ext_vector_type(8)));
typedef float f32x4 __attribute__((ext_vector_type(4)));
typedef unsigned u32x4 __attribute__((ext_vector_type(4)));
typedef unsigned u32x2 __attribute__((ext_vector_type(2)));
constexpr int BM = 256, BK = 64, HALF = 128, HTB = HALF * BK * 2, STAGE_BYTES = 8 * HTB, NXCD = 8, WGM = 8;

__host__ __device__ __forceinline__ int lds_byte(int r, int c) { const int st = (r >> 4) * 2 + (c >> 5), rr = r & 15, cc = c & 31, ob = rr * 64 + cc * 2; return st * 1024 + (ob ^ (((ob >> 9) & 1) << 5)); }
__host__ __device__ __forceinline__ void stage_rc(int b, int& R, int& C) { const int st = b / 1024, sb = b % 1024, swz = sb ^ (((sb >> 9) & 1) << 5); R = (st >> 1) * 16 + swz / 64; C = (st & 1) * 32 + (swz % 64) / 2; }
__host__ __device__ __forceinline__ int perm32(int rho) { const int n = rho >> 4, i = rho & 15; return 8 * (i >> 2) + 4 * n + (i & 3); }

struct Unit { int pm, pn; const char* A; const char* B; int tag; };

struct TileOrder {
    int nM, nN, nwg, G, c;
    __device__ void init(int nM_, int nN_, int G_, int c_) { nM = nM_; nN = nN_; nwg = nM * nN; G = G_; c = c_; }
    __device__ bool next(int i, int& pm, int& pn) const {
        const long L = (long)i * G + c; if (L >= nwg) return false;
        int wgid = (int)L; { const int q = nwg / NXCD, r = nwg % NXCD, xcd = wgid % NXCD, off = wgid / NXCD; wgid = (xcd < r ? xcd * (q + 1) : r * (q + 1) + (xcd - r) * q) + off; }
        const int nig = WGM * nN, gid = wgid / nig, fm = gid * WGM, gsz = (nM - fm) < WGM ? (nM - fm) : WGM;
        pm = fm + ((wgid % nig) % gsz); pn = (wgid % nig) / gsz; return true;
    }
};
struct DenseSched {
    TileOrder o; const char* A; const char* B; int lda, ldb;
    __device__ void init(const void* A_, const void* B_, int M, int N, int lda_, int ldb_) { A = (const char*)A_; B = (const char*)B_; lda = lda_; ldb = ldb_; o.init(M / BM, N / BM, gridDim.x, blockIdx.x); }
    __device__ __forceinline__ bool next(int i, Unit& u) const { if (!o.next(i, u.pm, u.pn)) return false; u.A = A + (size_t)u.pm * BM * lda * 2; u.B = B + (size_t)u.pn * BM * ldb * 2; u.tag = 0; return true; }
    __device__ __forceinline__ unsigned arow(const Unit&, int r) const { return (unsigned)r * (unsigned)lda * 2u; }
};

__device__ __forceinline__ unsigned cvt_pk_bf16(float lo, float hi) { unsigned r; asm volatile("v_cvt_pk_bf16_f32 %0, %1, %2" : "=v"(r) : "v"(lo), "v"(hi)); return r; }

template <class Epi, class Sched, bool ALIGN_EPI, bool GATHER>
__device__ __forceinline__ void gemm_phase(PG8_LAS unsigned char* lds, const int K, const int lda, const int ldb, const Sched& S, const Epi& E) {
    const int tid = TIDX(), wid = __builtin_amdgcn_readfirstlane(tid >> 6), lane = tid & 63, wr = wid >> 2, wc = wid & 3, fr = lane & 15, fq = lane >> 4;
    const int nt = K / BK;
    int sR[2], sC[2];
    unsigned voffA[2], voffB[2];
#pragma unroll
    for (int i = 0; i < 2; ++i) { stage_rc(tid * 16 + i * 8192, sR[i], sC[i]); const int Rb = Epi::PERM ? ((sR[i] & ~31) + perm32(sR[i] & 31)) : sR[i];
        voffA[i] = (unsigned)(sR[i] * lda + sC[i]) * 2u; voffB[i] = (unsigned)(Rb * ldb + sC[i]) * 2u; }
    unsigned gA[2][2], gN[2][2];
    const size_t kstep = (size_t)(BK * 2);
    const size_t hstepA = (size_t)HALF * lda * 2, hstepB = (size_t)HALF * ldb * 2;
    const unsigned ldsw = (unsigned)wid * 1024u;
    const int aoff = lds_byte(wr * 64 + fr, fq * 8), boff = lds_byte(wc * 32 + fr, fq * 8);
#define PG8_SA(b, h) (((b) * 2 + (h)) * HTB)
#define PG8_SB(b, h) ((4 + (b) * 2 + (h)) * HTB)
#define PG8_GLDS(bufoff, gptr, i_) __builtin_amdgcn_global_load_lds((const unsigned*)(gptr), (PG8_LAS unsigned*)(lds + (bufoff) + ldsw + (i_) * 8192), 16, 0, 0)
#define PG8_STAGE_B(bufoff, gbase) do { _Pragma("unroll") for (int _i = 0; _i < 2; ++_i) PG8_GLDS(bufoff, (const char*)(gbase) + voffB[_i], _i); } while (0)
#define PG8_STAGE_A(bufoff, gb, h, NX) do { _Pragma("unroll") for (int _i = 0; _i < 2; ++_i) { \
        if constexpr (GATHER) { const unsigned _o = (NX) ? gN[h][_i] : gA[h][_i]; PG8_GLDS(bufoff, (const char*)(gb) + _o, _i); } \
        else { PG8_GLDS(bufoff, (const char*)(gb) + (h) * hstepA + voffA[_i], _i); } } } while (0)
#define PG8_LDA(dst, b, h) do { _Pragma("unroll") for (int m = 0; m < 4; ++m) _Pragma("unroll") for (int k = 0; k < 2; ++k) dst[m][k] = *(const PG8_LAS bf16x8*)(lds + PG8_SA(b, h) + aoff + m * 2048 + k * 1024); } while (0)
#define PG8_LDB(dst, b, h) do { _Pragma("unroll") for (int n = 0; n < 2; ++n) _Pragma("unroll") for (int k = 0; k < 2; ++k) dst[n][k] = *(const PG8_LAS bf16x8*)(lds + PG8_SB(b, h) + boff + n * 2048 + k * 1024); } while (0)
#define PG8_MMA(ai, bj, At, Bt) do { __builtin_amdgcn_s_setprio(1); _Pragma("unroll") for (int m = 0; m < 4; ++m) _Pragma("unroll") for (int n = 0; n < 2; ++n) _Pragma("unroll") for (int k = 0; k < 2; ++k) \
        acc[ai][bj][m][n] = __builtin_amdgcn_mfma_f32_16x16x32_bf16(Bt[n][k], At[m][k], acc[ai][bj][m][n], 0, 0, 0); __builtin_amdgcn_s_setprio(0); } while (0)
#define PG8_WAIT_V(n) asm volatile("s_waitcnt vmcnt(" #n ")" ::: "memory")
#define PG8_WAIT_L(n) asm volatile("s_waitcnt lgkmcnt(" #n ")" ::: "memory")
#define PG8_BAR __builtin_amdgcn_s_barrier()
#define PG8_SCHED __builtin_amdgcn_sched_barrier(0)
#define PG8_GOFF(dst, u) do { if constexpr (GATHER) { _Pragma("unroll") for (int _h = 0; _h < 2; ++_h) _Pragma("unroll") for (int _i = 0; _i < 2; ++_i) dst[_h][_i] = S.arow(u, _h * HALF + sR[_i]) + (unsigned)sC[_i] * 2u; } } while (0)
    Unit cur, nxt; int ui = 0;
    if (!S.next(0, cur)) return;
    f32x4 acc[2][2][4][2];
#pragma unroll
    for (int a = 0; a < 2; ++a)
#pragma unroll
        for (int b = 0; b < 2; ++b)
#pragma unroll
            for (int m = 0; m < 4; ++m)
#pragma unroll
                for (int n = 0; n < 2; ++n) acc[a][b][m][n] = (f32x4){0.f, 0.f, 0.f, 0.f};
    bf16x8 At[4][2], B0[2][2], B1[2][2];
    const char* cA = cur.A; const char* cB = cur.B;
    PG8_GOFF(gA, cur);
    if constexpr (GATHER) { PG8_WAIT_V(0); }
    PG8_STAGE_B(PG8_SB(0, 0), cB); PG8_STAGE_B(PG8_SB(0, 1), cB + hstepB); PG8_STAGE_A(PG8_SA(0, 0), cA, 0, false); PG8_STAGE_A(PG8_SA(0, 1), cA, 1, false);
    if (wr == 1) PG8_BAR;
    PG8_WAIT_V(2); PG8_BAR;
    PG8_STAGE_B(PG8_SB(1, 0), cB + kstep); PG8_STAGE_A(PG8_SA(1, 0), cA + kstep, 0, false); PG8_STAGE_B(PG8_SB(1, 1), cB + hstepB + kstep);
    PG8_WAIT_V(6); PG8_BAR;
    for (;;) {
        const bool has_next = S.next(ui + 1, nxt);
        const char* nA = has_next ? nxt.A : cA; const char* nB = has_next ? nxt.B : cB;
        if constexpr (GATHER) { if (has_next) { PG8_GOFF(gN, nxt); } else {
#pragma unroll
            for (int _h = 0; _h < 2; ++_h)
#pragma unroll
                for (int _i = 0; _i < 2; ++_i) gN[_h][_i] = gA[_h][_i]; } }
        for (int t = 0; t < nt; t += 2) {
            const bool last = (t == nt - 2);
            const char* a1 = cA + (size_t)(t + 1) * kstep;
            const char* a2 = last ? nA : cA + (size_t)(t + 2) * kstep; const char* b2 = last ? nB : cB + (size_t)(t + 2) * kstep;
            const char* a3 = a2 + kstep; const char* b3 = b2 + kstep;
            PG8_LDB(B0, 0, 0); PG8_LDB(B1, 0, 1); PG8_SCHED; PG8_LDA(At, 0, 0); PG8_STAGE_A(PG8_SA(1, 1), a1, 1, false);
            PG8_WAIT_V(8); PG8_WAIT_L(0); PG8_BAR; PG8_MMA(0, 0, At, B0); PG8_MMA(0, 1, At, B1); PG8_BAR; PG8_SCHED;
            PG8_LDA(At, 0, 1); PG8_STAGE_B(PG8_SB(0, 0), b2); PG8_STAGE_B(PG8_SB(0, 1), b2 + hstepB); PG8_STAGE_A(PG8_SA(0, 0), a2, 0, last);
            PG8_WAIT_V(8); PG8_WAIT_L(0); PG8_BAR; PG8_MMA(1, 0, At, B0); PG8_MMA(1, 1, At, B1); PG8_BAR; PG8_SCHED;
            PG8_LDB(B0, 1, 0); PG8_LDB(B1, 1, 1); PG8_SCHED; PG8_LDA(At, 1, 0); PG8_STAGE_A(PG8_SA(0, 1), a2, 1, last);
            PG8_WAIT_V(8); PG8_WAIT_L(0); PG8_BAR; PG8_MMA(0, 0, At, B0); PG8_MMA(0, 1, At, B1); PG8_BAR; PG8_SCHED;
            PG8_LDA(At, 1, 1); PG8_STAGE_B(PG8_SB(1, 0), b3); PG8_STAGE_B(PG8_SB(1, 1), b3 + hstepB); PG8_STAGE_A(PG8_SA(1, 0), a3, 0, last);
            PG8_WAIT_V(8); PG8_WAIT_L(0); PG8_BAR; PG8_MMA(1, 0, At, B0); PG8_MMA(1, 1, At, B1); PG8_BAR; PG8_SCHED;
        }
        if constexpr (ALIGN_EPI) { if (wr == 0) PG8_BAR; }
        E(acc, cur, wr, wc, fr, fq);
        if (!has_next) break;
#pragma unroll
        for (int a = 0; a < 2; ++a)
#pragma unroll
            for (int b = 0; b < 2; ++b)
#pragma unroll
                for (int m = 0; m < 4; ++m)
#pragma unroll
                    for (int n = 0; n < 2; ++n) acc[a][b][m][n] = (f32x4){0.f, 0.f, 0.f, 0.f};
        cur = nxt; cA = nA; cB = nB; ++ui;
        if constexpr (GATHER) {
#pragma unroll
            for (int _h = 0; _h < 2; ++_h)
#pragma unroll
                for (int _i = 0; _i < 2; ++_i) gA[_h][_i] = gN[_h][_i]; }
        if constexpr (ALIGN_EPI) { if (wr == 1) PG8_BAR; }
    }
    PG8_WAIT_V(0);
    if constexpr (!ALIGN_EPI) { if (wr == 0) PG8_BAR; }
    PG8_BAR;
#undef PG8_SA
#undef PG8_SB
#undef PG8_GLDS
#undef PG8_STAGE_A
#undef PG8_STAGE_B
#undef PG8_LDA
#undef PG8_LDB
#undef PG8_MMA
#undef PG8_WAIT_V
#undef PG8_WAIT_L
#undef PG8_BAR
#undef PG8_SCHED
#undef PG8_GOFF
}
}

typedef float f32x4_t __attribute__((ext_vector_type(4)));
__device__ __forceinline__ int inproj_row(int j) {
    if (j < 512) { const int h = j >> 6, d = j & 63; return h * 64 + 2 * (d & 31) + (d >> 5); }
    if (j < 1280) { const int seg = (j - 512) >> 7, cc = (j - 512) & 127; int col = cc; if (seg == 2 || seg == 4) { const int g = cc >> 6, d = cc & 63; col = g * 64 + 2 * (d & 31) + (d >> 5); } return (2 + (seg >> 1)) * 256 + (seg & 1) * 128 + col; }
    if (j < 1304) return 11 * 256 + (j - 1280);
    if (j < 1560) return 5 * 256 + (j - 1304);
    if (j < 1816) return 6 * 256 + (j - 1560);
    if (j < 2328) return 7 * 256 + (j - 1816);
    if (j < 2344) return 11 * 256 + 32 + (j - 2328);
    if (j < 2856) return 9 * 256 + (j - 2344);
    if (j < 3880) return 12 * 256 + (j - 2856);
    return 16 * 256 + (j - 3880);
}
__device__ __forceinline__ unsigned pk2(float lo, float hi) { return (unsigned)f2bf(lo) | ((unsigned)f2bf(hi) << 16); }
template <class RM>
__device__ __forceinline__ void transpose_item(const float* W, int ldw, int N, bf16* WT, int ldt, float* scr, int k0, int n0, int lane, RM rm) {
    const int nn = n0 + (lane & 31);
#pragma unroll 8
    for (int i = 0; i < 32; ++i) { const int kk = 2 * i + (lane >> 5); scr[kk * 33 + (lane & 31)] = nn < N ? W[(size_t)(k0 + kk) * ldw + nn] : 0.f; }
    asm volatile("s_waitcnt lgkmcnt(0)" ::: "memory");
    const int c = lane & 7;
#pragma unroll
    for (int j = 0; j < 4; ++j) { const int n = (lane >> 3) + 8 * j; const float* s = scr + (8 * c) * 33 + n;
        uint4 o; o.x = pk2(s[0 * 33], s[1 * 33]); o.y = pk2(s[2 * 33], s[3 * 33]); o.z = pk2(s[4 * 33], s[5 * 33]); o.w = pk2(s[6 * 33], s[7 * 33]);
        const int row = (n0 + n < N) ? rm(n0 + n) : -1;
        if (row >= 0) *(uint4*)(WT + (size_t)row * ldt + k0 + 8 * c) = o; }
    asm volatile("s_waitcnt lgkmcnt(0)" ::: "memory");
}
constexpr int PREP_I_WIN = 16 * 154, PREP_I_C1 = 4 * 128, PREP_I_PN = 256, PREP_I_PG = 256, PREP_I_WO = 512, PREP_I_EXP = 3 * 32 * 256;
constexpr int PREP_ITEMS = PREP_I_WIN + PREP_I_C1 + PREP_I_PN + PREP_I_PG + PREP_I_WO + PREP_I_EXP;
__device__ __forceinline__ void prep_item(const P& p, int it, float* scr, int lane) {
    if (it < PREP_I_WIN) { const int kb = it / 154, nb = it % 154; transpose_item(p.w_in, INW, INW, p.Wt_in, 1024, scr, kb * 64, nb * 32, lane, [](int n) { return inproj_row(n); }); return; }
    it -= PREP_I_WIN;
    if (it < PREP_I_C1) { const int mat = it >> 7, r = it & 127, kb = r >> 3, nb = r & 7, kv = mat >> 1, half = mat & 1;
        const float* W = (kv ? p.cw1_v : p.cw1_k) + (size_t)half * 1024 * 256;
        transpose_item(W, 256, 256, p.Wc1 + (size_t)kv * 512 * 1024, 1024, scr, kb * 64, nb * 32, lane, [half](int n) { return half * 256 + n; }); return; }
    it -= PREP_I_C1;
    if (it < PREP_I_PN) { transpose_item(p.w_pn, 1024, 1024, p.Wpn, 512, scr, (it >> 5) * 64, (it & 31) * 32, lane, [](int n) { return n; }); return; }
    it -= PREP_I_PN;
    if (it < PREP_I_PG) { transpose_item(p.w_pg, 1024, 1024, p.Wpg, 512, scr, (it >> 5) * 64, (it & 31) * 32, lane, [](int n) { return n; }); return; }
    it -= PREP_I_PG;
    if (it < PREP_I_WO) { transpose_item(p.w_out, 1024, 1024, p.Wo, 1024, scr, (it >> 5) * 64, (it & 31) * 32, lane, [](int n) { return n; }); return; }
    it -= PREP_I_WO;
    { const int which = it / (32 * 256), r = it % (32 * 256), e = r >> 8, r2 = r & 255;
        if (which == 0) transpose_item(p.w_gate + (size_t)e * 1024 * 512, 512, 512, p.Wgu + (size_t)e * 1024 * 1024, 1024, scr, (r2 >> 4) * 64, (r2 & 15) * 32, lane, [](int n) { return (n >> 7) * 256 + (n & 127); });
        else if (which == 1) transpose_item(p.w_up + (size_t)e * 1024 * 512, 512, 512, p.Wgu + (size_t)e * 1024 * 1024, 1024, scr, (r2 >> 4) * 64, (r2 & 15) * 32, lane, [](int n) { return (n >> 7) * 256 + 128 + (n & 127); });
        else transpose_item(p.w_down + (size_t)e * 512 * 1024, 1024, 1024, p.Wd + (size_t)e * 1024 * 512, 512, scr, (r2 >> 5) * 64, (r2 & 31) * 32, lane, [](int n) { return n; }); }
}
__device__ __forceinline__ void phase_prep(const P& p, char* smem) {
    const int wave = TIDX() >> 6, lane = TIDX() & 63;
    float* scr = (float*)smem + wave * (64 * 33);
    const int gw = blockIdx.x * 8 + wave, NGW = gridDim.x * 8;
    for (int it = gw; it < PREP_ITEMS; it += NGW) prep_item(p, it, scr, lane);
    for (int i = blockIdx.x * NT + TIDX(); i < 216 * 128; i += gridDim.x * NT) { int r = i >> 7; r = r < 8 ? 24 + r : 40 + r; *(uint4*)(p.Wt_in + (size_t)(11 * 256 + r) * 1024 + (i & 127) * 8) = make_uint4(0, 0, 0, 0); }
    for (int vb = blockIdx.x; vb < p.T / 8; vb += gridDim.x) body_rms(p, vb);
    for (int vb = blockIdx.x; vb < p.T * 32 / NT; vb += gridDim.x) body_cs(p, vb);
}

struct EpiInA {
    static constexpr bool PERM = true;
    P p;
    __device__ __forceinline__ static void rope4(const float* cs, int t, int i0, const pg8::f32x4& v0, const pg8::f32x4& v1, float sc, pg8::u32x2& lo, pg8::u32x2& hi) {
        const f32x4_t c = *(const f32x4_t*)(cs + (size_t)t * 64 + i0), s = *(const f32x4_t*)(cs + (size_t)t * 64 + 32 + i0);
        const float a0 = (v0[0] * c[0] - v0[1] * s[0]) * sc, b0 = (v0[1] * c[0] + v0[0] * s[0]) * sc;
        const float a1 = (v0[2] * c[1] - v0[3] * s[1]) * sc, b1 = (v0[3] * c[1] + v0[2] * s[1]) * sc;
        const float a2 = (v1[0] * c[2] - v1[1] * s[2]) * sc, b2 = (v1[1] * c[2] + v1[0] * s[2]) * sc;
        const float a3 = (v1[2] * c[3] - v1[3] * s[3]) * sc, b3 = (v1[3] * c[3] + v1[2] * s[3]) * sc;
        lo.x = pk2(a0, a1); lo.y = pk2(a2, a3); hi.x = pk2(b0, b1); hi.y = pk2(b2, b3);
    }
    __device__ __forceinline__ static pg8::u32x4 pack8(const pg8::f32x4& v0, const pg8::f32x4& v1) { pg8::u32x4 w; w.x = pk2(v0[0], v0[1]); w.y = pk2(v0[2], v0[3]); w.z = pk2(v1[0], v1[1]); w.w = pk2(v1[2], v1[3]); return w; }
    __device__ __forceinline__ void operator()(const pg8::f32x4 (&acc)[2][2][4][2], const pg8::Unit& u, int wr, int wc, int fr, int fq) const {
        const int pn = u.pn, c8 = wc * 32 + 8 * fq; const size_t seg = kvseg(p);
#pragma unroll
        for (int ai = 0; ai < 2; ++ai)
#pragma unroll
            for (int m = 0; m < 4; ++m) {
                const int t = u.pm * 256 + ai * 128 + wr * 64 + m * 16 + fr; const int b = t / S, s = t % S;
#pragma unroll
                for (int bj = 0; bj < 2; ++bj) {
                    const pg8::f32x4 v0 = acc[ai][bj][m][0], v1 = acc[ai][bj][m][1];
                    if (pn <= 1) {
                        const int cq = pn * 256 + bj * 128 + c8, h = cq >> 6, i0 = (cq & 63) >> 1; pg8::u32x2 lo, hi;
                        rope4(p.cs, t, i0, v0, v1, 0.125f, lo, hi);
                        bf16* dst = p.q + (size_t)t * 512 + h * 64 + i0; *(pg8::u32x2*)dst = lo; *(pg8::u32x2*)(dst + 32) = hi;
                    } else if (pn <= 4) {
                        const int sgi = (pn - 2) * 2 + bj, g = c8 >> 6; bf16* base = p.kv6 + (size_t)sgi * seg + ((size_t)(b * 2 + g) * S + s) * 64;
                        if (bj == 0 && pn >= 3) { const int i0 = (c8 & 63) >> 1; pg8::u32x2 lo, hi; rope4(p.cs, t, i0, v0, v1, 1.f, lo, hi); *(pg8::u32x2*)(base + i0) = lo; *(pg8::u32x2*)(base + 32 + i0) = hi; }
                        else *(pg8::u32x4*)(base + (c8 & 63)) = pack8(v0, v1);
                    } else if (pn == 5) { *(pg8::u32x4*)(p.gq + (size_t)t * 256 + bj * 128 + c8) = pack8(v0 * 0.125f, v1 * 0.125f);
                    } else if (pn == 6) { *(pg8::u32x4*)(p.gk + (size_t)t * 256 + bj * 128 + c8) = pack8(v0, v1);
                    } else if (pn <= 8) { *(pg8::u32x4*)(p.gv + (size_t)t * 512 + (pn - 7) * 256 + bj * 128 + c8) = pack8(v0, v1);
                    } else if (pn <= 10) {
                        pg8::f32x4 a, c;
#pragma unroll
                        for (int e = 0; e < 4; ++e) { a[e] = siluf_(v0[e]); c[e] = siluf_(v1[e]); }
                        *(pg8::u32x4*)(p.rs + (size_t)t * 512 + (pn - 9) * 256 + bj * 128 + c8) = pack8(a, c);
                    } else {
                        if (bj == 0) {
                            if (c8 < 24) { float* d = p.gates + (size_t)t * 24 + c8;
#pragma unroll
                                for (int e = 0; e < 4; ++e) { d[e] = sigmoidf_(v0[e]); d[4 + e] = sigmoidf_(v1[e]); } }
                            else if (c8 >= 32 && c8 < 48) { float* d = p.alow + (size_t)t * 16 + (c8 - 32);
#pragma unroll
                                for (int e = 0; e < 4; ++e) { d[e] = v0[e]; d[4 + e] = v1[e]; } }
                        }
                    }
                }
            }
    }
};
struct EpiSig {
    static constexpr bool PERM = true;
    bf16* sa; bf16* sb;
    __device__ __forceinline__ void operator()(const pg8::f32x4 (&acc)[2][2][4][2], const pg8::Unit& u, int wr, int wc, int fr, int fq) const {
        bf16* base = (u.pn < 4 ? sa : sb) + (u.pn & 3) * 256 + wc * 32 + 8 * fq;
#pragma unroll
        for (int ai = 0; ai < 2; ++ai)
#pragma unroll
            for (int m = 0; m < 4; ++m) { const int t = u.pm * 256 + ai * 128 + wr * 64 + m * 16 + fr;
#pragma unroll
                for (int bj = 0; bj < 2; ++bj) { pg8::f32x4 a, c;
#pragma unroll
                    for (int e = 0; e < 4; ++e) { a[e] = sigmoidf_(acc[ai][bj][m][0][e]); c[e] = sigmoidf_(acc[ai][bj][m][1][e]); }
                    *(pg8::u32x4*)(base + (size_t)t * 1024 + bj * 128) = EpiInA::pack8(a, c); } }
    }
};
__device__ __forceinline__ void phase_inA(const P& p, char* smem) {
    pg8::DenseSched S; S.init(p.u, p.Wt_in, p.T, 3072, 1024, 1024);
    EpiInA E{p};
    pg8::gemm_phase<EpiInA, pg8::DenseSched, true, false>((PG8_LAS unsigned char*)smem, 1024, 1024, 1024, S, E);
}
__device__ __forceinline__ void phase_inB(const P& p, char* smem) {
    pg8::DenseSched S; S.init(p.u, p.Wt_in + (size_t)3072 * 1024, p.T, 2048, 1024, 1024);
    EpiSig E{p.sa, p.sb};
    pg8::gemm_phase<EpiSig, pg8::DenseSched, true, false>((PG8_LAS unsigned char*)smem, 1024, 1024, 1024, S, E);
}

struct EpiProj {
    static constexpr bool PERM = true;
    const bf16* g; bf16* mixed; int pass;
    __device__ __forceinline__ void operator()(const pg8::f32x4 (&acc)[2][2][4][2], const pg8::Unit& u, int wr, int wc, int fr, int fq) const {
        const int col0 = u.pn * 256 + wc * 32 + 8 * fq;
#pragma unroll
        for (int ai = 0; ai < 2; ++ai)
#pragma unroll
            for (int m = 0; m < 4; ++m) { const size_t t = (size_t)(u.pm * 256 + ai * 128 + wr * 64 + m * 16 + fr);
#pragma unroll
                for (int bj = 0; bj < 2; ++bj) { const size_t off = t * 1024 + col0 + bj * 128;
                    const uint4 gv = *(const uint4*)(g + off); const unsigned gw[4] = {gv.x, gv.y, gv.z, gv.w};
                    float r[8];
#pragma unroll
                    for (int e = 0; e < 4; ++e) { const float a = e < 2 ? acc[ai][bj][m][0][2 * e] : acc[ai][bj][m][1][2 * e - 4], b = e < 2 ? acc[ai][bj][m][0][2 * e + 1] : acc[ai][bj][m][1][2 * e - 3];
                        r[2 * e] = __uint_as_float(gw[e] << 16) * a; r[2 * e + 1] = __uint_as_float(gw[e] & 0xffff0000u) * b; }
                    if (pass) { const uint4 mv = *(const uint4*)(mixed + off); const unsigned mw[4] = {mv.x, mv.y, mv.z, mv.w};
#pragma unroll
                        for (int e = 0; e < 4; ++e) { r[2 * e] += __uint_as_float(mw[e] << 16); r[2 * e + 1] += __uint_as_float(mw[e] & 0xffff0000u); } }
                    uint4 o; o.x = pk2(r[0], r[1]); o.y = pk2(r[2], r[3]); o.z = pk2(r[4], r[5]); o.w = pk2(r[6], r[7]);
                    *(uint4*)(mixed + off) = o; } }
    }
};
struct EpiOut {
    static constexpr bool PERM = false;
    const float* x; float* h1;
    __device__ __forceinline__ void operator()(const pg8::f32x4 (&acc)[2][2][4][2], const pg8::Unit& u, int wr, int wc, int fr, int fq) const {
        const int col0 = u.pn * 256 + wc * 32 + 4 * fq;
#pragma unroll
        for (int ai = 0; ai < 2; ++ai)
#pragma unroll
            for (int m = 0; m < 4; ++m) { const size_t off = (size_t)(u.pm * 256 + ai * 128 + wr * 64 + m * 16 + fr) * 1024 + col0;
#pragma unroll
                for (int bj = 0; bj < 2; ++bj)
#pragma unroll
                    for (int n = 0; n < 2; ++n) { const pg8::f32x4 xv = *(const pg8::f32x4*)(x + off + bj * 128 + n * 16); *(pg8::f32x4*)(h1 + off + bj * 128 + n * 16) = xv + acc[ai][bj][m][n]; } }
    }
};
__device__ __forceinline__ void phase_proj(const P& p, char* smem) {
    { pg8::DenseSched S; S.init(p.onsa, p.Wpn, p.T, 1024, 512, 512); EpiProj E{p.sa, p.mixed, 0};
      pg8::gemm_phase<EpiProj, pg8::DenseSched, true, false>((PG8_LAS unsigned char*)smem, 512, 512, 512, S, E); }
    { pg8::DenseSched S; S.init(p.gla, p.Wpg, p.T, 1024, 512, 512); EpiProj E{p.sb, p.mixed, 1};
      pg8::gemm_phase<EpiProj, pg8::DenseSched, true, false>((PG8_LAS unsigned char*)smem, 512, 512, 512, S, E); }
}
__device__ __forceinline__ void phase_out(const P& p, char* smem) {
    pg8::DenseSched S; S.init(p.mixed, p.Wo, p.T, 1024, 1024, 1024); EpiOut E{p.x, p.h1};
    pg8::gemm_phase<EpiOut, pg8::DenseSched, true, false>((PG8_LAS unsigned char*)smem, 1024, 1024, 1024, S, E);
}

struct ExpertSched {
    const int* ub;
    const int* sb_;
    const unsigned* cnt; const int* list; int T;
    const char* A; const char* B; int lda, ldb; size_t bstride;
    int npn, G, c; bool gather;
    __device__ __forceinline__ bool next(int i, pg8::Unit& u) const {
        const int L = i * G + c; if (L >= ub[NEXP]) return false;
        int e = 0; while (L >= ub[e + 1]) ++e;
        const int rem = L - ub[e], tiles = (ub[e + 1] - ub[e]) / npn, pn = rem / tiles, pml = rem % tiles;
        u.pm = sb_[e] / 256 + pml; u.pn = pn; u.tag = e | (pml << 8);
        u.A = gather ? A : A + (size_t)u.pm * 256 * lda * 2; u.B = B + (size_t)e * bstride + (size_t)pn * 256 * ldb * 2; return true;
    }
    __device__ __forceinline__ unsigned arow(const pg8::Unit& u, int r) const {
        const int e = u.tag & 255, sl = (u.tag >> 8) * 256 + r; const int tok = list[(size_t)e * T + (sl < (int)cnt[e] ? sl : 0)];
        return (unsigned)tok * (unsigned)lda * 2u;
    }
};
__device__ __forceinline__ void expert_tables(const P& p, char* smem, int npn, int*& ub, int*& sb_) {
    ub = (int*)(smem + LDS_MISC + 1024); sb_ = ub + 40;
    __syncthreads();
    if (TIDX() == 0) { int ua = 0, sa = 0; for (int e = 0; e < NEXP; ++e) { ub[e] = ua; sb_[e] = sa; const int tl = ((int)p.ctl[e] + 255) >> 8; ua += tl * npn; sa += tl * 256; } ub[NEXP] = ua; sb_[NEXP] = sa; }
    __syncthreads();
}
struct EpiMoe1 {
    static constexpr bool PERM = true;
    bf16* H;
    __device__ __forceinline__ void operator()(const pg8::f32x4 (&acc)[2][2][4][2], const pg8::Unit& u, int wr, int wc, int fr, int fq) const {
        const int col0 = u.pn * 128 + wc * 32 + 8 * fq;
#pragma unroll
        for (int ai = 0; ai < 2; ++ai)
#pragma unroll
            for (int m = 0; m < 4; ++m) { const size_t row = (size_t)(u.pm * 256 + ai * 128 + wr * 64 + m * 16 + fr);
                pg8::f32x4 a, b;
#pragma unroll
                for (int e = 0; e < 4; ++e) { a[e] = siluf_(acc[ai][0][m][0][e]) * acc[ai][1][m][0][e]; b[e] = siluf_(acc[ai][0][m][1][e]) * acc[ai][1][m][1][e]; }
                *(pg8::u32x4*)(H + row * 512 + col0) = EpiInA::pack8(a, b); }
    }
};
struct EpiMoe2 {
    static constexpr bool PERM = true;
    bf16* Y;
    __device__ __forceinline__ void operator()(const pg8::f32x4 (&acc)[2][2][4][2], const pg8::Unit& u, int wr, int wc, int fr, int fq) const {
        const int col0 = u.pn * 256 + wc * 32 + 8 * fq;
#pragma unroll
        for (int ai = 0; ai < 2; ++ai)
#pragma unroll
            for (int m = 0; m < 4; ++m) { const size_t row = (size_t)(u.pm * 256 + ai * 128 + wr * 64 + m * 16 + fr);
#pragma unroll
                for (int bj = 0; bj < 2; ++bj) *(pg8::u32x4*)(Y + row * 1024 + col0 + bj * 128) = EpiInA::pack8(acc[ai][bj][m][0], acc[ai][bj][m][1]); }
    }
};
__device__ __forceinline__ void phase_moe1(const P& p, char* smem) {
    int *ub, *sb_; expert_tables(p, smem, 4, ub, sb_);
    ExpertSched S{ub, sb_, p.ctl, p.list, p.T, (const char*)p.vb, (const char*)p.Wgu, 1024, 1024, (size_t)1024 * 1024 * 2, 4, (int)gridDim.x, (int)blockIdx.x, true};
    EpiMoe1 E{p.H};
    pg8::gemm_phase<EpiMoe1, ExpertSched, true, true>((PG8_LAS unsigned char*)smem, 1024, 1024, 1024, S, E);
}
__device__ __forceinline__ void phase_moe2(const P& p, char* smem) {
    int *ub, *sb_; expert_tables(p, smem, 4, ub, sb_);
    ExpertSched S{ub, sb_, p.ctl, p.list, p.T, (const char*)p.H, (const char*)p.Wd, 512, 512, (size_t)1024 * 512 * 2, 4, (int)gridDim.x, (int)blockIdx.x, false};
    EpiMoe2 E{p.Y};
    pg8::gemm_phase<EpiMoe2, ExpertSched, true, false>((PG8_LAS unsigned char*)smem, 512, 512, 512, S, E);
}

template <int ST> __device__ __forceinline__ void run_stage(const P& p, char* smem, int first, int stride) {
    const int nvb = stage_nvb(ST, p.T);
    for (int vb = first; vb < nvb; vb += stride) {
        if constexpr (ST == ST_RMS) body_rms(p, vb);
        else if constexpr (ST == ST_CS) body_cs(p, vb);
        else if constexpr (ST == ST_INPROJ) body_inproj(p, vb, smem);
        else if constexpr (ST == ST_CMP1) body_cmp1(p, vb, smem);
        else if constexpr (ST == ST_CMP2) body_cmp2(p, vb);
        else if constexpr (ST == ST_NSACMP) body_nsacmp(p, vb, smem);
        else if constexpr (ST == ST_NSAATT) body_nsaatt(p, vb);
        else if constexpr (ST == ST_GLAA) body_glaa(p, vb);
        else if constexpr (ST == ST_GLASCAN) body_glascan(p, vb, smem);
        else if constexpr (ST == ST_GLANORM) body_glanorm(p, vb);
        else if constexpr (ST == ST_PROJ) body_proj(p, vb, smem);
        else if constexpr (ST == ST_OUT) body_out(p, vb, smem);
        else if constexpr (ST == ST_ROUTE) body_route(p, vb, smem);
        else if constexpr (ST == ST_MOE1) body_moe1(p, vb, smem);
        else if constexpr (ST == ST_MOE2) body_moe2(p, vb, smem);
        else if constexpr (ST == ST_FINAL) body_final(p, vb, smem);
    }
}
template <int ST> __global__ void __launch_bounds__(NT) k_stage(P p) {
    extern __shared__ __attribute__((aligned(16))) char smem[];
    run_stage<ST>(p, smem, blockIdx.x, gridDim.x);
}
__global__ void __launch_bounds__(NT) k_mega(P p) {
    extern __shared__ __attribute__((aligned(16))) char smem[];
    cg::grid_group grid = cg::this_grid();
    const int b0 = blockIdx.x, G = gridDim.x;
    if (b0 == 0 && TIDX() < NEXP) p.ctl[TIDX()] = 0u;
    phase_prep(p, smem); grid.sync();
    phase_inA(p, smem); grid.sync();
    run_stage<ST_CMP1>(p, smem, b0, G); run_stage<ST_GLAA>(p, smem, b0, G); grid.sync();
    run_stage<ST_CMP2>(p, smem, b0, G); run_stage<ST_GLASCAN>(p, smem, G - 1 - b0, G); grid.sync();
    run_stage<ST_NSACMP>(p, smem, b0, G); run_stage<ST_GLANORM>(p, smem, b0, G); grid.sync();
    run_stage<ST_NSAATT>(p, smem, b0, G); grid.sync();
    phase_inB(p, smem); grid.sync();
    phase_proj(p, smem); grid.sync();
    phase_out(p, smem); grid.sync();
    run_stage<ST_ROUTE>(p, smem, b0, G); grid.sync();
    phase_moe1(p, smem); grid.sync();
    phase_moe2(p, smem); grid.sync();
    run_stage<ST_FINAL>(p, smem, b0, G);
}

enum Phase { PH_PREP = 0, PH_INA, PH_INB, PH_PROJ, PH_OUT, PH_MOE1, PH_MOE2 };
template <int PH> __global__ void __launch_bounds__(NT) k_phase(P p) {
    extern __shared__ __attribute__((aligned(16))) char smem[];
    if constexpr (PH == PH_PREP) phase_prep(p, smem);
    else if constexpr (PH == PH_INA) phase_inA(p, smem);
    else if constexpr (PH == PH_INB) phase_inB(p, smem);
    else if constexpr (PH == PH_PROJ) phase_proj(p, smem);
    else if constexpr (PH == PH_OUT) phase_out(p, smem);
    else if constexpr (PH == PH_MOE1) phase_moe1(p, smem);
    else if constexpr (PH == PH_MOE2) phase_moe2(p, smem);
}
template <class TT> __device__ __forceinline__ float ldf(const TT* p, size_t i);
template <> __device__ __forceinline__ float ldf<bf16>(const bf16* p, size_t i) { return bf2f(p[i]); }
template <> __device__ __forceinline__ float ldf<float>(const float* p, size_t i) { return p[i]; }
template <class TT> __global__ void __launch_bounds__(256) k_compare(const TT* a, const TT* b, size_t n, float* err, int slot) {
    float num = 0.f, den = 0.f;
    for (size_t i = (size_t)blockIdx.x * 256 + TIDX(); i < n; i += (size_t)gridDim.x * 256) { const float x = ldf<TT>(a, i), y = ldf<TT>(b, i); const float d = x - y; num += (d == d) ? d * d : 1e30f; den += y * y; }
#pragma unroll
    for (int o = 1; o < 64; o <<= 1) { num += __shfl_xor(num, o); den += __shfl_xor(den, o); }
    if ((TIDX() & 63) == 0) { atomicAdd(err + 2 * slot, num); atomicAdd(err + 2 * slot + 1, den); }
}
__global__ void __launch_bounds__(256) k_report(float* out, size_t n, const float* err, int nslots, float tol) {
    int code = 0;
    for (int s = 0; s < nslots; ++s) { const float num = err[2 * s], den = err[2 * s + 1]; const bool bad = !(num <= tol * tol * den) || !(den > 0.f); if (bad) { code = s + 1; break; } }
    if (code == 0) return;
    const float f = 1.f + 0.1f * (float)code;
    for (size_t i = (size_t)blockIdx.x * 256 + TIDX(); i < n; i += (size_t)gridDim.x * 256) out[i] *= f;
}

static void set_inputs(P& p, void* const* d_in) {
    const float* const* in = (const float* const*)d_in;
    p.x = in[0]; p.pos = (const int*)d_in[1]; p.g_mix = in[2]; p.w_in = in[3];
    p.cpos_k = in[4]; p.cw1_k = in[5]; p.cb1_k = in[6]; p.cw2_k = in[7]; p.cb2_k = in[8];
    p.cpos_v = in[9]; p.cw1_v = in[10]; p.cb1_v = in[11]; p.cw2_v = in[12]; p.cb2_v = in[13];
    p.w_a2 = in[14]; p.b_a = in[15]; p.norm_g = in[16]; p.w_pn = in[17]; p.w_pg = in[18]; p.w_out = in[19];
    p.g_ffn = in[20]; p.w_grp = in[21]; p.b_grp = in[22]; p.w_exp = in[23]; p.b_exp = in[24]; p.w_gate = in[25]; p.w_up = in[26]; p.w_down = in[27]; p.g_final = in[28];
}
constexpr size_t MiB = 1u << 20;
static void layout_ref(P& p, char* small, char* act, char* scratch, float* out, int nb) {
    const size_t q = (MiB / 4) * nb;
    p.nb = nb; p.T = nb * S; p.out = out;
    p.ctl = (unsigned*)small; p.sel = (u64*)(small + q / 16 * 1); p.kcmp = (bf16*)(small + q / 2); p.vcmp = (bf16*)(small + q / 4 * 3);
    p.tokslot = (int*)(small + q); p.tokexp = (int*)(small + q + q / 8); p.tokw = (float*)(small + q + q / 4);
    p.alow = (float*)(small + 2 * q); p.gates = (float*)(small + 3 * q); p.cs = (float*)(small + 5 * q); p.hcmp = (float*)(small + 9 * q); p.list = (int*)(small + 13 * q);
    p.u = (bf16*)act; p.ocmp = (float*)act; p.mixed = (bf16*)act; p.vb = (bf16*)act;
    p.q = (bf16*)(act + 32 * q); p.kv6 = (bf16*)(act + 48 * q);
    p.gq = (bf16*)(act + 73 * q); p.gk = (bf16*)(act + 81 * q); p.gv = (bf16*)(act + 89 * q); p.rs = (bf16*)(act + 105 * q);
    p.H = (bf16*)(act + 32 * q);
    p.sa = (bf16*)(act + 123 * q); p.sb = (bf16*)(act + 155 * q); p.onsa = (bf16*)(act + 187 * q); p.gla = (bf16*)(act + 203 * q);
    p.Y = (bf16*)(act + 123 * q);
    p.ga = (float*)scratch; p.oraw = (float*)(scratch + 16 * q); p.h1 = (float*)(scratch + 48 * q);
}
static void layout_compact(P& p, char* ws, float* out) {
    p.nb = NB; p.T = NB * S; p.out = out;
    char* small = ws; const size_t q = MiB;
    p.ctl = (unsigned*)small; p.sel = (u64*)(small + q / 16 * 1); p.kcmp = (bf16*)(small + q / 2); p.vcmp = (bf16*)(small + q / 4 * 3);
    p.tokslot = (int*)(small + q); p.tokexp = (int*)(small + q + q / 8); p.tokw = (float*)(small + q + q / 4);
    p.alow = (float*)(small + 2 * q); p.gates = (float*)(small + 3 * q); p.cs = (float*)(small + 5 * q); p.hcmp = (float*)(small + 9 * q); p.list = (int*)(small + 13 * q);
    p.u = (bf16*)(ws + 128 * MiB); p.vb = (bf16*)(ws + 128 * MiB);
    p.q = (bf16*)(ws + 160 * MiB); p.kv6 = (bf16*)(ws + 176 * MiB); p.gq = (bf16*)(ws + 201 * MiB); p.gk = (bf16*)(ws + 209 * MiB); p.gv = (bf16*)(ws + 217 * MiB); p.rs = (bf16*)(ws + 233 * MiB);
    p.ga = (float*)(ws + 249 * MiB); p.ocmp = (float*)(ws + 249 * MiB);
    p.sa = (bf16*)(ws + 160 * MiB); p.sb = (bf16*)(ws + 192 * MiB); p.mixed = (bf16*)(ws + 224 * MiB);
    p.H = (bf16*)(ws + 160 * MiB); p.Y = (bf16*)(ws + 48 * MiB);
    p.onsa = (bf16*)out; p.gla = (bf16*)((char*)out + 16 * MiB); p.oraw = (float*)((char*)out + 32 * MiB); p.h1 = out;
}
static void layout_weights(P& p, char* w) {
    p.Wd = (bf16*)w; p.Wgu = (bf16*)(w + 32 * MiB); p.Wt_in = (bf16*)(w + 96 * MiB); p.Wc1 = (bf16*)(w + 106 * MiB);
    p.Wpn = (bf16*)(w + 108 * MiB); p.Wpg = (bf16*)(w + 109 * MiB); p.Wo = (bf16*)(w + 110 * MiB);
}

template <int ST> static void launch_stage(const P& p, hipStream_t stream) {
    static bool attr = false;
    if (!attr) { (void)hipFuncSetAttribute((const void*)k_stage<ST>, hipFuncAttributeMaxDynamicSharedMemorySize, LDS_BYTES); attr = true; }
    int nvb = stage_nvb(ST, p.T); if (nvb > 16384) nvb = 16384;
    hipLaunchKernelGGL(k_stage<ST>, dim3(nvb), dim3(NT), LDS_BYTES, stream, p);
}
template <int PH> static void launch_phase(const P& p, hipStream_t stream, int grid = 40) {
    static bool attr = false;
    if (!attr) { (void)hipFuncSetAttribute((const void*)k_phase<PH>, hipFuncAttributeMaxDynamicSharedMemorySize, LDS_BYTES); attr = true; }
    hipLaunchKernelGGL(k_phase<PH>, dim3(grid), dim3(NT), LDS_BYTES, stream, p);
}
template <class TT> static void compare(const TT* a, const TT* b, size_t n, float* err, int slot, hipStream_t stream) {
    hipLaunchKernelGGL(k_compare<TT>, dim3(1024), dim3(256), 0, stream, a, b, n, err, slot);
}
static void launch_mega(const P& p, hipStream_t stream) {
    static int grid = 0;
    if (!grid) {
        int dev = 0, cus = 0, per_cu = 0;
        (void)hipGetDevice(&dev); (void)hipDeviceGetAttribute(&cus, hipDeviceAttributeMultiprocessorCount, dev);
        (void)hipFuncSetAttribute((const void*)k_mega, hipFuncAttributeMaxDynamicSharedMemorySize, LDS_BYTES);
        (void)hipOccupancyMaxActiveBlocksPerMultiprocessor(&per_cu, (const void*)k_mega, NT, LDS_BYTES);
        if (per_cu < 1) per_cu = 1;
        grid = cus * per_cu;
    }
    P pp = p; void* args[] = {(void*)&pp};
    (void)hipLaunchCooperativeKernel((const void*)k_mega, dim3(grid), dim3(NT), args, LDS_BYTES, stream);
}

extern "C" void kernel_launch(void* const* d_in, const int* in_sizes, int n_in, void* d_out, int out_size, void* d_ws, size_t ws_size, hipStream_t stream) {
    char* ws = (char*)d_ws;
    P p{}; set_inputs(p, d_in); layout_ref(p, ws, ws + 16 * MiB, (char*)d_out, (float*)d_out, NB); p.h1 = (float*)d_out;
#if MODE == 0
    (void)hipMemsetAsync(d_ws, 0, 4096, stream);
    launch_stage<ST_RMS>(p, stream); launch_stage<ST_CS>(p, stream); launch_stage<ST_INPROJ>(p, stream);
    launch_stage<ST_CMP1>(p, stream); launch_stage<ST_CMP2>(p, stream); launch_stage<ST_NSACMP>(p, stream); launch_stage<ST_NSAATT>(p, stream);
    launch_stage<ST_GLAA>(p, stream); launch_stage<ST_GLASCAN>(p, stream); launch_stage<ST_GLANORM>(p, stream);
    launch_stage<ST_PROJ>(p, stream); launch_stage<ST_OUT>(p, stream); launch_stage<ST_ROUTE>(p, stream);
    launch_stage<ST_MOE1>(p, stream); launch_stage<ST_MOE2>(p, stream); launch_stage<ST_FINAL>(p, stream);
#elif MODE == 1
    { P c{}; set_inputs(c, d_in); layout_weights(c, ws + 16 * MiB); layout_compact(c, ws, (float*)d_out); launch_mega(c, stream); }
#else
    { P c{}; set_inputs(c, d_in); layout_weights(c, ws + 16 * MiB); layout_compact(c, ws, (float*)d_out); launch_mega(c, stream); }
    P r{}; set_inputs(r, d_in); layout_weights(r, ws + 16 * MiB);
    layout_ref(r, ws + 128 * MiB, ws + 132 * MiB, ws + 200 * MiB, (float*)(ws + 200 * MiB + 12 * MiB), 1);
    char* alt = ws + 228 * MiB; float* err = (float*)(ws + 128 * MiB + 2048);
    (void)hipMemsetAsync(ws + 128 * MiB, 0, 4096, stream);
    int slot = 0; const size_t T1 = S; const size_t ROWS1 = 2 * T1 + NEXP * 256;
    launch_stage<ST_RMS>(r, stream); launch_stage<ST_CS>(r, stream); launch_stage<ST_INPROJ>(r, stream);
    P f = r; { char* a = alt;
        f.u = (bf16*)a; a += T1 * 1024 * 2; f.cs = (float*)a; a += T1 * 64 * 4; f.q = (bf16*)a; a += T1 * 512 * 2; f.kv6 = (bf16*)a; a += 6 * (size_t)2 * S * 64 * 2 + 4096;
        f.gates = (float*)a; a += T1 * 24 * 4; f.gq = (bf16*)a; a += T1 * 256 * 2; f.gk = (bf16*)a; a += T1 * 256 * 2; f.gv = (bf16*)a; a += T1 * 512 * 2; f.alow = (float*)a; a += T1 * 16 * 4;
        f.rs = (bf16*)a; a += T1 * 512 * 2; f.sa = (bf16*)a; a += T1 * 1024 * 2; f.sb = (bf16*)a; a += T1 * 1024 * 2; }
    launch_phase<PH_PREP>(f, stream); launch_phase<PH_INA>(f, stream); launch_phase<PH_INB>(f, stream);
    compare<bf16>(f.q, r.q, T1 * 512, err, slot++, stream);
    compare<bf16>(f.kv6, r.kv6, 6 * (size_t)2 * S * 64, err, slot++, stream);
    compare<bf16>(f.sb, r.sb, T1 * 1024, err, slot++, stream);
    launch_stage<ST_CMP1>(r, stream); launch_stage<ST_CMP2>(r, stream); launch_stage<ST_NSACMP>(r, stream); launch_stage<ST_NSAATT>(r, stream);
    launch_stage<ST_GLAA>(r, stream); launch_stage<ST_GLASCAN>(r, stream); launch_stage<ST_GLANORM>(r, stream);
    launch_stage<ST_PROJ>(r, stream);
    f = r; f.mixed = (bf16*)alt; launch_phase<PH_PROJ>(f, stream);
    compare<bf16>(f.mixed, r.mixed, T1 * 1024, err, slot++, stream);
    launch_stage<ST_OUT>(r, stream);
    f = r; f.h1 = (float*)alt; launch_phase<PH_OUT>(f, stream);
    compare<float>(f.h1, r.h1, T1 * 1024, err, slot++, stream);
    launch_stage<ST_ROUTE>(r, stream);
    (void)hipMemsetAsync(r.H, 0, ROWS1 * 512 * 2, stream); (void)hipMemsetAsync(alt, 0, ROWS1 * 512 * 2, stream);
    launch_stage<ST_MOE1>(r, stream);
    f = r; f.H = (bf16*)alt; launch_phase<PH_MOE1>(f, stream);
    compare<bf16>(f.H, r.H, ROWS1 * 512, err, slot++, stream);
    (void)hipMemsetAsync(r.Y, 0, ROWS1 * 1024 * 2, stream); (void)hipMemsetAsync(alt + 17 * MiB, 0, ROWS1 * 1024 * 2, stream);
    launch_stage<ST_MOE2>(r, stream);
    f = r; f.Y = (bf16*)(alt + 17 * MiB); launch_phase<PH_MOE2>(f, stream);
    compare<bf16>(f.Y, r.Y, ROWS1 * 1024, err, slot++, stream);
    hipLaunchKernelGGL(k_report, dim3(1024), dim3(256), 0, stream, (float*)d_out, (size_t)NB * S * D, (const float*)err, slot, 0.02f);
#endif
}
```

```cpp
#include <hip/hip_runtime.h>
#include <hip/hip_cooperative_groups.h>
#include <stdint.h>
namespace cg = cooperative_groups;

#ifndef DUP
#define DUP 0
#endif
#ifndef MODE
#define MODE 1
#endif

typedef unsigned short bf16;
typedef unsigned long long u64;

__device__ __forceinline__ int TIDX() { int t = threadIdx.x; asm volatile("" : "+v"(t)); return t; }
__device__ __forceinline__ float bf2f(bf16 v) { return __uint_as_float(((unsigned)v) << 16); }
__device__ __forceinline__ bf16 f2bf(float f) { unsigned u = __float_as_uint(f); return (bf16)((u + 0x7fffu + ((u >> 16) & 1u)) >> 16); }
__device__ __forceinline__ float sigmoidf_(float x) { return 1.f / (1.f + __expf(-x)); }
__device__ __forceinline__ float siluf_(float x) { return x / (1.f + __expf(-x)); }
__device__ __forceinline__ float geluf_(float x) { const float u = 0.7978845608028654f * (x + 0.044715f * x * x * x); return 0.5f * x * (1.f + tanhf(u)); }

constexpr int NB = 4, S = 4096, D = 1024;
constexpr int NT = 512;
constexpr int LDS_BYTES = 144 * 1024;
constexpr int LDS_MISC = 136 * 1024;
constexpr int INW = 4904;
constexpr int OFF_Q = 0, OFF_KV = 512, OFF_NG = 1280, OFF_GQ = 1304, OFF_GK = 1560, OFF_GV = 1816, OFF_GA = 2328, OFF_GR = 2344, OFF_MA = 2856, OFF_MB = 3880;
constexpr int NEXP = 32;

struct P {
    const float* x; const int* pos; const float* g_mix; const float* w_in;
    const float *cpos_k, *cw1_k, *cb1_k, *cw2_k, *cb2_k, *cpos_v, *cw1_v, *cb1_v, *cw2_v, *cb2_v;
    const float *w_a2, *b_a, *norm_g, *w_pn, *w_pg, *w_out, *g_ffn, *w_grp, *b_grp, *w_exp, *b_exp, *w_gate, *w_up, *w_down, *g_final;
    float* out;
    unsigned* ctl;
    float* cs;
    bf16* u;
    bf16* q;
    bf16* kv6;
    float* gates;
    bf16 *gq, *gk, *gv;
    float* alow;
    bf16 *rs, *sa, *sb;
    float* hcmp;
    bf16 *kcmp, *vcmp;
    u64* sel;
    float* ocmp;
    bf16* onsa;
    float* ga;
    float* oraw;
    bf16* gla;
    bf16* mixed;
    float* h1;
    bf16* vb;
    int* list;
    int* tokslot;
    int* tokexp;
    float* tokw;
    bf16* H;
    bf16* Y;
    float* gst;
    float* gdec;
    float* pcmp;
    float* b1p;
    float* wr;
    bf16 *Wt_in, *Wc1, *Wpn, *Wpg, *Wo, *Wgu, *Wd;
    int nb, T;
};
__device__ __forceinline__ size_t kvseg(const P& p) { return (size_t)p.nb * 2 * S * 64; }

enum Stage { ST_RMS = 0, ST_CS, ST_INPROJ, ST_CMP1, ST_CMP2, ST_NSACMP, ST_NSAATT, ST_GLAA, ST_GLASCAN, ST_GLANORM, ST_PROJ, ST_OUT, ST_ROUTE, ST_MOE1, ST_MOE2, ST_FINAL, ST_COUNT };

__host__ __device__ inline int stage_nvb(int st, int T) {
    switch (st) {
        case ST_RMS: return T / 8;
        case ST_CS: return T * 32 / NT;
        case ST_INPROJ: return ((INW + NT - 1) / NT) * (T / 8);
        case ST_CMP1: return 2 * (T / S) * 2 * 256 / 8;
        case ST_CMP2: return 2 * (T / S) * 2 * 256 * 32 / NT;
        case ST_NSACMP: return T / 64 * 2 / 8;
        case ST_NSAATT: return T / 64 * 8 / 8;
        case ST_GLAA: return T / 2;
        case ST_GLASCAN: return (T / S) * 4 / 4;
        case ST_GLANORM: return T * 4 / NT;
        case ST_PROJ: return 2 * (T / 8);
        case ST_OUT: return 2 * (T / 8);
        case ST_ROUTE: return T / 8;
        case ST_MOE1: return (2 * T + NEXP * 256) / 8;
        case ST_MOE2: return 2 * ((2 * T + NEXP * 256) / 8);
        case ST_FINAL: return T / 8;
    }
    return 0;
}

__device__ __forceinline__ void body_rms(const P& p, int vb) {
    const int lane = TIDX() & 63, t = vb * 8 + (TIDX() >> 6);
    const float4* xr = (const float4*)(p.x + (size_t)t * D);
    float4 v[4]; float ss = 0.f;
#pragma unroll
    for (int j = 0; j < 4; ++j) { v[j] = xr[lane + 64 * j]; ss += v[j].x * v[j].x + v[j].y * v[j].y + v[j].z * v[j].z + v[j].w * v[j].w; }
#pragma unroll
    for (int o = 1; o < 64; o <<= 1) ss += __shfl_xor(ss, o);
    const float rstd = rsqrtf(ss * (1.f / D) + 1e-6f);
#pragma unroll
    for (int j = 0; j < 4; ++j) {
        const float4 g = ((const float4*)p.g_mix)[lane + 64 * j];
        ushort4 o; o.x = f2bf(v[j].x * rstd * g.x); o.y = f2bf(v[j].y * rstd * g.y); o.z = f2bf(v[j].z * rstd * g.z); o.w = f2bf(v[j].w * rstd * g.w);
        ((ushort4*)(p.u + (size_t)t * D))[lane + 64 * j] = o;
    }
}
__device__ __forceinline__ void body_cs(const P& p, int vb) {
    const int idx = vb * NT + TIDX(); const int t = idx >> 5, i = idx & 31;
    const float inv = 1.0f / powf(10000.0f, (float)i / 32.0f);
    const float ang = (float)p.pos[t] * inv;
    const double a = (double)ang; const double k = rint(a * 0.15915494309189535); const float r = (float)(a - k * 6.283185307179586);
    p.cs[(size_t)t * 64 + i] = cosf(r); p.cs[(size_t)t * 64 + 32 + i] = sinf(r);
}

template <int K, bool TWO, bool SAMEA, class AF1, class AF2, class Epi>
__device__ __forceinline__ void ngemm(float* lds, int m0, const float* W1, int ldw1, int n1, const float* W2, int ldw2, int n2, AF1 a1, AF2 a2, Epi epi) {
    const int tid = TIDX();
    for (int idx = tid; idx < 8 * K; idx += NT) { const int i = idx / K, k = idx % K; lds[idx] = a1(m0 + i, k); if (TWO && !SAMEA) lds[8 * K + idx] = a2(m0 + i, k); }
    __syncthreads();
    float acc1[8], acc2[8];
#pragma unroll
    for (int i = 0; i < 8; ++i) { acc1[i] = 0.f; acc2[i] = 0.f; }
    const float* w1 = W1 + n1; const float* w2 = TWO ? (W2 + n2) : w1;
    const float* l2 = (TWO && !SAMEA) ? lds + 8 * K : lds;
    for (int k = 0; k < K; k += 4) {
        float a[4], b[4];
#pragma unroll
        for (int kk = 0; kk < 4; ++kk) { a[kk] = w1[(size_t)(k + kk) * ldw1]; b[kk] = TWO ? w2[(size_t)(k + kk) * ldw2] : 0.f; }
#pragma unroll
        for (int i = 0; i < 8; ++i) {
            const float4 x1 = *(const float4*)(lds + i * K + k);
            acc1[i] += x1.x * a[0] + x1.y * a[1] + x1.z * a[2] + x1.w * a[3];
            if (TWO) { const float4 x2 = *(const float4*)(l2 + i * K + k); acc2[i] += x2.x * b[0] + x2.y * b[1] + x2.z * b[2] + x2.w * b[3]; }
        }
    }
#pragma unroll
    for (int i = 0; i < 8; ++i) epi(m0 + i, acc1[i], acc2[i]);
    __syncthreads();
}

__device__ __forceinline__ void store_z(const P& p, int t, int j, float z, float zp) {
    const int b = t / S, s = t % S;
    if (j < OFF_KV) {
        const int d = j & 63, i = d & 31; const float c = p.cs[(size_t)t * 64 + i], sn = p.cs[(size_t)t * 64 + 32 + i];
        const float r = (d < 32) ? (z * c - zp * sn) : (z * c + zp * sn);
        p.q[(size_t)t * 512 + j] = f2bf(r * 0.125f);
    } else if (j < OFF_NG) {
        const int seg = (j - OFF_KV) >> 7, cc = (j - OFF_KV) & 127, g = cc >> 6, d = cc & 63; float r = z;
        if (seg == 2 || seg == 4) { const int i = d & 31; const float c = p.cs[(size_t)t * 64 + i], sn = p.cs[(size_t)t * 64 + 32 + i]; r = (d < 32) ? (z * c - zp * sn) : (z * c + zp * sn); }
        p.kv6[(size_t)seg * kvseg(p) + ((size_t)(b * 2 + g) * S + s) * 64 + d] = f2bf(r);
    } else if (j < OFF_GQ) { p.gates[(size_t)t * 24 + (j - OFF_NG)] = sigmoidf_(z);
    } else if (j < OFF_GK) { p.gq[(size_t)t * 256 + (j - OFF_GQ)] = f2bf(z * 0.125f);
    } else if (j < OFF_GV) { p.gk[(size_t)t * 256 + (j - OFF_GK)] = f2bf(z);
    } else if (j < OFF_GA) { p.gv[(size_t)t * 512 + (j - OFF_GV)] = f2bf(z);
    } else if (j < OFF_GR) { p.alow[(size_t)t * 16 + (j - OFF_GA)] = z;
    } else if (j < OFF_MA) { p.rs[(size_t)t * 512 + (j - OFF_GR)] = f2bf(siluf_(z));
    } else if (j < OFF_MB) { p.sa[(size_t)t * 1024 + (j - OFF_MA)] = f2bf(sigmoidf_(z));
    } else { p.sb[(size_t)t * 1024 + (j - OFF_MB)] = f2bf(sigmoidf_(z)); }
}
__device__ __forceinline__ int rope_partner(int j) {
    int base;
    if (j < OFF_KV) base = 0; else if (j >= 768 && j < 896) base = 768; else if (j >= 1024 && j < 1152) base = 1024; else return -1;
    const int d = (j - base) & 63; return d < 32 ? j + 32 : j - 32;
}
__device__ __forceinline__ void body_inproj(const P& p, int vb, char* smem) {
    constexpr int NCB = (INW + NT - 1) / NT;
    const int bx = vb % NCB, by = vb / NCB;
    const int jr = bx * NT + TIDX(); const bool jv = jr < INW; const int j = jv ? jr : INW - 1;
    int jp = rope_partner(j); if (jp < 0) jp = j;
    ngemm<1024, true, true>((float*)smem, by * 8, p.w_in, INW, j, p.w_in, INW, jp,
        [&](int m, int k) { return bf2f(p.u[(size_t)m * D + k]); }, [&](int m, int k) { return 0.f; },
        [&](int m, float z, float zp) { if (jv) store_z(p, m, j, z, zp); });
}

__device__ __forceinline__ void body_cmp1(const P& p, int vb, char* smem) {
    const int nrows = p.nb * 2 * 256, ng = nrows / 8;
    const int kv = vb / ng, m0 = (vb % ng) * 8; const int n = TIDX() & 255; const bool act = TIDX() < 256;
    const bf16* src = p.kv6 + (size_t)kv * kvseg(p);
    const float* pe = kv ? p.cpos_v : p.cpos_k; const float* w1 = kv ? p.cw1_v : p.cw1_k; const float* b1 = kv ? p.cb1_v : p.cb1_k;
    float* dst = p.hcmp + (size_t)kv * nrows * 256;
    ngemm<2048, false, true>((float*)smem, m0, w1, 256, n, w1, 256, n,
        [&](int m, int k) { return bf2f(src[(size_t)m * 1024 + k]) + pe[k]; }, [&](int m, int k) { return 0.f; },
        [&](int m, float z, float) { if (act) dst[(size_t)m * 256 + n] = geluf_(z + b1[n]); });
}
__device__ __forceinline__ void body_cmp2(const P& p, int vb) {
    const int nrows = p.nb * 2 * 256;
    const int idx = vb * NT + TIDX();
    const int i = idx & 31, row = (idx >> 5) % nrows, kv = (idx >> 5) / nrows;
    const float* h = p.hcmp + ((size_t)kv * nrows + row) * 256; const float* w2 = kv ? p.cw2_v : p.cw2_k; const float* b2 = kv ? p.cb2_v : p.cb2_k;
    float z1 = b2[i], z2 = b2[i + 32];
    for (int n = 0; n < 256; ++n) { const float hv = h[n]; z1 += hv * w2[n * 64 + i]; z2 += hv * w2[n * 64 + i + 32]; }
    bf16* dst = (kv ? p.vcmp : p.kcmp) + (size_t)row * 64;
    if (kv == 0) {
        const int bg = row >> 8, m = row & 255, b = bg >> 1; int sp = 16 * m + 31; if (sp > S - 1) sp = S - 1;
        const size_t t = (size_t)b * S + sp; const float c = p.cs[t * 64 + i], sn = p.cs[t * 64 + 32 + i];
        const float r1 = z1 * c - z2 * sn, r2 = z2 * c + z1 * sn; z1 = r1; z2 = r2;
    }
    dst[i] = f2bf(z1); dst[i + 32] = f2bf(z2);
}

__device__ __forceinline__ void load_row64(const bf16* r, float* f) {
    const uint4* p4 = (const uint4*)r;
#pragma unroll
    for (int c = 0; c < 8; ++c) { const uint4 v = p4[c]; const unsigned w[4] = {v.x, v.y, v.z, v.w};
#pragma unroll
        for (int e = 0; e < 4; ++e) { f[c * 8 + e * 2] = __uint_as_float(w[e] << 16); f[c * 8 + e * 2 + 1] = __uint_as_float(w[e] & 0xffff0000u); } }
}
__device__ __forceinline__ float dot64(const float* a, const bf16* r) {
    const uint4* p4 = (const uint4*)r; float s = 0.f;
#pragma unroll
    for (int c = 0; c < 8; ++c) { const uint4 v = p4[c]; const unsigned w[4] = {v.x, v.y, v.z, v.w};
#pragma unroll
        for (int e = 0; e < 4; ++e) { s += a[c * 8 + e * 2] * __uint_as_float(w[e] << 16); s += a[c * 8 + e * 2 + 1] * __uint_as_float(w[e] & 0xffff0000u); } }
    return s;
}
__device__ __forceinline__ void axpy64(float* o, float a, const bf16* r) {
    const uint4* p4 = (const uint4*)r;
#pragma unroll
    for (int c = 0; c < 8; ++c) { const uint4 v = p4[c]; const unsigned w[4] = {v.x, v.y, v.z, v.w};
#pragma unroll
        for (int e = 0; e < 4; ++e) { o[c * 8 + e * 2] += a * __uint_as_float(w[e] << 16); o[c * 8 + e * 2 + 1] += a * __uint_as_float(w[e] & 0xffff0000u); } }
}
__device__ __forceinline__ void body_nsacmp(const P& p, int vb, char* smem) {
    const int wave = TIDX() >> 6, lane = TIDX() & 63, item = vb * 8 + wave;
    const int g = item & 1, t = (item >> 1) * 64 + lane;
    const int b = t / S, s = t % S; const int nv = s >= 31 ? (s - 31) / 16 + 1 : 0;
    float* my = (float*)smem + (size_t)wave * (64 * 65) + lane * 65;
    for (int j = 0; j < 64; ++j) my[j] = 0.f;
    const bf16* kc = p.kcmp + (size_t)(b * 2 + g) * 256 * 64; const bf16* vc = p.vcmp + (size_t)(b * 2 + g) * 256 * 64;
    for (int hh = 0; hh < 4; ++hh) {
        const int h = g * 4 + hh; float qv[64], o[64];
        load_row64(p.q + (size_t)t * 512 + h * 64, qv);
#pragma unroll
        for (int d = 0; d < 64; ++d) o[d] = 0.f;
        float m = -1e30f, l = 0.f;
        for (int n = 0; n < nv; ++n) { const float sc = dot64(qv, kc + n * 64); const float mn = fmaxf(m, sc); l = l * __expf(m - mn) + __expf(sc - mn); m = mn; }
        const float il = nv > 0 ? 1.f / l : 0.f;
        for (int n = 0; n < nv; ++n) {
            const float sc = dot64(qv, kc + n * 64); const float pn = __expf(sc - m) * il;
            axpy64(o, pn, vc + n * 64);
            const int j0 = n >> 2; if ((n & 3) != 3) my[j0] += pn; else { my[j0] += 0.5f * pn; my[j0 + 1] += 0.5f * pn; }
        }
#pragma unroll
        for (int d = 0; d < 64; ++d) p.ocmp[(size_t)t * 512 + h * 64 + d] = o[d];
    }
    const int cur = s >> 6; u64 mask = 0ull;
    for (int j = 0; j <= cur; ++j) {
        const float sj = (j == 0 || j == cur || j == cur - 1) ? 1e4f : my[j]; int rank = 0;
        for (int i = 0; i <= cur; ++i) { if (i == j) continue; const float si = (i == 0 || i == cur || i == cur - 1) ? 1e4f : my[i]; if (si > sj || (si == sj && i < j)) ++rank; }
        if (rank < 16) mask |= (1ull << j);
    }
    p.sel[(size_t)t * 2 + g] = mask;
}
__device__ __forceinline__ void body_nsaatt(const P& p, int vb) {
    const int wave = TIDX() >> 6, lane = TIDX() & 63, item = vb * 8 + wave;
    const int h = item & 7, t = (item >> 3) * 64 + lane, g = h >> 2;
    const int b = t / S, s = t % S, cur = s >> 6;
    const size_t seg = kvseg(p), ho = (size_t)(b * 2 + g) * S * 64;
    const bf16* ks = p.kv6 + 2 * seg + ho; const bf16* vs = p.kv6 + 3 * seg + ho; const bf16* kw = p.kv6 + 4 * seg + ho; const bf16* vw = p.kv6 + 5 * seg + ho;
    float qv[64], o[64];
    load_row64(p.q + (size_t)t * 512 + h * 64, qv);
    const float g0 = p.gates[(size_t)t * 24 + h * 3], g1 = p.gates[(size_t)t * 24 + h * 3 + 1], g2 = p.gates[(size_t)t * 24 + h * 3 + 2];
    float* accp = p.ocmp + (size_t)t * 512 + h * 64;
#pragma unroll
    for (int d = 0; d < 64; ++d) o[d] = 0.f;
    const u64 mask = p.sel[(size_t)t * 2 + g];
    float m = -1e30f, l = 0.f;
    for (int j = 0; j <= cur; ++j) {
        if (!((mask >> j) & 1ull)) continue;
        for (int kk = 0; kk < 64; ++kk) {
            const int key = j * 64 + kk; if (key > s) break;
            const float sc = dot64(qv, ks + (size_t)key * 64);
            if (sc > m) { const float f = __expf(m - sc); l *= f;
#pragma unroll
                for (int d = 0; d < 64; ++d) o[d] *= f;
                m = sc; }
            const float pe = __expf(sc - m); l += pe; axpy64(o, pe, vs + (size_t)key * 64);
        }
    }
    { const float f = g1 / l;
#pragma unroll
        for (int d = 0; d < 64; ++d) { accp[d] = g0 * accp[d] + f * o[d]; o[d] = 0.f; } }
    m = -1e30f; l = 0.f;
    for (int key = (s >= 511 ? s - 511 : 0); key <= s; ++key) {
        const float sc = dot64(qv, kw + (size_t)key * 64);
        if (sc > m) { const float f = __expf(m - sc); l *= f;
#pragma unroll
            for (int d = 0; d < 64; ++d) o[d] *= f;
            m = sc; }
        const float pe = __expf(sc - m); l += pe; axpy64(o, pe, vw + (size_t)key * 64);
    }
    { const float f = g2 / l;
#pragma unroll
        for (int d = 0; d < 64; ++d) p.onsa[(size_t)t * 512 + h * 64 + d] = f2bf(accp[d] + f * o[d]); }
}

__device__ __forceinline__ void body_glaa(const P& p, int vb) {
    const int c = TIDX() & 255, t = vb * 2 + (TIDX() >> 8); float z = p.b_a[c];
#pragma unroll
    for (int r = 0; r < 16; ++r) z += p.alow[(size_t)t * 16 + r] * p.w_a2[r * 256 + c];
    const float ls = fminf(z, 0.f) - log1pf(__expf(-fabsf(z)));
    p.ga[(size_t)t * 256 + c] = __expf(ls * (1.f / 16.f));
}
__device__ __forceinline__ void body_glascan(const P& p, int vb, char* smem) {
    const int sub = TIDX() >> 7, e = TIDX() & 127, bh = vb * 4 + sub, b = bh >> 2, h = bh & 3;
    float* sq = (float*)smem + sub * (3 * 32 * 64); float* sk = sq + 32 * 64; float* sg = sk + 32 * 64;
    float St[64];
#pragma unroll
    for (int d = 0; d < 64; ++d) St[d] = 0.f;
    for (int s0 = 0; s0 < S; s0 += 32) {
        __syncthreads();
        for (int i = e; i < 32 * 64; i += 128) { const int ss = i >> 6, d = i & 63; const size_t t = (size_t)b * S + s0 + ss;
            sq[i] = bf2f(p.gq[t * 256 + h * 64 + d]); sk[i] = bf2f(p.gk[t * 256 + h * 64 + d]); sg[i] = p.ga[t * 256 + h * 64 + d]; }
        __syncthreads();
        for (int ss = 0; ss < 32; ++ss) {
            const size_t t = (size_t)b * S + s0 + ss; const float v = bf2f(p.gv[t * 512 + h * 128 + e]); float o = 0.f;
#pragma unroll
            for (int d = 0; d < 64; ++d) { St[d] = sg[ss * 64 + d] * St[d] + sk[ss * 64 + d] * v; o += sq[ss * 64 + d] * St[d]; }
            p.oraw[t * 512 + h * 128 + e] = o;
        }
    }
    __syncthreads();
}
__device__ __forceinline__ void body_glanorm(const P& p, int vb) {
    const int idx = vb * NT + TIDX(); const int t = idx >> 2, h = idx & 3;
    const float* o = p.oraw + (size_t)t * 512 + h * 128; float ss = 0.f;
    for (int e = 0; e < 128; ++e) ss += o[e] * o[e];
    const float r = rsqrtf(ss * (1.f / 128.f) + 1e-6f);
    for (int e = 0; e < 128; ++e) p.gla[(size_t)t * 512 + h * 128 + e] = f2bf(o[e] * r * p.norm_g[h * 128 + e] * bf2f(p.rs[(size_t)t * 512 + h * 128 + e]));
}

__device__ __forceinline__ void body_proj(const P& p, int vb, char* smem) {
    const int n = (vb & 1) * NT + TIDX(), m0 = (vb >> 1) * 8;
    ngemm<512, true, false>((float*)smem, m0, p.w_pn, 1024, n, p.w_pg, 1024, n,
        [&](int m, int k) { return bf2f(p.onsa[(size_t)m * 512 + k]); }, [&](int m, int k) { return bf2f(p.gla[(size_t)m * 512 + k]); },
        [&](int m, float ya, float yb) { p.mixed[(size_t)m * 1024 + n] = f2bf(bf2f(p.sa[(size_t)m * 1024 + n]) * ya + bf2f(p.sb[(size_t)m * 1024 + n]) * yb); });
}
__device__ __forceinline__ void body_out(const P& p, int vb, char* smem) {
    const int n = (vb & 1) * NT + TIDX(), m0 = (vb >> 1) * 8;
    ngemm<1024, false, true>((float*)smem, m0, p.w_out, 1024, n, p.w_out, 1024, n,
        [&](int m, int k) { return bf2f(p.mixed[(size_t)m * 1024 + k]); }, [&](int m, int k) { return 0.f; },
        [&](int m, float z, float) { p.h1[(size_t)m * 1024 + n] = p.x[(size_t)m * 1024 + n] + z; });
}

__device__ __forceinline__ void body_route(const P& p, int vb, char* smem) {
    const int wave = TIDX() >> 6, lane = TIDX() & 63, t = vb * 8 + wave;
    const float4* hr = (const float4*)(p.h1 + (size_t)t * D);
    float v[16]; float ss = 0.f;
#pragma unroll
    for (int j = 0; j < 4; ++j) { const float4 a = hr[lane + 64 * j]; v[4 * j] = a.x; v[4 * j + 1] = a.y; v[4 * j + 2] = a.z; v[4 * j + 3] = a.w; ss += a.x * a.x + a.y * a.y + a.z * a.z + a.w * a.w; }
#pragma unroll
    for (int o = 1; o < 64; o <<= 1) ss += __shfl_xor(ss, o);
    const float rstd = rsqrtf(ss * (1.f / D) + 1e-6f);
#pragma unroll
    for (int j = 0; j < 4; ++j) {
        const float4 g = ((const float4*)p.g_ffn)[lane + 64 * j];
        v[4 * j] *= rstd * g.x; v[4 * j + 1] *= rstd * g.y; v[4 * j + 2] *= rstd * g.z; v[4 * j + 3] *= rstd * g.w;
        ushort4 o; o.x = f2bf(v[4 * j]); o.y = f2bf(v[4 * j + 1]); o.z = f2bf(v[4 * j + 2]); o.w = f2bf(v[4 * j + 3]);
        ((ushort4*)(p.vb + (size_t)t * D))[lane + 64 * j] = o;
    }
    float* sl = (float*)(smem + LDS_MISC) + wave * 40;
    for (int o = 0; o < 4; ++o) { float a = 0.f;
#pragma unroll
        for (int j = 0; j < 4; ++j)
#pragma unroll
            for (int e = 0; e < 4; ++e) a += v[4 * j + e] * p.w_grp[(size_t)(4 * (lane + 64 * j) + e) * 4 + o];
#pragma unroll
        for (int x = 1; x < 64; x <<= 1) a += __shfl_xor(a, x);
        if (lane == 0) sl[o] = a + p.b_grp[o]; }
    for (int o = 0; o < 32; ++o) { float a = 0.f;
#pragma unroll
        for (int j = 0; j < 4; ++j)
#pragma unroll
            for (int e = 0; e < 4; ++e) a += v[4 * j + e] * p.w_exp[(size_t)(4 * (lane + 64 * j) + e) * 32 + o];
#pragma unroll
        for (int x = 1; x < 64; x <<= 1) a += __shfl_xor(a, x);
        if (lane == 0) sl[4 + o] = a + p.b_exp[o]; }
    if (lane == 0) {
        int gs = 0; float gm = sl[0];
        for (int o = 1; o < 4; ++o) if (sl[o] > gm) { gm = sl[o]; gs = o; }
        float gsum = 0.f;
        for (int o = 0; o < 4; ++o) gsum += __expf(sl[o] - gm);
        const float pg = 1.f / gsum;
        const float* li = sl + 4 + gs * 8;
        int e0 = 0; float m0 = li[0];
        for (int e = 1; e < 8; ++e) if (li[e] > m0) { m0 = li[e]; e0 = e; }
        int e1 = -1; float m1 = -3e38f;
        for (int e = 0; e < 8; ++e) if (e != e0 && li[e] > m1) { m1 = li[e]; e1 = e; }
        const float p0 = 1.f, p1 = __expf(m1 - m0);
        const float w0 = pg * p0 / (p0 + p1), w1 = pg * p1 / (p0 + p1);
        const int x0 = gs * 8 + e0, x1 = gs * 8 + e1;
        const int s0 = (int)atomicAdd(&p.ctl[x0], 1u), s1 = (int)atomicAdd(&p.ctl[x1], 1u);
        p.list[(size_t)x0 * p.T + s0] = t; p.list[(size_t)x1 * p.T + s1] = t;
        p.tokexp[t * 2] = x0; p.tokexp[t * 2 + 1] = x1; p.tokslot[t * 2] = s0; p.tokslot[t * 2 + 1] = s1; p.tokw[t * 2] = w0; p.tokw[t * 2 + 1] = w1;
    }
}

__device__ __forceinline__ void body_route2(const P& p, int vb, char* smem) {
    const int tid = TIDX(), wave = tid >> 6, lane = tid & 63, t = vb * 8 + wave;
    const float4* hr = (const float4*)(p.h1 + (size_t)t * D);
    float4 v[4]; float ss = 0.f;
#pragma unroll
    for (int j = 0; j < 4; ++j) { v[j] = hr[lane + 64 * j]; ss += v[j].x * v[j].x + v[j].y * v[j].y + v[j].z * v[j].z + v[j].w * v[j].w; }
#pragma unroll
    for (int o = 1; o < 64; o <<= 1) ss += __shfl_xor(ss, o);
    const float rstd = rsqrtf(ss * (1.f / D) + 1e-6f);
#pragma unroll
    for (int j = 0; j < 4; ++j) {
        const float4 g = ((const float4*)p.g_ffn)[lane + 64 * j];
        v[j].x *= rstd * g.x; v[j].y *= rstd * g.y; v[j].z *= rstd * g.z; v[j].w *= rstd * g.w;
        ushort4 o; o.x = f2bf(v[j].x); o.y = f2bf(v[j].y); o.z = f2bf(v[j].z); o.w = f2bf(v[j].w);
        ((ushort4*)(p.vb + (size_t)t * D))[lane + 64 * j] = o;
    }
    float* sl = (float*)(smem + LDS_MISC) + wave * 40;
    float mine = 0.f;
#pragma unroll 4
    for (int o = 0; o < 36; ++o) { const float4* wrow = (const float4*)(p.wr + (size_t)o * 1024); float a = 0.f;
#pragma unroll
        for (int j = 0; j < 4; ++j) { const float4 w = wrow[lane + 64 * j]; a += v[j].x * w.x + v[j].y * w.y + v[j].z * w.z + v[j].w * w.w; }
#pragma unroll
        for (int x = 1; x < 64; x <<= 1) a += __shfl_xor(a, x);
        if (lane == o) mine = a; }
    if (lane < 36) sl[lane] = mine + (lane < 4 ? p.b_grp[lane] : p.b_exp[lane - 4]);
    asm volatile("s_waitcnt lgkmcnt(0)" ::: "memory");
    if (lane == 0) {
        int gs = 0; float gm = sl[0];
        for (int o = 1; o < 4; ++o) if (sl[o] > gm) { gm = sl[o]; gs = o; }
        float gsum = 0.f;
        for (int o = 0; o < 4; ++o) gsum += __expf(sl[o] - gm);
        const float pg = 1.f / gsum;
        const float* li = sl + 4 + gs * 8;
        int e0 = 0; float m0 = li[0];
        for (int e = 1; e < 8; ++e) if (li[e] > m0) { m0 = li[e]; e0 = e; }
        int e1 = -1; float m1 = -3e38f;
        for (int e = 0; e < 8; ++e) if (e != e0 && li[e] > m1) { m1 = li[e]; e1 = e; }
        const float p0 = 1.f, p1 = __expf(m1 - m0);
        const float w0 = pg * p0 / (p0 + p1), w1 = pg * p1 / (p0 + p1);
        const int x0 = gs * 8 + e0, x1 = gs * 8 + e1;
        const int s0 = (int)atomicAdd(&p.ctl[x0], 1u), s1 = (int)atomicAdd(&p.ctl[x1], 1u);
        p.list[(size_t)x0 * p.T + s0] = t; p.list[(size_t)x1 * p.T + s1] = t;
        p.tokexp[t * 2] = x0; p.tokexp[t * 2 + 1] = x1; p.tokslot[t * 2] = s0; p.tokslot[t * 2 + 1] = s1; p.tokw[t * 2] = w0; p.tokw[t * 2 + 1] = w1;
    }
}

__device__ __forceinline__ int* seg_bases(const P& p, char* smem) {
    int* sbase = (int*)(smem + LDS_MISC + 2048);
    __syncthreads();
    if (TIDX() == 0) { int acc = 0; for (int e = 0; e < NEXP; ++e) { sbase[e] = acc; acc += ((int)p.ctl[e] + 255) & ~255; } sbase[NEXP] = acc; }
    __syncthreads();
    return sbase;
}
__device__ __forceinline__ void body_moe1(const P& p, int vb, char* smem) {
    int* sbase = seg_bases(p, smem); int* stok = sbase + 40;
    const int r0 = vb * 8; if (r0 >= sbase[NEXP]) return;
    int e = 0; while (r0 >= sbase[e + 1]) ++e;
    const int cnt = (int)p.ctl[e];
    if (TIDX() < 8) { const int sl = r0 + TIDX() - sbase[e]; stok[TIDX()] = p.list[(size_t)e * p.T + (sl < cnt ? sl : 0)]; }
    __syncthreads();
    const int n = TIDX();
    const float* wg = p.w_gate + (size_t)e * 1024 * 512; const float* wu = p.w_up + (size_t)e * 1024 * 512;
    ngemm<1024, true, true>((float*)smem, 0, wg, 512, n, wu, 512, n,
        [&](int m, int k) { return bf2f(p.vb[(size_t)stok[m] * D + k]); }, [&](int m, int k) { return 0.f; },
        [&](int m, float zg, float zu) { p.H[(size_t)(r0 + m) * 512 + n] = f2bf(siluf_(zg) * zu); });
}
__device__ __forceinline__ void body_moe2(const P& p, int vb, char* smem) {
    int* sbase = seg_bases(p, smem);
    const int r0 = (vb >> 1) * 8; if (r0 >= sbase[NEXP]) return;
    int e = 0; while (r0 >= sbase[e + 1]) ++e;
    const int n = (vb & 1) * NT + TIDX();
    const float* wd = p.w_down + (size_t)e * 512 * 1024;
    ngemm<512, false, true>((float*)smem, r0, wd, 1024, n, wd, 1024, n,
        [&](int m, int k) { return bf2f(p.H[(size_t)m * 512 + k]); }, [&](int m, int k) { return 0.f; },
        [&](int m, float z, float) { p.Y[(size_t)m * 1024 + n] = f2bf(z); });
}
__device__ __forceinline__ void body_final(const P& p, int vb, char* smem) {
    int* sbase = seg_bases(p, smem);
    const int lane = TIDX() & 63, t = vb * 8 + (TIDX() >> 6);
    const int r0 = sbase[p.tokexp[t * 2]] + p.tokslot[t * 2], r1 = sbase[p.tokexp[t * 2 + 1]] + p.tokslot[t * 2 + 1];
    const float w0 = p.tokw[t * 2], w1 = p.tokw[t * 2 + 1];
    const float4* hr = (const float4*)(p.h1 + (size_t)t * D);
    float4 v[4]; float ss = 0.f;
#pragma unroll
    for (int j = 0; j < 4; ++j) {
        float4 a = hr[lane + 64 * j];
        const ushort4 y0 = ((const ushort4*)(p.Y + (size_t)r0 * D))[lane + 64 * j], y1 = ((const ushort4*)(p.Y + (size_t)r1 * D))[lane + 64 * j];
        a.x += w0 * bf2f(y0.x) + w1 * bf2f(y1.x); a.y += w0 * bf2f(y0.y) + w1 * bf2f(y1.y); a.z += w0 * bf2f(y0.z) + w1 * bf2f(y1.z); a.w += w0 * bf2f(y0.w) + w1 * bf2f(y1.w);
        v[j] = a; ss += a.x * a.x + a.y * a.y + a.z * a.z + a.w * a.w;
    }
#pragma unroll
    for (int o = 1; o < 64; o <<= 1) ss += __shfl_xor(ss, o);
    const float rstd = rsqrtf(ss * (1.f / D) + 1e-6f);
#pragma unroll
    for (int j = 0; j < 4; ++j) {
        const float4 g = ((const float4*)p.g_final)[lane + 64 * j];
        float4 o; o.x = v[j].x * rstd * g.x; o.y = v[j].y * rstd * g.y; o.z = v[j].z * rstd * g.z; o.w = v[j].w * rstd * g.w;
        ((float4*)(p.out + (size_t)t * D))[lane + 64 * j] = o;
    }
}

namespace pg8 {
#define PG8_LAS __attribute__((address_space(3)))
typedef short bf16x8 __attribute__((ext_vector_type(8)));
typedef float f32x4 __attribute__((ext_vector_type(4)));
typedef unsigned u32x4 __attribute__((ext_vector_type(4)));
typedef unsigned u32x2 __attribute__((ext_vector_type(2)));
constexpr int BM = 256, BK = 64, HALF = 128, HTB = HALF * BK * 2, STAGE_BYTES = 8 * HTB, NXCD = 8, WGM = 8;

__host__ __device__ __forceinline__ int lds_byte(int r, int c) { const int st = (r >> 4) * 2 + (c >> 5), rr = r & 15, cc = c & 31, ob = rr * 64 + cc * 2; return st * 1024 + (ob ^ (((ob >> 9) & 1) << 5)); }
__host__ __device__ __forceinline__ void stage_rc(int b, int& R, int& C) { const int st = b / 1024, sb = b % 1024, swz = sb ^ (((sb >> 9) & 1) << 5); R = (st >> 1) * 16 + swz / 64; C = (st & 1) * 32 + (swz % 64) / 2; }
__host__ __device__ __forceinline__ int perm32(int rho) { const int n = rho >> 4, i = rho & 15; return 8 * (i >> 2) + 4 * n + (i & 3); }

struct Unit { int pm, pn; const char* A; const char* B; int tag; };

struct TileOrder {
    int nM, nN, nwg, G, c;
    __device__ void init(int nM_, int nN_, int G_, int c_) { nM = nM_; nN = nN_; nwg = nM * nN; G = G_; c = c_; }
    __device__ bool next(int i, int& pm, int& pn) const {
        const long L = (long)i * G + c; if (L >= nwg) return false;
        int wgid = (int)L; { const int q = nwg / NXCD, r = nwg % NXCD, xcd = wgid % NXCD, off = wgid / NXCD; wgid = (xcd < r ? xcd * (q + 1) : r * (q + 1) + (xcd - r) * q) + off; }
        const int nig = WGM * nN, gid = wgid / nig, fm = gid * WGM, gsz = (nM - fm) < WGM ? (nM - fm) : WGM;
        pm = fm + ((wgid % nig) % gsz); pn = (wgid % nig) / gsz; return true;
    }
};
struct DenseSched {
    TileOrder o; const char* A; const char* B; int lda, ldb;
    __device__ void init(const void* A_, const void* B_, int M, int N, int lda_, int ldb_) { A = (const char*)A_; B = (const char*)B_; lda = lda_; ldb = ldb_; o.init(M / BM, N / BM, gridDim.x, blockIdx.x); }
    __device__ __forceinline__ bool next(int i, Unit& u) const { if (!o.next(i, u.pm, u.pn)) return false; u.A = A + (size_t)u.pm * BM * lda * 2; u.B = B + (size_t)u.pn * BM * ldb * 2; u.tag = 0; return true; }
    __device__ __forceinline__ unsigned arow(const Unit&, int r) const { return (unsigned)r * (unsigned)lda * 2u; }
};

__device__ __forceinline__ unsigned cvt_pk_bf16(float lo, float hi) { unsigned r; asm volatile("v_cvt_pk_bf16_f32 %0, %1, %2" : "=v"(r) : "v"(lo), "v"(hi)); return r; }

template <class Epi, class Sched, bool ALIGN_EPI, bool GATHER>
__device__ __forceinline__ void gemm_phase(PG8_LAS unsigned char* lds, const int K, const int lda, const int ldb, const Sched& S, const Epi& E) {
    const int tid = TIDX(), wid = __builtin_amdgcn_readfirstlane(tid >> 6), lane = tid & 63, wr = wid >> 2, wc = wid & 3, fr = lane & 15, fq = lane >> 4;
    const int nt = K / BK;
    int sR[2], sC[2];
    unsigned voffA[2], voffB[2];
#pragma unroll
    for (int i = 0; i < 2; ++i) { stage_rc(tid * 16 + i * 8192, sR[i], sC[i]); const int Rb = Epi::PERM ? ((sR[i] & ~31) + perm32(sR[i] & 31)) : sR[i];
        voffA[i] = (unsigned)(sR[i] * lda + sC[i]) * 2u; voffB[i] = (unsigned)(Rb * ldb + sC[i]) * 2u; }
    unsigned gA[2][2], gN[2][2];
    const size_t kstep = (size_t)(BK * 2);
    const size_t hstepA = (size_t)HALF * lda * 2, hstepB = (size_t)HALF * ldb * 2;
    const unsigned ldsw = (unsigned)wid * 1024u;
    const int aoff = lds_byte(wr * 64 + fr, fq * 8), boff = lds_byte(wc * 32 + fr, fq * 8);
#define PG8_SA(b, h) (((b) * 2 + (h)) * HTB)
#define PG8_SB(b, h) ((4 + (b) * 2 + (h)) * HTB)
#define PG8_GLDS(bufoff, gptr, i_) __builtin_amdgcn_global_load_lds((const unsigned*)(gptr), (PG8_LAS unsigned*)(lds + (bufoff) + ldsw + (i_) * 8192), 16, 0, 0)
#define PG8_STAGE_B(bufoff, gbase) do { _Pragma("unroll") for (int _i = 0; _i < 2; ++_i) PG8_GLDS(bufoff, (const char*)(gbase) + voffB[_i], _i); } while (0)
#define PG8_STAGE_A(bufoff, gb, h, NX) do { _Pragma("unroll") for (int _i = 0; _i < 2; ++_i) { \
        if constexpr (GATHER) { const unsigned _o = (NX) ? gN[h][_i] : gA[h][_i]; PG8_GLDS(bufoff, (const char*)(gb) + _o, _i); } \
        else { PG8_GLDS(bufoff, (const char*)(gb) + (h) * hstepA + voffA[_i], _i); } } } while (0)
#define PG8_LDA(dst, b, h) do { _Pragma("unroll") for (int m = 0; m < 4; ++m) _Pragma("unroll") for (int k = 0; k < 2; ++k) dst[m][k] = *(const PG8_LAS bf16x8*)(lds + PG8_SA(b, h) + aoff + m * 2048 + k * 1024); } while (0)
#define PG8_LDB(dst, b, h) do { _Pragma("unroll") for (int n = 0; n < 2; ++n) _Pragma("unroll") for (int k = 0; k < 2; ++k) dst[n][k] = *(const PG8_LAS bf16x8*)(lds + PG8_SB(b, h) + boff + n * 2048 + k * 1024); } while (0)
#define PG8_MMA(ai, bj, At, Bt) do { __builtin_amdgcn_s_setprio(1); _Pragma("unroll") for (int m = 0; m < 4; ++m) _Pragma("unroll") for (int n = 0; n < 2; ++n) _Pragma("unroll") for (int k = 0; k < 2; ++k) \
        acc[ai][bj][m][n] = __builtin_amdgcn_mfma_f32_16x16x32_bf16(Bt[n][k], At[m][k], acc[ai][bj][m][n], 0, 0, 0); __builtin_amdgcn_s_setprio(0); } while (0)
#define PG8_WAIT_V(n) asm volatile("s_waitcnt vmcnt(" #n ")" ::: "memory")
#define PG8_WAIT_L(n) asm volatile("s_waitcnt lgkmcnt(" #n ")" ::: "memory")
#define PG8_BAR __builtin_amdgcn_s_barrier()
#define PG8_SCHED __builtin_amdgcn_sched_barrier(0)
#define PG8_GOFF(dst, u) do { if constexpr (GATHER) { _Pragma("unroll") for (int _h = 0; _h < 2; ++_h) _Pragma("unroll") for (int _i = 0; _i < 2; ++_i) dst[_h][_i] = S.arow(u, _h * HALF + sR[_i]) + (unsigned)sC[_i] * 2u; } } while (0)
    Unit cur, nxt; int ui = 0;
    if (!S.next(0, cur)) return;
    f32x4 acc[2][2][4][2];
#pragma unroll
    for (int a = 0; a < 2; ++a)
#pragma unroll
        for (int b = 0; b < 2; ++b)
#pragma unroll
            for (int m = 0; m < 4; ++m)
#pragma unroll
                for (int n = 0; n < 2; ++n) acc[a][b][m][n] = (f32x4){0.f, 0.f, 0.f, 0.f};
    bf16x8 At[4][2], B0[2][2], B1[2][2];
    const char* cA = cur.A; const char* cB = cur.B;
    PG8_GOFF(gA, cur);
    if constexpr (GATHER) { PG8_WAIT_V(0); }
    PG8_STAGE_B(PG8_SB(0, 0), cB); PG8_STAGE_B(PG8_SB(0, 1), cB + hstepB); PG8_STAGE_A(PG8_SA(0, 0), cA, 0, false); PG8_STAGE_A(PG8_SA(0, 1), cA, 1, false);
    if (wr == 1) PG8_BAR;
    PG8_WAIT_V(2); PG8_BAR;
    PG8_STAGE_B(PG8_SB(1, 0), cB + kstep); PG8_STAGE_A(PG8_SA(1, 0), cA + kstep, 0, false); PG8_STAGE_B(PG8_SB(1, 1), cB + hstepB + kstep);
    PG8_WAIT_V(6); PG8_BAR;
    for (;;) {
        const bool has_next = S.next(ui + 1, nxt);
        const char* nA = has_next ? nxt.A : cA; const char* nB = has_next ? nxt.B : cB;
        if constexpr (GATHER) { if (has_next) { PG8_GOFF(gN, nxt); } else {
#pragma unroll
            for (int _h = 0; _h < 2; ++_h)
#pragma unroll
                for (int _i = 0; _i < 2; ++_i) gN[_h][_i] = gA[_h][_i]; } }
        for (int t = 0; t < nt; t += 2) {
            const bool last = (t == nt - 2);
            const char* a1 = cA + (size_t)(t + 1) * kstep;
            const char* a2 = last ? nA : cA + (size_t)(t + 2) * kstep; const char* b2 = last ? nB : cB + (size_t)(t + 2) * kstep;
            const char* a3 = a2 + kstep; const char* b3 = b2 + kstep;
            PG8_LDB(B0, 0, 0); PG8_LDB(B1, 0, 1); PG8_SCHED; PG8_LDA(At, 0, 0); PG8_STAGE_A(PG8_SA(1, 1), a1, 1, false);
            PG8_WAIT_V(8); PG8_WAIT_L(0); PG8_BAR; PG8_MMA(0, 0, At, B0); PG8_MMA(0, 1, At, B1); PG8_BAR; PG8_SCHED;
            PG8_LDA(At, 0, 1); PG8_STAGE_B(PG8_SB(0, 0), b2); PG8_STAGE_B(PG8_SB(0, 1), b2 + hstepB); PG8_STAGE_A(PG8_SA(0, 0), a2, 0, last);
            PG8_WAIT_V(8); PG8_WAIT_L(0); PG8_BAR; PG8_MMA(1, 0, At, B0); PG8_MMA(1, 1, At, B1); PG8_BAR; PG8_SCHED;
            PG8_LDB(B0, 1, 0); PG8_LDB(B1, 1, 1); PG8_SCHED; PG8_LDA(At, 1, 0); PG8_STAGE_A(PG8_SA(0, 1), a2, 1, last);
            PG8_WAIT_V(8); PG8_WAIT_L(0); PG8_BAR; PG8_MMA(0, 0, At, B0); PG8_MMA(0, 1, At, B1); PG8_BAR; PG8_SCHED;
            PG8_LDA(At, 1, 1); PG8_STAGE_B(PG8_SB(1, 0), b3); PG8_STAGE_B(PG8_SB(1, 1), b3 + hstepB); PG8_STAGE_A(PG8_SA(1, 0), a3, 0, last);
            PG8_WAIT_V(8); PG8_WAIT_L(0); PG8_BAR; PG8_MMA(1, 0, At, B0); PG8_MMA(1, 1, At, B1); PG8_BAR; PG8_SCHED;
        }
        if constexpr (ALIGN_EPI) { if (wr == 0) PG8_BAR; }
        E(acc, cur, wr, wc, fr, fq);
        if (!has_next) break;
#pragma unroll
        for (int a = 0; a < 2; ++a)
#pragma unroll
            for (int b = 0; b < 2; ++b)
#pragma unroll
                for (int m = 0; m < 4; ++m)
#pragma unroll
                    for (int n = 0; n < 2; ++n) acc[a][b][m][n] = (f32x4){0.f, 0.f, 0.f, 0.f};
        cur = nxt; cA = nA; cB = nB; ++ui;
        if constexpr (GATHER) {
#pragma unroll
            for (int _h = 0; _h < 2; ++_h)
#pragma unroll
                for (int _i = 0; _i < 2; ++_i) gA[_h][_i] = gN[_h][_i]; }
        if constexpr (ALIGN_EPI) { if (wr == 1) PG8_BAR; }
    }
    PG8_WAIT_V(0);
    if constexpr (!ALIGN_EPI) { if (wr == 0) PG8_BAR; }
    PG8_BAR;
#undef PG8_SA
#undef PG8_SB
#undef PG8_GLDS
#undef PG8_STAGE_A
#undef PG8_STAGE_B
#undef PG8_LDA
#undef PG8_LDB
#undef PG8_MMA
#undef PG8_WAIT_V
#undef PG8_WAIT_L
#undef PG8_BAR
#undef PG8_SCHED
#undef PG8_GOFF
}
}

typedef float f32x4_t __attribute__((ext_vector_type(4)));
__device__ __forceinline__ int inproj_row(int j) {
    if (j < 512) { const int h = j >> 6, d = j & 63; return h * 64 + 2 * (d & 31) + (d >> 5); }
    if (j < 1280) { const int seg = (j - 512) >> 7, cc = (j - 512) & 127; int col = cc; if (seg == 2 || seg == 4) { const int g = cc >> 6, d = cc & 63; col = g * 64 + 2 * (d & 31) + (d >> 5); } return (2 + (seg >> 1)) * 256 + (seg & 1) * 128 + col; }
    if (j < 1304) return 11 * 256 + (j - 1280);
    if (j < 1560) return 5 * 256 + (j - 1304);
    if (j < 1816) return 6 * 256 + (j - 1560);
    if (j < 2328) return 7 * 256 + (j - 1816);
    if (j < 2344) return 11 * 256 + 32 + (j - 2328);
    if (j < 2856) return 9 * 256 + (j - 2344);
    if (j < 3880) return 12 * 256 + (j - 2856);
    return 16 * 256 + (j - 3880);
}
__device__ __forceinline__ unsigned pk2(float lo, float hi) { return (unsigned)f2bf(lo) | ((unsigned)f2bf(hi) << 16); }
template <class RM>
__device__ __forceinline__ void transpose_item(const float* W, int ldw, int N, bf16* WT, int ldt, float* scr, int k0, int n0, int lane, RM rm) {
    const int nn = n0 + (lane & 31);
#pragma unroll 8
    for (int i = 0; i < 32; ++i) { const int kk = 2 * i + (lane >> 5); scr[kk * 33 + (lane & 31)] = nn < N ? W[(size_t)(k0 + kk) * ldw + nn] : 0.f; }
    asm volatile("s_waitcnt lgkmcnt(0)" ::: "memory");
    const int c = lane & 7;
#pragma unroll
    for (int j = 0; j < 4; ++j) { const int n = (lane >> 3) + 8 * j; const float* s = scr + (8 * c) * 33 + n;
        uint4 o; o.x = pk2(s[0 * 33], s[1 * 33]); o.y = pk2(s[2 * 33], s[3 * 33]); o.z = pk2(s[4 * 33], s[5 * 33]); o.w = pk2(s[6 * 33], s[7 * 33]);
        const int row = (n0 + n < N) ? rm(n0 + n) : -1;
        if (row >= 0) *(uint4*)(WT + (size_t)row * ldt + k0 + 8 * c) = o; }
    asm volatile("s_waitcnt lgkmcnt(0)" ::: "memory");
}
constexpr int PREP_I_WIN = 16 * 154, PREP_I_C1 = 4 * 128, PREP_I_PN = 256, PREP_I_PG = 256, PREP_I_WO = 512, PREP_I_EXP = 3 * 32 * 256;
constexpr int PREP_ITEMS = PREP_I_WIN + PREP_I_C1 + PREP_I_PN + PREP_I_PG + PREP_I_WO + PREP_I_EXP;
__device__ __forceinline__ void prep_item(const P& p, int it, float* scr, int lane) {
    if (it < PREP_I_WIN) { const int kb = it / 154, nb = it % 154; transpose_item(p.w_in, INW, INW, p.Wt_in, 1024, scr, kb * 64, nb * 32, lane, [](int n) { return inproj_row(n); }); return; }
    it -= PREP_I_WIN;
    if (it < PREP_I_C1) { const int mat = it >> 7, r = it & 127, kb = r >> 3, nb = r & 7, kv = mat >> 1, half = mat & 1;
        const float* W = (kv ? p.cw1_v : p.cw1_k) + (size_t)half * 1024 * 256;
        transpose_item(W, 256, 256, p.Wc1 + (size_t)kv * 512 * 1024, 1024, scr, kb * 64, nb * 32, lane, [half](int n) { return half * 256 + n; }); return; }
    it -= PREP_I_C1;
    if (it < PREP_I_PN) { transpose_item(p.w_pn, 1024, 1024, p.Wpn, 512, scr, (it >> 5) * 64, (it & 31) * 32, lane, [](int n) { return n; }); return; }
    it -= PREP_I_PN;
    if (it < PREP_I_PG) { transpose_item(p.w_pg, 1024, 1024, p.Wpg, 512, scr, (it >> 5) * 64, (it & 31) * 32, lane, [](int n) { return n; }); return; }
    it -= PREP_I_PG;
    if (it < PREP_I_WO) { transpose_item(p.w_out, 1024, 1024, p.Wo, 1024, scr, (it >> 5) * 64, (it & 31) * 32, lane, [](int n) { return n; }); return; }
    it -= PREP_I_WO;
    { const int which = it / (32 * 256), r = it % (32 * 256), e = r >> 8, r2 = r & 255;
        if (which == 0) transpose_item(p.w_gate + (size_t)e * 1024 * 512, 512, 512, p.Wgu + (size_t)e * 1024 * 1024, 1024, scr, (r2 >> 4) * 64, (r2 & 15) * 32, lane, [](int n) { return (n >> 7) * 256 + (n & 127); });
        else if (which == 1) transpose_item(p.w_up + (size_t)e * 1024 * 512, 512, 512, p.Wgu + (size_t)e * 1024 * 1024, 1024, scr, (r2 >> 4) * 64, (r2 & 15) * 32, lane, [](int n) { return (n >> 7) * 256 + 128 + (n & 127); });
        else transpose_item(p.w_down + (size_t)e * 512 * 1024, 1024, 1024, p.Wd + (size_t)e * 1024 * 512, 512, scr, (r2 >> 5) * 64, (r2 & 31) * 32, lane, [](int n) { return n; }); }
}
__device__ __forceinline__ void phase_prep_(const P& p, char* smem);
__device__ __forceinline__ void prep_b1p(const P& p, char* smem);
__device__ __forceinline__ void phase_prep(const P& p, char* smem) { prep_b1p(p, smem); phase_prep_(p, smem); }
__device__ __forceinline__ void phase_prep_(const P& p, char* smem) {
    const int wave = TIDX() >> 6, lane = TIDX() & 63;
    float* scr = (float*)smem + wave * (64 * 33);
    const int gw = blockIdx.x * 8 + wave, NGW = gridDim.x * 8;
    for (int it = gw; it < PREP_ITEMS; it += NGW) prep_item(p, it, scr, lane);
    for (int i = blockIdx.x * NT + TIDX(); i < 216 * 128; i += gridDim.x * NT) { int r = i >> 7; r = r < 8 ? 24 + r : 40 + r; *(uint4*)(p.Wt_in + (size_t)(11 * 256 + r) * 1024 + (i & 127) * 8) = make_uint4(0, 0, 0, 0); }
    for (int i = blockIdx.x * NT + TIDX(); i < 36 * 1024; i += gridDim.x * NT) { const int o = i >> 10, k = i & 1023; p.wr[i] = o < 4 ? p.w_grp[k * 4 + o] : p.w_exp[k * 32 + (o - 4)]; }
    for (int vb = blockIdx.x; vb < p.T / 8; vb += gridDim.x) body_rms(p, vb);
    for (int vb = blockIdx.x; vb < p.T * 32 / NT; vb += gridDim.x) body_cs(p, vb);
}

struct EpiInA {
    static constexpr bool PERM = true;
    P p;
    __device__ __forceinline__ static void rope4(const float* cs, int t, int i0, const pg8::f32x4& v0, const pg8::f32x4& v1, float sc, pg8::u32x2& lo, pg8::u32x2& hi) {
        const f32x4_t c = *(const f32x4_t*)(cs + (size_t)t * 64 + i0), s = *(const f32x4_t*)(cs + (size_t)t * 64 + 32 + i0);
        const float a0 = (v0[0] * c[0] - v0[1] * s[0]) * sc, b0 = (v0[1] * c[0] + v0[0] * s[0]) * sc;
        const float a1 = (v0[2] * c[1] - v0[3] * s[1]) * sc, b1 = (v0[3] * c[1] + v0[2] * s[1]) * sc;
        const float a2 = (v1[0] * c[2] - v1[1] * s[2]) * sc, b2 = (v1[1] * c[2] + v1[0] * s[2]) * sc;
        const float a3 = (v1[2] * c[3] - v1[3] * s[3]) * sc, b3 = (v1[3] * c[3] + v1[2] * s[3]) * sc;
        lo.x = pk2(a0, a1); lo.y = pk2(a2, a3); hi.x = pk2(b0, b1); hi.y = pk2(b2, b3);
    }
    __device__ __forceinline__ static pg8::u32x4 pack8(const pg8::f32x4& v0, const pg8::f32x4& v1) { pg8::u32x4 w; w.x = pk2(v0[0], v0[1]); w.y = pk2(v0[2], v0[3]); w.z = pk2(v1[0], v1[1]); w.w = pk2(v1[2], v1[3]); return w; }
    __device__ __forceinline__ void operator()(const pg8::f32x4 (&acc)[2][2][4][2], const pg8::Unit& u, int wr, int wc, int fr, int fq) const {
        const int pn = u.pn, c8 = wc * 32 + 8 * fq; const size_t seg = kvseg(p);
#pragma unroll
        for (int ai = 0; ai < 2; ++ai)
#pragma unroll
            for (int m = 0; m < 4; ++m) {
                const int t = u.pm * 256 + ai * 128 + wr * 64 + m * 16 + fr; const int b = t / S, s = t % S;
#pragma unroll
                for (int bj = 0; bj < 2; ++bj) {
                    const pg8::f32x4 v0 = acc[ai][bj][m][0], v1 = acc[ai][bj][m][1];
                    if (pn <= 1) {
                        const int cq = pn * 256 + bj * 128 + c8, h = cq >> 6, i0 = (cq & 63) >> 1; pg8::u32x2 lo, hi;
                        rope4(p.cs, t, i0, v0, v1, 0.125f, lo, hi);
                        bf16* dst = p.q + (size_t)t * 512 + h * 64 + i0; *(pg8::u32x2*)dst = lo; *(pg8::u32x2*)(dst + 32) = hi;
                    } else if (pn <= 4) {
                        const int sgi = (pn - 2) * 2 + bj, g = c8 >> 6; bf16* base = p.kv6 + (size_t)sgi * seg + ((size_t)(b * 2 + g) * S + s) * 64;
                        if (bj == 0 && pn >= 3) { const int i0 = (c8 & 63) >> 1; pg8::u32x2 lo, hi; rope4(p.cs, t, i0, v0, v1, 1.f, lo, hi); *(pg8::u32x2*)(base + i0) = lo; *(pg8::u32x2*)(base + 32 + i0) = hi; }
                        else *(pg8::u32x4*)(base + (c8 & 63)) = pack8(v0, v1);
                    } else if (pn == 5) { *(pg8::u32x4*)(p.gq + (size_t)t * 256 + bj * 128 + c8) = pack8(v0 * 0.125f, v1 * 0.125f);
                    } else if (pn == 6) { *(pg8::u32x4*)(p.gk + (size_t)t * 256 + bj * 128 + c8) = pack8(v0, v1);
                    } else if (pn <= 8) { *(pg8::u32x4*)(p.gv + (size_t)t * 512 + (pn - 7) * 256 + bj * 128 + c8) = pack8(v0, v1);
                    } else if (pn <= 10) {
                        pg8::f32x4 a, c;
#pragma unroll
                        for (int e = 0; e < 4; ++e) { a[e] = siluf_(v0[e]); c[e] = siluf_(v1[e]); }
                        *(pg8::u32x4*)(p.rs + (size_t)t * 512 + (pn - 9) * 256 + bj * 128 + c8) = pack8(a, c);
                    } else {
                        if (bj == 0) {
                            if (c8 < 24) { float* d = p.gates + (size_t)t * 24 + c8;
#pragma unroll
                                for (int e = 0; e < 4; ++e) { d[e] = sigmoidf_(v0[e]); d[4 + e] = sigmoidf_(v1[e]); } }
                            else if (c8 >= 32 && c8 < 48) { float* d = p.alow + (size_t)t * 16 + (c8 - 32);
#pragma unroll
                                for (int e = 0; e < 4; ++e) { d[e] = v0[e]; d[4 + e] = v1[e]; } }
                        }
                    }
                }
            }
    }
};
struct EpiSig {
    static constexpr bool PERM = true;
    bf16* sa; bf16* sb;
    __device__ __forceinline__ void operator()(const pg8::f32x4 (&acc)[2][2][4][2], const pg8::Unit& u, int wr, int wc, int fr, int fq) const {
        bf16* base = (u.pn < 4 ? sa : sb) + (u.pn & 3) * 256 + wc * 32 + 8 * fq;
#pragma unroll
        for (int ai = 0; ai < 2; ++ai)
#pragma unroll
            for (int m = 0; m < 4; ++m) { const int t = u.pm * 256 + ai * 128 + wr * 64 + m * 16 + fr;
#pragma unroll
                for (int bj = 0; bj < 2; ++bj) { pg8::f32x4 a, c;
#pragma unroll
                    for (int e = 0; e < 4; ++e) { a[e] = sigmoidf_(acc[ai][bj][m][0][e]); c[e] = sigmoidf_(acc[ai][bj][m][1][e]); }
                    *(pg8::u32x4*)(base + (size_t)t * 1024 + bj * 128) = EpiInA::pack8(a, c); } }
    }
};
__device__ __forceinline__ void phase_inA(const P& p, char* smem) {
    pg8::DenseSched S; S.init(p.u, p.Wt_in, p.T, 3072, 1024, 1024);
    EpiInA E{p};
    pg8::gemm_phase<EpiInA, pg8::DenseSched, true, false>((PG8_LAS unsigned char*)smem, 1024, 1024, 1024, S, E);
}
__device__ __forceinline__ void phase_inB(const P& p, char* smem) {
    pg8::DenseSched S; S.init(p.u, p.Wt_in + (size_t)3072 * 1024, p.T, 2048, 1024, 1024);
    EpiSig E{p.sa, p.sb};
    pg8::gemm_phase<EpiSig, pg8::DenseSched, true, false>((PG8_LAS unsigned char*)smem, 1024, 1024, 1024, S, E);
}

struct EpiProj {
    static constexpr bool PERM = true;
    const bf16* g; bf16* mixed; int pass;
    __device__ __forceinline__ void operator()(const pg8::f32x4 (&acc)[2][2][4][2], const pg8::Unit& u, int wr, int wc, int fr, int fq) const {
        const int col0 = u.pn * 256 + wc * 32 + 8 * fq;
#pragma unroll
        for (int ai = 0; ai < 2; ++ai)
#pragma unroll
            for (int m = 0; m < 4; ++m) { const size_t t = (size_t)(u.pm * 256 + ai * 128 + wr * 64 + m * 16 + fr);
#pragma unroll
                for (int bj = 0; bj < 2; ++bj) { const size_t off = t * 1024 + col0 + bj * 128;
                    const uint4 gv = *(const uint4*)(g + off); const unsigned gw[4] = {gv.x, gv.y, gv.z, gv.w};
                    float r[8];
#pragma unroll
                    for (int e = 0; e < 4; ++e) { const float a = e < 2 ? acc[ai][bj][m][0][2 * e] : acc[ai][bj][m][1][2 * e - 4], b = e < 2 ? acc[ai][bj][m][0][2 * e + 1] : acc[ai][bj][m][1][2 * e - 3];
                        r[2 * e] = __uint_as_float(gw[e] << 16) * a; r[2 * e + 1] = __uint_as_float(gw[e] & 0xffff0000u) * b; }
                    if (pass) { const uint4 mv = *(const uint4*)(mixed + off); const unsigned mw[4] = {mv.x, mv.y, mv.z, mv.w};
#pragma unroll
                        for (int e = 0; e < 4; ++e) { r[2 * e] += __uint_as_float(mw[e] << 16); r[2 * e + 1] += __uint_as_float(mw[e] & 0xffff0000u); } }
                    uint4 o; o.x = pk2(r[0], r[1]); o.y = pk2(r[2], r[3]); o.z = pk2(r[4], r[5]); o.w = pk2(r[6], r[7]);
                    *(uint4*)(mixed + off) = o; } }
    }
};
struct EpiOut {
    static constexpr bool PERM = false;
    const float* x; float* h1;
    __device__ __forceinline__ void operator()(const pg8::f32x4 (&acc)[2][2][4][2], const pg8::Unit& u, int wr, int wc, int fr, int fq) const {
        const int col0 = u.pn * 256 + wc * 32 + 4 * fq;
#pragma unroll
        for (int ai = 0; ai < 2; ++ai)
#pragma unroll
            for (int m = 0; m < 4; ++m) { const size_t off = (size_t)(u.pm * 256 + ai * 128 + wr * 64 + m * 16 + fr) * 1024 + col0;
#pragma unroll
                for (int bj = 0; bj < 2; ++bj)
#pragma unroll
                    for (int n = 0; n < 2; ++n) { const pg8::f32x4 xv = *(const pg8::f32x4*)(x + off + bj * 128 + n * 16); *(pg8::f32x4*)(h1 + off + bj * 128 + n * 16) = xv + acc[ai][bj][m][n]; } }
    }
};
__device__ __forceinline__ void phase_proj(const P& p, char* smem) {
    { pg8::DenseSched S; S.init(p.onsa, p.Wpn, p.T, 1024, 512, 512); EpiProj E{p.sa, p.mixed, 0};
      pg8::gemm_phase<EpiProj, pg8::DenseSched, true, false>((PG8_LAS unsigned char*)smem, 512, 512, 512, S, E); }
    { pg8::DenseSched S; S.init(p.gla, p.Wpg, p.T, 1024, 512, 512); EpiProj E{p.sb, p.mixed, 1};
      pg8::gemm_phase<EpiProj, pg8::DenseSched, true, false>((PG8_LAS unsigned char*)smem, 512, 512, 512, S, E); }
}
__device__ __forceinline__ void phase_out(const P& p, char* smem) {
    pg8::DenseSched S; S.init(p.mixed, p.Wo, p.T, 1024, 1024, 1024); EpiOut E{p.x, p.h1};
    pg8::gemm_phase<EpiOut, pg8::DenseSched, true, false>((PG8_LAS unsigned char*)smem, 1024, 1024, 1024, S, E);
}

struct ExpertSched {
    const int* ub;
    const int* sb_;
    const unsigned* cnt; const int* list; int T;
    const char* A; const char* B; int lda, ldb; size_t bstride;
    int npn, G, c; bool gather;
    __device__ __forceinline__ bool next(int i, pg8::Unit& u) const {
        const int L = i * G + c; if (L >= ub[NEXP]) return false;
        int e = 0; while (L >= ub[e + 1]) ++e;
        const int rem = L - ub[e], tiles = (ub[e + 1] - ub[e]) / npn, pn = rem / tiles, pml = rem % tiles;
        u.pm = sb_[e] / 256 + pml; u.pn = pn; u.tag = e | (pml << 8);
        u.A = gather ? A : A + (size_t)u.pm * 256 * lda * 2; u.B = B + (size_t)e * bstride + (size_t)pn * 256 * ldb * 2; return true;
    }
    __device__ __forceinline__ unsigned arow(const pg8::Unit& u, int r) const {
        const int e = u.tag & 255, sl = (u.tag >> 8) * 256 + r; const int tok = list[(size_t)e * T + (sl < (int)cnt[e] ? sl : 0)];
        return (unsigned)tok * (unsigned)lda * 2u;
    }
};
__device__ __forceinline__ void expert_tables(const P& p, char* smem, int npn, int*& ub, int*& sb_) {
    ub = (int*)(smem + LDS_MISC + 1024); sb_ = ub + 40;
    __syncthreads();
    if (TIDX() == 0) { int ua = 0, sa = 0; for (int e = 0; e < NEXP; ++e) { ub[e] = ua; sb_[e] = sa; const int tl = ((int)p.ctl[e] + 255) >> 8; ua += tl * npn; sa += tl * 256; } ub[NEXP] = ua; sb_[NEXP] = sa; }
    __syncthreads();
}
struct EpiMoe1 {
    static constexpr bool PERM = true;
    bf16* H;
    __device__ __forceinline__ void operator()(const pg8::f32x4 (&acc)[2][2][4][2], const pg8::Unit& u, int wr, int wc, int fr, int fq) const {
        const int col0 = u.pn * 128 + wc * 32 + 8 * fq;
#pragma unroll
        for (int ai = 0; ai < 2; ++ai)
#pragma unroll
            for (int m = 0; m < 4; ++m) { const size_t row = (size_t)(u.pm * 256 + ai * 128 + wr * 64 + m * 16 + fr);
                pg8::f32x4 a, b;
#pragma unroll
                for (int e = 0; e < 4; ++e) { a[e] = siluf_(acc[ai][0][m][0][e]) * acc[ai][1][m][0][e]; b[e] = siluf_(acc[ai][0][m][1][e]) * acc[ai][1][m][1][e]; }
                *(pg8::u32x4*)(H + row * 512 + col0) = EpiInA::pack8(a, b); }
    }
};
struct EpiMoe2 {
    static constexpr bool PERM = true;
    bf16* Y;
    __device__ __forceinline__ void operator()(const pg8::f32x4 (&acc)[2][2][4][2], const pg8::Unit& u, int wr, int wc, int fr, int fq) const {
        const int col0 = u.pn * 256 + wc * 32 + 8 * fq;
#pragma unroll
        for (int ai = 0; ai < 2; ++ai)
#pragma unroll
            for (int m = 0; m < 4; ++m) { const size_t row = (size_t)(u.pm * 256 + ai * 128 + wr * 64 + m * 16 + fr);
#pragma unroll
                for (int bj = 0; bj < 2; ++bj) *(pg8::u32x4*)(Y + row * 1024 + col0 + bj * 128) = EpiInA::pack8(acc[ai][bj][m][0], acc[ai][bj][m][1]); }
    }
};
__device__ __forceinline__ void phase_moe1(const P& p, char* smem) {
    int *ub, *sb_; expert_tables(p, smem, 4, ub, sb_);
    ExpertSched S{ub, sb_, p.ctl, p.list, p.T, (const char*)p.vb, (const char*)p.Wgu, 1024, 1024, (size_t)1024 * 1024 * 2, 4, (int)gridDim.x, (int)blockIdx.x, true};
    EpiMoe1 E{p.H};
    pg8::gemm_phase<EpiMoe1, ExpertSched, true, true>((PG8_LAS unsigned char*)smem, 1024, 1024, 1024, S, E);
}
__device__ __forceinline__ void phase_moe2(const P& p, char* smem) {
    int *ub, *sb_; expert_tables(p, smem, 4, ub, sb_);
    ExpertSched S{ub, sb_, p.ctl, p.list, p.T, (const char*)p.H, (const char*)p.Wd, 512, 512, (size_t)1024 * 512 * 2, 4, (int)gridDim.x, (int)blockIdx.x, false};
    EpiMoe2 E{p.Y};
    pg8::gemm_phase<EpiMoe2, ExpertSched, true, false>((PG8_LAS unsigned char*)smem, 512, 512, 512, S, E);
}

namespace nsa {
using f32x16 = __attribute__((ext_vector_type(16))) float;
using bf16x8 = __attribute__((ext_vector_type(8))) short;
using s16x4 = __attribute__((ext_vector_type(4))) short;
using u32x4 = __attribute__((ext_vector_type(4))) unsigned;
typedef __attribute__((address_space(3))) char* lptr;
typedef __attribute__((address_space(3))) const char* lcptr;
constexpr int SLOT = 8192;
constexpr int L_K = 0, L_V = 2 * SLOT, L_WS = 4 * SLOT, L_OST = L_WS + 8 * 512, L_IMPD = L_OST + 8 * 4096, L_IMPC = L_IMPD + 64 * 64 * 4, L_SEL = L_IMPC + 64 * 68 * 4, L_END = L_SEL + 64 * 8;
constexpr float LOG2E = 1.4426950408889634f, NEGM = -1e30f, M0 = -1e20f, THR = 8.f;
__device__ __forceinline__ int crow(int r, int hi) { return (r & 3) + 8 * (r >> 2) + 4 * hi; }
__device__ __forceinline__ void glds16(const void* gsrc, unsigned lds_dst) { unsigned keep;
    asm volatile("s_mov_b32 %0, m0\n\ts_mov_b32 m0, %2\n\ts_nop 0\n\tglobal_load_lds_dwordx4 %1, off\n\ts_mov_b32 m0, %0" : "=&s"(keep) : "v"(gsrc), "s"(lds_dst) : "memory"); }
#define NSA_WAIT_BAR() asm volatile("s_waitcnt vmcnt(0) lgkmcnt(0)\n\ts_barrier" ::: "memory")
#define NSA_LWAIT() asm volatile("s_waitcnt lgkmcnt(0)" ::: "memory")
__device__ __forceinline__ unsigned cvtpk(float lo, float hi) { typedef float f2 __attribute__((ext_vector_type(2))); typedef __bf16 b2 __attribute__((ext_vector_type(2))); f2 v = {lo, hi}; b2 b = __builtin_convertvector(v, b2); return __builtin_bit_cast(unsigned, b); }
__device__ __forceinline__ float xhalf_max(float m) { auto rr = __builtin_amdgcn_permlane32_swap(__float_as_uint(m), __float_as_uint(m), false, false); return fmaxf(__uint_as_float(rr[0]), __uint_as_float(rr[1])); }
__device__ __forceinline__ float xhalf_sum(float m) { auto rr = __builtin_amdgcn_permlane32_swap(__float_as_uint(m), __float_as_uint(m), false, false); return __uint_as_float(rr[0]) + __uint_as_float(rr[1]); }
__device__ __forceinline__ void qkt(f32x16& p0, f32x16& p1, lcptr Kslot, const bf16x8* qr, int r32, int hi) {
    lcptr kb = Kslot + hi * 1024 + r32 * 16;
    p0 = f32x16{}; p1 = f32x16{};
#pragma unroll
    for (int d0 = 0; d0 < 4; ++d0) {
        const bf16x8 b0 = *(const __attribute__((address_space(3))) bf16x8*)(kb + d0 * 2048);
        const bf16x8 b1 = *(const __attribute__((address_space(3))) bf16x8*)(kb + d0 * 2048 + 512);
        p0 = __builtin_amdgcn_mfma_f32_32x32x16_bf16(b0, qr[d0], p0, 0, 0, 0); p1 = __builtin_amdgcn_mfma_f32_32x32x16_bf16(b1, qr[d0], p1, 0, 0, 0); }
}
__device__ __forceinline__ void pv(f32x16* o, int vb, bf16x8 pa0, bf16x8 pa1, bf16x8 pa2, bf16x8 pa3) {
#pragma unroll
    for (int d0 = 0; d0 < 2; ++d0) { s16x4 lo[4], hi[4];
#pragma unroll
        for (int ks = 0; ks < 4; ++ks) {
            asm volatile("ds_read_b64_tr_b16 %0,%1 offset:%c2" : "=&v"(lo[ks]) : "v"(vb), "i"(d0 * 4096 + ks * 1024) : "memory");
            asm volatile("ds_read_b64_tr_b16 %0,%1 offset:%c2" : "=&v"(hi[ks]) : "v"(vb), "i"(d0 * 4096 + ks * 1024 + 512) : "memory"); }
        asm volatile("s_waitcnt lgkmcnt(0)" ::: "memory"); __builtin_amdgcn_sched_barrier(0);
#define NSA_PK(k) (bf16x8){lo[k][0], lo[k][1], lo[k][2], lo[k][3], hi[k][0], hi[k][1], hi[k][2], hi[k][3]}
        o[d0] = __builtin_amdgcn_mfma_f32_32x32x16_bf16(pa0, NSA_PK(0), o[d0], 0, 0, 0);
        o[d0] = __builtin_amdgcn_mfma_f32_32x32x16_bf16(pa1, NSA_PK(1), o[d0], 0, 0, 0);
        o[d0] = __builtin_amdgcn_mfma_f32_32x32x16_bf16(pa2, NSA_PK(2), o[d0], 0, 0, 0);
        o[d0] = __builtin_amdgcn_mfma_f32_32x32x16_bf16(pa3, NSA_PK(3), o[d0], 0, 0, 0);
#undef NSA_PK
    }
}
__device__ __forceinline__ float rowmax32(const f32x16& p0, const f32x16& p1) {
    float a = fmaxf(p0[0], p1[0]);
#pragma unroll
    for (int r = 1; r < 16; ++r) a = fmaxf(a, fmaxf(p0[r], p1[r]));
    return xhalf_max(a);
}
struct Ctx {
    int w, lane, r32, hi; unsigned lds0; lptr shm; const bf16* kt; const bf16* vt;
};
__device__ __forceinline__ void dma_kv(const Ctx& c, int tile, int slot) {
    const bf16* ksrc = c.kt + (size_t)tile * 64 * 64 + c.lane * 64 + c.w * 8;
    const bf16* vsrc = c.vt + (size_t)tile * 64 * 64 + (16 * (c.w & 3) + (c.lane >> 2)) * 64 + (c.w >> 2) * 32 + (c.lane & 3) * 8;
    glds16(ksrc, (unsigned)__builtin_amdgcn_readfirstlane(c.lds0 + L_K + slot * SLOT + c.w * 1024));
    glds16(vsrc, (unsigned)__builtin_amdgcn_readfirstlane(c.lds0 + L_V + slot * SLOT + c.w * 1024));
}
__device__ __forceinline__ void softmax_pv(const Ctx& c, f32x16& p0, f32x16& p1, f32x16* o, float& m, float& l, int slot) {
    const float rm = rowmax32(p0, p1);
    volatile __attribute__((address_space(3))) float* wsf = (volatile __attribute__((address_space(3))) float*)(c.shm + L_WS + c.w * 512);
    bool resc = false;
    if (__any(rm > m + THR)) { const float mn = fmaxf(m, rm); const float f = __builtin_amdgcn_exp2f(m - mn); l *= f; m = mn; if (c.hi == 0) wsf[c.r32] = f; resc = true; }
    float sacc = 0.f;
#pragma unroll
    for (int r = 0; r < 16; ++r) { p0[r] = __builtin_amdgcn_exp2f(p0[r] - m); p1[r] = __builtin_amdgcn_exp2f(p1[r] - m); sacc += p0[r] + p1[r]; }
    l += sacc;
    if (resc) { NSA_LWAIT();
#pragma unroll
        for (int r = 0; r < 16; ++r) { const float f = wsf[crow(r, c.hi)]; o[0][r] *= f; o[1][r] *= f; } }
    u32x4 w0, w1, w2, w3;
    w0 = (u32x4){cvtpk(p0[0], p0[1]), cvtpk(p0[2], p0[3]), cvtpk(p0[4], p0[5]), cvtpk(p0[6], p0[7])};
    w1 = (u32x4){cvtpk(p0[8], p0[9]), cvtpk(p0[10], p0[11]), cvtpk(p0[12], p0[13]), cvtpk(p0[14], p0[15])};
    w2 = (u32x4){cvtpk(p1[0], p1[1]), cvtpk(p1[2], p1[3]), cvtpk(p1[4], p1[5]), cvtpk(p1[6], p1[7])};
    w3 = (u32x4){cvtpk(p1[8], p1[9]), cvtpk(p1[10], p1[11]), cvtpk(p1[12], p1[13]), cvtpk(p1[14], p1[15])};
    const int vb = (int)(c.lds0 + L_V + slot * SLOT) + ((c.lane >> 4) & 1) * 32 + (c.lane & 3) * 8 + (4 * c.hi + ((c.lane & 15) >> 2)) * 64;
    pv(o, vb, __builtin_bit_cast(bf16x8, w0), __builtin_bit_cast(bf16x8, w1), __builtin_bit_cast(bf16x8, w2), __builtin_bit_cast(bf16x8, w3));
}
__device__ __forceinline__ void accum_branch(const Ctx& c, f32x16* oacc, const f32x16* o, float fac) {
    volatile __attribute__((address_space(3))) float* wsf = (volatile __attribute__((address_space(3))) float*)(c.shm + L_WS + c.w * 512);
    NSA_LWAIT(); if (c.hi == 0) wsf[64 + c.r32] = fac; NSA_LWAIT();
#pragma unroll
    for (int r = 0; r < 16; ++r) { const float f = wsf[64 + crow(r, c.hi)]; oacc[0][r] += o[0][r] * f; oacc[1][r] += o[1][r] * f; }
    NSA_LWAIT();
}
__device__ __forceinline__ void nsa_unit(const P& p, char* smem, int b, int g, int jq) {
    const int tid = TIDX(); Ctx c; c.lane = tid & 63; c.w = __builtin_amdgcn_readfirstlane(tid >> 6); c.r32 = c.lane & 31; c.hi = c.lane >> 5;
    c.shm = (lptr)smem; c.lds0 = (unsigned)(size_t)c.shm;
    const int hh = c.r32 >> 3, tokl = 8 * c.w + (c.r32 & 7), stok = 64 * jq + tokl, h = g * 4 + hh; const size_t t = (size_t)b * S + stok;
    const size_t seg = kvseg(p), ho = (size_t)(b * 2 + g) * S * 64;
    bf16x8 qr[4];
#pragma unroll
    for (int d0 = 0; d0 < 4; ++d0) qr[d0] = *(const bf16x8*)(p.q + t * 512 + h * 64 + d0 * 16 + c.hi * 8);
    const float g0 = p.gates[t * 24 + h * 3], g1 = p.gates[t * 24 + h * 3 + 1], g2 = p.gates[t * 24 + h * 3 + 2];
    f32x16 oacc[2], o[2], p0, p1; oacc[0] = f32x16{}; oacc[1] = f32x16{};
    __attribute__((address_space(3))) float* impD = (__attribute__((address_space(3))) float*)(c.shm + L_IMPD);
    __attribute__((address_space(3))) float* impC = (__attribute__((address_space(3))) float*)(c.shm + L_IMPC);
    __attribute__((address_space(3))) u64* selm = (__attribute__((address_space(3))) u64*)(c.shm + L_SEL);
    const int nv = stok >= 31 ? (stok - 31) / 16 + 1 : 0;
    const int nct = (4 * jq + 3 + 63) >> 6;
    c.kt = p.kcmp + (size_t)(b * 2 + g) * 256 * 64; c.vt = p.vcmp + (size_t)(b * 2 + g) * 256 * 64;
    float m = M0, l = 0.f;
    if (tid < 64) impC[tid * 68] = 0.f;
    __builtin_amdgcn_s_barrier();
    dma_kv(c, 0, 0);
    for (int ct = 0; ct < nct; ++ct) {
        NSA_WAIT_BAR(); if (ct + 1 < nct) dma_kv(c, ct + 1, (ct + 1) & 1);
        qkt(p0, p1, (lcptr)(c.shm + L_K + (ct & 1) * SLOT), qr, c.r32, c.hi);
#pragma unroll
        for (int r = 0; r < 16; ++r) { const int n = 64 * ct + crow(r, c.hi); p0[r] = n < nv ? p0[r] * LOG2E : NEGM; p1[r] = n + 32 < nv ? p1[r] * LOG2E : NEGM; }
        const float rm = rowmax32(p0, p1); const float mn = fmaxf(m, rm); float sacc = 0.f;
#pragma unroll
        for (int r = 0; r < 16; ++r) sacc += __builtin_amdgcn_exp2f(p0[r] - mn) + __builtin_amdgcn_exp2f(p1[r] - mn);
        l = l * __builtin_amdgcn_exp2f(m - mn) + sacc; m = mn;
    }
    l = xhalf_sum(l); const float il = l > 0.f ? 1.f / l : 0.f;
    o[0] = f32x16{}; o[1] = f32x16{};
    __builtin_amdgcn_s_barrier();
    dma_kv(c, 0, 0);
    for (int ct = 0; ct < nct; ++ct) {
        NSA_WAIT_BAR(); if (ct + 1 < nct) dma_kv(c, ct + 1, (ct + 1) & 1);
        qkt(p0, p1, (lcptr)(c.shm + L_K + (ct & 1) * SLOT), qr, c.r32, c.hi);
#pragma unroll
        for (int r = 0; r < 16; ++r) { const int n = 64 * ct + crow(r, c.hi); p0[r] = n < nv ? __builtin_amdgcn_exp2f(p0[r] * LOG2E - m) * il : 0.f; p1[r] = n + 32 < nv ? __builtin_amdgcn_exp2f(p1[r] * LOG2E - m) * il : 0.f; }
#pragma unroll
        for (int hb = 0; hb < 2; ++hb)
#pragma unroll
            for (int rg = 0; rg < 4; ++rg) {
                const f32x16& pp = hb ? p1 : p0;
                float dsum = pp[4 * rg] + pp[4 * rg + 1] + pp[4 * rg + 2] + 0.5f * pp[4 * rg + 3], csum = 0.5f * pp[4 * rg + 3];
                dsum += __shfl_xor(dsum, 8); dsum += __shfl_xor(dsum, 16); csum += __shfl_xor(csum, 8); csum += __shfl_xor(csum, 16);
                const int j = 16 * ct + 8 * hb + 2 * rg + c.hi;
                if (c.r32 < 8) { impD[tokl * 64 + j] = dsum; impC[tokl * 68 + j + 1] = csum; }
            }
        u32x4 w0, w1, w2, w3;
        w0 = (u32x4){cvtpk(p0[0], p0[1]), cvtpk(p0[2], p0[3]), cvtpk(p0[4], p0[5]), cvtpk(p0[6], p0[7])};
        w1 = (u32x4){cvtpk(p0[8], p0[9]), cvtpk(p0[10], p0[11]), cvtpk(p0[12], p0[13]), cvtpk(p0[14], p0[15])};
        w2 = (u32x4){cvtpk(p1[0], p1[1]), cvtpk(p1[2], p1[3]), cvtpk(p1[4], p1[5]), cvtpk(p1[6], p1[7])};
        w3 = (u32x4){cvtpk(p1[8], p1[9]), cvtpk(p1[10], p1[11]), cvtpk(p1[12], p1[13]), cvtpk(p1[14], p1[15])};
        const int vb = (int)(c.lds0 + L_V + (ct & 1) * SLOT) + ((c.lane >> 4) & 1) * 32 + (c.lane & 3) * 8 + (4 * c.hi + ((c.lane & 15) >> 2)) * 64;
        pv(o, vb, __builtin_bit_cast(bf16x8, w0), __builtin_bit_cast(bf16x8, w1), __builtin_bit_cast(bf16x8, w2), __builtin_bit_cast(bf16x8, w3));
    }
    accum_branch(c, oacc, o, g0);
    NSA_LWAIT(); __builtin_amdgcn_s_barrier();
    {
        const int tk = tid >> 3, part = tid & 7; unsigned mlo = 0u, mhi = 0u;
        for (int jj = 0; jj < 8; ++jj) { const int j = part * 8 + jj; if (j > jq) break;
            const float sj = (j == 0 || j == jq || j == jq - 1) ? 1e4f : impD[tk * 64 + j] + impC[tk * 68 + j]; int rank = 0;
            for (int i = 0; i <= jq; ++i) { const float si = (i == 0 || i == jq || i == jq - 1) ? 1e4f : impD[tk * 64 + i] + impC[tk * 68 + i]; rank += (i != j && (si > sj || (si == sj && i < j))) ? 1 : 0; }
            if (rank < 16) { if (j < 32) mlo |= 1u << j; else mhi |= 1u << (j - 32); } }
        mlo |= __shfl_xor(mlo, 1); mlo |= __shfl_xor(mlo, 2); mlo |= __shfl_xor(mlo, 4); mhi |= __shfl_xor(mhi, 1); mhi |= __shfl_xor(mhi, 2); mhi |= __shfl_xor(mhi, 4);
        if (part == 0) { const u64 mk = (u64)mlo | ((u64)mhi << 32); selm[tk] = mk; p.sel[((size_t)b * S + 64 * jq + tk) * 2 + g] = mk; }
    }
    NSA_LWAIT(); __builtin_amdgcn_s_barrier();
    const u64 mysel = selm[tokl];
    u64 uni = selm[c.lane];
#pragma unroll
    for (int x = 1; x < 64; x <<= 1) { const unsigned lo_ = __shfl_xor((unsigned)uni, x), hi_ = __shfl_xor((unsigned)(uni >> 32), x); uni |= (u64)lo_ | ((u64)hi_ << 32); }
    const unsigned ulo = __builtin_amdgcn_readfirstlane((unsigned)uni), uhi = __builtin_amdgcn_readfirstlane((unsigned)(uni >> 32));
    {
        c.kt = p.kv6 + 2 * seg + ho; c.vt = p.kv6 + 3 * seg + ho;
        u64 rem = (u64)ulo | ((u64)uhi << 32);
        m = M0; l = 0.f; o[0] = f32x16{}; o[1] = f32x16{};
        int j = __builtin_ctzll(rem); rem &= rem - 1; int it = 0;
        __builtin_amdgcn_s_barrier();
        dma_kv(c, j, 0);
        for (;;) {
            const int jn = rem ? __builtin_ctzll(rem) : -1; rem &= rem - 1;
            NSA_WAIT_BAR(); if (jn >= 0) dma_kv(c, jn, (it + 1) & 1);
            qkt(p0, p1, (lcptr)(c.shm + L_K + (it & 1) * SLOT), qr, c.r32, c.hi);
            const bool on = (mysel >> j) & 1ull;
#pragma unroll
            for (int r = 0; r < 16; ++r) { const int kr = crow(r, c.hi); const bool v0 = on && (j < jq || kr <= tokl), v1 = on && (j < jq || kr + 32 <= tokl);
                p0[r] = v0 ? p0[r] * LOG2E : NEGM; p1[r] = v1 ? p1[r] * LOG2E : NEGM; }
            softmax_pv(c, p0, p1, o, m, l, it & 1);
            if (jn < 0) break; j = jn; ++it;
        }
        l = xhalf_sum(l);
        accum_branch(c, oacc, o, g1 / l);
    }
    {
        c.kt = p.kv6 + 4 * seg + ho; c.vt = p.kv6 + 5 * seg + ho;
        const int j0 = jq >= 8 ? jq - 8 : 0;
        m = M0; l = 0.f; o[0] = f32x16{}; o[1] = f32x16{};
        __builtin_amdgcn_s_barrier();
        dma_kv(c, j0, 0);
        for (int j = j0; j <= jq; ++j) {
            const int it = j - j0;
            NSA_WAIT_BAR(); if (j < jq) dma_kv(c, j + 1, (it + 1) & 1);
            qkt(p0, p1, (lcptr)(c.shm + L_K + (it & 1) * SLOT), qr, c.r32, c.hi);
            const bool lowt = (jq >= 8 && j == jq - 8), diag = (j == jq);
#pragma unroll
            for (int r = 0; r < 16; ++r) { const int kr = crow(r, c.hi);
                const bool v0 = diag ? (kr <= tokl) : (lowt ? (kr > tokl) : true), v1 = diag ? (kr + 32 <= tokl) : (lowt ? (kr + 32 > tokl) : true);
                p0[r] = v0 ? p0[r] * LOG2E : NEGM; p1[r] = v1 ? p1[r] * LOG2E : NEGM; }
            softmax_pv(c, p0, p1, o, m, l, it & 1);
        }
        l = xhalf_sum(l);
        accum_branch(c, oacc, o, g2 / l);
    }
    {
        __attribute__((address_space(3))) bf16* stg = (__attribute__((address_space(3))) bf16*)(c.shm + L_OST + c.w * 4096);
#pragma unroll
        for (int r = 0; r < 16; ++r) { const int orow = crow(r, c.hi);
#pragma unroll
            for (int d0 = 0; d0 < 2; ++d0) stg[orow * 64 + d0 * 32 + c.r32] = f2bf(oacc[d0][r]); }
        NSA_LWAIT();
#pragma unroll
        for (int i = 0; i < 4; ++i) { const int row = i * 8 + (c.lane >> 3), ch = c.lane & 7; const u32x4 v = *(const __attribute__((address_space(3))) u32x4*)(stg + row * 64 + ch * 8);
            const int rh = row >> 3, rt = 8 * c.w + (row & 7);
            *(u32x4*)(p.onsa + ((size_t)b * S + 64 * jq + rt) * 512 + (g * 4 + rh) * 64 + ch * 8) = v; }
    }
    NSA_LWAIT(); __builtin_amdgcn_s_barrier();
}
}
__device__ __forceinline__ void phase_nsa(const P& p, char* smem) {
    const int nunits = p.nb * 2 * 64;
    for (int i = blockIdx.x; i < nunits; i += gridDim.x) { const int jq = 63 - i / (p.nb * 2), bg = i % (p.nb * 2); nsa::nsa_unit(p, smem, bg >> 1, bg & 1, jq); }
}

namespace gla {
using nsa::f32x16; using nsa::bf16x8; using nsa::s16x4; using nsa::u32x4; using nsa::lptr; using nsa::lcptr; using nsa::crow; using nsa::cvtpk;
typedef unsigned u32x2 __attribute__((ext_vector_type(2)));
constexpr int L_KI = 0, L_QI = 8192, L_VI = 16384, L_SI = 32768, L_OST = 49152, L_TOT = L_OST + 64 * 132 * 4, L_END = L_TOT + 8 * 64 * 4 + 64 * 4;
__device__ __forceinline__ int koff(int row, int d) { return (d >> 3) * 1024 + row * 16 + (d & 7) * 2; }
__device__ __forceinline__ int voff(int row, int col) { return ((col >> 5) * 4 + (row >> 4)) * 1024 + (row & 15) * 64 + (col & 31) * 2; }
__device__ __forceinline__ bf16x8 trfrag(unsigned img, int ks, int cb, int lane) {
    const int hi = lane >> 5; const unsigned a = img + (cb * 4 + ks) * 1024 + ((lane >> 4) & 1) * 32 + (lane & 3) * 8 + (4 * hi + ((lane & 15) >> 2)) * 64;
    s16x4 lo, hh;
    asm volatile("ds_read_b64_tr_b16 %0,%1" : "=&v"(lo) : "v"(a) : "memory");
    asm volatile("ds_read_b64_tr_b16 %0,%1 offset:512" : "=&v"(hh) : "v"(a) : "memory");
    asm volatile("s_waitcnt lgkmcnt(0)" ::: "memory"); __builtin_amdgcn_sched_barrier(0);
    return (bf16x8){lo[0], lo[1], lo[2], lo[3], hh[0], hh[1], hh[2], hh[3]};
}
template <int GM> __device__ __forceinline__ void chunk_images(const P& p, lptr shm, int b, int h, int c, int tid) {
    const int d = tid & 63, tg = tid >> 6; const size_t t0 = (size_t)b * S + c * 64;
    __attribute__((address_space(3))) float* tot = (__attribute__((address_space(3))) float*)(shm + L_TOT);
    float wa[16];
#pragma unroll
    for (int r = 0; r < 16; ++r) wa[r] = p.w_a2[r * 256 + h * 64 + d];
    const float ba = p.b_a[h * 64 + d];
    float loc[8]; float run = 0.f;
#pragma unroll
    for (int i = 0; i < 8; ++i) { const float* al = p.alow + (t0 + tg * 8 + i) * 16; float z = ba;
#pragma unroll
        for (int r = 0; r < 16; ++r) z += al[r] * wa[r];
        const float ls = fminf(z, 0.f) - log1pf(__expf(-fabsf(z))); run += ls * (1.f / 16.f); loc[i] = run; }
    tot[tg * 64 + d] = run;
#pragma unroll
    for (int k = 0; k < 2; ++k) { const int idx = tid + k * 512, s = idx >> 4, e = (idx & 15) * 8; *(__attribute__((address_space(3))) u32x4*)(shm + L_VI + voff(s, e)) = *(const u32x4*)(p.gv + (t0 + s) * 512 + h * 128 + e); }
    __syncthreads();
    float pre = 0.f, all = 0.f;
#pragma unroll
    for (int g = 0; g < 8; ++g) { const float x = tot[g * 64 + d]; all += x; pre += g < tg ? x : 0.f; }
#pragma unroll
    for (int i = 0; i < 8; ++i) { const int t = tg * 8 + i; const float bb = pre + loc[i]; const float kk = bf2f(p.gk[(t0 + t) * 256 + h * 64 + d]);
        if (GM == 0) { *(__attribute__((address_space(3))) bf16*)(shm + L_KI + voff(t, d)) = f2bf(kk * __expf(all - bb)); }
        else { const float qq = bf2f(p.gq[(t0 + t) * 256 + h * 64 + d]);
            *(__attribute__((address_space(3))) bf16*)(shm + L_KI + koff(t, d)) = f2bf(kk * __expf(-bb)); *(__attribute__((address_space(3))) bf16*)(shm + L_QI + koff(t, d)) = f2bf(qq * __expf(bb)); } }
    if (GM == 0 && tg == 0) p.gdec[((size_t)(b * 4 + h) * 64 + c) * 64 + d] = __expf(all);
    __syncthreads();
}
__device__ __forceinline__ void g1_chunk(const P& p, char* smem, int b, int h, int c) {
    const int tid = TIDX(), lane = tid & 63, w = __builtin_amdgcn_readfirstlane(tid >> 6), r32 = lane & 31, hi = lane >> 5;
    lptr shm = (lptr)smem; const unsigned l0 = (unsigned)(size_t)shm;
    chunk_images<0>(p, shm, b, h, c, tid);
    const int db = w & 1, eb = w >> 1; f32x16 acc = f32x16{};
#pragma unroll
    for (int ks = 0; ks < 4; ++ks) { const bf16x8 a = trfrag(l0 + L_KI, ks, db, lane), bq = trfrag(l0 + L_VI, ks, eb, lane); acc = __builtin_amdgcn_mfma_f32_32x32x16_bf16(a, bq, acc, 0, 0, 0); }
    float* U = p.gst + ((size_t)(b * 4 + h) * 64 + c) * (64 * 128);
#pragma unroll
    for (int r = 0; r < 16; ++r) U[(32 * db + crow(r, hi)) * 128 + 32 * eb + r32] = acc[r];
    __syncthreads();
}
__device__ __forceinline__ void g3_chunk(const P& p, char* smem, int b, int h, int c) {
    const int tid = TIDX(), lane = tid & 63, w = __builtin_amdgcn_readfirstlane(tid >> 6), r32 = lane & 31, hi = lane >> 5;
    lptr shm = (lptr)smem; const unsigned l0 = (unsigned)(size_t)shm; const size_t t0 = (size_t)b * S + c * 64;
    const float* St = p.gst + ((size_t)(b * 4 + h) * 64 + c) * (64 * 128);
    float4 sv[4];
#pragma unroll
    for (int k = 0; k < 4; ++k) sv[k] = *(const float4*)(St + (size_t)(tid + k * 512) * 4);
    chunk_images<1>(p, shm, b, h, c, tid);
#pragma unroll
    for (int k = 0; k < 4; ++k) { const int idx = (tid + k * 512) * 4, dd = idx >> 7, e = idx & 127; u32x2 o; o.x = cvtpk(sv[k].x, sv[k].y); o.y = cvtpk(sv[k].z, sv[k].w);
        *(__attribute__((address_space(3))) u32x2*)(shm + L_SI + voff(dd, e)) = o; }
    __syncthreads();
    const int tb = w & 1, eb = w >> 1, trow = 32 * tb + r32;
    f32x16 p0 = f32x16{}, p1 = f32x16{}, o = f32x16{};
    {
        lcptr kb = (lcptr)(shm + L_KI) + hi * 1024 + r32 * 16; lcptr qb = (lcptr)(shm + L_QI) + hi * 1024 + trow * 16;
#pragma unroll
        for (int d0 = 0; d0 < 4; ++d0) {
            const bf16x8 b0 = *(const __attribute__((address_space(3))) bf16x8*)(kb + d0 * 2048), b1 = *(const __attribute__((address_space(3))) bf16x8*)(kb + d0 * 2048 + 512);
            const bf16x8 qf = *(const __attribute__((address_space(3))) bf16x8*)(qb + d0 * 2048);
            p0 = __builtin_amdgcn_mfma_f32_32x32x16_bf16(b0, qf, p0, 0, 0, 0); p1 = __builtin_amdgcn_mfma_f32_32x32x16_bf16(b1, qf, p1, 0, 0, 0); }
    }
#pragma unroll
    for (int r = 0; r < 16; ++r) { const int s = crow(r, hi); p0[r] = s <= trow ? p0[r] : 0.f; p1[r] = s + 32 <= trow ? p1[r] : 0.f; }
#pragma unroll
    for (int ds = 0; ds < 4; ++ds) {
        const u32x2 a0 = *(const __attribute__((address_space(3))) u32x2*)(shm + L_QI + (2 * ds) * 1024 + trow * 16 + 8 * hi), a1 = *(const __attribute__((address_space(3))) u32x2*)(shm + L_QI + (2 * ds + 1) * 1024 + trow * 16 + 8 * hi);
        const u32x4 aw = {a0.x, a0.y, a1.x, a1.y};
        const bf16x8 bq = trfrag(l0 + L_SI, ds, eb, lane);
        o = __builtin_amdgcn_mfma_f32_32x32x16_bf16(__builtin_bit_cast(bf16x8, aw), bq, o, 0, 0, 0); }
    {
        const u32x4 w0 = {cvtpk(p0[0], p0[1]), cvtpk(p0[2], p0[3]), cvtpk(p0[4], p0[5]), cvtpk(p0[6], p0[7])}, w1 = {cvtpk(p0[8], p0[9]), cvtpk(p0[10], p0[11]), cvtpk(p0[12], p0[13]), cvtpk(p0[14], p0[15])};
        const u32x4 w2 = {cvtpk(p1[0], p1[1]), cvtpk(p1[2], p1[3]), cvtpk(p1[4], p1[5]), cvtpk(p1[6], p1[7])}, w3 = {cvtpk(p1[8], p1[9]), cvtpk(p1[10], p1[11]), cvtpk(p1[12], p1[13]), cvtpk(p1[14], p1[15])};
        o = __builtin_amdgcn_mfma_f32_32x32x16_bf16(__builtin_bit_cast(bf16x8, w0), trfrag(l0 + L_VI, 0, eb, lane), o, 0, 0, 0);
        o = __builtin_amdgcn_mfma_f32_32x32x16_bf16(__builtin_bit_cast(bf16x8, w1), trfrag(l0 + L_VI, 1, eb, lane), o, 0, 0, 0);
        o = __builtin_amdgcn_mfma_f32_32x32x16_bf16(__builtin_bit_cast(bf16x8, w2), trfrag(l0 + L_VI, 2, eb, lane), o, 0, 0, 0);
        o = __builtin_amdgcn_mfma_f32_32x32x16_bf16(__builtin_bit_cast(bf16x8, w3), trfrag(l0 + L_VI, 3, eb, lane), o, 0, 0, 0);
    }
    __attribute__((address_space(3))) float* ost = (__attribute__((address_space(3))) float*)(shm + L_OST);
#pragma unroll
    for (int r = 0; r < 16; ++r) ost[(32 * tb + crow(r, hi)) * 132 + 32 * eb + r32] = o[r];
    __syncthreads();
    { const int t = tid >> 3, part = tid & 7; float v[16]; float ss = 0.f;
#pragma unroll
        for (int k = 0; k < 4; ++k) { const f32x4_t x = *(const __attribute__((address_space(3))) f32x4_t*)(ost + t * 132 + part * 16 + k * 4); v[4 * k] = x[0]; v[4 * k + 1] = x[1]; v[4 * k + 2] = x[2]; v[4 * k + 3] = x[3]; ss += x[0] * x[0] + x[1] * x[1] + x[2] * x[2] + x[3] * x[3]; }
        ss += __shfl_xor(ss, 1); ss += __shfl_xor(ss, 2); ss += __shfl_xor(ss, 4);
        const float rstd = rsqrtf(ss * (1.f / 128.f) + 1e-6f);
        const size_t go = (t0 + t) * 512 + h * 128 + part * 16;
        const uint4 r0 = *(const uint4*)(p.rs + go), r1 = *(const uint4*)(p.rs + go + 8); const unsigned rw[8] = {r0.x, r0.y, r0.z, r0.w, r1.x, r1.y, r1.z, r1.w};
        unsigned ow[8];
#pragma unroll
        for (int k = 0; k < 8; ++k) { const float ga = p.norm_g[h * 128 + part * 16 + 2 * k], gb = p.norm_g[h * 128 + part * 16 + 2 * k + 1];
            ow[k] = pk2(v[2 * k] * rstd * ga * __uint_as_float(rw[k] << 16), v[2 * k + 1] * rstd * gb * __uint_as_float(rw[k] & 0xffff0000u)); }
        *(uint4*)(p.gla + go) = make_uint4(ow[0], ow[1], ow[2], ow[3]); *(uint4*)(p.gla + go + 8) = make_uint4(ow[4], ow[5], ow[6], ow[7]); }
    __syncthreads();
}
}
__device__ __forceinline__ void phase_gla1(const P& p, char* smem) {
    const int n = p.nb * 4 * 64;
    for (int i = blockIdx.x; i < n; i += gridDim.x) gla::g1_chunk(p, smem, i >> 8, (i >> 6) & 3, i & 63);
}
__device__ __forceinline__ void phase_gla2(const P& p) {
    const int n = p.nb * 4 * 8192;
    for (int idx = blockIdx.x * NT + TIDX(); idx < n; idx += gridDim.x * NT) {
        const int bh = idx >> 13, de = idx & 8191, d = de >> 7; float* U = p.gst + (size_t)bh * 64 * 8192 + de; const float* gd = p.gdec + (size_t)bh * 64 * 64 + d;
        float s = 0.f;
        for (int c0 = 0; c0 < 64; c0 += 8) { float tmp[8], g[8];
#pragma unroll
            for (int k = 0; k < 8; ++k) { tmp[k] = U[(size_t)(c0 + k) * 8192]; g[k] = gd[(c0 + k) * 64]; }
#pragma unroll
            for (int k = 0; k < 8; ++k) { U[(size_t)(c0 + k) * 8192] = s; s = g[k] * s + tmp[k]; } }
    }
}
__device__ __forceinline__ void phase_gla3(const P& p, char* smem) {
    const int n = p.nb * 4 * 64;
    for (int i = blockIdx.x; i < n; i += gridDim.x) gla::g3_chunk(p, smem, i >> 8, (i >> 6) & 3, i & 63);
}

struct CmpSched {
    const char* kc; const char* Wc1; float* Pc; int nM, G, c; size_t aseg, pseg;
    __device__ __forceinline__ bool next(int i, pg8::Unit& u) const {
        const int L = i * G + c, per = nM * 2 * 2; if (L >= 2 * per) return false;
        const int kv = L / per, r = L % per, ks = r & 1, pn = (r >> 1) & 1, pm = r >> 2;
        u.pm = pm; u.pn = pn; u.tag = kv * 2 + ks;
        u.A = kc + (size_t)kv * aseg + (size_t)pm * 256 * 1024 * 2 + ks * 512 * 2; u.B = Wc1 + ((size_t)kv * 512 + pn * 256) * 1024 * 2 + ks * 512 * 2; return true;
    }
    __device__ __forceinline__ unsigned arow(const pg8::Unit&, int r) const { return (unsigned)r * 2048u; }
};
struct EpiCmp {
    static constexpr bool PERM = false;
    float* Pc; size_t pseg;
    __device__ __forceinline__ void operator()(const pg8::f32x4 (&acc)[2][2][4][2], const pg8::Unit& u, int wr, int wc, int fr, int fq) const {
        float* base = Pc + (size_t)u.tag * pseg; const int col0 = u.pn * 256 + wc * 32 + 4 * fq;
#pragma unroll
        for (int ai = 0; ai < 2; ++ai)
#pragma unroll
            for (int m = 0; m < 4; ++m) { float* rowp = base + (size_t)(u.pm * 256 + ai * 128 + wr * 64 + m * 16 + fr) * 512 + col0;
#pragma unroll
                for (int bj = 0; bj < 2; ++bj)
#pragma unroll
                    for (int n = 0; n < 2; ++n) *(pg8::f32x4*)(rowp + bj * 128 + n * 16) = acc[ai][bj][m][n]; }
    }
};
__device__ __forceinline__ void phase_cmp1(const P& p, char* smem) {
    const int nrows = p.nb * 2 * 256;
    CmpSched Sc{(const char*)p.kv6, (const char*)p.Wc1, p.pcmp, nrows / 256, (int)gridDim.x, (int)blockIdx.x, kvseg(p) * 2, (size_t)(nrows + 8) * 512};
    EpiCmp E{p.pcmp, (size_t)(nrows + 8) * 512};
    pg8::gemm_phase<EpiCmp, CmpSched, true, false>((PG8_LAS unsigned char*)smem, 512, 1024, 1024, Sc, E);
}
__device__ __forceinline__ void body_cmp2f(const P& p, int vb, char* smem) {
    const int tid = TIDX(); const int nrows = p.nb * 2 * 256, nvb1 = nrows / 16; const int kv = vb / nvb1, row0 = (vb % nvb1) * 16;
    const size_t pseg = (size_t)(nrows + 8) * 512; const float* P0 = p.pcmp + (size_t)(kv * 2) * pseg; const float* P1 = P0 + pseg;
    float* hs = (float*)smem;
    __syncthreads();
#pragma unroll
    for (int k = 0; k < 8; ++k) { const int idx = tid + k * 512, rr = idx >> 8, n = idx & 255; const size_t m = (size_t)(row0 + rr);
        const float z = P0[m * 512 + n] + P1[m * 512 + n] + P0[(m + 1) * 512 + 256 + n] + P1[(m + 1) * 512 + 256 + n] + p.b1p[kv * 256 + n];
        hs[idx] = geluf_(z); }
    __syncthreads();
    const int rr = tid >> 5, i = tid & 31, row = row0 + rr;
    const float* h = hs + rr * 256; const float* w2 = kv ? p.cw2_v : p.cw2_k; const float* b2 = kv ? p.cb2_v : p.cb2_k;
    float z1 = b2[i], z2 = b2[i + 32];
#pragma unroll 8
    for (int n = 0; n < 256; ++n) { const float hv = h[n]; z1 += hv * w2[n * 64 + i]; z2 += hv * w2[n * 64 + i + 32]; }
    bf16* dst = (kv ? p.vcmp : p.kcmp) + (size_t)row * 64;
    if (kv == 0) {
        const int bg = row >> 8, m = row & 255, b = bg >> 1; int sp = 16 * m + 31; if (sp > S - 1) sp = S - 1;
        const size_t t = (size_t)b * S + sp; const float c = p.cs[t * 64 + i], sn = p.cs[t * 64 + 32 + i];
        const float r1 = z1 * c - z2 * sn, r2 = z2 * c + z1 * sn; z1 = r1; z2 = r2;
    }
    dst[i] = f2bf(z1); dst[i + 32] = f2bf(z2);
}
__device__ __forceinline__ void phase_cmp2(const P& p, char* smem) {
    const int n = 2 * (p.nb * 2 * 256) / 16;
    for (int vb = blockIdx.x; vb < n; vb += gridDim.x) body_cmp2f(p, vb, smem);
}
__device__ __forceinline__ void prep_b1p(const P& p, char* smem) {
    if (blockIdx.x >= 2) return;
    const int tid = TIDX(), kv = blockIdx.x, n = tid & 255, half = tid >> 8;
    const float* pe = kv ? p.cpos_v : p.cpos_k; const float* w1 = kv ? p.cw1_v : p.cw1_k; const float* b1 = kv ? p.cb1_v : p.cb1_k;
    float a = 0.f;
    for (int f = half * 1024; f < half * 1024 + 1024; ++f) a += pe[f] * w1[(size_t)f * 256 + n];
    float* sc = (float*)(smem + LDS_MISC);
    __syncthreads();
    if (half == 1) sc[n] = a;
    __syncthreads();
    if (half == 0) p.b1p[kv * 256 + n] = a + sc[n] + b1[n];
    __syncthreads();
}

template <int ST> __device__ __forceinline__ void run_stage(const P& p, char* smem, int first, int stride) {
    const int nvb = stage_nvb(ST, p.T);
    for (int vb = first; vb < nvb; vb += stride) {
        if constexpr (ST == ST_RMS) body_rms(p, vb);
        else if constexpr (ST == ST_CS) body_cs(p, vb);
        else if constexpr (ST == ST_INPROJ) body_inproj(p, vb, smem);
        else if constexpr (ST == ST_CMP1) body_cmp1(p, vb, smem);
        else if constexpr (ST == ST_CMP2) body_cmp2(p, vb);
        else if constexpr (ST == ST_NSACMP) body_nsacmp(p, vb, smem);
        else if constexpr (ST == ST_NSAATT) body_nsaatt(p, vb);
        else if constexpr (ST == ST_GLAA) body_glaa(p, vb);
        else if constexpr (ST == ST_GLASCAN) body_glascan(p, vb, smem);
        else if constexpr (ST == ST_GLANORM) body_glanorm(p, vb);
        else if constexpr (ST == ST_PROJ) body_proj(p, vb, smem);
        else if constexpr (ST == ST_OUT) body_out(p, vb, smem);
        else if constexpr (ST == ST_ROUTE) body_route(p, vb, smem);
        else if constexpr (ST == ST_MOE1) body_moe1(p, vb, smem);
        else if constexpr (ST == ST_MOE2) body_moe2(p, vb, smem);
        else if constexpr (ST == ST_FINAL) body_final(p, vb, smem);
    }
}
template <int ST> __global__ void __launch_bounds__(NT) k_stage(P p) {
    extern __shared__ __attribute__((aligned(16))) char smem[];
    run_stage<ST>(p, smem, blockIdx.x, gridDim.x);
}
__global__ void __launch_bounds__(NT) k_mega(P p) {
    extern __shared__ __attribute__((aligned(16))) char smem[];
    cg::grid_group grid = cg::this_grid();
    const int b0 = blockIdx.x, G = gridDim.x;
    if (b0 == 0 && TIDX() < NEXP) p.ctl[TIDX()] = 0u;
    phase_prep(p, smem); grid.sync();
#if DUP == 5
    phase_prep(p, smem); grid.sync();
#endif
    phase_inA(p, smem); grid.sync();
    phase_cmp1(p, smem); phase_gla1(p, smem); grid.sync();
#if DUP == 3
    run_stage<ST_CMP1>(p, smem, b0, G); grid.sync();
#elif DUP == 4
    phase_gla1(p, smem); grid.sync();
#endif
    phase_cmp2(p, smem); phase_gla2(p); grid.sync();
    phase_nsa(p, smem); phase_gla3(p, smem); grid.sync();
#if DUP == 1
    phase_nsa(p, smem); grid.sync();
#elif DUP == 2
    phase_gla3(p, smem); grid.sync();
#endif
    phase_inB(p, smem); grid.sync();
    phase_proj(p, smem); grid.sync();
    phase_out(p, smem); grid.sync();
    for (int vb = b0; vb < p.T / 8; vb += G) body_route2(p, vb, smem);
    grid.sync();
    phase_moe1(p, smem); grid.sync();
#if DUP == 6
    phase_moe1(p, smem); grid.sync();
#endif
    phase_moe2(p, smem); grid.sync();
    run_stage<ST_FINAL>(p, smem, b0, G);
}

enum Phase { PH_PREP = 0, PH_INA, PH_INB, PH_PROJ, PH_OUT, PH_MOE1, PH_MOE2, PH_NSA, PH_GLA1, PH_GLA2, PH_GLA3, PH_CMP1, PH_CMP2 };
template <int PH> __global__ void __launch_bounds__(NT) k_phase(P p) {
    extern __shared__ __attribute__((aligned(16))) char smem[];
    if constexpr (PH == PH_PREP) phase_prep(p, smem);
    else if constexpr (PH == PH_INA) phase_inA(p, smem);
    else if constexpr (PH == PH_INB) phase_inB(p, smem);
    else if constexpr (PH == PH_PROJ) phase_proj(p, smem);
    else if constexpr (PH == PH_OUT) phase_out(p, smem);
    else if constexpr (PH == PH_MOE1) phase_moe1(p, smem);
    else if constexpr (PH == PH_MOE2) phase_moe2(p, smem);
    else if constexpr (PH == PH_NSA) phase_nsa(p, smem);
    else if constexpr (PH == PH_GLA1) phase_gla1(p, smem);
    else if constexpr (PH == PH_GLA2) phase_gla2(p);
    else if constexpr (PH == PH_GLA3) phase_gla3(p, smem);
    else if constexpr (PH == PH_CMP1) phase_cmp1(p, smem);
    else if constexpr (PH == PH_CMP2) phase_cmp2(p, smem);
}
template <class TT> __device__ __forceinline__ float ldf(const TT* p, size_t i);
template <> __device__ __forceinline__ float ldf<bf16>(const bf16* p, size_t i) { return bf2f(p[i]); }
template <> __device__ __forceinline__ float ldf<float>(const float* p, size_t i) { return p[i]; }
template <class TT> __global__ void __launch_bounds__(256) k_compare(const TT* a, const TT* b, size_t n, float* err, int slot) {
    float num = 0.f, den = 0.f;
    for (size_t i = (size_t)blockIdx.x * 256 + TIDX(); i < n; i += (size_t)gridDim.x * 256) { const float x = ldf<TT>(a, i), y = ldf<TT>(b, i); const float d = x - y; num += (d == d) ? d * d : 1e30f; den += y * y; }
#pragma unroll
    for (int o = 1; o < 64; o <<= 1) { num += __shfl_xor(num, o); den += __shfl_xor(den, o); }
    if ((TIDX() & 63) == 0) { atomicAdd(err + 2 * slot, num); atomicAdd(err + 2 * slot + 1, den); }
}
__global__ void __launch_bounds__(256) k_compare_sel(const u64* a, const u64* b, size_t n, float* err, int slot) {
    float num = 0.f, den = 0.f;
    for (size_t i = (size_t)blockIdx.x * 256 + threadIdx.x; i < n; i += (size_t)gridDim.x * 256) { num += (a[i] != b[i]) ? 1.f : 0.f; den += 100.f; }
#pragma unroll
    for (int o = 1; o < 64; o <<= 1) { num += __shfl_xor(num, o); den += __shfl_xor(den, o); }
    if ((threadIdx.x & 63) == 0) { atomicAdd(err + 2 * slot, num); atomicAdd(err + 2 * slot + 1, den); }
}
__global__ void __launch_bounds__(256) k_report(float* out, size_t n, const float* err, int nslots, float tol) {
    int code = 0;
    for (int s = 0; s < nslots; ++s) { const float num = err[2 * s], den = err[2 * s + 1]; const bool bad = !(num <= tol * tol * den) || !(den > 0.f); if (bad) { code = s + 1; break; } }
    if (code == 0) return;
    const float f = 1.f + 0.1f * (float)code;
    for (size_t i = (size_t)blockIdx.x * 256 + TIDX(); i < n; i += (size_t)gridDim.x * 256) out[i] *= f;
}

static void set_inputs(P& p, void* const* d_in) {
    const float* const* in = (const float* const*)d_in;
    p.x = in[0]; p.pos = (const int*)d_in[1]; p.g_mix = in[2]; p.w_in = in[3];
    p.cpos_k = in[4]; p.cw1_k = in[5]; p.cb1_k = in[6]; p.cw2_k = in[7]; p.cb2_k = in[8];
    p.cpos_v = in[9]; p.cw1_v = in[10]; p.cb1_v = in[11]; p.cw2_v = in[12]; p.cb2_v = in[13];
    p.w_a2 = in[14]; p.b_a = in[15]; p.norm_g = in[16]; p.w_pn = in[17]; p.w_pg = in[18]; p.w_out = in[19];
    p.g_ffn = in[20]; p.w_grp = in[21]; p.b_grp = in[22]; p.w_exp = in[23]; p.b_exp = in[24]; p.w_gate = in[25]; p.w_up = in[26]; p.w_down = in[27]; p.g_final = in[28];
}
constexpr size_t MiB = 1u << 20;
static void layout_ref(P& p, char* small, char* act, char* scratch, float* out, int nb) {
    const size_t q = (MiB / 4) * nb;
    p.nb = nb; p.T = nb * S; p.out = out;
    p.ctl = (unsigned*)small; p.sel = (u64*)(small + q / 16 * 1); p.kcmp = (bf16*)(small + q / 2); p.vcmp = (bf16*)(small + q / 4 * 3);
    p.tokslot = (int*)(small + q); p.tokexp = (int*)(small + q + q / 8); p.tokw = (float*)(small + q + q / 4);
    p.alow = (float*)(small + 2 * q); p.gates = (float*)(small + 3 * q); p.cs = (float*)(small + 5 * q); p.hcmp = (float*)(small + 9 * q); p.list = (int*)(small + 13 * q);
    p.u = (bf16*)act; p.ocmp = (float*)act; p.mixed = (bf16*)act; p.vb = (bf16*)act;
    p.q = (bf16*)(act + 32 * q); p.kv6 = (bf16*)(act + 48 * q);
    p.gq = (bf16*)(act + 73 * q); p.gk = (bf16*)(act + 81 * q); p.gv = (bf16*)(act + 89 * q); p.rs = (bf16*)(act + 105 * q);
    p.H = (bf16*)(act + 32 * q);
    p.sa = (bf16*)(act + 123 * q); p.sb = (bf16*)(act + 155 * q); p.onsa = (bf16*)(act + 187 * q); p.gla = (bf16*)(act + 203 * q);
    p.Y = (bf16*)(act + 123 * q);
    p.ga = (float*)scratch; p.oraw = (float*)(scratch + 16 * q); p.h1 = (float*)(scratch + 48 * q);
    p.gst = (float*)(scratch + 16 * q); p.gdec = (float*)(small + 15 * q);
}
static void layout_compact(P& p, char* ws, float* out) {
    p.nb = NB; p.T = NB * S; p.out = out;
    char* small = ws; const size_t q = MiB;
    p.ctl = (unsigned*)small; p.sel = (u64*)(small + q / 16 * 1); p.kcmp = (bf16*)(small + q / 2); p.vcmp = (bf16*)(small + q / 4 * 3);
    p.tokslot = (int*)(small + q); p.tokexp = (int*)(small + q + q / 8); p.tokw = (float*)(small + q + q / 4);
    p.alow = (float*)(small + 2 * q); p.gates = (float*)(small + 3 * q); p.cs = (float*)(small + 5 * q); p.hcmp = (float*)(small + 9 * q); p.list = (int*)(small + 13 * q);
    p.u = (bf16*)(ws + 128 * MiB); p.vb = (bf16*)(ws + 128 * MiB);
    p.q = (bf16*)(ws + 160 * MiB); p.kv6 = (bf16*)(ws + 176 * MiB); p.gq = (bf16*)(ws + 201 * MiB); p.gk = (bf16*)(ws + 209 * MiB); p.gv = (bf16*)(ws + 217 * MiB); p.rs = (bf16*)(ws + 233 * MiB);
    p.ga = (float*)(ws + 249 * MiB); p.ocmp = (float*)(ws + 249 * MiB);
    p.sa = (bf16*)(ws + 160 * MiB); p.sb = (bf16*)(ws + 192 * MiB); p.mixed = (bf16*)(ws + 224 * MiB);
    p.H = (bf16*)(ws + 160 * MiB); p.Y = (bf16*)(ws + 48 * MiB);
    p.onsa = (bf16*)out; p.gla = (bf16*)((char*)out + 16 * MiB); p.oraw = (float*)((char*)out + 32 * MiB); p.h1 = out;
    p.gst = (float*)((char*)out + 32 * MiB); p.gdec = (float*)(small + 15 * q); p.pcmp = (float*)(ws + 249 * MiB);
}
static void layout_weights(P& p, char* w) {
    p.wr = (float*)(w - 256 * 1024); p.b1p = (float*)(w - 64 * 1024);
    p.Wd = (bf16*)w; p.Wgu = (bf16*)(w + 32 * MiB); p.Wt_in = (bf16*)(w + 96 * MiB); p.Wc1 = (bf16*)(w + 106 * MiB);
    p.Wpn = (bf16*)(w + 108 * MiB); p.Wpg = (bf16*)(w + 109 * MiB); p.Wo = (bf16*)(w + 110 * MiB);
}

template <int ST> static void launch_stage(const P& p, hipStream_t stream) {
    static bool attr = false;
    if (!attr) { (void)hipFuncSetAttribute((const void*)k_stage<ST>, hipFuncAttributeMaxDynamicSharedMemorySize, LDS_BYTES); attr = true; }
    int nvb = stage_nvb(ST, p.T); if (nvb > 16384) nvb = 16384;
    hipLaunchKernelGGL(k_stage<ST>, dim3(nvb), dim3(NT), LDS_BYTES, stream, p);
}
template <int PH> static void launch_phase(const P& p, hipStream_t stream, int grid = 40) {
    static bool attr = false;
    if (!attr) { (void)hipFuncSetAttribute((const void*)k_phase<PH>, hipFuncAttributeMaxDynamicSharedMemorySize, LDS_BYTES); attr = true; }
    hipLaunchKernelGGL(k_phase<PH>, dim3(grid), dim3(NT), LDS_BYTES, stream, p);
}
template <class TT> static void compare(const TT* a, const TT* b, size_t n, float* err, int slot, hipStream_t stream) {
    hipLaunchKernelGGL(k_compare<TT>, dim3(1024), dim3(256), 0, stream, a, b, n, err, slot);
}
static void launch_mega(const P& p, hipStream_t stream) {
    static int grid = 0;
    if (!grid) {
        int dev = 0, cus = 0, per_cu = 0;
        (void)hipGetDevice(&dev); (void)hipDeviceGetAttribute(&cus, hipDeviceAttributeMultiprocessorCount, dev);
        (void)hipFuncSetAttribute((const void*)k_mega, hipFuncAttributeMaxDynamicSharedMemorySize, LDS_BYTES);
        (void)hipOccupancyMaxActiveBlocksPerMultiprocessor(&per_cu, (const void*)k_mega, NT, LDS_BYTES);
        if (per_cu < 1) per_cu = 1;
        grid = cus * per_cu;
    }
    P pp = p; void* args[] = {(void*)&pp};
    (void)hipLaunchCooperativeKernel((const void*)k_mega, dim3(grid), dim3(NT), args, LDS_BYTES, stream);
}

extern "C" void kernel_launch(void* const* d_in, const int* in_sizes, int n_in, void* d_out, int out_size, void* d_ws, size_t ws_size, hipStream_t stream) {
    char* ws = (char*)d_ws;
    P p{}; set_inputs(p, d_in); layout_ref(p, ws, ws + 16 * MiB, (char*)d_out, (float*)d_out, NB); p.h1 = (float*)d_out;
#if MODE == 0
    (void)hipMemsetAsync(d_ws, 0, 4096, stream);
    launch_stage<ST_RMS>(p, stream); launch_stage<ST_CS>(p, stream); launch_stage<ST_INPROJ>(p, stream);
    launch_stage<ST_CMP1>(p, stream); launch_stage<ST_CMP2>(p, stream); launch_stage<ST_NSACMP>(p, stream); launch_stage<ST_NSAATT>(p, stream);
    launch_stage<ST_GLAA>(p, stream); launch_stage<ST_GLASCAN>(p, stream); launch_stage<ST_GLANORM>(p, stream);
    launch_stage<ST_PROJ>(p, stream); launch_stage<ST_OUT>(p, stream); launch_stage<ST_ROUTE>(p, stream);
    launch_stage<ST_MOE1>(p, stream); launch_stage<ST_MOE2>(p, stream); launch_stage<ST_FINAL>(p, stream);
#elif MODE == 1
    { P c{}; set_inputs(c, d_in); layout_weights(c, ws + 16 * MiB); layout_compact(c, ws, (float*)d_out); launch_mega(c, stream); }
#else
    { P c{}; set_inputs(c, d_in); layout_weights(c, ws + 16 * MiB); layout_compact(c, ws, (float*)d_out); launch_mega(c, stream); }
    P r{}; set_inputs(r, d_in); layout_weights(r, ws + 16 * MiB);
    layout_ref(r, ws + 128 * MiB, ws + 132 * MiB, ws + 200 * MiB, (float*)(ws + 200 * MiB + 12 * MiB), 1);
    char* alt = ws + 228 * MiB; float* err = (float*)(ws + 128 * MiB + 2048);
    (void)hipMemsetAsync(ws + 128 * MiB, 0, 4096, stream);
    int slot = 0; const size_t T1 = S; const size_t ROWS1 = 2 * T1 + NEXP * 256;
    launch_stage<ST_RMS>(r, stream); launch_stage<ST_CS>(r, stream); launch_stage<ST_INPROJ>(r, stream);
    P f = r; { char* a = alt;
        f.u = (bf16*)a; a += T1 * 1024 * 2; f.cs = (float*)a; a += T1 * 64 * 4; f.q = (bf16*)a; a += T1 * 512 * 2; f.kv6 = (bf16*)a; a += 6 * (size_t)2 * S * 64 * 2 + 4096;
        f.gates = (float*)a; a += T1 * 24 * 4; f.gq = (bf16*)a; a += T1 * 256 * 2; f.gk = (bf16*)a; a += T1 * 256 * 2; f.gv = (bf16*)a; a += T1 * 512 * 2; f.alow = (float*)a; a += T1 * 16 * 4;
        f.rs = (bf16*)a; a += T1 * 512 * 2; f.sa = (bf16*)a; a += T1 * 1024 * 2; f.sb = (bf16*)a; a += T1 * 1024 * 2; }
    launch_phase<PH_PREP>(f, stream); launch_phase<PH_INA>(f, stream); launch_phase<PH_INB>(f, stream);
    compare<bf16>(f.q, r.q, T1 * 512, err, slot++, stream);
    compare<bf16>(f.kv6, r.kv6, 6 * (size_t)2 * S * 64, err, slot++, stream);
    compare<bf16>(f.sb, r.sb, T1 * 1024, err, slot++, stream);
    launch_stage<ST_CMP1>(r, stream); launch_stage<ST_CMP2>(r, stream);
    f = r; f.pcmp = (float*)alt; f.kcmp = (bf16*)(alt + 20 * MiB); f.vcmp = (bf16*)(alt + 21 * MiB); launch_phase<PH_CMP1>(f, stream); launch_phase<PH_CMP2>(f, stream);
    compare<bf16>(f.kcmp, r.kcmp, (size_t)2 * 255 * 64, err, slot++, stream); compare<bf16>(f.vcmp + 256 * 64, r.vcmp + 256 * 64, (size_t)255 * 64, err, slot++, stream);
    launch_stage<ST_NSACMP>(r, stream); launch_stage<ST_NSAATT>(r, stream);
    f = r; f.onsa = (bf16*)alt; f.sel = (u64*)(alt + 8 * MiB); launch_phase<PH_NSA>(f, stream);
    hipLaunchKernelGGL(k_compare_sel, dim3(64), dim3(256), 0, stream, (const u64*)f.sel, (const u64*)r.sel, T1 * 2, err, slot++);
    compare<bf16>(f.onsa, r.onsa, T1 * 512, err, slot++, stream);
    launch_stage<ST_GLAA>(r, stream); launch_stage<ST_GLASCAN>(r, stream); launch_stage<ST_GLANORM>(r, stream);
    f = r; f.gla = (bf16*)alt; f.gst = (float*)(alt + 8 * MiB); f.gdec = (float*)(alt + 18 * MiB); launch_phase<PH_GLA1>(f, stream); launch_phase<PH_GLA2>(f, stream); launch_phase<PH_GLA3>(f, stream);
    compare<bf16>(f.gla, r.gla, T1 * 512, err, slot++, stream);
    launch_stage<ST_PROJ>(r, stream);
    f = r; f.mixed = (bf16*)alt; launch_phase<PH_PROJ>(f, stream);
    compare<bf16>(f.mixed, r.mixed, T1 * 1024, err, slot++, stream);
    launch_stage<ST_OUT>(r, stream);
    f = r; f.h1 = (float*)alt; launch_phase<PH_OUT>(f, stream);
    compare<float>(f.h1, r.h1, T1 * 1024, err, slot++, stream);
    launch_stage<ST_ROUTE>(r, stream);
    (void)hipMemsetAsync(r.H, 0, ROWS1 * 512 * 2, stream); (void)hipMemsetAsync(alt, 0, ROWS1 * 512 * 2, stream);
    launch_stage<ST_MOE1>(r, stream);
    f = r; f.H = (bf16*)alt; launch_phase<PH_MOE1>(f, stream);
    compare<bf16>(f.H, r.H, ROWS1 * 512, err, slot++, stream);
    (void)hipMemsetAsync(r.Y, 0, ROWS1 * 1024 * 2, stream); (void)hipMemsetAsync(alt + 17 * MiB, 0, ROWS1 * 1024 * 2, stream);
    launch_stage<ST_MOE2>(r, stream);
    f = r; f.Y = (bf16*)(alt + 17 * MiB); launch_phase<PH_MOE2>(f, stream);
    compare<bf16>(f.Y, r.Y, ROWS1 * 1024, err, slot++, stream);
    hipLaunchKernelGGL(k_report, dim3(1024), dim3(256), 0, stream, (float*)d_out, (size_t)NB * S * D, (const float*)err, slot, 0.02f);
#endif
}
```

```cpp
#include <hip/hip_runtime.h>
#include <hip/hip_cooperative_groups.h>
#include <stdint.h>
namespace cg = cooperative_groups;

#ifndef DUP
#define DUP 0
#endif
#ifndef MODE
#define MODE 1
#endif

typedef unsigned short bf16;
typedef unsigned long long u64;

__device__ __forceinline__ int TIDX() { int t = threadIdx.x; asm volatile("" : "+v"(t)); return t; }
__device__ __forceinline__ float bf2f(bf16 v) { return __uint_as_float(((unsigned)v) << 16); }
__device__ __forceinline__ bf16 f2bf(float f) { unsigned u = __float_as_uint(f); return (bf16)((u + 0x7fffu + ((u >> 16) & 1u)) >> 16); }
__device__ __forceinline__ float sigmoidf_(float x) { return 1.f / (1.f + __expf(-x)); }
__device__ __forceinline__ float siluf_(float x) { return x / (1.f + __expf(-x)); }
__device__ __forceinline__ float geluf_(float x) { const float u = 0.7978845608028654f * (x + 0.044715f * x * x * x); return 0.5f * x * (1.f + tanhf(u)); }

constexpr int NB = 4, S = 4096, D = 1024;
constexpr int NT = 512;
constexpr int LDS_BYTES = 144 * 1024;
constexpr int LDS_MISC = 136 * 1024;
constexpr int INW = 4904;
constexpr int OFF_Q = 0, OFF_KV = 512, OFF_NG = 1280, OFF_GQ = 1304, OFF_GK = 1560, OFF_GV = 1816, OFF_GA = 2328, OFF_GR = 2344, OFF_MA = 2856, OFF_MB = 3880;
constexpr int NEXP = 32;

struct P {
    const float* x; const int* pos; const float* g_mix; const float* w_in;
    const float *cpos_k, *cw1_k, *cb1_k, *cw2_k, *cb2_k, *cpos_v, *cw1_v, *cb1_v, *cw2_v, *cb2_v;
    const float *w_a2, *b_a, *norm_g, *w_pn, *w_pg, *w_out, *g_ffn, *w_grp, *b_grp, *w_exp, *b_exp, *w_gate, *w_up, *w_down, *g_final;
    float* out;
    unsigned* ctl;
    float* cs;
    bf16* u;
    bf16* q;
    bf16* kv6;
    float* gates;
    bf16 *gq, *gk, *gv;
    float* alow;
    bf16 *rs, *sa, *sb;
    float* hcmp;
    bf16 *kcmp, *vcmp;
    u64* sel;
    float* ocmp;
    bf16* onsa;
    float* ga;
    float* oraw;
    bf16* gla;
    bf16* mixed;
    float* h1;
    bf16* vb;
    int* list;
    int* tokslot;
    int* tokexp;
    float* tokw;
    bf16* H;
    bf16* Y;
    float* gst;
    float* gdec;
    float* pcmp;
    float* b1p;
    float* wr;
    bf16 *Wt_in, *Wc1, *Wpn, *Wpg, *Wo, *Wgu, *Wd;
    int nb, T;
};
__device__ __forceinline__ size_t kvseg(const P& p) { return (size_t)p.nb * 2 * S * 64; }

enum Stage { ST_RMS = 0, ST_CS, ST_INPROJ, ST_CMP1, ST_CMP2, ST_NSACMP, ST_NSAATT, ST_GLAA, ST_GLASCAN, ST_GLANORM, ST_PROJ, ST_OUT, ST_ROUTE, ST_MOE1, ST_MOE2, ST_FINAL, ST_COUNT };

__host__ __device__ inline int stage_nvb(int st, int T) {
    switch (st) {
        case ST_RMS: return T / 8;
        case ST_CS: return T * 32 / NT;
        case ST_INPROJ: return ((INW + NT - 1) / NT) * (T / 8);
        case ST_CMP1: return 2 * (T / S) * 2 * 256 / 8;
        case ST_CMP2: return 2 * (T / S) * 2 * 256 * 32 / NT;
        case ST_NSACMP: return T / 64 * 2 / 8;
        case ST_NSAATT: return T / 64 * 8 / 8;
        case ST_GLAA: return T / 2;
        case ST_GLASCAN: return (T / S) * 4 / 4;
        case ST_GLANORM: return T * 4 / NT;
        case ST_PROJ: return 2 * (T / 8);
        case ST_OUT: return 2 * (T / 8);
        case ST_ROUTE: return T / 8;
        case ST_MOE1: return (2 * T + NEXP * 256) / 8;
        case ST_MOE2: return 2 * ((2 * T + NEXP * 256) / 8);
        case ST_FINAL: return T / 8;
    }
    return 0;
}

__device__ __forceinline__ void body_rms(const P& p, int vb) {
    const int lane = TIDX() & 63, t = vb * 8 + (TIDX() >> 6);
    const float4* xr = (const float4*)(p.x + (size_t)t * D);
    float4 v[4]; float ss = 0.f;
#pragma unroll
    for (int j = 0; j < 4; ++j) { v[j] = xr[lane + 64 * j]; ss += v[j].x * v[j].x + v[j].y * v[j].y + v[j].z * v[j].z + v[j].w * v[j].w; }
#pragma unroll
    for (int o = 1; o < 64; o <<= 1) ss += __shfl_xor(ss, o);
    const float rstd = rsqrtf(ss * (1.f / D) + 1e-6f);
#pragma unroll
    for (int j = 0; j < 4; ++j) {
        const float4 g = ((const float4*)p.g_mix)[lane + 64 * j];
        ushort4 o; o.x = f2bf(v[j].x * rstd * g.x); o.y = f2bf(v[j].y * rstd * g.y); o.z = f2bf(v[j].z * rstd * g.z); o.w = f2bf(v[j].w * rstd * g.w);
        ((ushort4*)(p.u + (size_t)t * D))[lane + 64 * j] = o;
    }
}
__device__ __forceinline__ void body_cs(const P& p, int vb) {
    const int idx = vb * NT + TIDX(); const int t = idx >> 5, i = idx & 31;
    const float inv = 1.0f / powf(10000.0f, (float)i / 32.0f);
    const float ang = (float)p.pos[t] * inv;
    const double a = (double)ang; const double k = rint(a * 0.15915494309189535); const float r = (float)(a - k * 6.283185307179586);
    p.cs[(size_t)t * 64 + i] = cosf(r); p.cs[(size_t)t * 64 + 32 + i] = sinf(r);
}

template <int K, bool TWO, bool SAMEA, class AF1, class AF2, class Epi>
__device__ __forceinline__ void ngemm(float* lds, int m0, const float* W1, int ldw1, int n1, const float* W2, int ldw2, int n2, AF1 a1, AF2 a2, Epi epi) {
    const int tid = TIDX();
    for (int idx = tid; idx < 8 * K; idx += NT) { const int i = idx / K, k = idx % K; lds[idx] = a1(m0 + i, k); if (TWO && !SAMEA) lds[8 * K + idx] = a2(m0 + i, k); }
    __syncthreads();
    float acc1[8], acc2[8];
#pragma unroll
    for (int i = 0; i < 8; ++i) { acc1[i] = 0.f; acc2[i] = 0.f; }
    const float* w1 = W1 + n1; const float* w2 = TWO ? (W2 + n2) : w1;
    const float* l2 = (TWO && !SAMEA) ? lds + 8 * K : lds;
    for (int k = 0; k < K; k += 4) {
        float a[4], b[4];
#pragma unroll
        for (int kk = 0; kk < 4; ++kk) { a[kk] = w1[(size_t)(k + kk) * ldw1]; b[kk] = TWO ? w2[(size_t)(k + kk) * ldw2] : 0.f; }
#pragma unroll
        for (int i = 0; i < 8; ++i) {
            const float4 x1 = *(const float4*)(lds + i * K + k);
            acc1[i] += x1.x * a[0] + x1.y * a[1] + x1.z * a[2] + x1.w * a[3];
            if (TWO) { const float4 x2 = *(const float4*)(l2 + i * K + k); acc2[i] += x2.x * b[0] + x2.y * b[1] + x2.z * b[2] + x2.w * b[3]; }
        }
    }
#pragma unroll
    for (int i = 0; i < 8; ++i) epi(m0 + i, acc1[i], acc2[i]);
    __syncthreads();
}

__device__ __forceinline__ void store_z(const P& p, int t, int j, float z, float zp) {
    const int b = t / S, s = t % S;
    if (j < OFF_KV) {
        const int d = j & 63, i = d & 31; const float c = p.cs[(size_t)t * 64 + i], sn = p.cs[(size_t)t * 64 + 32 + i];
        const float r = (d < 32) ? (z * c - zp * sn) : (z * c + zp * sn);
        p.q[(size_t)t * 512 + j] = f2bf(r * 0.125f);
    } else if (j < OFF_NG) {
        const int seg = (j - OFF_KV) >> 7, cc = (j - OFF_KV) & 127, g = cc >> 6, d = cc & 63; float r = z;
        if (seg == 2 || seg == 4) { const int i = d & 31; const float c = p.cs[(size_t)t * 64 + i], sn = p.cs[(size_t)t * 64 + 32 + i]; r = (d < 32) ? (z * c - zp * sn) : (z * c + zp * sn); }
        p.kv6[(size_t)seg * kvseg(p) + ((size_t)(b * 2 + g) * S + s) * 64 + d] = f2bf(r);
    } else if (j < OFF_GQ) { p.gates[(size_t)t * 24 + (j - OFF_NG)] = sigmoidf_(z);
    } else if (j < OFF_GK) { p.gq[(size_t)t * 256 + (j - OFF_GQ)] = f2bf(z * 0.125f);
    } else if (j < OFF_GV) { p.gk[(size_t)t * 256 + (j - OFF_GK)] = f2bf(z);
    } else if (j < OFF_GA) { p.gv[(size_t)t * 512 + (j - OFF_GV)] = f2bf(z);
    } else if (j < OFF_GR) { p.alow[(size_t)t * 16 + (j - OFF_GA)] = z;
    } else if (j < OFF_MA) { p.rs[(size_t)t * 512 + (j - OFF_GR)] = f2bf(siluf_(z));
    } else if (j < OFF_MB) { p.sa[(size_t)t * 1024 + (j - OFF_MA)] = f2bf(sigmoidf_(z));
    } else { p.sb[(size_t)t * 1024 + (j - OFF_MB)] = f2bf(sigmoidf_(z)); }
}
__device__ __forceinline__ int rope_partner(int j) {
    int base;
    if (j < OFF_KV) base = 0; else if (j >= 768 && j < 896) base = 768; else if (j >= 1024 && j < 1152) base = 1024; else return -1;
    const int d = (j - base) & 63; return d < 32 ? j + 32 : j - 32;
}
__device__ __forceinline__ void body_inproj(const P& p, int vb, char* smem) {
    constexpr int NCB = (INW + NT - 1) / NT;
    const int bx = vb % NCB, by = vb / NCB;
    const int jr = bx * NT + TIDX(); const bool jv = jr < INW; const int j = jv ? jr : INW - 1;
    int jp = rope_partner(j); if (jp < 0) jp = j;
    ngemm<1024, true, true>((float*)smem, by * 8, p.w_in, INW, j, p.w_in, INW, jp,
        [&](int m, int k) { return bf2f(p.u[(size_t)m * D + k]); }, [&](int m, int k) { return 0.f; },
        [&](int m, float z, float zp) { if (jv) store_z(p, m, j, z, zp); });
}

__device__ __forceinline__ void body_cmp1(const P& p, int vb, char* smem) {
    const int nrows = p.nb * 2 * 256, ng = nrows / 8;
    const int kv = vb / ng, m0 = (vb % ng) * 8; const int n = TIDX() & 255; const bool act = TIDX() < 256;
    const bf16* src = p.kv6 + (size_t)kv * kvseg(p);
    const float* pe = kv ? p.cpos_v : p.cpos_k; const float* w1 = kv ? p.cw1_v : p.cw1_k; const float* b1 = kv ? p.cb1_v : p.cb1_k;
    float* dst = p.hcmp + (size_t)kv * nrows * 256;
    ngemm<2048, false, true>((float*)smem, m0, w1, 256, n, w1, 256, n,
        [&](int m, int k) { return bf2f(src[(size_t)m * 1024 + k]) + pe[k]; }, [&](int m, int k) { return 0.f; },
        [&](int m, float z, float) { if (act) dst[(size_t)m * 256 + n] = geluf_(z + b1[n]); });
}
__device__ __forceinline__ void body_cmp2(const P& p, int vb) {
    const int nrows = p.nb * 2 * 256;
    const int idx = vb * NT + TIDX();
    const int i = idx & 31, row = (idx >> 5) % nrows, kv = (idx >> 5) / nrows;
    const float* h = p.hcmp + ((size_t)kv * nrows + row) * 256; const float* w2 = kv ? p.cw2_v : p.cw2_k; const float* b2 = kv ? p.cb2_v : p.cb2_k;
    float z1 = b2[i], z2 = b2[i + 32];
    for (int n = 0; n < 256; ++n) { const float hv = h[n]; z1 += hv * w2[n * 64 + i]; z2 += hv * w2[n * 64 + i + 32]; }
    bf16* dst = (kv ? p.vcmp : p.kcmp) + (size_t)row * 64;
    if (kv == 0) {
        const int bg = row >> 8, m = row & 255, b = bg >> 1; int sp = 16 * m + 31; if (sp > S - 1) sp = S - 1;
        const size_t t = (size_t)b * S + sp; const float c = p.cs[t * 64 + i], sn = p.cs[t * 64 + 32 + i];
        const float r1 = z1 * c - z2 * sn, r2 = z2 * c + z1 * sn; z1 = r1; z2 = r2;
    }
    dst[i] = f2bf(z1); dst[i + 32] = f2bf(z2);
}

__device__ __forceinline__ void load_row64(const bf16* r, float* f) {
    const uint4* p4 = (const uint4*)r;
#pragma unroll
    for (int c = 0; c < 8; ++c) { const uint4 v = p4[c]; const unsigned w[4] = {v.x, v.y, v.z, v.w};
#pragma unroll
        for (int e = 0; e < 4; ++e) { f[c * 8 + e * 2] = __uint_as_float(w[e] << 16); f[c * 8 + e * 2 + 1] = __uint_as_float(w[e] & 0xffff0000u); } }
}
__device__ __forceinline__ float dot64(const float* a, const bf16* r) {
    const uint4* p4 = (const uint4*)r; float s = 0.f;
#pragma unroll
    for (int c = 0; c < 8; ++c) { const uint4 v = p4[c]; const unsigned w[4] = {v.x, v.y, v.z, v.w};
#pragma unroll
        for (int e = 0; e < 4; ++e) { s += a[c * 8 + e * 2] * __uint_as_float(w[e] << 16); s += a[c * 8 + e * 2 + 1] * __uint_as_float(w[e] & 0xffff0000u); } }
    return s;
}
__device__ __forceinline__ void axpy64(float* o, float a, const bf16* r) {
    const uint4* p4 = (const uint4*)r;
#pragma unroll
    for (int c = 0; c < 8; ++c) { const uint4 v = p4[c]; const unsigned w[4] = {v.x, v.y, v.z, v.w};
#pragma unroll
        for (int e = 0; e < 4; ++e) { o[c * 8 + e * 2] += a * __uint_as_float(w[e] << 16); o[c * 8 + e * 2 + 1] += a * __uint_as_float(w[e] & 0xffff0000u); } }
}
__device__ __forceinline__ void body_nsacmp(const P& p, int vb, char* smem) {
    const int wave = TIDX() >> 6, lane = TIDX() & 63, item = vb * 8 + wave;
    const int g = item & 1, t = (item >> 1) * 64 + lane;
    const int b = t / S, s = t % S; const int nv = s >= 31 ? (s - 31) / 16 + 1 : 0;
    float* my = (float*)smem + (size_t)wave * (64 * 65) + lane * 65;
    for (int j = 0; j < 64; ++j) my[j] = 0.f;
    const bf16* kc = p.kcmp + (size_t)(b * 2 + g) * 256 * 64; const bf16* vc = p.vcmp + (size_t)(b * 2 + g) * 256 * 64;
    for (int hh = 0; hh < 4; ++hh) {
        const int h = g * 4 + hh; float qv[64], o[64];
        load_row64(p.q + (size_t)t * 512 + h * 64, qv);
#pragma unroll
        for (int d = 0; d < 64; ++d) o[d] = 0.f;
        float m = -1e30f, l = 0.f;
        for (int n = 0; n < nv; ++n) { const float sc = dot64(qv, kc + n * 64); const float mn = fmaxf(m, sc); l = l * __expf(m - mn) + __expf(sc - mn); m = mn; }
        const float il = nv > 0 ? 1.f / l : 0.f;
        for (int n = 0; n < nv; ++n) {
            const float sc = dot64(qv, kc + n * 64); const float pn = __expf(sc - m) * il;
            axpy64(o, pn, vc + n * 64);
            const int j0 = n >> 2; if ((n & 3) != 3) my[j0] += pn; else { my[j0] += 0.5f * pn; my[j0 + 1] += 0.5f * pn; }
        }
#pragma unroll
        for (int d = 0; d < 64; ++d) p.ocmp[(size_t)t * 512 + h * 64 + d] = o[d];
    }
    const int cur = s >> 6; u64 mask = 0ull;
    for (int j = 0; j <= cur; ++j) {
        const float sj = (j == 0 || j == cur || j == cur - 1) ? 1e4f : my[j]; int rank = 0;
        for (int i = 0; i <= cur; ++i) { if (i == j) continue; const float si = (i == 0 || i == cur || i == cur - 1) ? 1e4f : my[i]; if (si > sj || (si == sj && i < j)) ++rank; }
        if (rank < 16) mask |= (1ull << j);
    }
    p.sel[(size_t)t * 2 + g] = mask;
}
__device__ __forceinline__ void body_nsaatt(const P& p, int vb) {
    const int wave = TIDX() >> 6, lane = TIDX() & 63, item = vb * 8 + wave;
    const int h = item & 7, t = (item >> 3) * 64 + lane, g = h >> 2;
    const int b = t / S, s = t % S, cur = s >> 6;
    const size_t seg = kvseg(p), ho = (size_t)(b * 2 + g) * S * 64;
    const bf16* ks = p.kv6 + 2 * seg + ho; const bf16* vs = p.kv6 + 3 * seg + ho; const bf16* kw = p.kv6 + 4 * seg + ho; const bf16* vw = p.kv6 + 5 * seg + ho;
    float qv[64], o[64];
    load_row64(p.q + (size_t)t * 512 + h * 64, qv);
    const float g0 = p.gates[(size_t)t * 24 + h * 3], g1 = p.gates[(size_t)t * 24 + h * 3 + 1], g2 = p.gates[(size_t)t * 24 + h * 3 + 2];
    float* accp = p.ocmp + (size_t)t * 512 + h * 64;
#pragma unroll
    for (int d = 0; d < 64; ++d) o[d] = 0.f;
    const u64 mask = p.sel[(size_t)t * 2 + g];
    float m = -1e30f, l = 0.f;
    for (int j = 0; j <= cur; ++j) {
        if (!((mask >> j) & 1ull)) continue;
        for (int kk = 0; kk < 64; ++kk) {
            const int key = j * 64 + kk; if (key > s) break;
            const float sc = dot64(qv, ks + (size_t)key * 64);
            if (sc > m) { const float f = __expf(m - sc); l *= f;
#pragma unroll
                for (int d = 0; d < 64; ++d) o[d] *= f;
                m = sc; }
            const float pe = __expf(sc - m); l += pe; axpy64(o, pe, vs + (size_t)key * 64);
        }
    }
    { const float f = g1 / l;
#pragma unroll
        for (int d = 0; d < 64; ++d) { accp[d] = g0 * accp[d] + f * o[d]; o[d] = 0.f; } }
    m = -1e30f; l = 0.f;
    for (int key = (s >= 511 ? s - 511 : 0); key <= s; ++key) {
        const float sc = dot64(qv, kw + (size_t)key * 64);
        if (sc > m) { const float f = __expf(m - sc); l *= f;
#pragma unroll
            for (int d = 0; d < 64; ++d) o[d] *= f;
            m = sc; }
        const float pe = __expf(sc - m); l += pe; axpy64(o, pe, vw + (size_t)key * 64);
    }
    { const float f = g2 / l;
#pragma unroll
        for (int d = 0; d < 64; ++d) p.onsa[(size_t)t * 512 + h * 64 + d] = f2bf(accp[d] + f * o[d]); }
}

__device__ __forceinline__ void body_glaa(const P& p, int vb) {
    const int c = TIDX() & 255, t = vb * 2 + (TIDX() >> 8); float z = p.b_a[c];
#pragma unroll
    for (int r = 0; r < 16; ++r) z += p.alow[(size_t)t * 16 + r] * p.w_a2[r * 256 + c];
    const float ls = fminf(z, 0.f) - log1pf(__expf(-fabsf(z)));
    p.ga[(size_t)t * 256 + c] = __expf(ls * (1.f / 16.f));
}
__device__ __forceinline__ void body_glascan(const P& p, int vb, char* smem) {
    const int sub = TIDX() >> 7, e = TIDX() & 127, bh = vb * 4 + sub, b = bh >> 2, h = bh & 3;
    float* sq = (float*)smem + sub * (3 * 32 * 64); float* sk = sq + 32 * 64; float* sg = sk + 32 * 64;
    float St[64];
#pragma unroll
    for (int d = 0; d < 64; ++d) St[d] = 0.f;
    for (int s0 = 0; s0 < S; s0 += 32) {
        __syncthreads();
        for (int i = e; i < 32 * 64; i += 128) { const int ss = i >> 6, d = i & 63; const size_t t = (size_t)b * S + s0 + ss;
            sq[i] = bf2f(p.gq[t * 256 + h * 64 + d]); sk[i] = bf2f(p.gk[t * 256 + h * 64 + d]); sg[i] = p.ga[t * 256 + h * 64 + d]; }
        __syncthreads();
        for (int ss = 0; ss < 32; ++ss) {
            const size_t t = (size_t)b * S + s0 + ss; const float v = bf2f(p.gv[t * 512 + h * 128 + e]); float o = 0.f;
#pragma unroll
            for (int d = 0; d < 64; ++d) { St[d] = sg[ss * 64 + d] * St[d] + sk[ss * 64 + d] * v; o += sq[ss * 64 + d] * St[d]; }
            p.oraw[t * 512 + h * 128 + e] = o;
        }
    }
    __syncthreads();
}
__device__ __forceinline__ void body_glanorm(const P& p, int vb) {
    const int idx = vb * NT + TIDX(); const int t = idx >> 2, h = idx & 3;
    const float* o = p.oraw + (size_t)t * 512 + h * 128; float ss = 0.f;
    for (int e = 0; e < 128; ++e) ss += o[e] * o[e];
    const float r = rsqrtf(ss * (1.f / 128.f) + 1e-6f);
    for (int e = 0; e < 128; ++e) p.gla[(size_t)t * 512 + h * 128 + e] = f2bf(o[e] * r * p.norm_g[h * 128 + e] * bf2f(p.rs[(size_t)t * 512 + h * 128 + e]));
}

__device__ __forceinline__ void body_proj(const P& p, int vb, char* smem) {
    const int n = (vb & 1) * NT + TIDX(), m0 = (vb >> 1) * 8;
    ngemm<512, true, false>((float*)smem, m0, p.w_pn, 1024, n, p.w_pg, 1024, n,
        [&](int m, int k) { return bf2f(p.onsa[(size_t)m * 512 + k]); }, [&](int m, int k) { return bf2f(p.gla[(size_t)m * 512 + k]); },
        [&](int m, float ya, float yb) { p.mixed[(size_t)m * 1024 + n] = f2bf(bf2f(p.sa[(size_t)m * 1024 + n]) * ya + bf2f(p.sb[(size_t)m * 1024 + n]) * yb); });
}
__device__ __forceinline__ void body_out(const P& p, int vb, char* smem) {
    const int n = (vb & 1) * NT + TIDX(), m0 = (vb >> 1) * 8;
    ngemm<1024, false, true>((float*)smem, m0, p.w_out, 1024, n, p.w_out, 1024, n,
        [&](int m, int k) { return bf2f(p.mixed[(size_t)m * 1024 + k]); }, [&](int m, int k) { return 0.f; },
        [&](int m, float z, float) { p.h1[(size_t)m * 1024 + n] = p.x[(size_t)m * 1024 + n] + z; });
}

__device__ __forceinline__ void body_route(const P& p, int vb, char* smem) {
    const int wave = TIDX() >> 6, lane = TIDX() & 63, t = vb * 8 + wave;
    const float4* hr = (const float4*)(p.h1 + (size_t)t * D);
    float v[16]; float ss = 0.f;
#pragma unroll
    for (int j = 0; j < 4; ++j) { const float4 a = hr[lane + 64 * j]; v[4 * j] = a.x; v[4 * j + 1] = a.y; v[4 * j + 2] = a.z; v[4 * j + 3] = a.w; ss += a.x * a.x + a.y * a.y + a.z * a.z + a.w * a.w; }
#pragma unroll
    for (int o = 1; o < 64; o <<= 1) ss += __shfl_xor(ss, o);
    const float rstd = rsqrtf(ss * (1.f / D) + 1e-6f);
#pragma unroll
    for (int j = 0; j < 4; ++j) {
        const float4 g = ((const float4*)p.g_ffn)[lane + 64 * j];
        v[4 * j] *= rstd * g.x; v[4 * j + 1] *= rstd * g.y; v[4 * j + 2] *= rstd * g.z; v[4 * j + 3] *= rstd * g.w;
        ushort4 o; o.x = f2bf(v[4 * j]); o.y = f2bf(v[4 * j + 1]); o.z = f2bf(v[4 * j + 2]); o.w = f2bf(v[4 * j + 3]);
        ((ushort4*)(p.vb + (size_t)t * D))[lane + 64 * j] = o;
    }
    float* sl = (float*)(smem + LDS_MISC) + wave * 40;
    for (int o = 0; o < 4; ++o) { float a = 0.f;
#pragma unroll
        for (int j = 0; j < 4; ++j)
#pragma unroll
            for (int e = 0; e < 4; ++e) a += v[4 * j + e] * p.w_grp[(size_t)(4 * (lane + 64 * j) + e) * 4 + o];
#pragma unroll
        for (int x = 1; x < 64; x <<= 1) a += __shfl_xor(a, x);
        if (lane == 0) sl[o] = a + p.b_grp[o]; }
    for (int o = 0; o < 32; ++o) { float a = 0.f;
#pragma unroll
        for (int j = 0; j < 4; ++j)
#pragma unroll
            for (int e = 0; e < 4; ++e) a += v[4 * j + e] * p.w_exp[(size_t)(4 * (lane + 64 * j) + e) * 32 + o];
#pragma unroll
        for (int x = 1; x < 64; x <<= 1) a += __shfl_xor(a, x);
        if (lane == 0) sl[4 + o] = a + p.b_exp[o]; }
    if (lane == 0) {
        int gs = 0; float gm = sl[0];
        for (int o = 1; o < 4; ++o) if (sl[o] > gm) { gm = sl[o]; gs = o; }
        float gsum = 0.f;
        for (int o = 0; o < 4; ++o) gsum += __expf(sl[o] - gm);
        const float pg = 1.f / gsum;
        const float* li = sl + 4 + gs * 8;
        int e0 = 0; float m0 = li[0];
        for (int e = 1; e < 8; ++e) if (li[e] > m0) { m0 = li[e]; e0 = e; }
        int e1 = -1; float m1 = -3e38f;
        for (int e = 0; e < 8; ++e) if (e != e0 && li[e] > m1) { m1 = li[e]; e1 = e; }
        const float p0 = 1.f, p1 = __expf(m1 - m0);
        const float w0 = pg * p0 / (p0 + p1), w1 = pg * p1 / (p0 + p1);
        const int x0 = gs * 8 + e0, x1 = gs * 8 + e1;
        const int s0 = (int)atomicAdd(&p.ctl[x0 * 32], 1u), s1 = (int)atomicAdd(&p.ctl[x1 * 32], 1u);
        p.list[(size_t)x0 * p.T + s0] = t; p.list[(size_t)x1 * p.T + s1] = t;
        p.tokexp[t * 2] = x0; p.tokexp[t * 2 + 1] = x1; p.tokslot[t * 2] = s0; p.tokslot[t * 2 + 1] = s1; p.tokw[t * 2] = w0; p.tokw[t * 2 + 1] = w1;
    }
}

__device__ __forceinline__ void body_route2(const P& p, int vb, char* smem) {
    const int tid = TIDX(), wave = tid >> 6, lane = tid & 63, t = vb * 8 + wave;
    const float4* hr = (const float4*)(p.h1 + (size_t)t * D);
    float4 v[4]; float ss = 0.f;
#pragma unroll
    for (int j = 0; j < 4; ++j) { v[j] = hr[lane + 64 * j]; ss += v[j].x * v[j].x + v[j].y * v[j].y + v[j].z * v[j].z + v[j].w * v[j].w; }
#pragma unroll
    for (int o = 1; o < 64; o <<= 1) ss += __shfl_xor(ss, o);
    const float rstd = rsqrtf(ss * (1.f / D) + 1e-6f);
#pragma unroll
    for (int j = 0; j < 4; ++j) {
        const float4 g = ((const float4*)p.g_ffn)[lane + 64 * j];
        v[j].x *= rstd * g.x; v[j].y *= rstd * g.y; v[j].z *= rstd * g.z; v[j].w *= rstd * g.w;
        ushort4 o; o.x = f2bf(v[j].x); o.y = f2bf(v[j].y); o.z = f2bf(v[j].z); o.w = f2bf(v[j].w);
        ((ushort4*)(p.vb + (size_t)t * D))[lane + 64 * j] = o;
    }
    float* sl = (float*)(smem + LDS_MISC) + wave * 40;
    float mine = 0.f;
#pragma unroll 4
    for (int o = 0; o < 36; ++o) { const float4* wrow = (const float4*)(p.wr + (size_t)o * 1024); float a = 0.f;
#pragma unroll
        for (int j = 0; j < 4; ++j) { const float4 w = wrow[lane + 64 * j]; a += v[j].x * w.x + v[j].y * w.y + v[j].z * w.z + v[j].w * w.w; }
#pragma unroll
        for (int x = 1; x < 64; x <<= 1) a += __shfl_xor(a, x);
        if (lane == o) mine = a; }
    if (lane < 36) sl[lane] = mine + (lane < 4 ? p.b_grp[lane] : p.b_exp[lane - 4]);
    asm volatile("s_waitcnt lgkmcnt(0)" ::: "memory");
    if (lane == 0) {
        int gs = 0; float gm = sl[0];
        for (int o = 1; o < 4; ++o) if (sl[o] > gm) { gm = sl[o]; gs = o; }
        float gsum = 0.f;
        for (int o = 0; o < 4; ++o) gsum += __expf(sl[o] - gm);
        const float pg = 1.f / gsum;
        const float* li = sl + 4 + gs * 8;
        int e0 = 0; float m0 = li[0];
        for (int e = 1; e < 8; ++e) if (li[e] > m0) { m0 = li[e]; e0 = e; }
        int e1 = -1; float m1 = -3e38f;
        for (int e = 0; e < 8; ++e) if (e != e0 && li[e] > m1) { m1 = li[e]; e1 = e; }
        const float p0 = 1.f, p1 = __expf(m1 - m0);
        const float w0 = pg * p0 / (p0 + p1), w1 = pg * p1 / (p0 + p1);
        const int x0 = gs * 8 + e0, x1 = gs * 8 + e1;
        const int s0 = (int)atomicAdd(&p.ctl[x0 * 32], 1u), s1 = (int)atomicAdd(&p.ctl[x1 * 32], 1u);
        p.list[(size_t)x0 * p.T + s0] = t; p.list[(size_t)x1 * p.T + s1] = t;
        p.tokexp[t * 2] = x0; p.tokexp[t * 2 + 1] = x1; p.tokslot[t * 2] = s0; p.tokslot[t * 2 + 1] = s1; p.tokw[t * 2] = w0; p.tokw[t * 2 + 1] = w1;
    }
}

__device__ __forceinline__ float tred8(float (&a)[8], int lane) {
    const bool b5 = lane & 32, b4 = lane & 16, b3 = lane & 8;
    float k4[4], k2[2], k1;
#pragma unroll
    for (int i = 0; i < 4; ++i) { const float snd = b5 ? a[i] : a[i + 4]; const float kp = b5 ? a[i + 4] : a[i]; k4[i] = kp + __shfl_xor(snd, 32); }
#pragma unroll
    for (int i = 0; i < 2; ++i) { const float snd = b4 ? k4[i] : k4[i + 2]; const float kp = b4 ? k4[i + 2] : k4[i]; k2[i] = kp + __shfl_xor(snd, 16); }
    { const float snd = b3 ? k2[0] : k2[1]; const float kp = b3 ? k2[1] : k2[0]; k1 = kp + __shfl_xor(snd, 8); }
    k1 += __shfl_xor(k1, 4); k1 += __shfl_xor(k1, 2); k1 += __shfl_xor(k1, 1);
    return k1;
}
__device__ __forceinline__ void body_route3(const P& p, int vb, char* smem) {
    const int tid = TIDX(), wave = tid >> 6, lane = tid & 63, t0 = vb * 64 + wave * 8;
    float4 v[8][4]; float ss[8];
#pragma unroll
    for (int tk = 0; tk < 8; ++tk) { const float4* hr = (const float4*)(p.h1 + (size_t)(t0 + tk) * D); float s = 0.f;
#pragma unroll
        for (int j = 0; j < 4; ++j) { v[tk][j] = hr[lane + 64 * j]; s += v[tk][j].x * v[tk][j].x + v[tk][j].y * v[tk][j].y + v[tk][j].z * v[tk][j].z + v[tk][j].w * v[tk][j].w; }
        ss[tk] = s; }
    const float tot = tred8(ss, lane);
#pragma unroll
    for (int tk = 0; tk < 8; ++tk) { const float rstd = rsqrtf(__shfl(tot, tk * 8) * (1.f / D) + 1e-6f);
#pragma unroll
        for (int j = 0; j < 4; ++j) {
            const float4 g = ((const float4*)p.g_ffn)[lane + 64 * j];
            v[tk][j].x *= rstd * g.x; v[tk][j].y *= rstd * g.y; v[tk][j].z *= rstd * g.z; v[tk][j].w *= rstd * g.w;
            ushort4 o; o.x = f2bf(v[tk][j].x); o.y = f2bf(v[tk][j].y); o.z = f2bf(v[tk][j].z); o.w = f2bf(v[tk][j].w);
            ((ushort4*)(p.vb + (size_t)(t0 + tk) * D))[lane + 64 * j] = o; } }
    float* sl = (float*)smem + wave * (8 * 40);
#pragma unroll 3
    for (int o = 0; o < 36; ++o) { const float4* wrow = (const float4*)(p.wr + (size_t)o * 1024); float a[8];
        float4 w[4];
#pragma unroll
        for (int j = 0; j < 4; ++j) w[j] = wrow[lane + 64 * j];
#pragma unroll
        for (int tk = 0; tk < 8; ++tk) { float s = 0.f;
#pragma unroll
            for (int j = 0; j < 4; ++j) s += v[tk][j].x * w[j].x + v[tk][j].y * w[j].y + v[tk][j].z * w[j].z + v[tk][j].w * w[j].w;
            a[tk] = s; }
        const float r = tred8(a, lane);
        if ((lane & 7) == 0) sl[(lane >> 3) * 40 + o] = r + (o < 4 ? p.b_grp[o] : p.b_exp[o - 4]); }
    asm volatile("s_waitcnt lgkmcnt(0)" ::: "memory");
    int* cntl = (int*)((float*)smem + 8 * 320); int* basel = cntl + 32;
    if (tid < 32) cntl[tid] = 0;
    __syncthreads();
    int x0 = 0, x1 = 0, l0 = 0, l1 = 0; float w0 = 0.f, w1 = 0.f;
    if (lane < 8) {
        const float* s8 = sl + lane * 40;
        int gs = 0; float gm = s8[0];
        for (int o = 1; o < 4; ++o) if (s8[o] > gm) { gm = s8[o]; gs = o; }
        float gsum = 0.f;
        for (int o = 0; o < 4; ++o) gsum += __expf(s8[o] - gm);
        const float pg = 1.f / gsum;
        const float* li = s8 + 4 + gs * 8;
        int e0 = 0; float m0 = li[0];
        for (int e = 1; e < 8; ++e) if (li[e] > m0) { m0 = li[e]; e0 = e; }
        int e1 = -1; float m1 = -3e38f;
        for (int e = 0; e < 8; ++e) if (e != e0 && li[e] > m1) { m1 = li[e]; e1 = e; }
        const float p0 = 1.f, p1 = __expf(m1 - m0);
        w0 = pg * p0 / (p0 + p1); w1 = pg * p1 / (p0 + p1);
        x0 = gs * 8 + e0; x1 = gs * 8 + e1;
        l0 = atomicAdd(&cntl[x0], 1); l1 = atomicAdd(&cntl[x1], 1);
    }
    __syncthreads();
    if (tid < 32) { const int c = cntl[tid]; basel[tid] = c > 0 ? (int)atomicAdd(&p.ctl[tid * 32], (unsigned)c) : 0; }
    __syncthreads();
    if (lane < 8) {
        const int t = t0 + lane; const int s0 = basel[x0] + l0, s1 = basel[x1] + l1;
        p.list[(size_t)x0 * p.T + s0] = t; p.list[(size_t)x1 * p.T + s1] = t;
        p.tokexp[t * 2] = x0; p.tokexp[t * 2 + 1] = x1; p.tokslot[t * 2] = s0; p.tokslot[t * 2 + 1] = s1; p.tokw[t * 2] = w0; p.tokw[t * 2 + 1] = w1;
    }
    __syncthreads();
}

__device__ __forceinline__ int* seg_bases(const P& p, char* smem) {
    int* sbase = (int*)(smem + LDS_MISC + 2048);
    __syncthreads();
    if (TIDX() == 0) { int acc = 0; for (int e = 0; e < NEXP; ++e) { sbase[e] = acc; acc += ((int)p.ctl[e * 32] + 255) & ~255; } sbase[NEXP] = acc; }
    __syncthreads();
    return sbase;
}
__device__ __forceinline__ void body_moe1(const P& p, int vb, char* smem) {
    int* sbase = seg_bases(p, smem); int* stok = sbase + 40;
    const int r0 = vb * 8; if (r0 >= sbase[NEXP]) return;
    int e = 0; while (r0 >= sbase[e + 1]) ++e;
    const int cnt = (int)p.ctl[e * 32];
    if (TIDX() < 8) { const int sl = r0 + TIDX() - sbase[e]; stok[TIDX()] = p.list[(size_t)e * p.T + (sl < cnt ? sl : 0)]; }
    __syncthreads();
    const int n = TIDX();
    const float* wg = p.w_gate + (size_t)e * 1024 * 512; const float* wu = p.w_up + (size_t)e * 1024 * 512;
    ngemm<1024, true, true>((float*)smem, 0, wg, 512, n, wu, 512, n,
        [&](int m, int k) { return bf2f(p.vb[(size_t)stok[m] * D + k]); }, [&](int m, int k) { return 0.f; },
        [&](int m, float zg, float zu) { p.H[(size_t)(r0 + m) * 512 + n] = f2bf(siluf_(zg) * zu); });
}
__device__ __forceinline__ void body_moe2(const P& p, int vb, char* smem) {
    int* sbase = seg_bases(p, smem);
    const int r0 = (vb >> 1) * 8; if (r0 >= sbase[NEXP]) return;
    int e = 0; while (r0 >= sbase[e + 1]) ++e;
    const int n = (vb & 1) * NT + TIDX();
    const float* wd = p.w_down + (size_t)e * 512 * 1024;
    ngemm<512, false, true>((float*)smem, r0, wd, 1024, n, wd, 1024, n,
        [&](int m, int k) { return bf2f(p.H[(size_t)m * 512 + k]); }, [&](int m, int k) { return 0.f; },
        [&](int m, float z, float) { p.Y[(size_t)m * 1024 + n] = f2bf(z); });
}
__device__ __forceinline__ void body_final(const P& p, int vb, char* smem) {
    int* sbase = seg_bases(p, smem);
    const int lane = TIDX() & 63, t = vb * 8 + (TIDX() >> 6);
    const int r0 = sbase[p.tokexp[t * 2]] + p.tokslot[t * 2], r1 = sbase[p.tokexp[t * 2 + 1]] + p.tokslot[t * 2 + 1];
    const float w0 = p.tokw[t * 2], w1 = p.tokw[t * 2 + 1];
    const float4* hr = (const float4*)(p.h1 + (size_t)t * D);
    float4 v[4]; float ss = 0.f;
#pragma unroll
    for (int j = 0; j < 4; ++j) {
        float4 a = hr[lane + 64 * j];
        const ushort4 y0 = ((const ushort4*)(p.Y + (size_t)r0 * D))[lane + 64 * j], y1 = ((const ushort4*)(p.Y + (size_t)r1 * D))[lane + 64 * j];
        a.x += w0 * bf2f(y0.x) + w1 * bf2f(y1.x); a.y += w0 * bf2f(y0.y) + w1 * bf2f(y1.y); a.z += w0 * bf2f(y0.z) + w1 * bf2f(y1.z); a.w += w0 * bf2f(y0.w) + w1 * bf2f(y1.w);
        v[j] = a; ss += a.x * a.x + a.y * a.y + a.z * a.z + a.w * a.w;
    }
#pragma unroll
    for (int o = 1; o < 64; o <<= 1) ss += __shfl_xor(ss, o);
    const float rstd = rsqrtf(ss * (1.f / D) + 1e-6f);
#pragma unroll
    for (int j = 0; j < 4; ++j) {
        const float4 g = ((const float4*)p.g_final)[lane + 64 * j];
        float4 o; o.x = v[j].x * rstd * g.x; o.y = v[j].y * rstd * g.y; o.z = v[j].z * rstd * g.z; o.w = v[j].w * rstd * g.w;
        ((float4*)(p.out + (size_t)t * D))[lane + 64 * j] = o;
    }
}

namespace pg8 {
#define PG8_LAS __attribute__((address_space(3)))
typedef short bf16x8 __attribute__((ext_vector_type(8)));
typedef float f32x4 __attribute__((ext_vector_type(4)));
typedef unsigned u32x4 __attribute__((ext_vector_type(4)));
typedef unsigned u32x2 __attribute__((ext_vector_type(2)));
constexpr int BM = 256, BK = 64, HALF = 128, HTB = HALF * BK * 2, STAGE_BYTES = 8 * HTB, NXCD = 8, WGM = 8;

__host__ __device__ __forceinline__ int lds_byte(int r, int c) { const int st = (r >> 4) * 2 + (c >> 5), rr = r & 15, cc = c & 31, ob = rr * 64 + cc * 2; return st * 1024 + (ob ^ (((ob >> 9) & 1) << 5)); }
__host__ __device__ __forceinline__ void stage_rc(int b, int& R, int& C) { const int st = b / 1024, sb = b % 1024, swz = sb ^ (((sb >> 9) & 1) << 5); R = (st >> 1) * 16 + swz / 64; C = (st & 1) * 32 + (swz % 64) / 2; }
__host__ __device__ __forceinline__ int perm32(int rho) { const int n = rho >> 4, i = rho & 15; return 8 * (i >> 2) + 4 * n + (i & 3); }

struct Unit { int pm, pn; const char* A; const char* B; int tag; };

struct TileOrder {
    int nM, nN, nwg, G, c;
    __device__ void init(int nM_, int nN_, int G_, int c_) { nM = nM_; nN = nN_; nwg = nM * nN; G = G_; c = c_; }
    __device__ bool next(int i, int& pm, int& pn) const {
        const long L = (long)i * G + c; if (L >= nwg) return false;
        int wgid = (int)L; { const int q = nwg / NXCD, r = nwg % NXCD, xcd = wgid % NXCD, off = wgid / NXCD; wgid = (xcd < r ? xcd * (q + 1) : r * (q + 1) + (xcd - r) * q) + off; }
        const int nig = WGM * nN, gid = wgid / nig, fm = gid * WGM, gsz = (nM - fm) < WGM ? (nM - fm) : WGM;
        pm = fm + ((wgid % nig) % gsz); pn = (wgid % nig) / gsz; return true;
    }
};
struct DenseSched {
    TileOrder o; const char* A; const char* B; int lda, ldb;
    __device__ void init(const void* A_, const void* B_, int M, int N, int lda_, int ldb_) { A = (const char*)A_; B = (const char*)B_; lda = lda_; ldb = ldb_; o.init(M / BM, N / BM, gridDim.x, blockIdx.x); }
    __device__ __forceinline__ bool next(int i, Unit& u) const { if (!o.next(i, u.pm, u.pn)) return false; u.A = A + (size_t)u.pm * BM * lda * 2; u.B = B + (size_t)u.pn * BM * ldb * 2; u.tag = 0; return true; }
    __device__ __forceinline__ unsigned arow(const Unit&, int r) const { return (unsigned)r * (unsigned)lda * 2u; }
};

__device__ __forceinline__ unsigned cvt_pk_bf16(float lo, float hi) { unsigned r; asm volatile("v_cvt_pk_bf16_f32 %0, %1, %2" : "=v"(r) : "v"(lo), "v"(hi)); return r; }

template <class Epi, class Sched, bool ALIGN_EPI, bool GATHER>
__device__ __forceinline__ void gemm_phase(PG8_LAS unsigned char* lds, const int K, const int lda, const int ldb, const Sched& S, const Epi& E) {
    const int tid = TIDX(), wid = __builtin_amdgcn_readfirstlane(tid >> 6), lane = tid & 63, wr = wid >> 2, wc = wid & 3, fr = lane & 15, fq = lane >> 4;
    const int nt = K / BK;
    int sR[2], sC[2];
    unsigned voffA[2], voffB[2];
#pragma unroll
    for (int i = 0; i < 2; ++i) { stage_rc(tid * 16 + i * 8192, sR[i], sC[i]); const int Rb = Epi::PERM ? ((sR[i] & ~31) + perm32(sR[i] & 31)) : sR[i];
        voffA[i] = (unsigned)(sR[i] * lda + sC[i]) * 2u; voffB[i] = (unsigned)(Rb * ldb + sC[i]) * 2u; }
    unsigned gA[2][2], gN[2][2];
    const size_t kstep = (size_t)(BK * 2);
    const size_t hstepA = (size_t)HALF * lda * 2, hstepB = (size_t)HALF * ldb * 2;
    const unsigned ldsw = (unsigned)wid * 1024u;
    const int aoff = lds_byte(wr * 64 + fr, fq * 8), boff = lds_byte(wc * 32 + fr, fq * 8);
#define PG8_SA(b, h) (((b) * 2 + (h)) * HTB)
#define PG8_SB(b, h) ((4 + (b) * 2 + (h)) * HTB)
#define PG8_GLDS(bufoff, gptr, i_) __builtin_amdgcn_global_load_lds((const unsigned*)(gptr), (PG8_LAS unsigned*)(lds + (bufoff) + ldsw + (i_) * 8192), 16, 0, 0)
#define PG8_STAGE_B(bufoff, gbase) do { _Pragma("unroll") for (int _i = 0; _i < 2; ++_i) PG8_GLDS(bufoff, (const char*)(gbase) + voffB[_i], _i); } while (0)
#define PG8_STAGE_A(bufoff, gb, h, NX) do { _Pragma("unroll") for (int _i = 0; _i < 2; ++_i) { \
        if constexpr (GATHER) { const unsigned _o = (NX) ? gN[h][_i] : gA[h][_i]; PG8_GLDS(bufoff, (const char*)(gb) + _o, _i); } \
        else { PG8_GLDS(bufoff, (const char*)(gb) + (h) * hstepA + voffA[_i], _i); } } } while (0)
#define PG8_LDA(dst, b, h) do { _Pragma("unroll") for (int m = 0; m < 4; ++m) _Pragma("unroll") for (int k = 0; k < 2; ++k) dst[m][k] = *(const PG8_LAS bf16x8*)(lds + PG8_SA(b, h) + aoff + m * 2048 + k * 1024); } while (0)
#define PG8_LDB(dst, b, h) do { _Pragma("unroll") for (int n = 0; n < 2; ++n) _Pragma("unroll") for (int k = 0; k < 2; ++k) dst[n][k] = *(const PG8_LAS bf16x8*)(lds + PG8_SB(b, h) + boff + n * 2048 + k * 1024); } while (0)
#define PG8_MMA(ai, bj, At, Bt) do { __builtin_amdgcn_s_setprio(1); _Pragma("unroll") for (int m = 0; m < 4; ++m) _Pragma("unroll") for (int n = 0; n < 2; ++n) _Pragma("unroll") for (int k = 0; k < 2; ++k) \
        acc[ai][bj][m][n] = __builtin_amdgcn_mfma_f32_16x16x32_bf16(Bt[n][k], At[m][k], acc[ai][bj][m][n], 0, 0, 0); __builtin_amdgcn_s_setprio(0); } while (0)
#define PG8_WAIT_V(n) asm volatile("s_waitcnt vmcnt(" #n ")" ::: "memory")
#define PG8_WAIT_L(n) asm volatile("s_waitcnt lgkmcnt(" #n ")" ::: "memory")
#define PG8_BAR __builtin_amdgcn_s_barrier()
#define PG8_SCHED __builtin_amdgcn_sched_barrier(0)
#define PG8_GOFF(dst, u) do { if constexpr (GATHER) { _Pragma("unroll") for (int _h = 0; _h < 2; ++_h) _Pragma("unroll") for (int _i = 0; _i < 2; ++_i) dst[_h][_i] = S.arow(u, _h * HALF + sR[_i]) + (unsigned)sC[_i] * 2u; } } while (0)
    Unit cur, nxt; int ui = 0;
    if (!S.next(0, cur)) return;
    f32x4 acc[2][2][4][2];
#pragma unroll
    for (int a = 0; a < 2; ++a)
#pragma unroll
        for (int b = 0; b < 2; ++b)
#pragma unroll
            for (int m = 0; m < 4; ++m)
#pragma unroll
                for (int n = 0; n < 2; ++n) acc[a][b][m][n] = (f32x4){0.f, 0.f, 0.f, 0.f};
    bf16x8 At[4][2], B0[2][2], B1[2][2];
    const char* cA = cur.A; const char* cB = cur.B;
    PG8_GOFF(gA, cur);
    if constexpr (GATHER) { PG8_WAIT_V(0); }
    PG8_STAGE_B(PG8_SB(0, 0), cB); PG8_STAGE_B(PG8_SB(0, 1), cB + hstepB); PG8_STAGE_A(PG8_SA(0, 0), cA, 0, false); PG8_STAGE_A(PG8_SA(0, 1), cA, 1, false);
    if (wr == 1) PG8_BAR;
    PG8_WAIT_V(2); PG8_BAR;
    PG8_STAGE_B(PG8_SB(1, 0), cB + kstep); PG8_STAGE_A(PG8_SA(1, 0), cA + kstep, 0, false); PG8_STAGE_B(PG8_SB(1, 1), cB + hstepB + kstep);
    PG8_WAIT_V(6); PG8_BAR;
    for (;;) {
        const bool has_next = S.next(ui + 1, nxt);
        const char* nA = has_next ? nxt.A : cA; const char* nB = has_next ? nxt.B : cB;
        if constexpr (GATHER) { if (has_next) { PG8_GOFF(gN, nxt); } else {
#pragma unroll
            for (int _h = 0; _h < 2; ++_h)
#pragma unroll
                for (int _i = 0; _i < 2; ++_i) gN[_h][_i] = gA[_h][_i]; } }
        for (int t = 0; t < nt; t += 2) {
            const bool last = (t == nt - 2);
            const char* a1 = cA + (size_t)(t + 1) * kstep;
            const char* a2 = last ? nA : cA + (size_t)(t + 2) * kstep; const char* b2 = last ? nB : cB + (size_t)(t + 2) * kstep;
            const char* a3 = a2 + kstep; const char* b3 = b2 + kstep;
            PG8_LDB(B0, 0, 0); PG8_LDB(B1, 0, 1); PG8_SCHED; PG8_LDA(At, 0, 0); PG8_STAGE_A(PG8_SA(1, 1), a1, 1, false);
            PG8_WAIT_V(8); PG8_WAIT_L(0); PG8_BAR; PG8_MMA(0, 0, At, B0); PG8_MMA(0, 1, At, B1); PG8_BAR; PG8_SCHED;
            PG8_LDA(At, 0, 1); PG8_STAGE_B(PG8_SB(0, 0), b2); PG8_STAGE_B(PG8_SB(0, 1), b2 + hstepB); PG8_STAGE_A(PG8_SA(0, 0), a2, 0, last);
            PG8_WAIT_V(8); PG8_WAIT_L(0); PG8_BAR; PG8_MMA(1, 0, At, B0); PG8_MMA(1, 1, At, B1); PG8_BAR; PG8_SCHED;
            PG8_LDB(B0, 1, 0); PG8_LDB(B1, 1, 1); PG8_SCHED; PG8_LDA(At, 1, 0); PG8_STAGE_A(PG8_SA(0, 1), a2, 1, last);
            PG8_WAIT_V(8); PG8_WAIT_L(0); PG8_BAR; PG8_MMA(0, 0, At, B0); PG8_MMA(0, 1, At, B1); PG8_BAR; PG8_SCHED;
            PG8_LDA(At, 1, 1); PG8_STAGE_B(PG8_SB(1, 0), b3); PG8_STAGE_B(PG8_SB(1, 1), b3 + hstepB); PG8_STAGE_A(PG8_SA(1, 0), a3, 0, last);
            PG8_WAIT_V(8); PG8_WAIT_L(0); PG8_BAR; PG8_MMA(1, 0, At, B0); PG8_MMA(1, 1, At, B1); PG8_BAR; PG8_SCHED;
        }
        if constexpr (ALIGN_EPI) { if (wr == 0) PG8_BAR; }
        E(acc, cur, wr, wc, fr, fq);
        if (!has_next) break;
#pragma unroll
        for (int a = 0; a < 2; ++a)
#pragma unroll
            for (int b = 0; b < 2; ++b)
#pragma unroll
                for (int m = 0; m < 4; ++m)
#pragma unroll
                    for (int n = 0; n < 2; ++n) acc[a][b][m][n] = (f32x4){0.f, 0.f, 0.f, 0.f};
        cur = nxt; cA = nA; cB = nB; ++ui;
        if constexpr (GATHER) {
#pragma unroll
            for (int _h = 0; _h < 2; ++_h)
#pragma unroll
                for (int _i = 0; _i < 2; ++_i) gA[_h][_i] = gN[_h][_i]; }
        if constexpr (ALIGN_EPI) { if (wr == 1) PG8_BAR; }
    }
    PG8_WAIT_V(0);
    if constexpr (!ALIGN_EPI) { if (wr == 0) PG8_BAR; }
    PG8_BAR;
#undef PG8_SA
#undef PG8_SB
#undef PG8_GLDS
#undef PG8_STAGE_A
#undef PG8_STAGE_B
#undef PG8_LDA
#undef PG8_LDB
#undef PG8_MMA
#undef PG8_WAIT_V
#undef PG8_WAIT_L
#undef PG8_BAR
#undef PG8_SCHED
#undef PG8_GOFF
}
}

typedef float f32x4_t __attribute__((ext_vector_type(4)));
__device__ __forceinline__ int inproj_row(int j) {
    if (j < 512) { const int h = j >> 6, d = j & 63; return h * 64 + 2 * (d & 31) + (d >> 5); }
    if (j < 1280) { const int seg = (j - 512) >> 7, cc = (j - 512) & 127; int col = cc; if (seg == 2 || seg == 4) { const int g = cc >> 6, d = cc & 63; col = g * 64 + 2 * (d & 31) + (d >> 5); } return (2 + (seg >> 1)) * 256 + (seg & 1) * 128 + col; }
    if (j < 1304) return 11 * 256 + (j - 1280);
    if (j < 1560) return 5 * 256 + (j - 1304);
    if (j < 1816) return 6 * 256 + (j - 1560);
    if (j < 2328) return 7 * 256 + (j - 1816);
    if (j < 2344) return 11 * 256 + 32 + (j - 2328);
    if (j < 2856) return 9 * 256 + (j - 2344);
    if (j < 3880) return 12 * 256 + (j - 2856);
    return 16 * 256 + (j - 3880);
}
__device__ __forceinline__ unsigned pk2(float lo, float hi) { return (unsigned)f2bf(lo) | ((unsigned)f2bf(hi) << 16); }
template <class RM>
__device__ __forceinline__ void transpose_item(const float* W, int ldw, int N, bf16* WT, int ldt, float* scr, int k0, int n0, int lane, RM rm) {
    const int nn = n0 + (lane & 31);
#pragma unroll 8
    for (int i = 0; i < 32; ++i) { const int kk = 2 * i + (lane >> 5); scr[kk * 33 + (lane & 31)] = nn < N ? W[(size_t)(k0 + kk) * ldw + nn] : 0.f; }
    asm volatile("s_waitcnt lgkmcnt(0)" ::: "memory");
    const int c = lane & 7;
#pragma unroll
    for (int j = 0; j < 4; ++j) { const int n = (lane >> 3) + 8 * j; const float* s = scr + (8 * c) * 33 + n;
        uint4 o; o.x = pk2(s[0 * 33], s[1 * 33]); o.y = pk2(s[2 * 33], s[3 * 33]); o.z = pk2(s[4 * 33], s[5 * 33]); o.w = pk2(s[6 * 33], s[7 * 33]);
        const int row = (n0 + n < N) ? rm(n0 + n) : -1;
        if (row >= 0) *(uint4*)(WT + (size_t)row * ldt + k0 + 8 * c) = o; }
    asm volatile("s_waitcnt lgkmcnt(0)" ::: "memory");
}
constexpr int PREP_I_WIN = 16 * 154, PREP_I_C1 = 4 * 128, PREP_I_PN = 256, PREP_I_PG = 256, PREP_I_WO = 512, PREP_I_EXP = 3 * 32 * 256;
constexpr int PREP_ITEMS = PREP_I_WIN + PREP_I_C1 + PREP_I_PN + PREP_I_PG + PREP_I_WO + PREP_I_EXP;
__device__ __forceinline__ void prep_item(const P& p, int it, float* scr, int lane) {
    if (it < PREP_I_WIN) { const int kb = it / 154, nb = it % 154; transpose_item(p.w_in, INW, INW, p.Wt_in, 1024, scr, kb * 64, nb * 32, lane, [](int n) { return inproj_row(n); }); return; }
    it -= PREP_I_WIN;
    if (it < PREP_I_C1) { const int mat = it >> 7, r = it & 127, kb = r >> 3, nb = r & 7, kv = mat >> 1, half = mat & 1;
        const float* W = (kv ? p.cw1_v : p.cw1_k) + (size_t)half * 1024 * 256;
        transpose_item(W, 256, 256, p.Wc1 + (size_t)kv * 512 * 1024, 1024, scr, kb * 64, nb * 32, lane, [half](int n) { return half * 256 + n; }); return; }
    it -= PREP_I_C1;
    if (it < PREP_I_PN) { transpose_item(p.w_pn, 1024, 1024, p.Wpn, 512, scr, (it >> 5) * 64, (it & 31) * 32, lane, [](int n) { return n; }); return; }
    it -= PREP_I_PN;
    if (it < PREP_I_PG) { transpose_item(p.w_pg, 1024, 1024, p.Wpg, 512, scr, (it >> 5) * 64, (it & 31) * 32, lane, [](int n) { return n; }); return; }
    it -= PREP_I_PG;
    if (it < PREP_I_WO) { transpose_item(p.w_out, 1024, 1024, p.Wo, 1024, scr, (it >> 5) * 64, (it & 31) * 32, lane, [](int n) { return n; }); return; }
    it -= PREP_I_WO;
    { const int which = it / (32 * 256), r = it % (32 * 256), e = r >> 8, r2 = r & 255;
        if (which == 0) transpose_item(p.w_gate + (size_t)e * 1024 * 512, 512, 512, p.Wgu + (size_t)e * 1024 * 1024, 1024, scr, (r2 >> 4) * 64, (r2 & 15) * 32, lane, [](int n) { return (n >> 7) * 256 + (n & 127); });
        else if (which == 1) transpose_item(p.w_up + (size_t)e * 1024 * 512, 512, 512, p.Wgu + (size_t)e * 1024 * 1024, 1024, scr, (r2 >> 4) * 64, (r2 & 15) * 32, lane, [](int n) { return (n >> 7) * 256 + 128 + (n & 127); });
        else transpose_item(p.w_down + (size_t)e * 512 * 1024, 1024, 1024, p.Wd + (size_t)e * 1024 * 512, 512, scr, (r2 >> 5) * 64, (r2 & 31) * 32, lane, [](int n) { return n; }); }
}
__device__ __forceinline__ void phase_prep_(const P& p, char* smem);
__device__ __forceinline__ void prep_b1p(const P& p, char* smem);
__device__ __forceinline__ void phase_prep(const P& p, char* smem) { prep_b1p(p, smem); phase_prep_(p, smem); }
__device__ __forceinline__ void phase_prep_(const P& p, char* smem) {
    const int wave = TIDX() >> 6, lane = TIDX() & 63;
    float* scr = (float*)smem + wave * (64 * 33);
    const int gw = blockIdx.x * 8 + wave, NGW = gridDim.x * 8;
    for (int it = gw; it < PREP_ITEMS; it += NGW) prep_item(p, it, scr, lane);
    for (int i = blockIdx.x * NT + TIDX(); i < 216 * 128; i += gridDim.x * NT) { int r = i >> 7; r = r < 8 ? 24 + r : 40 + r; *(uint4*)(p.Wt_in + (size_t)(11 * 256 + r) * 1024 + (i & 127) * 8) = make_uint4(0, 0, 0, 0); }
    for (int i = blockIdx.x * NT + TIDX(); i < 36 * 1024; i += gridDim.x * NT) { const int o = i >> 10, k = i & 1023; p.wr[i] = o < 4 ? p.w_grp[k * 4 + o] : p.w_exp[k * 32 + (o - 4)]; }
    for (int vb = blockIdx.x; vb < p.T / 8; vb += gridDim.x) body_rms(p, vb);
    for (int vb = blockIdx.x; vb < p.T * 32 / NT; vb += gridDim.x) body_cs(p, vb);
}

struct EpiInA {
    static constexpr bool PERM = true;
    P p;
    __device__ __forceinline__ static void rope4(const float* cs, int t, int i0, const pg8::f32x4& v0, const pg8::f32x4& v1, float sc, pg8::u32x2& lo, pg8::u32x2& hi) {
        const f32x4_t c = *(const f32x4_t*)(cs + (size_t)t * 64 + i0), s = *(const f32x4_t*)(cs + (size_t)t * 64 + 32 + i0);
        const float a0 = (v0[0] * c[0] - v0[1] * s[0]) * sc, b0 = (v0[1] * c[0] + v0[0] * s[0]) * sc;
        const float a1 = (v0[2] * c[1] - v0[3] * s[1]) * sc, b1 = (v0[3] * c[1] + v0[2] * s[1]) * sc;
        const float a2 = (v1[0] * c[2] - v1[1] * s[2]) * sc, b2 = (v1[1] * c[2] + v1[0] * s[2]) * sc;
        const float a3 = (v1[2] * c[3] - v1[3] * s[3]) * sc, b3 = (v1[3] * c[3] + v1[2] * s[3]) * sc;
        lo.x = pk2(a0, a1); lo.y = pk2(a2, a3); hi.x = pk2(b0, b1); hi.y = pk2(b2, b3);
    }
    __device__ __forceinline__ static pg8::u32x4 pack8(const pg8::f32x4& v0, const pg8::f32x4& v1) { pg8::u32x4 w; w.x = pk2(v0[0], v0[1]); w.y = pk2(v0[2], v0[3]); w.z = pk2(v1[0], v1[1]); w.w = pk2(v1[2], v1[3]); return w; }
    __device__ __forceinline__ void operator()(const pg8::f32x4 (&acc)[2][2][4][2], const pg8::Unit& u, int wr, int wc, int fr, int fq) const {
        const int pn = u.pn, c8 = wc * 32 + 8 * fq; const size_t seg = kvseg(p);
#pragma unroll
        for (int ai = 0; ai < 2; ++ai)
#pragma unroll
            for (int m = 0; m < 4; ++m) {
                const int t = u.pm * 256 + ai * 128 + wr * 64 + m * 16 + fr; const int b = t / S, s = t % S;
#pragma unroll
                for (int bj = 0; bj < 2; ++bj) {
                    const pg8::f32x4 v0 = acc[ai][bj][m][0], v1 = acc[ai][bj][m][1];
                    if (pn <= 1) {
                        const int cq = pn * 256 + bj * 128 + c8, h = cq >> 6, i0 = (cq & 63) >> 1; pg8::u32x2 lo, hi;
                        rope4(p.cs, t, i0, v0, v1, 0.125f, lo, hi);
                        bf16* dst = p.q + (size_t)t * 512 + h * 64 + i0; *(pg8::u32x2*)dst = lo; *(pg8::u32x2*)(dst + 32) = hi;
                    } else if (pn <= 4) {
                        const int sgi = (pn - 2) * 2 + bj, g = c8 >> 6; bf16* base = p.kv6 + (size_t)sgi * seg + ((size_t)(b * 2 + g) * S + s) * 64;
                        if (bj == 0 && pn >= 3) { const int i0 = (c8 & 63) >> 1; pg8::u32x2 lo, hi; rope4(p.cs, t, i0, v0, v1, 1.f, lo, hi); *(pg8::u32x2*)(base + i0) = lo; *(pg8::u32x2*)(base + 32 + i0) = hi; }
                        else *(pg8::u32x4*)(base + (c8 & 63)) = pack8(v0, v1);
                    } else if (pn == 5) { *(pg8::u32x4*)(p.gq + (size_t)t * 256 + bj * 128 + c8) = pack8(v0 * 0.125f, v1 * 0.125f);
                    } else if (pn == 6) { *(pg8::u32x4*)(p.gk + (size_t)t * 256 + bj * 128 + c8) = pack8(v0, v1);
                    } else if (pn <= 8) { *(pg8::u32x4*)(p.gv + (size_t)t * 512 + (pn - 7) * 256 + bj * 128 + c8) = pack8(v0, v1);
                    } else if (pn <= 10) {
                        pg8::f32x4 a, c;
#pragma unroll
                        for (int e = 0; e < 4; ++e) { a[e] = siluf_(v0[e]); c[e] = siluf_(v1[e]); }
                        *(pg8::u32x4*)(p.rs + (size_t)t * 512 + (pn - 9) * 256 + bj * 128 + c8) = pack8(a, c);
                    } else {
                        if (bj == 0) {
                            if (c8 < 24) { float* d = p.gates + (size_t)t * 24 + c8;
#pragma unroll
                                for (int e = 0; e < 4; ++e) { d[e] = sigmoidf_(v0[e]); d[4 + e] = sigmoidf_(v1[e]); } }
                            else if (c8 >= 32 && c8 < 48) { float* d = p.alow + (size_t)t * 16 + (c8 - 32);
#pragma unroll
                                for (int e = 0; e < 4; ++e) { d[e] = v0[e]; d[4 + e] = v1[e]; } }
                        }
                    }
                }
            }
    }
};
struct EpiSig {
    static constexpr bool PERM = true;
    bf16* sa; bf16* sb;
    __device__ __forceinline__ void operator()(const pg8::f32x4 (&acc)[2][2][4][2], const pg8::Unit& u, int wr, int wc, int fr, int fq) const {
        bf16* base = (u.pn < 4 ? sa : sb) + (u.pn & 3) * 256 + wc * 32 + 8 * fq;
#pragma unroll
        for (int ai = 0; ai < 2; ++ai)
#pragma unroll
            for (int m = 0; m < 4; ++m) { const int t = u.pm * 256 + ai * 128 + wr * 64 + m * 16 + fr;
#pragma unroll
                for (int bj = 0; bj < 2; ++bj) { pg8::f32x4 a, c;
#pragma unroll
                    for (int e = 0; e < 4; ++e) { a[e] = sigmoidf_(acc[ai][bj][m][0][e]); c[e] = sigmoidf_(acc[ai][bj][m][1][e]); }
                    *(pg8::u32x4*)(base + (size_t)t * 1024 + bj * 128) = EpiInA::pack8(a, c); } }
    }
};
__device__ __forceinline__ void phase_inA(const P& p, char* smem) {
    pg8::DenseSched S; S.init(p.u, p.Wt_in, p.T, 3072, 1024, 1024);
    EpiInA E{p};
    pg8::gemm_phase<EpiInA, pg8::DenseSched, true, false>((PG8_LAS unsigned char*)smem, 1024, 1024, 1024, S, E);
}
__device__ __forceinline__ void phase_inB(const P& p, char* smem) {
    pg8::DenseSched S; S.init(p.u, p.Wt_in + (size_t)3072 * 1024, p.T, 2048, 1024, 1024);
    EpiSig E{p.sa, p.sb};
    pg8::gemm_phase<EpiSig, pg8::DenseSched, true, false>((PG8_LAS unsigned char*)smem, 1024, 1024, 1024, S, E);
}

struct EpiProj {
    static constexpr bool PERM = true;
    const bf16* g; bf16* mixed; int pass;
    __device__ __forceinline__ void operator()(const pg8::f32x4 (&acc)[2][2][4][2], const pg8::Unit& u, int wr, int wc, int fr, int fq) const {
        const int col0 = u.pn * 256 + wc * 32 + 8 * fq;
#pragma unroll
        for (int ai = 0; ai < 2; ++ai)
#pragma unroll
            for (int m = 0; m < 4; ++m) { const size_t t = (size_t)(u.pm * 256 + ai * 128 + wr * 64 + m * 16 + fr);
#pragma unroll
                for (int bj = 0; bj < 2; ++bj) { const size_t off = t * 1024 + col0 + bj * 128;
                    const uint4 gv = *(const uint4*)(g + off); const unsigned gw[4] = {gv.x, gv.y, gv.z, gv.w};
                    float r[8];
#pragma unroll
                    for (int e = 0; e < 4; ++e) { const float a = e < 2 ? acc[ai][bj][m][0][2 * e] : acc[ai][bj][m][1][2 * e - 4], b = e < 2 ? acc[ai][bj][m][0][2 * e + 1] : acc[ai][bj][m][1][2 * e - 3];
                        r[2 * e] = __uint_as_float(gw[e] << 16) * a; r[2 * e + 1] = __uint_as_float(gw[e] & 0xffff0000u) * b; }
                    if (pass) { const uint4 mv = *(const uint4*)(mixed + off); const unsigned mw[4] = {mv.x, mv.y, mv.z, mv.w};
#pragma unroll
                        for (int e = 0; e < 4; ++e) { r[2 * e] += __uint_as_float(mw[e] << 16); r[2 * e + 1] += __uint_as_float(mw[e] & 0xffff0000u); } }
                    uint4 o; o.x = pk2(r[0], r[1]); o.y = pk2(r[2], r[3]); o.z = pk2(r[4], r[5]); o.w = pk2(r[6], r[7]);
                    *(uint4*)(mixed + off) = o; } }
    }
};
struct EpiOut {
    static constexpr bool PERM = false;
    const float* x; float* h1;
    __device__ __forceinline__ void operator()(const pg8::f32x4 (&acc)[2][2][4][2], const pg8::Unit& u, int wr, int wc, int fr, int fq) const {
        const int col0 = u.pn * 256 + wc * 32 + 4 * fq;
#pragma unroll
        for (int ai = 0; ai < 2; ++ai)
#pragma unroll
            for (int m = 0; m < 4; ++m) { const size_t off = (size_t)(u.pm * 256 + ai * 128 + wr * 64 + m * 16 + fr) * 1024 + col0;
#pragma unroll
                for (int bj = 0; bj < 2; ++bj)
#pragma unroll
                    for (int n = 0; n < 2; ++n) { const pg8::f32x4 xv = *(const pg8::f32x4*)(x + off + bj * 128 + n * 16); *(pg8::f32x4*)(h1 + off + bj * 128 + n * 16) = xv + acc[ai][bj][m][n]; } }
    }
};
__device__ __forceinline__ void phase_proj(const P& p, char* smem) {
    { pg8::DenseSched S; S.init(p.onsa, p.Wpn, p.T, 1024, 512, 512); EpiProj E{p.sa, p.mixed, 0};
      pg8::gemm_phase<EpiProj, pg8::DenseSched, true, false>((PG8_LAS unsigned char*)smem, 512, 512, 512, S, E); }
    { pg8::DenseSched S; S.init(p.gla, p.Wpg, p.T, 1024, 512, 512); EpiProj E{p.sb, p.mixed, 1};
      pg8::gemm_phase<EpiProj, pg8::DenseSched, true, false>((PG8_LAS unsigned char*)smem, 512, 512, 512, S, E); }
}
__device__ __forceinline__ void phase_out(const P& p, char* smem) {
    pg8::DenseSched S; S.init(p.mixed, p.Wo, p.T, 1024, 1024, 1024); EpiOut E{p.x, p.h1};
    pg8::gemm_phase<EpiOut, pg8::DenseSched, true, false>((PG8_LAS unsigned char*)smem, 1024, 1024, 1024, S, E);
}

struct ExpertSched {
    const int* ub;
    const int* sb_;
    const unsigned* cnt; const int* list; int T;
    const char* A; const char* B; int lda, ldb; size_t bstride;
    int npn, G, c; bool gather;
    __device__ __forceinline__ bool next(int i, pg8::Unit& u) const {
        const int L = i * G + c; if (L >= ub[NEXP]) return false;
        int e = 0; while (L >= ub[e + 1]) ++e;
        const int rem = L - ub[e], tiles = (ub[e + 1] - ub[e]) / npn, pn = rem / tiles, pml = rem % tiles;
        u.pm = sb_[e] / 256 + pml; u.pn = pn; u.tag = e | (pml << 8);
        u.A = gather ? A : A + (size_t)u.pm * 256 * lda * 2; u.B = B + (size_t)e * bstride + (size_t)pn * 256 * ldb * 2; return true;
    }
    __device__ __forceinline__ unsigned arow(const pg8::Unit& u, int r) const {
        const int e = u.tag & 255, sl = (u.tag >> 8) * 256 + r; const int tok = list[(size_t)e * T + (sl < (int)cnt[e * 32] ? sl : 0)];
        return (unsigned)tok * (unsigned)lda * 2u;
    }
};
__device__ __forceinline__ void expert_tables(const P& p, char* smem, int npn, int*& ub, int*& sb_) {
    ub = (int*)(smem + LDS_MISC + 1024); sb_ = ub + 40;
    __syncthreads();
    if (TIDX() == 0) { int ua = 0, sa = 0; for (int e = 0; e < NEXP; ++e) { ub[e] = ua; sb_[e] = sa; const int tl = ((int)p.ctl[e * 32] + 255) >> 8; ua += tl * npn; sa += tl * 256; } ub[NEXP] = ua; sb_[NEXP] = sa; }
    __syncthreads();
}
struct EpiMoe1 {
    static constexpr bool PERM = true;
    bf16* H;
    __device__ __forceinline__ void operator()(const pg8::f32x4 (&acc)[2][2][4][2], const pg8::Unit& u, int wr, int wc, int fr, int fq) const {
        const int col0 = u.pn * 128 + wc * 32 + 8 * fq;
#pragma unroll
        for (int ai = 0; ai < 2; ++ai)
#pragma unroll
            for (int m = 0; m < 4; ++m) { const size_t row = (size_t)(u.pm * 256 + ai * 128 + wr * 64 + m * 16 + fr);
                pg8::f32x4 a, b;
#pragma unroll
                for (int e = 0; e < 4; ++e) { a[e] = siluf_(acc[ai][0][m][0][e]) * acc[ai][1][m][0][e]; b[e] = siluf_(acc[ai][0][m][1][e]) * acc[ai][1][m][1][e]; }
                *(pg8::u32x4*)(H + row * 512 + col0) = EpiInA::pack8(a, b); }
    }
};
struct EpiMoe2 {
    static constexpr bool PERM = true;
    bf16* Y;
    __device__ __forceinline__ void operator()(const pg8::f32x4 (&acc)[2][2][4][2], const pg8::Unit& u, int wr, int wc, int fr, int fq) const {
        const int col0 = u.pn * 256 + wc * 32 + 8 * fq;
#pragma unroll
        for (int ai = 0; ai < 2; ++ai)
#pragma unroll
            for (int m = 0; m < 4; ++m) { const size_t row = (size_t)(u.pm * 256 + ai * 128 + wr * 64 + m * 16 + fr);
#pragma unroll
                for (int bj = 0; bj < 2; ++bj) *(pg8::u32x4*)(Y + row * 1024 + col0 + bj * 128) = EpiInA::pack8(acc[ai][bj][m][0], acc[ai][bj][m][1]); }
    }
};
__device__ __forceinline__ void phase_moe1(const P& p, char* smem) {
    int *ub, *sb_; expert_tables(p, smem, 4, ub, sb_);
    ExpertSched S{ub, sb_, p.ctl, p.list, p.T, (const char*)p.vb, (const char*)p.Wgu, 1024, 1024, (size_t)1024 * 1024 * 2, 4, (int)gridDim.x, (int)blockIdx.x, true};
    EpiMoe1 E{p.H};
    pg8::gemm_phase<EpiMoe1, ExpertSched, true, true>((PG8_LAS unsigned char*)smem, 1024, 1024, 1024, S, E);
}
__device__ __forceinline__ void phase_moe2(const P& p, char* smem) {
    int *ub, *sb_; expert_tables(p, smem, 4, ub, sb_);
    ExpertSched S{ub, sb_, p.ctl, p.list, p.T, (const char*)p.H, (const char*)p.Wd, 512, 512, (size_t)1024 * 512 * 2, 4, (int)gridDim.x, (int)blockIdx.x, false};
    EpiMoe2 E{p.Y};
    pg8::gemm_phase<EpiMoe2, ExpertSched, true, false>((PG8_LAS unsigned char*)smem, 512, 512, 512, S, E);
}

namespace nsa {
using f32x16 = __attribute__((ext_vector_type(16))) float;
using bf16x8 = __attribute__((ext_vector_type(8))) short;
using s16x4 = __attribute__((ext_vector_type(4))) short;
using u32x4 = __attribute__((ext_vector_type(4))) unsigned;
typedef __attribute__((address_space(3))) char* lptr;
typedef __attribute__((address_space(3))) const char* lcptr;
constexpr int SLOT = 8192;
constexpr int L_K = 0, L_V = 2 * SLOT, L_WS = 4 * SLOT, L_OST = L_WS + 8 * 512, L_IMPD = L_OST + 8 * 4096, L_IMPC = L_IMPD + 64 * 64 * 4, L_SEL = L_IMPC + 64 * 68 * 4, L_END = L_SEL + 64 * 8;
constexpr float LOG2E = 1.4426950408889634f, NEGM = -1e30f, M0 = -1e20f, THR = 8.f;
__device__ __forceinline__ int crow(int r, int hi) { return (r & 3) + 8 * (r >> 2) + 4 * hi; }
__device__ __forceinline__ void glds16(const void* gsrc, unsigned lds_dst) { unsigned keep;
    asm volatile("s_mov_b32 %0, m0\n\ts_mov_b32 m0, %2\n\ts_nop 0\n\tglobal_load_lds_dwordx4 %1, off\n\ts_mov_b32 m0, %0" : "=&s"(keep) : "v"(gsrc), "s"(lds_dst) : "memory"); }
#define NSA_WAIT_BAR() asm volatile("s_waitcnt vmcnt(0) lgkmcnt(0)\n\ts_barrier" ::: "memory")
#define NSA_LWAIT() asm volatile("s_waitcnt lgkmcnt(0)" ::: "memory")
__device__ __forceinline__ unsigned cvtpk(float lo, float hi) { typedef float f2 __attribute__((ext_vector_type(2))); typedef __bf16 b2 __attribute__((ext_vector_type(2))); f2 v = {lo, hi}; b2 b = __builtin_convertvector(v, b2); return __builtin_bit_cast(unsigned, b); }
__device__ __forceinline__ float xhalf_max(float m) { auto rr = __builtin_amdgcn_permlane32_swap(__float_as_uint(m), __float_as_uint(m), false, false); return fmaxf(__uint_as_float(rr[0]), __uint_as_float(rr[1])); }
__device__ __forceinline__ float xhalf_sum(float m) { auto rr = __builtin_amdgcn_permlane32_swap(__float_as_uint(m), __float_as_uint(m), false, false); return __uint_as_float(rr[0]) + __uint_as_float(rr[1]); }
__device__ __forceinline__ void qkt(f32x16& p0, f32x16& p1, lcptr Kslot, const bf16x8* qr, int r32, int hi) {
    lcptr kb = Kslot + hi * 1024 + r32 * 16;
    p0 = f32x16{}; p1 = f32x16{};
#pragma unroll
    for (int d0 = 0; d0 < 4; ++d0) {
        const bf16x8 b0 = *(const __attribute__((address_space(3))) bf16x8*)(kb + d0 * 2048);
        const bf16x8 b1 = *(const __attribute__((address_space(3))) bf16x8*)(kb + d0 * 2048 + 512);
        p0 = __builtin_amdgcn_mfma_f32_32x32x16_bf16(b0, qr[d0], p0, 0, 0, 0); p1 = __builtin_amdgcn_mfma_f32_32x32x16_bf16(b1, qr[d0], p1, 0, 0, 0); }
}
__device__ __forceinline__ void pv(f32x16* o, int vb, bf16x8 pa0, bf16x8 pa1, bf16x8 pa2, bf16x8 pa3) {
#pragma unroll
    for (int d0 = 0; d0 < 2; ++d0) { s16x4 lo[4], hi[4];
#pragma unroll
        for (int ks = 0; ks < 4; ++ks) {
            asm volatile("ds_read_b64_tr_b16 %0,%1 offset:%c2" : "=&v"(lo[ks]) : "v"(vb), "i"(d0 * 4096 + ks * 1024) : "memory");
            asm volatile("ds_read_b64_tr_b16 %0,%1 offset:%c2" : "=&v"(hi[ks]) : "v"(vb), "i"(d0 * 4096 + ks * 1024 + 512) : "memory"); }
        asm volatile("s_waitcnt lgkmcnt(0)" ::: "memory"); __builtin_amdgcn_sched_barrier(0);
#define NSA_PK(k) (bf16x8){lo[k][0], lo[k][1], lo[k][2], lo[k][3], hi[k][0], hi[k][1], hi[k][2], hi[k][3]}
        o[d0] = __builtin_amdgcn_mfma_f32_32x32x16_bf16(pa0, NSA_PK(0), o[d0], 0, 0, 0);
        o[d0] = __builtin_amdgcn_mfma_f32_32x32x16_bf16(pa1, NSA_PK(1), o[d0], 0, 0, 0);
        o[d0] = __builtin_amdgcn_mfma_f32_32x32x16_bf16(pa2, NSA_PK(2), o[d0], 0, 0, 0);
        o[d0] = __builtin_amdgcn_mfma_f32_32x32x16_bf16(pa3, NSA_PK(3), o[d0], 0, 0, 0);
#undef NSA_PK
    }
}
__device__ __forceinline__ float rowmax32(const f32x16& p0, const f32x16& p1) {
    float a = fmaxf(p0[0], p1[0]);
#pragma unroll
    for (int r = 1; r < 16; ++r) a = fmaxf(a, fmaxf(p0[r], p1[r]));
    return xhalf_max(a);
}
struct Ctx {
    int w, lane, r32, hi; unsigned lds0; lptr shm; const bf16* kt; const bf16* vt;
};
__device__ __forceinline__ void dma_kv(const Ctx& c, int tile, int slot) {
    const bf16* ksrc = c.kt + (size_t)tile * 64 * 64 + c.lane * 64 + c.w * 8;
    const bf16* vsrc = c.vt + (size_t)tile * 64 * 64 + (16 * (c.w & 3) + (c.lane >> 2)) * 64 + (c.w >> 2) * 32 + (c.lane & 3) * 8;
    glds16(ksrc, (unsigned)__builtin_amdgcn_readfirstlane(c.lds0 + L_K + slot * SLOT + c.w * 1024));
    glds16(vsrc, (unsigned)__builtin_amdgcn_readfirstlane(c.lds0 + L_V + slot * SLOT + c.w * 1024));
}
__device__ __forceinline__ void softmax_pv(const Ctx& c, f32x16& p0, f32x16& p1, f32x16* o, float& m, float& l, int slot) {
    const float rm = rowmax32(p0, p1);
    volatile __attribute__((address_space(3))) float* wsf = (volatile __attribute__((address_space(3))) float*)(c.shm + L_WS + c.w * 512);
    bool resc = false;
    if (__any(rm > m + THR)) { const float mn = fmaxf(m, rm); const float f = __builtin_amdgcn_exp2f(m - mn); l *= f; m = mn; if (c.hi == 0) wsf[c.r32] = f; resc = true; }
    float sacc = 0.f;
#pragma unroll
    for (int r = 0; r < 16; ++r) { p0[r] = __builtin_amdgcn_exp2f(p0[r] - m); p1[r] = __builtin_amdgcn_exp2f(p1[r] - m); sacc += p0[r] + p1[r]; }
    l += sacc;
    if (resc) { NSA_LWAIT();
#pragma unroll
        for (int r = 0; r < 16; ++r) { const float f = wsf[crow(r, c.hi)]; o[0][r] *= f; o[1][r] *= f; } }
    u32x4 w0, w1, w2, w3;
    w0 = (u32x4){cvtpk(p0[0], p0[1]), cvtpk(p0[2], p0[3]), cvtpk(p0[4], p0[5]), cvtpk(p0[6], p0[7])};
    w1 = (u32x4){cvtpk(p0[8], p0[9]), cvtpk(p0[10], p0[11]), cvtpk(p0[12], p0[13]), cvtpk(p0[14], p0[15])};
    w2 = (u32x4){cvtpk(p1[0], p1[1]), cvtpk(p1[2], p1[3]), cvtpk(p1[4], p1[5]), cvtpk(p1[6], p1[7])};
    w3 = (u32x4){cvtpk(p1[8], p1[9]), cvtpk(p1[10], p1[11]), cvtpk(p1[12], p1[13]), cvtpk(p1[14], p1[15])};
    const int vb = (int)(c.lds0 + L_V + slot * SLOT) + ((c.lane >> 4) & 1) * 32 + (c.lane & 3) * 8 + (4 * c.hi + ((c.lane & 15) >> 2)) * 64;
    pv(o, vb, __builtin_bit_cast(bf16x8, w0), __builtin_bit_cast(bf16x8, w1), __builtin_bit_cast(bf16x8, w2), __builtin_bit_cast(bf16x8, w3));
}
__device__ __forceinline__ void accum_branch(const Ctx& c, f32x16* oacc, const f32x16* o, float fac) {
    volatile __attribute__((address_space(3))) float* wsf = (volatile __attribute__((address_space(3))) float*)(c.shm + L_WS + c.w * 512);
    NSA_LWAIT(); if (c.hi == 0) wsf[64 + c.r32] = fac; NSA_LWAIT();
#pragma unroll
    for (int r = 0; r < 16; ++r) { const float f = wsf[64 + crow(r, c.hi)]; oacc[0][r] += o[0][r] * f; oacc[1][r] += o[1][r] * f; }
    NSA_LWAIT();
}
__device__ __forceinline__ void nsa_unit(const P& p, char* smem, int b, int g, int jq) {
    const int tid = TIDX(); Ctx c; c.lane = tid & 63; c.w = __builtin_amdgcn_readfirstlane(tid >> 6); c.r32 = c.lane & 31; c.hi = c.lane >> 5;
    c.shm = (lptr)smem; c.lds0 = (unsigned)(size_t)c.shm;
    const int hh = c.r32 >> 3, tokl = 8 * c.w + (c.r32 & 7), stok = 64 * jq + tokl, h = g * 4 + hh; const size_t t = (size_t)b * S + stok;
    const size_t seg = kvseg(p), ho = (size_t)(b * 2 + g) * S * 64;
    bf16x8 qr[4];
#pragma unroll
    for (int d0 = 0; d0 < 4; ++d0) qr[d0] = *(const bf16x8*)(p.q + t * 512 + h * 64 + d0 * 16 + c.hi * 8);
    const float g0 = p.gates[t * 24 + h * 3], g1 = p.gates[t * 24 + h * 3 + 1], g2 = p.gates[t * 24 + h * 3 + 2];
    f32x16 oacc[2], o[2], p0, p1; oacc[0] = f32x16{}; oacc[1] = f32x16{};
    __attribute__((address_space(3))) float* impD = (__attribute__((address_space(3))) float*)(c.shm + L_IMPD);
    __attribute__((address_space(3))) float* impC = (__attribute__((address_space(3))) float*)(c.shm + L_IMPC);
    __attribute__((address_space(3))) u64* selm = (__attribute__((address_space(3))) u64*)(c.shm + L_SEL);
    const int nv = stok >= 31 ? (stok - 31) / 16 + 1 : 0;
    const int nct = (4 * jq + 3 + 63) >> 6;
    c.kt = p.kcmp + (size_t)(b * 2 + g) * 256 * 64; c.vt = p.vcmp + (size_t)(b * 2 + g) * 256 * 64;
    float m = M0, l = 0.f;
    if (tid < 64) impC[tid * 68] = 0.f;
    __builtin_amdgcn_s_barrier();
    dma_kv(c, 0, 0);
    for (int ct = 0; ct < nct; ++ct) {
        NSA_WAIT_BAR(); if (ct + 1 < nct) dma_kv(c, ct + 1, (ct + 1) & 1);
        qkt(p0, p1, (lcptr)(c.shm + L_K + (ct & 1) * SLOT), qr, c.r32, c.hi);
#pragma unroll
        for (int r = 0; r < 16; ++r) { const int n = 64 * ct + crow(r, c.hi); p0[r] = n < nv ? p0[r] * LOG2E : NEGM; p1[r] = n + 32 < nv ? p1[r] * LOG2E : NEGM; }
        const float rm = rowmax32(p0, p1); const float mn = fmaxf(m, rm); float sacc = 0.f;
#pragma unroll
        for (int r = 0; r < 16; ++r) sacc += __builtin_amdgcn_exp2f(p0[r] - mn) + __builtin_amdgcn_exp2f(p1[r] - mn);
        l = l * __builtin_amdgcn_exp2f(m - mn) + sacc; m = mn;
    }
    l = xhalf_sum(l); const float il = l > 0.f ? 1.f / l : 0.f;
    o[0] = f32x16{}; o[1] = f32x16{};
    __builtin_amdgcn_s_barrier();
    dma_kv(c, 0, 0);
    for (int ct = 0; ct < nct; ++ct) {
        NSA_WAIT_BAR(); if (ct + 1 < nct) dma_kv(c, ct + 1, (ct + 1) & 1);
        qkt(p0, p1, (lcptr)(c.shm + L_K + (ct & 1) * SLOT), qr, c.r32, c.hi);
#pragma unroll
        for (int r = 0; r < 16; ++r) { const int n = 64 * ct + crow(r, c.hi); p0[r] = n < nv ? __builtin_amdgcn_exp2f(p0[r] * LOG2E - m) * il : 0.f; p1[r] = n + 32 < nv ? __builtin_amdgcn_exp2f(p1[r] * LOG2E - m) * il : 0.f; }
#pragma unroll
        for (int hb = 0; hb < 2; ++hb)
#pragma unroll
            for (int rg = 0; rg < 4; ++rg) {
                const f32x16& pp = hb ? p1 : p0;
                float dsum = pp[4 * rg] + pp[4 * rg + 1] + pp[4 * rg + 2] + 0.5f * pp[4 * rg + 3], csum = 0.5f * pp[4 * rg + 3];
                dsum += __shfl_xor(dsum, 8); dsum += __shfl_xor(dsum, 16); csum += __shfl_xor(csum, 8); csum += __shfl_xor(csum, 16);
                const int j = 16 * ct + 8 * hb + 2 * rg + c.hi;
                if (c.r32 < 8) { impD[tokl * 64 + j] = dsum; impC[tokl * 68 + j + 1] = csum; }
            }
        u32x4 w0, w1, w2, w3;
        w0 = (u32x4){cvtpk(p0[0], p0[1]), cvtpk(p0[2], p0[3]), cvtpk(p0[4], p0[5]), cvtpk(p0[6], p0[7])};
        w1 = (u32x4){cvtpk(p0[8], p0[9]), cvtpk(p0[10], p0[11]), cvtpk(p0[12], p0[13]), cvtpk(p0[14], p0[15])};
        w2 = (u32x4){cvtpk(p1[0], p1[1]), cvtpk(p1[2], p1[3]), cvtpk(p1[4], p1[5]), cvtpk(p1[6], p1[7])};
        w3 = (u32x4){cvtpk(p1[8], p1[9]), cvtpk(p1[10], p1[11]), cvtpk(p1[12], p1[13]), cvtpk(p1[14], p1[15])};
        const int vb = (int)(c.lds0 + L_V + (ct & 1) * SLOT) + ((c.lane >> 4) & 1) * 32 + (c.lane & 3) * 8 + (4 * c.hi + ((c.lane & 15) >> 2)) * 64;
        pv(o, vb, __builtin_bit_cast(bf16x8, w0), __builtin_bit_cast(bf16x8, w1), __builtin_bit_cast(bf16x8, w2), __builtin_bit_cast(bf16x8, w3));
    }
    accum_branch(c, oacc, o, g0);
    NSA_LWAIT(); __builtin_amdgcn_s_barrier();
    {
        const int tk = tid >> 3, part = tid & 7; unsigned mlo = 0u, mhi = 0u;
        for (int jj = 0; jj < 8; ++jj) { const int j = part * 8 + jj; if (j > jq) break;
            const float sj = (j == 0 || j == jq || j == jq - 1) ? 1e4f : impD[tk * 64 + j] + impC[tk * 68 + j]; int rank = 0;
            for (int i = 0; i <= jq; ++i) { const float si = (i == 0 || i == jq || i == jq - 1) ? 1e4f : impD[tk * 64 + i] + impC[tk * 68 + i]; rank += (i != j && (si > sj || (si == sj && i < j))) ? 1 : 0; }
            if (rank < 16) { if (j < 32) mlo |= 1u << j; else mhi |= 1u << (j - 32); } }
        mlo |= __shfl_xor(mlo, 1); mlo |= __shfl_xor(mlo, 2); mlo |= __shfl_xor(mlo, 4); mhi |= __shfl_xor(mhi, 1); mhi |= __shfl_xor(mhi, 2); mhi |= __shfl_xor(mhi, 4);
        if (part == 0) { const u64 mk = (u64)mlo | ((u64)mhi << 32); selm[tk] = mk; p.sel[((size_t)b * S + 64 * jq + tk) * 2 + g] = mk; }
    }
    NSA_LWAIT(); __builtin_amdgcn_s_barrier();
    const u64 mysel = selm[tokl];
    u64 uni = selm[c.lane];
#pragma unroll
    for (int x = 1; x < 64; x <<= 1) { const unsigned lo_ = __shfl_xor((unsigned)uni, x), hi_ = __shfl_xor((unsigned)(uni >> 32), x); uni |= (u64)lo_ | ((u64)hi_ << 32); }
    const unsigned ulo = __builtin_amdgcn_readfirstlane((unsigned)uni), uhi = __builtin_amdgcn_readfirstlane((unsigned)(uni >> 32));
    {
        c.kt = p.kv6 + 2 * seg + ho; c.vt = p.kv6 + 3 * seg + ho;
        u64 rem = (u64)ulo | ((u64)uhi << 32);
        m = M0; l = 0.f; o[0] = f32x16{}; o[1] = f32x16{};
        int j = __builtin_ctzll(rem); rem &= rem - 1; int it = 0;
        __builtin_amdgcn_s_barrier();
        dma_kv(c, j, 0);
        for (;;) {
            const int jn = rem ? __builtin_ctzll(rem) : -1; rem &= rem - 1;
            NSA_WAIT_BAR(); if (jn >= 0) dma_kv(c, jn, (it + 1) & 1);
            qkt(p0, p1, (lcptr)(c.shm + L_K + (it & 1) * SLOT), qr, c.r32, c.hi);
            const bool on = (mysel >> j) & 1ull;
#pragma unroll
            for (int r = 0; r < 16; ++r) { const int kr = crow(r, c.hi); const bool v0 = on && (j < jq || kr <= tokl), v1 = on && (j < jq || kr + 32 <= tokl);
                p0[r] = v0 ? p0[r] * LOG2E : NEGM; p1[r] = v1 ? p1[r] * LOG2E : NEGM; }
            softmax_pv(c, p0, p1, o, m, l, it & 1);
            if (jn < 0) break; j = jn; ++it;
        }
        l = xhalf_sum(l);
        accum_branch(c, oacc, o, g1 / l);
    }
    {
        c.kt = p.kv6 + 4 * seg + ho; c.vt = p.kv6 + 5 * seg + ho;
        const int j0 = jq >= 8 ? jq - 8 : 0;
        m = M0; l = 0.f; o[0] = f32x16{}; o[1] = f32x16{};
        __builtin_amdgcn_s_barrier();
        dma_kv(c, j0, 0);
        for (int j = j0; j <= jq; ++j) {
            const int it = j - j0;
            NSA_WAIT_BAR(); if (j < jq) dma_kv(c, j + 1, (it + 1) & 1);
            qkt(p0, p1, (lcptr)(c.shm + L_K + (it & 1) * SLOT), qr, c.r32, c.hi);
            const bool lowt = (jq >= 8 && j == jq - 8), diag = (j == jq);
#pragma unroll
            for (int r = 0; r < 16; ++r) { const int kr = crow(r, c.hi);
                const bool v0 = diag ? (kr <= tokl) : (lowt ? (kr > tokl) : true), v1 = diag ? (kr + 32 <= tokl) : (lowt ? (kr + 32 > tokl) : true);
                p0[r] = v0 ? p0[r] * LOG2E : NEGM; p1[r] = v1 ? p1[r] * LOG2E : NEGM; }
            softmax_pv(c, p0, p1, o, m, l, it & 1);
        }
        l = xhalf_sum(l);
        accum_branch(c, oacc, o, g2 / l);
    }
    {
        __attribute__((address_space(3))) bf16* stg = (__attribute__((address_space(3))) bf16*)(c.shm + L_OST + c.w * 4096);
#pragma unroll
        for (int r = 0; r < 16; ++r) { const int orow = crow(r, c.hi);
#pragma unroll
            for (int d0 = 0; d0 < 2; ++d0) stg[orow * 64 + d0 * 32 + c.r32] = f2bf(oacc[d0][r]); }
        NSA_LWAIT();
#pragma unroll
        for (int i = 0; i < 4; ++i) { const int row = i * 8 + (c.lane >> 3), ch = c.lane & 7; const u32x4 v = *(const __attribute__((address_space(3))) u32x4*)(stg + row * 64 + ch * 8);
            const int rh = row >> 3, rt = 8 * c.w + (row & 7);
            *(u32x4*)(p.onsa + ((size_t)b * S + 64 * jq + rt) * 512 + (g * 4 + rh) * 64 + ch * 8) = v; }
    }
    NSA_LWAIT(); __builtin_amdgcn_s_barrier();
}
}
__device__ __forceinline__ void phase_nsa(const P& p, char* smem) {
    const int nunits = p.nb * 2 * 64;
    for (int i = blockIdx.x; i < nunits; i += gridDim.x) { const int jq = 63 - i / (p.nb * 2), bg = i % (p.nb * 2); nsa::nsa_unit(p, smem, bg >> 1, bg & 1, jq); }
}

namespace gla {
using nsa::f32x16; using nsa::bf16x8; using nsa::s16x4; using nsa::u32x4; using nsa::lptr; using nsa::lcptr; using nsa::crow; using nsa::cvtpk;
typedef unsigned u32x2 __attribute__((ext_vector_type(2)));
constexpr int L_KI = 0, L_QI = 8192, L_VI = 16384, L_SI = 32768, L_OST = 49152, L_TOT = L_OST + 64 * 132 * 4, L_END = L_TOT + 8 * 64 * 4 + 64 * 4;
__device__ __forceinline__ int koff(int row, int d) { return (d >> 3) * 1024 + row * 16 + (d & 7) * 2; }
__device__ __forceinline__ int voff(int row, int col) { return ((col >> 5) * 4 + (row >> 4)) * 1024 + (row & 15) * 64 + (col & 31) * 2; }
__device__ __forceinline__ bf16x8 trfrag(unsigned img, int ks, int cb, int lane) {
    const int hi = lane >> 5; const unsigned a = img + (cb * 4 + ks) * 1024 + ((lane >> 4) & 1) * 32 + (lane & 3) * 8 + (4 * hi + ((lane & 15) >> 2)) * 64;
    s16x4 lo, hh;
    asm volatile("ds_read_b64_tr_b16 %0,%1" : "=&v"(lo) : "v"(a) : "memory");
    asm volatile("ds_read_b64_tr_b16 %0,%1 offset:512" : "=&v"(hh) : "v"(a) : "memory");
    asm volatile("s_waitcnt lgkmcnt(0)" ::: "memory"); __builtin_amdgcn_sched_barrier(0);
    return (bf16x8){lo[0], lo[1], lo[2], lo[3], hh[0], hh[1], hh[2], hh[3]};
}
template <int GM> __device__ __forceinline__ void chunk_images(const P& p, lptr shm, int b, int h, int c, int tid) {
    const int d = tid & 63, tg = tid >> 6; const size_t t0 = (size_t)b * S + c * 64;
    __attribute__((address_space(3))) float* tot = (__attribute__((address_space(3))) float*)(shm + L_TOT);
    float wa[16];
#pragma unroll
    for (int r = 0; r < 16; ++r) wa[r] = p.w_a2[r * 256 + h * 64 + d];
    const float ba = p.b_a[h * 64 + d];
    float loc[8]; float run = 0.f;
#pragma unroll
    for (int i = 0; i < 8; ++i) { const float* al = p.alow + (t0 + tg * 8 + i) * 16; float z = ba;
#pragma unroll
        for (int r = 0; r < 16; ++r) z += al[r] * wa[r];
        const float ls = fminf(z, 0.f) - log1pf(__expf(-fabsf(z))); run += ls * (1.f / 16.f); loc[i] = run; }
    tot[tg * 64 + d] = run;
#pragma unroll
    for (int k = 0; k < 2; ++k) { const int idx = tid + k * 512, s = idx >> 4, e = (idx & 15) * 8; *(__attribute__((address_space(3))) u32x4*)(shm + L_VI + voff(s, e)) = *(const u32x4*)(p.gv + (t0 + s) * 512 + h * 128 + e); }
    __syncthreads();
    float pre = 0.f, all = 0.f;
#pragma unroll
    for (int g = 0; g < 8; ++g) { const float x = tot[g * 64 + d]; all += x; pre += g < tg ? x : 0.f; }
#pragma unroll
    for (int i = 0; i < 8; ++i) { const int t = tg * 8 + i; const float bb = pre + loc[i]; const float kk = bf2f(p.gk[(t0 + t) * 256 + h * 64 + d]);
        if (GM == 0) { *(__attribute__((address_space(3))) bf16*)(shm + L_KI + voff(t, d)) = f2bf(kk * __expf(all - bb)); }
        else { const float qq = bf2f(p.gq[(t0 + t) * 256 + h * 64 + d]);
            *(__attribute__((address_space(3))) bf16*)(shm + L_KI + koff(t, d)) = f2bf(kk * __expf(-bb)); *(__attribute__((address_space(3))) bf16*)(shm + L_QI + koff(t, d)) = f2bf(qq * __expf(bb)); } }
    if (GM == 0 && tg == 0) p.gdec[((size_t)(b * 4 + h) * 64 + c) * 64 + d] = __expf(all);
    __syncthreads();
}
__device__ __forceinline__ void g1_chunk(const P& p, char* smem, int b, int h, int c) {
    const int tid = TIDX(), lane = tid & 63, w = __builtin_amdgcn_readfirstlane(tid >> 6), r32 = lane & 31, hi = lane >> 5;
    lptr shm = (lptr)smem; const unsigned l0 = (unsigned)(size_t)shm;
    chunk_images<0>(p, shm, b, h, c, tid);
    const int db = w & 1, eb = w >> 1; f32x16 acc = f32x16{};
#pragma unroll
    for (int ks = 0; ks < 4; ++ks) { const bf16x8 a = trfrag(l0 + L_KI, ks, db, lane), bq = trfrag(l0 + L_VI, ks, eb, lane); acc = __builtin_amdgcn_mfma_f32_32x32x16_bf16(a, bq, acc, 0, 0, 0); }
    float* U = p.gst + ((size_t)(b * 4 + h) * 64 + c) * (64 * 128);
#pragma unroll
    for (int r = 0; r < 16; ++r) U[(32 * db + crow(r, hi)) * 128 + 32 * eb + r32] = acc[r];
    __syncthreads();
}
__device__ __forceinline__ void g3_chunk(const P& p, char* smem, int b, int h, int c) {
    const int tid = TIDX(), lane = tid & 63, w = __builtin_amdgcn_readfirstlane(tid >> 6), r32 = lane & 31, hi = lane >> 5;
    lptr shm = (lptr)smem; const unsigned l0 = (unsigned)(size_t)shm; const size_t t0 = (size_t)b * S + c * 64;
    const float* St = p.gst + ((size_t)(b * 4 + h) * 64 + c) * (64 * 128);
    float4 sv[4];
#pragma unroll
    for (int k = 0; k < 4; ++k) sv[k] = *(const float4*)(St + (size_t)(tid + k * 512) * 4);
    chunk_images<1>(p, shm, b, h, c, tid);
#pragma unroll
    for (int k = 0; k < 4; ++k) { const int idx = (tid + k * 512) * 4, dd = idx >> 7, e = idx & 127; u32x2 o; o.x = cvtpk(sv[k].x, sv[k].y); o.y = cvtpk(sv[k].z, sv[k].w);
        *(__attribute__((address_space(3))) u32x2*)(shm + L_SI + voff(dd, e)) = o; }
    __syncthreads();
    const int tb = w & 1, eb = w >> 1, trow = 32 * tb + r32;
    f32x16 p0 = f32x16{}, p1 = f32x16{}, o = f32x16{};
    {
        lcptr kb = (lcptr)(shm + L_KI) + hi * 1024 + r32 * 16; lcptr qb = (lcptr)(shm + L_QI) + hi * 1024 + trow * 16;
#pragma unroll
        for (int d0 = 0; d0 < 4; ++d0) {
            const bf16x8 b0 = *(const __attribute__((address_space(3))) bf16x8*)(kb + d0 * 2048), b1 = *(const __attribute__((address_space(3))) bf16x8*)(kb + d0 * 2048 + 512);
            const bf16x8 qf = *(const __attribute__((address_space(3))) bf16x8*)(qb + d0 * 2048);
            p0 = __builtin_amdgcn_mfma_f32_32x32x16_bf16(b0, qf, p0, 0, 0, 0); p1 = __builtin_amdgcn_mfma_f32_32x32x16_bf16(b1, qf, p1, 0, 0, 0); }
    }
#pragma unroll
    for (int r = 0; r < 16; ++r) { const int s = crow(r, hi); p0[r] = s <= trow ? p0[r] : 0.f; p1[r] = s + 32 <= trow ? p1[r] : 0.f; }
#pragma unroll
    for (int ds = 0; ds < 4; ++ds) {
        const u32x2 a0 = *(const __attribute__((address_space(3))) u32x2*)(shm + L_QI + (2 * ds) * 1024 + trow * 16 + 8 * hi), a1 = *(const __attribute__((address_space(3))) u32x2*)(shm + L_QI + (2 * ds + 1) * 1024 + trow * 16 + 8 * hi);
        const u32x4 aw = {a0.x, a0.y, a1.x, a1.y};
        const bf16x8 bq = trfrag(l0 + L_SI, ds, eb, lane);
        o = __builtin_amdgcn_mfma_f32_32x32x16_bf16(__builtin_bit_cast(bf16x8, aw), bq, o, 0, 0, 0); }
    {
        const u32x4 w0 = {cvtpk(p0[0], p0[1]), cvtpk(p0[2], p0[3]), cvtpk(p0[4], p0[5]), cvtpk(p0[6], p0[7])}, w1 = {cvtpk(p0[8], p0[9]), cvtpk(p0[10], p0[11]), cvtpk(p0[12], p0[13]), cvtpk(p0[14], p0[15])};
        const u32x4 w2 = {cvtpk(p1[0], p1[1]), cvtpk(p1[2], p1[3]), cvtpk(p1[4], p1[5]), cvtpk(p1[6], p1[7])}, w3 = {cvtpk(p1[8], p1[9]), cvtpk(p1[10], p1[11]), cvtpk(p1[12], p1[13]), cvtpk(p1[14], p1[15])};
        o = __builtin_amdgcn_mfma_f32_32x32x16_bf16(__builtin_bit_cast(bf16x8, w0), trfrag(l0 + L_VI, 0, eb, lane), o, 0, 0, 0);
        o = __builtin_amdgcn_mfma_f32_32x32x16_bf16(__builtin_bit_cast(bf16x8, w1), trfrag(l0 + L_VI, 1, eb, lane), o, 0, 0, 0);
        o = __builtin_amdgcn_mfma_f32_32x32x16_bf16(__builtin_bit_cast(bf16x8, w2), trfrag(l0 + L_VI, 2, eb, lane), o, 0, 0, 0);
        o = __builtin_amdgcn_mfma_f32_32x32x16_bf16(__builtin_bit_cast(bf16x8, w3), trfrag(l0 + L_VI, 3, eb, lane), o, 0, 0, 0);
    }
    __attribute__((address_space(3))) float* ost = (__attribute__((address_space(3))) float*)(shm + L_OST);
#pragma unroll
    for (int r = 0; r < 16; ++r) ost[(32 * tb + crow(r, hi)) * 132 + 32 * eb + r32] = o[r];
    __syncthreads();
    { const int t = tid >> 3, part = tid & 7; float v[16]; float ss = 0.f;
#pragma unroll
        for (int k = 0; k < 4; ++k) { const f32x4_t x = *(const __attribute__((address_space(3))) f32x4_t*)(ost + t * 132 + part * 16 + k * 4); v[4 * k] = x[0]; v[4 * k + 1] = x[1]; v[4 * k + 2] = x[2]; v[4 * k + 3] = x[3]; ss += x[0] * x[0] + x[1] * x[1] + x[2] * x[2] + x[3] * x[3]; }
        ss += __shfl_xor(ss, 1); ss += __shfl_xor(ss, 2); ss += __shfl_xor(ss, 4);
        const float rstd = rsqrtf(ss * (1.f / 128.f) + 1e-6f);
        const size_t go = (t0 + t) * 512 + h * 128 + part * 16;
        const uint4 r0 = *(const uint4*)(p.rs + go), r1 = *(const uint4*)(p.rs + go + 8); const unsigned rw[8] = {r0.x, r0.y, r0.z, r0.w, r1.x, r1.y, r1.z, r1.w};
        unsigned ow[8];
#pragma unroll
        for (int k = 0; k < 8; ++k) { const float ga = p.norm_g[h * 128 + part * 16 + 2 * k], gb = p.norm_g[h * 128 + part * 16 + 2 * k + 1];
            ow[k] = pk2(v[2 * k] * rstd * ga * __uint_as_float(rw[k] << 16), v[2 * k + 1] * rstd * gb * __uint_as_float(rw[k] & 0xffff0000u)); }
        *(uint4*)(p.gla + go) = make_uint4(ow[0], ow[1], ow[2], ow[3]); *(uint4*)(p.gla + go + 8) = make_uint4(ow[4], ow[5], ow[6], ow[7]); }
    __syncthreads();
}
}
__device__ __forceinline__ void phase_gla1(const P& p, char* smem) {
    const int n = p.nb * 4 * 64;
    for (int i = blockIdx.x; i < n; i += gridDim.x) gla::g1_chunk(p, smem, i >> 8, (i >> 6) & 3, i & 63);
}
__device__ __forceinline__ void phase_gla2(const P& p) {
    const int n = p.nb * 4 * 8192;
    for (int idx = blockIdx.x * NT + TIDX(); idx < n; idx += gridDim.x * NT) {
        const int bh = idx >> 13, de = idx & 8191, d = de >> 7; float* U = p.gst + (size_t)bh * 64 * 8192 + de; const float* gd = p.gdec + (size_t)bh * 64 * 64 + d;
        float s = 0.f;
        for (int c0 = 0; c0 < 64; c0 += 8) { float tmp[8], g[8];
#pragma unroll
            for (int k = 0; k < 8; ++k) { tmp[k] = U[(size_t)(c0 + k) * 8192]; g[k] = gd[(c0 + k) * 64]; }
#pragma unroll
            for (int k = 0; k < 8; ++k) { U[(size_t)(c0 + k) * 8192] = s; s = g[k] * s + tmp[k]; } }
    }
}
__device__ __forceinline__ void phase_gla3(const P& p, char* smem) {
    const int n = p.nb * 4 * 64;
    for (int i = blockIdx.x; i < n; i += gridDim.x) gla::g3_chunk(p, smem, i >> 8, (i >> 6) & 3, i & 63);
}

struct CmpSched {
    const char* kc; const char* Wc1; float* Pc; int nM, G, c; size_t aseg, pseg;
    __device__ __forceinline__ bool next(int i, pg8::Unit& u) const {
        const int L = i * G + c, per = nM * 2 * 2; if (L >= 2 * per) return false;
        const int kv = L / per, r = L % per, ks = r & 1, pn = (r >> 1) & 1, pm = r >> 2;
        u.pm = pm; u.pn = pn; u.tag = kv * 2 + ks;
        u.A = kc + (size_t)kv * aseg + (size_t)pm * 256 * 1024 * 2 + ks * 512 * 2; u.B = Wc1 + ((size_t)kv * 512 + pn * 256) * 1024 * 2 + ks * 512 * 2; return true;
    }
    __device__ __forceinline__ unsigned arow(const pg8::Unit&, int r) const { return (unsigned)r * 2048u; }
};
struct EpiCmp {
    static constexpr bool PERM = false;
    float* Pc; size_t pseg;
    __device__ __forceinline__ void operator()(const pg8::f32x4 (&acc)[2][2][4][2], const pg8::Unit& u, int wr, int wc, int fr, int fq) const {
        float* base = Pc + (size_t)u.tag * pseg; const int col0 = u.pn * 256 + wc * 32 + 4 * fq;
#pragma unroll
        for (int ai = 0; ai < 2; ++ai)
#pragma unroll
            for (int m = 0; m < 4; ++m) { float* rowp = base + (size_t)(u.pm * 256 + ai * 128 + wr * 64 + m * 16 + fr) * 512 + col0;
#pragma unroll
                for (int bj = 0; bj < 2; ++bj)
#pragma unroll
                    for (int n = 0; n < 2; ++n) *(pg8::f32x4*)(rowp + bj * 128 + n * 16) = acc[ai][bj][m][n]; }
    }
};
__device__ __forceinline__ void phase_cmp1(const P& p, char* smem) {
    const int nrows = p.nb * 2 * 256;
    CmpSched Sc{(const char*)p.kv6, (const char*)p.Wc1, p.pcmp, nrows / 256, (int)gridDim.x, (int)blockIdx.x, kvseg(p) * 2, (size_t)(nrows + 8) * 512};
    EpiCmp E{p.pcmp, (size_t)(nrows + 8) * 512};
    pg8::gemm_phase<EpiCmp, CmpSched, true, false>((PG8_LAS unsigned char*)smem, 512, 1024, 1024, Sc, E);
}
__device__ __forceinline__ void body_cmp2f(const P& p, int vb, char* smem) {
    const int tid = TIDX(); const int nrows = p.nb * 2 * 256, nvb1 = nrows / 16; const int kv = vb / nvb1, row0 = (vb % nvb1) * 16;
    const size_t pseg = (size_t)(nrows + 8) * 512; const float* P0 = p.pcmp + (size_t)(kv * 2) * pseg; const float* P1 = P0 + pseg;
    float* hs = (float*)smem;
    float* w2s = (float*)smem + 16 * 256;
    __syncthreads();
    { const float4* wsrc = (const float4*)(kv ? p.cw2_v : p.cw2_k);
#pragma unroll
      for (int k = 0; k < 8; ++k) ((float4*)w2s)[tid + k * 512] = wsrc[tid + k * 512]; }
#pragma unroll
    for (int k = 0; k < 8; ++k) { const int idx = tid + k * 512, rr = idx >> 8, n = idx & 255; const size_t m = (size_t)(row0 + rr);
        const float z = P0[m * 512 + n] + P1[m * 512 + n] + P0[(m + 1) * 512 + 256 + n] + P1[(m + 1) * 512 + 256 + n] + p.b1p[kv * 256 + n];
        hs[idx] = geluf_(z); }
    __syncthreads();
    const int rr = tid >> 5, i = tid & 31, row = row0 + rr;
    const float* h = hs + rr * 256; const float* b2 = kv ? p.cb2_v : p.cb2_k;
    float z1 = b2[i], z2 = b2[i + 32];
#pragma unroll 8
    for (int n = 0; n < 256; ++n) { const float hv = h[n]; z1 += hv * w2s[n * 64 + i]; z2 += hv * w2s[n * 64 + i + 32]; }
    bf16* dst = (kv ? p.vcmp : p.kcmp) + (size_t)row * 64;
    if (kv == 0) {
        const int bg = row >> 8, m = row & 255, b = bg >> 1; int sp = 16 * m + 31; if (sp > S - 1) sp = S - 1;
        const size_t t = (size_t)b * S + sp; const float c = p.cs[t * 64 + i], sn = p.cs[t * 64 + 32 + i];
        const float r1 = z1 * c - z2 * sn, r2 = z2 * c + z1 * sn; z1 = r1; z2 = r2;
    }
    dst[i] = f2bf(z1); dst[i + 32] = f2bf(z2);
}
__device__ __forceinline__ void phase_cmp2(const P& p, char* smem) {
    const int n = 2 * (p.nb * 2 * 256) / 16;
    for (int vb = blockIdx.x; vb < n; vb += gridDim.x) body_cmp2f(p, vb, smem);
}
__device__ __forceinline__ void prep_b1p(const P& p, char* smem) {
    if (blockIdx.x >= 2) return;
    const int tid = TIDX(), kv = blockIdx.x, n = tid & 255, half = tid >> 8;
    const float* pe = kv ? p.cpos_v : p.cpos_k; const float* w1 = kv ? p.cw1_v : p.cw1_k; const float* b1 = kv ? p.cb1_v : p.cb1_k;
    float a = 0.f;
    for (int f = half * 1024; f < half * 1024 + 1024; ++f) a += pe[f] * w1[(size_t)f * 256 + n];
    float* sc = (float*)(smem + LDS_MISC);
    __syncthreads();
    if (half == 1) sc[n] = a;
    __syncthreads();
    if (half == 0) p.b1p[kv * 256 + n] = a + sc[n] + b1[n];
    __syncthreads();
}

#define XB_TMO      128
#define XB_XCNT(j)  (256  + 64 * (j))
#define XB_XSUB(j)  (1280 + 64 * (j))
#define XB_XGEN(j)  (2304 + 64 * (j))
#define XB_TOP      3328
#define XB_TOPGEN   3392
#define XCD_BAR_WORDS 3456
#define XB_SPIN_CAP (1u << 18)
#define XLAS __attribute__((address_space(3)))
__device__ __forceinline__ unsigned xb_ld(unsigned* p)              { return __hip_atomic_load(p, __ATOMIC_RELAXED, __HIP_MEMORY_SCOPE_AGENT); }
__device__ __forceinline__ unsigned xb_add(unsigned* p, unsigned v) { return __hip_atomic_fetch_add(p, v, __ATOMIC_RELAXED, __HIP_MEMORY_SCOPE_AGENT); }
__device__ __forceinline__ unsigned xb_xcc_id() { return (unsigned)__builtin_amdgcn_s_getreg((3 << 11) | 20) & 0xFu; }
#define XB_SPIN(cond, bar) do { unsigned _sp = 0; while (cond) { __builtin_amdgcn_s_sleep(1); \
    if ((++_sp & 255u) == 0u) { if (xb_ld(&(bar)[XB_TMO])) break; if (_sp > XB_SPIN_CAP) { atomicAdd(&(bar)[XB_TMO], 1u); break; } } } } while (0)
struct XcdBarrier { unsigned* bar; unsigned x; volatile XLAS unsigned* st; };
__device__ __forceinline__ XcdBarrier xcd_barrier_post(unsigned* bar, volatile XLAS unsigned* st) {
    XcdBarrier b; b.bar = bar; b.x = xb_xcc_id(); b.st = st;
    if (TIDX() == 0) (void)xb_add(&bar[XB_XCNT(b.x)], 1u);
    return b;
}
__device__ __forceinline__ void xcd_barrier_complete(unsigned* bar, unsigned x, unsigned& nloc, unsigned& nx) {
    const unsigned G = gridDim.x * gridDim.y * gridDim.z;
    unsigned sum, cnt, mine, sp = 0u;
    for (;;) {
        sum = 0u; cnt = 0u; mine = 0u;
#pragma unroll
        for (unsigned j = 0; j < 16; ++j) { const unsigned c = xb_ld(&bar[XB_XCNT(j)]); sum += c; cnt += (c > 0u) ? 1u : 0u; mine = (j == x) ? c : mine; }
        if (sum == G) break;
        __builtin_amdgcn_s_sleep(1);
        if ((++sp & 255u) == 0u) { if (xb_ld(&bar[XB_TMO])) break; if (sp > XB_SPIN_CAP) { atomicAdd(&bar[XB_TMO], 1u); break; } }
    }
    nloc = mine > 0u ? mine : 1u; nx = cnt > 0u ? cnt : 1u;
}
__device__ __forceinline__ void xcd_barrier(const XcdBarrier& b) {
    asm volatile("s_waitcnt vmcnt(0)" ::: "memory");
    __syncthreads();
    if (TIDX() == 0) {
        unsigned* bar = b.bar;
        __builtin_amdgcn_s_waitcnt(0);
        unsigned nloc = b.st[0], nx = b.st[1];
        if (nloc == 0u) { xcd_barrier_complete(bar, b.x, nloc, nx); b.st[0] = nloc; b.st[1] = nx; }
        const unsigned old = xb_add(&bar[XB_XSUB(b.x)], 1u);
        const unsigned gen = old / nloc;
        if (old + 1u == (gen + 1u) * nloc) {
            __builtin_amdgcn_fence(__ATOMIC_RELEASE, "agent");
            asm volatile("s_waitcnt vmcnt(0)" ::: "memory");
            const unsigned og = xb_add(&bar[XB_TOP], 1u);
            const unsigned tg = og / nx;
            if (og + 1u == (tg + 1u) * nx) xb_add(&bar[XB_TOPGEN], 1u);
            else XB_SPIN(xb_ld(&bar[XB_TOPGEN]) == tg, bar);
            __builtin_amdgcn_fence(__ATOMIC_ACQUIRE, "agent");
            xb_add(&bar[XB_XGEN(b.x)], 1u);
            asm volatile("s_waitcnt vmcnt(0)" ::: "memory");
        } else {
            XB_SPIN(xb_ld(&bar[XB_XGEN(b.x)]) == gen, bar);
            __builtin_amdgcn_fence(__ATOMIC_ACQUIRE, "agent");
            asm volatile("s_waitcnt vmcnt(0)" ::: "memory");
        }
    }
    __syncthreads();
}

template <int ST> __device__ __forceinline__ void run_stage(const P& p, char* smem, int first, int stride) {
    const int nvb = stage_nvb(ST, p.T);
    for (int vb = first; vb < nvb; vb += stride) {
        if constexpr (ST == ST_RMS) body_rms(p, vb);
        else if constexpr (ST == ST_CS) body_cs(p, vb);
        else if constexpr (ST == ST_INPROJ) body_inproj(p, vb, smem);
        else if constexpr (ST == ST_CMP1) body_cmp1(p, vb, smem);
        else if constexpr (ST == ST_CMP2) body_cmp2(p, vb);
        else if constexpr (ST == ST_NSACMP) body_nsacmp(p, vb, smem);
        else if constexpr (ST == ST_NSAATT) body_nsaatt(p, vb);
        else if constexpr (ST == ST_GLAA) body_glaa(p, vb);
        else if constexpr (ST == ST_GLASCAN) body_glascan(p, vb, smem);
        else if constexpr (ST == ST_GLANORM) body_glanorm(p, vb);
        else if constexpr (ST == ST_PROJ) body_proj(p, vb, smem);
        else if constexpr (ST == ST_OUT) body_out(p, vb, smem);
        else if constexpr (ST == ST_ROUTE) body_route(p, vb, smem);
        else if constexpr (ST == ST_MOE1) body_moe1(p, vb, smem);
        else if constexpr (ST == ST_MOE2) body_moe2(p, vb, smem);
        else if constexpr (ST == ST_FINAL) body_final(p, vb, smem);
    }
}
template <int ST> __global__ void __launch_bounds__(NT) k_stage(P p) {
    extern __shared__ __attribute__((aligned(16))) char smem[];
    run_stage<ST>(p, smem, blockIdx.x, gridDim.x);
}
__global__ void __launch_bounds__(NT) k_mega(P p) {
    extern __shared__ __attribute__((aligned(16))) char smem[];
    cg::grid_group grid = cg::this_grid();
    const int b0 = blockIdx.x, G = gridDim.x;
    volatile XLAS unsigned* xst = (volatile XLAS unsigned*)((XLAS char*)smem + LDS_MISC + 3072);
    if (TIDX() < 4) xst[TIDX()] = 0u;
    __syncthreads();
    const XcdBarrier xb = xcd_barrier_post(p.ctl + 4096, xst);
#define GSYNC() xcd_barrier(xb)
#define DUPRUN(k, stmt) do { if (DUP == (k)) { stmt; GSYNC(); } } while (0)
    phase_prep(p, smem); grid.sync();
    phase_inA(p, smem); GSYNC();                               DUPRUN(7, phase_inA(p, smem));
    phase_cmp1(p, smem); phase_gla1(p, smem); GSYNC();         DUPRUN(8, phase_cmp1(p, smem)); DUPRUN(4, phase_gla1(p, smem));
    phase_cmp2(p, smem); phase_gla2(p); GSYNC();               DUPRUN(9, phase_cmp2(p, smem));
    phase_nsa(p, smem); phase_gla3(p, smem); GSYNC();          DUPRUN(1, phase_nsa(p, smem)); DUPRUN(2, phase_gla3(p, smem));
    phase_inB(p, smem); GSYNC();                               DUPRUN(11, phase_inB(p, smem));
    phase_proj(p, smem); GSYNC();                              DUPRUN(12, phase_proj(p, smem));
    phase_out(p, smem); GSYNC();                               DUPRUN(13, phase_out(p, smem));
    if (DUP == 17) { P p2 = p; p2.ctl = p.ctl + 8192; p2.vb = p.sa; p2.list = (int*)p.mixed; p2.tokslot = (int*)p.mixed + (1 << 20); p2.tokexp = (int*)p.mixed + (2 << 20); p2.tokw = (float*)p.mixed + (3 << 20);
        for (int vb = b0; vb < p.T / 64; vb += G) body_route3(p2, vb, smem);
        GSYNC(); }
    for (int vb = b0; vb < p.T / 64; vb += G) body_route3(p, vb, smem);
    GSYNC();
    phase_moe1(p, smem); GSYNC();                              DUPRUN(6, phase_moe1(p, smem));
    phase_moe2(p, smem); GSYNC();                              DUPRUN(14, phase_moe2(p, smem));
    if (DUP == 15) { GSYNC(); GSYNC(); GSYNC(); GSYNC(); GSYNC(); GSYNC(); GSYNC(); GSYNC(); GSYNC(); GSYNC(); }
    if (DUP == 16) { P p2 = p; p2.out = (float*)p.sb; run_stage<ST_FINAL>(p2, smem, b0, G); GSYNC(); }
    run_stage<ST_FINAL>(p, smem, b0, G);
#undef DUPRUN
#undef GSYNC
}

enum Phase { PH_PREP = 0, PH_INA, PH_INB, PH_PROJ, PH_OUT, PH_MOE1, PH_MOE2, PH_NSA, PH_GLA1, PH_GLA2, PH_GLA3, PH_CMP1, PH_CMP2 };
template <int PH> __global__ void __launch_bounds__(NT) k_phase(P p) {
    extern __shared__ __attribute__((aligned(16))) char smem[];
    if constexpr (PH == PH_PREP) phase_prep(p, smem);
    else if constexpr (PH == PH_INA) phase_inA(p, smem);
    else if constexpr (PH == PH_INB) phase_inB(p, smem);
    else if constexpr (PH == PH_PROJ) phase_proj(p, smem);
    else if constexpr (PH == PH_OUT) phase_out(p, smem);
    else if constexpr (PH == PH_MOE1) phase_moe1(p, smem);
    else if constexpr (PH == PH_MOE2) phase_moe2(p, smem);
    else if constexpr (PH == PH_NSA) phase_nsa(p, smem);
    else if constexpr (PH == PH_GLA1) phase_gla1(p, smem);
    else if constexpr (PH == PH_GLA2) phase_gla2(p);
    else if constexpr (PH == PH_GLA3) phase_gla3(p, smem);
    else if constexpr (PH == PH_CMP1) phase_cmp1(p, smem);
    else if constexpr (PH == PH_CMP2) phase_cmp2(p, smem);
}
template <class TT> __device__ __forceinline__ float ldf(const TT* p, size_t i);
template <> __device__ __forceinline__ float ldf<bf16>(const bf16* p, size_t i) { return bf2f(p[i]); }
template <> __device__ __forceinline__ float ldf<float>(const float* p, size_t i) { return p[i]; }
template <class TT> __global__ void __launch_bounds__(256) k_compare(const TT* a, const TT* b, size_t n, float* err, int slot) {
    float num = 0.f, den = 0.f;
    for (size_t i = (size_t)blockIdx.x * 256 + TIDX(); i < n; i += (size_t)gridDim.x * 256) { const float x = ldf<TT>(a, i), y = ldf<TT>(b, i); const float d = x - y; num += (d == d) ? d * d : 1e30f; den += y * y; }
#pragma unroll
    for (int o = 1; o < 64; o <<= 1) { num += __shfl_xor(num, o); den += __shfl_xor(den, o); }
    if ((TIDX() & 63) == 0) { atomicAdd(err + 2 * slot, num); atomicAdd(err + 2 * slot + 1, den); }
}
__global__ void __launch_bounds__(256) k_compare_sel(const u64* a, const u64* b, size_t n, float* err, int slot) {
    float num = 0.f, den = 0.f;
    for (size_t i = (size_t)blockIdx.x * 256 + threadIdx.x; i < n; i += (size_t)gridDim.x * 256) { num += (a[i] != b[i]) ? 1.f : 0.f; den += 100.f; }
#pragma unroll
    for (int o = 1; o < 64; o <<= 1) { num += __shfl_xor(num, o); den += __shfl_xor(den, o); }
    if ((threadIdx.x & 63) == 0) { atomicAdd(err + 2 * slot, num); atomicAdd(err + 2 * slot + 1, den); }
}
__global__ void __launch_bounds__(256) k_report(float* out, size_t n, const float* err, int nslots, float tol) {
    int code = 0;
    for (int s = 0; s < nslots; ++s) { const float num = err[2 * s], den = err[2 * s + 1]; const bool bad = !(num <= tol * tol * den) || !(den > 0.f); if (bad) { code = s + 1; break; } }
    if (code == 0) return;
    const float f = 1.f + 0.1f * (float)code;
    for (size_t i = (size_t)blockIdx.x * 256 + TIDX(); i < n; i += (size_t)gridDim.x * 256) out[i] *= f;
}

static void set_inputs(P& p, void* const* d_in) {
    const float* const* in = (const float* const*)d_in;
    p.x = in[0]; p.pos = (const int*)d_in[1]; p.g_mix = in[2]; p.w_in = in[3];
    p.cpos_k = in[4]; p.cw1_k = in[5]; p.cb1_k = in[6]; p.cw2_k = in[7]; p.cb2_k = in[8];
    p.cpos_v = in[9]; p.cw1_v = in[10]; p.cb1_v = in[11]; p.cw2_v = in[12]; p.cb2_v = in[13];
    p.w_a2 = in[14]; p.b_a = in[15]; p.norm_g = in[16]; p.w_pn = in[17]; p.w_pg = in[18]; p.w_out = in[19];
    p.g_ffn = in[20]; p.w_grp = in[21]; p.b_grp = in[22]; p.w_exp = in[23]; p.b_exp = in[24]; p.w_gate = in[25]; p.w_up = in[26]; p.w_down = in[27]; p.g_final = in[28];
}
constexpr size_t MiB = 1u << 20;
static void layout_ref(P& p, char* small, char* act, char* scratch, float* out, int nb) {
    const size_t q = (MiB / 4) * nb;
    p.nb = nb; p.T = nb * S; p.out = out;
    p.ctl = (unsigned*)small; p.sel = (u64*)(small + q / 16 * 1); p.kcmp = (bf16*)(small + q / 2); p.vcmp = (bf16*)(small + q / 4 * 3);
    p.tokslot = (int*)(small + q); p.tokexp = (int*)(small + q + q / 8); p.tokw = (float*)(small + q + q / 4);
    p.alow = (float*)(small + 2 * q); p.gates = (float*)(small + 3 * q); p.cs = (float*)(small + 5 * q); p.hcmp = (float*)(small + 9 * q); p.list = (int*)(small + 13 * q);
    p.u = (bf16*)act; p.ocmp = (float*)act; p.mixed = (bf16*)act; p.vb = (bf16*)act;
    p.q = (bf16*)(act + 32 * q); p.kv6 = (bf16*)(act + 48 * q);
    p.gq = (bf16*)(act + 73 * q); p.gk = (bf16*)(act + 81 * q); p.gv = (bf16*)(act + 89 * q); p.rs = (bf16*)(act + 105 * q);
    p.H = (bf16*)(act + 32 * q);
    p.sa = (bf16*)(act + 123 * q); p.sb = (bf16*)(act + 155 * q); p.onsa = (bf16*)(act + 187 * q); p.gla = (bf16*)(act + 203 * q);
    p.Y = (bf16*)(act + 123 * q);
    p.ga = (float*)scratch; p.oraw = (float*)(scratch + 16 * q); p.h1 = (float*)(scratch + 48 * q);
    p.gst = (float*)(scratch + 16 * q); p.gdec = (float*)(small + 15 * q);
}
static void layout_compact(P& p, char* ws, float* out) {
    p.nb = NB; p.T = NB * S; p.out = out;
    char* small = ws; const size_t q = MiB;
    p.ctl = (unsigned*)small; p.sel = (u64*)(small + q / 16 * 1); p.kcmp = (bf16*)(small + q / 2); p.vcmp = (bf16*)(small + q / 4 * 3);
    p.tokslot = (int*)(small + q); p.tokexp = (int*)(small + q + q / 8); p.tokw = (float*)(small + q + q / 4);
    p.alow = (float*)(small + 2 * q); p.gates = (float*)(small + 3 * q); p.cs = (float*)(small + 5 * q); p.hcmp = (float*)(small + 9 * q); p.list = (int*)(small + 13 * q);
    p.u = (bf16*)(ws + 128 * MiB); p.vb = (bf16*)(ws + 128 * MiB);
    p.q = (bf16*)(ws + 160 * MiB); p.kv6 = (bf16*)(ws + 176 * MiB); p.gq = (bf16*)(ws + 201 * MiB); p.gk = (bf16*)(ws + 209 * MiB); p.gv = (bf16*)(ws + 217 * MiB); p.rs = (bf16*)(ws + 233 * MiB);
    p.ga = (float*)(ws + 249 * MiB); p.ocmp = (float*)(ws + 249 * MiB);
    p.sa = (bf16*)(ws + 160 * MiB); p.sb = (bf16*)(ws + 192 * MiB); p.mixed = (bf16*)(ws + 224 * MiB);
    p.H = (bf16*)(ws + 160 * MiB); p.Y = (bf16*)(ws + 48 * MiB);
    p.onsa = (bf16*)out; p.gla = (bf16*)((char*)out + 16 * MiB); p.oraw = (float*)((char*)out + 32 * MiB); p.h1 = out;
    p.gst = (float*)((char*)out + 32 * MiB); p.gdec = (float*)(small + 15 * q); p.pcmp = (float*)(ws + 249 * MiB);
}
static void layout_weights(P& p, char* w) {
    p.wr = (float*)(w - 256 * 1024); p.b1p = (float*)(w - 64 * 1024);
    p.Wd = (bf16*)w; p.Wgu = (bf16*)(w + 32 * MiB); p.Wt_in = (bf16*)(w + 96 * MiB); p.Wc1 = (bf16*)(w + 106 * MiB);
    p.Wpn = (bf16*)(w + 108 * MiB); p.Wpg = (bf16*)(w + 109 * MiB); p.Wo = (bf16*)(w + 110 * MiB);
}

template <int ST> static void launch_stage(const P& p, hipStream_t stream) {
    static bool attr = false;
    if (!attr) { (void)hipFuncSetAttribute((const void*)k_stage<ST>, hipFuncAttributeMaxDynamicSharedMemorySize, LDS_BYTES); attr = true; }
    int nvb = stage_nvb(ST, p.T); if (nvb > 16384) nvb = 16384;
    hipLaunchKernelGGL(k_stage<ST>, dim3(nvb), dim3(NT), LDS_BYTES, stream, p);
}
template <int PH> static void launch_phase(const P& p, hipStream_t stream, int grid = 40) {
    static bool attr = false;
    if (!attr) { (void)hipFuncSetAttribute((const void*)k_phase<PH>, hipFuncAttributeMaxDynamicSharedMemorySize, LDS_BYTES); attr = true; }
    hipLaunchKernelGGL(k_phase<PH>, dim3(grid), dim3(NT), LDS_BYTES, stream, p);
}
template <class TT> static void compare(const TT* a, const TT* b, size_t n, float* err, int slot, hipStream_t stream) {
    hipLaunchKernelGGL(k_compare<TT>, dim3(1024), dim3(256), 0, stream, a, b, n, err, slot);
}
static void launch_mega(const P& p, hipStream_t stream) {
    static int grid = 0;
    if (!grid) {
        int dev = 0, cus = 0, per_cu = 0;
        (void)hipGetDevice(&dev); (void)hipDeviceGetAttribute(&cus, hipDeviceAttributeMultiprocessorCount, dev);
        (void)hipFuncSetAttribute((const void*)k_mega, hipFuncAttributeMaxDynamicSharedMemorySize, LDS_BYTES);
        (void)hipOccupancyMaxActiveBlocksPerMultiprocessor(&per_cu, (const void*)k_mega, NT, LDS_BYTES);
        if (per_cu < 1) per_cu = 1;
        grid = cus * per_cu;
    }
    (void)hipMemsetAsync((void*)p.ctl, 0, 64 * 1024, stream);
    P pp = p; void* args[] = {(void*)&pp};
    (void)hipLaunchCooperativeKernel((const void*)k_mega, dim3(grid), dim3(NT), args, LDS_BYTES, stream);
}

extern "C" void kernel_launch(void* const* d_in, const int* in_sizes, int n_in, void* d_out, int out_size, void* d_ws, size_t ws_size, hipStream_t stream) {
    char* ws = (char*)d_ws;
    P p{}; set_inputs(p, d_in); layout_ref(p, ws, ws + 16 * MiB, (char*)d_out, (float*)d_out, NB); p.h1 = (float*)d_out;
#if MODE == 0
    (void)hipMemsetAsync(d_ws, 0, 4096, stream);
    launch_stage<ST_RMS>(p, stream); launch_stage<ST_CS>(p, stream); launch_stage<ST_INPROJ>(p, stream);
    launch_stage<ST_CMP1>(p, stream); launch_stage<ST_CMP2>(p, stream); launch_stage<ST_NSACMP>(p, stream); launch_stage<ST_NSAATT>(p, stream);
    launch_stage<ST_GLAA>(p, stream); launch_stage<ST_GLASCAN>(p, stream); launch_stage<ST_GLANORM>(p, stream);
    launch_stage<ST_PROJ>(p, stream); launch_stage<ST_OUT>(p, stream); launch_stage<ST_ROUTE>(p, stream);
    launch_stage<ST_MOE1>(p, stream); launch_stage<ST_MOE2>(p, stream); launch_stage<ST_FINAL>(p, stream);
#elif MODE == 1
    { P c{}; set_inputs(c, d_in); layout_weights(c, ws + 16 * MiB); layout_compact(c, ws, (float*)d_out); launch_mega(c, stream); }
#else
    { P c{}; set_inputs(c, d_in); layout_weights(c, ws + 16 * MiB); layout_compact(c, ws, (float*)d_out); launch_mega(c, stream); }
    P r{}; set_inputs(r, d_in); layout_weights(r, ws + 16 * MiB);
    layout_ref(r, ws + 128 * MiB, ws + 132 * MiB, ws + 200 * MiB, (float*)(ws + 200 * MiB + 12 * MiB), 1);
    char* alt = ws + 228 * MiB; float* err = (float*)(ws + 128 * MiB + 32768);
    (void)hipMemsetAsync(ws + 128 * MiB, 0, 65536, stream);
    int slot = 0; const size_t T1 = S; const size_t ROWS1 = 2 * T1 + NEXP * 256;
    launch_stage<ST_RMS>(r, stream); launch_stage<ST_CS>(r, stream); launch_stage<ST_INPROJ>(r, stream);
    P f = r; { char* a = alt;
        f.u = (bf16*)a; a += T1 * 1024 * 2; f.cs = (float*)a; a += T1 * 64 * 4; f.q = (bf16*)a; a += T1 * 512 * 2; f.kv6 = (bf16*)a; a += 6 * (size_t)2 * S * 64 * 2 + 4096;
        f.gates = (float*)a; a += T1 * 24 * 4; f.gq = (bf16*)a; a += T1 * 256 * 2; f.gk = (bf16*)a; a += T1 * 256 * 2; f.gv = (bf16*)a; a += T1 * 512 * 2; f.alow = (float*)a; a += T1 * 16 * 4;
        f.rs = (bf16*)a; a += T1 * 512 * 2; f.sa = (bf16*)a; a += T1 * 1024 * 2; f.sb = (bf16*)a; a += T1 * 1024 * 2; }
    launch_phase<PH_PREP>(f, stream); launch_phase<PH_INA>(f, stream); launch_phase<PH_INB>(f, stream);
    compare<bf16>(f.q, r.q, T1 * 512, err, slot++, stream);
    compare<bf16>(f.kv6, r.kv6, 6 * (size_t)2 * S * 64, err, slot++, stream);
    compare<bf16>(f.sb, r.sb, T1 * 1024, err, slot++, stream);
    launch_stage<ST_CMP1>(r, stream); launch_stage<ST_CMP2>(r, stream);
    f = r; f.pcmp = (float*)alt; f.kcmp = (bf16*)(alt + 20 * MiB); f.vcmp = (bf16*)(alt + 21 * MiB); launch_phase<PH_CMP1>(f, stream); launch_phase<PH_CMP2>(f, stream);
    compare<bf16>(f.kcmp, r.kcmp, (size_t)2 * 255 * 64, err, slot++, stream); compare<bf16>(f.vcmp + 256 * 64, r.vcmp + 256 * 64, (size_t)255 * 64, err, slot++, stream);
    launch_stage<ST_NSACMP>(r, stream); launch_stage<ST_NSAATT>(r, stream);
    f = r; f.onsa = (bf16*)alt; f.sel = (u64*)(alt + 8 * MiB); launch_phase<PH_NSA>(f, stream);
    hipLaunchKernelGGL(k_compare_sel, dim3(64), dim3(256), 0, stream, (const u64*)f.sel, (const u64*)r.sel, T1 * 2, err, slot++);
    compare<bf16>(f.onsa, r.onsa, T1 * 512, err, slot++, stream);
    launch_stage<ST_GLAA>(r, stream); launch_stage<ST_GLASCAN>(r, stream); launch_stage<ST_GLANORM>(r, stream);
    f = r; f.gla = (bf16*)alt; f.gst = (float*)(alt + 8 * MiB); f.gdec = (float*)(alt + 18 * MiB); launch_phase<PH_GLA1>(f, stream); launch_phase<PH_GLA2>(f, stream); launch_phase<PH_GLA3>(f, stream);
    compare<bf16>(f.gla, r.gla, T1 * 512, err, slot++, stream);
    launch_stage<ST_PROJ>(r, stream);
    f = r; f.mixed = (bf16*)alt; launch_phase<PH_PROJ>(f, stream);
    compare<bf16>(f.mixed, r.mixed, T1 * 1024, err, slot++, stream);
    launch_stage<ST_OUT>(r, stream);
    f = r; f.h1 = (float*)alt; launch_phase<PH_OUT>(f, stream);
    compare<float>(f.h1, r.h1, T1 * 1024, err, slot++, stream);
    launch_stage<ST_ROUTE>(r, stream);
    (void)hipMemsetAsync(r.H, 0, ROWS1 * 512 * 2, stream); (void)hipMemsetAsync(alt, 0, ROWS1 * 512 * 2, stream);
    launch_stage<ST_MOE1>(r, stream);
    f = r; f.H = (bf16*)alt; launch_phase<PH_MOE1>(f, stream);
    compare<bf16>(f.H, r.H, ROWS1 * 512, err, slot++, stream);
    (void)hipMemsetAsync(r.Y, 0, ROWS1 * 1024 * 2, stream); (void)hipMemsetAsync(alt + 17 * MiB, 0, ROWS1 * 1024 * 2, stream);
    launch_stage<ST_MOE2>(r, stream);
    f = r; f.Y = (bf16*)(alt + 17 * MiB); launch_phase<PH_MOE2>(f, stream);
    compare<bf16>(f.Y, r.Y, ROWS1 * 1024, err, slot++, stream);
    hipLaunchKernelGGL(k_report, dim3(1024), dim3(256), 0, stream, (float*)d_out, (size_t)NB * S * D, (const float*)err, slot, 0.02f);
#endif
}
```

```cpp
#include <hip/hip_runtime.h>
#include <hip/hip_cooperative_groups.h>
#include <stdint.h>
namespace cg = cooperative_groups;

#ifndef DUP
#define DUP 0
#endif
#ifndef MODE
#define MODE 1
#endif

typedef unsigned short bf16;
typedef unsigned long long u64;

__device__ __forceinline__ int TIDX() { int t = threadIdx.x; asm volatile("" : "+v"(t)); return t; }
__device__ __forceinline__ float bf2f(bf16 v) { return __uint_as_float(((unsigned)v) << 16); }
__device__ __forceinline__ bf16 f2bf(float f) { unsigned u = __float_as_uint(f); return (bf16)((u + 0x7fffu + ((u >> 16) & 1u)) >> 16); }
__device__ __forceinline__ float sigmoidf_(float x) { return 1.f / (1.f + __expf(-x)); }
__device__ __forceinline__ float siluf_(float x) { return x / (1.f + __expf(-x)); }
__device__ __forceinline__ float geluf_(float x) { const float u = 0.7978845608028654f * (x + 0.044715f * x * x * x); return 0.5f * x * (1.f + tanhf(u)); }

constexpr int NB = 4, S = 4096, D = 1024;
constexpr int NT = 512;
constexpr int LDS_BYTES = 144 * 1024;
constexpr int LDS_MISC = 136 * 1024;
constexpr int INW = 4904;
constexpr int OFF_Q = 0, OFF_KV = 512, OFF_NG = 1280, OFF_GQ = 1304, OFF_GK = 1560, OFF_GV = 1816, OFF_GA = 2328, OFF_GR = 2344, OFF_MA = 2856, OFF_MB = 3880;
constexpr int NEXP = 32;

struct P {
    const float* x; const int* pos; const float* g_mix; const float* w_in;
    const float *cpos_k, *cw1_k, *cb1_k, *cw2_k, *cb2_k, *cpos_v, *cw1_v, *cb1_v, *cw2_v, *cb2_v;
    const float *w_a2, *b_a, *norm_g, *w_pn, *w_pg, *w_out, *g_ffn, *w_grp, *b_grp, *w_exp, *b_exp, *w_gate, *w_up, *w_down, *g_final;
    float* out;
    unsigned* ctl;
    float* cs;
    bf16* u;
    bf16* q;
    bf16* kv6;
    float* gates;
    bf16 *gq, *gk, *gv;
    float* alow;
    bf16 *rs, *sa, *sb;
    float* hcmp;
    bf16 *kcmp, *vcmp;
    u64* sel;
    float* ocmp;
    bf16* onsa;
    float* ga;
    float* oraw;
    bf16* gla;
    bf16* mixed;
    float* h1;
    bf16* vb;
    int* list;
    int* tokslot;
    int* tokexp;
    float* tokw;
    bf16* H;
    bf16* Y;
    float* gst;
    float* gdec;
    float* pcmp;
    float* b1p;
    float* wr;
    bf16 *Wt_in, *Wc1, *Wpn, *Wpg, *Wo, *Wgu, *Wd;
    int nb, T;
};
__device__ __forceinline__ size_t kvseg(const P& p) { return (size_t)p.nb * 2 * S * 64; }

enum Stage { ST_RMS = 0, ST_CS, ST_INPROJ, ST_CMP1, ST_CMP2, ST_NSACMP, ST_NSAATT, ST_GLAA, ST_GLASCAN, ST_GLANORM, ST_PROJ, ST_OUT, ST_ROUTE, ST_MOE1, ST_MOE2, ST_FINAL, ST_COUNT };

__host__ __device__ inline int stage_nvb(int st, int T) {
    switch (st) {
        case ST_RMS: return T / 8;
        case ST_CS: return T * 32 / NT;
        case ST_INPROJ: return ((INW + NT - 1) / NT) * (T / 8);
        case ST_CMP1: return 2 * (T / S) * 2 * 256 / 8;
        case ST_CMP2: return 2 * (T / S) * 2 * 256 * 32 / NT;
        case ST_NSACMP: return T / 64 * 2 / 8;
        case ST_NSAATT: return T / 64 * 8 / 8;
        case ST_GLAA: return T / 2;
        case ST_GLASCAN: return (T / S) * 4 / 4;
        case ST_GLANORM: return T * 4 / NT;
        case ST_PROJ: return 2 * (T / 8);
        case ST_OUT: return 2 * (T / 8);
        case ST_ROUTE: return T / 8;
        case ST_MOE1: return (2 * T + NEXP * 256) / 8;
        case ST_MOE2: return 2 * ((2 * T + NEXP * 256) / 8);
        case ST_FINAL: return T / 8;
    }
    return 0;
}

__device__ __forceinline__ void body_rms(const P& p, int vb) {
    const int lane = TIDX() & 63, t = vb * 8 + (TIDX() >> 6);
    const float4* xr = (const float4*)(p.x + (size_t)t * D);
    float4 v[4]; float ss = 0.f;
#pragma unroll
    for (int j = 0; j < 4; ++j) { v[j] = xr[lane + 64 * j]; ss += v[j].x * v[j].x + v[j].y * v[j].y + v[j].z * v[j].z + v[j].w * v[j].w; }
#pragma unroll
    for (int o = 1; o < 64; o <<= 1) ss += __shfl_xor(ss, o);
    const float rstd = rsqrtf(ss * (1.f / D) + 1e-6f);
#pragma unroll
    for (int j = 0; j < 4; ++j) {
        const float4 g = ((const float4*)p.g_mix)[lane + 64 * j];
        ushort4 o; o.x = f2bf(v[j].x * rstd * g.x); o.y = f2bf(v[j].y * rstd * g.y); o.z = f2bf(v[j].z * rstd * g.z); o.w = f2bf(v[j].w * rstd * g.w);
        ((ushort4*)(p.u + (size_t)t * D))[lane + 64 * j] = o;
    }
}
__device__ __forceinline__ void body_cs(const P& p, int vb) {
    const int idx = vb * NT + TIDX(); const int t = idx >> 5, i = idx & 31;
    const float inv = 1.0f / powf(10000.0f, (float)i / 32.0f);
    const float ang = (float)p.pos[t] * inv;
    const double a = (double)ang; const double k = rint(a * 0.15915494309189535); const float r = (float)(a - k * 6.283185307179586);
    p.cs[(size_t)t * 64 + i] = cosf(r); p.cs[(size_t)t * 64 + 32 + i] = sinf(r);
}

template <int K, bool TWO, bool SAMEA, class AF1, class AF2, class Epi>
__device__ __forceinline__ void ngemm(float* lds, int m0, const float* W1, int ldw1, int n1, const float* W2, int ldw2, int n2, AF1 a1, AF2 a2, Epi epi) {
    const int tid = TIDX();
    for (int idx = tid; idx < 8 * K; idx += NT) { const int i = idx / K, k = idx % K; lds[idx] = a1(m0 + i, k); if (TWO && !SAMEA) lds[8 * K + idx] = a2(m0 + i, k); }
    __syncthreads();
    float acc1[8], acc2[8];
#pragma unroll
    for (int i = 0; i < 8; ++i) { acc1[i] = 0.f; acc2[i] = 0.f; }
    const float* w1 = W1 + n1; const float* w2 = TWO ? (W2 + n2) : w1;
    const float* l2 = (TWO && !SAMEA) ? lds + 8 * K : lds;
    for (int k = 0; k < K; k += 4) {
        float a[4], b[4];
#pragma unroll
        for (int kk = 0; kk < 4; ++kk) { a[kk] = w1[(size_t)(k + kk) * ldw1]; b[kk] = TWO ? w2[(size_t)(k + kk) * ldw2] : 0.f; }
#pragma unroll
        for (int i = 0; i < 8; ++i) {
            const float4 x1 = *(const float4*)(lds + i * K + k);
            acc1[i] += x1.x * a[0] + x1.y * a[1] + x1.z * a[2] + x1.w * a[3];
            if (TWO) { const float4 x2 = *(const float4*)(l2 + i * K + k); acc2[i] += x2.x * b[0] + x2.y * b[1] + x2.z * b[2] + x2.w * b[3]; }
        }
    }
#pragma unroll
    for (int i = 0; i < 8; ++i) epi(m0 + i, acc1[i], acc2[i]);
    __syncthreads();
}

__device__ __forceinline__ void store_z(const P& p, int t, int j, float z, float zp) {
    const int b = t / S, s = t % S;
    if (j < OFF_KV) {
        const int d = j & 63, i = d & 31; const float c = p.cs[(size_t)t * 64 + i], sn = p.cs[(size_t)t * 64 + 32 + i];
        const float r = (d < 32) ? (z * c - zp * sn) : (z * c + zp * sn);
        p.q[(size_t)t * 512 + j] = f2bf(r * 0.125f);
    } else if (j < OFF_NG) {
        const int seg = (j - OFF_KV) >> 7, cc = (j - OFF_KV) & 127, g = cc >> 6, d = cc & 63; float r = z;
        if (seg == 2 || seg == 4) { const int i = d & 31; const float c = p.cs[(size_t)t * 64 + i], sn = p.cs[(size_t)t * 64 + 32 + i]; r = (d < 32) ? (z * c - zp * sn) : (z * c + zp * sn); }
        p.kv6[(size_t)seg * kvseg(p) + ((size_t)(b * 2 + g) * S + s) * 64 + d] = f2bf(r);
    } else if (j < OFF_GQ) { p.gates[(size_t)t * 24 + (j - OFF_NG)] = sigmoidf_(z);
    } else if (j < OFF_GK) { p.gq[(size_t)t * 256 + (j - OFF_GQ)] = f2bf(z * 0.125f);
    } else if (j < OFF_GV) { p.gk[(size_t)t * 256 + (j - OFF_GK)] = f2bf(z);
    } else if (j < OFF_GA) { p.gv[(size_t)t * 512 + (j - OFF_GV)] = f2bf(z);
    } else if (j < OFF_GR) { p.alow[(size_t)t * 16 + (j - OFF_GA)] = z;
    } else if (j < OFF_MA) { p.rs[(size_t)t * 512 + (j - OFF_GR)] = f2bf(siluf_(z));
    } else if (j < OFF_MB) { p.sa[(size_t)t * 1024 + (j - OFF_MA)] = f2bf(sigmoidf_(z));
    } else { p.sb[(size_t)t * 1024 + (j - OFF_MB)] = f2bf(sigmoidf_(z)); }
}
__device__ __forceinline__ int rope_partner(int j) {
    int base;
    if (j < OFF_KV) base = 0; else if (j >= 768 && j < 896) base = 768; else if (j >= 1024 && j < 1152) base = 1024; else return -1;
    const int d = (j - base) & 63; return d < 32 ? j + 32 : j - 32;
}
__device__ __forceinline__ void body_inproj(const P& p, int vb, char* smem) {
    constexpr int NCB = (INW + NT - 1) / NT;
    const int bx = vb % NCB, by = vb / NCB;
    const int jr = bx * NT + TIDX(); const bool jv = jr < INW; const int j = jv ? jr : INW - 1;
    int jp = rope_partner(j); if (jp < 0) jp = j;
    ngemm<1024, true, true>((float*)smem, by * 8, p.w_in, INW, j, p.w_in, INW, jp,
        [&](int m, int k) { return bf2f(p.u[(size_t)m * D + k]); }, [&](int m, int k) { return 0.f; },
        [&](int m, float z, float zp) { if (jv) store_z(p, m, j, z, zp); });
}

__device__ __forceinline__ void body_cmp1(const P& p, int vb, char* smem) {
    const int nrows = p.nb * 2 * 256, ng = nrows / 8;
    const int kv = vb / ng, m0 = (vb % ng) * 8; const int n = TIDX() & 255; const bool act = TIDX() < 256;
    const bf16* src = p.kv6 + (size_t)kv * kvseg(p);
    const float* pe = kv ? p.cpos_v : p.cpos_k; const float* w1 = kv ? p.cw1_v : p.cw1_k; const float* b1 = kv ? p.cb1_v : p.cb1_k;
    float* dst = p.hcmp + (size_t)kv * nrows * 256;
    ngemm<2048, false, true>((float*)smem, m0, w1, 256, n, w1, 256, n,
        [&](int m, int k) { return bf2f(src[(size_t)m * 1024 + k]) + pe[k]; }, [&](int m, int k) { return 0.f; },
        [&](int m, float z, float) { if (act) dst[(size_t)m * 256 + n] = geluf_(z + b1[n]); });
}
__device__ __forceinline__ void body_cmp2(const P& p, int vb) {
    const int nrows = p.nb * 2 * 256;
    const int idx = vb * NT + TIDX();
    const int i = idx & 31, row = (idx >> 5) % nrows, kv = (idx >> 5) / nrows;
    const float* h = p.hcmp + ((size_t)kv * nrows + row) * 256; const float* w2 = kv ? p.cw2_v : p.cw2_k; const float* b2 = kv ? p.cb2_v : p.cb2_k;
    float z1 = b2[i], z2 = b2[i + 32];
    for (int n = 0; n < 256; ++n) { const float hv = h[n]; z1 += hv * w2[n * 64 + i]; z2 += hv * w2[n * 64 + i + 32]; }
    bf16* dst = (kv ? p.vcmp : p.kcmp) + (size_t)row * 64;
    if (kv == 0) {
        const int bg = row >> 8, m = row & 255, b = bg >> 1; int sp = 16 * m + 31; if (sp > S - 1) sp = S - 1;
        const size_t t = (size_t)b * S + sp; const float c = p.cs[t * 64 + i], sn = p.cs[t * 64 + 32 + i];
        const float r1 = z1 * c - z2 * sn, r2 = z2 * c + z1 * sn; z1 = r1; z2 = r2;
    }
    dst[i] = f2bf(z1); dst[i + 32] = f2bf(z2);
}

__device__ __forceinline__ void load_row64(const bf16* r, float* f) {
    const uint4* p4 = (const uint4*)r;
#pragma unroll
    for (int c = 0; c < 8; ++c) { const uint4 v = p4[c]; const unsigned w[4] = {v.x, v.y, v.z, v.w};
#pragma unroll
        for (int e = 0; e < 4; ++e) { f[c * 8 + e * 2] = __uint_as_float(w[e] << 16); f[c * 8 + e * 2 + 1] = __uint_as_float(w[e] & 0xffff0000u); } }
}
__device__ __forceinline__ float dot64(const float* a, const bf16* r) {
    const uint4* p4 = (const uint4*)r; float s = 0.f;
#pragma unroll
    for (int c = 0; c < 8; ++c) { const uint4 v = p4[c]; const unsigned w[4] = {v.x, v.y, v.z, v.w};
#pragma unroll
        for (int e = 0; e < 4; ++e) { s += a[c * 8 + e * 2] * __uint_as_float(w[e] << 16); s += a[c * 8 + e * 2 + 1] * __uint_as_float(w[e] & 0xffff0000u); } }
    return s;
}
__device__ __forceinline__ void axpy64(float* o, float a, const bf16* r) {
    const uint4* p4 = (const uint4*)r;
#pragma unroll
    for (int c = 0; c < 8; ++c) { const uint4 v = p4[c]; const unsigned w[4] = {v.x, v.y, v.z, v.w};
#pragma unroll
        for (int e = 0; e < 4; ++e) { o[c * 8 + e * 2] += a * __uint_as_float(w[e] << 16); o[c * 8 + e * 2 + 1] += a * __uint_as_float(w[e] & 0xffff0000u); } }
}
__device__ __forceinline__ void body_nsacmp(const P& p, int vb, char* smem) {
    const int wave = TIDX() >> 6, lane = TIDX() & 63, item = vb * 8 + wave;
    const int g = item & 1, t = (item >> 1) * 64 + lane;
    const int b = t / S, s = t % S; const int nv = s >= 31 ? (s - 31) / 16 + 1 : 0;
    float* my = (float*)smem + (size_t)wave * (64 * 65) + lane * 65;
    for (int j = 0; j < 64; ++j) my[j] = 0.f;
    const bf16* kc = p.kcmp + (size_t)(b * 2 + g) * 256 * 64; const bf16* vc = p.vcmp + (size_t)(b * 2 + g) * 256 * 64;
    for (int hh = 0; hh < 4; ++hh) {
        const int h = g * 4 + hh; float qv[64], o[64];
        load_row64(p.q + (size_t)t * 512 + h * 64, qv);
#pragma unroll
        for (int d = 0; d < 64; ++d) o[d] = 0.f;
        float m = -1e30f, l = 0.f;
        for (int n = 0; n < nv; ++n) { const float sc = dot64(qv, kc + n * 64); const float mn = fmaxf(m, sc); l = l * __expf(m - mn) + __expf(sc - mn); m = mn; }
        const float il = nv > 0 ? 1.f / l : 0.f;
        for (int n = 0; n < nv; ++n) {
            const float sc = dot64(qv, kc + n * 64); const float pn = __expf(sc - m) * il;
            axpy64(o, pn, vc + n * 64);
            const int j0 = n >> 2; if ((n & 3) != 3) my[j0] += pn; else { my[j0] += 0.5f * pn; my[j0 + 1] += 0.5f * pn; }
        }
#pragma unroll
        for (int d = 0; d < 64; ++d) p.ocmp[(size_t)t * 512 + h * 64 + d] = o[d];
    }
    const int cur = s >> 6; u64 mask = 0ull;
    for (int j = 0; j <= cur; ++j) {
        const float sj = (j == 0 || j == cur || j == cur - 1) ? 1e4f : my[j]; int rank = 0;
        for (int i = 0; i <= cur; ++i) { if (i == j) continue; const float si = (i == 0 || i == cur || i == cur - 1) ? 1e4f : my[i]; if (si > sj || (si == sj && i < j)) ++rank; }
        if (rank < 16) mask |= (1ull << j);
    }
    p.sel[(size_t)t * 2 + g] = mask;
}
__device__ __forceinline__ void body_nsaatt(const P& p, int vb) {
    const int wave = TIDX() >> 6, lane = TIDX() & 63, item = vb * 8 + wave;
    const int h = item & 7, t = (item >> 3) * 64 + lane, g = h >> 2;
    const int b = t / S, s = t % S, cur = s >> 6;
    const size_t seg = kvseg(p), ho = (size_t)(b * 2 + g) * S * 64;
    const bf16* ks = p.kv6 + 2 * seg + ho; const bf16* vs = p.kv6 + 3 * seg + ho; const bf16* kw = p.kv6 + 4 * seg + ho; const bf16* vw = p.kv6 + 5 * seg + ho;
    float qv[64], o[64];
    load_row64(p.q + (size_t)t * 512 + h * 64, qv);
    const float g0 = p.gates[(size_t)t * 24 + h * 3], g1 = p.gates[(size_t)t * 24 + h * 3 + 1], g2 = p.gates[(size_t)t * 24 + h * 3 + 2];
    float* accp = p.ocmp + (size_t)t * 512 + h * 64;
#pragma unroll
    for (int d = 0; d < 64; ++d) o[d] = 0.f;
    const u64 mask = p.sel[(size_t)t * 2 + g];
    float m = -1e30f, l = 0.f;
    for (int j = 0; j <= cur; ++j) {
        if (!((mask >> j) & 1ull)) continue;
        for (int kk = 0; kk < 64; ++kk) {
            const int key = j * 64 + kk; if (key > s) break;
            const float sc = dot64(qv, ks + (size_t)key * 64);
            if (sc > m) { const float f = __expf(m - sc); l *= f;
#pragma unroll
                for (int d = 0; d < 64; ++d) o[d] *= f;
                m = sc; }
            const float pe = __expf(sc - m); l += pe; axpy64(o, pe, vs + (size_t)key * 64);
        }
    }
    { const float f = g1 / l;
#pragma unroll
        for (int d = 0; d < 64; ++d) { accp[d] = g0 * accp[d] + f * o[d]; o[d] = 0.f; } }
    m = -1e30f; l = 0.f;
    for (int key = (s >= 511 ? s - 511 : 0); key <= s; ++key) {
        const float sc = dot64(qv, kw + (size_t)key * 64);
        if (sc > m) { const float f = __expf(m - sc); l *= f;
#pragma unroll
            for (int d = 0; d < 64; ++d) o[d] *= f;
            m = sc; }
        const float pe = __expf(sc - m); l += pe; axpy64(o, pe, vw + (size_t)key * 64);
    }
    { const float f = g2 / l;
#pragma unroll
        for (int d = 0; d < 64; ++d) p.onsa[(size_t)t * 512 + h * 64 + d] = f2bf(accp[d] + f * o[d]); }
}

__device__ __forceinline__ void body_glaa(const P& p, int vb) {
    const int c = TIDX() & 255, t = vb * 2 + (TIDX() >> 8); float z = p.b_a[c];
#pragma unroll
    for (int r = 0; r < 16; ++r) z += p.alow[(size_t)t * 16 + r] * p.w_a2[r * 256 + c];
    const float ls = fminf(z, 0.f) - log1pf(__expf(-fabsf(z)));
    p.ga[(size_t)t * 256 + c] = __expf(ls * (1.f / 16.f));
}
__device__ __forceinline__ void body_glascan(const P& p, int vb, char* smem) {
    const int sub = TIDX() >> 7, e = TIDX() & 127, bh = vb * 4 + sub, b = bh >> 2, h = bh & 3;
    float* sq = (float*)smem + sub * (3 * 32 * 64); float* sk = sq + 32 * 64; float* sg = sk + 32 * 64;
    float St[64];
#pragma unroll
    for (int d = 0; d < 64; ++d) St[d] = 0.f;
    for (int s0 = 0; s0 < S; s0 += 32) {
        __syncthreads();
        for (int i = e; i < 32 * 64; i += 128) { const int ss = i >> 6, d = i & 63; const size_t t = (size_t)b * S + s0 + ss;
            sq[i] = bf2f(p.gq[t * 256 + h * 64 + d]); sk[i] = bf2f(p.gk[t * 256 + h * 64 + d]); sg[i] = p.ga[t * 256 + h * 64 + d]; }
        __syncthreads();
        for (int ss = 0; ss < 32; ++ss) {
            const size_t t = (size_t)b * S + s0 + ss; const float v = bf2f(p.gv[t * 512 + h * 128 + e]); float o = 0.f;
#pragma unroll
            for (int d = 0; d < 64; ++d) { St[d] = sg[ss * 64 + d] * St[d] + sk[ss * 64 + d] * v; o += sq[ss * 64 + d] * St[d]; }
            p.oraw[t * 512 + h * 128 + e] = o;
        }
    }
    __syncthreads();
}
__device__ __forceinline__ void body_glanorm(const P& p, int vb) {
    const int idx = vb * NT + TIDX(); const int t = idx >> 2, h = idx & 3;
    const float* o = p.oraw + (size_t)t * 512 + h * 128; float ss = 0.f;
    for (int e = 0; e < 128; ++e) ss += o[e] * o[e];
    const float r = rsqrtf(ss * (1.f / 128.f) + 1e-6f);
    for (int e = 0; e < 128; ++e) p.gla[(size_t)t * 512 + h * 128 + e] = f2bf(o[e] * r * p.norm_g[h * 128 + e] * bf2f(p.rs[(size_t)t * 512 + h * 128 + e]));
}

__device__ __forceinline__ void body_proj(const P& p, int vb, char* smem) {
    const int n = (vb & 1) * NT + TIDX(), m0 = (vb >> 1) * 8;
    ngemm<512, true, false>((float*)smem, m0, p.w_pn, 1024, n, p.w_pg, 1024, n,
        [&](int m, int k) { return bf2f(p.onsa[(size_t)m * 512 + k]); }, [&](int m, int k) { return bf2f(p.gla[(size_t)m * 512 + k]); },
        [&](int m, float ya, float yb) { p.mixed[(size_t)m * 1024 + n] = f2bf(bf2f(p.sa[(size_t)m * 1024 + n]) * ya + bf2f(p.sb[(size_t)m * 1024 + n]) * yb); });
}
__device__ __forceinline__ void body_out(const P& p, int vb, char* smem) {
    const int n = (vb & 1) * NT + TIDX(), m0 = (vb >> 1) * 8;
    ngemm<1024, false, true>((float*)smem, m0, p.w_out, 1024, n, p.w_out, 1024, n,
        [&](int m, int k) { return bf2f(p.mixed[(size_t)m * 1024 + k]); }, [&](int m, int k) { return 0.f; },
        [&](int m, float z, float) { p.h1[(size_t)m * 1024 + n] = p.x[(size_t)m * 1024 + n] + z; });
}

__device__ __forceinline__ void body_route(const P& p, int vb, char* smem) {
    const int wave = TIDX() >> 6, lane = TIDX() & 63, t = vb * 8 + wave;
    const float4* hr = (const float4*)(p.h1 + (size_t)t * D);
    float v[16]; float ss = 0.f;
#pragma unroll
    for (int j = 0; j < 4; ++j) { const float4 a = hr[lane + 64 * j]; v[4 * j] = a.x; v[4 * j + 1] = a.y; v[4 * j + 2] = a.z; v[4 * j + 3] = a.w; ss += a.x * a.x + a.y * a.y + a.z * a.z + a.w * a.w; }
#pragma unroll
    for (int o = 1; o < 64; o <<= 1) ss += __shfl_xor(ss, o);
    const float rstd = rsqrtf(ss * (1.f / D) + 1e-6f);
#pragma unroll
    for (int j = 0; j < 4; ++j) {
        const float4 g = ((const float4*)p.g_ffn)[lane + 64 * j];
        v[4 * j] *= rstd * g.x; v[4 * j + 1] *= rstd * g.y; v[4 * j + 2] *= rstd * g.z; v[4 * j + 3] *= rstd * g.w;
        ushort4 o; o.x = f2bf(v[4 * j]); o.y = f2bf(v[4 * j + 1]); o.z = f2bf(v[4 * j + 2]); o.w = f2bf(v[4 * j + 3]);
        ((ushort4*)(p.vb + (size_t)t * D))[lane + 64 * j] = o;
    }
    float* sl = (float*)(smem + LDS_MISC) + wave * 40;
    for (int o = 0; o < 4; ++o) { float a = 0.f;
#pragma unroll
        for (int j = 0; j < 4; ++j)
#pragma unroll
            for (int e = 0; e < 4; ++e) a += v[4 * j + e] * p.w_grp[(size_t)(4 * (lane + 64 * j) + e) * 4 + o];
#pragma unroll
        for (int x = 1; x < 64; x <<= 1) a += __shfl_xor(a, x);
        if (lane == 0) sl[o] = a + p.b_grp[o]; }
    for (int o = 0; o < 32; ++o) { float a = 0.f;
#pragma unroll
        for (int j = 0; j < 4; ++j)
#pragma unroll
            for (int e = 0; e < 4; ++e) a += v[4 * j + e] * p.w_exp[(size_t)(4 * (lane + 64 * j) + e) * 32 + o];
#pragma unroll
        for (int x = 1; x < 64; x <<= 1) a += __shfl_xor(a, x);
        if (lane == 0) sl[4 + o] = a + p.b_exp[o]; }
    if (lane == 0) {
        int gs = 0; float gm = sl[0];
        for (int o = 1; o < 4; ++o) if (sl[o] > gm) { gm = sl[o]; gs = o; }
        float gsum = 0.f;
        for (int o = 0; o < 4; ++o) gsum += __expf(sl[o] - gm);
        const float pg = 1.f / gsum;
        const float* li = sl + 4 + gs * 8;
        int e0 = 0; float m0 = li[0];
        for (int e = 1; e < 8; ++e) if (li[e] > m0) { m0 = li[e]; e0 = e; }
        int e1 = -1; float m1 = -3e38f;
        for (int e = 0; e < 8; ++e) if (e != e0 && li[e] > m1) { m1 = li[e]; e1 = e; }
        const float p0 = 1.f, p1 = __expf(m1 - m0);
        const float w0 = pg * p0 / (p0 + p1), w1 = pg * p1 / (p0 + p1);
        const int x0 = gs * 8 + e0, x1 = gs * 8 + e1;
        const int s0 = (int)atomicAdd(&p.ctl[x0 * 32], 1u), s1 = (int)atomicAdd(&p.ctl[x1 * 32], 1u);
        p.list[(size_t)x0 * p.T + s0] = t; p.list[(size_t)x1 * p.T + s1] = t;
        p.tokexp[t * 2] = x0; p.tokexp[t * 2 + 1] = x1; p.tokslot[t * 2] = s0; p.tokslot[t * 2 + 1] = s1; p.tokw[t * 2] = w0; p.tokw[t * 2 + 1] = w1;
    }
}

__device__ __forceinline__ void body_route2(const P& p, int vb, char* smem) {
    const int tid = TIDX(), wave = tid >> 6, lane = tid & 63, t = vb * 8 + wave;
    const float4* hr = (const float4*)(p.h1 + (size_t)t * D);
    float4 v[4]; float ss = 0.f;
#pragma unroll
    for (int j = 0; j < 4; ++j) { v[j] = hr[lane + 64 * j]; ss += v[j].x * v[j].x + v[j].y * v[j].y + v[j].z * v[j].z + v[j].w * v[j].w; }
#pragma unroll
    for (int o = 1; o < 64; o <<= 1) ss += __shfl_xor(ss, o);
    const float rstd = rsqrtf(ss * (1.f / D) + 1e-6f);
#pragma unroll
    for (int j = 0; j < 4; ++j) {
        const float4 g = ((const float4*)p.g_ffn)[lane + 64 * j];
        v[j].x *= rstd * g.x; v[j].y *= rstd * g.y; v[j].z *= rstd * g.z; v[j].w *= rstd * g.w;
        ushort4 o; o.x = f2bf(v[j].x); o.y = f2bf(v[j].y); o.z = f2bf(v[j].z); o.w = f2bf(v[j].w);
        ((ushort4*)(p.vb + (size_t)t * D))[lane + 64 * j] = o;
    }
    float* sl = (float*)(smem + LDS_MISC) + wave * 40;
    float mine = 0.f;
#pragma unroll 4
    for (int o = 0; o < 36; ++o) { const float4* wrow = (const float4*)(p.wr + (size_t)o * 1024); float a = 0.f;
#pragma unroll
        for (int j = 0; j < 4; ++j) { const float4 w = wrow[lane + 64 * j]; a += v[j].x * w.x + v[j].y * w.y + v[j].z * w.z + v[j].w * w.w; }
#pragma unroll
        for (int x = 1; x < 64; x <<= 1) a += __shfl_xor(a, x);
        if (lane == o) mine = a; }
    if (lane < 36) sl[lane] = mine + (lane < 4 ? p.b_grp[lane] : p.b_exp[lane - 4]);
    asm volatile("s_waitcnt lgkmcnt(0)" ::: "memory");
    if (lane == 0) {
        int gs = 0; float gm = sl[0];
        for (int o = 1; o < 4; ++o) if (sl[o] > gm) { gm = sl[o]; gs = o; }
        float gsum = 0.f;
        for (int o = 0; o < 4; ++o) gsum += __expf(sl[o] - gm);
        const float pg = 1.f / gsum;
        const float* li = sl + 4 + gs * 8;
        int e0 = 0; float m0 = li[0];
        for (int e = 1; e < 8; ++e) if (li[e] > m0) { m0 = li[e]; e0 = e; }
        int e1 = -1; float m1 = -3e38f;
        for (int e = 0; e < 8; ++e) if (e != e0 && li[e] > m1) { m1 = li[e]; e1 = e; }
        const float p0 = 1.f, p1 = __expf(m1 - m0);
        const float w0 = pg * p0 / (p0 + p1), w1 = pg * p1 / (p0 + p1);
        const int x0 = gs * 8 + e0, x1 = gs * 8 + e1;
        const int s0 = (int)atomicAdd(&p.ctl[x0 * 32], 1u), s1 = (int)atomicAdd(&p.ctl[x1 * 32], 1u);
        p.list[(size_t)x0 * p.T + s0] = t; p.list[(size_t)x1 * p.T + s1] = t;
        p.tokexp[t * 2] = x0; p.tokexp[t * 2 + 1] = x1; p.tokslot[t * 2] = s0; p.tokslot[t * 2 + 1] = s1; p.tokw[t * 2] = w0; p.tokw[t * 2 + 1] = w1;
    }
}

__device__ __forceinline__ float tred8(float (&a)[8], int lane) {
    const bool b5 = lane & 32, b4 = lane & 16, b3 = lane & 8;
    float k4[4], k2[2], k1;
#pragma unroll
    for (int i = 0; i < 4; ++i) { const float snd = b5 ? a[i] : a[i + 4]; const float kp = b5 ? a[i + 4] : a[i]; k4[i] = kp + __shfl_xor(snd, 32); }
#pragma unroll
    for (int i = 0; i < 2; ++i) { const float snd = b4 ? k4[i] : k4[i + 2]; const float kp = b4 ? k4[i + 2] : k4[i]; k2[i] = kp + __shfl_xor(snd, 16); }
    { const float snd = b3 ? k2[0] : k2[1]; const float kp = b3 ? k2[1] : k2[0]; k1 = kp + __shfl_xor(snd, 8); }
    k1 += __shfl_xor(k1, 4); k1 += __shfl_xor(k1, 2); k1 += __shfl_xor(k1, 1);
    return k1;
}
__device__ __forceinline__ void body_route3(const P& p, int vb, char* smem) {
    const int tid = TIDX(), wave = tid >> 6, lane = tid & 63, t0 = vb * 64 + wave * 8;
    float4 v[8][4]; float ss[8];
#pragma unroll
    for (int tk = 0; tk < 8; ++tk) { const float4* hr = (const float4*)(p.h1 + (size_t)(t0 + tk) * D); float s = 0.f;
#pragma unroll
        for (int j = 0; j < 4; ++j) { v[tk][j] = hr[lane + 64 * j]; s += v[tk][j].x * v[tk][j].x + v[tk][j].y * v[tk][j].y + v[tk][j].z * v[tk][j].z + v[tk][j].w * v[tk][j].w; }
        ss[tk] = s; }
    const float tot = tred8(ss, lane);
#pragma unroll
    for (int tk = 0; tk < 8; ++tk) { const float rstd = rsqrtf(__shfl(tot, tk * 8) * (1.f / D) + 1e-6f);
#pragma unroll
        for (int j = 0; j < 4; ++j) {
            const float4 g = ((const float4*)p.g_ffn)[lane + 64 * j];
            v[tk][j].x *= rstd * g.x; v[tk][j].y *= rstd * g.y; v[tk][j].z *= rstd * g.z; v[tk][j].w *= rstd * g.w;
            ushort4 o; o.x = f2bf(v[tk][j].x); o.y = f2bf(v[tk][j].y); o.z = f2bf(v[tk][j].z); o.w = f2bf(v[tk][j].w);
            ((ushort4*)(p.vb + (size_t)(t0 + tk) * D))[lane + 64 * j] = o; } }
    float* sl = (float*)smem + wave * (8 * 40);
#pragma unroll 3
    for (int o = 0; o < 36; ++o) { const float4* wrow = (const float4*)(p.wr + (size_t)o * 1024); float a[8];
        float4 w[4];
#pragma unroll
        for (int j = 0; j < 4; ++j) w[j] = wrow[lane + 64 * j];
#pragma unroll
        for (int tk = 0; tk < 8; ++tk) { float s = 0.f;
#pragma unroll
            for (int j = 0; j < 4; ++j) s += v[tk][j].x * w[j].x + v[tk][j].y * w[j].y + v[tk][j].z * w[j].z + v[tk][j].w * w[j].w;
            a[tk] = s; }
        const float r = tred8(a, lane);
        if ((lane & 7) == 0) sl[(lane >> 3) * 40 + o] = r + (o < 4 ? p.b_grp[o] : p.b_exp[o - 4]); }
    asm volatile("s_waitcnt lgkmcnt(0)" ::: "memory");
    int* cntl = (int*)((float*)smem + 8 * 320); int* basel = cntl + 32;
    if (tid < 32) cntl[tid] = 0;
    __syncthreads();
    int x0 = 0, x1 = 0, l0 = 0, l1 = 0; float w0 = 0.f, w1 = 0.f;
    if (lane < 8) {
        const float* s8 = sl + lane * 40;
        int gs = 0; float gm = s8[0];
        for (int o = 1; o < 4; ++o) if (s8[o] > gm) { gm = s8[o]; gs = o; }
        float gsum = 0.f;
        for (int o = 0; o < 4; ++o) gsum += __expf(s8[o] - gm);
        const float pg = 1.f / gsum;
        const float* li = s8 + 4 + gs * 8;
        int e0 = 0; float m0 = li[0];
        for (int e = 1; e < 8; ++e) if (li[e] > m0) { m0 = li[e]; e0 = e; }
        int e1 = -1; float m1 = -3e38f;
        for (int e = 0; e < 8; ++e) if (e != e0 && li[e] > m1) { m1 = li[e]; e1 = e; }
        const float p0 = 1.f, p1 = __expf(m1 - m0);
        w0 = pg * p0 / (p0 + p1); w1 = pg * p1 / (p0 + p1);
        x0 = gs * 8 + e0; x1 = gs * 8 + e1;
        l0 = atomicAdd(&cntl[x0], 1); l1 = atomicAdd(&cntl[x1], 1);
    }
    __syncthreads();
    if (tid < 32) { const int c = cntl[tid]; basel[tid] = c > 0 ? (int)atomicAdd(&p.ctl[tid * 32], (unsigned)c) : 0; }
    __syncthreads();
    if (lane < 8) {
        const int t = t0 + lane; const int s0 = basel[x0] + l0, s1 = basel[x1] + l1;
        p.list[(size_t)x0 * p.T + s0] = t; p.list[(size_t)x1 * p.T + s1] = t;
        p.tokexp[t * 2] = x0; p.tokexp[t * 2 + 1] = x1; p.tokslot[t * 2] = s0; p.tokslot[t * 2 + 1] = s1; p.tokw[t * 2] = w0; p.tokw[t * 2 + 1] = w1;
    }
    __syncthreads();
}

__device__ __forceinline__ int* seg_bases(const P& p, char* smem) {
    int* sbase = (int*)(smem + LDS_MISC + 2048);
    __syncthreads();
    if (TIDX() == 0) { int acc = 0; for (int e = 0; e < NEXP; ++e) { sbase[e] = acc; acc += ((int)p.ctl[e * 32] + 255) & ~255; } sbase[NEXP] = acc; }
    __syncthreads();
    return sbase;
}
__device__ __forceinline__ void body_moe1(const P& p, int vb, char* smem) {
    int* sbase = seg_bases(p, smem); int* stok = sbase + 40;
    const int r0 = vb * 8; if (r0 >= sbase[NEXP]) return;
    int e = 0; while (r0 >= sbase[e + 1]) ++e;
    const int cnt = (int)p.ctl[e * 32];
    if (TIDX() < 8) { const int sl = r0 + TIDX() - sbase[e]; stok[TIDX()] = p.list[(size_t)e * p.T + (sl < cnt ? sl : 0)]; }
    __syncthreads();
    const int n = TIDX();
    const float* wg = p.w_gate + (size_t)e * 1024 * 512; const float* wu = p.w_up + (size_t)e * 1024 * 512;
    ngemm<1024, true, true>((float*)smem, 0, wg, 512, n, wu, 512, n,
        [&](int m, int k) { return bf2f(p.vb[(size_t)stok[m] * D + k]); }, [&](int m, int k) { return 0.f; },
        [&](int m, float zg, float zu) { p.H[(size_t)(r0 + m) * 512 + n] = f2bf(siluf_(zg) * zu); });
}
__device__ __forceinline__ void body_moe2(const P& p, int vb, char* smem) {
    int* sbase = seg_bases(p, smem);
    const int r0 = (vb >> 1) * 8; if (r0 >= sbase[NEXP]) return;
    int e = 0; while (r0 >= sbase[e + 1]) ++e;
    const int n = (vb & 1) * NT + TIDX();
    const float* wd = p.w_down + (size_t)e * 512 * 1024;
    ngemm<512, false, true>((float*)smem, r0, wd, 1024, n, wd, 1024, n,
        [&](int m, int k) { return bf2f(p.H[(size_t)m * 512 + k]); }, [&](int m, int k) { return 0.f; },
        [&](int m, float z, float) { p.Y[(size_t)m * 1024 + n] = f2bf(z); });
}
__device__ __forceinline__ void body_final(const P& p, int vb, char* smem) {
    int* sbase = seg_bases(p, smem);
    const int lane = TIDX() & 63, t = vb * 8 + (TIDX() >> 6);
    const int r0 = sbase[p.tokexp[t * 2]] + p.tokslot[t * 2], r1 = sbase[p.tokexp[t * 2 + 1]] + p.tokslot[t * 2 + 1];
    const float w0 = p.tokw[t * 2], w1 = p.tokw[t * 2 + 1];
    const float4* hr = (const float4*)(p.h1 + (size_t)t * D);
    float4 v[4]; float ss = 0.f;
#pragma unroll
    for (int j = 0; j < 4; ++j) {
        float4 a = hr[lane + 64 * j];
        const ushort4 y0 = ((const ushort4*)(p.Y + (size_t)r0 * D))[lane + 64 * j], y1 = ((const ushort4*)(p.Y + (size_t)r1 * D))[lane + 64 * j];
        a.x += w0 * bf2f(y0.x) + w1 * bf2f(y1.x); a.y += w0 * bf2f(y0.y) + w1 * bf2f(y1.y); a.z += w0 * bf2f(y0.z) + w1 * bf2f(y1.z); a.w += w0 * bf2f(y0.w) + w1 * bf2f(y1.w);
        v[j] = a; ss += a.x * a.x + a.y * a.y + a.z * a.z + a.w * a.w;
    }
#pragma unroll
    for (int o = 1; o < 64; o <<= 1) ss += __shfl_xor(ss, o);
    const float rstd = rsqrtf(ss * (1.f / D) + 1e-6f);
#pragma unroll
    for (int j = 0; j < 4; ++j) {
        const float4 g = ((const float4*)p.g_final)[lane + 64 * j];
        float4 o; o.x = v[j].x * rstd * g.x; o.y = v[j].y * rstd * g.y; o.z = v[j].z * rstd * g.z; o.w = v[j].w * rstd * g.w;
        ((float4*)(p.out + (size_t)t * D))[lane + 64 * j] = o;
    }
}

namespace pg8 {
#define PG8_LAS __attribute__((address_space(3)))
typedef short bf16x8 __attribute__((ext_vector_type(8)));
typedef float f32x4 __attribute__((ext_vector_type(4)));
typedef unsigned u32x4 __attribute__((ext_vector_type(4)));
typedef unsigned u32x2 __attribute__((ext_vector_type(2)));
constexpr int BM = 256, BK = 64, HALF = 128, HTB = HALF * BK * 2, STAGE_BYTES = 8 * HTB, NXCD = 8, WGM = 8;

__host__ __device__ __forceinline__ int lds_byte(int r, int c) { const int st = (r >> 4) * 2 + (c >> 5), rr = r & 15, cc = c & 31, ob = rr * 64 + cc * 2; return st * 1024 + (ob ^ (((ob >> 9) & 1) << 5)); }
__host__ __device__ __forceinline__ void stage_rc(int b, int& R, int& C) { const int st = b / 1024, sb = b % 1024, swz = sb ^ (((sb >> 9) & 1) << 5); R = (st >> 1) * 16 + swz / 64; C = (st & 1) * 32 + (swz % 64) / 2; }
__host__ __device__ __forceinline__ int perm32(int rho) { const int n = rho >> 4, i = rho & 15; return 8 * (i >> 2) + 4 * n + (i & 3); }

struct Unit { int pm, pn; const char* A; const char* B; int tag; };

struct TileOrder {
    int nM, nN, nwg, G, c;
    __device__ void init(int nM_, int nN_, int G_, int c_) { nM = nM_; nN = nN_; nwg = nM * nN; G = G_; c = c_; }
    __device__ bool next(int i, int& pm, int& pn) const {
        const long L = (long)i * G + c; if (L >= nwg) return false;
        int wgid = (int)L; { const int q = nwg / NXCD, r = nwg % NXCD, xcd = wgid % NXCD, off = wgid / NXCD; wgid = (xcd < r ? xcd * (q + 1) : r * (q + 1) + (xcd - r) * q) + off; }
        const int nig = WGM * nN, gid = wgid / nig, fm = gid * WGM, gsz = (nM - fm) < WGM ? (nM - fm) : WGM;
        pm = fm + ((wgid % nig) % gsz); pn = (wgid % nig) / gsz; return true;
    }
};
struct DenseSched {
    TileOrder o; const char* A; const char* B; int lda, ldb;
    __device__ void init(const void* A_, const void* B_, int M, int N, int lda_, int ldb_) { A = (const char*)A_; B = (const char*)B_; lda = lda_; ldb = ldb_; o.init(M / BM, N / BM, gridDim.x, blockIdx.x); }
    __device__ __forceinline__ bool next(int i, Unit& u) const { if (!o.next(i, u.pm, u.pn)) return false; u.A = A + (size_t)u.pm * BM * lda * 2; u.B = B + (size_t)u.pn * BM * ldb * 2; u.tag = 0; return true; }
    __device__ __forceinline__ unsigned arow(const Unit&, int r) const { return (unsigned)r * (unsigned)lda * 2u; }
};

__device__ __forceinline__ unsigned cvt_pk_bf16(float lo, float hi) { unsigned r; asm volatile("v_cvt_pk_bf16_f32 %0, %1, %2" : "=v"(r) : "v"(lo), "v"(hi)); return r; }

template <class Epi, class Sched, bool ALIGN_EPI, bool GATHER>
__device__ __forceinline__ void gemm_phase(PG8_LAS unsigned char* lds, const int K, const int lda, const int ldb, const Sched& S, const Epi& E) {
    const int tid = TIDX(), wid = __builtin_amdgcn_readfirstlane(tid >> 6), lane = tid & 63, wr = wid >> 2, wc = wid & 3, fr = lane & 15, fq = lane >> 4;
    const int nt = K / BK;
    int sR[2], sC[2];
    unsigned voffA[2], voffB[2];
#pragma unroll
    for (int i = 0; i < 2; ++i) { stage_rc(tid * 16 + i * 8192, sR[i], sC[i]); const int Rb = Epi::PERM ? ((sR[i] & ~31) + perm32(sR[i] & 31)) : sR[i];
        voffA[i] = (unsigned)(sR[i] * lda + sC[i]) * 2u; voffB[i] = (unsigned)(Rb * ldb + sC[i]) * 2u; }
    unsigned gA[2][2], gN[2][2];
    const size_t kstep = (size_t)(BK * 2);
    const size_t hstepA = (size_t)HALF * lda * 2, hstepB = (size_t)HALF * ldb * 2;
    const unsigned ldsw = (unsigned)wid * 1024u;
    const int aoff = lds_byte(wr * 64 + fr, fq * 8), boff = lds_byte(wc * 32 + fr, fq * 8);
#define PG8_SA(b, h) (((b) * 2 + (h)) * HTB)
#define PG8_SB(b, h) ((4 + (b) * 2 + (h)) * HTB)
#define PG8_GLDS(bufoff, gptr, i_) __builtin_amdgcn_global_load_lds((const unsigned*)(gptr), (PG8_LAS unsigned*)(lds + (bufoff) + ldsw + (i_) * 8192), 16, 0, 0)
#define PG8_STAGE_B(bufoff, gbase) do { _Pragma("unroll") for (int _i = 0; _i < 2; ++_i) PG8_GLDS(bufoff, (const char*)(gbase) + voffB[_i], _i); } while (0)
#define PG8_STAGE_A(bufoff, gb, h, NX) do { _Pragma("unroll") for (int _i = 0; _i < 2; ++_i) { \
        if constexpr (GATHER) { const unsigned _o = (NX) ? gN[h][_i] : gA[h][_i]; PG8_GLDS(bufoff, (const char*)(gb) + _o, _i); } \
        else { PG8_GLDS(bufoff, (const char*)(gb) + (h) * hstepA + voffA[_i], _i); } } } while (0)
#define PG8_LDA(dst, b, h) do { _Pragma("unroll") for (int m = 0; m < 4; ++m) _Pragma("unroll") for (int k = 0; k < 2; ++k) dst[m][k] = *(const PG8_LAS bf16x8*)(lds + PG8_SA(b, h) + aoff + m * 2048 + k * 1024); } while (0)
#define PG8_LDB(dst, b, h) do { _Pragma("unroll") for (int n = 0; n < 2; ++n) _Pragma("unroll") for (int k = 0; k < 2; ++k) dst[n][k] = *(const PG8_LAS bf16x8*)(lds + PG8_SB(b, h) + boff + n * 2048 + k * 1024); } while (0)
#define PG8_MMA(ai, bj, At, Bt) do { __builtin_amdgcn_s_setprio(1); _Pragma("unroll") for (int m = 0; m < 4; ++m) _Pragma("unroll") for (int n = 0; n < 2; ++n) _Pragma("unroll") for (int k = 0; k < 2; ++k) \
        acc[ai][bj][m][n] = __builtin_amdgcn_mfma_f32_16x16x32_bf16(Bt[n][k], At[m][k], acc[ai][bj][m][n], 0, 0, 0); __builtin_amdgcn_s_setprio(0); } while (0)
#define PG8_WAIT_V(n) asm volatile("s_waitcnt vmcnt(" #n ")" ::: "memory")
#define PG8_WAIT_L(n) asm volatile("s_waitcnt lgkmcnt(" #n ")" ::: "memory")
#define PG8_BAR __builtin_amdgcn_s_barrier()
#define PG8_SCHED __builtin_amdgcn_sched_barrier(0)
#define PG8_GOFF(dst, u) do { if constexpr (GATHER) { _Pragma("unroll") for (int _h = 0; _h < 2; ++_h) _Pragma("unroll") for (int _i = 0; _i < 2; ++_i) dst[_h][_i] = S.arow(u, _h * HALF + sR[_i]) + (unsigned)sC[_i] * 2u; } } while (0)
    Unit cur, nxt; int ui = 0;
    if (!S.next(0, cur)) return;
    f32x4 acc[2][2][4][2];
#pragma unroll
    for (int a = 0; a < 2; ++a)
#pragma unroll
        for (int b = 0; b < 2; ++b)
#pragma unroll
            for (int m = 0; m < 4; ++m)
#pragma unroll
                for (int n = 0; n < 2; ++n) acc[a][b][m][n] = (f32x4){0.f, 0.f, 0.f, 0.f};
    bf16x8 At[4][2], B0[2][2], B1[2][2];
    const char* cA = cur.A; const char* cB = cur.B;
    PG8_GOFF(gA, cur);
    if constexpr (GATHER) { PG8_WAIT_V(0); }
    PG8_STAGE_B(PG8_SB(0, 0), cB); PG8_STAGE_B(PG8_SB(0, 1), cB + hstepB); PG8_STAGE_A(PG8_SA(0, 0), cA, 0, false); PG8_STAGE_A(PG8_SA(0, 1), cA, 1, false);
    if (wr == 1) PG8_BAR;
    PG8_WAIT_V(2); PG8_BAR;
    PG8_STAGE_B(PG8_SB(1, 0), cB + kstep); PG8_STAGE_A(PG8_SA(1, 0), cA + kstep, 0, false); PG8_STAGE_B(PG8_SB(1, 1), cB + hstepB + kstep);
    PG8_WAIT_V(6); PG8_BAR;
    for (;;) {
        const bool has_next = S.next(ui + 1, nxt);
        const char* nA = has_next ? nxt.A : cA; const char* nB = has_next ? nxt.B : cB;
        if constexpr (GATHER) { if (has_next) { PG8_GOFF(gN, nxt); } else {
#pragma unroll
            for (int _h = 0; _h < 2; ++_h)
#pragma unroll
                for (int _i = 0; _i < 2; ++_i) gN[_h][_i] = gA[_h][_i]; } }
        for (int t = 0; t < nt; t += 2) {
            const bool last = (t == nt - 2);
            const char* a1 = cA + (size_t)(t + 1) * kstep;
            const char* a2 = last ? nA : cA + (size_t)(t + 2) * kstep; const char* b2 = last ? nB : cB + (size_t)(t + 2) * kstep;
            const char* a3 = a2 + kstep; const char* b3 = b2 + kstep;
            PG8_LDB(B0, 0, 0); PG8_LDB(B1, 0, 1); PG8_SCHED; PG8_LDA(At, 0, 0); PG8_STAGE_A(PG8_SA(1, 1), a1, 1, false);
            PG8_WAIT_V(8); PG8_WAIT_L(0); PG8_BAR; PG8_MMA(0, 0, At, B0); PG8_MMA(0, 1, At, B1); PG8_BAR; PG8_SCHED;
            PG8_LDA(At, 0, 1); PG8_STAGE_B(PG8_SB(0, 0), b2); PG8_STAGE_B(PG8_SB(0, 1), b2 + hstepB); PG8_STAGE_A(PG8_SA(0, 0), a2, 0, last);
            PG8_WAIT_V(8); PG8_WAIT_L(0); PG8_BAR; PG8_MMA(1, 0, At, B0); PG8_MMA(1, 1, At, B1); PG8_BAR; PG8_SCHED;
            PG8_LDB(B0, 1, 0); PG8_LDB(B1, 1, 1); PG8_SCHED; PG8_LDA(At, 1, 0); PG8_STAGE_A(PG8_SA(0, 1), a2, 1, last);
            PG8_WAIT_V(8); PG8_WAIT_L(0); PG8_BAR; PG8_MMA(0, 0, At, B0); PG8_MMA(0, 1, At, B1); PG8_BAR; PG8_SCHED;
            PG8_LDA(At, 1, 1); PG8_STAGE_B(PG8_SB(1, 0), b3); PG8_STAGE_B(PG8_SB(1, 1), b3 + hstepB); PG8_STAGE_A(PG8_SA(1, 0), a3, 0, last);
            PG8_WAIT_V(8); PG8_WAIT_L(0); PG8_BAR; PG8_MMA(1, 0, At, B0); PG8_MMA(1, 1, At, B1); PG8_BAR; PG8_SCHED;
        }
        if constexpr (ALIGN_EPI) { if (wr == 0) PG8_BAR; }
        E(acc, cur, wr, wc, fr, fq);
        if (!has_next) break;
#pragma unroll
        for (int a = 0; a < 2; ++a)
#pragma unroll
            for (int b = 0; b < 2; ++b)
#pragma unroll
                for (int m = 0; m < 4; ++m)
#pragma unroll
                    for (int n = 0; n < 2; ++n) acc[a][b][m][n] = (f32x4){0.f, 0.f, 0.f, 0.f};
        cur = nxt; cA = nA; cB = nB; ++ui;
        if constexpr (GATHER) {
#pragma unroll
            for (int _h = 0; _h < 2; ++_h)
#pragma unroll
                for (int _i = 0; _i < 2; ++_i) gA[_h][_i] = gN[_h][_i]; }
        if constexpr (ALIGN_EPI) { if (wr == 1) PG8_BAR; }
    }
    PG8_WAIT_V(0);
    if constexpr (!ALIGN_EPI) { if (wr == 0) PG8_BAR; }
    PG8_BAR;
#undef PG8_SA
#undef PG8_SB
#undef PG8_GLDS
#undef PG8_STAGE_A
#undef PG8_STAGE_B
#undef PG8_LDA
#undef PG8_LDB
#undef PG8_MMA
#undef PG8_WAIT_V
#undef PG8_WAIT_L
#undef PG8_BAR
#undef PG8_SCHED
#undef PG8_GOFF
}
}

typedef float f32x4_t __attribute__((ext_vector_type(4)));
__device__ __forceinline__ int inproj_row(int j) {
    if (j < 512) { const int h = j >> 6, d = j & 63; return h * 64 + 2 * (d & 31) + (d >> 5); }
    if (j < 1280) { const int seg = (j - 512) >> 7, cc = (j - 512) & 127; int col = cc; if (seg == 2 || seg == 4) { const int g = cc >> 6, d = cc & 63; col = g * 64 + 2 * (d & 31) + (d >> 5); } return (2 + (seg >> 1)) * 256 + (seg & 1) * 128 + col; }
    if (j < 1304) return 11 * 256 + (j - 1280);
    if (j < 1560) return 5 * 256 + (j - 1304);
    if (j < 1816) return 6 * 256 + (j - 1560);
    if (j < 2328) return 7 * 256 + (j - 1816);
    if (j < 2344) return 11 * 256 + 32 + (j - 2328);
    if (j < 2856) return 9 * 256 + (j - 2344);
    if (j < 3880) return 12 * 256 + (j - 2856);
    return 16 * 256 + (j - 3880);
}
__device__ __forceinline__ unsigned pk2(float lo, float hi) { return (unsigned)f2bf(lo) | ((unsigned)f2bf(hi) << 16); }
template <class RM>
__device__ __forceinline__ void transpose_item(const float* W, int ldw, int N, bf16* WT, int ldt, float* scr, int k0, int n0, int lane, RM rm) {
    const int nn = n0 + (lane & 31);
#pragma unroll 8
    for (int i = 0; i < 32; ++i) { const int kk = 2 * i + (lane >> 5); scr[kk * 33 + (lane & 31)] = nn < N ? W[(size_t)(k0 + kk) * ldw + nn] : 0.f; }
    asm volatile("s_waitcnt lgkmcnt(0)" ::: "memory");
    const int c = lane & 7;
#pragma unroll
    for (int j = 0; j < 4; ++j) { const int n = (lane >> 3) + 8 * j; const float* s = scr + (8 * c) * 33 + n;
        uint4 o; o.x = pk2(s[0 * 33], s[1 * 33]); o.y = pk2(s[2 * 33], s[3 * 33]); o.z = pk2(s[4 * 33], s[5 * 33]); o.w = pk2(s[6 * 33], s[7 * 33]);
        const int row = (n0 + n < N) ? rm(n0 + n) : -1;
        if (row >= 0) *(uint4*)(WT + (size_t)row * ldt + k0 + 8 * c) = o; }
    asm volatile("s_waitcnt lgkmcnt(0)" ::: "memory");
}
constexpr int PREP_I_WIN = 16 * 154, PREP_I_C1 = 4 * 128, PREP_I_PN = 256, PREP_I_PG = 256, PREP_I_WO = 512, PREP_I_EXP = 3 * 32 * 256;
constexpr int PREP_ITEMS = PREP_I_WIN + PREP_I_C1 + PREP_I_PN + PREP_I_PG + PREP_I_WO + PREP_I_EXP;
__device__ __forceinline__ void prep_item(const P& p, int it, float* scr, int lane) {
    if (it < PREP_I_WIN) { const int kb = it / 154, nb = it % 154; transpose_item(p.w_in, INW, INW, p.Wt_in, 1024, scr, kb * 64, nb * 32, lane, [](int n) { return inproj_row(n); }); return; }
    it -= PREP_I_WIN;
    if (it < PREP_I_C1) { const int mat = it >> 7, r = it & 127, kb = r >> 3, nb = r & 7, kv = mat >> 1, half = mat & 1;
        const float* W = (kv ? p.cw1_v : p.cw1_k) + (size_t)half * 1024 * 256;
        transpose_item(W, 256, 256, p.Wc1 + (size_t)kv * 512 * 1024, 1024, scr, kb * 64, nb * 32, lane, [half](int n) { return half * 256 + n; }); return; }
    it -= PREP_I_C1;
    if (it < PREP_I_PN) { transpose_item(p.w_pn, 1024, 1024, p.Wpn, 512, scr, (it >> 5) * 64, (it & 31) * 32, lane, [](int n) { return n; }); return; }
    it -= PREP_I_PN;
    if (it < PREP_I_PG) { transpose_item(p.w_pg, 1024, 1024, p.Wpg, 512, scr, (it >> 5) * 64, (it & 31) * 32, lane, [](int n) { return n; }); return; }
    it -= PREP_I_PG;
    if (it < PREP_I_WO) { transpose_item(p.w_out, 1024, 1024, p.Wo, 1024, scr, (it >> 5) * 64, (it & 31) * 32, lane, [](int n) { return n; }); return; }
    it -= PREP_I_WO;
    { const int which = it / (32 * 256), r = it % (32 * 256), e = r >> 8, r2 = r & 255;
        if (which == 0) transpose_item(p.w_gate + (size_t)e * 1024 * 512, 512, 512, p.Wgu + (size_t)e * 1024 * 1024, 1024, scr, (r2 >> 4) * 64, (r2 & 15) * 32, lane, [](int n) { return (n >> 7) * 256 + (n & 127); });
        else if (which == 1) transpose_item(p.w_up + (size_t)e * 1024 * 512, 512, 512, p.Wgu + (size_t)e * 1024 * 1024, 1024, scr, (r2 >> 4) * 64, (r2 & 15) * 32, lane, [](int n) { return (n >> 7) * 256 + 128 + (n & 127); });
        else transpose_item(p.w_down + (size_t)e * 512 * 1024, 1024, 1024, p.Wd + (size_t)e * 1024 * 512, 512, scr, (r2 >> 5) * 64, (r2 & 31) * 32, lane, [](int n) { return n; }); }
}
__device__ __forceinline__ void phase_prep_(const P& p, char* smem);
__device__ __forceinline__ void prep_b1p(const P& p, char* smem);
__device__ __forceinline__ void phase_prep(const P& p, char* smem) { prep_b1p(p, smem); phase_prep_(p, smem); }
__device__ __forceinline__ void phase_prep_(const P& p, char* smem) {
    const int wave = TIDX() >> 6, lane = TIDX() & 63;
    float* scr = (float*)smem + wave * (64 * 33);
    const int gw = blockIdx.x * 8 + wave, NGW = gridDim.x * 8;
    for (int it = gw; it < PREP_ITEMS; it += NGW) prep_item(p, it, scr, lane);
    for (int i = blockIdx.x * NT + TIDX(); i < 216 * 128; i += gridDim.x * NT) { int r = i >> 7; r = r < 8 ? 24 + r : 40 + r; *(uint4*)(p.Wt_in + (size_t)(11 * 256 + r) * 1024 + (i & 127) * 8) = make_uint4(0, 0, 0, 0); }
    for (int i = blockIdx.x * NT + TIDX(); i < 36 * 1024; i += gridDim.x * NT) { const int o = i >> 10, k = i & 1023; p.wr[i] = o < 4 ? p.w_grp[k * 4 + o] : p.w_exp[k * 32 + (o - 4)]; }
    for (int vb = blockIdx.x; vb < p.T / 8; vb += gridDim.x) body_rms(p, vb);
    for (int vb = blockIdx.x; vb < p.T * 32 / NT; vb += gridDim.x) body_cs(p, vb);
}

struct EpiInA {
    static constexpr bool PERM = true;
    P p;
    __device__ __forceinline__ static void rope4(const float* cs, int t, int i0, const pg8::f32x4& v0, const pg8::f32x4& v1, float sc, pg8::u32x2& lo, pg8::u32x2& hi) {
        const f32x4_t c = *(const f32x4_t*)(cs + (size_t)t * 64 + i0), s = *(const f32x4_t*)(cs + (size_t)t * 64 + 32 + i0);
        const float a0 = (v0[0] * c[0] - v0[1] * s[0]) * sc, b0 = (v0[1] * c[0] + v0[0] * s[0]) * sc;
        const float a1 = (v0[2] * c[1] - v0[3] * s[1]) * sc, b1 = (v0[3] * c[1] + v0[2] * s[1]) * sc;
        const float a2 = (v1[0] * c[2] - v1[1] * s[2]) * sc, b2 = (v1[1] * c[2] + v1[0] * s[2]) * sc;
        const float a3 = (v1[2] * c[3] - v1[3] * s[3]) * sc, b3 = (v1[3] * c[3] + v1[2] * s[3]) * sc;
        lo.x = pk2(a0, a1); lo.y = pk2(a2, a3); hi.x = pk2(b0, b1); hi.y = pk2(b2, b3);
    }
    __device__ __forceinline__ static pg8::u32x4 pack8(const pg8::f32x4& v0, const pg8::f32x4& v1) { pg8::u32x4 w; w.x = pk2(v0[0], v0[1]); w.y = pk2(v0[2], v0[3]); w.z = pk2(v1[0], v1[1]); w.w = pk2(v1[2], v1[3]); return w; }
    __device__ __forceinline__ void operator()(const pg8::f32x4 (&acc)[2][2][4][2], const pg8::Unit& u, int wr, int wc, int fr, int fq) const {
        const int pn = u.pn, c8 = wc * 32 + 8 * fq; const size_t seg = kvseg(p);
#pragma unroll
        for (int ai = 0; ai < 2; ++ai)
#pragma unroll
            for (int m = 0; m < 4; ++m) {
                const int t = u.pm * 256 + ai * 128 + wr * 64 + m * 16 + fr; const int b = t / S, s = t % S;
#pragma unroll
                for (int bj = 0; bj < 2; ++bj) {
                    const pg8::f32x4 v0 = acc[ai][bj][m][0], v1 = acc[ai][bj][m][1];
                    if (pn <= 1) {
                        const int cq = pn * 256 + bj * 128 + c8, h = cq >> 6, i0 = (cq & 63) >> 1; pg8::u32x2 lo, hi;
                        rope4(p.cs, t, i0, v0, v1, 0.125f, lo, hi);
                        bf16* dst = p.q + (size_t)t * 512 + h * 64 + i0; *(pg8::u32x2*)dst = lo; *(pg8::u32x2*)(dst + 32) = hi;
                    } else if (pn <= 4) {
                        const int sgi = (pn - 2) * 2 + bj, g = c8 >> 6; bf16* base = p.kv6 + (size_t)sgi * seg + ((size_t)(b * 2 + g) * S + s) * 64;
                        if (bj == 0 && pn >= 3) { const int i0 = (c8 & 63) >> 1; pg8::u32x2 lo, hi; rope4(p.cs, t, i0, v0, v1, 1.f, lo, hi); *(pg8::u32x2*)(base + i0) = lo; *(pg8::u32x2*)(base + 32 + i0) = hi; }
                        else *(pg8::u32x4*)(base + (c8 & 63)) = pack8(v0, v1);
                    } else if (pn == 5) { *(pg8::u32x4*)(p.gq + (size_t)t * 256 + bj * 128 + c8) = pack8(v0 * 0.125f, v1 * 0.125f);
                    } else if (pn == 6) { *(pg8::u32x4*)(p.gk + (size_t)t * 256 + bj * 128 + c8) = pack8(v0, v1);
                    } else if (pn <= 8) { *(pg8::u32x4*)(p.gv + (size_t)t * 512 + (pn - 7) * 256 + bj * 128 + c8) = pack8(v0, v1);
                    } else if (pn <= 10) {
                        pg8::f32x4 a, c;
#pragma unroll
                        for (int e = 0; e < 4; ++e) { a[e] = siluf_(v0[e]); c[e] = siluf_(v1[e]); }
                        *(pg8::u32x4*)(p.rs + (size_t)t * 512 + (pn - 9) * 256 + bj * 128 + c8) = pack8(a, c);
                    } else {
                        if (bj == 0) {
                            if (c8 < 24) { float* d = p.gates + (size_t)t * 24 + c8;
#pragma unroll
                                for (int e = 0; e < 4; ++e) { d[e] = sigmoidf_(v0[e]); d[4 + e] = sigmoidf_(v1[e]); } }
                            else if (c8 >= 32 && c8 < 48) { float* d = p.alow + (size_t)t * 16 + (c8 - 32);
#pragma unroll
                                for (int e = 0; e < 4; ++e) { d[e] = v0[e]; d[4 + e] = v1[e]; } }
                        }
                    }
                }
            }
    }
};
struct EpiSig {
    static constexpr bool PERM = true;
    bf16* sa; bf16* sb;
    __device__ __forceinline__ void operator()(const pg8::f32x4 (&acc)[2][2][4][2], const pg8::Unit& u, int wr, int wc, int fr, int fq) const {
        bf16* base = (u.pn < 4 ? sa : sb) + (u.pn & 3) * 256 + wc * 32 + 8 * fq;
#pragma unroll
        for (int ai = 0; ai < 2; ++ai)
#pragma unroll
            for (int m = 0; m < 4; ++m) { const int t = u.pm * 256 + ai * 128 + wr * 64 + m * 16 + fr;
#pragma unroll
                for (int bj = 0; bj < 2; ++bj) { pg8::f32x4 a, c;
#pragma unroll
                    for (int e = 0; e < 4; ++e) { a[e] = sigmoidf_(acc[ai][bj][m][0][e]); c[e] = sigmoidf_(acc[ai][bj][m][1][e]); }
                    *(pg8::u32x4*)(base + (size_t)t * 1024 + bj * 128) = EpiInA::pack8(a, c); } }
    }
};
__device__ __forceinline__ void phase_inA(const P& p, char* smem) {
    pg8::DenseSched S; S.init(p.u, p.Wt_in, p.T, 3072, 1024, 1024);
    EpiInA E{p};
    pg8::gemm_phase<EpiInA, pg8::DenseSched, true, false>((PG8_LAS unsigned char*)smem, 1024, 1024, 1024, S, E);
}
__device__ __forceinline__ void phase_inB(const P& p, char* smem) {
    pg8::DenseSched S; S.init(p.u, p.Wt_in + (size_t)3072 * 1024, p.T, 2048, 1024, 1024);
    EpiSig E{p.sa, p.sb};
    pg8::gemm_phase<EpiSig, pg8::DenseSched, true, false>((PG8_LAS unsigned char*)smem, 1024, 1024, 1024, S, E);
}

struct EpiProj {
    static constexpr bool PERM = true;
    const bf16* g; bf16* mixed; int pass;
    __device__ __forceinline__ void operator()(const pg8::f32x4 (&acc)[2][2][4][2], const pg8::Unit& u, int wr, int wc, int fr, int fq) const {
        const int col0 = u.pn * 256 + wc * 32 + 8 * fq;
#pragma unroll
        for (int ai = 0; ai < 2; ++ai)
#pragma unroll
            for (int m = 0; m < 4; ++m) { const size_t t = (size_t)(u.pm * 256 + ai * 128 + wr * 64 + m * 16 + fr);
#pragma unroll
                for (int bj = 0; bj < 2; ++bj) { const size_t off = t * 1024 + col0 + bj * 128;
                    const uint4 gv = *(const uint4*)(g + off); const unsigned gw[4] = {gv.x, gv.y, gv.z, gv.w};
                    float r[8];
#pragma unroll
                    for (int e = 0; e < 4; ++e) { const float a = e < 2 ? acc[ai][bj][m][0][2 * e] : acc[ai][bj][m][1][2 * e - 4], b = e < 2 ? acc[ai][bj][m][0][2 * e + 1] : acc[ai][bj][m][1][2 * e - 3];
                        r[2 * e] = __uint_as_float(gw[e] << 16) * a; r[2 * e + 1] = __uint_as_float(gw[e] & 0xffff0000u) * b; }
                    if (pass) { const uint4 mv = *(const uint4*)(mixed + off); const unsigned mw[4] = {mv.x, mv.y, mv.z, mv.w};
#pragma unroll
                        for (int e = 0; e < 4; ++e) { r[2 * e] += __uint_as_float(mw[e] << 16); r[2 * e + 1] += __uint_as_float(mw[e] & 0xffff0000u); } }
                    uint4 o; o.x = pk2(r[0], r[1]); o.y = pk2(r[2], r[3]); o.z = pk2(r[4], r[5]); o.w = pk2(r[6], r[7]);
                    *(uint4*)(mixed + off) = o; } }
    }
};
struct EpiOut {
    static constexpr bool PERM = false;
    const float* x; float* h1;
    __device__ __forceinline__ void operator()(const pg8::f32x4 (&acc)[2][2][4][2], const pg8::Unit& u, int wr, int wc, int fr, int fq) const {
        const int col0 = u.pn * 256 + wc * 32 + 4 * fq;
#pragma unroll
        for (int ai = 0; ai < 2; ++ai)
#pragma unroll
            for (int m = 0; m < 4; ++m) { const size_t off = (size_t)(u.pm * 256 + ai * 128 + wr * 64 + m * 16 + fr) * 1024 + col0;
#pragma unroll
                for (int bj = 0; bj < 2; ++bj)
#pragma unroll
                    for (int n = 0; n < 2; ++n) { const pg8::f32x4 xv = *(const pg8::f32x4*)(x + off + bj * 128 + n * 16); *(pg8::f32x4*)(h1 + off + bj * 128 + n * 16) = xv + acc[ai][bj][m][n]; } }
    }
};
__device__ __forceinline__ void phase_proj(const P& p, char* smem) {
    { pg8::DenseSched S; S.init(p.onsa, p.Wpn, p.T, 1024, 512, 512); EpiProj E{p.sa, p.mixed, 0};
      pg8::gemm_phase<EpiProj, pg8::DenseSched, true, false>((PG8_LAS unsigned char*)smem, 512, 512, 512, S, E); }
    { pg8::DenseSched S; S.init(p.gla, p.Wpg, p.T, 1024, 512, 512); EpiProj E{p.sb, p.mixed, 1};
      pg8::gemm_phase<EpiProj, pg8::DenseSched, true, false>((PG8_LAS unsigned char*)smem, 512, 512, 512, S, E); }
}
__device__ __forceinline__ void phase_out(const P& p, char* smem) {
    pg8::DenseSched S; S.init(p.mixed, p.Wo, p.T, 1024, 1024, 1024); EpiOut E{p.x, p.h1};
    pg8::gemm_phase<EpiOut, pg8::DenseSched, true, false>((PG8_LAS unsigned char*)smem, 1024, 1024, 1024, S, E);
}

struct ExpertSched {
    const int* ub;
    const int* sb_;
    const unsigned* cnt; const int* list; int T;
    const char* A; const char* B; int lda, ldb; size_t bstride;
    int npn, G, c; bool gather;
    __device__ __forceinline__ bool next(int i, pg8::Unit& u) const {
        const int L = i * G + c; if (L >= ub[NEXP]) return false;
        int e = 0; while (L >= ub[e + 1]) ++e;
        const int rem = L - ub[e], tiles = (ub[e + 1] - ub[e]) / npn, pn = rem / tiles, pml = rem % tiles;
        u.pm = sb_[e] / 256 + pml; u.pn = pn; u.tag = e | (pml << 8);
        u.A = gather ? A : A + (size_t)u.pm * 256 * lda * 2; u.B = B + (size_t)e * bstride + (size_t)pn * 256 * ldb * 2; return true;
    }
    __device__ __forceinline__ unsigned arow(const pg8::Unit& u, int r) const {
        const int e = u.tag & 255, sl = (u.tag >> 8) * 256 + r; const int tok = list[(size_t)e * T + (sl < (int)cnt[e * 32] ? sl : 0)];
        return (unsigned)tok * (unsigned)lda * 2u;
    }
};
__device__ __forceinline__ void expert_tables(const P& p, char* smem, int npn, int*& ub, int*& sb_) {
    ub = (int*)(smem + LDS_MISC + 1024); sb_ = ub + 40;
    __syncthreads();
    if (TIDX() == 0) { int ua = 0, sa = 0; for (int e = 0; e < NEXP; ++e) { ub[e] = ua; sb_[e] = sa; const int tl = ((int)p.ctl[e * 32] + 255) >> 8; ua += tl * npn; sa += tl * 256; } ub[NEXP] = ua; sb_[NEXP] = sa; }
    __syncthreads();
}
struct EpiMoe1 {
    static constexpr bool PERM = true;
    bf16* H;
    __device__ __forceinline__ void operator()(const pg8::f32x4 (&acc)[2][2][4][2], const pg8::Unit& u, int wr, int wc, int fr, int fq) const {
        const int col0 = u.pn * 128 + wc * 32 + 8 * fq;
#pragma unroll
        for (int ai = 0; ai < 2; ++ai)
#pragma unroll
            for (int m = 0; m < 4; ++m) { const size_t row = (size_t)(u.pm * 256 + ai * 128 + wr * 64 + m * 16 + fr);
                pg8::f32x4 a, b;
#pragma unroll
                for (int e = 0; e < 4; ++e) { a[e] = siluf_(acc[ai][0][m][0][e]) * acc[ai][1][m][0][e]; b[e] = siluf_(acc[ai][0][m][1][e]) * acc[ai][1][m][1][e]; }
                *(pg8::u32x4*)(H + row * 512 + col0) = EpiInA::pack8(a, b); }
    }
};
struct EpiMoe2 {
    static constexpr bool PERM = true;
    bf16* Y;
    __device__ __forceinline__ void operator()(const pg8::f32x4 (&acc)[2][2][4][2], const pg8::Unit& u, int wr, int wc, int fr, int fq) const {
        const int col0 = u.pn * 256 + wc * 32 + 8 * fq;
#pragma unroll
        for (int ai = 0; ai < 2; ++ai)
#pragma unroll
            for (int m = 0; m < 4; ++m) { const size_t row = (size_t)(u.pm * 256 + ai * 128 + wr * 64 + m * 16 + fr);
#pragma unroll
                for (int bj = 0; bj < 2; ++bj) *(pg8::u32x4*)(Y + row * 1024 + col0 + bj * 128) = EpiInA::pack8(acc[ai][bj][m][0], acc[ai][bj][m][1]); }
    }
};
__device__ __forceinline__ void phase_moe1(const P& p, char* smem) {
    int *ub, *sb_; expert_tables(p, smem, 4, ub, sb_);
    ExpertSched S{ub, sb_, p.ctl, p.list, p.T, (const char*)p.vb, (const char*)p.Wgu, 1024, 1024, (size_t)1024 * 1024 * 2, 4, (int)gridDim.x, (int)blockIdx.x, true};
    EpiMoe1 E{p.H};
    pg8::gemm_phase<EpiMoe1, ExpertSched, true, true>((PG8_LAS unsigned char*)smem, 1024, 1024, 1024, S, E);
}
__device__ __forceinline__ void phase_moe2(const P& p, char* smem) {
    int *ub, *sb_; expert_tables(p, smem, 4, ub, sb_);
    ExpertSched S{ub, sb_, p.ctl, p.list, p.T, (const char*)p.H, (const char*)p.Wd, 512, 512, (size_t)1024 * 512 * 2, 4, (int)gridDim.x, (int)blockIdx.x, false};
    EpiMoe2 E{p.Y};
    pg8::gemm_phase<EpiMoe2, ExpertSched, true, false>((PG8_LAS unsigned char*)smem, 512, 512, 512, S, E);
}

namespace nsa {
using f32x16 = __attribute__((ext_vector_type(16))) float;
using bf16x8 = __attribute__((ext_vector_type(8))) short;
using s16x4 = __attribute__((ext_vector_type(4))) short;
using u32x4 = __attribute__((ext_vector_type(4))) unsigned;
typedef __attribute__((address_space(3))) char* lptr;
typedef __attribute__((address_space(3))) const char* lcptr;
constexpr int SLOT = 8192;
constexpr int NSLOT = 3;
constexpr int L_K = 0, L_V = NSLOT * SLOT, L_WS = 2 * NSLOT * SLOT, L_OST = L_WS + 8 * 512, L_IMPD = L_OST + 8 * 4096, L_IMPC = L_IMPD + 64 * 64 * 4, L_SEL = L_IMPC + 64 * 68 * 4, L_END = L_SEL + 64 * 8;
constexpr float LOG2E = 1.4426950408889634f, NEGM = -1e30f, M0 = -1e20f, THR = 8.f;
__device__ __forceinline__ int crow(int r, int hi) { return (r & 3) + 8 * (r >> 2) + 4 * hi; }
__device__ __forceinline__ void glds16(const void* gsrc, unsigned lds_dst) { unsigned keep;
    asm volatile("s_mov_b32 %0, m0\n\ts_mov_b32 m0, %2\n\ts_nop 0\n\tglobal_load_lds_dwordx4 %1, off\n\ts_mov_b32 m0, %0" : "=&s"(keep) : "v"(gsrc), "s"(lds_dst) : "memory"); }
#define NSA_WAIT_BAR() asm volatile("s_waitcnt vmcnt(2) lgkmcnt(0)\n\ts_barrier" ::: "memory")
#define NSA_DRAIN_BAR() asm volatile("s_waitcnt vmcnt(0) lgkmcnt(0)\n\ts_barrier" ::: "memory")
#define NSA_LWAIT() asm volatile("s_waitcnt lgkmcnt(0)" ::: "memory")
__device__ __forceinline__ unsigned cvtpk(float lo, float hi) { typedef float f2 __attribute__((ext_vector_type(2))); typedef __bf16 b2 __attribute__((ext_vector_type(2))); f2 v = {lo, hi}; b2 b = __builtin_convertvector(v, b2); return __builtin_bit_cast(unsigned, b); }
__device__ __forceinline__ float xhalf_max(float m) { auto rr = __builtin_amdgcn_permlane32_swap(__float_as_uint(m), __float_as_uint(m), false, false); return fmaxf(__uint_as_float(rr[0]), __uint_as_float(rr[1])); }
__device__ __forceinline__ float xhalf_sum(float m) { auto rr = __builtin_amdgcn_permlane32_swap(__float_as_uint(m), __float_as_uint(m), false, false); return __uint_as_float(rr[0]) + __uint_as_float(rr[1]); }
__device__ __forceinline__ void qkt(f32x16& p0, f32x16& p1, lcptr Kslot, const bf16x8* qr, int r32, int hi) {
    lcptr kb = Kslot + hi * 1024 + r32 * 16;
    p0 = f32x16{}; p1 = f32x16{};
#pragma unroll
    for (int d0 = 0; d0 < 4; ++d0) {
        const bf16x8 b0 = *(const __attribute__((address_space(3))) bf16x8*)(kb + d0 * 2048);
        const bf16x8 b1 = *(const __attribute__((address_space(3))) bf16x8*)(kb + d0 * 2048 + 512);
        p0 = __builtin_amdgcn_mfma_f32_32x32x16_bf16(b0, qr[d0], p0, 0, 0, 0); p1 = __builtin_amdgcn_mfma_f32_32x32x16_bf16(b1, qr[d0], p1, 0, 0, 0); }
}
__device__ __forceinline__ void pv(f32x16* o, int vb, bf16x8 pa0, bf16x8 pa1, bf16x8 pa2, bf16x8 pa3) {
#pragma unroll
    for (int d0 = 0; d0 < 2; ++d0) { s16x4 lo[4], hi[4];
#pragma unroll
        for (int ks = 0; ks < 4; ++ks) {
            asm volatile("ds_read_b64_tr_b16 %0,%1 offset:%c2" : "=&v"(lo[ks]) : "v"(vb), "i"(d0 * 4096 + ks * 1024) : "memory");
            asm volatile("ds_read_b64_tr_b16 %0,%1 offset:%c2" : "=&v"(hi[ks]) : "v"(vb), "i"(d0 * 4096 + ks * 1024 + 512) : "memory"); }
        asm volatile("s_waitcnt lgkmcnt(0)" ::: "memory"); __builtin_amdgcn_sched_barrier(0);
#define NSA_PK(k) (bf16x8){lo[k][0], lo[k][1], lo[k][2], lo[k][3], hi[k][0], hi[k][1], hi[k][2], hi[k][3]}
        o[d0] = __builtin_amdgcn_mfma_f32_32x32x16_bf16(pa0, NSA_PK(0), o[d0], 0, 0, 0);
        o[d0] = __builtin_amdgcn_mfma_f32_32x32x16_bf16(pa1, NSA_PK(1), o[d0], 0, 0, 0);
        o[d0] = __builtin_amdgcn_mfma_f32_32x32x16_bf16(pa2, NSA_PK(2), o[d0], 0, 0, 0);
        o[d0] = __builtin_amdgcn_mfma_f32_32x32x16_bf16(pa3, NSA_PK(3), o[d0], 0, 0, 0);
#undef NSA_PK
    }
}
__device__ __forceinline__ float rowmax32(const f32x16& p0, const f32x16& p1) {
    float a = fmaxf(p0[0], p1[0]);
#pragma unroll
    for (int r = 1; r < 16; ++r) a = fmaxf(a, fmaxf(p0[r], p1[r]));
    return xhalf_max(a);
}
struct Ctx {
    int w, lane, r32, hi, rs; unsigned lds0; lptr shm; const bf16* kt; const bf16* vt;
};
__device__ __forceinline__ void dma_kv(const Ctx& c, int tile, int slot) {
    const bf16* ksrc = c.kt + (size_t)tile * 64 * 64 + c.lane * 64 + c.w * 8;
    const bf16* vsrc = c.vt + (size_t)tile * 64 * 64 + (16 * (c.w & 3) + (c.lane >> 2)) * 64 + (c.w >> 2) * 32 + (c.lane & 3) * 8;
    glds16(ksrc, (unsigned)__builtin_amdgcn_readfirstlane(c.lds0 + L_K + slot * SLOT + c.w * 1024));
    glds16(vsrc, (unsigned)__builtin_amdgcn_readfirstlane(c.lds0 + L_V + slot * SLOT + c.w * 1024));
}
__device__ __forceinline__ void ring_begin(Ctx& c, int t0, int t1) { NSA_DRAIN_BAR(); dma_kv(c, t0, 0); dma_kv(c, t1 >= 0 ? t1 : t0, 1); c.rs = 0; }
__device__ __forceinline__ void ring_step(Ctx& c, int t2, int tcur) { NSA_WAIT_BAR(); int s2 = c.rs + 2; if (s2 >= NSLOT) s2 -= NSLOT; dma_kv(c, t2 >= 0 ? t2 : tcur, s2); }
__device__ __forceinline__ void ring_next(Ctx& c) { c.rs = (c.rs == NSLOT - 1) ? 0 : c.rs + 1; }
__device__ __forceinline__ void softmax_pv(const Ctx& c, f32x16& p0, f32x16& p1, f32x16* o, float& m, float& l, int slot) {
    const float rm = rowmax32(p0, p1);
    volatile __attribute__((address_space(3))) float* wsf = (volatile __attribute__((address_space(3))) float*)(c.shm + L_WS + c.w * 512);
    bool resc = false;
    if (__any(rm > m + THR)) { const float mn = fmaxf(m, rm); const float f = __builtin_amdgcn_exp2f(m - mn); l *= f; m = mn; if (c.hi == 0) wsf[c.r32] = f; resc = true; }
    float sacc = 0.f;
#pragma unroll
    for (int r = 0; r < 16; ++r) { p0[r] = __builtin_amdgcn_exp2f(p0[r] - m); p1[r] = __builtin_amdgcn_exp2f(p1[r] - m); sacc += p0[r] + p1[r]; }
    l += sacc;
    if (resc) { NSA_LWAIT();
#pragma unroll
        for (int r = 0; r < 16; ++r) { const float f = wsf[crow(r, c.hi)]; o[0][r] *= f; o[1][r] *= f; } }
    u32x4 w0, w1, w2, w3;
    w0 = (u32x4){cvtpk(p0[0], p0[1]), cvtpk(p0[2], p0[3]), cvtpk(p0[4], p0[5]), cvtpk(p0[6], p0[7])};
    w1 = (u32x4){cvtpk(p0[8], p0[9]), cvtpk(p0[10], p0[11]), cvtpk(p0[12], p0[13]), cvtpk(p0[14], p0[15])};
    w2 = (u32x4){cvtpk(p1[0], p1[1]), cvtpk(p1[2], p1[3]), cvtpk(p1[4], p1[5]), cvtpk(p1[6], p1[7])};
    w3 = (u32x4){cvtpk(p1[8], p1[9]), cvtpk(p1[10], p1[11]), cvtpk(p1[12], p1[13]), cvtpk(p1[14], p1[15])};
    const int vb = (int)(c.lds0 + L_V + slot * SLOT) + ((c.lane >> 4) & 1) * 32 + (c.lane & 3) * 8 + (4 * c.hi + ((c.lane & 15) >> 2)) * 64;
    pv(o, vb, __builtin_bit_cast(bf16x8, w0), __builtin_bit_cast(bf16x8, w1), __builtin_bit_cast(bf16x8, w2), __builtin_bit_cast(bf16x8, w3));
}
__device__ __forceinline__ void accum_branch(const Ctx& c, f32x16* oacc, const f32x16* o, float fac) {
    volatile __attribute__((address_space(3))) float* wsf = (volatile __attribute__((address_space(3))) float*)(c.shm + L_WS + c.w * 512);
    NSA_LWAIT(); if (c.hi == 0) wsf[64 + c.r32] = fac; NSA_LWAIT();
#pragma unroll
    for (int r = 0; r < 16; ++r) { const float f = wsf[64 + crow(r, c.hi)]; oacc[0][r] += o[0][r] * f; oacc[1][r] += o[1][r] * f; }
    NSA_LWAIT();
}
__device__ __forceinline__ void nsa_unit(const P& p, char* smem, int b, int g, int jq) {
    const int tid = TIDX(); Ctx c; c.lane = tid & 63; c.w = __builtin_amdgcn_readfirstlane(tid >> 6); c.r32 = c.lane & 31; c.hi = c.lane >> 5;
    c.shm = (lptr)smem; c.lds0 = (unsigned)(size_t)c.shm;
    const int hh = c.r32 >> 3, tokl = 8 * c.w + (c.r32 & 7), stok = 64 * jq + tokl, h = g * 4 + hh; const size_t t = (size_t)b * S + stok;
    const size_t seg = kvseg(p), ho = (size_t)(b * 2 + g) * S * 64;
    bf16x8 qr[4];
#pragma unroll
    for (int d0 = 0; d0 < 4; ++d0) qr[d0] = *(const bf16x8*)(p.q + t * 512 + h * 64 + d0 * 16 + c.hi * 8);
    const float g0 = p.gates[t * 24 + h * 3], g1 = p.gates[t * 24 + h * 3 + 1], g2 = p.gates[t * 24 + h * 3 + 2];
    f32x16 oacc[2], o[2], p0, p1; oacc[0] = f32x16{}; oacc[1] = f32x16{};
    __attribute__((address_space(3))) float* impD = (__attribute__((address_space(3))) float*)(c.shm + L_IMPD);
    __attribute__((address_space(3))) float* impC = (__attribute__((address_space(3))) float*)(c.shm + L_IMPC);
    __attribute__((address_space(3))) u64* selm = (__attribute__((address_space(3))) u64*)(c.shm + L_SEL);
    const int nv = stok >= 31 ? (stok - 31) / 16 + 1 : 0;
    const int nct = (4 * jq + 3 + 63) >> 6;
    c.kt = p.kcmp + (size_t)(b * 2 + g) * 256 * 64; c.vt = p.vcmp + (size_t)(b * 2 + g) * 256 * 64;
    float m = M0, l = 0.f;
    if (tid < 64) impC[tid * 68] = 0.f;
    ring_begin(c, 0, nct > 1 ? 1 : -1);
    for (int ct = 0; ct < nct; ++ct) {
        ring_step(c, ct + 2 < nct ? ct + 2 : -1, ct);
        qkt(p0, p1, (lcptr)(c.shm + L_K + c.rs * SLOT), qr, c.r32, c.hi); ring_next(c);
#pragma unroll
        for (int r = 0; r < 16; ++r) { const int n = 64 * ct + crow(r, c.hi); p0[r] = n < nv ? p0[r] * LOG2E : NEGM; p1[r] = n + 32 < nv ? p1[r] * LOG2E : NEGM; }
        const float rm = rowmax32(p0, p1); const float mn = fmaxf(m, rm); float sacc = 0.f;
#pragma unroll
        for (int r = 0; r < 16; ++r) sacc += __builtin_amdgcn_exp2f(p0[r] - mn) + __builtin_amdgcn_exp2f(p1[r] - mn);
        l = l * __builtin_amdgcn_exp2f(m - mn) + sacc; m = mn;
    }
    l = xhalf_sum(l); const float il = l > 0.f ? 1.f / l : 0.f;
    o[0] = f32x16{}; o[1] = f32x16{};
    ring_begin(c, 0, nct > 1 ? 1 : -1);
    for (int ct = 0; ct < nct; ++ct) {
        ring_step(c, ct + 2 < nct ? ct + 2 : -1, ct);
        qkt(p0, p1, (lcptr)(c.shm + L_K + c.rs * SLOT), qr, c.r32, c.hi);
#pragma unroll
        for (int r = 0; r < 16; ++r) { const int n = 64 * ct + crow(r, c.hi); p0[r] = n < nv ? __builtin_amdgcn_exp2f(p0[r] * LOG2E - m) * il : 0.f; p1[r] = n + 32 < nv ? __builtin_amdgcn_exp2f(p1[r] * LOG2E - m) * il : 0.f; }
#pragma unroll
        for (int hb = 0; hb < 2; ++hb)
#pragma unroll
            for (int rg = 0; rg < 4; ++rg) {
                const f32x16& pp = hb ? p1 : p0;
                float dsum = pp[4 * rg] + pp[4 * rg + 1] + pp[4 * rg + 2] + 0.5f * pp[4 * rg + 3], csum = 0.5f * pp[4 * rg + 3];
                dsum += __shfl_xor(dsum, 8); dsum += __shfl_xor(dsum, 16); csum += __shfl_xor(csum, 8); csum += __shfl_xor(csum, 16);
                const int j = 16 * ct + 8 * hb + 2 * rg + c.hi;
                if (c.r32 < 8) { impD[tokl * 64 + j] = dsum; impC[tokl * 68 + j + 1] = csum; }
            }
        u32x4 w0, w1, w2, w3;
        w0 = (u32x4){cvtpk(p0[0], p0[1]), cvtpk(p0[2], p0[3]), cvtpk(p0[4], p0[5]), cvtpk(p0[6], p0[7])};
        w1 = (u32x4){cvtpk(p0[8], p0[9]), cvtpk(p0[10], p0[11]), cvtpk(p0[12], p0[13]), cvtpk(p0[14], p0[15])};
        w2 = (u32x4){cvtpk(p1[0], p1[1]), cvtpk(p1[2], p1[3]), cvtpk(p1[4], p1[5]), cvtpk(p1[6], p1[7])};
        w3 = (u32x4){cvtpk(p1[8], p1[9]), cvtpk(p1[10], p1[11]), cvtpk(p1[12], p1[13]), cvtpk(p1[14], p1[15])};
        const int vb = (int)(c.lds0 + L_V + c.rs * SLOT) + ((c.lane >> 4) & 1) * 32 + (c.lane & 3) * 8 + (4 * c.hi + ((c.lane & 15) >> 2)) * 64;
        pv(o, vb, __builtin_bit_cast(bf16x8, w0), __builtin_bit_cast(bf16x8, w1), __builtin_bit_cast(bf16x8, w2), __builtin_bit_cast(bf16x8, w3));
        ring_next(c);
    }
    accum_branch(c, oacc, o, g0);
    NSA_LWAIT(); __builtin_amdgcn_s_barrier();
    {
        const int tk = tid >> 3, part = tid & 7; unsigned mlo = 0u, mhi = 0u;
        for (int jj = 0; jj < 8; ++jj) { const int j = part * 8 + jj; if (j > jq) break;
            const float sj = (j == 0 || j == jq || j == jq - 1) ? 1e4f : impD[tk * 64 + j] + impC[tk * 68 + j]; int rank = 0;
            for (int i = 0; i <= jq; ++i) { const float si = (i == 0 || i == jq || i == jq - 1) ? 1e4f : impD[tk * 64 + i] + impC[tk * 68 + i]; rank += (i != j && (si > sj || (si == sj && i < j))) ? 1 : 0; }
            if (rank < 16) { if (j < 32) mlo |= 1u << j; else mhi |= 1u << (j - 32); } }
        mlo |= __shfl_xor(mlo, 1); mlo |= __shfl_xor(mlo, 2); mlo |= __shfl_xor(mlo, 4); mhi |= __shfl_xor(mhi, 1); mhi |= __shfl_xor(mhi, 2); mhi |= __shfl_xor(mhi, 4);
        if (part == 0) { const u64 mk = (u64)mlo | ((u64)mhi << 32); selm[tk] = mk; p.sel[((size_t)b * S + 64 * jq + tk) * 2 + g] = mk; }
    }
    NSA_LWAIT(); __builtin_amdgcn_s_barrier();
    const u64 mysel = selm[tokl];
    u64 uni = selm[c.lane];
#pragma unroll
    for (int x = 1; x < 64; x <<= 1) { const unsigned lo_ = __shfl_xor((unsigned)uni, x), hi_ = __shfl_xor((unsigned)(uni >> 32), x); uni |= (u64)lo_ | ((u64)hi_ << 32); }
    const unsigned ulo = __builtin_amdgcn_readfirstlane((unsigned)uni), uhi = __builtin_amdgcn_readfirstlane((unsigned)(uni >> 32));
    {
        c.kt = p.kv6 + 2 * seg + ho; c.vt = p.kv6 + 3 * seg + ho;
        u64 rem = (u64)ulo | ((u64)uhi << 32);
        m = M0; l = 0.f; o[0] = f32x16{}; o[1] = f32x16{};
        int j = __builtin_ctzll(rem); rem &= rem - 1;
        int j1 = rem ? __builtin_ctzll(rem) : -1; if (rem) rem &= rem - 1;
        ring_begin(c, j, j1);
        for (;;) {
            const int j2 = rem ? __builtin_ctzll(rem) : -1; if (rem) rem &= rem - 1;
            ring_step(c, j2, j);
            qkt(p0, p1, (lcptr)(c.shm + L_K + c.rs * SLOT), qr, c.r32, c.hi);
            const bool on = (mysel >> j) & 1ull;
            if (j == jq) {
#pragma unroll
                for (int r = 0; r < 16; ++r) { const int kr = crow(r, c.hi); p0[r] = (on && kr <= tokl) ? p0[r] * LOG2E : NEGM; p1[r] = (on && kr + 32 <= tokl) ? p1[r] * LOG2E : NEGM; }
            } else { const float bias = on ? 0.f : NEGM;
#pragma unroll
                for (int r = 0; r < 16; ++r) { p0[r] = p0[r] * LOG2E + bias; p1[r] = p1[r] * LOG2E + bias; } }
            softmax_pv(c, p0, p1, o, m, l, c.rs); ring_next(c);
            if (j1 < 0) break; j = j1; j1 = j2;
        }
        l = xhalf_sum(l);
        accum_branch(c, oacc, o, g1 / l);
    }
    {
        c.kt = p.kv6 + 4 * seg + ho; c.vt = p.kv6 + 5 * seg + ho;
        const int j0 = jq >= 8 ? jq - 8 : 0;
        m = M0; l = 0.f; o[0] = f32x16{}; o[1] = f32x16{};
        ring_begin(c, j0, j0 + 1 <= jq ? j0 + 1 : -1);
        for (int j = j0; j <= jq; ++j) {
            ring_step(c, j + 2 <= jq ? j + 2 : -1, j);
            qkt(p0, p1, (lcptr)(c.shm + L_K + c.rs * SLOT), qr, c.r32, c.hi);
            const bool lowt = (jq >= 8 && j == jq - 8), diag = (j == jq);
            if (diag || lowt) {
#pragma unroll
                for (int r = 0; r < 16; ++r) { const int kr = crow(r, c.hi);
                    const bool v0 = diag ? (kr <= tokl) : (kr > tokl), v1 = diag ? (kr + 32 <= tokl) : (kr + 32 > tokl);
                    p0[r] = v0 ? p0[r] * LOG2E : NEGM; p1[r] = v1 ? p1[r] * LOG2E : NEGM; }
            } else {
#pragma unroll
                for (int r = 0; r < 16; ++r) { p0[r] *= LOG2E; p1[r] *= LOG2E; } }
            softmax_pv(c, p0, p1, o, m, l, c.rs); ring_next(c);
        }
        l = xhalf_sum(l);
        accum_branch(c, oacc, o, g2 / l);
    }
    {
        __attribute__((address_space(3))) bf16* stg = (__attribute__((address_space(3))) bf16*)(c.shm + L_OST + c.w * 4096);
#pragma unroll
        for (int r = 0; r < 16; ++r) { const int orow = crow(r, c.hi);
#pragma unroll
            for (int d0 = 0; d0 < 2; ++d0) stg[orow * 64 + d0 * 32 + c.r32] = f2bf(oacc[d0][r]); }
        NSA_LWAIT();
#pragma unroll
        for (int i = 0; i < 4; ++i) { const int row = i * 8 + (c.lane >> 3), ch = c.lane & 7; const u32x4 v = *(const __attribute__((address_space(3))) u32x4*)(stg + row * 64 + ch * 8);
            const int rh = row >> 3, rt = 8 * c.w + (row & 7);
            *(u32x4*)(p.onsa + ((size_t)b * S + 64 * jq + rt) * 512 + (g * 4 + rh) * 64 + ch * 8) = v; }
    }
    NSA_DRAIN_BAR();
}
}
__device__ __forceinline__ void phase_nsa(const P& p, char* smem) {
    const int nunits = p.nb * 2 * 64;
    const int G = gridDim.x; int r = 0;
    for (int base = 0; base < nunits; base += G, ++r) {
        const int w = (r & 1) ? G - 1 - (int)blockIdx.x : (int)blockIdx.x, i = base + w; if (i >= nunits) continue;
        const int jq = 63 - i / (p.nb * 2), bg = i % (p.nb * 2); nsa::nsa_unit(p, smem, bg >> 1, bg & 1, jq); }
}

namespace gla {
using nsa::f32x16; using nsa::bf16x8; using nsa::s16x4; using nsa::u32x4; using nsa::lptr; using nsa::lcptr; using nsa::crow; using nsa::cvtpk;
typedef unsigned u32x2 __attribute__((ext_vector_type(2)));
constexpr int L_KI = 0, L_QI = 8192, L_VI = 16384, L_SI = 32768, L_OST = 49152, L_TOT = L_OST + 64 * 132 * 4, L_END = L_TOT + 8 * 64 * 4 + 64 * 4;
__device__ __forceinline__ int koff(int row, int d) { return (d >> 3) * 1024 + row * 16 + (d & 7) * 2; }
__device__ __forceinline__ int voff(int row, int col) { return ((col >> 5) * 4 + (row >> 4)) * 1024 + (row & 15) * 64 + (col & 31) * 2; }
__device__ __forceinline__ bf16x8 trfrag(unsigned img, int ks, int cb, int lane) {
    const int hi = lane >> 5; const unsigned a = img + (cb * 4 + ks) * 1024 + ((lane >> 4) & 1) * 32 + (lane & 3) * 8 + (4 * hi + ((lane & 15) >> 2)) * 64;
    s16x4 lo, hh;
    asm volatile("ds_read_b64_tr_b16 %0,%1" : "=&v"(lo) : "v"(a) : "memory");
    asm volatile("ds_read_b64_tr_b16 %0,%1 offset:512" : "=&v"(hh) : "v"(a) : "memory");
    asm volatile("s_waitcnt lgkmcnt(0)" ::: "memory"); __builtin_amdgcn_sched_barrier(0);
    return (bf16x8){lo[0], lo[1], lo[2], lo[3], hh[0], hh[1], hh[2], hh[3]};
}
template <int GM> __device__ __forceinline__ void chunk_images(const P& p, lptr shm, int b, int h, int c, int tid) {
    const int d = tid & 63, tg = tid >> 6; const size_t t0 = (size_t)b * S + c * 64;
    __attribute__((address_space(3))) float* tot = (__attribute__((address_space(3))) float*)(shm + L_TOT);
    float wa[16];
#pragma unroll
    for (int r = 0; r < 16; ++r) wa[r] = p.w_a2[r * 256 + h * 64 + d];
    const float ba = p.b_a[h * 64 + d];
    float loc[8]; float run = 0.f;
#pragma unroll
    for (int i = 0; i < 8; ++i) { const float* al = p.alow + (t0 + tg * 8 + i) * 16; float z = ba;
#pragma unroll
        for (int r = 0; r < 16; ++r) z += al[r] * wa[r];
        const float ls = fminf(z, 0.f) - log1pf(__expf(-fabsf(z))); run += ls * (1.f / 16.f); loc[i] = run; }
    tot[tg * 64 + d] = run;
#pragma unroll
    for (int k = 0; k < 2; ++k) { const int idx = tid + k * 512, s = idx >> 4, e = (idx & 15) * 8; *(__attribute__((address_space(3))) u32x4*)(shm + L_VI + voff(s, e)) = *(const u32x4*)(p.gv + (t0 + s) * 512 + h * 128 + e); }
    __syncthreads();
    float pre = 0.f, all = 0.f;
#pragma unroll
    for (int g = 0; g < 8; ++g) { const float x = tot[g * 64 + d]; all += x; pre += g < tg ? x : 0.f; }
#pragma unroll
    for (int i = 0; i < 8; ++i) { const int t = tg * 8 + i; const float bb = pre + loc[i]; const float kk = bf2f(p.gk[(t0 + t) * 256 + h * 64 + d]);
        if (GM == 0) { *(__attribute__((address_space(3))) bf16*)(shm + L_KI + voff(t, d)) = f2bf(kk * __expf(all - bb)); }
        else { const float qq = bf2f(p.gq[(t0 + t) * 256 + h * 64 + d]);
            *(__attribute__((address_space(3))) bf16*)(shm + L_KI + koff(t, d)) = f2bf(kk * __expf(-bb)); *(__attribute__((address_space(3))) bf16*)(shm + L_QI + koff(t, d)) = f2bf(qq * __expf(bb)); } }
    if (GM == 0 && tg == 0) p.gdec[((size_t)(b * 4 + h) * 64 + c) * 64 + d] = __expf(all);
    __syncthreads();
}
__device__ __forceinline__ void g1_chunk(const P& p, char* smem, int b, int h, int c) {
    const int tid = TIDX(), lane = tid & 63, w = __builtin_amdgcn_readfirstlane(tid >> 6), r32 = lane & 31, hi = lane >> 5;
    lptr shm = (lptr)smem; const unsigned l0 = (unsigned)(size_t)shm;
    chunk_images<0>(p, shm, b, h, c, tid);
    const int db = w & 1, eb = w >> 1; f32x16 acc = f32x16{};
#pragma unroll
    for (int ks = 0; ks < 4; ++ks) { const bf16x8 a = trfrag(l0 + L_KI, ks, db, lane), bq = trfrag(l0 + L_VI, ks, eb, lane); acc = __builtin_amdgcn_mfma_f32_32x32x16_bf16(a, bq, acc, 0, 0, 0); }
    float* U = p.gst + ((size_t)(b * 4 + h) * 64 + c) * (64 * 128);
#pragma unroll
    for (int r = 0; r < 16; ++r) U[(32 * db + crow(r, hi)) * 128 + 32 * eb + r32] = acc[r];
    __syncthreads();
}
__device__ __forceinline__ void g3_chunk(const P& p, char* smem, int b, int h, int c) {
    const int tid = TIDX(), lane = tid & 63, w = __builtin_amdgcn_readfirstlane(tid >> 6), r32 = lane & 31, hi = lane >> 5;
    lptr shm = (lptr)smem; const unsigned l0 = (unsigned)(size_t)shm; const size_t t0 = (size_t)b * S + c * 64;
    const float* St = p.gst + ((size_t)(b * 4 + h) * 64 + c) * (64 * 128);
    float4 sv[4];
#pragma unroll
    for (int k = 0; k < 4; ++k) sv[k] = *(const float4*)(St + (size_t)(tid + k * 512) * 4);
    chunk_images<1>(p, shm, b, h, c, tid);
#pragma unroll
    for (int k = 0; k < 4; ++k) { const int idx = (tid + k * 512) * 4, dd = idx >> 7, e = idx & 127; u32x2 o; o.x = cvtpk(sv[k].x, sv[k].y); o.y = cvtpk(sv[k].z, sv[k].w);
        *(__attribute__((address_space(3))) u32x2*)(shm + L_SI + voff(dd, e)) = o; }
    __syncthreads();
    const int tb = w & 1, eb = w >> 1, trow = 32 * tb + r32;
    f32x16 p0 = f32x16{}, p1 = f32x16{}, o = f32x16{};
    {
        lcptr kb = (lcptr)(shm + L_KI) + hi * 1024 + r32 * 16; lcptr qb = (lcptr)(shm + L_QI) + hi * 1024 + trow * 16;
#pragma unroll
        for (int d0 = 0; d0 < 4; ++d0) {
            const bf16x8 b0 = *(const __attribute__((address_space(3))) bf16x8*)(kb + d0 * 2048), b1 = *(const __attribute__((address_space(3))) bf16x8*)(kb + d0 * 2048 + 512);
            const bf16x8 qf = *(const __attribute__((address_space(3))) bf16x8*)(qb + d0 * 2048);
            p0 = __builtin_amdgcn_mfma_f32_32x32x16_bf16(b0, qf, p0, 0, 0, 0); p1 = __builtin_amdgcn_mfma_f32_32x32x16_bf16(b1, qf, p1, 0, 0, 0); }
    }
#pragma unroll
    for (int r = 0; r < 16; ++r) { const int s = crow(r, hi); p0[r] = s <= trow ? p0[r] : 0.f; p1[r] = s + 32 <= trow ? p1[r] : 0.f; }
#pragma unroll
    for (int ds = 0; ds < 4; ++ds) {
        const u32x2 a0 = *(const __attribute__((address_space(3))) u32x2*)(shm + L_QI + (2 * ds) * 1024 + trow * 16 + 8 * hi), a1 = *(const __attribute__((address_space(3))) u32x2*)(shm + L_QI + (2 * ds + 1) * 1024 + trow * 16 + 8 * hi);
        const u32x4 aw = {a0.x, a0.y, a1.x, a1.y};
        const bf16x8 bq = trfrag(l0 + L_SI, ds, eb, lane);
        o = __builtin_amdgcn_mfma_f32_32x32x16_bf16(__builtin_bit_cast(bf16x8, aw), bq, o, 0, 0, 0); }
    {
        const u32x4 w0 = {cvtpk(p0[0], p0[1]), cvtpk(p0[2], p0[3]), cvtpk(p0[4], p0[5]), cvtpk(p0[6], p0[7])}, w1 = {cvtpk(p0[8], p0[9]), cvtpk(p0[10], p0[11]), cvtpk(p0[12], p0[13]), cvtpk(p0[14], p0[15])};
        const u32x4 w2 = {cvtpk(p1[0], p1[1]), cvtpk(p1[2], p1[3]), cvtpk(p1[4], p1[5]), cvtpk(p1[6], p1[7])}, w3 = {cvtpk(p1[8], p1[9]), cvtpk(p1[10], p1[11]), cvtpk(p1[12], p1[13]), cvtpk(p1[14], p1[15])};
        o = __builtin_amdgcn_mfma_f32_32x32x16_bf16(__builtin_bit_cast(bf16x8, w0), trfrag(l0 + L_VI, 0, eb, lane), o, 0, 0, 0);
        o = __builtin_amdgcn_mfma_f32_32x32x16_bf16(__builtin_bit_cast(bf16x8, w1), trfrag(l0 + L_VI, 1, eb, lane), o, 0, 0, 0);
        o = __builtin_amdgcn_mfma_f32_32x32x16_bf16(__builtin_bit_cast(bf16x8, w2), trfrag(l0 + L_VI, 2, eb, lane), o, 0, 0, 0);
        o = __builtin_amdgcn_mfma_f32_32x32x16_bf16(__builtin_bit_cast(bf16x8, w3), trfrag(l0 + L_VI, 3, eb, lane), o, 0, 0, 0);
    }
    __attribute__((address_space(3))) float* ost = (__attribute__((address_space(3))) float*)(shm + L_OST);
#pragma unroll
    for (int r = 0; r < 16; ++r) ost[(32 * tb + crow(r, hi)) * 132 + 32 * eb + r32] = o[r];
    __syncthreads();
    { const int t = tid >> 3, part = tid & 7; float v[16]; float ss = 0.f;
#pragma unroll
        for (int k = 0; k < 4; ++k) { const f32x4_t x = *(const __attribute__((address_space(3))) f32x4_t*)(ost + t * 132 + part * 16 + k * 4); v[4 * k] = x[0]; v[4 * k + 1] = x[1]; v[4 * k + 2] = x[2]; v[4 * k + 3] = x[3]; ss += x[0] * x[0] + x[1] * x[1] + x[2] * x[2] + x[3] * x[3]; }
        ss += __shfl_xor(ss, 1); ss += __shfl_xor(ss, 2); ss += __shfl_xor(ss, 4);
        const float rstd = rsqrtf(ss * (1.f / 128.f) + 1e-6f);
        const size_t go = (t0 + t) * 512 + h * 128 + part * 16;
        const uint4 r0 = *(const uint4*)(p.rs + go), r1 = *(const uint4*)(p.rs + go + 8); const unsigned rw[8] = {r0.x, r0.y, r0.z, r0.w, r1.x, r1.y, r1.z, r1.w};
        unsigned ow[8];
#pragma unroll
        for (int k = 0; k < 8; ++k) { const float ga = p.norm_g[h * 128 + part * 16 + 2 * k], gb = p.norm_g[h * 128 + part * 16 + 2 * k + 1];
            ow[k] = pk2(v[2 * k] * rstd * ga * __uint_as_float(rw[k] << 16), v[2 * k + 1] * rstd * gb * __uint_as_float(rw[k] & 0xffff0000u)); }
        *(uint4*)(p.gla + go) = make_uint4(ow[0], ow[1], ow[2], ow[3]); *(uint4*)(p.gla + go + 8) = make_uint4(ow[4], ow[5], ow[6], ow[7]); }
    __syncthreads();
}
}
__device__ __forceinline__ void phase_gla1(const P& p, char* smem) {
    const int n = p.nb * 4 * 64;
    for (int i = blockIdx.x; i < n; i += gridDim.x) gla::g1_chunk(p, smem, i >> 8, (i >> 6) & 3, i & 63);
}
__device__ __forceinline__ void phase_gla2(const P& p) {
    const int n = p.nb * 4 * 8192;
    for (int idx = blockIdx.x * NT + TIDX(); idx < n; idx += gridDim.x * NT) {
        const int bh = idx >> 13, de = idx & 8191, d = de >> 7; float* U = p.gst + (size_t)bh * 64 * 8192 + de; const float* gd = p.gdec + (size_t)bh * 64 * 64 + d;
        float s = 0.f;
        for (int c0 = 0; c0 < 64; c0 += 8) { float tmp[8], g[8];
#pragma unroll
            for (int k = 0; k < 8; ++k) { tmp[k] = U[(size_t)(c0 + k) * 8192]; g[k] = gd[(c0 + k) * 64]; }
#pragma unroll
            for (int k = 0; k < 8; ++k) { U[(size_t)(c0 + k) * 8192] = s; s = g[k] * s + tmp[k]; } }
    }
}
__device__ __forceinline__ void phase_gla3(const P& p, char* smem) {
    const int n = p.nb * 4 * 64;
    for (int i = blockIdx.x; i < n; i += gridDim.x) gla::g3_chunk(p, smem, i >> 8, (i >> 6) & 3, i & 63);
}

struct CmpSched {
    const char* kc; const char* Wc1; float* Pc; int nM, G, c; size_t aseg, pseg;
    __device__ __forceinline__ bool next(int i, pg8::Unit& u) const {
        const int L = i * G + c, per = nM * 2 * 2; if (L >= 2 * per) return false;
        const int kv = L / per, r = L % per, ks = r & 1, pn = (r >> 1) & 1, pm = r >> 2;
        u.pm = pm; u.pn = pn; u.tag = kv * 2 + ks;
        u.A = kc + (size_t)kv * aseg + (size_t)pm * 256 * 1024 * 2 + ks * 512 * 2; u.B = Wc1 + ((size_t)kv * 512 + pn * 256) * 1024 * 2 + ks * 512 * 2; return true;
    }
    __device__ __forceinline__ unsigned arow(const pg8::Unit&, int r) const { return (unsigned)r * 2048u; }
};
struct EpiCmp {
    static constexpr bool PERM = false;
    float* Pc; size_t pseg;
    __device__ __forceinline__ void operator()(const pg8::f32x4 (&acc)[2][2][4][2], const pg8::Unit& u, int wr, int wc, int fr, int fq) const {
        float* base = Pc + (size_t)u.tag * pseg; const int col0 = u.pn * 256 + wc * 32 + 4 * fq;
#pragma unroll
        for (int ai = 0; ai < 2; ++ai)
#pragma unroll
            for (int m = 0; m < 4; ++m) { float* rowp = base + (size_t)(u.pm * 256 + ai * 128 + wr * 64 + m * 16 + fr) * 512 + col0;
#pragma unroll
                for (int bj = 0; bj < 2; ++bj)
#pragma unroll
                    for (int n = 0; n < 2; ++n) *(pg8::f32x4*)(rowp + bj * 128 + n * 16) = acc[ai][bj][m][n]; }
    }
};
__device__ __forceinline__ void phase_cmp1(const P& p, char* smem) {
    const int nrows = p.nb * 2 * 256;
    CmpSched Sc{(const char*)p.kv6, (const char*)p.Wc1, p.pcmp, nrows / 256, (int)gridDim.x, (int)blockIdx.x, kvseg(p) * 2, (size_t)(nrows + 8) * 512};
    EpiCmp E{p.pcmp, (size_t)(nrows + 8) * 512};
    pg8::gemm_phase<EpiCmp, CmpSched, true, false>((PG8_LAS unsigned char*)smem, 512, 1024, 1024, Sc, E);
}
__device__ __forceinline__ void body_cmp2f(const P& p, int vb, char* smem) {
    const int tid = TIDX(); const int nrows = p.nb * 2 * 256, nvb1 = nrows / 16; const int kv = vb / nvb1, row0 = (vb % nvb1) * 16;
    const size_t pseg = (size_t)(nrows + 8) * 512; const float* P0 = p.pcmp + (size_t)(kv * 2) * pseg; const float* P1 = P0 + pseg;
    float* hs = (float*)smem;
    float* w2s = (float*)smem + 16 * 256;
    __syncthreads();
    { const float4* wsrc = (const float4*)(kv ? p.cw2_v : p.cw2_k);
#pragma unroll
      for (int k = 0; k < 8; ++k) ((float4*)w2s)[tid + k * 512] = wsrc[tid + k * 512]; }
#pragma unroll
    for (int k = 0; k < 8; ++k) { const int idx = tid + k * 512, rr = idx >> 8, n = idx & 255; const size_t m = (size_t)(row0 + rr);
        const float z = P0[m * 512 + n] + P1[m * 512 + n] + P0[(m + 1) * 512 + 256 + n] + P1[(m + 1) * 512 + 256 + n] + p.b1p[kv * 256 + n];
        hs[idx] = geluf_(z); }
    __syncthreads();
    const int rr = tid >> 5, i = tid & 31, row = row0 + rr;
    const float* h = hs + rr * 256; const float* b2 = kv ? p.cb2_v : p.cb2_k;
    float z1 = b2[i], z2 = b2[i + 32];
#pragma unroll 8
    for (int n = 0; n < 256; ++n) { const float hv = h[n]; z1 += hv * w2s[n * 64 + i]; z2 += hv * w2s[n * 64 + i + 32]; }
    bf16* dst = (kv ? p.vcmp : p.kcmp) + (size_t)row * 64;
    if (kv == 0) {
        const int bg = row >> 8, m = row & 255, b = bg >> 1; int sp = 16 * m + 31; if (sp > S - 1) sp = S - 1;
        const size_t t = (size_t)b * S + sp; const float c = p.cs[t * 64 + i], sn = p.cs[t * 64 + 32 + i];
        const float r1 = z1 * c - z2 * sn, r2 = z2 * c + z1 * sn; z1 = r1; z2 = r2;
    }
    dst[i] = f2bf(z1); dst[i + 32] = f2bf(z2);
}
__device__ __forceinline__ void phase_cmp2(const P& p, char* smem) {
    const int n = 2 * (p.nb * 2 * 256) / 16;
    for (int vb = blockIdx.x; vb < n; vb += gridDim.x) body_cmp2f(p, vb, smem);
}
__device__ __forceinline__ void prep_b1p(const P& p, char* smem) {
    if (blockIdx.x >= 2) return;
    const int tid = TIDX(), kv = blockIdx.x, n = tid & 255, half = tid >> 8;
    const float* pe = kv ? p.cpos_v : p.cpos_k; const float* w1 = kv ? p.cw1_v : p.cw1_k; const float* b1 = kv ? p.cb1_v : p.cb1_k;
    float a = 0.f;
    for (int f = half * 1024; f < half * 1024 + 1024; ++f) a += pe[f] * w1[(size_t)f * 256 + n];
    float* sc = (float*)(smem + LDS_MISC);
    __syncthreads();
    if (half == 1) sc[n] = a;
    __syncthreads();
    if (half == 0) p.b1p[kv * 256 + n] = a + sc[n] + b1[n];
    __syncthreads();
}

#define XB_TMO      128
#define XB_XCNT(j)  (256  + 64 * (j))
#define XB_XSUB(j)  (1280 + 64 * (j))
#define XB_XGEN(j)  (2304 + 64 * (j))
#define XB_TOP      3328
#define XB_TOPGEN   3392
#define XCD_BAR_WORDS 3456
#define XB_SPIN_CAP (1u << 18)
#define XLAS __attribute__((address_space(3)))
__device__ __forceinline__ unsigned xb_ld(unsigned* p)              { return __hip_atomic_load(p, __ATOMIC_RELAXED, __HIP_MEMORY_SCOPE_AGENT); }
__device__ __forceinline__ unsigned xb_add(unsigned* p, unsigned v) { return __hip_atomic_fetch_add(p, v, __ATOMIC_RELAXED, __HIP_MEMORY_SCOPE_AGENT); }
__device__ __forceinline__ unsigned xb_xcc_id() { return (unsigned)__builtin_amdgcn_s_getreg((3 << 11) | 20) & 0xFu; }
#define XB_SPIN(cond, bar) do { unsigned _sp = 0; while (cond) { __builtin_amdgcn_s_sleep(1); \
    if ((++_sp & 255u) == 0u) { if (xb_ld(&(bar)[XB_TMO])) break; if (_sp > XB_SPIN_CAP) { atomicAdd(&(bar)[XB_TMO], 1u); break; } } } } while (0)
struct XcdBarrier { unsigned* bar; unsigned x; volatile XLAS unsigned* st; };
__device__ __forceinline__ XcdBarrier xcd_barrier_post(unsigned* bar, volatile XLAS unsigned* st) {
    XcdBarrier b; b.bar = bar; b.x = xb_xcc_id(); b.st = st;
    if (TIDX() == 0) (void)xb_add(&bar[XB_XCNT(b.x)], 1u);
    return b;
}
__device__ __forceinline__ void xcd_barrier_complete(unsigned* bar, unsigned x, unsigned& nloc, unsigned& nx) {
    const unsigned G = gridDim.x * gridDim.y * gridDim.z;
    unsigned sum, cnt, mine, sp = 0u;
    for (;;) {
        sum = 0u; cnt = 0u; mine = 0u;
#pragma unroll
        for (unsigned j = 0; j < 16; ++j) { const unsigned c = xb_ld(&bar[XB_XCNT(j)]); sum += c; cnt += (c > 0u) ? 1u : 0u; mine = (j == x) ? c : mine; }
        if (sum == G) break;
        __builtin_amdgcn_s_sleep(1);
        if ((++sp & 255u) == 0u) { if (xb_ld(&bar[XB_TMO])) break; if (sp > XB_SPIN_CAP) { atomicAdd(&bar[XB_TMO], 1u); break; } }
    }
    nloc = mine > 0u ? mine : 1u; nx = cnt > 0u ? cnt : 1u;
}
__device__ __forceinline__ void xcd_barrier(const XcdBarrier& b) {
    asm volatile("s_waitcnt vmcnt(0)" ::: "memory");
    __syncthreads();
    if (TIDX() == 0) {
        unsigned* bar = b.bar;
        __builtin_amdgcn_s_waitcnt(0);
        unsigned nloc = b.st[0], nx = b.st[1];
        if (nloc == 0u) { xcd_barrier_complete(bar, b.x, nloc, nx); b.st[0] = nloc; b.st[1] = nx; }
        const unsigned old = xb_add(&bar[XB_XSUB(b.x)], 1u);
        const unsigned gen = old / nloc;
        if (old + 1u == (gen + 1u) * nloc) {
            __builtin_amdgcn_fence(__ATOMIC_RELEASE, "agent");
            asm volatile("s_waitcnt vmcnt(0)" ::: "memory");
            const unsigned og = xb_add(&bar[XB_TOP], 1u);
            const unsigned tg = og / nx;
            if (og + 1u == (tg + 1u) * nx) xb_add(&bar[XB_TOPGEN], 1u);
            else XB_SPIN(xb_ld(&bar[XB_TOPGEN]) == tg, bar);
            __builtin_amdgcn_fence(__ATOMIC_ACQUIRE, "agent");
            xb_add(&bar[XB_XGEN(b.x)], 1u);
            asm volatile("s_waitcnt vmcnt(0)" ::: "memory");
        } else {
            XB_SPIN(xb_ld(&bar[XB_XGEN(b.x)]) == gen, bar);
            __builtin_amdgcn_fence(__ATOMIC_ACQUIRE, "agent");
            asm volatile("s_waitcnt vmcnt(0)" ::: "memory");
        }
    }
    __syncthreads();
}

template <int ST> __device__ __forceinline__ void run_stage(const P& p, char* smem, int first, int stride) {
    const int nvb = stage_nvb(ST, p.T);
    for (int vb = first; vb < nvb; vb += stride) {
        if constexpr (ST == ST_RMS) body_rms(p, vb);
        else if constexpr (ST == ST_CS) body_cs(p, vb);
        else if constexpr (ST == ST_INPROJ) body_inproj(p, vb, smem);
        else if constexpr (ST == ST_CMP1) body_cmp1(p, vb, smem);
        else if constexpr (ST == ST_CMP2) body_cmp2(p, vb);
        else if constexpr (ST == ST_NSACMP) body_nsacmp(p, vb, smem);
        else if constexpr (ST == ST_NSAATT) body_nsaatt(p, vb);
        else if constexpr (ST == ST_GLAA) body_glaa(p, vb);
        else if constexpr (ST == ST_GLASCAN) body_glascan(p, vb, smem);
        else if constexpr (ST == ST_GLANORM) body_glanorm(p, vb);
        else if constexpr (ST == ST_PROJ) body_proj(p, vb, smem);
        else if constexpr (ST == ST_OUT) body_out(p, vb, smem);
        else if constexpr (ST == ST_ROUTE) body_route(p, vb, smem);
        else if constexpr (ST == ST_MOE1) body_moe1(p, vb, smem);
        else if constexpr (ST == ST_MOE2) body_moe2(p, vb, smem);
        else if constexpr (ST == ST_FINAL) body_final(p, vb, smem);
    }
}
template <int ST> __global__ void __launch_bounds__(NT) k_stage(P p) {
    extern __shared__ __attribute__((aligned(16))) char smem[];
    run_stage<ST>(p, smem, blockIdx.x, gridDim.x);
}
__global__ void __launch_bounds__(NT) k_mega(P p) {
    extern __shared__ __attribute__((aligned(16))) char smem[];
    cg::grid_group grid = cg::this_grid();
    const int b0 = blockIdx.x, G = gridDim.x;
    volatile XLAS unsigned* xst = (volatile XLAS unsigned*)((XLAS char*)smem + LDS_MISC + 3072);
    if (TIDX() < 4) xst[TIDX()] = 0u;
    __syncthreads();
    const XcdBarrier xb = xcd_barrier_post(p.ctl + 4096, xst);
#define GSYNC() xcd_barrier(xb)
#define DUPRUN(k, stmt) do { if (DUP == (k)) { stmt; GSYNC(); } } while (0)
    phase_prep(p, smem); grid.sync();
    phase_inA(p, smem); GSYNC();                               DUPRUN(7, phase_inA(p, smem));
    phase_cmp1(p, smem); phase_gla1(p, smem); GSYNC();         DUPRUN(8, phase_cmp1(p, smem)); DUPRUN(4, phase_gla1(p, smem));
    phase_cmp2(p, smem); phase_gla2(p); GSYNC();               DUPRUN(9, phase_cmp2(p, smem));
    phase_nsa(p, smem); phase_gla3(p, smem); GSYNC();          DUPRUN(1, phase_nsa(p, smem)); DUPRUN(2, phase_gla3(p, smem));
    phase_inB(p, smem); GSYNC();                               DUPRUN(11, phase_inB(p, smem));
    phase_proj(p, smem); GSYNC();                              DUPRUN(12, phase_proj(p, smem));
    phase_out(p, smem); GSYNC();                               DUPRUN(13, phase_out(p, smem));
    if (DUP == 17) { P p2 = p; p2.ctl = p.ctl + 8192; p2.vb = p.sa; p2.list = (int*)p.mixed; p2.tokslot = (int*)p.mixed + (1 << 20); p2.tokexp = (int*)p.mixed + (2 << 20); p2.tokw = (float*)p.mixed + (3 << 20);
        for (int vb = b0; vb < p.T / 64; vb += G) body_route3(p2, vb, smem);
        GSYNC(); }
    for (int vb = b0; vb < p.T / 64; vb += G) body_route3(p, vb, smem);
    GSYNC();
    phase_moe1(p, smem); GSYNC();                              DUPRUN(6, phase_moe1(p, smem));
    phase_moe2(p, smem); GSYNC();                              DUPRUN(14, phase_moe2(p, smem));
    if (DUP == 15) { GSYNC(); GSYNC(); GSYNC(); GSYNC(); GSYNC(); GSYNC(); GSYNC(); GSYNC(); GSYNC(); GSYNC(); }
    if (DUP == 16) { P p2 = p; p2.out = (float*)p.sb; run_stage<ST_FINAL>(p2, smem, b0, G); GSYNC(); }
    run_stage<ST_FINAL>(p, smem, b0, G);
#undef DUPRUN
#undef GSYNC
}

enum Phase { PH_PREP = 0, PH_INA, PH_INB, PH_PROJ, PH_OUT, PH_MOE1, PH_MOE2, PH_NSA, PH_GLA1, PH_GLA2, PH_GLA3, PH_CMP1, PH_CMP2 };
template <int PH> __global__ void __launch_bounds__(NT) k_phase(P p) {
    extern __shared__ __attribute__((aligned(16))) char smem[];
    if constexpr (PH == PH_PREP) phase_prep(p, smem);
    else if constexpr (PH == PH_INA) phase_inA(p, smem);
    else if constexpr (PH == PH_INB) phase_inB(p, smem);
    else if constexpr (PH == PH_PROJ) phase_proj(p, smem);
    else if constexpr (PH == PH_OUT) phase_out(p, smem);
    else if constexpr (PH == PH_MOE1) phase_moe1(p, smem);
    else if constexpr (PH == PH_MOE2) phase_moe2(p, smem);
    else if constexpr (PH == PH_NSA) phase_nsa(p, smem);
    else if constexpr (PH == PH_GLA1) phase_gla1(p, smem);
    else if constexpr (PH == PH_GLA2) phase_gla2(p);
    else if constexpr (PH == PH_GLA3) phase_gla3(p, smem);
    else if constexpr (PH == PH_CMP1) phase_cmp1(p, smem);
    else if constexpr (PH == PH_CMP2) phase_cmp2(p, smem);
}
template <class TT> __device__ __forceinline__ float ldf(const TT* p, size_t i);
template <> __device__ __forceinline__ float ldf<bf16>(const bf16* p, size_t i) { return bf2f(p[i]); }
template <> __device__ __forceinline__ float ldf<float>(const float* p, size_t i) { return p[i]; }
template <class TT> __global__ void __launch_bounds__(256) k_compare(const TT* a, const TT* b, size_t n, float* err, int slot) {
    float num = 0.f, den = 0.f;
    for (size_t i = (size_t)blockIdx.x * 256 + TIDX(); i < n; i += (size_t)gridDim.x * 256) { const float x = ldf<TT>(a, i), y = ldf<TT>(b, i); const float d = x - y; num += (d == d) ? d * d : 1e30f; den += y * y; }
#pragma unroll
    for (int o = 1; o < 64; o <<= 1) { num += __shfl_xor(num, o); den += __shfl_xor(den, o); }
    if ((TIDX() & 63) == 0) { atomicAdd(err + 2 * slot, num); atomicAdd(err + 2 * slot + 1, den); }
}
__global__ void __launch_bounds__(256) k_compare_sel(const u64* a, const u64* b, size_t n, float* err, int slot) {
    float num = 0.f, den = 0.f;
    for (size_t i = (size_t)blockIdx.x * 256 + threadIdx.x; i < n; i += (size_t)gridDim.x * 256) { num += (a[i] != b[i]) ? 1.f : 0.f; den += 100.f; }
#pragma unroll
    for (int o = 1; o < 64; o <<= 1) { num += __shfl_xor(num, o); den += __shfl_xor(den, o); }
    if ((threadIdx.x & 63) == 0) { atomicAdd(err + 2 * slot, num); atomicAdd(err + 2 * slot + 1, den); }
}
__global__ void __launch_bounds__(256) k_report(float* out, size_t n, const float* err, int nslots, float tol) {
    int code = 0;
    for (int s = 0; s < nslots; ++s) { const float num = err[2 * s], den = err[2 * s + 1]; const bool bad = !(num <= tol * tol * den) || !(den > 0.f); if (bad) { code = s + 1; break; } }
    if (code == 0) return;
    const float f = 1.f + 0.1f * (float)code;
    for (size_t i = (size_t)blockIdx.x * 256 + TIDX(); i < n; i += (size_t)gridDim.x * 256) out[i] *= f;
}

static void set_inputs(P& p, void* const* d_in) {
    const float* const* in = (const float* const*)d_in;
    p.x = in[0]; p.pos = (const int*)d_in[1]; p.g_mix = in[2]; p.w_in = in[3];
    p.cpos_k = in[4]; p.cw1_k = in[5]; p.cb1_k = in[6]; p.cw2_k = in[7]; p.cb2_k = in[8];
    p.cpos_v = in[9]; p.cw1_v = in[10]; p.cb1_v = in[11]; p.cw2_v = in[12]; p.cb2_v = in[13];
    p.w_a2 = in[14]; p.b_a = in[15]; p.norm_g = in[16]; p.w_pn = in[17]; p.w_pg = in[18]; p.w_out = in[19];
    p.g_ffn = in[20]; p.w_grp = in[21]; p.b_grp = in[22]; p.w_exp = in[23]; p.b_exp = in[24]; p.w_gate = in[25]; p.w_up = in[26]; p.w_down = in[27]; p.g_final = in[28];
}
constexpr size_t MiB = 1u << 20;
static void layout_ref(P& p, char* small, char* act, char* scratch, float* out, int nb) {
    const size_t q = (MiB / 4) * nb;
    p.nb = nb; p.T = nb * S; p.out = out;
    p.ctl = (unsigned*)small; p.sel = (u64*)(small + q / 16 * 1); p.kcmp = (bf16*)(small + q / 2); p.vcmp = (bf16*)(small + q / 4 * 3);
    p.tokslot = (int*)(small + q); p.tokexp = (int*)(small + q + q / 8); p.tokw = (float*)(small + q + q / 4);
    p.alow = (float*)(small + 2 * q); p.gates = (float*)(small + 3 * q); p.cs = (float*)(small + 5 * q); p.hcmp = (float*)(small + 9 * q); p.list = (int*)(small + 13 * q);
    p.u = (bf16*)act; p.ocmp = (float*)act; p.mixed = (bf16*)act; p.vb = (bf16*)act;
    p.q = (bf16*)(act + 32 * q); p.kv6 = (bf16*)(act + 48 * q);
    p.gq = (bf16*)(act + 73 * q); p.gk = (bf16*)(act + 81 * q); p.gv = (bf16*)(act + 89 * q); p.rs = (bf16*)(act + 105 * q);
    p.H = (bf16*)(act + 32 * q);
    p.sa = (bf16*)(act + 123 * q); p.sb = (bf16*)(act + 155 * q); p.onsa = (bf16*)(act + 187 * q); p.gla = (bf16*)(act + 203 * q);
    p.Y = (bf16*)(act + 123 * q);
    p.ga = (float*)scratch; p.oraw = (float*)(scratch + 16 * q); p.h1 = (float*)(scratch + 48 * q);
    p.gst = (float*)(scratch + 16 * q); p.gdec = (float*)(small + 15 * q);
}
static void layout_compact(P& p, char* ws, float* out) {
    p.nb = NB; p.T = NB * S; p.out = out;
    char* small = ws; const size_t q = MiB;
    p.ctl = (unsigned*)small; p.sel = (u64*)(small + q / 16 * 1); p.kcmp = (bf16*)(small + q / 2); p.vcmp = (bf16*)(small + q / 4 * 3);
    p.tokslot = (int*)(small + q); p.tokexp = (int*)(small + q + q / 8); p.tokw = (float*)(small + q + q / 4);
    p.alow = (float*)(small + 2 * q); p.gates = (float*)(small + 3 * q); p.cs = (float*)(small + 5 * q); p.hcmp = (float*)(small + 9 * q); p.list = (int*)(small + 13 * q);
    p.u = (bf16*)(ws + 128 * MiB); p.vb = (bf16*)(ws + 128 * MiB);
    p.q = (bf16*)(ws + 160 * MiB); p.kv6 = (bf16*)(ws + 176 * MiB); p.gq = (bf16*)(ws + 201 * MiB); p.gk = (bf16*)(ws + 209 * MiB); p.gv = (bf16*)(ws + 217 * MiB); p.rs = (bf16*)(ws + 233 * MiB);
    p.ga = (float*)(ws + 249 * MiB); p.ocmp = (float*)(ws + 249 * MiB);
    p.sa = (bf16*)(ws + 160 * MiB); p.sb = (bf16*)(ws + 192 * MiB); p.mixed = (bf16*)(ws + 224 * MiB);
    p.H = (bf16*)(ws + 160 * MiB); p.Y = (bf16*)(ws + 48 * MiB);
    p.onsa = (bf16*)out; p.gla = (bf16*)((char*)out + 16 * MiB); p.oraw = (float*)((char*)out + 32 * MiB); p.h1 = out;
    p.gst = (float*)((char*)out + 32 * MiB); p.gdec = (float*)(small + 15 * q); p.pcmp = (float*)(ws + 249 * MiB);
}
static void layout_weights(P& p, char* w) {
    p.wr = (float*)(w - 256 * 1024); p.b1p = (float*)(w - 64 * 1024);
    p.Wd = (bf16*)w; p.Wgu = (bf16*)(w + 32 * MiB); p.Wt_in = (bf16*)(w + 96 * MiB); p.Wc1 = (bf16*)(w + 106 * MiB);
    p.Wpn = (bf16*)(w + 108 * MiB); p.Wpg = (bf16*)(w + 109 * MiB); p.Wo = (bf16*)(w + 110 * MiB);
}

template <int ST> static void launch_stage(const P& p, hipStream_t stream) {
    static bool attr = false;
    if (!attr) { (void)hipFuncSetAttribute((const void*)k_stage<ST>, hipFuncAttributeMaxDynamicSharedMemorySize, LDS_BYTES); attr = true; }
    int nvb = stage_nvb(ST, p.T); if (nvb > 16384) nvb = 16384;
    hipLaunchKernelGGL(k_stage<ST>, dim3(nvb), dim3(NT), LDS_BYTES, stream, p);
}
template <int PH> static void launch_phase(const P& p, hipStream_t stream, int grid = 40) {
    static bool attr = false;
    if (!attr) { (void)hipFuncSetAttribute((const void*)k_phase<PH>, hipFuncAttributeMaxDynamicSharedMemorySize, LDS_BYTES); attr = true; }
    hipLaunchKernelGGL(k_phase<PH>, dim3(grid), dim3(NT), LDS_BYTES, stream, p);
}
template <class TT> static void compare(const TT* a, const TT* b, size_t n, float* err, int slot, hipStream_t stream) {
    hipLaunchKernelGGL(k_compare<TT>, dim3(1024), dim3(256), 0, stream, a, b, n, err, slot);
}
static void launch_mega(const P& p, hipStream_t stream) {
    static int grid = 0;
    if (!grid) {
        int dev = 0, cus = 0, per_cu = 0;
        (void)hipGetDevice(&dev); (void)hipDeviceGetAttribute(&cus, hipDeviceAttributeMultiprocessorCount, dev);
        (void)hipFuncSetAttribute((const void*)k_mega, hipFuncAttributeMaxDynamicSharedMemorySize, LDS_BYTES);
        (void)hipOccupancyMaxActiveBlocksPerMultiprocessor(&per_cu, (const void*)k_mega, NT, LDS_BYTES);
        if (per_cu < 1) per_cu = 1;
        grid = cus * per_cu;
    }
    (void)hipMemsetAsync((void*)p.ctl, 0, 64 * 1024, stream);
    P pp = p; void* args[] = {(void*)&pp};
    (void)hipLaunchCooperativeKernel((const void*)k_mega, dim3(grid), dim3(NT), args, LDS_BYTES, stream);
}

extern "C" void kernel_launch(void* const* d_in, const int* in_sizes, int n_in, void* d_out, int out_size, void* d_ws, size_t ws_size, hipStream_t stream) {
    char* ws = (char*)d_ws;
    P p{}; set_inputs(p, d_in); layout_ref(p, ws, ws + 16 * MiB, (char*)d_out, (float*)d_out, NB); p.h1 = (float*)d_out;
#if MODE == 0
    (void)hipMemsetAsync(d_ws, 0, 4096, stream);
    launch_stage<ST_RMS>(p, stream); launch_stage<ST_CS>(p, stream); launch_stage<ST_INPROJ>(p, stream);
    launch_stage<ST_CMP1>(p, stream); launch_stage<ST_CMP2>(p, stream); launch_stage<ST_NSACMP>(p, stream); launch_stage<ST_NSAATT>(p, stream);
    launch_stage<ST_GLAA>(p, stream); launch_stage<ST_GLASCAN>(p, stream); launch_stage<ST_GLANORM>(p, stream);
    launch_stage<ST_PROJ>(p, stream); launch_stage<ST_OUT>(p, stream); launch_stage<ST_ROUTE>(p, stream);
    launch_stage<ST_MOE1>(p, stream); launch_stage<ST_MOE2>(p, stream); launch_stage<ST_FINAL>(p, stream);
#elif MODE == 1
    { P c{}; set_inputs(c, d_in); layout_weights(c, ws + 16 * MiB); layout_compact(c, ws, (float*)d_out); launch_mega(c, stream); }
#else
    { P c{}; set_inputs(c, d_in); layout_weights(c, ws + 16 * MiB); layout_compact(c, ws, (float*)d_out); launch_mega(c, stream); }
    P r{}; set_inputs(r, d_in); layout_weights(r, ws + 16 * MiB);
    layout_ref(r, ws + 128 * MiB, ws + 132 * MiB, ws + 200 * MiB, (float*)(ws + 200 * MiB + 12 * MiB), 1);
    char* alt = ws + 228 * MiB; float* err = (float*)(ws + 128 * MiB + 8192);
    (void)hipMemsetAsync(ws + 128 * MiB, 0, 16384, stream);
    int slot = 0; const size_t T1 = S; const size_t ROWS1 = 2 * T1 + NEXP * 256;
    launch_stage<ST_RMS>(r, stream); launch_stage<ST_CS>(r, stream); launch_stage<ST_INPROJ>(r, stream);
    P f = r; { char* a = alt;
        f.u = (bf16*)a; a += T1 * 1024 * 2; f.cs = (float*)a; a += T1 * 64 * 4; f.q = (bf16*)a; a += T1 * 512 * 2; f.kv6 = (bf16*)a; a += 6 * (size_t)2 * S * 64 * 2 + 4096;
        f.gates = (float*)a; a += T1 * 24 * 4; f.gq = (bf16*)a; a += T1 * 256 * 2; f.gk = (bf16*)a; a += T1 * 256 * 2; f.gv = (bf16*)a; a += T1 * 512 * 2; f.alow = (float*)a; a += T1 * 16 * 4;
        f.rs = (bf16*)a; a += T1 * 512 * 2; f.sa = (bf16*)a; a += T1 * 1024 * 2; f.sb = (bf16*)a; a += T1 * 1024 * 2; }
    launch_phase<PH_PREP>(f, stream); launch_phase<PH_INA>(f, stream); launch_phase<PH_INB>(f, stream);
    compare<bf16>(f.q, r.q, T1 * 512, err, slot++, stream);
    compare<bf16>(f.kv6, r.kv6, 6 * (size_t)2 * S * 64, err, slot++, stream);
    compare<bf16>(f.sb, r.sb, T1 * 1024, err, slot++, stream);
    launch_stage<ST_CMP1>(r, stream); launch_stage<ST_CMP2>(r, stream);
    f = r; f.pcmp = (float*)alt; f.kcmp = (bf16*)(alt + 20 * MiB); f.vcmp = (bf16*)(alt + 21 * MiB); launch_phase<PH_CMP1>(f, stream); launch_phase<PH_CMP2>(f, stream);
    compare<bf16>(f.kcmp, r.kcmp, (size_t)2 * 255 * 64, err, slot++, stream); compare<bf16>(f.vcmp + 256 * 64, r.vcmp + 256 * 64, (size_t)255 * 64, err, slot++, stream);
    launch_stage<ST_NSACMP>(r, stream); launch_stage<ST_NSAATT>(r, stream);
    f = r; f.onsa = (bf16*)alt; f.sel = (u64*)(alt + 8 * MiB); launch_phase<PH_NSA>(f, stream);
    hipLaunchKernelGGL(k_compare_sel, dim3(64), dim3(256), 0, stream, (const u64*)f.sel, (const u64*)r.sel, T1 * 2, err, slot++);
    compare<bf16>(f.onsa, r.onsa, T1 * 512, err, slot++, stream);
    launch_stage<ST_GLAA>(r, stream); launch_stage<ST_GLASCAN>(r, stream); launch_stage<ST_GLANORM>(r, stream);
    f = r; f.gla = (bf16*)alt; f.gst = (float*)(alt + 8 * MiB); f.gdec = (float*)(alt + 18 * MiB); launch_phase<PH_GLA1>(f, stream); launch_phase<PH_GLA2>(f, stream); launch_phase<PH_GLA3>(f, stream);
    compare<bf16>(f.gla, r.gla, T1 * 512, err, slot++, stream);
    launch_stage<ST_PROJ>(r, stream);
    f = r; f.mixed = (bf16*)alt; launch_phase<PH_PROJ>(f, stream);
    compare<bf16>(f.mixed, r.mixed, T1 * 1024, err, slot++, stream);
    launch_stage<ST_OUT>(r, stream);
    f = r; f.h1 = (float*)alt; launch_phase<PH_OUT>(f, stream);
    compare<float>(f.h1, r.h1, T1 * 1024, err, slot++, stream);
    launch_stage<ST_ROUTE>(r, stream);
    (void)hipMemsetAsync(r.H, 0, ROWS1 * 512 * 2, stream); (void)hipMemsetAsync(alt, 0, ROWS1 * 512 * 2, stream);
    launch_stage<ST_MOE1>(r, stream);
    f = r; f.H = (bf16*)alt; launch_phase<PH_MOE1>(f, stream);
    compare<bf16>(f.H, r.H, ROWS1 * 512, err, slot++, stream);
    (void)hipMemsetAsync(r.Y, 0, ROWS1 * 1024 * 2, stream); (void)hipMemsetAsync(alt + 17 * MiB, 0, ROWS1 * 1024 * 2, stream);
    launch_stage<ST_MOE2>(r, stream);
    f = r; f.Y = (bf16*)(alt + 17 * MiB); launch_phase<PH_MOE2>(f, stream);
    compare<bf16>(f.Y, r.Y, ROWS1 * 1024, err, slot++, stream);
    hipLaunchKernelGGL(k_report, dim3(1024), dim3(256), 0, stream, (float*)d_out, (size_t)NB * S * D, (const float*)err, slot, 0.02f);
#endif
}
```

```cpp
#include <hip/hip_runtime.h>
#include <hip/hip_cooperative_groups.h>
#include <stdint.h>
namespace cg = cooperative_groups;

#ifndef DUP
#define DUP 0
#endif
#ifndef MODE
#define MODE 1
#endif

typedef unsigned short bf16;
typedef unsigned long long u64;

__device__ __forceinline__ int TIDX() { int t = threadIdx.x; asm volatile("" : "+v"(t)); return t; }
__device__ __forceinline__ float bf2f(bf16 v) { return __uint_as_float(((unsigned)v) << 16); }
__device__ __forceinline__ bf16 f2bf(float f) { unsigned u = __float_as_uint(f); return (bf16)((u + 0x7fffu + ((u >> 16) & 1u)) >> 16); }
__device__ __forceinline__ float sigmoidf_(float x) { return 1.f / (1.f + __expf(-x)); }
__device__ __forceinline__ float siluf_(float x) { return x / (1.f + __expf(-x)); }
__device__ __forceinline__ float geluf_(float x) { const float u = 0.7978845608028654f * (x + 0.044715f * x * x * x); return 0.5f * x * (1.f + tanhf(u)); }

constexpr int NB = 4, S = 4096, D = 1024;
constexpr int NT = 512;
constexpr int LDS_BYTES = 144 * 1024;
constexpr int LDS_MISC = 136 * 1024;
constexpr int INW = 4904;
constexpr int OFF_Q = 0, OFF_KV = 512, OFF_NG = 1280, OFF_GQ = 1304, OFF_GK = 1560, OFF_GV = 1816, OFF_GA = 2328, OFF_GR = 2344, OFF_MA = 2856, OFF_MB = 3880;
constexpr int NEXP = 32;
constexpr size_t MiB_ = 1u << 20;

struct P {
    const float* x; const int* pos; const float* g_mix; const float* w_in;
    const float *cpos_k, *cw1_k, *cb1_k, *cw2_k, *cb2_k, *cpos_v, *cw1_v, *cb1_v, *cw2_v, *cb2_v;
    const float *w_a2, *b_a, *norm_g, *w_pn, *w_pg, *w_out, *g_ffn, *w_grp, *b_grp, *w_exp, *b_exp, *w_gate, *w_up, *w_down, *g_final;
    float* out;
    unsigned* ctl;
    float* cs;
    bf16* u;
    bf16* q;
    bf16* kv6;
    float* gates;
    bf16 *gq, *gk, *gv;
    float* alow;
    bf16 *rs, *sa, *sb;
    float* hcmp;
    bf16 *kcmp, *vcmp;
    u64* sel;
    float* ocmp;
    bf16* onsa;
    float* ga;
    float* oraw;
    bf16* gla;
    bf16* mixed;
    float* h1;
    bf16* vb;
    int* list;
    int* tokslot;
    int* tokexp;
    float* tokw;
    bf16* H;
    bf16* Y;
    float* gst;
    float* gdec;
    float* pcmp;
    float* b1p;
    float* wr;
    bf16 *Wt_in, *Wc1, *Wpn, *Wpg, *Wo, *Wgu, *Wd;
    int nb, T;
};
__device__ __forceinline__ size_t kvseg(const P& p) { return (size_t)p.nb * 2 * S * 64; }

enum Stage { ST_RMS = 0, ST_CS, ST_INPROJ, ST_CMP1, ST_CMP2, ST_NSACMP, ST_NSAATT, ST_GLAA, ST_GLASCAN, ST_GLANORM, ST_PROJ, ST_OUT, ST_ROUTE, ST_MOE1, ST_MOE2, ST_FINAL, ST_COUNT };

__host__ __device__ inline int stage_nvb(int st, int T) {
    switch (st) {
        case ST_RMS: return T / 8;
        case ST_CS: return T * 32 / NT;
        case ST_INPROJ: return ((INW + NT - 1) / NT) * (T / 8);
        case ST_CMP1: return 2 * (T / S) * 2 * 256 / 8;
        case ST_CMP2: return 2 * (T / S) * 2 * 256 * 32 / NT;
        case ST_NSACMP: return T / 64 * 2 / 8;
        case ST_NSAATT: return T / 64 * 8 / 8;
        case ST_GLAA: return T / 2;
        case ST_GLASCAN: return (T / S) * 4 / 4;
        case ST_GLANORM: return T * 4 / NT;
        case ST_PROJ: return 2 * (T / 8);
        case ST_OUT: return 2 * (T / 8);
        case ST_ROUTE: return T / 8;
        case ST_MOE1: return (2 * T + NEXP * 256) / 8;
        case ST_MOE2: return 2 * ((2 * T + NEXP * 256) / 8);
        case ST_FINAL: return T / 8;
    }
    return 0;
}

__device__ __forceinline__ void body_rms(const P& p, int vb) {
    const int lane = TIDX() & 63, t = vb * 8 + (TIDX() >> 6);
    const float4* xr = (const float4*)(p.x + (size_t)t * D);
    float4 v[4]; float ss = 0.f;
#pragma unroll
    for (int j = 0; j < 4; ++j) { v[j] = xr[lane + 64 * j]; ss += v[j].x * v[j].x + v[j].y * v[j].y + v[j].z * v[j].z + v[j].w * v[j].w; }
#pragma unroll
    for (int o = 1; o < 64; o <<= 1) ss += __shfl_xor(ss, o);
    const float rstd = rsqrtf(ss * (1.f / D) + 1e-6f);
#pragma unroll
    for (int j = 0; j < 4; ++j) {
        const float4 g = ((const float4*)p.g_mix)[lane + 64 * j];
        ushort4 o; o.x = f2bf(v[j].x * rstd * g.x); o.y = f2bf(v[j].y * rstd * g.y); o.z = f2bf(v[j].z * rstd * g.z); o.w = f2bf(v[j].w * rstd * g.w);
        ((ushort4*)(p.u + (size_t)t * D))[lane + 64 * j] = o;
    }
}
__device__ __forceinline__ void body_cs(const P& p, int vb) {
    const int idx = vb * NT + TIDX(); const int t = idx >> 5, i = idx & 31;
    const float inv = 1.0f / powf(10000.0f, (float)i / 32.0f);
    const float ang = (float)p.pos[t] * inv;
    const double a = (double)ang; const double k = rint(a * 0.15915494309189535); const float r = (float)(a - k * 6.283185307179586);
    p.cs[(size_t)t * 64 + i] = cosf(r); p.cs[(size_t)t * 64 + 32 + i] = sinf(r);
}

template <int K, bool TWO, bool SAMEA, class AF1, class AF2, class Epi>
__device__ __forceinline__ void ngemm(float* lds, int m0, const float* W1, int ldw1, int n1, const float* W2, int ldw2, int n2, AF1 a1, AF2 a2, Epi epi) {
    const int tid = TIDX();
    for (int idx = tid; idx < 8 * K; idx += NT) { const int i = idx / K, k = idx % K; lds[idx] = a1(m0 + i, k); if (TWO && !SAMEA) lds[8 * K + idx] = a2(m0 + i, k); }
    __syncthreads();
    float acc1[8], acc2[8];
#pragma unroll
    for (int i = 0; i < 8; ++i) { acc1[i] = 0.f; acc2[i] = 0.f; }
    const float* w1 = W1 + n1; const float* w2 = TWO ? (W2 + n2) : w1;
    const float* l2 = (TWO && !SAMEA) ? lds + 8 * K : lds;
    for (int k = 0; k < K; k += 4) {
        float a[4], b[4];
#pragma unroll
        for (int kk = 0; kk < 4; ++kk) { a[kk] = w1[(size_t)(k + kk) * ldw1]; b[kk] = TWO ? w2[(size_t)(k + kk) * ldw2] : 0.f; }
#pragma unroll
        for (int i = 0; i < 8; ++i) {
            const float4 x1 = *(const float4*)(lds + i * K + k);
            acc1[i] += x1.x * a[0] + x1.y * a[1] + x1.z * a[2] + x1.w * a[3];
            if (TWO) { const float4 x2 = *(const float4*)(l2 + i * K + k); acc2[i] += x2.x * b[0] + x2.y * b[1] + x2.z * b[2] + x2.w * b[3]; }
        }
    }
#pragma unroll
    for (int i = 0; i < 8; ++i) epi(m0 + i, acc1[i], acc2[i]);
    __syncthreads();
}

__device__ __forceinline__ void store_z(const P& p, int t, int j, float z, float zp) {
    const int b = t / S, s = t % S;
    if (j < OFF_KV) {
        const int d = j & 63, i = d & 31; const float c = p.cs[(size_t)t * 64 + i], sn = p.cs[(size_t)t * 64 + 32 + i];
        const float r = (d < 32) ? (z * c - zp * sn) : (z * c + zp * sn);
        p.q[(size_t)t * 512 + j] = f2bf(r * 0.125f);
    } else if (j < OFF_NG) {
        const int seg = (j - OFF_KV) >> 7, cc = (j - OFF_KV) & 127, g = cc >> 6, d = cc & 63; float r = z;
        if (seg == 2 || seg == 4) { const int i = d & 31; const float c = p.cs[(size_t)t * 64 + i], sn = p.cs[(size_t)t * 64 + 32 + i]; r = (d < 32) ? (z * c - zp * sn) : (z * c + zp * sn); }
        p.kv6[(size_t)seg * kvseg(p) + ((size_t)(b * 2 + g) * S + s) * 64 + d] = f2bf(r);
    } else if (j < OFF_GQ) { p.gates[(size_t)t * 24 + (j - OFF_NG)] = sigmoidf_(z);
    } else if (j < OFF_GK) { p.gq[(size_t)t * 256 + (j - OFF_GQ)] = f2bf(z * 0.125f);
    } else if (j < OFF_GV) { p.gk[(size_t)t * 256 + (j - OFF_GK)] = f2bf(z);
    } else if (j < OFF_GA) { p.gv[(size_t)t * 512 + (j - OFF_GV)] = f2bf(z);
    } else if (j < OFF_GR) { p.alow[(size_t)t * 16 + (j - OFF_GA)] = z;
    } else if (j < OFF_MA) { p.rs[(size_t)t * 512 + (j - OFF_GR)] = f2bf(siluf_(z));
    } else if (j < OFF_MB) { p.sa[(size_t)t * 1024 + (j - OFF_MA)] = f2bf(sigmoidf_(z));
    } else { p.sb[(size_t)t * 1024 + (j - OFF_MB)] = f2bf(sigmoidf_(z)); }
}
__device__ __forceinline__ int rope_partner(int j) {
    int base;
    if (j < OFF_KV) base = 0; else if (j >= 768 && j < 896) base = 768; else if (j >= 1024 && j < 1152) base = 1024; else return -1;
    const int d = (j - base) & 63; return d < 32 ? j + 32 : j - 32;
}
__device__ __forceinline__ void body_inproj(const P& p, int vb, char* smem) {
    constexpr int NCB = (INW + NT - 1) / NT;
    const int bx = vb % NCB, by = vb / NCB;
    const int jr = bx * NT + TIDX(); const bool jv = jr < INW; const int j = jv ? jr : INW - 1;
    int jp = rope_partner(j); if (jp < 0) jp = j;
    ngemm<1024, true, true>((float*)smem, by * 8, p.w_in, INW, j, p.w_in, INW, jp,
        [&](int m, int k) { return bf2f(p.u[(size_t)m * D + k]); }, [&](int m, int k) { return 0.f; },
        [&](int m, float z, float zp) { if (jv) store_z(p, m, j, z, zp); });
}

__device__ __forceinline__ void body_cmp1(const P& p, int vb, char* smem) {
    const int nrows = p.nb * 2 * 256, ng = nrows / 8;
    const int kv = vb / ng, m0 = (vb % ng) * 8; const int n = TIDX() & 255; const bool act = TIDX() < 256;
    const bf16* src = p.kv6 + (size_t)kv * kvseg(p);
    const float* pe = kv ? p.cpos_v : p.cpos_k; const float* w1 = kv ? p.cw1_v : p.cw1_k; const float* b1 = kv ? p.cb1_v : p.cb1_k;
    float* dst = p.hcmp + (size_t)kv * nrows * 256;
    ngemm<2048, false, true>((float*)smem, m0, w1, 256, n, w1, 256, n,
        [&](int m, int k) { return bf2f(src[(size_t)m * 1024 + k]) + pe[k]; }, [&](int m, int k) { return 0.f; },
        [&](int m, float z, float) { if (act) dst[(size_t)m * 256 + n] = geluf_(z + b1[n]); });
}
__device__ __forceinline__ void body_cmp2(const P& p, int vb) {
    const int nrows = p.nb * 2 * 256;
    const int idx = vb * NT + TIDX();
    const int i = idx & 31, row = (idx >> 5) % nrows, kv = (idx >> 5) / nrows;
    const float* h = p.hcmp + ((size_t)kv * nrows + row) * 256; const float* w2 = kv ? p.cw2_v : p.cw2_k; const float* b2 = kv ? p.cb2_v : p.cb2_k;
    float z1 = b2[i], z2 = b2[i + 32];
    for (int n = 0; n < 256; ++n) { const float hv = h[n]; z1 += hv * w2[n * 64 + i]; z2 += hv * w2[n * 64 + i + 32]; }
    bf16* dst = (kv ? p.vcmp : p.kcmp) + (size_t)row * 64;
    if (kv == 0) {
        const int bg = row >> 8, m = row & 255, b = bg >> 1; int sp = 16 * m + 31; if (sp > S - 1) sp = S - 1;
        const size_t t = (size_t)b * S + sp; const float c = p.cs[t * 64 + i], sn = p.cs[t * 64 + 32 + i];
        const float r1 = z1 * c - z2 * sn, r2 = z2 * c + z1 * sn; z1 = r1; z2 = r2;
    }
    dst[i] = f2bf(z1); dst[i + 32] = f2bf(z2);
}

__device__ __forceinline__ void load_row64(const bf16* r, float* f) {
    const uint4* p4 = (const uint4*)r;
#pragma unroll
    for (int c = 0; c < 8; ++c) { const uint4 v = p4[c]; const unsigned w[4] = {v.x, v.y, v.z, v.w};
#pragma unroll
        for (int e = 0; e < 4; ++e) { f[c * 8 + e * 2] = __uint_as_float(w[e] << 16); f[c * 8 + e * 2 + 1] = __uint_as_float(w[e] & 0xffff0000u); } }
}
__device__ __forceinline__ float dot64(const float* a, const bf16* r) {
    const uint4* p4 = (const uint4*)r; float s = 0.f;
#pragma unroll
    for (int c = 0; c < 8; ++c) { const uint4 v = p4[c]; const unsigned w[4] = {v.x, v.y, v.z, v.w};
#pragma unroll
        for (int e = 0; e < 4; ++e) { s += a[c * 8 + e * 2] * __uint_as_float(w[e] << 16); s += a[c * 8 + e * 2 + 1] * __uint_as_float(w[e] & 0xffff0000u); } }
    return s;
}
__device__ __forceinline__ void axpy64(float* o, float a, const bf16* r) {
    const uint4* p4 = (const uint4*)r;
#pragma unroll
    for (int c = 0; c < 8; ++c) { const uint4 v = p4[c]; const unsigned w[4] = {v.x, v.y, v.z, v.w};
#pragma unroll
        for (int e = 0; e < 4; ++e) { o[c * 8 + e * 2] += a * __uint_as_float(w[e] << 16); o[c * 8 + e * 2 + 1] += a * __uint_as_float(w[e] & 0xffff0000u); } }
}
__device__ __forceinline__ void body_nsacmp(const P& p, int vb, char* smem) {
    const int wave = TIDX() >> 6, lane = TIDX() & 63, item = vb * 8 + wave;
    const int g = item & 1, t = (item >> 1) * 64 + lane;
    const int b = t / S, s = t % S; const int nv = s >= 31 ? (s - 31) / 16 + 1 : 0;
    float* my = (float*)smem + (size_t)wave * (64 * 65) + lane * 65;
    for (int j = 0; j < 64; ++j) my[j] = 0.f;
    const bf16* kc = p.kcmp + (size_t)(b * 2 + g) * 256 * 64; const bf16* vc = p.vcmp + (size_t)(b * 2 + g) * 256 * 64;
    for (int hh = 0; hh < 4; ++hh) {
        const int h = g * 4 + hh; float qv[64], o[64];
        load_row64(p.q + (size_t)t * 512 + h * 64, qv);
#pragma unroll
        for (int d = 0; d < 64; ++d) o[d] = 0.f;
        float m = -1e30f, l = 0.f;
        for (int n = 0; n < nv; ++n) { const float sc = dot64(qv, kc + n * 64); const float mn = fmaxf(m, sc); l = l * __expf(m - mn) + __expf(sc - mn); m = mn; }
        const float il = nv > 0 ? 1.f / l : 0.f;
        for (int n = 0; n < nv; ++n) {
            const float sc = dot64(qv, kc + n * 64); const float pn = __expf(sc - m) * il;
            axpy64(o, pn, vc + n * 64);
            const int j0 = n >> 2; if ((n & 3) != 3) my[j0] += pn; else { my[j0] += 0.5f * pn; my[j0 + 1] += 0.5f * pn; }
        }
#pragma unroll
        for (int d = 0; d < 64; ++d) p.ocmp[(size_t)t * 512 + h * 64 + d] = o[d];
    }
    const int cur = s >> 6; u64 mask = 0ull;
    for (int j = 0; j <= cur; ++j) {
        const float sj = (j == 0 || j == cur || j == cur - 1) ? 1e4f : my[j]; int rank = 0;
        for (int i = 0; i <= cur; ++i) { if (i == j) continue; const float si = (i == 0 || i == cur || i == cur - 1) ? 1e4f : my[i]; if (si > sj || (si == sj && i < j)) ++rank; }
        if (rank < 16) mask |= (1ull << j);
    }
    p.sel[(size_t)t * 2 + g] = mask;
}
__device__ __forceinline__ void body_nsaatt(const P& p, int vb) {
    const int wave = TIDX() >> 6, lane = TIDX() & 63, item = vb * 8 + wave;
    const int h = item & 7, t = (item >> 3) * 64 + lane, g = h >> 2;
    const int b = t / S, s = t % S, cur = s >> 6;
    const size_t seg = kvseg(p), ho = (size_t)(b * 2 + g) * S * 64;
    const bf16* ks = p.kv6 + 2 * seg + ho; const bf16* vs = p.kv6 + 3 * seg + ho; const bf16* kw = p.kv6 + 4 * seg + ho; const bf16* vw = p.kv6 + 5 * seg + ho;
    float qv[64], o[64];
    load_row64(p.q + (size_t)t * 512 + h * 64, qv);
    const float g0 = p.gates[(size_t)t * 24 + h * 3], g1 = p.gates[(size_t)t * 24 + h * 3 + 1], g2 = p.gates[(size_t)t * 24 + h * 3 + 2];
    float* accp = p.ocmp + (size_t)t * 512 + h * 64;
#pragma unroll
    for (int d = 0; d < 64; ++d) o[d] = 0.f;
    const u64 mask = p.sel[(size_t)t * 2 + g];
    float m = -1e30f, l = 0.f;
    for (int j = 0; j <= cur; ++j) {
        if (!((mask >> j) & 1ull)) continue;
        for (int kk = 0; kk < 64; ++kk) {
            const int key = j * 64 + kk; if (key > s) break;
            const float sc = dot64(qv, ks + (size_t)key * 64);
            if (sc > m) { const float f = __expf(m - sc); l *= f;
#pragma unroll
                for (int d = 0; d < 64; ++d) o[d] *= f;
                m = sc; }
            const float pe = __expf(sc - m); l += pe; axpy64(o, pe, vs + (size_t)key * 64);
        }
    }
    { const float f = g1 / l;
#pragma unroll
        for (int d = 0; d < 64; ++d) { accp[d] = g0 * accp[d] + f * o[d]; o[d] = 0.f; } }
    m = -1e30f; l = 0.f;
    for (int key = (s >= 511 ? s - 511 : 0); key <= s; ++key) {
        const float sc = dot64(qv, kw + (size_t)key * 64);
        if (sc > m) { const float f = __expf(m - sc); l *= f;
#pragma unroll
            for (int d = 0; d < 64; ++d) o[d] *= f;
            m = sc; }
        const float pe = __expf(sc - m); l += pe; axpy64(o, pe, vw + (size_t)key * 64);
    }
    { const float f = g2 / l;
#pragma unroll
        for (int d = 0; d < 64; ++d) p.onsa[(size_t)t * 512 + h * 64 + d] = f2bf(accp[d] + f * o[d]); }
}

__device__ __forceinline__ void body_glaa(const P& p, int vb) {
    const int c = TIDX() & 255, t = vb * 2 + (TIDX() >> 8); float z = p.b_a[c];
#pragma unroll
    for (int r = 0; r < 16; ++r) z += p.alow[(size_t)t * 16 + r] * p.w_a2[r * 256 + c];
    const float ls = fminf(z, 0.f) - log1pf(__expf(-fabsf(z)));
    p.ga[(size_t)t * 256 + c] = __expf(ls * (1.f / 16.f));
}
__device__ __forceinline__ void body_glascan(const P& p, int vb, char* smem) {
    const int sub = TIDX() >> 7, e = TIDX() & 127, bh = vb * 4 + sub, b = bh >> 2, h = bh & 3;
    float* sq = (float*)smem + sub * (3 * 32 * 64); float* sk = sq + 32 * 64; float* sg = sk + 32 * 64;
    float St[64];
#pragma unroll
    for (int d = 0; d < 64; ++d) St[d] = 0.f;
    for (int s0 = 0; s0 < S; s0 += 32) {
        __syncthreads();
        for (int i = e; i < 32 * 64; i += 128) { const int ss = i >> 6, d = i & 63; const size_t t = (size_t)b * S + s0 + ss;
            sq[i] = bf2f(p.gq[t * 256 + h * 64 + d]); sk[i] = bf2f(p.gk[t * 256 + h * 64 + d]); sg[i] = p.ga[t * 256 + h * 64 + d]; }
        __syncthreads();
        for (int ss = 0; ss < 32; ++ss) {
            const size_t t = (size_t)b * S + s0 + ss; const float v = bf2f(p.gv[t * 512 + h * 128 + e]); float o = 0.f;
#pragma unroll
            for (int d = 0; d < 64; ++d) { St[d] = sg[ss * 64 + d] * St[d] + sk[ss * 64 + d] * v; o += sq[ss * 64 + d] * St[d]; }
            p.oraw[t * 512 + h * 128 + e] = o;
        }
    }
    __syncthreads();
}
__device__ __forceinline__ void body_glanorm(const P& p, int vb) {
    const int idx = vb * NT + TIDX(); const int t = idx >> 2, h = idx & 3;
    const float* o = p.oraw + (size_t)t * 512 + h * 128; float ss = 0.f;
    for (int e = 0; e < 128; ++e) ss += o[e] * o[e];
    const float r = rsqrtf(ss * (1.f / 128.f) + 1e-6f);
    for (int e = 0; e < 128; ++e) p.gla[(size_t)t * 512 + h * 128 + e] = f2bf(o[e] * r * p.norm_g[h * 128 + e] * bf2f(p.rs[(size_t)t * 512 + h * 128 + e]));
}

__device__ __forceinline__ void body_proj(const P& p, int vb, char* smem) {
    const int n = (vb & 1) * NT + TIDX(), m0 = (vb >> 1) * 8;
    ngemm<512, true, false>((float*)smem, m0, p.w_pn, 1024, n, p.w_pg, 1024, n,
        [&](int m, int k) { return bf2f(p.onsa[(size_t)m * 512 + k]); }, [&](int m, int k) { return bf2f(p.gla[(size_t)m * 512 + k]); },
        [&](int m, float ya, float yb) { p.mixed[(size_t)m * 1024 + n] = f2bf(bf2f(p.sa[(size_t)m * 1024 + n]) * ya + bf2f(p.sb[(size_t)m * 1024 + n]) * yb); });
}
__device__ __forceinline__ void body_out(const P& p, int vb, char* smem) {
    const int n = (vb & 1) * NT + TIDX(), m0 = (vb >> 1) * 8;
    ngemm<1024, false, true>((float*)smem, m0, p.w_out, 1024, n, p.w_out, 1024, n,
        [&](int m, int k) { return bf2f(p.mixed[(size_t)m * 1024 + k]); }, [&](int m, int k) { return 0.f; },
        [&](int m, float z, float) { p.h1[(size_t)m * 1024 + n] = p.x[(size_t)m * 1024 + n] + z; });
}

__device__ __forceinline__ void body_route(const P& p, int vb, char* smem) {
    const int wave = TIDX() >> 6, lane = TIDX() & 63, t = vb * 8 + wave;
    const float4* hr = (const float4*)(p.h1 + (size_t)t * D);
    float v[16]; float ss = 0.f;
#pragma unroll
    for (int j = 0; j < 4; ++j) { const float4 a = hr[lane + 64 * j]; v[4 * j] = a.x; v[4 * j + 1] = a.y; v[4 * j + 2] = a.z; v[4 * j + 3] = a.w; ss += a.x * a.x + a.y * a.y + a.z * a.z + a.w * a.w; }
#pragma unroll
    for (int o = 1; o < 64; o <<= 1) ss += __shfl_xor(ss, o);
    const float rstd = rsqrtf(ss * (1.f / D) + 1e-6f);
#pragma unroll
    for (int j = 0; j < 4; ++j) {
        const float4 g = ((const float4*)p.g_ffn)[lane + 64 * j];
        v[4 * j] *= rstd * g.x; v[4 * j + 1] *= rstd * g.y; v[4 * j + 2] *= rstd * g.z; v[4 * j + 3] *= rstd * g.w;
        ushort4 o; o.x = f2bf(v[4 * j]); o.y = f2bf(v[4 * j + 1]); o.z = f2bf(v[4 * j + 2]); o.w = f2bf(v[4 * j + 3]);
        ((ushort4*)(p.vb + (size_t)t * D))[lane + 64 * j] = o;
    }
    float* sl = (float*)(smem + LDS_MISC) + wave * 40;
    for (int o = 0; o < 4; ++o) { float a = 0.f;
#pragma unroll
        for (int j = 0; j < 4; ++j)
#pragma unroll
            for (int e = 0; e < 4; ++e) a += v[4 * j + e] * p.w_grp[(size_t)(4 * (lane + 64 * j) + e) * 4 + o];
#pragma unroll
        for (int x = 1; x < 64; x <<= 1) a += __shfl_xor(a, x);
        if (lane == 0) sl[o] = a + p.b_grp[o]; }
    for (int o = 0; o < 32; ++o) { float a = 0.f;
#pragma unroll
        for (int j = 0; j < 4; ++j)
#pragma unroll
            for (int e = 0; e < 4; ++e) a += v[4 * j + e] * p.w_exp[(size_t)(4 * (lane + 64 * j) + e) * 32 + o];
#pragma unroll
        for (int x = 1; x < 64; x <<= 1) a += __shfl_xor(a, x);
        if (lane == 0) sl[4 + o] = a + p.b_exp[o]; }
    if (lane == 0) {
        int gs = 0; float gm = sl[0];
        for (int o = 1; o < 4; ++o) if (sl[o] > gm) { gm = sl[o]; gs = o; }
        float gsum = 0.f;
        for (int o = 0; o < 4; ++o) gsum += __expf(sl[o] - gm);
        const float pg = 1.f / gsum;
        const float* li = sl + 4 + gs * 8;
        int e0 = 0; float m0 = li[0];
        for (int e = 1; e < 8; ++e) if (li[e] > m0) { m0 = li[e]; e0 = e; }
        int e1 = -1; float m1 = -3e38f;
        for (int e = 0; e < 8; ++e) if (e != e0 && li[e] > m1) { m1 = li[e]; e1 = e; }
        const float p0 = 1.f, p1 = __expf(m1 - m0);
        const float w0 = pg * p0 / (p0 + p1), w1 = pg * p1 / (p0 + p1);
        const int x0 = gs * 8 + e0, x1 = gs * 8 + e1;
        const int s0 = (int)atomicAdd(&p.ctl[x0 * 32], 1u), s1 = (int)atomicAdd(&p.ctl[x1 * 32], 1u);
        p.list[(size_t)x0 * p.T + s0] = t; p.list[(size_t)x1 * p.T + s1] = t;
        p.tokexp[t * 2] = x0; p.tokexp[t * 2 + 1] = x1; p.tokslot[t * 2] = s0; p.tokslot[t * 2 + 1] = s1; p.tokw[t * 2] = w0; p.tokw[t * 2 + 1] = w1;
    }
}

__device__ __forceinline__ void body_route2(const P& p, int vb, char* smem) {
    const int tid = TIDX(), wave = tid >> 6, lane = tid & 63, t = vb * 8 + wave;
    const float4* hr = (const float4*)(p.h1 + (size_t)t * D);
    float4 v[4]; float ss = 0.f;
#pragma unroll
    for (int j = 0; j < 4; ++j) { v[j] = hr[lane + 64 * j]; ss += v[j].x * v[j].x + v[j].y * v[j].y + v[j].z * v[j].z + v[j].w * v[j].w; }
#pragma unroll
    for (int o = 1; o < 64; o <<= 1) ss += __shfl_xor(ss, o);
    const float rstd = rsqrtf(ss * (1.f / D) + 1e-6f);
#pragma unroll
    for (int j = 0; j < 4; ++j) {
        const float4 g = ((const float4*)p.g_ffn)[lane + 64 * j];
        v[j].x *= rstd * g.x; v[j].y *= rstd * g.y; v[j].z *= rstd * g.z; v[j].w *= rstd * g.w;
        ushort4 o; o.x = f2bf(v[j].x); o.y = f2bf(v[j].y); o.z = f2bf(v[j].z); o.w = f2bf(v[j].w);
        ((ushort4*)(p.vb + (size_t)t * D))[lane + 64 * j] = o;
    }
    float* sl = (float*)(smem + LDS_MISC) + wave * 40;
    float mine = 0.f;
#pragma unroll 4
    for (int o = 0; o < 36; ++o) { const float4* wrow = (const float4*)(p.wr + (size_t)o * 1024); float a = 0.f;
#pragma unroll
        for (int j = 0; j < 4; ++j) { const float4 w = wrow[lane + 64 * j]; a += v[j].x * w.x + v[j].y * w.y + v[j].z * w.z + v[j].w * w.w; }
#pragma unroll
        for (int x = 1; x < 64; x <<= 1) a += __shfl_xor(a, x);
        if (lane == o) mine = a; }
    if (lane < 36) sl[lane] = mine + (lane < 4 ? p.b_grp[lane] : p.b_exp[lane - 4]);
    asm volatile("s_waitcnt lgkmcnt(0)" ::: "memory");
    if (lane == 0) {
        int gs = 0; float gm = sl[0];
        for (int o = 1; o < 4; ++o) if (sl[o] > gm) { gm = sl[o]; gs = o; }
        float gsum = 0.f;
        for (int o = 0; o < 4; ++o) gsum += __expf(sl[o] - gm);
        const float pg = 1.f / gsum;
        const float* li = sl + 4 + gs * 8;
        int e0 = 0; float m0 = li[0];
        for (int e = 1; e < 8; ++e) if (li[e] > m0) { m0 = li[e]; e0 = e; }
        int e1 = -1; float m1 = -3e38f;
        for (int e = 0; e < 8; ++e) if (e != e0 && li[e] > m1) { m1 = li[e]; e1 = e; }
        const float p0 = 1.f, p1 = __expf(m1 - m0);
        const float w0 = pg * p0 / (p0 + p1), w1 = pg * p1 / (p0 + p1);
        const int x0 = gs * 8 + e0, x1 = gs * 8 + e1;
        const int s0 = (int)atomicAdd(&p.ctl[x0 * 32], 1u), s1 = (int)atomicAdd(&p.ctl[x1 * 32], 1u);
        p.list[(size_t)x0 * p.T + s0] = t; p.list[(size_t)x1 * p.T + s1] = t;
        p.tokexp[t * 2] = x0; p.tokexp[t * 2 + 1] = x1; p.tokslot[t * 2] = s0; p.tokslot[t * 2 + 1] = s1; p.tokw[t * 2] = w0; p.tokw[t * 2 + 1] = w1;
    }
}

__device__ __forceinline__ float tred8(float (&a)[8], int lane) {
    const bool b5 = lane & 32, b4 = lane & 16, b3 = lane & 8;
    float k4[4], k2[2], k1;
#pragma unroll
    for (int i = 0; i < 4; ++i) { const float snd = b5 ? a[i] : a[i + 4]; const float kp = b5 ? a[i + 4] : a[i]; k4[i] = kp + __shfl_xor(snd, 32); }
#pragma unroll
    for (int i = 0; i < 2; ++i) { const float snd = b4 ? k4[i] : k4[i + 2]; const float kp = b4 ? k4[i + 2] : k4[i]; k2[i] = kp + __shfl_xor(snd, 16); }
    { const float snd = b3 ? k2[0] : k2[1]; const float kp = b3 ? k2[1] : k2[0]; k1 = kp + __shfl_xor(snd, 8); }
    k1 += __shfl_xor(k1, 4); k1 += __shfl_xor(k1, 2); k1 += __shfl_xor(k1, 1);
    return k1;
}
__device__ __forceinline__ void body_route3(const P& p, int vb, char* smem) {
    const int tid = TIDX(), wave = tid >> 6, lane = tid & 63, t0 = vb * 64 + wave * 8;
    float4 v[8][4]; float ss[8];
#pragma unroll
    for (int tk = 0; tk < 8; ++tk) { const float4* hr = (const float4*)(p.h1 + (size_t)(t0 + tk) * D); float s = 0.f;
#pragma unroll
        for (int j = 0; j < 4; ++j) { v[tk][j] = hr[lane + 64 * j]; s += v[tk][j].x * v[tk][j].x + v[tk][j].y * v[tk][j].y + v[tk][j].z * v[tk][j].z + v[tk][j].w * v[tk][j].w; }
        ss[tk] = s; }
    const float tot = tred8(ss, lane);
#pragma unroll
    for (int tk = 0; tk < 8; ++tk) { const float rstd = rsqrtf(__shfl(tot, tk * 8) * (1.f / D) + 1e-6f);
#pragma unroll
        for (int j = 0; j < 4; ++j) {
            const float4 g = ((const float4*)p.g_ffn)[lane + 64 * j];
            v[tk][j].x *= rstd * g.x; v[tk][j].y *= rstd * g.y; v[tk][j].z *= rstd * g.z; v[tk][j].w *= rstd * g.w;
            ushort4 o; o.x = f2bf(v[tk][j].x); o.y = f2bf(v[tk][j].y); o.z = f2bf(v[tk][j].z); o.w = f2bf(v[tk][j].w);
            ((ushort4*)(p.vb + (size_t)(t0 + tk) * D))[lane + 64 * j] = o; } }
    float* sl = (float*)smem + wave * (8 * 40);
    float* wl = (float*)smem + 4096;
    for (int o = 0; o < 36; ++o) {
        if (o == 0 || o == 18) { __syncthreads();
#pragma unroll
            for (int k = 0; k < 9; ++k) ((float4*)wl)[tid + k * 512] = ((const float4*)(p.wr + (size_t)o * 1024))[tid + k * 512];
            __syncthreads(); }
        const float4* wrow = (const float4*)(wl + (size_t)(o >= 18 ? o - 18 : o) * 1024); float a[8];
        float4 w[4];
#pragma unroll
        for (int j = 0; j < 4; ++j) w[j] = wrow[lane + 64 * j];
#pragma unroll
        for (int tk = 0; tk < 8; ++tk) { float s = 0.f;
#pragma unroll
            for (int j = 0; j < 4; ++j) s += v[tk][j].x * w[j].x + v[tk][j].y * w[j].y + v[tk][j].z * w[j].z + v[tk][j].w * w[j].w;
            a[tk] = s; }
        const float r = tred8(a, lane);
        if ((lane & 7) == 0) sl[(lane >> 3) * 40 + o] = r + (o < 4 ? p.b_grp[o] : p.b_exp[o - 4]); }
    asm volatile("s_waitcnt lgkmcnt(0)" ::: "memory");
    int* cntl = (int*)((float*)smem + 8 * 320); int* basel = cntl + 32;
    if (tid < 32) cntl[tid] = 0;
    __syncthreads();
    int x0 = 0, x1 = 0, l0 = 0, l1 = 0; float w0 = 0.f, w1 = 0.f;
    if (lane < 8) {
        const float* s8 = sl + lane * 40;
        int gs = 0; float gm = s8[0];
        for (int o = 1; o < 4; ++o) if (s8[o] > gm) { gm = s8[o]; gs = o; }
        float gsum = 0.f;
        for (int o = 0; o < 4; ++o) gsum += __expf(s8[o] - gm);
        const float pg = 1.f / gsum;
        const float* li = s8 + 4 + gs * 8;
        int e0 = 0; float m0 = li[0];
        for (int e = 1; e < 8; ++e) if (li[e] > m0) { m0 = li[e]; e0 = e; }
        int e1 = -1; float m1 = -3e38f;
        for (int e = 0; e < 8; ++e) if (e != e0 && li[e] > m1) { m1 = li[e]; e1 = e; }
        const float p0 = 1.f, p1 = __expf(m1 - m0);
        w0 = pg * p0 / (p0 + p1); w1 = pg * p1 / (p0 + p1);
        x0 = gs * 8 + e0; x1 = gs * 8 + e1;
        l0 = atomicAdd(&cntl[x0], 1); l1 = atomicAdd(&cntl[x1], 1);
    }
    __syncthreads();
    if (tid < 32) { const int c = cntl[tid]; basel[tid] = c > 0 ? (int)atomicAdd(&p.ctl[tid * 32], (unsigned)c) : 0; }
    __syncthreads();
    if (lane < 8) {
        const int t = t0 + lane; const int s0 = basel[x0] + l0, s1 = basel[x1] + l1;
        p.list[(size_t)x0 * p.T + s0] = t; p.list[(size_t)x1 * p.T + s1] = t;
        p.tokexp[t * 2] = x0; p.tokexp[t * 2 + 1] = x1; p.tokslot[t * 2] = s0; p.tokslot[t * 2 + 1] = s1; p.tokw[t * 2] = w0; p.tokw[t * 2 + 1] = w1;
    }
    __syncthreads();
}

__device__ __forceinline__ int* seg_bases(const P& p, char* smem) {
    int* sbase = (int*)(smem + LDS_MISC + 2048);
    __syncthreads();
    if (TIDX() == 0) { int acc = 0; for (int e = 0; e < NEXP; ++e) { sbase[e] = acc; acc += ((int)p.ctl[e * 32] + 255) & ~255; } sbase[NEXP] = acc; }
    __syncthreads();
    return sbase;
}
__device__ __forceinline__ void body_moe1(const P& p, int vb, char* smem) {
    int* sbase = seg_bases(p, smem); int* stok = sbase + 40;
    const int r0 = vb * 8; if (r0 >= sbase[NEXP]) return;
    int e = 0; while (r0 >= sbase[e + 1]) ++e;
    const int cnt = (int)p.ctl[e * 32];
    if (TIDX() < 8) { const int sl = r0 + TIDX() - sbase[e]; stok[TIDX()] = p.list[(size_t)e * p.T + (sl < cnt ? sl : 0)]; }
    __syncthreads();
    const int n = TIDX();
    const float* wg = p.w_gate + (size_t)e * 1024 * 512; const float* wu = p.w_up + (size_t)e * 1024 * 512;
    ngemm<1024, true, true>((float*)smem, 0, wg, 512, n, wu, 512, n,
        [&](int m, int k) { return bf2f(p.vb[(size_t)stok[m] * D + k]); }, [&](int m, int k) { return 0.f; },
        [&](int m, float zg, float zu) { p.H[(size_t)(r0 + m) * 512 + n] = f2bf(siluf_(zg) * zu); });
}
__device__ __forceinline__ void body_moe2(const P& p, int vb, char* smem) {
    int* sbase = seg_bases(p, smem);
    const int r0 = (vb >> 1) * 8; if (r0 >= sbase[NEXP]) return;
    int e = 0; while (r0 >= sbase[e + 1]) ++e;
    const int n = (vb & 1) * NT + TIDX();
    const float* wd = p.w_down + (size_t)e * 512 * 1024;
    ngemm<512, false, true>((float*)smem, r0, wd, 1024, n, wd, 1024, n,
        [&](int m, int k) { return bf2f(p.H[(size_t)m * 512 + k]); }, [&](int m, int k) { return 0.f; },
        [&](int m, float z, float) { p.Y[(size_t)m * 1024 + n] = f2bf(z); });
}
__device__ __forceinline__ void body_final(const P& p, int vb, char* smem) {
    int* sbase = seg_bases(p, smem);
    const int lane = TIDX() & 63, t = vb * 8 + (TIDX() >> 6);
    const int r0 = sbase[p.tokexp[t * 2]] + p.tokslot[t * 2], r1 = sbase[p.tokexp[t * 2 + 1]] + p.tokslot[t * 2 + 1];
    const float w0 = p.tokw[t * 2], w1 = p.tokw[t * 2 + 1];
    const float4* hr = (const float4*)(p.h1 + (size_t)t * D);
    float4 v[4]; float ss = 0.f;
#pragma unroll
    for (int j = 0; j < 4; ++j) {
        float4 a = hr[lane + 64 * j];
        const ushort4 y0 = ((const ushort4*)(p.Y + (size_t)r0 * D))[lane + 64 * j], y1 = ((const ushort4*)(p.Y + (size_t)r1 * D))[lane + 64 * j];
        a.x += w0 * bf2f(y0.x) + w1 * bf2f(y1.x); a.y += w0 * bf2f(y0.y) + w1 * bf2f(y1.y); a.z += w0 * bf2f(y0.z) + w1 * bf2f(y1.z); a.w += w0 * bf2f(y0.w) + w1 * bf2f(y1.w);
        v[j] = a; ss += a.x * a.x + a.y * a.y + a.z * a.z + a.w * a.w;
    }
#pragma unroll
    for (int o = 1; o < 64; o <<= 1) ss += __shfl_xor(ss, o);
    const float rstd = rsqrtf(ss * (1.f / D) + 1e-6f);
#pragma unroll
    for (int j = 0; j < 4; ++j) {
        const float4 g = ((const float4*)p.g_final)[lane + 64 * j];
        float4 o; o.x = v[j].x * rstd * g.x; o.y = v[j].y * rstd * g.y; o.z = v[j].z * rstd * g.z; o.w = v[j].w * rstd * g.w;
        ((float4*)(p.out + (size_t)t * D))[lane + 64 * j] = o;
    }
}

namespace pg8 {
#define PG8_LAS __attribute__((address_space(3)))
typedef short bf16x8 __attribute__((ext_vector_type(8)));
typedef float f32x4 __attribute__((ext_vector_type(4)));
typedef unsigned u32x4 __attribute__((ext_vector_type(4)));
typedef unsigned u32x2 __attribute__((ext_vector_type(2)));
constexpr int BM = 256, BK = 64, HALF = 128, HTB = HALF * BK * 2, STAGE_BYTES = 8 * HTB, NXCD = 8, WGM = 8;

__host__ __device__ __forceinline__ int lds_byte(int r, int c) { const int st = (r >> 4) * 2 + (c >> 5), rr = r & 15, cc = c & 31, ob = rr * 64 + cc * 2; return st * 1024 + (ob ^ (((ob >> 9) & 1) << 5)); }
__host__ __device__ __forceinline__ void stage_rc(int b, int& R, int& C) { const int st = b / 1024, sb = b % 1024, swz = sb ^ (((sb >> 9) & 1) << 5); R = (st >> 1) * 16 + swz / 64; C = (st & 1) * 32 + (swz % 64) / 2; }
__host__ __device__ __forceinline__ int perm32(int rho) { const int n = rho >> 4, i = rho & 15; return 8 * (i >> 2) + 4 * n + (i & 3); }

struct Unit { int pm, pn; const char* A; const char* B; int tag; };

struct TileOrder {
    int nM, nN, nwg, G, c;
    __device__ void init(int nM_, int nN_, int G_, int c_) { nM = nM_; nN = nN_; nwg = nM * nN; G = G_; c = c_; }
    __device__ bool next(int i, int& pm, int& pn) const {
        const long L = (long)i * G + c; if (L >= nwg) return false;
        int wgid = (int)L; { const int q = nwg / NXCD, r = nwg % NXCD, xcd = wgid % NXCD, off = wgid / NXCD; wgid = (xcd < r ? xcd * (q + 1) : r * (q + 1) + (xcd - r) * q) + off; }
        const int nig = WGM * nN, gid = wgid / nig, fm = gid * WGM, gsz = (nM - fm) < WGM ? (nM - fm) : WGM;
        pm = fm + ((wgid % nig) % gsz); pn = (wgid % nig) / gsz; return true;
    }
};
struct DenseSched {
    TileOrder o; const char* A; const char* B; int lda, ldb;
    __device__ void init(const void* A_, const void* B_, int M, int N, int lda_, int ldb_) { A = (const char*)A_; B = (const char*)B_; lda = lda_; ldb = ldb_; o.init(M / BM, N / BM, gridDim.x, blockIdx.x); }
    __device__ __forceinline__ bool next(int i, Unit& u) const { if (!o.next(i, u.pm, u.pn)) return false; u.A = A + (size_t)u.pm * BM * lda * 2; u.B = B + (size_t)u.pn * BM * ldb * 2; u.tag = 0; return true; }
    __device__ __forceinline__ unsigned arow(const Unit&, int r) const { return (unsigned)r * (unsigned)lda * 2u; }
};

__device__ __forceinline__ unsigned cvt_pk_bf16(float lo, float hi) { unsigned r; asm volatile("v_cvt_pk_bf16_f32 %0, %1, %2" : "=v"(r) : "v"(lo), "v"(hi)); return r; }

template <class Epi, class Sched, bool ALIGN_EPI, bool GATHER>
__device__ __forceinline__ void gemm_phase(PG8_LAS unsigned char* lds, const int K, const int lda, const int ldb, const Sched& S, const Epi& E) {
    const int tid = TIDX(), wid = __builtin_amdgcn_readfirstlane(tid >> 6), lane = tid & 63, wr = wid >> 2, wc = wid & 3, fr = lane & 15, fq = lane >> 4;
    const int nt = K / BK;
    int sR[2], sC[2];
    unsigned voffA[2], voffB[2];
#pragma unroll
    for (int i = 0; i < 2; ++i) { stage_rc(tid * 16 + i * 8192, sR[i], sC[i]); const int Rb = Epi::PERM ? ((sR[i] & ~31) + perm32(sR[i] & 31)) : sR[i];
        voffA[i] = (unsigned)(sR[i] * lda + sC[i]) * 2u; voffB[i] = (unsigned)(Rb * ldb + sC[i]) * 2u; }
    unsigned gA[2][2], gN[2][2];
    const size_t kstep = (size_t)(BK * 2);
    const size_t hstepA = (size_t)HALF * lda * 2, hstepB = (size_t)HALF * ldb * 2;
    const unsigned ldsw = (unsigned)wid * 1024u;
    const int aoff = lds_byte(wr * 64 + fr, fq * 8), boff = lds_byte(wc * 32 + fr, fq * 8);
#define PG8_SA(b, h) (((b) * 2 + (h)) * HTB)
#define PG8_SB(b, h) ((4 + (b) * 2 + (h)) * HTB)
#define PG8_GLDS(bufoff, gptr, i_) __builtin_amdgcn_global_load_lds((const unsigned*)(gptr), (PG8_LAS unsigned*)(lds + (bufoff) + ldsw + (i_) * 8192), 16, 0, 0)
#define PG8_STAGE_B(bufoff, gbase) do { _Pragma("unroll") for (int _i = 0; _i < 2; ++_i) PG8_GLDS(bufoff, (const char*)(gbase) + voffB[_i], _i); } while (0)
#define PG8_STAGE_A(bufoff, gb, h, NX) do { _Pragma("unroll") for (int _i = 0; _i < 2; ++_i) { \
        if constexpr (GATHER) { const unsigned _o = (NX) ? gN[h][_i] : gA[h][_i]; PG8_GLDS(bufoff, (const char*)(gb) + _o, _i); } \
        else { PG8_GLDS(bufoff, (const char*)(gb) + (h) * hstepA + voffA[_i], _i); } } } while (0)
#define PG8_LDA(dst, b, h) do { _Pragma("unroll") for (int m = 0; m < 4; ++m) _Pragma("unroll") for (int k = 0; k < 2; ++k) dst[m][k] = *(const PG8_LAS bf16x8*)(lds + PG8_SA(b, h) + aoff + m * 2048 + k * 1024); } while (0)
#define PG8_LDB(dst, b, h) do { _Pragma("unroll") for (int n = 0; n < 2; ++n) _Pragma("unroll") for (int k = 0; k < 2; ++k) dst[n][k] = *(const PG8_LAS bf16x8*)(lds + PG8_SB(b, h) + boff + n * 2048 + k * 1024); } while (0)
#define PG8_MMA(ai, bj, At, Bt) do { __builtin_amdgcn_s_setprio(1); _Pragma("unroll") for (int m = 0; m < 4; ++m) _Pragma("unroll") for (int n = 0; n < 2; ++n) _Pragma("unroll") for (int k = 0; k < 2; ++k) \
        acc[ai][bj][m][n] = __builtin_amdgcn_mfma_f32_16x16x32_bf16(Bt[n][k], At[m][k], acc[ai][bj][m][n], 0, 0, 0); __builtin_amdgcn_s_setprio(0); } while (0)
#define PG8_WAIT_V(n) asm volatile("s_waitcnt vmcnt(" #n ")" ::: "memory")
#define PG8_WAIT_L(n) asm volatile("s_waitcnt lgkmcnt(" #n ")" ::: "memory")
#define PG8_BAR __builtin_amdgcn_s_barrier()
#define PG8_SCHED __builtin_amdgcn_sched_barrier(0)
#define PG8_GOFF(dst, u) do { if constexpr (GATHER) { _Pragma("unroll") for (int _h = 0; _h < 2; ++_h) _Pragma("unroll") for (int _i = 0; _i < 2; ++_i) dst[_h][_i] = S.arow(u, _h * HALF + sR[_i]) + (unsigned)sC[_i] * 2u; } } while (0)
    Unit cur, nxt; int ui = 0;
    if (!S.next(0, cur)) return;
    f32x4 acc[2][2][4][2];
#pragma unroll
    for (int a = 0; a < 2; ++a)
#pragma unroll
        for (int b = 0; b < 2; ++b)
#pragma unroll
            for (int m = 0; m < 4; ++m)
#pragma unroll
                for (int n = 0; n < 2; ++n) acc[a][b][m][n] = (f32x4){0.f, 0.f, 0.f, 0.f};
    bf16x8 At[4][2], B0[2][2], B1[2][2];
    const char* cA = cur.A; const char* cB = cur.B;
    PG8_GOFF(gA, cur);
    if constexpr (GATHER) { PG8_WAIT_V(0); }
    PG8_STAGE_B(PG8_SB(0, 0), cB); PG8_STAGE_B(PG8_SB(0, 1), cB + hstepB); PG8_STAGE_A(PG8_SA(0, 0), cA, 0, false); PG8_STAGE_A(PG8_SA(0, 1), cA, 1, false);
    if (wr == 1) PG8_BAR;
    PG8_WAIT_V(2); PG8_BAR;
    PG8_STAGE_B(PG8_SB(1, 0), cB + kstep); PG8_STAGE_A(PG8_SA(1, 0), cA + kstep, 0, false); PG8_STAGE_B(PG8_SB(1, 1), cB + hstepB + kstep);
    PG8_WAIT_V(6); PG8_BAR;
    for (;;) {
        const bool has_next = S.next(ui + 1, nxt);
        const char* nA = has_next ? nxt.A : cA; const char* nB = has_next ? nxt.B : cB;
        if constexpr (GATHER) { if (has_next) { PG8_GOFF(gN, nxt); } else {
#pragma unroll
            for (int _h = 0; _h < 2; ++_h)
#pragma unroll
                for (int _i = 0; _i < 2; ++_i) gN[_h][_i] = gA[_h][_i]; } }
        for (int t = 0; t < nt; t += 2) {
            const bool last = (t == nt - 2);
            const char* a1 = cA + (size_t)(t + 1) * kstep;
            const char* a2 = last ? nA : cA + (size_t)(t + 2) * kstep; const char* b2 = last ? nB : cB + (size_t)(t + 2) * kstep;
            const char* a3 = a2 + kstep; const char* b3 = b2 + kstep;
            PG8_LDB(B0, 0, 0); PG8_LDB(B1, 0, 1); PG8_SCHED; PG8_LDA(At, 0, 0); PG8_STAGE_A(PG8_SA(1, 1), a1, 1, false);
            PG8_WAIT_V(8); PG8_WAIT_L(0); PG8_BAR; PG8_MMA(0, 0, At, B0); PG8_MMA(0, 1, At, B1); PG8_BAR; PG8_SCHED;
            PG8_LDA(At, 0, 1); PG8_STAGE_B(PG8_SB(0, 0), b2); PG8_STAGE_B(PG8_SB(0, 1), b2 + hstepB); PG8_STAGE_A(PG8_SA(0, 0), a2, 0, last);
            PG8_WAIT_V(8); PG8_WAIT_L(0); PG8_BAR; PG8_MMA(1, 0, At, B0); PG8_MMA(1, 1, At, B1); PG8_BAR; PG8_SCHED;
            PG8_LDB(B0, 1, 0); PG8_LDB(B1, 1, 1); PG8_SCHED; PG8_LDA(At, 1, 0); PG8_STAGE_A(PG8_SA(0, 1), a2, 1, last);
            PG8_WAIT_V(8); PG8_WAIT_L(0); PG8_BAR; PG8_MMA(0, 0, At, B0); PG8_MMA(0, 1, At, B1); PG8_BAR; PG8_SCHED;
            PG8_LDA(At, 1, 1); PG8_STAGE_B(PG8_SB(1, 0), b3); PG8_STAGE_B(PG8_SB(1, 1), b3 + hstepB); PG8_STAGE_A(PG8_SA(1, 0), a3, 0, last);
            PG8_WAIT_V(8); PG8_WAIT_L(0); PG8_BAR; PG8_MMA(1, 0, At, B0); PG8_MMA(1, 1, At, B1); PG8_BAR; PG8_SCHED;
        }
        if constexpr (ALIGN_EPI) { if (wr == 0) PG8_BAR; }
        E(acc, cur, wr, wc, fr, fq);
        if (!has_next) break;
#pragma unroll
        for (int a = 0; a < 2; ++a)
#pragma unroll
            for (int b = 0; b < 2; ++b)
#pragma unroll
                for (int m = 0; m < 4; ++m)
#pragma unroll
                    for (int n = 0; n < 2; ++n) acc[a][b][m][n] = (f32x4){0.f, 0.f, 0.f, 0.f};
        cur = nxt; cA = nA; cB = nB; ++ui;
        if constexpr (GATHER) {
#pragma unroll
            for (int _h = 0; _h < 2; ++_h)
#pragma unroll
                for (int _i = 0; _i < 2; ++_i) gA[_h][_i] = gN[_h][_i]; }
        if constexpr (ALIGN_EPI) { if (wr == 1) PG8_BAR; }
    }
    PG8_WAIT_V(0);
    if constexpr (!ALIGN_EPI) { if (wr == 0) PG8_BAR; }
    PG8_BAR;
#undef PG8_SA
#undef PG8_SB
#undef PG8_GLDS
#undef PG8_STAGE_A
#undef PG8_STAGE_B
#undef PG8_LDA
#undef PG8_LDB
#undef PG8_MMA
#undef PG8_WAIT_V
#undef PG8_WAIT_L
#undef PG8_BAR
#undef PG8_SCHED
#undef PG8_GOFF
}
}

typedef float f32x4_t __attribute__((ext_vector_type(4)));
__device__ __forceinline__ int inproj_row(int j) {
    if (j < 512) { const int h = j >> 6, d = j & 63; return h * 64 + 2 * (d & 31) + (d >> 5); }
    if (j < 1280) { const int seg = (j - 512) >> 7, cc = (j - 512) & 127; int col = cc; if (seg == 2 || seg == 4) { const int g = cc >> 6, d = cc & 63; col = g * 64 + 2 * (d & 31) + (d >> 5); } return (2 + (seg >> 1)) * 256 + (seg & 1) * 128 + col; }
    if (j < 1304) return 11 * 256 + (j - 1280);
    if (j < 1560) return 5 * 256 + (j - 1304);
    if (j < 1816) return 6 * 256 + (j - 1560);
    if (j < 2328) return 7 * 256 + (j - 1816);
    if (j < 2344) return 11 * 256 + 32 + (j - 2328);
    if (j < 2856) return 9 * 256 + (j - 2344);
    if (j < 3880) return 12 * 256 + (j - 2856);
    return 16 * 256 + (j - 3880);
}
__device__ __forceinline__ unsigned pk2(float lo, float hi) { return (unsigned)f2bf(lo) | ((unsigned)f2bf(hi) << 16); }
template <class RM>
__device__ __forceinline__ void transpose_item(const float* W, int ldw, int N, bf16* WT, int ldt, float* scr, int k0, int n0, int lane, RM rm) {
    const int nn = n0 + (lane & 31);
#pragma unroll 8
    for (int i = 0; i < 32; ++i) { const int kk = 2 * i + (lane >> 5); scr[kk * 33 + (lane & 31)] = nn < N ? W[(size_t)(k0 + kk) * ldw + nn] : 0.f; }
    asm volatile("s_waitcnt lgkmcnt(0)" ::: "memory");
    const int c = lane & 7;
#pragma unroll
    for (int j = 0; j < 4; ++j) { const int n = (lane >> 3) + 8 * j; const float* s = scr + (8 * c) * 33 + n;
        uint4 o; o.x = pk2(s[0 * 33], s[1 * 33]); o.y = pk2(s[2 * 33], s[3 * 33]); o.z = pk2(s[4 * 33], s[5 * 33]); o.w = pk2(s[6 * 33], s[7 * 33]);
        const int row = (n0 + n < N) ? rm(n0 + n) : -1;
        if (row >= 0) *(uint4*)(WT + (size_t)row * ldt + k0 + 8 * c) = o; }
    asm volatile("s_waitcnt lgkmcnt(0)" ::: "memory");
}
constexpr int PREP_I_WIN = 16 * 154, PREP_I_C1 = 4 * 128, PREP_I_PN = 256, PREP_I_PG = 256, PREP_I_WO = 512, PREP_I_EXP = 3 * 32 * 256;
constexpr int PREP_ITEMS = PREP_I_WIN + PREP_I_C1 + PREP_I_PN + PREP_I_PG + PREP_I_WO + PREP_I_EXP;
__device__ __forceinline__ void prep_item(const P& p, int it, float* scr, int lane) {
    if (it < PREP_I_WIN) { const int kb = it / 154, nb = it % 154; transpose_item(p.w_in, INW, INW, p.Wt_in, 1024, scr, kb * 64, nb * 32, lane, [](int n) { return inproj_row(n); }); return; }
    it -= PREP_I_WIN;
    if (it < PREP_I_C1) { const int mat = it >> 7, r = it & 127, kb = r >> 3, nb = r & 7, kv = mat >> 1, half = mat & 1;
        const float* W = (kv ? p.cw1_v : p.cw1_k) + (size_t)half * 1024 * 256;
        transpose_item(W, 256, 256, p.Wc1 + (size_t)kv * 512 * 1024, 1024, scr, kb * 64, nb * 32, lane, [half](int n) { return half * 256 + n; }); return; }
    it -= PREP_I_C1;
    if (it < PREP_I_PN) { transpose_item(p.w_pn, 1024, 1024, p.Wpn, 512, scr, (it >> 5) * 64, (it & 31) * 32, lane, [](int n) { return n; }); return; }
    it -= PREP_I_PN;
    if (it < PREP_I_PG) { transpose_item(p.w_pg, 1024, 1024, p.Wpg, 512, scr, (it >> 5) * 64, (it & 31) * 32, lane, [](int n) { return n; }); return; }
    it -= PREP_I_PG;
    if (it < PREP_I_WO) { transpose_item(p.w_out, 1024, 1024, p.Wo, 1024, scr, (it >> 5) * 64, (it & 31) * 32, lane, [](int n) { return n; }); return; }
    it -= PREP_I_WO;
    { const int which = it / (32 * 256), r = it % (32 * 256), e = r >> 8, r2 = r & 255;
        if (which == 0) transpose_item(p.w_gate + (size_t)e * 1024 * 512, 512, 512, p.Wgu + (size_t)e * 1024 * 1024, 1024, scr, (r2 >> 4) * 64, (r2 & 15) * 32, lane, [](int n) { return (n >> 7) * 256 + (n & 127); });
        else if (which == 1) transpose_item(p.w_up + (size_t)e * 1024 * 512, 512, 512, p.Wgu + (size_t)e * 1024 * 1024, 1024, scr, (r2 >> 4) * 64, (r2 & 15) * 32, lane, [](int n) { return (n >> 7) * 256 + 128 + (n & 127); });
        else transpose_item(p.w_down + (size_t)e * 512 * 1024, 1024, 1024, p.Wd + (size_t)e * 1024 * 512, 512, scr, (r2 >> 5) * 64, (r2 & 31) * 32, lane, [](int n) { return n; }); }
}
__device__ __forceinline__ void phase_prep_(const P& p, char* smem);
__device__ __forceinline__ void prep_b1p(const P& p, char* smem);
__device__ __forceinline__ void phase_prep(const P& p, char* smem) { prep_b1p(p, smem); phase_prep_(p, smem); }
__device__ __forceinline__ void phase_prep_(const P& p, char* smem) {
    const int wave = TIDX() >> 6, lane = TIDX() & 63;
    float* scr = (float*)smem + wave * (64 * 33);
    const int gw = blockIdx.x * 8 + wave, NGW = gridDim.x * 8;
    for (int it = gw; it < PREP_ITEMS; it += NGW) prep_item(p, it, scr, lane);
    for (int i = blockIdx.x * NT + TIDX(); i < 216 * 128; i += gridDim.x * NT) { int r = i >> 7; r = r < 8 ? 24 + r : 40 + r; *(uint4*)(p.Wt_in + (size_t)(11 * 256 + r) * 1024 + (i & 127) * 8) = make_uint4(0, 0, 0, 0); }
    for (int i = blockIdx.x * NT + TIDX(); i < 36 * 1024; i += gridDim.x * NT) { const int o = i >> 10, k = i & 1023; p.wr[i] = o < 4 ? p.w_grp[k * 4 + o] : p.w_exp[k * 32 + (o - 4)]; }
    for (int vb = blockIdx.x; vb < p.T / 8; vb += gridDim.x) body_rms(p, vb);
    for (int vb = blockIdx.x; vb < p.T * 32 / NT; vb += gridDim.x) body_cs(p, vb);
}

struct EpiInA {
    static constexpr bool PERM = true;
    P p;
    __device__ __forceinline__ static void rope4(const float* cs, int t, int i0, const pg8::f32x4& v0, const pg8::f32x4& v1, float sc, pg8::u32x2& lo, pg8::u32x2& hi) {
        const f32x4_t c = *(const f32x4_t*)(cs + (size_t)t * 64 + i0), s = *(const f32x4_t*)(cs + (size_t)t * 64 + 32 + i0);
        const float a0 = (v0[0] * c[0] - v0[1] * s[0]) * sc, b0 = (v0[1] * c[0] + v0[0] * s[0]) * sc;
        const float a1 = (v0[2] * c[1] - v0[3] * s[1]) * sc, b1 = (v0[3] * c[1] + v0[2] * s[1]) * sc;
        const float a2 = (v1[0] * c[2] - v1[1] * s[2]) * sc, b2 = (v1[1] * c[2] + v1[0] * s[2]) * sc;
        const float a3 = (v1[2] * c[3] - v1[3] * s[3]) * sc, b3 = (v1[3] * c[3] + v1[2] * s[3]) * sc;
        lo.x = pk2(a0, a1); lo.y = pk2(a2, a3); hi.x = pk2(b0, b1); hi.y = pk2(b2, b3);
    }
    __device__ __forceinline__ static pg8::u32x4 pack8(const pg8::f32x4& v0, const pg8::f32x4& v1) { pg8::u32x4 w; w.x = pk2(v0[0], v0[1]); w.y = pk2(v0[2], v0[3]); w.z = pk2(v1[0], v1[1]); w.w = pk2(v1[2], v1[3]); return w; }
    __device__ __forceinline__ void operator()(const pg8::f32x4 (&acc)[2][2][4][2], const pg8::Unit& u, int wr, int wc, int fr, int fq) const {
        const int pn = u.pn, c8 = wc * 32 + 8 * fq; const size_t seg = kvseg(p);
#pragma unroll
        for (int ai = 0; ai < 2; ++ai)
#pragma unroll
            for (int m = 0; m < 4; ++m) {
                const int t = u.pm * 256 + ai * 128 + wr * 64 + m * 16 + fr; const int b = t / S, s = t % S;
#pragma unroll
                for (int bj = 0; bj < 2; ++bj) {
                    const pg8::f32x4 v0 = acc[ai][bj][m][0], v1 = acc[ai][bj][m][1];
                    if (pn <= 1) {
                        const int cq = pn * 256 + bj * 128 + c8, h = cq >> 6, i0 = (cq & 63) >> 1; pg8::u32x2 lo, hi;
                        rope4(p.cs, t, i0, v0, v1, 0.125f, lo, hi);
                        bf16* dst = p.q + (size_t)t * 512 + h * 64 + i0; *(pg8::u32x2*)dst = lo; *(pg8::u32x2*)(dst + 32) = hi;
                    } else if (pn <= 4) {
                        const int sgi = (pn - 2) * 2 + bj, g = c8 >> 6; bf16* base = p.kv6 + (size_t)sgi * seg + ((size_t)(b * 2 + g) * S + s) * 64;
                        if (bj == 0 && pn >= 3) { const int i0 = (c8 & 63) >> 1; pg8::u32x2 lo, hi; rope4(p.cs, t, i0, v0, v1, 1.f, lo, hi); *(pg8::u32x2*)(base + i0) = lo; *(pg8::u32x2*)(base + 32 + i0) = hi; }
                        else *(pg8::u32x4*)(base + (c8 & 63)) = pack8(v0, v1);
                    } else if (pn == 5) { *(pg8::u32x4*)(p.gq + (size_t)t * 256 + bj * 128 + c8) = pack8(v0 * 0.125f, v1 * 0.125f);
                    } else if (pn == 6) { *(pg8::u32x4*)(p.gk + (size_t)t * 256 + bj * 128 + c8) = pack8(v0, v1);
                    } else if (pn <= 8) { *(pg8::u32x4*)(p.gv + (size_t)t * 512 + (pn - 7) * 256 + bj * 128 + c8) = pack8(v0, v1);
                    } else if (pn <= 10) {
                        pg8::f32x4 a, c;
#pragma unroll
                        for (int e = 0; e < 4; ++e) { a[e] = siluf_(v0[e]); c[e] = siluf_(v1[e]); }
                        *(pg8::u32x4*)(p.rs + (size_t)t * 512 + (pn - 9) * 256 + bj * 128 + c8) = pack8(a, c);
                    } else {
                        if (bj == 0) {
                            if (c8 < 24) { float* d = p.gates + (size_t)t * 24 + c8;
#pragma unroll
                                for (int e = 0; e < 4; ++e) { d[e] = sigmoidf_(v0[e]); d[4 + e] = sigmoidf_(v1[e]); } }
                            else if (c8 >= 32 && c8 < 48) { float* d = p.alow + (size_t)t * 16 + (c8 - 32);
#pragma unroll
                                for (int e = 0; e < 4; ++e) { d[e] = v0[e]; d[4 + e] = v1[e]; } }
                        }
                    }
                }
            }
    }
};
struct EpiSig {
    static constexpr bool PERM = true;
    bf16* sa; bf16* sb;
    __device__ __forceinline__ void operator()(const pg8::f32x4 (&acc)[2][2][4][2], const pg8::Unit& u, int wr, int wc, int fr, int fq) const {
        bf16* base = (u.pn < 4 ? sa : sb) + (u.pn & 3) * 256 + wc * 32 + 8 * fq;
#pragma unroll
        for (int ai = 0; ai < 2; ++ai)
#pragma unroll
            for (int m = 0; m < 4; ++m) { const int t = u.pm * 256 + ai * 128 + wr * 64 + m * 16 + fr;
#pragma unroll
                for (int bj = 0; bj < 2; ++bj) { pg8::f32x4 a, c;
#pragma unroll
                    for (int e = 0; e < 4; ++e) { a[e] = sigmoidf_(acc[ai][bj][m][0][e]); c[e] = sigmoidf_(acc[ai][bj][m][1][e]); }
                    *(pg8::u32x4*)(base + (size_t)t * 1024 + bj * 128) = EpiInA::pack8(a, c); } }
    }
};
__device__ __forceinline__ void phase_inA(const P& p, char* smem) {
    pg8::DenseSched S; S.init(p.u, p.Wt_in, p.T, 3072, 1024, 1024);
    EpiInA E{p};
    pg8::gemm_phase<EpiInA, pg8::DenseSched, true, false>((PG8_LAS unsigned char*)smem, 1024, 1024, 1024, S, E);
}
__device__ __forceinline__ void phase_inB(const P& p, char* smem) {
    pg8::DenseSched S; S.init(p.u, p.Wt_in + (size_t)3072 * 1024, p.T, 2048, 1024, 1024);
    EpiSig E{p.sa, p.sb};
    pg8::gemm_phase<EpiSig, pg8::DenseSched, true, false>((PG8_LAS unsigned char*)smem, 1024, 1024, 1024, S, E);
}

struct EpiProj {
    static constexpr bool PERM = true;
    const bf16* g; bf16* mixed; int pass;
    __device__ __forceinline__ void operator()(const pg8::f32x4 (&acc)[2][2][4][2], const pg8::Unit& u, int wr, int wc, int fr, int fq) const {
        const int col0 = u.pn * 256 + wc * 32 + 8 * fq;
#pragma unroll
        for (int ai = 0; ai < 2; ++ai)
#pragma unroll
            for (int m = 0; m < 4; ++m) { const size_t t = (size_t)(u.pm * 256 + ai * 128 + wr * 64 + m * 16 + fr);
#pragma unroll
                for (int bj = 0; bj < 2; ++bj) { const size_t off = t * 1024 + col0 + bj * 128;
                    const uint4 gv = *(const uint4*)(g + off); const unsigned gw[4] = {gv.x, gv.y, gv.z, gv.w};
                    float r[8];
#pragma unroll
                    for (int e = 0; e < 4; ++e) { const float a = e < 2 ? acc[ai][bj][m][0][2 * e] : acc[ai][bj][m][1][2 * e - 4], b = e < 2 ? acc[ai][bj][m][0][2 * e + 1] : acc[ai][bj][m][1][2 * e - 3];
                        r[2 * e] = __uint_as_float(gw[e] << 16) * a; r[2 * e + 1] = __uint_as_float(gw[e] & 0xffff0000u) * b; }
                    if (pass) { const uint4 mv = *(const uint4*)(mixed + off); const unsigned mw[4] = {mv.x, mv.y, mv.z, mv.w};
#pragma unroll
                        for (int e = 0; e < 4; ++e) { r[2 * e] += __uint_as_float(mw[e] << 16); r[2 * e + 1] += __uint_as_float(mw[e] & 0xffff0000u); } }
                    uint4 o; o.x = pk2(r[0], r[1]); o.y = pk2(r[2], r[3]); o.z = pk2(r[4], r[5]); o.w = pk2(r[6], r[7]);
                    *(uint4*)(mixed + off) = o; } }
    }
};
struct EpiOut {
    static constexpr bool PERM = false;
    const float* x; float* h1;
    __device__ __forceinline__ void operator()(const pg8::f32x4 (&acc)[2][2][4][2], const pg8::Unit& u, int wr, int wc, int fr, int fq) const {
        const int col0 = u.pn * 256 + wc * 32 + 4 * fq;
#pragma unroll
        for (int ai = 0; ai < 2; ++ai)
#pragma unroll
            for (int m = 0; m < 4; ++m) { const size_t off = (size_t)(u.pm * 256 + ai * 128 + wr * 64 + m * 16 + fr) * 1024 + col0;
#pragma unroll
                for (int bj = 0; bj < 2; ++bj)
#pragma unroll
                    for (int n = 0; n < 2; ++n) { const pg8::f32x4 xv = *(const pg8::f32x4*)(x + off + bj * 128 + n * 16); *(pg8::f32x4*)(h1 + off + bj * 128 + n * 16) = xv + acc[ai][bj][m][n]; } }
    }
};
__device__ __forceinline__ void phase_proj(const P& p, char* smem) {
    { pg8::DenseSched S; S.init(p.onsa, p.Wpn, p.T, 1024, 512, 512); EpiProj E{p.sa, p.mixed, 0};
      pg8::gemm_phase<EpiProj, pg8::DenseSched, true, false>((PG8_LAS unsigned char*)smem, 512, 512, 512, S, E); }
    { pg8::DenseSched S; S.init(p.gla, p.Wpg, p.T, 1024, 512, 512); EpiProj E{p.sb, p.mixed, 1};
      pg8::gemm_phase<EpiProj, pg8::DenseSched, true, false>((PG8_LAS unsigned char*)smem, 512, 512, 512, S, E); }
}
__device__ __forceinline__ void phase_out(const P& p, char* smem) {
    pg8::DenseSched S; S.init(p.mixed, p.Wo, p.T, 1024, 1024, 1024); EpiOut E{p.x, p.h1};
    pg8::gemm_phase<EpiOut, pg8::DenseSched, true, false>((PG8_LAS unsigned char*)smem, 1024, 1024, 1024, S, E);
}

struct ExpertSched {
    const int* ub;
    const int* sb_;
    const unsigned* cnt; const int* list; int T;
    const char* A; const char* B; int lda, ldb; size_t bstride;
    int npn, G, c; bool gather;
    __device__ __forceinline__ bool next(int i, pg8::Unit& u) const {
        const int L = i * G + c; if (L >= ub[NEXP]) return false;
        int e = 0; while (L >= ub[e + 1]) ++e;
        const int rem = L - ub[e], tiles = (ub[e + 1] - ub[e]) / npn, pn = rem / tiles, pml = rem % tiles;
        u.pm = sb_[e] / 256 + pml; u.pn = pn; u.tag = e | (pml << 8);
        u.A = gather ? A : A + (size_t)u.pm * 256 * lda * 2; u.B = B + (size_t)e * bstride + (size_t)pn * 256 * ldb * 2; return true;
    }
    __device__ __forceinline__ unsigned arow(const pg8::Unit& u, int r) const {
        const int e = u.tag & 255, sl = (u.tag >> 8) * 256 + r; const int tok = list[(size_t)e * T + (sl < (int)cnt[e * 32] ? sl : 0)];
        return (unsigned)tok * (unsigned)lda * 2u;
    }
};
__device__ __forceinline__ void expert_tables(const P& p, char* smem, int npn, int*& ub, int*& sb_) {
    ub = (int*)(smem + LDS_MISC + 1024); sb_ = ub + 40;
    __syncthreads();
    if (TIDX() == 0) { int ua = 0, sa = 0; for (int e = 0; e < NEXP; ++e) { ub[e] = ua; sb_[e] = sa; const int tl = ((int)p.ctl[e * 32] + 255) >> 8; ua += tl * npn; sa += tl * 256; } ub[NEXP] = ua; sb_[NEXP] = sa; }
    __syncthreads();
}
struct EpiMoe1 {
    static constexpr bool PERM = true;
    bf16* H;
    __device__ __forceinline__ void operator()(const pg8::f32x4 (&acc)[2][2][4][2], const pg8::Unit& u, int wr, int wc, int fr, int fq) const {
        const int col0 = u.pn * 128 + wc * 32 + 8 * fq;
#pragma unroll
        for (int ai = 0; ai < 2; ++ai)
#pragma unroll
            for (int m = 0; m < 4; ++m) { const size_t row = (size_t)(u.pm * 256 + ai * 128 + wr * 64 + m * 16 + fr);
                pg8::f32x4 a, b;
#pragma unroll
                for (int e = 0; e < 4; ++e) { a[e] = siluf_(acc[ai][0][m][0][e]) * acc[ai][1][m][0][e]; b[e] = siluf_(acc[ai][0][m][1][e]) * acc[ai][1][m][1][e]; }
                *(pg8::u32x4*)(H + row * 512 + col0) = EpiInA::pack8(a, b); }
    }
};
struct EpiMoe2 {
    static constexpr bool PERM = true;
    bf16* Y;
    __device__ __forceinline__ void operator()(const pg8::f32x4 (&acc)[2][2][4][2], const pg8::Unit& u, int wr, int wc, int fr, int fq) const {
        const int col0 = u.pn * 256 + wc * 32 + 8 * fq;
#pragma unroll
        for (int ai = 0; ai < 2; ++ai)
#pragma unroll
            for (int m = 0; m < 4; ++m) { const size_t row = (size_t)(u.pm * 256 + ai * 128 + wr * 64 + m * 16 + fr);
#pragma unroll
                for (int bj = 0; bj < 2; ++bj) *(pg8::u32x4*)(Y + row * 1024 + col0 + bj * 128) = EpiInA::pack8(acc[ai][bj][m][0], acc[ai][bj][m][1]); }
    }
};
__device__ __forceinline__ void phase_moe1(const P& p, char* smem) {
    int *ub, *sb_; expert_tables(p, smem, 4, ub, sb_);
    ExpertSched S{ub, sb_, p.ctl, p.list, p.T, (const char*)p.vb, (const char*)p.Wgu, 1024, 1024, (size_t)1024 * 1024 * 2, 4, (int)gridDim.x, (int)blockIdx.x, true};
    EpiMoe1 E{p.H};
    pg8::gemm_phase<EpiMoe1, ExpertSched, true, true>((PG8_LAS unsigned char*)smem, 1024, 1024, 1024, S, E);
}
__device__ __forceinline__ void phase_moe2(const P& p, char* smem) {
    int *ub, *sb_; expert_tables(p, smem, 4, ub, sb_);
    ExpertSched S{ub, sb_, p.ctl, p.list, p.T, (const char*)p.H, (const char*)p.Wd, 512, 512, (size_t)1024 * 512 * 2, 4, (int)gridDim.x, (int)blockIdx.x, false};
    EpiMoe2 E{p.Y};
    pg8::gemm_phase<EpiMoe2, ExpertSched, true, false>((PG8_LAS unsigned char*)smem, 512, 512, 512, S, E);
}

namespace nsa {
using f32x16 = __attribute__((ext_vector_type(16))) float;
using bf16x8 = __attribute__((ext_vector_type(8))) short;
using s16x4 = __attribute__((ext_vector_type(4))) short;
using u32x4 = __attribute__((ext_vector_type(4))) unsigned;
typedef __attribute__((address_space(3))) char* lptr;
typedef __attribute__((address_space(3))) const char* lcptr;
constexpr int SLOT = 8192;
constexpr int NSLOT = 3;
constexpr int L_K = 0, L_V = NSLOT * SLOT, L_WS = 2 * NSLOT * SLOT, L_OST = L_WS + 8 * 512, L_IMPD = L_OST + 8 * 4096, L_IMPC = L_IMPD + 64 * 64 * 4, L_SEL = L_IMPC + 64 * 68 * 4, L_END = L_SEL + 64 * 8;
constexpr float LOG2E = 1.4426950408889634f, NEGM = -1e30f, M0 = -1e20f, THR = 8.f;
__device__ __forceinline__ int crow(int r, int hi) { return (r & 3) + 8 * (r >> 2) + 4 * hi; }
__device__ __forceinline__ void glds16(const void* gsrc, unsigned lds_dst) { unsigned keep;
    asm volatile("s_mov_b32 %0, m0\n\ts_mov_b32 m0, %2\n\ts_nop 0\n\tglobal_load_lds_dwordx4 %1, off\n\ts_mov_b32 m0, %0" : "=&s"(keep) : "v"(gsrc), "s"(lds_dst) : "memory"); }
#define NSA_WAIT_BAR() asm volatile("s_waitcnt vmcnt(2) lgkmcnt(0)\n\ts_barrier" ::: "memory")
#define NSA_DRAIN_BAR() asm volatile("s_waitcnt vmcnt(0) lgkmcnt(0)\n\ts_barrier" ::: "memory")
#define NSA_LWAIT() asm volatile("s_waitcnt lgkmcnt(0)" ::: "memory")
__device__ __forceinline__ unsigned cvtpk(float lo, float hi) { typedef float f2 __attribute__((ext_vector_type(2))); typedef __bf16 b2 __attribute__((ext_vector_type(2))); f2 v = {lo, hi}; b2 b = __builtin_convertvector(v, b2); return __builtin_bit_cast(unsigned, b); }
__device__ __forceinline__ float xhalf_max(float m) { auto rr = __builtin_amdgcn_permlane32_swap(__float_as_uint(m), __float_as_uint(m), false, false); return fmaxf(__uint_as_float(rr[0]), __uint_as_float(rr[1])); }
__device__ __forceinline__ float xhalf_sum(float m) { auto rr = __builtin_amdgcn_permlane32_swap(__float_as_uint(m), __float_as_uint(m), false, false); return __uint_as_float(rr[0]) + __uint_as_float(rr[1]); }
__device__ __forceinline__ void qkt(f32x16& p0, f32x16& p1, lcptr Kslot, const bf16x8* qr, int r32, int hi) {
    lcptr kb = Kslot + hi * 1024 + r32 * 16;
    p0 = f32x16{}; p1 = f32x16{};
#pragma unroll
    for (int d0 = 0; d0 < 4; ++d0) {
        const bf16x8 b0 = *(const __attribute__((address_space(3))) bf16x8*)(kb + d0 * 2048);
        const bf16x8 b1 = *(const __attribute__((address_space(3))) bf16x8*)(kb + d0 * 2048 + 512);
        p0 = __builtin_amdgcn_mfma_f32_32x32x16_bf16(b0, qr[d0], p0, 0, 0, 0); p1 = __builtin_amdgcn_mfma_f32_32x32x16_bf16(b1, qr[d0], p1, 0, 0, 0); }
}
__device__ __forceinline__ void pv(f32x16* o, int vb, bf16x8 pa0, bf16x8 pa1, bf16x8 pa2, bf16x8 pa3) {
#pragma unroll
    for (int d0 = 0; d0 < 2; ++d0) { s16x4 lo[4], hi[4];
#pragma unroll
        for (int ks = 0; ks < 4; ++ks) {
            asm volatile("ds_read_b64_tr_b16 %0,%1 offset:%c2" : "=&v"(lo[ks]) : "v"(vb), "i"(d0 * 4096 + ks * 1024) : "memory");
            asm volatile("ds_read_b64_tr_b16 %0,%1 offset:%c2" : "=&v"(hi[ks]) : "v"(vb), "i"(d0 * 4096 + ks * 1024 + 512) : "memory"); }
        asm volatile("s_waitcnt lgkmcnt(0)" ::: "memory"); __builtin_amdgcn_sched_barrier(0);
#define NSA_PK(k) (bf16x8){lo[k][0], lo[k][1], lo[k][2], lo[k][3], hi[k][0], hi[k][1], hi[k][2], hi[k][3]}
        o[d0] = __builtin_amdgcn_mfma_f32_32x32x16_bf16(pa0, NSA_PK(0), o[d0], 0, 0, 0);
        o[d0] = __builtin_amdgcn_mfma_f32_32x32x16_bf16(pa1, NSA_PK(1), o[d0], 0, 0, 0);
        o[d0] = __builtin_amdgcn_mfma_f32_32x32x16_bf16(pa2, NSA_PK(2), o[d0], 0, 0, 0);
        o[d0] = __builtin_amdgcn_mfma_f32_32x32x16_bf16(pa3, NSA_PK(3), o[d0], 0, 0, 0);
#undef NSA_PK
    }
}
__device__ __forceinline__ float rowmax32(const f32x16& p0, const f32x16& p1) {
    float a = fmaxf(p0[0], p1[0]);
#pragma unroll
    for (int r = 1; r < 16; ++r) a = fmaxf(a, fmaxf(p0[r], p1[r]));
    return xhalf_max(a);
}
struct Ctx {
    int w, lane, r32, hi, rs; unsigned lds0; lptr shm; const bf16* kt; const bf16* vt;
};
__device__ __forceinline__ void dma_kv(const Ctx& c, int tile, int slot) {
    const bf16* ksrc = c.kt + (size_t)tile * 64 * 64 + c.lane * 64 + c.w * 8;
    const bf16* vsrc = c.vt + (size_t)tile * 64 * 64 + (16 * (c.w & 3) + (c.lane >> 2)) * 64 + (c.w >> 2) * 32 + (c.lane & 3) * 8;
    glds16(ksrc, (unsigned)__builtin_amdgcn_readfirstlane(c.lds0 + L_K + slot * SLOT + c.w * 1024));
    glds16(vsrc, (unsigned)__builtin_amdgcn_readfirstlane(c.lds0 + L_V + slot * SLOT + c.w * 1024));
}
template <int ABL = 0> __device__ __forceinline__ void ring_begin(Ctx& c, int t0, int t1) { NSA_DRAIN_BAR(); if (!(ABL & 8)) { dma_kv(c, t0, 0); dma_kv(c, t1 >= 0 ? t1 : t0, 1); } c.rs = 0; }
template <int ABL = 0> __device__ __forceinline__ void ring_step(Ctx& c, int t2, int tcur) { if (!(ABL & 16)) NSA_WAIT_BAR(); int s2 = c.rs + 2; if (s2 >= NSLOT) s2 -= NSLOT; if (!(ABL & 8)) dma_kv(c, t2 >= 0 ? t2 : tcur, s2); }
__device__ __forceinline__ void ring_next(Ctx& c) { c.rs = (c.rs == NSLOT - 1) ? 0 : c.rs + 1; }
template <int ABL> __device__ __forceinline__ void softmax_pv(const Ctx& c, f32x16& p0, f32x16& p1, f32x16* o, float& m, float& l, int slot, bool on) {
    float a0 = fmaxf(fmaxf(p0[0], p0[1]), p1[0]), a1 = fmaxf(fmaxf(p0[2], p0[3]), p1[1]), a2 = fmaxf(fmaxf(p0[4], p0[5]), p1[2]), a3 = fmaxf(fmaxf(p0[6], p0[7]), p1[3]);
    a0 = fmaxf(fmaxf(a0, p0[8]), p0[9]); a1 = fmaxf(fmaxf(a1, p0[10]), p0[11]); a2 = fmaxf(fmaxf(a2, p0[12]), p0[13]); a3 = fmaxf(fmaxf(a3, p0[14]), p0[15]);
    a0 = fmaxf(fmaxf(a0, p1[4]), p1[5]); a1 = fmaxf(fmaxf(a1, p1[6]), p1[7]); a2 = fmaxf(fmaxf(a2, p1[8]), p1[9]); a3 = fmaxf(fmaxf(a3, p1[10]), p1[11]);
    a0 = fmaxf(fmaxf(a0, p1[12]), p1[13]); a1 = fmaxf(fmaxf(a1, p1[14]), p1[15]);
    float rm = xhalf_max(fmaxf(fmaxf(a0, a1), fmaxf(a2, a3)));
    rm = on ? rm : NEGM;
    volatile __attribute__((address_space(3))) float* wsf = (volatile __attribute__((address_space(3))) float*)(c.shm + L_WS + c.w * 512);
    bool resc = false;
    if (__any(rm > m + THR)) { const float mn = fmaxf(m, rm); const float f = __builtin_amdgcn_exp2f(m - mn); l *= f; m = mn; if (c.hi == 0) wsf[c.r32] = f; resc = true; }
    const float ms = on ? m : 1e30f;
    float s0 = 0.f, s1 = 0.f, s2 = 0.f, s3 = 0.f;
#pragma unroll
    for (int r = 0; r < 16; r += 2) {
        if (!(ABL & 2)) { p0[r] = __builtin_amdgcn_exp2f(p0[r] - ms); p0[r + 1] = __builtin_amdgcn_exp2f(p0[r + 1] - ms); p1[r] = __builtin_amdgcn_exp2f(p1[r] - ms); p1[r + 1] = __builtin_amdgcn_exp2f(p1[r + 1] - ms); }
        else { p0[r] -= ms; p0[r + 1] -= ms; p1[r] -= ms; p1[r + 1] -= ms; }
        s0 += p0[r]; s1 += p0[r + 1]; s2 += p1[r]; s3 += p1[r + 1]; }
    l += (s0 + s1) + (s2 + s3);
    if (resc) { NSA_LWAIT();
#pragma unroll
        for (int r = 0; r < 16; ++r) { const float f = wsf[crow(r, c.hi)]; o[0][r] *= f; o[1][r] *= f; } }
    u32x4 w0, w1, w2, w3;
    w0 = (u32x4){cvtpk(p0[0], p0[1]), cvtpk(p0[2], p0[3]), cvtpk(p0[4], p0[5]), cvtpk(p0[6], p0[7])};
    w1 = (u32x4){cvtpk(p0[8], p0[9]), cvtpk(p0[10], p0[11]), cvtpk(p0[12], p0[13]), cvtpk(p0[14], p0[15])};
    w2 = (u32x4){cvtpk(p1[0], p1[1]), cvtpk(p1[2], p1[3]), cvtpk(p1[4], p1[5]), cvtpk(p1[6], p1[7])};
    w3 = (u32x4){cvtpk(p1[8], p1[9]), cvtpk(p1[10], p1[11]), cvtpk(p1[12], p1[13]), cvtpk(p1[14], p1[15])};
    const int vb = (int)(c.lds0 + L_V + slot * SLOT) + ((c.lane >> 4) & 1) * 32 + (c.lane & 3) * 8 + (4 * c.hi + ((c.lane & 15) >> 2)) * 64;
    if (!(ABL & 1)) pv(o, vb, __builtin_bit_cast(bf16x8, w0), __builtin_bit_cast(bf16x8, w1), __builtin_bit_cast(bf16x8, w2), __builtin_bit_cast(bf16x8, w3));
    else { asm volatile("" :: "v"(w0), "v"(w1), "v"(w2), "v"(w3)); }
}
__device__ __forceinline__ void accum_branch(const Ctx& c, f32x16* oacc, const f32x16* o, float fac) {
    volatile __attribute__((address_space(3))) float* wsf = (volatile __attribute__((address_space(3))) float*)(c.shm + L_WS + c.w * 512);
    NSA_LWAIT(); if (c.hi == 0) wsf[64 + c.r32] = fac; NSA_LWAIT();
#pragma unroll
    for (int r = 0; r < 16; ++r) { const float f = wsf[64 + crow(r, c.hi)]; oacc[0][r] += o[0][r] * f; oacc[1][r] += o[1][r] * f; }
    NSA_LWAIT();
}
template <int ABL> __device__ __forceinline__ void nsa_unit(const P& p, char* smem, int b, int g, int jq) {
    const int tid = TIDX(); Ctx c; c.lane = tid & 63; c.w = __builtin_amdgcn_readfirstlane(tid >> 6); c.r32 = c.lane & 31; c.hi = c.lane >> 5;
    c.shm = (lptr)smem; c.lds0 = (unsigned)(size_t)c.shm;
    const int hh = c.r32 >> 3, tokl = 8 * c.w + (c.r32 & 7), stok = 64 * jq + tokl, h = g * 4 + hh; const size_t t = (size_t)b * S + stok;
    const size_t seg = kvseg(p), ho = (size_t)(b * 2 + g) * S * 64;
    bf16x8 qr[4];
#pragma unroll
    for (int d0 = 0; d0 < 4; ++d0) { const u32x4 raw = *(const u32x4*)(p.q + t * 512 + h * 64 + d0 * 16 + c.hi * 8); u32x4 sc;
#pragma unroll
        for (int e4 = 0; e4 < 4; ++e4) sc[e4] = cvtpk(__uint_as_float(raw[e4] << 16) * LOG2E, __uint_as_float(raw[e4] & 0xffff0000u) * LOG2E);
        qr[d0] = __builtin_bit_cast(bf16x8, sc); }
    const float g0 = p.gates[t * 24 + h * 3], g1 = p.gates[t * 24 + h * 3 + 1], g2 = p.gates[t * 24 + h * 3 + 2];
    f32x16 oacc[2], o[2], p0, p1; oacc[0] = f32x16{}; oacc[1] = f32x16{};
    __attribute__((address_space(3))) float* impD = (__attribute__((address_space(3))) float*)(c.shm + L_IMPD);
    __attribute__((address_space(3))) float* impC = (__attribute__((address_space(3))) float*)(c.shm + L_IMPC);
    __attribute__((address_space(3))) u64* selm = (__attribute__((address_space(3))) u64*)(c.shm + L_SEL);
    const int nv = stok >= 31 ? (stok - 31) / 16 + 1 : 0;
    const int nct = (4 * jq + 3 + 63) >> 6;
    c.kt = p.kcmp + (size_t)(b * 2 + g) * 256 * 64; c.vt = p.vcmp + (size_t)(b * 2 + g) * 256 * 64;
    float m = M0, l = 0.f;
    if (tid < 64) impC[tid * 68] = 0.f;
    ring_begin(c, 0, nct > 1 ? 1 : -1);
    for (int ct = 0; ct < ((ABL & 64) ? 0 : nct); ++ct) {
        ring_step(c, ct + 2 < nct ? ct + 2 : -1, ct);
        qkt(p0, p1, (lcptr)(c.shm + L_K + c.rs * SLOT), qr, c.r32, c.hi); ring_next(c);
#pragma unroll
        for (int r = 0; r < 16; ++r) { const int n = 64 * ct + crow(r, c.hi); p0[r] = n < nv ? p0[r] : NEGM; p1[r] = n + 32 < nv ? p1[r] : NEGM; }
        const float rm = rowmax32(p0, p1); const float mn = fmaxf(m, rm); float sacc = 0.f;
#pragma unroll
        for (int r = 0; r < 16; ++r) sacc += __builtin_amdgcn_exp2f(p0[r] - mn) + __builtin_amdgcn_exp2f(p1[r] - mn);
        l = l * __builtin_amdgcn_exp2f(m - mn) + sacc; m = mn;
    }
    l = xhalf_sum(l); const float il = l > 0.f ? 1.f / l : 0.f;
    o[0] = f32x16{}; o[1] = f32x16{};
    ring_begin(c, 0, nct > 1 ? 1 : -1);
    for (int ct = 0; ct < ((ABL & 64) ? 0 : nct); ++ct) {
        ring_step(c, ct + 2 < nct ? ct + 2 : -1, ct);
        qkt(p0, p1, (lcptr)(c.shm + L_K + c.rs * SLOT), qr, c.r32, c.hi);
#pragma unroll
        for (int r = 0; r < 16; ++r) { const int n = 64 * ct + crow(r, c.hi); p0[r] = n < nv ? __builtin_amdgcn_exp2f(p0[r] - m) * il : 0.f; p1[r] = n + 32 < nv ? __builtin_amdgcn_exp2f(p1[r] - m) * il : 0.f; }
#pragma unroll
        for (int hb = 0; hb < 2; ++hb)
#pragma unroll
            for (int rg = 0; rg < 4; ++rg) {
                const f32x16& pp = hb ? p1 : p0;
                float dsum = pp[4 * rg] + pp[4 * rg + 1] + pp[4 * rg + 2] + 0.5f * pp[4 * rg + 3], csum = 0.5f * pp[4 * rg + 3];
                dsum += __shfl_xor(dsum, 8); dsum += __shfl_xor(dsum, 16); csum += __shfl_xor(csum, 8); csum += __shfl_xor(csum, 16);
                const int j = 16 * ct + 8 * hb + 2 * rg + c.hi;
                if (c.r32 < 8) { impD[tokl * 64 + j] = dsum; impC[tokl * 68 + j + 1] = csum; }
            }
        u32x4 w0, w1, w2, w3;
        w0 = (u32x4){cvtpk(p0[0], p0[1]), cvtpk(p0[2], p0[3]), cvtpk(p0[4], p0[5]), cvtpk(p0[6], p0[7])};
        w1 = (u32x4){cvtpk(p0[8], p0[9]), cvtpk(p0[10], p0[11]), cvtpk(p0[12], p0[13]), cvtpk(p0[14], p0[15])};
        w2 = (u32x4){cvtpk(p1[0], p1[1]), cvtpk(p1[2], p1[3]), cvtpk(p1[4], p1[5]), cvtpk(p1[6], p1[7])};
        w3 = (u32x4){cvtpk(p1[8], p1[9]), cvtpk(p1[10], p1[11]), cvtpk(p1[12], p1[13]), cvtpk(p1[14], p1[15])};
        const int vb = (int)(c.lds0 + L_V + c.rs * SLOT) + ((c.lane >> 4) & 1) * 32 + (c.lane & 3) * 8 + (4 * c.hi + ((c.lane & 15) >> 2)) * 64;
        pv(o, vb, __builtin_bit_cast(bf16x8, w0), __builtin_bit_cast(bf16x8, w1), __builtin_bit_cast(bf16x8, w2), __builtin_bit_cast(bf16x8, w3));
        ring_next(c);
    }
    accum_branch(c, oacc, o, g0);
    NSA_LWAIT(); __builtin_amdgcn_s_barrier();
    {
#pragma unroll 1
        for (int tkk = 0; tkk < 8; ++tkk) { const int tk = 8 * c.w + tkk, j = c.lane; const bool valid = j <= jq;
            const float sc = (j == 0 || j == jq || j == jq - 1) ? 1e4f : impD[tk * 64 + j] + impC[tk * 68 + j];
            const unsigned key = valid ? ((__float_as_uint(sc) & ~63u) | (unsigned)(63 - j)) : 0u;
            int rank = 0;
            if (!(ABL & 32)) {
#pragma unroll
                for (int i = 0; i < 64; ++i) { const unsigned ki = (unsigned)__builtin_amdgcn_readlane((int)key, i); rank += (ki > key) ? 1 : 0; } }
            const u64 mk = __ballot(valid && rank < 16);
            if (j == 0) { selm[tk] = mk; p.sel[((size_t)b * S + 64 * jq + tk) * 2 + g] = mk; } }
    }
    NSA_LWAIT(); __builtin_amdgcn_s_barrier();
    const u64 mysel = selm[tokl];
    u64 uni = selm[c.lane];
#pragma unroll
    for (int x = 1; x < 64; x <<= 1) { const unsigned lo_ = __shfl_xor((unsigned)uni, x), hi_ = __shfl_xor((unsigned)(uni >> 32), x); uni |= (u64)lo_ | ((u64)hi_ << 32); }
    const unsigned ulo = __builtin_amdgcn_readfirstlane((unsigned)uni), uhi = __builtin_amdgcn_readfirstlane((unsigned)(uni >> 32));
    {
        c.kt = p.kv6 + 2 * seg + ho; c.vt = p.kv6 + 3 * seg + ho;
        u64 rem = (u64)ulo | ((u64)uhi << 32);
        m = M0; l = 0.f; o[0] = f32x16{}; o[1] = f32x16{};
        int j = __builtin_ctzll(rem); rem &= rem - 1;
        int j1 = rem ? __builtin_ctzll(rem) : -1; if (rem) rem &= rem - 1;
        ring_begin<ABL>(c, j, j1);
        for (;;) {
            const int j2 = rem ? __builtin_ctzll(rem) : -1; if (rem) rem &= rem - 1;
            ring_step<ABL>(c, j2, j);
            if (!(ABL & 4)) qkt(p0, p1, (lcptr)(c.shm + L_K + c.rs * SLOT), qr, c.r32, c.hi); else { asm volatile("" : "+v"(p0), "+v"(p1)); }
            const bool on = (mysel >> j) & 1ull;
            if (j == jq) {
#pragma unroll
                for (int r = 0; r < 16; ++r) { const int kr = crow(r, c.hi); p0[r] = (kr <= tokl) ? p0[r] : NEGM; p1[r] = (kr + 32 <= tokl) ? p1[r] : NEGM; } }
            softmax_pv<ABL>(c, p0, p1, o, m, l, c.rs, on); ring_next(c);
            if (j1 < 0) break; j = j1; j1 = j2;
        }
        l = xhalf_sum(l);
        accum_branch(c, oacc, o, g1 / l);
    }
    {
        c.kt = p.kv6 + 4 * seg + ho; c.vt = p.kv6 + 5 * seg + ho;
        const int j0 = jq >= 8 ? jq - 8 : 0;
        m = M0; l = 0.f; o[0] = f32x16{}; o[1] = f32x16{};
        ring_begin<ABL>(c, j0, j0 + 1 <= jq ? j0 + 1 : -1);
        for (int j = j0; j <= jq; ++j) {
            ring_step<ABL>(c, j + 2 <= jq ? j + 2 : -1, j);
            if (!(ABL & 4)) qkt(p0, p1, (lcptr)(c.shm + L_K + c.rs * SLOT), qr, c.r32, c.hi); else { asm volatile("" : "+v"(p0), "+v"(p1)); }
            const bool lowt = (jq >= 8 && j == jq - 8), diag = (j == jq);
            if (diag || lowt) {
#pragma unroll
                for (int r = 0; r < 16; ++r) { const int kr = crow(r, c.hi);
                    const bool v0 = diag ? (kr <= tokl) : (kr > tokl), v1 = diag ? (kr + 32 <= tokl) : (kr + 32 > tokl);
                    p0[r] = v0 ? p0[r] : NEGM; p1[r] = v1 ? p1[r] : NEGM; } }
            softmax_pv<ABL>(c, p0, p1, o, m, l, c.rs, true); ring_next(c);
        }
        l = xhalf_sum(l);
        accum_branch(c, oacc, o, g2 / l);
    }
    {
        __attribute__((address_space(3))) bf16* stg = (__attribute__((address_space(3))) bf16*)(c.shm + L_OST + c.w * 4096);
#pragma unroll
        for (int r = 0; r < 16; ++r) { const int orow = crow(r, c.hi);
#pragma unroll
            for (int d0 = 0; d0 < 2; ++d0) stg[orow * 64 + d0 * 32 + c.r32] = f2bf(oacc[d0][r]); }
        NSA_LWAIT();
#pragma unroll
        for (int i = 0; i < 4; ++i) { const int row = i * 8 + (c.lane >> 3), ch = c.lane & 7; const u32x4 v = *(const __attribute__((address_space(3))) u32x4*)(stg + row * 64 + ch * 8);
            const int rh = row >> 3, rt = 8 * c.w + (row & 7);
            *(u32x4*)(p.onsa + ((size_t)b * S + 64 * jq + rt) * 512 + (g * 4 + rh) * 64 + ch * 8) = v; }
    }
    NSA_DRAIN_BAR();
}
}
template <int ABL = 0> __device__ __forceinline__ void phase_nsa(const P& p, char* smem) {
    const int nunits = p.nb * 2 * 64;
    const int G = gridDim.x; int r = 0;
    for (int base = 0; base < nunits; base += G, ++r) {
        const int w = (r & 1) ? G - 1 - (int)blockIdx.x : (int)blockIdx.x, i = base + w; if (i >= nunits) continue;
        const int jq = 63 - i / (p.nb * 2), bg = i % (p.nb * 2); nsa::nsa_unit<ABL>(p, smem, bg >> 1, bg & 1, jq); }
}

namespace gla {
using nsa::f32x16; using nsa::bf16x8; using nsa::s16x4; using nsa::u32x4; using nsa::lptr; using nsa::lcptr; using nsa::crow; using nsa::cvtpk;
typedef unsigned u32x2 __attribute__((ext_vector_type(2)));
constexpr int L_KI = 0, L_QI = 8192, L_VI = 16384, L_SI = 32768, L_OST = 49152, L_TOT = L_OST + 64 * 132 * 4, L_END = L_TOT + 8 * 64 * 4 + 64 * 4;
__device__ __forceinline__ int koff(int row, int d) { return (d >> 3) * 1024 + row * 16 + (d & 7) * 2; }
__device__ __forceinline__ int voff(int row, int col) { return ((col >> 5) * 4 + (row >> 4)) * 1024 + (row & 15) * 64 + (col & 31) * 2; }
__device__ __forceinline__ bf16x8 trfrag(unsigned img, int ks, int cb, int lane) {
    const int hi = lane >> 5; const unsigned a = img + (cb * 4 + ks) * 1024 + ((lane >> 4) & 1) * 32 + (lane & 3) * 8 + (4 * hi + ((lane & 15) >> 2)) * 64;
    s16x4 lo, hh;
    asm volatile("ds_read_b64_tr_b16 %0,%1" : "=&v"(lo) : "v"(a) : "memory");
    asm volatile("ds_read_b64_tr_b16 %0,%1 offset:512" : "=&v"(hh) : "v"(a) : "memory");
    asm volatile("s_waitcnt lgkmcnt(0)" ::: "memory"); __builtin_amdgcn_sched_barrier(0);
    return (bf16x8){lo[0], lo[1], lo[2], lo[3], hh[0], hh[1], hh[2], hh[3]};
}
template <int GM> __device__ __forceinline__ void chunk_images(const P& p, lptr shm, int b, int h, int c, int tid) {
    const int d = tid & 63, tg = tid >> 6; const size_t t0 = (size_t)b * S + c * 64;
    __attribute__((address_space(3))) float* tot = (__attribute__((address_space(3))) float*)(shm + L_TOT);
    float wa[16];
#pragma unroll
    for (int r = 0; r < 16; ++r) wa[r] = p.w_a2[r * 256 + h * 64 + d];
    const float ba = p.b_a[h * 64 + d];
    float loc[8]; float run = 0.f;
#pragma unroll
    for (int i = 0; i < 8; ++i) { const float* al = p.alow + (t0 + tg * 8 + i) * 16; float z = ba;
#pragma unroll
        for (int r = 0; r < 16; ++r) z += al[r] * wa[r];
        const float ls = fminf(z, 0.f) - log1pf(__expf(-fabsf(z))); run += ls * (1.f / 16.f); loc[i] = run; }
    tot[tg * 64 + d] = run;
#pragma unroll
    for (int k = 0; k < 2; ++k) { const int idx = tid + k * 512, s = idx >> 4, e = (idx & 15) * 8; *(__attribute__((address_space(3))) u32x4*)(shm + L_VI + voff(s, e)) = *(const u32x4*)(p.gv + (t0 + s) * 512 + h * 128 + e); }
    __syncthreads();
    float pre = 0.f, all = 0.f;
#pragma unroll
    for (int g = 0; g < 8; ++g) { const float x = tot[g * 64 + d]; all += x; pre += g < tg ? x : 0.f; }
#pragma unroll
    for (int i = 0; i < 8; ++i) { const int t = tg * 8 + i; const float bb = pre + loc[i]; const float kk = bf2f(p.gk[(t0 + t) * 256 + h * 64 + d]);
        if (GM == 0) { *(__attribute__((address_space(3))) bf16*)(shm + L_KI + voff(t, d)) = f2bf(kk * __expf(all - bb)); }
        else { const float qq = bf2f(p.gq[(t0 + t) * 256 + h * 64 + d]);
            *(__attribute__((address_space(3))) bf16*)(shm + L_KI + koff(t, d)) = f2bf(kk * __expf(-bb)); *(__attribute__((address_space(3))) bf16*)(shm + L_QI + koff(t, d)) = f2bf(qq * __expf(bb)); } }
    if (GM == 0 && tg == 0) p.gdec[((size_t)(b * 4 + h) * 64 + c) * 64 + d] = __expf(all);
    __syncthreads();
}
__device__ __forceinline__ void g1_chunk(const P& p, char* smem, int b, int h, int c) {
    const int tid = TIDX(), lane = tid & 63, w = __builtin_amdgcn_readfirstlane(tid >> 6), r32 = lane & 31, hi = lane >> 5;
    lptr shm = (lptr)smem; const unsigned l0 = (unsigned)(size_t)shm;
    chunk_images<0>(p, shm, b, h, c, tid);
    const int db = w & 1, eb = w >> 1; f32x16 acc = f32x16{};
#pragma unroll
    for (int ks = 0; ks < 4; ++ks) { const bf16x8 a = trfrag(l0 + L_KI, ks, db, lane), bq = trfrag(l0 + L_VI, ks, eb, lane); acc = __builtin_amdgcn_mfma_f32_32x32x16_bf16(a, bq, acc, 0, 0, 0); }
    float* U = p.gst + ((size_t)(b * 4 + h) * 64 + c) * (64 * 128);
#pragma unroll
    for (int r = 0; r < 16; ++r) U[(32 * db + crow(r, hi)) * 128 + 32 * eb + r32] = acc[r];
    __syncthreads();
}
__device__ __forceinline__ void g3_chunk(const P& p, char* smem, int b, int h, int c) {
    const int tid = TIDX(), lane = tid & 63, w = __builtin_amdgcn_readfirstlane(tid >> 6), r32 = lane & 31, hi = lane >> 5;
    lptr shm = (lptr)smem; const unsigned l0 = (unsigned)(size_t)shm; const size_t t0 = (size_t)b * S + c * 64;
    const float* St = p.gst + ((size_t)(b * 4 + h) * 64 + c) * (64 * 128);
    float4 sv[4];
#pragma unroll
    for (int k = 0; k < 4; ++k) sv[k] = *(const float4*)(St + (size_t)(tid + k * 512) * 4);
    chunk_images<1>(p, shm, b, h, c, tid);
#pragma unroll
    for (int k = 0; k < 4; ++k) { const int idx = (tid + k * 512) * 4, dd = idx >> 7, e = idx & 127; u32x2 o; o.x = cvtpk(sv[k].x, sv[k].y); o.y = cvtpk(sv[k].z, sv[k].w);
        *(__attribute__((address_space(3))) u32x2*)(shm + L_SI + voff(dd, e)) = o; }
    __syncthreads();
    const int tb = w & 1, eb = w >> 1, trow = 32 * tb + r32;
    f32x16 p0 = f32x16{}, p1 = f32x16{}, o = f32x16{};
    {
        lcptr kb = (lcptr)(shm + L_KI) + hi * 1024 + r32 * 16; lcptr qb = (lcptr)(shm + L_QI) + hi * 1024 + trow * 16;
#pragma unroll
        for (int d0 = 0; d0 < 4; ++d0) {
            const bf16x8 b0 = *(const __attribute__((address_space(3))) bf16x8*)(kb + d0 * 2048), b1 = *(const __attribute__((address_space(3))) bf16x8*)(kb + d0 * 2048 + 512);
            const bf16x8 qf = *(const __attribute__((address_space(3))) bf16x8*)(qb + d0 * 2048);
            p0 = __builtin_amdgcn_mfma_f32_32x32x16_bf16(b0, qf, p0, 0, 0, 0); p1 = __builtin_amdgcn_mfma_f32_32x32x16_bf16(b1, qf, p1, 0, 0, 0); }
    }
#pragma unroll
    for (int r = 0; r < 16; ++r) { const int s = crow(r, hi); p0[r] = s <= trow ? p0[r] : 0.f; p1[r] = s + 32 <= trow ? p1[r] : 0.f; }
#pragma unroll
    for (int ds = 0; ds < 4; ++ds) {
        const u32x2 a0 = *(const __attribute__((address_space(3))) u32x2*)(shm + L_QI + (2 * ds) * 1024 + trow * 16 + 8 * hi), a1 = *(const __attribute__((address_space(3))) u32x2*)(shm + L_QI + (2 * ds + 1) * 1024 + trow * 16 + 8 * hi);
        const u32x4 aw = {a0.x, a0.y, a1.x, a1.y};
        const bf16x8 bq = trfrag(l0 + L_SI, ds, eb, lane);
        o = __builtin_amdgcn_mfma_f32_32x32x16_bf16(__builtin_bit_cast(bf16x8, aw), bq, o, 0, 0, 0); }
    {
        const u32x4 w0 = {cvtpk(p0[0], p0[1]), cvtpk(p0[2], p0[3]), cvtpk(p0[4], p0[5]), cvtpk(p0[6], p0[7])}, w1 = {cvtpk(p0[8], p0[9]), cvtpk(p0[10], p0[11]), cvtpk(p0[12], p0[13]), cvtpk(p0[14], p0[15])};
        const u32x4 w2 = {cvtpk(p1[0], p1[1]), cvtpk(p1[2], p1[3]), cvtpk(p1[4], p1[5]), cvtpk(p1[6], p1[7])}, w3 = {cvtpk(p1[8], p1[9]), cvtpk(p1[10], p1[11]), cvtpk(p1[12], p1[13]), cvtpk(p1[14], p1[15])};
        o = __builtin_amdgcn_mfma_f32_32x32x16_bf16(__builtin_bit_cast(bf16x8, w0), trfrag(l0 + L_VI, 0, eb, lane), o, 0, 0, 0);
        o = __builtin_amdgcn_mfma_f32_32x32x16_bf16(__builtin_bit_cast(bf16x8, w1), trfrag(l0 + L_VI, 1, eb, lane), o, 0, 0, 0);
        o = __builtin_amdgcn_mfma_f32_32x32x16_bf16(__builtin_bit_cast(bf16x8, w2), trfrag(l0 + L_VI, 2, eb, lane), o, 0, 0, 0);
        o = __builtin_amdgcn_mfma_f32_32x32x16_bf16(__builtin_bit_cast(bf16x8, w3), trfrag(l0 + L_VI, 3, eb, lane), o, 0, 0, 0);
    }
    __attribute__((address_space(3))) float* ost = (__attribute__((address_space(3))) float*)(shm + L_OST);
#pragma unroll
    for (int r = 0; r < 16; ++r) ost[(32 * tb + crow(r, hi)) * 132 + 32 * eb + r32] = o[r];
    __syncthreads();
    { const int t = tid >> 3, part = tid & 7; float v[16]; float ss = 0.f;
#pragma unroll
        for (int k = 0; k < 4; ++k) { const f32x4_t x = *(const __attribute__((address_space(3))) f32x4_t*)(ost + t * 132 + part * 16 + k * 4); v[4 * k] = x[0]; v[4 * k + 1] = x[1]; v[4 * k + 2] = x[2]; v[4 * k + 3] = x[3]; ss += x[0] * x[0] + x[1] * x[1] + x[2] * x[2] + x[3] * x[3]; }
        ss += __shfl_xor(ss, 1); ss += __shfl_xor(ss, 2); ss += __shfl_xor(ss, 4);
        const float rstd = rsqrtf(ss * (1.f / 128.f) + 1e-6f);
        const size_t go = (t0 + t) * 512 + h * 128 + part * 16;
        const uint4 r0 = *(const uint4*)(p.rs + go), r1 = *(const uint4*)(p.rs + go + 8); const unsigned rw[8] = {r0.x, r0.y, r0.z, r0.w, r1.x, r1.y, r1.z, r1.w};
        unsigned ow[8];
#pragma unroll
        for (int k = 0; k < 8; ++k) { const float ga = p.norm_g[h * 128 + part * 16 + 2 * k], gb = p.norm_g[h * 128 + part * 16 + 2 * k + 1];
            ow[k] = pk2(v[2 * k] * rstd * ga * __uint_as_float(rw[k] << 16), v[2 * k + 1] * rstd * gb * __uint_as_float(rw[k] & 0xffff0000u)); }
        *(uint4*)(p.gla + go) = make_uint4(ow[0], ow[1], ow[2], ow[3]); *(uint4*)(p.gla + go + 8) = make_uint4(ow[4], ow[5], ow[6], ow[7]); }
    __syncthreads();
}
}
__device__ __forceinline__ void phase_gla1(const P& p, char* smem) {
    const int n = p.nb * 4 * 64;
    for (int i = blockIdx.x; i < n; i += gridDim.x) gla::g1_chunk(p, smem, i >> 8, (i >> 6) & 3, i & 63);
}
__device__ __forceinline__ void phase_gla2(const P& p) {
    const int n = p.nb * 4 * 8192;
    for (int idx = blockIdx.x * NT + TIDX(); idx < n; idx += gridDim.x * NT) {
        const int bh = idx >> 13, de = idx & 8191, d = de >> 7; float* U = p.gst + (size_t)bh * 64 * 8192 + de; const float* gd = p.gdec + (size_t)bh * 64 * 64 + d;
        float s = 0.f;
        for (int c0 = 0; c0 < 64; c0 += 8) { float tmp[8], g[8];
#pragma unroll
            for (int k = 0; k < 8; ++k) { tmp[k] = U[(size_t)(c0 + k) * 8192]; g[k] = gd[(c0 + k) * 64]; }
#pragma unroll
            for (int k = 0; k < 8; ++k) { U[(size_t)(c0 + k) * 8192] = s; s = g[k] * s + tmp[k]; } }
    }
}
__device__ __forceinline__ void phase_gla3(const P& p, char* smem) {
    const int n = p.nb * 4 * 64;
    for (int i = blockIdx.x; i < n; i += gridDim.x) gla::g3_chunk(p, smem, i >> 8, (i >> 6) & 3, i & 63);
}

struct CmpSched {
    const char* kc; const char* Wc1; float* Pc; int nM, G, c; size_t aseg, pseg;
    __device__ __forceinline__ bool next(int i, pg8::Unit& u) const {
        const int L = i * G + c, per = nM * 2 * 2; if (L >= 2 * per) return false;
        const int kv = L / per, r = L % per, ks = r & 1, pn = (r >> 1) & 1, pm = r >> 2;
        u.pm = pm; u.pn = pn; u.tag = kv * 2 + ks;
        u.A = kc + (size_t)kv * aseg + (size_t)pm * 256 * 1024 * 2 + ks * 512 * 2; u.B = Wc1 + ((size_t)kv * 512 + pn * 256) * 1024 * 2 + ks * 512 * 2; return true;
    }
    __device__ __forceinline__ unsigned arow(const pg8::Unit&, int r) const { return (unsigned)r * 2048u; }
};
struct EpiCmp {
    static constexpr bool PERM = false;
    float* Pc; size_t pseg;
    __device__ __forceinline__ void operator()(const pg8::f32x4 (&acc)[2][2][4][2], const pg8::Unit& u, int wr, int wc, int fr, int fq) const {
        float* base = Pc + (size_t)u.tag * pseg; const int col0 = u.pn * 256 + wc * 32 + 4 * fq;
#pragma unroll
        for (int ai = 0; ai < 2; ++ai)
#pragma unroll
            for (int m = 0; m < 4; ++m) { float* rowp = base + (size_t)(u.pm * 256 + ai * 128 + wr * 64 + m * 16 + fr) * 512 + col0;
#pragma unroll
                for (int bj = 0; bj < 2; ++bj)
#pragma unroll
                    for (int n = 0; n < 2; ++n) *(pg8::f32x4*)(rowp + bj * 128 + n * 16) = acc[ai][bj][m][n]; }
    }
};
__device__ __forceinline__ void phase_cmp1(const P& p, char* smem) {
    const int nrows = p.nb * 2 * 256;
    CmpSched Sc{(const char*)p.kv6, (const char*)p.Wc1, p.pcmp, nrows / 256, (int)gridDim.x, (int)blockIdx.x, kvseg(p) * 2, (size_t)(nrows + 8) * 512};
    EpiCmp E{p.pcmp, (size_t)(nrows + 8) * 512};
    pg8::gemm_phase<EpiCmp, CmpSched, true, false>((PG8_LAS unsigned char*)smem, 512, 1024, 1024, Sc, E);
}
__device__ __forceinline__ void body_cmp2f(const P& p, int vb, char* smem) {
    const int tid = TIDX(); const int nrows = p.nb * 2 * 256, nvb1 = nrows / 16; const int kv = vb / nvb1, row0 = (vb % nvb1) * 16;
    const size_t pseg = (size_t)(nrows + 8) * 512; const float* P0 = p.pcmp + (size_t)(kv * 2) * pseg; const float* P1 = P0 + pseg;
    float* hs = (float*)smem;
    float* w2s = (float*)smem + 16 * 256;
    __syncthreads();
    { const float4* wsrc = (const float4*)(kv ? p.cw2_v : p.cw2_k);
#pragma unroll
      for (int k = 0; k < 8; ++k) ((float4*)w2s)[tid + k * 512] = wsrc[tid + k * 512]; }
#pragma unroll
    for (int k = 0; k < 8; ++k) { const int idx = tid + k * 512, rr = idx >> 8, n = idx & 255; const size_t m = (size_t)(row0 + rr);
        const float z = P0[m * 512 + n] + P1[m * 512 + n] + P0[(m + 1) * 512 + 256 + n] + P1[(m + 1) * 512 + 256 + n] + p.b1p[kv * 256 + n];
        hs[idx] = geluf_(z); }
    __syncthreads();
    const int rr = tid >> 5, i = tid & 31, row = row0 + rr;
    const float* h = hs + rr * 256; const float* b2 = kv ? p.cb2_v : p.cb2_k;
    float z1 = b2[i], z2 = b2[i + 32];
#pragma unroll 8
    for (int n = 0; n < 256; ++n) { const float hv = h[n]; z1 += hv * w2s[n * 64 + i]; z2 += hv * w2s[n * 64 + i + 32]; }
    bf16* dst = (kv ? p.vcmp : p.kcmp) + (size_t)row * 64;
    if (kv == 0) {
        const int bg = row >> 8, m = row & 255, b = bg >> 1; int sp = 16 * m + 31; if (sp > S - 1) sp = S - 1;
        const size_t t = (size_t)b * S + sp; const float c = p.cs[t * 64 + i], sn = p.cs[t * 64 + 32 + i];
        const float r1 = z1 * c - z2 * sn, r2 = z2 * c + z1 * sn; z1 = r1; z2 = r2;
    }
    dst[i] = f2bf(z1); dst[i + 32] = f2bf(z2);
}
__device__ __forceinline__ void phase_cmp2(const P& p, char* smem) {
    const int n = 2 * (p.nb * 2 * 256) / 16;
    for (int vb = blockIdx.x; vb < n; vb += gridDim.x) body_cmp2f(p, vb, smem);
}
__device__ __forceinline__ void prep_b1p(const P& p, char* smem) {
    if (blockIdx.x >= 2) return;
    const int tid = TIDX(), kv = blockIdx.x, n = tid & 255, half = tid >> 8;
    const float* pe = kv ? p.cpos_v : p.cpos_k; const float* w1 = kv ? p.cw1_v : p.cw1_k; const float* b1 = kv ? p.cb1_v : p.cb1_k;
    float a = 0.f;
    for (int f = half * 1024; f < half * 1024 + 1024; ++f) a += pe[f] * w1[(size_t)f * 256 + n];
    float* sc = (float*)(smem + LDS_MISC);
    __syncthreads();
    if (half == 1) sc[n] = a;
    __syncthreads();
    if (half == 0) p.b1p[kv * 256 + n] = a + sc[n] + b1[n];
    __syncthreads();
}

#define XB_TMO      128
#define XB_XCNT(j)  (256  + 64 * (j))
#define XB_XSUB(j)  (1280 + 64 * (j))
#define XB_XGEN(j)  (2304 + 64 * (j))
#define XB_TOP      3328
#define XB_TOPGEN   3392
#define XCD_BAR_WORDS 3456
#define XB_SPIN_CAP (1u << 18)
#define XLAS __attribute__((address_space(3)))
__device__ __forceinline__ unsigned xb_ld(unsigned* p)              { return __hip_atomic_load(p, __ATOMIC_RELAXED, __HIP_MEMORY_SCOPE_AGENT); }
__device__ __forceinline__ unsigned xb_add(unsigned* p, unsigned v) { return __hip_atomic_fetch_add(p, v, __ATOMIC_RELAXED, __HIP_MEMORY_SCOPE_AGENT); }
__device__ __forceinline__ unsigned xb_xcc_id() { return (unsigned)__builtin_amdgcn_s_getreg((3 << 11) | 20) & 0xFu; }
#define XB_SPIN(cond, bar) do { unsigned _sp = 0; while (cond) { __builtin_amdgcn_s_sleep(1); \
    if ((++_sp & 255u) == 0u) { if (xb_ld(&(bar)[XB_TMO])) break; if (_sp > XB_SPIN_CAP) { atomicAdd(&(bar)[XB_TMO], 1u); break; } } } } while (0)
struct XcdBarrier { unsigned* bar; unsigned x; volatile XLAS unsigned* st; };
__device__ __forceinline__ XcdBarrier xcd_barrier_post(unsigned* bar, volatile XLAS unsigned* st) {
    XcdBarrier b; b.bar = bar; b.x = xb_xcc_id(); b.st = st;
    if (TIDX() == 0) (void)xb_add(&bar[XB_XCNT(b.x)], 1u);
    return b;
}
__device__ __forceinline__ void xcd_barrier_complete(unsigned* bar, unsigned x, unsigned& nloc, unsigned& nx) {
    const unsigned G = gridDim.x * gridDim.y * gridDim.z;
    unsigned sum, cnt, mine, sp = 0u;
    for (;;) {
        sum = 0u; cnt = 0u; mine = 0u;
#pragma unroll
        for (unsigned j = 0; j < 16; ++j) { const unsigned c = xb_ld(&bar[XB_XCNT(j)]); sum += c; cnt += (c > 0u) ? 1u : 0u; mine = (j == x) ? c : mine; }
        if (sum == G) break;
        __builtin_amdgcn_s_sleep(1);
        if ((++sp & 255u) == 0u) { if (xb_ld(&bar[XB_TMO])) break; if (sp > XB_SPIN_CAP) { atomicAdd(&bar[XB_TMO], 1u); break; } }
    }
    nloc = mine > 0u ? mine : 1u; nx = cnt > 0u ? cnt : 1u;
}
__device__ __forceinline__ void xcd_barrier(const XcdBarrier& b) {
    asm volatile("s_waitcnt vmcnt(0)" ::: "memory");
    __syncthreads();
    if (TIDX() == 0) {
        unsigned* bar = b.bar;
        __builtin_amdgcn_s_waitcnt(0);
        unsigned nloc = b.st[0], nx = b.st[1];
        if (nloc == 0u) { xcd_barrier_complete(bar, b.x, nloc, nx); b.st[0] = nloc; b.st[1] = nx; }
        const unsigned old = xb_add(&bar[XB_XSUB(b.x)], 1u);
        const unsigned gen = old / nloc;
        if (old + 1u == (gen + 1u) * nloc) {
            __builtin_amdgcn_fence(__ATOMIC_RELEASE, "agent");
            asm volatile("s_waitcnt vmcnt(0)" ::: "memory");
            const unsigned og = xb_add(&bar[XB_TOP], 1u);
            const unsigned tg = og / nx;
            if (og + 1u == (tg + 1u) * nx) xb_add(&bar[XB_TOPGEN], 1u);
            else XB_SPIN(xb_ld(&bar[XB_TOPGEN]) == tg, bar);
            __builtin_amdgcn_fence(__ATOMIC_ACQUIRE, "agent");
            xb_add(&bar[XB_XGEN(b.x)], 1u);
            asm volatile("s_waitcnt vmcnt(0)" ::: "memory");
        } else {
            XB_SPIN(xb_ld(&bar[XB_XGEN(b.x)]) == gen, bar);
            __builtin_amdgcn_fence(__ATOMIC_ACQUIRE, "agent");
            asm volatile("s_waitcnt vmcnt(0)" ::: "memory");
        }
    }
    __syncthreads();
}

template <int ST> __device__ __forceinline__ void run_stage(const P& p, char* smem, int first, int stride) {
    const int nvb = stage_nvb(ST, p.T);
    for (int vb = first; vb < nvb; vb += stride) {
        if constexpr (ST == ST_RMS) body_rms(p, vb);
        else if constexpr (ST == ST_CS) body_cs(p, vb);
        else if constexpr (ST == ST_INPROJ) body_inproj(p, vb, smem);
        else if constexpr (ST == ST_CMP1) body_cmp1(p, vb, smem);
        else if constexpr (ST == ST_CMP2) body_cmp2(p, vb);
        else if constexpr (ST == ST_NSACMP) body_nsacmp(p, vb, smem);
        else if constexpr (ST == ST_NSAATT) body_nsaatt(p, vb);
        else if constexpr (ST == ST_GLAA) body_glaa(p, vb);
        else if constexpr (ST == ST_GLASCAN) body_glascan(p, vb, smem);
        else if constexpr (ST == ST_GLANORM) body_glanorm(p, vb);
        else if constexpr (ST == ST_PROJ) body_proj(p, vb, smem);
        else if constexpr (ST == ST_OUT) body_out(p, vb, smem);
        else if constexpr (ST == ST_ROUTE) body_route(p, vb, smem);
        else if constexpr (ST == ST_MOE1) body_moe1(p, vb, smem);
        else if constexpr (ST == ST_MOE2) body_moe2(p, vb, smem);
        else if constexpr (ST == ST_FINAL) body_final(p, vb, smem);
    }
}
template <int ST> __global__ void __launch_bounds__(NT) k_stage(P p) {
    extern __shared__ __attribute__((aligned(16))) char smem[];
    run_stage<ST>(p, smem, blockIdx.x, gridDim.x);
}
__global__ void __launch_bounds__(NT) k_mega(P p) {
    extern __shared__ __attribute__((aligned(16))) char smem[];
    cg::grid_group grid = cg::this_grid();
    const int b0 = blockIdx.x, G = gridDim.x;
    volatile XLAS unsigned* xst = (volatile XLAS unsigned*)((XLAS char*)smem + LDS_MISC + 3072);
    if (TIDX() < 4) xst[TIDX()] = 0u;
    __syncthreads();
    const XcdBarrier xb = xcd_barrier_post(p.ctl + 4096, xst);
#define GSYNC() xcd_barrier(xb)
#define DUPRUN(k, stmt) do { if (DUP == (k)) { stmt; GSYNC(); } } while (0)
    if (p.T < 0) grid.sync();
    phase_prep(p, smem); GSYNC();
    phase_inA(p, smem); GSYNC();                               DUPRUN(7, phase_inA(p, smem));
    phase_cmp1(p, smem); phase_gla1(p, smem); GSYNC();         DUPRUN(8, phase_cmp1(p, smem)); DUPRUN(4, phase_gla1(p, smem));
    phase_cmp2(p, smem); phase_gla2(p); GSYNC();               DUPRUN(9, phase_cmp2(p, smem));
    if (DUP >= 20 && DUP < 148) { P p2 = p; p2.onsa = (bf16*)p.pcmp; p2.sel = (u64*)((char*)p.pcmp + 16 * MiB_); phase_nsa<(DUP >= 20 && DUP < 148) ? DUP - 20 : 0>(p2, smem); GSYNC(); }
    phase_nsa(p, smem); phase_gla3(p, smem); GSYNC();          DUPRUN(1, phase_nsa(p, smem)); DUPRUN(2, phase_gla3(p, smem));
    phase_inB(p, smem); GSYNC();                               DUPRUN(11, phase_inB(p, smem));
    phase_proj(p, smem); GSYNC();                              DUPRUN(12, phase_proj(p, smem));
    phase_out(p, smem); GSYNC();                               DUPRUN(13, phase_out(p, smem));
    if (DUP == 17) { P p2 = p; p2.ctl = p.ctl + 8192; p2.vb = p.sa; p2.list = (int*)p.mixed; p2.tokslot = (int*)p.mixed + (1 << 20); p2.tokexp = (int*)p.mixed + (2 << 20); p2.tokw = (float*)p.mixed + (3 << 20);
        for (int vb = b0; vb < p.T / 64; vb += G) body_route3(p2, vb, smem);
        GSYNC(); }
    for (int vb = b0; vb < p.T / 64; vb += G) body_route3(p, vb, smem);
    GSYNC();
    phase_moe1(p, smem); GSYNC();                              DUPRUN(6, phase_moe1(p, smem));
    phase_moe2(p, smem); GSYNC();                              DUPRUN(14, phase_moe2(p, smem));
    if (DUP == 15) { GSYNC(); GSYNC(); GSYNC(); GSYNC(); GSYNC(); GSYNC(); GSYNC(); GSYNC(); GSYNC(); GSYNC(); }
    if (DUP == 16) { P p2 = p; p2.out = (float*)p.sb; run_stage<ST_FINAL>(p2, smem, b0, G); GSYNC(); }
    run_stage<ST_FINAL>(p, smem, b0, G);
#undef DUPRUN
#undef GSYNC
}

enum Phase { PH_PREP = 0, PH_INA, PH_INB, PH_PROJ, PH_OUT, PH_MOE1, PH_MOE2, PH_NSA, PH_GLA1, PH_GLA2, PH_GLA3, PH_CMP1, PH_CMP2 };
template <int PH> __global__ void __launch_bounds__(NT) k_phase(P p) {
    extern __shared__ __attribute__((aligned(16))) char smem[];
    if constexpr (PH == PH_PREP) phase_prep(p, smem);
    else if constexpr (PH == PH_INA) phase_inA(p, smem);
    else if constexpr (PH == PH_INB) phase_inB(p, smem);
    else if constexpr (PH == PH_PROJ) phase_proj(p, smem);
    else if constexpr (PH == PH_OUT) phase_out(p, smem);
    else if constexpr (PH == PH_MOE1) phase_moe1(p, smem);
    else if constexpr (PH == PH_MOE2) phase_moe2(p, smem);
    else if constexpr (PH == PH_NSA) phase_nsa(p, smem);
    else if constexpr (PH == PH_GLA1) phase_gla1(p, smem);
    else if constexpr (PH == PH_GLA2) phase_gla2(p);
    else if constexpr (PH == PH_GLA3) phase_gla3(p, smem);
    else if constexpr (PH == PH_CMP1) phase_cmp1(p, smem);
    else if constexpr (PH == PH_CMP2) phase_cmp2(p, smem);
}
template <class TT> __device__ __forceinline__ float ldf(const TT* p, size_t i);
template <> __device__ __forceinline__ float ldf<bf16>(const bf16* p, size_t i) { return bf2f(p[i]); }
template <> __device__ __forceinline__ float ldf<float>(const float* p, size_t i) { return p[i]; }
template <class TT> __global__ void __launch_bounds__(256) k_compare(const TT* a, const TT* b, size_t n, float* err, int slot) {
    float num = 0.f, den = 0.f;
    for (size_t i = (size_t)blockIdx.x * 256 + TIDX(); i < n; i += (size_t)gridDim.x * 256) { const float x = ldf<TT>(a, i), y = ldf<TT>(b, i); const float d = x - y; num += (d == d) ? d * d : 1e30f; den += y * y; }
#pragma unroll
    for (int o = 1; o < 64; o <<= 1) { num += __shfl_xor(num, o); den += __shfl_xor(den, o); }
    if ((TIDX() & 63) == 0) { atomicAdd(err + 2 * slot, num); atomicAdd(err + 2 * slot + 1, den); }
}
__global__ void __launch_bounds__(256) k_compare_sel(const u64* a, const u64* b, size_t n, float* err, int slot) {
    float num = 0.f, den = 0.f;
    for (size_t i = (size_t)blockIdx.x * 256 + threadIdx.x; i < n; i += (size_t)gridDim.x * 256) { num += (a[i] != b[i]) ? 1.f : 0.f; den += 100.f; }
#pragma unroll
    for (int o = 1; o < 64; o <<= 1) { num += __shfl_xor(num, o); den += __shfl_xor(den, o); }
    if ((threadIdx.x & 63) == 0) { atomicAdd(err + 2 * slot, num); atomicAdd(err + 2 * slot + 1, den); }
}
__global__ void __launch_bounds__(256) k_report(float* out, size_t n, const float* err, int nslots, float tol) {
    int code = 0;
    for (int s = 0; s < nslots; ++s) { const float num = err[2 * s], den = err[2 * s + 1]; const bool bad = !(num <= tol * tol * den) || !(den > 0.f); if (bad) { code = s + 1; break; } }
    if (code == 0) return;
    const float f = 1.f + 0.1f * (float)code;
    for (size_t i = (size_t)blockIdx.x * 256 + TIDX(); i < n; i += (size_t)gridDim.x * 256) out[i] *= f;
}

static void set_inputs(P& p, void* const* d_in) {
    const float* const* in = (const float* const*)d_in;
    p.x = in[0]; p.pos = (const int*)d_in[1]; p.g_mix = in[2]; p.w_in = in[3];
    p.cpos_k = in[4]; p.cw1_k = in[5]; p.cb1_k = in[6]; p.cw2_k = in[7]; p.cb2_k = in[8];
    p.cpos_v = in[9]; p.cw1_v = in[10]; p.cb1_v = in[11]; p.cw2_v = in[12]; p.cb2_v = in[13];
    p.w_a2 = in[14]; p.b_a = in[15]; p.norm_g = in[16]; p.w_pn = in[17]; p.w_pg = in[18]; p.w_out = in[19];
    p.g_ffn = in[20]; p.w_grp = in[21]; p.b_grp = in[22]; p.w_exp = in[23]; p.b_exp = in[24]; p.w_gate = in[25]; p.w_up = in[26]; p.w_down = in[27]; p.g_final = in[28];
}
constexpr size_t MiB = 1u << 20;
static void layout_ref(P& p, char* small, char* act, char* scratch, float* out, int nb) {
    const size_t q = (MiB / 4) * nb;
    p.nb = nb; p.T = nb * S; p.out = out;
    p.ctl = (unsigned*)small; p.sel = (u64*)(small + q / 16 * 1); p.kcmp = (bf16*)(small + q / 2); p.vcmp = (bf16*)(small + q / 4 * 3);
    p.tokslot = (int*)(small + q); p.tokexp = (int*)(small + q + q / 8); p.tokw = (float*)(small + q + q / 4);
    p.alow = (float*)(small + 2 * q); p.gates = (float*)(small + 3 * q); p.cs = (float*)(small + 5 * q); p.hcmp = (float*)(small + 9 * q); p.list = (int*)(small + 13 * q);
    p.u = (bf16*)act; p.ocmp = (float*)act; p.mixed = (bf16*)act; p.vb = (bf16*)act;
    p.q = (bf16*)(act + 32 * q); p.kv6 = (bf16*)(act + 48 * q);
    p.gq = (bf16*)(act + 73 * q); p.gk = (bf16*)(act + 81 * q); p.gv = (bf16*)(act + 89 * q); p.rs = (bf16*)(act + 105 * q);
    p.H = (bf16*)(act + 32 * q);
    p.sa = (bf16*)(act + 123 * q); p.sb = (bf16*)(act + 155 * q); p.onsa = (bf16*)(act + 187 * q); p.gla = (bf16*)(act + 203 * q);
    p.Y = (bf16*)(act + 123 * q);
    p.ga = (float*)scratch; p.oraw = (float*)(scratch + 16 * q); p.h1 = (float*)(scratch + 48 * q);
    p.gst = (float*)(scratch + 16 * q); p.gdec = (float*)(small + 15 * q);
}
static void layout_compact(P& p, char* ws, float* out) {
    p.nb = NB; p.T = NB * S; p.out = out;
    char* small = ws; const size_t q = MiB;
    p.ctl = (unsigned*)small; p.sel = (u64*)(small + q / 16 * 1); p.kcmp = (bf16*)(small + q / 2); p.vcmp = (bf16*)(small + q / 4 * 3);
    p.tokslot = (int*)(small + q); p.tokexp = (int*)(small + q + q / 8); p.tokw = (float*)(small + q + q / 4);
    p.alow = (float*)(small + 2 * q); p.gates = (float*)(small + 3 * q); p.cs = (float*)(small + 5 * q); p.hcmp = (float*)(small + 9 * q); p.list = (int*)(small + 13 * q);
    p.u = (bf16*)(ws + 128 * MiB); p.vb = (bf16*)(ws + 128 * MiB);
    p.q = (bf16*)(ws + 160 * MiB); p.kv6 = (bf16*)(ws + 176 * MiB); p.gq = (bf16*)(ws + 201 * MiB); p.gk = (bf16*)(ws + 209 * MiB); p.gv = (bf16*)(ws + 217 * MiB); p.rs = (bf16*)(ws + 233 * MiB);
    p.ga = (float*)(ws + 249 * MiB); p.ocmp = (float*)(ws + 249 * MiB);
    p.sa = (bf16*)(ws + 160 * MiB); p.sb = (bf16*)(ws + 192 * MiB); p.mixed = (bf16*)(ws + 224 * MiB);
    p.H = (bf16*)(ws + 160 * MiB); p.Y = (bf16*)(ws + 48 * MiB);
    p.onsa = (bf16*)out; p.gla = (bf16*)((char*)out + 16 * MiB); p.oraw = (float*)((char*)out + 32 * MiB); p.h1 = out;
    p.gst = (float*)((char*)out + 32 * MiB); p.gdec = (float*)(small + 15 * q); p.pcmp = (float*)(ws + 249 * MiB);
}
static void layout_weights(P& p, char* w) {
    p.wr = (float*)(w - 256 * 1024); p.b1p = (float*)(w - 64 * 1024);
    p.Wd = (bf16*)w; p.Wgu = (bf16*)(w + 32 * MiB); p.Wt_in = (bf16*)(w + 96 * MiB); p.Wc1 = (bf16*)(w + 106 * MiB);
    p.Wpn = (bf16*)(w + 108 * MiB); p.Wpg = (bf16*)(w + 109 * MiB); p.Wo = (bf16*)(w + 110 * MiB);
}

template <int ST> static void launch_stage(const P& p, hipStream_t stream) {
    static bool attr = false;
    if (!attr) { (void)hipFuncSetAttribute((const void*)k_stage<ST>, hipFuncAttributeMaxDynamicSharedMemorySize, LDS_BYTES); attr = true; }
    int nvb = stage_nvb(ST, p.T); if (nvb > 16384) nvb = 16384;
    hipLaunchKernelGGL(k_stage<ST>, dim3(nvb), dim3(NT), LDS_BYTES, stream, p);
}
template <int PH> static void launch_phase(const P& p, hipStream_t stream, int grid = 40) {
    static bool attr = false;
    if (!attr) { (void)hipFuncSetAttribute((const void*)k_phase<PH>, hipFuncAttributeMaxDynamicSharedMemorySize, LDS_BYTES); attr = true; }
    hipLaunchKernelGGL(k_phase<PH>, dim3(grid), dim3(NT), LDS_BYTES, stream, p);
}
template <class TT> static void compare(const TT* a, const TT* b, size_t n, float* err, int slot, hipStream_t stream) {
    hipLaunchKernelGGL(k_compare<TT>, dim3(1024), dim3(256), 0, stream, a, b, n, err, slot);
}
static void launch_mega(const P& p, hipStream_t stream) {
    static int grid = 0;
    if (!grid) {
        int dev = 0, cus = 0, per_cu = 0;
        (void)hipGetDevice(&dev); (void)hipDeviceGetAttribute(&cus, hipDeviceAttributeMultiprocessorCount, dev);
        (void)hipFuncSetAttribute((const void*)k_mega, hipFuncAttributeMaxDynamicSharedMemorySize, LDS_BYTES);
        (void)hipOccupancyMaxActiveBlocksPerMultiprocessor(&per_cu, (const void*)k_mega, NT, LDS_BYTES);
        if (per_cu < 1) per_cu = 1;
        grid = cus * per_cu;
    }
    (void)hipMemsetAsync((void*)p.ctl, 0, 64 * 1024, stream);
    P pp = p; void* args[] = {(void*)&pp};
    (void)hipLaunchCooperativeKernel((const void*)k_mega, dim3(grid), dim3(NT), args, LDS_BYTES, stream);
}

extern "C" void kernel_launch(void* const* d_in, const int* in_sizes, int n_in, void* d_out, int out_size, void* d_ws, size_t ws_size, hipStream_t stream) {
    char* ws = (char*)d_ws;
    P p{}; set_inputs(p, d_in); layout_ref(p, ws, ws + 16 * MiB, (char*)d_out, (float*)d_out, NB); p.h1 = (float*)d_out;
#if MODE == 0
    (void)hipMemsetAsync(d_ws, 0, 4096, stream);
    launch_stage<ST_RMS>(p, stream); launch_stage<ST_CS>(p, stream); launch_stage<ST_INPROJ>(p, stream);
    launch_stage<ST_CMP1>(p, stream); launch_stage<ST_CMP2>(p, stream); launch_stage<ST_NSACMP>(p, stream); launch_stage<ST_NSAATT>(p, stream);
    launch_stage<ST_GLAA>(p, stream); launch_stage<ST_GLASCAN>(p, stream); launch_stage<ST_GLANORM>(p, stream);
    launch_stage<ST_PROJ>(p, stream); launch_stage<ST_OUT>(p, stream); launch_stage<ST_ROUTE>(p, stream);
    launch_stage<ST_MOE1>(p, stream); launch_stage<ST_MOE2>(p, stream); launch_stage<ST_FINAL>(p, stream);
#elif MODE == 1
    { P c{}; set_inputs(c, d_in); layout_weights(c, ws + 16 * MiB); layout_compact(c, ws, (float*)d_out); launch_mega(c, stream); }
#else
    { P c{}; set_inputs(c, d_in); layout_weights(c, ws + 16 * MiB); layout_compact(c, ws, (float*)d_out); launch_mega(c, stream); }
    P r{}; set_inputs(r, d_in); layout_weights(r, ws + 16 * MiB);
    layout_ref(r, ws + 128 * MiB, ws + 132 * MiB, ws + 200 * MiB, (float*)(ws + 200 * MiB + 12 * MiB), 1);
    char* alt = ws + 228 * MiB; float* err = (float*)(ws + 128 * MiB + 8192);
    (void)hipMemsetAsync(ws + 128 * MiB, 0, 16384, stream);
    int slot = 0; const size_t T1 = S; const size_t ROWS1 = 2 * T1 + NEXP * 256;
    launch_stage<ST_RMS>(r, stream); launch_stage<ST_CS>(r, stream); launch_stage<ST_INPROJ>(r, stream);
    P f = r; { char* a = alt;
        f.u = (bf16*)a; a += T1 * 1024 * 2; f.cs = (float*)a; a += T1 * 64 * 4; f.q = (bf16*)a; a += T1 * 512 * 2; f.kv6 = (bf16*)a; a += 6 * (size_t)2 * S * 64 * 2 + 4096;
        f.gates = (float*)a; a += T1 * 24 * 4; f.gq = (bf16*)a; a += T1 * 256 * 2; f.gk = (bf16*)a; a += T1 * 256 * 2; f.gv = (bf16*)a; a += T1 * 512 * 2; f.alow = (float*)a; a += T1 * 16 * 4;
        f.rs = (bf16*)a; a += T1 * 512 * 2; f.sa = (bf16*)a; a += T1 * 1024 * 2; f.sb = (bf16*)a; a += T1 * 1024 * 2; }
    launch_phase<PH_PREP>(f, stream); launch_phase<PH_INA>(f, stream); launch_phase<PH_INB>(f, stream);
    compare<bf16>(f.q, r.q, T1 * 512, err, slot++, stream);
    compare<bf16>(f.kv6, r.kv6, 6 * (size_t)2 * S * 64, err, slot++, stream);
    compare<bf16>(f.sb, r.sb, T1 * 1024, err, slot++, stream);
    launch_stage<ST_CMP1>(r, stream); launch_stage<ST_CMP2>(r, stream);
    f = r; f.pcmp = (float*)alt; f.kcmp = (bf16*)(alt + 20 * MiB); f.vcmp = (bf16*)(alt + 21 * MiB); launch_phase<PH_CMP1>(f, stream); launch_phase<PH_CMP2>(f, stream);
    compare<bf16>(f.kcmp, r.kcmp, (size_t)2 * 255 * 64, err, slot++, stream); compare<bf16>(f.vcmp + 256 * 64, r.vcmp + 256 * 64, (size_t)255 * 64, err, slot++, stream);
    launch_stage<ST_NSACMP>(r, stream); launch_stage<ST_NSAATT>(r, stream);
    f = r; f.onsa = (bf16*)alt; f.sel = (u64*)(alt + 8 * MiB); launch_phase<PH_NSA>(f, stream);
    hipLaunchKernelGGL(k_compare_sel, dim3(64), dim3(256), 0, stream, (const u64*)f.sel, (const u64*)r.sel, T1 * 2, err, slot++);
    compare<bf16>(f.onsa, r.onsa, T1 * 512, err, slot++, stream);
    launch_stage<ST_GLAA>(r, stream); launch_stage<ST_GLASCAN>(r, stream); launch_stage<ST_GLANORM>(r, stream);
    f = r; f.gla = (bf16*)alt; f.gst = (float*)(alt + 8 * MiB); f.gdec = (float*)(alt + 18 * MiB); launch_phase<PH_GLA1>(f, stream); launch_phase<PH_GLA2>(f, stream); launch_phase<PH_GLA3>(f, stream);
    compare<bf16>(f.gla, r.gla, T1 * 512, err, slot++, stream);
    launch_stage<ST_PROJ>(r, stream);
    f = r; f.mixed = (bf16*)alt; launch_phase<PH_PROJ>(f, stream);
    compare<bf16>(f.mixed, r.mixed, T1 * 1024, err, slot++, stream);
    launch_stage<ST_OUT>(r, stream);
    f = r; f.h1 = (float*)alt; launch_phase<PH_OUT>(f, stream);
    compare<float>(f.h1, r.h1, T1 * 1024, err, slot++, stream);
    launch_stage<ST_ROUTE>(r, stream);
    (void)hipMemsetAsync(r.H, 0, ROWS1 * 512 * 2, stream); (void)hipMemsetAsync(alt, 0, ROWS1 * 512 * 2, stream);
    launch_stage<ST_MOE1>(r, stream);
    f = r; f.H = (bf16*)alt; launch_phase<PH_MOE1>(f, stream);
    compare<bf16>(f.H, r.H, ROWS1 * 512, err, slot++, stream);
    (void)hipMemsetAsync(r.Y, 0, ROWS1 * 1024 * 2, stream); (void)hipMemsetAsync(alt + 17 * MiB, 0, ROWS1 * 1024 * 2, stream);
    launch_stage<ST_MOE2>(r, stream);
    f = r; f.Y = (bf16*)(alt + 17 * MiB); launch_phase<PH_MOE2>(f, stream);
    compare<bf16>(f.Y, r.Y, ROWS1 * 1024, err, slot++, stream);
    hipLaunchKernelGGL(k_report, dim3(1024), dim3(256), 0, stream, (float*)d_out, (size_t)NB * S * D, (const float*)err, slot, 0.02f);
#endif
}
```

```cpp
#include <hip/hip_runtime.h>
#include <hip/hip_cooperative_groups.h>
#include <stdint.h>
namespace cg = cooperative_groups;

#ifndef DUP
#define DUP 0
#endif
#ifndef TSEL
#define TSEL -1
#endif
#ifndef MODE
#define MODE 1
#endif

typedef unsigned short bf16;
typedef unsigned long long u64;

__device__ __forceinline__ int TIDX() { int t = threadIdx.x; asm volatile("" : "+v"(t)); return t; }
__device__ __forceinline__ float bf2f(bf16 v) { return __uint_as_float(((unsigned)v) << 16); }
__device__ __forceinline__ bf16 f2bf(float f) { unsigned u = __float_as_uint(f); return (bf16)((u + 0x7fffu + ((u >> 16) & 1u)) >> 16); }
__device__ __forceinline__ float sigmoidf_(float x) { return 1.f / (1.f + __expf(-x)); }
__device__ __forceinline__ float siluf_(float x) { return x / (1.f + __expf(-x)); }
__device__ __forceinline__ float geluf_(float x) { const float u = 0.7978845608028654f * (x + 0.044715f * x * x * x); return 0.5f * x * (1.f + tanhf(u)); }

constexpr int NB = 4, S = 4096, D = 1024;
constexpr int NT = 512;
constexpr int LDS_BYTES = 144 * 1024;
constexpr int LDS_MISC = 136 * 1024;
constexpr int INW = 4904;
constexpr int OFF_Q = 0, OFF_KV = 512, OFF_NG = 1280, OFF_GQ = 1304, OFF_GK = 1560, OFF_GV = 1816, OFF_GA = 2328, OFF_GR = 2344, OFF_MA = 2856, OFF_MB = 3880;
constexpr int NEXP = 32;
constexpr size_t MiB_ = 1u << 20;

struct P {
    const float* x; const int* pos; const float* g_mix; const float* w_in;
    const float *cpos_k, *cw1_k, *cb1_k, *cw2_k, *cb2_k, *cpos_v, *cw1_v, *cb1_v, *cw2_v, *cb2_v;
    const float *w_a2, *b_a, *norm_g, *w_pn, *w_pg, *w_out, *g_ffn, *w_grp, *b_grp, *w_exp, *b_exp, *w_gate, *w_up, *w_down, *g_final;
    float* out;
    unsigned* ctl;
    float* cs;
    bf16* u;
    bf16* q;
    bf16* kv6;
    float* gates;
    bf16 *gq, *gk, *gv;
    float* alow;
    bf16 *rs, *sa, *sb;
    float* hcmp;
    bf16 *kcmp, *vcmp;
    u64* sel;
    float* ocmp;
    bf16* onsa;
    float* ga;
    float* oraw;
    bf16* gla;
    bf16* mixed;
    float* h1;
    bf16* vb;
    int* list;
    int* tokslot;
    int* tokexp;
    float* tokw;
    bf16* H;
    bf16* Y;
    float* gst;
    float* gdec;
    float* pcmp;
    float* b1p;
    float* wr;
    bf16 *Wt_in, *Wc1, *Wpn, *Wpg, *Wo, *Wgu, *Wd;
    int nb, T;
};
__device__ __forceinline__ size_t kvseg(const P& p) { return (size_t)p.nb * 2 * S * 64; }

enum Stage { ST_RMS = 0, ST_CS, ST_INPROJ, ST_CMP1, ST_CMP2, ST_NSACMP, ST_NSAATT, ST_GLAA, ST_GLASCAN, ST_GLANORM, ST_PROJ, ST_OUT, ST_ROUTE, ST_MOE1, ST_MOE2, ST_FINAL, ST_COUNT };

__host__ __device__ inline int stage_nvb(int st, int T) {
    switch (st) {
        case ST_RMS: return T / 8;
        case ST_CS: return T * 32 / NT;
        case ST_INPROJ: return ((INW + NT - 1) / NT) * (T / 8);
        case ST_CMP1: return 2 * (T / S) * 2 * 256 / 8;
        case ST_CMP2: return 2 * (T / S) * 2 * 256 * 32 / NT;
        case ST_NSACMP: return T / 64 * 2 / 8;
        case ST_NSAATT: return T / 64 * 8 / 8;
        case ST_GLAA: return T / 2;
        case ST_GLASCAN: return (T / S) * 4 / 4;
        case ST_GLANORM: return T * 4 / NT;
        case ST_PROJ: return 2 * (T / 8);
        case ST_OUT: return 2 * (T / 8);
        case ST_ROUTE: return T / 8;
        case ST_MOE1: return (2 * T + NEXP * 256) / 8;
        case ST_MOE2: return 2 * ((2 * T + NEXP * 256) / 8);
        case ST_FINAL: return T / 8;
    }
    return 0;
}

__device__ __forceinline__ void body_rms(const P& p, int vb) {
    const int lane = TIDX() & 63, t = vb * 8 + (TIDX() >> 6);
    const float4* xr = (const float4*)(p.x + (size_t)t * D);
    float4 v[4]; float ss = 0.f;
#pragma unroll
    for (int j = 0; j < 4; ++j) { v[j] = xr[lane + 64 * j]; ss += v[j].x * v[j].x + v[j].y * v[j].y + v[j].z * v[j].z + v[j].w * v[j].w; }
#pragma unroll
    for (int o = 1; o < 64; o <<= 1) ss += __shfl_xor(ss, o);
    const float rstd = rsqrtf(ss * (1.f / D) + 1e-6f);
#pragma unroll
    for (int j = 0; j < 4; ++j) {
        const float4 g = ((const float4*)p.g_mix)[lane + 64 * j];
        ushort4 o; o.x = f2bf(v[j].x * rstd * g.x); o.y = f2bf(v[j].y * rstd * g.y); o.z = f2bf(v[j].z * rstd * g.z); o.w = f2bf(v[j].w * rstd * g.w);
        ((ushort4*)(p.u + (size_t)t * D))[lane + 64 * j] = o;
    }
}
__device__ __forceinline__ void body_cs(const P& p, int vb) {
    const int idx = vb * NT + TIDX(); const int t = idx >> 5, i = idx & 31;
    const float inv = 1.0f / powf(10000.0f, (float)i / 32.0f);
    const float ang = (float)p.pos[t] * inv;
    const double a = (double)ang; const double k = rint(a * 0.15915494309189535); const float r = (float)(a - k * 6.283185307179586);
    p.cs[(size_t)t * 64 + i] = cosf(r); p.cs[(size_t)t * 64 + 32 + i] = sinf(r);
}

template <int K, bool TWO, bool SAMEA, class AF1, class AF2, class Epi>
__device__ __forceinline__ void ngemm(float* lds, int m0, const float* W1, int ldw1, int n1, const float* W2, int ldw2, int n2, AF1 a1, AF2 a2, Epi epi) {
    const int tid = TIDX();
    for (int idx = tid; idx < 8 * K; idx += NT) { const int i = idx / K, k = idx % K; lds[idx] = a1(m0 + i, k); if (TWO && !SAMEA) lds[8 * K + idx] = a2(m0 + i, k); }
    __syncthreads();
    float acc1[8], acc2[8];
#pragma unroll
    for (int i = 0; i < 8; ++i) { acc1[i] = 0.f; acc2[i] = 0.f; }
    const float* w1 = W1 + n1; const float* w2 = TWO ? (W2 + n2) : w1;
    const float* l2 = (TWO && !SAMEA) ? lds + 8 * K : lds;
    for (int k = 0; k < K; k += 4) {
        float a[4], b[4];
#pragma unroll
        for (int kk = 0; kk < 4; ++kk) { a[kk] = w1[(size_t)(k + kk) * ldw1]; b[kk] = TWO ? w2[(size_t)(k + kk) * ldw2] : 0.f; }
#pragma unroll
        for (int i = 0; i < 8; ++i) {
            const float4 x1 = *(const float4*)(lds + i * K + k);
            acc1[i] += x1.x * a[0] + x1.y * a[1] + x1.z * a[2] + x1.w * a[3];
            if (TWO) { const float4 x2 = *(const float4*)(l2 + i * K + k); acc2[i] += x2.x * b[0] + x2.y * b[1] + x2.z * b[2] + x2.w * b[3]; }
        }
    }
#pragma unroll
    for (int i = 0; i < 8; ++i) epi(m0 + i, acc1[i], acc2[i]);
    __syncthreads();
}

__device__ __forceinline__ void store_z(const P& p, int t, int j, float z, float zp) {
    const int b = t / S, s = t % S;
    if (j < OFF_KV) {
        const int d = j & 63, i = d & 31; const float c = p.cs[(size_t)t * 64 + i], sn = p.cs[(size_t)t * 64 + 32 + i];
        const float r = (d < 32) ? (z * c - zp * sn) : (z * c + zp * sn);
        p.q[(size_t)t * 512 + j] = f2bf(r * 0.125f);
    } else if (j < OFF_NG) {
        const int seg = (j - OFF_KV) >> 7, cc = (j - OFF_KV) & 127, g = cc >> 6, d = cc & 63; float r = z;
        if (seg == 2 || seg == 4) { const int i = d & 31; const float c = p.cs[(size_t)t * 64 + i], sn = p.cs[(size_t)t * 64 + 32 + i]; r = (d < 32) ? (z * c - zp * sn) : (z * c + zp * sn); }
        p.kv6[(size_t)seg * kvseg(p) + ((size_t)(b * 2 + g) * S + s) * 64 + d] = f2bf(r);
    } else if (j < OFF_GQ) { p.gates[(size_t)t * 24 + (j - OFF_NG)] = sigmoidf_(z);
    } else if (j < OFF_GK) { p.gq[(size_t)t * 256 + (j - OFF_GQ)] = f2bf(z * 0.125f);
    } else if (j < OFF_GV) { p.gk[(size_t)t * 256 + (j - OFF_GK)] = f2bf(z);
    } else if (j < OFF_GA) { p.gv[(size_t)t * 512 + (j - OFF_GV)] = f2bf(z);
    } else if (j < OFF_GR) { p.alow[(size_t)t * 16 + (j - OFF_GA)] = z;
    } else if (j < OFF_MA) { p.rs[(size_t)t * 512 + (j - OFF_GR)] = f2bf(siluf_(z));
    } else if (j < OFF_MB) { p.sa[(size_t)t * 1024 + (j - OFF_MA)] = f2bf(sigmoidf_(z));
    } else { p.sb[(size_t)t * 1024 + (j - OFF_MB)] = f2bf(sigmoidf_(z)); }
}
__device__ __forceinline__ int rope_partner(int j) {
    int base;
    if (j < OFF_KV) base = 0; else if (j >= 768 && j < 896) base = 768; else if (j >= 1024 && j < 1152) base = 1024; else return -1;
    const int d = (j - base) & 63; return d < 32 ? j + 32 : j - 32;
}
__device__ __forceinline__ void body_inproj(const P& p, int vb, char* smem) {
    constexpr int NCB = (INW + NT - 1) / NT;
    const int bx = vb % NCB, by = vb / NCB;
    const int jr = bx * NT + TIDX(); const bool jv = jr < INW; const int j = jv ? jr : INW - 1;
    int jp = rope_partner(j); if (jp < 0) jp = j;
    ngemm<1024, true, true>((float*)smem, by * 8, p.w_in, INW, j, p.w_in, INW, jp,
        [&](int m, int k) { return bf2f(p.u[(size_t)m * D + k]); }, [&](int m, int k) { return 0.f; },
        [&](int m, float z, float zp) { if (jv) store_z(p, m, j, z, zp); });
}

__device__ __forceinline__ void body_cmp1(const P& p, int vb, char* smem) {
    const int nrows = p.nb * 2 * 256, ng = nrows / 8;
    const int kv = vb / ng, m0 = (vb % ng) * 8; const int n = TIDX() & 255; const bool act = TIDX() < 256;
    const bf16* src = p.kv6 + (size_t)kv * kvseg(p);
    const float* pe = kv ? p.cpos_v : p.cpos_k; const float* w1 = kv ? p.cw1_v : p.cw1_k; const float* b1 = kv ? p.cb1_v : p.cb1_k;
    float* dst = p.hcmp + (size_t)kv * nrows * 256;
    ngemm<2048, false, true>((float*)smem, m0, w1, 256, n, w1, 256, n,
        [&](int m, int k) { return bf2f(src[(size_t)m * 1024 + k]) + pe[k]; }, [&](int m, int k) { return 0.f; },
        [&](int m, float z, float) { if (act) dst[(size_t)m * 256 + n] = geluf_(z + b1[n]); });
}
__device__ __forceinline__ void body_cmp2(const P& p, int vb) {
    const int nrows = p.nb * 2 * 256;
    const int idx = vb * NT + TIDX();
    const int i = idx & 31, row = (idx >> 5) % nrows, kv = (idx >> 5) / nrows;
    const float* h = p.hcmp + ((size_t)kv * nrows + row) * 256; const float* w2 = kv ? p.cw2_v : p.cw2_k; const float* b2 = kv ? p.cb2_v : p.cb2_k;
    float z1 = b2[i], z2 = b2[i + 32];
    for (int n = 0; n < 256; ++n) { const float hv = h[n]; z1 += hv * w2[n * 64 + i]; z2 += hv * w2[n * 64 + i + 32]; }
    bf16* dst = (kv ? p.vcmp : p.kcmp) + (size_t)row * 64;
    if (kv == 0) {
        const int bg = row >> 8, m = row & 255, b = bg >> 1; int sp = 16 * m + 31; if (sp > S - 1) sp = S - 1;
        const size_t t = (size_t)b * S + sp; const float c = p.cs[t * 64 + i], sn = p.cs[t * 64 + 32 + i];
        const float r1 = z1 * c - z2 * sn, r2 = z2 * c + z1 * sn; z1 = r1; z2 = r2;
    }
    dst[i] = f2bf(z1); dst[i + 32] = f2bf(z2);
}

__device__ __forceinline__ void load_row64(const bf16* r, float* f) {
    const uint4* p4 = (const uint4*)r;
#pragma unroll
    for (int c = 0; c < 8; ++c) { const uint4 v = p4[c]; const unsigned w[4] = {v.x, v.y, v.z, v.w};
#pragma unroll
        for (int e = 0; e < 4; ++e) { f[c * 8 + e * 2] = __uint_as_float(w[e] << 16); f[c * 8 + e * 2 + 1] = __uint_as_float(w[e] & 0xffff0000u); } }
}
__device__ __forceinline__ float dot64(const float* a, const bf16* r) {
    const uint4* p4 = (const uint4*)r; float s = 0.f;
#pragma unroll
    for (int c = 0; c < 8; ++c) { const uint4 v = p4[c]; const unsigned w[4] = {v.x, v.y, v.z, v.w};
#pragma unroll
        for (int e = 0; e < 4; ++e) { s += a[c * 8 + e * 2] * __uint_as_float(w[e] << 16); s += a[c * 8 + e * 2 + 1] * __uint_as_float(w[e] & 0xffff0000u); } }
    return s;
}
__device__ __forceinline__ void axpy64(float* o, float a, const bf16* r) {
    const uint4* p4 = (const uint4*)r;
#pragma unroll
    for (int c = 0; c < 8; ++c) { const uint4 v = p4[c]; const unsigned w[4] = {v.x, v.y, v.z, v.w};
#pragma unroll
        for (int e = 0; e < 4; ++e) { o[c * 8 + e * 2] += a * __uint_as_float(w[e] << 16); o[c * 8 + e * 2 + 1] += a * __uint_as_float(w[e] & 0xffff0000u); } }
}
__device__ __forceinline__ void body_nsacmp(const P& p, int vb, char* smem) {
    const int wave = TIDX() >> 6, lane = TIDX() & 63, item = vb * 8 + wave;
    const int g = item & 1, t = (item >> 1) * 64 + lane;
    const int b = t / S, s = t % S; const int nv = s >= 31 ? (s - 31) / 16 + 1 : 0;
    float* my = (float*)smem + (size_t)wave * (64 * 65) + lane * 65;
    for (int j = 0; j < 64; ++j) my[j] = 0.f;
    const bf16* kc = p.kcmp + (size_t)(b * 2 + g) * 256 * 64; const bf16* vc = p.vcmp + (size_t)(b * 2 + g) * 256 * 64;
    for (int hh = 0; hh < 4; ++hh) {
        const int h = g * 4 + hh; float qv[64], o[64];
        load_row64(p.q + (size_t)t * 512 + h * 64, qv);
#pragma unroll
        for (int d = 0; d < 64; ++d) o[d] = 0.f;
        float m = -1e30f, l = 0.f;
        for (int n = 0; n < nv; ++n) { const float sc = dot64(qv, kc + n * 64); const float mn = fmaxf(m, sc); l = l * __expf(m - mn) + __expf(sc - mn); m = mn; }
        const float il = nv > 0 ? 1.f / l : 0.f;
        for (int n = 0; n < nv; ++n) {
            const float sc = dot64(qv, kc + n * 64); const float pn = __expf(sc - m) * il;
            axpy64(o, pn, vc + n * 64);
            const int j0 = n >> 2; if ((n & 3) != 3) my[j0] += pn; else { my[j0] += 0.5f * pn; my[j0 + 1] += 0.5f * pn; }
        }
#pragma unroll
        for (int d = 0; d < 64; ++d) p.ocmp[(size_t)t * 512 + h * 64 + d] = o[d];
    }
    const int cur = s >> 6; u64 mask = 0ull;
    for (int j = 0; j <= cur; ++j) {
        const float sj = (j == 0 || j == cur || j == cur - 1) ? 1e4f : my[j]; int rank = 0;
        for (int i = 0; i <= cur; ++i) { if (i == j) continue; const float si = (i == 0 || i == cur || i == cur - 1) ? 1e4f : my[i]; if (si > sj || (si == sj && i < j)) ++rank; }
        if (rank < 16) mask |= (1ull << j);
    }
    p.sel[(size_t)t * 2 + g] = mask;
}
__device__ __forceinline__ void body_nsaatt(const P& p, int vb) {
    const int wave = TIDX() >> 6, lane = TIDX() & 63, item = vb * 8 + wave;
    const int h = item & 7, t = (item >> 3) * 64 + lane, g = h >> 2;
    const int b = t / S, s = t % S, cur = s >> 6;
    const size_t seg = kvseg(p), ho = (size_t)(b * 2 + g) * S * 64;
    const bf16* ks = p.kv6 + 2 * seg + ho; const bf16* vs = p.kv6 + 3 * seg + ho; const bf16* kw = p.kv6 + 4 * seg + ho; const bf16* vw = p.kv6 + 5 * seg + ho;
    float qv[64], o[64];
    load_row64(p.q + (size_t)t * 512 + h * 64, qv);
    const float g0 = p.gates[(size_t)t * 24 + h * 3], g1 = p.gates[(size_t)t * 24 + h * 3 + 1], g2 = p.gates[(size_t)t * 24 + h * 3 + 2];
    float* accp = p.ocmp + (size_t)t * 512 + h * 64;
#pragma unroll
    for (int d = 0; d < 64; ++d) o[d] = 0.f;
    const u64 mask = p.sel[(size_t)t * 2 + g];
    float m = -1e30f, l = 0.f;
    for (int j = 0; j <= cur; ++j) {
        if (!((mask >> j) & 1ull)) continue;
        for (int kk = 0; kk < 64; ++kk) {
            const int key = j * 64 + kk; if (key > s) break;
            const float sc = dot64(qv, ks + (size_t)key * 64);
            if (sc > m) { const float f = __expf(m - sc); l *= f;
#pragma unroll
                for (int d = 0; d < 64; ++d) o[d] *= f;
                m = sc; }
            const float pe = __expf(sc - m); l += pe; axpy64(o, pe, vs + (size_t)key * 64);
        }
    }
    { const float f = g1 / l;
#pragma unroll
        for (int d = 0; d < 64; ++d) { accp[d] = g0 * accp[d] + f * o[d]; o[d] = 0.f; } }
    m = -1e30f; l = 0.f;
    for (int key = (s >= 511 ? s - 511 : 0); key <= s; ++key) {
        const float sc = dot64(qv, kw + (size_t)key * 64);
        if (sc > m) { const float f = __expf(m - sc); l *= f;
#pragma unroll
            for (int d = 0; d < 64; ++d) o[d] *= f;
            m = sc; }
        const float pe = __expf(sc - m); l += pe; axpy64(o, pe, vw + (size_t)key * 64);
    }
    { const float f = g2 / l;
#pragma unroll
        for (int d = 0; d < 64; ++d) p.onsa[(size_t)t * 512 + h * 64 + d] = f2bf(accp[d] + f * o[d]); }
}

__device__ __forceinline__ void body_glaa(const P& p, int vb) {
    const int c = TIDX() & 255, t = vb * 2 + (TIDX() >> 8); float z = p.b_a[c];
#pragma unroll
    for (int r = 0; r < 16; ++r) z += p.alow[(size_t)t * 16 + r] * p.w_a2[r * 256 + c];
    const float ls = fminf(z, 0.f) - log1pf(__expf(-fabsf(z)));
    p.ga[(size_t)t * 256 + c] = __expf(ls * (1.f / 16.f));
}
__device__ __forceinline__ void body_glascan(const P& p, int vb, char* smem) {
    const int sub = TIDX() >> 7, e = TIDX() & 127, bh = vb * 4 + sub, b = bh >> 2, h = bh & 3;
    float* sq = (float*)smem + sub * (3 * 32 * 64); float* sk = sq + 32 * 64; float* sg = sk + 32 * 64;
    float St[64];
#pragma unroll
    for (int d = 0; d < 64; ++d) St[d] = 0.f;
    for (int s0 = 0; s0 < S; s0 += 32) {
        __syncthreads();
        for (int i = e; i < 32 * 64; i += 128) { const int ss = i >> 6, d = i & 63; const size_t t = (size_t)b * S + s0 + ss;
            sq[i] = bf2f(p.gq[t * 256 + h * 64 + d]); sk[i] = bf2f(p.gk[t * 256 + h * 64 + d]); sg[i] = p.ga[t * 256 + h * 64 + d]; }
        __syncthreads();
        for (int ss = 0; ss < 32; ++ss) {
            const size_t t = (size_t)b * S + s0 + ss; const float v = bf2f(p.gv[t * 512 + h * 128 + e]); float o = 0.f;
#pragma unroll
            for (int d = 0; d < 64; ++d) { St[d] = sg[ss * 64 + d] * St[d] + sk[ss * 64 + d] * v; o += sq[ss * 64 + d] * St[d]; }
            p.oraw[t * 512 + h * 128 + e] = o;
        }
    }
    __syncthreads();
}
__device__ __forceinline__ void body_glanorm(const P& p, int vb) {
    const int idx = vb * NT + TIDX(); const int t = idx >> 2, h = idx & 3;
    const float* o = p.oraw + (size_t)t * 512 + h * 128; float ss = 0.f;
    for (int e = 0; e < 128; ++e) ss += o[e] * o[e];
    const float r = rsqrtf(ss * (1.f / 128.f) + 1e-6f);
    for (int e = 0; e < 128; ++e) p.gla[(size_t)t * 512 + h * 128 + e] = f2bf(o[e] * r * p.norm_g[h * 128 + e] * bf2f(p.rs[(size_t)t * 512 + h * 128 + e]));
}

__device__ __forceinline__ void body_proj(const P& p, int vb, char* smem) {
    const int n = (vb & 1) * NT + TIDX(), m0 = (vb >> 1) * 8;
    ngemm<512, true, false>((float*)smem, m0, p.w_pn, 1024, n, p.w_pg, 1024, n,
        [&](int m, int k) { return bf2f(p.onsa[(size_t)m * 512 + k]); }, [&](int m, int k) { return bf2f(p.gla[(size_t)m * 512 + k]); },
        [&](int m, float ya, float yb) { p.mixed[(size_t)m * 1024 + n] = f2bf(bf2f(p.sa[(size_t)m * 1024 + n]) * ya + bf2f(p.sb[(size_t)m * 1024 + n]) * yb); });
}
__device__ __forceinline__ void body_out(const P& p, int vb, char* smem) {
    const int n = (vb & 1) * NT + TIDX(), m0 = (vb >> 1) * 8;
    ngemm<1024, false, true>((float*)smem, m0, p.w_out, 1024, n, p.w_out, 1024, n,
        [&](int m, int k) { return bf2f(p.mixed[(size_t)m * 1024 + k]); }, [&](int m, int k) { return 0.f; },
        [&](int m, float z, float) { p.h1[(size_t)m * 1024 + n] = p.x[(size_t)m * 1024 + n] + z; });
}

__device__ __forceinline__ void body_route(const P& p, int vb, char* smem) {
    const int wave = TIDX() >> 6, lane = TIDX() & 63, t = vb * 8 + wave;
    const float4* hr = (const float4*)(p.h1 + (size_t)t * D);
    float v[16]; float ss = 0.f;
#pragma unroll
    for (int j = 0; j < 4; ++j) { const float4 a = hr[lane + 64 * j]; v[4 * j] = a.x; v[4 * j + 1] = a.y; v[4 * j + 2] = a.z; v[4 * j + 3] = a.w; ss += a.x * a.x + a.y * a.y + a.z * a.z + a.w * a.w; }
#pragma unroll
    for (int o = 1; o < 64; o <<= 1) ss += __shfl_xor(ss, o);
    const float rstd = rsqrtf(ss * (1.f / D) + 1e-6f);
#pragma unroll
    for (int j = 0; j < 4; ++j) {
        const float4 g = ((const float4*)p.g_ffn)[lane + 64 * j];
        v[4 * j] *= rstd * g.x; v[4 * j + 1] *= rstd * g.y; v[4 * j + 2] *= rstd * g.z; v[4 * j + 3] *= rstd * g.w;
        ushort4 o; o.x = f2bf(v[4 * j]); o.y = f2bf(v[4 * j + 1]); o.z = f2bf(v[4 * j + 2]); o.w = f2bf(v[4 * j + 3]);
        ((ushort4*)(p.vb + (size_t)t * D))[lane + 64 * j] = o;
    }
    float* sl = (float*)(smem + LDS_MISC) + wave * 40;
    for (int o = 0; o < 4; ++o) { float a = 0.f;
#pragma unroll
        for (int j = 0; j < 4; ++j)
#pragma unroll
            for (int e = 0; e < 4; ++e) a += v[4 * j + e] * p.w_grp[(size_t)(4 * (lane + 64 * j) + e) * 4 + o];
#pragma unroll
        for (int x = 1; x < 64; x <<= 1) a += __shfl_xor(a, x);
        if (lane == 0) sl[o] = a + p.b_grp[o]; }
    for (int o = 0; o < 32; ++o) { float a = 0.f;
#pragma unroll
        for (int j = 0; j < 4; ++j)
#pragma unroll
            for (int e = 0; e < 4; ++e) a += v[4 * j + e] * p.w_exp[(size_t)(4 * (lane + 64 * j) + e) * 32 + o];
#pragma unroll
        for (int x = 1; x < 64; x <<= 1) a += __shfl_xor(a, x);
        if (lane == 0) sl[4 + o] = a + p.b_exp[o]; }
    if (lane == 0) {
        int gs = 0; float gm = sl[0];
        for (int o = 1; o < 4; ++o) if (sl[o] > gm) { gm = sl[o]; gs = o; }
        float gsum = 0.f;
        for (int o = 0; o < 4; ++o) gsum += __expf(sl[o] - gm);
        const float pg = 1.f / gsum;
        const float* li = sl + 4 + gs * 8;
        int e0 = 0; float m0 = li[0];
        for (int e = 1; e < 8; ++e) if (li[e] > m0) { m0 = li[e]; e0 = e; }
        int e1 = -1; float m1 = -3e38f;
        for (int e = 0; e < 8; ++e) if (e != e0 && li[e] > m1) { m1 = li[e]; e1 = e; }
        const float p0 = 1.f, p1 = __expf(m1 - m0);
        const float w0 = pg * p0 / (p0 + p1), w1 = pg * p1 / (p0 + p1);
        const int x0 = gs * 8 + e0, x1 = gs * 8 + e1;
        const int s0 = (int)atomicAdd(&p.ctl[x0 * 32], 1u), s1 = (int)atomicAdd(&p.ctl[x1 * 32], 1u);
        p.list[(size_t)x0 * p.T + s0] = t; p.list[(size_t)x1 * p.T + s1] = t;
        p.tokexp[t * 2] = x0; p.tokexp[t * 2 + 1] = x1; p.tokslot[t * 2] = s0; p.tokslot[t * 2 + 1] = s1; p.tokw[t * 2] = w0; p.tokw[t * 2 + 1] = w1;
    }
}

__device__ __forceinline__ void body_route2(const P& p, int vb, char* smem) {
    const int tid = TIDX(), wave = tid >> 6, lane = tid & 63, t = vb * 8 + wave;
    const float4* hr = (const float4*)(p.h1 + (size_t)t * D);
    float4 v[4]; float ss = 0.f;
#pragma unroll
    for (int j = 0; j < 4; ++j) { v[j] = hr[lane + 64 * j]; ss += v[j].x * v[j].x + v[j].y * v[j].y + v[j].z * v[j].z + v[j].w * v[j].w; }
#pragma unroll
    for (int o = 1; o < 64; o <<= 1) ss += __shfl_xor(ss, o);
    const float rstd = rsqrtf(ss * (1.f / D) + 1e-6f);
#pragma unroll
    for (int j = 0; j < 4; ++j) {
        const float4 g = ((const float4*)p.g_ffn)[lane + 64 * j];
        v[j].x *= rstd * g.x; v[j].y *= rstd * g.y; v[j].z *= rstd * g.z; v[j].w *= rstd * g.w;
        ushort4 o; o.x = f2bf(v[j].x); o.y = f2bf(v[j].y); o.z = f2bf(v[j].z); o.w = f2bf(v[j].w);
        ((ushort4*)(p.vb + (size_t)t * D))[lane + 64 * j] = o;
    }
    float* sl = (float*)(smem + LDS_MISC) + wave * 40;
    float mine = 0.f;
#pragma unroll 4
    for (int o = 0; o < 36; ++o) { const float4* wrow = (const float4*)(p.wr + (size_t)o * 1024); float a = 0.f;
#pragma unroll
        for (int j = 0; j < 4; ++j) { const float4 w = wrow[lane + 64 * j]; a += v[j].x * w.x + v[j].y * w.y + v[j].z * w.z + v[j].w * w.w; }
#pragma unroll
        for (int x = 1; x < 64; x <<= 1) a += __shfl_xor(a, x);
        if (lane == o) mine = a; }
    if (lane < 36) sl[lane] = mine + (lane < 4 ? p.b_grp[lane] : p.b_exp[lane - 4]);
    asm volatile("s_waitcnt lgkmcnt(0)" ::: "memory");
    if (lane == 0) {
        int gs = 0; float gm = sl[0];
        for (int o = 1; o < 4; ++o) if (sl[o] > gm) { gm = sl[o]; gs = o; }
        float gsum = 0.f;
        for (int o = 0; o < 4; ++o) gsum += __expf(sl[o] - gm);
        const float pg = 1.f / gsum;
        const float* li = sl + 4 + gs * 8;
        int e0 = 0; float m0 = li[0];
        for (int e = 1; e < 8; ++e) if (li[e] > m0) { m0 = li[e]; e0 = e; }
        int e1 = -1; float m1 = -3e38f;
        for (int e = 0; e < 8; ++e) if (e != e0 && li[e] > m1) { m1 = li[e]; e1 = e; }
        const float p0 = 1.f, p1 = __expf(m1 - m0);
        const float w0 = pg * p0 / (p0 + p1), w1 = pg * p1 / (p0 + p1);
        const int x0 = gs * 8 + e0, x1 = gs * 8 + e1;
        const int s0 = (int)atomicAdd(&p.ctl[x0 * 32], 1u), s1 = (int)atomicAdd(&p.ctl[x1 * 32], 1u);
        p.list[(size_t)x0 * p.T + s0] = t; p.list[(size_t)x1 * p.T + s1] = t;
        p.tokexp[t * 2] = x0; p.tokexp[t * 2 + 1] = x1; p.tokslot[t * 2] = s0; p.tokslot[t * 2 + 1] = s1; p.tokw[t * 2] = w0; p.tokw[t * 2 + 1] = w1;
    }
}

__device__ __forceinline__ float tred8(float (&a)[8], int lane) {
    const bool b5 = lane & 32, b4 = lane & 16, b3 = lane & 8;
    float k4[4], k2[2], k1;
#pragma unroll
    for (int i = 0; i < 4; ++i) { const float snd = b5 ? a[i] : a[i + 4]; const float kp = b5 ? a[i + 4] : a[i]; k4[i] = kp + __shfl_xor(snd, 32); }
#pragma unroll
    for (int i = 0; i < 2; ++i) { const float snd = b4 ? k4[i] : k4[i + 2]; const float kp = b4 ? k4[i + 2] : k4[i]; k2[i] = kp + __shfl_xor(snd, 16); }
    { const float snd = b3 ? k2[0] : k2[1]; const float kp = b3 ? k2[1] : k2[0]; k1 = kp + __shfl_xor(snd, 8); }
    k1 += __shfl_xor(k1, 4); k1 += __shfl_xor(k1, 2); k1 += __shfl_xor(k1, 1);
    return k1;
}
__device__ __forceinline__ void body_route3(const P& p, int vb, char* smem) {
    const int tid = TIDX(), wave = tid >> 6, lane = tid & 63, t0 = vb * 64 + wave * 8;
    float4 v[8][4]; float ss[8];
#pragma unroll
    for (int tk = 0; tk < 8; ++tk) { const float4* hr = (const float4*)(p.h1 + (size_t)(t0 + tk) * D); float s = 0.f;
#pragma unroll
        for (int j = 0; j < 4; ++j) { v[tk][j] = hr[lane + 64 * j]; s += v[tk][j].x * v[tk][j].x + v[tk][j].y * v[tk][j].y + v[tk][j].z * v[tk][j].z + v[tk][j].w * v[tk][j].w; }
        ss[tk] = s; }
    const float tot = tred8(ss, lane);
#pragma unroll
    for (int tk = 0; tk < 8; ++tk) { const float rstd = rsqrtf(__shfl(tot, tk * 8) * (1.f / D) + 1e-6f);
#pragma unroll
        for (int j = 0; j < 4; ++j) {
            const float4 g = ((const float4*)p.g_ffn)[lane + 64 * j];
            v[tk][j].x *= rstd * g.x; v[tk][j].y *= rstd * g.y; v[tk][j].z *= rstd * g.z; v[tk][j].w *= rstd * g.w;
            ushort4 o; o.x = f2bf(v[tk][j].x); o.y = f2bf(v[tk][j].y); o.z = f2bf(v[tk][j].z); o.w = f2bf(v[tk][j].w);
            ((ushort4*)(p.vb + (size_t)(t0 + tk) * D))[lane + 64 * j] = o; } }
    float* sl = (float*)smem + wave * (8 * 40);
    float* wl = (float*)smem + 4096;
    for (int o = 0; o < 36; ++o) {
        if (o == 0 || o == 18) { __syncthreads();
#pragma unroll
            for (int k = 0; k < 9; ++k) ((float4*)wl)[tid + k * 512] = ((const float4*)(p.wr + (size_t)o * 1024))[tid + k * 512];
            __syncthreads(); }
        const float4* wrow = (const float4*)(wl + (size_t)(o >= 18 ? o - 18 : o) * 1024); float a[8];
        float4 w[4];
#pragma unroll
        for (int j = 0; j < 4; ++j) w[j] = wrow[lane + 64 * j];
#pragma unroll
        for (int tk = 0; tk < 8; ++tk) { float s = 0.f;
#pragma unroll
            for (int j = 0; j < 4; ++j) s += v[tk][j].x * w[j].x + v[tk][j].y * w[j].y + v[tk][j].z * w[j].z + v[tk][j].w * w[j].w;
            a[tk] = s; }
        const float r = tred8(a, lane);
        if ((lane & 7) == 0) sl[(lane >> 3) * 40 + o] = r + (o < 4 ? p.b_grp[o] : p.b_exp[o - 4]); }
    asm volatile("s_waitcnt lgkmcnt(0)" ::: "memory");
    int* cntl = (int*)((float*)smem + 8 * 320); int* basel = cntl + 32;
    if (tid < 32) cntl[tid] = 0;
    __syncthreads();
    int x0 = 0, x1 = 0, l0 = 0, l1 = 0; float w0 = 0.f, w1 = 0.f;
    if (lane < 8) {
        const float* s8 = sl + lane * 40;
        int gs = 0; float gm = s8[0];
        for (int o = 1; o < 4; ++o) if (s8[o] > gm) { gm = s8[o]; gs = o; }
        float gsum = 0.f;
        for (int o = 0; o < 4; ++o) gsum += __expf(s8[o] - gm);
        const float pg = 1.f / gsum;
        const float* li = s8 + 4 + gs * 8;
        int e0 = 0; float m0 = li[0];
        for (int e = 1; e < 8; ++e) if (li[e] > m0) { m0 = li[e]; e0 = e; }
        int e1 = -1; float m1 = -3e38f;
        for (int e = 0; e < 8; ++e) if (e != e0 && li[e] > m1) { m1 = li[e]; e1 = e; }
        const float p0 = 1.f, p1 = __expf(m1 - m0);
        w0 = pg * p0 / (p0 + p1); w1 = pg * p1 / (p0 + p1);
        x0 = gs * 8 + e0; x1 = gs * 8 + e1;
        l0 = atomicAdd(&cntl[x0], 1); l1 = atomicAdd(&cntl[x1], 1);
    }
    __syncthreads();
    if (tid < 32) { const int c = cntl[tid]; basel[tid] = c > 0 ? (int)atomicAdd(&p.ctl[tid * 32], (unsigned)c) : 0; }
    __syncthreads();
    if (lane < 8) {
        const int t = t0 + lane; const int s0 = basel[x0] + l0, s1 = basel[x1] + l1;
        p.list[(size_t)x0 * p.T + s0] = t; p.list[(size_t)x1 * p.T + s1] = t;
        p.tokexp[t * 2] = x0; p.tokexp[t * 2 + 1] = x1; p.tokslot[t * 2] = s0; p.tokslot[t * 2 + 1] = s1; p.tokw[t * 2] = w0; p.tokw[t * 2 + 1] = w1;
    }
    __syncthreads();
}

__device__ __forceinline__ int* seg_bases(const P& p, char* smem) {
    int* sbase = (int*)(smem + LDS_MISC + 2048);
    __syncthreads();
    if (TIDX() == 0) { int acc = 0; for (int e = 0; e < NEXP; ++e) { sbase[e] = acc; acc += ((int)p.ctl[e * 32] + 255) & ~255; } sbase[NEXP] = acc; }
    __syncthreads();
    return sbase;
}
__device__ __forceinline__ void body_moe1(const P& p, int vb, char* smem) {
    int* sbase = seg_bases(p, smem); int* stok = sbase + 40;
    const int r0 = vb * 8; if (r0 >= sbase[NEXP]) return;
    int e = 0; while (r0 >= sbase[e + 1]) ++e;
    const int cnt = (int)p.ctl[e * 32];
    if (TIDX() < 8) { const int sl = r0 + TIDX() - sbase[e]; stok[TIDX()] = p.list[(size_t)e * p.T + (sl < cnt ? sl : 0)]; }
    __syncthreads();
    const int n = TIDX();
    const float* wg = p.w_gate + (size_t)e * 1024 * 512; const float* wu = p.w_up + (size_t)e * 1024 * 512;
    ngemm<1024, true, true>((float*)smem, 0, wg, 512, n, wu, 512, n,
        [&](int m, int k) { return bf2f(p.vb[(size_t)stok[m] * D + k]); }, [&](int m, int k) { return 0.f; },
        [&](int m, float zg, float zu) { p.H[(size_t)(r0 + m) * 512 + n] = f2bf(siluf_(zg) * zu); });
}
__device__ __forceinline__ void body_moe2(const P& p, int vb, char* smem) {
    int* sbase = seg_bases(p, smem);
    const int r0 = (vb >> 1) * 8; if (r0 >= sbase[NEXP]) return;
    int e = 0; while (r0 >= sbase[e + 1]) ++e;
    const int n = (vb & 1) * NT + TIDX();
    const float* wd = p.w_down + (size_t)e * 512 * 1024;
    ngemm<512, false, true>((float*)smem, r0, wd, 1024, n, wd, 1024, n,
        [&](int m, int k) { return bf2f(p.H[(size_t)m * 512 + k]); }, [&](int m, int k) { return 0.f; },
        [&](int m, float z, float) { p.Y[(size_t)m * 1024 + n] = f2bf(z); });
}
__device__ __forceinline__ void body_final(const P& p, int vb, char* smem) {
    int* sbase = seg_bases(p, smem);
    const int lane = TIDX() & 63, t = vb * 8 + (TIDX() >> 6);
    const int r0 = sbase[p.tokexp[t * 2]] + p.tokslot[t * 2], r1 = sbase[p.tokexp[t * 2 + 1]] + p.tokslot[t * 2 + 1];
    const float w0 = p.tokw[t * 2], w1 = p.tokw[t * 2 + 1];
    const float4* hr = (const float4*)(p.h1 + (size_t)t * D);
    float4 v[4]; float ss = 0.f;
#pragma unroll
    for (int j = 0; j < 4; ++j) {
        float4 a = hr[lane + 64 * j];
        const ushort4 y0 = ((const ushort4*)(p.Y + (size_t)r0 * D))[lane + 64 * j], y1 = ((const ushort4*)(p.Y + (size_t)r1 * D))[lane + 64 * j];
        a.x += w0 * bf2f(y0.x) + w1 * bf2f(y1.x); a.y += w0 * bf2f(y0.y) + w1 * bf2f(y1.y); a.z += w0 * bf2f(y0.z) + w1 * bf2f(y1.z); a.w += w0 * bf2f(y0.w) + w1 * bf2f(y1.w);
        v[j] = a; ss += a.x * a.x + a.y * a.y + a.z * a.z + a.w * a.w;
    }
#pragma unroll
    for (int o = 1; o < 64; o <<= 1) ss += __shfl_xor(ss, o);
    const float rstd = rsqrtf(ss * (1.f / D) + 1e-6f);
#pragma unroll
    for (int j = 0; j < 4; ++j) {
        const float4 g = ((const float4*)p.g_final)[lane + 64 * j];
        float4 o; o.x = v[j].x * rstd * g.x; o.y = v[j].y * rstd * g.y; o.z = v[j].z * rstd * g.z; o.w = v[j].w * rstd * g.w;
        ((float4*)(p.out + (size_t)t * D))[lane + 64 * j] = o;
    }
}

namespace pg8 {
#define PG8_LAS __attribute__((address_space(3)))
typedef short bf16x8 __attribute__((ext_vector_type(8)));
typedef float f32x4 __attribute__((ext_vector_type(4)));
typedef unsigned u32x4 __attribute__((ext_vector_type(4)));
typedef unsigned u32x2 __attribute__((ext_vector_type(2)));
constexpr int BM = 256, BK = 64, HALF = 128, HTB = HALF * BK * 2, STAGE_BYTES = 8 * HTB, NXCD = 8, WGM = 8;

__host__ __device__ __forceinline__ int lds_byte(int r, int c) { const int st = (r >> 4) * 2 + (c >> 5), rr = r & 15, cc = c & 31, ob = rr * 64 + cc * 2; return st * 1024 + (ob ^ (((ob >> 9) & 1) << 5)); }
__host__ __device__ __forceinline__ void stage_rc(int b, int& R, int& C) { const int st = b / 1024, sb = b % 1024, swz = sb ^ (((sb >> 9) & 1) << 5); R = (st >> 1) * 16 + swz / 64; C = (st & 1) * 32 + (swz % 64) / 2; }
__host__ __device__ __forceinline__ int perm32(int rho) { const int n = rho >> 4, i = rho & 15; return 8 * (i >> 2) + 4 * n + (i & 3); }

struct Unit { int pm, pn; const char* A; const char* B; int tag; };

struct TileOrder {
    int nM, nN, nwg, G, c;
    __device__ void init(int nM_, int nN_, int G_, int c_) { nM = nM_; nN = nN_; nwg = nM * nN; G = G_; c = c_; }
    __device__ bool next(int i, int& pm, int& pn) const {
        const long L = (long)i * G + c; if (L >= nwg) return false;
        int wgid = (int)L; { const int q = nwg / NXCD, r = nwg % NXCD, xcd = wgid % NXCD, off = wgid / NXCD; wgid = (xcd < r ? xcd * (q + 1) : r * (q + 1) + (xcd - r) * q) + off; }
        const int nig = WGM * nN, gid = wgid / nig, fm = gid * WGM, gsz = (nM - fm) < WGM ? (nM - fm) : WGM;
        pm = fm + ((wgid % nig) % gsz); pn = (wgid % nig) / gsz; return true;
    }
};
struct DenseSched {
    TileOrder o; const char* A; const char* B; int lda, ldb;
    __device__ void init(const void* A_, const void* B_, int M, int N, int lda_, int ldb_) { A = (const char*)A_; B = (const char*)B_; lda = lda_; ldb = ldb_; o.init(M / BM, N / BM, gridDim.x, blockIdx.x); }
    __device__ __forceinline__ bool next(int i, Unit& u) const { if (!o.next(i, u.pm, u.pn)) return false; u.A = A + (size_t)u.pm * BM * lda * 2; u.B = B + (size_t)u.pn * BM * ldb * 2; u.tag = 0; return true; }
    __device__ __forceinline__ unsigned arow(const Unit&, int r) const { return (unsigned)r * (unsigned)lda * 2u; }
};

__device__ __forceinline__ unsigned cvt_pk_bf16(float lo, float hi) { unsigned r; asm volatile("v_cvt_pk_bf16_f32 %0, %1, %2" : "=v"(r) : "v"(lo), "v"(hi)); return r; }

template <class Epi, class Sched, bool ALIGN_EPI, bool GATHER>
__device__ __forceinline__ void gemm_phase(PG8_LAS unsigned char* lds, const int K, const int lda, const int ldb, const Sched& S, const Epi& E) {
    const int tid = TIDX(), wid = __builtin_amdgcn_readfirstlane(tid >> 6), lane = tid & 63, wr = wid >> 2, wc = wid & 3, fr = lane & 15, fq = lane >> 4;
    const int nt = K / BK;
    int sR[2], sC[2];
    unsigned voffA[2], voffB[2];
#pragma unroll
    for (int i = 0; i < 2; ++i) { stage_rc(tid * 16 + i * 8192, sR[i], sC[i]); const int Rb = Epi::PERM ? ((sR[i] & ~31) + perm32(sR[i] & 31)) : sR[i];
        voffA[i] = (unsigned)(sR[i] * lda + sC[i]) * 2u; voffB[i] = (unsigned)(Rb * ldb + sC[i]) * 2u; }
    unsigned gA[2][2], gN[2][2];
    const size_t kstep = (size_t)(BK * 2);
    const size_t hstepA = (size_t)HALF * lda * 2, hstepB = (size_t)HALF * ldb * 2;
    const unsigned ldsw = (unsigned)wid * 1024u;
    const int aoff = lds_byte(wr * 64 + fr, fq * 8), boff = lds_byte(wc * 32 + fr, fq * 8);
#define PG8_SA(b, h) (((b) * 2 + (h)) * HTB)
#define PG8_SB(b, h) ((4 + (b) * 2 + (h)) * HTB)
#define PG8_GLDS(bufoff, gptr, i_) __builtin_amdgcn_global_load_lds((const unsigned*)(gptr), (PG8_LAS unsigned*)(lds + (bufoff) + ldsw + (i_) * 8192), 16, 0, 0)
#define PG8_STAGE_B(bufoff, gbase) do { _Pragma("unroll") for (int _i = 0; _i < 2; ++_i) PG8_GLDS(bufoff, (const char*)(gbase) + voffB[_i], _i); } while (0)
#define PG8_STAGE_A(bufoff, gb, h, NX) do { _Pragma("unroll") for (int _i = 0; _i < 2; ++_i) { \
        if constexpr (GATHER) { const unsigned _o = (NX) ? gN[h][_i] : gA[h][_i]; PG8_GLDS(bufoff, (const char*)(gb) + _o, _i); } \
        else { PG8_GLDS(bufoff, (const char*)(gb) + (h) * hstepA + voffA[_i], _i); } } } while (0)
#define PG8_LDA(dst, b, h) do { _Pragma("unroll") for (int m = 0; m < 4; ++m) _Pragma("unroll") for (int k = 0; k < 2; ++k) dst[m][k] = *(const PG8_LAS bf16x8*)(lds + PG8_SA(b, h) + aoff + m * 2048 + k * 1024); } while (0)
#define PG8_LDB(dst, b, h) do { _Pragma("unroll") for (int n = 0; n < 2; ++n) _Pragma("unroll") for (int k = 0; k < 2; ++k) dst[n][k] = *(const PG8_LAS bf16x8*)(lds + PG8_SB(b, h) + boff + n * 2048 + k * 1024); } while (0)
#define PG8_MMA(ai, bj, At, Bt) do { __builtin_amdgcn_s_setprio(1); _Pragma("unroll") for (int m = 0; m < 4; ++m) _Pragma("unroll") for (int n = 0; n < 2; ++n) _Pragma("unroll") for (int k = 0; k < 2; ++k) \
        acc[ai][bj][m][n] = __builtin_amdgcn_mfma_f32_16x16x32_bf16(Bt[n][k], At[m][k], acc[ai][bj][m][n], 0, 0, 0); __builtin_amdgcn_s_setprio(0); } while (0)
#define PG8_WAIT_V(n) asm volatile("s_waitcnt vmcnt(" #n ")" ::: "memory")
#define PG8_WAIT_L(n) asm volatile("s_waitcnt lgkmcnt(" #n ")" ::: "memory")
#define PG8_BAR __builtin_amdgcn_s_barrier()
#define PG8_SCHED __builtin_amdgcn_sched_barrier(0)
#define PG8_GOFF(dst, u) do { if constexpr (GATHER) { _Pragma("unroll") for (int _h = 0; _h < 2; ++_h) _Pragma("unroll") for (int _i = 0; _i < 2; ++_i) dst[_h][_i] = S.arow(u, _h * HALF + sR[_i]) + (unsigned)sC[_i] * 2u; } } while (0)
    Unit cur, nxt; int ui = 0;
    if (!S.next(0, cur)) return;
    f32x4 acc[2][2][4][2];
#pragma unroll
    for (int a = 0; a < 2; ++a)
#pragma unroll
        for (int b = 0; b < 2; ++b)
#pragma unroll
            for (int m = 0; m < 4; ++m)
#pragma unroll
                for (int n = 0; n < 2; ++n) acc[a][b][m][n] = (f32x4){0.f, 0.f, 0.f, 0.f};
    bf16x8 At[4][2], B0[2][2], B1[2][2];
    const char* cA = cur.A; const char* cB = cur.B;
    PG8_GOFF(gA, cur);
    if constexpr (GATHER) { PG8_WAIT_V(0); }
    PG8_STAGE_B(PG8_SB(0, 0), cB); PG8_STAGE_B(PG8_SB(0, 1), cB + hstepB); PG8_STAGE_A(PG8_SA(0, 0), cA, 0, false); PG8_STAGE_A(PG8_SA(0, 1), cA, 1, false);
    if (wr == 1) PG8_BAR;
    PG8_WAIT_V(2); PG8_BAR;
    PG8_STAGE_B(PG8_SB(1, 0), cB + kstep); PG8_STAGE_A(PG8_SA(1, 0), cA + kstep, 0, false); PG8_STAGE_B(PG8_SB(1, 1), cB + hstepB + kstep);
    PG8_WAIT_V(6); PG8_BAR;
    for (;;) {
        const bool has_next = S.next(ui + 1, nxt);
        const char* nA = has_next ? nxt.A : cA; const char* nB = has_next ? nxt.B : cB;
        if constexpr (GATHER) { if (has_next) { PG8_GOFF(gN, nxt); } else {
#pragma unroll
            for (int _h = 0; _h < 2; ++_h)
#pragma unroll
                for (int _i = 0; _i < 2; ++_i) gN[_h][_i] = gA[_h][_i]; } }
        for (int t = 0; t < nt; t += 2) {
            const bool last = (t == nt - 2);
            const char* a1 = cA + (size_t)(t + 1) * kstep;
            const char* a2 = last ? nA : cA + (size_t)(t + 2) * kstep; const char* b2 = last ? nB : cB + (size_t)(t + 2) * kstep;
            const char* a3 = a2 + kstep; const char* b3 = b2 + kstep;
            PG8_LDB(B0, 0, 0); PG8_LDB(B1, 0, 1); PG8_SCHED; PG8_LDA(At, 0, 0); PG8_STAGE_A(PG8_SA(1, 1), a1, 1, false);
            PG8_WAIT_V(8); PG8_WAIT_L(0); PG8_BAR; PG8_MMA(0, 0, At, B0); PG8_MMA(0, 1, At, B1); PG8_BAR; PG8_SCHED;
            PG8_LDA(At, 0, 1); PG8_STAGE_B(PG8_SB(0, 0), b2); PG8_STAGE_B(PG8_SB(0, 1), b2 + hstepB); PG8_STAGE_A(PG8_SA(0, 0), a2, 0, last);
            PG8_WAIT_V(8); PG8_WAIT_L(0); PG8_BAR; PG8_MMA(1, 0, At, B0); PG8_MMA(1, 1, At, B1); PG8_BAR; PG8_SCHED;
            PG8_LDB(B0, 1, 0); PG8_LDB(B1, 1, 1); PG8_SCHED; PG8_LDA(At, 1, 0); PG8_STAGE_A(PG8_SA(0, 1), a2, 1, last);
            PG8_WAIT_V(8); PG8_WAIT_L(0); PG8_BAR; PG8_MMA(0, 0, At, B0); PG8_MMA(0, 1, At, B1); PG8_BAR; PG8_SCHED;
            PG8_LDA(At, 1, 1); PG8_STAGE_B(PG8_SB(1, 0), b3); PG8_STAGE_B(PG8_SB(1, 1), b3 + hstepB); PG8_STAGE_A(PG8_SA(1, 0), a3, 0, last);
            PG8_WAIT_V(8); PG8_WAIT_L(0); PG8_BAR; PG8_MMA(1, 0, At, B0); PG8_MMA(1, 1, At, B1); PG8_BAR; PG8_SCHED;
        }
        if constexpr (ALIGN_EPI) { if (wr == 0) PG8_BAR; }
        E(acc, cur, wr, wc, fr, fq);
        if (!has_next) break;
#pragma unroll
        for (int a = 0; a < 2; ++a)
#pragma unroll
            for (int b = 0; b < 2; ++b)
#pragma unroll
                for (int m = 0; m < 4; ++m)
#pragma unroll
                    for (int n = 0; n < 2; ++n) acc[a][b][m][n] = (f32x4){0.f, 0.f, 0.f, 0.f};
        cur = nxt; cA = nA; cB = nB; ++ui;
        if constexpr (GATHER) {
#pragma unroll
            for (int _h = 0; _h < 2; ++_h)
#pragma unroll
                for (int _i = 0; _i < 2; ++_i) gA[_h][_i] = gN[_h][_i]; }
        if constexpr (ALIGN_EPI) { if (wr == 1) PG8_BAR; }
    }
    PG8_WAIT_V(0);
    if constexpr (!ALIGN_EPI) { if (wr == 0) PG8_BAR; }
    PG8_BAR;
#undef PG8_SA
#undef PG8_SB
#undef PG8_GLDS
#undef PG8_STAGE_A
#undef PG8_STAGE_B
#undef PG8_LDA
#undef PG8_LDB
#undef PG8_MMA
#undef PG8_WAIT_V
#undef PG8_WAIT_L
#undef PG8_BAR
#undef PG8_SCHED
#undef PG8_GOFF
}
}

typedef float f32x4_t __attribute__((ext_vector_type(4)));
__device__ __forceinline__ int inproj_row(int j) {
    if (j < 512) { const int h = j >> 6, d = j & 63; return h * 64 + 2 * (d & 31) + (d >> 5); }
    if (j < 1280) { const int seg = (j - 512) >> 7, cc = (j - 512) & 127; int col = cc; if (seg == 2 || seg == 4) { const int g = cc >> 6, d = cc & 63; col = g * 64 + 2 * (d & 31) + (d >> 5); } return (2 + (seg >> 1)) * 256 + (seg & 1) * 128 + col; }
    if (j < 1304) return 11 * 256 + (j - 1280);
    if (j < 1560) return 5 * 256 + (j - 1304);
    if (j < 1816) return 6 * 256 + (j - 1560);
    if (j < 2328) return 7 * 256 + (j - 1816);
    if (j < 2344) return 11 * 256 + 32 + (j - 2328);
    if (j < 2856) return 9 * 256 + (j - 2344);
    if (j < 3880) return 12 * 256 + (j - 2856);
    return 16 * 256 + (j - 3880);
}
__device__ __forceinline__ unsigned pk2(float lo, float hi) { return (unsigned)f2bf(lo) | ((unsigned)f2bf(hi) << 16); }
template <class RM>
__device__ __forceinline__ void transpose_item(const float* W, int ldw, int N, bf16* WT, int ldt, float* scr, int k0, int n0, int lane, RM rm) {
    const int rr = lane >> 4, c4 = (lane & 15) * 4; const bool inb = n0 + c4 < N;
    f32x4_t v[16];
#pragma unroll
    for (int i = 0; i < 16; ++i) v[i] = inb ? *(const f32x4_t*)(W + (size_t)(k0 + 4 * i + rr) * ldw + n0 + c4) : (f32x4_t){0.f, 0.f, 0.f, 0.f};
#pragma unroll
    for (int i = 0; i < 16; ++i) *(f32x4_t*)(scr + (4 * i + rr) * 68 + c4) = v[i];
    asm volatile("s_waitcnt lgkmcnt(0)" ::: "memory");
    const int c = lane & 7;
#pragma unroll
    for (int j = 0; j < 8; ++j) { const int n = (lane >> 3) + 8 * j; const float* s = scr + (8 * c) * 68 + n;
        uint4 o; o.x = pk2(s[0 * 68], s[1 * 68]); o.y = pk2(s[2 * 68], s[3 * 68]); o.z = pk2(s[4 * 68], s[5 * 68]); o.w = pk2(s[6 * 68], s[7 * 68]);
        const int row = (n0 + n < N) ? rm(n0 + n) : -1;
        if (row >= 0) *(uint4*)(WT + (size_t)row * ldt + k0 + 8 * c) = o; }
    asm volatile("s_waitcnt lgkmcnt(0)" ::: "memory");
}
constexpr int PREP_I_WIN = 16 * 77, PREP_I_C1 = 4 * 64, PREP_I_PN = 128, PREP_I_PG = 128, PREP_I_WO = 256, PREP_I_EXP = 3 * 32 * 128;
constexpr int PREP_ITEMS = PREP_I_WIN + PREP_I_C1 + PREP_I_PN + PREP_I_PG + PREP_I_WO + PREP_I_EXP;
__device__ __forceinline__ void prep_item(const P& p, int it, float* scr, int lane) {
    if (it < PREP_I_WIN) { const int kb = it / 77, nb = it % 77; transpose_item(p.w_in, INW, INW, p.Wt_in, 1024, scr, kb * 64, nb * 64, lane, [](int n) { return inproj_row(n); }); return; }
    it -= PREP_I_WIN;
    if (it < PREP_I_C1) { const int mat = it >> 6, r = it & 63, kb = r >> 2, nb = r & 3, kv = mat >> 1, half = mat & 1;
        const float* W = (kv ? p.cw1_v : p.cw1_k) + (size_t)half * 1024 * 256;
        transpose_item(W, 256, 256, p.Wc1 + (size_t)kv * 512 * 1024, 1024, scr, kb * 64, nb * 64, lane, [half](int n) { return half * 256 + n; }); return; }
    it -= PREP_I_C1;
    if (it < PREP_I_PN) { transpose_item(p.w_pn, 1024, 1024, p.Wpn, 512, scr, (it >> 4) * 64, (it & 15) * 64, lane, [](int n) { return n; }); return; }
    it -= PREP_I_PN;
    if (it < PREP_I_PG) { transpose_item(p.w_pg, 1024, 1024, p.Wpg, 512, scr, (it >> 4) * 64, (it & 15) * 64, lane, [](int n) { return n; }); return; }
    it -= PREP_I_PG;
    if (it < PREP_I_WO) { transpose_item(p.w_out, 1024, 1024, p.Wo, 1024, scr, (it >> 4) * 64, (it & 15) * 64, lane, [](int n) { return n; }); return; }
    it -= PREP_I_WO;
    { const int which = it / (32 * 128), r = it % (32 * 128), e = r >> 7, r2 = r & 127;
        if (which == 0) transpose_item(p.w_gate + (size_t)e * 1024 * 512, 512, 512, p.Wgu + (size_t)e * 1024 * 1024, 1024, scr, (r2 >> 3) * 64, (r2 & 7) * 64, lane, [](int n) { return (n >> 7) * 256 + (n & 127); });
        else if (which == 1) transpose_item(p.w_up + (size_t)e * 1024 * 512, 512, 512, p.Wgu + (size_t)e * 1024 * 1024, 1024, scr, (r2 >> 3) * 64, (r2 & 7) * 64, lane, [](int n) { return (n >> 7) * 256 + 128 + (n & 127); });
        else transpose_item(p.w_down + (size_t)e * 512 * 1024, 1024, 1024, p.Wd + (size_t)e * 1024 * 512, 512, scr, (r2 >> 4) * 64, (r2 & 15) * 64, lane, [](int n) { return n; }); }
}
__device__ __forceinline__ void phase_prep_(const P& p, char* smem);
__device__ __forceinline__ void prep_b1p(const P& p, char* smem);
__device__ __forceinline__ void phase_prep(const P& p, char* smem) { prep_b1p(p, smem); phase_prep_(p, smem); }
__device__ __forceinline__ void phase_prep_(const P& p, char* smem) {
    const int wave = TIDX() >> 6, lane = TIDX() & 63;
    float* scr = (float*)smem + wave * (64 * 68);
    const int gw = blockIdx.x * 8 + wave, NGW = gridDim.x * 8;
    for (int it = gw; it < PREP_ITEMS; it += NGW) prep_item(p, it, scr, lane);
    for (int i = blockIdx.x * NT + TIDX(); i < 216 * 128; i += gridDim.x * NT) { int r = i >> 7; r = r < 8 ? 24 + r : 40 + r; *(uint4*)(p.Wt_in + (size_t)(11 * 256 + r) * 1024 + (i & 127) * 8) = make_uint4(0, 0, 0, 0); }
    for (int i = blockIdx.x * NT + TIDX(); i < 36 * 1024; i += gridDim.x * NT) { const int o = i >> 10, k = i & 1023; p.wr[i] = o < 4 ? p.w_grp[k * 4 + o] : p.w_exp[k * 32 + (o - 4)]; }
    for (int vb = blockIdx.x; vb < p.T / 8; vb += gridDim.x) body_rms(p, vb);
    for (int vb = blockIdx.x; vb < p.T * 32 / NT; vb += gridDim.x) body_cs(p, vb);
}

struct EpiInA {
    static constexpr bool PERM = true;
    P p;
    __device__ __forceinline__ static void rope4(const float* cs, int t, int i0, const pg8::f32x4& v0, const pg8::f32x4& v1, float sc, pg8::u32x2& lo, pg8::u32x2& hi) {
        const f32x4_t c = *(const f32x4_t*)(cs + (size_t)t * 64 + i0), s = *(const f32x4_t*)(cs + (size_t)t * 64 + 32 + i0);
        const float a0 = (v0[0] * c[0] - v0[1] * s[0]) * sc, b0 = (v0[1] * c[0] + v0[0] * s[0]) * sc;
        const float a1 = (v0[2] * c[1] - v0[3] * s[1]) * sc, b1 = (v0[3] * c[1] + v0[2] * s[1]) * sc;
        const float a2 = (v1[0] * c[2] - v1[1] * s[2]) * sc, b2 = (v1[1] * c[2] + v1[0] * s[2]) * sc;
        const float a3 = (v1[2] * c[3] - v1[3] * s[3]) * sc, b3 = (v1[3] * c[3] + v1[2] * s[3]) * sc;
        lo.x = pk2(a0, a1); lo.y = pk2(a2, a3); hi.x = pk2(b0, b1); hi.y = pk2(b2, b3);
    }
    __device__ __forceinline__ static pg8::u32x4 pack8(const pg8::f32x4& v0, const pg8::f32x4& v1) { pg8::u32x4 w; w.x = pk2(v0[0], v0[1]); w.y = pk2(v0[2], v0[3]); w.z = pk2(v1[0], v1[1]); w.w = pk2(v1[2], v1[3]); return w; }
    __device__ __forceinline__ void operator()(const pg8::f32x4 (&acc)[2][2][4][2], const pg8::Unit& u, int wr, int wc, int fr, int fq) const {
        const int pn = u.pn, c8 = wc * 32 + 8 * fq; const size_t seg = kvseg(p);
#pragma unroll
        for (int ai = 0; ai < 2; ++ai)
#pragma unroll
            for (int m = 0; m < 4; ++m) {
                const int t = u.pm * 256 + ai * 128 + wr * 64 + m * 16 + fr; const int b = t / S, s = t % S;
#pragma unroll
                for (int bj = 0; bj < 2; ++bj) {
                    const pg8::f32x4 v0 = acc[ai][bj][m][0], v1 = acc[ai][bj][m][1];
                    if (pn <= 1) {
                        const int cq = pn * 256 + bj * 128 + c8, h = cq >> 6, i0 = (cq & 63) >> 1; pg8::u32x2 lo, hi;
                        rope4(p.cs, t, i0, v0, v1, 0.125f, lo, hi);
                        bf16* dst = p.q + (size_t)t * 512 + h * 64 + i0; *(pg8::u32x2*)dst = lo; *(pg8::u32x2*)(dst + 32) = hi;
                    } else if (pn <= 4) {
                        const int sgi = (pn - 2) * 2 + bj, g = c8 >> 6; bf16* base = p.kv6 + (size_t)sgi * seg + ((size_t)(b * 2 + g) * S + s) * 64;
                        if (bj == 0 && pn >= 3) { const int i0 = (c8 & 63) >> 1; pg8::u32x2 lo, hi; rope4(p.cs, t, i0, v0, v1, 1.f, lo, hi); *(pg8::u32x2*)(base + i0) = lo; *(pg8::u32x2*)(base + 32 + i0) = hi; }
                        else *(pg8::u32x4*)(base + (c8 & 63)) = pack8(v0, v1);
                    } else if (pn == 5) { *(pg8::u32x4*)(p.gq + (size_t)t * 256 + bj * 128 + c8) = pack8(v0 * 0.125f, v1 * 0.125f);
                    } else if (pn == 6) { *(pg8::u32x4*)(p.gk + (size_t)t * 256 + bj * 128 + c8) = pack8(v0, v1);
                    } else if (pn <= 8) { *(pg8::u32x4*)(p.gv + (size_t)t * 512 + (pn - 7) * 256 + bj * 128 + c8) = pack8(v0, v1);
                    } else if (pn <= 10) {
                        pg8::f32x4 a, c;
#pragma unroll
                        for (int e = 0; e < 4; ++e) { a[e] = siluf_(v0[e]); c[e] = siluf_(v1[e]); }
                        *(pg8::u32x4*)(p.rs + (size_t)t * 512 + (pn - 9) * 256 + bj * 128 + c8) = pack8(a, c);
                    } else {
                        if (bj == 0) {
                            if (c8 < 24) { float* d = p.gates + (size_t)t * 24 + c8;
#pragma unroll
                                for (int e = 0; e < 4; ++e) { d[e] = sigmoidf_(v0[e]); d[4 + e] = sigmoidf_(v1[e]); } }
                            else if (c8 >= 32 && c8 < 48) { float* d = p.alow + (size_t)t * 16 + (c8 - 32);
#pragma unroll
                                for (int e = 0; e < 4; ++e) { d[e] = v0[e]; d[4 + e] = v1[e]; } }
                        }
                    }
                }
            }
    }
};
struct EpiSig {
    static constexpr bool PERM = true;
    bf16* sa; bf16* sb;
    __device__ __forceinline__ void operator()(const pg8::f32x4 (&acc)[2][2][4][2], const pg8::Unit& u, int wr, int wc, int fr, int fq) const {
        bf16* base = (u.pn < 4 ? sa : sb) + (u.pn & 3) * 256 + wc * 32 + 8 * fq;
#pragma unroll
        for (int ai = 0; ai < 2; ++ai)
#pragma unroll
            for (int m = 0; m < 4; ++m) { const int t = u.pm * 256 + ai * 128 + wr * 64 + m * 16 + fr;
#pragma unroll
                for (int bj = 0; bj < 2; ++bj) { pg8::f32x4 a, c;
#pragma unroll
                    for (int e = 0; e < 4; ++e) { a[e] = sigmoidf_(acc[ai][bj][m][0][e]); c[e] = sigmoidf_(acc[ai][bj][m][1][e]); }
                    *(pg8::u32x4*)(base + (size_t)t * 1024 + bj * 128) = EpiInA::pack8(a, c); } }
    }
};
__device__ __forceinline__ void phase_inA(const P& p, char* smem) {
    pg8::DenseSched S; S.init(p.u, p.Wt_in, p.T, 3072, 1024, 1024);
    EpiInA E{p};
    pg8::gemm_phase<EpiInA, pg8::DenseSched, true, false>((PG8_LAS unsigned char*)smem, 1024, 1024, 1024, S, E);
}
__device__ __forceinline__ void phase_inB(const P& p, char* smem) {
    pg8::DenseSched S; S.init(p.u, p.Wt_in + (size_t)3072 * 1024, p.T, 2048, 1024, 1024);
    EpiSig E{p.sa, p.sb};
    pg8::gemm_phase<EpiSig, pg8::DenseSched, true, false>((PG8_LAS unsigned char*)smem, 1024, 1024, 1024, S, E);
}

struct EpiProj {
    static constexpr bool PERM = true;
    const bf16* g; bf16* mixed; int pass;
    __device__ __forceinline__ void operator()(const pg8::f32x4 (&acc)[2][2][4][2], const pg8::Unit& u, int wr, int wc, int fr, int fq) const {
        const int col0 = u.pn * 256 + wc * 32 + 8 * fq;
#pragma unroll
        for (int ai = 0; ai < 2; ++ai)
#pragma unroll
            for (int m = 0; m < 4; ++m) { const size_t t = (size_t)(u.pm * 256 + ai * 128 + wr * 64 + m * 16 + fr);
#pragma unroll
                for (int bj = 0; bj < 2; ++bj) { const size_t off = t * 1024 + col0 + bj * 128;
                    const uint4 gv = *(const uint4*)(g + off); const unsigned gw[4] = {gv.x, gv.y, gv.z, gv.w};
                    float r[8];
#pragma unroll
                    for (int e = 0; e < 4; ++e) { const float a = e < 2 ? acc[ai][bj][m][0][2 * e] : acc[ai][bj][m][1][2 * e - 4], b = e < 2 ? acc[ai][bj][m][0][2 * e + 1] : acc[ai][bj][m][1][2 * e - 3];
                        r[2 * e] = __uint_as_float(gw[e] << 16) * a; r[2 * e + 1] = __uint_as_float(gw[e] & 0xffff0000u) * b; }
                    if (pass) { const uint4 mv = *(const uint4*)(mixed + off); const unsigned mw[4] = {mv.x, mv.y, mv.z, mv.w};
#pragma unroll
                        for (int e = 0; e < 4; ++e) { r[2 * e] += __uint_as_float(mw[e] << 16); r[2 * e + 1] += __uint_as_float(mw[e] & 0xffff0000u); } }
                    uint4 o; o.x = pk2(r[0], r[1]); o.y = pk2(r[2], r[3]); o.z = pk2(r[4], r[5]); o.w = pk2(r[6], r[7]);
                    *(uint4*)(mixed + off) = o; } }
    }
};
struct EpiOut {
    static constexpr bool PERM = false;
    const float* x; float* h1;
    __device__ __forceinline__ void operator()(const pg8::f32x4 (&acc)[2][2][4][2], const pg8::Unit& u, int wr, int wc, int fr, int fq) const {
        const int col0 = u.pn * 256 + wc * 32 + 4 * fq;
#pragma unroll
        for (int ai = 0; ai < 2; ++ai)
#pragma unroll
            for (int m = 0; m < 4; ++m) { const size_t off = (size_t)(u.pm * 256 + ai * 128 + wr * 64 + m * 16 + fr) * 1024 + col0;
#pragma unroll
                for (int bj = 0; bj < 2; ++bj)
#pragma unroll
                    for (int n = 0; n < 2; ++n) { const pg8::f32x4 xv = *(const pg8::f32x4*)(x + off + bj * 128 + n * 16); *(pg8::f32x4*)(h1 + off + bj * 128 + n * 16) = xv + acc[ai][bj][m][n]; } }
    }
};
__device__ __forceinline__ void phase_proj(const P& p, char* smem) {
    { pg8::DenseSched S; S.init(p.onsa, p.Wpn, p.T, 1024, 512, 512); EpiProj E{p.sa, p.mixed, 0};
      pg8::gemm_phase<EpiProj, pg8::DenseSched, true, false>((PG8_LAS unsigned char*)smem, 512, 512, 512, S, E); }
    { pg8::DenseSched S; S.init(p.gla, p.Wpg, p.T, 1024, 512, 512); EpiProj E{p.sb, p.mixed, 1};
      pg8::gemm_phase<EpiProj, pg8::DenseSched, true, false>((PG8_LAS unsigned char*)smem, 512, 512, 512, S, E); }
}
__device__ __forceinline__ void phase_out(const P& p, char* smem) {
    pg8::DenseSched S; S.init(p.mixed, p.Wo, p.T, 1024, 1024, 1024); EpiOut E{p.x, p.h1};
    pg8::gemm_phase<EpiOut, pg8::DenseSched, true, false>((PG8_LAS unsigned char*)smem, 1024, 1024, 1024, S, E);
}

struct ExpertSched {
    const int* ub;
    const int* sb_;
    const unsigned* cnt; const int* list; int T;
    const char* A; const char* B; int lda, ldb; size_t bstride;
    int npn, G, c; bool gather;
    __device__ __forceinline__ bool next(int i, pg8::Unit& u) const {
        const int L = i * G + c; if (L >= ub[NEXP]) return false;
        int e = 0; while (L >= ub[e + 1]) ++e;
        const int rem = L - ub[e], tiles = (ub[e + 1] - ub[e]) / npn, pn = rem / tiles, pml = rem % tiles;
        u.pm = sb_[e] / 256 + pml; u.pn = pn; u.tag = e | (pml << 8);
        u.A = gather ? A : A + (size_t)u.pm * 256 * lda * 2; u.B = B + (size_t)e * bstride + (size_t)pn * 256 * ldb * 2; return true;
    }
    __device__ __forceinline__ unsigned arow(const pg8::Unit& u, int r) const {
        const int e = u.tag & 255, sl = (u.tag >> 8) * 256 + r; const int tok = list[(size_t)e * T + (sl < (int)cnt[e * 32] ? sl : 0)];
        return (unsigned)tok * (unsigned)lda * 2u;
    }
};
__device__ __forceinline__ void expert_tables(const P& p, char* smem, int npn, int*& ub, int*& sb_) {
    ub = (int*)(smem + LDS_MISC + 1024); sb_ = ub + 40;
    __syncthreads();
    if (TIDX() == 0) { int ua = 0, sa = 0; for (int e = 0; e < NEXP; ++e) { ub[e] = ua; sb_[e] = sa; const int tl = ((int)p.ctl[e * 32] + 255) >> 8; ua += tl * npn; sa += tl * 256; } ub[NEXP] = ua; sb_[NEXP] = sa; }
    __syncthreads();
}
struct EpiMoe1 {
    static constexpr bool PERM = true;
    bf16* H;
    __device__ __forceinline__ void operator()(const pg8::f32x4 (&acc)[2][2][4][2], const pg8::Unit& u, int wr, int wc, int fr, int fq) const {
        const int col0 = u.pn * 128 + wc * 32 + 8 * fq;
#pragma unroll
        for (int ai = 0; ai < 2; ++ai)
#pragma unroll
            for (int m = 0; m < 4; ++m) { const size_t row = (size_t)(u.pm * 256 + ai * 128 + wr * 64 + m * 16 + fr);
                pg8::f32x4 a, b;
#pragma unroll
                for (int e = 0; e < 4; ++e) { a[e] = siluf_(acc[ai][0][m][0][e]) * acc[ai][1][m][0][e]; b[e] = siluf_(acc[ai][0][m][1][e]) * acc[ai][1][m][1][e]; }
                *(pg8::u32x4*)(H + row * 512 + col0) = EpiInA::pack8(a, b); }
    }
};
struct EpiMoe2 {
    static constexpr bool PERM = true;
    bf16* Y;
    __device__ __forceinline__ void operator()(const pg8::f32x4 (&acc)[2][2][4][2], const pg8::Unit& u, int wr, int wc, int fr, int fq) const {
        const int col0 = u.pn * 256 + wc * 32 + 8 * fq;
#pragma unroll
        for (int ai = 0; ai < 2; ++ai)
#pragma unroll
            for (int m = 0; m < 4; ++m) { const size_t row = (size_t)(u.pm * 256 + ai * 128 + wr * 64 + m * 16 + fr);
#pragma unroll
                for (int bj = 0; bj < 2; ++bj) *(pg8::u32x4*)(Y + row * 1024 + col0 + bj * 128) = EpiInA::pack8(acc[ai][bj][m][0], acc[ai][bj][m][1]); }
    }
};
__device__ __forceinline__ void phase_moe1(const P& p, char* smem) {
    int *ub, *sb_; expert_tables(p, smem, 4, ub, sb_);
    ExpertSched S{ub, sb_, p.ctl, p.list, p.T, (const char*)p.vb, (const char*)p.Wgu, 1024, 1024, (size_t)1024 * 1024 * 2, 4, (int)gridDim.x, (int)blockIdx.x, true};
    EpiMoe1 E{p.H};
    pg8::gemm_phase<EpiMoe1, ExpertSched, true, true>((PG8_LAS unsigned char*)smem, 1024, 1024, 1024, S, E);
}
__device__ __forceinline__ void phase_moe2(const P& p, char* smem) {
    int *ub, *sb_; expert_tables(p, smem, 4, ub, sb_);
    ExpertSched S{ub, sb_, p.ctl, p.list, p.T, (const char*)p.H, (const char*)p.Wd, 512, 512, (size_t)1024 * 512 * 2, 4, (int)gridDim.x, (int)blockIdx.x, false};
    EpiMoe2 E{p.Y};
    pg8::gemm_phase<EpiMoe2, ExpertSched, true, false>((PG8_LAS unsigned char*)smem, 512, 512, 512, S, E);
}

namespace nsa {
using f32x16 = __attribute__((ext_vector_type(16))) float;
using bf16x8 = __attribute__((ext_vector_type(8))) short;
using s16x4 = __attribute__((ext_vector_type(4))) short;
using u32x4 = __attribute__((ext_vector_type(4))) unsigned;
typedef __attribute__((address_space(3))) char* lptr;
typedef __attribute__((address_space(3))) const char* lcptr;
constexpr int SLOT = 8192;
constexpr int NSLOT = 3;
constexpr int L_K = 0, L_V = NSLOT * SLOT, L_WS = 2 * NSLOT * SLOT, L_OST = L_WS + 8 * 512, L_IMPD = L_OST + 8 * 4096, L_IMPC = L_IMPD + 64 * 64 * 4, L_SEL = L_IMPC + 64 * 68 * 4, L_END = L_SEL + 64 * 8;
constexpr float LOG2E = 1.4426950408889634f, NEGM = -1e30f, M0 = -1e20f, THR = 8.f;
__device__ __forceinline__ int crow(int r, int hi) { return (r & 3) + 8 * (r >> 2) + 4 * hi; }
__device__ __forceinline__ void glds16(const void* gsrc, unsigned lds_dst) { unsigned keep;
    asm volatile("s_mov_b32 %0, m0\n\ts_mov_b32 m0, %2\n\ts_nop 0\n\tglobal_load_lds_dwordx4 %1, off\n\ts_mov_b32 m0, %0" : "=&s"(keep) : "v"(gsrc), "s"(lds_dst) : "memory"); }
#define NSA_WAIT_BAR() asm volatile("s_waitcnt vmcnt(2) lgkmcnt(0)\n\ts_barrier" ::: "memory")
#define NSA_DRAIN_BAR() asm volatile("s_waitcnt vmcnt(0) lgkmcnt(0)\n\ts_barrier" ::: "memory")
#define NSA_LWAIT() asm volatile("s_waitcnt lgkmcnt(0)" ::: "memory")
__device__ __forceinline__ unsigned cvtpk(float lo, float hi) { typedef float f2 __attribute__((ext_vector_type(2))); typedef __bf16 b2 __attribute__((ext_vector_type(2))); f2 v = {lo, hi}; b2 b = __builtin_convertvector(v, b2); return __builtin_bit_cast(unsigned, b); }
__device__ __forceinline__ float xhalf_max(float m) { auto rr = __builtin_amdgcn_permlane32_swap(__float_as_uint(m), __float_as_uint(m), false, false); return fmaxf(__uint_as_float(rr[0]), __uint_as_float(rr[1])); }
__device__ __forceinline__ float xhalf_sum(float m) { auto rr = __builtin_amdgcn_permlane32_swap(__float_as_uint(m), __float_as_uint(m), false, false); return __uint_as_float(rr[0]) + __uint_as_float(rr[1]); }
__device__ __forceinline__ void qkt(f32x16& p0, f32x16& p1, lcptr Kslot, const bf16x8* qr, int r32, int hi) {
    lcptr kb = Kslot + hi * 1024 + r32 * 16;
    p0 = f32x16{}; p1 = f32x16{};
#pragma unroll
    for (int d0 = 0; d0 < 4; ++d0) {
        const bf16x8 b0 = *(const __attribute__((address_space(3))) bf16x8*)(kb + d0 * 2048);
        const bf16x8 b1 = *(const __attribute__((address_space(3))) bf16x8*)(kb + d0 * 2048 + 512);
        p0 = __builtin_amdgcn_mfma_f32_32x32x16_bf16(b0, qr[d0], p0, 0, 0, 0); p1 = __builtin_amdgcn_mfma_f32_32x32x16_bf16(b1, qr[d0], p1, 0, 0, 0); }
}
__device__ __forceinline__ void pv(f32x16* o, int vb, bf16x8 pa0, bf16x8 pa1, bf16x8 pa2, bf16x8 pa3) {
#pragma unroll
    for (int d0 = 0; d0 < 2; ++d0) { s16x4 lo[4], hi[4];
#pragma unroll
        for (int ks = 0; ks < 4; ++ks) {
            asm volatile("ds_read_b64_tr_b16 %0,%1 offset:%c2" : "=&v"(lo[ks]) : "v"(vb), "i"(d0 * 4096 + ks * 1024) : "memory");
            asm volatile("ds_read_b64_tr_b16 %0,%1 offset:%c2" : "=&v"(hi[ks]) : "v"(vb), "i"(d0 * 4096 + ks * 1024 + 512) : "memory"); }
        asm volatile("s_waitcnt lgkmcnt(0)" ::: "memory"); __builtin_amdgcn_sched_barrier(0);
#define NSA_PK(k) (bf16x8){lo[k][0], lo[k][1], lo[k][2], lo[k][3], hi[k][0], hi[k][1], hi[k][2], hi[k][3]}
        o[d0] = __builtin_amdgcn_mfma_f32_32x32x16_bf16(pa0, NSA_PK(0), o[d0], 0, 0, 0);
        o[d0] = __builtin_amdgcn_mfma_f32_32x32x16_bf16(pa1, NSA_PK(1), o[d0], 0, 0, 0);
        o[d0] = __builtin_amdgcn_mfma_f32_32x32x16_bf16(pa2, NSA_PK(2), o[d0], 0, 0, 0);
        o[d0] = __builtin_amdgcn_mfma_f32_32x32x16_bf16(pa3, NSA_PK(3), o[d0], 0, 0, 0);
#undef NSA_PK
    }
}
__device__ __forceinline__ float rowmax32(const f32x16& p0, const f32x16& p1) {
    float a = fmaxf(p0[0], p1[0]);
#pragma unroll
    for (int r = 1; r < 16; ++r) a = fmaxf(a, fmaxf(p0[r], p1[r]));
    return xhalf_max(a);
}
struct Ctx {
    int w, lane, r32, hi, rs; unsigned lds0; lptr shm; const bf16* kt; const bf16* vt;
};
__device__ __forceinline__ void dma_kv(const Ctx& c, int tile, int slot) {
    const bf16* ksrc = c.kt + (size_t)tile * 64 * 64 + c.lane * 64 + c.w * 8;
    const bf16* vsrc = c.vt + (size_t)tile * 64 * 64 + (16 * (c.w & 3) + (c.lane >> 2)) * 64 + (c.w >> 2) * 32 + (c.lane & 3) * 8;
    glds16(ksrc, (unsigned)__builtin_amdgcn_readfirstlane(c.lds0 + L_K + slot * SLOT + c.w * 1024));
    glds16(vsrc, (unsigned)__builtin_amdgcn_readfirstlane(c.lds0 + L_V + slot * SLOT + c.w * 1024));
}
template <int ABL = 0> __device__ __forceinline__ void ring_begin(Ctx& c, int t0, int t1) { NSA_DRAIN_BAR(); if (!(ABL & 8)) { dma_kv(c, t0, 0); dma_kv(c, t1 >= 0 ? t1 : t0, 1); } c.rs = 0; }
template <int ABL = 0> __device__ __forceinline__ void ring_step(Ctx& c, int t2, int tcur) { if (!(ABL & 16)) NSA_WAIT_BAR(); int s2 = c.rs + 2; if (s2 >= NSLOT) s2 -= NSLOT; if (!(ABL & 8)) dma_kv(c, t2 >= 0 ? t2 : tcur, s2); }
__device__ __forceinline__ void ring_next(Ctx& c) { c.rs = (c.rs == NSLOT - 1) ? 0 : c.rs + 1; }
template <int ABL> __device__ __forceinline__ void softmax_pv(const Ctx& c, f32x16& p0, f32x16& p1, f32x16* o, float& m, float& l, int slot, bool on) {
    float a0 = fmaxf(fmaxf(p0[0], p0[1]), p1[0]), a1 = fmaxf(fmaxf(p0[2], p0[3]), p1[1]), a2 = fmaxf(fmaxf(p0[4], p0[5]), p1[2]), a3 = fmaxf(fmaxf(p0[6], p0[7]), p1[3]);
    a0 = fmaxf(fmaxf(a0, p0[8]), p0[9]); a1 = fmaxf(fmaxf(a1, p0[10]), p0[11]); a2 = fmaxf(fmaxf(a2, p0[12]), p0[13]); a3 = fmaxf(fmaxf(a3, p0[14]), p0[15]);
    a0 = fmaxf(fmaxf(a0, p1[4]), p1[5]); a1 = fmaxf(fmaxf(a1, p1[6]), p1[7]); a2 = fmaxf(fmaxf(a2, p1[8]), p1[9]); a3 = fmaxf(fmaxf(a3, p1[10]), p1[11]);
    a0 = fmaxf(fmaxf(a0, p1[12]), p1[13]); a1 = fmaxf(fmaxf(a1, p1[14]), p1[15]);
    float rm = xhalf_max(fmaxf(fmaxf(a0, a1), fmaxf(a2, a3)));
    rm = on ? rm : NEGM;
    volatile __attribute__((address_space(3))) float* wsf = (volatile __attribute__((address_space(3))) float*)(c.shm + L_WS + c.w * 512);
    bool resc = false;
    if (__any(rm > m + THR)) { const float mn = fmaxf(m, rm); const float f = __builtin_amdgcn_exp2f(m - mn); l *= f; m = mn; if (c.hi == 0) wsf[c.r32] = f; resc = true; }
    const float ms = on ? m : 1e30f;
    float s0 = 0.f, s1 = 0.f, s2 = 0.f, s3 = 0.f;
#pragma unroll
    for (int r = 0; r < 16; r += 2) {
        if (!(ABL & 2)) { p0[r] = __builtin_amdgcn_exp2f(p0[r] - ms); p0[r + 1] = __builtin_amdgcn_exp2f(p0[r + 1] - ms); p1[r] = __builtin_amdgcn_exp2f(p1[r] - ms); p1[r + 1] = __builtin_amdgcn_exp2f(p1[r + 1] - ms); }
        else { p0[r] -= ms; p0[r + 1] -= ms; p1[r] -= ms; p1[r + 1] -= ms; }
        s0 += p0[r]; s1 += p0[r + 1]; s2 += p1[r]; s3 += p1[r + 1]; }
    l += (s0 + s1) + (s2 + s3);
    if (resc) { NSA_LWAIT();
#pragma unroll
        for (int r = 0; r < 16; ++r) { const float f = wsf[crow(r, c.hi)]; o[0][r] *= f; o[1][r] *= f; } }
    u32x4 w0, w1, w2, w3;
    w0 = (u32x4){cvtpk(p0[0], p0[1]), cvtpk(p0[2], p0[3]), cvtpk(p0[4], p0[5]), cvtpk(p0[6], p0[7])};
    w1 = (u32x4){cvtpk(p0[8], p0[9]), cvtpk(p0[10], p0[11]), cvtpk(p0[12], p0[13]), cvtpk(p0[14], p0[15])};
    w2 = (u32x4){cvtpk(p1[0], p1[1]), cvtpk(p1[2], p1[3]), cvtpk(p1[4], p1[5]), cvtpk(p1[6], p1[7])};
    w3 = (u32x4){cvtpk(p1[8], p1[9]), cvtpk(p1[10], p1[11]), cvtpk(p1[12], p1[13]), cvtpk(p1[14], p1[15])};
    const int vb = (int)(c.lds0 + L_V + slot * SLOT) + ((c.lane >> 4) & 1) * 32 + (c.lane & 3) * 8 + (4 * c.hi + ((c.lane & 15) >> 2)) * 64;
    if (!(ABL & 1)) pv(o, vb, __builtin_bit_cast(bf16x8, w0), __builtin_bit_cast(bf16x8, w1), __builtin_bit_cast(bf16x8, w2), __builtin_bit_cast(bf16x8, w3));
    else { asm volatile("" :: "v"(w0), "v"(w1), "v"(w2), "v"(w3)); }
}
__device__ __forceinline__ void accum_branch(const Ctx& c, f32x16* oacc, const f32x16* o, float fac) {
    volatile __attribute__((address_space(3))) float* wsf = (volatile __attribute__((address_space(3))) float*)(c.shm + L_WS + c.w * 512);
    NSA_LWAIT(); if (c.hi == 0) wsf[64 + c.r32] = fac; NSA_LWAIT();
#pragma unroll
    for (int r = 0; r < 16; ++r) { const float f = wsf[64 + crow(r, c.hi)]; oacc[0][r] += o[0][r] * f; oacc[1][r] += o[1][r] * f; }
    NSA_LWAIT();
}
template <int ABL> __device__ __forceinline__ void nsa_unit(const P& p, char* smem, int b, int g, int jq) {
    const int tid = TIDX(); Ctx c; c.lane = tid & 63; c.w = __builtin_amdgcn_readfirstlane(tid >> 6); c.r32 = c.lane & 31; c.hi = c.lane >> 5;
    c.shm = (lptr)smem; c.lds0 = (unsigned)(size_t)c.shm;
    const int hh = c.r32 >> 3, tokl = 8 * c.w + (c.r32 & 7), stok = 64 * jq + tokl, h = g * 4 + hh; const size_t t = (size_t)b * S + stok;
    const size_t seg = kvseg(p), ho = (size_t)(b * 2 + g) * S * 64;
    bf16x8 qr[4];
#pragma unroll
    for (int d0 = 0; d0 < 4; ++d0) { const u32x4 raw = *(const u32x4*)(p.q + t * 512 + h * 64 + d0 * 16 + c.hi * 8); u32x4 sc;
#pragma unroll
        for (int e4 = 0; e4 < 4; ++e4) sc[e4] = cvtpk(__uint_as_float(raw[e4] << 16) * LOG2E, __uint_as_float(raw[e4] & 0xffff0000u) * LOG2E);
        qr[d0] = __builtin_bit_cast(bf16x8, sc); }
    const float g0 = p.gates[t * 24 + h * 3], g1 = p.gates[t * 24 + h * 3 + 1], g2 = p.gates[t * 24 + h * 3 + 2];
    f32x16 oacc[2], o[2], p0, p1; oacc[0] = f32x16{}; oacc[1] = f32x16{};
    __attribute__((address_space(3))) float* impD = (__attribute__((address_space(3))) float*)(c.shm + L_IMPD);
    __attribute__((address_space(3))) float* impC = (__attribute__((address_space(3))) float*)(c.shm + L_IMPC);
    __attribute__((address_space(3))) u64* selm = (__attribute__((address_space(3))) u64*)(c.shm + L_SEL);
    const int nv = stok >= 31 ? (stok - 31) / 16 + 1 : 0;
    const int nct = (4 * jq + 3 + 63) >> 6;
    c.kt = p.kcmp + (size_t)(b * 2 + g) * 256 * 64; c.vt = p.vcmp + (size_t)(b * 2 + g) * 256 * 64;
    float m = M0, l = 0.f;
    if (tid < 64) impC[tid * 68] = 0.f;
    ring_begin(c, 0, nct > 1 ? 1 : -1);
    for (int ct = 0; ct < ((ABL & 64) ? 0 : nct); ++ct) {
        ring_step(c, ct + 2 < nct ? ct + 2 : -1, ct);
        qkt(p0, p1, (lcptr)(c.shm + L_K + c.rs * SLOT), qr, c.r32, c.hi); ring_next(c);
#pragma unroll
        for (int r = 0; r < 16; ++r) { const int n = 64 * ct + crow(r, c.hi); p0[r] = n < nv ? p0[r] : NEGM; p1[r] = n + 32 < nv ? p1[r] : NEGM; }
        const float rm = rowmax32(p0, p1); const float mn = fmaxf(m, rm); float sacc = 0.f;
#pragma unroll
        for (int r = 0; r < 16; ++r) sacc += __builtin_amdgcn_exp2f(p0[r] - mn) + __builtin_amdgcn_exp2f(p1[r] - mn);
        l = l * __builtin_amdgcn_exp2f(m - mn) + sacc; m = mn;
    }
    l = xhalf_sum(l); const float il = l > 0.f ? 1.f / l : 0.f;
    o[0] = f32x16{}; o[1] = f32x16{};
    ring_begin(c, 0, nct > 1 ? 1 : -1);
    for (int ct = 0; ct < ((ABL & 64) ? 0 : nct); ++ct) {
        ring_step(c, ct + 2 < nct ? ct + 2 : -1, ct);
        qkt(p0, p1, (lcptr)(c.shm + L_K + c.rs * SLOT), qr, c.r32, c.hi);
#pragma unroll
        for (int r = 0; r < 16; ++r) { const int n = 64 * ct + crow(r, c.hi); p0[r] = n < nv ? __builtin_amdgcn_exp2f(p0[r] - m) * il : 0.f; p1[r] = n + 32 < nv ? __builtin_amdgcn_exp2f(p1[r] - m) * il : 0.f; }
#pragma unroll
        for (int hb = 0; hb < 2; ++hb)
#pragma unroll
            for (int rg = 0; rg < 4; ++rg) {
                const f32x16& pp = hb ? p1 : p0;
                float dsum = pp[4 * rg] + pp[4 * rg + 1] + pp[4 * rg + 2] + 0.5f * pp[4 * rg + 3], csum = 0.5f * pp[4 * rg + 3];
                dsum += __shfl_xor(dsum, 8); dsum += __shfl_xor(dsum, 16); csum += __shfl_xor(csum, 8); csum += __shfl_xor(csum, 16);
                const int j = 16 * ct + 8 * hb + 2 * rg + c.hi;
                if (c.r32 < 8) { impD[tokl * 64 + j] = dsum; impC[tokl * 68 + j + 1] = csum; }
            }
        u32x4 w0, w1, w2, w3;
        w0 = (u32x4){cvtpk(p0[0], p0[1]), cvtpk(p0[2], p0[3]), cvtpk(p0[4], p0[5]), cvtpk(p0[6], p0[7])};
        w1 = (u32x4){cvtpk(p0[8], p0[9]), cvtpk(p0[10], p0[11]), cvtpk(p0[12], p0[13]), cvtpk(p0[14], p0[15])};
        w2 = (u32x4){cvtpk(p1[0], p1[1]), cvtpk(p1[2], p1[3]), cvtpk(p1[4], p1[5]), cvtpk(p1[6], p1[7])};
        w3 = (u32x4){cvtpk(p1[8], p1[9]), cvtpk(p1[10], p1[11]), cvtpk(p1[12], p1[13]), cvtpk(p1[14], p1[15])};
        const int vb = (int)(c.lds0 + L_V + c.rs * SLOT) + ((c.lane >> 4) & 1) * 32 + (c.lane & 3) * 8 + (4 * c.hi + ((c.lane & 15) >> 2)) * 64;
        pv(o, vb, __builtin_bit_cast(bf16x8, w0), __builtin_bit_cast(bf16x8, w1), __builtin_bit_cast(bf16x8, w2), __builtin_bit_cast(bf16x8, w3));
        ring_next(c);
    }
    accum_branch(c, oacc, o, g0);
    NSA_LWAIT(); __builtin_amdgcn_s_barrier();
    {
#pragma unroll 1
        for (int tkk = 0; tkk < 8; ++tkk) { const int tk = 8 * c.w + tkk, j = c.lane; const bool valid = j <= jq;
            const float sc = (j == 0 || j == jq || j == jq - 1) ? 1e4f : impD[tk * 64 + j] + impC[tk * 68 + j];
            const unsigned key = valid ? ((__float_as_uint(sc) & ~63u) | (unsigned)(63 - j)) : 0u;
            int rank = 0;
            if (!(ABL & 32)) {
#pragma unroll
                for (int i = 0; i < 64; ++i) { const unsigned ki = (unsigned)__builtin_amdgcn_readlane((int)key, i); rank += (ki > key) ? 1 : 0; } }
            const u64 mk = __ballot(valid && rank < 16);
            if (j == 0) { selm[tk] = mk; p.sel[((size_t)b * S + 64 * jq + tk) * 2 + g] = mk; } }
    }
    NSA_LWAIT(); __builtin_amdgcn_s_barrier();
    const u64 mysel = selm[tokl];
    u64 uni = selm[c.lane];
#pragma unroll
    for (int x = 1; x < 64; x <<= 1) { const unsigned lo_ = __shfl_xor((unsigned)uni, x), hi_ = __shfl_xor((unsigned)(uni >> 32), x); uni |= (u64)lo_ | ((u64)hi_ << 32); }
    const unsigned ulo = __builtin_amdgcn_readfirstlane((unsigned)uni), uhi = __builtin_amdgcn_readfirstlane((unsigned)(uni >> 32));
    {
        c.kt = p.kv6 + 2 * seg + ho; c.vt = p.kv6 + 3 * seg + ho;
        u64 rem = (u64)ulo | ((u64)uhi << 32);
        m = M0; l = 0.f; o[0] = f32x16{}; o[1] = f32x16{};
        int j = __builtin_ctzll(rem); rem &= rem - 1;
        int j1 = rem ? __builtin_ctzll(rem) : -1; if (rem) rem &= rem - 1;
        ring_begin<ABL>(c, j, j1);
        for (;;) {
            const int j2 = rem ? __builtin_ctzll(rem) : -1; if (rem) rem &= rem - 1;
            ring_step<ABL>(c, j2, j);
            if (!(ABL & 4)) qkt(p0, p1, (lcptr)(c.shm + L_K + c.rs * SLOT), qr, c.r32, c.hi); else { asm volatile("" : "+v"(p0), "+v"(p1)); }
            const bool on = (mysel >> j) & 1ull;
            if (j == jq) {
#pragma unroll
                for (int r = 0; r < 16; ++r) { const int kr = crow(r, c.hi); p0[r] = (kr <= tokl) ? p0[r] : NEGM; p1[r] = (kr + 32 <= tokl) ? p1[r] : NEGM; } }
            softmax_pv<ABL>(c, p0, p1, o, m, l, c.rs, on); ring_next(c);
            if (j1 < 0) break; j = j1; j1 = j2;
        }
        l = xhalf_sum(l);
        accum_branch(c, oacc, o, g1 / l);
    }
    {
        c.kt = p.kv6 + 4 * seg + ho; c.vt = p.kv6 + 5 * seg + ho;
        const int j0 = jq >= 8 ? jq - 8 : 0;
        m = M0; l = 0.f; o[0] = f32x16{}; o[1] = f32x16{};
        ring_begin<ABL>(c, j0, j0 + 1 <= jq ? j0 + 1 : -1);
        for (int j = j0; j <= jq; ++j) {
            ring_step<ABL>(c, j + 2 <= jq ? j + 2 : -1, j);
            if (!(ABL & 4)) qkt(p0, p1, (lcptr)(c.shm + L_K + c.rs * SLOT), qr, c.r32, c.hi); else { asm volatile("" : "+v"(p0), "+v"(p1)); }
            const bool lowt = (jq >= 8 && j == jq - 8), diag = (j == jq);
            if (diag || lowt) {
#pragma unroll
                for (int r = 0; r < 16; ++r) { const int kr = crow(r, c.hi);
                    const bool v0 = diag ? (kr <= tokl) : (kr > tokl), v1 = diag ? (kr + 32 <= tokl) : (kr + 32 > tokl);
                    p0[r] = v0 ? p0[r] : NEGM; p1[r] = v1 ? p1[r] : NEGM; } }
            softmax_pv<ABL>(c, p0, p1, o, m, l, c.rs, true); ring_next(c);
        }
        l = xhalf_sum(l);
        accum_branch(c, oacc, o, g2 / l);
    }
    {
        __attribute__((address_space(3))) bf16* stg = (__attribute__((address_space(3))) bf16*)(c.shm + L_OST + c.w * 4096);
#pragma unroll
        for (int r = 0; r < 16; ++r) { const int orow = crow(r, c.hi);
#pragma unroll
            for (int d0 = 0; d0 < 2; ++d0) stg[orow * 64 + d0 * 32 + c.r32] = f2bf(oacc[d0][r]); }
        NSA_LWAIT();
#pragma unroll
        for (int i = 0; i < 4; ++i) { const int row = i * 8 + (c.lane >> 3), ch = c.lane & 7; const u32x4 v = *(const __attribute__((address_space(3))) u32x4*)(stg + row * 64 + ch * 8);
            const int rh = row >> 3, rt = 8 * c.w + (row & 7);
            *(u32x4*)(p.onsa + ((size_t)b * S + 64 * jq + rt) * 512 + (g * 4 + rh) * 64 + ch * 8) = v; }
    }
    NSA_DRAIN_BAR();
}
}
template <int ABL = 0> __device__ __forceinline__ void phase_nsa(const P& p, char* smem) {
    const int nunits = p.nb * 2 * 64;
    const int G = gridDim.x; int r = 0;
    for (int base = 0; base < nunits; base += G, ++r) {
        const int w = (r & 1) ? G - 1 - (int)blockIdx.x : (int)blockIdx.x, i = base + w; if (i >= nunits) continue;
        const int jq = 63 - i / (p.nb * 2), bg = i % (p.nb * 2); nsa::nsa_unit<ABL>(p, smem, bg >> 1, bg & 1, jq); }
}

namespace gla {
using nsa::f32x16; using nsa::bf16x8; using nsa::s16x4; using nsa::u32x4; using nsa::lptr; using nsa::lcptr; using nsa::crow; using nsa::cvtpk;
typedef unsigned u32x2 __attribute__((ext_vector_type(2)));
constexpr int L_KI = 0, L_QI = 8192, L_VI = 16384, L_SI = 32768, L_OST = 49152, L_TOT = L_OST + 64 * 132 * 4, L_END = L_TOT + 8 * 64 * 4 + 64 * 4;
__device__ __forceinline__ int koff(int row, int d) { return (d >> 3) * 1024 + row * 16 + (d & 7) * 2; }
__device__ __forceinline__ int voff(int row, int col) { return ((col >> 5) * 4 + (row >> 4)) * 1024 + (row & 15) * 64 + (col & 31) * 2; }
__device__ __forceinline__ bf16x8 trfrag(unsigned img, int ks, int cb, int lane) {
    const int hi = lane >> 5; const unsigned a = img + (cb * 4 + ks) * 1024 + ((lane >> 4) & 1) * 32 + (lane & 3) * 8 + (4 * hi + ((lane & 15) >> 2)) * 64;
    s16x4 lo, hh;
    asm volatile("ds_read_b64_tr_b16 %0,%1" : "=&v"(lo) : "v"(a) : "memory");
    asm volatile("ds_read_b64_tr_b16 %0,%1 offset:512" : "=&v"(hh) : "v"(a) : "memory");
    asm volatile("s_waitcnt lgkmcnt(0)" ::: "memory"); __builtin_amdgcn_sched_barrier(0);
    return (bf16x8){lo[0], lo[1], lo[2], lo[3], hh[0], hh[1], hh[2], hh[3]};
}
template <int GM> __device__ __forceinline__ void chunk_images(const P& p, lptr shm, int b, int h, int c, int tid) {
    const int d = tid & 63, tg = tid >> 6; const size_t t0 = (size_t)b * S + c * 64;
    __attribute__((address_space(3))) float* tot = (__attribute__((address_space(3))) float*)(shm + L_TOT);
    float wa[16];
#pragma unroll
    for (int r = 0; r < 16; ++r) wa[r] = p.w_a2[r * 256 + h * 64 + d];
    const float ba = p.b_a[h * 64 + d];
    float loc[8]; float run = 0.f;
#pragma unroll
    for (int i = 0; i < 8; ++i) { const float* al = p.alow + (t0 + tg * 8 + i) * 16; float z = ba;
#pragma unroll
        for (int r = 0; r < 16; ++r) z += al[r] * wa[r];
        const float ls = fminf(z, 0.f) - log1pf(__expf(-fabsf(z))); run += ls * (1.f / 16.f); loc[i] = run; }
    tot[tg * 64 + d] = run;
#pragma unroll
    for (int k = 0; k < 2; ++k) { const int idx = tid + k * 512, s = idx >> 4, e = (idx & 15) * 8; *(__attribute__((address_space(3))) u32x4*)(shm + L_VI + voff(s, e)) = *(const u32x4*)(p.gv + (t0 + s) * 512 + h * 128 + e); }
    __syncthreads();
    float pre = 0.f, all = 0.f;
#pragma unroll
    for (int g = 0; g < 8; ++g) { const float x = tot[g * 64 + d]; all += x; pre += g < tg ? x : 0.f; }
#pragma unroll
    for (int i = 0; i < 8; ++i) { const int t = tg * 8 + i; const float bb = pre + loc[i]; const float kk = bf2f(p.gk[(t0 + t) * 256 + h * 64 + d]);
        if (GM == 0) { *(__attribute__((address_space(3))) bf16*)(shm + L_KI + voff(t, d)) = f2bf(kk * __expf(all - bb)); }
        else { const float qq = bf2f(p.gq[(t0 + t) * 256 + h * 64 + d]);
            *(__attribute__((address_space(3))) bf16*)(shm + L_KI + koff(t, d)) = f2bf(kk * __expf(-bb)); *(__attribute__((address_space(3))) bf16*)(shm + L_QI + koff(t, d)) = f2bf(qq * __expf(bb)); } }
    if (GM == 0 && tg == 0) p.gdec[((size_t)(b * 4 + h) * 64 + c) * 64 + d] = __expf(all);
    __syncthreads();
}
__device__ __forceinline__ void g1_chunk(const P& p, char* smem, int b, int h, int c) {
    const int tid = TIDX(), lane = tid & 63, w = __builtin_amdgcn_readfirstlane(tid >> 6), r32 = lane & 31, hi = lane >> 5;
    lptr shm = (lptr)smem; const unsigned l0 = (unsigned)(size_t)shm;
    chunk_images<0>(p, shm, b, h, c, tid);
    const int db = w & 1, eb = w >> 1; f32x16 acc = f32x16{};
#pragma unroll
    for (int ks = 0; ks < 4; ++ks) { const bf16x8 a = trfrag(l0 + L_KI, ks, db, lane), bq = trfrag(l0 + L_VI, ks, eb, lane); acc = __builtin_amdgcn_mfma_f32_32x32x16_bf16(a, bq, acc, 0, 0, 0); }
    float* U = p.gst + ((size_t)(b * 4 + h) * 64 + c) * (64 * 128);
#pragma unroll
    for (int r = 0; r < 16; ++r) U[(32 * db + crow(r, hi)) * 128 + 32 * eb + r32] = acc[r];
    __syncthreads();
}
__device__ __forceinline__ void g3_chunk(const P& p, char* smem, int b, int h, int c) {
    const int tid = TIDX(), lane = tid & 63, w = __builtin_amdgcn_readfirstlane(tid >> 6), r32 = lane & 31, hi = lane >> 5;
    lptr shm = (lptr)smem; const unsigned l0 = (unsigned)(size_t)shm; const size_t t0 = (size_t)b * S + c * 64;
    const float* St = p.gst + ((size_t)(b * 4 + h) * 64 + c) * (64 * 128);
    float4 sv[4];
#pragma unroll
    for (int k = 0; k < 4; ++k) sv[k] = *(const float4*)(St + (size_t)(tid + k * 512) * 4);
    chunk_images<1>(p, shm, b, h, c, tid);
#pragma unroll
    for (int k = 0; k < 4; ++k) { const int idx = (tid + k * 512) * 4, dd = idx >> 7, e = idx & 127; u32x2 o; o.x = cvtpk(sv[k].x, sv[k].y); o.y = cvtpk(sv[k].z, sv[k].w);
        *(__attribute__((address_space(3))) u32x2*)(shm + L_SI + voff(dd, e)) = o; }
    __syncthreads();
    const int tb = w & 1, eb = w >> 1, trow = 32 * tb + r32;
    f32x16 p0 = f32x16{}, p1 = f32x16{}, o = f32x16{};
    {
        lcptr kb = (lcptr)(shm + L_KI) + hi * 1024 + r32 * 16; lcptr qb = (lcptr)(shm + L_QI) + hi * 1024 + trow * 16;
#pragma unroll
        for (int d0 = 0; d0 < 4; ++d0) {
            const bf16x8 b0 = *(const __attribute__((address_space(3))) bf16x8*)(kb + d0 * 2048), b1 = *(const __attribute__((address_space(3))) bf16x8*)(kb + d0 * 2048 + 512);
            const bf16x8 qf = *(const __attribute__((address_space(3))) bf16x8*)(qb + d0 * 2048);
            p0 = __builtin_amdgcn_mfma_f32_32x32x16_bf16(b0, qf, p0, 0, 0, 0); p1 = __builtin_amdgcn_mfma_f32_32x32x16_bf16(b1, qf, p1, 0, 0, 0); }
    }
#pragma unroll
    for (int r = 0; r < 16; ++r) { const int s = crow(r, hi); p0[r] = s <= trow ? p0[r] : 0.f; p1[r] = s + 32 <= trow ? p1[r] : 0.f; }
#pragma unroll
    for (int ds = 0; ds < 4; ++ds) {
        const u32x2 a0 = *(const __attribute__((address_space(3))) u32x2*)(shm + L_QI + (2 * ds) * 1024 + trow * 16 + 8 * hi), a1 = *(const __attribute__((address_space(3))) u32x2*)(shm + L_QI + (2 * ds + 1) * 1024 + trow * 16 + 8 * hi);
        const u32x4 aw = {a0.x, a0.y, a1.x, a1.y};
        const bf16x8 bq = trfrag(l0 + L_SI, ds, eb, lane);
        o = __builtin_amdgcn_mfma_f32_32x32x16_bf16(__builtin_bit_cast(bf16x8, aw), bq, o, 0, 0, 0); }
    {
        const u32x4 w0 = {cvtpk(p0[0], p0[1]), cvtpk(p0[2], p0[3]), cvtpk(p0[4], p0[5]), cvtpk(p0[6], p0[7])}, w1 = {cvtpk(p0[8], p0[9]), cvtpk(p0[10], p0[11]), cvtpk(p0[12], p0[13]), cvtpk(p0[14], p0[15])};
        const u32x4 w2 = {cvtpk(p1[0], p1[1]), cvtpk(p1[2], p1[3]), cvtpk(p1[4], p1[5]), cvtpk(p1[6], p1[7])}, w3 = {cvtpk(p1[8], p1[9]), cvtpk(p1[10], p1[11]), cvtpk(p1[12], p1[13]), cvtpk(p1[14], p1[15])};
        o = __builtin_amdgcn_mfma_f32_32x32x16_bf16(__builtin_bit_cast(bf16x8, w0), trfrag(l0 + L_VI, 0, eb, lane), o, 0, 0, 0);
        o = __builtin_amdgcn_mfma_f32_32x32x16_bf16(__builtin_bit_cast(bf16x8, w1), trfrag(l0 + L_VI, 1, eb, lane), o, 0, 0, 0);
        o = __builtin_amdgcn_mfma_f32_32x32x16_bf16(__builtin_bit_cast(bf16x8, w2), trfrag(l0 + L_VI, 2, eb, lane), o, 0, 0, 0);
        o = __builtin_amdgcn_mfma_f32_32x32x16_bf16(__builtin_bit_cast(bf16x8, w3), trfrag(l0 + L_VI, 3, eb, lane), o, 0, 0, 0);
    }
    __attribute__((address_space(3))) float* ost = (__attribute__((address_space(3))) float*)(shm + L_OST);
#pragma unroll
    for (int r = 0; r < 16; ++r) ost[(32 * tb + crow(r, hi)) * 132 + 32 * eb + r32] = o[r];
    __syncthreads();
    { const int t = tid >> 3, part = tid & 7; float v[16]; float ss = 0.f;
#pragma unroll
        for (int k = 0; k < 4; ++k) { const f32x4_t x = *(const __attribute__((address_space(3))) f32x4_t*)(ost + t * 132 + part * 16 + k * 4); v[4 * k] = x[0]; v[4 * k + 1] = x[1]; v[4 * k + 2] = x[2]; v[4 * k + 3] = x[3]; ss += x[0] * x[0] + x[1] * x[1] + x[2] * x[2] + x[3] * x[3]; }
        ss += __shfl_xor(ss, 1); ss += __shfl_xor(ss, 2); ss += __shfl_xor(ss, 4);
        const float rstd = rsqrtf(ss * (1.f / 128.f) + 1e-6f);
        const size_t go = (t0 + t) * 512 + h * 128 + part * 16;
        const uint4 r0 = *(const uint4*)(p.rs + go), r1 = *(const uint4*)(p.rs + go + 8); const unsigned rw[8] = {r0.x, r0.y, r0.z, r0.w, r1.x, r1.y, r1.z, r1.w};
        unsigned ow[8];
#pragma unroll
        for (int k = 0; k < 8; ++k) { const float ga = p.norm_g[h * 128 + part * 16 + 2 * k], gb = p.norm_g[h * 128 + part * 16 + 2 * k + 1];
            ow[k] = pk2(v[2 * k] * rstd * ga * __uint_as_float(rw[k] << 16), v[2 * k + 1] * rstd * gb * __uint_as_float(rw[k] & 0xffff0000u)); }
        *(uint4*)(p.gla + go) = make_uint4(ow[0], ow[1], ow[2], ow[3]); *(uint4*)(p.gla + go + 8) = make_uint4(ow[4], ow[5], ow[6], ow[7]); }
    __syncthreads();
}
}
__device__ __forceinline__ void phase_gla1(const P& p, char* smem) {
    const int n = p.nb * 4 * 64;
    for (int i = blockIdx.x; i < n; i += gridDim.x) gla::g1_chunk(p, smem, i >> 8, (i >> 6) & 3, i & 63);
}
__device__ __forceinline__ void phase_gla2(const P& p) {
    const int n = p.nb * 4 * 8192;
    for (int idx = blockIdx.x * NT + TIDX(); idx < n; idx += gridDim.x * NT) {
        const int bh = idx >> 13, de = idx & 8191, d = de >> 7; float* U = p.gst + (size_t)bh * 64 * 8192 + de; const float* gd = p.gdec + (size_t)bh * 64 * 64 + d;
        float s = 0.f;
        for (int c0 = 0; c0 < 64; c0 += 8) { float tmp[8], g[8];
#pragma unroll
            for (int k = 0; k < 8; ++k) { tmp[k] = U[(size_t)(c0 + k) * 8192]; g[k] = gd[(c0 + k) * 64]; }
#pragma unroll
            for (int k = 0; k < 8; ++k) { U[(size_t)(c0 + k) * 8192] = s; s = g[k] * s + tmp[k]; } }
    }
}
__device__ __forceinline__ void phase_gla3(const P& p, char* smem) {
    const int n = p.nb * 4 * 64;
    for (int i = blockIdx.x; i < n; i += gridDim.x) gla::g3_chunk(p, smem, i >> 8, (i >> 6) & 3, i & 63);
}

struct CmpSched {
    const char* kc; const char* Wc1; float* Pc; int nM, G, c; size_t aseg, pseg;
    __device__ __forceinline__ bool next(int i, pg8::Unit& u) const {
        const int L = i * G + c, per = nM * 2 * 2; if (L >= 2 * per) return false;
        const int kv = L / per, r = L % per, ks = r & 1, pn = (r >> 1) & 1, pm = r >> 2;
        u.pm = pm; u.pn = pn; u.tag = kv * 2 + ks;
        u.A = kc + (size_t)kv * aseg + (size_t)pm * 256 * 1024 * 2 + ks * 512 * 2; u.B = Wc1 + ((size_t)kv * 512 + pn * 256) * 1024 * 2 + ks * 512 * 2; return true;
    }
    __device__ __forceinline__ unsigned arow(const pg8::Unit&, int r) const { return (unsigned)r * 2048u; }
};
struct EpiCmp {
    static constexpr bool PERM = false;
    float* Pc; size_t pseg;
    __device__ __forceinline__ void operator()(const pg8::f32x4 (&acc)[2][2][4][2], const pg8::Unit& u, int wr, int wc, int fr, int fq) const {
        float* base = Pc + (size_t)u.tag * pseg; const int col0 = u.pn * 256 + wc * 32 + 4 * fq;
#pragma unroll
        for (int ai = 0; ai < 2; ++ai)
#pragma unroll
            for (int m = 0; m < 4; ++m) { float* rowp = base + (size_t)(u.pm * 256 + ai * 128 + wr * 64 + m * 16 + fr) * 512 + col0;
#pragma unroll
                for (int bj = 0; bj < 2; ++bj)
#pragma unroll
                    for (int n = 0; n < 2; ++n) *(pg8::f32x4*)(rowp + bj * 128 + n * 16) = acc[ai][bj][m][n]; }
    }
};
__device__ __forceinline__ void finish_b1p(const P& p);
__device__ __forceinline__ void phase_cmp1(const P& p, char* smem) {
    if (blockIdx.x == gridDim.x - 1) finish_b1p(p);
    const int nrows = p.nb * 2 * 256;
    CmpSched Sc{(const char*)p.kv6, (const char*)p.Wc1, p.pcmp, nrows / 256, (int)gridDim.x, (int)blockIdx.x, kvseg(p) * 2, (size_t)(nrows + 8) * 512};
    EpiCmp E{p.pcmp, (size_t)(nrows + 8) * 512};
    pg8::gemm_phase<EpiCmp, CmpSched, true, false>((PG8_LAS unsigned char*)smem, 512, 1024, 1024, Sc, E);
}
__device__ __forceinline__ void body_cmp2f(const P& p, int vb, char* smem) {
    const int tid = TIDX(); const int nrows = p.nb * 2 * 256, nvb1 = nrows / 16; const int kv = vb / nvb1, row0 = (vb % nvb1) * 16;
    const size_t pseg = (size_t)(nrows + 8) * 512; const float* P0 = p.pcmp + (size_t)(kv * 2) * pseg; const float* P1 = P0 + pseg;
    float* hs = (float*)smem;
    float* w2s = (float*)smem + 16 * 256;
    __syncthreads();
    { const float4* wsrc = (const float4*)(kv ? p.cw2_v : p.cw2_k);
#pragma unroll
      for (int k = 0; k < 8; ++k) ((float4*)w2s)[tid + k * 512] = wsrc[tid + k * 512]; }
#pragma unroll
    for (int k = 0; k < 8; ++k) { const int idx = tid + k * 512, rr = idx >> 8, n = idx & 255; const size_t m = (size_t)(row0 + rr);
        const float z = P0[m * 512 + n] + P1[m * 512 + n] + P0[(m + 1) * 512 + 256 + n] + P1[(m + 1) * 512 + 256 + n] + p.b1p[kv * 256 + n];
        hs[idx] = geluf_(z); }
    __syncthreads();
    const int rr = tid >> 5, i = tid & 31, row = row0 + rr;
    const float* h = hs + rr * 256; const float* b2 = kv ? p.cb2_v : p.cb2_k;
    float z1 = b2[i], z2 = b2[i + 32];
#pragma unroll 8
    for (int n = 0; n < 256; ++n) { const float hv = h[n]; z1 += hv * w2s[n * 64 + i]; z2 += hv * w2s[n * 64 + i + 32]; }
    bf16* dst = (kv ? p.vcmp : p.kcmp) + (size_t)row * 64;
    if (kv == 0) {
        const int bg = row >> 8, m = row & 255, b = bg >> 1; int sp = 16 * m + 31; if (sp > S - 1) sp = S - 1;
        const size_t t = (size_t)b * S + sp; const float c = p.cs[t * 64 + i], sn = p.cs[t * 64 + 32 + i];
        const float r1 = z1 * c - z2 * sn, r2 = z2 * c + z1 * sn; z1 = r1; z2 = r2;
    }
    dst[i] = f2bf(z1); dst[i + 32] = f2bf(z2);
}
__device__ __forceinline__ void phase_cmp2(const P& p, char* smem) {
    const int n = 2 * (p.nb * 2 * 256) / 16;
    for (int vb = blockIdx.x; vb < n; vb += gridDim.x) body_cmp2f(p, vb, smem);
}
__device__ __forceinline__ void prep_b1p(const P& p, char* smem) {
    if (blockIdx.x >= 64) return;
    const int tid = TIDX(), kv = blockIdx.x >> 5, part = blockIdx.x & 31, n = tid & 255, fh = tid >> 8;
    const float* pe = kv ? p.cpos_v : p.cpos_k; const float* w1 = kv ? p.cw1_v : p.cw1_k;
    const int f0 = part * 64 + fh * 32; float a = 0.f;
#pragma unroll
    for (int i = 0; i < 32; ++i) a += pe[f0 + i] * w1[(size_t)(f0 + i) * 256 + n];
    float* sc = (float*)(smem + LDS_MISC);
    __syncthreads();
    if (fh == 1) sc[n] = a;
    __syncthreads();
    if (fh == 0) p.b1p[512 + (kv * 32 + part) * 256 + n] = a + sc[n];
    __syncthreads();
}
__device__ __forceinline__ void finish_b1p(const P& p) {
    const int tid = TIDX(), kv = tid >> 8, n = tid & 255; float a = (kv ? p.cb1_v : p.cb1_k)[n];
    for (int part = 0; part < 32; ++part) a += p.b1p[512 + (kv * 32 + part) * 256 + n];
    p.b1p[kv * 256 + n] = a;
}
#define XB_TMO      128
#define XB_XCNT(j)  (256  + 64 * (j))
#define XB_XSUB(j)  (1280 + 64 * (j))
#define XB_XGEN(j)  (2304 + 64 * (j))
#define XB_TOP      3328
#define XB_TOPGEN   3392
#define XCD_BAR_WORDS 3456
#define XB_SPIN_CAP (1u << 18)
#define XLAS __attribute__((address_space(3)))
__device__ __forceinline__ unsigned xb_ld(unsigned* p)              { return __hip_atomic_load(p, __ATOMIC_RELAXED, __HIP_MEMORY_SCOPE_AGENT); }
__device__ __forceinline__ unsigned xb_add(unsigned* p, unsigned v) { return __hip_atomic_fetch_add(p, v, __ATOMIC_RELAXED, __HIP_MEMORY_SCOPE_AGENT); }
__device__ __forceinline__ unsigned xb_xcc_id() { return (unsigned)__builtin_amdgcn_s_getreg((3 << 11) | 20) & 0xFu; }
#define XB_SPIN(cond, bar) do { unsigned _sp = 0; while (cond) { __builtin_amdgcn_s_sleep(1); \
    if ((++_sp & 255u) == 0u) { if (xb_ld(&(bar)[XB_TMO])) break; if (_sp > XB_SPIN_CAP) { atomicAdd(&(bar)[XB_TMO], 1u); break; } } } } while (0)
struct XcdBarrier { unsigned* bar; unsigned x; volatile XLAS unsigned* st; };
__device__ __forceinline__ XcdBarrier xcd_barrier_post(unsigned* bar, volatile XLAS unsigned* st) {
    XcdBarrier b; b.bar = bar; b.x = xb_xcc_id(); b.st = st;
    if (TIDX() == 0) (void)xb_add(&bar[XB_XCNT(b.x)], 1u);
    return b;
}
__device__ __forceinline__ void xcd_barrier_complete(unsigned* bar, unsigned x, unsigned& nloc, unsigned& nx) {
    const unsigned G = gridDim.x * gridDim.y * gridDim.z;
    unsigned sum, cnt, mine, sp = 0u;
    for (;;) {
        sum = 0u; cnt = 0u; mine = 0u;
#pragma unroll
        for (unsigned j = 0; j < 16; ++j) { const unsigned c = xb_ld(&bar[XB_XCNT(j)]); sum += c; cnt += (c > 0u) ? 1u : 0u; mine = (j == x) ? c : mine; }
        if (sum == G) break;
        __builtin_amdgcn_s_sleep(1);
        if ((++sp & 255u) == 0u) { if (xb_ld(&bar[XB_TMO])) break; if (sp > XB_SPIN_CAP) { atomicAdd(&bar[XB_TMO], 1u); break; } }
    }
    nloc = mine > 0u ? mine : 1u; nx = cnt > 0u ? cnt : 1u;
}
__device__ __forceinline__ void xcd_barrier(const XcdBarrier& b) {
    asm volatile("s_waitcnt vmcnt(0)" ::: "memory");
    __syncthreads();
    if (TIDX() == 0) {
        unsigned* bar = b.bar;
        __builtin_amdgcn_s_waitcnt(0);
        unsigned nloc = b.st[0], nx = b.st[1];
        if (nloc == 0u) { xcd_barrier_complete(bar, b.x, nloc, nx); b.st[0] = nloc; b.st[1] = nx; }
        const unsigned old = xb_add(&bar[XB_XSUB(b.x)], 1u);
        const unsigned gen = old / nloc;
        if (old + 1u == (gen + 1u) * nloc) {
            __builtin_amdgcn_fence(__ATOMIC_RELEASE, "agent");
            asm volatile("s_waitcnt vmcnt(0)" ::: "memory");
            const unsigned og = xb_add(&bar[XB_TOP], 1u);
            const unsigned tg = og / nx;
            if (og + 1u == (tg + 1u) * nx) xb_add(&bar[XB_TOPGEN], 1u);
            else XB_SPIN(xb_ld(&bar[XB_TOPGEN]) == tg, bar);
            __builtin_amdgcn_fence(__ATOMIC_ACQUIRE, "agent");
            xb_add(&bar[XB_XGEN(b.x)], 1u);
            asm volatile("s_waitcnt vmcnt(0)" ::: "memory");
        } else {
            XB_SPIN(xb_ld(&bar[XB_XGEN(b.x)]) == gen, bar);
            __builtin_amdgcn_fence(__ATOMIC_ACQUIRE, "agent");
            asm volatile("s_waitcnt vmcnt(0)" ::: "memory");
        }
    }
    __syncthreads();
}

template <int ST> __device__ __forceinline__ void run_stage(const P& p, char* smem, int first, int stride) {
    const int nvb = stage_nvb(ST, p.T);
    for (int vb = first; vb < nvb; vb += stride) {
        if constexpr (ST == ST_RMS) body_rms(p, vb);
        else if constexpr (ST == ST_CS) body_cs(p, vb);
        else if constexpr (ST == ST_INPROJ) body_inproj(p, vb, smem);
        else if constexpr (ST == ST_CMP1) body_cmp1(p, vb, smem);
        else if constexpr (ST == ST_CMP2) body_cmp2(p, vb);
        else if constexpr (ST == ST_NSACMP) body_nsacmp(p, vb, smem);
        else if constexpr (ST == ST_NSAATT) body_nsaatt(p, vb);
        else if constexpr (ST == ST_GLAA) body_glaa(p, vb);
        else if constexpr (ST == ST_GLASCAN) body_glascan(p, vb, smem);
        else if constexpr (ST == ST_GLANORM) body_glanorm(p, vb);
        else if constexpr (ST == ST_PROJ) body_proj(p, vb, smem);
        else if constexpr (ST == ST_OUT) body_out(p, vb, smem);
        else if constexpr (ST == ST_ROUTE) body_route(p, vb, smem);
        else if constexpr (ST == ST_MOE1) body_moe1(p, vb, smem);
        else if constexpr (ST == ST_MOE2) body_moe2(p, vb, smem);
        else if constexpr (ST == ST_FINAL) body_final(p, vb, smem);
    }
}
template <int ST> __global__ void __launch_bounds__(NT) k_stage(P p) {
    extern __shared__ __attribute__((aligned(16))) char smem[];
    run_stage<ST>(p, smem, blockIdx.x, gridDim.x);
}
__global__ void __launch_bounds__(NT) k_mega(P p) {
    extern __shared__ __attribute__((aligned(16))) char smem[];
    cg::grid_group grid = cg::this_grid();
    const int b0 = blockIdx.x, G = gridDim.x;
    volatile XLAS unsigned* xst = (volatile XLAS unsigned*)((XLAS char*)smem + LDS_MISC + 3072);
    if (TIDX() < 4) xst[TIDX()] = 0u;
    __syncthreads();
    volatile unsigned long long* tsv = (volatile unsigned long long*)(p.ctl + 12288); int nts = 1;
    if (TSEL >= 0 && b0 == 0 && TIDX() == 0) tsv[0] = __builtin_amdgcn_s_memrealtime();
    const XcdBarrier xb = xcd_barrier_post(p.ctl + 4096, xst);
#define GSYNC() do { xcd_barrier(xb); if (TSEL >= 0 && b0 == 0 && TIDX() == 0) { tsv[nts] = __builtin_amdgcn_s_memrealtime(); } ++nts; } while (0)
#define DUPRUN(k, stmt) do { if (DUP == (k)) { stmt; GSYNC(); } } while (0)
    if (p.T < 0) grid.sync();
    phase_prep(p, smem); GSYNC();
    phase_inA(p, smem); GSYNC();                               DUPRUN(7, phase_inA(p, smem));
    phase_cmp1(p, smem); phase_gla1(p, smem); GSYNC();         DUPRUN(8, phase_cmp1(p, smem)); DUPRUN(4, phase_gla1(p, smem));
    phase_cmp2(p, smem); phase_gla2(p); GSYNC();               DUPRUN(9, phase_cmp2(p, smem));
    if (DUP >= 20 && DUP < 148) { P p2 = p; p2.onsa = (bf16*)p.pcmp; p2.sel = (u64*)((char*)p.pcmp + 16 * MiB_); phase_nsa<(DUP >= 20 && DUP < 148) ? DUP - 20 : 0>(p2, smem); GSYNC(); }
    phase_nsa(p, smem); phase_gla3(p, smem); GSYNC();          DUPRUN(1, phase_nsa(p, smem)); DUPRUN(2, phase_gla3(p, smem));
    phase_inB(p, smem); GSYNC();                               DUPRUN(11, phase_inB(p, smem));
    phase_proj(p, smem); GSYNC();                              DUPRUN(12, phase_proj(p, smem));
    phase_out(p, smem); GSYNC();                               DUPRUN(13, phase_out(p, smem));
    if (DUP == 17) { P p2 = p; p2.ctl = p.ctl + 8192; p2.vb = p.sa; p2.list = (int*)p.mixed; p2.tokslot = (int*)p.mixed + (1 << 20); p2.tokexp = (int*)p.mixed + (2 << 20); p2.tokw = (float*)p.mixed + (3 << 20);
        for (int vb = b0; vb < p.T / 64; vb += G) body_route3(p2, vb, smem);
        GSYNC(); }
    for (int vb = b0; vb < p.T / 64; vb += G) body_route3(p, vb, smem);
    GSYNC();
    phase_moe1(p, smem); GSYNC();                              DUPRUN(6, phase_moe1(p, smem));
    phase_moe2(p, smem); GSYNC();                              DUPRUN(14, phase_moe2(p, smem));
    if (DUP == 15) { GSYNC(); GSYNC(); GSYNC(); GSYNC(); GSYNC(); GSYNC(); GSYNC(); GSYNC(); GSYNC(); GSYNC(); }
    if (DUP == 16) { P p2 = p; p2.out = (float*)p.sb; run_stage<ST_FINAL>(p2, smem, b0, G); GSYNC(); }
    run_stage<ST_FINAL>(p, smem, b0, G);
    if (TSEL >= 0 && b0 == 0 && TIDX() == 0) { const unsigned long long tend = __builtin_amdgcn_s_memrealtime(); tsv[nts] = tend;
        const unsigned long long d = tsv[TSEL + 1] - tsv[TSEL]; while (__builtin_amdgcn_s_memrealtime() - tend < 4ull * d) __builtin_amdgcn_s_sleep(16); }
#undef DUPRUN
#undef GSYNC
}

enum Phase { PH_PREP = 0, PH_INA, PH_INB, PH_PROJ, PH_OUT, PH_MOE1, PH_MOE2, PH_NSA, PH_GLA1, PH_GLA2, PH_GLA3, PH_CMP1, PH_CMP2 };
template <int PH> __global__ void __launch_bounds__(NT) k_phase(P p) {
    extern __shared__ __attribute__((aligned(16))) char smem[];
    if constexpr (PH == PH_PREP) phase_prep(p, smem);
    else if constexpr (PH == PH_INA) phase_inA(p, smem);
    else if constexpr (PH == PH_INB) phase_inB(p, smem);
    else if constexpr (PH == PH_PROJ) phase_proj(p, smem);
    else if constexpr (PH == PH_OUT) phase_out(p, smem);
    else if constexpr (PH == PH_MOE1) phase_moe1(p, smem);
    else if constexpr (PH == PH_MOE2) phase_moe2(p, smem);
    else if constexpr (PH == PH_NSA) phase_nsa(p, smem);
    else if constexpr (PH == PH_GLA1) phase_gla1(p, smem);
    else if constexpr (PH == PH_GLA2) phase_gla2(p);
    else if constexpr (PH == PH_GLA3) phase_gla3(p, smem);
    else if constexpr (PH == PH_CMP1) phase_cmp1(p, smem);
    else if constexpr (PH == PH_CMP2) phase_cmp2(p, smem);
}
template <class TT> __device__ __forceinline__ float ldf(const TT* p, size_t i);
template <> __device__ __forceinline__ float ldf<bf16>(const bf16* p, size_t i) { return bf2f(p[i]); }
template <> __device__ __forceinline__ float ldf<float>(const float* p, size_t i) { return p[i]; }
template <class TT> __global__ void __launch_bounds__(256) k_compare(const TT* a, const TT* b, size_t n, float* err, int slot) {
    float num = 0.f, den = 0.f;
    for (size_t i = (size_t)blockIdx.x * 256 + TIDX(); i < n; i += (size_t)gridDim.x * 256) { const float x = ldf<TT>(a, i), y = ldf<TT>(b, i); const float d = x - y; num += (d == d) ? d * d : 1e30f; den += y * y; }
#pragma unroll
    for (int o = 1; o < 64; o <<= 1) { num += __shfl_xor(num, o); den += __shfl_xor(den, o); }
    if ((TIDX() & 63) == 0) { atomicAdd(err + 2 * slot, num); atomicAdd(err + 2 * slot + 1, den); }
}
__global__ void __launch_bounds__(256) k_compare_sel(const u64* a, const u64* b, size_t n, float* err, int slot) {
    float num = 0.f, den = 0.f;
    for (size_t i = (size_t)blockIdx.x * 256 + threadIdx.x; i < n; i += (size_t)gridDim.x * 256) { num += (a[i] != b[i]) ? 1.f : 0.f; den += 100.f; }
#pragma unroll
    for (int o = 1; o < 64; o <<= 1) { num += __shfl_xor(num, o); den += __shfl_xor(den, o); }
    if ((threadIdx.x & 63) == 0) { atomicAdd(err + 2 * slot, num); atomicAdd(err + 2 * slot + 1, den); }
}
__global__ void __launch_bounds__(256) k_report(float* out, size_t n, const float* err, int nslots, float tol) {
    int code = 0;
    for (int s = 0; s < nslots; ++s) { const float num = err[2 * s], den = err[2 * s + 1]; const bool bad = !(num <= tol * tol * den) || !(den > 0.f); if (bad) { code = s + 1; break; } }
    if (code == 0) return;
    const float f = 1.f + 0.1f * (float)code;
    for (size_t i = (size_t)blockIdx.x * 256 + TIDX(); i < n; i += (size_t)gridDim.x * 256) out[i] *= f;
}

static void set_inputs(P& p, void* const* d_in) {
    const float* const* in = (const float* const*)d_in;
    p.x = in[0]; p.pos = (const int*)d_in[1]; p.g_mix = in[2]; p.w_in = in[3];
    p.cpos_k = in[4]; p.cw1_k = in[5]; p.cb1_k = in[6]; p.cw2_k = in[7]; p.cb2_k = in[8];
    p.cpos_v = in[9]; p.cw1_v = in[10]; p.cb1_v = in[11]; p.cw2_v = in[12]; p.cb2_v = in[13];
    p.w_a2 = in[14]; p.b_a = in[15]; p.norm_g = in[16]; p.w_pn = in[17]; p.w_pg = in[18]; p.w_out = in[19];
    p.g_ffn = in[20]; p.w_grp = in[21]; p.b_grp = in[22]; p.w_exp = in[23]; p.b_exp = in[24]; p.w_gate = in[25]; p.w_up = in[26]; p.w_down = in[27]; p.g_final = in[28];
}
constexpr size_t MiB = 1u << 20;
static void layout_ref(P& p, char* small, char* act, char* scratch, float* out, int nb) {
    const size_t q = (MiB / 4) * nb;
    p.nb = nb; p.T = nb * S; p.out = out;
    p.ctl = (unsigned*)small; p.sel = (u64*)(small + q / 16 * 1); p.kcmp = (bf16*)(small + q / 2); p.vcmp = (bf16*)(small + q / 4 * 3);
    p.tokslot = (int*)(small + q); p.tokexp = (int*)(small + q + q / 8); p.tokw = (float*)(small + q + q / 4);
    p.alow = (float*)(small + 2 * q); p.gates = (float*)(small + 3 * q); p.cs = (float*)(small + 5 * q); p.hcmp = (float*)(small + 9 * q); p.list = (int*)(small + 13 * q);
    p.u = (bf16*)act; p.ocmp = (float*)act; p.mixed = (bf16*)act; p.vb = (bf16*)act;
    p.q = (bf16*)(act + 32 * q); p.kv6 = (bf16*)(act + 48 * q);
    p.gq = (bf16*)(act + 73 * q); p.gk = (bf16*)(act + 81 * q); p.gv = (bf16*)(act + 89 * q); p.rs = (bf16*)(act + 105 * q);
    p.H = (bf16*)(act + 32 * q);
    p.sa = (bf16*)(act + 123 * q); p.sb = (bf16*)(act + 155 * q); p.onsa = (bf16*)(act + 187 * q); p.gla = (bf16*)(act + 203 * q);
    p.Y = (bf16*)(act + 123 * q);
    p.ga = (float*)scratch; p.oraw = (float*)(scratch + 16 * q); p.h1 = (float*)(scratch + 48 * q);
    p.gst = (float*)(scratch + 16 * q); p.gdec = (float*)(small + 15 * q);
}
static void layout_compact(P& p, char* ws, float* out) {
    p.nb = NB; p.T = NB * S; p.out = out;
    char* small = ws; const size_t q = MiB;
    p.ctl = (unsigned*)small; p.sel = (u64*)(small + q / 16 * 1); p.kcmp = (bf16*)(small + q / 2); p.vcmp = (bf16*)(small + q / 4 * 3);
    p.tokslot = (int*)(small + q); p.tokexp = (int*)(small + q + q / 8); p.tokw = (float*)(small + q + q / 4);
    p.alow = (float*)(small + 2 * q); p.gates = (float*)(small + 3 * q); p.cs = (float*)(small + 5 * q); p.hcmp = (float*)(small + 9 * q); p.list = (int*)(small + 13 * q);
    p.u = (bf16*)(ws + 128 * MiB); p.vb = (bf16*)(ws + 128 * MiB);
    p.q = (bf16*)(ws + 160 * MiB); p.kv6 = (bf16*)(ws + 176 * MiB); p.gq = (bf16*)(ws + 201 * MiB); p.gk = (bf16*)(ws + 209 * MiB); p.gv = (bf16*)(ws + 217 * MiB); p.rs = (bf16*)(ws + 233 * MiB);
    p.ga = (float*)(ws + 249 * MiB); p.ocmp = (float*)(ws + 249 * MiB);
    p.sa = (bf16*)(ws + 160 * MiB); p.sb = (bf16*)(ws + 192 * MiB); p.mixed = (bf16*)(ws + 224 * MiB);
    p.H = (bf16*)(ws + 160 * MiB); p.Y = (bf16*)(ws + 48 * MiB);
    p.onsa = (bf16*)out; p.gla = (bf16*)((char*)out + 16 * MiB); p.oraw = (float*)((char*)out + 32 * MiB); p.h1 = out;
    p.gst = (float*)((char*)out + 32 * MiB); p.gdec = (float*)(small + 15 * q); p.pcmp = (float*)(ws + 249 * MiB);
}
static void layout_weights(P& p, char* w) {
    p.wr = (float*)(w - 256 * 1024); p.b1p = (float*)(w - 100 * 1024);
    p.Wd = (bf16*)w; p.Wgu = (bf16*)(w + 32 * MiB); p.Wt_in = (bf16*)(w + 96 * MiB); p.Wc1 = (bf16*)(w + 106 * MiB);
    p.Wpn = (bf16*)(w + 108 * MiB); p.Wpg = (bf16*)(w + 109 * MiB); p.Wo = (bf16*)(w + 110 * MiB);
}

template <int ST> static void launch_stage(const P& p, hipStream_t stream) {
    static bool attr = false;
    if (!attr) { (void)hipFuncSetAttribute((const void*)k_stage<ST>, hipFuncAttributeMaxDynamicSharedMemorySize, LDS_BYTES); attr = true; }
    int nvb = stage_nvb(ST, p.T); if (nvb > 16384) nvb = 16384;
    hipLaunchKernelGGL(k_stage<ST>, dim3(nvb), dim3(NT), LDS_BYTES, stream, p);
}
template <int PH> static void launch_phase(const P& p, hipStream_t stream, int grid = 40) {
    static bool attr = false;
    if (!attr) { (void)hipFuncSetAttribute((const void*)k_phase<PH>, hipFuncAttributeMaxDynamicSharedMemorySize, LDS_BYTES); attr = true; }
    hipLaunchKernelGGL(k_phase<PH>, dim3(grid), dim3(NT), LDS_BYTES, stream, p);
}
template <class TT> static void compare(const TT* a, const TT* b, size_t n, float* err, int slot, hipStream_t stream) {
    hipLaunchKernelGGL(k_compare<TT>, dim3(1024), dim3(256), 0, stream, a, b, n, err, slot);
}
static void launch_mega(const P& p, hipStream_t stream) {
    static int grid = 0;
    if (!grid) {
        int dev = 0, cus = 0, per_cu = 0;
        (void)hipGetDevice(&dev); (void)hipDeviceGetAttribute(&cus, hipDeviceAttributeMultiprocessorCount, dev);
        (void)hipFuncSetAttribute((const void*)k_mega, hipFuncAttributeMaxDynamicSharedMemorySize, LDS_BYTES);
        (void)hipOccupancyMaxActiveBlocksPerMultiprocessor(&per_cu, (const void*)k_mega, NT, LDS_BYTES);
        if (per_cu < 1) per_cu = 1;
        grid = cus * per_cu;
    }
    (void)hipMemsetAsync((void*)p.ctl, 0, 64 * 1024, stream);
    P pp = p; void* args[] = {(void*)&pp};
    (void)hipLaunchCooperativeKernel((const void*)k_mega, dim3(grid), dim3(NT), args, LDS_BYTES, stream);
}

extern "C" void kernel_launch(void* const* d_in, const int* in_sizes, int n_in, void* d_out, int out_size, void* d_ws, size_t ws_size, hipStream_t stream) {
    char* ws = (char*)d_ws;
    P p{}; set_inputs(p, d_in); layout_ref(p, ws, ws + 16 * MiB, (char*)d_out, (float*)d_out, NB); p.h1 = (float*)d_out;
#if MODE == 0
    (void)hipMemsetAsync(d_ws, 0, 4096, stream);
    launch_stage<ST_RMS>(p, stream); launch_stage<ST_CS>(p, stream); launch_stage<ST_INPROJ>(p, stream);
    launch_stage<ST_CMP1>(p, stream); launch_stage<ST_CMP2>(p, stream); launch_stage<ST_NSACMP>(p, stream); launch_stage<ST_NSAATT>(p, stream);
    launch_stage<ST_GLAA>(p, stream); launch_stage<ST_GLASCAN>(p, stream); launch_stage<ST_GLANORM>(p, stream);
    launch_stage<ST_PROJ>(p, stream); launch_stage<ST_OUT>(p, stream); launch_stage<ST_ROUTE>(p, stream);
    launch_stage<ST_MOE1>(p, stream); launch_stage<ST_MOE2>(p, stream); launch_stage<ST_FINAL>(p, stream);
#elif MODE == 1
    { P c{}; set_inputs(c, d_in); layout_weights(c, ws + 16 * MiB); layout_compact(c, ws, (float*)d_out); launch_mega(c, stream); }
#else
    { P c{}; set_inputs(c, d_in); layout_weights(c, ws + 16 * MiB); layout_compact(c, ws, (float*)d_out); launch_mega(c, stream); }
    P r{}; set_inputs(r, d_in); layout_weights(r, ws + 16 * MiB);
    layout_ref(r, ws + 128 * MiB, ws + 132 * MiB, ws + 200 * MiB, (float*)(ws + 200 * MiB + 12 * MiB), 1);
    char* alt = ws + 228 * MiB; float* err = (float*)(ws + 128 * MiB + 8192);
    (void)hipMemsetAsync(ws + 128 * MiB, 0, 16384, stream);
    int slot = 0; const size_t T1 = S; const size_t ROWS1 = 2 * T1 + NEXP * 256;
    launch_stage<ST_RMS>(r, stream); launch_stage<ST_CS>(r, stream); launch_stage<ST_INPROJ>(r, stream);
    P f = r; { char* a = alt;
        f.u = (bf16*)a; a += T1 * 1024 * 2; f.cs = (float*)a; a += T1 * 64 * 4; f.q = (bf16*)a; a += T1 * 512 * 2; f.kv6 = (bf16*)a; a += 6 * (size_t)2 * S * 64 * 2 + 4096;
        f.gates = (float*)a; a += T1 * 24 * 4; f.gq = (bf16*)a; a += T1 * 256 * 2; f.gk = (bf16*)a; a += T1 * 256 * 2; f.gv = (bf16*)a; a += T1 * 512 * 2; f.alow = (float*)a; a += T1 * 16 * 4;
        f.rs = (bf16*)a; a += T1 * 512 * 2; f.sa = (bf16*)a; a += T1 * 1024 * 2; f.sb = (bf16*)a; a += T1 * 1024 * 2; }
    launch_phase<PH_PREP>(f, stream); launch_phase<PH_INA>(f, stream); launch_phase<PH_INB>(f, stream);
    compare<bf16>(f.q, r.q, T1 * 512, err, slot++, stream);
    compare<bf16>(f.kv6, r.kv6, 6 * (size_t)2 * S * 64, err, slot++, stream);
    compare<bf16>(f.sb, r.sb, T1 * 1024, err, slot++, stream);
    launch_stage<ST_CMP1>(r, stream); launch_stage<ST_CMP2>(r, stream);
    f = r; f.pcmp = (float*)alt; f.kcmp = (bf16*)(alt + 20 * MiB); f.vcmp = (bf16*)(alt + 21 * MiB); launch_phase<PH_CMP1>(f, stream); launch_phase<PH_CMP2>(f, stream);
    compare<bf16>(f.kcmp, r.kcmp, (size_t)2 * 255 * 64, err, slot++, stream); compare<bf16>(f.vcmp + 256 * 64, r.vcmp + 256 * 64, (size_t)255 * 64, err, slot++, stream);
    launch_stage<ST_NSACMP>(r, stream); launch_stage<ST_NSAATT>(r, stream);
    f = r; f.onsa = (bf16*)alt; f.sel = (u64*)(alt + 8 * MiB); launch_phase<PH_NSA>(f, stream);
    hipLaunchKernelGGL(k_compare_sel, dim3(64), dim3(256), 0, stream, (const u64*)f.sel, (const u64*)r.sel, T1 * 2, err, slot++);
    compare<bf16>(f.onsa, r.onsa, T1 * 512, err, slot++, stream);
    launch_stage<ST_GLAA>(r, stream); launch_stage<ST_GLASCAN>(r, stream); launch_stage<ST_GLANORM>(r, stream);
    f = r; f.gla = (bf16*)alt; f.gst = (float*)(alt + 8 * MiB); f.gdec = (float*)(alt + 18 * MiB); launch_phase<PH_GLA1>(f, stream); launch_phase<PH_GLA2>(f, stream); launch_phase<PH_GLA3>(f, stream);
    compare<bf16>(f.gla, r.gla, T1 * 512, err, slot++, stream);
    launch_stage<ST_PROJ>(r, stream);
    f = r; f.mixed = (bf16*)alt; launch_phase<PH_PROJ>(f, stream);
    compare<bf16>(f.mixed, r.mixed, T1 * 1024, err, slot++, stream);
    launch_stage<ST_OUT>(r, stream);
    f = r; f.h1 = (float*)alt; launch_phase<PH_OUT>(f, stream);
    compare<float>(f.h1, r.h1, T1 * 1024, err, slot++, stream);
    launch_stage<ST_ROUTE>(r, stream);
    (void)hipMemsetAsync(r.H, 0, ROWS1 * 512 * 2, stream); (void)hipMemsetAsync(alt, 0, ROWS1 * 512 * 2, stream);
    launch_stage<ST_MOE1>(r, stream);
    f = r; f.H = (bf16*)alt; launch_phase<PH_MOE1>(f, stream);
    compare<bf16>(f.H, r.H, ROWS1 * 512, err, slot++, stream);
    (void)hipMemsetAsync(r.Y, 0, ROWS1 * 1024 * 2, stream); (void)hipMemsetAsync(alt + 17 * MiB, 0, ROWS1 * 1024 * 2, stream);
    launch_stage<ST_MOE2>(r, stream);
    f = r; f.Y = (bf16*)(alt + 17 * MiB); launch_phase<PH_MOE2>(f, stream);
    compare<bf16>(f.Y, r.Y, ROWS1 * 1024, err, slot++, stream);
    hipLaunchKernelGGL(k_report, dim3(1024), dim3(256), 0, stream, (float*)d_out, (size_t)NB * S * D, (const float*)err, slot, 0.02f);
#endif
}
```

```cpp
#include <hip/hip_runtime.h>
#include <hip/hip_cooperative_groups.h>
#include <stdint.h>
namespace cg = cooperative_groups;

#ifndef DUP
#define DUP 0
#endif
#ifndef TSEL
#define TSEL -1
#endif
#ifndef MODE
#define MODE 1
#endif

typedef unsigned short bf16;
typedef unsigned long long u64;

__device__ __forceinline__ int TIDX() { int t = threadIdx.x; asm volatile("" : "+v"(t)); return t; }
__device__ __forceinline__ float bf2f(bf16 v) { return __uint_as_float(((unsigned)v) << 16); }
__device__ __forceinline__ bf16 f2bf(float f) { unsigned u = __float_as_uint(f); return (bf16)((u + 0x7fffu + ((u >> 16) & 1u)) >> 16); }
__device__ __forceinline__ float sigmoidf_(float x) { return 1.f / (1.f + __expf(-x)); }
__device__ __forceinline__ float siluf_(float x) { return x / (1.f + __expf(-x)); }
__device__ __forceinline__ float geluf_(float x) { const float u = 0.7978845608028654f * (x + 0.044715f * x * x * x); return 0.5f * x * (1.f + tanhf(u)); }

constexpr int NB = 4, S = 4096, D = 1024;
constexpr int NT = 512;
constexpr int LDS_BYTES = 144 * 1024;
constexpr int LDS_MISC = 136 * 1024;
constexpr int INW = 4904;
constexpr int OFF_Q = 0, OFF_KV = 512, OFF_NG = 1280, OFF_GQ = 1304, OFF_GK = 1560, OFF_GV = 1816, OFF_GA = 2328, OFF_GR = 2344, OFF_MA = 2856, OFF_MB = 3880;
constexpr int NEXP = 32;
constexpr size_t MiB_ = 1u << 20;

struct P {
    const float* x; const int* pos; const float* g_mix; const float* w_in;
    const float *cpos_k, *cw1_k, *cb1_k, *cw2_k, *cb2_k, *cpos_v, *cw1_v, *cb1_v, *cw2_v, *cb2_v;
    const float *w_a2, *b_a, *norm_g, *w_pn, *w_pg, *w_out, *g_ffn, *w_grp, *b_grp, *w_exp, *b_exp, *w_gate, *w_up, *w_down, *g_final;
    float* out;
    unsigned* ctl;
    float* cs;
    bf16* u;
    bf16* q;
    bf16* kv6;
    float* gates;
    bf16 *gq, *gk, *gv;
    float* alow;
    bf16 *rs, *sa, *sb;
    float* hcmp;
    bf16 *kcmp, *vcmp;
    u64* sel;
    float* ocmp;
    bf16* onsa;
    float* ga;
    float* oraw;
    bf16* gla;
    bf16* mixed;
    float* h1;
    bf16* h1b;
    bf16* vb;
    int* list;
    int* tokslot;
    int* tokexp;
    float* tokw;
    bf16* H;
    bf16* Y;
    float* gst;
    float* gdec;
    float* pcmp;
    float* b1p;
    float* wr;
    bf16 *Wt_in, *Wc1, *Wpn, *Wpg, *Wo, *Wgu, *Wd;
    int nb, T;
};
__device__ __forceinline__ size_t kvseg(const P& p) { return (size_t)p.nb * 2 * S * 64; }

enum Stage { ST_RMS = 0, ST_CS, ST_INPROJ, ST_CMP1, ST_CMP2, ST_NSACMP, ST_NSAATT, ST_GLAA, ST_GLASCAN, ST_GLANORM, ST_PROJ, ST_OUT, ST_ROUTE, ST_MOE1, ST_MOE2, ST_FINAL, ST_COUNT };

__host__ __device__ inline int stage_nvb(int st, int T) {
    switch (st) {
        case ST_RMS: return T / 8;
        case ST_CS: return T * 32 / NT;
        case ST_INPROJ: return ((INW + NT - 1) / NT) * (T / 8);
        case ST_CMP1: return 2 * (T / S) * 2 * 256 / 8;
        case ST_CMP2: return 2 * (T / S) * 2 * 256 * 32 / NT;
        case ST_NSACMP: return T / 64 * 2 / 8;
        case ST_NSAATT: return T / 64 * 8 / 8;
        case ST_GLAA: return T / 2;
        case ST_GLASCAN: return (T / S) * 4 / 4;
        case ST_GLANORM: return T * 4 / NT;
        case ST_PROJ: return 2 * (T / 8);
        case ST_OUT: return 2 * (T / 8);
        case ST_ROUTE: return T / 8;
        case ST_MOE1: return (2 * T + NEXP * 256) / 8;
        case ST_MOE2: return 2 * ((2 * T + NEXP * 256) / 8);
        case ST_FINAL: return T / 8;
    }
    return 0;
}

__device__ __forceinline__ void body_rms(const P& p, int vb) {
    const int lane = TIDX() & 63, t = vb * 8 + (TIDX() >> 6);
    const float4* xr = (const float4*)(p.x + (size_t)t * D);
    float4 v[4]; float ss = 0.f;
#pragma unroll
    for (int j = 0; j < 4; ++j) { v[j] = xr[lane + 64 * j]; ss += v[j].x * v[j].x + v[j].y * v[j].y + v[j].z * v[j].z + v[j].w * v[j].w; }
#pragma unroll
    for (int o = 1; o < 64; o <<= 1) ss += __shfl_xor(ss, o);
    const float rstd = rsqrtf(ss * (1.f / D) + 1e-6f);
#pragma unroll
    for (int j = 0; j < 4; ++j) {
        const float4 g = ((const float4*)p.g_mix)[lane + 64 * j];
        ushort4 o; o.x = f2bf(v[j].x * rstd * g.x); o.y = f2bf(v[j].y * rstd * g.y); o.z = f2bf(v[j].z * rstd * g.z); o.w = f2bf(v[j].w * rstd * g.w);
        ((ushort4*)(p.u + (size_t)t * D))[lane + 64 * j] = o;
    }
}
__device__ __forceinline__ void body_rms2(const P& p, int vb) {
    const int lane = TIDX() & 63, t = vb * 16 + (TIDX() >> 6) * 2;
    const float4* xr = (const float4*)(p.x + (size_t)t * D);
    float4 v[8]; float s0 = 0.f, s1 = 0.f;
#pragma unroll
    for (int j = 0; j < 8; ++j) v[j] = xr[lane + 64 * j];
#pragma unroll
    for (int j = 0; j < 4; ++j) { s0 += v[j].x * v[j].x + v[j].y * v[j].y + v[j].z * v[j].z + v[j].w * v[j].w; s1 += v[4 + j].x * v[4 + j].x + v[4 + j].y * v[4 + j].y + v[4 + j].z * v[4 + j].z + v[4 + j].w * v[4 + j].w; }
#pragma unroll
    for (int o = 1; o < 64; o <<= 1) { s0 += __shfl_xor(s0, o); s1 += __shfl_xor(s1, o); }
    const float r0 = rsqrtf(s0 * (1.f / D) + 1e-6f), r1 = rsqrtf(s1 * (1.f / D) + 1e-6f);
#pragma unroll
    for (int j = 0; j < 4; ++j) {
        const float4 g = ((const float4*)p.g_mix)[lane + 64 * j];
        ushort4 o; o.x = f2bf(v[j].x * r0 * g.x); o.y = f2bf(v[j].y * r0 * g.y); o.z = f2bf(v[j].z * r0 * g.z); o.w = f2bf(v[j].w * r0 * g.w);
        ((ushort4*)(p.u + (size_t)t * D))[lane + 64 * j] = o;
        ushort4 q; q.x = f2bf(v[4 + j].x * r1 * g.x); q.y = f2bf(v[4 + j].y * r1 * g.y); q.z = f2bf(v[4 + j].z * r1 * g.z); q.w = f2bf(v[4 + j].w * r1 * g.w);
        ((ushort4*)(p.u + (size_t)(t + 1) * D))[lane + 64 * j] = q;
    }
}
__device__ __forceinline__ void body_cs(const P& p, int vb) {
    const int idx = vb * NT + TIDX(); const int t = idx >> 5, i = idx & 31;
    const float inv = 1.0f / powf(10000.0f, (float)i / 32.0f);
    const float ang = (float)p.pos[t] * inv;
    const double a = (double)ang; const double k = rint(a * 0.15915494309189535); const float r = (float)(a - k * 6.283185307179586);
    p.cs[(size_t)t * 64 + i] = cosf(r); p.cs[(size_t)t * 64 + 32 + i] = sinf(r);
}

template <int K, bool TWO, bool SAMEA, class AF1, class AF2, class Epi>
__device__ __forceinline__ void ngemm(float* lds, int m0, const float* W1, int ldw1, int n1, const float* W2, int ldw2, int n2, AF1 a1, AF2 a2, Epi epi) {
    const int tid = TIDX();
    for (int idx = tid; idx < 8 * K; idx += NT) { const int i = idx / K, k = idx % K; lds[idx] = a1(m0 + i, k); if (TWO && !SAMEA) lds[8 * K + idx] = a2(m0 + i, k); }
    __syncthreads();
    float acc1[8], acc2[8];
#pragma unroll
    for (int i = 0; i < 8; ++i) { acc1[i] = 0.f; acc2[i] = 0.f; }
    const float* w1 = W1 + n1; const float* w2 = TWO ? (W2 + n2) : w1;
    const float* l2 = (TWO && !SAMEA) ? lds + 8 * K : lds;
    for (int k = 0; k < K; k += 4) {
        float a[4], b[4];
#pragma unroll
        for (int kk = 0; kk < 4; ++kk) { a[kk] = w1[(size_t)(k + kk) * ldw1]; b[kk] = TWO ? w2[(size_t)(k + kk) * ldw2] : 0.f; }
#pragma unroll
        for (int i = 0; i < 8; ++i) {
            const float4 x1 = *(const float4*)(lds + i * K + k);
            acc1[i] += x1.x * a[0] + x1.y * a[1] + x1.z * a[2] + x1.w * a[3];
            if (TWO) { const float4 x2 = *(const float4*)(l2 + i * K + k); acc2[i] += x2.x * b[0] + x2.y * b[1] + x2.z * b[2] + x2.w * b[3]; }
        }
    }
#pragma unroll
    for (int i = 0; i < 8; ++i) epi(m0 + i, acc1[i], acc2[i]);
    __syncthreads();
}

__device__ __forceinline__ void store_z(const P& p, int t, int j, float z, float zp) {
    const int b = t / S, s = t % S;
    if (j < OFF_KV) {
        const int d = j & 63, i = d & 31; const float c = p.cs[(size_t)t * 64 + i], sn = p.cs[(size_t)t * 64 + 32 + i];
        const float r = (d < 32) ? (z * c - zp * sn) : (z * c + zp * sn);
        p.q[(size_t)t * 512 + j] = f2bf(r * 0.125f);
    } else if (j < OFF_NG) {
        const int seg = (j - OFF_KV) >> 7, cc = (j - OFF_KV) & 127, g = cc >> 6, d = cc & 63; float r = z;
        if (seg == 2 || seg == 4) { const int i = d & 31; const float c = p.cs[(size_t)t * 64 + i], sn = p.cs[(size_t)t * 64 + 32 + i]; r = (d < 32) ? (z * c - zp * sn) : (z * c + zp * sn); }
        p.kv6[(size_t)seg * kvseg(p) + ((size_t)(b * 2 + g) * S + s) * 64 + d] = f2bf(r);
    } else if (j < OFF_GQ) { p.gates[(size_t)t * 24 + (j - OFF_NG)] = sigmoidf_(z);
    } else if (j < OFF_GK) { p.gq[(size_t)t * 256 + (j - OFF_GQ)] = f2bf(z * 0.125f);
    } else if (j < OFF_GV) { p.gk[(size_t)t * 256 + (j - OFF_GK)] = f2bf(z);
    } else if (j < OFF_GA) { p.gv[(size_t)t * 512 + (j - OFF_GV)] = f2bf(z);
    } else if (j < OFF_GR) { p.alow[(size_t)t * 16 + (j - OFF_GA)] = z;
    } else if (j < OFF_MA) { p.rs[(size_t)t * 512 + (j - OFF_GR)] = f2bf(siluf_(z));
    } else if (j < OFF_MB) { p.sa[(size_t)t * 1024 + (j - OFF_MA)] = f2bf(sigmoidf_(z));
    } else { p.sb[(size_t)t * 1024 + (j - OFF_MB)] = f2bf(sigmoidf_(z)); }
}
__device__ __forceinline__ int rope_partner(int j) {
    int base;
    if (j < OFF_KV) base = 0; else if (j >= 768 && j < 896) base = 768; else if (j >= 1024 && j < 1152) base = 1024; else return -1;
    const int d = (j - base) & 63; return d < 32 ? j + 32 : j - 32;
}
__device__ __forceinline__ void body_inproj(const P& p, int vb, char* smem) {
    constexpr int NCB = (INW + NT - 1) / NT;
    const int bx = vb % NCB, by = vb / NCB;
    const int jr = bx * NT + TIDX(); const bool jv = jr < INW; const int j = jv ? jr : INW - 1;
    int jp = rope_partner(j); if (jp < 0) jp = j;
    ngemm<1024, true, true>((float*)smem, by * 8, p.w_in, INW, j, p.w_in, INW, jp,
        [&](int m, int k) { return bf2f(p.u[(size_t)m * D + k]); }, [&](int m, int k) { return 0.f; },
        [&](int m, float z, float zp) { if (jv) store_z(p, m, j, z, zp); });
}

__device__ __forceinline__ void body_cmp1(const P& p, int vb, char* smem) {
    const int nrows = p.nb * 2 * 256, ng = nrows / 8;
    const int kv = vb / ng, m0 = (vb % ng) * 8; const int n = TIDX() & 255; const bool act = TIDX() < 256;
    const bf16* src = p.kv6 + (size_t)kv * kvseg(p);
    const float* pe = kv ? p.cpos_v : p.cpos_k; const float* w1 = kv ? p.cw1_v : p.cw1_k; const float* b1 = kv ? p.cb1_v : p.cb1_k;
    float* dst = p.hcmp + (size_t)kv * nrows * 256;
    ngemm<2048, false, true>((float*)smem, m0, w1, 256, n, w1, 256, n,
        [&](int m, int k) { return bf2f(src[(size_t)m * 1024 + k]) + pe[k]; }, [&](int m, int k) { return 0.f; },
        [&](int m, float z, float) { if (act) dst[(size_t)m * 256 + n] = geluf_(z + b1[n]); });
}
__device__ __forceinline__ void body_cmp2(const P& p, int vb) {
    const int nrows = p.nb * 2 * 256;
    const int idx = vb * NT + TIDX();
    const int i = idx & 31, row = (idx >> 5) % nrows, kv = (idx >> 5) / nrows;
    const float* h = p.hcmp + ((size_t)kv * nrows + row) * 256; const float* w2 = kv ? p.cw2_v : p.cw2_k; const float* b2 = kv ? p.cb2_v : p.cb2_k;
    float z1 = b2[i], z2 = b2[i + 32];
    for (int n = 0; n < 256; ++n) { const float hv = h[n]; z1 += hv * w2[n * 64 + i]; z2 += hv * w2[n * 64 + i + 32]; }
    bf16* dst = (kv ? p.vcmp : p.kcmp) + (size_t)row * 64;
    if (kv == 0) {
        const int bg = row >> 8, m = row & 255, b = bg >> 1; int sp = 16 * m + 31; if (sp > S - 1) sp = S - 1;
        const size_t t = (size_t)b * S + sp; const float c = p.cs[t * 64 + i], sn = p.cs[t * 64 + 32 + i];
        const float r1 = z1 * c - z2 * sn, r2 = z2 * c + z1 * sn; z1 = r1; z2 = r2;
    }
    dst[i] = f2bf(z1); dst[i + 32] = f2bf(z2);
}

__device__ __forceinline__ void load_row64(const bf16* r, float* f) {
    const uint4* p4 = (const uint4*)r;
#pragma unroll
    for (int c = 0; c < 8; ++c) { const uint4 v = p4[c]; const unsigned w[4] = {v.x, v.y, v.z, v.w};
#pragma unroll
        for (int e = 0; e < 4; ++e) { f[c * 8 + e * 2] = __uint_as_float(w[e] << 16); f[c * 8 + e * 2 + 1] = __uint_as_float(w[e] & 0xffff0000u); } }
}
__device__ __forceinline__ float dot64(const float* a, const bf16* r) {
    const uint4* p4 = (const uint4*)r; float s = 0.f;
#pragma unroll
    for (int c = 0; c < 8; ++c) { const uint4 v = p4[c]; const unsigned w[4] = {v.x, v.y, v.z, v.w};
#pragma unroll
        for (int e = 0; e < 4; ++e) { s += a[c * 8 + e * 2] * __uint_as_float(w[e] << 16); s += a[c * 8 + e * 2 + 1] * __uint_as_float(w[e] & 0xffff0000u); } }
    return s;
}
__device__ __forceinline__ void axpy64(float* o, float a, const bf16* r) {
    const uint4* p4 = (const uint4*)r;
#pragma unroll
    for (int c = 0; c < 8; ++c) { const uint4 v = p4[c]; const unsigned w[4] = {v.x, v.y, v.z, v.w};
#pragma unroll
        for (int e = 0; e < 4; ++e) { o[c * 8 + e * 2] += a * __uint_as_float(w[e] << 16); o[c * 8 + e * 2 + 1] += a * __uint_as_float(w[e] & 0xffff0000u); } }
}
__device__ __forceinline__ void body_nsacmp(const P& p, int vb, char* smem) {
    const int wave = TIDX() >> 6, lane = TIDX() & 63, item = vb * 8 + wave;
    const int g = item & 1, t = (item >> 1) * 64 + lane;
    const int b = t / S, s = t % S; const int nv = s >= 31 ? (s - 31) / 16 + 1 : 0;
    float* my = (float*)smem + (size_t)wave * (64 * 65) + lane * 65;
    for (int j = 0; j < 64; ++j) my[j] = 0.f;
    const bf16* kc = p.kcmp + (size_t)(b * 2 + g) * 256 * 64; const bf16* vc = p.vcmp + (size_t)(b * 2 + g) * 256 * 64;
    for (int hh = 0; hh < 4; ++hh) {
        const int h = g * 4 + hh; float qv[64], o[64];
        load_row64(p.q + (size_t)t * 512 + h * 64, qv);
#pragma unroll
        for (int d = 0; d < 64; ++d) o[d] = 0.f;
        float m = -1e30f, l = 0.f;
        for (int n = 0; n < nv; ++n) { const float sc = dot64(qv, kc + n * 64); const float mn = fmaxf(m, sc); l = l * __expf(m - mn) + __expf(sc - mn); m = mn; }
        const float il = nv > 0 ? 1.f / l : 0.f;
        for (int n = 0; n < nv; ++n) {
            const float sc = dot64(qv, kc + n * 64); const float pn = __expf(sc - m) * il;
            axpy64(o, pn, vc + n * 64);
            const int j0 = n >> 2; if ((n & 3) != 3) my[j0] += pn; else { my[j0] += 0.5f * pn; my[j0 + 1] += 0.5f * pn; }
        }
#pragma unroll
        for (int d = 0; d < 64; ++d) p.ocmp[(size_t)t * 512 + h * 64 + d] = o[d];
    }
    const int cur = s >> 6; u64 mask = 0ull;
    for (int j = 0; j <= cur; ++j) {
        const float sj = (j == 0 || j == cur || j == cur - 1) ? 1e4f : my[j]; int rank = 0;
        for (int i = 0; i <= cur; ++i) { if (i == j) continue; const float si = (i == 0 || i == cur || i == cur - 1) ? 1e4f : my[i]; if (si > sj || (si == sj && i < j)) ++rank; }
        if (rank < 16) mask |= (1ull << j);
    }
    p.sel[(size_t)t * 2 + g] = mask;
}
__device__ __forceinline__ void body_nsaatt(const P& p, int vb) {
    const int wave = TIDX() >> 6, lane = TIDX() & 63, item = vb * 8 + wave;
    const int h = item & 7, t = (item >> 3) * 64 + lane, g = h >> 2;
    const int b = t / S, s = t % S, cur = s >> 6;
    const size_t seg = kvseg(p), ho = (size_t)(b * 2 + g) * S * 64;
    const bf16* ks = p.kv6 + 2 * seg + ho; const bf16* vs = p.kv6 + 3 * seg + ho; const bf16* kw = p.kv6 + 4 * seg + ho; const bf16* vw = p.kv6 + 5 * seg + ho;
    float qv[64], o[64];
    load_row64(p.q + (size_t)t * 512 + h * 64, qv);
    const float g0 = p.gates[(size_t)t * 24 + h * 3], g1 = p.gates[(size_t)t * 24 + h * 3 + 1], g2 = p.gates[(size_t)t * 24 + h * 3 + 2];
    float* accp = p.ocmp + (size_t)t * 512 + h * 64;
#pragma unroll
    for (int d = 0; d < 64; ++d) o[d] = 0.f;
    const u64 mask = p.sel[(size_t)t * 2 + g];
    float m = -1e30f, l = 0.f;
    for (int j = 0; j <= cur; ++j) {
        if (!((mask >> j) & 1ull)) continue;
        for (int kk = 0; kk < 64; ++kk) {
            const int key = j * 64 + kk; if (key > s) break;
            const float sc = dot64(qv, ks + (size_t)key * 64);
            if (sc > m) { const float f = __expf(m - sc); l *= f;
#pragma unroll
                for (int d = 0; d < 64; ++d) o[d] *= f;
                m = sc; }
            const float pe = __expf(sc - m); l += pe; axpy64(o, pe, vs + (size_t)key * 64);
        }
    }
    { const float f = g1 / l;
#pragma unroll
        for (int d = 0; d < 64; ++d) { accp[d] = g0 * accp[d] + f * o[d]; o[d] = 0.f; } }
    m = -1e30f; l = 0.f;
    for (int key = (s >= 511 ? s - 511 : 0); key <= s; ++key) {
        const float sc = dot64(qv, kw + (size_t)key * 64);
        if (sc > m) { const float f = __expf(m - sc); l *= f;
#pragma unroll
            for (int d = 0; d < 64; ++d) o[d] *= f;
            m = sc; }
        const float pe = __expf(sc - m); l += pe; axpy64(o, pe, vw + (size_t)key * 64);
    }
    { const float f = g2 / l;
#pragma unroll
        for (int d = 0; d < 64; ++d) p.onsa[(size_t)t * 512 + h * 64 + d] = f2bf(accp[d] + f * o[d]); }
}

__device__ __forceinline__ void body_glaa(const P& p, int vb) {
    const int c = TIDX() & 255, t = vb * 2 + (TIDX() >> 8); float z = p.b_a[c];
#pragma unroll
    for (int r = 0; r < 16; ++r) z += p.alow[(size_t)t * 16 + r] * p.w_a2[r * 256 + c];
    const float ls = fminf(z, 0.f) - log1pf(__expf(-fabsf(z)));
    p.ga[(size_t)t * 256 + c] = __expf(ls * (1.f / 16.f));
}
__device__ __forceinline__ void body_glascan(const P& p, int vb, char* smem) {
    const int sub = TIDX() >> 7, e = TIDX() & 127, bh = vb * 4 + sub, b = bh >> 2, h = bh & 3;
    float* sq = (float*)smem + sub * (3 * 32 * 64); float* sk = sq + 32 * 64; float* sg = sk + 32 * 64;
    float St[64];
#pragma unroll
    for (int d = 0; d < 64; ++d) St[d] = 0.f;
    for (int s0 = 0; s0 < S; s0 += 32) {
        __syncthreads();
        for (int i = e; i < 32 * 64; i += 128) { const int ss = i >> 6, d = i & 63; const size_t t = (size_t)b * S + s0 + ss;
            sq[i] = bf2f(p.gq[t * 256 + h * 64 + d]); sk[i] = bf2f(p.gk[t * 256 + h * 64 + d]); sg[i] = p.ga[t * 256 + h * 64 + d]; }
        __syncthreads();
        for (int ss = 0; ss < 32; ++ss) {
            const size_t t = (size_t)b * S + s0 + ss; const float v = bf2f(p.gv[t * 512 + h * 128 + e]); float o = 0.f;
#pragma unroll
            for (int d = 0; d < 64; ++d) { St[d] = sg[ss * 64 + d] * St[d] + sk[ss * 64 + d] * v; o += sq[ss * 64 + d] * St[d]; }
            p.oraw[t * 512 + h * 128 + e] = o;
        }
    }
    __syncthreads();
}
__device__ __forceinline__ void body_glanorm(const P& p, int vb) {
    const int idx = vb * NT + TIDX(); const int t = idx >> 2, h = idx & 3;
    const float* o = p.oraw + (size_t)t * 512 + h * 128; float ss = 0.f;
    for (int e = 0; e < 128; ++e) ss += o[e] * o[e];
    const float r = rsqrtf(ss * (1.f / 128.f) + 1e-6f);
    for (int e = 0; e < 128; ++e) p.gla[(size_t)t * 512 + h * 128 + e] = f2bf(o[e] * r * p.norm_g[h * 128 + e] * bf2f(p.rs[(size_t)t * 512 + h * 128 + e]));
}

__device__ __forceinline__ void body_proj(const P& p, int vb, char* smem) {
    const int n = (vb & 1) * NT + TIDX(), m0 = (vb >> 1) * 8;
    ngemm<512, true, false>((float*)smem, m0, p.w_pn, 1024, n, p.w_pg, 1024, n,
        [&](int m, int k) { return bf2f(p.onsa[(size_t)m * 512 + k]); }, [&](int m, int k) { return bf2f(p.gla[(size_t)m * 512 + k]); },
        [&](int m, float ya, float yb) { p.mixed[(size_t)m * 1024 + n] = f2bf(bf2f(p.sa[(size_t)m * 1024 + n]) * ya + bf2f(p.sb[(size_t)m * 1024 + n]) * yb); });
}
__device__ __forceinline__ void body_out(const P& p, int vb, char* smem) {
    const int n = (vb & 1) * NT + TIDX(), m0 = (vb >> 1) * 8;
    ngemm<1024, false, true>((float*)smem, m0, p.w_out, 1024, n, p.w_out, 1024, n,
        [&](int m, int k) { return bf2f(p.mixed[(size_t)m * 1024 + k]); }, [&](int m, int k) { return 0.f; },
        [&](int m, float z, float) { p.h1[(size_t)m * 1024 + n] = p.x[(size_t)m * 1024 + n] + z; });
}

__device__ __forceinline__ void body_route(const P& p, int vb, char* smem) {
    const int wave = TIDX() >> 6, lane = TIDX() & 63, t = vb * 8 + wave;
    const float4* hr = (const float4*)(p.h1 + (size_t)t * D);
    float v[16]; float ss = 0.f;
#pragma unroll
    for (int j = 0; j < 4; ++j) { const float4 a = hr[lane + 64 * j]; v[4 * j] = a.x; v[4 * j + 1] = a.y; v[4 * j + 2] = a.z; v[4 * j + 3] = a.w; ss += a.x * a.x + a.y * a.y + a.z * a.z + a.w * a.w; }
#pragma unroll
    for (int o = 1; o < 64; o <<= 1) ss += __shfl_xor(ss, o);
    const float rstd = rsqrtf(ss * (1.f / D) + 1e-6f);
#pragma unroll
    for (int j = 0; j < 4; ++j) {
        const float4 g = ((const float4*)p.g_ffn)[lane + 64 * j];
        v[4 * j] *= rstd * g.x; v[4 * j + 1] *= rstd * g.y; v[4 * j + 2] *= rstd * g.z; v[4 * j + 3] *= rstd * g.w;
        ushort4 o; o.x = f2bf(v[4 * j]); o.y = f2bf(v[4 * j + 1]); o.z = f2bf(v[4 * j + 2]); o.w = f2bf(v[4 * j + 3]);
        ((ushort4*)(p.vb + (size_t)t * D))[lane + 64 * j] = o;
    }
    float* sl = (float*)(smem + LDS_MISC) + wave * 40;
    for (int o = 0; o < 4; ++o) { float a = 0.f;
#pragma unroll
        for (int j = 0; j < 4; ++j)
#pragma unroll
            for (int e = 0; e < 4; ++e) a += v[4 * j + e] * p.w_grp[(size_t)(4 * (lane + 64 * j) + e) * 4 + o];
#pragma unroll
        for (int x = 1; x < 64; x <<= 1) a += __shfl_xor(a, x);
        if (lane == 0) sl[o] = a + p.b_grp[o]; }
    for (int o = 0; o < 32; ++o) { float a = 0.f;
#pragma unroll
        for (int j = 0; j < 4; ++j)
#pragma unroll
            for (int e = 0; e < 4; ++e) a += v[4 * j + e] * p.w_exp[(size_t)(4 * (lane + 64 * j) + e) * 32 + o];
#pragma unroll
        for (int x = 1; x < 64; x <<= 1) a += __shfl_xor(a, x);
        if (lane == 0) sl[4 + o] = a + p.b_exp[o]; }
    if (lane == 0) {
        int gs = 0; float gm = sl[0];
        for (int o = 1; o < 4; ++o) if (sl[o] > gm) { gm = sl[o]; gs = o; }
        float gsum = 0.f;
        for (int o = 0; o < 4; ++o) gsum += __expf(sl[o] - gm);
        const float pg = 1.f / gsum;
        const float* li = sl + 4 + gs * 8;
        int e0 = 0; float m0 = li[0];
        for (int e = 1; e < 8; ++e) if (li[e] > m0) { m0 = li[e]; e0 = e; }
        int e1 = -1; float m1 = -3e38f;
        for (int e = 0; e < 8; ++e) if (e != e0 && li[e] > m1) { m1 = li[e]; e1 = e; }
        const float p0 = 1.f, p1 = __expf(m1 - m0);
        const float w0 = pg * p0 / (p0 + p1), w1 = pg * p1 / (p0 + p1);
        const int x0 = gs * 8 + e0, x1 = gs * 8 + e1;
        const int s0 = (int)atomicAdd(&p.ctl[x0 * 32], 1u), s1 = (int)atomicAdd(&p.ctl[x1 * 32], 1u);
        p.list[(size_t)x0 * p.T + s0] = t; p.list[(size_t)x1 * p.T + s1] = t;
        p.tokexp[t * 2] = x0; p.tokexp[t * 2 + 1] = x1; p.tokslot[t * 2] = s0; p.tokslot[t * 2 + 1] = s1; p.tokw[t * 2] = w0; p.tokw[t * 2 + 1] = w1;
    }
}

__device__ __forceinline__ void body_route2(const P& p, int vb, char* smem) {
    const int tid = TIDX(), wave = tid >> 6, lane = tid & 63, t = vb * 8 + wave;
    const float4* hr = (const float4*)(p.h1 + (size_t)t * D);
    float4 v[4]; float ss = 0.f;
#pragma unroll
    for (int j = 0; j < 4; ++j) { v[j] = hr[lane + 64 * j]; ss += v[j].x * v[j].x + v[j].y * v[j].y + v[j].z * v[j].z + v[j].w * v[j].w; }
#pragma unroll
    for (int o = 1; o < 64; o <<= 1) ss += __shfl_xor(ss, o);
    const float rstd = rsqrtf(ss * (1.f / D) + 1e-6f);
#pragma unroll
    for (int j = 0; j < 4; ++j) {
        const float4 g = ((const float4*)p.g_ffn)[lane + 64 * j];
        v[j].x *= rstd * g.x; v[j].y *= rstd * g.y; v[j].z *= rstd * g.z; v[j].w *= rstd * g.w;
        ushort4 o; o.x = f2bf(v[j].x); o.y = f2bf(v[j].y); o.z = f2bf(v[j].z); o.w = f2bf(v[j].w);
        ((ushort4*)(p.vb + (size_t)t * D))[lane + 64 * j] = o;
    }
    float* sl = (float*)(smem + LDS_MISC) + wave * 40;
    float mine = 0.f;
#pragma unroll 4
    for (int o = 0; o < 36; ++o) { const float4* wrow = (const float4*)(p.wr + (size_t)o * 1024); float a = 0.f;
#pragma unroll
        for (int j = 0; j < 4; ++j) { const float4 w = wrow[lane + 64 * j]; a += v[j].x * w.x + v[j].y * w.y + v[j].z * w.z + v[j].w * w.w; }
#pragma unroll
        for (int x = 1; x < 64; x <<= 1) a += __shfl_xor(a, x);
        if (lane == o) mine = a; }
    if (lane < 36) sl[lane] = mine + (lane < 4 ? p.b_grp[lane] : p.b_exp[lane - 4]);
    asm volatile("s_waitcnt lgkmcnt(0)" ::: "memory");
    if (lane == 0) {
        int gs = 0; float gm = sl[0];
        for (int o = 1; o < 4; ++o) if (sl[o] > gm) { gm = sl[o]; gs = o; }
        float gsum = 0.f;
        for (int o = 0; o < 4; ++o) gsum += __expf(sl[o] - gm);
        const float pg = 1.f / gsum;
        const float* li = sl + 4 + gs * 8;
        int e0 = 0; float m0 = li[0];
        for (int e = 1; e < 8; ++e) if (li[e] > m0) { m0 = li[e]; e0 = e; }
        int e1 = -1; float m1 = -3e38f;
        for (int e = 0; e < 8; ++e) if (e != e0 && li[e] > m1) { m1 = li[e]; e1 = e; }
        const float p0 = 1.f, p1 = __expf(m1 - m0);
        const float w0 = pg * p0 / (p0 + p1), w1 = pg * p1 / (p0 + p1);
        const int x0 = gs * 8 + e0, x1 = gs * 8 + e1;
        const int s0 = (int)atomicAdd(&p.ctl[x0 * 32], 1u), s1 = (int)atomicAdd(&p.ctl[x1 * 32], 1u);
        p.list[(size_t)x0 * p.T + s0] = t; p.list[(size_t)x1 * p.T + s1] = t;
        p.tokexp[t * 2] = x0; p.tokexp[t * 2 + 1] = x1; p.tokslot[t * 2] = s0; p.tokslot[t * 2 + 1] = s1; p.tokw[t * 2] = w0; p.tokw[t * 2 + 1] = w1;
    }
}

__device__ __forceinline__ float tred8(float (&a)[8], int lane) {
    const bool b5 = lane & 32, b4 = lane & 16, b3 = lane & 8;
    float k4[4], k2[2], k1;
#pragma unroll
    for (int i = 0; i < 4; ++i) { const float snd = b5 ? a[i] : a[i + 4]; const float kp = b5 ? a[i + 4] : a[i]; k4[i] = kp + __shfl_xor(snd, 32); }
#pragma unroll
    for (int i = 0; i < 2; ++i) { const float snd = b4 ? k4[i] : k4[i + 2]; const float kp = b4 ? k4[i + 2] : k4[i]; k2[i] = kp + __shfl_xor(snd, 16); }
    { const float snd = b3 ? k2[0] : k2[1]; const float kp = b3 ? k2[1] : k2[0]; k1 = kp + __shfl_xor(snd, 8); }
    k1 += __shfl_xor(k1, 4); k1 += __shfl_xor(k1, 2); k1 += __shfl_xor(k1, 1);
    return k1;
}
__device__ __forceinline__ void body_route3(const P& p, int vb, char* smem) {
    const int tid = TIDX(), wave = tid >> 6, lane = tid & 63, t0 = vb * 64 + wave * 8;
    float4 v[8][4]; float ss[8];
#pragma unroll
    for (int tk = 0; tk < 8; ++tk) { const ushort4* hr = (const ushort4*)(p.h1b + (size_t)(t0 + tk) * D); float s = 0.f;
#pragma unroll
        for (int j = 0; j < 4; ++j) { const ushort4 hb = hr[lane + 64 * j]; v[tk][j] = make_float4(bf2f(hb.x), bf2f(hb.y), bf2f(hb.z), bf2f(hb.w)); s += v[tk][j].x * v[tk][j].x + v[tk][j].y * v[tk][j].y + v[tk][j].z * v[tk][j].z + v[tk][j].w * v[tk][j].w; }
        ss[tk] = s; }
    const float tot = tred8(ss, lane);
#pragma unroll
    for (int tk = 0; tk < 8; ++tk) { const float rstd = rsqrtf(__shfl(tot, tk * 8) * (1.f / D) + 1e-6f);
#pragma unroll
        for (int j = 0; j < 4; ++j) {
            const float4 g = ((const float4*)p.g_ffn)[lane + 64 * j];
            v[tk][j].x *= rstd * g.x; v[tk][j].y *= rstd * g.y; v[tk][j].z *= rstd * g.z; v[tk][j].w *= rstd * g.w;
            ushort4 o; o.x = f2bf(v[tk][j].x); o.y = f2bf(v[tk][j].y); o.z = f2bf(v[tk][j].z); o.w = f2bf(v[tk][j].w);
            ((ushort4*)(p.vb + (size_t)(t0 + tk) * D))[lane + 64 * j] = o; } }
    float* sl = (float*)smem + wave * (8 * 40);
    float* wl = (float*)smem + 4096;
    for (int o = 0; o < 36; ++o) {
        if (o == 0 || o == 18) { __syncthreads();
#pragma unroll
            for (int k = 0; k < 9; ++k) ((float4*)wl)[tid + k * 512] = ((const float4*)(p.wr + (size_t)o * 1024))[tid + k * 512];
            __syncthreads(); }
        const float4* wrow = (const float4*)(wl + (size_t)(o >= 18 ? o - 18 : o) * 1024); float a[8];
        float4 w[4];
#pragma unroll
        for (int j = 0; j < 4; ++j) w[j] = wrow[lane + 64 * j];
#pragma unroll
        for (int tk = 0; tk < 8; ++tk) { float s = 0.f;
#pragma unroll
            for (int j = 0; j < 4; ++j) s += v[tk][j].x * w[j].x + v[tk][j].y * w[j].y + v[tk][j].z * w[j].z + v[tk][j].w * w[j].w;
            a[tk] = s; }
        const float r = tred8(a, lane);
        if ((lane & 7) == 0) sl[(lane >> 3) * 40 + o] = r + (o < 4 ? p.b_grp[o] : p.b_exp[o - 4]); }
    asm volatile("s_waitcnt lgkmcnt(0)" ::: "memory");
    int* cntl = (int*)((float*)smem + 8 * 320); int* basel = cntl + 32;
    if (tid < 32) cntl[tid] = 0;
    __syncthreads();
    int x0 = 0, x1 = 0, l0 = 0, l1 = 0; float w0 = 0.f, w1 = 0.f;
    if (lane < 8) {
        const float* s8 = sl + lane * 40;
        int gs = 0; float gm = s8[0];
        for (int o = 1; o < 4; ++o) if (s8[o] > gm) { gm = s8[o]; gs = o; }
        float gsum = 0.f;
        for (int o = 0; o < 4; ++o) gsum += __expf(s8[o] - gm);
        const float pg = 1.f / gsum;
        const float* li = s8 + 4 + gs * 8;
        int e0 = 0; float m0 = li[0];
        for (int e = 1; e < 8; ++e) if (li[e] > m0) { m0 = li[e]; e0 = e; }
        int e1 = -1; float m1 = -3e38f;
        for (int e = 0; e < 8; ++e) if (e != e0 && li[e] > m1) { m1 = li[e]; e1 = e; }
        const float p0 = 1.f, p1 = __expf(m1 - m0);
        w0 = pg * p0 / (p0 + p1); w1 = pg * p1 / (p0 + p1);
        x0 = gs * 8 + e0; x1 = gs * 8 + e1;
        l0 = atomicAdd(&cntl[x0], 1); l1 = atomicAdd(&cntl[x1], 1);
    }
    __syncthreads();
    if (tid < 32) { const int c = cntl[tid]; basel[tid] = c > 0 ? (int)atomicAdd(&p.ctl[tid * 32], (unsigned)c) : 0; }
    __syncthreads();
    if (lane < 8) {
        const int t = t0 + lane; const int s0 = basel[x0] + l0, s1 = basel[x1] + l1;
        p.list[(size_t)x0 * p.T + s0] = t; p.list[(size_t)x1 * p.T + s1] = t;
        p.tokexp[t * 2] = x0; p.tokexp[t * 2 + 1] = x1; p.tokslot[t * 2] = s0; p.tokslot[t * 2 + 1] = s1; p.tokw[t * 2] = w0; p.tokw[t * 2 + 1] = w1;
    }
    __syncthreads();
}

__device__ __forceinline__ int* seg_bases(const P& p, char* smem) {
    int* sbase = (int*)(smem + LDS_MISC + 2048);
    __syncthreads();
    if (TIDX() == 0) { int acc = 0; for (int e = 0; e < NEXP; ++e) { sbase[e] = acc; acc += ((int)p.ctl[e * 32] + 255) & ~255; } sbase[NEXP] = acc; }
    __syncthreads();
    return sbase;
}
__device__ __forceinline__ void body_moe1(const P& p, int vb, char* smem) {
    int* sbase = seg_bases(p, smem); int* stok = sbase + 40;
    const int r0 = vb * 8; if (r0 >= sbase[NEXP]) return;
    int e = 0; while (r0 >= sbase[e + 1]) ++e;
    const int cnt = (int)p.ctl[e * 32];
    if (TIDX() < 8) { const int sl = r0 + TIDX() - sbase[e]; stok[TIDX()] = p.list[(size_t)e * p.T + (sl < cnt ? sl : 0)]; }
    __syncthreads();
    const int n = TIDX();
    const float* wg = p.w_gate + (size_t)e * 1024 * 512; const float* wu = p.w_up + (size_t)e * 1024 * 512;
    ngemm<1024, true, true>((float*)smem, 0, wg, 512, n, wu, 512, n,
        [&](int m, int k) { return bf2f(p.vb[(size_t)stok[m] * D + k]); }, [&](int m, int k) { return 0.f; },
        [&](int m, float zg, float zu) { p.H[(size_t)(r0 + m) * 512 + n] = f2bf(siluf_(zg) * zu); });
}
__device__ __forceinline__ void body_moe2(const P& p, int vb, char* smem) {
    int* sbase = seg_bases(p, smem);
    const int r0 = (vb >> 1) * 8; if (r0 >= sbase[NEXP]) return;
    int e = 0; while (r0 >= sbase[e + 1]) ++e;
    const int n = (vb & 1) * NT + TIDX();
    const float* wd = p.w_down + (size_t)e * 512 * 1024;
    ngemm<512, false, true>((float*)smem, r0, wd, 1024, n, wd, 1024, n,
        [&](int m, int k) { return bf2f(p.H[(size_t)m * 512 + k]); }, [&](int m, int k) { return 0.f; },
        [&](int m, float z, float) { p.Y[(size_t)m * 1024 + n] = f2bf(z); });
}
__device__ __forceinline__ void body_final(const P& p, int vb, char* smem) {
    int* sbase = seg_bases(p, smem);
    const int lane = TIDX() & 63, t = vb * 8 + (TIDX() >> 6);
    const int r0 = sbase[p.tokexp[t * 2]] + p.tokslot[t * 2], r1 = sbase[p.tokexp[t * 2 + 1]] + p.tokslot[t * 2 + 1];
    const float w0 = p.tokw[t * 2], w1 = p.tokw[t * 2 + 1];
    const float4* hr = (const float4*)(p.h1 + (size_t)t * D);
    float4 v[4]; float ss = 0.f;
#pragma unroll
    for (int j = 0; j < 4; ++j) {
        float4 a = hr[lane + 64 * j];
        const ushort4 y0 = ((const ushort4*)(p.Y + (size_t)r0 * D))[lane + 64 * j], y1 = ((const ushort4*)(p.Y + (size_t)r1 * D))[lane + 64 * j];
        a.x += w0 * bf2f(y0.x) + w1 * bf2f(y1.x); a.y += w0 * bf2f(y0.y) + w1 * bf2f(y1.y); a.z += w0 * bf2f(y0.z) + w1 * bf2f(y1.z); a.w += w0 * bf2f(y0.w) + w1 * bf2f(y1.w);
        v[j] = a; ss += a.x * a.x + a.y * a.y + a.z * a.z + a.w * a.w;
    }
#pragma unroll
    for (int o = 1; o < 64; o <<= 1) ss += __shfl_xor(ss, o);
    const float rstd = rsqrtf(ss * (1.f / D) + 1e-6f);
#pragma unroll
    for (int j = 0; j < 4; ++j) {
        const float4 g = ((const float4*)p.g_final)[lane + 64 * j];
        float4 o; o.x = v[j].x * rstd * g.x; o.y = v[j].y * rstd * g.y; o.z = v[j].z * rstd * g.z; o.w = v[j].w * rstd * g.w;
        ((float4*)(p.out + (size_t)t * D))[lane + 64 * j] = o;
    }
}

__device__ __forceinline__ void body_final_b(const P& p, int vb, char* smem) {
    int* sbase = seg_bases(p, smem);
    const int lane = TIDX() & 63, t = vb * 8 + (TIDX() >> 6);
    const int r0 = sbase[p.tokexp[t * 2]] + p.tokslot[t * 2], r1 = sbase[p.tokexp[t * 2 + 1]] + p.tokslot[t * 2 + 1];
    const float w0 = p.tokw[t * 2], w1 = p.tokw[t * 2 + 1];
    float4 v[4]; float ss = 0.f;
#pragma unroll
    for (int j = 0; j < 4; ++j) {
        const ushort4 hb = ((const ushort4*)(p.h1b + (size_t)t * D))[lane + 64 * j];
        const ushort4 y0 = ((const ushort4*)(p.Y + (size_t)r0 * D))[lane + 64 * j], y1 = ((const ushort4*)(p.Y + (size_t)r1 * D))[lane + 64 * j];
        float4 a; a.x = bf2f(hb.x) + w0 * bf2f(y0.x) + w1 * bf2f(y1.x); a.y = bf2f(hb.y) + w0 * bf2f(y0.y) + w1 * bf2f(y1.y); a.z = bf2f(hb.z) + w0 * bf2f(y0.z) + w1 * bf2f(y1.z); a.w = bf2f(hb.w) + w0 * bf2f(y0.w) + w1 * bf2f(y1.w);
        v[j] = a; ss += a.x * a.x + a.y * a.y + a.z * a.z + a.w * a.w;
    }
#pragma unroll
    for (int o = 1; o < 64; o <<= 1) ss += __shfl_xor(ss, o);
    const float rstd = rsqrtf(ss * (1.f / D) + 1e-6f);
#pragma unroll
    for (int j = 0; j < 4; ++j) {
        const float4 g = ((const float4*)p.g_final)[lane + 64 * j];
        float4 o; o.x = v[j].x * rstd * g.x; o.y = v[j].y * rstd * g.y; o.z = v[j].z * rstd * g.z; o.w = v[j].w * rstd * g.w;
        ((float4*)(p.out + (size_t)t * D))[lane + 64 * j] = o;
    }
}

namespace pg8 {
#define PG8_LAS __attribute__((address_space(3)))
typedef short bf16x8 __attribute__((ext_vector_type(8)));
typedef float f32x4 __attribute__((ext_vector_type(4)));
typedef unsigned u32x4 __attribute__((ext_vector_type(4)));
typedef unsigned u32x2 __attribute__((ext_vector_type(2)));
constexpr int BM = 256, BK = 64, HALF = 128, HTB = HALF * BK * 2, STAGE_BYTES = 8 * HTB, NXCD = 8, WGM = 8;

__host__ __device__ __forceinline__ int lds_byte(int r, int c) { const int st = (r >> 4) * 2 + (c >> 5), rr = r & 15, cc = c & 31, ob = rr * 64 + cc * 2; return st * 1024 + (ob ^ (((ob >> 9) & 1) << 5)); }
__host__ __device__ __forceinline__ void stage_rc(int b, int& R, int& C) { const int st = b / 1024, sb = b % 1024, swz = sb ^ (((sb >> 9) & 1) << 5); R = (st >> 1) * 16 + swz / 64; C = (st & 1) * 32 + (swz % 64) / 2; }
__host__ __device__ __forceinline__ int perm32(int rho) { const int n = rho >> 4, i = rho & 15; return 8 * (i >> 2) + 4 * n + (i & 3); }

struct Unit { int pm, pn; const char* A; const char* B; int tag; };

struct TileOrder {
    int nM, nN, nwg, G, c;
    __device__ void init(int nM_, int nN_, int G_, int c_) { nM = nM_; nN = nN_; nwg = nM * nN; G = G_; c = c_; }
    __device__ bool next(int i, int& pm, int& pn) const {
        const long L = (long)i * G + c; if (L >= nwg) return false;
        int wgid = (int)L; { const int q = nwg / NXCD, r = nwg % NXCD, xcd = wgid % NXCD, off = wgid / NXCD; wgid = (xcd < r ? xcd * (q + 1) : r * (q + 1) + (xcd - r) * q) + off; }
        const int nig = WGM * nN, gid = wgid / nig, fm = gid * WGM, gsz = (nM - fm) < WGM ? (nM - fm) : WGM;
        pm = fm + ((wgid % nig) % gsz); pn = (wgid % nig) / gsz; return true;
    }
};
struct DenseSched {
    TileOrder o; const char* A; const char* B; int lda, ldb;
    __device__ void init(const void* A_, const void* B_, int M, int N, int lda_, int ldb_) { A = (const char*)A_; B = (const char*)B_; lda = lda_; ldb = ldb_; o.init(M / BM, N / BM, gridDim.x, blockIdx.x); }
    __device__ __forceinline__ bool next(int i, Unit& u) const { if (!o.next(i, u.pm, u.pn)) return false; u.A = A + (size_t)u.pm * BM * lda * 2; u.B = B + (size_t)u.pn * BM * ldb * 2; u.tag = 0; return true; }
    __device__ __forceinline__ unsigned arow(const Unit&, int r) const { return (unsigned)r * (unsigned)lda * 2u; }
};

__device__ __forceinline__ unsigned cvt_pk_bf16(float lo, float hi) { unsigned r; asm volatile("v_cvt_pk_bf16_f32 %0, %1, %2" : "=v"(r) : "v"(lo), "v"(hi)); return r; }

template <class Epi, class Sched, bool ALIGN_EPI, bool GATHER>
__device__ __forceinline__ void gemm_phase(PG8_LAS unsigned char* lds, const int K, const int lda, const int ldb, const Sched& S, const Epi& E) {
    const int tid = TIDX(), wid = __builtin_amdgcn_readfirstlane(tid >> 6), lane = tid & 63, wr = wid >> 2, wc = wid & 3, fr = lane & 15, fq = lane >> 4;
    const int nt = K / BK;
    int sR[2], sC[2];
    unsigned voffA[2], voffB[2];
#pragma unroll
    for (int i = 0; i < 2; ++i) { stage_rc(tid * 16 + i * 8192, sR[i], sC[i]); const int Rb = Epi::PERM ? ((sR[i] & ~31) + perm32(sR[i] & 31)) : sR[i];
        voffA[i] = (unsigned)(sR[i] * lda + sC[i]) * 2u; voffB[i] = (unsigned)(Rb * ldb + sC[i]) * 2u; }
    unsigned gA[2][2], gN[2][2];
    const size_t kstep = (size_t)(BK * 2);
    const size_t hstepA = (size_t)HALF * lda * 2, hstepB = (size_t)HALF * ldb * 2;
    const unsigned ldsw = (unsigned)wid * 1024u;
    const int aoff = lds_byte(wr * 64 + fr, fq * 8), boff = lds_byte(wc * 32 + fr, fq * 8);
#define PG8_SA(b, h) (((b) * 2 + (h)) * HTB)
#define PG8_SB(b, h) ((4 + (b) * 2 + (h)) * HTB)
#define PG8_GLDS(bufoff, gptr, i_) __builtin_amdgcn_global_load_lds((const unsigned*)(gptr), (PG8_LAS unsigned*)(lds + (bufoff) + ldsw + (i_) * 8192), 16, 0, 0)
#define PG8_STAGE_B(bufoff, gbase) do { _Pragma("unroll") for (int _i = 0; _i < 2; ++_i) PG8_GLDS(bufoff, (const char*)(gbase) + voffB[_i], _i); } while (0)
#define PG8_STAGE_A(bufoff, gb, h, NX) do { _Pragma("unroll") for (int _i = 0; _i < 2; ++_i) { \
        if constexpr (GATHER) { const unsigned _o = (NX) ? gN[h][_i] : gA[h][_i]; PG8_GLDS(bufoff, (const char*)(gb) + _o, _i); } \
        else { PG8_GLDS(bufoff, (const char*)(gb) + (h) * hstepA + voffA[_i], _i); } } } while (0)
#define PG8_LDA(dst, b, h) do { _Pragma("unroll") for (int m = 0; m < 4; ++m) _Pragma("unroll") for (int k = 0; k < 2; ++k) dst[m][k] = *(const PG8_LAS bf16x8*)(lds + PG8_SA(b, h) + aoff + m * 2048 + k * 1024); } while (0)
#define PG8_LDB(dst, b, h) do { _Pragma("unroll") for (int n = 0; n < 2; ++n) _Pragma("unroll") for (int k = 0; k < 2; ++k) dst[n][k] = *(const PG8_LAS bf16x8*)(lds + PG8_SB(b, h) + boff + n * 2048 + k * 1024); } while (0)
#define PG8_MMA(ai, bj, At, Bt) do { __builtin_amdgcn_s_setprio(1); _Pragma("unroll") for (int m = 0; m < 4; ++m) _Pragma("unroll") for (int n = 0; n < 2; ++n) _Pragma("unroll") for (int k = 0; k < 2; ++k) \
        acc[ai][bj][m][n] = __builtin_amdgcn_mfma_f32_16x16x32_bf16(Bt[n][k], At[m][k], acc[ai][bj][m][n], 0, 0, 0); __builtin_amdgcn_s_setprio(0); } while (0)
#define PG8_WAIT_V(n) asm volatile("s_waitcnt vmcnt(" #n ")" ::: "memory")
#define PG8_WAIT_L(n) asm volatile("s_waitcnt lgkmcnt(" #n ")" ::: "memory")
#define PG8_BAR __builtin_amdgcn_s_barrier()
#define PG8_SCHED __builtin_amdgcn_sched_barrier(0)
#define PG8_GOFF(dst, u) do { if constexpr (GATHER) { _Pragma("unroll") for (int _h = 0; _h < 2; ++_h) _Pragma("unroll") for (int _i = 0; _i < 2; ++_i) dst[_h][_i] = S.arow(u, _h * HALF + sR[_i]) + (unsigned)sC[_i] * 2u; } } while (0)
    Unit cur, nxt; int ui = 0;
    if (!S.next(0, cur)) return;
    f32x4 acc[2][2][4][2];
#pragma unroll
    for (int a = 0; a < 2; ++a)
#pragma unroll
        for (int b = 0; b < 2; ++b)
#pragma unroll
            for (int m = 0; m < 4; ++m)
#pragma unroll
                for (int n = 0; n < 2; ++n) acc[a][b][m][n] = (f32x4){0.f, 0.f, 0.f, 0.f};
    bf16x8 At[4][2], B0[2][2], B1[2][2];
    const char* cA = cur.A; const char* cB = cur.B;
    PG8_GOFF(gA, cur);
    if constexpr (GATHER) { PG8_WAIT_V(0); }
    PG8_STAGE_B(PG8_SB(0, 0), cB); PG8_STAGE_B(PG8_SB(0, 1), cB + hstepB); PG8_STAGE_A(PG8_SA(0, 0), cA, 0, false); PG8_STAGE_A(PG8_SA(0, 1), cA, 1, false);
    if (wr == 1) PG8_BAR;
    PG8_WAIT_V(2); PG8_BAR;
    PG8_STAGE_B(PG8_SB(1, 0), cB + kstep); PG8_STAGE_A(PG8_SA(1, 0), cA + kstep, 0, false); PG8_STAGE_B(PG8_SB(1, 1), cB + hstepB + kstep);
    PG8_WAIT_V(6); PG8_BAR;
    for (;;) {
        const bool has_next = S.next(ui + 1, nxt);
        const char* nA = has_next ? nxt.A : cA; const char* nB = has_next ? nxt.B : cB;
        if constexpr (GATHER) { if (has_next) { PG8_GOFF(gN, nxt); } else {
#pragma unroll
            for (int _h = 0; _h < 2; ++_h)
#pragma unroll
                for (int _i = 0; _i < 2; ++_i) gN[_h][_i] = gA[_h][_i]; } }
        for (int t = 0; t < nt; t += 2) {
            const bool last = (t == nt - 2);
            const char* a1 = cA + (size_t)(t + 1) * kstep;
            const char* a2 = last ? nA : cA + (size_t)(t + 2) * kstep; const char* b2 = last ? nB : cB + (size_t)(t + 2) * kstep;
            const char* a3 = a2 + kstep; const char* b3 = b2 + kstep;
            PG8_LDB(B0, 0, 0); PG8_LDB(B1, 0, 1); PG8_SCHED; PG8_LDA(At, 0, 0); PG8_STAGE_A(PG8_SA(1, 1), a1, 1, false);
            PG8_WAIT_V(8); PG8_WAIT_L(0); PG8_BAR; PG8_MMA(0, 0, At, B0); PG8_MMA(0, 1, At, B1); PG8_BAR; PG8_SCHED;
            PG8_LDA(At, 0, 1); PG8_STAGE_B(PG8_SB(0, 0), b2); PG8_STAGE_B(PG8_SB(0, 1), b2 + hstepB); PG8_STAGE_A(PG8_SA(0, 0), a2, 0, last);
            PG8_WAIT_V(8); PG8_WAIT_L(0); PG8_BAR; PG8_MMA(1, 0, At, B0); PG8_MMA(1, 1, At, B1); PG8_BAR; PG8_SCHED;
            PG8_LDB(B0, 1, 0); PG8_LDB(B1, 1, 1); PG8_SCHED; PG8_LDA(At, 1, 0); PG8_STAGE_A(PG8_SA(0, 1), a2, 1, last);
            PG8_WAIT_V(8); PG8_WAIT_L(0); PG8_BAR; PG8_MMA(0, 0, At, B0); PG8_MMA(0, 1, At, B1); PG8_BAR; PG8_SCHED;
            PG8_LDA(At, 1, 1); PG8_STAGE_B(PG8_SB(1, 0), b3); PG8_STAGE_B(PG8_SB(1, 1), b3 + hstepB); PG8_STAGE_A(PG8_SA(1, 0), a3, 0, last);
            PG8_WAIT_V(8); PG8_WAIT_L(0); PG8_BAR; PG8_MMA(1, 0, At, B0); PG8_MMA(1, 1, At, B1); PG8_BAR; PG8_SCHED;
        }
        if constexpr (ALIGN_EPI) { if (wr == 0) PG8_BAR; }
        E(acc, cur, wr, wc, fr, fq);
        if (!has_next) break;
#pragma unroll
        for (int a = 0; a < 2; ++a)
#pragma unroll
            for (int b = 0; b < 2; ++b)
#pragma unroll
                for (int m = 0; m < 4; ++m)
#pragma unroll
                    for (int n = 0; n < 2; ++n) acc[a][b][m][n] = (f32x4){0.f, 0.f, 0.f, 0.f};
        cur = nxt; cA = nA; cB = nB; ++ui;
        if constexpr (GATHER) {
#pragma unroll
            for (int _h = 0; _h < 2; ++_h)
#pragma unroll
                for (int _i = 0; _i < 2; ++_i) gA[_h][_i] = gN[_h][_i]; }
        if constexpr (ALIGN_EPI) { if (wr == 1) PG8_BAR; }
    }
    PG8_WAIT_V(0);
    if constexpr (!ALIGN_EPI) { if (wr == 0) PG8_BAR; }
    PG8_BAR;
#undef PG8_SA
#undef PG8_SB
#undef PG8_GLDS
#undef PG8_STAGE_A
#undef PG8_STAGE_B
#undef PG8_LDA
#undef PG8_LDB
#undef PG8_MMA
#undef PG8_WAIT_V
#undef PG8_WAIT_L
#undef PG8_BAR
#undef PG8_SCHED
#undef PG8_GOFF
}
}

typedef float f32x4_t __attribute__((ext_vector_type(4)));
__device__ __forceinline__ int inproj_row(int j) {
    if (j < 512) { const int h = j >> 6, d = j & 63; return h * 64 + 2 * (d & 31) + (d >> 5); }
    if (j < 1280) { const int seg = (j - 512) >> 7, cc = (j - 512) & 127; int col = cc; if (seg == 2 || seg == 4) { const int g = cc >> 6, d = cc & 63; col = g * 64 + 2 * (d & 31) + (d >> 5); } return (2 + (seg >> 1)) * 256 + (seg & 1) * 128 + col; }
    if (j < 1304) return 11 * 256 + (j - 1280);
    if (j < 1560) return 5 * 256 + (j - 1304);
    if (j < 1816) return 6 * 256 + (j - 1560);
    if (j < 2328) return 7 * 256 + (j - 1816);
    if (j < 2344) return 11 * 256 + 32 + (j - 2328);
    if (j < 2856) return 9 * 256 + (j - 2344);
    if (j < 3880) return 12 * 256 + (j - 2856);
    return 16 * 256 + (j - 3880);
}
__device__ __forceinline__ unsigned pk2(float lo, float hi) { return (unsigned)f2bf(lo) | ((unsigned)f2bf(hi) << 16); }
template <class RM>
__device__ __forceinline__ void transpose_item(const float* W, int ldw, int N, bf16* WT, int ldt, float* scr, int k0, int n0, int lane, RM rm) {
    const int rr = lane >> 4, c4 = (lane & 15) * 4; const bool inb = n0 + c4 < N;
    f32x4_t v[16];
#pragma unroll
    for (int i = 0; i < 16; ++i) v[i] = inb ? *(const f32x4_t*)(W + (size_t)(k0 + 4 * i + rr) * ldw + n0 + c4) : (f32x4_t){0.f, 0.f, 0.f, 0.f};
#pragma unroll
    for (int i = 0; i < 16; ++i) *(f32x4_t*)(scr + (4 * i + rr) * 68 + c4) = v[i];
    asm volatile("s_waitcnt lgkmcnt(0)" ::: "memory");
    const int c = lane & 7;
#pragma unroll
    for (int j = 0; j < 8; ++j) { const int n = (lane >> 3) + 8 * j; const float* s = scr + (8 * c) * 68 + n;
        uint4 o; o.x = pk2(s[0 * 68], s[1 * 68]); o.y = pk2(s[2 * 68], s[3 * 68]); o.z = pk2(s[4 * 68], s[5 * 68]); o.w = pk2(s[6 * 68], s[7 * 68]);
        const int row = (n0 + n < N) ? rm(n0 + n) : -1;
        if (row >= 0) *(uint4*)(WT + (size_t)row * ldt + k0 + 8 * c) = o; }
    asm volatile("s_waitcnt lgkmcnt(0)" ::: "memory");
}
constexpr int PREP_I_WIN = 16 * 77, PREP_I_C1 = 4 * 64, PREP_I_PN = 128, PREP_I_PG = 128, PREP_I_WO = 256, PREP_I_EXP = 3 * 32 * 128;
constexpr int PREP_ITEMS = PREP_I_WIN + PREP_I_C1 + PREP_I_PN + PREP_I_PG + PREP_I_WO + PREP_I_EXP;
__device__ __forceinline__ void prep_item(const P& p, int it, float* scr, int lane) {
    if (it < PREP_I_WIN) { const int kb = it / 77, nb = it % 77; transpose_item(p.w_in, INW, INW, p.Wt_in, 1024, scr, kb * 64, nb * 64, lane, [](int n) { return inproj_row(n); }); return; }
    it -= PREP_I_WIN;
    if (it < PREP_I_C1) { const int mat = it >> 6, r = it & 63, kb = r >> 2, nb = r & 3, kv = mat >> 1, half = mat & 1;
        const float* W = (kv ? p.cw1_v : p.cw1_k) + (size_t)half * 1024 * 256;
        transpose_item(W, 256, 256, p.Wc1 + (size_t)kv * 512 * 1024, 1024, scr, kb * 64, nb * 64, lane, [half](int n) { return half * 256 + n; }); return; }
    it -= PREP_I_C1;
    if (it < PREP_I_PN) { transpose_item(p.w_pn, 1024, 1024, p.Wpn, 512, scr, (it >> 4) * 64, (it & 15) * 64, lane, [](int n) { return n; }); return; }
    it -= PREP_I_PN;
    if (it < PREP_I_PG) { transpose_item(p.w_pg, 1024, 1024, p.Wpg, 512, scr, (it >> 4) * 64, (it & 15) * 64, lane, [](int n) { return n; }); return; }
    it -= PREP_I_PG;
    if (it < PREP_I_WO) { transpose_item(p.w_out, 1024, 1024, p.Wo, 1024, scr, (it >> 4) * 64, (it & 15) * 64, lane, [](int n) { return n; }); return; }
    it -= PREP_I_WO;
    { const int which = it / (32 * 128), r = it % (32 * 128), e = r >> 7, r2 = r & 127;
        if (which == 0) transpose_item(p.w_gate + (size_t)e * 1024 * 512, 512, 512, p.Wgu + (size_t)e * 1024 * 1024, 1024, scr, (r2 >> 3) * 64, (r2 & 7) * 64, lane, [](int n) { return (n >> 7) * 256 + (n & 127); });
        else if (which == 1) transpose_item(p.w_up + (size_t)e * 1024 * 512, 512, 512, p.Wgu + (size_t)e * 1024 * 1024, 1024, scr, (r2 >> 3) * 64, (r2 & 7) * 64, lane, [](int n) { return (n >> 7) * 256 + 128 + (n & 127); });
        else transpose_item(p.w_down + (size_t)e * 512 * 1024, 1024, 1024, p.Wd + (size_t)e * 1024 * 512, 512, scr, (r2 >> 4) * 64, (r2 & 15) * 64, lane, [](int n) { return n; }); }
}
__device__ __forceinline__ void phase_prep_(const P& p, char* smem);
__device__ __forceinline__ void prep_b1p(const P& p, char* smem);
__device__ __forceinline__ void phase_prep(const P& p, char* smem) { prep_b1p(p, smem); phase_prep_(p, smem); }
__device__ __forceinline__ void phase_prep_(const P& p, char* smem) {
    const int wave = TIDX() >> 6, lane = TIDX() & 63;
    float* scr = (float*)smem + wave * (64 * 68);
    const int gw = blockIdx.x * 8 + wave, NGW = gridDim.x * 8;
    for (int it = gw; it < PREP_ITEMS; it += NGW) prep_item(p, it, scr, lane);
    for (int i = blockIdx.x * NT + TIDX(); i < 216 * 128; i += gridDim.x * NT) { int r = i >> 7; r = r < 8 ? 24 + r : 40 + r; *(uint4*)(p.Wt_in + (size_t)(11 * 256 + r) * 1024 + (i & 127) * 8) = make_uint4(0, 0, 0, 0); }
    for (int i = blockIdx.x * NT + TIDX(); i < 36 * 1024; i += gridDim.x * NT) { const int o = i >> 10, k = i & 1023; p.wr[i] = o < 4 ? p.w_grp[k * 4 + o] : p.w_exp[k * 32 + (o - 4)]; }
    for (int vb = blockIdx.x; vb < p.T / 16; vb += gridDim.x) body_rms2(p, vb);
    for (int vb = blockIdx.x; vb < p.T * 32 / NT; vb += gridDim.x) body_cs(p, vb);
}

struct EpiInA {
    static constexpr bool PERM = true;
    P p;
    __device__ __forceinline__ static void rope4(const float* cs, int t, int i0, const pg8::f32x4& v0, const pg8::f32x4& v1, float sc, pg8::u32x2& lo, pg8::u32x2& hi) {
        const f32x4_t c = *(const f32x4_t*)(cs + (size_t)t * 64 + i0), s = *(const f32x4_t*)(cs + (size_t)t * 64 + 32 + i0);
        const float a0 = (v0[0] * c[0] - v0[1] * s[0]) * sc, b0 = (v0[1] * c[0] + v0[0] * s[0]) * sc;
        const float a1 = (v0[2] * c[1] - v0[3] * s[1]) * sc, b1 = (v0[3] * c[1] + v0[2] * s[1]) * sc;
        const float a2 = (v1[0] * c[2] - v1[1] * s[2]) * sc, b2 = (v1[1] * c[2] + v1[0] * s[2]) * sc;
        const float a3 = (v1[2] * c[3] - v1[3] * s[3]) * sc, b3 = (v1[3] * c[3] + v1[2] * s[3]) * sc;
        lo.x = pk2(a0, a1); lo.y = pk2(a2, a3); hi.x = pk2(b0, b1); hi.y = pk2(b2, b3);
    }
    __device__ __forceinline__ static pg8::u32x4 pack8(const pg8::f32x4& v0, const pg8::f32x4& v1) { pg8::u32x4 w; w.x = pk2(v0[0], v0[1]); w.y = pk2(v0[2], v0[3]); w.z = pk2(v1[0], v1[1]); w.w = pk2(v1[2], v1[3]); return w; }
    __device__ __forceinline__ void operator()(const pg8::f32x4 (&acc)[2][2][4][2], const pg8::Unit& u, int wr, int wc, int fr, int fq) const {
        const int pn = u.pn, c8 = wc * 32 + 8 * fq; const size_t seg = kvseg(p);
#pragma unroll
        for (int ai = 0; ai < 2; ++ai)
#pragma unroll
            for (int m = 0; m < 4; ++m) {
                const int t = u.pm * 256 + ai * 128 + wr * 64 + m * 16 + fr; const int b = t / S, s = t % S;
#pragma unroll
                for (int bj = 0; bj < 2; ++bj) {
                    const pg8::f32x4 v0 = acc[ai][bj][m][0], v1 = acc[ai][bj][m][1];
                    if (pn <= 1) {
                        const int cq = pn * 256 + bj * 128 + c8, h = cq >> 6, i0 = (cq & 63) >> 1; pg8::u32x2 lo, hi;
                        rope4(p.cs, t, i0, v0, v1, 0.125f, lo, hi);
                        bf16* dst = p.q + (size_t)t * 512 + h * 64 + i0; *(pg8::u32x2*)dst = lo; *(pg8::u32x2*)(dst + 32) = hi;
                    } else if (pn <= 4) {
                        const int sgi = (pn - 2) * 2 + bj, g = c8 >> 6; bf16* base = p.kv6 + (size_t)sgi * seg + ((size_t)(b * 2 + g) * S + s) * 64;
                        if (bj == 0 && pn >= 3) { const int i0 = (c8 & 63) >> 1; pg8::u32x2 lo, hi; rope4(p.cs, t, i0, v0, v1, 1.f, lo, hi); *(pg8::u32x2*)(base + i0) = lo; *(pg8::u32x2*)(base + 32 + i0) = hi; }
                        else *(pg8::u32x4*)(base + (c8 & 63)) = pack8(v0, v1);
                    } else if (pn == 5) { *(pg8::u32x4*)(p.gq + (size_t)t * 256 + bj * 128 + c8) = pack8(v0 * 0.125f, v1 * 0.125f);
                    } else if (pn == 6) { *(pg8::u32x4*)(p.gk + (size_t)t * 256 + bj * 128 + c8) = pack8(v0, v1);
                    } else if (pn <= 8) { *(pg8::u32x4*)(p.gv + (size_t)t * 512 + (pn - 7) * 256 + bj * 128 + c8) = pack8(v0, v1);
                    } else if (pn <= 10) {
                        pg8::f32x4 a, c;
#pragma unroll
                        for (int e = 0; e < 4; ++e) { a[e] = siluf_(v0[e]); c[e] = siluf_(v1[e]); }
                        *(pg8::u32x4*)(p.rs + (size_t)t * 512 + (pn - 9) * 256 + bj * 128 + c8) = pack8(a, c);
                    } else {
                        if (bj == 0) {
                            if (c8 < 24) { float* d = p.gates + (size_t)t * 24 + c8;
#pragma unroll
                                for (int e = 0; e < 4; ++e) { d[e] = sigmoidf_(v0[e]); d[4 + e] = sigmoidf_(v1[e]); } }
                            else if (c8 >= 32 && c8 < 48) { float* d = p.alow + (size_t)t * 16 + (c8 - 32);
#pragma unroll
                                for (int e = 0; e < 4; ++e) { d[e] = v0[e]; d[4 + e] = v1[e]; } }
                        }
                    }
                }
            }
    }
};
struct EpiSig {
    static constexpr bool PERM = true;
    bf16* sa; bf16* sb;
    __device__ __forceinline__ void operator()(const pg8::f32x4 (&acc)[2][2][4][2], const pg8::Unit& u, int wr, int wc, int fr, int fq) const {
        bf16* base = (u.pn < 4 ? sa : sb) + (u.pn & 3) * 256 + wc * 32 + 8 * fq;
#pragma unroll
        for (int ai = 0; ai < 2; ++ai)
#pragma unroll
            for (int m = 0; m < 4; ++m) { const int t = u.pm * 256 + ai * 128 + wr * 64 + m * 16 + fr;
#pragma unroll
                for (int bj = 0; bj < 2; ++bj) { pg8::f32x4 a, c;
#pragma unroll
                    for (int e = 0; e < 4; ++e) { a[e] = sigmoidf_(acc[ai][bj][m][0][e]); c[e] = sigmoidf_(acc[ai][bj][m][1][e]); }
                    *(pg8::u32x4*)(base + (size_t)t * 1024 + bj * 128) = EpiInA::pack8(a, c); } }
    }
};
__device__ __forceinline__ void phase_inA(const P& p, char* smem) {
    pg8::DenseSched S; S.init(p.u, p.Wt_in, p.T, 3072, 1024, 1024);
    EpiInA E{p};
    pg8::gemm_phase<EpiInA, pg8::DenseSched, true, false>((PG8_LAS unsigned char*)smem, 1024, 1024, 1024, S, E);
}
__device__ __forceinline__ void phase_inB(const P& p, char* smem) {
    pg8::DenseSched S; S.init(p.u, p.Wt_in + (size_t)3072 * 1024, p.T, 2048, 1024, 1024);
    EpiSig E{p.sa, p.sb};
    pg8::gemm_phase<EpiSig, pg8::DenseSched, true, false>((PG8_LAS unsigned char*)smem, 1024, 1024, 1024, S, E);
}

struct EpiProj {
    static constexpr bool PERM = true;
    const bf16* g; bf16* mixed; int pass;
    __device__ __forceinline__ void operator()(const pg8::f32x4 (&acc)[2][2][4][2], const pg8::Unit& u, int wr, int wc, int fr, int fq) const {
        const int col0 = u.pn * 256 + wc * 32 + 8 * fq;
#pragma unroll
        for (int ai = 0; ai < 2; ++ai)
#pragma unroll
            for (int m = 0; m < 4; ++m) { const size_t t = (size_t)(u.pm * 256 + ai * 128 + wr * 64 + m * 16 + fr);
#pragma unroll
                for (int bj = 0; bj < 2; ++bj) { const size_t off = t * 1024 + col0 + bj * 128;
                    const uint4 gv = *(const uint4*)(g + off); const unsigned gw[4] = {gv.x, gv.y, gv.z, gv.w};
                    float r[8];
#pragma unroll
                    for (int e = 0; e < 4; ++e) { const float a = e < 2 ? acc[ai][bj][m][0][2 * e] : acc[ai][bj][m][1][2 * e - 4], b = e < 2 ? acc[ai][bj][m][0][2 * e + 1] : acc[ai][bj][m][1][2 * e - 3];
                        r[2 * e] = __uint_as_float(gw[e] << 16) * a; r[2 * e + 1] = __uint_as_float(gw[e] & 0xffff0000u) * b; }
                    if (pass) { const uint4 mv = *(const uint4*)(mixed + off); const unsigned mw[4] = {mv.x, mv.y, mv.z, mv.w};
#pragma unroll
                        for (int e = 0; e < 4; ++e) { r[2 * e] += __uint_as_float(mw[e] << 16); r[2 * e + 1] += __uint_as_float(mw[e] & 0xffff0000u); } }
                    uint4 o; o.x = pk2(r[0], r[1]); o.y = pk2(r[2], r[3]); o.z = pk2(r[4], r[5]); o.w = pk2(r[6], r[7]);
                    *(uint4*)(mixed + off) = o; } }
    }
};
struct EpiOut {
    static constexpr bool PERM = true;
    const float* x; bf16* h1b;
    __device__ __forceinline__ void operator()(const pg8::f32x4 (&acc)[2][2][4][2], const pg8::Unit& u, int wr, int wc, int fr, int fq) const {
        const int col0 = u.pn * 256 + wc * 32 + 8 * fq;
#pragma unroll
        for (int ai = 0; ai < 2; ++ai)
#pragma unroll
            for (int m = 0; m < 4; ++m) { const size_t off = (size_t)(u.pm * 256 + ai * 128 + wr * 64 + m * 16 + fr) * 1024 + col0;
#pragma unroll
                for (int bj = 0; bj < 2; ++bj) { const pg8::f32x4 x0 = *(const pg8::f32x4*)(x + off + bj * 128), x1 = *(const pg8::f32x4*)(x + off + bj * 128 + 4);
                    *(pg8::u32x4*)(h1b + off + bj * 128) = EpiInA::pack8(x0 + acc[ai][bj][m][0], x1 + acc[ai][bj][m][1]); } }
    }
};
__device__ __forceinline__ void phase_proj(const P& p, char* smem) {
    { pg8::DenseSched S; S.init(p.onsa, p.Wpn, p.T, 1024, 512, 512); EpiProj E{p.sa, p.mixed, 0};
      pg8::gemm_phase<EpiProj, pg8::DenseSched, true, false>((PG8_LAS unsigned char*)smem, 512, 512, 512, S, E); }
    { pg8::DenseSched S; S.init(p.gla, p.Wpg, p.T, 1024, 512, 512); EpiProj E{p.sb, p.mixed, 1};
      pg8::gemm_phase<EpiProj, pg8::DenseSched, true, false>((PG8_LAS unsigned char*)smem, 512, 512, 512, S, E); }
}
__device__ __forceinline__ void phase_out(const P& p, char* smem) {
    pg8::DenseSched S; S.init(p.mixed, p.Wo, p.T, 1024, 1024, 1024); EpiOut E{p.x, p.h1b};
    pg8::gemm_phase<EpiOut, pg8::DenseSched, true, false>((PG8_LAS unsigned char*)smem, 1024, 1024, 1024, S, E);
}

struct ExpertSched {
    const int* ub;
    const int* sb_;
    const unsigned* cnt; const int* list; int T;
    const char* A; const char* B; int lda, ldb; size_t bstride;
    int npn, G, c; bool gather;
    __device__ __forceinline__ bool next(int i, pg8::Unit& u) const {
        const int L = i * G + c; if (L >= ub[NEXP]) return false;
        int e = 0; while (L >= ub[e + 1]) ++e;
        const int rem = L - ub[e], tiles = (ub[e + 1] - ub[e]) / npn, pn = rem / tiles, pml = rem % tiles;
        u.pm = sb_[e] / 256 + pml; u.pn = pn; u.tag = e | (pml << 8);
        u.A = gather ? A : A + (size_t)u.pm * 256 * lda * 2; u.B = B + (size_t)e * bstride + (size_t)pn * 256 * ldb * 2; return true;
    }
    __device__ __forceinline__ unsigned arow(const pg8::Unit& u, int r) const {
        const int e = u.tag & 255, sl = (u.tag >> 8) * 256 + r; const int tok = list[(size_t)e * T + (sl < (int)cnt[e * 32] ? sl : 0)];
        return (unsigned)tok * (unsigned)lda * 2u;
    }
};
__device__ __forceinline__ void expert_tables(const P& p, char* smem, int npn, int*& ub, int*& sb_) {
    ub = (int*)(smem + LDS_MISC + 1024); sb_ = ub + 40;
    __syncthreads();
    if (TIDX() == 0) { int ua = 0, sa = 0; for (int e = 0; e < NEXP; ++e) { ub[e] = ua; sb_[e] = sa; const int tl = ((int)p.ctl[e * 32] + 255) >> 8; ua += tl * npn; sa += tl * 256; } ub[NEXP] = ua; sb_[NEXP] = sa; }
    __syncthreads();
}
struct EpiMoe1 {
    static constexpr bool PERM = true;
    bf16* H;
    __device__ __forceinline__ void operator()(const pg8::f32x4 (&acc)[2][2][4][2], const pg8::Unit& u, int wr, int wc, int fr, int fq) const {
        const int col0 = u.pn * 128 + wc * 32 + 8 * fq;
#pragma unroll
        for (int ai = 0; ai < 2; ++ai)
#pragma unroll
            for (int m = 0; m < 4; ++m) { const size_t row = (size_t)(u.pm * 256 + ai * 128 + wr * 64 + m * 16 + fr);
                pg8::f32x4 a, b;
#pragma unroll
                for (int e = 0; e < 4; ++e) { a[e] = siluf_(acc[ai][0][m][0][e]) * acc[ai][1][m][0][e]; b[e] = siluf_(acc[ai][0][m][1][e]) * acc[ai][1][m][1][e]; }
                *(pg8::u32x4*)(H + row * 512 + col0) = EpiInA::pack8(a, b); }
    }
};
struct EpiMoe2 {
    static constexpr bool PERM = true;
    bf16* Y;
    __device__ __forceinline__ void operator()(const pg8::f32x4 (&acc)[2][2][4][2], const pg8::Unit& u, int wr, int wc, int fr, int fq) const {
        const int col0 = u.pn * 256 + wc * 32 + 8 * fq;
#pragma unroll
        for (int ai = 0; ai < 2; ++ai)
#pragma unroll
            for (int m = 0; m < 4; ++m) { const size_t row = (size_t)(u.pm * 256 + ai * 128 + wr * 64 + m * 16 + fr);
#pragma unroll
                for (int bj = 0; bj < 2; ++bj) *(pg8::u32x4*)(Y + row * 1024 + col0 + bj * 128) = EpiInA::pack8(acc[ai][bj][m][0], acc[ai][bj][m][1]); }
    }
};
__device__ __forceinline__ void phase_moe1(const P& p, char* smem) {
    int *ub, *sb_; expert_tables(p, smem, 4, ub, sb_);
    ExpertSched S{ub, sb_, p.ctl, p.list, p.T, (const char*)p.vb, (const char*)p.Wgu, 1024, 1024, (size_t)1024 * 1024 * 2, 4, (int)gridDim.x, (int)blockIdx.x, true};
    EpiMoe1 E{p.H};
    pg8::gemm_phase<EpiMoe1, ExpertSched, true, true>((PG8_LAS unsigned char*)smem, 1024, 1024, 1024, S, E);
}
__device__ __forceinline__ void phase_moe2(const P& p, char* smem) {
    int *ub, *sb_; expert_tables(p, smem, 4, ub, sb_);
    ExpertSched S{ub, sb_, p.ctl, p.list, p.T, (const char*)p.H, (const char*)p.Wd, 512, 512, (size_t)1024 * 512 * 2, 4, (int)gridDim.x, (int)blockIdx.x, false};
    EpiMoe2 E{p.Y};
    pg8::gemm_phase<EpiMoe2, ExpertSched, true, false>((PG8_LAS unsigned char*)smem, 512, 512, 512, S, E);
}

namespace nsa {
using f32x16 = __attribute__((ext_vector_type(16))) float;
using bf16x8 = __attribute__((ext_vector_type(8))) short;
using s16x4 = __attribute__((ext_vector_type(4))) short;
using u32x4 = __attribute__((ext_vector_type(4))) unsigned;
typedef __attribute__((address_space(3))) char* lptr;
typedef __attribute__((address_space(3))) const char* lcptr;
constexpr int SLOT = 8192;
constexpr int NSLOT = 3;
constexpr int L_K = 0, L_V = NSLOT * SLOT, L_WS = 2 * NSLOT * SLOT, L_OST = L_WS + 8 * 512, L_IMPD = L_OST + 8 * 4096, L_IMPC = L_IMPD + 64 * 64 * 4, L_SEL = L_IMPC + 64 * 68 * 4, L_END = L_SEL + 64 * 8;
constexpr float LOG2E = 1.4426950408889634f, NEGM = -1e30f, M0 = -1e20f, THR = 8.f;
__device__ __forceinline__ int crow(int r, int hi) { return (r & 3) + 8 * (r >> 2) + 4 * hi; }
__device__ __forceinline__ void glds16(const void* gsrc, unsigned lds_dst) { unsigned keep;
    asm volatile("s_mov_b32 %0, m0\n\ts_mov_b32 m0, %2\n\ts_nop 0\n\tglobal_load_lds_dwordx4 %1, off\n\ts_mov_b32 m0, %0" : "=&s"(keep) : "v"(gsrc), "s"(lds_dst) : "memory"); }
#define NSA_WAIT_BAR() asm volatile("s_waitcnt vmcnt(2) lgkmcnt(0)\n\ts_barrier" ::: "memory")
#define NSA_DRAIN_BAR() asm volatile("s_waitcnt vmcnt(0) lgkmcnt(0)\n\ts_barrier" ::: "memory")
#define NSA_LWAIT() asm volatile("s_waitcnt lgkmcnt(0)" ::: "memory")
__device__ __forceinline__ unsigned cvtpk(float lo, float hi) { typedef float f2 __attribute__((ext_vector_type(2))); typedef __bf16 b2 __attribute__((ext_vector_type(2))); f2 v = {lo, hi}; b2 b = __builtin_convertvector(v, b2); return __builtin_bit_cast(unsigned, b); }
__device__ __forceinline__ float xhalf_max(float m) { auto rr = __builtin_amdgcn_permlane32_swap(__float_as_uint(m), __float_as_uint(m), false, false); return fmaxf(__uint_as_float(rr[0]), __uint_as_float(rr[1])); }
__device__ __forceinline__ float xhalf_sum(float m) { auto rr = __builtin_amdgcn_permlane32_swap(__float_as_uint(m), __float_as_uint(m), false, false); return __uint_as_float(rr[0]) + __uint_as_float(rr[1]); }
__device__ __forceinline__ void qkt(f32x16& p0, f32x16& p1, lcptr Kslot, const bf16x8* qr, int r32, int hi) {
    lcptr kb = Kslot + hi * 1024 + r32 * 16;
    p0 = f32x16{}; p1 = f32x16{};
#pragma unroll
    for (int d0 = 0; d0 < 4; ++d0) {
        const bf16x8 b0 = *(const __attribute__((address_space(3))) bf16x8*)(kb + d0 * 2048);
        const bf16x8 b1 = *(const __attribute__((address_space(3))) bf16x8*)(kb + d0 * 2048 + 512);
        p0 = __builtin_amdgcn_mfma_f32_32x32x16_bf16(b0, qr[d0], p0, 0, 0, 0); p1 = __builtin_amdgcn_mfma_f32_32x32x16_bf16(b1, qr[d0], p1, 0, 0, 0); }
}
__device__ __forceinline__ void pv(f32x16* o, int vb, bf16x8 pa0, bf16x8 pa1, bf16x8 pa2, bf16x8 pa3) {
#pragma unroll
    for (int d0 = 0; d0 < 2; ++d0) { s16x4 lo[4], hi[4];
#pragma unroll
        for (int ks = 0; ks < 4; ++ks) {
            asm volatile("ds_read_b64_tr_b16 %0,%1 offset:%c2" : "=&v"(lo[ks]) : "v"(vb), "i"(d0 * 4096 + ks * 1024) : "memory");
            asm volatile("ds_read_b64_tr_b16 %0,%1 offset:%c2" : "=&v"(hi[ks]) : "v"(vb), "i"(d0 * 4096 + ks * 1024 + 512) : "memory"); }
        asm volatile("s_waitcnt lgkmcnt(0)" ::: "memory"); __builtin_amdgcn_sched_barrier(0);
#define NSA_PK(k) (bf16x8){lo[k][0], lo[k][1], lo[k][2], lo[k][3], hi[k][0], hi[k][1], hi[k][2], hi[k][3]}
        o[d0] = __builtin_amdgcn_mfma_f32_32x32x16_bf16(pa0, NSA_PK(0), o[d0], 0, 0, 0);
        o[d0] = __builtin_amdgcn_mfma_f32_32x32x16_bf16(pa1, NSA_PK(1), o[d0], 0, 0, 0);
        o[d0] = __builtin_amdgcn_mfma_f32_32x32x16_bf16(pa2, NSA_PK(2), o[d0], 0, 0, 0);
        o[d0] = __builtin_amdgcn_mfma_f32_32x32x16_bf16(pa3, NSA_PK(3), o[d0], 0, 0, 0);
#undef NSA_PK
    }
}
__device__ __forceinline__ float rowmax32(const f32x16& p0, const f32x16& p1) {
    float a = fmaxf(p0[0], p1[0]);
#pragma unroll
    for (int r = 1; r < 16; ++r) a = fmaxf(a, fmaxf(p0[r], p1[r]));
    return xhalf_max(a);
}
struct Ctx {
    int w, lane, r32, hi, rs; unsigned lds0; lptr shm; const bf16* kt; const bf16* vt;
};
__device__ __forceinline__ void dma_kv(const Ctx& c, int tile, int slot) {
    const bf16* ksrc = c.kt + (size_t)tile * 64 * 64 + c.lane * 64 + c.w * 8;
    const bf16* vsrc = c.vt + (size_t)tile * 64 * 64 + (16 * (c.w & 3) + (c.lane >> 2)) * 64 + (c.w >> 2) * 32 + (c.lane & 3) * 8;
    glds16(ksrc, (unsigned)__builtin_amdgcn_readfirstlane(c.lds0 + L_K + slot * SLOT + c.w * 1024));
    glds16(vsrc, (unsigned)__builtin_amdgcn_readfirstlane(c.lds0 + L_V + slot * SLOT + c.w * 1024));
}
template <int ABL = 0> __device__ __forceinline__ void ring_begin(Ctx& c, int t0, int t1) { NSA_DRAIN_BAR(); if (!(ABL & 8)) { dma_kv(c, t0, 0); dma_kv(c, t1 >= 0 ? t1 : t0, 1); } c.rs = 0; }
template <int ABL = 0> __device__ __forceinline__ void ring_step(Ctx& c, int t2, int tcur) { if (!(ABL & 16)) NSA_WAIT_BAR(); int s2 = c.rs + 2; if (s2 >= NSLOT) s2 -= NSLOT; if (!(ABL & 8)) dma_kv(c, t2 >= 0 ? t2 : tcur, s2); }
__device__ __forceinline__ void ring_next(Ctx& c) { c.rs = (c.rs == NSLOT - 1) ? 0 : c.rs + 1; }
template <int ABL> __device__ __forceinline__ void softmax_pv(const Ctx& c, f32x16& p0, f32x16& p1, f32x16* o, float& m, float& l, int slot, bool on) {
    float a0 = fmaxf(fmaxf(p0[0], p0[1]), p1[0]), a1 = fmaxf(fmaxf(p0[2], p0[3]), p1[1]), a2 = fmaxf(fmaxf(p0[4], p0[5]), p1[2]), a3 = fmaxf(fmaxf(p0[6], p0[7]), p1[3]);
    a0 = fmaxf(fmaxf(a0, p0[8]), p0[9]); a1 = fmaxf(fmaxf(a1, p0[10]), p0[11]); a2 = fmaxf(fmaxf(a2, p0[12]), p0[13]); a3 = fmaxf(fmaxf(a3, p0[14]), p0[15]);
    a0 = fmaxf(fmaxf(a0, p1[4]), p1[5]); a1 = fmaxf(fmaxf(a1, p1[6]), p1[7]); a2 = fmaxf(fmaxf(a2, p1[8]), p1[9]); a3 = fmaxf(fmaxf(a3, p1[10]), p1[11]);
    a0 = fmaxf(fmaxf(a0, p1[12]), p1[13]); a1 = fmaxf(fmaxf(a1, p1[14]), p1[15]);
    float rm = xhalf_max(fmaxf(fmaxf(a0, a1), fmaxf(a2, a3)));
    rm = on ? rm : NEGM;
    volatile __attribute__((address_space(3))) float* wsf = (volatile __attribute__((address_space(3))) float*)(c.shm + L_WS + c.w * 512);
    bool resc = false;
    if (__any(rm > m + THR)) { const float mn = fmaxf(m, rm); const float f = __builtin_amdgcn_exp2f(m - mn); l *= f; m = mn; if (c.hi == 0) wsf[c.r32] = f; resc = true; }
    const float ms = on ? m : 1e30f;
    float s0 = 0.f, s1 = 0.f, s2 = 0.f, s3 = 0.f;
#pragma unroll
    for (int r = 0; r < 16; r += 2) {
        if (!(ABL & 2)) { p0[r] = __builtin_amdgcn_exp2f(p0[r] - ms); p0[r + 1] = __builtin_amdgcn_exp2f(p0[r + 1] - ms); p1[r] = __builtin_amdgcn_exp2f(p1[r] - ms); p1[r + 1] = __builtin_amdgcn_exp2f(p1[r + 1] - ms); }
        else { p0[r] -= ms; p0[r + 1] -= ms; p1[r] -= ms; p1[r + 1] -= ms; }
        s0 += p0[r]; s1 += p0[r + 1]; s2 += p1[r]; s3 += p1[r + 1]; }
    l += (s0 + s1) + (s2 + s3);
    if (resc) { NSA_LWAIT();
#pragma unroll
        for (int r = 0; r < 16; ++r) { const float f = wsf[crow(r, c.hi)]; o[0][r] *= f; o[1][r] *= f; } }
    u32x4 w0, w1, w2, w3;
    w0 = (u32x4){cvtpk(p0[0], p0[1]), cvtpk(p0[2], p0[3]), cvtpk(p0[4], p0[5]), cvtpk(p0[6], p0[7])};
    w1 = (u32x4){cvtpk(p0[8], p0[9]), cvtpk(p0[10], p0[11]), cvtpk(p0[12], p0[13]), cvtpk(p0[14], p0[15])};
    w2 = (u32x4){cvtpk(p1[0], p1[1]), cvtpk(p1[2], p1[3]), cvtpk(p1[4], p1[5]), cvtpk(p1[6], p1[7])};
    w3 = (u32x4){cvtpk(p1[8], p1[9]), cvtpk(p1[10], p1[11]), cvtpk(p1[12], p1[13]), cvtpk(p1[14], p1[15])};
    const int vb = (int)(c.lds0 + L_V + slot * SLOT) + ((c.lane >> 4) & 1) * 32 + (c.lane & 3) * 8 + (4 * c.hi + ((c.lane & 15) >> 2)) * 64;
    if (!(ABL & 1)) pv(o, vb, __builtin_bit_cast(bf16x8, w0), __builtin_bit_cast(bf16x8, w1), __builtin_bit_cast(bf16x8, w2), __builtin_bit_cast(bf16x8, w3));
    else { asm volatile("" :: "v"(w0), "v"(w1), "v"(w2), "v"(w3)); }
}
__device__ __forceinline__ void accum_branch(const Ctx& c, f32x16* oacc, const f32x16* o, float fac) {
    volatile __attribute__((address_space(3))) float* wsf = (volatile __attribute__((address_space(3))) float*)(c.shm + L_WS + c.w * 512);
    NSA_LWAIT(); if (c.hi == 0) wsf[64 + c.r32] = fac; NSA_LWAIT();
#pragma unroll
    for (int r = 0; r < 16; ++r) { const float f = wsf[64 + crow(r, c.hi)]; oacc[0][r] += o[0][r] * f; oacc[1][r] += o[1][r] * f; }
    NSA_LWAIT();
}
template <int ABL> __device__ __forceinline__ void nsa_unit(const P& p, char* smem, int b, int g, int jq) {
    const int tid = TIDX(); Ctx c; c.lane = tid & 63; c.w = __builtin_amdgcn_readfirstlane(tid >> 6); c.r32 = c.lane & 31; c.hi = c.lane >> 5;
    c.shm = (lptr)smem; c.lds0 = (unsigned)(size_t)c.shm;
    const int hh = c.r32 >> 3, tokl = 8 * c.w + (c.r32 & 7), stok = 64 * jq + tokl, h = g * 4 + hh; const size_t t = (size_t)b * S + stok;
    const size_t seg = kvseg(p), ho = (size_t)(b * 2 + g) * S * 64;
    bf16x8 qr[4];
#pragma unroll
    for (int d0 = 0; d0 < 4; ++d0) { const u32x4 raw = *(const u32x4*)(p.q + t * 512 + h * 64 + d0 * 16 + c.hi * 8); u32x4 sc;
#pragma unroll
        for (int e4 = 0; e4 < 4; ++e4) sc[e4] = cvtpk(__uint_as_float(raw[e4] << 16) * LOG2E, __uint_as_float(raw[e4] & 0xffff0000u) * LOG2E);
        qr[d0] = __builtin_bit_cast(bf16x8, sc); }
    const float g0 = p.gates[t * 24 + h * 3], g1 = p.gates[t * 24 + h * 3 + 1], g2 = p.gates[t * 24 + h * 3 + 2];
    f32x16 oacc[2], o[2], p0, p1; oacc[0] = f32x16{}; oacc[1] = f32x16{};
    __attribute__((address_space(3))) float* impD = (__attribute__((address_space(3))) float*)(c.shm + L_IMPD);
    __attribute__((address_space(3))) float* impC = (__attribute__((address_space(3))) float*)(c.shm + L_IMPC);
    __attribute__((address_space(3))) u64* selm = (__attribute__((address_space(3))) u64*)(c.shm + L_SEL);
    const int nv = stok >= 31 ? (stok - 31) / 16 + 1 : 0;
    const int nct = (4 * jq + 3 + 63) >> 6;
    c.kt = p.kcmp + (size_t)(b * 2 + g) * 256 * 64; c.vt = p.vcmp + (size_t)(b * 2 + g) * 256 * 64;
    float m = M0, l = 0.f;
    if (tid < 64) impC[tid * 68] = 0.f;
    ring_begin(c, 0, nct > 1 ? 1 : -1);
    for (int ct = 0; ct < ((ABL & 64) ? 0 : nct); ++ct) {
        ring_step(c, ct + 2 < nct ? ct + 2 : -1, ct);
        qkt(p0, p1, (lcptr)(c.shm + L_K + c.rs * SLOT), qr, c.r32, c.hi); ring_next(c);
#pragma unroll
        for (int r = 0; r < 16; ++r) { const int n = 64 * ct + crow(r, c.hi); p0[r] = n < nv ? p0[r] : NEGM; p1[r] = n + 32 < nv ? p1[r] : NEGM; }
        const float rm = rowmax32(p0, p1); const float mn = fmaxf(m, rm); float sacc = 0.f;
#pragma unroll
        for (int r = 0; r < 16; ++r) sacc += __builtin_amdgcn_exp2f(p0[r] - mn) + __builtin_amdgcn_exp2f(p1[r] - mn);
        l = l * __builtin_amdgcn_exp2f(m - mn) + sacc; m = mn;
    }
    l = xhalf_sum(l); const float il = l > 0.f ? 1.f / l : 0.f;
    o[0] = f32x16{}; o[1] = f32x16{};
    ring_begin(c, 0, nct > 1 ? 1 : -1);
    for (int ct = 0; ct < ((ABL & 64) ? 0 : nct); ++ct) {
        ring_step(c, ct + 2 < nct ? ct + 2 : -1, ct);
        qkt(p0, p1, (lcptr)(c.shm + L_K + c.rs * SLOT), qr, c.r32, c.hi);
#pragma unroll
        for (int r = 0; r < 16; ++r) { const int n = 64 * ct + crow(r, c.hi); p0[r] = n < nv ? __builtin_amdgcn_exp2f(p0[r] - m) * il : 0.f; p1[r] = n + 32 < nv ? __builtin_amdgcn_exp2f(p1[r] - m) * il : 0.f; }
#pragma unroll
        for (int hb = 0; hb < 2; ++hb)
#pragma unroll
            for (int rg = 0; rg < 4; ++rg) {
                const f32x16& pp = hb ? p1 : p0;
                float dsum = pp[4 * rg] + pp[4 * rg + 1] + pp[4 * rg + 2] + 0.5f * pp[4 * rg + 3], csum = 0.5f * pp[4 * rg + 3];
                dsum += __shfl_xor(dsum, 8); dsum += __shfl_xor(dsum, 16); csum += __shfl_xor(csum, 8); csum += __shfl_xor(csum, 16);
                const int j = 16 * ct + 8 * hb + 2 * rg + c.hi;
                if (c.r32 < 8) { impD[tokl * 64 + j] = dsum; impC[tokl * 68 + j + 1] = csum; }
            }
        u32x4 w0, w1, w2, w3;
        w0 = (u32x4){cvtpk(p0[0], p0[1]), cvtpk(p0[2], p0[3]), cvtpk(p0[4], p0[5]), cvtpk(p0[6], p0[7])};
        w1 = (u32x4){cvtpk(p0[8], p0[9]), cvtpk(p0[10], p0[11]), cvtpk(p0[12], p0[13]), cvtpk(p0[14], p0[15])};
        w2 = (u32x4){cvtpk(p1[0], p1[1]), cvtpk(p1[2], p1[3]), cvtpk(p1[4], p1[5]), cvtpk(p1[6], p1[7])};
        w3 = (u32x4){cvtpk(p1[8], p1[9]), cvtpk(p1[10], p1[11]), cvtpk(p1[12], p1[13]), cvtpk(p1[14], p1[15])};
        const int vb = (int)(c.lds0 + L_V + c.rs * SLOT) + ((c.lane >> 4) & 1) * 32 + (c.lane & 3) * 8 + (4 * c.hi + ((c.lane & 15) >> 2)) * 64;
        pv(o, vb, __builtin_bit_cast(bf16x8, w0), __builtin_bit_cast(bf16x8, w1), __builtin_bit_cast(bf16x8, w2), __builtin_bit_cast(bf16x8, w3));
        ring_next(c);
    }
    accum_branch(c, oacc, o, g0);
    NSA_LWAIT(); __builtin_amdgcn_s_barrier();
    {
#pragma unroll 1
        for (int tkk = 0; tkk < 8; ++tkk) { const int tk = 8 * c.w + tkk, j = c.lane; const bool valid = j <= jq;
            const float sc = (j == 0 || j == jq || j == jq - 1) ? 1e4f : impD[tk * 64 + j] + impC[tk * 68 + j];
            const unsigned key = valid ? ((__float_as_uint(sc) & ~63u) | (unsigned)(63 - j)) : 0u;
            int rank = 0;
            if (!(ABL & 32)) {
#pragma unroll
                for (int i = 0; i < 64; ++i) { const unsigned ki = (unsigned)__builtin_amdgcn_readlane((int)key, i); rank += (ki > key) ? 1 : 0; } }
            const u64 mk = __ballot(valid && rank < 16);
            if (j == 0) { selm[tk] = mk; p.sel[((size_t)b * S + 64 * jq + tk) * 2 + g] = mk; } }
    }
    NSA_LWAIT(); __builtin_amdgcn_s_barrier();
    const u64 mysel = selm[tokl];
    u64 uni = selm[c.lane];
#pragma unroll
    for (int x = 1; x < 64; x <<= 1) { const unsigned lo_ = __shfl_xor((unsigned)uni, x), hi_ = __shfl_xor((unsigned)(uni >> 32), x); uni |= (u64)lo_ | ((u64)hi_ << 32); }
    const unsigned ulo = __builtin_amdgcn_readfirstlane((unsigned)uni), uhi = __builtin_amdgcn_readfirstlane((unsigned)(uni >> 32));
    {
        c.kt = p.kv6 + 2 * seg + ho; c.vt = p.kv6 + 3 * seg + ho;
        u64 rem = (u64)ulo | ((u64)uhi << 32);
        m = M0; l = 0.f; o[0] = f32x16{}; o[1] = f32x16{};
        int j = __builtin_ctzll(rem); rem &= rem - 1;
        int j1 = rem ? __builtin_ctzll(rem) : -1; if (rem) rem &= rem - 1;
        ring_begin<ABL>(c, j, j1);
        for (;;) {
            const int j2 = rem ? __builtin_ctzll(rem) : -1; if (rem) rem &= rem - 1;
            ring_step<ABL>(c, j2, j);
            if (!(ABL & 4)) qkt(p0, p1, (lcptr)(c.shm + L_K + c.rs * SLOT), qr, c.r32, c.hi); else { asm volatile("" : "+v"(p0), "+v"(p1)); }
            const bool on = (mysel >> j) & 1ull;
            if (j == jq) {
#pragma unroll
                for (int r = 0; r < 16; ++r) { const int kr = crow(r, c.hi); p0[r] = (kr <= tokl) ? p0[r] : NEGM; p1[r] = (kr + 32 <= tokl) ? p1[r] : NEGM; } }
            softmax_pv<ABL>(c, p0, p1, o, m, l, c.rs, on); ring_next(c);
            if (j1 < 0) break; j = j1; j1 = j2;
        }
        l = xhalf_sum(l);
        accum_branch(c, oacc, o, g1 / l);
    }
    {
        c.kt = p.kv6 + 4 * seg + ho; c.vt = p.kv6 + 5 * seg + ho;
        const int j0 = jq >= 8 ? jq - 8 : 0;
        m = M0; l = 0.f; o[0] = f32x16{}; o[1] = f32x16{};
        ring_begin<ABL>(c, j0, j0 + 1 <= jq ? j0 + 1 : -1);
        for (int j = j0; j <= jq; ++j) {
            ring_step<ABL>(c, j + 2 <= jq ? j + 2 : -1, j);
            if (!(ABL & 4)) qkt(p0, p1, (lcptr)(c.shm + L_K + c.rs * SLOT), qr, c.r32, c.hi); else { asm volatile("" : "+v"(p0), "+v"(p1)); }
            const bool lowt = (jq >= 8 && j == jq - 8), diag = (j == jq);
            if (diag || lowt) {
#pragma unroll
                for (int r = 0; r < 16; ++r) { const int kr = crow(r, c.hi);
                    const bool v0 = diag ? (kr <= tokl) : (kr > tokl), v1 = diag ? (kr + 32 <= tokl) : (kr + 32 > tokl);
                    p0[r] = v0 ? p0[r] : NEGM; p1[r] = v1 ? p1[r] : NEGM; } }
            softmax_pv<ABL>(c, p0, p1, o, m, l, c.rs, true); ring_next(c);
        }
        l = xhalf_sum(l);
        accum_branch(c, oacc, o, g2 / l);
    }
    {
        __attribute__((address_space(3))) bf16* stg = (__attribute__((address_space(3))) bf16*)(c.shm + L_OST + c.w * 4096);
#pragma unroll
        for (int r = 0; r < 16; ++r) { const int orow = crow(r, c.hi);
#pragma unroll
            for (int d0 = 0; d0 < 2; ++d0) stg[orow * 64 + d0 * 32 + c.r32] = f2bf(oacc[d0][r]); }
        NSA_LWAIT();
#pragma unroll
        for (int i = 0; i < 4; ++i) { const int row = i * 8 + (c.lane >> 3), ch = c.lane & 7; const u32x4 v = *(const __attribute__((address_space(3))) u32x4*)(stg + row * 64 + ch * 8);
            const int rh = row >> 3, rt = 8 * c.w + (row & 7);
            *(u32x4*)(p.onsa + ((size_t)b * S + 64 * jq + rt) * 512 + (g * 4 + rh) * 64 + ch * 8) = v; }
    }
    NSA_DRAIN_BAR();
}
}
template <int ABL = 0> __device__ __forceinline__ void phase_nsa(const P& p, char* smem) {
    const int nunits = p.nb * 2 * 64;
    const int G = gridDim.x; int r = 0;
    for (int base = 0; base < nunits; base += G, ++r) {
        const int w = (r & 1) ? G - 1 - (int)blockIdx.x : (int)blockIdx.x, i = base + w; if (i >= nunits) continue;
        const int jq = 63 - i / (p.nb * 2), bg = i % (p.nb * 2); nsa::nsa_unit<ABL>(p, smem, bg >> 1, bg & 1, jq); }
}

namespace gla {
using nsa::f32x16; using nsa::bf16x8; using nsa::s16x4; using nsa::u32x4; using nsa::lptr; using nsa::lcptr; using nsa::crow; using nsa::cvtpk;
typedef unsigned u32x2 __attribute__((ext_vector_type(2)));
constexpr int L_KI = 0, L_QI = 8192, L_VI = 16384, L_SI = 32768, L_OST = 49152, L_TOT = L_OST + 64 * 132 * 4, L_END = L_TOT + 8 * 64 * 4 + 64 * 4;
__device__ __forceinline__ int koff(int row, int d) { return (d >> 3) * 1024 + row * 16 + (d & 7) * 2; }
__device__ __forceinline__ int voff(int row, int col) { return ((col >> 5) * 4 + (row >> 4)) * 1024 + (row & 15) * 64 + (col & 31) * 2; }
__device__ __forceinline__ bf16x8 trfrag(unsigned img, int ks, int cb, int lane) {
    const int hi = lane >> 5; const unsigned a = img + (cb * 4 + ks) * 1024 + ((lane >> 4) & 1) * 32 + (lane & 3) * 8 + (4 * hi + ((lane & 15) >> 2)) * 64;
    s16x4 lo, hh;
    asm volatile("ds_read_b64_tr_b16 %0,%1" : "=&v"(lo) : "v"(a) : "memory");
    asm volatile("ds_read_b64_tr_b16 %0,%1 offset:512" : "=&v"(hh) : "v"(a) : "memory");
    asm volatile("s_waitcnt lgkmcnt(0)" ::: "memory"); __builtin_amdgcn_sched_barrier(0);
    return (bf16x8){lo[0], lo[1], lo[2], lo[3], hh[0], hh[1], hh[2], hh[3]};
}
template <int GM> __device__ __forceinline__ void chunk_images(const P& p, lptr shm, int b, int h, int c, int tid) {
    const int d = tid & 63, tg = tid >> 6; const size_t t0 = (size_t)b * S + c * 64;
    __attribute__((address_space(3))) float* tot = (__attribute__((address_space(3))) float*)(shm + L_TOT);
    bf16 kraw[8], qraw[8];
#pragma unroll
    for (int i = 0; i < 8; ++i) { kraw[i] = p.gk[(t0 + tg * 8 + i) * 256 + h * 64 + d]; qraw[i] = GM ? p.gq[(t0 + tg * 8 + i) * 256 + h * 64 + d] : (bf16)0; }
    float wa[16];
#pragma unroll
    for (int r = 0; r < 16; ++r) wa[r] = p.w_a2[r * 256 + h * 64 + d];
    const float ba = p.b_a[h * 64 + d];
    __attribute__((address_space(3))) float* als = (__attribute__((address_space(3))) float*)(shm + L_OST);
    { const f32x4_t a4 = tid < 256 ? *(const f32x4_t*)(p.alow + t0 * 16 + tid * 4) : (f32x4_t){0.f, 0.f, 0.f, 0.f}; if (tid < 256) *(__attribute__((address_space(3))) f32x4_t*)(als + tid * 4) = a4; }
    __syncthreads();
    float loc[8]; float run = 0.f;
#pragma unroll
    for (int i = 0; i < 8; ++i) { const __attribute__((address_space(3))) float* al = als + (tg * 8 + i) * 16; float z = ba;
#pragma unroll
        for (int r = 0; r < 16; ++r) z += al[r] * wa[r];
        const float ls = fminf(z, 0.f) - log1pf(__expf(-fabsf(z))); run += ls * (1.f / 16.f); loc[i] = run; }
    tot[tg * 64 + d] = run;
#pragma unroll
    for (int k = 0; k < 2; ++k) { const int idx = tid + k * 512, s = idx >> 4, e = (idx & 15) * 8; *(__attribute__((address_space(3))) u32x4*)(shm + L_VI + voff(s, e)) = *(const u32x4*)(p.gv + (t0 + s) * 512 + h * 128 + e); }
    __syncthreads();
    float pre = 0.f, all = 0.f;
#pragma unroll
    for (int g = 0; g < 8; ++g) { const float x = tot[g * 64 + d]; all += x; pre += g < tg ? x : 0.f; }
#pragma unroll
    for (int i = 0; i < 8; ++i) { const int t = tg * 8 + i; const float bb = pre + loc[i]; const float kk = bf2f(kraw[i]);
        if (GM == 0) { *(__attribute__((address_space(3))) bf16*)(shm + L_KI + voff(t, d)) = f2bf(kk * __expf(all - bb)); }
        else { const float qq = bf2f(qraw[i]);
            *(__attribute__((address_space(3))) bf16*)(shm + L_KI + koff(t, d)) = f2bf(kk * __expf(-bb)); *(__attribute__((address_space(3))) bf16*)(shm + L_QI + koff(t, d)) = f2bf(qq * __expf(bb)); } }
    if (GM == 0 && tg == 0) p.gdec[((size_t)(b * 4 + h) * 64 + c) * 64 + d] = __expf(all);
    __syncthreads();
}
__device__ __forceinline__ void g1_chunk(const P& p, char* smem, int b, int h, int c) {
    const int tid = TIDX(), lane = tid & 63, w = __builtin_amdgcn_readfirstlane(tid >> 6), r32 = lane & 31, hi = lane >> 5;
    lptr shm = (lptr)smem; const unsigned l0 = (unsigned)(size_t)shm;
    chunk_images<0>(p, shm, b, h, c, tid);
    const int db = w & 1, eb = w >> 1; f32x16 acc = f32x16{};
#pragma unroll
    for (int ks = 0; ks < 4; ++ks) { const bf16x8 a = trfrag(l0 + L_KI, ks, db, lane), bq = trfrag(l0 + L_VI, ks, eb, lane); acc = __builtin_amdgcn_mfma_f32_32x32x16_bf16(a, bq, acc, 0, 0, 0); }
    float* U = p.gst + ((size_t)(b * 4 + h) * 64 + c) * (64 * 128);
#pragma unroll
    for (int r = 0; r < 16; ++r) U[(32 * db + crow(r, hi)) * 128 + 32 * eb + r32] = acc[r];
    __syncthreads();
}
__device__ __forceinline__ void g3_chunk(const P& p, char* smem, int b, int h, int c) {
    const int tid = TIDX(), lane = tid & 63, w = __builtin_amdgcn_readfirstlane(tid >> 6), r32 = lane & 31, hi = lane >> 5;
    lptr shm = (lptr)smem; const unsigned l0 = (unsigned)(size_t)shm; const size_t t0 = (size_t)b * S + c * 64;
    const float* St = p.gst + ((size_t)(b * 4 + h) * 64 + c) * (64 * 128);
    float4 sv[4];
#pragma unroll
    for (int k = 0; k < 4; ++k) sv[k] = *(const float4*)(St + (size_t)(tid + k * 512) * 4);
    const size_t go_ = (t0 + (tid >> 3)) * 512 + h * 128 + (tid & 7) * 16;
    const uint4 rs0 = *(const uint4*)(p.rs + go_), rs1 = *(const uint4*)(p.rs + go_ + 8);
    chunk_images<1>(p, shm, b, h, c, tid);
#pragma unroll
    for (int k = 0; k < 4; ++k) { const int idx = (tid + k * 512) * 4, dd = idx >> 7, e = idx & 127; u32x2 o; o.x = cvtpk(sv[k].x, sv[k].y); o.y = cvtpk(sv[k].z, sv[k].w);
        *(__attribute__((address_space(3))) u32x2*)(shm + L_SI + voff(dd, e)) = o; }
    __syncthreads();
    const int tb = w & 1, eb = w >> 1, trow = 32 * tb + r32;
    f32x16 p0 = f32x16{}, p1 = f32x16{}, o = f32x16{};
    {
        lcptr kb = (lcptr)(shm + L_KI) + hi * 1024 + r32 * 16; lcptr qb = (lcptr)(shm + L_QI) + hi * 1024 + trow * 16;
#pragma unroll
        for (int d0 = 0; d0 < 4; ++d0) {
            const bf16x8 b0 = *(const __attribute__((address_space(3))) bf16x8*)(kb + d0 * 2048), b1 = *(const __attribute__((address_space(3))) bf16x8*)(kb + d0 * 2048 + 512);
            const bf16x8 qf = *(const __attribute__((address_space(3))) bf16x8*)(qb + d0 * 2048);
            p0 = __builtin_amdgcn_mfma_f32_32x32x16_bf16(b0, qf, p0, 0, 0, 0); p1 = __builtin_amdgcn_mfma_f32_32x32x16_bf16(b1, qf, p1, 0, 0, 0); }
    }
#pragma unroll
    for (int r = 0; r < 16; ++r) { const int s = crow(r, hi); p0[r] = s <= trow ? p0[r] : 0.f; p1[r] = s + 32 <= trow ? p1[r] : 0.f; }
#pragma unroll
    for (int ds = 0; ds < 4; ++ds) {
        const u32x2 a0 = *(const __attribute__((address_space(3))) u32x2*)(shm + L_QI + (2 * ds) * 1024 + trow * 16 + 8 * hi), a1 = *(const __attribute__((address_space(3))) u32x2*)(shm + L_QI + (2 * ds + 1) * 1024 + trow * 16 + 8 * hi);
        const u32x4 aw = {a0.x, a0.y, a1.x, a1.y};
        const bf16x8 bq = trfrag(l0 + L_SI, ds, eb, lane);
        o = __builtin_amdgcn_mfma_f32_32x32x16_bf16(__builtin_bit_cast(bf16x8, aw), bq, o, 0, 0, 0); }
    {
        const u32x4 w0 = {cvtpk(p0[0], p0[1]), cvtpk(p0[2], p0[3]), cvtpk(p0[4], p0[5]), cvtpk(p0[6], p0[7])}, w1 = {cvtpk(p0[8], p0[9]), cvtpk(p0[10], p0[11]), cvtpk(p0[12], p0[13]), cvtpk(p0[14], p0[15])};
        const u32x4 w2 = {cvtpk(p1[0], p1[1]), cvtpk(p1[2], p1[3]), cvtpk(p1[4], p1[5]), cvtpk(p1[6], p1[7])}, w3 = {cvtpk(p1[8], p1[9]), cvtpk(p1[10], p1[11]), cvtpk(p1[12], p1[13]), cvtpk(p1[14], p1[15])};
        o = __builtin_amdgcn_mfma_f32_32x32x16_bf16(__builtin_bit_cast(bf16x8, w0), trfrag(l0 + L_VI, 0, eb, lane), o, 0, 0, 0);
        o = __builtin_amdgcn_mfma_f32_32x32x16_bf16(__builtin_bit_cast(bf16x8, w1), trfrag(l0 + L_VI, 1, eb, lane), o, 0, 0, 0);
        o = __builtin_amdgcn_mfma_f32_32x32x16_bf16(__builtin_bit_cast(bf16x8, w2), trfrag(l0 + L_VI, 2, eb, lane), o, 0, 0, 0);
        o = __builtin_amdgcn_mfma_f32_32x32x16_bf16(__builtin_bit_cast(bf16x8, w3), trfrag(l0 + L_VI, 3, eb, lane), o, 0, 0, 0);
    }
    __attribute__((address_space(3))) float* ost = (__attribute__((address_space(3))) float*)(shm + L_OST);
#pragma unroll
    for (int r = 0; r < 16; ++r) ost[(32 * tb + crow(r, hi)) * 132 + 32 * eb + r32] = o[r];
    __syncthreads();
    { const int t = tid >> 3, part = tid & 7; float v[16]; float ss = 0.f;
#pragma unroll
        for (int k = 0; k < 4; ++k) { const f32x4_t x = *(const __attribute__((address_space(3))) f32x4_t*)(ost + t * 132 + part * 16 + k * 4); v[4 * k] = x[0]; v[4 * k + 1] = x[1]; v[4 * k + 2] = x[2]; v[4 * k + 3] = x[3]; ss += x[0] * x[0] + x[1] * x[1] + x[2] * x[2] + x[3] * x[3]; }
        ss += __shfl_xor(ss, 1); ss += __shfl_xor(ss, 2); ss += __shfl_xor(ss, 4);
        const float rstd = rsqrtf(ss * (1.f / 128.f) + 1e-6f);
        const size_t go = (t0 + t) * 512 + h * 128 + part * 16;
        const uint4 r0 = rs0, r1 = rs1; const unsigned rw[8] = {r0.x, r0.y, r0.z, r0.w, r1.x, r1.y, r1.z, r1.w};
        unsigned ow[8];
#pragma unroll
        for (int k = 0; k < 8; ++k) { const float ga = p.norm_g[h * 128 + part * 16 + 2 * k], gb = p.norm_g[h * 128 + part * 16 + 2 * k + 1];
            ow[k] = pk2(v[2 * k] * rstd * ga * __uint_as_float(rw[k] << 16), v[2 * k + 1] * rstd * gb * __uint_as_float(rw[k] & 0xffff0000u)); }
        *(uint4*)(p.gla + go) = make_uint4(ow[0], ow[1], ow[2], ow[3]); *(uint4*)(p.gla + go + 8) = make_uint4(ow[4], ow[5], ow[6], ow[7]); }
    __syncthreads();
}
}
__device__ __forceinline__ void phase_gla1(const P& p, char* smem) {
    const int n = p.nb * 4 * 64;
    for (int i = blockIdx.x; i < n; i += gridDim.x) gla::g1_chunk(p, smem, i >> 8, (i >> 6) & 3, i & 63);
}
__device__ __forceinline__ void phase_gla2(const P& p) {
    const int n = p.nb * 4 * 8192;
    for (int idx = blockIdx.x * NT + TIDX(); idx < n; idx += gridDim.x * NT) {
        const int bh = idx >> 13, de = idx & 8191, d = de >> 7; float* U = p.gst + (size_t)bh * 64 * 8192 + de; const float* gd = p.gdec + (size_t)bh * 64 * 64 + d;
        float s = 0.f;
        for (int c0 = 0; c0 < 64; c0 += 8) { float tmp[8], g[8];
#pragma unroll
            for (int k = 0; k < 8; ++k) { tmp[k] = U[(size_t)(c0 + k) * 8192]; g[k] = gd[(c0 + k) * 64]; }
#pragma unroll
            for (int k = 0; k < 8; ++k) { U[(size_t)(c0 + k) * 8192] = s; s = g[k] * s + tmp[k]; } }
    }
}
__device__ __forceinline__ void phase_gla3(const P& p, char* smem) {
    const int n = p.nb * 4 * 64;
    for (int i = blockIdx.x; i < n; i += gridDim.x) gla::g3_chunk(p, smem, i >> 8, (i >> 6) & 3, i & 63);
}

struct CmpSched {
    const char* kc; const char* Wc1; float* Pc; int nM, G, c; size_t aseg, pseg;
    __device__ __forceinline__ bool next(int i, pg8::Unit& u) const {
        const int L = i * G + c, per = nM * 2 * 2; if (L >= 2 * per) return false;
        const int kv = L / per, r = L % per, ks = r & 1, pn = (r >> 1) & 1, pm = r >> 2;
        u.pm = pm; u.pn = pn; u.tag = kv * 2 + ks;
        u.A = kc + (size_t)kv * aseg + (size_t)pm * 256 * 1024 * 2 + ks * 512 * 2; u.B = Wc1 + ((size_t)kv * 512 + pn * 256) * 1024 * 2 + ks * 512 * 2; return true;
    }
    __device__ __forceinline__ unsigned arow(const pg8::Unit&, int r) const { return (unsigned)r * 2048u; }
};
struct EpiCmp {
    static constexpr bool PERM = false;
    float* Pc; size_t pseg;
    __device__ __forceinline__ void operator()(const pg8::f32x4 (&acc)[2][2][4][2], const pg8::Unit& u, int wr, int wc, int fr, int fq) const {
        float* base = Pc + (size_t)u.tag * pseg; const int col0 = u.pn * 256 + wc * 32 + 4 * fq;
#pragma unroll
        for (int ai = 0; ai < 2; ++ai)
#pragma unroll
            for (int m = 0; m < 4; ++m) { float* rowp = base + (size_t)(u.pm * 256 + ai * 128 + wr * 64 + m * 16 + fr) * 512 + col0;
#pragma unroll
                for (int bj = 0; bj < 2; ++bj)
#pragma unroll
                    for (int n = 0; n < 2; ++n) *(pg8::f32x4*)(rowp + bj * 128 + n * 16) = acc[ai][bj][m][n]; }
    }
};
__device__ __forceinline__ void finish_b1p(const P& p);
__device__ __forceinline__ void phase_cmp1(const P& p, char* smem) {
    if (blockIdx.x == gridDim.x - 1) finish_b1p(p);
    const int nrows = p.nb * 2 * 256;
    CmpSched Sc{(const char*)p.kv6, (const char*)p.Wc1, p.pcmp, nrows / 256, (int)gridDim.x, (int)blockIdx.x, kvseg(p) * 2, (size_t)(nrows + 8) * 512};
    EpiCmp E{p.pcmp, (size_t)(nrows + 8) * 512};
    pg8::gemm_phase<EpiCmp, CmpSched, true, false>((PG8_LAS unsigned char*)smem, 512, 1024, 1024, Sc, E);
}
__device__ __forceinline__ void body_cmp2f(const P& p, int vb, char* smem) {
    const int tid = TIDX(); const int nrows = p.nb * 2 * 256, nvb1 = nrows / 16; const int kv = vb / nvb1, row0 = (vb % nvb1) * 16;
    const size_t pseg = (size_t)(nrows + 8) * 512; const float* P0 = p.pcmp + (size_t)(kv * 2) * pseg; const float* P1 = P0 + pseg;
    float* hs = (float*)smem;
    float* w2s = (float*)smem + 16 * 256;
    __syncthreads();
    { const float4* wsrc = (const float4*)(kv ? p.cw2_v : p.cw2_k);
#pragma unroll
      for (int k = 0; k < 8; ++k) ((float4*)w2s)[tid + k * 512] = wsrc[tid + k * 512]; }
#pragma unroll
    for (int k = 0; k < 8; ++k) { const int idx = tid + k * 512, rr = idx >> 8, n = idx & 255; const size_t m = (size_t)(row0 + rr);
        const float z = P0[m * 512 + n] + P1[m * 512 + n] + P0[(m + 1) * 512 + 256 + n] + P1[(m + 1) * 512 + 256 + n] + p.b1p[kv * 256 + n];
        hs[idx] = geluf_(z); }
    __syncthreads();
    const int rr = tid >> 5, i = tid & 31, row = row0 + rr;
    const float* h = hs + rr * 256; const float* b2 = kv ? p.cb2_v : p.cb2_k;
    float z1 = b2[i], z2 = b2[i + 32];
#pragma unroll 8
    for (int n = 0; n < 256; ++n) { const float hv = h[n]; z1 += hv * w2s[n * 64 + i]; z2 += hv * w2s[n * 64 + i + 32]; }
    bf16* dst = (kv ? p.vcmp : p.kcmp) + (size_t)row * 64;
    if (kv == 0) {
        const int bg = row >> 8, m = row & 255, b = bg >> 1; int sp = 16 * m + 31; if (sp > S - 1) sp = S - 1;
        const size_t t = (size_t)b * S + sp; const float c = p.cs[t * 64 + i], sn = p.cs[t * 64 + 32 + i];
        const float r1 = z1 * c - z2 * sn, r2 = z2 * c + z1 * sn; z1 = r1; z2 = r2;
    }
    dst[i] = f2bf(z1); dst[i + 32] = f2bf(z2);
}
__device__ __forceinline__ void phase_cmp2(const P& p, char* smem) {
    const int n = 2 * (p.nb * 2 * 256) / 16;
    for (int vb = blockIdx.x; vb < n; vb += gridDim.x) body_cmp2f(p, vb, smem);
}
__device__ __forceinline__ void prep_b1p(const P& p, char* smem) {
    if (blockIdx.x >= 64) return;
    const int tid = TIDX(), kv = blockIdx.x >> 5, part = blockIdx.x & 31, n = tid & 255, fh = tid >> 8;
    const float* pe = kv ? p.cpos_v : p.cpos_k; const float* w1 = kv ? p.cw1_v : p.cw1_k;
    const int f0 = part * 64 + fh * 32; float a = 0.f;
#pragma unroll
    for (int i = 0; i < 32; ++i) a += pe[f0 + i] * w1[(size_t)(f0 + i) * 256 + n];
    float* sc = (float*)(smem + LDS_MISC);
    __syncthreads();
    if (fh == 1) sc[n] = a;
    __syncthreads();
    if (fh == 0) p.b1p[512 + (kv * 32 + part) * 256 + n] = a + sc[n];
    __syncthreads();
}
__device__ __forceinline__ void finish_b1p(const P& p) {
    const int tid = TIDX(), kv = tid >> 8, n = tid & 255; float a = (kv ? p.cb1_v : p.cb1_k)[n];
    for (int part = 0; part < 32; ++part) a += p.b1p[512 + (kv * 32 + part) * 256 + n];
    p.b1p[kv * 256 + n] = a;
}
#define XB_TMO      128
#define XB_XCNT(j)  (256  + 64 * (j))
#define XB_XSUB(j)  (1280 + 64 * (j))
#define XB_XGEN(j)  (2304 + 64 * (j))
#define XB_TOP      3328
#define XB_TOPGEN   3392
#define XCD_BAR_WORDS 3456
#define XB_SPIN_CAP (1u << 18)
#define XLAS __attribute__((address_space(3)))
__device__ __forceinline__ unsigned xb_ld(unsigned* p)              { return __hip_atomic_load(p, __ATOMIC_RELAXED, __HIP_MEMORY_SCOPE_AGENT); }
__device__ __forceinline__ unsigned xb_add(unsigned* p, unsigned v) { return __hip_atomic_fetch_add(p, v, __ATOMIC_RELAXED, __HIP_MEMORY_SCOPE_AGENT); }
__device__ __forceinline__ unsigned xb_xcc_id() { return (unsigned)__builtin_amdgcn_s_getreg((3 << 11) | 20) & 0xFu; }
#define XB_SPIN(cond, bar) do { unsigned _sp = 0; while (cond) { __builtin_amdgcn_s_sleep(1); \
    if ((++_sp & 255u) == 0u) { if (xb_ld(&(bar)[XB_TMO])) break; if (_sp > XB_SPIN_CAP) { atomicAdd(&(bar)[XB_TMO], 1u); break; } } } } while (0)
struct XcdBarrier { unsigned* bar; unsigned x; volatile XLAS unsigned* st; };
__device__ __forceinline__ XcdBarrier xcd_barrier_post(unsigned* bar, volatile XLAS unsigned* st) {
    XcdBarrier b; b.bar = bar; b.x = xb_xcc_id(); b.st = st;
    if (TIDX() == 0) (void)xb_add(&bar[XB_XCNT(b.x)], 1u);
    return b;
}
__device__ __forceinline__ void xcd_barrier_complete(unsigned* bar, unsigned x, unsigned& nloc, unsigned& nx) {
    const unsigned G = gridDim.x * gridDim.y * gridDim.z;
    unsigned sum, cnt, mine, sp = 0u;
    for (;;) {
        sum = 0u; cnt = 0u; mine = 0u;
#pragma unroll
        for (unsigned j = 0; j < 16; ++j) { const unsigned c = xb_ld(&bar[XB_XCNT(j)]); sum += c; cnt += (c > 0u) ? 1u : 0u; mine = (j == x) ? c : mine; }
        if (sum == G) break;
        __builtin_amdgcn_s_sleep(1);
        if ((++sp & 255u) == 0u) { if (xb_ld(&bar[XB_TMO])) break; if (sp > XB_SPIN_CAP) { atomicAdd(&bar[XB_TMO], 1u); break; } }
    }
    nloc = mine > 0u ? mine : 1u; nx = cnt > 0u ? cnt : 1u;
}
__device__ __forceinline__ void xcd_barrier(const XcdBarrier& b) {
    asm volatile("s_waitcnt vmcnt(0)" ::: "memory");
    __syncthreads();
    if (TIDX() == 0) {
        unsigned* bar = b.bar;
        __builtin_amdgcn_s_waitcnt(0);
        unsigned nloc = b.st[0], nx = b.st[1];
        if (nloc == 0u) { xcd_barrier_complete(bar, b.x, nloc, nx); b.st[0] = nloc; b.st[1] = nx; }
        const unsigned old = xb_add(&bar[XB_XSUB(b.x)], 1u);
        const unsigned gen = old / nloc;
        if (old + 1u == (gen + 1u) * nloc) {
            __builtin_amdgcn_fence(__ATOMIC_RELEASE, "agent");
            asm volatile("s_waitcnt vmcnt(0)" ::: "memory");
            const unsigned og = xb_add(&bar[XB_TOP], 1u);
            const unsigned tg = og / nx;
            if (og + 1u == (tg + 1u) * nx) xb_add(&bar[XB_TOPGEN], 1u);
            else XB_SPIN(xb_ld(&bar[XB_TOPGEN]) == tg, bar);
            __builtin_amdgcn_fence(__ATOMIC_ACQUIRE, "agent");
            xb_add(&bar[XB_XGEN(b.x)], 1u);
            asm volatile("s_waitcnt vmcnt(0)" ::: "memory");
        } else {
            XB_SPIN(xb_ld(&bar[XB_XGEN(b.x)]) == gen, bar);
            __builtin_amdgcn_fence(__ATOMIC_ACQUIRE, "agent");
            asm volatile("s_waitcnt vmcnt(0)" ::: "memory");
        }
    }
    __syncthreads();
}

template <int ST> __device__ __forceinline__ void run_stage(const P& p, char* smem, int first, int stride) {
    const int nvb = stage_nvb(ST, p.T);
    for (int vb = first; vb < nvb; vb += stride) {
        if constexpr (ST == ST_RMS) body_rms(p, vb);
        else if constexpr (ST == ST_CS) body_cs(p, vb);
        else if constexpr (ST == ST_INPROJ) body_inproj(p, vb, smem);
        else if constexpr (ST == ST_CMP1) body_cmp1(p, vb, smem);
        else if constexpr (ST == ST_CMP2) body_cmp2(p, vb);
        else if constexpr (ST == ST_NSACMP) body_nsacmp(p, vb, smem);
        else if constexpr (ST == ST_NSAATT) body_nsaatt(p, vb);
        else if constexpr (ST == ST_GLAA) body_glaa(p, vb);
        else if constexpr (ST == ST_GLASCAN) body_glascan(p, vb, smem);
        else if constexpr (ST == ST_GLANORM) body_glanorm(p, vb);
        else if constexpr (ST == ST_PROJ) body_proj(p, vb, smem);
        else if constexpr (ST == ST_OUT) body_out(p, vb, smem);
        else if constexpr (ST == ST_ROUTE) body_route(p, vb, smem);
        else if constexpr (ST == ST_MOE1) body_moe1(p, vb, smem);
        else if constexpr (ST == ST_MOE2) body_moe2(p, vb, smem);
        else if constexpr (ST == ST_FINAL) body_final(p, vb, smem);
    }
}
template <int ST> __global__ void __launch_bounds__(NT) k_stage(P p) {
    extern __shared__ __attribute__((aligned(16))) char smem[];
    run_stage<ST>(p, smem, blockIdx.x, gridDim.x);
}
__global__ void __launch_bounds__(NT) k_mega(P p) {
    extern __shared__ __attribute__((aligned(16))) char smem[];
    cg::grid_group grid = cg::this_grid();
    const int b0 = blockIdx.x, G = gridDim.x;
    volatile XLAS unsigned* xst = (volatile XLAS unsigned*)((XLAS char*)smem + LDS_MISC + 3072);
    if (TIDX() < 4) xst[TIDX()] = 0u;
    __syncthreads();
    volatile unsigned long long* tsv = (volatile unsigned long long*)(p.ctl + 12288); int nts = 1;
    if (TSEL >= 0 && b0 == 0 && TIDX() == 0) tsv[0] = __builtin_amdgcn_s_memrealtime();
    const XcdBarrier xb = xcd_barrier_post(p.ctl + 4096, xst);
#define GSYNC() do { xcd_barrier(xb); if (TSEL >= 0 && b0 == 0 && TIDX() == 0) { tsv[nts] = __builtin_amdgcn_s_memrealtime(); } ++nts; } while (0)
#define DUPRUN(k, stmt) do { if (DUP == (k)) { stmt; GSYNC(); } } while (0)
    if (p.T < 0) grid.sync();
    phase_prep(p, smem); GSYNC();
    phase_inA(p, smem); GSYNC();                               DUPRUN(7, phase_inA(p, smem));
    phase_cmp1(p, smem); phase_gla1(p, smem); GSYNC();         DUPRUN(8, phase_cmp1(p, smem)); DUPRUN(4, phase_gla1(p, smem));
    phase_cmp2(p, smem); phase_gla2(p); GSYNC();               DUPRUN(9, phase_cmp2(p, smem));
    if (DUP >= 20 && DUP < 148) { P p2 = p; p2.onsa = (bf16*)p.pcmp; p2.sel = (u64*)((char*)p.pcmp + 16 * MiB_); phase_nsa<(DUP >= 20 && DUP < 148) ? DUP - 20 : 0>(p2, smem); GSYNC(); }
    phase_nsa(p, smem); phase_gla3(p, smem); GSYNC();          DUPRUN(1, phase_nsa(p, smem)); DUPRUN(2, phase_gla3(p, smem));
    phase_inB(p, smem); GSYNC();                               DUPRUN(11, phase_inB(p, smem));
    phase_proj(p, smem); GSYNC();                              DUPRUN(12, phase_proj(p, smem));
    phase_out(p, smem); GSYNC();                               DUPRUN(13, phase_out(p, smem));
    if (DUP == 17) { P p2 = p; p2.ctl = p.ctl + 8192; p2.vb = p.sa; p2.list = (int*)p.mixed; p2.tokslot = (int*)p.mixed + (1 << 20); p2.tokexp = (int*)p.mixed + (2 << 20); p2.tokw = (float*)p.mixed + (3 << 20);
        for (int vb = b0; vb < p.T / 64; vb += G) body_route3(p2, vb, smem);
        GSYNC(); }
    for (int vb = b0; vb < p.T / 64; vb += G) body_route3(p, vb, smem);
    GSYNC();
    phase_moe1(p, smem); GSYNC();                              DUPRUN(6, phase_moe1(p, smem));
    phase_moe2(p, smem); GSYNC();                              DUPRUN(14, phase_moe2(p, smem));
    if (DUP == 15) { GSYNC(); GSYNC(); GSYNC(); GSYNC(); GSYNC(); GSYNC(); GSYNC(); GSYNC(); GSYNC(); GSYNC(); }
    for (int vb = b0; vb < p.T / 8; vb += G) body_final_b(p, vb, smem);
    if (TSEL >= 0 && b0 == 0 && TIDX() == 0) { const unsigned long long tend = __builtin_amdgcn_s_memrealtime(); tsv[nts] = tend;
        const unsigned long long d = tsv[TSEL + 1] - tsv[TSEL]; while (__builtin_amdgcn_s_memrealtime() - tend < 4ull * d) __builtin_amdgcn_s_sleep(16); }
#undef DUPRUN
#undef GSYNC
}

enum Phase { PH_PREP = 0, PH_INA, PH_INB, PH_PROJ, PH_OUT, PH_MOE1, PH_MOE2, PH_NSA, PH_GLA1, PH_GLA2, PH_GLA3, PH_CMP1, PH_CMP2 };
template <int PH> __global__ void __launch_bounds__(NT) k_phase(P p) {
    extern __shared__ __attribute__((aligned(16))) char smem[];
    if constexpr (PH == PH_PREP) phase_prep(p, smem);
    else if constexpr (PH == PH_INA) phase_inA(p, smem);
    else if constexpr (PH == PH_INB) phase_inB(p, smem);
    else if constexpr (PH == PH_PROJ) phase_proj(p, smem);
    else if constexpr (PH == PH_OUT) phase_out(p, smem);
    else if constexpr (PH == PH_MOE1) phase_moe1(p, smem);
    else if constexpr (PH == PH_MOE2) phase_moe2(p, smem);
    else if constexpr (PH == PH_NSA) phase_nsa(p, smem);
    else if constexpr (PH == PH_GLA1) phase_gla1(p, smem);
    else if constexpr (PH == PH_GLA2) phase_gla2(p);
    else if constexpr (PH == PH_GLA3) phase_gla3(p, smem);
    else if constexpr (PH == PH_CMP1) phase_cmp1(p, smem);
    else if constexpr (PH == PH_CMP2) phase_cmp2(p, smem);
}
template <class TT> __device__ __forceinline__ float ldf(const TT* p, size_t i);
template <> __device__ __forceinline__ float ldf<bf16>(const bf16* p, size_t i) { return bf2f(p[i]); }
template <> __device__ __forceinline__ float ldf<float>(const float* p, size_t i) { return p[i]; }
template <class TT> __global__ void __launch_bounds__(256) k_compare(const TT* a, const TT* b, size_t n, float* err, int slot) {
    float num = 0.f, den = 0.f;
    for (size_t i = (size_t)blockIdx.x * 256 + TIDX(); i < n; i += (size_t)gridDim.x * 256) { const float x = ldf<TT>(a, i), y = ldf<TT>(b, i); const float d = x - y; num += (d == d) ? d * d : 1e30f; den += y * y; }
#pragma unroll
    for (int o = 1; o < 64; o <<= 1) { num += __shfl_xor(num, o); den += __shfl_xor(den, o); }
    if ((TIDX() & 63) == 0) { atomicAdd(err + 2 * slot, num); atomicAdd(err + 2 * slot + 1, den); }
}
__global__ void __launch_bounds__(256) k_compare_sel(const u64* a, const u64* b, size_t n, float* err, int slot) {
    float num = 0.f, den = 0.f;
    for (size_t i = (size_t)blockIdx.x * 256 + threadIdx.x; i < n; i += (size_t)gridDim.x * 256) { num += (a[i] != b[i]) ? 1.f : 0.f; den += 100.f; }
#pragma unroll
    for (int o = 1; o < 64; o <<= 1) { num += __shfl_xor(num, o); den += __shfl_xor(den, o); }
    if ((threadIdx.x & 63) == 0) { atomicAdd(err + 2 * slot, num); atomicAdd(err + 2 * slot + 1, den); }
}
__global__ void __launch_bounds__(256) k_report(float* out, size_t n, const float* err, int nslots, float tol) {
    int code = 0;
    for (int s = 0; s < nslots; ++s) { const float num = err[2 * s], den = err[2 * s + 1]; const bool bad = !(num <= tol * tol * den) || !(den > 0.f); if (bad) { code = s + 1; break; } }
    if (code == 0) return;
    const float f = 1.f + 0.1f * (float)code;
    for (size_t i = (size_t)blockIdx.x * 256 + TIDX(); i < n; i += (size_t)gridDim.x * 256) out[i] *= f;
}

static void set_inputs(P& p, void* const* d_in) {
    const float* const* in = (const float* const*)d_in;
    p.x = in[0]; p.pos = (const int*)d_in[1]; p.g_mix = in[2]; p.w_in = in[3];
    p.cpos_k = in[4]; p.cw1_k = in[5]; p.cb1_k = in[6]; p.cw2_k = in[7]; p.cb2_k = in[8];
    p.cpos_v = in[9]; p.cw1_v = in[10]; p.cb1_v = in[11]; p.cw2_v = in[12]; p.cb2_v = in[13];
    p.w_a2 = in[14]; p.b_a = in[15]; p.norm_g = in[16]; p.w_pn = in[17]; p.w_pg = in[18]; p.w_out = in[19];
    p.g_ffn = in[20]; p.w_grp = in[21]; p.b_grp = in[22]; p.w_exp = in[23]; p.b_exp = in[24]; p.w_gate = in[25]; p.w_up = in[26]; p.w_down = in[27]; p.g_final = in[28];
}
constexpr size_t MiB = 1u << 20;
static void layout_ref(P& p, char* small, char* act, char* scratch, float* out, int nb) {
    const size_t q = (MiB / 4) * nb;
    p.nb = nb; p.T = nb * S; p.out = out;
    p.ctl = (unsigned*)small; p.sel = (u64*)(small + q / 16 * 1); p.kcmp = (bf16*)(small + q / 2); p.vcmp = (bf16*)(small + q / 4 * 3);
    p.tokslot = (int*)(small + q); p.tokexp = (int*)(small + q + q / 8); p.tokw = (float*)(small + q + q / 4);
    p.alow = (float*)(small + 2 * q); p.gates = (float*)(small + 3 * q); p.cs = (float*)(small + 5 * q); p.hcmp = (float*)(small + 9 * q); p.list = (int*)(small + 13 * q);
    p.u = (bf16*)act; p.ocmp = (float*)act; p.mixed = (bf16*)act; p.vb = (bf16*)act;
    p.q = (bf16*)(act + 32 * q); p.kv6 = (bf16*)(act + 48 * q);
    p.gq = (bf16*)(act + 73 * q); p.gk = (bf16*)(act + 81 * q); p.gv = (bf16*)(act + 89 * q); p.rs = (bf16*)(act + 105 * q);
    p.H = (bf16*)(act + 32 * q);
    p.sa = (bf16*)(act + 123 * q); p.sb = (bf16*)(act + 155 * q); p.onsa = (bf16*)(act + 187 * q); p.gla = (bf16*)(act + 203 * q);
    p.Y = (bf16*)(act + 123 * q);
    p.ga = (float*)scratch; p.oraw = (float*)(scratch + 16 * q); p.h1 = (float*)(scratch + 48 * q);
    p.gst = (float*)(scratch + 16 * q); p.gdec = (float*)(small + 15 * q);
}
static void layout_compact(P& p, char* ws, float* out) {
    p.nb = NB; p.T = NB * S; p.out = out;
    char* small = ws; const size_t q = MiB;
    p.ctl = (unsigned*)small; p.sel = (u64*)(small + q / 16 * 1); p.kcmp = (bf16*)(small + q / 2); p.vcmp = (bf16*)(small + q / 4 * 3);
    p.tokslot = (int*)(small + q); p.tokexp = (int*)(small + q + q / 8); p.tokw = (float*)(small + q + q / 4);
    p.alow = (float*)(small + 2 * q); p.gates = (float*)(small + 3 * q); p.cs = (float*)(small + 5 * q); p.hcmp = (float*)(small + 9 * q); p.list = (int*)(small + 13 * q);
    p.u = (bf16*)(ws + 128 * MiB); p.vb = (bf16*)(ws + 128 * MiB);
    p.q = (bf16*)(ws + 160 * MiB); p.kv6 = (bf16*)(ws + 176 * MiB); p.gq = (bf16*)(ws + 201 * MiB); p.gk = (bf16*)(ws + 209 * MiB); p.gv = (bf16*)(ws + 217 * MiB); p.rs = (bf16*)(ws + 233 * MiB);
    p.ga = (float*)(ws + 249 * MiB); p.ocmp = (float*)(ws + 249 * MiB);
    p.sa = (bf16*)(ws + 160 * MiB); p.sb = (bf16*)(ws + 192 * MiB); p.mixed = (bf16*)(ws + 224 * MiB);
    p.H = (bf16*)(ws + 160 * MiB); p.Y = (bf16*)(ws + 48 * MiB);
    p.onsa = (bf16*)out; p.gla = (bf16*)((char*)out + 16 * MiB); p.oraw = (float*)((char*)out + 32 * MiB); p.h1 = out;
    p.gst = (float*)((char*)out + 32 * MiB); p.gdec = (float*)(small + 15 * q); p.pcmp = (float*)(ws + 249 * MiB); p.h1b = (bf16*)(ws + 249 * MiB);
}
static void layout_weights(P& p, char* w) {
    p.wr = (float*)(w - 256 * 1024); p.b1p = (float*)(w - 100 * 1024);
    p.Wd = (bf16*)w; p.Wgu = (bf16*)(w + 32 * MiB); p.Wt_in = (bf16*)(w + 96 * MiB); p.Wc1 = (bf16*)(w + 106 * MiB);
    p.Wpn = (bf16*)(w + 108 * MiB); p.Wpg = (bf16*)(w + 109 * MiB); p.Wo = (bf16*)(w + 110 * MiB);
}

template <int ST> static void launch_stage(const P& p, hipStream_t stream) {
    static bool attr = false;
    if (!attr) { (void)hipFuncSetAttribute((const void*)k_stage<ST>, hipFuncAttributeMaxDynamicSharedMemorySize, LDS_BYTES); attr = true; }
    int nvb = stage_nvb(ST, p.T); if (nvb > 16384) nvb = 16384;
    hipLaunchKernelGGL(k_stage<ST>, dim3(nvb), dim3(NT), LDS_BYTES, stream, p);
}
template <int PH> static void launch_phase(const P& p, hipStream_t stream, int grid = 40) {
    static bool attr = false;
    if (!attr) { (void)hipFuncSetAttribute((const void*)k_phase<PH>, hipFuncAttributeMaxDynamicSharedMemorySize, LDS_BYTES); attr = true; }
    hipLaunchKernelGGL(k_phase<PH>, dim3(grid), dim3(NT), LDS_BYTES, stream, p);
}
template <class TT> static void compare(const TT* a, const TT* b, size_t n, float* err, int slot, hipStream_t stream) {
    hipLaunchKernelGGL(k_compare<TT>, dim3(1024), dim3(256), 0, stream, a, b, n, err, slot);
}
static void launch_mega(const P& p, hipStream_t stream) {
    static int grid = 0;
    if (!grid) {
        int dev = 0, cus = 0, per_cu = 0;
        (void)hipGetDevice(&dev); (void)hipDeviceGetAttribute(&cus, hipDeviceAttributeMultiprocessorCount, dev);
        (void)hipFuncSetAttribute((const void*)k_mega, hipFuncAttributeMaxDynamicSharedMemorySize, LDS_BYTES);
        (void)hipOccupancyMaxActiveBlocksPerMultiprocessor(&per_cu, (const void*)k_mega, NT, LDS_BYTES);
        if (per_cu < 1) per_cu = 1;
        grid = cus * per_cu;
    }
    (void)hipMemsetAsync((void*)p.ctl, 0, 64 * 1024, stream);
    P pp = p; void* args[] = {(void*)&pp};
    (void)hipLaunchCooperativeKernel((const void*)k_mega, dim3(grid), dim3(NT), args, LDS_BYTES, stream);
}

extern "C" void kernel_launch(void* const* d_in, const int* in_sizes, int n_in, void* d_out, int out_size, void* d_ws, size_t ws_size, hipStream_t stream) {
    char* ws = (char*)d_ws;
    P p{}; set_inputs(p, d_in); layout_ref(p, ws, ws + 16 * MiB, (char*)d_out, (float*)d_out, NB); p.h1 = (float*)d_out;
#if MODE == 0
    (void)hipMemsetAsync(d_ws, 0, 4096, stream);
    launch_stage<ST_RMS>(p, stream); launch_stage<ST_CS>(p, stream); launch_stage<ST_INPROJ>(p, stream);
    launch_stage<ST_CMP1>(p, stream); launch_stage<ST_CMP2>(p, stream); launch_stage<ST_NSACMP>(p, stream); launch_stage<ST_NSAATT>(p, stream);
    launch_stage<ST_GLAA>(p, stream); launch_stage<ST_GLASCAN>(p, stream); launch_stage<ST_GLANORM>(p, stream);
    launch_stage<ST_PROJ>(p, stream); launch_stage<ST_OUT>(p, stream); launch_stage<ST_ROUTE>(p, stream);
    launch_stage<ST_MOE1>(p, stream); launch_stage<ST_MOE2>(p, stream); launch_stage<ST_FINAL>(p, stream);
#elif MODE == 1
    { P c{}; set_inputs(c, d_in); layout_weights(c, ws + 16 * MiB); layout_compact(c, ws, (float*)d_out); launch_mega(c, stream); }
#else
    { P c{}; set_inputs(c, d_in); layout_weights(c, ws + 16 * MiB); layout_compact(c, ws, (float*)d_out); launch_mega(c, stream); }
    P r{}; set_inputs(r, d_in); layout_weights(r, ws + 16 * MiB);
    layout_ref(r, ws + 128 * MiB, ws + 132 * MiB, ws + 200 * MiB, (float*)(ws + 200 * MiB + 12 * MiB), 1);
    char* alt = ws + 228 * MiB; float* err = (float*)(ws + 128 * MiB + 8192);
    (void)hipMemsetAsync(ws + 128 * MiB, 0, 16384, stream);
    int slot = 0; const size_t T1 = S; const size_t ROWS1 = 2 * T1 + NEXP * 256;
    launch_stage<ST_RMS>(r, stream); launch_stage<ST_CS>(r, stream); launch_stage<ST_INPROJ>(r, stream);
    P f = r; { char* a = alt;
        f.u = (bf16*)a; a += T1 * 1024 * 2; f.cs = (float*)a; a += T1 * 64 * 4; f.q = (bf16*)a; a += T1 * 512 * 2; f.kv6 = (bf16*)a; a += 6 * (size_t)2 * S * 64 * 2 + 4096;
        f.gates = (float*)a; a += T1 * 24 * 4; f.gq = (bf16*)a; a += T1 * 256 * 2; f.gk = (bf16*)a; a += T1 * 256 * 2; f.gv = (bf16*)a; a += T1 * 512 * 2; f.alow = (float*)a; a += T1 * 16 * 4;
        f.rs = (bf16*)a; a += T1 * 512 * 2; f.sa = (bf16*)a; a += T1 * 1024 * 2; f.sb = (bf16*)a; a += T1 * 1024 * 2; }
    launch_phase<PH_PREP>(f, stream); launch_phase<PH_INA>(f, stream); launch_phase<PH_INB>(f, stream);
    compare<bf16>(f.q, r.q, T1 * 512, err, slot++, stream);
    compare<bf16>(f.kv6, r.kv6, 6 * (size_t)2 * S * 64, err, slot++, stream);
    compare<bf16>(f.sb, r.sb, T1 * 1024, err, slot++, stream);
    launch_stage<ST_CMP1>(r, stream); launch_stage<ST_CMP2>(r, stream);
    f = r; f.pcmp = (float*)alt; f.kcmp = (bf16*)(alt + 20 * MiB); f.vcmp = (bf16*)(alt + 21 * MiB); launch_phase<PH_CMP1>(f, stream); launch_phase<PH_CMP2>(f, stream);
    compare<bf16>(f.kcmp, r.kcmp, (size_t)2 * 255 * 64, err, slot++, stream); compare<bf16>(f.vcmp + 256 * 64, r.vcmp + 256 * 64, (size_t)255 * 64, err, slot++, stream);
    launch_stage<ST_NSACMP>(r, stream); launch_stage<ST_NSAATT>(r, stream);
    f = r; f.onsa = (bf16*)alt; f.sel = (u64*)(alt + 8 * MiB); launch_phase<PH_NSA>(f, stream);
    hipLaunchKernelGGL(k_compare_sel, dim3(64), dim3(256), 0, stream, (const u64*)f.sel, (const u64*)r.sel, T1 * 2, err, slot++);
    compare<bf16>(f.onsa, r.onsa, T1 * 512, err, slot++, stream);
    launch_stage<ST_GLAA>(r, stream); launch_stage<ST_GLASCAN>(r, stream); launch_stage<ST_GLANORM>(r, stream);
    f = r; f.gla = (bf16*)alt; f.gst = (float*)(alt + 8 * MiB); f.gdec = (float*)(alt + 18 * MiB); launch_phase<PH_GLA1>(f, stream); launch_phase<PH_GLA2>(f, stream); launch_phase<PH_GLA3>(f, stream);
    compare<bf16>(f.gla, r.gla, T1 * 512, err, slot++, stream);
    launch_stage<ST_PROJ>(r, stream);
    f = r; f.mixed = (bf16*)alt; launch_phase<PH_PROJ>(f, stream);
    compare<bf16>(f.mixed, r.mixed, T1 * 1024, err, slot++, stream);
    launch_stage<ST_OUT>(r, stream);
    f = r; f.h1b = (bf16*)alt; launch_phase<PH_OUT>(f, stream);
    launch_stage<ST_ROUTE>(r, stream);
    (void)hipMemsetAsync(r.H, 0, ROWS1 * 512 * 2, stream); (void)hipMemsetAsync(alt, 0, ROWS1 * 512 * 2, stream);
    launch_stage<ST_MOE1>(r, stream);
    f = r; f.H = (bf16*)alt; launch_phase<PH_MOE1>(f, stream);
    compare<bf16>(f.H, r.H, ROWS1 * 512, err, slot++, stream);
    (void)hipMemsetAsync(r.Y, 0, ROWS1 * 1024 * 2, stream); (void)hipMemsetAsync(alt + 17 * MiB, 0, ROWS1 * 1024 * 2, stream);
    launch_stage<ST_MOE2>(r, stream);
    f = r; f.Y = (bf16*)(alt + 17 * MiB); launch_phase<PH_MOE2>(f, stream);
    compare<bf16>(f.Y, r.Y, ROWS1 * 1024, err, slot++, stream);
    hipLaunchKernelGGL(k_report, dim3(1024), dim3(256), 0, stream, (float*)d_out, (size_t)NB * S * D, (const float*)err, slot, 0.02f);
#endif
}
```

```cpp
#include <hip/hip_runtime.h>
#include <hip/hip_cooperative_groups.h>
#include <stdint.h>
namespace cg = cooperative_groups;

#ifndef DUP
#define DUP 0
#endif
#ifndef TSEL
#define TSEL -1
#endif
#ifndef MODE
#define MODE 1
#endif

typedef unsigned short bf16;
typedef unsigned long long u64;

__device__ __forceinline__ int TIDX() { int t = threadIdx.x; asm volatile("" : "+v"(t)); return t; }
__device__ __forceinline__ float bf2f(bf16 v) { return __uint_as_float(((unsigned)v) << 16); }
__device__ __forceinline__ bf16 f2bf(float f) { unsigned u = __float_as_uint(f); return (bf16)((u + 0x7fffu + ((u >> 16) & 1u)) >> 16); }
__device__ __forceinline__ float sigmoidf_(float x) { return 1.f / (1.f + __expf(-x)); }
__device__ __forceinline__ float siluf_(float x) { return x / (1.f + __expf(-x)); }
__device__ __forceinline__ float geluf_(float x) { const float u = 0.7978845608028654f * (x + 0.044715f * x * x * x); return 0.5f * x * (1.f + tanhf(u)); }

constexpr int NB = 4, S = 4096, D = 1024;
constexpr int NT = 512;
constexpr int LDS_BYTES = 144 * 1024;
constexpr int LDS_MISC = 136 * 1024;
constexpr int INW = 4904;
constexpr int OFF_Q = 0, OFF_KV = 512, OFF_NG = 1280, OFF_GQ = 1304, OFF_GK = 1560, OFF_GV = 1816, OFF_GA = 2328, OFF_GR = 2344, OFF_MA = 2856, OFF_MB = 3880;
constexpr int NEXP = 32;
constexpr size_t MiB_ = 1u << 20;

struct P {
    const float* x; const int* pos; const float* g_mix; const float* w_in;
    const float *cpos_k, *cw1_k, *cb1_k, *cw2_k, *cb2_k, *cpos_v, *cw1_v, *cb1_v, *cw2_v, *cb2_v;
    const float *w_a2, *b_a, *norm_g, *w_pn, *w_pg, *w_out, *g_ffn, *w_grp, *b_grp, *w_exp, *b_exp, *w_gate, *w_up, *w_down, *g_final;
    float* out;
    unsigned* ctl;
    float* cs;
    bf16* u;
    bf16* q;
    bf16* kv6;
    float* gates;
    bf16 *gq, *gk, *gv;
    float* alow;
    bf16 *rs, *sa, *sb;
    float* hcmp;
    bf16 *kcmp, *vcmp;
    u64* sel;
    float* ocmp;
    bf16* onsa;
    float* ga;
    float* oraw;
    bf16* gla;
    bf16* mixed;
    float* h1;
    bf16* h1b;
    bf16* vb;
    int* list;
    int* tokslot;
    int* tokexp;
    float* tokw;
    bf16* H;
    bf16* Y;
    float* gst;
    float* gdec;
    float* pcmp;
    float* b1p;
    float* wr;
    bf16 *Wt_in, *Wc1, *Wpn, *Wpg, *Wo, *Wgu, *Wd;
    int nb, T;
};
__device__ __forceinline__ size_t kvseg(const P& p) { return (size_t)p.nb * 2 * S * 64; }

enum Stage { ST_RMS = 0, ST_CS, ST_INPROJ, ST_CMP1, ST_CMP2, ST_NSACMP, ST_NSAATT, ST_GLAA, ST_GLASCAN, ST_GLANORM, ST_PROJ, ST_OUT, ST_ROUTE, ST_MOE1, ST_MOE2, ST_FINAL, ST_COUNT };

__host__ __device__ inline int stage_nvb(int st, int T) {
    switch (st) {
        case ST_RMS: return T / 8;
        case ST_CS: return T * 32 / NT;
        case ST_INPROJ: return ((INW + NT - 1) / NT) * (T / 8);
        case ST_CMP1: return 2 * (T / S) * 2 * 256 / 8;
        case ST_CMP2: return 2 * (T / S) * 2 * 256 * 32 / NT;
        case ST_NSACMP: return T / 64 * 2 / 8;
        case ST_NSAATT: return T / 64 * 8 / 8;
        case ST_GLAA: return T / 2;
        case ST_GLASCAN: return (T / S) * 4 / 4;
        case ST_GLANORM: return T * 4 / NT;
        case ST_PROJ: return 2 * (T / 8);
        case ST_OUT: return 2 * (T / 8);
        case ST_ROUTE: return T / 8;
        case ST_MOE1: return (2 * T + NEXP * 256) / 8;
        case ST_MOE2: return 2 * ((2 * T + NEXP * 256) / 8);
        case ST_FINAL: return T / 8;
    }
    return 0;
}

__device__ __forceinline__ void body_rms(const P& p, int vb) {
    const int lane = TIDX() & 63, t = vb * 8 + (TIDX() >> 6);
    const float4* xr = (const float4*)(p.x + (size_t)t * D);
    float4 v[4]; float ss = 0.f;
#pragma unroll
    for (int j = 0; j < 4; ++j) { v[j] = xr[lane + 64 * j]; ss += v[j].x * v[j].x + v[j].y * v[j].y + v[j].z * v[j].z + v[j].w * v[j].w; }
#pragma unroll
    for (int o = 1; o < 64; o <<= 1) ss += __shfl_xor(ss, o);
    const float rstd = rsqrtf(ss * (1.f / D) + 1e-6f);
#pragma unroll
    for (int j = 0; j < 4; ++j) {
        const float4 g = ((const float4*)p.g_mix)[lane + 64 * j];
        ushort4 o; o.x = f2bf(v[j].x * rstd * g.x); o.y = f2bf(v[j].y * rstd * g.y); o.z = f2bf(v[j].z * rstd * g.z); o.w = f2bf(v[j].w * rstd * g.w);
        ((ushort4*)(p.u + (size_t)t * D))[lane + 64 * j] = o;
    }
}
__device__ __forceinline__ void body_rms2(const P& p, int vb) {
    const int lane = TIDX() & 63, t = vb * 16 + (TIDX() >> 6) * 2;
    const float4* xr = (const float4*)(p.x + (size_t)t * D);
    float4 v[8]; float s0 = 0.f, s1 = 0.f;
#pragma unroll
    for (int j = 0; j < 8; ++j) v[j] = xr[lane + 64 * j];
#pragma unroll
    for (int j = 0; j < 4; ++j) { s0 += v[j].x * v[j].x + v[j].y * v[j].y + v[j].z * v[j].z + v[j].w * v[j].w; s1 += v[4 + j].x * v[4 + j].x + v[4 + j].y * v[4 + j].y + v[4 + j].z * v[4 + j].z + v[4 + j].w * v[4 + j].w; }
#pragma unroll
    for (int o = 1; o < 64; o <<= 1) { s0 += __shfl_xor(s0, o); s1 += __shfl_xor(s1, o); }
    const float r0 = rsqrtf(s0 * (1.f / D) + 1e-6f), r1 = rsqrtf(s1 * (1.f / D) + 1e-6f);
#pragma unroll
    for (int j = 0; j < 4; ++j) {
        const float4 g = ((const float4*)p.g_mix)[lane + 64 * j];
        ushort4 o; o.x = f2bf(v[j].x * r0 * g.x); o.y = f2bf(v[j].y * r0 * g.y); o.z = f2bf(v[j].z * r0 * g.z); o.w = f2bf(v[j].w * r0 * g.w);
        ((ushort4*)(p.u + (size_t)t * D))[lane + 64 * j] = o;
        ushort4 q; q.x = f2bf(v[4 + j].x * r1 * g.x); q.y = f2bf(v[4 + j].y * r1 * g.y); q.z = f2bf(v[4 + j].z * r1 * g.z); q.w = f2bf(v[4 + j].w * r1 * g.w);
        ((ushort4*)(p.u + (size_t)(t + 1) * D))[lane + 64 * j] = q;
    }
}
__device__ __forceinline__ void body_cs(const P& p, int vb) {
    const int idx = vb * NT + TIDX(); const int t = idx >> 5, i = idx & 31;
    const float inv = 1.0f / powf(10000.0f, (float)i / 32.0f);
    const float ang = (float)p.pos[t] * inv;
    const double a = (double)ang; const double k = rint(a * 0.15915494309189535); const float r = (float)(a - k * 6.283185307179586);
    p.cs[(size_t)t * 64 + i] = cosf(r); p.cs[(size_t)t * 64 + 32 + i] = sinf(r);
}

template <int K, bool TWO, bool SAMEA, class AF1, class AF2, class Epi>
__device__ __forceinline__ void ngemm(float* lds, int m0, const float* W1, int ldw1, int n1, const float* W2, int ldw2, int n2, AF1 a1, AF2 a2, Epi epi) {
    const int tid = TIDX();
    for (int idx = tid; idx < 8 * K; idx += NT) { const int i = idx / K, k = idx % K; lds[idx] = a1(m0 + i, k); if (TWO && !SAMEA) lds[8 * K + idx] = a2(m0 + i, k); }
    __syncthreads();
    float acc1[8], acc2[8];
#pragma unroll
    for (int i = 0; i < 8; ++i) { acc1[i] = 0.f; acc2[i] = 0.f; }
    const float* w1 = W1 + n1; const float* w2 = TWO ? (W2 + n2) : w1;
    const float* l2 = (TWO && !SAMEA) ? lds + 8 * K : lds;
    for (int k = 0; k < K; k += 4) {
        float a[4], b[4];
#pragma unroll
        for (int kk = 0; kk < 4; ++kk) { a[kk] = w1[(size_t)(k + kk) * ldw1]; b[kk] = TWO ? w2[(size_t)(k + kk) * ldw2] : 0.f; }
#pragma unroll
        for (int i = 0; i < 8; ++i) {
            const float4 x1 = *(const float4*)(lds + i * K + k);
            acc1[i] += x1.x * a[0] + x1.y * a[1] + x1.z * a[2] + x1.w * a[3];
            if (TWO) { const float4 x2 = *(const float4*)(l2 + i * K + k); acc2[i] += x2.x * b[0] + x2.y * b[1] + x2.z * b[2] + x2.w * b[3]; }
        }
    }
#pragma unroll
    for (int i = 0; i < 8; ++i) epi(m0 + i, acc1[i], acc2[i]);
    __syncthreads();
}

__device__ __forceinline__ void store_z(const P& p, int t, int j, float z, float zp) {
    const int b = t / S, s = t % S;
    if (j < OFF_KV) {
        const int d = j & 63, i = d & 31; const float c = p.cs[(size_t)t * 64 + i], sn = p.cs[(size_t)t * 64 + 32 + i];
        const float r = (d < 32) ? (z * c - zp * sn) : (z * c + zp * sn);
        p.q[(size_t)t * 512 + j] = f2bf(r * 0.125f);
    } else if (j < OFF_NG) {
        const int seg = (j - OFF_KV) >> 7, cc = (j - OFF_KV) & 127, g = cc >> 6, d = cc & 63; float r = z;
        if (seg == 2 || seg == 4) { const int i = d & 31; const float c = p.cs[(size_t)t * 64 + i], sn = p.cs[(size_t)t * 64 + 32 + i]; r = (d < 32) ? (z * c - zp * sn) : (z * c + zp * sn); }
        p.kv6[(size_t)seg * kvseg(p) + ((size_t)(b * 2 + g) * S + s) * 64 + d] = f2bf(r);
    } else if (j < OFF_GQ) { p.gates[(size_t)t * 24 + (j - OFF_NG)] = sigmoidf_(z);
    } else if (j < OFF_GK) { p.gq[(size_t)t * 256 + (j - OFF_GQ)] = f2bf(z * 0.125f);
    } else if (j < OFF_GV) { p.gk[(size_t)t * 256 + (j - OFF_GK)] = f2bf(z);
    } else if (j < OFF_GA) { p.gv[(size_t)t * 512 + (j - OFF_GV)] = f2bf(z);
    } else if (j < OFF_GR) { p.alow[(size_t)t * 16 + (j - OFF_GA)] = z;
    } else if (j < OFF_MA) { p.rs[(size_t)t * 512 + (j - OFF_GR)] = f2bf(siluf_(z));
    } else if (j < OFF_MB) { p.sa[(size_t)t * 1024 + (j - OFF_MA)] = f2bf(sigmoidf_(z));
    } else { p.sb[(size_t)t * 1024 + (j - OFF_MB)] = f2bf(sigmoidf_(z)); }
}
__device__ __forceinline__ int rope_partner(int j) {
    int base;
    if (j < OFF_KV) base = 0; else if (j >= 768 && j < 896) base = 768; else if (j >= 1024 && j < 1152) base = 1024; else return -1;
    const int d = (j - base) & 63; return d < 32 ? j + 32 : j - 32;
}
__device__ __forceinline__ void body_inproj(const P& p, int vb, char* smem) {
    constexpr int NCB = (INW + NT - 1) / NT;
    const int bx = vb % NCB, by = vb / NCB;
    const int jr = bx * NT + TIDX(); const bool jv = jr < INW; const int j = jv ? jr : INW - 1;
    int jp = rope_partner(j); if (jp < 0) jp = j;
    ngemm<1024, true, true>((float*)smem, by * 8, p.w_in, INW, j, p.w_in, INW, jp,
        [&](int m, int k) { return bf2f(p.u[(size_t)m * D + k]); }, [&](int m, int k) { return 0.f; },
        [&](int m, float z, float zp) { if (jv) store_z(p, m, j, z, zp); });
}

__device__ __forceinline__ void body_cmp1(const P& p, int vb, char* smem) {
    const int nrows = p.nb * 2 * 256, ng = nrows / 8;
    const int kv = vb / ng, m0 = (vb % ng) * 8; const int n = TIDX() & 255; const bool act = TIDX() < 256;
    const bf16* src = p.kv6 + (size_t)kv * kvseg(p);
    const float* pe = kv ? p.cpos_v : p.cpos_k; const float* w1 = kv ? p.cw1_v : p.cw1_k; const float* b1 = kv ? p.cb1_v : p.cb1_k;
    float* dst = p.hcmp + (size_t)kv * nrows * 256;
    ngemm<2048, false, true>((float*)smem, m0, w1, 256, n, w1, 256, n,
        [&](int m, int k) { return bf2f(src[(size_t)m * 1024 + k]) + pe[k]; }, [&](int m, int k) { return 0.f; },
        [&](int m, float z, float) { if (act) dst[(size_t)m * 256 + n] = geluf_(z + b1[n]); });
}
__device__ __forceinline__ void body_cmp2(const P& p, int vb) {
    const int nrows = p.nb * 2 * 256;
    const int idx = vb * NT + TIDX();
    const int i = idx & 31, row = (idx >> 5) % nrows, kv = (idx >> 5) / nrows;
    const float* h = p.hcmp + ((size_t)kv * nrows + row) * 256; const float* w2 = kv ? p.cw2_v : p.cw2_k; const float* b2 = kv ? p.cb2_v : p.cb2_k;
    float z1 = b2[i], z2 = b2[i + 32];
    for (int n = 0; n < 256; ++n) { const float hv = h[n]; z1 += hv * w2[n * 64 + i]; z2 += hv * w2[n * 64 + i + 32]; }
    bf16* dst = (kv ? p.vcmp : p.kcmp) + (size_t)row * 64;
    if (kv == 0) {
        const int bg = row >> 8, m = row & 255, b = bg >> 1; int sp = 16 * m + 31; if (sp > S - 1) sp = S - 1;
        const size_t t = (size_t)b * S + sp; const float c = p.cs[t * 64 + i], sn = p.cs[t * 64 + 32 + i];
        const float r1 = z1 * c - z2 * sn, r2 = z2 * c + z1 * sn; z1 = r1; z2 = r2;
    }
    dst[i] = f2bf(z1); dst[i + 32] = f2bf(z2);
}

__device__ __forceinline__ void load_row64(const bf16* r, float* f) {
    const uint4* p4 = (const uint4*)r;
#pragma unroll
    for (int c = 0; c < 8; ++c) { const uint4 v = p4[c]; const unsigned w[4] = {v.x, v.y, v.z, v.w};
#pragma unroll
        for (int e = 0; e < 4; ++e) { f[c * 8 + e * 2] = __uint_as_float(w[e] << 16); f[c * 8 + e * 2 + 1] = __uint_as_float(w[e] & 0xffff0000u); } }
}
__device__ __forceinline__ float dot64(const float* a, const bf16* r) {
    const uint4* p4 = (const uint4*)r; float s = 0.f;
#pragma unroll
    for (int c = 0; c < 8; ++c) { const uint4 v = p4[c]; const unsigned w[4] = {v.x, v.y, v.z, v.w};
#pragma unroll
        for (int e = 0; e < 4; ++e) { s += a[c * 8 + e * 2] * __uint_as_float(w[e] << 16); s += a[c * 8 + e * 2 + 1] * __uint_as_float(w[e] & 0xffff0000u); } }
    return s;
}
__device__ __forceinline__ void axpy64(float* o, float a, const bf16* r) {
    const uint4* p4 = (const uint4*)r;
#pragma unroll
    for (int c = 0; c < 8; ++c) { const uint4 v = p4[c]; const unsigned w[4] = {v.x, v.y, v.z, v.w};
#pragma unroll
        for (int e = 0; e < 4; ++e) { o[c * 8 + e * 2] += a * __uint_as_float(w[e] << 16); o[c * 8 + e * 2 + 1] += a * __uint_as_float(w[e] & 0xffff0000u); } }
}
__device__ __forceinline__ void body_nsacmp(const P& p, int vb, char* smem) {
    const int wave = TIDX() >> 6, lane = TIDX() & 63, item = vb * 8 + wave;
    const int g = item & 1, t = (item >> 1) * 64 + lane;
    const int b = t / S, s = t % S; const int nv = s >= 31 ? (s - 31) / 16 + 1 : 0;
    float* my = (float*)smem + (size_t)wave * (64 * 65) + lane * 65;
    for (int j = 0; j < 64; ++j) my[j] = 0.f;
    const bf16* kc = p.kcmp + (size_t)(b * 2 + g) * 256 * 64; const bf16* vc = p.vcmp + (size_t)(b * 2 + g) * 256 * 64;
    for (int hh = 0; hh < 4; ++hh) {
        const int h = g * 4 + hh; float qv[64], o[64];
        load_row64(p.q + (size_t)t * 512 + h * 64, qv);
#pragma unroll
        for (int d = 0; d < 64; ++d) o[d] = 0.f;
        float m = -1e30f, l = 0.f;
        for (int n = 0; n < nv; ++n) { const float sc = dot64(qv, kc + n * 64); const float mn = fmaxf(m, sc); l = l * __expf(m - mn) + __expf(sc - mn); m = mn; }
        const float il = nv > 0 ? 1.f / l : 0.f;
        for (int n = 0; n < nv; ++n) {
            const float sc = dot64(qv, kc + n * 64); const float pn = __expf(sc - m) * il;
            axpy64(o, pn, vc + n * 64);
            const int j0 = n >> 2; if ((n & 3) != 3) my[j0] += pn; else { my[j0] += 0.5f * pn; my[j0 + 1] += 0.5f * pn; }
        }
#pragma unroll
        for (int d = 0; d < 64; ++d) p.ocmp[(size_t)t * 512 + h * 64 + d] = o[d];
    }
    const int cur = s >> 6; u64 mask = 0ull;
    for (int j = 0; j <= cur; ++j) {
        const float sj = (j == 0 || j == cur || j == cur - 1) ? 1e4f : my[j]; int rank = 0;
        for (int i = 0; i <= cur; ++i) { if (i == j) continue; const float si = (i == 0 || i == cur || i == cur - 1) ? 1e4f : my[i]; if (si > sj || (si == sj && i < j)) ++rank; }
        if (rank < 16) mask |= (1ull << j);
    }
    p.sel[(size_t)t * 2 + g] = mask;
}
__device__ __forceinline__ void body_nsaatt(const P& p, int vb) {
    const int wave = TIDX() >> 6, lane = TIDX() & 63, item = vb * 8 + wave;
    const int h = item & 7, t = (item >> 3) * 64 + lane, g = h >> 2;
    const int b = t / S, s = t % S, cur = s >> 6;
    const size_t seg = kvseg(p), ho = (size_t)(b * 2 + g) * S * 64;
    const bf16* ks = p.kv6 + 2 * seg + ho; const bf16* vs = p.kv6 + 3 * seg + ho; const bf16* kw = p.kv6 + 4 * seg + ho; const bf16* vw = p.kv6 + 5 * seg + ho;
    float qv[64], o[64];
    load_row64(p.q + (size_t)t * 512 + h * 64, qv);
    const float g0 = p.gates[(size_t)t * 24 + h * 3], g1 = p.gates[(size_t)t * 24 + h * 3 + 1], g2 = p.gates[(size_t)t * 24 + h * 3 + 2];
    float* accp = p.ocmp + (size_t)t * 512 + h * 64;
#pragma unroll
    for (int d = 0; d < 64; ++d) o[d] = 0.f;
    const u64 mask = p.sel[(size_t)t * 2 + g];
    float m = -1e30f, l = 0.f;
    for (int j = 0; j <= cur; ++j) {
        if (!((mask >> j) & 1ull)) continue;
        for (int kk = 0; kk < 64; ++kk) {
            const int key = j * 64 + kk; if (key > s) break;
            const float sc = dot64(qv, ks + (size_t)key * 64);
            if (sc > m) { const float f = __expf(m - sc); l *= f;
#pragma unroll
                for (int d = 0; d < 64; ++d) o[d] *= f;
                m = sc; }
            const float pe = __expf(sc - m); l += pe; axpy64(o, pe, vs + (size_t)key * 64);
        }
    }
    { const float f = g1 / l;
#pragma unroll
        for (int d = 0; d < 64; ++d) { accp[d] = g0 * accp[d] + f * o[d]; o[d] = 0.f; } }
    m = -1e30f; l = 0.f;
    for (int key = (s >= 511 ? s - 511 : 0); key <= s; ++key) {
        const float sc = dot64(qv, kw + (size_t)key * 64);
        if (sc > m) { const float f = __expf(m - sc); l *= f;
#pragma unroll
            for (int d = 0; d < 64; ++d) o[d] *= f;
            m = sc; }
        const float pe = __expf(sc - m); l += pe; axpy64(o, pe, vw + (size_t)key * 64);
    }
    { const float f = g2 / l;
#pragma unroll
        for (int d = 0; d < 64; ++d) p.onsa[(size_t)t * 512 + h * 64 + d] = f2bf(accp[d] + f * o[d]); }
}

__device__ __forceinline__ void body_glaa(const P& p, int vb) {
    const int c = TIDX() & 255, t = vb * 2 + (TIDX() >> 8); float z = p.b_a[c];
#pragma unroll
    for (int r = 0; r < 16; ++r) z += p.alow[(size_t)t * 16 + r] * p.w_a2[r * 256 + c];
    const float ls = fminf(z, 0.f) - log1pf(__expf(-fabsf(z)));
    p.ga[(size_t)t * 256 + c] = __expf(ls * (1.f / 16.f));
}
__device__ __forceinline__ void body_glascan(const P& p, int vb, char* smem) {
    const int sub = TIDX() >> 7, e = TIDX() & 127, bh = vb * 4 + sub, b = bh >> 2, h = bh & 3;
    float* sq = (float*)smem + sub * (3 * 32 * 64); float* sk = sq + 32 * 64; float* sg = sk + 32 * 64;
    float St[64];
#pragma unroll
    for (int d = 0; d < 64; ++d) St[d] = 0.f;
    for (int s0 = 0; s0 < S; s0 += 32) {
        __syncthreads();
        for (int i = e; i < 32 * 64; i += 128) { const int ss = i >> 6, d = i & 63; const size_t t = (size_t)b * S + s0 + ss;
            sq[i] = bf2f(p.gq[t * 256 + h * 64 + d]); sk[i] = bf2f(p.gk[t * 256 + h * 64 + d]); sg[i] = p.ga[t * 256 + h * 64 + d]; }
        __syncthreads();
        for (int ss = 0; ss < 32; ++ss) {
            const size_t t = (size_t)b * S + s0 + ss; const float v = bf2f(p.gv[t * 512 + h * 128 + e]); float o = 0.f;
#pragma unroll
            for (int d = 0; d < 64; ++d) { St[d] = sg[ss * 64 + d] * St[d] + sk[ss * 64 + d] * v; o += sq[ss * 64 + d] * St[d]; }
            p.oraw[t * 512 + h * 128 + e] = o;
        }
    }
    __syncthreads();
}
__device__ __forceinline__ void body_glanorm(const P& p, int vb) {
    const int idx = vb * NT + TIDX(); const int t = idx >> 2, h = idx & 3;
    const float* o = p.oraw + (size_t)t * 512 + h * 128; float ss = 0.f;
    for (int e = 0; e < 128; ++e) ss += o[e] * o[e];
    const float r = rsqrtf(ss * (1.f / 128.f) + 1e-6f);
    for (int e = 0; e < 128; ++e) p.gla[(size_t)t * 512 + h * 128 + e] = f2bf(o[e] * r * p.norm_g[h * 128 + e] * bf2f(p.rs[(size_t)t * 512 + h * 128 + e]));
}

__device__ __forceinline__ void body_proj(const P& p, int vb, char* smem) {
    const int n = (vb & 1) * NT + TIDX(), m0 = (vb >> 1) * 8;
    ngemm<512, true, false>((float*)smem, m0, p.w_pn, 1024, n, p.w_pg, 1024, n,
        [&](int m, int k) { return bf2f(p.onsa[(size_t)m * 512 + k]); }, [&](int m, int k) { return bf2f(p.gla[(size_t)m * 512 + k]); },
        [&](int m, float ya, float yb) { p.mixed[(size_t)m * 1024 + n] = f2bf(bf2f(p.sa[(size_t)m * 1024 + n]) * ya + bf2f(p.sb[(size_t)m * 1024 + n]) * yb); });
}
__device__ __forceinline__ void body_out(const P& p, int vb, char* smem) {
    const int n = (vb & 1) * NT + TIDX(), m0 = (vb >> 1) * 8;
    ngemm<1024, false, true>((float*)smem, m0, p.w_out, 1024, n, p.w_out, 1024, n,
        [&](int m, int k) { return bf2f(p.mixed[(size_t)m * 1024 + k]); }, [&](int m, int k) { return 0.f; },
        [&](int m, float z, float) { p.h1[(size_t)m * 1024 + n] = p.x[(size_t)m * 1024 + n] + z; });
}

__device__ __forceinline__ void body_route(const P& p, int vb, char* smem) {
    const int wave = TIDX() >> 6, lane = TIDX() & 63, t = vb * 8 + wave;
    const float4* hr = (const float4*)(p.h1 + (size_t)t * D);
    float v[16]; float ss = 0.f;
#pragma unroll
    for (int j = 0; j < 4; ++j) { const float4 a = hr[lane + 64 * j]; v[4 * j] = a.x; v[4 * j + 1] = a.y; v[4 * j + 2] = a.z; v[4 * j + 3] = a.w; ss += a.x * a.x + a.y * a.y + a.z * a.z + a.w * a.w; }
#pragma unroll
    for (int o = 1; o < 64; o <<= 1) ss += __shfl_xor(ss, o);
    const float rstd = rsqrtf(ss * (1.f / D) + 1e-6f);
#pragma unroll
    for (int j = 0; j < 4; ++j) {
        const float4 g = ((const float4*)p.g_ffn)[lane + 64 * j];
        v[4 * j] *= rstd * g.x; v[4 * j + 1] *= rstd * g.y; v[4 * j + 2] *= rstd * g.z; v[4 * j + 3] *= rstd * g.w;
        ushort4 o; o.x = f2bf(v[4 * j]); o.y = f2bf(v[4 * j + 1]); o.z = f2bf(v[4 * j + 2]); o.w = f2bf(v[4 * j + 3]);
        ((ushort4*)(p.vb + (size_t)t * D))[lane + 64 * j] = o;
    }
    float* sl = (float*)(smem + LDS_MISC) + wave * 40;
    for (int o = 0; o < 4; ++o) { float a = 0.f;
#pragma unroll
        for (int j = 0; j < 4; ++j)
#pragma unroll
            for (int e = 0; e < 4; ++e) a += v[4 * j + e] * p.w_grp[(size_t)(4 * (lane + 64 * j) + e) * 4 + o];
#pragma unroll
        for (int x = 1; x < 64; x <<= 1) a += __shfl_xor(a, x);
        if (lane == 0) sl[o] = a + p.b_grp[o]; }
    for (int o = 0; o < 32; ++o) { float a = 0.f;
#pragma unroll
        for (int j = 0; j < 4; ++j)
#pragma unroll
            for (int e = 0; e < 4; ++e) a += v[4 * j + e] * p.w_exp[(size_t)(4 * (lane + 64 * j) + e) * 32 + o];
#pragma unroll
        for (int x = 1; x < 64; x <<= 1) a += __shfl_xor(a, x);
        if (lane == 0) sl[4 + o] = a + p.b_exp[o]; }
    if (lane == 0) {
        int gs = 0; float gm = sl[0];
        for (int o = 1; o < 4; ++o) if (sl[o] > gm) { gm = sl[o]; gs = o; }
        float gsum = 0.f;
        for (int o = 0; o < 4; ++o) gsum += __expf(sl[o] - gm);
        const float pg = 1.f / gsum;
        const float* li = sl + 4 + gs * 8;
        int e0 = 0; float m0 = li[0];
        for (int e = 1; e < 8; ++e) if (li[e] > m0) { m0 = li[e]; e0 = e; }
        int e1 = -1; float m1 = -3e38f;
        for (int e = 0; e < 8; ++e) if (e != e0 && li[e] > m1) { m1 = li[e]; e1 = e; }
        const float p0 = 1.f, p1 = __expf(m1 - m0);
        const float w0 = pg * p0 / (p0 + p1), w1 = pg * p1 / (p0 + p1);
        const int x0 = gs * 8 + e0, x1 = gs * 8 + e1;
        const int s0 = (int)atomicAdd(&p.ctl[x0 * 32], 1u), s1 = (int)atomicAdd(&p.ctl[x1 * 32], 1u);
        p.list[(size_t)x0 * p.T + s0] = t; p.list[(size_t)x1 * p.T + s1] = t;
        p.tokexp[t * 2] = x0; p.tokexp[t * 2 + 1] = x1; p.tokslot[t * 2] = s0; p.tokslot[t * 2 + 1] = s1; p.tokw[t * 2] = w0; p.tokw[t * 2 + 1] = w1;
    }
}

__device__ __forceinline__ void body_route2(const P& p, int vb, char* smem) {
    const int tid = TIDX(), wave = tid >> 6, lane = tid & 63, t = vb * 8 + wave;
    const float4* hr = (const float4*)(p.h1 + (size_t)t * D);
    float4 v[4]; float ss = 0.f;
#pragma unroll
    for (int j = 0; j < 4; ++j) { v[j] = hr[lane + 64 * j]; ss += v[j].x * v[j].x + v[j].y * v[j].y + v[j].z * v[j].z + v[j].w * v[j].w; }
#pragma unroll
    for (int o = 1; o < 64; o <<= 1) ss += __shfl_xor(ss, o);
    const float rstd = rsqrtf(ss * (1.f / D) + 1e-6f);
#pragma unroll
    for (int j = 0; j < 4; ++j) {
        const float4 g = ((const float4*)p.g_ffn)[lane + 64 * j];
        v[j].x *= rstd * g.x; v[j].y *= rstd * g.y; v[j].z *= rstd * g.z; v[j].w *= rstd * g.w;
        ushort4 o; o.x = f2bf(v[j].x); o.y = f2bf(v[j].y); o.z = f2bf(v[j].z); o.w = f2bf(v[j].w);
        ((ushort4*)(p.vb + (size_t)t * D))[lane + 64 * j] = o;
    }
    float* sl = (float*)(smem + LDS_MISC) + wave * 40;
    float mine = 0.f;
#pragma unroll 4
    for (int o = 0; o < 36; ++o) { const float4* wrow = (const float4*)(p.wr + (size_t)o * 1024); float a = 0.f;
#pragma unroll
        for (int j = 0; j < 4; ++j) { const float4 w = wrow[lane + 64 * j]; a += v[j].x * w.x + v[j].y * w.y + v[j].z * w.z + v[j].w * w.w; }
#pragma unroll
        for (int x = 1; x < 64; x <<= 1) a += __shfl_xor(a, x);
        if (lane == o) mine = a; }
    if (lane < 36) sl[lane] = mine + (lane < 4 ? p.b_grp[lane] : p.b_exp[lane - 4]);
    asm volatile("s_waitcnt lgkmcnt(0)" ::: "memory");
    if (lane == 0) {
        int gs = 0; float gm = sl[0];
        for (int o = 1; o < 4; ++o) if (sl[o] > gm) { gm = sl[o]; gs = o; }
        float gsum = 0.f;
        for (int o = 0; o < 4; ++o) gsum += __expf(sl[o] - gm);
        const float pg = 1.f / gsum;
        const float* li = sl + 4 + gs * 8;
        int e0 = 0; float m0 = li[0];
        for (int e = 1; e < 8; ++e) if (li[e] > m0) { m0 = li[e]; e0 = e; }
        int e1 = -1; float m1 = -3e38f;
        for (int e = 0; e < 8; ++e) if (e != e0 && li[e] > m1) { m1 = li[e]; e1 = e; }
        const float p0 = 1.f, p1 = __expf(m1 - m0);
        const float w0 = pg * p0 / (p0 + p1), w1 = pg * p1 / (p0 + p1);
        const int x0 = gs * 8 + e0, x1 = gs * 8 + e1;
        const int s0 = (int)atomicAdd(&p.ctl[x0 * 32], 1u), s1 = (int)atomicAdd(&p.ctl[x1 * 32], 1u);
        p.list[(size_t)x0 * p.T + s0] = t; p.list[(size_t)x1 * p.T + s1] = t;
        p.tokexp[t * 2] = x0; p.tokexp[t * 2 + 1] = x1; p.tokslot[t * 2] = s0; p.tokslot[t * 2 + 1] = s1; p.tokw[t * 2] = w0; p.tokw[t * 2 + 1] = w1;
    }
}

__device__ __forceinline__ float tred8(float (&a)[8], int lane) {
    const bool b5 = lane & 32, b4 = lane & 16, b3 = lane & 8;
    float k4[4], k2[2], k1;
#pragma unroll
    for (int i = 0; i < 4; ++i) { const float snd = b5 ? a[i] : a[i + 4]; const float kp = b5 ? a[i + 4] : a[i]; k4[i] = kp + __shfl_xor(snd, 32); }
#pragma unroll
    for (int i = 0; i < 2; ++i) { const float snd = b4 ? k4[i] : k4[i + 2]; const float kp = b4 ? k4[i + 2] : k4[i]; k2[i] = kp + __shfl_xor(snd, 16); }
    { const float snd = b3 ? k2[0] : k2[1]; const float kp = b3 ? k2[1] : k2[0]; k1 = kp + __shfl_xor(snd, 8); }
    k1 += __shfl_xor(k1, 4); k1 += __shfl_xor(k1, 2); k1 += __shfl_xor(k1, 1);
    return k1;
}
__device__ __forceinline__ void body_route3(const P& p, int vb, char* smem) {
    const int tid = TIDX(), wave = tid >> 6, lane = tid & 63, t0 = vb * 64 + wave * 8;
    float4 v[8][4]; float ss[8];
#pragma unroll
    for (int tk = 0; tk < 8; ++tk) { const ushort4* hr = (const ushort4*)(p.h1b + (size_t)(t0 + tk) * D); float s = 0.f;
#pragma unroll
        for (int j = 0; j < 4; ++j) { const ushort4 hb = hr[lane + 64 * j]; v[tk][j] = make_float4(bf2f(hb.x), bf2f(hb.y), bf2f(hb.z), bf2f(hb.w)); s += v[tk][j].x * v[tk][j].x + v[tk][j].y * v[tk][j].y + v[tk][j].z * v[tk][j].z + v[tk][j].w * v[tk][j].w; }
        ss[tk] = s; }
    const float tot = tred8(ss, lane);
#pragma unroll
    for (int tk = 0; tk < 8; ++tk) { const float rstd = rsqrtf(__shfl(tot, tk * 8) * (1.f / D) + 1e-6f);
#pragma unroll
        for (int j = 0; j < 4; ++j) {
            const float4 g = ((const float4*)p.g_ffn)[lane + 64 * j];
            v[tk][j].x *= rstd * g.x; v[tk][j].y *= rstd * g.y; v[tk][j].z *= rstd * g.z; v[tk][j].w *= rstd * g.w;
            ushort4 o; o.x = f2bf(v[tk][j].x); o.y = f2bf(v[tk][j].y); o.z = f2bf(v[tk][j].z); o.w = f2bf(v[tk][j].w);
            ((ushort4*)(p.vb + (size_t)(t0 + tk) * D))[lane + 64 * j] = o; } }
    float* sl = (float*)smem + wave * (8 * 40);
    float* wl = (float*)smem + 4096;
    for (int o = 0; o < 36; ++o) {
        if (o == 0 || o == 18) { __syncthreads();
#pragma unroll
            for (int k = 0; k < 9; ++k) ((float4*)wl)[tid + k * 512] = ((const float4*)(p.wr + (size_t)o * 1024))[tid + k * 512];
            __syncthreads(); }
        const float4* wrow = (const float4*)(wl + (size_t)(o >= 18 ? o - 18 : o) * 1024); float a[8];
        float4 w[4];
#pragma unroll
        for (int j = 0; j < 4; ++j) w[j] = wrow[lane + 64 * j];
#pragma unroll
        for (int tk = 0; tk < 8; ++tk) { float s = 0.f;
#pragma unroll
            for (int j = 0; j < 4; ++j) s += v[tk][j].x * w[j].x + v[tk][j].y * w[j].y + v[tk][j].z * w[j].z + v[tk][j].w * w[j].w;
            a[tk] = s; }
        const float r = tred8(a, lane);
        if ((lane & 7) == 0) sl[(lane >> 3) * 40 + o] = r + (o < 4 ? p.b_grp[o] : p.b_exp[o - 4]); }
    asm volatile("s_waitcnt lgkmcnt(0)" ::: "memory");
    int* cntl = (int*)((float*)smem + 8 * 320); int* basel = cntl + 32;
    if (tid < 32) cntl[tid] = 0;
    __syncthreads();
    int x0 = 0, x1 = 0, l0 = 0, l1 = 0; float w0 = 0.f, w1 = 0.f;
    if (lane < 8) {
        const float* s8 = sl + lane * 40;
        int gs = 0; float gm = s8[0];
        for (int o = 1; o < 4; ++o) if (s8[o] > gm) { gm = s8[o]; gs = o; }
        float gsum = 0.f;
        for (int o = 0; o < 4; ++o) gsum += __expf(s8[o] - gm);
        const float pg = 1.f / gsum;
        const float* li = s8 + 4 + gs * 8;
        int e0 = 0; float m0 = li[0];
        for (int e = 1; e < 8; ++e) if (li[e] > m0) { m0 = li[e]; e0 = e; }
        int e1 = -1; float m1 = -3e38f;
        for (int e = 0; e < 8; ++e) if (e != e0 && li[e] > m1) { m1 = li[e]; e1 = e; }
        const float p0 = 1.f, p1 = __expf(m1 - m0);
        w0 = pg * p0 / (p0 + p1); w1 = pg * p1 / (p0 + p1);
        x0 = gs * 8 + e0; x1 = gs * 8 + e1;
        l0 = atomicAdd(&cntl[x0], 1); l1 = atomicAdd(&cntl[x1], 1);
    }
    __syncthreads();
    if (tid < 32) { const int c = cntl[tid]; basel[tid] = c > 0 ? (int)atomicAdd(&p.ctl[tid * 32], (unsigned)c) : 0; }
    __syncthreads();
    if (lane < 8) {
        const int t = t0 + lane; const int s0 = basel[x0] + l0, s1 = basel[x1] + l1;
        p.list[(size_t)x0 * p.T + s0] = t; p.list[(size_t)x1 * p.T + s1] = t;
        p.tokexp[t * 2] = x0; p.tokexp[t * 2 + 1] = x1; p.tokslot[t * 2] = s0; p.tokslot[t * 2 + 1] = s1; p.tokw[t * 2] = w0; p.tokw[t * 2 + 1] = w1;
    }
    __syncthreads();
}

__device__ __forceinline__ int* seg_bases(const P& p, char* smem) {
    int* sbase = (int*)(smem + LDS_MISC + 2048);
    __syncthreads();
    if (TIDX() == 0) { int acc = 0; for (int e = 0; e < NEXP; ++e) { sbase[e] = acc; acc += ((int)p.ctl[e * 32] + 255) & ~255; } sbase[NEXP] = acc; }
    __syncthreads();
    return sbase;
}
__device__ __forceinline__ void body_moe1(const P& p, int vb, char* smem) {
    int* sbase = seg_bases(p, smem); int* stok = sbase + 40;
    const int r0 = vb * 8; if (r0 >= sbase[NEXP]) return;
    int e = 0; while (r0 >= sbase[e + 1]) ++e;
    const int cnt = (int)p.ctl[e * 32];
    if (TIDX() < 8) { const int sl = r0 + TIDX() - sbase[e]; stok[TIDX()] = p.list[(size_t)e * p.T + (sl < cnt ? sl : 0)]; }
    __syncthreads();
    const int n = TIDX();
    const float* wg = p.w_gate + (size_t)e * 1024 * 512; const float* wu = p.w_up + (size_t)e * 1024 * 512;
    ngemm<1024, true, true>((float*)smem, 0, wg, 512, n, wu, 512, n,
        [&](int m, int k) { return bf2f(p.vb[(size_t)stok[m] * D + k]); }, [&](int m, int k) { return 0.f; },
        [&](int m, float zg, float zu) { p.H[(size_t)(r0 + m) * 512 + n] = f2bf(siluf_(zg) * zu); });
}
__device__ __forceinline__ void body_moe2(const P& p, int vb, char* smem) {
    int* sbase = seg_bases(p, smem);
    const int r0 = (vb >> 1) * 8; if (r0 >= sbase[NEXP]) return;
    int e = 0; while (r0 >= sbase[e + 1]) ++e;
    const int n = (vb & 1) * NT + TIDX();
    const float* wd = p.w_down + (size_t)e * 512 * 1024;
    ngemm<512, false, true>((float*)smem, r0, wd, 1024, n, wd, 1024, n,
        [&](int m, int k) { return bf2f(p.H[(size_t)m * 512 + k]); }, [&](int m, int k) { return 0.f; },
        [&](int m, float z, float) { p.Y[(size_t)m * 1024 + n] = f2bf(z); });
}
__device__ __forceinline__ void body_final(const P& p, int vb, char* smem) {
    int* sbase = seg_bases(p, smem);
    const int lane = TIDX() & 63, t = vb * 8 + (TIDX() >> 6);
    const int r0 = sbase[p.tokexp[t * 2]] + p.tokslot[t * 2], r1 = sbase[p.tokexp[t * 2 + 1]] + p.tokslot[t * 2 + 1];
    const float w0 = p.tokw[t * 2], w1 = p.tokw[t * 2 + 1];
    const float4* hr = (const float4*)(p.h1 + (size_t)t * D);
    float4 v[4]; float ss = 0.f;
#pragma unroll
    for (int j = 0; j < 4; ++j) {
        float4 a = hr[lane + 64 * j];
        const ushort4 y0 = ((const ushort4*)(p.Y + (size_t)r0 * D))[lane + 64 * j], y1 = ((const ushort4*)(p.Y + (size_t)r1 * D))[lane + 64 * j];
        a.x += w0 * bf2f(y0.x) + w1 * bf2f(y1.x); a.y += w0 * bf2f(y0.y) + w1 * bf2f(y1.y); a.z += w0 * bf2f(y0.z) + w1 * bf2f(y1.z); a.w += w0 * bf2f(y0.w) + w1 * bf2f(y1.w);
        v[j] = a; ss += a.x * a.x + a.y * a.y + a.z * a.z + a.w * a.w;
    }
#pragma unroll
    for (int o = 1; o < 64; o <<= 1) ss += __shfl_xor(ss, o);
    const float rstd = rsqrtf(ss * (1.f / D) + 1e-6f);
#pragma unroll
    for (int j = 0; j < 4; ++j) {
        const float4 g = ((const float4*)p.g_final)[lane + 64 * j];
        float4 o; o.x = v[j].x * rstd * g.x; o.y = v[j].y * rstd * g.y; o.z = v[j].z * rstd * g.z; o.w = v[j].w * rstd * g.w;
        ((float4*)(p.out + (size_t)t * D))[lane + 64 * j] = o;
    }
}

__device__ __forceinline__ void body_final_b(const P& p, int vb, char* smem) {
    int* sbase = seg_bases(p, smem);
    const int lane = TIDX() & 63, t = vb * 8 + (TIDX() >> 6);
    const int r0 = sbase[p.tokexp[t * 2]] + p.tokslot[t * 2], r1 = sbase[p.tokexp[t * 2 + 1]] + p.tokslot[t * 2 + 1];
    const float w0 = p.tokw[t * 2], w1 = p.tokw[t * 2 + 1];
    float4 v[4]; float ss = 0.f;
#pragma unroll
    for (int j = 0; j < 4; ++j) {
        const ushort4 hb = ((const ushort4*)(p.h1b + (size_t)t * D))[lane + 64 * j];
        const ushort4 y0 = ((const ushort4*)(p.Y + (size_t)r0 * D))[lane + 64 * j], y1 = ((const ushort4*)(p.Y + (size_t)r1 * D))[lane + 64 * j];
        float4 a; a.x = bf2f(hb.x) + w0 * bf2f(y0.x) + w1 * bf2f(y1.x); a.y = bf2f(hb.y) + w0 * bf2f(y0.y) + w1 * bf2f(y1.y); a.z = bf2f(hb.z) + w0 * bf2f(y0.z) + w1 * bf2f(y1.z); a.w = bf2f(hb.w) + w0 * bf2f(y0.w) + w1 * bf2f(y1.w);
        v[j] = a; ss += a.x * a.x + a.y * a.y + a.z * a.z + a.w * a.w;
    }
#pragma unroll
    for (int o = 1; o < 64; o <<= 1) ss += __shfl_xor(ss, o);
    const float rstd = rsqrtf(ss * (1.f / D) + 1e-6f);
#pragma unroll
    for (int j = 0; j < 4; ++j) {
        const float4 g = ((const float4*)p.g_final)[lane + 64 * j];
        float4 o; o.x = v[j].x * rstd * g.x; o.y = v[j].y * rstd * g.y; o.z = v[j].z * rstd * g.z; o.w = v[j].w * rstd * g.w;
        ((float4*)(p.out + (size_t)t * D))[lane + 64 * j] = o;
    }
}

namespace pg8 {
#define PG8_LAS __attribute__((address_space(3)))
typedef short bf16x8 __attribute__((ext_vector_type(8)));
typedef float f32x4 __attribute__((ext_vector_type(4)));
typedef unsigned u32x4 __attribute__((ext_vector_type(4)));
typedef unsigned u32x2 __attribute__((ext_vector_type(2)));
constexpr int BM = 256, BK = 64, HALF = 128, HTB = HALF * BK * 2, STAGE_BYTES = 8 * HTB, NXCD = 8, WGM = 8;

__host__ __device__ __forceinline__ int lds_byte(int r, int c) { const int st = (r >> 4) * 2 + (c >> 5), rr = r & 15, cc = c & 31, ob = rr * 64 + cc * 2; return st * 1024 + (ob ^ (((ob >> 9) & 1) << 5)); }
__host__ __device__ __forceinline__ void stage_rc(int b, int& R, int& C) { const int st = b / 1024, sb = b % 1024, swz = sb ^ (((sb >> 9) & 1) << 5); R = (st >> 1) * 16 + swz / 64; C = (st & 1) * 32 + (swz % 64) / 2; }
__host__ __device__ __forceinline__ int perm32(int rho) { const int n = rho >> 4, i = rho & 15; return 8 * (i >> 2) + 4 * n + (i & 3); }

struct Unit { int pm, pn; const char* A; const char* B; int tag; };

struct TileOrder {
    int nM, nN, nwg, G, c;
    __device__ void init(int nM_, int nN_, int G_, int c_) { nM = nM_; nN = nN_; nwg = nM * nN; G = G_; c = c_; }
    __device__ bool next(int i, int& pm, int& pn) const {
        const long L = (long)i * G + c; if (L >= nwg) return false;
        int wgid = (int)L; { const int q = nwg / NXCD, r = nwg % NXCD, xcd = wgid % NXCD, off = wgid / NXCD; wgid = (xcd < r ? xcd * (q + 1) : r * (q + 1) + (xcd - r) * q) + off; }
        const int nig = WGM * nN, gid = wgid / nig, fm = gid * WGM, gsz = (nM - fm) < WGM ? (nM - fm) : WGM;
        pm = fm + ((wgid % nig) % gsz); pn = (wgid % nig) / gsz; return true;
    }
};
struct DenseSched {
    TileOrder o; const char* A; const char* B; int lda, ldb;
    __device__ void init(const void* A_, const void* B_, int M, int N, int lda_, int ldb_) { A = (const char*)A_; B = (const char*)B_; lda = lda_; ldb = ldb_; o.init(M / BM, N / BM, gridDim.x, blockIdx.x); }
    __device__ __forceinline__ bool next(int i, Unit& u) const { if (!o.next(i, u.pm, u.pn)) return false; u.A = A + (size_t)u.pm * BM * lda * 2; u.B = B + (size_t)u.pn * BM * ldb * 2; u.tag = 0; return true; }
    __device__ __forceinline__ unsigned arow(const Unit&, int r) const { return (unsigned)r * (unsigned)lda * 2u; }
    __device__ __forceinline__ void a_ready(const Unit&) const {}
    __device__ __forceinline__ void done(const Unit&) const {}
};

__device__ __forceinline__ unsigned cvt_pk_bf16(float lo, float hi) { unsigned r; asm volatile("v_cvt_pk_bf16_f32 %0, %1, %2" : "=v"(r) : "v"(lo), "v"(hi)); return r; }

template <class Epi, class Sched, bool ALIGN_EPI, bool GATHER>
__device__ __forceinline__ void gemm_phase(PG8_LAS unsigned char* lds, const int K, const int lda, const int ldb, const Sched& S, const Epi& E) {
    const int tid = TIDX(), wid = __builtin_amdgcn_readfirstlane(tid >> 6), lane = tid & 63, wr = wid >> 2, wc = wid & 3, fr = lane & 15, fq = lane >> 4;
    const int nt = K / BK;
    int sR[2], sC[2];
    unsigned voffA[2], voffB[2];
#pragma unroll
    for (int i = 0; i < 2; ++i) { stage_rc(tid * 16 + i * 8192, sR[i], sC[i]); const int Rb = Epi::PERM ? ((sR[i] & ~31) + perm32(sR[i] & 31)) : sR[i];
        voffA[i] = (unsigned)(sR[i] * lda + sC[i]) * 2u; voffB[i] = (unsigned)(Rb * ldb + sC[i]) * 2u; }
    unsigned gA[2][2], gN[2][2];
    const size_t kstep = (size_t)(BK * 2);
    const size_t hstepA = (size_t)HALF * lda * 2, hstepB = (size_t)HALF * ldb * 2;
    const unsigned ldsw = (unsigned)wid * 1024u;
    const int aoff = lds_byte(wr * 64 + fr, fq * 8), boff = lds_byte(wc * 32 + fr, fq * 8);
#define PG8_SA(b, h) (((b) * 2 + (h)) * HTB)
#define PG8_SB(b, h) ((4 + (b) * 2 + (h)) * HTB)
#define PG8_GLDS(bufoff, gptr, i_) __builtin_amdgcn_global_load_lds((const unsigned*)(gptr), (PG8_LAS unsigned*)(lds + (bufoff) + ldsw + (i_) * 8192), 16, 0, 0)
#define PG8_STAGE_B(bufoff, gbase) do { _Pragma("unroll") for (int _i = 0; _i < 2; ++_i) PG8_GLDS(bufoff, (const char*)(gbase) + voffB[_i], _i); } while (0)
#define PG8_STAGE_A(bufoff, gb, h, NX) do { _Pragma("unroll") for (int _i = 0; _i < 2; ++_i) { \
        if constexpr (GATHER) { const unsigned _o = (NX) ? gN[h][_i] : gA[h][_i]; PG8_GLDS(bufoff, (const char*)(gb) + _o, _i); } \
        else { PG8_GLDS(bufoff, (const char*)(gb) + (h) * hstepA + voffA[_i], _i); } } } while (0)
#define PG8_LDA(dst, b, h) do { _Pragma("unroll") for (int m = 0; m < 4; ++m) _Pragma("unroll") for (int k = 0; k < 2; ++k) dst[m][k] = *(const PG8_LAS bf16x8*)(lds + PG8_SA(b, h) + aoff + m * 2048 + k * 1024); } while (0)
#define PG8_LDB(dst, b, h) do { _Pragma("unroll") for (int n = 0; n < 2; ++n) _Pragma("unroll") for (int k = 0; k < 2; ++k) dst[n][k] = *(const PG8_LAS bf16x8*)(lds + PG8_SB(b, h) + boff + n * 2048 + k * 1024); } while (0)
#define PG8_MMA(ai, bj, At, Bt) do { __builtin_amdgcn_s_setprio(1); _Pragma("unroll") for (int m = 0; m < 4; ++m) _Pragma("unroll") for (int n = 0; n < 2; ++n) _Pragma("unroll") for (int k = 0; k < 2; ++k) \
        acc[ai][bj][m][n] = __builtin_amdgcn_mfma_f32_16x16x32_bf16(Bt[n][k], At[m][k], acc[ai][bj][m][n], 0, 0, 0); __builtin_amdgcn_s_setprio(0); } while (0)
#define PG8_WAIT_V(n) asm volatile("s_waitcnt vmcnt(" #n ")" ::: "memory")
#define PG8_WAIT_L(n) asm volatile("s_waitcnt lgkmcnt(" #n ")" ::: "memory")
#define PG8_BAR __builtin_amdgcn_s_barrier()
#define PG8_SCHED __builtin_amdgcn_sched_barrier(0)
#define PG8_GOFF(dst, u) do { if constexpr (GATHER) { _Pragma("unroll") for (int _h = 0; _h < 2; ++_h) _Pragma("unroll") for (int _i = 0; _i < 2; ++_i) dst[_h][_i] = S.arow(u, _h * HALF + sR[_i]) + (unsigned)sC[_i] * 2u; } } while (0)
    Unit cur, nxt; int ui = 0;
    if (!S.next(0, cur)) return;
    f32x4 acc[2][2][4][2];
#pragma unroll
    for (int a = 0; a < 2; ++a)
#pragma unroll
        for (int b = 0; b < 2; ++b)
#pragma unroll
            for (int m = 0; m < 4; ++m)
#pragma unroll
                for (int n = 0; n < 2; ++n) acc[a][b][m][n] = (f32x4){0.f, 0.f, 0.f, 0.f};
    bf16x8 At[4][2], B0[2][2], B1[2][2];
    const char* cA = cur.A; const char* cB = cur.B;
    S.a_ready(cur);
    PG8_GOFF(gA, cur);
    if constexpr (GATHER) { PG8_WAIT_V(0); }
    PG8_STAGE_B(PG8_SB(0, 0), cB); PG8_STAGE_B(PG8_SB(0, 1), cB + hstepB); PG8_STAGE_A(PG8_SA(0, 0), cA, 0, false); PG8_STAGE_A(PG8_SA(0, 1), cA, 1, false);
    if (wr == 1) PG8_BAR;
    PG8_WAIT_V(2); PG8_BAR;
    PG8_STAGE_B(PG8_SB(1, 0), cB + kstep); PG8_STAGE_A(PG8_SA(1, 0), cA + kstep, 0, false); PG8_STAGE_B(PG8_SB(1, 1), cB + hstepB + kstep);
    PG8_WAIT_V(6); PG8_BAR;
    for (;;) {
        const bool has_next = S.next(ui + 1, nxt);
        const char* nA = has_next ? nxt.A : cA; const char* nB = has_next ? nxt.B : cB;
        if constexpr (GATHER) { if (has_next) { PG8_GOFF(gN, nxt); } else {
#pragma unroll
            for (int _h = 0; _h < 2; ++_h)
#pragma unroll
                for (int _i = 0; _i < 2; ++_i) gN[_h][_i] = gA[_h][_i]; } }
        for (int t = 0; t < nt; t += 2) {
            const bool last = (t == nt - 2);
            if (last && has_next) S.a_ready(nxt);
            const char* a1 = cA + (size_t)(t + 1) * kstep;
            const char* a2 = last ? nA : cA + (size_t)(t + 2) * kstep; const char* b2 = last ? nB : cB + (size_t)(t + 2) * kstep;
            const char* a3 = a2 + kstep; const char* b3 = b2 + kstep;
            PG8_LDB(B0, 0, 0); PG8_LDB(B1, 0, 1); PG8_SCHED; PG8_LDA(At, 0, 0); PG8_STAGE_A(PG8_SA(1, 1), a1, 1, false);
            PG8_WAIT_V(8); PG8_WAIT_L(0); PG8_BAR; PG8_MMA(0, 0, At, B0); PG8_MMA(0, 1, At, B1); PG8_BAR; PG8_SCHED;
            PG8_LDA(At, 0, 1); PG8_STAGE_B(PG8_SB(0, 0), b2); PG8_STAGE_B(PG8_SB(0, 1), b2 + hstepB); PG8_STAGE_A(PG8_SA(0, 0), a2, 0, last);
            PG8_WAIT_V(8); PG8_WAIT_L(0); PG8_BAR; PG8_MMA(1, 0, At, B0); PG8_MMA(1, 1, At, B1); PG8_BAR; PG8_SCHED;
            PG8_LDB(B0, 1, 0); PG8_LDB(B1, 1, 1); PG8_SCHED; PG8_LDA(At, 1, 0); PG8_STAGE_A(PG8_SA(0, 1), a2, 1, last);
            PG8_WAIT_V(8); PG8_WAIT_L(0); PG8_BAR; PG8_MMA(0, 0, At, B0); PG8_MMA(0, 1, At, B1); PG8_BAR; PG8_SCHED;
            PG8_LDA(At, 1, 1); PG8_STAGE_B(PG8_SB(1, 0), b3); PG8_STAGE_B(PG8_SB(1, 1), b3 + hstepB); PG8_STAGE_A(PG8_SA(1, 0), a3, 0, last);
            PG8_WAIT_V(8); PG8_WAIT_L(0); PG8_BAR; PG8_MMA(1, 0, At, B0); PG8_MMA(1, 1, At, B1); PG8_BAR; PG8_SCHED;
        }
        if constexpr (ALIGN_EPI) { if (wr == 0) PG8_BAR; }
        E(acc, cur, wr, wc, fr, fq); S.done(cur);
        if (!has_next) break;
#pragma unroll
        for (int a = 0; a < 2; ++a)
#pragma unroll
            for (int b = 0; b < 2; ++b)
#pragma unroll
                for (int m = 0; m < 4; ++m)
#pragma unroll
                    for (int n = 0; n < 2; ++n) acc[a][b][m][n] = (f32x4){0.f, 0.f, 0.f, 0.f};
        cur = nxt; cA = nA; cB = nB; ++ui;
        if constexpr (GATHER) {
#pragma unroll
            for (int _h = 0; _h < 2; ++_h)
#pragma unroll
                for (int _i = 0; _i < 2; ++_i) gA[_h][_i] = gN[_h][_i]; }
        if constexpr (ALIGN_EPI) { if (wr == 1) PG8_BAR; }
    }
    PG8_WAIT_V(0);
    if constexpr (!ALIGN_EPI) { if (wr == 0) PG8_BAR; }
    PG8_BAR;
#undef PG8_SA
#undef PG8_SB
#undef PG8_GLDS
#undef PG8_STAGE_A
#undef PG8_STAGE_B
#undef PG8_LDA
#undef PG8_LDB
#undef PG8_MMA
#undef PG8_WAIT_V
#undef PG8_WAIT_L
#undef PG8_BAR
#undef PG8_SCHED
#undef PG8_GOFF
}
}

typedef float f32x4_t __attribute__((ext_vector_type(4)));
__device__ __forceinline__ int inproj_row(int j) {
    if (j < 512) { const int h = j >> 6, d = j & 63; return h * 64 + 2 * (d & 31) + (d >> 5); }
    if (j < 1280) { const int seg = (j - 512) >> 7, cc = (j - 512) & 127; int col = cc; if (seg == 2 || seg == 4) { const int g = cc >> 6, d = cc & 63; col = g * 64 + 2 * (d & 31) + (d >> 5); } return (2 + (seg >> 1)) * 256 + (seg & 1) * 128 + col; }
    if (j < 1304) return 11 * 256 + (j - 1280);
    if (j < 1560) return 5 * 256 + (j - 1304);
    if (j < 1816) return 6 * 256 + (j - 1560);
    if (j < 2328) return 7 * 256 + (j - 1816);
    if (j < 2344) return 11 * 256 + 32 + (j - 2328);
    if (j < 2856) return 9 * 256 + (j - 2344);
    if (j < 3880) return 12 * 256 + (j - 2856);
    return 16 * 256 + (j - 3880);
}
__device__ __forceinline__ unsigned pk2(float lo, float hi) { return (unsigned)f2bf(lo) | ((unsigned)f2bf(hi) << 16); }
template <class RM>
__device__ __forceinline__ void transpose_item(const float* W, int ldw, int N, bf16* WT, int ldt, float* scr, int k0, int n0, int lane, RM rm) {
    const int rr = lane >> 4, c4 = (lane & 15) * 4; const bool inb = n0 + c4 < N;
    f32x4_t v[16];
#pragma unroll
    for (int i = 0; i < 16; ++i) v[i] = inb ? *(const f32x4_t*)(W + (size_t)(k0 + 4 * i + rr) * ldw + n0 + c4) : (f32x4_t){0.f, 0.f, 0.f, 0.f};
#pragma unroll
    for (int i = 0; i < 16; ++i) *(f32x4_t*)(scr + (4 * i + rr) * 68 + c4) = v[i];
    asm volatile("s_waitcnt lgkmcnt(0)" ::: "memory");
    const int c = lane & 7;
#pragma unroll
    for (int j = 0; j < 8; ++j) { const int n = (lane >> 3) + 8 * j; const float* s = scr + (8 * c) * 68 + n;
        uint4 o; o.x = pk2(s[0 * 68], s[1 * 68]); o.y = pk2(s[2 * 68], s[3 * 68]); o.z = pk2(s[4 * 68], s[5 * 68]); o.w = pk2(s[6 * 68], s[7 * 68]);
        const int row = (n0 + n < N) ? rm(n0 + n) : -1;
        if (row >= 0) *(uint4*)(WT + (size_t)row * ldt + k0 + 8 * c) = o; }
    asm volatile("s_waitcnt lgkmcnt(0)" ::: "memory");
}
constexpr int PREP_I_WIN = 16 * 77, PREP_I_C1 = 4 * 64, PREP_I_PN = 128, PREP_I_PG = 128, PREP_I_WO = 256, PREP_I_EXP = 3 * 32 * 128;
constexpr int PREP_ITEMS = PREP_I_WIN + PREP_I_C1 + PREP_I_PN + PREP_I_PG + PREP_I_WO + PREP_I_EXP;
__device__ __forceinline__ void prep_item(const P& p, int it, float* scr, int lane) {
    if (it < PREP_I_WIN) { const int kb = it / 77, nb = it % 77; transpose_item(p.w_in, INW, INW, p.Wt_in, 1024, scr, kb * 64, nb * 64, lane, [](int n) { return inproj_row(n); }); return; }
    it -= PREP_I_WIN;
    if (it < PREP_I_C1) { const int mat = it >> 6, r = it & 63, kb = r >> 2, nb = r & 3, kv = mat >> 1, half = mat & 1;
        const float* W = (kv ? p.cw1_v : p.cw1_k) + (size_t)half * 1024 * 256;
        transpose_item(W, 256, 256, p.Wc1 + (size_t)kv * 512 * 1024, 1024, scr, kb * 64, nb * 64, lane, [half](int n) { return half * 256 + n; }); return; }
    it -= PREP_I_C1;
    if (it < PREP_I_PN) { transpose_item(p.w_pn, 1024, 1024, p.Wpn, 512, scr, (it >> 4) * 64, (it & 15) * 64, lane, [](int n) { return n; }); return; }
    it -= PREP_I_PN;
    if (it < PREP_I_PG) { transpose_item(p.w_pg, 1024, 1024, p.Wpg, 512, scr, (it >> 4) * 64, (it & 15) * 64, lane, [](int n) { return n; }); return; }
    it -= PREP_I_PG;
    if (it < PREP_I_WO) { transpose_item(p.w_out, 1024, 1024, p.Wo, 1024, scr, (it >> 4) * 64, (it & 15) * 64, lane, [](int n) { return n; }); return; }
    it -= PREP_I_WO;
    { const int which = it / (32 * 128), r = it % (32 * 128), e = r >> 7, r2 = r & 127;
        if (which == 0) transpose_item(p.w_gate + (size_t)e * 1024 * 512, 512, 512, p.Wgu + (size_t)e * 1024 * 1024, 1024, scr, (r2 >> 3) * 64, (r2 & 7) * 64, lane, [](int n) { return (n >> 7) * 256 + (n & 127); });
        else if (which == 1) transpose_item(p.w_up + (size_t)e * 1024 * 512, 512, 512, p.Wgu + (size_t)e * 1024 * 1024, 1024, scr, (r2 >> 3) * 64, (r2 & 7) * 64, lane, [](int n) { return (n >> 7) * 256 + 128 + (n & 127); });
        else transpose_item(p.w_down + (size_t)e * 512 * 1024, 1024, 1024, p.Wd + (size_t)e * 1024 * 512, 512, scr, (r2 >> 4) * 64, (r2 & 15) * 64, lane, [](int n) { return n; }); }
}
__device__ __forceinline__ void phase_prep_(const P& p, char* smem);
__device__ __forceinline__ void prep_b1p(const P& p, char* smem);
__device__ __forceinline__ void phase_prep(const P& p, char* smem) { prep_b1p(p, smem); phase_prep_(p, smem); }
__device__ __forceinline__ void phase_prep_(const P& p, char* smem) {
    const int wave = TIDX() >> 6, lane = TIDX() & 63;
    float* scr = (float*)smem + wave * (64 * 68);
    const int gw = blockIdx.x * 8 + wave, NGW = gridDim.x * 8;
    for (int it = gw; it < PREP_ITEMS; it += NGW) prep_item(p, it, scr, lane);
    for (int i = blockIdx.x * NT + TIDX(); i < 216 * 128; i += gridDim.x * NT) { int r = i >> 7; r = r < 8 ? 24 + r : 40 + r; *(uint4*)(p.Wt_in + (size_t)(11 * 256 + r) * 1024 + (i & 127) * 8) = make_uint4(0, 0, 0, 0); }
    for (int i = blockIdx.x * NT + TIDX(); i < 36 * 1024; i += gridDim.x * NT) { const int o = i >> 10, k = i & 1023; p.wr[i] = o < 4 ? p.w_grp[k * 4 + o] : p.w_exp[k * 32 + (o - 4)]; }
    for (int vb = blockIdx.x; vb < p.T / 16; vb += gridDim.x) body_rms2(p, vb);
    for (int vb = blockIdx.x; vb < p.T * 32 / NT; vb += gridDim.x) body_cs(p, vb);
}

struct EpiInA {
    static constexpr bool PERM = true;
    P p;
    __device__ __forceinline__ static void rope4(const float* cs, int t, int i0, const pg8::f32x4& v0, const pg8::f32x4& v1, float sc, pg8::u32x2& lo, pg8::u32x2& hi) {
        const f32x4_t c = *(const f32x4_t*)(cs + (size_t)t * 64 + i0), s = *(const f32x4_t*)(cs + (size_t)t * 64 + 32 + i0);
        const float a0 = (v0[0] * c[0] - v0[1] * s[0]) * sc, b0 = (v0[1] * c[0] + v0[0] * s[0]) * sc;
        const float a1 = (v0[2] * c[1] - v0[3] * s[1]) * sc, b1 = (v0[3] * c[1] + v0[2] * s[1]) * sc;
        const float a2 = (v1[0] * c[2] - v1[1] * s[2]) * sc, b2 = (v1[1] * c[2] + v1[0] * s[2]) * sc;
        const float a3 = (v1[2] * c[3] - v1[3] * s[3]) * sc, b3 = (v1[3] * c[3] + v1[2] * s[3]) * sc;
        lo.x = pk2(a0, a1); lo.y = pk2(a2, a3); hi.x = pk2(b0, b1); hi.y = pk2(b2, b3);
    }
    __device__ __forceinline__ static pg8::u32x4 pack8(const pg8::f32x4& v0, const pg8::f32x4& v1) { pg8::u32x4 w; w.x = pk2(v0[0], v0[1]); w.y = pk2(v0[2], v0[3]); w.z = pk2(v1[0], v1[1]); w.w = pk2(v1[2], v1[3]); return w; }
    __device__ __forceinline__ void operator()(const pg8::f32x4 (&acc)[2][2][4][2], const pg8::Unit& u, int wr, int wc, int fr, int fq) const {
        const int pn = u.pn, c8 = wc * 32 + 8 * fq; const size_t seg = kvseg(p);
#pragma unroll
        for (int ai = 0; ai < 2; ++ai)
#pragma unroll
            for (int m = 0; m < 4; ++m) {
                const int t = u.pm * 256 + ai * 128 + wr * 64 + m * 16 + fr; const int b = t / S, s = t % S;
#pragma unroll
                for (int bj = 0; bj < 2; ++bj) {
                    const pg8::f32x4 v0 = acc[ai][bj][m][0], v1 = acc[ai][bj][m][1];
                    if (pn <= 1) {
                        const int cq = pn * 256 + bj * 128 + c8, h = cq >> 6, i0 = (cq & 63) >> 1; pg8::u32x2 lo, hi;
                        rope4(p.cs, t, i0, v0, v1, 0.125f, lo, hi);
                        bf16* dst = p.q + (size_t)t * 512 + h * 64 + i0; *(pg8::u32x2*)dst = lo; *(pg8::u32x2*)(dst + 32) = hi;
                    } else if (pn <= 4) {
                        const int sgi = (pn - 2) * 2 + bj, g = c8 >> 6; bf16* base = p.kv6 + (size_t)sgi * seg + ((size_t)(b * 2 + g) * S + s) * 64;
                        if (bj == 0 && pn >= 3) { const int i0 = (c8 & 63) >> 1; pg8::u32x2 lo, hi; rope4(p.cs, t, i0, v0, v1, 1.f, lo, hi); *(pg8::u32x2*)(base + i0) = lo; *(pg8::u32x2*)(base + 32 + i0) = hi; }
                        else *(pg8::u32x4*)(base + (c8 & 63)) = pack8(v0, v1);
                    } else if (pn == 5) { *(pg8::u32x4*)(p.gq + (size_t)t * 256 + bj * 128 + c8) = pack8(v0 * 0.125f, v1 * 0.125f);
                    } else if (pn == 6) { *(pg8::u32x4*)(p.gk + (size_t)t * 256 + bj * 128 + c8) = pack8(v0, v1);
                    } else if (pn <= 8) { *(pg8::u32x4*)(p.gv + (size_t)t * 512 + (pn - 7) * 256 + bj * 128 + c8) = pack8(v0, v1);
                    } else if (pn <= 10) {
                        pg8::f32x4 a, c;
#pragma unroll
                        for (int e = 0; e < 4; ++e) { a[e] = siluf_(v0[e]); c[e] = siluf_(v1[e]); }
                        *(pg8::u32x4*)(p.rs + (size_t)t * 512 + (pn - 9) * 256 + bj * 128 + c8) = pack8(a, c);
                    } else {
                        if (bj == 0) {
                            if (c8 < 24) { float* d = p.gates + (size_t)t * 24 + c8;
#pragma unroll
                                for (int e = 0; e < 4; ++e) { d[e] = sigmoidf_(v0[e]); d[4 + e] = sigmoidf_(v1[e]); } }
                            else if (c8 >= 32 && c8 < 48) { float* d = p.alow + (size_t)t * 16 + (c8 - 32);
#pragma unroll
                                for (int e = 0; e < 4; ++e) { d[e] = v0[e]; d[4 + e] = v1[e]; } }
                        }
                    }
                }
            }
    }
};
struct EpiSig {
    static constexpr bool PERM = true;
    bf16* sa; bf16* sb;
    __device__ __forceinline__ void operator()(const pg8::f32x4 (&acc)[2][2][4][2], const pg8::Unit& u, int wr, int wc, int fr, int fq) const {
        bf16* base = (u.pn < 4 ? sa : sb) + (u.pn & 3) * 256 + wc * 32 + 8 * fq;
#pragma unroll
        for (int ai = 0; ai < 2; ++ai)
#pragma unroll
            for (int m = 0; m < 4; ++m) { const int t = u.pm * 256 + ai * 128 + wr * 64 + m * 16 + fr;
#pragma unroll
                for (int bj = 0; bj < 2; ++bj) { pg8::f32x4 a, c;
#pragma unroll
                    for (int e = 0; e < 4; ++e) { a[e] = sigmoidf_(acc[ai][bj][m][0][e]); c[e] = sigmoidf_(acc[ai][bj][m][1][e]); }
                    *(pg8::u32x4*)(base + (size_t)t * 1024 + bj * 128) = EpiInA::pack8(a, c); } }
    }
};
__device__ __forceinline__ void phase_inA(const P& p, char* smem) {
    pg8::DenseSched S; S.init(p.u, p.Wt_in, p.T, 3072, 1024, 1024);
    EpiInA E{p};
    pg8::gemm_phase<EpiInA, pg8::DenseSched, true, false>((PG8_LAS unsigned char*)smem, 1024, 1024, 1024, S, E);
}
__device__ __forceinline__ void phase_inB(const P& p, char* smem) {
    pg8::DenseSched S; S.init(p.u, p.Wt_in + (size_t)3072 * 1024, p.T, 2048, 1024, 1024);
    EpiSig E{p.sa, p.sb};
    pg8::gemm_phase<EpiSig, pg8::DenseSched, true, false>((PG8_LAS unsigned char*)smem, 1024, 1024, 1024, S, E);
}

struct EpiProj {
    static constexpr bool PERM = true;
    const bf16* g; bf16* mixed; int pass;
    __device__ __forceinline__ void operator()(const pg8::f32x4 (&acc)[2][2][4][2], const pg8::Unit& u, int wr, int wc, int fr, int fq) const {
        const int col0 = u.pn * 256 + wc * 32 + 8 * fq;
#pragma unroll
        for (int ai = 0; ai < 2; ++ai)
#pragma unroll
            for (int m = 0; m < 4; ++m) { const size_t t = (size_t)(u.pm * 256 + ai * 128 + wr * 64 + m * 16 + fr);
#pragma unroll
                for (int bj = 0; bj < 2; ++bj) { const size_t off = t * 1024 + col0 + bj * 128;
                    const uint4 gv = *(const uint4*)(g + off); const unsigned gw[4] = {gv.x, gv.y, gv.z, gv.w};
                    float r[8];
#pragma unroll
                    for (int e = 0; e < 4; ++e) { const float a = e < 2 ? acc[ai][bj][m][0][2 * e] : acc[ai][bj][m][1][2 * e - 4], b = e < 2 ? acc[ai][bj][m][0][2 * e + 1] : acc[ai][bj][m][1][2 * e - 3];
                        r[2 * e] = __uint_as_float(gw[e] << 16) * a; r[2 * e + 1] = __uint_as_float(gw[e] & 0xffff0000u) * b; }
                    if (pass) { const uint4 mv = *(const uint4*)(mixed + off); const unsigned mw[4] = {mv.x, mv.y, mv.z, mv.w};
#pragma unroll
                        for (int e = 0; e < 4; ++e) { r[2 * e] += __uint_as_float(mw[e] << 16); r[2 * e + 1] += __uint_as_float(mw[e] & 0xffff0000u); } }
                    uint4 o; o.x = pk2(r[0], r[1]); o.y = pk2(r[2], r[3]); o.z = pk2(r[4], r[5]); o.w = pk2(r[6], r[7]);
                    *(uint4*)(mixed + off) = o; } }
    }
};
struct EpiOut {
    static constexpr bool PERM = true;
    const float* x; bf16* h1b;
    __device__ __forceinline__ void operator()(const pg8::f32x4 (&acc)[2][2][4][2], const pg8::Unit& u, int wr, int wc, int fr, int fq) const {
        const int col0 = u.pn * 256 + wc * 32 + 8 * fq;
#pragma unroll
        for (int ai = 0; ai < 2; ++ai)
#pragma unroll
            for (int m = 0; m < 4; ++m) { const size_t off = (size_t)(u.pm * 256 + ai * 128 + wr * 64 + m * 16 + fr) * 1024 + col0;
#pragma unroll
                for (int bj = 0; bj < 2; ++bj) { const pg8::f32x4 x0 = *(const pg8::f32x4*)(x + off + bj * 128), x1 = *(const pg8::f32x4*)(x + off + bj * 128 + 4);
                    *(pg8::u32x4*)(h1b + off + bj * 128) = EpiInA::pack8(x0 + acc[ai][bj][m][0], x1 + acc[ai][bj][m][1]); } }
    }
};
__device__ __forceinline__ void phase_proj(const P& p, char* smem) {
    { pg8::DenseSched S; S.init(p.onsa, p.Wpn, p.T, 1024, 512, 512); EpiProj E{p.sa, p.mixed, 0};
      pg8::gemm_phase<EpiProj, pg8::DenseSched, true, false>((PG8_LAS unsigned char*)smem, 512, 512, 512, S, E); }
    { pg8::DenseSched S; S.init(p.gla, p.Wpg, p.T, 1024, 512, 512); EpiProj E{p.sb, p.mixed, 1};
      pg8::gemm_phase<EpiProj, pg8::DenseSched, true, false>((PG8_LAS unsigned char*)smem, 512, 512, 512, S, E); }
}
__device__ __forceinline__ void phase_out(const P& p, char* smem) {
    pg8::DenseSched S; S.init(p.mixed, p.Wo, p.T, 1024, 1024, 1024); EpiOut E{p.x, p.h1b};
    pg8::gemm_phase<EpiOut, pg8::DenseSched, true, false>((PG8_LAS unsigned char*)smem, 1024, 1024, 1024, S, E);
}

struct ExpertSched {
    const int* ub;
    const int* sb_;
    const unsigned* cnt; const int* list; int T;
    const char* A; const char* B; int lda, ldb; size_t bstride;
    int npn, G, c; bool gather;
    int r1;
    unsigned* ready; int role;
    __device__ __forceinline__ bool next(int i, pg8::Unit& u) const {
        int L = i * G + c;
        if (role == 2 && r1 > 0) { const int nl = G - r1, period = 2 * nl + r1;
            L = (c < r1) ? i * period + 2 * nl + c : (i >> 1) * period + (i & 1) * nl + (c - r1); }
        if (L >= ub[NEXP]) return false;
        int e = 0; while (L >= ub[e + 1]) ++e;
        const int rem = L - ub[e], tiles = (ub[e + 1] - ub[e]) / npn, pn = rem / tiles, pml = rem % tiles;
        u.pm = sb_[e] / 256 + pml; u.pn = pn; u.tag = e | (pml << 8);
        u.A = gather ? A : A + (size_t)u.pm * 256 * lda * 2; u.B = B + (size_t)e * bstride + (size_t)pn * 256 * ldb * 2; return true;
    }
    __device__ __forceinline__ unsigned arow(const pg8::Unit& u, int r) const {
        const int e = u.tag & 255, sl = (u.tag >> 8) * 256 + r; const int tok = list[(size_t)e * T + (sl < (int)cnt[e * 32] ? sl : 0)];
        return (unsigned)tok * (unsigned)lda * 2u;
    }
    __device__ __forceinline__ void a_ready(const pg8::Unit& u) const {
        if (role != 2) return;
        if (TIDX() < 64) { unsigned spins = 0;
            while ((unsigned)__builtin_amdgcn_readfirstlane((int)__hip_atomic_load(ready + u.pm, __ATOMIC_RELAXED, __HIP_MEMORY_SCOPE_AGENT)) < 32u) { __builtin_amdgcn_s_sleep(2); if (++spins > (1u << 22)) break; }
            __builtin_amdgcn_fence(__ATOMIC_ACQUIRE, "agent");
            asm volatile("s_waitcnt vmcnt(0)" ::: "memory"); }
        asm volatile("" ::: "memory"); __builtin_amdgcn_s_barrier(); asm volatile("" ::: "memory");
    }
    __device__ __forceinline__ void done(const pg8::Unit& u) const {
        if (role != 1) return;
        asm volatile("s_waitcnt vmcnt(0)" ::: "memory");
        if ((TIDX() & 63) == 0) __hip_atomic_fetch_add(ready + u.pm, 1u, __ATOMIC_RELAXED, __HIP_MEMORY_SCOPE_AGENT);
    }
};
__device__ __forceinline__ void expert_tables(const P& p, char* smem, int npn, int*& ub, int*& sb_) {
    ub = (int*)(smem + LDS_MISC + 1024); sb_ = ub + 40;
    __syncthreads();
    if (TIDX() == 0) { int ua = 0, sa = 0; for (int e = 0; e < NEXP; ++e) { ub[e] = ua; sb_[e] = sa; const int tl = ((int)p.ctl[e * 32] + 255) >> 8; ua += tl * npn; sa += tl * 256; } ub[NEXP] = ua; sb_[NEXP] = sa; }
    __syncthreads();
}
struct EpiMoe1 {
    static constexpr bool PERM = true;
    __amdgpu_buffer_rsrc_t rsrc;
    __device__ __forceinline__ void operator()(const pg8::f32x4 (&acc)[2][2][4][2], const pg8::Unit& u, int wr, int wc, int fr, int fq) const {
        const int col0 = u.pn * 128 + wc * 32 + 8 * fq;
#pragma unroll
        for (int ai = 0; ai < 2; ++ai)
#pragma unroll
            for (int m = 0; m < 4; ++m) { const size_t row = (size_t)(u.pm * 256 + ai * 128 + wr * 64 + m * 16 + fr);
                pg8::f32x4 a, b;
#pragma unroll
                for (int e = 0; e < 4; ++e) { a[e] = siluf_(acc[ai][0][m][0][e]) * acc[ai][1][m][0][e]; b[e] = siluf_(acc[ai][0][m][1][e]) * acc[ai][1][m][1][e]; }
                __builtin_amdgcn_raw_buffer_store_b128(EpiInA::pack8(a, b), rsrc, (unsigned)((row * 512 + col0) * 2), 0, 16  ); }
    }
};
struct EpiMoe2 {
    static constexpr bool PERM = true;
    bf16* Y;
    __device__ __forceinline__ void operator()(const pg8::f32x4 (&acc)[2][2][4][2], const pg8::Unit& u, int wr, int wc, int fr, int fq) const {
        const int col0 = u.pn * 256 + wc * 32 + 8 * fq;
#pragma unroll
        for (int ai = 0; ai < 2; ++ai)
#pragma unroll
            for (int m = 0; m < 4; ++m) { const size_t row = (size_t)(u.pm * 256 + ai * 128 + wr * 64 + m * 16 + fr);
#pragma unroll
                for (int bj = 0; bj < 2; ++bj) *(pg8::u32x4*)(Y + row * 1024 + col0 + bj * 128) = EpiInA::pack8(acc[ai][bj][m][0], acc[ai][bj][m][1]); }
    }
};
__device__ __forceinline__ void phase_moe12(const P& p, char* smem) {
    int *ub, *sb_; expert_tables(p, smem, 4, ub, sb_);
    unsigned* ready = p.ctl + 3072;
    { ExpertSched S{ub, sb_, p.ctl, p.list, p.T, (const char*)p.vb, (const char*)p.Wgu, 1024, 1024, (size_t)1024 * 1024 * 2, 4, (int)gridDim.x, (int)blockIdx.x, true, 0, ready, 1};
      EpiMoe1 E{__builtin_amdgcn_make_buffer_rsrc((void*)p.H, 0, (int)((2 * (size_t)p.T + NEXP * 256) * 512 * 2), 0x00020000)};
      pg8::gemm_phase<EpiMoe1, ExpertSched, true, true>((PG8_LAS unsigned char*)smem, 1024, 1024, 1024, S, E); }
    { const int G = (int)gridDim.x, r1 = (ub[NEXP] % G);
      ExpertSched S{ub, sb_, p.ctl, p.list, p.T, (const char*)p.H, (const char*)p.Wd, 512, 512, (size_t)1024 * 512 * 2, 4, G, (int)blockIdx.x, false, r1, ready, 2};
      EpiMoe2 E{p.Y};
      pg8::gemm_phase<EpiMoe2, ExpertSched, true, false>((PG8_LAS unsigned char*)smem, 512, 512, 512, S, E); }
}

namespace nsa {
using f32x16 = __attribute__((ext_vector_type(16))) float;
using bf16x8 = __attribute__((ext_vector_type(8))) short;
using s16x4 = __attribute__((ext_vector_type(4))) short;
using u32x4 = __attribute__((ext_vector_type(4))) unsigned;
typedef __attribute__((address_space(3))) char* lptr;
typedef __attribute__((address_space(3))) const char* lcptr;
constexpr int SLOT = 8192;
constexpr int NSLOT = 3;
constexpr int L_K = 0, L_V = NSLOT * SLOT, L_WS = 2 * NSLOT * SLOT, L_OST = L_WS + 8 * 512, L_IMPD = L_OST + 8 * 4096, L_IMPC = L_IMPD + 64 * 64 * 4, L_SEL = L_IMPC + 64 * 68 * 4, L_END = L_SEL + 64 * 8;
constexpr float LOG2E = 1.4426950408889634f, NEGM = -1e30f, M0 = -1e20f, THR = 8.f;
__device__ __forceinline__ int crow(int r, int hi) { return (r & 3) + 8 * (r >> 2) + 4 * hi; }
__device__ __forceinline__ void glds16(const void* gsrc, unsigned lds_dst) { unsigned keep;
    asm volatile("s_mov_b32 %0, m0\n\ts_mov_b32 m0, %2\n\ts_nop 0\n\tglobal_load_lds_dwordx4 %1, off\n\ts_mov_b32 m0, %0" : "=&s"(keep) : "v"(gsrc), "s"(lds_dst) : "memory"); }
#define NSA_WAIT_BAR() asm volatile("s_waitcnt vmcnt(2) lgkmcnt(0)\n\ts_barrier" ::: "memory")
#define NSA_DRAIN_BAR() asm volatile("s_waitcnt vmcnt(0) lgkmcnt(0)\n\ts_barrier" ::: "memory")
#define NSA_LWAIT() asm volatile("s_waitcnt lgkmcnt(0)" ::: "memory")
__device__ __forceinline__ unsigned cvtpk(float lo, float hi) { typedef float f2 __attribute__((ext_vector_type(2))); typedef __bf16 b2 __attribute__((ext_vector_type(2))); f2 v = {lo, hi}; b2 b = __builtin_convertvector(v, b2); return __builtin_bit_cast(unsigned, b); }
__device__ __forceinline__ float xhalf_max(float m) { auto rr = __builtin_amdgcn_permlane32_swap(__float_as_uint(m), __float_as_uint(m), false, false); return fmaxf(__uint_as_float(rr[0]), __uint_as_float(rr[1])); }
__device__ __forceinline__ float xhalf_sum(float m) { auto rr = __builtin_amdgcn_permlane32_swap(__float_as_uint(m), __float_as_uint(m), false, false); return __uint_as_float(rr[0]) + __uint_as_float(rr[1]); }
__device__ __forceinline__ void qkt(f32x16& p0, f32x16& p1, lcptr Kslot, const bf16x8* qr, int r32, int hi) {
    lcptr kb = Kslot + hi * 1024 + r32 * 16;
    p0 = f32x16{}; p1 = f32x16{};
#pragma unroll
    for (int d0 = 0; d0 < 4; ++d0) {
        const bf16x8 b0 = *(const __attribute__((address_space(3))) bf16x8*)(kb + d0 * 2048);
        const bf16x8 b1 = *(const __attribute__((address_space(3))) bf16x8*)(kb + d0 * 2048 + 512);
        p0 = __builtin_amdgcn_mfma_f32_32x32x16_bf16(b0, qr[d0], p0, 0, 0, 0); p1 = __builtin_amdgcn_mfma_f32_32x32x16_bf16(b1, qr[d0], p1, 0, 0, 0); }
}
__device__ __forceinline__ void pv(f32x16* o, int vb, bf16x8 pa0, bf16x8 pa1, bf16x8 pa2, bf16x8 pa3) {
#pragma unroll
    for (int d0 = 0; d0 < 2; ++d0) { s16x4 lo[4], hi[4];
#pragma unroll
        for (int ks = 0; ks < 4; ++ks) {
            asm volatile("ds_read_b64_tr_b16 %0,%1 offset:%c2" : "=&v"(lo[ks]) : "v"(vb), "i"(d0 * 4096 + ks * 1024) : "memory");
            asm volatile("ds_read_b64_tr_b16 %0,%1 offset:%c2" : "=&v"(hi[ks]) : "v"(vb), "i"(d0 * 4096 + ks * 1024 + 512) : "memory"); }
        asm volatile("s_waitcnt lgkmcnt(0)" ::: "memory"); __builtin_amdgcn_sched_barrier(0);
#define NSA_PK(k) (bf16x8){lo[k][0], lo[k][1], lo[k][2], lo[k][3], hi[k][0], hi[k][1], hi[k][2], hi[k][3]}
        o[d0] = __builtin_amdgcn_mfma_f32_32x32x16_bf16(pa0, NSA_PK(0), o[d0], 0, 0, 0);
        o[d0] = __builtin_amdgcn_mfma_f32_32x32x16_bf16(pa1, NSA_PK(1), o[d0], 0, 0, 0);
        o[d0] = __builtin_amdgcn_mfma_f32_32x32x16_bf16(pa2, NSA_PK(2), o[d0], 0, 0, 0);
        o[d0] = __builtin_amdgcn_mfma_f32_32x32x16_bf16(pa3, NSA_PK(3), o[d0], 0, 0, 0);
#undef NSA_PK
    }
}
__device__ __forceinline__ float rowmax32(const f32x16& p0, const f32x16& p1) {
    float a = fmaxf(p0[0], p1[0]);
#pragma unroll
    for (int r = 1; r < 16; ++r) a = fmaxf(a, fmaxf(p0[r], p1[r]));
    return xhalf_max(a);
}
struct Ctx {
    int w, lane, r32, hi, rs; unsigned lds0; lptr shm; const bf16* kt; const bf16* vt;
};
__device__ __forceinline__ void dma_kv(const Ctx& c, int tile, int slot) {
    const bf16* ksrc = c.kt + (size_t)tile * 64 * 64 + c.lane * 64 + c.w * 8;
    const bf16* vsrc = c.vt + (size_t)tile * 64 * 64 + (16 * (c.w & 3) + (c.lane >> 2)) * 64 + (c.w >> 2) * 32 + (c.lane & 3) * 8;
    glds16(ksrc, (unsigned)__builtin_amdgcn_readfirstlane(c.lds0 + L_K + slot * SLOT + c.w * 1024));
    glds16(vsrc, (unsigned)__builtin_amdgcn_readfirstlane(c.lds0 + L_V + slot * SLOT + c.w * 1024));
}
template <int ABL = 0> __device__ __forceinline__ void ring_begin(Ctx& c, int t0, int t1) { NSA_DRAIN_BAR(); if (!(ABL & 8)) { dma_kv(c, t0, 0); dma_kv(c, t1 >= 0 ? t1 : t0, 1); } c.rs = 0; }
template <int ABL = 0> __device__ __forceinline__ void ring_step(Ctx& c, int t2, int tcur) { if (!(ABL & 16)) NSA_WAIT_BAR(); int s2 = c.rs + 2; if (s2 >= NSLOT) s2 -= NSLOT; if (!(ABL & 8)) dma_kv(c, t2 >= 0 ? t2 : tcur, s2); }
__device__ __forceinline__ void ring_next(Ctx& c) { c.rs = (c.rs == NSLOT - 1) ? 0 : c.rs + 1; }
template <int ABL> __device__ __forceinline__ void softmax_pv(const Ctx& c, f32x16& p0, f32x16& p1, f32x16* o, float& m, float& l, int slot, bool on) {
    float a0 = fmaxf(fmaxf(p0[0], p0[1]), p1[0]), a1 = fmaxf(fmaxf(p0[2], p0[3]), p1[1]), a2 = fmaxf(fmaxf(p0[4], p0[5]), p1[2]), a3 = fmaxf(fmaxf(p0[6], p0[7]), p1[3]);
    a0 = fmaxf(fmaxf(a0, p0[8]), p0[9]); a1 = fmaxf(fmaxf(a1, p0[10]), p0[11]); a2 = fmaxf(fmaxf(a2, p0[12]), p0[13]); a3 = fmaxf(fmaxf(a3, p0[14]), p0[15]);
    a0 = fmaxf(fmaxf(a0, p1[4]), p1[5]); a1 = fmaxf(fmaxf(a1, p1[6]), p1[7]); a2 = fmaxf(fmaxf(a2, p1[8]), p1[9]); a3 = fmaxf(fmaxf(a3, p1[10]), p1[11]);
    a0 = fmaxf(fmaxf(a0, p1[12]), p1[13]); a1 = fmaxf(fmaxf(a1, p1[14]), p1[15]);
    float rm = xhalf_max(fmaxf(fmaxf(a0, a1), fmaxf(a2, a3)));
    rm = on ? rm : NEGM;
    volatile __attribute__((address_space(3))) float* wsf = (volatile __attribute__((address_space(3))) float*)(c.shm + L_WS + c.w * 512);
    bool resc = false;
    if (__any(rm > m + THR)) { const float mn = fmaxf(m, rm); const float f = __builtin_amdgcn_exp2f(m - mn); l *= f; m = mn; if (c.hi == 0) wsf[c.r32] = f; resc = true; }
    const float ms = on ? m : 1e30f;
    float s0 = 0.f, s1 = 0.f, s2 = 0.f, s3 = 0.f;
#pragma unroll
    for (int r = 0; r < 16; r += 2) {
        if (!(ABL & 2)) { p0[r] = __builtin_amdgcn_exp2f(p0[r] - ms); p0[r + 1] = __builtin_amdgcn_exp2f(p0[r + 1] - ms); p1[r] = __builtin_amdgcn_exp2f(p1[r] - ms); p1[r + 1] = __builtin_amdgcn_exp2f(p1[r + 1] - ms); }
        else { p0[r] -= ms; p0[r + 1] -= ms; p1[r] -= ms; p1[r + 1] -= ms; }
        s0 += p0[r]; s1 += p0[r + 1]; s2 += p1[r]; s3 += p1[r + 1]; }
    l += (s0 + s1) + (s2 + s3);
    if (resc) { NSA_LWAIT();
#pragma unroll
        for (int r = 0; r < 16; ++r) { const float f = wsf[crow(r, c.hi)]; o[0][r] *= f; o[1][r] *= f; } }
    u32x4 w0, w1, w2, w3;
    w0 = (u32x4){cvtpk(p0[0], p0[1]), cvtpk(p0[2], p0[3]), cvtpk(p0[4], p0[5]), cvtpk(p0[6], p0[7])};
    w1 = (u32x4){cvtpk(p0[8], p0[9]), cvtpk(p0[10], p0[11]), cvtpk(p0[12], p0[13]), cvtpk(p0[14], p0[15])};
    w2 = (u32x4){cvtpk(p1[0], p1[1]), cvtpk(p1[2], p1[3]), cvtpk(p1[4], p1[5]), cvtpk(p1[6], p1[7])};
    w3 = (u32x4){cvtpk(p1[8], p1[9]), cvtpk(p1[10], p1[11]), cvtpk(p1[12], p1[13]), cvtpk(p1[14], p1[15])};
    const int vb = (int)(c.lds0 + L_V + slot * SLOT) + ((c.lane >> 4) & 1) * 32 + (c.lane & 3) * 8 + (4 * c.hi + ((c.lane & 15) >> 2)) * 64;
    if (!(ABL & 1)) pv(o, vb, __builtin_bit_cast(bf16x8, w0), __builtin_bit_cast(bf16x8, w1), __builtin_bit_cast(bf16x8, w2), __builtin_bit_cast(bf16x8, w3));
    else { asm volatile("" :: "v"(w0), "v"(w1), "v"(w2), "v"(w3)); }
}
__device__ __forceinline__ void accum_branch(const Ctx& c, f32x16* oacc, const f32x16* o, float fac) {
    volatile __attribute__((address_space(3))) float* wsf = (volatile __attribute__((address_space(3))) float*)(c.shm + L_WS + c.w * 512);
    NSA_LWAIT(); if (c.hi == 0) wsf[64 + c.r32] = fac; NSA_LWAIT();
#pragma unroll
    for (int r = 0; r < 16; ++r) { const float f = wsf[64 + crow(r, c.hi)]; oacc[0][r] += o[0][r] * f; oacc[1][r] += o[1][r] * f; }
    NSA_LWAIT();
}
template <int ABL> __device__ __forceinline__ void nsa_unit(const P& p, char* smem, int b, int g, int jq) {
    const int tid = TIDX(); Ctx c; c.lane = tid & 63; c.w = __builtin_amdgcn_readfirstlane(tid >> 6); c.r32 = c.lane & 31; c.hi = c.lane >> 5;
    c.shm = (lptr)smem; c.lds0 = (unsigned)(size_t)c.shm;
    const int hh = c.r32 >> 3, tokl = 8 * c.w + (c.r32 & 7), stok = 64 * jq + tokl, h = g * 4 + hh; const size_t t = (size_t)b * S + stok;
    const size_t seg = kvseg(p), ho = (size_t)(b * 2 + g) * S * 64;
    bf16x8 qr[4];
#pragma unroll
    for (int d0 = 0; d0 < 4; ++d0) { const u32x4 raw = *(const u32x4*)(p.q + t * 512 + h * 64 + d0 * 16 + c.hi * 8); u32x4 sc;
#pragma unroll
        for (int e4 = 0; e4 < 4; ++e4) sc[e4] = cvtpk(__uint_as_float(raw[e4] << 16) * LOG2E, __uint_as_float(raw[e4] & 0xffff0000u) * LOG2E);
        qr[d0] = __builtin_bit_cast(bf16x8, sc); }
    const float g0 = p.gates[t * 24 + h * 3], g1 = p.gates[t * 24 + h * 3 + 1], g2 = p.gates[t * 24 + h * 3 + 2];
    f32x16 oacc[2], o[2], p0, p1; oacc[0] = f32x16{}; oacc[1] = f32x16{};
    __attribute__((address_space(3))) float* impD = (__attribute__((address_space(3))) float*)(c.shm + L_IMPD);
    __attribute__((address_space(3))) float* impC = (__attribute__((address_space(3))) float*)(c.shm + L_IMPC);
    __attribute__((address_space(3))) u64* selm = (__attribute__((address_space(3))) u64*)(c.shm + L_SEL);
    const int nv = stok >= 31 ? (stok - 31) / 16 + 1 : 0;
    const int nct = (4 * jq + 3 + 63) >> 6;
    c.kt = p.kcmp + (size_t)(b * 2 + g) * 256 * 64; c.vt = p.vcmp + (size_t)(b * 2 + g) * 256 * 64;
    float m = M0, l = 0.f;
    if (tid < 64) impC[tid * 68] = 0.f;
    ring_begin(c, 0, nct > 1 ? 1 : -1);
    for (int ct = 0; ct < ((ABL & 64) ? 0 : nct); ++ct) {
        ring_step(c, ct + 2 < nct ? ct + 2 : -1, ct);
        qkt(p0, p1, (lcptr)(c.shm + L_K + c.rs * SLOT), qr, c.r32, c.hi); ring_next(c);
#pragma unroll
        for (int r = 0; r < 16; ++r) { const int n = 64 * ct + crow(r, c.hi); p0[r] = n < nv ? p0[r] : NEGM; p1[r] = n + 32 < nv ? p1[r] : NEGM; }
        const float rm = rowmax32(p0, p1); const float mn = fmaxf(m, rm); float sacc = 0.f;
#pragma unroll
        for (int r = 0; r < 16; ++r) sacc += __builtin_amdgcn_exp2f(p0[r] - mn) + __builtin_amdgcn_exp2f(p1[r] - mn);
        l = l * __builtin_amdgcn_exp2f(m - mn) + sacc; m = mn;
    }
    l = xhalf_sum(l); const float il = l > 0.f ? 1.f / l : 0.f;
    o[0] = f32x16{}; o[1] = f32x16{};
    ring_begin(c, 0, nct > 1 ? 1 : -1);
    for (int ct = 0; ct < ((ABL & 64) ? 0 : nct); ++ct) {
        ring_step(c, ct + 2 < nct ? ct + 2 : -1, ct);
        qkt(p0, p1, (lcptr)(c.shm + L_K + c.rs * SLOT), qr, c.r32, c.hi);
#pragma unroll
        for (int r = 0; r < 16; ++r) { const int n = 64 * ct + crow(r, c.hi); p0[r] = n < nv ? __builtin_amdgcn_exp2f(p0[r] - m) * il : 0.f; p1[r] = n + 32 < nv ? __builtin_amdgcn_exp2f(p1[r] - m) * il : 0.f; }
#pragma unroll
        for (int hb = 0; hb < 2; ++hb)
#pragma unroll
            for (int rg = 0; rg < 4; ++rg) {
                const f32x16& pp = hb ? p1 : p0;
                float dsum = pp[4 * rg] + pp[4 * rg + 1] + pp[4 * rg + 2] + 0.5f * pp[4 * rg + 3], csum = 0.5f * pp[4 * rg + 3];
                dsum += __shfl_xor(dsum, 8); dsum += __shfl_xor(dsum, 16); csum += __shfl_xor(csum, 8); csum += __shfl_xor(csum, 16);
                const int j = 16 * ct + 8 * hb + 2 * rg + c.hi;
                if (c.r32 < 8) { impD[tokl * 64 + j] = dsum; impC[tokl * 68 + j + 1] = csum; }
            }
        u32x4 w0, w1, w2, w3;
        w0 = (u32x4){cvtpk(p0[0], p0[1]), cvtpk(p0[2], p0[3]), cvtpk(p0[4], p0[5]), cvtpk(p0[6], p0[7])};
        w1 = (u32x4){cvtpk(p0[8], p0[9]), cvtpk(p0[10], p0[11]), cvtpk(p0[12], p0[13]), cvtpk(p0[14], p0[15])};
        w2 = (u32x4){cvtpk(p1[0], p1[1]), cvtpk(p1[2], p1[3]), cvtpk(p1[4], p1[5]), cvtpk(p1[6], p1[7])};
        w3 = (u32x4){cvtpk(p1[8], p1[9]), cvtpk(p1[10], p1[11]), cvtpk(p1[12], p1[13]), cvtpk(p1[14], p1[15])};
        const int vb = (int)(c.lds0 + L_V + c.rs * SLOT) + ((c.lane >> 4) & 1) * 32 + (c.lane & 3) * 8 + (4 * c.hi + ((c.lane & 15) >> 2)) * 64;
        pv(o, vb, __builtin_bit_cast(bf16x8, w0), __builtin_bit_cast(bf16x8, w1), __builtin_bit_cast(bf16x8, w2), __builtin_bit_cast(bf16x8, w3));
        ring_next(c);
    }
    accum_branch(c, oacc, o, g0);
    NSA_LWAIT(); __builtin_amdgcn_s_barrier();
    {
#pragma unroll 1
        for (int tkk = 0; tkk < 8; ++tkk) { const int tk = 8 * c.w + tkk, j = c.lane; const bool valid = j <= jq;
            const float sc = (j == 0 || j == jq || j == jq - 1) ? 1e4f : impD[tk * 64 + j] + impC[tk * 68 + j];
            const unsigned key = valid ? ((__float_as_uint(sc) & ~63u) | (unsigned)(63 - j)) : 0u;
            int rank = 0;
            if (!(ABL & 32)) {
#pragma unroll
                for (int i = 0; i < 64; ++i) { const unsigned ki = (unsigned)__builtin_amdgcn_readlane((int)key, i); rank += (ki > key) ? 1 : 0; } }
            const u64 mk = __ballot(valid && rank < 16);
            if (j == 0) { selm[tk] = mk; p.sel[((size_t)b * S + 64 * jq + tk) * 2 + g] = mk; } }
    }
    NSA_LWAIT(); __builtin_amdgcn_s_barrier();
    const u64 mysel = selm[tokl];
    u64 uni = selm[c.lane];
#pragma unroll
    for (int x = 1; x < 64; x <<= 1) { const unsigned lo_ = __shfl_xor((unsigned)uni, x), hi_ = __shfl_xor((unsigned)(uni >> 32), x); uni |= (u64)lo_ | ((u64)hi_ << 32); }
    const unsigned ulo = __builtin_amdgcn_readfirstlane((unsigned)uni), uhi = __builtin_amdgcn_readfirstlane((unsigned)(uni >> 32));
    {
        c.kt = p.kv6 + 2 * seg + ho; c.vt = p.kv6 + 3 * seg + ho;
        u64 rem = (u64)ulo | ((u64)uhi << 32);
        m = M0; l = 0.f; o[0] = f32x16{}; o[1] = f32x16{};
        int j = __builtin_ctzll(rem); rem &= rem - 1;
        int j1 = rem ? __builtin_ctzll(rem) : -1; if (rem) rem &= rem - 1;
        ring_begin<ABL>(c, j, j1);
        for (;;) {
            const int j2 = rem ? __builtin_ctzll(rem) : -1; if (rem) rem &= rem - 1;
            ring_step<ABL>(c, j2, j);
            if (!(ABL & 4)) qkt(p0, p1, (lcptr)(c.shm + L_K + c.rs * SLOT), qr, c.r32, c.hi); else { asm volatile("" : "+v"(p0), "+v"(p1)); }
            const bool on = (mysel >> j) & 1ull;
            if (j == jq) {
#pragma unroll
                for (int r = 0; r < 16; ++r) { const int kr = crow(r, c.hi); p0[r] = (kr <= tokl) ? p0[r] : NEGM; p1[r] = (kr + 32 <= tokl) ? p1[r] : NEGM; } }
            softmax_pv<ABL>(c, p0, p1, o, m, l, c.rs, on); ring_next(c);
            if (j1 < 0) break; j = j1; j1 = j2;
        }
        l = xhalf_sum(l);
        accum_branch(c, oacc, o, g1 / l);
    }
    {
        c.kt = p.kv6 + 4 * seg + ho; c.vt = p.kv6 + 5 * seg + ho;
        const int j0 = jq >= 8 ? jq - 8 : 0;
        m = M0; l = 0.f; o[0] = f32x16{}; o[1] = f32x16{};
        ring_begin<ABL>(c, j0, j0 + 1 <= jq ? j0 + 1 : -1);
        for (int j = j0; j <= jq; ++j) {
            ring_step<ABL>(c, j + 2 <= jq ? j + 2 : -1, j);
            if (!(ABL & 4)) qkt(p0, p1, (lcptr)(c.shm + L_K + c.rs * SLOT), qr, c.r32, c.hi); else { asm volatile("" : "+v"(p0), "+v"(p1)); }
            const bool lowt = (jq >= 8 && j == jq - 8), diag = (j == jq);
            if (diag || lowt) {
#pragma unroll
                for (int r = 0; r < 16; ++r) { const int kr = crow(r, c.hi);
                    const bool v0 = diag ? (kr <= tokl) : (kr > tokl), v1 = diag ? (kr + 32 <= tokl) : (kr + 32 > tokl);
                    p0[r] = v0 ? p0[r] : NEGM; p1[r] = v1 ? p1[r] : NEGM; } }
            softmax_pv<ABL>(c, p0, p1, o, m, l, c.rs, true); ring_next(c);
        }
        l = xhalf_sum(l);
        accum_branch(c, oacc, o, g2 / l);
    }
    {
        __attribute__((address_space(3))) bf16* stg = (__attribute__((address_space(3))) bf16*)(c.shm + L_OST + c.w * 4096);
#pragma unroll
        for (int r = 0; r < 16; ++r) { const int orow = crow(r, c.hi);
#pragma unroll
            for (int d0 = 0; d0 < 2; ++d0) stg[orow * 64 + d0 * 32 + c.r32] = f2bf(oacc[d0][r]); }
        NSA_LWAIT();
#pragma unroll
        for (int i = 0; i < 4; ++i) { const int row = i * 8 + (c.lane >> 3), ch = c.lane & 7; const u32x4 v = *(const __attribute__((address_space(3))) u32x4*)(stg + row * 64 + ch * 8);
            const int rh = row >> 3, rt = 8 * c.w + (row & 7);
            *(u32x4*)(p.onsa + ((size_t)b * S + 64 * jq + rt) * 512 + (g * 4 + rh) * 64 + ch * 8) = v; }
    }
    NSA_DRAIN_BAR();
}
}
template <int ABL = 0> __device__ __forceinline__ void phase_nsa(const P& p, char* smem) {
    const int nunits = p.nb * 2 * 64;
    const int G = gridDim.x; int r = 0;
    for (int base = 0; base < nunits; base += G, ++r) {
        const int w = (r & 1) ? G - 1 - (int)blockIdx.x : (int)blockIdx.x, i = base + w; if (i >= nunits) continue;
        const int jq = 63 - i / (p.nb * 2), bg = i % (p.nb * 2); nsa::nsa_unit<ABL>(p, smem, bg >> 1, bg & 1, jq); }
}

namespace gla {
using nsa::f32x16; using nsa::bf16x8; using nsa::s16x4; using nsa::u32x4; using nsa::lptr; using nsa::lcptr; using nsa::crow; using nsa::cvtpk;
typedef unsigned u32x2 __attribute__((ext_vector_type(2)));
constexpr int L_KI = 0, L_QI = 8192, L_VI = 16384, L_SI = 32768, L_OST = 49152, L_TOT = L_OST + 64 * 132 * 4, L_END = L_TOT + 8 * 64 * 4 + 64 * 4;
__device__ __forceinline__ int koff(int row, int d) { return (d >> 3) * 1024 + row * 16 + (d & 7) * 2; }
__device__ __forceinline__ int voff(int row, int col) { return ((col >> 5) * 4 + (row >> 4)) * 1024 + (row & 15) * 64 + (col & 31) * 2; }
__device__ __forceinline__ bf16x8 trfrag(unsigned img, int ks, int cb, int lane) {
    const int hi = lane >> 5; const unsigned a = img + (cb * 4 + ks) * 1024 + ((lane >> 4) & 1) * 32 + (lane & 3) * 8 + (4 * hi + ((lane & 15) >> 2)) * 64;
    s16x4 lo, hh;
    asm volatile("ds_read_b64_tr_b16 %0,%1" : "=&v"(lo) : "v"(a) : "memory");
    asm volatile("ds_read_b64_tr_b16 %0,%1 offset:512" : "=&v"(hh) : "v"(a) : "memory");
    asm volatile("s_waitcnt lgkmcnt(0)" ::: "memory"); __builtin_amdgcn_sched_barrier(0);
    return (bf16x8){lo[0], lo[1], lo[2], lo[3], hh[0], hh[1], hh[2], hh[3]};
}
template <int GM> __device__ __forceinline__ void chunk_images(const P& p, lptr shm, int b, int h, int c, int tid) {
    const int d = tid & 63, tg = tid >> 6; const size_t t0 = (size_t)b * S + c * 64;
    __attribute__((address_space(3))) float* tot = (__attribute__((address_space(3))) float*)(shm + L_TOT);
    bf16 kraw[8], qraw[8];
#pragma unroll
    for (int i = 0; i < 8; ++i) { kraw[i] = p.gk[(t0 + tg * 8 + i) * 256 + h * 64 + d]; qraw[i] = GM ? p.gq[(t0 + tg * 8 + i) * 256 + h * 64 + d] : (bf16)0; }
    float wa[16];
#pragma unroll
    for (int r = 0; r < 16; ++r) wa[r] = p.w_a2[r * 256 + h * 64 + d];
    const float ba = p.b_a[h * 64 + d];
    __attribute__((address_space(3))) float* als = (__attribute__((address_space(3))) float*)(shm + L_OST);
    { const f32x4_t a4 = tid < 256 ? *(const f32x4_t*)(p.alow + t0 * 16 + tid * 4) : (f32x4_t){0.f, 0.f, 0.f, 0.f}; if (tid < 256) *(__attribute__((address_space(3))) f32x4_t*)(als + tid * 4) = a4; }
    __syncthreads();
    float loc[8]; float run = 0.f;
#pragma unroll
    for (int i = 0; i < 8; ++i) { const __attribute__((address_space(3))) float* al = als + (tg * 8 + i) * 16; float z = ba;
#pragma unroll
        for (int r = 0; r < 16; ++r) z += al[r] * wa[r];
        const float ls = fminf(z, 0.f) - log1pf(__expf(-fabsf(z))); run += ls * (1.f / 16.f); loc[i] = run; }
    tot[tg * 64 + d] = run;
#pragma unroll
    for (int k = 0; k < 2; ++k) { const int idx = tid + k * 512, s = idx >> 4, e = (idx & 15) * 8; *(__attribute__((address_space(3))) u32x4*)(shm + L_VI + voff(s, e)) = *(const u32x4*)(p.gv + (t0 + s) * 512 + h * 128 + e); }
    __syncthreads();
    float pre = 0.f, all = 0.f;
#pragma unroll
    for (int g = 0; g < 8; ++g) { const float x = tot[g * 64 + d]; all += x; pre += g < tg ? x : 0.f; }
#pragma unroll
    for (int i = 0; i < 8; ++i) { const int t = tg * 8 + i; const float bb = pre + loc[i]; const float kk = bf2f(kraw[i]);
        if (GM == 0) { *(__attribute__((address_space(3))) bf16*)(shm + L_KI + voff(t, d)) = f2bf(kk * __expf(all - bb)); }
        else { const float qq = bf2f(qraw[i]);
            *(__attribute__((address_space(3))) bf16*)(shm + L_KI + koff(t, d)) = f2bf(kk * __expf(-bb)); *(__attribute__((address_space(3))) bf16*)(shm + L_QI + koff(t, d)) = f2bf(qq * __expf(bb)); } }
    if (GM == 0 && tg == 0) p.gdec[((size_t)(b * 4 + h) * 64 + c) * 64 + d] = __expf(all);
    __syncthreads();
}
__device__ __forceinline__ void g1_chunk(const P& p, char* smem, int b, int h, int c) {
    const int tid = TIDX(), lane = tid & 63, w = __builtin_amdgcn_readfirstlane(tid >> 6), r32 = lane & 31, hi = lane >> 5;
    lptr shm = (lptr)smem; const unsigned l0 = (unsigned)(size_t)shm;
    chunk_images<0>(p, shm, b, h, c, tid);
    const int db = w & 1, eb = w >> 1; f32x16 acc = f32x16{};
#pragma unroll
    for (int ks = 0; ks < 4; ++ks) { const bf16x8 a = trfrag(l0 + L_KI, ks, db, lane), bq = trfrag(l0 + L_VI, ks, eb, lane); acc = __builtin_amdgcn_mfma_f32_32x32x16_bf16(a, bq, acc, 0, 0, 0); }
    float* U = p.gst + ((size_t)(b * 4 + h) * 64 + c) * (64 * 128);
#pragma unroll
    for (int r = 0; r < 16; ++r) U[(32 * db + crow(r, hi)) * 128 + 32 * eb + r32] = acc[r];
    __syncthreads();
}
__device__ __forceinline__ void g3_chunk(const P& p, char* smem, int b, int h, int c) {
    const int tid = TIDX(), lane = tid & 63, w = __builtin_amdgcn_readfirstlane(tid >> 6), r32 = lane & 31, hi = lane >> 5;
    lptr shm = (lptr)smem; const unsigned l0 = (unsigned)(size_t)shm; const size_t t0 = (size_t)b * S + c * 64;
    const float* St = p.gst + ((size_t)(b * 4 + h) * 64 + c) * (64 * 128);
    float4 sv[4];
#pragma unroll
    for (int k = 0; k < 4; ++k) sv[k] = *(const float4*)(St + (size_t)(tid + k * 512) * 4);
    const size_t go_ = (t0 + (tid >> 3)) * 512 + h * 128 + (tid & 7) * 16;
    const uint4 rs0 = *(const uint4*)(p.rs + go_), rs1 = *(const uint4*)(p.rs + go_ + 8);
    chunk_images<1>(p, shm, b, h, c, tid);
#pragma unroll
    for (int k = 0; k < 4; ++k) { const int idx = (tid + k * 512) * 4, dd = idx >> 7, e = idx & 127; u32x2 o; o.x = cvtpk(sv[k].x, sv[k].y); o.y = cvtpk(sv[k].z, sv[k].w);
        *(__attribute__((address_space(3))) u32x2*)(shm + L_SI + voff(dd, e)) = o; }
    __syncthreads();
    const int tb = w & 1, eb = w >> 1, trow = 32 * tb + r32;
    f32x16 p0 = f32x16{}, p1 = f32x16{}, o = f32x16{};
    {
        lcptr kb = (lcptr)(shm + L_KI) + hi * 1024 + r32 * 16; lcptr qb = (lcptr)(shm + L_QI) + hi * 1024 + trow * 16;
#pragma unroll
        for (int d0 = 0; d0 < 4; ++d0) {
            const bf16x8 b0 = *(const __attribute__((address_space(3))) bf16x8*)(kb + d0 * 2048), b1 = *(const __attribute__((address_space(3))) bf16x8*)(kb + d0 * 2048 + 512);
            const bf16x8 qf = *(const __attribute__((address_space(3))) bf16x8*)(qb + d0 * 2048);
            p0 = __builtin_amdgcn_mfma_f32_32x32x16_bf16(b0, qf, p0, 0, 0, 0); p1 = __builtin_amdgcn_mfma_f32_32x32x16_bf16(b1, qf, p1, 0, 0, 0); }
    }
#pragma unroll
    for (int r = 0; r < 16; ++r) { const int s = crow(r, hi); p0[r] = s <= trow ? p0[r] : 0.f; p1[r] = s + 32 <= trow ? p1[r] : 0.f; }
#pragma unroll
    for (int ds = 0; ds < 4; ++ds) {
        const u32x2 a0 = *(const __attribute__((address_space(3))) u32x2*)(shm + L_QI + (2 * ds) * 1024 + trow * 16 + 8 * hi), a1 = *(const __attribute__((address_space(3))) u32x2*)(shm + L_QI + (2 * ds + 1) * 1024 + trow * 16 + 8 * hi);
        const u32x4 aw = {a0.x, a0.y, a1.x, a1.y};
        const bf16x8 bq = trfrag(l0 + L_SI, ds, eb, lane);
        o = __builtin_amdgcn_mfma_f32_32x32x16_bf16(__builtin_bit_cast(bf16x8, aw), bq, o, 0, 0, 0); }
    {
        const u32x4 w0 = {cvtpk(p0[0], p0[1]), cvtpk(p0[2], p0[3]), cvtpk(p0[4], p0[5]), cvtpk(p0[6], p0[7])}, w1 = {cvtpk(p0[8], p0[9]), cvtpk(p0[10], p0[11]), cvtpk(p0[12], p0[13]), cvtpk(p0[14], p0[15])};
        const u32x4 w2 = {cvtpk(p1[0], p1[1]), cvtpk(p1[2], p1[3]), cvtpk(p1[4], p1[5]), cvtpk(p1[6], p1[7])}, w3 = {cvtpk(p1[8], p1[9]), cvtpk(p1[10], p1[11]), cvtpk(p1[12], p1[13]), cvtpk(p1[14], p1[15])};
        o = __builtin_amdgcn_mfma_f32_32x32x16_bf16(__builtin_bit_cast(bf16x8, w0), trfrag(l0 + L_VI, 0, eb, lane), o, 0, 0, 0);
        o = __builtin_amdgcn_mfma_f32_32x32x16_bf16(__builtin_bit_cast(bf16x8, w1), trfrag(l0 + L_VI, 1, eb, lane), o, 0, 0, 0);
        o = __builtin_amdgcn_mfma_f32_32x32x16_bf16(__builtin_bit_cast(bf16x8, w2), trfrag(l0 + L_VI, 2, eb, lane), o, 0, 0, 0);
        o = __builtin_amdgcn_mfma_f32_32x32x16_bf16(__builtin_bit_cast(bf16x8, w3), trfrag(l0 + L_VI, 3, eb, lane), o, 0, 0, 0);
    }
    __attribute__((address_space(3))) float* ost = (__attribute__((address_space(3))) float*)(shm + L_OST);
#pragma unroll
    for (int r = 0; r < 16; ++r) ost[(32 * tb + crow(r, hi)) * 132 + 32 * eb + r32] = o[r];
    __syncthreads();
    { const int t = tid >> 3, part = tid & 7; float v[16]; float ss = 0.f;
#pragma unroll
        for (int k = 0; k < 4; ++k) { const f32x4_t x = *(const __attribute__((address_space(3))) f32x4_t*)(ost + t * 132 + part * 16 + k * 4); v[4 * k] = x[0]; v[4 * k + 1] = x[1]; v[4 * k + 2] = x[2]; v[4 * k + 3] = x[3]; ss += x[0] * x[0] + x[1] * x[1] + x[2] * x[2] + x[3] * x[3]; }
        ss += __shfl_xor(ss, 1); ss += __shfl_xor(ss, 2); ss += __shfl_xor(ss, 4);
        const float rstd = rsqrtf(ss * (1.f / 128.f) + 1e-6f);
        const size_t go = (t0 + t) * 512 + h * 128 + part * 16;
        const uint4 r0 = rs0, r1 = rs1; const unsigned rw[8] = {r0.x, r0.y, r0.z, r0.w, r1.x, r1.y, r1.z, r1.w};
        unsigned ow[8];
#pragma unroll
        for (int k = 0; k < 8; ++k) { const float ga = p.norm_g[h * 128 + part * 16 + 2 * k], gb = p.norm_g[h * 128 + part * 16 + 2 * k + 1];
            ow[k] = pk2(v[2 * k] * rstd * ga * __uint_as_float(rw[k] << 16), v[2 * k + 1] * rstd * gb * __uint_as_float(rw[k] & 0xffff0000u)); }
        *(uint4*)(p.gla + go) = make_uint4(ow[0], ow[1], ow[2], ow[3]); *(uint4*)(p.gla + go + 8) = make_uint4(ow[4], ow[5], ow[6], ow[7]); }
    __syncthreads();
}
}
__device__ __forceinline__ void phase_gla1(const P& p, char* smem) {
    const int n = p.nb * 4 * 64;
    for (int i = blockIdx.x; i < n; i += gridDim.x) gla::g1_chunk(p, smem, i >> 8, (i >> 6) & 3, i & 63);
}
__device__ __forceinline__ void phase_gla2(const P& p) {
    const int n = p.nb * 4 * 8192;
    for (int idx = blockIdx.x * NT + TIDX(); idx < n; idx += gridDim.x * NT) {
        const int bh = idx >> 13, de = idx & 8191, d = de >> 7; float* U = p.gst + (size_t)bh * 64 * 8192 + de; const float* gd = p.gdec + (size_t)bh * 64 * 64 + d;
        float s = 0.f;
        for (int c0 = 0; c0 < 64; c0 += 8) { float tmp[8], g[8];
#pragma unroll
            for (int k = 0; k < 8; ++k) { tmp[k] = U[(size_t)(c0 + k) * 8192]; g[k] = gd[(c0 + k) * 64]; }
#pragma unroll
            for (int k = 0; k < 8; ++k) { U[(size_t)(c0 + k) * 8192] = s; s = g[k] * s + tmp[k]; } }
    }
}
__device__ __forceinline__ void phase_gla3(const P& p, char* smem) {
    const int n = p.nb * 4 * 64;
    for (int i = blockIdx.x; i < n; i += gridDim.x) gla::g3_chunk(p, smem, i >> 8, (i >> 6) & 3, i & 63);
}

struct CmpSched {
    const char* kc; const char* Wc1; float* Pc; int nM, G, c; size_t aseg, pseg;
    __device__ __forceinline__ bool next(int i, pg8::Unit& u) const {
        const int L = i * G + c, per = nM * 2 * 2; if (L >= 2 * per) return false;
        const int kv = L / per, r = L % per, ks = r & 1, pn = (r >> 1) & 1, pm = r >> 2;
        u.pm = pm; u.pn = pn; u.tag = kv * 2 + ks;
        u.A = kc + (size_t)kv * aseg + (size_t)pm * 256 * 1024 * 2 + ks * 512 * 2; u.B = Wc1 + ((size_t)kv * 512 + pn * 256) * 1024 * 2 + ks * 512 * 2; return true;
    }
    __device__ __forceinline__ unsigned arow(const pg8::Unit&, int r) const { return (unsigned)r * 2048u; }
    __device__ __forceinline__ void a_ready(const pg8::Unit&) const {}
    __device__ __forceinline__ void done(const pg8::Unit&) const {}
};
struct EpiCmp {
    static constexpr bool PERM = false;
    float* Pc; size_t pseg;
    __device__ __forceinline__ void operator()(const pg8::f32x4 (&acc)[2][2][4][2], const pg8::Unit& u, int wr, int wc, int fr, int fq) const {
        float* base = Pc + (size_t)u.tag * pseg; const int col0 = u.pn * 256 + wc * 32 + 4 * fq;
#pragma unroll
        for (int ai = 0; ai < 2; ++ai)
#pragma unroll
            for (int m = 0; m < 4; ++m) { float* rowp = base + (size_t)(u.pm * 256 + ai * 128 + wr * 64 + m * 16 + fr) * 512 + col0;
#pragma unroll
                for (int bj = 0; bj < 2; ++bj)
#pragma unroll
                    for (int n = 0; n < 2; ++n) *(pg8::f32x4*)(rowp + bj * 128 + n * 16) = acc[ai][bj][m][n]; }
    }
};
__device__ __forceinline__ void finish_b1p(const P& p);
__device__ __forceinline__ void phase_cmp1(const P& p, char* smem) {
    if (blockIdx.x == gridDim.x - 1) finish_b1p(p);
    const int nrows = p.nb * 2 * 256;
    CmpSched Sc{(const char*)p.kv6, (const char*)p.Wc1, p.pcmp, nrows / 256, (int)gridDim.x, (int)blockIdx.x, kvseg(p) * 2, (size_t)(nrows + 8) * 512};
    EpiCmp E{p.pcmp, (size_t)(nrows + 8) * 512};
    pg8::gemm_phase<EpiCmp, CmpSched, true, false>((PG8_LAS unsigned char*)smem, 512, 1024, 1024, Sc, E);
}
__device__ __forceinline__ void body_cmp2f(const P& p, int vb, char* smem) {
    const int tid = TIDX(); const int nrows = p.nb * 2 * 256, nvb1 = nrows / 16; const int kv = vb / nvb1, row0 = (vb % nvb1) * 16;
    const size_t pseg = (size_t)(nrows + 8) * 512; const float* P0 = p.pcmp + (size_t)(kv * 2) * pseg; const float* P1 = P0 + pseg;
    float* hs = (float*)smem;
    float* w2s = (float*)smem + 16 * 256;
    __syncthreads();
    { const float4* wsrc = (const float4*)(kv ? p.cw2_v : p.cw2_k);
#pragma unroll
      for (int k = 0; k < 8; ++k) ((float4*)w2s)[tid + k * 512] = wsrc[tid + k * 512]; }
#pragma unroll
    for (int k = 0; k < 8; ++k) { const int idx = tid + k * 512, rr = idx >> 8, n = idx & 255; const size_t m = (size_t)(row0 + rr);
        const float z = P0[m * 512 + n] + P1[m * 512 + n] + P0[(m + 1) * 512 + 256 + n] + P1[(m + 1) * 512 + 256 + n] + p.b1p[kv * 256 + n];
        hs[idx] = geluf_(z); }
    __syncthreads();
    const int rr = tid >> 5, i = tid & 31, row = row0 + rr;
    const float* h = hs + rr * 256; const float* b2 = kv ? p.cb2_v : p.cb2_k;
    float z1 = b2[i], z2 = b2[i + 32];
#pragma unroll 8
    for (int n = 0; n < 256; ++n) { const float hv = h[n]; z1 += hv * w2s[n * 64 + i]; z2 += hv * w2s[n * 64 + i + 32]; }
    bf16* dst = (kv ? p.vcmp : p.kcmp) + (size_t)row * 64;
    if (kv == 0) {
        const int bg = row >> 8, m = row & 255, b = bg >> 1; int sp = 16 * m + 31; if (sp > S - 1) sp = S - 1;
        const size_t t = (size_t)b * S + sp; const float c = p.cs[t * 64 + i], sn = p.cs[t * 64 + 32 + i];
        const float r1 = z1 * c - z2 * sn, r2 = z2 * c + z1 * sn; z1 = r1; z2 = r2;
    }
    dst[i] = f2bf(z1); dst[i + 32] = f2bf(z2);
}
__device__ __forceinline__ void phase_cmp2(const P& p, char* smem) {
    const int n = 2 * (p.nb * 2 * 256) / 16;
    for (int vb = blockIdx.x; vb < n; vb += gridDim.x) body_cmp2f(p, vb, smem);
}
__device__ __forceinline__ void prep_b1p(const P& p, char* smem) {
    if (blockIdx.x >= 64) return;
    const int tid = TIDX(), kv = blockIdx.x >> 5, part = blockIdx.x & 31, n = tid & 255, fh = tid >> 8;
    const float* pe = kv ? p.cpos_v : p.cpos_k; const float* w1 = kv ? p.cw1_v : p.cw1_k;
    const int f0 = part * 64 + fh * 32; float a = 0.f;
#pragma unroll
    for (int i = 0; i < 32; ++i) a += pe[f0 + i] * w1[(size_t)(f0 + i) * 256 + n];
    float* sc = (float*)(smem + LDS_MISC);
    __syncthreads();
    if (fh == 1) sc[n] = a;
    __syncthreads();
    if (fh == 0) p.b1p[512 + (kv * 32 + part) * 256 + n] = a + sc[n];
    __syncthreads();
}
__device__ __forceinline__ void finish_b1p(const P& p) {
    const int tid = TIDX(), kv = tid >> 8, n = tid & 255; float a = (kv ? p.cb1_v : p.cb1_k)[n];
    for (int part = 0; part < 32; ++part) a += p.b1p[512 + (kv * 32 + part) * 256 + n];
    p.b1p[kv * 256 + n] = a;
}
#define XB_TMO      128
#define XB_XCNT(j)  (256  + 64 * (j))
#define XB_XSUB(j)  (1280 + 64 * (j))
#define XB_XGEN(j)  (2304 + 64 * (j))
#define XB_TOP      3328
#define XB_TOPGEN   3392
#define XCD_BAR_WORDS 3456
#define XB_SPIN_CAP (1u << 18)
#define XLAS __attribute__((address_space(3)))
__device__ __forceinline__ unsigned xb_ld(unsigned* p)              { return __hip_atomic_load(p, __ATOMIC_RELAXED, __HIP_MEMORY_SCOPE_AGENT); }
__device__ __forceinline__ unsigned xb_add(unsigned* p, unsigned v) { return __hip_atomic_fetch_add(p, v, __ATOMIC_RELAXED, __HIP_MEMORY_SCOPE_AGENT); }
__device__ __forceinline__ unsigned xb_xcc_id() { return (unsigned)__builtin_amdgcn_s_getreg((3 << 11) | 20) & 0xFu; }
#define XB_SPIN(cond, bar) do { unsigned _sp = 0; while (cond) { __builtin_amdgcn_s_sleep(1); \
    if ((++_sp & 255u) == 0u) { if (xb_ld(&(bar)[XB_TMO])) break; if (_sp > XB_SPIN_CAP) { atomicAdd(&(bar)[XB_TMO], 1u); break; } } } } while (0)
struct XcdBarrier { unsigned* bar; unsigned x; volatile XLAS unsigned* st; };
__device__ __forceinline__ XcdBarrier xcd_barrier_post(unsigned* bar, volatile XLAS unsigned* st) {
    XcdBarrier b; b.bar = bar; b.x = xb_xcc_id(); b.st = st;
    if (TIDX() == 0) (void)xb_add(&bar[XB_XCNT(b.x)], 1u);
    return b;
}
__device__ __forceinline__ void xcd_barrier_complete(unsigned* bar, unsigned x, unsigned& nloc, unsigned& nx) {
    const unsigned G = gridDim.x * gridDim.y * gridDim.z;
    unsigned sum, cnt, mine, sp = 0u;
    for (;;) {
        sum = 0u; cnt = 0u; mine = 0u;
#pragma unroll
        for (unsigned j = 0; j < 16; ++j) { const unsigned c = xb_ld(&bar[XB_XCNT(j)]); sum += c; cnt += (c > 0u) ? 1u : 0u; mine = (j == x) ? c : mine; }
        if (sum == G) break;
        __builtin_amdgcn_s_sleep(1);
        if ((++sp & 255u) == 0u) { if (xb_ld(&bar[XB_TMO])) break; if (sp > XB_SPIN_CAP) { atomicAdd(&bar[XB_TMO], 1u); break; } }
    }
    nloc = mine > 0u ? mine : 1u; nx = cnt > 0u ? cnt : 1u;
}
__device__ __forceinline__ void xcd_barrier(const XcdBarrier& b) {
    asm volatile("s_waitcnt vmcnt(0)" ::: "memory");
    __syncthreads();
    if (TIDX() == 0) {
        unsigned* bar = b.bar;
        __builtin_amdgcn_s_waitcnt(0);
        unsigned nloc = b.st[0], nx = b.st[1];
        if (nloc == 0u) { xcd_barrier_complete(bar, b.x, nloc, nx); b.st[0] = nloc; b.st[1] = nx; }
        const unsigned old = xb_add(&bar[XB_XSUB(b.x)], 1u);
        const unsigned gen = old / nloc;
        if (old + 1u == (gen + 1u) * nloc) {
            __builtin_amdgcn_fence(__ATOMIC_RELEASE, "agent");
            asm volatile("s_waitcnt vmcnt(0)" ::: "memory");
            const unsigned og = xb_add(&bar[XB_TOP], 1u);
            const unsigned tg = og / nx;
            if (og + 1u == (tg + 1u) * nx) xb_add(&bar[XB_TOPGEN], 1u);
            else XB_SPIN(xb_ld(&bar[XB_TOPGEN]) == tg, bar);
            __builtin_amdgcn_fence(__ATOMIC_ACQUIRE, "agent");
            xb_add(&bar[XB_XGEN(b.x)], 1u);
            asm volatile("s_waitcnt vmcnt(0)" ::: "memory");
        } else {
            XB_SPIN(xb_ld(&bar[XB_XGEN(b.x)]) == gen, bar);
            __builtin_amdgcn_fence(__ATOMIC_ACQUIRE, "agent");
            asm volatile("s_waitcnt vmcnt(0)" ::: "memory");
        }
    }
    __syncthreads();
}

template <int ST> __device__ __forceinline__ void run_stage(const P& p, char* smem, int first, int stride) {
    const int nvb = stage_nvb(ST, p.T);
    for (int vb = first; vb < nvb; vb += stride) {
        if constexpr (ST == ST_RMS) body_rms(p, vb);
        else if constexpr (ST == ST_CS) body_cs(p, vb);
        else if constexpr (ST == ST_INPROJ) body_inproj(p, vb, smem);
        else if constexpr (ST == ST_CMP1) body_cmp1(p, vb, smem);
        else if constexpr (ST == ST_CMP2) body_cmp2(p, vb);
        else if constexpr (ST == ST_NSACMP) body_nsacmp(p, vb, smem);
        else if constexpr (ST == ST_NSAATT) body_nsaatt(p, vb);
        else if constexpr (ST == ST_GLAA) body_glaa(p, vb);
        else if constexpr (ST == ST_GLASCAN) body_glascan(p, vb, smem);
        else if constexpr (ST == ST_GLANORM) body_glanorm(p, vb);
        else if constexpr (ST == ST_PROJ) body_proj(p, vb, smem);
        else if constexpr (ST == ST_OUT) body_out(p, vb, smem);
        else if constexpr (ST == ST_ROUTE) body_route(p, vb, smem);
        else if constexpr (ST == ST_MOE1) body_moe1(p, vb, smem);
        else if constexpr (ST == ST_MOE2) body_moe2(p, vb, smem);
        else if constexpr (ST == ST_FINAL) body_final(p, vb, smem);
    }
}
template <int ST> __global__ void __launch_bounds__(NT) k_stage(P p) {
    extern __shared__ __attribute__((aligned(16))) char smem[];
    run_stage<ST>(p, smem, blockIdx.x, gridDim.x);
}
__global__ void __launch_bounds__(NT) k_mega(P p) {
    extern __shared__ __attribute__((aligned(16))) char smem[];
    cg::grid_group grid = cg::this_grid();
    const int b0 = blockIdx.x, G = gridDim.x;
    volatile XLAS unsigned* xst = (volatile XLAS unsigned*)((XLAS char*)smem + LDS_MISC + 3072);
    if (TIDX() < 4) xst[TIDX()] = 0u;
    __syncthreads();
    volatile unsigned long long* tsv = (volatile unsigned long long*)(p.ctl + 12288); int nts = 1;
    if (TSEL >= 0 && b0 == 0 && TIDX() == 0) tsv[0] = __builtin_amdgcn_s_memrealtime();
    const XcdBarrier xb = xcd_barrier_post(p.ctl + 4096, xst);
#define GSYNC() do { xcd_barrier(xb); if (TSEL >= 0 && b0 == 0 && TIDX() == 0) { tsv[nts] = __builtin_amdgcn_s_memrealtime(); } ++nts; } while (0)
#define DUPRUN(k, stmt) do { if (DUP == (k)) { stmt; GSYNC(); } } while (0)
    if (p.T < 0) grid.sync();
    phase_prep(p, smem); GSYNC();
    phase_inA(p, smem); GSYNC();                               DUPRUN(7, phase_inA(p, smem));
    phase_cmp1(p, smem); phase_gla1(p, smem); GSYNC();         DUPRUN(8, phase_cmp1(p, smem)); DUPRUN(4, phase_gla1(p, smem));
    phase_cmp2(p, smem); phase_gla2(p); GSYNC();               DUPRUN(9, phase_cmp2(p, smem));
    if (DUP >= 20 && DUP < 148) { P p2 = p; p2.onsa = (bf16*)p.pcmp; p2.sel = (u64*)((char*)p.pcmp + 16 * MiB_); phase_nsa<(DUP >= 20 && DUP < 148) ? DUP - 20 : 0>(p2, smem); GSYNC(); }
    phase_nsa(p, smem); phase_gla3(p, smem); GSYNC();          DUPRUN(1, phase_nsa(p, smem)); DUPRUN(2, phase_gla3(p, smem));
    phase_inB(p, smem); GSYNC();                               DUPRUN(11, phase_inB(p, smem));
    phase_proj(p, smem); GSYNC();                              DUPRUN(12, phase_proj(p, smem));
    phase_out(p, smem); GSYNC();                               DUPRUN(13, phase_out(p, smem));
    if (DUP == 17) { P p2 = p; p2.ctl = p.ctl + 8192; p2.vb = p.sa; p2.list = (int*)p.mixed; p2.tokslot = (int*)p.mixed + (1 << 20); p2.tokexp = (int*)p.mixed + (2 << 20); p2.tokw = (float*)p.mixed + (3 << 20);
        for (int vb = b0; vb < p.T / 64; vb += G) body_route3(p2, vb, smem);
        GSYNC(); }
    for (int vb = b0; vb < p.T / 64; vb += G) body_route3(p, vb, smem);
    GSYNC();
    phase_moe12(p, smem); GSYNC();
    if (DUP == 15) { GSYNC(); GSYNC(); GSYNC(); GSYNC(); GSYNC(); GSYNC(); GSYNC(); GSYNC(); GSYNC(); GSYNC(); }
    for (int vb = b0; vb < p.T / 8; vb += G) body_final_b(p, vb, smem);
    if (TSEL >= 0 && b0 == 0 && TIDX() == 0) { const unsigned long long tend = __builtin_amdgcn_s_memrealtime(); tsv[nts] = tend;
        const unsigned long long d = tsv[TSEL + 1] - tsv[TSEL]; while (__builtin_amdgcn_s_memrealtime() - tend < 4ull * d) __builtin_amdgcn_s_sleep(16); }
#undef DUPRUN
#undef GSYNC
}

enum Phase { PH_PREP = 0, PH_INA, PH_INB, PH_PROJ, PH_OUT, PH_MOE1, PH_MOE2, PH_NSA, PH_GLA1, PH_GLA2, PH_GLA3, PH_CMP1, PH_CMP2 };
template <int PH> __global__ void __launch_bounds__(NT) k_phase(P p) {
    extern __shared__ __attribute__((aligned(16))) char smem[];
    if constexpr (PH == PH_PREP) phase_prep(p, smem);
    else if constexpr (PH == PH_INA) phase_inA(p, smem);
    else if constexpr (PH == PH_INB) phase_inB(p, smem);
    else if constexpr (PH == PH_PROJ) phase_proj(p, smem);
    else if constexpr (PH == PH_OUT) phase_out(p, smem);
    else if constexpr (PH == PH_MOE1) phase_moe12(p, smem);
    else if constexpr (PH == PH_MOE2) { }
    else if constexpr (PH == PH_NSA) phase_nsa(p, smem);
    else if constexpr (PH == PH_GLA1) phase_gla1(p, smem);
    else if constexpr (PH == PH_GLA2) phase_gla2(p);
    else if constexpr (PH == PH_GLA3) phase_gla3(p, smem);
    else if constexpr (PH == PH_CMP1) phase_cmp1(p, smem);
    else if constexpr (PH == PH_CMP2) phase_cmp2(p, smem);
}
template <class TT> __device__ __forceinline__ float ldf(const TT* p, size_t i);
template <> __device__ __forceinline__ float ldf<bf16>(const bf16* p, size_t i) { return bf2f(p[i]); }
template <> __device__ __forceinline__ float ldf<float>(const float* p, size_t i) { return p[i]; }
template <class TT> __global__ void __launch_bounds__(256) k_compare(const TT* a, const TT* b, size_t n, float* err, int slot) {
    float num = 0.f, den = 0.f;
    for (size_t i = (size_t)blockIdx.x * 256 + TIDX(); i < n; i += (size_t)gridDim.x * 256) { const float x = ldf<TT>(a, i), y = ldf<TT>(b, i); const float d = x - y; num += (d == d) ? d * d : 1e30f; den += y * y; }
#pragma unroll
    for (int o = 1; o < 64; o <<= 1) { num += __shfl_xor(num, o); den += __shfl_xor(den, o); }
    if ((TIDX() & 63) == 0) { atomicAdd(err + 2 * slot, num); atomicAdd(err + 2 * slot + 1, den); }
}
__global__ void __launch_bounds__(256) k_compare_sel(const u64* a, const u64* b, size_t n, float* err, int slot) {
    float num = 0.f, den = 0.f;
    for (size_t i = (size_t)blockIdx.x * 256 + threadIdx.x; i < n; i += (size_t)gridDim.x * 256) { num += (a[i] != b[i]) ? 1.f : 0.f; den += 100.f; }
#pragma unroll
    for (int o = 1; o < 64; o <<= 1) { num += __shfl_xor(num, o); den += __shfl_xor(den, o); }
    if ((threadIdx.x & 63) == 0) { atomicAdd(err + 2 * slot, num); atomicAdd(err + 2 * slot + 1, den); }
}
__global__ void __launch_bounds__(256) k_report(float* out, size_t n, const float* err, int nslots, float tol) {
    int code = 0;
    for (int s = 0; s < nslots; ++s) { const float num = err[2 * s], den = err[2 * s + 1]; const bool bad = !(num <= tol * tol * den) || !(den > 0.f); if (bad) { code = s + 1; break; } }
    if (code == 0) return;
    const float f = 1.f + 0.1f * (float)code;
    for (size_t i = (size_t)blockIdx.x * 256 + TIDX(); i < n; i += (size_t)gridDim.x * 256) out[i] *= f;
}

static void set_inputs(P& p, void* const* d_in) {
    const float* const* in = (const float* const*)d_in;
    p.x = in[0]; p.pos = (const int*)d_in[1]; p.g_mix = in[2]; p.w_in = in[3];
    p.cpos_k = in[4]; p.cw1_k = in[5]; p.cb1_k = in[6]; p.cw2_k = in[7]; p.cb2_k = in[8];
    p.cpos_v = in[9]; p.cw1_v = in[10]; p.cb1_v = in[11]; p.cw2_v = in[12]; p.cb2_v = in[13];
    p.w_a2 = in[14]; p.b_a = in[15]; p.norm_g = in[16]; p.w_pn = in[17]; p.w_pg = in[18]; p.w_out = in[19];
    p.g_ffn = in[20]; p.w_grp = in[21]; p.b_grp = in[22]; p.w_exp = in[23]; p.b_exp = in[24]; p.w_gate = in[25]; p.w_up = in[26]; p.w_down = in[27]; p.g_final = in[28];
}
constexpr size_t MiB = 1u << 20;
static void layout_ref(P& p, char* small, char* act, char* scratch, float* out, int nb) {
    const size_t q = (MiB / 4) * nb;
    p.nb = nb; p.T = nb * S; p.out = out;
    p.ctl = (unsigned*)small; p.sel = (u64*)(small + q / 16 * 1); p.kcmp = (bf16*)(small + q / 2); p.vcmp = (bf16*)(small + q / 4 * 3);
    p.tokslot = (int*)(small + q); p.tokexp = (int*)(small + q + q / 8); p.tokw = (float*)(small + q + q / 4);
    p.alow = (float*)(small + 2 * q); p.gates = (float*)(small + 3 * q); p.cs = (float*)(small + 5 * q); p.hcmp = (float*)(small + 9 * q); p.list = (int*)(small + 13 * q);
    p.u = (bf16*)act; p.ocmp = (float*)act; p.mixed = (bf16*)act; p.vb = (bf16*)act;
    p.q = (bf16*)(act + 32 * q); p.kv6 = (bf16*)(act + 48 * q);
    p.gq = (bf16*)(act + 73 * q); p.gk = (bf16*)(act + 81 * q); p.gv = (bf16*)(act + 89 * q); p.rs = (bf16*)(act + 105 * q);
    p.H = (bf16*)(act + 32 * q);
    p.sa = (bf16*)(act + 123 * q); p.sb = (bf16*)(act + 155 * q); p.onsa = (bf16*)(act + 187 * q); p.gla = (bf16*)(act + 203 * q);
    p.Y = (bf16*)(act + 123 * q);
    p.ga = (float*)scratch; p.oraw = (float*)(scratch + 16 * q); p.h1 = (float*)(scratch + 48 * q);
    p.gst = (float*)(scratch + 16 * q); p.gdec = (float*)(small + 15 * q);
}
static void layout_compact(P& p, char* ws, float* out) {
    p.nb = NB; p.T = NB * S; p.out = out;
    char* small = ws; const size_t q = MiB;
    p.ctl = (unsigned*)small; p.sel = (u64*)(small + q / 16 * 1); p.kcmp = (bf16*)(small + q / 2); p.vcmp = (bf16*)(small + q / 4 * 3);
    p.tokslot = (int*)(small + q); p.tokexp = (int*)(small + q + q / 8); p.tokw = (float*)(small + q + q / 4);
    p.alow = (float*)(small + 2 * q); p.gates = (float*)(small + 3 * q); p.cs = (float*)(small + 5 * q); p.hcmp = (float*)(small + 9 * q); p.list = (int*)(small + 13 * q);
    p.u = (bf16*)(ws + 128 * MiB); p.vb = (bf16*)(ws + 128 * MiB);
    p.q = (bf16*)(ws + 160 * MiB); p.kv6 = (bf16*)(ws + 176 * MiB); p.gq = (bf16*)(ws + 201 * MiB); p.gk = (bf16*)(ws + 209 * MiB); p.gv = (bf16*)(ws + 217 * MiB); p.rs = (bf16*)(ws + 233 * MiB);
    p.ga = (float*)(ws + 249 * MiB); p.ocmp = (float*)(ws + 249 * MiB);
    p.sa = (bf16*)(ws + 160 * MiB); p.sb = (bf16*)(ws + 192 * MiB); p.mixed = (bf16*)(ws + 224 * MiB);
    p.H = (bf16*)(ws + 160 * MiB); p.Y = (bf16*)(ws + 48 * MiB);
    p.onsa = (bf16*)out; p.gla = (bf16*)((char*)out + 16 * MiB); p.oraw = (float*)((char*)out + 32 * MiB); p.h1 = out;
    p.gst = (float*)((char*)out + 32 * MiB); p.gdec = (float*)(small + 15 * q); p.pcmp = (float*)(ws + 249 * MiB); p.h1b = (bf16*)(ws + 249 * MiB);
}
static void layout_weights(P& p, char* w) {
    p.wr = (float*)(w - 256 * 1024); p.b1p = (float*)(w - 100 * 1024);
    p.Wd = (bf16*)w; p.Wgu = (bf16*)(w + 32 * MiB); p.Wt_in = (bf16*)(w + 96 * MiB); p.Wc1 = (bf16*)(w + 106 * MiB);
    p.Wpn = (bf16*)(w + 108 * MiB); p.Wpg = (bf16*)(w + 109 * MiB); p.Wo = (bf16*)(w + 110 * MiB);
}

template <int ST> static void launch_stage(const P& p, hipStream_t stream) {
    static bool attr = false;
    if (!attr) { (void)hipFuncSetAttribute((const void*)k_stage<ST>, hipFuncAttributeMaxDynamicSharedMemorySize, LDS_BYTES); attr = true; }
    int nvb = stage_nvb(ST, p.T); if (nvb > 16384) nvb = 16384;
    hipLaunchKernelGGL(k_stage<ST>, dim3(nvb), dim3(NT), LDS_BYTES, stream, p);
}
template <int PH> static void launch_phase(const P& p, hipStream_t stream, int grid = 40) {
    static bool attr = false;
    if (!attr) { (void)hipFuncSetAttribute((const void*)k_phase<PH>, hipFuncAttributeMaxDynamicSharedMemorySize, LDS_BYTES); attr = true; }
    hipLaunchKernelGGL(k_phase<PH>, dim3(grid), dim3(NT), LDS_BYTES, stream, p);
}
template <class TT> static void compare(const TT* a, const TT* b, size_t n, float* err, int slot, hipStream_t stream) {
    hipLaunchKernelGGL(k_compare<TT>, dim3(1024), dim3(256), 0, stream, a, b, n, err, slot);
}
static void launch_mega(const P& p, hipStream_t stream) {
    static int grid = 0;
    if (!grid) {
        int dev = 0, cus = 0, per_cu = 0;
        (void)hipGetDevice(&dev); (void)hipDeviceGetAttribute(&cus, hipDeviceAttributeMultiprocessorCount, dev);
        (void)hipFuncSetAttribute((const void*)k_mega, hipFuncAttributeMaxDynamicSharedMemorySize, LDS_BYTES);
        (void)hipOccupancyMaxActiveBlocksPerMultiprocessor(&per_cu, (const void*)k_mega, NT, LDS_BYTES);
        if (per_cu < 1) per_cu = 1;
        grid = cus * per_cu;
    }
    (void)hipMemsetAsync((void*)p.ctl, 0, 64 * 1024, stream);
    P pp = p; void* args[] = {(void*)&pp};
    (void)hipLaunchCooperativeKernel((const void*)k_mega, dim3(grid), dim3(NT), args, LDS_BYTES, stream);
}

extern "C" void kernel_launch(void* const* d_in, const int* in_sizes, int n_in, void* d_out, int out_size, void* d_ws, size_t ws_size, hipStream_t stream) {
    char* ws = (char*)d_ws;
    P p{}; set_inputs(p, d_in); layout_ref(p, ws, ws + 16 * MiB, (char*)d_out, (float*)d_out, NB); p.h1 = (float*)d_out;
#if MODE == 0
    (void)hipMemsetAsync(d_ws, 0, 4096, stream);
    launch_stage<ST_RMS>(p, stream); launch_stage<ST_CS>(p, stream); launch_stage<ST_INPROJ>(p, stream);
    launch_stage<ST_CMP1>(p, stream); launch_stage<ST_CMP2>(p, stream); launch_stage<ST_NSACMP>(p, stream); launch_stage<ST_NSAATT>(p, stream);
    launch_stage<ST_GLAA>(p, stream); launch_stage<ST_GLASCAN>(p, stream); launch_stage<ST_GLANORM>(p, stream);
    launch_stage<ST_PROJ>(p, stream); launch_stage<ST_OUT>(p, stream); launch_stage<ST_ROUTE>(p, stream);
    launch_stage<ST_MOE1>(p, stream); launch_stage<ST_MOE2>(p, stream); launch_stage<ST_FINAL>(p, stream);
#elif MODE == 1
    { P c{}; set_inputs(c, d_in); layout_weights(c, ws + 16 * MiB); layout_compact(c, ws, (float*)d_out); launch_mega(c, stream); }
#else
    { P c{}; set_inputs(c, d_in); layout_weights(c, ws + 16 * MiB); layout_compact(c, ws, (float*)d_out); launch_mega(c, stream); }
    P r{}; set_inputs(r, d_in); layout_weights(r, ws + 16 * MiB);
    layout_ref(r, ws + 128 * MiB, ws + 132 * MiB, ws + 200 * MiB, (float*)(ws + 200 * MiB + 12 * MiB), 1);
    char* alt = ws + 228 * MiB; float* err = (float*)(ws + 128 * MiB + 8192);
    (void)hipMemsetAsync(ws + 128 * MiB, 0, 16384, stream);
    int slot = 0; const size_t T1 = S; const size_t ROWS1 = 2 * T1 + NEXP * 256;
    launch_stage<ST_RMS>(r, stream); launch_stage<ST_CS>(r, stream); launch_stage<ST_INPROJ>(r, stream);
    P f = r; { char* a = alt;
        f.u = (bf16*)a; a += T1 * 1024 * 2; f.cs = (float*)a; a += T1 * 64 * 4; f.q = (bf16*)a; a += T1 * 512 * 2; f.kv6 = (bf16*)a; a += 6 * (size_t)2 * S * 64 * 2 + 4096;
        f.gates = (float*)a; a += T1 * 24 * 4; f.gq = (bf16*)a; a += T1 * 256 * 2; f.gk = (bf16*)a; a += T1 * 256 * 2; f.gv = (bf16*)a; a += T1 * 512 * 2; f.alow = (float*)a; a += T1 * 16 * 4;
        f.rs = (bf16*)a; a += T1 * 512 * 2; f.sa = (bf16*)a; a += T1 * 1024 * 2; f.sb = (bf16*)a; a += T1 * 1024 * 2; }
    launch_phase<PH_PREP>(f, stream); launch_phase<PH_INA>(f, stream); launch_phase<PH_INB>(f, stream);
    compare<bf16>(f.q, r.q, T1 * 512, err, slot++, stream);
    compare<bf16>(f.kv6, r.kv6, 6 * (size_t)2 * S * 64, err, slot++, stream);
    compare<bf16>(f.sb, r.sb, T1 * 1024, err, slot++, stream);
    launch_stage<ST_CMP1>(r, stream); launch_stage<ST_CMP2>(r, stream);
    f = r; f.pcmp = (float*)alt; f.kcmp = (bf16*)(alt + 20 * MiB); f.vcmp = (bf16*)(alt + 21 * MiB); launch_phase<PH_CMP1>(f, stream); launch_phase<PH_CMP2>(f, stream);
    compare<bf16>(f.kcmp, r.kcmp, (size_t)2 * 255 * 64, err, slot++, stream); compare<bf16>(f.vcmp + 256 * 64, r.vcmp + 256 * 64, (size_t)255 * 64, err, slot++, stream);
    launch_stage<ST_NSACMP>(r, stream); launch_stage<ST_NSAATT>(r, stream);
    f = r; f.onsa = (bf16*)alt; f.sel = (u64*)(alt + 8 * MiB); launch_phase<PH_NSA>(f, stream);
    hipLaunchKernelGGL(k_compare_sel, dim3(64), dim3(256), 0, stream, (const u64*)f.sel, (const u64*)r.sel, T1 * 2, err, slot++);
    compare<bf16>(f.onsa, r.onsa, T1 * 512, err, slot++, stream);
    launch_stage<ST_GLAA>(r, stream); launch_stage<ST_GLASCAN>(r, stream); launch_stage<ST_GLANORM>(r, stream);
    f = r; f.gla = (bf16*)alt; f.gst = (float*)(alt + 8 * MiB); f.gdec = (float*)(alt + 18 * MiB); launch_phase<PH_GLA1>(f, stream); launch_phase<PH_GLA2>(f, stream); launch_phase<PH_GLA3>(f, stream);
    compare<bf16>(f.gla, r.gla, T1 * 512, err, slot++, stream);
    launch_stage<ST_PROJ>(r, stream);
    f = r; f.mixed = (bf16*)alt; launch_phase<PH_PROJ>(f, stream);
    compare<bf16>(f.mixed, r.mixed, T1 * 1024, err, slot++, stream);
    launch_stage<ST_OUT>(r, stream);
    f = r; f.h1b = (bf16*)alt; launch_phase<PH_OUT>(f, stream);
    launch_stage<ST_ROUTE>(r, stream);
    (void)hipMemsetAsync(r.H, 0, ROWS1 * 512 * 2, stream); (void)hipMemsetAsync(alt, 0, ROWS1 * 512 * 2, stream);
    (void)hipMemsetAsync(r.Y, 0, ROWS1 * 1024 * 2, stream); (void)hipMemsetAsync(alt + 17 * MiB, 0, ROWS1 * 1024 * 2, stream);
    launch_stage<ST_MOE1>(r, stream); launch_stage<ST_MOE2>(r, stream);
    f = r; f.H = (bf16*)alt; f.Y = (bf16*)(alt + 17 * MiB); launch_phase<PH_MOE1>(f, stream);
    compare<bf16>(f.H, r.H, ROWS1 * 512, err, slot++, stream);
    compare<bf16>(f.Y, r.Y, ROWS1 * 1024, err, slot++, stream);
    hipLaunchKernelGGL(k_report, dim3(1024), dim3(256), 0, stream, (float*)d_out, (size_t)NB * S * D, (const float*)err, slot, 0.02f);
#endif
}
```

```cpp
#include <hip/hip_runtime.h>
#include <hip/hip_cooperative_groups.h>
#include <stdint.h>
namespace cg = cooperative_groups;

#ifndef DUP
#define DUP 0
#endif
#ifndef TSEL
#define TSEL -1
#endif
#ifndef MODE
#define MODE 1
#endif

typedef unsigned short bf16;
typedef unsigned long long u64;

__device__ __forceinline__ int TIDX() { int t = threadIdx.x; asm volatile("" : "+v"(t)); return t; }
__device__ __forceinline__ float bf2f(bf16 v) { return __uint_as_float(((unsigned)v) << 16); }
__device__ __forceinline__ bf16 f2bf(float f) { unsigned u = __float_as_uint(f); return (bf16)((u + 0x7fffu + ((u >> 16) & 1u)) >> 16); }
__device__ __forceinline__ float sigmoidf_(float x) { return 1.f / (1.f + __expf(-x)); }
__device__ __forceinline__ float siluf_(float x) { return x / (1.f + __expf(-x)); }
__device__ __forceinline__ float geluf_(float x) { const float u = 0.7978845608028654f * (x + 0.044715f * x * x * x); return 0.5f * x * (1.f + tanhf(u)); }

constexpr int NB = 4, S = 4096, D = 1024;
constexpr int NT = 512;
constexpr int LDS_BYTES = 144 * 1024;
constexpr int LDS_MISC = 136 * 1024;
constexpr int INW = 4904;
constexpr int OFF_Q = 0, OFF_KV = 512, OFF_NG = 1280, OFF_GQ = 1304, OFF_GK = 1560, OFF_GV = 1816, OFF_GA = 2328, OFF_GR = 2344, OFF_MA = 2856, OFF_MB = 3880;
constexpr int NEXP = 32;
constexpr size_t MiB_ = 1u << 20;

struct P {
    const float* x; const int* pos; const float* g_mix; const float* w_in;
    const float *cpos_k, *cw1_k, *cb1_k, *cw2_k, *cb2_k, *cpos_v, *cw1_v, *cb1_v, *cw2_v, *cb2_v;
    const float *w_a2, *b_a, *norm_g, *w_pn, *w_pg, *w_out, *g_ffn, *w_grp, *b_grp, *w_exp, *b_exp, *w_gate, *w_up, *w_down, *g_final;
    float* out;
    unsigned* ctl;
    float* cs;
    bf16* u;
    bf16* q;
    bf16* kv6;
    float* gates;
    bf16 *gq, *gk, *gv;
    float* alow;
    bf16 *rs, *sa, *sb;
    float* hcmp;
    bf16 *kcmp, *vcmp;
    u64* sel;
    float* ocmp;
    bf16* onsa;
    float* ga;
    float* oraw;
    bf16* gla;
    bf16* mixed;
    float* h1;
    bf16* h1b;
    bf16* vb;
    int* list;
    int* tokslot;
    int* tokexp;
    float* tokw;
    bf16* H;
    bf16* Y;
    float* gst;
    float* gdec;
    float* gb;
    float* pcmp;
    float* b1p;
    float* wr;
    bf16 *Wt_in, *Wc1, *Wpn, *Wpg, *Wo, *Wgu, *Wd;
    int nb, T;
};
__device__ __forceinline__ size_t kvseg(const P& p) { return (size_t)p.nb * 2 * S * 64; }

enum Stage { ST_RMS = 0, ST_CS, ST_INPROJ, ST_CMP1, ST_CMP2, ST_NSACMP, ST_NSAATT, ST_GLAA, ST_GLASCAN, ST_GLANORM, ST_PROJ, ST_OUT, ST_ROUTE, ST_MOE1, ST_MOE2, ST_FINAL, ST_COUNT };

__host__ __device__ inline int stage_nvb(int st, int T) {
    switch (st) {
        case ST_RMS: return T / 8;
        case ST_CS: return T * 32 / NT;
        case ST_INPROJ: return ((INW + NT - 1) / NT) * (T / 8);
        case ST_CMP1: return 2 * (T / S) * 2 * 256 / 8;
        case ST_CMP2: return 2 * (T / S) * 2 * 256 * 32 / NT;
        case ST_NSACMP: return T / 64 * 2 / 8;
        case ST_NSAATT: return T / 64 * 8 / 8;
        case ST_GLAA: return T / 2;
        case ST_GLASCAN: return (T / S) * 4 / 4;
        case ST_GLANORM: return T * 4 / NT;
        case ST_PROJ: return 2 * (T / 8);
        case ST_OUT: return 2 * (T / 8);
        case ST_ROUTE: return T / 8;
        case ST_MOE1: return (2 * T + NEXP * 256) / 8;
        case ST_MOE2: return 2 * ((2 * T + NEXP * 256) / 8);
        case ST_FINAL: return T / 8;
    }
    return 0;
}

__device__ __forceinline__ void body_rms(const P& p, int vb) {
    const int lane = TIDX() & 63, t = vb * 8 + (TIDX() >> 6);
    const float4* xr = (const float4*)(p.x + (size_t)t * D);
    float4 v[4]; float ss = 0.f;
#pragma unroll
    for (int j = 0; j < 4; ++j) { v[j] = xr[lane + 64 * j]; ss += v[j].x * v[j].x + v[j].y * v[j].y + v[j].z * v[j].z + v[j].w * v[j].w; }
#pragma unroll
    for (int o = 1; o < 64; o <<= 1) ss += __shfl_xor(ss, o);
    const float rstd = rsqrtf(ss * (1.f / D) + 1e-6f);
#pragma unroll
    for (int j = 0; j < 4; ++j) {
        const float4 g = ((const float4*)p.g_mix)[lane + 64 * j];
        ushort4 o; o.x = f2bf(v[j].x * rstd * g.x); o.y = f2bf(v[j].y * rstd * g.y); o.z = f2bf(v[j].z * rstd * g.z); o.w = f2bf(v[j].w * rstd * g.w);
        ((ushort4*)(p.u + (size_t)t * D))[lane + 64 * j] = o;
    }
}
__device__ __forceinline__ void body_rms2(const P& p, int vb) {
    const int lane = TIDX() & 63, t = vb * 16 + (TIDX() >> 6) * 2;
    const float4* xr = (const float4*)(p.x + (size_t)t * D);
    float4 v[8]; float s0 = 0.f, s1 = 0.f;
#pragma unroll
    for (int j = 0; j < 8; ++j) v[j] = xr[lane + 64 * j];
#pragma unroll
    for (int j = 0; j < 4; ++j) { s0 += v[j].x * v[j].x + v[j].y * v[j].y + v[j].z * v[j].z + v[j].w * v[j].w; s1 += v[4 + j].x * v[4 + j].x + v[4 + j].y * v[4 + j].y + v[4 + j].z * v[4 + j].z + v[4 + j].w * v[4 + j].w; }
#pragma unroll
    for (int o = 1; o < 64; o <<= 1) { s0 += __shfl_xor(s0, o); s1 += __shfl_xor(s1, o); }
    const float r0 = rsqrtf(s0 * (1.f / D) + 1e-6f), r1 = rsqrtf(s1 * (1.f / D) + 1e-6f);
#pragma unroll
    for (int j = 0; j < 4; ++j) {
        const float4 g = ((const float4*)p.g_mix)[lane + 64 * j];
        ushort4 o; o.x = f2bf(v[j].x * r0 * g.x); o.y = f2bf(v[j].y * r0 * g.y); o.z = f2bf(v[j].z * r0 * g.z); o.w = f2bf(v[j].w * r0 * g.w);
        ((ushort4*)(p.u + (size_t)t * D))[lane + 64 * j] = o;
        ushort4 q; q.x = f2bf(v[4 + j].x * r1 * g.x); q.y = f2bf(v[4 + j].y * r1 * g.y); q.z = f2bf(v[4 + j].z * r1 * g.z); q.w = f2bf(v[4 + j].w * r1 * g.w);
        ((ushort4*)(p.u + (size_t)(t + 1) * D))[lane + 64 * j] = q;
    }
}
__device__ __forceinline__ void body_cs(const P& p, int vb) {
    const int idx = vb * NT + TIDX(); const int t = idx >> 5, i = idx & 31;
    const float inv = 1.0f / powf(10000.0f, (float)i / 32.0f);
    const float ang = (float)p.pos[t] * inv;
    const double a = (double)ang; const double k = rint(a * 0.15915494309189535); const float r = (float)(a - k * 6.283185307179586);
    p.cs[(size_t)t * 64 + i] = cosf(r); p.cs[(size_t)t * 64 + 32 + i] = sinf(r);
}

template <int K, bool TWO, bool SAMEA, class AF1, class AF2, class Epi>
__device__ __forceinline__ void ngemm(float* lds, int m0, const float* W1, int ldw1, int n1, const float* W2, int ldw2, int n2, AF1 a1, AF2 a2, Epi epi) {
    const int tid = TIDX();
    for (int idx = tid; idx < 8 * K; idx += NT) { const int i = idx / K, k = idx % K; lds[idx] = a1(m0 + i, k); if (TWO && !SAMEA) lds[8 * K + idx] = a2(m0 + i, k); }
    __syncthreads();
    float acc1[8], acc2[8];
#pragma unroll
    for (int i = 0; i < 8; ++i) { acc1[i] = 0.f; acc2[i] = 0.f; }
    const float* w1 = W1 + n1; const float* w2 = TWO ? (W2 + n2) : w1;
    const float* l2 = (TWO && !SAMEA) ? lds + 8 * K : lds;
    for (int k = 0; k < K; k += 4) {
        float a[4], b[4];
#pragma unroll
        for (int kk = 0; kk < 4; ++kk) { a[kk] = w1[(size_t)(k + kk) * ldw1]; b[kk] = TWO ? w2[(size_t)(k + kk) * ldw2] : 0.f; }
#pragma unroll
        for (int i = 0; i < 8; ++i) {
            const float4 x1 = *(const float4*)(lds + i * K + k);
            acc1[i] += x1.x * a[0] + x1.y * a[1] + x1.z * a[2] + x1.w * a[3];
            if (TWO) { const float4 x2 = *(const float4*)(l2 + i * K + k); acc2[i] += x2.x * b[0] + x2.y * b[1] + x2.z * b[2] + x2.w * b[3]; }
        }
    }
#pragma unroll
    for (int i = 0; i < 8; ++i) epi(m0 + i, acc1[i], acc2[i]);
    __syncthreads();
}

__device__ __forceinline__ void store_z(const P& p, int t, int j, float z, float zp) {
    const int b = t / S, s = t % S;
    if (j < OFF_KV) {
        const int d = j & 63, i = d & 31; const float c = p.cs[(size_t)t * 64 + i], sn = p.cs[(size_t)t * 64 + 32 + i];
        const float r = (d < 32) ? (z * c - zp * sn) : (z * c + zp * sn);
        p.q[(size_t)t * 512 + j] = f2bf(r * 0.125f);
    } else if (j < OFF_NG) {
        const int seg = (j - OFF_KV) >> 7, cc = (j - OFF_KV) & 127, g = cc >> 6, d = cc & 63; float r = z;
        if (seg == 2 || seg == 4) { const int i = d & 31; const float c = p.cs[(size_t)t * 64 + i], sn = p.cs[(size_t)t * 64 + 32 + i]; r = (d < 32) ? (z * c - zp * sn) : (z * c + zp * sn); }
        p.kv6[(size_t)seg * kvseg(p) + ((size_t)(b * 2 + g) * S + s) * 64 + d] = f2bf(r);
    } else if (j < OFF_GQ) { p.gates[(size_t)t * 24 + (j - OFF_NG)] = sigmoidf_(z);
    } else if (j < OFF_GK) { p.gq[(size_t)t * 256 + (j - OFF_GQ)] = f2bf(z * 0.125f);
    } else if (j < OFF_GV) { p.gk[(size_t)t * 256 + (j - OFF_GK)] = f2bf(z);
    } else if (j < OFF_GA) { p.gv[(size_t)t * 512 + (j - OFF_GV)] = f2bf(z);
    } else if (j < OFF_GR) { p.alow[(size_t)t * 16 + (j - OFF_GA)] = z;
    } else if (j < OFF_MA) { p.rs[(size_t)t * 512 + (j - OFF_GR)] = f2bf(siluf_(z));
    } else if (j < OFF_MB) { p.sa[(size_t)t * 1024 + (j - OFF_MA)] = f2bf(sigmoidf_(z));
    } else { p.sb[(size_t)t * 1024 + (j - OFF_MB)] = f2bf(sigmoidf_(z)); }
}
__device__ __forceinline__ int rope_partner(int j) {
    int base;
    if (j < OFF_KV) base = 0; else if (j >= 768 && j < 896) base = 768; else if (j >= 1024 && j < 1152) base = 1024; else return -1;
    const int d = (j - base) & 63; return d < 32 ? j + 32 : j - 32;
}
__device__ __forceinline__ void body_inproj(const P& p, int vb, char* smem) {
    constexpr int NCB = (INW + NT - 1) / NT;
    const int bx = vb % NCB, by = vb / NCB;
    const int jr = bx * NT + TIDX(); const bool jv = jr < INW; const int j = jv ? jr : INW - 1;
    int jp = rope_partner(j); if (jp < 0) jp = j;
    ngemm<1024, true, true>((float*)smem, by * 8, p.w_in, INW, j, p.w_in, INW, jp,
        [&](int m, int k) { return bf2f(p.u[(size_t)m * D + k]); }, [&](int m, int k) { return 0.f; },
        [&](int m, float z, float zp) { if (jv) store_z(p, m, j, z, zp); });
}

__device__ __forceinline__ void body_cmp1(const P& p, int vb, char* smem) {
    const int nrows = p.nb * 2 * 256, ng = nrows / 8;
    const int kv = vb / ng, m0 = (vb % ng) * 8; const int n = TIDX() & 255; const bool act = TIDX() < 256;
    const bf16* src = p.kv6 + (size_t)kv * kvseg(p);
    const float* pe = kv ? p.cpos_v : p.cpos_k; const float* w1 = kv ? p.cw1_v : p.cw1_k; const float* b1 = kv ? p.cb1_v : p.cb1_k;
    float* dst = p.hcmp + (size_t)kv * nrows * 256;
    ngemm<2048, false, true>((float*)smem, m0, w1, 256, n, w1, 256, n,
        [&](int m, int k) { return bf2f(src[(size_t)m * 1024 + k]) + pe[k]; }, [&](int m, int k) { return 0.f; },
        [&](int m, float z, float) { if (act) dst[(size_t)m * 256 + n] = geluf_(z + b1[n]); });
}
__device__ __forceinline__ void body_cmp2(const P& p, int vb) {
    const int nrows = p.nb * 2 * 256;
    const int idx = vb * NT + TIDX();
    const int i = idx & 31, row = (idx >> 5) % nrows, kv = (idx >> 5) / nrows;
    const float* h = p.hcmp + ((size_t)kv * nrows + row) * 256; const float* w2 = kv ? p.cw2_v : p.cw2_k; const float* b2 = kv ? p.cb2_v : p.cb2_k;
    float z1 = b2[i], z2 = b2[i + 32];
    for (int n = 0; n < 256; ++n) { const float hv = h[n]; z1 += hv * w2[n * 64 + i]; z2 += hv * w2[n * 64 + i + 32]; }
    bf16* dst = (kv ? p.vcmp : p.kcmp) + (size_t)row * 64;
    if (kv == 0) {
        const int bg = row >> 8, m = row & 255, b = bg >> 1; int sp = 16 * m + 31; if (sp > S - 1) sp = S - 1;
        const size_t t = (size_t)b * S + sp; const float c = p.cs[t * 64 + i], sn = p.cs[t * 64 + 32 + i];
        const float r1 = z1 * c - z2 * sn, r2 = z2 * c + z1 * sn; z1 = r1; z2 = r2;
    }
    dst[i] = f2bf(z1); dst[i + 32] = f2bf(z2);
}

__device__ __forceinline__ void load_row64(const bf16* r, float* f) {
    const uint4* p4 = (const uint4*)r;
#pragma unroll
    for (int c = 0; c < 8; ++c) { const uint4 v = p4[c]; const unsigned w[4] = {v.x, v.y, v.z, v.w};
#pragma unroll
        for (int e = 0; e < 4; ++e) { f[c * 8 + e * 2] = __uint_as_float(w[e] << 16); f[c * 8 + e * 2 + 1] = __uint_as_float(w[e] & 0xffff0000u); } }
}
__device__ __forceinline__ float dot64(const float* a, const bf16* r) {
    const uint4* p4 = (const uint4*)r; float s = 0.f;
#pragma unroll
    for (int c = 0; c < 8; ++c) { const uint4 v = p4[c]; const unsigned w[4] = {v.x, v.y, v.z, v.w};
#pragma unroll
        for (int e = 0; e < 4; ++e) { s += a[c * 8 + e * 2] * __uint_as_float(w[e] << 16); s += a[c * 8 + e * 2 + 1] * __uint_as_float(w[e] & 0xffff0000u); } }
    return s;
}
__device__ __forceinline__ void axpy64(float* o, float a, const bf16* r) {
    const uint4* p4 = (const uint4*)r;
#pragma unroll
    for (int c = 0; c < 8; ++c) { const uint4 v = p4[c]; const unsigned w[4] = {v.x, v.y, v.z, v.w};
#pragma unroll
        for (int e = 0; e < 4; ++e) { o[c * 8 + e * 2] += a * __uint_as_float(w[e] << 16); o[c * 8 + e * 2 + 1] += a * __uint_as_float(w[e] & 0xffff0000u); } }
}
__device__ __forceinline__ void body_nsacmp(const P& p, int vb, char* smem) {
    const int wave = TIDX() >> 6, lane = TIDX() & 63, item = vb * 8 + wave;
    const int g = item & 1, t = (item >> 1) * 64 + lane;
    const int b = t / S, s = t % S; const int nv = s >= 31 ? (s - 31) / 16 + 1 : 0;
    float* my = (float*)smem + (size_t)wave * (64 * 65) + lane * 65;
    for (int j = 0; j < 64; ++j) my[j] = 0.f;
    const bf16* kc = p.kcmp + (size_t)(b * 2 + g) * 256 * 64; const bf16* vc = p.vcmp + (size_t)(b * 2 + g) * 256 * 64;
    for (int hh = 0; hh < 4; ++hh) {
        const int h = g * 4 + hh; float qv[64], o[64];
        load_row64(p.q + (size_t)t * 512 + h * 64, qv);
#pragma unroll
        for (int d = 0; d < 64; ++d) o[d] = 0.f;
        float m = -1e30f, l = 0.f;
        for (int n = 0; n < nv; ++n) { const float sc = dot64(qv, kc + n * 64); const float mn = fmaxf(m, sc); l = l * __expf(m - mn) + __expf(sc - mn); m = mn; }
        const float il = nv > 0 ? 1.f / l : 0.f;
        for (int n = 0; n < nv; ++n) {
            const float sc = dot64(qv, kc + n * 64); const float pn = __expf(sc - m) * il;
            axpy64(o, pn, vc + n * 64);
            const int j0 = n >> 2; if ((n & 3) != 3) my[j0] += pn; else { my[j0] += 0.5f * pn; my[j0 + 1] += 0.5f * pn; }
        }
#pragma unroll
        for (int d = 0; d < 64; ++d) p.ocmp[(size_t)t * 512 + h * 64 + d] = o[d];
    }
    const int cur = s >> 6; u64 mask = 0ull;
    for (int j = 0; j <= cur; ++j) {
        const float sj = (j == 0 || j == cur || j == cur - 1) ? 1e4f : my[j]; int rank = 0;
        for (int i = 0; i <= cur; ++i) { if (i == j) continue; const float si = (i == 0 || i == cur || i == cur - 1) ? 1e4f : my[i]; if (si > sj || (si == sj && i < j)) ++rank; }
        if (rank < 16) mask |= (1ull << j);
    }
    p.sel[(size_t)t * 2 + g] = mask;
}
__device__ __forceinline__ void body_nsaatt(const P& p, int vb) {
    const int wave = TIDX() >> 6, lane = TIDX() & 63, item = vb * 8 + wave;
    const int h = item & 7, t = (item >> 3) * 64 + lane, g = h >> 2;
    const int b = t / S, s = t % S, cur = s >> 6;
    const size_t seg = kvseg(p), ho = (size_t)(b * 2 + g) * S * 64;
    const bf16* ks = p.kv6 + 2 * seg + ho; const bf16* vs = p.kv6 + 3 * seg + ho; const bf16* kw = p.kv6 + 4 * seg + ho; const bf16* vw = p.kv6 + 5 * seg + ho;
    float qv[64], o[64];
    load_row64(p.q + (size_t)t * 512 + h * 64, qv);
    const float g0 = p.gates[(size_t)t * 24 + h * 3], g1 = p.gates[(size_t)t * 24 + h * 3 + 1], g2 = p.gates[(size_t)t * 24 + h * 3 + 2];
    float* accp = p.ocmp + (size_t)t * 512 + h * 64;
#pragma unroll
    for (int d = 0; d < 64; ++d) o[d] = 0.f;
    const u64 mask = p.sel[(size_t)t * 2 + g];
    float m = -1e30f, l = 0.f;
    for (int j = 0; j <= cur; ++j) {
        if (!((mask >> j) & 1ull)) continue;
        for (int kk = 0; kk < 64; ++kk) {
            const int key = j * 64 + kk; if (key > s) break;
            const float sc = dot64(qv, ks + (size_t)key * 64);
            if (sc > m) { const float f = __expf(m - sc); l *= f;
#pragma unroll
                for (int d = 0; d < 64; ++d) o[d] *= f;
                m = sc; }
            const float pe = __expf(sc - m); l += pe; axpy64(o, pe, vs + (size_t)key * 64);
        }
    }
    { const float f = g1 / l;
#pragma unroll
        for (int d = 0; d < 64; ++d) { accp[d] = g0 * accp[d] + f * o[d]; o[d] = 0.f; } }
    m = -1e30f; l = 0.f;
    for (int key = (s >= 511 ? s - 511 : 0); key <= s; ++key) {
        const float sc = dot64(qv, kw + (size_t)key * 64);
        if (sc > m) { const float f = __expf(m - sc); l *= f;
#pragma unroll
            for (int d = 0; d < 64; ++d) o[d] *= f;
            m = sc; }
        const float pe = __expf(sc - m); l += pe; axpy64(o, pe, vw + (size_t)key * 64);
    }
    { const float f = g2 / l;
#pragma unroll
        for (int d = 0; d < 64; ++d) p.onsa[(size_t)t * 512 + h * 64 + d] = f2bf(accp[d] + f * o[d]); }
}

__device__ __forceinline__ void body_glaa(const P& p, int vb) {
    const int c = TIDX() & 255, t = vb * 2 + (TIDX() >> 8); float z = p.b_a[c];
#pragma unroll
    for (int r = 0; r < 16; ++r) z += p.alow[(size_t)t * 16 + r] * p.w_a2[r * 256 + c];
    const float ls = fminf(z, 0.f) - log1pf(__expf(-fabsf(z)));
    p.ga[(size_t)t * 256 + c] = __expf(ls * (1.f / 16.f));
}
__device__ __forceinline__ void body_glascan(const P& p, int vb, char* smem) {
    const int sub = TIDX() >> 7, e = TIDX() & 127, bh = vb * 4 + sub, b = bh >> 2, h = bh & 3;
    float* sq = (float*)smem + sub * (3 * 32 * 64); float* sk = sq + 32 * 64; float* sg = sk + 32 * 64;
    float St[64];
#pragma unroll
    for (int d = 0; d < 64; ++d) St[d] = 0.f;
    for (int s0 = 0; s0 < S; s0 += 32) {
        __syncthreads();
        for (int i = e; i < 32 * 64; i += 128) { const int ss = i >> 6, d = i & 63; const size_t t = (size_t)b * S + s0 + ss;
            sq[i] = bf2f(p.gq[t * 256 + h * 64 + d]); sk[i] = bf2f(p.gk[t * 256 + h * 64 + d]); sg[i] = p.ga[t * 256 + h * 64 + d]; }
        __syncthreads();
        for (int ss = 0; ss < 32; ++ss) {
            const size_t t = (size_t)b * S + s0 + ss; const float v = bf2f(p.gv[t * 512 + h * 128 + e]); float o = 0.f;
#pragma unroll
            for (int d = 0; d < 64; ++d) { St[d] = sg[ss * 64 + d] * St[d] + sk[ss * 64 + d] * v; o += sq[ss * 64 + d] * St[d]; }
            p.oraw[t * 512 + h * 128 + e] = o;
        }
    }
    __syncthreads();
}
__device__ __forceinline__ void body_glanorm(const P& p, int vb) {
    const int idx = vb * NT + TIDX(); const int t = idx >> 2, h = idx & 3;
    const float* o = p.oraw + (size_t)t * 512 + h * 128; float ss = 0.f;
    for (int e = 0; e < 128; ++e) ss += o[e] * o[e];
    const float r = rsqrtf(ss * (1.f / 128.f) + 1e-6f);
    for (int e = 0; e < 128; ++e) p.gla[(size_t)t * 512 + h * 128 + e] = f2bf(o[e] * r * p.norm_g[h * 128 + e] * bf2f(p.rs[(size_t)t * 512 + h * 128 + e]));
}

__device__ __forceinline__ void body_proj(const P& p, int vb, char* smem) {
    const int n = (vb & 1) * NT + TIDX(), m0 = (vb >> 1) * 8;
    ngemm<512, true, false>((float*)smem, m0, p.w_pn, 1024, n, p.w_pg, 1024, n,
        [&](int m, int k) { return bf2f(p.onsa[(size_t)m * 512 + k]); }, [&](int m, int k) { return bf2f(p.gla[(size_t)m * 512 + k]); },
        [&](int m, float ya, float yb) { p.mixed[(size_t)m * 1024 + n] = f2bf(bf2f(p.sa[(size_t)m * 1024 + n]) * ya + bf2f(p.sb[(size_t)m * 1024 + n]) * yb); });
}
__device__ __forceinline__ void body_out(const P& p, int vb, char* smem) {
    const int n = (vb & 1) * NT + TIDX(), m0 = (vb >> 1) * 8;
    ngemm<1024, false, true>((float*)smem, m0, p.w_out, 1024, n, p.w_out, 1024, n,
        [&](int m, int k) { return bf2f(p.mixed[(size_t)m * 1024 + k]); }, [&](int m, int k) { return 0.f; },
        [&](int m, float z, float) { p.h1[(size_t)m * 1024 + n] = p.x[(size_t)m * 1024 + n] + z; });
}

__device__ __forceinline__ void body_route(const P& p, int vb, char* smem) {
    const int wave = TIDX() >> 6, lane = TIDX() & 63, t = vb * 8 + wave;
    const float4* hr = (const float4*)(p.h1 + (size_t)t * D);
    float v[16]; float ss = 0.f;
#pragma unroll
    for (int j = 0; j < 4; ++j) { const float4 a = hr[lane + 64 * j]; v[4 * j] = a.x; v[4 * j + 1] = a.y; v[4 * j + 2] = a.z; v[4 * j + 3] = a.w; ss += a.x * a.x + a.y * a.y + a.z * a.z + a.w * a.w; }
#pragma unroll
    for (int o = 1; o < 64; o <<= 1) ss += __shfl_xor(ss, o);
    const float rstd = rsqrtf(ss * (1.f / D) + 1e-6f);
#pragma unroll
    for (int j = 0; j < 4; ++j) {
        const float4 g = ((const float4*)p.g_ffn)[lane + 64 * j];
        v[4 * j] *= rstd * g.x; v[4 * j + 1] *= rstd * g.y; v[4 * j + 2] *= rstd * g.z; v[4 * j + 3] *= rstd * g.w;
        ushort4 o; o.x = f2bf(v[4 * j]); o.y = f2bf(v[4 * j + 1]); o.z = f2bf(v[4 * j + 2]); o.w = f2bf(v[4 * j + 3]);
        ((ushort4*)(p.vb + (size_t)t * D))[lane + 64 * j] = o;
    }
    float* sl = (float*)(smem + LDS_MISC) + wave * 40;
    for (int o = 0; o < 4; ++o) { float a = 0.f;
#pragma unroll
        for (int j = 0; j < 4; ++j)
#pragma unroll
            for (int e = 0; e < 4; ++e) a += v[4 * j + e] * p.w_grp[(size_t)(4 * (lane + 64 * j) + e) * 4 + o];
#pragma unroll
        for (int x = 1; x < 64; x <<= 1) a += __shfl_xor(a, x);
        if (lane == 0) sl[o] = a + p.b_grp[o]; }
    for (int o = 0; o < 32; ++o) { float a = 0.f;
#pragma unroll
        for (int j = 0; j < 4; ++j)
#pragma unroll
            for (int e = 0; e < 4; ++e) a += v[4 * j + e] * p.w_exp[(size_t)(4 * (lane + 64 * j) + e) * 32 + o];
#pragma unroll
        for (int x = 1; x < 64; x <<= 1) a += __shfl_xor(a, x);
        if (lane == 0) sl[4 + o] = a + p.b_exp[o]; }
    if (lane == 0) {
        int gs = 0; float gm = sl[0];
        for (int o = 1; o < 4; ++o) if (sl[o] > gm) { gm = sl[o]; gs = o; }
        float gsum = 0.f;
        for (int o = 0; o < 4; ++o) gsum += __expf(sl[o] - gm);
        const float pg = 1.f / gsum;
        const float* li = sl + 4 + gs * 8;
        int e0 = 0; float m0 = li[0];
        for (int e = 1; e < 8; ++e) if (li[e] > m0) { m0 = li[e]; e0 = e; }
        int e1 = -1; float m1 = -3e38f;
        for (int e = 0; e < 8; ++e) if (e != e0 && li[e] > m1) { m1 = li[e]; e1 = e; }
        const float p0 = 1.f, p1 = __expf(m1 - m0);
        const float w0 = pg * p0 / (p0 + p1), w1 = pg * p1 / (p0 + p1);
        const int x0 = gs * 8 + e0, x1 = gs * 8 + e1;
        const int s0 = (int)atomicAdd(&p.ctl[x0 * 32], 1u), s1 = (int)atomicAdd(&p.ctl[x1 * 32], 1u);
        p.list[(size_t)x0 * p.T + s0] = t; p.list[(size_t)x1 * p.T + s1] = t;
        p.tokexp[t * 2] = x0; p.tokexp[t * 2 + 1] = x1; p.tokslot[t * 2] = s0; p.tokslot[t * 2 + 1] = s1; p.tokw[t * 2] = w0; p.tokw[t * 2 + 1] = w1;
    }
}

__device__ __forceinline__ void body_route2(const P& p, int vb, char* smem) {
    const int tid = TIDX(), wave = tid >> 6, lane = tid & 63, t = vb * 8 + wave;
    const float4* hr = (const float4*)(p.h1 + (size_t)t * D);
    float4 v[4]; float ss = 0.f;
#pragma unroll
    for (int j = 0; j < 4; ++j) { v[j] = hr[lane + 64 * j]; ss += v[j].x * v[j].x + v[j].y * v[j].y + v[j].z * v[j].z + v[j].w * v[j].w; }
#pragma unroll
    for (int o = 1; o < 64; o <<= 1) ss += __shfl_xor(ss, o);
    const float rstd = rsqrtf(ss * (1.f / D) + 1e-6f);
#pragma unroll
    for (int j = 0; j < 4; ++j) {
        const float4 g = ((const float4*)p.g_ffn)[lane + 64 * j];
        v[j].x *= rstd * g.x; v[j].y *= rstd * g.y; v[j].z *= rstd * g.z; v[j].w *= rstd * g.w;
        ushort4 o; o.x = f2bf(v[j].x); o.y = f2bf(v[j].y); o.z = f2bf(v[j].z); o.w = f2bf(v[j].w);
        ((ushort4*)(p.vb + (size_t)t * D))[lane + 64 * j] = o;
    }
    float* sl = (float*)(smem + LDS_MISC) + wave * 40;
    float mine = 0.f;
#pragma unroll 4
    for (int o = 0; o < 36; ++o) { const float4* wrow = (const float4*)(p.wr + (size_t)o * 1024); float a = 0.f;
#pragma unroll
        for (int j = 0; j < 4; ++j) { const float4 w = wrow[lane + 64 * j]; a += v[j].x * w.x + v[j].y * w.y + v[j].z * w.z + v[j].w * w.w; }
#pragma unroll
        for (int x = 1; x < 64; x <<= 1) a += __shfl_xor(a, x);
        if (lane == o) mine = a; }
    if (lane < 36) sl[lane] = mine + (lane < 4 ? p.b_grp[lane] : p.b_exp[lane - 4]);
    asm volatile("s_waitcnt lgkmcnt(0)" ::: "memory");
    if (lane == 0) {
        int gs = 0; float gm = sl[0];
        for (int o = 1; o < 4; ++o) if (sl[o] > gm) { gm = sl[o]; gs = o; }
        float gsum = 0.f;
        for (int o = 0; o < 4; ++o) gsum += __expf(sl[o] - gm);
        const float pg = 1.f / gsum;
        const float* li = sl + 4 + gs * 8;
        int e0 = 0; float m0 = li[0];
        for (int e = 1; e < 8; ++e) if (li[e] > m0) { m0 = li[e]; e0 = e; }
        int e1 = -1; float m1 = -3e38f;
        for (int e = 0; e < 8; ++e) if (e != e0 && li[e] > m1) { m1 = li[e]; e1 = e; }
        const float p0 = 1.f, p1 = __expf(m1 - m0);
        const float w0 = pg * p0 / (p0 + p1), w1 = pg * p1 / (p0 + p1);
        const int x0 = gs * 8 + e0, x1 = gs * 8 + e1;
        const int s0 = (int)atomicAdd(&p.ctl[x0 * 32], 1u), s1 = (int)atomicAdd(&p.ctl[x1 * 32], 1u);
        p.list[(size_t)x0 * p.T + s0] = t; p.list[(size_t)x1 * p.T + s1] = t;
        p.tokexp[t * 2] = x0; p.tokexp[t * 2 + 1] = x1; p.tokslot[t * 2] = s0; p.tokslot[t * 2 + 1] = s1; p.tokw[t * 2] = w0; p.tokw[t * 2 + 1] = w1;
    }
}

__device__ __forceinline__ float tred8(float (&a)[8], int lane) {
    const bool b5 = lane & 32, b4 = lane & 16, b3 = lane & 8;
    float k4[4], k2[2], k1;
#pragma unroll
    for (int i = 0; i < 4; ++i) { const float snd = b5 ? a[i] : a[i + 4]; const float kp = b5 ? a[i + 4] : a[i]; k4[i] = kp + __shfl_xor(snd, 32); }
#pragma unroll
    for (int i = 0; i < 2; ++i) { const float snd = b4 ? k4[i] : k4[i + 2]; const float kp = b4 ? k4[i + 2] : k4[i]; k2[i] = kp + __shfl_xor(snd, 16); }
    { const float snd = b3 ? k2[0] : k2[1]; const float kp = b3 ? k2[1] : k2[0]; k1 = kp + __shfl_xor(snd, 8); }
    k1 += __shfl_xor(k1, 4); k1 += __shfl_xor(k1, 2); k1 += __shfl_xor(k1, 1);
    return k1;
}
__device__ __forceinline__ void body_route3(const P& p, int vb, char* smem) {
    const int tid = TIDX(), wave = tid >> 6, lane = tid & 63, t0 = vb * 64 + wave * 8;
    float4 v[8][4]; float ss[8];
#pragma unroll
    for (int tk = 0; tk < 8; ++tk) { const ushort4* hr = (const ushort4*)(p.h1b + (size_t)(t0 + tk) * D); float s = 0.f;
#pragma unroll
        for (int j = 0; j < 4; ++j) { const ushort4 hb = hr[lane + 64 * j]; v[tk][j] = make_float4(bf2f(hb.x), bf2f(hb.y), bf2f(hb.z), bf2f(hb.w)); s += v[tk][j].x * v[tk][j].x + v[tk][j].y * v[tk][j].y + v[tk][j].z * v[tk][j].z + v[tk][j].w * v[tk][j].w; }
        ss[tk] = s; }
    const float tot = tred8(ss, lane);
#pragma unroll
    for (int tk = 0; tk < 8; ++tk) { const float rstd = rsqrtf(__shfl(tot, tk * 8) * (1.f / D) + 1e-6f);
#pragma unroll
        for (int j = 0; j < 4; ++j) {
            const float4 g = ((const float4*)p.g_ffn)[lane + 64 * j];
            v[tk][j].x *= rstd * g.x; v[tk][j].y *= rstd * g.y; v[tk][j].z *= rstd * g.z; v[tk][j].w *= rstd * g.w;
            ushort4 o; o.x = f2bf(v[tk][j].x); o.y = f2bf(v[tk][j].y); o.z = f2bf(v[tk][j].z); o.w = f2bf(v[tk][j].w);
            ((ushort4*)(p.vb + (size_t)(t0 + tk) * D))[lane + 64 * j] = o; } }
    float* sl = (float*)smem + wave * (8 * 40);
    float* wl = (float*)smem + 4096;
    for (int o = 0; o < 36; ++o) {
        if (o == 0 || o == 18) { __syncthreads();
#pragma unroll
            for (int k = 0; k < 9; ++k) ((float4*)wl)[tid + k * 512] = ((const float4*)(p.wr + (size_t)o * 1024))[tid + k * 512];
            __syncthreads(); }
        const float4* wrow = (const float4*)(wl + (size_t)(o >= 18 ? o - 18 : o) * 1024); float a[8];
        float4 w[4];
#pragma unroll
        for (int j = 0; j < 4; ++j) w[j] = wrow[lane + 64 * j];
#pragma unroll
        for (int tk = 0; tk < 8; ++tk) { float s = 0.f;
#pragma unroll
            for (int j = 0; j < 4; ++j) s += v[tk][j].x * w[j].x + v[tk][j].y * w[j].y + v[tk][j].z * w[j].z + v[tk][j].w * w[j].w;
            a[tk] = s; }
        const float r = tred8(a, lane);
        if ((lane & 7) == 0) sl[(lane >> 3) * 40 + o] = r + (o < 4 ? p.b_grp[o] : p.b_exp[o - 4]); }
    asm volatile("s_waitcnt lgkmcnt(0)" ::: "memory");
    int* cntl = (int*)((float*)smem + 8 * 320); int* basel = cntl + 32;
    if (tid < 32) cntl[tid] = 0;
    __syncthreads();
    int x0 = 0, x1 = 0, l0 = 0, l1 = 0; float w0 = 0.f, w1 = 0.f;
    if (lane < 8) {
        const float* s8 = sl + lane * 40;
        int gs = 0; float gm = s8[0];
        for (int o = 1; o < 4; ++o) if (s8[o] > gm) { gm = s8[o]; gs = o; }
        float gsum = 0.f;
        for (int o = 0; o < 4; ++o) gsum += __expf(s8[o] - gm);
        const float pg = 1.f / gsum;
        const float* li = s8 + 4 + gs * 8;
        int e0 = 0; float m0 = li[0];
        for (int e = 1; e < 8; ++e) if (li[e] > m0) { m0 = li[e]; e0 = e; }
        int e1 = -1; float m1 = -3e38f;
        for (int e = 0; e < 8; ++e) if (e != e0 && li[e] > m1) { m1 = li[e]; e1 = e; }
        const float p0 = 1.f, p1 = __expf(m1 - m0);
        w0 = pg * p0 / (p0 + p1); w1 = pg * p1 / (p0 + p1);
        x0 = gs * 8 + e0; x1 = gs * 8 + e1;
        l0 = atomicAdd(&cntl[x0], 1); l1 = atomicAdd(&cntl[x1], 1);
    }
    __syncthreads();
    if (tid < 32) { const int c = cntl[tid]; basel[tid] = c > 0 ? (int)atomicAdd(&p.ctl[tid * 32], (unsigned)c) : 0; }
    __syncthreads();
    if (lane < 8) {
        const int t = t0 + lane; const int s0 = basel[x0] + l0, s1 = basel[x1] + l1;
        p.list[(size_t)x0 * p.T + s0] = t; p.list[(size_t)x1 * p.T + s1] = t;
        p.tokexp[t * 2] = x0; p.tokexp[t * 2 + 1] = x1; p.tokslot[t * 2] = s0; p.tokslot[t * 2 + 1] = s1; p.tokw[t * 2] = w0; p.tokw[t * 2 + 1] = w1;
    }
    __syncthreads();
}

__device__ __forceinline__ int* seg_bases(const P& p, char* smem) {
    int* sbase = (int*)(smem + LDS_MISC + 2048);
    __syncthreads();
    if (TIDX() == 0) { int acc = 0; for (int e = 0; e < NEXP; ++e) { sbase[e] = acc; acc += ((int)p.ctl[e * 32] + 255) & ~255; } sbase[NEXP] = acc; }
    __syncthreads();
    return sbase;
}
__device__ __forceinline__ void body_moe1(const P& p, int vb, char* smem) {
    int* sbase = seg_bases(p, smem); int* stok = sbase + 40;
    const int r0 = vb * 8; if (r0 >= sbase[NEXP]) return;
    int e = 0; while (r0 >= sbase[e + 1]) ++e;
    const int cnt = (int)p.ctl[e * 32];
    if (TIDX() < 8) { const int sl = r0 + TIDX() - sbase[e]; stok[TIDX()] = p.list[(size_t)e * p.T + (sl < cnt ? sl : 0)]; }
    __syncthreads();
    const int n = TIDX();
    const float* wg = p.w_gate + (size_t)e * 1024 * 512; const float* wu = p.w_up + (size_t)e * 1024 * 512;
    ngemm<1024, true, true>((float*)smem, 0, wg, 512, n, wu, 512, n,
        [&](int m, int k) { return bf2f(p.vb[(size_t)stok[m] * D + k]); }, [&](int m, int k) { return 0.f; },
        [&](int m, float zg, float zu) { p.H[(size_t)(r0 + m) * 512 + n] = f2bf(siluf_(zg) * zu); });
}
__device__ __forceinline__ void body_moe2(const P& p, int vb, char* smem) {
    int* sbase = seg_bases(p, smem);
    const int r0 = (vb >> 1) * 8; if (r0 >= sbase[NEXP]) return;
    int e = 0; while (r0 >= sbase[e + 1]) ++e;
    const int n = (vb & 1) * NT + TIDX();
    const float* wd = p.w_down + (size_t)e * 512 * 1024;
    ngemm<512, false, true>((float*)smem, r0, wd, 1024, n, wd, 1024, n,
        [&](int m, int k) { return bf2f(p.H[(size_t)m * 512 + k]); }, [&](int m, int k) { return 0.f; },
        [&](int m, float z, float) { p.Y[(size_t)m * 1024 + n] = f2bf(z); });
}
__device__ __forceinline__ void body_final(const P& p, int vb, char* smem) {
    int* sbase = seg_bases(p, smem);
    const int lane = TIDX() & 63, t = vb * 8 + (TIDX() >> 6);
    const int r0 = sbase[p.tokexp[t * 2]] + p.tokslot[t * 2], r1 = sbase[p.tokexp[t * 2 + 1]] + p.tokslot[t * 2 + 1];
    const float w0 = p.tokw[t * 2], w1 = p.tokw[t * 2 + 1];
    const float4* hr = (const float4*)(p.h1 + (size_t)t * D);
    float4 v[4]; float ss = 0.f;
#pragma unroll
    for (int j = 0; j < 4; ++j) {
        float4 a = hr[lane + 64 * j];
        const ushort4 y0 = ((const ushort4*)(p.Y + (size_t)r0 * D))[lane + 64 * j], y1 = ((const ushort4*)(p.Y + (size_t)r1 * D))[lane + 64 * j];
        a.x += w0 * bf2f(y0.x) + w1 * bf2f(y1.x); a.y += w0 * bf2f(y0.y) + w1 * bf2f(y1.y); a.z += w0 * bf2f(y0.z) + w1 * bf2f(y1.z); a.w += w0 * bf2f(y0.w) + w1 * bf2f(y1.w);
        v[j] = a; ss += a.x * a.x + a.y * a.y + a.z * a.z + a.w * a.w;
    }
#pragma unroll
    for (int o = 1; o < 64; o <<= 1) ss += __shfl_xor(ss, o);
    const float rstd = rsqrtf(ss * (1.f / D) + 1e-6f);
#pragma unroll
    for (int j = 0; j < 4; ++j) {
        const float4 g = ((const float4*)p.g_final)[lane + 64 * j];
        float4 o; o.x = v[j].x * rstd * g.x; o.y = v[j].y * rstd * g.y; o.z = v[j].z * rstd * g.z; o.w = v[j].w * rstd * g.w;
        ((float4*)(p.out + (size_t)t * D))[lane + 64 * j] = o;
    }
}

__device__ __forceinline__ void body_final_b(const P& p, int vb, char* smem) {
    int* sbase = seg_bases(p, smem);
    const int lane = TIDX() & 63, t = vb * 8 + (TIDX() >> 6);
    const int r0 = sbase[p.tokexp[t * 2]] + p.tokslot[t * 2], r1 = sbase[p.tokexp[t * 2 + 1]] + p.tokslot[t * 2 + 1];
    const float w0 = p.tokw[t * 2], w1 = p.tokw[t * 2 + 1];
    float4 v[4]; float ss = 0.f;
#pragma unroll
    for (int j = 0; j < 4; ++j) {
        const ushort4 hb = ((const ushort4*)(p.h1b + (size_t)t * D))[lane + 64 * j];
        const ushort4 y0 = ((const ushort4*)(p.Y + (size_t)r0 * D))[lane + 64 * j], y1 = ((const ushort4*)(p.Y + (size_t)r1 * D))[lane + 64 * j];
        float4 a; a.x = bf2f(hb.x) + w0 * bf2f(y0.x) + w1 * bf2f(y1.x); a.y = bf2f(hb.y) + w0 * bf2f(y0.y) + w1 * bf2f(y1.y); a.z = bf2f(hb.z) + w0 * bf2f(y0.z) + w1 * bf2f(y1.z); a.w = bf2f(hb.w) + w0 * bf2f(y0.w) + w1 * bf2f(y1.w);
        v[j] = a; ss += a.x * a.x + a.y * a.y + a.z * a.z + a.w * a.w;
    }
#pragma unroll
    for (int o = 1; o < 64; o <<= 1) ss += __shfl_xor(ss, o);
    const float rstd = rsqrtf(ss * (1.f / D) + 1e-6f);
#pragma unroll
    for (int j = 0; j < 4; ++j) {
        const float4 g = ((const float4*)p.g_final)[lane + 64 * j];
        float4 o; o.x = v[j].x * rstd * g.x; o.y = v[j].y * rstd * g.y; o.z = v[j].z * rstd * g.z; o.w = v[j].w * rstd * g.w;
        ((float4*)(p.out + (size_t)t * D))[lane + 64 * j] = o;
    }
}

namespace pg8 {
#define PG8_LAS __attribute__((address_space(3)))
typedef short bf16x8 __attribute__((ext_vector_type(8)));
typedef float f32x4 __attribute__((ext_vector_type(4)));
typedef unsigned u32x4 __attribute__((ext_vector_type(4)));
typedef unsigned u32x2 __attribute__((ext_vector_type(2)));
constexpr int BM = 256, BK = 64, HALF = 128, HTB = HALF * BK * 2, STAGE_BYTES = 8 * HTB, NXCD = 8, WGM = 8;

__host__ __device__ __forceinline__ int lds_byte(int r, int c) { const int st = (r >> 4) * 2 + (c >> 5), rr = r & 15, cc = c & 31, ob = rr * 64 + cc * 2; return st * 1024 + (ob ^ (((ob >> 9) & 1) << 5)); }
__host__ __device__ __forceinline__ void stage_rc(int b, int& R, int& C) { const int st = b / 1024, sb = b % 1024, swz = sb ^ (((sb >> 9) & 1) << 5); R = (st >> 1) * 16 + swz / 64; C = (st & 1) * 32 + (swz % 64) / 2; }
__host__ __device__ __forceinline__ int perm32(int rho) { const int n = rho >> 4, i = rho & 15; return 8 * (i >> 2) + 4 * n + (i & 3); }

struct Unit { int pm, pn; const char* A; const char* B; int tag; };

struct TileOrder {
    int nM, nN, nwg, G, c;
    __device__ void init(int nM_, int nN_, int G_, int c_) { nM = nM_; nN = nN_; nwg = nM * nN; G = G_; c = c_; }
    __device__ bool next(int i, int& pm, int& pn) const {
        const long L = (long)i * G + c; if (L >= nwg) return false;
        int wgid = (int)L; { const int q = nwg / NXCD, r = nwg % NXCD, xcd = wgid % NXCD, off = wgid / NXCD; wgid = (xcd < r ? xcd * (q + 1) : r * (q + 1) + (xcd - r) * q) + off; }
        const int nig = WGM * nN, gid = wgid / nig, fm = gid * WGM, gsz = (nM - fm) < WGM ? (nM - fm) : WGM;
        pm = fm + ((wgid % nig) % gsz); pn = (wgid % nig) / gsz; return true;
    }
};
struct DenseSched {
    TileOrder o; const char* A; const char* B; int lda, ldb;
    __device__ void init(const void* A_, const void* B_, int M, int N, int lda_, int ldb_) { A = (const char*)A_; B = (const char*)B_; lda = lda_; ldb = ldb_; o.init(M / BM, N / BM, gridDim.x, blockIdx.x); }
    __device__ __forceinline__ bool next(int i, Unit& u) const { if (!o.next(i, u.pm, u.pn)) return false; u.A = A + (size_t)u.pm * BM * lda * 2; u.B = B + (size_t)u.pn * BM * ldb * 2; u.tag = 0; return true; }
    __device__ __forceinline__ unsigned arow(const Unit&, int r) const { return (unsigned)r * (unsigned)lda * 2u; }
    __device__ __forceinline__ void a_ready(const Unit&) const {}
    __device__ __forceinline__ void done(const Unit&) const {}
};

__device__ __forceinline__ unsigned cvt_pk_bf16(float lo, float hi) { unsigned r; asm volatile("v_cvt_pk_bf16_f32 %0, %1, %2" : "=v"(r) : "v"(lo), "v"(hi)); return r; }

template <class Epi, class Sched, bool ALIGN_EPI, bool GATHER>
__device__ __forceinline__ void gemm_phase(PG8_LAS unsigned char* lds, const int K, const int lda, const int ldb, const Sched& S, const Epi& E) {
    const int tid = TIDX(), wid = __builtin_amdgcn_readfirstlane(tid >> 6), lane = tid & 63, wr = wid >> 2, wc = wid & 3, fr = lane & 15, fq = lane >> 4;
    const int nt = K / BK;
    int sR[2], sC[2];
    unsigned voffA[2], voffB[2];
#pragma unroll
    for (int i = 0; i < 2; ++i) { stage_rc(tid * 16 + i * 8192, sR[i], sC[i]); const int Rb = Epi::PERM ? ((sR[i] & ~31) + perm32(sR[i] & 31)) : sR[i];
        voffA[i] = (unsigned)(sR[i] * lda + sC[i]) * 2u; voffB[i] = (unsigned)(Rb * ldb + sC[i]) * 2u; }
    unsigned gA[2][2], gN[2][2];
    const size_t kstep = (size_t)(BK * 2);
    const size_t hstepA = (size_t)HALF * lda * 2, hstepB = (size_t)HALF * ldb * 2;
    const unsigned ldsw = (unsigned)wid * 1024u;
    const int aoff = lds_byte(wr * 64 + fr, fq * 8), boff = lds_byte(wc * 32 + fr, fq * 8);
#define PG8_SA(b, h) (((b) * 2 + (h)) * HTB)
#define PG8_SB(b, h) ((4 + (b) * 2 + (h)) * HTB)
#define PG8_GLDS(bufoff, gptr, i_) __builtin_amdgcn_global_load_lds((const unsigned*)(gptr), (PG8_LAS unsigned*)(lds + (bufoff) + ldsw + (i_) * 8192), 16, 0, 0)
#define PG8_STAGE_B(bufoff, gbase) do { _Pragma("unroll") for (int _i = 0; _i < 2; ++_i) PG8_GLDS(bufoff, (const char*)(gbase) + voffB[_i], _i); } while (0)
#define PG8_STAGE_A(bufoff, gb, h, NX) do { _Pragma("unroll") for (int _i = 0; _i < 2; ++_i) { \
        if constexpr (GATHER) { const unsigned _o = (NX) ? gN[h][_i] : gA[h][_i]; PG8_GLDS(bufoff, (const char*)(gb) + _o, _i); } \
        else { PG8_GLDS(bufoff, (const char*)(gb) + (h) * hstepA + voffA[_i], _i); } } } while (0)
#define PG8_LDA(dst, b, h) do { _Pragma("unroll") for (int m = 0; m < 4; ++m) _Pragma("unroll") for (int k = 0; k < 2; ++k) dst[m][k] = *(const PG8_LAS bf16x8*)(lds + PG8_SA(b, h) + aoff + m * 2048 + k * 1024); } while (0)
#define PG8_LDB(dst, b, h) do { _Pragma("unroll") for (int n = 0; n < 2; ++n) _Pragma("unroll") for (int k = 0; k < 2; ++k) dst[n][k] = *(const PG8_LAS bf16x8*)(lds + PG8_SB(b, h) + boff + n * 2048 + k * 1024); } while (0)
#define PG8_MMA(ai, bj, At, Bt) do { __builtin_amdgcn_s_setprio(1); _Pragma("unroll") for (int m = 0; m < 4; ++m) _Pragma("unroll") for (int n = 0; n < 2; ++n) _Pragma("unroll") for (int k = 0; k < 2; ++k) \
        acc[ai][bj][m][n] = __builtin_amdgcn_mfma_f32_16x16x32_bf16(Bt[n][k], At[m][k], acc[ai][bj][m][n], 0, 0, 0); __builtin_amdgcn_s_setprio(0); } while (0)
#define PG8_WAIT_V(n) asm volatile("s_waitcnt vmcnt(" #n ")" ::: "memory")
#define PG8_WAIT_L(n) asm volatile("s_waitcnt lgkmcnt(" #n ")" ::: "memory")
#define PG8_BAR __builtin_amdgcn_s_barrier()
#define PG8_SCHED __builtin_amdgcn_sched_barrier(0)
#define PG8_GOFF(dst, u) do { if constexpr (GATHER) { _Pragma("unroll") for (int _h = 0; _h < 2; ++_h) _Pragma("unroll") for (int _i = 0; _i < 2; ++_i) dst[_h][_i] = S.arow(u, _h * HALF + sR[_i]) + (unsigned)sC[_i] * 2u; } } while (0)
    Unit cur, nxt; int ui = 0;
    if (!S.next(0, cur)) return;
    f32x4 acc[2][2][4][2];
#pragma unroll
    for (int a = 0; a < 2; ++a)
#pragma unroll
        for (int b = 0; b < 2; ++b)
#pragma unroll
            for (int m = 0; m < 4; ++m)
#pragma unroll
                for (int n = 0; n < 2; ++n) acc[a][b][m][n] = (f32x4){0.f, 0.f, 0.f, 0.f};
    bf16x8 At[4][2], B0[2][2], B1[2][2];
    const char* cA = cur.A; const char* cB = cur.B;
    S.a_ready(cur);
    PG8_GOFF(gA, cur);
    if constexpr (GATHER) { PG8_WAIT_V(0); }
    PG8_STAGE_B(PG8_SB(0, 0), cB); PG8_STAGE_B(PG8_SB(0, 1), cB + hstepB); PG8_STAGE_A(PG8_SA(0, 0), cA, 0, false); PG8_STAGE_A(PG8_SA(0, 1), cA, 1, false);
    if (wr == 1) PG8_BAR;
    PG8_WAIT_V(2); PG8_BAR;
    PG8_STAGE_B(PG8_SB(1, 0), cB + kstep); PG8_STAGE_A(PG8_SA(1, 0), cA + kstep, 0, false); PG8_STAGE_B(PG8_SB(1, 1), cB + hstepB + kstep);
    PG8_WAIT_V(6); PG8_BAR;
    for (;;) {
        const bool has_next = S.next(ui + 1, nxt);
        const char* nA = has_next ? nxt.A : cA; const char* nB = has_next ? nxt.B : cB;
        if constexpr (GATHER) { if (has_next) { PG8_GOFF(gN, nxt); } else {
#pragma unroll
            for (int _h = 0; _h < 2; ++_h)
#pragma unroll
                for (int _i = 0; _i < 2; ++_i) gN[_h][_i] = gA[_h][_i]; } }
        for (int t = 0; t < nt; t += 2) {
            const bool last = (t == nt - 2);
            if (last && has_next) S.a_ready(nxt);
            const char* a1 = cA + (size_t)(t + 1) * kstep;
            const char* a2 = last ? nA : cA + (size_t)(t + 2) * kstep; const char* b2 = last ? nB : cB + (size_t)(t + 2) * kstep;
            const char* a3 = a2 + kstep; const char* b3 = b2 + kstep;
            PG8_LDB(B0, 0, 0); PG8_LDB(B1, 0, 1); PG8_SCHED; PG8_LDA(At, 0, 0); PG8_STAGE_A(PG8_SA(1, 1), a1, 1, false);
            PG8_WAIT_V(8); PG8_WAIT_L(0); PG8_BAR; PG8_MMA(0, 0, At, B0); PG8_MMA(0, 1, At, B1); PG8_BAR; PG8_SCHED;
            PG8_LDA(At, 0, 1); PG8_STAGE_B(PG8_SB(0, 0), b2); PG8_STAGE_B(PG8_SB(0, 1), b2 + hstepB); PG8_STAGE_A(PG8_SA(0, 0), a2, 0, last);
            PG8_WAIT_V(8); PG8_WAIT_L(0); PG8_BAR; PG8_MMA(1, 0, At, B0); PG8_MMA(1, 1, At, B1); PG8_BAR; PG8_SCHED;
            PG8_LDB(B0, 1, 0); PG8_LDB(B1, 1, 1); PG8_SCHED; PG8_LDA(At, 1, 0); PG8_STAGE_A(PG8_SA(0, 1), a2, 1, last);
            PG8_WAIT_V(8); PG8_WAIT_L(0); PG8_BAR; PG8_MMA(0, 0, At, B0); PG8_MMA(0, 1, At, B1); PG8_BAR; PG8_SCHED;
            PG8_LDA(At, 1, 1); PG8_STAGE_B(PG8_SB(1, 0), b3); PG8_STAGE_B(PG8_SB(1, 1), b3 + hstepB); PG8_STAGE_A(PG8_SA(1, 0), a3, 0, last);
            PG8_WAIT_V(8); PG8_WAIT_L(0); PG8_BAR; PG8_MMA(1, 0, At, B0); PG8_MMA(1, 1, At, B1); PG8_BAR; PG8_SCHED;
        }
        if constexpr (ALIGN_EPI) { if (wr == 0) PG8_BAR; }
        E(acc, cur, wr, wc, fr, fq); S.done(cur);
        if (!has_next) break;
        if (!(Epi::CHAIN && !(cur.tag & 1))) {
#pragma unroll
        for (int a = 0; a < 2; ++a)
#pragma unroll
            for (int b = 0; b < 2; ++b)
#pragma unroll
                for (int m = 0; m < 4; ++m)
#pragma unroll
                    for (int n = 0; n < 2; ++n) acc[a][b][m][n] = (f32x4){0.f, 0.f, 0.f, 0.f};
        }
        cur = nxt; cA = nA; cB = nB; ++ui;
        if constexpr (GATHER) {
#pragma unroll
            for (int _h = 0; _h < 2; ++_h)
#pragma unroll
                for (int _i = 0; _i < 2; ++_i) gA[_h][_i] = gN[_h][_i]; }
        if constexpr (ALIGN_EPI) { if (wr == 1) PG8_BAR; }
    }
    PG8_WAIT_V(0);
    if constexpr (!ALIGN_EPI) { if (wr == 0) PG8_BAR; }
    PG8_BAR;
#undef PG8_SA
#undef PG8_SB
#undef PG8_GLDS
#undef PG8_STAGE_A
#undef PG8_STAGE_B
#undef PG8_LDA
#undef PG8_LDB
#undef PG8_MMA
#undef PG8_WAIT_V
#undef PG8_WAIT_L
#undef PG8_BAR
#undef PG8_SCHED
#undef PG8_GOFF
}
}

typedef float f32x4_t __attribute__((ext_vector_type(4)));
__device__ __forceinline__ int inproj_row(int j) {
    if (j < 512) { const int h = j >> 6, d = j & 63; return h * 64 + 2 * (d & 31) + (d >> 5); }
    if (j < 1280) { const int seg = (j - 512) >> 7, cc = (j - 512) & 127; int col = cc; if (seg == 2 || seg == 4) { const int g = cc >> 6, d = cc & 63; col = g * 64 + 2 * (d & 31) + (d >> 5); } return (2 + (seg >> 1)) * 256 + (seg & 1) * 128 + col; }
    if (j < 1304) return 11 * 256 + (j - 1280);
    if (j < 1560) return 5 * 256 + (j - 1304);
    if (j < 1816) return 6 * 256 + (j - 1560);
    if (j < 2328) return 7 * 256 + (j - 1816);
    if (j < 2344) return 11 * 256 + 32 + (j - 2328);
    if (j < 2856) return 9 * 256 + (j - 2344);
    if (j < 3880) return 12 * 256 + (j - 2856);
    return 16 * 256 + (j - 3880);
}
__device__ __forceinline__ unsigned pk2(float lo, float hi) { return (unsigned)f2bf(lo) | ((unsigned)f2bf(hi) << 16); }
template <class RM>
__device__ __forceinline__ void transpose_item(const float* W, int ldw, int N, bf16* WT, int ldt, float* scr, int k0, int n0, int lane, RM rm) {
    const int rr = lane >> 4, c4 = (lane & 15) * 4; const bool inb = n0 + c4 < N;
    f32x4_t v[16];
#pragma unroll
    for (int i = 0; i < 16; ++i) v[i] = inb ? *(const f32x4_t*)(W + (size_t)(k0 + 4 * i + rr) * ldw + n0 + c4) : (f32x4_t){0.f, 0.f, 0.f, 0.f};
#pragma unroll
    for (int i = 0; i < 16; ++i) *(f32x4_t*)(scr + (4 * i + rr) * 68 + c4) = v[i];
    asm volatile("s_waitcnt lgkmcnt(0)" ::: "memory");
    const int c = lane & 7;
#pragma unroll
    for (int j = 0; j < 8; ++j) { const int n = (lane >> 3) + 8 * j; const float* s = scr + (8 * c) * 68 + n;
        uint4 o; o.x = pk2(s[0 * 68], s[1 * 68]); o.y = pk2(s[2 * 68], s[3 * 68]); o.z = pk2(s[4 * 68], s[5 * 68]); o.w = pk2(s[6 * 68], s[7 * 68]);
        const int row = (n0 + n < N) ? rm(n0 + n) : -1;
        if (row >= 0) *(uint4*)(WT + (size_t)row * ldt + k0 + 8 * c) = o; }
    asm volatile("s_waitcnt lgkmcnt(0)" ::: "memory");
}
constexpr int PREP_I_WIN = 16 * 77, PREP_I_C1 = 4 * 64, PREP_I_PN = 128, PREP_I_PG = 128, PREP_I_WO = 256, PREP_I_EXP = 3 * 32 * 128;
constexpr int PREP_ITEMS = PREP_I_WIN + PREP_I_C1 + PREP_I_PN + PREP_I_PG + PREP_I_WO + PREP_I_EXP;
__device__ __forceinline__ void prep_item(const P& p, int it, float* scr, int lane) {
    if (it < PREP_I_WIN) { const int kb = it / 77, nb = it % 77; transpose_item(p.w_in, INW, INW, p.Wt_in, 1024, scr, kb * 64, nb * 64, lane, [](int n) { return inproj_row(n); }); return; }
    it -= PREP_I_WIN;
    if (it < PREP_I_C1) { const int mat = it >> 6, r = it & 63, kb = r >> 2, nb = r & 3, kv = mat >> 1, half = mat & 1;
        const float* W = (kv ? p.cw1_v : p.cw1_k) + (size_t)half * 1024 * 256;
        transpose_item(W, 256, 256, p.Wc1 + (size_t)kv * 512 * 1024, 1024, scr, kb * 64, nb * 64, lane, [half](int n) { return half * 256 + n; }); return; }
    it -= PREP_I_C1;
    if (it < PREP_I_PN) { transpose_item(p.w_pn, 1024, 1024, p.Wpn, 512, scr, (it >> 4) * 64, (it & 15) * 64, lane, [](int n) { return n; }); return; }
    it -= PREP_I_PN;
    if (it < PREP_I_PG) { transpose_item(p.w_pg, 1024, 1024, p.Wpg, 512, scr, (it >> 4) * 64, (it & 15) * 64, lane, [](int n) { return n; }); return; }
    it -= PREP_I_PG;
    if (it < PREP_I_WO) { transpose_item(p.w_out, 1024, 1024, p.Wo, 1024, scr, (it >> 4) * 64, (it & 15) * 64, lane, [](int n) { return n; }); return; }
    it -= PREP_I_WO;
    { const int which = it / (32 * 128), r = it % (32 * 128), e = r >> 7, r2 = r & 127;
        if (which == 0) transpose_item(p.w_gate + (size_t)e * 1024 * 512, 512, 512, p.Wgu + (size_t)e * 1024 * 1024, 1024, scr, (r2 >> 3) * 64, (r2 & 7) * 64, lane, [](int n) { return (n >> 7) * 256 + (n & 127); });
        else if (which == 1) transpose_item(p.w_up + (size_t)e * 1024 * 512, 512, 512, p.Wgu + (size_t)e * 1024 * 1024, 1024, scr, (r2 >> 3) * 64, (r2 & 7) * 64, lane, [](int n) { return (n >> 7) * 256 + 128 + (n & 127); });
        else transpose_item(p.w_down + (size_t)e * 512 * 1024, 1024, 1024, p.Wd + (size_t)e * 1024 * 512, 512, scr, (r2 >> 4) * 64, (r2 & 15) * 64, lane, [](int n) { return n; }); }
}
__device__ __forceinline__ void phase_prep_(const P& p, char* smem);
__device__ __forceinline__ void prep_b1p(const P& p, char* smem);
__device__ __forceinline__ void phase_prep(const P& p, char* smem) { prep_b1p(p, smem); phase_prep_(p, smem); }
__device__ __forceinline__ void phase_prep_(const P& p, char* smem) {
    const int wave = TIDX() >> 6, lane = TIDX() & 63;
    float* scr = (float*)smem + wave * (64 * 68);
    const int gw = blockIdx.x * 8 + wave, NGW = gridDim.x * 8;
    for (int it = gw; it < PREP_ITEMS; it += NGW) prep_item(p, it, scr, lane);
    for (int i = blockIdx.x * NT + TIDX(); i < 216 * 128; i += gridDim.x * NT) { int r = i >> 7; r = r < 8 ? 24 + r : 40 + r; *(uint4*)(p.Wt_in + (size_t)(11 * 256 + r) * 1024 + (i & 127) * 8) = make_uint4(0, 0, 0, 0); }
    for (int i = blockIdx.x * NT + TIDX(); i < 36 * 1024; i += gridDim.x * NT) { const int o = i >> 10, k = i & 1023; p.wr[i] = o < 4 ? p.w_grp[k * 4 + o] : p.w_exp[k * 32 + (o - 4)]; }
    for (int vb = blockIdx.x; vb < p.T / 16; vb += gridDim.x) body_rms2(p, vb);
    for (int vb = blockIdx.x; vb < p.T * 32 / NT; vb += gridDim.x) body_cs(p, vb);
}

struct EpiInA {
    static constexpr bool PERM = true, CHAIN = false;
    P p;
    __device__ __forceinline__ static void rope4(const float* cs, int t, int i0, const pg8::f32x4& v0, const pg8::f32x4& v1, float sc, pg8::u32x2& lo, pg8::u32x2& hi) {
        const f32x4_t c = *(const f32x4_t*)(cs + (size_t)t * 64 + i0), s = *(const f32x4_t*)(cs + (size_t)t * 64 + 32 + i0);
        const float a0 = (v0[0] * c[0] - v0[1] * s[0]) * sc, b0 = (v0[1] * c[0] + v0[0] * s[0]) * sc;
        const float a1 = (v0[2] * c[1] - v0[3] * s[1]) * sc, b1 = (v0[3] * c[1] + v0[2] * s[1]) * sc;
        const float a2 = (v1[0] * c[2] - v1[1] * s[2]) * sc, b2 = (v1[1] * c[2] + v1[0] * s[2]) * sc;
        const float a3 = (v1[2] * c[3] - v1[3] * s[3]) * sc, b3 = (v1[3] * c[3] + v1[2] * s[3]) * sc;
        lo.x = pk2(a0, a1); lo.y = pk2(a2, a3); hi.x = pk2(b0, b1); hi.y = pk2(b2, b3);
    }
    __device__ __forceinline__ static pg8::u32x4 pack8(const pg8::f32x4& v0, const pg8::f32x4& v1) { pg8::u32x4 w; w.x = pk2(v0[0], v0[1]); w.y = pk2(v0[2], v0[3]); w.z = pk2(v1[0], v1[1]); w.w = pk2(v1[2], v1[3]); return w; }
    __device__ __forceinline__ void operator()(const pg8::f32x4 (&acc)[2][2][4][2], const pg8::Unit& u, int wr, int wc, int fr, int fq) const {
        const int pn = u.pn, c8 = wc * 32 + 8 * fq; const size_t seg = kvseg(p);
#pragma unroll
        for (int ai = 0; ai < 2; ++ai)
#pragma unroll
            for (int m = 0; m < 4; ++m) {
                const int t = u.pm * 256 + ai * 128 + wr * 64 + m * 16 + fr; const int b = t / S, s = t % S;
#pragma unroll
                for (int bj = 0; bj < 2; ++bj) {
                    const pg8::f32x4 v0 = acc[ai][bj][m][0], v1 = acc[ai][bj][m][1];
                    if (pn <= 1) {
                        const int cq = pn * 256 + bj * 128 + c8, h = cq >> 6, i0 = (cq & 63) >> 1; pg8::u32x2 lo, hi;
                        rope4(p.cs, t, i0, v0, v1, 0.125f, lo, hi);
                        bf16* dst = p.q + (size_t)t * 512 + h * 64 + i0; *(pg8::u32x2*)dst = lo; *(pg8::u32x2*)(dst + 32) = hi;
                    } else if (pn <= 4) {
                        const int sgi = (pn - 2) * 2 + bj, g = c8 >> 6; bf16* base = p.kv6 + (size_t)sgi * seg + ((size_t)(b * 2 + g) * S + s) * 64;
                        if (bj == 0 && pn >= 3) { const int i0 = (c8 & 63) >> 1; pg8::u32x2 lo, hi; rope4(p.cs, t, i0, v0, v1, 1.f, lo, hi); *(pg8::u32x2*)(base + i0) = lo; *(pg8::u32x2*)(base + 32 + i0) = hi; }
                        else *(pg8::u32x4*)(base + (c8 & 63)) = pack8(v0, v1);
                    } else if (pn == 5) { *(pg8::u32x4*)(p.gq + (size_t)t * 256 + bj * 128 + c8) = pack8(v0 * 0.125f, v1 * 0.125f);
                    } else if (pn == 6) { *(pg8::u32x4*)(p.gk + (size_t)t * 256 + bj * 128 + c8) = pack8(v0, v1);
                    } else if (pn <= 8) { *(pg8::u32x4*)(p.gv + (size_t)t * 512 + (pn - 7) * 256 + bj * 128 + c8) = pack8(v0, v1);
                    } else if (pn <= 10) {
                        pg8::f32x4 a, c;
#pragma unroll
                        for (int e = 0; e < 4; ++e) { a[e] = siluf_(v0[e]); c[e] = siluf_(v1[e]); }
                        *(pg8::u32x4*)(p.rs + (size_t)t * 512 + (pn - 9) * 256 + bj * 128 + c8) = pack8(a, c);
                    } else {
                        if (bj == 0) {
                            if (c8 < 24) { float* d = p.gates + (size_t)t * 24 + c8;
#pragma unroll
                                for (int e = 0; e < 4; ++e) { d[e] = sigmoidf_(v0[e]); d[4 + e] = sigmoidf_(v1[e]); } }
                            else if (c8 >= 32 && c8 < 48) { float* d = p.alow + (size_t)t * 16 + (c8 - 32);
#pragma unroll
                                for (int e = 0; e < 4; ++e) { d[e] = v0[e]; d[4 + e] = v1[e]; } }
                        }
                    }
                }
            }
    }
};
struct EpiSig {
    static constexpr bool PERM = true, CHAIN = false;
    bf16* sa; bf16* sb;
    __device__ __forceinline__ void operator()(const pg8::f32x4 (&acc)[2][2][4][2], const pg8::Unit& u, int wr, int wc, int fr, int fq) const {
        bf16* base = (u.pn < 4 ? sa : sb) + (u.pn & 3) * 256 + wc * 32 + 8 * fq;
#pragma unroll
        for (int ai = 0; ai < 2; ++ai)
#pragma unroll
            for (int m = 0; m < 4; ++m) { const int t = u.pm * 256 + ai * 128 + wr * 64 + m * 16 + fr;
#pragma unroll
                for (int bj = 0; bj < 2; ++bj) { pg8::f32x4 a, c;
#pragma unroll
                    for (int e = 0; e < 4; ++e) { a[e] = sigmoidf_(acc[ai][bj][m][0][e]); c[e] = sigmoidf_(acc[ai][bj][m][1][e]); }
                    *(pg8::u32x4*)(base + (size_t)t * 1024 + bj * 128) = EpiInA::pack8(a, c); } }
    }
};
__device__ __forceinline__ void phase_inA(const P& p, char* smem) {
    pg8::DenseSched S; S.init(p.u, p.Wt_in, p.T, 3072, 1024, 1024);
    EpiInA E{p};
    pg8::gemm_phase<EpiInA, pg8::DenseSched, true, false>((PG8_LAS unsigned char*)smem, 1024, 1024, 1024, S, E);
}
__device__ __forceinline__ void phase_inB(const P& p, char* smem) {
    pg8::DenseSched S; S.init(p.u, p.Wt_in + (size_t)3072 * 1024, p.T, 2048, 1024, 1024);
    EpiSig E{p.sa, p.sb};
    pg8::gemm_phase<EpiSig, pg8::DenseSched, true, false>((PG8_LAS unsigned char*)smem, 1024, 1024, 1024, S, E);
}

struct EpiProj {
    static constexpr bool PERM = true, CHAIN = false;
    const bf16* g; bf16* mixed; int pass;
    __device__ __forceinline__ void operator()(const pg8::f32x4 (&acc)[2][2][4][2], const pg8::Unit& u, int wr, int wc, int fr, int fq) const {
        const int col0 = u.pn * 256 + wc * 32 + 8 * fq;
#pragma unroll
        for (int ai = 0; ai < 2; ++ai)
#pragma unroll
            for (int m = 0; m < 4; ++m) { const size_t t = (size_t)(u.pm * 256 + ai * 128 + wr * 64 + m * 16 + fr);
#pragma unroll
                for (int bj = 0; bj < 2; ++bj) { const size_t off = t * 1024 + col0 + bj * 128;
                    const uint4 gv = *(const uint4*)(g + off); const unsigned gw[4] = {gv.x, gv.y, gv.z, gv.w};
                    float r[8];
#pragma unroll
                    for (int e = 0; e < 4; ++e) { const float a = e < 2 ? acc[ai][bj][m][0][2 * e] : acc[ai][bj][m][1][2 * e - 4], b = e < 2 ? acc[ai][bj][m][0][2 * e + 1] : acc[ai][bj][m][1][2 * e - 3];
                        r[2 * e] = __uint_as_float(gw[e] << 16) * a; r[2 * e + 1] = __uint_as_float(gw[e] & 0xffff0000u) * b; }
                    if (pass) { const uint4 mv = *(const uint4*)(mixed + off); const unsigned mw[4] = {mv.x, mv.y, mv.z, mv.w};
#pragma unroll
                        for (int e = 0; e < 4; ++e) { r[2 * e] += __uint_as_float(mw[e] << 16); r[2 * e + 1] += __uint_as_float(mw[e] & 0xffff0000u); } }
                    uint4 o; o.x = pk2(r[0], r[1]); o.y = pk2(r[2], r[3]); o.z = pk2(r[4], r[5]); o.w = pk2(r[6], r[7]);
                    *(uint4*)(mixed + off) = o; } }
    }
};
struct EpiOut {
    static constexpr bool PERM = true, CHAIN = false;
    const float* x; bf16* h1b;
    __device__ __forceinline__ void operator()(const pg8::f32x4 (&acc)[2][2][4][2], const pg8::Unit& u, int wr, int wc, int fr, int fq) const {
        const int col0 = u.pn * 256 + wc * 32 + 8 * fq;
#pragma unroll
        for (int ai = 0; ai < 2; ++ai)
#pragma unroll
            for (int m = 0; m < 4; ++m) { const size_t off = (size_t)(u.pm * 256 + ai * 128 + wr * 64 + m * 16 + fr) * 1024 + col0;
#pragma unroll
                for (int bj = 0; bj < 2; ++bj) { const pg8::f32x4 x0 = *(const pg8::f32x4*)(x + off + bj * 128), x1 = *(const pg8::f32x4*)(x + off + bj * 128 + 4);
                    *(pg8::u32x4*)(h1b + off + bj * 128) = EpiInA::pack8(x0 + acc[ai][bj][m][0], x1 + acc[ai][bj][m][1]); } }
    }
};
struct ProjSched {
    pg8::TileOrder o; const char *A0, *A1, *B0, *B1;
    __device__ __forceinline__ bool next(int i, pg8::Unit& u) const {
        if (!o.next(i >> 1, u.pm, u.pn)) return false;
        const int part = i & 1; u.tag = part;
        u.A = (part ? A1 : A0) + (size_t)u.pm * 256 * 512 * 2; u.B = (part ? B1 : B0) + (size_t)u.pn * 256 * 512 * 2; return true;
    }
    __device__ __forceinline__ unsigned arow(const pg8::Unit&, int r) const { return (unsigned)r * 1024u; }
    __device__ __forceinline__ void a_ready(const pg8::Unit&) const {}
    __device__ __forceinline__ void done(const pg8::Unit&) const {}
};
struct EpiProj2 {
    static constexpr bool PERM = true, CHAIN = true;
    const bf16* sa; const bf16* sb; bf16* mixed;
    __device__ __forceinline__ void operator()(const pg8::f32x4 (&acc_)[2][2][4][2], const pg8::Unit& u, int wr, int wc, int fr, int fq) const {
        pg8::f32x4 (&acc)[2][2][4][2] = const_cast<pg8::f32x4 (&)[2][2][4][2]>(acc_);
        const int col0 = u.pn * 256 + wc * 32 + 8 * fq;
#pragma unroll
        for (int ai = 0; ai < 2; ++ai)
#pragma unroll
            for (int m = 0; m < 4; ++m) { const size_t t = (size_t)(u.pm * 256 + ai * 128 + wr * 64 + m * 16 + fr);
#pragma unroll
                for (int bj = 0; bj < 2; ++bj) { const size_t off = t * 1024 + col0 + bj * 128;
                    const uint4 bv = *(const uint4*)(sb + off); const unsigned bw[4] = {bv.x, bv.y, bv.z, bv.w};
                    if (u.tag == 0) {
                        const uint4 av = *(const uint4*)(sa + off); const unsigned aw[4] = {av.x, av.y, av.z, av.w};
#pragma unroll
                        for (int e = 0; e < 4; ++e) { const float r0 = __uint_as_float(aw[e] << 16) * __builtin_amdgcn_rcpf(__uint_as_float(bw[e] << 16)), r1 = __uint_as_float(aw[e] & 0xffff0000u) * __builtin_amdgcn_rcpf(__uint_as_float(bw[e] & 0xffff0000u));
                            if (e < 2) { acc[ai][bj][m][0][2 * e] *= r0; acc[ai][bj][m][0][2 * e + 1] *= r1; } else { acc[ai][bj][m][1][2 * e - 4] *= r0; acc[ai][bj][m][1][2 * e - 3] *= r1; } }
                    } else {
                        float r[8];
#pragma unroll
                        for (int e = 0; e < 4; ++e) { const float a = e < 2 ? acc[ai][bj][m][0][2 * e] : acc[ai][bj][m][1][2 * e - 4], b = e < 2 ? acc[ai][bj][m][0][2 * e + 1] : acc[ai][bj][m][1][2 * e - 3];
                            r[2 * e] = __uint_as_float(bw[e] << 16) * a; r[2 * e + 1] = __uint_as_float(bw[e] & 0xffff0000u) * b; }
                        uint4 o; o.x = pk2(r[0], r[1]); o.y = pk2(r[2], r[3]); o.z = pk2(r[4], r[5]); o.w = pk2(r[6], r[7]);
                        *(uint4*)(mixed + off) = o; } } }
    }
};
__device__ __forceinline__ void phase_proj(const P& p, char* smem) {
    ProjSched S; S.o.init(p.T / 256, 4, gridDim.x, blockIdx.x); S.A0 = (const char*)p.onsa; S.A1 = (const char*)p.gla; S.B0 = (const char*)p.Wpn; S.B1 = (const char*)p.Wpg;
    EpiProj2 E{p.sa, p.sb, p.mixed};
    pg8::gemm_phase<EpiProj2, ProjSched, true, false>((PG8_LAS unsigned char*)smem, 512, 512, 512, S, E);
}
__device__ __forceinline__ void phase_out(const P& p, char* smem) {
    pg8::DenseSched S; S.init(p.mixed, p.Wo, p.T, 1024, 1024, 1024); EpiOut E{p.x, p.h1b};
    pg8::gemm_phase<EpiOut, pg8::DenseSched, true, false>((PG8_LAS unsigned char*)smem, 1024, 1024, 1024, S, E);
}

struct ExpertSched {
    const int* ub;
    const int* sb_;
    const unsigned* cnt; const int* list; int T;
    const char* A; const char* B; int lda, ldb; size_t bstride;
    int npn, G, c; bool gather;
    int r1;
    unsigned* ready; int role;
    __device__ __forceinline__ bool next(int i, pg8::Unit& u) const {
        int L = i * G + c;
        if (role == 2 && r1 > 0) { const int nl = G - r1, period = 2 * nl + r1;
            L = (c < r1) ? i * period + 2 * nl + c : (i >> 1) * period + (i & 1) * nl + (c - r1); }
        if (L >= ub[NEXP]) return false;
        int e = 0; while (L >= ub[e + 1]) ++e;
        const int rem = L - ub[e], tiles = (ub[e + 1] - ub[e]) / npn, pn = rem / tiles, pml = rem % tiles;
        u.pm = sb_[e] / 256 + pml; u.pn = pn; u.tag = e | (pml << 8);
        u.A = gather ? A : A + (size_t)u.pm * 256 * lda * 2; u.B = B + (size_t)e * bstride + (size_t)pn * 256 * ldb * 2; return true;
    }
    __device__ __forceinline__ unsigned arow(const pg8::Unit& u, int r) const {
        const int e = u.tag & 255, sl = (u.tag >> 8) * 256 + r; const int tok = list[(size_t)e * T + (sl < (int)cnt[e * 32] ? sl : 0)];
        return (unsigned)tok * (unsigned)lda * 2u;
    }
    __device__ __forceinline__ void a_ready(const pg8::Unit& u) const {
        if (role != 2) return;
        if (TIDX() < 64) { unsigned spins = 0;
            while ((unsigned)__builtin_amdgcn_readfirstlane((int)__hip_atomic_load(ready + u.pm, __ATOMIC_RELAXED, __HIP_MEMORY_SCOPE_AGENT)) < 32u) { __builtin_amdgcn_s_sleep(2); if (++spins > (1u << 22)) break; }
            __builtin_amdgcn_fence(__ATOMIC_ACQUIRE, "agent");
            asm volatile("s_waitcnt vmcnt(0)" ::: "memory"); }
        asm volatile("" ::: "memory"); __builtin_amdgcn_s_barrier(); asm volatile("" ::: "memory");
    }
    __device__ __forceinline__ void done(const pg8::Unit& u) const {
        if (role != 1) return;
        asm volatile("s_waitcnt vmcnt(0)" ::: "memory");
        if ((TIDX() & 63) == 0) __hip_atomic_fetch_add(ready + u.pm, 1u, __ATOMIC_RELAXED, __HIP_MEMORY_SCOPE_AGENT);
    }
};
__device__ __forceinline__ void expert_tables(const P& p, char* smem, int npn, int*& ub, int*& sb_) {
    ub = (int*)(smem + LDS_MISC + 1024); sb_ = ub + 40;
    __syncthreads();
    if (TIDX() == 0) { int ua = 0, sa = 0; for (int e = 0; e < NEXP; ++e) { ub[e] = ua; sb_[e] = sa; const int tl = ((int)p.ctl[e * 32] + 255) >> 8; ua += tl * npn; sa += tl * 256; } ub[NEXP] = ua; sb_[NEXP] = sa; }
    __syncthreads();
}
struct EpiMoe1 {
    static constexpr bool PERM = true, CHAIN = false;
    __amdgpu_buffer_rsrc_t rsrc;
    __device__ __forceinline__ void operator()(const pg8::f32x4 (&acc)[2][2][4][2], const pg8::Unit& u, int wr, int wc, int fr, int fq) const {
        const int col0 = u.pn * 128 + wc * 32 + 8 * fq;
#pragma unroll
        for (int ai = 0; ai < 2; ++ai)
#pragma unroll
            for (int m = 0; m < 4; ++m) { const size_t row = (size_t)(u.pm * 256 + ai * 128 + wr * 64 + m * 16 + fr);
                pg8::f32x4 a, b;
#pragma unroll
                for (int e = 0; e < 4; ++e) { a[e] = siluf_(acc[ai][0][m][0][e]) * acc[ai][1][m][0][e]; b[e] = siluf_(acc[ai][0][m][1][e]) * acc[ai][1][m][1][e]; }
                __builtin_amdgcn_raw_buffer_store_b128(EpiInA::pack8(a, b), rsrc, (unsigned)((row * 512 + col0) * 2), 0, 16  ); }
    }
};
struct EpiMoe2 {
    static constexpr bool PERM = true, CHAIN = false;
    bf16* Y;
    __device__ __forceinline__ void operator()(const pg8::f32x4 (&acc)[2][2][4][2], const pg8::Unit& u, int wr, int wc, int fr, int fq) const {
        const int col0 = u.pn * 256 + wc * 32 + 8 * fq;
#pragma unroll
        for (int ai = 0; ai < 2; ++ai)
#pragma unroll
            for (int m = 0; m < 4; ++m) { const size_t row = (size_t)(u.pm * 256 + ai * 128 + wr * 64 + m * 16 + fr);
#pragma unroll
                for (int bj = 0; bj < 2; ++bj) *(pg8::u32x4*)(Y + row * 1024 + col0 + bj * 128) = EpiInA::pack8(acc[ai][bj][m][0], acc[ai][bj][m][1]); }
    }
};
__device__ __forceinline__ void phase_moe12(const P& p, char* smem) {
    int *ub, *sb_; expert_tables(p, smem, 4, ub, sb_);
    unsigned* ready = p.ctl + 3072;
    { ExpertSched S{ub, sb_, p.ctl, p.list, p.T, (const char*)p.vb, (const char*)p.Wgu, 1024, 1024, (size_t)1024 * 1024 * 2, 4, (int)gridDim.x, (int)blockIdx.x, true, 0, ready, 1};
      EpiMoe1 E{__builtin_amdgcn_make_buffer_rsrc((void*)p.H, 0, (int)((2 * (size_t)p.T + NEXP * 256) * 512 * 2), 0x00020000)};
      pg8::gemm_phase<EpiMoe1, ExpertSched, true, true>((PG8_LAS unsigned char*)smem, 1024, 1024, 1024, S, E); }
    { const int G = (int)gridDim.x, r1 = (ub[NEXP] % G);
      ExpertSched S{ub, sb_, p.ctl, p.list, p.T, (const char*)p.H, (const char*)p.Wd, 512, 512, (size_t)1024 * 512 * 2, 4, G, (int)blockIdx.x, false, r1, ready, 2};
      EpiMoe2 E{p.Y};
      pg8::gemm_phase<EpiMoe2, ExpertSched, true, false>((PG8_LAS unsigned char*)smem, 512, 512, 512, S, E); }
}

namespace nsa {
using f32x16 = __attribute__((ext_vector_type(16))) float;
using bf16x8 = __attribute__((ext_vector_type(8))) short;
using s16x4 = __attribute__((ext_vector_type(4))) short;
using u32x4 = __attribute__((ext_vector_type(4))) unsigned;
typedef __attribute__((address_space(3))) char* lptr;
typedef __attribute__((address_space(3))) const char* lcptr;
constexpr int SLOT = 8192;
constexpr int NSLOT = 3;
constexpr int L_K = 0, L_V = NSLOT * SLOT, L_WS = 2 * NSLOT * SLOT, L_OST = L_WS + 8 * 512, L_IMPD = L_OST + 8 * 4096, L_IMPC = L_IMPD + 64 * 64 * 4, L_SEL = L_IMPC + 64 * 68 * 4, L_END = L_SEL + 64 * 8;
constexpr float LOG2E = 1.4426950408889634f, NEGM = -1e30f, M0 = -1e20f, THR = 8.f;
__device__ __forceinline__ int crow(int r, int hi) { return (r & 3) + 8 * (r >> 2) + 4 * hi; }
__device__ __forceinline__ void glds16(const void* gsrc, unsigned lds_dst) { unsigned keep;
    asm volatile("s_mov_b32 %0, m0\n\ts_mov_b32 m0, %2\n\ts_nop 0\n\tglobal_load_lds_dwordx4 %1, off\n\ts_mov_b32 m0, %0" : "=&s"(keep) : "v"(gsrc), "s"(lds_dst) : "memory"); }
#define NSA_WAIT_BAR() asm volatile("s_waitcnt vmcnt(2) lgkmcnt(0)\n\ts_barrier" ::: "memory")
#define NSA_DRAIN_BAR() asm volatile("s_waitcnt vmcnt(0) lgkmcnt(0)\n\ts_barrier" ::: "memory")
#define NSA_LWAIT() asm volatile("s_waitcnt lgkmcnt(0)" ::: "memory")
__device__ __forceinline__ unsigned cvtpk(float lo, float hi) { typedef float f2 __attribute__((ext_vector_type(2))); typedef __bf16 b2 __attribute__((ext_vector_type(2))); f2 v = {lo, hi}; b2 b = __builtin_convertvector(v, b2); return __builtin_bit_cast(unsigned, b); }
__device__ __forceinline__ float xhalf_max(float m) { auto rr = __builtin_amdgcn_permlane32_swap(__float_as_uint(m), __float_as_uint(m), false, false); return fmaxf(__uint_as_float(rr[0]), __uint_as_float(rr[1])); }
__device__ __forceinline__ float xhalf_sum(float m) { auto rr = __builtin_amdgcn_permlane32_swap(__float_as_uint(m), __float_as_uint(m), false, false); return __uint_as_float(rr[0]) + __uint_as_float(rr[1]); }
__device__ __forceinline__ void qkt(f32x16& p0, f32x16& p1, lcptr Kslot, const bf16x8* qr, int r32, int hi) {
    lcptr kb = Kslot + hi * 1024 + r32 * 16;
    p0 = f32x16{}; p1 = f32x16{};
#pragma unroll
    for (int d0 = 0; d0 < 4; ++d0) {
        const bf16x8 b0 = *(const __attribute__((address_space(3))) bf16x8*)(kb + d0 * 2048);
        const bf16x8 b1 = *(const __attribute__((address_space(3))) bf16x8*)(kb + d0 * 2048 + 512);
        p0 = __builtin_amdgcn_mfma_f32_32x32x16_bf16(b0, qr[d0], p0, 0, 0, 0); p1 = __builtin_amdgcn_mfma_f32_32x32x16_bf16(b1, qr[d0], p1, 0, 0, 0); }
}
__device__ __forceinline__ void pv(f32x16* o, int vb, bf16x8 pa0, bf16x8 pa1, bf16x8 pa2, bf16x8 pa3) {
#pragma unroll
    for (int d0 = 0; d0 < 2; ++d0) { s16x4 lo[4], hi[4];
#pragma unroll
        for (int ks = 0; ks < 4; ++ks) {
            asm volatile("ds_read_b64_tr_b16 %0,%1 offset:%c2" : "=&v"(lo[ks]) : "v"(vb), "i"(d0 * 4096 + ks * 1024) : "memory");
            asm volatile("ds_read_b64_tr_b16 %0,%1 offset:%c2" : "=&v"(hi[ks]) : "v"(vb), "i"(d0 * 4096 + ks * 1024 + 512) : "memory"); }
        asm volatile("s_waitcnt lgkmcnt(0)" ::: "memory"); __builtin_amdgcn_sched_barrier(0);
#define NSA_PK(k) (bf16x8){lo[k][0], lo[k][1], lo[k][2], lo[k][3], hi[k][0], hi[k][1], hi[k][2], hi[k][3]}
        o[d0] = __builtin_amdgcn_mfma_f32_32x32x16_bf16(pa0, NSA_PK(0), o[d0], 0, 0, 0);
        o[d0] = __builtin_amdgcn_mfma_f32_32x32x16_bf16(pa1, NSA_PK(1), o[d0], 0, 0, 0);
        o[d0] = __builtin_amdgcn_mfma_f32_32x32x16_bf16(pa2, NSA_PK(2), o[d0], 0, 0, 0);
        o[d0] = __builtin_amdgcn_mfma_f32_32x32x16_bf16(pa3, NSA_PK(3), o[d0], 0, 0, 0);
#undef NSA_PK
    }
}
__device__ __forceinline__ float rowmax32(const f32x16& p0, const f32x16& p1) {
    float a = fmaxf(p0[0], p1[0]);
#pragma unroll
    for (int r = 1; r < 16; ++r) a = fmaxf(a, fmaxf(p0[r], p1[r]));
    return xhalf_max(a);
}
struct Ctx {
    int w, lane, r32, hi, rs; unsigned lds0; lptr shm; const bf16* kt; const bf16* vt;
};
__device__ __forceinline__ void dma_kv(const Ctx& c, int tile, int slot) {
    const bf16* ksrc = c.kt + (size_t)tile * 64 * 64 + c.lane * 64 + c.w * 8;
    const bf16* vsrc = c.vt + (size_t)tile * 64 * 64 + (16 * (c.w & 3) + (c.lane >> 2)) * 64 + (c.w >> 2) * 32 + (c.lane & 3) * 8;
    glds16(ksrc, (unsigned)__builtin_amdgcn_readfirstlane(c.lds0 + L_K + slot * SLOT + c.w * 1024));
    glds16(vsrc, (unsigned)__builtin_amdgcn_readfirstlane(c.lds0 + L_V + slot * SLOT + c.w * 1024));
}
template <int ABL = 0> __device__ __forceinline__ void ring_begin(Ctx& c, int t0, int t1) { NSA_DRAIN_BAR(); if (!(ABL & 8)) { dma_kv(c, t0, 0); dma_kv(c, t1 >= 0 ? t1 : t0, 1); } c.rs = 0; }
template <int ABL = 0> __device__ __forceinline__ void ring_step(Ctx& c, int t2, int tcur) { if (!(ABL & 16)) NSA_WAIT_BAR(); int s2 = c.rs + 2; if (s2 >= NSLOT) s2 -= NSLOT; if (!(ABL & 8)) dma_kv(c, t2 >= 0 ? t2 : tcur, s2); }
__device__ __forceinline__ void ring_next(Ctx& c) { c.rs = (c.rs == NSLOT - 1) ? 0 : c.rs + 1; }
template <int ABL> __device__ __forceinline__ void softmax_pv(const Ctx& c, f32x16& p0, f32x16& p1, f32x16* o, float& m, float& l, int slot, bool on) {
    float a0 = fmaxf(fmaxf(p0[0], p0[1]), p1[0]), a1 = fmaxf(fmaxf(p0[2], p0[3]), p1[1]), a2 = fmaxf(fmaxf(p0[4], p0[5]), p1[2]), a3 = fmaxf(fmaxf(p0[6], p0[7]), p1[3]);
    a0 = fmaxf(fmaxf(a0, p0[8]), p0[9]); a1 = fmaxf(fmaxf(a1, p0[10]), p0[11]); a2 = fmaxf(fmaxf(a2, p0[12]), p0[13]); a3 = fmaxf(fmaxf(a3, p0[14]), p0[15]);
    a0 = fmaxf(fmaxf(a0, p1[4]), p1[5]); a1 = fmaxf(fmaxf(a1, p1[6]), p1[7]); a2 = fmaxf(fmaxf(a2, p1[8]), p1[9]); a3 = fmaxf(fmaxf(a3, p1[10]), p1[11]);
    a0 = fmaxf(fmaxf(a0, p1[12]), p1[13]); a1 = fmaxf(fmaxf(a1, p1[14]), p1[15]);
    float rm = xhalf_max(fmaxf(fmaxf(a0, a1), fmaxf(a2, a3)));
    rm = on ? rm : NEGM;
    volatile __attribute__((address_space(3))) float* wsf = (volatile __attribute__((address_space(3))) float*)(c.shm + L_WS + c.w * 512);
    bool resc = false;
    if (__any(rm > m + THR)) { const float mn = fmaxf(m, rm); const float f = __builtin_amdgcn_exp2f(m - mn); l *= f; m = mn; if (c.hi == 0) wsf[c.r32] = f; resc = true; }
    const float ms = on ? m : 1e30f;
    float s0 = 0.f, s1 = 0.f, s2 = 0.f, s3 = 0.f;
#pragma unroll
    for (int r = 0; r < 16; r += 2) {
        if (!(ABL & 2)) { p0[r] = __builtin_amdgcn_exp2f(p0[r] - ms); p0[r + 1] = __builtin_amdgcn_exp2f(p0[r + 1] - ms); p1[r] = __builtin_amdgcn_exp2f(p1[r] - ms); p1[r + 1] = __builtin_amdgcn_exp2f(p1[r + 1] - ms); }
        else { p0[r] -= ms; p0[r + 1] -= ms; p1[r] -= ms; p1[r + 1] -= ms; }
        s0 += p0[r]; s1 += p0[r + 1]; s2 += p1[r]; s3 += p1[r + 1]; }
    l += (s0 + s1) + (s2 + s3);
    if (resc) { NSA_LWAIT();
#pragma unroll
        for (int r = 0; r < 16; ++r) { const float f = wsf[crow(r, c.hi)]; o[0][r] *= f; o[1][r] *= f; } }
    u32x4 w0, w1, w2, w3;
    w0 = (u32x4){cvtpk(p0[0], p0[1]), cvtpk(p0[2], p0[3]), cvtpk(p0[4], p0[5]), cvtpk(p0[6], p0[7])};
    w1 = (u32x4){cvtpk(p0[8], p0[9]), cvtpk(p0[10], p0[11]), cvtpk(p0[12], p0[13]), cvtpk(p0[14], p0[15])};
    w2 = (u32x4){cvtpk(p1[0], p1[1]), cvtpk(p1[2], p1[3]), cvtpk(p1[4], p1[5]), cvtpk(p1[6], p1[7])};
    w3 = (u32x4){cvtpk(p1[8], p1[9]), cvtpk(p1[10], p1[11]), cvtpk(p1[12], p1[13]), cvtpk(p1[14], p1[15])};
    const int vb = (int)(c.lds0 + L_V + slot * SLOT) + ((c.lane >> 4) & 1) * 32 + (c.lane & 3) * 8 + (4 * c.hi + ((c.lane & 15) >> 2)) * 64;
    if (!(ABL & 1)) pv(o, vb, __builtin_bit_cast(bf16x8, w0), __builtin_bit_cast(bf16x8, w1), __builtin_bit_cast(bf16x8, w2), __builtin_bit_cast(bf16x8, w3));
    else { asm volatile("" :: "v"(w0), "v"(w1), "v"(w2), "v"(w3)); }
}
__device__ __forceinline__ void accum_branch(const Ctx& c, f32x16* oacc, const f32x16* o, float fac) {
    volatile __attribute__((address_space(3))) float* wsf = (volatile __attribute__((address_space(3))) float*)(c.shm + L_WS + c.w * 512);
    NSA_LWAIT(); if (c.hi == 0) wsf[64 + c.r32] = fac; NSA_LWAIT();
#pragma unroll
    for (int r = 0; r < 16; ++r) { const float f = wsf[64 + crow(r, c.hi)]; oacc[0][r] += o[0][r] * f; oacc[1][r] += o[1][r] * f; }
    NSA_LWAIT();
}
template <int ABL> __device__ __forceinline__ void nsa_unit(const P& p, char* smem, int b, int g, int jq) {
    const int tid = TIDX(); Ctx c; c.lane = tid & 63; c.w = __builtin_amdgcn_readfirstlane(tid >> 6); c.r32 = c.lane & 31; c.hi = c.lane >> 5;
    c.shm = (lptr)smem; c.lds0 = (unsigned)(size_t)c.shm;
    const int hh = c.r32 >> 3, tokl = 8 * c.w + (c.r32 & 7), stok = 64 * jq + tokl, h = g * 4 + hh; const size_t t = (size_t)b * S + stok;
    const size_t seg = kvseg(p), ho = (size_t)(b * 2 + g) * S * 64;
    bf16x8 qr[4];
#pragma unroll
    for (int d0 = 0; d0 < 4; ++d0) { const u32x4 raw = *(const u32x4*)(p.q + t * 512 + h * 64 + d0 * 16 + c.hi * 8); u32x4 sc;
#pragma unroll
        for (int e4 = 0; e4 < 4; ++e4) sc[e4] = cvtpk(__uint_as_float(raw[e4] << 16) * LOG2E, __uint_as_float(raw[e4] & 0xffff0000u) * LOG2E);
        qr[d0] = __builtin_bit_cast(bf16x8, sc); }
    const float g0 = p.gates[t * 24 + h * 3], g1 = p.gates[t * 24 + h * 3 + 1], g2 = p.gates[t * 24 + h * 3 + 2];
    f32x16 oacc[2], o[2], p0, p1; oacc[0] = f32x16{}; oacc[1] = f32x16{};
    __attribute__((address_space(3))) float* impD = (__attribute__((address_space(3))) float*)(c.shm + L_IMPD);
    __attribute__((address_space(3))) float* impC = (__attribute__((address_space(3))) float*)(c.shm + L_IMPC);
    __attribute__((address_space(3))) u64* selm = (__attribute__((address_space(3))) u64*)(c.shm + L_SEL);
    const int nv = stok >= 31 ? (stok - 31) / 16 + 1 : 0;
    const int nct = (4 * jq + 3 + 63) >> 6;
    c.kt = p.kcmp + (size_t)(b * 2 + g) * 256 * 64; c.vt = p.vcmp + (size_t)(b * 2 + g) * 256 * 64;
    float m = M0, l = 0.f;
    if (tid < 64) impC[tid * 68] = 0.f;
    ring_begin(c, 0, nct > 1 ? 1 : -1);
    for (int ct = 0; ct < ((ABL & 64) ? 0 : nct); ++ct) {
        ring_step(c, ct + 2 < nct ? ct + 2 : -1, ct);
        qkt(p0, p1, (lcptr)(c.shm + L_K + c.rs * SLOT), qr, c.r32, c.hi); ring_next(c);
#pragma unroll
        for (int r = 0; r < 16; ++r) { const int n = 64 * ct + crow(r, c.hi); p0[r] = n < nv ? p0[r] : NEGM; p1[r] = n + 32 < nv ? p1[r] : NEGM; }
        const float rm = rowmax32(p0, p1); const float mn = fmaxf(m, rm); float sacc = 0.f;
#pragma unroll
        for (int r = 0; r < 16; ++r) sacc += __builtin_amdgcn_exp2f(p0[r] - mn) + __builtin_amdgcn_exp2f(p1[r] - mn);
        l = l * __builtin_amdgcn_exp2f(m - mn) + sacc; m = mn;
    }
    l = xhalf_sum(l); const float il = l > 0.f ? 1.f / l : 0.f;
    o[0] = f32x16{}; o[1] = f32x16{};
    ring_begin(c, 0, nct > 1 ? 1 : -1);
    for (int ct = 0; ct < ((ABL & 64) ? 0 : nct); ++ct) {
        ring_step(c, ct + 2 < nct ? ct + 2 : -1, ct);
        qkt(p0, p1, (lcptr)(c.shm + L_K + c.rs * SLOT), qr, c.r32, c.hi);
#pragma unroll
        for (int r = 0; r < 16; ++r) { const int n = 64 * ct + crow(r, c.hi); p0[r] = n < nv ? __builtin_amdgcn_exp2f(p0[r] - m) * il : 0.f; p1[r] = n + 32 < nv ? __builtin_amdgcn_exp2f(p1[r] - m) * il : 0.f; }
#pragma unroll
        for (int hb = 0; hb < 2; ++hb)
#pragma unroll
            for (int rg = 0; rg < 4; ++rg) {
                const f32x16& pp = hb ? p1 : p0;
                float dsum = pp[4 * rg] + pp[4 * rg + 1] + pp[4 * rg + 2] + 0.5f * pp[4 * rg + 3], csum = 0.5f * pp[4 * rg + 3];
                dsum += __shfl_xor(dsum, 8); dsum += __shfl_xor(dsum, 16); csum += __shfl_xor(csum, 8); csum += __shfl_xor(csum, 16);
                const int j = 16 * ct + 8 * hb + 2 * rg + c.hi;
                if (c.r32 < 8) { impD[tokl * 64 + j] = dsum; impC[tokl * 68 + j + 1] = csum; }
            }
        u32x4 w0, w1, w2, w3;
        w0 = (u32x4){cvtpk(p0[0], p0[1]), cvtpk(p0[2], p0[3]), cvtpk(p0[4], p0[5]), cvtpk(p0[6], p0[7])};
        w1 = (u32x4){cvtpk(p0[8], p0[9]), cvtpk(p0[10], p0[11]), cvtpk(p0[12], p0[13]), cvtpk(p0[14], p0[15])};
        w2 = (u32x4){cvtpk(p1[0], p1[1]), cvtpk(p1[2], p1[3]), cvtpk(p1[4], p1[5]), cvtpk(p1[6], p1[7])};
        w3 = (u32x4){cvtpk(p1[8], p1[9]), cvtpk(p1[10], p1[11]), cvtpk(p1[12], p1[13]), cvtpk(p1[14], p1[15])};
        const int vb = (int)(c.lds0 + L_V + c.rs * SLOT) + ((c.lane >> 4) & 1) * 32 + (c.lane & 3) * 8 + (4 * c.hi + ((c.lane & 15) >> 2)) * 64;
        pv(o, vb, __builtin_bit_cast(bf16x8, w0), __builtin_bit_cast(bf16x8, w1), __builtin_bit_cast(bf16x8, w2), __builtin_bit_cast(bf16x8, w3));
        ring_next(c);
    }
    accum_branch(c, oacc, o, g0);
    NSA_LWAIT(); __builtin_amdgcn_s_barrier();
    {
#pragma unroll 1
        for (int tkk = 0; tkk < 8; ++tkk) { const int tk = 8 * c.w + tkk, j = c.lane; const bool valid = j <= jq;
            const float sc = (j == 0 || j == jq || j == jq - 1) ? 1e4f : impD[tk * 64 + j] + impC[tk * 68 + j];
            const unsigned key = valid ? ((__float_as_uint(sc) & ~63u) | (unsigned)(63 - j)) : 0u;
            int rank = 0;
            if (!(ABL & 32)) {
#pragma unroll
                for (int i = 0; i < 64; ++i) { const unsigned ki = (unsigned)__builtin_amdgcn_readlane((int)key, i); rank += (ki > key) ? 1 : 0; } }
            const u64 mk = __ballot(valid && rank < 16);
            if (j == 0) { selm[tk] = mk; p.sel[((size_t)b * S + 64 * jq + tk) * 2 + g] = mk; } }
    }
    NSA_LWAIT(); __builtin_amdgcn_s_barrier();
    const u64 mysel = selm[tokl];
    u64 uni = selm[c.lane];
#pragma unroll
    for (int x = 1; x < 64; x <<= 1) { const unsigned lo_ = __shfl_xor((unsigned)uni, x), hi_ = __shfl_xor((unsigned)(uni >> 32), x); uni |= (u64)lo_ | ((u64)hi_ << 32); }
    const unsigned ulo = __builtin_amdgcn_readfirstlane((unsigned)uni), uhi = __builtin_amdgcn_readfirstlane((unsigned)(uni >> 32));
    {
        c.kt = p.kv6 + 2 * seg + ho; c.vt = p.kv6 + 3 * seg + ho;
        u64 rem = (u64)ulo | ((u64)uhi << 32);
        m = M0; l = 0.f; o[0] = f32x16{}; o[1] = f32x16{};
        int j = __builtin_ctzll(rem); rem &= rem - 1;
        int j1 = rem ? __builtin_ctzll(rem) : -1; if (rem) rem &= rem - 1;
        ring_begin<ABL>(c, j, j1);
        for (;;) {
            const int j2 = rem ? __builtin_ctzll(rem) : -1; if (rem) rem &= rem - 1;
            ring_step<ABL>(c, j2, j);
            if (!(ABL & 4)) qkt(p0, p1, (lcptr)(c.shm + L_K + c.rs * SLOT), qr, c.r32, c.hi); else { asm volatile("" : "+v"(p0), "+v"(p1)); }
            const bool on = (mysel >> j) & 1ull;
            if (j == jq) {
#pragma unroll
                for (int r = 0; r < 16; ++r) { const int kr = crow(r, c.hi); p0[r] = (kr <= tokl) ? p0[r] : NEGM; p1[r] = (kr + 32 <= tokl) ? p1[r] : NEGM; } }
            softmax_pv<ABL>(c, p0, p1, o, m, l, c.rs, on); ring_next(c);
            if (j1 < 0) break; j = j1; j1 = j2;
        }
        l = xhalf_sum(l);
        accum_branch(c, oacc, o, g1 / l);
    }
    {
        c.kt = p.kv6 + 4 * seg + ho; c.vt = p.kv6 + 5 * seg + ho;
        const int j0 = jq >= 8 ? jq - 8 : 0;
        m = M0; l = 0.f; o[0] = f32x16{}; o[1] = f32x16{};
        ring_begin<ABL>(c, j0, j0 + 1 <= jq ? j0 + 1 : -1);
        for (int j = j0; j <= jq; ++j) {
            ring_step<ABL>(c, j + 2 <= jq ? j + 2 : -1, j);
            if (!(ABL & 4)) qkt(p0, p1, (lcptr)(c.shm + L_K + c.rs * SLOT), qr, c.r32, c.hi); else { asm volatile("" : "+v"(p0), "+v"(p1)); }
            const bool lowt = (jq >= 8 && j == jq - 8), diag = (j == jq);
            if (diag || lowt) {
#pragma unroll
                for (int r = 0; r < 16; ++r) { const int kr = crow(r, c.hi);
                    const bool v0 = diag ? (kr <= tokl) : (kr > tokl), v1 = diag ? (kr + 32 <= tokl) : (kr + 32 > tokl);
                    p0[r] = v0 ? p0[r] : NEGM; p1[r] = v1 ? p1[r] : NEGM; } }
            softmax_pv<ABL>(c, p0, p1, o, m, l, c.rs, true); ring_next(c);
        }
        l = xhalf_sum(l);
        accum_branch(c, oacc, o, g2 / l);
    }
    {
        __attribute__((address_space(3))) bf16* stg = (__attribute__((address_space(3))) bf16*)(c.shm + L_OST + c.w * 4096);
#pragma unroll
        for (int r = 0; r < 16; ++r) { const int orow = crow(r, c.hi);
#pragma unroll
            for (int d0 = 0; d0 < 2; ++d0) stg[orow * 64 + d0 * 32 + c.r32] = f2bf(oacc[d0][r]); }
        NSA_LWAIT();
#pragma unroll
        for (int i = 0; i < 4; ++i) { const int row = i * 8 + (c.lane >> 3), ch = c.lane & 7; const u32x4 v = *(const __attribute__((address_space(3))) u32x4*)(stg + row * 64 + ch * 8);
            const int rh = row >> 3, rt = 8 * c.w + (row & 7);
            *(u32x4*)(p.onsa + ((size_t)b * S + 64 * jq + rt) * 512 + (g * 4 + rh) * 64 + ch * 8) = v; }
    }
    NSA_DRAIN_BAR();
}
}
template <int ABL = 0> __device__ __forceinline__ void phase_nsa(const P& p, char* smem) {
    const int nunits = p.nb * 2 * 64;
    const int G = gridDim.x; int r = 0;
    for (int base = 0; base < nunits; base += G, ++r) {
        const int w = (r & 1) ? G - 1 - (int)blockIdx.x : (int)blockIdx.x, i = base + w; if (i >= nunits) continue;
        const int jq = 63 - i / (p.nb * 2), bg = i % (p.nb * 2); nsa::nsa_unit<ABL>(p, smem, bg >> 1, bg & 1, jq); }
}

namespace gla {
using nsa::f32x16; using nsa::bf16x8; using nsa::s16x4; using nsa::u32x4; using nsa::lptr; using nsa::lcptr; using nsa::crow; using nsa::cvtpk;
typedef unsigned u32x2 __attribute__((ext_vector_type(2)));
constexpr int L_KI = 0, L_QI = 8192, L_VI = 16384, L_SI = 32768, L_OST = 49152, L_TOT = L_OST + 64 * 132 * 4, L_END = L_TOT + 8 * 64 * 4 + 64 * 4;
__device__ __forceinline__ int koff(int row, int d) { return (d >> 3) * 1024 + row * 16 + (d & 7) * 2; }
__device__ __forceinline__ int voff(int row, int col) { return ((col >> 5) * 4 + (row >> 4)) * 1024 + (row & 15) * 64 + (col & 31) * 2; }
__device__ __forceinline__ bf16x8 trfrag(unsigned img, int ks, int cb, int lane) {
    const int hi = lane >> 5; const unsigned a = img + (cb * 4 + ks) * 1024 + ((lane >> 4) & 1) * 32 + (lane & 3) * 8 + (4 * hi + ((lane & 15) >> 2)) * 64;
    s16x4 lo, hh;
    asm volatile("ds_read_b64_tr_b16 %0,%1" : "=&v"(lo) : "v"(a) : "memory");
    asm volatile("ds_read_b64_tr_b16 %0,%1 offset:512" : "=&v"(hh) : "v"(a) : "memory");
    asm volatile("s_waitcnt lgkmcnt(0)" ::: "memory"); __builtin_amdgcn_sched_barrier(0);
    return (bf16x8){lo[0], lo[1], lo[2], lo[3], hh[0], hh[1], hh[2], hh[3]};
}
template <int GM> __device__ __forceinline__ void chunk_images(const P& p, lptr shm, int b, int h, int c, int tid) {
    const int d = tid & 63, tg = tid >> 6; const size_t t0 = (size_t)b * S + c * 64;
    bf16 kraw[8], qraw[8];
#pragma unroll
    for (int i = 0; i < 8; ++i) { kraw[i] = p.gk[(t0 + tg * 8 + i) * 256 + h * 64 + d]; qraw[i] = GM ? p.gq[(t0 + tg * 8 + i) * 256 + h * 64 + d] : (bf16)0; }
    if (GM == 1) {
        float bbv[8];
#pragma unroll
        for (int i = 0; i < 8; ++i) bbv[i] = p.gb[(t0 + tg * 8 + i) * 256 + h * 64 + d];
#pragma unroll
        for (int k = 0; k < 2; ++k) { const int idx = tid + k * 512, s = idx >> 4, e = (idx & 15) * 8; *(__attribute__((address_space(3))) u32x4*)(shm + L_VI + voff(s, e)) = *(const u32x4*)(p.gv + (t0 + s) * 512 + h * 128 + e); }
#pragma unroll
        for (int i = 0; i < 8; ++i) { const int t = tg * 8 + i; const float bb = bbv[i], kk = bf2f(kraw[i]), qq = bf2f(qraw[i]);
            *(__attribute__((address_space(3))) bf16*)(shm + L_KI + koff(t, d)) = f2bf(kk * __expf(-bb)); *(__attribute__((address_space(3))) bf16*)(shm + L_QI + koff(t, d)) = f2bf(qq * __expf(bb)); }
        __syncthreads();
        return;
    }
    __attribute__((address_space(3))) float* tot = (__attribute__((address_space(3))) float*)(shm + L_TOT);
    float wa[16];
#pragma unroll
    for (int r = 0; r < 16; ++r) wa[r] = p.w_a2[r * 256 + h * 64 + d];
    const float ba = p.b_a[h * 64 + d];
    __attribute__((address_space(3))) float* als = (__attribute__((address_space(3))) float*)(shm + L_OST);
    { const f32x4_t a4 = tid < 256 ? *(const f32x4_t*)(p.alow + t0 * 16 + tid * 4) : (f32x4_t){0.f, 0.f, 0.f, 0.f}; if (tid < 256) *(__attribute__((address_space(3))) f32x4_t*)(als + tid * 4) = a4; }
    __syncthreads();
    float loc[8]; float run = 0.f;
#pragma unroll
    for (int i = 0; i < 8; ++i) { const __attribute__((address_space(3))) float* al = als + (tg * 8 + i) * 16; float z = ba;
#pragma unroll
        for (int r = 0; r < 16; ++r) z += al[r] * wa[r];
        const float ls = fminf(z, 0.f) - log1pf(__expf(-fabsf(z))); run += ls * (1.f / 16.f); loc[i] = run; }
    tot[tg * 64 + d] = run;
#pragma unroll
    for (int k = 0; k < 2; ++k) { const int idx = tid + k * 512, s = idx >> 4, e = (idx & 15) * 8; *(__attribute__((address_space(3))) u32x4*)(shm + L_VI + voff(s, e)) = *(const u32x4*)(p.gv + (t0 + s) * 512 + h * 128 + e); }
    __syncthreads();
    float pre = 0.f, all = 0.f;
#pragma unroll
    for (int g = 0; g < 8; ++g) { const float x = tot[g * 64 + d]; all += x; pre += g < tg ? x : 0.f; }
#pragma unroll
    for (int i = 0; i < 8; ++i) { const int t = tg * 8 + i; const float bb = pre + loc[i]; const float kk = bf2f(kraw[i]);
        p.gb[(t0 + t) * 256 + h * 64 + d] = bb;
        *(__attribute__((address_space(3))) bf16*)(shm + L_KI + voff(t, d)) = f2bf(kk * __expf(all - bb)); }
    if (tg == 0) p.gdec[((size_t)(b * 4 + h) * 64 + c) * 64 + d] = __expf(all);
    __syncthreads();
}
__device__ __forceinline__ void g1_chunk(const P& p, char* smem, int b, int h, int c) {
    const int tid = TIDX(), lane = tid & 63, w = __builtin_amdgcn_readfirstlane(tid >> 6), r32 = lane & 31, hi = lane >> 5;
    lptr shm = (lptr)smem; const unsigned l0 = (unsigned)(size_t)shm;
    chunk_images<0>(p, shm, b, h, c, tid);
    const int db = w & 1, eb = w >> 1; f32x16 acc = f32x16{};
#pragma unroll
    for (int ks = 0; ks < 4; ++ks) { const bf16x8 a = trfrag(l0 + L_KI, ks, db, lane), bq = trfrag(l0 + L_VI, ks, eb, lane); acc = __builtin_amdgcn_mfma_f32_32x32x16_bf16(a, bq, acc, 0, 0, 0); }
    float* U = p.gst + ((size_t)(b * 4 + h) * 64 + c) * (64 * 128);
#pragma unroll
    for (int r = 0; r < 16; ++r) U[(32 * db + crow(r, hi)) * 128 + 32 * eb + r32] = acc[r];
    __syncthreads();
}
__device__ __forceinline__ void g3_chunk(const P& p, char* smem, int b, int h, int c) {
    const int tid = TIDX(), lane = tid & 63, w = __builtin_amdgcn_readfirstlane(tid >> 6), r32 = lane & 31, hi = lane >> 5;
    lptr shm = (lptr)smem; const unsigned l0 = (unsigned)(size_t)shm; const size_t t0 = (size_t)b * S + c * 64;
    const float* St = p.gst + ((size_t)(b * 4 + h) * 64 + c) * (64 * 128);
    float4 sv[4];
#pragma unroll
    for (int k = 0; k < 4; ++k) sv[k] = *(const float4*)(St + (size_t)(tid + k * 512) * 4);
    const size_t go_ = (t0 + (tid >> 3)) * 512 + h * 128 + (tid & 7) * 16;
    const uint4 rs0 = *(const uint4*)(p.rs + go_), rs1 = *(const uint4*)(p.rs + go_ + 8);
    chunk_images<1>(p, shm, b, h, c, tid);
#pragma unroll
    for (int k = 0; k < 4; ++k) { const int idx = (tid + k * 512) * 4, dd = idx >> 7, e = idx & 127; u32x2 o; o.x = cvtpk(sv[k].x, sv[k].y); o.y = cvtpk(sv[k].z, sv[k].w);
        *(__attribute__((address_space(3))) u32x2*)(shm + L_SI + voff(dd, e)) = o; }
    __syncthreads();
    const int tb = w & 1, eb = w >> 1, trow = 32 * tb + r32;
    f32x16 p0 = f32x16{}, p1 = f32x16{}, o = f32x16{};
    {
        lcptr kb = (lcptr)(shm + L_KI) + hi * 1024 + r32 * 16; lcptr qb = (lcptr)(shm + L_QI) + hi * 1024 + trow * 16;
#pragma unroll
        for (int d0 = 0; d0 < 4; ++d0) {
            const bf16x8 b0 = *(const __attribute__((address_space(3))) bf16x8*)(kb + d0 * 2048), b1 = *(const __attribute__((address_space(3))) bf16x8*)(kb + d0 * 2048 + 512);
            const bf16x8 qf = *(const __attribute__((address_space(3))) bf16x8*)(qb + d0 * 2048);
            p0 = __builtin_amdgcn_mfma_f32_32x32x16_bf16(b0, qf, p0, 0, 0, 0); p1 = __builtin_amdgcn_mfma_f32_32x32x16_bf16(b1, qf, p1, 0, 0, 0); }
    }
#pragma unroll
    for (int r = 0; r < 16; ++r) { const int s = crow(r, hi); p0[r] = s <= trow ? p0[r] : 0.f; p1[r] = s + 32 <= trow ? p1[r] : 0.f; }
#pragma unroll
    for (int ds = 0; ds < 4; ++ds) {
        const u32x2 a0 = *(const __attribute__((address_space(3))) u32x2*)(shm + L_QI + (2 * ds) * 1024 + trow * 16 + 8 * hi), a1 = *(const __attribute__((address_space(3))) u32x2*)(shm + L_QI + (2 * ds + 1) * 1024 + trow * 16 + 8 * hi);
        const u32x4 aw = {a0.x, a0.y, a1.x, a1.y};
        const bf16x8 bq = trfrag(l0 + L_SI, ds, eb, lane);
        o = __builtin_amdgcn_mfma_f32_32x32x16_bf16(__builtin_bit_cast(bf16x8, aw), bq, o, 0, 0, 0); }
    {
        const u32x4 w0 = {cvtpk(p0[0], p0[1]), cvtpk(p0[2], p0[3]), cvtpk(p0[4], p0[5]), cvtpk(p0[6], p0[7])}, w1 = {cvtpk(p0[8], p0[9]), cvtpk(p0[10], p0[11]), cvtpk(p0[12], p0[13]), cvtpk(p0[14], p0[15])};
        const u32x4 w2 = {cvtpk(p1[0], p1[1]), cvtpk(p1[2], p1[3]), cvtpk(p1[4], p1[5]), cvtpk(p1[6], p1[7])}, w3 = {cvtpk(p1[8], p1[9]), cvtpk(p1[10], p1[11]), cvtpk(p1[12], p1[13]), cvtpk(p1[14], p1[15])};
        o = __builtin_amdgcn_mfma_f32_32x32x16_bf16(__builtin_bit_cast(bf16x8, w0), trfrag(l0 + L_VI, 0, eb, lane), o, 0, 0, 0);
        o = __builtin_amdgcn_mfma_f32_32x32x16_bf16(__builtin_bit_cast(bf16x8, w1), trfrag(l0 + L_VI, 1, eb, lane), o, 0, 0, 0);
        o = __builtin_amdgcn_mfma_f32_32x32x16_bf16(__builtin_bit_cast(bf16x8, w2), trfrag(l0 + L_VI, 2, eb, lane), o, 0, 0, 0);
        o = __builtin_amdgcn_mfma_f32_32x32x16_bf16(__builtin_bit_cast(bf16x8, w3), trfrag(l0 + L_VI, 3, eb, lane), o, 0, 0, 0);
    }
    __attribute__((address_space(3))) float* ost = (__attribute__((address_space(3))) float*)(shm + L_OST);
#pragma unroll
    for (int r = 0; r < 16; ++r) ost[(32 * tb + crow(r, hi)) * 132 + 32 * eb + r32] = o[r];
    __syncthreads();
    { const int t = tid >> 3, part = tid & 7; float v[16]; float ss = 0.f;
#pragma unroll
        for (int k = 0; k < 4; ++k) { const f32x4_t x = *(const __attribute__((address_space(3))) f32x4_t*)(ost + t * 132 + part * 16 + k * 4); v[4 * k] = x[0]; v[4 * k + 1] = x[1]; v[4 * k + 2] = x[2]; v[4 * k + 3] = x[3]; ss += x[0] * x[0] + x[1] * x[1] + x[2] * x[2] + x[3] * x[3]; }
        ss += __shfl_xor(ss, 1); ss += __shfl_xor(ss, 2); ss += __shfl_xor(ss, 4);
        const float rstd = rsqrtf(ss * (1.f / 128.f) + 1e-6f);
        const size_t go = (t0 + t) * 512 + h * 128 + part * 16;
        const uint4 r0 = rs0, r1 = rs1; const unsigned rw[8] = {r0.x, r0.y, r0.z, r0.w, r1.x, r1.y, r1.z, r1.w};
        unsigned ow[8];
#pragma unroll
        for (int k = 0; k < 8; ++k) { const float ga = p.norm_g[h * 128 + part * 16 + 2 * k], gb = p.norm_g[h * 128 + part * 16 + 2 * k + 1];
            ow[k] = pk2(v[2 * k] * rstd * ga * __uint_as_float(rw[k] << 16), v[2 * k + 1] * rstd * gb * __uint_as_float(rw[k] & 0xffff0000u)); }
        *(uint4*)(p.gla + go) = make_uint4(ow[0], ow[1], ow[2], ow[3]); *(uint4*)(p.gla + go + 8) = make_uint4(ow[4], ow[5], ow[6], ow[7]); }
    __syncthreads();
}
}
__device__ __forceinline__ void phase_gla1(const P& p, char* smem) {
    const int n = p.nb * 4 * 64;
    for (int i = blockIdx.x; i < n; i += gridDim.x) gla::g1_chunk(p, smem, i >> 8, (i >> 6) & 3, i & 63);
}
__device__ __forceinline__ void phase_gla2(const P& p) {
    const int n = p.nb * 4 * 8192;
    for (int idx = blockIdx.x * NT + TIDX(); idx < n; idx += gridDim.x * NT) {
        const int bh = idx >> 13, de = idx & 8191, d = de >> 7; float* U = p.gst + (size_t)bh * 64 * 8192 + de; const float* gd = p.gdec + (size_t)bh * 64 * 64 + d;
        float s = 0.f;
        for (int c0 = 0; c0 < 64; c0 += 8) { float tmp[8], g[8];
#pragma unroll
            for (int k = 0; k < 8; ++k) { tmp[k] = U[(size_t)(c0 + k) * 8192]; g[k] = gd[(c0 + k) * 64]; }
#pragma unroll
            for (int k = 0; k < 8; ++k) { U[(size_t)(c0 + k) * 8192] = s; s = g[k] * s + tmp[k]; } }
    }
}
__device__ __forceinline__ void phase_gla3(const P& p, char* smem) {
    const int n = p.nb * 4 * 64;
    for (int i = blockIdx.x; i < n; i += gridDim.x) gla::g3_chunk(p, smem, i >> 8, (i >> 6) & 3, i & 63);
}

struct CmpSched {
    const char* kc; const char* Wc1; float* Pc; int nM, G, c; size_t aseg, pseg;
    __device__ __forceinline__ bool next(int i, pg8::Unit& u) const {
        const int L = i * G + c, per = nM * 2 * 2; if (L >= 2 * per) return false;
        const int kv = L / per, r = L % per, ks = r & 1, pn = (r >> 1) & 1, pm = r >> 2;
        u.pm = pm; u.pn = pn; u.tag = kv * 2 + ks;
        u.A = kc + (size_t)kv * aseg + (size_t)pm * 256 * 1024 * 2 + ks * 512 * 2; u.B = Wc1 + ((size_t)kv * 512 + pn * 256) * 1024 * 2 + ks * 512 * 2; return true;
    }
    __device__ __forceinline__ unsigned arow(const pg8::Unit&, int r) const { return (unsigned)r * 2048u; }
    __device__ __forceinline__ void a_ready(const pg8::Unit&) const {}
    __device__ __forceinline__ void done(const pg8::Unit&) const {}
};
struct EpiCmp {
    static constexpr bool PERM = false, CHAIN = false;
    float* Pc; size_t pseg;
    __device__ __forceinline__ void operator()(const pg8::f32x4 (&acc)[2][2][4][2], const pg8::Unit& u, int wr, int wc, int fr, int fq) const {
        float* base = Pc + (size_t)u.tag * pseg; const int col0 = u.pn * 256 + wc * 32 + 4 * fq;
#pragma unroll
        for (int ai = 0; ai < 2; ++ai)
#pragma unroll
            for (int m = 0; m < 4; ++m) { float* rowp = base + (size_t)(u.pm * 256 + ai * 128 + wr * 64 + m * 16 + fr) * 512 + col0;
#pragma unroll
                for (int bj = 0; bj < 2; ++bj)
#pragma unroll
                    for (int n = 0; n < 2; ++n) *(pg8::f32x4*)(rowp + bj * 128 + n * 16) = acc[ai][bj][m][n]; }
    }
};
__device__ __forceinline__ void finish_b1p(const P& p);
__device__ __forceinline__ void phase_cmp1(const P& p, char* smem) {
    if (blockIdx.x == gridDim.x - 1) finish_b1p(p);
    const int nrows = p.nb * 2 * 256;
    CmpSched Sc{(const char*)p.kv6, (const char*)p.Wc1, p.pcmp, nrows / 256, (int)gridDim.x, (int)blockIdx.x, kvseg(p) * 2, (size_t)(nrows + 8) * 512};
    EpiCmp E{p.pcmp, (size_t)(nrows + 8) * 512};
    pg8::gemm_phase<EpiCmp, CmpSched, true, false>((PG8_LAS unsigned char*)smem, 512, 1024, 1024, Sc, E);
}
__device__ __forceinline__ void body_cmp2f(const P& p, int vb, char* smem) {
    const int tid = TIDX(); const int nrows = p.nb * 2 * 256, nvb1 = nrows / 16; const int kv = vb / nvb1, row0 = (vb % nvb1) * 16;
    const size_t pseg = (size_t)(nrows + 8) * 512; const float* P0 = p.pcmp + (size_t)(kv * 2) * pseg; const float* P1 = P0 + pseg;
    float* hs = (float*)smem;
    float* w2s = (float*)smem + 16 * 256;
    __syncthreads();
    { const float4* wsrc = (const float4*)(kv ? p.cw2_v : p.cw2_k);
#pragma unroll
      for (int k = 0; k < 8; ++k) ((float4*)w2s)[tid + k * 512] = wsrc[tid + k * 512]; }
#pragma unroll
    for (int k = 0; k < 8; ++k) { const int idx = tid + k * 512, rr = idx >> 8, n = idx & 255; const size_t m = (size_t)(row0 + rr);
        const float z = P0[m * 512 + n] + P1[m * 512 + n] + P0[(m + 1) * 512 + 256 + n] + P1[(m + 1) * 512 + 256 + n] + p.b1p[kv * 256 + n];
        hs[idx] = geluf_(z); }
    __syncthreads();
    const int rr = tid >> 5, i = tid & 31, row = row0 + rr;
    const float* h = hs + rr * 256; const float* b2 = kv ? p.cb2_v : p.cb2_k;
    float z1 = b2[i], z2 = b2[i + 32];
#pragma unroll 8
    for (int n = 0; n < 256; ++n) { const float hv = h[n]; z1 += hv * w2s[n * 64 + i]; z2 += hv * w2s[n * 64 + i + 32]; }
    bf16* dst = (kv ? p.vcmp : p.kcmp) + (size_t)row * 64;
    if (kv == 0) {
        const int bg = row >> 8, m = row & 255, b = bg >> 1; int sp = 16 * m + 31; if (sp > S - 1) sp = S - 1;
        const size_t t = (size_t)b * S + sp; const float c = p.cs[t * 64 + i], sn = p.cs[t * 64 + 32 + i];
        const float r1 = z1 * c - z2 * sn, r2 = z2 * c + z1 * sn; z1 = r1; z2 = r2;
    }
    dst[i] = f2bf(z1); dst[i + 32] = f2bf(z2);
}
__device__ __forceinline__ void phase_cmp2(const P& p, char* smem) {
    const int n = 2 * (p.nb * 2 * 256) / 16;
    for (int vb = blockIdx.x; vb < n; vb += gridDim.x) body_cmp2f(p, vb, smem);
}
__device__ __forceinline__ void prep_b1p(const P& p, char* smem) {
    if (blockIdx.x >= 64) return;
    const int tid = TIDX(), kv = blockIdx.x >> 5, part = blockIdx.x & 31, n = tid & 255, fh = tid >> 8;
    const float* pe = kv ? p.cpos_v : p.cpos_k; const float* w1 = kv ? p.cw1_v : p.cw1_k;
    const int f0 = part * 64 + fh * 32; float a = 0.f;
#pragma unroll
    for (int i = 0; i < 32; ++i) a += pe[f0 + i] * w1[(size_t)(f0 + i) * 256 + n];
    float* sc = (float*)(smem + LDS_MISC);
    __syncthreads();
    if (fh == 1) sc[n] = a;
    __syncthreads();
    if (fh == 0) p.b1p[512 + (kv * 32 + part) * 256 + n] = a + sc[n];
    __syncthreads();
}
__device__ __forceinline__ void finish_b1p(const P& p) {
    const int tid = TIDX(), kv = tid >> 8, n = tid & 255; float a = (kv ? p.cb1_v : p.cb1_k)[n];
    for (int part = 0; part < 32; ++part) a += p.b1p[512 + (kv * 32 + part) * 256 + n];
    p.b1p[kv * 256 + n] = a;
}
#define XB_TMO      128
#define XB_XCNT(j)  (256  + 64 * (j))
#define XB_XSUB(j)  (1280 + 64 * (j))
#define XB_XGEN(j)  (2304 + 64 * (j))
#define XB_TOP      3328
#define XB_TOPGEN   3392
#define XCD_BAR_WORDS 3456
#define XB_SPIN_CAP (1u << 18)
#define XLAS __attribute__((address_space(3)))
__device__ __forceinline__ unsigned xb_ld(unsigned* p)              { return __hip_atomic_load(p, __ATOMIC_RELAXED, __HIP_MEMORY_SCOPE_AGENT); }
__device__ __forceinline__ unsigned xb_add(unsigned* p, unsigned v) { return __hip_atomic_fetch_add(p, v, __ATOMIC_RELAXED, __HIP_MEMORY_SCOPE_AGENT); }
__device__ __forceinline__ unsigned xb_xcc_id() { return (unsigned)__builtin_amdgcn_s_getreg((3 << 11) | 20) & 0xFu; }
#define XB_SPIN(cond, bar) do { unsigned _sp = 0; while (cond) { __builtin_amdgcn_s_sleep(1); \
    if ((++_sp & 255u) == 0u) { if (xb_ld(&(bar)[XB_TMO])) break; if (_sp > XB_SPIN_CAP) { atomicAdd(&(bar)[XB_TMO], 1u); break; } } } } while (0)
struct XcdBarrier { unsigned* bar; unsigned x; volatile XLAS unsigned* st; };
__device__ __forceinline__ XcdBarrier xcd_barrier_post(unsigned* bar, volatile XLAS unsigned* st) {
    XcdBarrier b; b.bar = bar; b.x = xb_xcc_id(); b.st = st;
    if (TIDX() == 0) (void)xb_add(&bar[XB_XCNT(b.x)], 1u);
    return b;
}
__device__ __forceinline__ void xcd_barrier_complete(unsigned* bar, unsigned x, unsigned& nloc, unsigned& nx) {
    const unsigned G = gridDim.x * gridDim.y * gridDim.z;
    unsigned sum, cnt, mine, sp = 0u;
    for (;;) {
        sum = 0u; cnt = 0u; mine = 0u;
#pragma unroll
        for (unsigned j = 0; j < 16; ++j) { const unsigned c = xb_ld(&bar[XB_XCNT(j)]); sum += c; cnt += (c > 0u) ? 1u : 0u; mine = (j == x) ? c : mine; }
        if (sum == G) break;
        __builtin_amdgcn_s_sleep(1);
        if ((++sp & 255u) == 0u) { if (xb_ld(&bar[XB_TMO])) break; if (sp > XB_SPIN_CAP) { atomicAdd(&bar[XB_TMO], 1u); break; } }
    }
    nloc = mine > 0u ? mine : 1u; nx = cnt > 0u ? cnt : 1u;
}
__device__ __forceinline__ void xcd_barrier(const XcdBarrier& b) {
    asm volatile("s_waitcnt vmcnt(0)" ::: "memory");
    __syncthreads();
    if (TIDX() == 0) {
        unsigned* bar = b.bar;
        __builtin_amdgcn_s_waitcnt(0);
        unsigned nloc = b.st[0], nx = b.st[1];
        if (nloc == 0u) { xcd_barrier_complete(bar, b.x, nloc, nx); b.st[0] = nloc; b.st[1] = nx; }
        const unsigned old = xb_add(&bar[XB_XSUB(b.x)], 1u);
        const unsigned gen = old / nloc;
        if (old + 1u == (gen + 1u) * nloc) {
            __builtin_amdgcn_fence(__ATOMIC_RELEASE, "agent");
            asm volatile("s_waitcnt vmcnt(0)" ::: "memory");
            const unsigned og = xb_add(&bar[XB_TOP], 1u);
            const unsigned tg = og / nx;
            if (og + 1u == (tg + 1u) * nx) xb_add(&bar[XB_TOPGEN], 1u);
            else XB_SPIN(xb_ld(&bar[XB_TOPGEN]) == tg, bar);
            __builtin_amdgcn_fence(__ATOMIC_ACQUIRE, "agent");
            xb_add(&bar[XB_XGEN(b.x)], 1u);
            asm volatile("s_waitcnt vmcnt(0)" ::: "memory");
        } else {
            XB_SPIN(xb_ld(&bar[XB_XGEN(b.x)]) == gen, bar);
            __builtin_amdgcn_fence(__ATOMIC_ACQUIRE, "agent");
            asm volatile("s_waitcnt vmcnt(0)" ::: "memory");
        }
    }
    __syncthreads();
}

template <int ST> __device__ __forceinline__ void run_stage(const P& p, char* smem, int first, int stride) {
    const int nvb = stage_nvb(ST, p.T);
    for (int vb = first; vb < nvb; vb += stride) {
        if constexpr (ST == ST_RMS) body_rms(p, vb);
        else if constexpr (ST == ST_CS) body_cs(p, vb);
        else if constexpr (ST == ST_INPROJ) body_inproj(p, vb, smem);
        else if constexpr (ST == ST_CMP1) body_cmp1(p, vb, smem);
        else if constexpr (ST == ST_CMP2) body_cmp2(p, vb);
        else if constexpr (ST == ST_NSACMP) body_nsacmp(p, vb, smem);
        else if constexpr (ST == ST_NSAATT) body_nsaatt(p, vb);
        else if constexpr (ST == ST_GLAA) body_glaa(p, vb);
        else if constexpr (ST == ST_GLASCAN) body_glascan(p, vb, smem);
        else if constexpr (ST == ST_GLANORM) body_glanorm(p, vb);
        else if constexpr (ST == ST_PROJ) body_proj(p, vb, smem);
        else if constexpr (ST == ST_OUT) body_out(p, vb, smem);
        else if constexpr (ST == ST_ROUTE) body_route(p, vb, smem);
        else if constexpr (ST == ST_MOE1) body_moe1(p, vb, smem);
        else if constexpr (ST == ST_MOE2) body_moe2(p, vb, smem);
        else if constexpr (ST == ST_FINAL) body_final(p, vb, smem);
    }
}
template <int ST> __global__ void __launch_bounds__(NT) k_stage(P p) {
    extern __shared__ __attribute__((aligned(16))) char smem[];
    run_stage<ST>(p, smem, blockIdx.x, gridDim.x);
}
__global__ void __launch_bounds__(NT) k_mega(P p) {
    extern __shared__ __attribute__((aligned(16))) char smem[];
    cg::grid_group grid = cg::this_grid();
    const int b0 = blockIdx.x, G = gridDim.x;
    volatile XLAS unsigned* xst = (volatile XLAS unsigned*)((XLAS char*)smem + LDS_MISC + 3072);
    if (TIDX() < 4) xst[TIDX()] = 0u;
    __syncthreads();
    volatile unsigned long long* tsv = (volatile unsigned long long*)(p.ctl + 12288); int nts = 1;
    if (TSEL >= 0 && b0 == 0 && TIDX() == 0) tsv[0] = __builtin_amdgcn_s_memrealtime();
    const XcdBarrier xb = xcd_barrier_post(p.ctl + 4096, xst);
#define GSYNC() do { xcd_barrier(xb); if (TSEL >= 0 && b0 == 0 && TIDX() == 0) { tsv[nts] = __builtin_amdgcn_s_memrealtime(); } ++nts; } while (0)
#define DUPRUN(k, stmt) do { if (DUP == (k)) { stmt; GSYNC(); } } while (0)
    if (p.T < 0) grid.sync();
    phase_prep(p, smem); GSYNC();
    phase_inA(p, smem); GSYNC();                               DUPRUN(7, phase_inA(p, smem));
    phase_cmp1(p, smem); phase_gla1(p, smem); GSYNC();         DUPRUN(8, phase_cmp1(p, smem)); DUPRUN(4, phase_gla1(p, smem));
    phase_cmp2(p, smem); phase_gla2(p); GSYNC();               DUPRUN(9, phase_cmp2(p, smem));
    if (DUP >= 20 && DUP < 148) { P p2 = p; p2.onsa = (bf16*)p.pcmp; p2.sel = (u64*)((char*)p.pcmp + 16 * MiB_); phase_nsa<(DUP >= 20 && DUP < 148) ? DUP - 20 : 0>(p2, smem); GSYNC(); }
    phase_nsa(p, smem); phase_gla3(p, smem); GSYNC();          DUPRUN(1, phase_nsa(p, smem)); DUPRUN(2, phase_gla3(p, smem));
    phase_inB(p, smem); GSYNC();                               DUPRUN(11, phase_inB(p, smem));
    phase_proj(p, smem); GSYNC();                              DUPRUN(12, phase_proj(p, smem));
    phase_out(p, smem); GSYNC();                               DUPRUN(13, phase_out(p, smem));
    if (DUP == 17) { P p2 = p; p2.ctl = p.ctl + 8192; p2.vb = p.sa; p2.list = (int*)p.mixed; p2.tokslot = (int*)p.mixed + (1 << 20); p2.tokexp = (int*)p.mixed + (2 << 20); p2.tokw = (float*)p.mixed + (3 << 20);
        for (int vb = b0; vb < p.T / 64; vb += G) body_route3(p2, vb, smem);
        GSYNC(); }
    for (int vb = b0; vb < p.T / 64; vb += G) body_route3(p, vb, smem);
    GSYNC();
    phase_moe12(p, smem); GSYNC();
    if (DUP == 15) { GSYNC(); GSYNC(); GSYNC(); GSYNC(); GSYNC(); GSYNC(); GSYNC(); GSYNC(); GSYNC(); GSYNC(); }
    for (int vb = b0; vb < p.T / 8; vb += G) body_final_b(p, vb, smem);
    if (TSEL >= 0 && b0 == 0 && TIDX() == 0) { const unsigned long long tend = __builtin_amdgcn_s_memrealtime(); tsv[nts] = tend;
        const unsigned long long d = tsv[TSEL + 1] - tsv[TSEL]; while (__builtin_amdgcn_s_memrealtime() - tend < 4ull * d) __builtin_amdgcn_s_sleep(16); }
#undef DUPRUN
#undef GSYNC
}

enum Phase { PH_PREP = 0, PH_INA, PH_INB, PH_PROJ, PH_OUT, PH_MOE1, PH_MOE2, PH_NSA, PH_GLA1, PH_GLA2, PH_GLA3, PH_CMP1, PH_CMP2 };
template <int PH> __global__ void __launch_bounds__(NT) k_phase(P p) {
    extern __shared__ __attribute__((aligned(16))) char smem[];
    if constexpr (PH == PH_PREP) phase_prep(p, smem);
    else if constexpr (PH == PH_INA) phase_inA(p, smem);
    else if constexpr (PH == PH_INB) phase_inB(p, smem);
    else if constexpr (PH == PH_PROJ) phase_proj(p, smem);
    else if constexpr (PH == PH_OUT) phase_out(p, smem);
    else if constexpr (PH == PH_MOE1) phase_moe12(p, smem);
    else if constexpr (PH == PH_MOE2) { }
    else if constexpr (PH == PH_NSA) phase_nsa(p, smem);
    else if constexpr (PH == PH_GLA1) phase_gla1(p, smem);
    else if constexpr (PH == PH_GLA2) phase_gla2(p);
    else if constexpr (PH == PH_GLA3) phase_gla3(p, smem);
    else if constexpr (PH == PH_CMP1) phase_cmp1(p, smem);
    else if constexpr (PH == PH_CMP2) phase_cmp2(p, smem);
}
template <class TT> __device__ __forceinline__ float ldf(const TT* p, size_t i);
template <> __device__ __forceinline__ float ldf<bf16>(const bf16* p, size_t i) { return bf2f(p[i]); }
template <> __device__ __forceinline__ float ldf<float>(const float* p, size_t i) { return p[i]; }
template <class TT> __global__ void __launch_bounds__(256) k_compare(const TT* a, const TT* b, size_t n, float* err, int slot) {
    float num = 0.f, den = 0.f;
    for (size_t i = (size_t)blockIdx.x * 256 + TIDX(); i < n; i += (size_t)gridDim.x * 256) { const float x = ldf<TT>(a, i), y = ldf<TT>(b, i); const float d = x - y; num += (d == d) ? d * d : 1e30f; den += y * y; }
#pragma unroll
    for (int o = 1; o < 64; o <<= 1) { num += __shfl_xor(num, o); den += __shfl_xor(den, o); }
    if ((TIDX() & 63) == 0) { atomicAdd(err + 2 * slot, num); atomicAdd(err + 2 * slot + 1, den); }
}
__global__ void __launch_bounds__(256) k_compare_sel(const u64* a, const u64* b, size_t n, float* err, int slot) {
    float num = 0.f, den = 0.f;
    for (size_t i = (size_t)blockIdx.x * 256 + threadIdx.x; i < n; i += (size_t)gridDim.x * 256) { num += (a[i] != b[i]) ? 1.f : 0.f; den += 100.f; }
#pragma unroll
    for (int o = 1; o < 64; o <<= 1) { num += __shfl_xor(num, o); den += __shfl_xor(den, o); }
    if ((threadIdx.x & 63) == 0) { atomicAdd(err + 2 * slot, num); atomicAdd(err + 2 * slot + 1, den); }
}
__global__ void __launch_bounds__(256) k_report(float* out, size_t n, const float* err, int nslots, float tol) {
    int code = 0;
    for (int s = 0; s < nslots; ++s) { const float num = err[2 * s], den = err[2 * s + 1]; const bool bad = !(num <= tol * tol * den) || !(den > 0.f); if (bad) { code = s + 1; break; } }
    if (code == 0) return;
    const float f = 1.f + 0.1f * (float)code;
    for (size_t i = (size_t)blockIdx.x * 256 + TIDX(); i < n; i += (size_t)gridDim.x * 256) out[i] *= f;
}

static void set_inputs(P& p, void* const* d_in) {
    const float* const* in = (const float* const*)d_in;
    p.x = in[0]; p.pos = (const int*)d_in[1]; p.g_mix = in[2]; p.w_in = in[3];
    p.cpos_k = in[4]; p.cw1_k = in[5]; p.cb1_k = in[6]; p.cw2_k = in[7]; p.cb2_k = in[8];
    p.cpos_v = in[9]; p.cw1_v = in[10]; p.cb1_v = in[11]; p.cw2_v = in[12]; p.cb2_v = in[13];
    p.w_a2 = in[14]; p.b_a = in[15]; p.norm_g = in[16]; p.w_pn = in[17]; p.w_pg = in[18]; p.w_out = in[19];
    p.g_ffn = in[20]; p.w_grp = in[21]; p.b_grp = in[22]; p.w_exp = in[23]; p.b_exp = in[24]; p.w_gate = in[25]; p.w_up = in[26]; p.w_down = in[27]; p.g_final = in[28];
}
constexpr size_t MiB = 1u << 20;
static void layout_ref(P& p, char* small, char* act, char* scratch, float* out, int nb) {
    const size_t q = (MiB / 4) * nb;
    p.nb = nb; p.T = nb * S; p.out = out;
    p.ctl = (unsigned*)small; p.sel = (u64*)(small + q / 16 * 1); p.kcmp = (bf16*)(small + q / 2); p.vcmp = (bf16*)(small + q / 4 * 3);
    p.tokslot = (int*)(small + q); p.tokexp = (int*)(small + q + q / 8); p.tokw = (float*)(small + q + q / 4);
    p.alow = (float*)(small + 2 * q); p.gates = (float*)(small + 3 * q); p.cs = (float*)(small + 5 * q); p.hcmp = (float*)(small + 9 * q); p.list = (int*)(small + 13 * q);
    p.u = (bf16*)act; p.ocmp = (float*)act; p.mixed = (bf16*)act; p.vb = (bf16*)act;
    p.q = (bf16*)(act + 32 * q); p.kv6 = (bf16*)(act + 48 * q);
    p.gq = (bf16*)(act + 73 * q); p.gk = (bf16*)(act + 81 * q); p.gv = (bf16*)(act + 89 * q); p.rs = (bf16*)(act + 105 * q);
    p.H = (bf16*)(act + 32 * q);
    p.sa = (bf16*)(act + 123 * q); p.sb = (bf16*)(act + 155 * q); p.onsa = (bf16*)(act + 187 * q); p.gla = (bf16*)(act + 203 * q);
    p.Y = (bf16*)(act + 123 * q);
    p.ga = (float*)scratch; p.oraw = (float*)(scratch + 16 * q); p.h1 = (float*)(scratch + 48 * q);
    p.gst = (float*)(scratch + 16 * q); p.gdec = (float*)(small + 15 * q); p.gb = (float*)(act + 219 * q);
}
static void layout_compact(P& p, char* ws, float* out) {
    p.nb = NB; p.T = NB * S; p.out = out;
    char* small = ws; const size_t q = MiB;
    p.ctl = (unsigned*)small; p.sel = (u64*)(small + q / 16 * 1); p.kcmp = (bf16*)(small + q / 2); p.vcmp = (bf16*)(small + q / 4 * 3);
    p.tokslot = (int*)(small + q); p.tokexp = (int*)(small + q + q / 8); p.tokw = (float*)(small + q + q / 4);
    p.alow = (float*)(small + 2 * q); p.gates = (float*)(small + 3 * q); p.cs = (float*)(small + 5 * q); p.hcmp = (float*)(small + 9 * q); p.list = (int*)(small + 13 * q);
    p.u = (bf16*)(ws + 128 * MiB); p.vb = (bf16*)(ws + 128 * MiB);
    p.q = (bf16*)(ws + 160 * MiB); p.kv6 = (bf16*)(ws + 176 * MiB); p.gq = (bf16*)(ws + 201 * MiB); p.gk = (bf16*)(ws + 209 * MiB); p.gv = (bf16*)(ws + 217 * MiB); p.rs = (bf16*)(ws + 233 * MiB);
    p.ga = (float*)(ws + 249 * MiB); p.ocmp = (float*)(ws + 249 * MiB);
    p.sa = (bf16*)(ws + 160 * MiB); p.sb = (bf16*)(ws + 192 * MiB); p.mixed = (bf16*)(ws + 224 * MiB);
    p.H = (bf16*)(ws + 160 * MiB); p.Y = (bf16*)(ws + 48 * MiB);
    p.onsa = (bf16*)out; p.gla = (bf16*)((char*)out + 16 * MiB); p.oraw = (float*)((char*)out + 32 * MiB); p.h1 = out;
    p.gst = (float*)((char*)out + 32 * MiB); p.gdec = (float*)(small + 15 * q); p.pcmp = (float*)(ws + 249 * MiB); p.h1b = (bf16*)(ws + 249 * MiB); p.gb = (float*)(ws + 266 * MiB);
}
static void layout_weights(P& p, char* w) {
    p.wr = (float*)(w - 256 * 1024); p.b1p = (float*)(w - 100 * 1024);
    p.Wd = (bf16*)w; p.Wgu = (bf16*)(w + 32 * MiB); p.Wt_in = (bf16*)(w + 96 * MiB); p.Wc1 = (bf16*)(w + 106 * MiB);
    p.Wpn = (bf16*)(w + 108 * MiB); p.Wpg = (bf16*)(w + 109 * MiB); p.Wo = (bf16*)(w + 110 * MiB);
}

template <int ST> static void launch_stage(const P& p, hipStream_t stream) {
    static bool attr = false;
    if (!attr) { (void)hipFuncSetAttribute((const void*)k_stage<ST>, hipFuncAttributeMaxDynamicSharedMemorySize, LDS_BYTES); attr = true; }
    int nvb = stage_nvb(ST, p.T); if (nvb > 16384) nvb = 16384;
    hipLaunchKernelGGL(k_stage<ST>, dim3(nvb), dim3(NT), LDS_BYTES, stream, p);
}
template <int PH> static void launch_phase(const P& p, hipStream_t stream, int grid = 40) {
    static bool attr = false;
    if (!attr) { (void)hipFuncSetAttribute((const void*)k_phase<PH>, hipFuncAttributeMaxDynamicSharedMemorySize, LDS_BYTES); attr = true; }
    hipLaunchKernelGGL(k_phase<PH>, dim3(grid), dim3(NT), LDS_BYTES, stream, p);
}
template <class TT> static void compare(const TT* a, const TT* b, size_t n, float* err, int slot, hipStream_t stream) {
    hipLaunchKernelGGL(k_compare<TT>, dim3(1024), dim3(256), 0, stream, a, b, n, err, slot);
}
static void launch_mega(const P& p, hipStream_t stream) {
    static int grid = 0;
    if (!grid) {
        int dev = 0, cus = 0, per_cu = 0;
        (void)hipGetDevice(&dev); (void)hipDeviceGetAttribute(&cus, hipDeviceAttributeMultiprocessorCount, dev);
        (void)hipFuncSetAttribute((const void*)k_mega, hipFuncAttributeMaxDynamicSharedMemorySize, LDS_BYTES);
        (void)hipOccupancyMaxActiveBlocksPerMultiprocessor(&per_cu, (const void*)k_mega, NT, LDS_BYTES);
        if (per_cu < 1) per_cu = 1;
        grid = cus * per_cu;
    }
    (void)hipMemsetAsync((void*)p.ctl, 0, 64 * 1024, stream);
    P pp = p; void* args[] = {(void*)&pp};
    (void)hipLaunchCooperativeKernel((const void*)k_mega, dim3(grid), dim3(NT), args, LDS_BYTES, stream);
}

extern "C" void kernel_launch(void* const* d_in, const int* in_sizes, int n_in, void* d_out, int out_size, void* d_ws, size_t ws_size, hipStream_t stream) {
    char* ws = (char*)d_ws;
    P p{}; set_inputs(p, d_in); layout_ref(p, ws, ws + 16 * MiB, (char*)d_out, (float*)d_out, NB); p.h1 = (float*)d_out;
#if MODE == 0
    (void)hipMemsetAsync(d_ws, 0, 4096, stream);
    launch_stage<ST_RMS>(p, stream); launch_stage<ST_CS>(p, stream); launch_stage<ST_INPROJ>(p, stream);
    launch_stage<ST_CMP1>(p, stream); launch_stage<ST_CMP2>(p, stream); launch_stage<ST_NSACMP>(p, stream); launch_stage<ST_NSAATT>(p, stream);
    launch_stage<ST_GLAA>(p, stream); launch_stage<ST_GLASCAN>(p, stream); launch_stage<ST_GLANORM>(p, stream);
    launch_stage<ST_PROJ>(p, stream); launch_stage<ST_OUT>(p, stream); launch_stage<ST_ROUTE>(p, stream);
    launch_stage<ST_MOE1>(p, stream); launch_stage<ST_MOE2>(p, stream); launch_stage<ST_FINAL>(p, stream);
#elif MODE == 1
    { P c{}; set_inputs(c, d_in); layout_weights(c, ws + 16 * MiB); layout_compact(c, ws, (float*)d_out); launch_mega(c, stream); }
#else
    { P c{}; set_inputs(c, d_in); layout_weights(c, ws + 16 * MiB); layout_compact(c, ws, (float*)d_out); launch_mega(c, stream); }
    P r{}; set_inputs(r, d_in); layout_weights(r, ws + 16 * MiB);
    layout_ref(r, ws + 128 * MiB, ws + 132 * MiB, ws + 200 * MiB, (float*)(ws + 200 * MiB + 12 * MiB), 1);
    char* alt = ws + 228 * MiB; float* err = (float*)(ws + 128 * MiB + 8192);
    (void)hipMemsetAsync(ws + 128 * MiB, 0, 16384, stream);
    int slot = 0; const size_t T1 = S; const size_t ROWS1 = 2 * T1 + NEXP * 256;
    launch_stage<ST_RMS>(r, stream); launch_stage<ST_CS>(r, stream); launch_stage<ST_INPROJ>(r, stream);
    P f = r; { char* a = alt;
        f.u = (bf16*)a; a += T1 * 1024 * 2; f.cs = (float*)a; a += T1 * 64 * 4; f.q = (bf16*)a; a += T1 * 512 * 2; f.kv6 = (bf16*)a; a += 6 * (size_t)2 * S * 64 * 2 + 4096;
        f.gates = (float*)a; a += T1 * 24 * 4; f.gq = (bf16*)a; a += T1 * 256 * 2; f.gk = (bf16*)a; a += T1 * 256 * 2; f.gv = (bf16*)a; a += T1 * 512 * 2; f.alow = (float*)a; a += T1 * 16 * 4;
        f.rs = (bf16*)a; a += T1 * 512 * 2; f.sa = (bf16*)a; a += T1 * 1024 * 2; f.sb = (bf16*)a; a += T1 * 1024 * 2; }
    launch_phase<PH_PREP>(f, stream); launch_phase<PH_INA>(f, stream); launch_phase<PH_INB>(f, stream);
    compare<bf16>(f.q, r.q, T1 * 512, err, slot++, stream);
    compare<bf16>(f.kv6, r.kv6, 6 * (size_t)2 * S * 64, err, slot++, stream);
    compare<bf16>(f.sb, r.sb, T1 * 1024, err, slot++, stream);
    launch_stage<ST_CMP1>(r, stream); launch_stage<ST_CMP2>(r, stream);
    f = r; f.pcmp = (float*)alt; f.kcmp = (bf16*)(alt + 20 * MiB); f.vcmp = (bf16*)(alt + 21 * MiB); launch_phase<PH_CMP1>(f, stream); launch_phase<PH_CMP2>(f, stream);
    compare<bf16>(f.kcmp, r.kcmp, (size_t)2 * 255 * 64, err, slot++, stream); compare<bf16>(f.vcmp + 256 * 64, r.vcmp + 256 * 64, (size_t)255 * 64, err, slot++, stream);
    launch_stage<ST_NSACMP>(r, stream); launch_stage<ST_NSAATT>(r, stream);
    f = r; f.onsa = (bf16*)alt; f.sel = (u64*)(alt + 8 * MiB); launch_phase<PH_NSA>(f, stream);
    hipLaunchKernelGGL(k_compare_sel, dim3(64), dim3(256), 0, stream, (const u64*)f.sel, (const u64*)r.sel, T1 * 2, err, slot++);
    compare<bf16>(f.onsa, r.onsa, T1 * 512, err, slot++, stream);
    launch_stage<ST_GLAA>(r, stream); launch_stage<ST_GLASCAN>(r, stream); launch_stage<ST_GLANORM>(r, stream);
    f = r; f.gla = (bf16*)alt; f.gst = (float*)(alt + 8 * MiB); f.gdec = (float*)(alt + 18 * MiB); launch_phase<PH_GLA1>(f, stream); launch_phase<PH_GLA2>(f, stream); launch_phase<PH_GLA3>(f, stream);
    compare<bf16>(f.gla, r.gla, T1 * 512, err, slot++, stream);
    launch_stage<ST_PROJ>(r, stream);
    f = r; f.mixed = (bf16*)alt; launch_phase<PH_PROJ>(f, stream);
    compare<bf16>(f.mixed, r.mixed, T1 * 1024, err, slot++, stream);
    launch_stage<ST_OUT>(r, stream);
    f = r; f.h1b = (bf16*)alt; launch_phase<PH_OUT>(f, stream);
    launch_stage<ST_ROUTE>(r, stream);
    (void)hipMemsetAsync(r.H, 0, ROWS1 * 512 * 2, stream); (void)hipMemsetAsync(alt, 0, ROWS1 * 512 * 2, stream);
    (void)hipMemsetAsync(r.Y, 0, ROWS1 * 1024 * 2, stream); (void)hipMemsetAsync(alt + 17 * MiB, 0, ROWS1 * 1024 * 2, stream);
    launch_stage<ST_MOE1>(r, stream); launch_stage<ST_MOE2>(r, stream);
    f = r; f.H = (bf16*)alt; f.Y = (bf16*)(alt + 17 * MiB); launch_phase<PH_MOE1>(f, stream);
    compare<bf16>(f.H, r.H, ROWS1 * 512, err, slot++, stream);
    compare<bf16>(f.Y, r.Y, ROWS1 * 1024, err, slot++, stream);
    hipLaunchKernelGGL(k_report, dim3(1024), dim3(256), 0, stream, (float*)d_out, (size_t)NB * S * D, (const float*)err, slot, 0.02f);
#endif
}
```

```cpp
#include <hip/hip_runtime.h>
#include <hip/hip_cooperative_groups.h>
#include <stdint.h>
namespace cg = cooperative_groups;

#ifndef DUP
#define DUP 0
#endif
#ifndef TSEL
#define TSEL -1
#endif
#ifndef MODE
#define MODE 1
#endif

typedef unsigned short bf16;
typedef unsigned long long u64;

__device__ __forceinline__ int TIDX() { int t = threadIdx.x; asm volatile("" : "+v"(t)); return t; }
__device__ __forceinline__ float bf2f(bf16 v) { return __uint_as_float(((unsigned)v) << 16); }
__device__ __forceinline__ bf16 f2bf(float f) { unsigned u = __float_as_uint(f); return (bf16)((u + 0x7fffu + ((u >> 16) & 1u)) >> 16); }
__device__ __forceinline__ float sigmoidf_(float x) { return __builtin_amdgcn_rcpf(1.f + __expf(-x)); }
__device__ __forceinline__ float siluf_(float x) { return x * __builtin_amdgcn_rcpf(1.f + __expf(-x)); }
__device__ __forceinline__ float geluf_(float x) { const float u = 0.7978845608028654f * (x + 0.044715f * x * x * x); return x * __builtin_amdgcn_rcpf(1.f + __expf(-2.f * u)); }

constexpr int NB = 4, S = 4096, D = 1024;
constexpr int NT = 512;
constexpr int LDS_BYTES = 144 * 1024;
constexpr int LDS_MISC = 136 * 1024;
constexpr int INW = 4904;
constexpr int OFF_Q = 0, OFF_KV = 512, OFF_NG = 1280, OFF_GQ = 1304, OFF_GK = 1560, OFF_GV = 1816, OFF_GA = 2328, OFF_GR = 2344, OFF_MA = 2856, OFF_MB = 3880;
constexpr int NEXP = 32;
constexpr size_t MiB_ = 1u << 20;

struct P {
    const float* x; const int* pos; const float* g_mix; const float* w_in;
    const float *cpos_k, *cw1_k, *cb1_k, *cw2_k, *cb2_k, *cpos_v, *cw1_v, *cb1_v, *cw2_v, *cb2_v;
    const float *w_a2, *b_a, *norm_g, *w_pn, *w_pg, *w_out, *g_ffn, *w_grp, *b_grp, *w_exp, *b_exp, *w_gate, *w_up, *w_down, *g_final;
    float* out;
    unsigned* ctl;
    float* cs;
    bf16* u;
    bf16* q;
    bf16* kv6;
    float* gates;
    bf16 *gq, *gk, *gv;
    float* alow;
    bf16 *rs, *sa, *sb;
    float* hcmp;
    bf16 *kcmp, *vcmp;
    u64* sel;
    float* ocmp;
    bf16* onsa;
    float* ga;
    float* oraw;
    bf16* gla;
    bf16* mixed;
    float* h1;
    bf16* h1b;
    bf16* vb;
    int* list;
    int* tokslot;
    int* tokexp;
    float* tokw;
    bf16* H;
    bf16* Y;
    float* gst;
    float* gdec;
    float* gb;
    float* pcmp;
    float* b1p;
    float* wr;
    bf16 *Wt_in, *Wc1, *Wpn, *Wpg, *Wo, *Wgu, *Wd;
    int nb, T;
};
__device__ __forceinline__ size_t kvseg(const P& p) { return (size_t)p.nb * 2 * S * 64; }

enum Stage { ST_RMS = 0, ST_CS, ST_INPROJ, ST_CMP1, ST_CMP2, ST_NSACMP, ST_NSAATT, ST_GLAA, ST_GLASCAN, ST_GLANORM, ST_PROJ, ST_OUT, ST_ROUTE, ST_MOE1, ST_MOE2, ST_FINAL, ST_COUNT };

__host__ __device__ inline int stage_nvb(int st, int T) {
    switch (st) {
        case ST_RMS: return T / 8;
        case ST_CS: return T * 32 / NT;
        case ST_INPROJ: return ((INW + NT - 1) / NT) * (T / 8);
        case ST_CMP1: return 2 * (T / S) * 2 * 256 / 8;
        case ST_CMP2: return 2 * (T / S) * 2 * 256 * 32 / NT;
        case ST_NSACMP: return T / 64 * 2 / 8;
        case ST_NSAATT: return T / 64 * 8 / 8;
        case ST_GLAA: return T / 2;
        case ST_GLASCAN: return (T / S) * 4 / 4;
        case ST_GLANORM: return T * 4 / NT;
        case ST_PROJ: return 2 * (T / 8);
        case ST_OUT: return 2 * (T / 8);
        case ST_ROUTE: return T / 8;
        case ST_MOE1: return (2 * T + NEXP * 256) / 8;
        case ST_MOE2: return 2 * ((2 * T + NEXP * 256) / 8);
        case ST_FINAL: return T / 8;
    }
    return 0;
}

__device__ __forceinline__ void body_rms(const P& p, int vb) {
    const int lane = TIDX() & 63, t = vb * 8 + (TIDX() >> 6);
    const float4* xr = (const float4*)(p.x + (size_t)t * D);
    float4 v[4]; float ss = 0.f;
#pragma unroll
    for (int j = 0; j < 4; ++j) { v[j] = xr[lane + 64 * j]; ss += v[j].x * v[j].x + v[j].y * v[j].y + v[j].z * v[j].z + v[j].w * v[j].w; }
#pragma unroll
    for (int o = 1; o < 64; o <<= 1) ss += __shfl_xor(ss, o);
    const float rstd = rsqrtf(ss * (1.f / D) + 1e-6f);
#pragma unroll
    for (int j = 0; j < 4; ++j) {
        const float4 g = ((const float4*)p.g_mix)[lane + 64 * j];
        ushort4 o; o.x = f2bf(v[j].x * rstd * g.x); o.y = f2bf(v[j].y * rstd * g.y); o.z = f2bf(v[j].z * rstd * g.z); o.w = f2bf(v[j].w * rstd * g.w);
        ((ushort4*)(p.u + (size_t)t * D))[lane + 64 * j] = o;
    }
}
__device__ __forceinline__ void body_rms2(const P& p, int vb) {
    const int lane = TIDX() & 63, t = vb * 16 + (TIDX() >> 6) * 2;
    const float4* xr = (const float4*)(p.x + (size_t)t * D);
    float4 v[8]; float s0 = 0.f, s1 = 0.f;
#pragma unroll
    for (int j = 0; j < 8; ++j) v[j] = xr[lane + 64 * j];
#pragma unroll
    for (int j = 0; j < 4; ++j) { s0 += v[j].x * v[j].x + v[j].y * v[j].y + v[j].z * v[j].z + v[j].w * v[j].w; s1 += v[4 + j].x * v[4 + j].x + v[4 + j].y * v[4 + j].y + v[4 + j].z * v[4 + j].z + v[4 + j].w * v[4 + j].w; }
#pragma unroll
    for (int o = 1; o < 64; o <<= 1) { s0 += __shfl_xor(s0, o); s1 += __shfl_xor(s1, o); }
    const float r0 = rsqrtf(s0 * (1.f / D) + 1e-6f), r1 = rsqrtf(s1 * (1.f / D) + 1e-6f);
#pragma unroll
    for (int j = 0; j < 4; ++j) {
        const float4 g = ((const float4*)p.g_mix)[lane + 64 * j];
        ushort4 o; o.x = f2bf(v[j].x * r0 * g.x); o.y = f2bf(v[j].y * r0 * g.y); o.z = f2bf(v[j].z * r0 * g.z); o.w = f2bf(v[j].w * r0 * g.w);
        ((ushort4*)(p.u + (size_t)t * D))[lane + 64 * j] = o;
        ushort4 q; q.x = f2bf(v[4 + j].x * r1 * g.x); q.y = f2bf(v[4 + j].y * r1 * g.y); q.z = f2bf(v[4 + j].z * r1 * g.z); q.w = f2bf(v[4 + j].w * r1 * g.w);
        ((ushort4*)(p.u + (size_t)(t + 1) * D))[lane + 64 * j] = q;
    }
}
__device__ __forceinline__ void body_cs(const P& p, int vb) {
    const int idx = vb * NT + TIDX(); const int t = idx >> 5, i = idx & 31;
    const float inv = 1.0f / powf(10000.0f, (float)i / 32.0f);
    const float ang = (float)p.pos[t] * inv;
    const double a = (double)ang; const double k = rint(a * 0.15915494309189535); const float r = (float)(a - k * 6.283185307179586);
    p.cs[(size_t)t * 64 + i] = cosf(r); p.cs[(size_t)t * 64 + 32 + i] = sinf(r);
}

template <int K, bool TWO, bool SAMEA, class AF1, class AF2, class Epi>
__device__ __forceinline__ void ngemm(float* lds, int m0, const float* W1, int ldw1, int n1, const float* W2, int ldw2, int n2, AF1 a1, AF2 a2, Epi epi) {
    const int tid = TIDX();
    for (int idx = tid; idx < 8 * K; idx += NT) { const int i = idx / K, k = idx % K; lds[idx] = a1(m0 + i, k); if (TWO && !SAMEA) lds[8 * K + idx] = a2(m0 + i, k); }
    __syncthreads();
    float acc1[8], acc2[8];
#pragma unroll
    for (int i = 0; i < 8; ++i) { acc1[i] = 0.f; acc2[i] = 0.f; }
    const float* w1 = W1 + n1; const float* w2 = TWO ? (W2 + n2) : w1;
    const float* l2 = (TWO && !SAMEA) ? lds + 8 * K : lds;
    for (int k = 0; k < K; k += 4) {
        float a[4], b[4];
#pragma unroll
        for (int kk = 0; kk < 4; ++kk) { a[kk] = w1[(size_t)(k + kk) * ldw1]; b[kk] = TWO ? w2[(size_t)(k + kk) * ldw2] : 0.f; }
#pragma unroll
        for (int i = 0; i < 8; ++i) {
            const float4 x1 = *(const float4*)(lds + i * K + k);
            acc1[i] += x1.x * a[0] + x1.y * a[1] + x1.z * a[2] + x1.w * a[3];
            if (TWO) { const float4 x2 = *(const float4*)(l2 + i * K + k); acc2[i] += x2.x * b[0] + x2.y * b[1] + x2.z * b[2] + x2.w * b[3]; }
        }
    }
#pragma unroll
    for (int i = 0; i < 8; ++i) epi(m0 + i, acc1[i], acc2[i]);
    __syncthreads();
}

__device__ __forceinline__ void store_z(const P& p, int t, int j, float z, float zp) {
    const int b = t / S, s = t % S;
    if (j < OFF_KV) {
        const int d = j & 63, i = d & 31; const float c = p.cs[(size_t)t * 64 + i], sn = p.cs[(size_t)t * 64 + 32 + i];
        const float r = (d < 32) ? (z * c - zp * sn) : (z * c + zp * sn);
        p.q[(size_t)t * 512 + j] = f2bf(r * 0.125f);
    } else if (j < OFF_NG) {
        const int seg = (j - OFF_KV) >> 7, cc = (j - OFF_KV) & 127, g = cc >> 6, d = cc & 63; float r = z;
        if (seg == 2 || seg == 4) { const int i = d & 31; const float c = p.cs[(size_t)t * 64 + i], sn = p.cs[(size_t)t * 64 + 32 + i]; r = (d < 32) ? (z * c - zp * sn) : (z * c + zp * sn); }
        p.kv6[(size_t)seg * kvseg(p) + ((size_t)(b * 2 + g) * S + s) * 64 + d] = f2bf(r);
    } else if (j < OFF_GQ) { p.gates[(size_t)t * 24 + (j - OFF_NG)] = sigmoidf_(z);
    } else if (j < OFF_GK) { p.gq[(size_t)t * 256 + (j - OFF_GQ)] = f2bf(z * 0.125f);
    } else if (j < OFF_GV) { p.gk[(size_t)t * 256 + (j - OFF_GK)] = f2bf(z);
    } else if (j < OFF_GA) { p.gv[(size_t)t * 512 + (j - OFF_GV)] = f2bf(z);
    } else if (j < OFF_GR) { p.alow[(size_t)t * 16 + (j - OFF_GA)] = z;
    } else if (j < OFF_MA) { p.rs[(size_t)t * 512 + (j - OFF_GR)] = f2bf(siluf_(z));
    } else if (j < OFF_MB) { p.sa[(size_t)t * 1024 + (j - OFF_MA)] = f2bf(sigmoidf_(z));
    } else { p.sb[(size_t)t * 1024 + (j - OFF_MB)] = f2bf(sigmoidf_(z)); }
}
__device__ __forceinline__ int rope_partner(int j) {
    int base;
    if (j < OFF_KV) base = 0; else if (j >= 768 && j < 896) base = 768; else if (j >= 1024 && j < 1152) base = 1024; else return -1;
    const int d = (j - base) & 63; return d < 32 ? j + 32 : j - 32;
}
__device__ __forceinline__ void body_inproj(const P& p, int vb, char* smem) {
    constexpr int NCB = (INW + NT - 1) / NT;
    const int bx = vb % NCB, by = vb / NCB;
    const int jr = bx * NT + TIDX(); const bool jv = jr < INW; const int j = jv ? jr : INW - 1;
    int jp = rope_partner(j); if (jp < 0) jp = j;
    ngemm<1024, true, true>((float*)smem, by * 8, p.w_in, INW, j, p.w_in, INW, jp,
        [&](int m, int k) { return bf2f(p.u[(size_t)m * D + k]); }, [&](int m, int k) { return 0.f; },
        [&](int m, float z, float zp) { if (jv) store_z(p, m, j, z, zp); });
}

__device__ __forceinline__ void body_cmp1(const P& p, int vb, char* smem) {
    const int nrows = p.nb * 2 * 256, ng = nrows / 8;
    const int kv = vb / ng, m0 = (vb % ng) * 8; const int n = TIDX() & 255; const bool act = TIDX() < 256;
    const bf16* src = p.kv6 + (size_t)kv * kvseg(p);
    const float* pe = kv ? p.cpos_v : p.cpos_k; const float* w1 = kv ? p.cw1_v : p.cw1_k; const float* b1 = kv ? p.cb1_v : p.cb1_k;
    float* dst = p.hcmp + (size_t)kv * nrows * 256;
    ngemm<2048, false, true>((float*)smem, m0, w1, 256, n, w1, 256, n,
        [&](int m, int k) { return bf2f(src[(size_t)m * 1024 + k]) + pe[k]; }, [&](int m, int k) { return 0.f; },
        [&](int m, float z, float) { if (act) dst[(size_t)m * 256 + n] = geluf_(z + b1[n]); });
}
__device__ __forceinline__ void body_cmp2(const P& p, int vb) {
    const int nrows = p.nb * 2 * 256;
    const int idx = vb * NT + TIDX();
    const int i = idx & 31, row = (idx >> 5) % nrows, kv = (idx >> 5) / nrows;
    const float* h = p.hcmp + ((size_t)kv * nrows + row) * 256; const float* w2 = kv ? p.cw2_v : p.cw2_k; const float* b2 = kv ? p.cb2_v : p.cb2_k;
    float z1 = b2[i], z2 = b2[i + 32];
    for (int n = 0; n < 256; ++n) { const float hv = h[n]; z1 += hv * w2[n * 64 + i]; z2 += hv * w2[n * 64 + i + 32]; }
    bf16* dst = (kv ? p.vcmp : p.kcmp) + (size_t)row * 64;
    if (kv == 0) {
        const int bg = row >> 8, m = row & 255, b = bg >> 1; int sp = 16 * m + 31; if (sp > S - 1) sp = S - 1;
        const size_t t = (size_t)b * S + sp; const float c = p.cs[t * 64 + i], sn = p.cs[t * 64 + 32 + i];
        const float r1 = z1 * c - z2 * sn, r2 = z2 * c + z1 * sn; z1 = r1; z2 = r2;
    }
    dst[i] = f2bf(z1); dst[i + 32] = f2bf(z2);
}

__device__ __forceinline__ void load_row64(const bf16* r, float* f) {
    const uint4* p4 = (const uint4*)r;
#pragma unroll
    for (int c = 0; c < 8; ++c) { const uint4 v = p4[c]; const unsigned w[4] = {v.x, v.y, v.z, v.w};
#pragma unroll
        for (int e = 0; e < 4; ++e) { f[c * 8 + e * 2] = __uint_as_float(w[e] << 16); f[c * 8 + e * 2 + 1] = __uint_as_float(w[e] & 0xffff0000u); } }
}
__device__ __forceinline__ float dot64(const float* a, const bf16* r) {
    const uint4* p4 = (const uint4*)r; float s = 0.f;
#pragma unroll
    for (int c = 0; c < 8; ++c) { const uint4 v = p4[c]; const unsigned w[4] = {v.x, v.y, v.z, v.w};
#pragma unroll
        for (int e = 0; e < 4; ++e) { s += a[c * 8 + e * 2] * __uint_as_float(w[e] << 16); s += a[c * 8 + e * 2 + 1] * __uint_as_float(w[e] & 0xffff0000u); } }
    return s;
}
__device__ __forceinline__ void axpy64(float* o, float a, const bf16* r) {
    const uint4* p4 = (const uint4*)r;
#pragma unroll
    for (int c = 0; c < 8; ++c) { const uint4 v = p4[c]; const unsigned w[4] = {v.x, v.y, v.z, v.w};
#pragma unroll
        for (int e = 0; e < 4; ++e) { o[c * 8 + e * 2] += a * __uint_as_float(w[e] << 16); o[c * 8 + e * 2 + 1] += a * __uint_as_float(w[e] & 0xffff0000u); } }
}
__device__ __forceinline__ void body_nsacmp(const P& p, int vb, char* smem) {
    const int wave = TIDX() >> 6, lane = TIDX() & 63, item = vb * 8 + wave;
    const int g = item & 1, t = (item >> 1) * 64 + lane;
    const int b = t / S, s = t % S; const int nv = s >= 31 ? (s - 31) / 16 + 1 : 0;
    float* my = (float*)smem + (size_t)wave * (64 * 65) + lane * 65;
    for (int j = 0; j < 64; ++j) my[j] = 0.f;
    const bf16* kc = p.kcmp + (size_t)(b * 2 + g) * 256 * 64; const bf16* vc = p.vcmp + (size_t)(b * 2 + g) * 256 * 64;
    for (int hh = 0; hh < 4; ++hh) {
        const int h = g * 4 + hh; float qv[64], o[64];
        load_row64(p.q + (size_t)t * 512 + h * 64, qv);
#pragma unroll
        for (int d = 0; d < 64; ++d) o[d] = 0.f;
        float m = -1e30f, l = 0.f;
        for (int n = 0; n < nv; ++n) { const float sc = dot64(qv, kc + n * 64); const float mn = fmaxf(m, sc); l = l * __expf(m - mn) + __expf(sc - mn); m = mn; }
        const float il = nv > 0 ? 1.f / l : 0.f;
        for (int n = 0; n < nv; ++n) {
            const float sc = dot64(qv, kc + n * 64); const float pn = __expf(sc - m) * il;
            axpy64(o, pn, vc + n * 64);
            const int j0 = n >> 2; if ((n & 3) != 3) my[j0] += pn; else { my[j0] += 0.5f * pn; my[j0 + 1] += 0.5f * pn; }
        }
#pragma unroll
        for (int d = 0; d < 64; ++d) p.ocmp[(size_t)t * 512 + h * 64 + d] = o[d];
    }
    const int cur = s >> 6; u64 mask = 0ull;
    for (int j = 0; j <= cur; ++j) {
        const float sj = (j == 0 || j == cur || j == cur - 1) ? 1e4f : my[j]; int rank = 0;
        for (int i = 0; i <= cur; ++i) { if (i == j) continue; const float si = (i == 0 || i == cur || i == cur - 1) ? 1e4f : my[i]; if (si > sj || (si == sj && i < j)) ++rank; }
        if (rank < 16) mask |= (1ull << j);
    }
    p.sel[(size_t)t * 2 + g] = mask;
}
__device__ __forceinline__ void body_nsaatt(const P& p, int vb) {
    const int wave = TIDX() >> 6, lane = TIDX() & 63, item = vb * 8 + wave;
    const int h = item & 7, t = (item >> 3) * 64 + lane, g = h >> 2;
    const int b = t / S, s = t % S, cur = s >> 6;
    const size_t seg = kvseg(p), ho = (size_t)(b * 2 + g) * S * 64;
    const bf16* ks = p.kv6 + 2 * seg + ho; const bf16* vs = p.kv6 + 3 * seg + ho; const bf16* kw = p.kv6 + 4 * seg + ho; const bf16* vw = p.kv6 + 5 * seg + ho;
    float qv[64], o[64];
    load_row64(p.q + (size_t)t * 512 + h * 64, qv);
    const float g0 = p.gates[(size_t)t * 24 + h * 3], g1 = p.gates[(size_t)t * 24 + h * 3 + 1], g2 = p.gates[(size_t)t * 24 + h * 3 + 2];
    float* accp = p.ocmp + (size_t)t * 512 + h * 64;
#pragma unroll
    for (int d = 0; d < 64; ++d) o[d] = 0.f;
    const u64 mask = p.sel[(size_t)t * 2 + g];
    float m = -1e30f, l = 0.f;
    for (int j = 0; j <= cur; ++j) {
        if (!((mask >> j) & 1ull)) continue;
        for (int kk = 0; kk < 64; ++kk) {
            const int key = j * 64 + kk; if (key > s) break;
            const float sc = dot64(qv, ks + (size_t)key * 64);
            if (sc > m) { const float f = __expf(m - sc); l *= f;
#pragma unroll
                for (int d = 0; d < 64; ++d) o[d] *= f;
                m = sc; }
            const float pe = __expf(sc - m); l += pe; axpy64(o, pe, vs + (size_t)key * 64);
        }
    }
    { const float f = g1 / l;
#pragma unroll
        for (int d = 0; d < 64; ++d) { accp[d] = g0 * accp[d] + f * o[d]; o[d] = 0.f; } }
    m = -1e30f; l = 0.f;
    for (int key = (s >= 511 ? s - 511 : 0); key <= s; ++key) {
        const float sc = dot64(qv, kw + (size_t)key * 64);
        if (sc > m) { const float f = __expf(m - sc); l *= f;
#pragma unroll
            for (int d = 0; d < 64; ++d) o[d] *= f;
            m = sc; }
        const float pe = __expf(sc - m); l += pe; axpy64(o, pe, vw + (size_t)key * 64);
    }
    { const float f = g2 / l;
#pragma unroll
        for (int d = 0; d < 64; ++d) p.onsa[(size_t)t * 512 + h * 64 + d] = f2bf(accp[d] + f * o[d]); }
}

__device__ __forceinline__ void body_glaa(const P& p, int vb) {
    const int c = TIDX() & 255, t = vb * 2 + (TIDX() >> 8); float z = p.b_a[c];
#pragma unroll
    for (int r = 0; r < 16; ++r) z += p.alow[(size_t)t * 16 + r] * p.w_a2[r * 256 + c];
    const float ls = fminf(z, 0.f) - log1pf(__expf(-fabsf(z)));
    p.ga[(size_t)t * 256 + c] = __expf(ls * (1.f / 16.f));
}
__device__ __forceinline__ void body_glascan(const P& p, int vb, char* smem) {
    const int sub = TIDX() >> 7, e = TIDX() & 127, bh = vb * 4 + sub, b = bh >> 2, h = bh & 3;
    float* sq = (float*)smem + sub * (3 * 32 * 64); float* sk = sq + 32 * 64; float* sg = sk + 32 * 64;
    float St[64];
#pragma unroll
    for (int d = 0; d < 64; ++d) St[d] = 0.f;
    for (int s0 = 0; s0 < S; s0 += 32) {
        __syncthreads();
        for (int i = e; i < 32 * 64; i += 128) { const int ss = i >> 6, d = i & 63; const size_t t = (size_t)b * S + s0 + ss;
            sq[i] = bf2f(p.gq[t * 256 + h * 64 + d]); sk[i] = bf2f(p.gk[t * 256 + h * 64 + d]); sg[i] = p.ga[t * 256 + h * 64 + d]; }
        __syncthreads();
        for (int ss = 0; ss < 32; ++ss) {
            const size_t t = (size_t)b * S + s0 + ss; const float v = bf2f(p.gv[t * 512 + h * 128 + e]); float o = 0.f;
#pragma unroll
            for (int d = 0; d < 64; ++d) { St[d] = sg[ss * 64 + d] * St[d] + sk[ss * 64 + d] * v; o += sq[ss * 64 + d] * St[d]; }
            p.oraw[t * 512 + h * 128 + e] = o;
        }
    }
    __syncthreads();
}
__device__ __forceinline__ void body_glanorm(const P& p, int vb) {
    const int idx = vb * NT + TIDX(); const int t = idx >> 2, h = idx & 3;
    const float* o = p.oraw + (size_t)t * 512 + h * 128; float ss = 0.f;
    for (int e = 0; e < 128; ++e) ss += o[e] * o[e];
    const float r = rsqrtf(ss * (1.f / 128.f) + 1e-6f);
    for (int e = 0; e < 128; ++e) p.gla[(size_t)t * 512 + h * 128 + e] = f2bf(o[e] * r * p.norm_g[h * 128 + e] * bf2f(p.rs[(size_t)t * 512 + h * 128 + e]));
}

__device__ __forceinline__ void body_proj(const P& p, int vb, char* smem) {
    const int n = (vb & 1) * NT + TIDX(), m0 = (vb >> 1) * 8;
    ngemm<512, true, false>((float*)smem, m0, p.w_pn, 1024, n, p.w_pg, 1024, n,
        [&](int m, int k) { return bf2f(p.onsa[(size_t)m * 512 + k]); }, [&](int m, int k) { return bf2f(p.gla[(size_t)m * 512 + k]); },
        [&](int m, float ya, float yb) { p.mixed[(size_t)m * 1024 + n] = f2bf(bf2f(p.sa[(size_t)m * 1024 + n]) * ya + bf2f(p.sb[(size_t)m * 1024 + n]) * yb); });
}
__device__ __forceinline__ void body_out(const P& p, int vb, char* smem) {
    const int n = (vb & 1) * NT + TIDX(), m0 = (vb >> 1) * 8;
    ngemm<1024, false, true>((float*)smem, m0, p.w_out, 1024, n, p.w_out, 1024, n,
        [&](int m, int k) { return bf2f(p.mixed[(size_t)m * 1024 + k]); }, [&](int m, int k) { return 0.f; },
        [&](int m, float z, float) { p.h1[(size_t)m * 1024 + n] = p.x[(size_t)m * 1024 + n] + z; });
}

__device__ __forceinline__ void body_route(const P& p, int vb, char* smem) {
    const int wave = TIDX() >> 6, lane = TIDX() & 63, t = vb * 8 + wave;
    const float4* hr = (const float4*)(p.h1 + (size_t)t * D);
    float v[16]; float ss = 0.f;
#pragma unroll
    for (int j = 0; j < 4; ++j) { const float4 a = hr[lane + 64 * j]; v[4 * j] = a.x; v[4 * j + 1] = a.y; v[4 * j + 2] = a.z; v[4 * j + 3] = a.w; ss += a.x * a.x + a.y * a.y + a.z * a.z + a.w * a.w; }
#pragma unroll
    for (int o = 1; o < 64; o <<= 1) ss += __shfl_xor(ss, o);
    const float rstd = rsqrtf(ss * (1.f / D) + 1e-6f);
#pragma unroll
    for (int j = 0; j < 4; ++j) {
        const float4 g = ((const float4*)p.g_ffn)[lane + 64 * j];
        v[4 * j] *= rstd * g.x; v[4 * j + 1] *= rstd * g.y; v[4 * j + 2] *= rstd * g.z; v[4 * j + 3] *= rstd * g.w;
        ushort4 o; o.x = f2bf(v[4 * j]); o.y = f2bf(v[4 * j + 1]); o.z = f2bf(v[4 * j + 2]); o.w = f2bf(v[4 * j + 3]);
        ((ushort4*)(p.vb + (size_t)t * D))[lane + 64 * j] = o;
    }
    float* sl = (float*)(smem + LDS_MISC) + wave * 40;
    for (int o = 0; o < 4; ++o) { float a = 0.f;
#pragma unroll
        for (int j = 0; j < 4; ++j)
#pragma unroll
            for (int e = 0; e < 4; ++e) a += v[4 * j + e] * p.w_grp[(size_t)(4 * (lane + 64 * j) + e) * 4 + o];
#pragma unroll
        for (int x = 1; x < 64; x <<= 1) a += __shfl_xor(a, x);
        if (lane == 0) sl[o] = a + p.b_grp[o]; }
    for (int o = 0; o < 32; ++o) { float a = 0.f;
#pragma unroll
        for (int j = 0; j < 4; ++j)
#pragma unroll
            for (int e = 0; e < 4; ++e) a += v[4 * j + e] * p.w_exp[(size_t)(4 * (lane + 64 * j) + e) * 32 + o];
#pragma unroll
        for (int x = 1; x < 64; x <<= 1) a += __shfl_xor(a, x);
        if (lane == 0) sl[4 + o] = a + p.b_exp[o]; }
    if (lane == 0) {
        int gs = 0; float gm = sl[0];
        for (int o = 1; o < 4; ++o) if (sl[o] > gm) { gm = sl[o]; gs = o; }
        float gsum = 0.f;
        for (int o = 0; o < 4; ++o) gsum += __expf(sl[o] - gm);
        const float pg = 1.f / gsum;
        const float* li = sl + 4 + gs * 8;
        int e0 = 0; float m0 = li[0];
        for (int e = 1; e < 8; ++e) if (li[e] > m0) { m0 = li[e]; e0 = e; }
        int e1 = -1; float m1 = -3e38f;
        for (int e = 0; e < 8; ++e) if (e != e0 && li[e] > m1) { m1 = li[e]; e1 = e; }
        const float p0 = 1.f, p1 = __expf(m1 - m0);
        const float w0 = pg * p0 / (p0 + p1), w1 = pg * p1 / (p0 + p1);
        const int x0 = gs * 8 + e0, x1 = gs * 8 + e1;
        const int s0 = (int)atomicAdd(&p.ctl[x0 * 32], 1u), s1 = (int)atomicAdd(&p.ctl[x1 * 32], 1u);
        p.list[(size_t)x0 * p.T + s0] = t; p.list[(size_t)x1 * p.T + s1] = t;
        p.tokexp[t * 2] = x0; p.tokexp[t * 2 + 1] = x1; p.tokslot[t * 2] = s0; p.tokslot[t * 2 + 1] = s1; p.tokw[t * 2] = w0; p.tokw[t * 2 + 1] = w1;
    }
}

__device__ __forceinline__ void body_route2(const P& p, int vb, char* smem) {
    const int tid = TIDX(), wave = tid >> 6, lane = tid & 63, t = vb * 8 + wave;
    const float4* hr = (const float4*)(p.h1 + (size_t)t * D);
    float4 v[4]; float ss = 0.f;
#pragma unroll
    for (int j = 0; j < 4; ++j) { v[j] = hr[lane + 64 * j]; ss += v[j].x * v[j].x + v[j].y * v[j].y + v[j].z * v[j].z + v[j].w * v[j].w; }
#pragma unroll
    for (int o = 1; o < 64; o <<= 1) ss += __shfl_xor(ss, o);
    const float rstd = rsqrtf(ss * (1.f / D) + 1e-6f);
#pragma unroll
    for (int j = 0; j < 4; ++j) {
        const float4 g = ((const float4*)p.g_ffn)[lane + 64 * j];
        v[j].x *= rstd * g.x; v[j].y *= rstd * g.y; v[j].z *= rstd * g.z; v[j].w *= rstd * g.w;
        ushort4 o; o.x = f2bf(v[j].x); o.y = f2bf(v[j].y); o.z = f2bf(v[j].z); o.w = f2bf(v[j].w);
        ((ushort4*)(p.vb + (size_t)t * D))[lane + 64 * j] = o;
    }
    float* sl = (float*)(smem + LDS_MISC) + wave * 40;
    float mine = 0.f;
#pragma unroll 4
    for (int o = 0; o < 36; ++o) { const float4* wrow = (const float4*)(p.wr + (size_t)o * 1024); float a = 0.f;
#pragma unroll
        for (int j = 0; j < 4; ++j) { const float4 w = wrow[lane + 64 * j]; a += v[j].x * w.x + v[j].y * w.y + v[j].z * w.z + v[j].w * w.w; }
#pragma unroll
        for (int x = 1; x < 64; x <<= 1) a += __shfl_xor(a, x);
        if (lane == o) mine = a; }
    if (lane < 36) sl[lane] = mine + (lane < 4 ? p.b_grp[lane] : p.b_exp[lane - 4]);
    asm volatile("s_waitcnt lgkmcnt(0)" ::: "memory");
    if (lane == 0) {
        int gs = 0; float gm = sl[0];
        for (int o = 1; o < 4; ++o) if (sl[o] > gm) { gm = sl[o]; gs = o; }
        float gsum = 0.f;
        for (int o = 0; o < 4; ++o) gsum += __expf(sl[o] - gm);
        const float pg = 1.f / gsum;
        const float* li = sl + 4 + gs * 8;
        int e0 = 0; float m0 = li[0];
        for (int e = 1; e < 8; ++e) if (li[e] > m0) { m0 = li[e]; e0 = e; }
        int e1 = -1; float m1 = -3e38f;
        for (int e = 0; e < 8; ++e) if (e != e0 && li[e] > m1) { m1 = li[e]; e1 = e; }
        const float p0 = 1.f, p1 = __expf(m1 - m0);
        const float w0 = pg * p0 / (p0 + p1), w1 = pg * p1 / (p0 + p1);
        const int x0 = gs * 8 + e0, x1 = gs * 8 + e1;
        const int s0 = (int)atomicAdd(&p.ctl[x0 * 32], 1u), s1 = (int)atomicAdd(&p.ctl[x1 * 32], 1u);
        p.list[(size_t)x0 * p.T + s0] = t; p.list[(size_t)x1 * p.T + s1] = t;
        p.tokexp[t * 2] = x0; p.tokexp[t * 2 + 1] = x1; p.tokslot[t * 2] = s0; p.tokslot[t * 2 + 1] = s1; p.tokw[t * 2] = w0; p.tokw[t * 2 + 1] = w1;
    }
}

__device__ __forceinline__ float tred8(float (&a)[8], int lane) {
    const bool b5 = lane & 32, b4 = lane & 16, b3 = lane & 8;
    float k4[4], k2[2], k1;
#pragma unroll
    for (int i = 0; i < 4; ++i) { const float snd = b5 ? a[i] : a[i + 4]; const float kp = b5 ? a[i + 4] : a[i]; k4[i] = kp + __shfl_xor(snd, 32); }
#pragma unroll
    for (int i = 0; i < 2; ++i) { const float snd = b4 ? k4[i] : k4[i + 2]; const float kp = b4 ? k4[i + 2] : k4[i]; k2[i] = kp + __shfl_xor(snd, 16); }
    { const float snd = b3 ? k2[0] : k2[1]; const float kp = b3 ? k2[1] : k2[0]; k1 = kp + __shfl_xor(snd, 8); }
    k1 += __shfl_xor(k1, 4); k1 += __shfl_xor(k1, 2); k1 += __shfl_xor(k1, 1);
    return k1;
}
__device__ __forceinline__ void body_route3(const P& p, int vb, char* smem) {
    const int tid = TIDX(), wave = tid >> 6, lane = tid & 63, t0 = vb * 64 + wave * 8;
    float4 v[8][4]; float ss[8];
#pragma unroll
    for (int tk = 0; tk < 8; ++tk) { const ushort4* hr = (const ushort4*)(p.h1b + (size_t)(t0 + tk) * D); float s = 0.f;
#pragma unroll
        for (int j = 0; j < 4; ++j) { const ushort4 hb = hr[lane + 64 * j]; v[tk][j] = make_float4(bf2f(hb.x), bf2f(hb.y), bf2f(hb.z), bf2f(hb.w)); s += v[tk][j].x * v[tk][j].x + v[tk][j].y * v[tk][j].y + v[tk][j].z * v[tk][j].z + v[tk][j].w * v[tk][j].w; }
        ss[tk] = s; }
    const float tot = tred8(ss, lane);
#pragma unroll
    for (int tk = 0; tk < 8; ++tk) { const float rstd = rsqrtf(__shfl(tot, tk * 8) * (1.f / D) + 1e-6f);
#pragma unroll
        for (int j = 0; j < 4; ++j) {
            const float4 g = ((const float4*)p.g_ffn)[lane + 64 * j];
            v[tk][j].x *= rstd * g.x; v[tk][j].y *= rstd * g.y; v[tk][j].z *= rstd * g.z; v[tk][j].w *= rstd * g.w;
            ushort4 o; o.x = f2bf(v[tk][j].x); o.y = f2bf(v[tk][j].y); o.z = f2bf(v[tk][j].z); o.w = f2bf(v[tk][j].w);
            ((ushort4*)(p.vb + (size_t)(t0 + tk) * D))[lane + 64 * j] = o; } }
    float* sl = (float*)smem + wave * (8 * 40);
    float* wl = (float*)smem + 4096;
    for (int o = 0; o < 36; ++o) {
        if (o == 0 || o == 18) { __syncthreads();
#pragma unroll
            for (int k = 0; k < 9; ++k) ((float4*)wl)[tid + k * 512] = ((const float4*)(p.wr + (size_t)o * 1024))[tid + k * 512];
            __syncthreads(); }
        const float4* wrow = (const float4*)(wl + (size_t)(o >= 18 ? o - 18 : o) * 1024); float a[8];
        float4 w[4];
#pragma unroll
        for (int j = 0; j < 4; ++j) w[j] = wrow[lane + 64 * j];
#pragma unroll
        for (int tk = 0; tk < 8; ++tk) { float s = 0.f;
#pragma unroll
            for (int j = 0; j < 4; ++j) s += v[tk][j].x * w[j].x + v[tk][j].y * w[j].y + v[tk][j].z * w[j].z + v[tk][j].w * w[j].w;
            a[tk] = s; }
        const float r = tred8(a, lane);
        if ((lane & 7) == 0) sl[(lane >> 3) * 40 + o] = r + (o < 4 ? p.b_grp[o] : p.b_exp[o - 4]); }
    asm volatile("s_waitcnt lgkmcnt(0)" ::: "memory");
    int* cntl = (int*)((float*)smem + 8 * 320); int* basel = cntl + 32;
    if (tid < 32) cntl[tid] = 0;
    __syncthreads();
    int x0 = 0, x1 = 0, l0 = 0, l1 = 0; float w0 = 0.f, w1 = 0.f;
    if (lane < 8) {
        const float* s8 = sl + lane * 40;
        int gs = 0; float gm = s8[0];
        for (int o = 1; o < 4; ++o) if (s8[o] > gm) { gm = s8[o]; gs = o; }
        float gsum = 0.f;
        for (int o = 0; o < 4; ++o) gsum += __expf(s8[o] - gm);
        const float pg = 1.f / gsum;
        const float* li = s8 + 4 + gs * 8;
        int e0 = 0; float m0 = li[0];
        for (int e = 1; e < 8; ++e) if (li[e] > m0) { m0 = li[e]; e0 = e; }
        int e1 = -1; float m1 = -3e38f;
        for (int e = 0; e < 8; ++e) if (e != e0 && li[e] > m1) { m1 = li[e]; e1 = e; }
        const float p0 = 1.f, p1 = __expf(m1 - m0);
        w0 = pg * p0 / (p0 + p1); w1 = pg * p1 / (p0 + p1);
        x0 = gs * 8 + e0; x1 = gs * 8 + e1;
        l0 = atomicAdd(&cntl[x0], 1); l1 = atomicAdd(&cntl[x1], 1);
    }
    __syncthreads();
    if (tid < 32) { const int c = cntl[tid]; basel[tid] = c > 0 ? (int)atomicAdd(&p.ctl[tid * 32], (unsigned)c) : 0; }
    __syncthreads();
    if (lane < 8) {
        const int t = t0 + lane; const int s0 = basel[x0] + l0, s1 = basel[x1] + l1;
        p.list[(size_t)x0 * p.T + s0] = t; p.list[(size_t)x1 * p.T + s1] = t;
        p.tokexp[t * 2] = x0; p.tokexp[t * 2 + 1] = x1; p.tokslot[t * 2] = s0; p.tokslot[t * 2 + 1] = s1; p.tokw[t * 2] = w0; p.tokw[t * 2 + 1] = w1;
    }
    __syncthreads();
}

__device__ __forceinline__ int* seg_bases(const P& p, char* smem) {
    int* sbase = (int*)(smem + LDS_MISC + 2048);
    __syncthreads();
    if (TIDX() == 0) { int acc = 0; for (int e = 0; e < NEXP; ++e) { sbase[e] = acc; acc += ((int)p.ctl[e * 32] + 255) & ~255; } sbase[NEXP] = acc; }
    __syncthreads();
    return sbase;
}
__device__ __forceinline__ void body_moe1(const P& p, int vb, char* smem) {
    int* sbase = seg_bases(p, smem); int* stok = sbase + 40;
    const int r0 = vb * 8; if (r0 >= sbase[NEXP]) return;
    int e = 0; while (r0 >= sbase[e + 1]) ++e;
    const int cnt = (int)p.ctl[e * 32];
    if (TIDX() < 8) { const int sl = r0 + TIDX() - sbase[e]; stok[TIDX()] = p.list[(size_t)e * p.T + (sl < cnt ? sl : 0)]; }
    __syncthreads();
    const int n = TIDX();
    const float* wg = p.w_gate + (size_t)e * 1024 * 512; const float* wu = p.w_up + (size_t)e * 1024 * 512;
    ngemm<1024, true, true>((float*)smem, 0, wg, 512, n, wu, 512, n,
        [&](int m, int k) { return bf2f(p.vb[(size_t)stok[m] * D + k]); }, [&](int m, int k) { return 0.f; },
        [&](int m, float zg, float zu) { p.H[(size_t)(r0 + m) * 512 + n] = f2bf(siluf_(zg) * zu); });
}
__device__ __forceinline__ void body_moe2(const P& p, int vb, char* smem) {
    int* sbase = seg_bases(p, smem);
    const int r0 = (vb >> 1) * 8; if (r0 >= sbase[NEXP]) return;
    int e = 0; while (r0 >= sbase[e + 1]) ++e;
    const int n = (vb & 1) * NT + TIDX();
    const float* wd = p.w_down + (size_t)e * 512 * 1024;
    ngemm<512, false, true>((float*)smem, r0, wd, 1024, n, wd, 1024, n,
        [&](int m, int k) { return bf2f(p.H[(size_t)m * 512 + k]); }, [&](int m, int k) { return 0.f; },
        [&](int m, float z, float) { p.Y[(size_t)m * 1024 + n] = f2bf(z); });
}
__device__ __forceinline__ void body_final(const P& p, int vb, char* smem) {
    int* sbase = seg_bases(p, smem);
    const int lane = TIDX() & 63, t = vb * 8 + (TIDX() >> 6);
    const int r0 = sbase[p.tokexp[t * 2]] + p.tokslot[t * 2], r1 = sbase[p.tokexp[t * 2 + 1]] + p.tokslot[t * 2 + 1];
    const float w0 = p.tokw[t * 2], w1 = p.tokw[t * 2 + 1];
    const float4* hr = (const float4*)(p.h1 + (size_t)t * D);
    float4 v[4]; float ss = 0.f;
#pragma unroll
    for (int j = 0; j < 4; ++j) {
        float4 a = hr[lane + 64 * j];
        const ushort4 y0 = ((const ushort4*)(p.Y + (size_t)r0 * D))[lane + 64 * j], y1 = ((const ushort4*)(p.Y + (size_t)r1 * D))[lane + 64 * j];
        a.x += w0 * bf2f(y0.x) + w1 * bf2f(y1.x); a.y += w0 * bf2f(y0.y) + w1 * bf2f(y1.y); a.z += w0 * bf2f(y0.z) + w1 * bf2f(y1.z); a.w += w0 * bf2f(y0.w) + w1 * bf2f(y1.w);
        v[j] = a; ss += a.x * a.x + a.y * a.y + a.z * a.z + a.w * a.w;
    }
#pragma unroll
    for (int o = 1; o < 64; o <<= 1) ss += __shfl_xor(ss, o);
    const float rstd = rsqrtf(ss * (1.f / D) + 1e-6f);
#pragma unroll
    for (int j = 0; j < 4; ++j) {
        const float4 g = ((const float4*)p.g_final)[lane + 64 * j];
        float4 o; o.x = v[j].x * rstd * g.x; o.y = v[j].y * rstd * g.y; o.z = v[j].z * rstd * g.z; o.w = v[j].w * rstd * g.w;
        ((float4*)(p.out + (size_t)t * D))[lane + 64 * j] = o;
    }
}

__device__ __forceinline__ void body_final_b(const P& p, int vb, char* smem) {
    int* sbase = seg_bases(p, smem);
    const int lane = TIDX() & 63, t = vb * 8 + (TIDX() >> 6);
    const int r0 = sbase[p.tokexp[t * 2]] + p.tokslot[t * 2], r1 = sbase[p.tokexp[t * 2 + 1]] + p.tokslot[t * 2 + 1];
    const float w0 = p.tokw[t * 2], w1 = p.tokw[t * 2 + 1];
    float4 v[4]; float ss = 0.f;
#pragma unroll
    for (int j = 0; j < 4; ++j) {
        const ushort4 hb = ((const ushort4*)(p.h1b + (size_t)t * D))[lane + 64 * j];
        const ushort4 y0 = ((const ushort4*)(p.Y + (size_t)r0 * D))[lane + 64 * j], y1 = ((const ushort4*)(p.Y + (size_t)r1 * D))[lane + 64 * j];
        float4 a; a.x = bf2f(hb.x) + w0 * bf2f(y0.x) + w1 * bf2f(y1.x); a.y = bf2f(hb.y) + w0 * bf2f(y0.y) + w1 * bf2f(y1.y); a.z = bf2f(hb.z) + w0 * bf2f(y0.z) + w1 * bf2f(y1.z); a.w = bf2f(hb.w) + w0 * bf2f(y0.w) + w1 * bf2f(y1.w);
        v[j] = a; ss += a.x * a.x + a.y * a.y + a.z * a.z + a.w * a.w;
    }
#pragma unroll
    for (int o = 1; o < 64; o <<= 1) ss += __shfl_xor(ss, o);
    const float rstd = rsqrtf(ss * (1.f / D) + 1e-6f);
#pragma unroll
    for (int j = 0; j < 4; ++j) {
        const float4 g = ((const float4*)p.g_final)[lane + 64 * j];
        float4 o; o.x = v[j].x * rstd * g.x; o.y = v[j].y * rstd * g.y; o.z = v[j].z * rstd * g.z; o.w = v[j].w * rstd * g.w;
        ((float4*)(p.out + (size_t)t * D))[lane + 64 * j] = o;
    }
}

namespace pg8 {
#define PG8_LAS __attribute__((address_space(3)))
typedef short bf16x8 __attribute__((ext_vector_type(8)));
typedef float f32x4 __attribute__((ext_vector_type(4)));
typedef unsigned u32x4 __attribute__((ext_vector_type(4)));
typedef unsigned u32x2 __attribute__((ext_vector_type(2)));
constexpr int BM = 256, BK = 64, HALF = 128, HTB = HALF * BK * 2, STAGE_BYTES = 8 * HTB, NXCD = 8, WGM = 8;

__host__ __device__ __forceinline__ int lds_byte(int r, int c) { const int st = (r >> 4) * 2 + (c >> 5), rr = r & 15, cc = c & 31, ob = rr * 64 + cc * 2; return st * 1024 + (ob ^ (((ob >> 9) & 1) << 5)); }
__host__ __device__ __forceinline__ void stage_rc(int b, int& R, int& C) { const int st = b / 1024, sb = b % 1024, swz = sb ^ (((sb >> 9) & 1) << 5); R = (st >> 1) * 16 + swz / 64; C = (st & 1) * 32 + (swz % 64) / 2; }
__host__ __device__ __forceinline__ int perm32(int rho) { const int n = rho >> 4, i = rho & 15; return 8 * (i >> 2) + 4 * n + (i & 3); }

struct Unit { int pm, pn; const char* A; const char* B; int tag; };

struct TileOrder {
    int nM, nN, nwg, G, c;
    __device__ void init(int nM_, int nN_, int G_, int c_) { nM = nM_; nN = nN_; nwg = nM * nN; G = G_; c = c_; }
    __device__ bool next(int i, int& pm, int& pn) const {
        const long L = (long)i * G + c; if (L >= nwg) return false;
        int wgid = (int)L; { const int q = nwg / NXCD, r = nwg % NXCD, xcd = wgid % NXCD, off = wgid / NXCD; wgid = (xcd < r ? xcd * (q + 1) : r * (q + 1) + (xcd - r) * q) + off; }
        const int nig = WGM * nN, gid = wgid / nig, fm = gid * WGM, gsz = (nM - fm) < WGM ? (nM - fm) : WGM;
        pm = fm + ((wgid % nig) % gsz); pn = (wgid % nig) / gsz; return true;
    }
};
struct DenseSched {
    TileOrder o; const char* A; const char* B; int lda, ldb;
    __device__ void init(const void* A_, const void* B_, int M, int N, int lda_, int ldb_) { A = (const char*)A_; B = (const char*)B_; lda = lda_; ldb = ldb_; o.init(M / BM, N / BM, gridDim.x, blockIdx.x); }
    __device__ __forceinline__ bool next(int i, Unit& u) const { if (!o.next(i, u.pm, u.pn)) return false; u.A = A + (size_t)u.pm * BM * lda * 2; u.B = B + (size_t)u.pn * BM * ldb * 2; u.tag = 0; return true; }
    __device__ __forceinline__ unsigned arow(const Unit&, int r) const { return (unsigned)r * (unsigned)lda * 2u; }
    __device__ __forceinline__ void a_ready(const Unit&) const {}
    __device__ __forceinline__ void done(const Unit&) const {}
};

__device__ __forceinline__ unsigned cvt_pk_bf16(float lo, float hi) { unsigned r; asm volatile("v_cvt_pk_bf16_f32 %0, %1, %2" : "=v"(r) : "v"(lo), "v"(hi)); return r; }

template <class Epi, class Sched, bool ALIGN_EPI, bool GATHER>
__device__ __forceinline__ void gemm_phase(PG8_LAS unsigned char* lds, const int K, const int lda, const int ldb, const Sched& S, const Epi& E) {
    const int tid = TIDX(), wid = __builtin_amdgcn_readfirstlane(tid >> 6), lane = tid & 63, wr = wid >> 2, wc = wid & 3, fr = lane & 15, fq = lane >> 4;
    const int nt = K / BK;
    int sR[2], sC[2];
    unsigned voffA[2], voffB[2];
#pragma unroll
    for (int i = 0; i < 2; ++i) { stage_rc(tid * 16 + i * 8192, sR[i], sC[i]); const int Rb = Epi::PERM ? ((sR[i] & ~31) + perm32(sR[i] & 31)) : sR[i];
        voffA[i] = (unsigned)(sR[i] * lda + sC[i]) * 2u; voffB[i] = (unsigned)(Rb * ldb + sC[i]) * 2u; }
    unsigned gA[2][2], gN[2][2];
    const size_t kstep = (size_t)(BK * 2);
    const size_t hstepA = (size_t)HALF * lda * 2, hstepB = (size_t)HALF * ldb * 2;
    const unsigned ldsw = (unsigned)wid * 1024u;
    const int aoff = lds_byte(wr * 64 + fr, fq * 8), boff = lds_byte(wc * 32 + fr, fq * 8);
#define PG8_SA(b, h) (((b) * 2 + (h)) * HTB)
#define PG8_SB(b, h) ((4 + (b) * 2 + (h)) * HTB)
#define PG8_GLDS(bufoff, gptr, i_) __builtin_amdgcn_global_load_lds((const unsigned*)(gptr), (PG8_LAS unsigned*)(lds + (bufoff) + ldsw + (i_) * 8192), 16, 0, 0)
#define PG8_STAGE_B(bufoff, gbase) do { _Pragma("unroll") for (int _i = 0; _i < 2; ++_i) PG8_GLDS(bufoff, (const char*)(gbase) + voffB[_i], _i); } while (0)
#define PG8_STAGE_A(bufoff, gb, h, NX) do { _Pragma("unroll") for (int _i = 0; _i < 2; ++_i) { \
        if constexpr (GATHER) { const unsigned _o = (NX) ? gN[h][_i] : gA[h][_i]; PG8_GLDS(bufoff, (const char*)(gb) + _o, _i); } \
        else { PG8_GLDS(bufoff, (const char*)(gb) + (h) * hstepA + voffA[_i], _i); } } } while (0)
#define PG8_LDA(dst, b, h) do { _Pragma("unroll") for (int m = 0; m < 4; ++m) _Pragma("unroll") for (int k = 0; k < 2; ++k) dst[m][k] = *(const PG8_LAS bf16x8*)(lds + PG8_SA(b, h) + aoff + m * 2048 + k * 1024); } while (0)
#define PG8_LDB(dst, b, h) do { _Pragma("unroll") for (int n = 0; n < 2; ++n) _Pragma("unroll") for (int k = 0; k < 2; ++k) dst[n][k] = *(const PG8_LAS bf16x8*)(lds + PG8_SB(b, h) + boff + n * 2048 + k * 1024); } while (0)
#define PG8_MMA(ai, bj, At, Bt) do { __builtin_amdgcn_s_setprio(1); _Pragma("unroll") for (int m = 0; m < 4; ++m) _Pragma("unroll") for (int n = 0; n < 2; ++n) _Pragma("unroll") for (int k = 0; k < 2; ++k) \
        acc[ai][bj][m][n] = __builtin_amdgcn_mfma_f32_16x16x32_bf16(Bt[n][k], At[m][k], acc[ai][bj][m][n], 0, 0, 0); __builtin_amdgcn_s_setprio(0); } while (0)
#define PG8_WAIT_V(n) asm volatile("s_waitcnt vmcnt(" #n ")" ::: "memory")
#define PG8_WAIT_L(n) asm volatile("s_waitcnt lgkmcnt(" #n ")" ::: "memory")
#define PG8_BAR __builtin_amdgcn_s_barrier()
#define PG8_SCHED __builtin_amdgcn_sched_barrier(0)
#define PG8_GOFF(dst, u) do { if constexpr (GATHER) { _Pragma("unroll") for (int _h = 0; _h < 2; ++_h) _Pragma("unroll") for (int _i = 0; _i < 2; ++_i) dst[_h][_i] = S.arow(u, _h * HALF + sR[_i]) + (unsigned)sC[_i] * 2u; } } while (0)
    Unit cur, nxt; int ui = 0;
    if (!S.next(0, cur)) return;
    f32x4 acc[2][2][4][2];
#pragma unroll
    for (int a = 0; a < 2; ++a)
#pragma unroll
        for (int b = 0; b < 2; ++b)
#pragma unroll
            for (int m = 0; m < 4; ++m)
#pragma unroll
                for (int n = 0; n < 2; ++n) acc[a][b][m][n] = (f32x4){0.f, 0.f, 0.f, 0.f};
    bf16x8 At[4][2], B0[2][2], B1[2][2];
    const char* cA = cur.A; const char* cB = cur.B;
    S.a_ready(cur);
    PG8_GOFF(gA, cur);
    if constexpr (GATHER) { PG8_WAIT_V(0); }
    PG8_STAGE_B(PG8_SB(0, 0), cB); PG8_STAGE_B(PG8_SB(0, 1), cB + hstepB); PG8_STAGE_A(PG8_SA(0, 0), cA, 0, false); PG8_STAGE_A(PG8_SA(0, 1), cA, 1, false);
    if (wr == 1) PG8_BAR;
    PG8_WAIT_V(2); PG8_BAR;
    PG8_STAGE_B(PG8_SB(1, 0), cB + kstep); PG8_STAGE_A(PG8_SA(1, 0), cA + kstep, 0, false); PG8_STAGE_B(PG8_SB(1, 1), cB + hstepB + kstep);
    PG8_WAIT_V(6); PG8_BAR;
    for (;;) {
        const bool has_next = S.next(ui + 1, nxt);
        const char* nA = has_next ? nxt.A : cA; const char* nB = has_next ? nxt.B : cB;
        if constexpr (GATHER) { if (has_next) { PG8_GOFF(gN, nxt); } else {
#pragma unroll
            for (int _h = 0; _h < 2; ++_h)
#pragma unroll
                for (int _i = 0; _i < 2; ++_i) gN[_h][_i] = gA[_h][_i]; } }
        for (int t = 0; t < nt; t += 2) {
            const bool last = (t == nt - 2);
            if (last && has_next) S.a_ready(nxt);
            const char* a1 = cA + (size_t)(t + 1) * kstep;
            const char* a2 = last ? nA : cA + (size_t)(t + 2) * kstep; const char* b2 = last ? nB : cB + (size_t)(t + 2) * kstep;
            const char* a3 = a2 + kstep; const char* b3 = b2 + kstep;
            PG8_LDB(B0, 0, 0); PG8_LDB(B1, 0, 1); PG8_SCHED; PG8_LDA(At, 0, 0); PG8_STAGE_A(PG8_SA(1, 1), a1, 1, false);
            PG8_WAIT_V(8); PG8_WAIT_L(0); PG8_BAR; PG8_MMA(0, 0, At, B0); PG8_MMA(0, 1, At, B1); PG8_BAR; PG8_SCHED;
            PG8_LDA(At, 0, 1); PG8_STAGE_B(PG8_SB(0, 0), b2); PG8_STAGE_B(PG8_SB(0, 1), b2 + hstepB); PG8_STAGE_A(PG8_SA(0, 0), a2, 0, last);
            PG8_WAIT_V(8); PG8_WAIT_L(0); PG8_BAR; PG8_MMA(1, 0, At, B0); PG8_MMA(1, 1, At, B1); PG8_BAR; PG8_SCHED;
            PG8_LDB(B0, 1, 0); PG8_LDB(B1, 1, 1); PG8_SCHED; PG8_LDA(At, 1, 0); PG8_STAGE_A(PG8_SA(0, 1), a2, 1, last);
            PG8_WAIT_V(8); PG8_WAIT_L(0); PG8_BAR; PG8_MMA(0, 0, At, B0); PG8_MMA(0, 1, At, B1); PG8_BAR; PG8_SCHED;
            PG8_LDA(At, 1, 1); PG8_STAGE_B(PG8_SB(1, 0), b3); PG8_STAGE_B(PG8_SB(1, 1), b3 + hstepB); PG8_STAGE_A(PG8_SA(1, 0), a3, 0, last);
            PG8_WAIT_V(8); PG8_WAIT_L(0); PG8_BAR; PG8_MMA(1, 0, At, B0); PG8_MMA(1, 1, At, B1); PG8_BAR; PG8_SCHED;
        }
        if constexpr (ALIGN_EPI) { if (wr == 0) PG8_BAR; }
        E(acc, cur, wr, wc, fr, fq); S.done(cur);
        if (!has_next) break;
        if (!(Epi::CHAIN && !(cur.tag & 1))) {
#pragma unroll
        for (int a = 0; a < 2; ++a)
#pragma unroll
            for (int b = 0; b < 2; ++b)
#pragma unroll
                for (int m = 0; m < 4; ++m)
#pragma unroll
                    for (int n = 0; n < 2; ++n) acc[a][b][m][n] = (f32x4){0.f, 0.f, 0.f, 0.f};
        }
        cur = nxt; cA = nA; cB = nB; ++ui;
        if constexpr (GATHER) {
#pragma unroll
            for (int _h = 0; _h < 2; ++_h)
#pragma unroll
                for (int _i = 0; _i < 2; ++_i) gA[_h][_i] = gN[_h][_i]; }
        if constexpr (ALIGN_EPI) { if (wr == 1) PG8_BAR; }
    }
    PG8_WAIT_V(0);
    if constexpr (!ALIGN_EPI) { if (wr == 0) PG8_BAR; }
    PG8_BAR;
#undef PG8_SA
#undef PG8_SB
#undef PG8_GLDS
#undef PG8_STAGE_A
#undef PG8_STAGE_B
#undef PG8_LDA
#undef PG8_LDB
#undef PG8_MMA
#undef PG8_WAIT_V
#undef PG8_WAIT_L
#undef PG8_BAR
#undef PG8_SCHED
#undef PG8_GOFF
}
}

typedef float f32x4_t __attribute__((ext_vector_type(4)));
__device__ __forceinline__ int inproj_row(int j) {
    if (j < 512) { const int h = j >> 6, d = j & 63; return h * 64 + 2 * (d & 31) + (d >> 5); }
    if (j < 1280) { const int seg = (j - 512) >> 7, cc = (j - 512) & 127; int col = cc; if (seg == 2 || seg == 4) { const int g = cc >> 6, d = cc & 63; col = g * 64 + 2 * (d & 31) + (d >> 5); } return (2 + (seg >> 1)) * 256 + (seg & 1) * 128 + col; }
    if (j < 1304) return 11 * 256 + (j - 1280);
    if (j < 1560) return 5 * 256 + (j - 1304);
    if (j < 1816) return 6 * 256 + (j - 1560);
    if (j < 2328) return 7 * 256 + (j - 1816);
    if (j < 2344) return 11 * 256 + 32 + (j - 2328);
    if (j < 2856) return 9 * 256 + (j - 2344);
    if (j < 3880) return 12 * 256 + (j - 2856);
    return 16 * 256 + (j - 3880);
}
__device__ __forceinline__ unsigned pk2(float lo, float hi) { typedef float f2_ __attribute__((ext_vector_type(2))); typedef __bf16 b2_ __attribute__((ext_vector_type(2))); const f2_ v = {lo, hi}; const b2_ b = __builtin_convertvector(v, b2_); return __builtin_bit_cast(unsigned, b); }
template <class RM>
__device__ __forceinline__ void transpose_item(const float* W, int ldw, int N, bf16* WT, int ldt, float* scr, int k0, int n0, int lane, RM rm) {
    const int rr = lane >> 4, c4 = (lane & 15) * 4; const bool inb = n0 + c4 < N;
    f32x4_t v[16];
#pragma unroll
    for (int i = 0; i < 16; ++i) v[i] = inb ? *(const f32x4_t*)(W + (size_t)(k0 + 4 * i + rr) * ldw + n0 + c4) : (f32x4_t){0.f, 0.f, 0.f, 0.f};
#pragma unroll
    for (int i = 0; i < 16; ++i) *(f32x4_t*)(scr + (4 * i + rr) * 68 + c4) = v[i];
    asm volatile("s_waitcnt lgkmcnt(0)" ::: "memory");
    const int c = lane & 7;
#pragma unroll
    for (int j = 0; j < 8; ++j) { const int n = (lane >> 3) + 8 * j; const float* s = scr + (8 * c) * 68 + n;
        uint4 o; o.x = pk2(s[0 * 68], s[1 * 68]); o.y = pk2(s[2 * 68], s[3 * 68]); o.z = pk2(s[4 * 68], s[5 * 68]); o.w = pk2(s[6 * 68], s[7 * 68]);
        const int row = (n0 + n < N) ? rm(n0 + n) : -1;
        if (row >= 0) *(uint4*)(WT + (size_t)row * ldt + k0 + 8 * c) = o; }
    asm volatile("s_waitcnt lgkmcnt(0)" ::: "memory");
}
constexpr int PREP_I_WIN = 16 * 77, PREP_I_C1 = 4 * 64, PREP_I_PN = 128, PREP_I_PG = 128, PREP_I_WO = 256, PREP_I_EXP = 3 * 32 * 128;
constexpr int PREP_ITEMS = PREP_I_WIN + PREP_I_C1 + PREP_I_PN + PREP_I_PG + PREP_I_WO + PREP_I_EXP;
__device__ __forceinline__ void prep_item(const P& p, int it, float* scr, int lane) {
    if (it < PREP_I_WIN) { const int kb = it / 77, nb = it % 77; transpose_item(p.w_in, INW, INW, p.Wt_in, 1024, scr, kb * 64, nb * 64, lane, [](int n) { return inproj_row(n); }); return; }
    it -= PREP_I_WIN;
    if (it < PREP_I_C1) { const int mat = it >> 6, r = it & 63, kb = r >> 2, nb = r & 3, kv = mat >> 1, half = mat & 1;
        const float* W = (kv ? p.cw1_v : p.cw1_k) + (size_t)half * 1024 * 256;
        transpose_item(W, 256, 256, p.Wc1 + (size_t)kv * 512 * 1024, 1024, scr, kb * 64, nb * 64, lane, [half](int n) { return half * 256 + n; }); return; }
    it -= PREP_I_C1;
    if (it < PREP_I_PN) { transpose_item(p.w_pn, 1024, 1024, p.Wpn, 512, scr, (it >> 4) * 64, (it & 15) * 64, lane, [](int n) { return n; }); return; }
    it -= PREP_I_PN;
    if (it < PREP_I_PG) { transpose_item(p.w_pg, 1024, 1024, p.Wpg, 512, scr, (it >> 4) * 64, (it & 15) * 64, lane, [](int n) { return n; }); return; }
    it -= PREP_I_PG;
    if (it < PREP_I_WO) { transpose_item(p.w_out, 1024, 1024, p.Wo, 1024, scr, (it >> 4) * 64, (it & 15) * 64, lane, [](int n) { return n; }); return; }
    it -= PREP_I_WO;
    { const int which = it / (32 * 128), r = it % (32 * 128), e = r >> 7, r2 = r & 127;
        if (which == 0) transpose_item(p.w_gate + (size_t)e * 1024 * 512, 512, 512, p.Wgu + (size_t)e * 1024 * 1024, 1024, scr, (r2 >> 3) * 64, (r2 & 7) * 64, lane, [](int n) { return (n >> 7) * 256 + (n & 127); });
        else if (which == 1) transpose_item(p.w_up + (size_t)e * 1024 * 512, 512, 512, p.Wgu + (size_t)e * 1024 * 1024, 1024, scr, (r2 >> 3) * 64, (r2 & 7) * 64, lane, [](int n) { return (n >> 7) * 256 + 128 + (n & 127); });
        else transpose_item(p.w_down + (size_t)e * 512 * 1024, 1024, 1024, p.Wd + (size_t)e * 1024 * 512, 512, scr, (r2 >> 4) * 64, (r2 & 15) * 64, lane, [](int n) { return n; }); }
}
__device__ __forceinline__ void phase_prep_(const P& p, char* smem);
__device__ __forceinline__ void prep_b1p(const P& p, char* smem);
__device__ __forceinline__ void phase_prep(const P& p, char* smem) { prep_b1p(p, smem); phase_prep_(p, smem); }
__device__ __forceinline__ void phase_prep_(const P& p, char* smem) {
    const int wave = TIDX() >> 6, lane = TIDX() & 63;
    float* scr = (float*)smem + wave * (64 * 68);
    const int gw = blockIdx.x * 8 + wave, NGW = gridDim.x * 8;
    for (int it = gw; it < PREP_ITEMS; it += NGW) prep_item(p, it, scr, lane);
    for (int i = blockIdx.x * NT + TIDX(); i < 216 * 128; i += gridDim.x * NT) { int r = i >> 7; r = r < 8 ? 24 + r : 40 + r; *(uint4*)(p.Wt_in + (size_t)(11 * 256 + r) * 1024 + (i & 127) * 8) = make_uint4(0, 0, 0, 0); }
    for (int i = blockIdx.x * NT + TIDX(); i < 36 * 1024; i += gridDim.x * NT) { const int o = i >> 10, k = i & 1023; p.wr[i] = o < 4 ? p.w_grp[k * 4 + o] : p.w_exp[k * 32 + (o - 4)]; }
    for (int vb = blockIdx.x; vb < p.T / 16; vb += gridDim.x) body_rms2(p, vb);
    for (int vb = blockIdx.x; vb < p.T * 32 / NT; vb += gridDim.x) body_cs(p, vb);
}

struct EpiInA {
    static constexpr bool PERM = true, CHAIN = false;
    P p;
    __device__ __forceinline__ static void rope4(const float* cs, int t, int i0, const pg8::f32x4& v0, const pg8::f32x4& v1, float sc, pg8::u32x2& lo, pg8::u32x2& hi) {
        const f32x4_t c = *(const f32x4_t*)(cs + (size_t)t * 64 + i0), s = *(const f32x4_t*)(cs + (size_t)t * 64 + 32 + i0);
        const float a0 = (v0[0] * c[0] - v0[1] * s[0]) * sc, b0 = (v0[1] * c[0] + v0[0] * s[0]) * sc;
        const float a1 = (v0[2] * c[1] - v0[3] * s[1]) * sc, b1 = (v0[3] * c[1] + v0[2] * s[1]) * sc;
        const float a2 = (v1[0] * c[2] - v1[1] * s[2]) * sc, b2 = (v1[1] * c[2] + v1[0] * s[2]) * sc;
        const float a3 = (v1[2] * c[3] - v1[3] * s[3]) * sc, b3 = (v1[3] * c[3] + v1[2] * s[3]) * sc;
        lo.x = pk2(a0, a1); lo.y = pk2(a2, a3); hi.x = pk2(b0, b1); hi.y = pk2(b2, b3);
    }
    __device__ __forceinline__ static pg8::u32x4 pack8(const pg8::f32x4& v0, const pg8::f32x4& v1) { pg8::u32x4 w; w.x = pk2(v0[0], v0[1]); w.y = pk2(v0[2], v0[3]); w.z = pk2(v1[0], v1[1]); w.w = pk2(v1[2], v1[3]); return w; }
    __device__ __forceinline__ void operator()(const pg8::f32x4 (&acc)[2][2][4][2], const pg8::Unit& u, int wr, int wc, int fr, int fq) const {
        const int pn = u.pn, c8 = wc * 32 + 8 * fq; const size_t seg = kvseg(p);
#pragma unroll
        for (int ai = 0; ai < 2; ++ai)
#pragma unroll
            for (int m = 0; m < 4; ++m) {
                const int t = u.pm * 256 + ai * 128 + wr * 64 + m * 16 + fr; const int b = t / S, s = t % S;
#pragma unroll
                for (int bj = 0; bj < 2; ++bj) {
                    const pg8::f32x4 v0 = acc[ai][bj][m][0], v1 = acc[ai][bj][m][1];
                    if (pn <= 1) {
                        const int cq = pn * 256 + bj * 128 + c8, h = cq >> 6, i0 = (cq & 63) >> 1; pg8::u32x2 lo, hi;
                        rope4(p.cs, t, i0, v0, v1, 0.125f, lo, hi);
                        bf16* dst = p.q + (size_t)t * 512 + h * 64 + i0; *(pg8::u32x2*)dst = lo; *(pg8::u32x2*)(dst + 32) = hi;
                    } else if (pn <= 4) {
                        const int sgi = (pn - 2) * 2 + bj, g = c8 >> 6; bf16* base = p.kv6 + (size_t)sgi * seg + ((size_t)(b * 2 + g) * S + s) * 64;
                        if (bj == 0 && pn >= 3) { const int i0 = (c8 & 63) >> 1; pg8::u32x2 lo, hi; rope4(p.cs, t, i0, v0, v1, 1.f, lo, hi); *(pg8::u32x2*)(base + i0) = lo; *(pg8::u32x2*)(base + 32 + i0) = hi; }
                        else *(pg8::u32x4*)(base + (c8 & 63)) = pack8(v0, v1);
                    } else if (pn == 5) { *(pg8::u32x4*)(p.gq + (size_t)t * 256 + bj * 128 + c8) = pack8(v0 * 0.125f, v1 * 0.125f);
                    } else if (pn == 6) { *(pg8::u32x4*)(p.gk + (size_t)t * 256 + bj * 128 + c8) = pack8(v0, v1);
                    } else if (pn <= 8) { *(pg8::u32x4*)(p.gv + (size_t)t * 512 + (pn - 7) * 256 + bj * 128 + c8) = pack8(v0, v1);
                    } else if (pn <= 10) {
                        pg8::f32x4 a, c;
#pragma unroll
                        for (int e = 0; e < 4; ++e) { a[e] = siluf_(v0[e]); c[e] = siluf_(v1[e]); }
                        *(pg8::u32x4*)(p.rs + (size_t)t * 512 + (pn - 9) * 256 + bj * 128 + c8) = pack8(a, c);
                    } else {
                        if (bj == 0) {
                            if (c8 < 24) { float* d = p.gates + (size_t)t * 24 + c8;
#pragma unroll
                                for (int e = 0; e < 4; ++e) { d[e] = sigmoidf_(v0[e]); d[4 + e] = sigmoidf_(v1[e]); } }
                            else if (c8 >= 32 && c8 < 48) { float* d = p.alow + (size_t)t * 16 + (c8 - 32);
#pragma unroll
                                for (int e = 0; e < 4; ++e) { d[e] = v0[e]; d[4 + e] = v1[e]; } }
                        }
                    }
                }
            }
    }
};
struct EpiSig {
    static constexpr bool PERM = true, CHAIN = false;
    bf16* sa; bf16* sb;
    __device__ __forceinline__ void operator()(const pg8::f32x4 (&acc)[2][2][4][2], const pg8::Unit& u, int wr, int wc, int fr, int fq) const {
        bf16* base = (u.pn < 4 ? sa : sb) + (u.pn & 3) * 256 + wc * 32 + 8 * fq;
#pragma unroll
        for (int ai = 0; ai < 2; ++ai)
#pragma unroll
            for (int m = 0; m < 4; ++m) { const int t = u.pm * 256 + ai * 128 + wr * 64 + m * 16 + fr;
#pragma unroll
                for (int bj = 0; bj < 2; ++bj) { pg8::f32x4 a, c;
#pragma unroll
                    for (int e = 0; e < 4; ++e) { a[e] = sigmoidf_(acc[ai][bj][m][0][e]); c[e] = sigmoidf_(acc[ai][bj][m][1][e]); }
                    *(pg8::u32x4*)(base + (size_t)t * 1024 + bj * 128) = EpiInA::pack8(a, c); } }
    }
};
__device__ __forceinline__ void phase_inA(const P& p, char* smem) {
    pg8::DenseSched S; S.init(p.u, p.Wt_in, p.T, 3072, 1024, 1024);
    EpiInA E{p};
    pg8::gemm_phase<EpiInA, pg8::DenseSched, true, false>((PG8_LAS unsigned char*)smem, 1024, 1024, 1024, S, E);
}
__device__ __forceinline__ void phase_inB(const P& p, char* smem) {
    pg8::DenseSched S; S.init(p.u, p.Wt_in + (size_t)3072 * 1024, p.T, 2048, 1024, 1024);
    EpiSig E{p.sa, p.sb};
    pg8::gemm_phase<EpiSig, pg8::DenseSched, true, false>((PG8_LAS unsigned char*)smem, 1024, 1024, 1024, S, E);
}

struct EpiProj {
    static constexpr bool PERM = true, CHAIN = false;
    const bf16* g; bf16* mixed; int pass;
    __device__ __forceinline__ void operator()(const pg8::f32x4 (&acc)[2][2][4][2], const pg8::Unit& u, int wr, int wc, int fr, int fq) const {
        const int col0 = u.pn * 256 + wc * 32 + 8 * fq;
#pragma unroll
        for (int ai = 0; ai < 2; ++ai)
#pragma unroll
            for (int m = 0; m < 4; ++m) { const size_t t = (size_t)(u.pm * 256 + ai * 128 + wr * 64 + m * 16 + fr);
#pragma unroll
                for (int bj = 0; bj < 2; ++bj) { const size_t off = t * 1024 + col0 + bj * 128;
                    const uint4 gv = *(const uint4*)(g + off); const unsigned gw[4] = {gv.x, gv.y, gv.z, gv.w};
                    float r[8];
#pragma unroll
                    for (int e = 0; e < 4; ++e) { const float a = e < 2 ? acc[ai][bj][m][0][2 * e] : acc[ai][bj][m][1][2 * e - 4], b = e < 2 ? acc[ai][bj][m][0][2 * e + 1] : acc[ai][bj][m][1][2 * e - 3];
                        r[2 * e] = __uint_as_float(gw[e] << 16) * a; r[2 * e + 1] = __uint_as_float(gw[e] & 0xffff0000u) * b; }
                    if (pass) { const uint4 mv = *(const uint4*)(mixed + off); const unsigned mw[4] = {mv.x, mv.y, mv.z, mv.w};
#pragma unroll
                        for (int e = 0; e < 4; ++e) { r[2 * e] += __uint_as_float(mw[e] << 16); r[2 * e + 1] += __uint_as_float(mw[e] & 0xffff0000u); } }
                    uint4 o; o.x = pk2(r[0], r[1]); o.y = pk2(r[2], r[3]); o.z = pk2(r[4], r[5]); o.w = pk2(r[6], r[7]);
                    *(uint4*)(mixed + off) = o; } }
    }
};
struct EpiOut {
    static constexpr bool PERM = true, CHAIN = false;
    const float* x; bf16* h1b;
    __device__ __forceinline__ void operator()(const pg8::f32x4 (&acc)[2][2][4][2], const pg8::Unit& u, int wr, int wc, int fr, int fq) const {
        const int col0 = u.pn * 256 + wc * 32 + 8 * fq;
#pragma unroll
        for (int ai = 0; ai < 2; ++ai)
#pragma unroll
            for (int m = 0; m < 4; ++m) { const size_t off = (size_t)(u.pm * 256 + ai * 128 + wr * 64 + m * 16 + fr) * 1024 + col0;
#pragma unroll
                for (int bj = 0; bj < 2; ++bj) { const pg8::f32x4 x0 = *(const pg8::f32x4*)(x + off + bj * 128), x1 = *(const pg8::f32x4*)(x + off + bj * 128 + 4);
                    *(pg8::u32x4*)(h1b + off + bj * 128) = EpiInA::pack8(x0 + acc[ai][bj][m][0], x1 + acc[ai][bj][m][1]); } }
    }
};
struct ProjSched {
    pg8::TileOrder o; const char *A0, *A1, *B0, *B1;
    __device__ __forceinline__ bool next(int i, pg8::Unit& u) const {
        if (!o.next(i >> 1, u.pm, u.pn)) return false;
        const int part = i & 1; u.tag = part;
        u.A = (part ? A1 : A0) + (size_t)u.pm * 256 * 512 * 2; u.B = (part ? B1 : B0) + (size_t)u.pn * 256 * 512 * 2; return true;
    }
    __device__ __forceinline__ unsigned arow(const pg8::Unit&, int r) const { return (unsigned)r * 1024u; }
    __device__ __forceinline__ void a_ready(const pg8::Unit&) const {}
    __device__ __forceinline__ void done(const pg8::Unit&) const {}
};
struct EpiProj2 {
    static constexpr bool PERM = true, CHAIN = true;
    const bf16* sa; const bf16* sb; bf16* mixed;
    __device__ __forceinline__ void operator()(const pg8::f32x4 (&acc_)[2][2][4][2], const pg8::Unit& u, int wr, int wc, int fr, int fq) const {
        pg8::f32x4 (&acc)[2][2][4][2] = const_cast<pg8::f32x4 (&)[2][2][4][2]>(acc_);
        const int col0 = u.pn * 256 + wc * 32 + 8 * fq;
#pragma unroll
        for (int ai = 0; ai < 2; ++ai)
#pragma unroll
            for (int m = 0; m < 4; ++m) { const size_t t = (size_t)(u.pm * 256 + ai * 128 + wr * 64 + m * 16 + fr);
#pragma unroll
                for (int bj = 0; bj < 2; ++bj) { const size_t off = t * 1024 + col0 + bj * 128;
                    const uint4 bv = *(const uint4*)(sb + off); const unsigned bw[4] = {bv.x, bv.y, bv.z, bv.w};
                    if (u.tag == 0) {
                        const uint4 av = *(const uint4*)(sa + off); const unsigned aw[4] = {av.x, av.y, av.z, av.w};
#pragma unroll
                        for (int e = 0; e < 4; ++e) { const float r0 = __uint_as_float(aw[e] << 16) * __builtin_amdgcn_rcpf(fmaxf(__uint_as_float(bw[e] << 16), 1e-30f)), r1 = __uint_as_float(aw[e] & 0xffff0000u) * __builtin_amdgcn_rcpf(fmaxf(__uint_as_float(bw[e] & 0xffff0000u), 1e-30f));
                            if (e < 2) { acc[ai][bj][m][0][2 * e] *= r0; acc[ai][bj][m][0][2 * e + 1] *= r1; } else { acc[ai][bj][m][1][2 * e - 4] *= r0; acc[ai][bj][m][1][2 * e - 3] *= r1; } }
                    } else {
                        float r[8];
#pragma unroll
                        for (int e = 0; e < 4; ++e) { const float a = e < 2 ? acc[ai][bj][m][0][2 * e] : acc[ai][bj][m][1][2 * e - 4], b = e < 2 ? acc[ai][bj][m][0][2 * e + 1] : acc[ai][bj][m][1][2 * e - 3];
                            r[2 * e] = __uint_as_float(bw[e] << 16) * a; r[2 * e + 1] = __uint_as_float(bw[e] & 0xffff0000u) * b; }
                        uint4 o; o.x = pk2(r[0], r[1]); o.y = pk2(r[2], r[3]); o.z = pk2(r[4], r[5]); o.w = pk2(r[6], r[7]);
                        *(uint4*)(mixed + off) = o; } } }
    }
};
__device__ __forceinline__ void phase_proj(const P& p, char* smem) {
    ProjSched S; S.o.init(p.T / 256, 4, gridDim.x, blockIdx.x); S.A0 = (const char*)p.onsa; S.A1 = (const char*)p.gla; S.B0 = (const char*)p.Wpn; S.B1 = (const char*)p.Wpg;
    EpiProj2 E{p.sa, p.sb, p.mixed};
    pg8::gemm_phase<EpiProj2, ProjSched, true, false>((PG8_LAS unsigned char*)smem, 512, 512, 512, S, E);
}
__device__ __forceinline__ void phase_out(const P& p, char* smem) {
    pg8::DenseSched S; S.init(p.mixed, p.Wo, p.T, 1024, 1024, 1024); EpiOut E{p.x, p.h1b};
    pg8::gemm_phase<EpiOut, pg8::DenseSched, true, false>((PG8_LAS unsigned char*)smem, 1024, 1024, 1024, S, E);
}

struct ExpertSched {
    const int* ub;
    const int* sb_;
    const unsigned* cnt; const int* list; int T;
    const char* A; const char* B; int lda, ldb; size_t bstride;
    int npn, G, c; bool gather;
    int r1;
    unsigned* ready; int role;
    __device__ __forceinline__ bool next(int i, pg8::Unit& u) const {
        int L = i * G + c;
        if (role == 2 && r1 > 0) { const int nl = G - r1, period = 2 * nl + r1;
            L = (c < r1) ? i * period + 2 * nl + c : (i >> 1) * period + (i & 1) * nl + (c - r1); }
        if (L >= ub[NEXP]) return false;
        int e = 0; while (L >= ub[e + 1]) ++e;
        const int rem = L - ub[e], tiles = (ub[e + 1] - ub[e]) / npn, pn = rem / tiles, pml = rem % tiles;
        u.pm = sb_[e] / 256 + pml; u.pn = pn; u.tag = e | (pml << 8);
        u.A = gather ? A : A + (size_t)u.pm * 256 * lda * 2; u.B = B + (size_t)e * bstride + (size_t)pn * 256 * ldb * 2; return true;
    }
    __device__ __forceinline__ unsigned arow(const pg8::Unit& u, int r) const {
        const int e = u.tag & 255, sl = (u.tag >> 8) * 256 + r; const int tok = list[(size_t)e * T + (sl < (int)cnt[e * 32] ? sl : 0)];
        return (unsigned)tok * (unsigned)lda * 2u;
    }
    __device__ __forceinline__ void a_ready(const pg8::Unit& u) const {
        if (role != 2) return;
        if (TIDX() < 64) { unsigned spins = 0;
            while ((unsigned)__builtin_amdgcn_readfirstlane((int)__hip_atomic_load(ready + u.pm, __ATOMIC_RELAXED, __HIP_MEMORY_SCOPE_AGENT)) < 32u) { __builtin_amdgcn_s_sleep(2); if (++spins > (1u << 22)) break; }
            __builtin_amdgcn_fence(__ATOMIC_ACQUIRE, "agent");
            asm volatile("s_waitcnt vmcnt(0)" ::: "memory"); }
        asm volatile("" ::: "memory"); __builtin_amdgcn_s_barrier(); asm volatile("" ::: "memory");
    }
    __device__ __forceinline__ void done(const pg8::Unit& u) const {
        if (role != 1) return;
        asm volatile("s_waitcnt vmcnt(0)" ::: "memory");
        if ((TIDX() & 63) == 0) __hip_atomic_fetch_add(ready + u.pm, 1u, __ATOMIC_RELAXED, __HIP_MEMORY_SCOPE_AGENT);
    }
};
__device__ __forceinline__ void expert_tables(const P& p, char* smem, int npn, int*& ub, int*& sb_) {
    ub = (int*)(smem + LDS_MISC + 1024); sb_ = ub + 40;
    __syncthreads();
    if (TIDX() == 0) { int ua = 0, sa = 0; for (int e = 0; e < NEXP; ++e) { ub[e] = ua; sb_[e] = sa; const int tl = ((int)p.ctl[e * 32] + 255) >> 8; ua += tl * npn; sa += tl * 256; } ub[NEXP] = ua; sb_[NEXP] = sa; }
    __syncthreads();
}
struct EpiMoe1 {
    static constexpr bool PERM = true, CHAIN = false;
    __amdgpu_buffer_rsrc_t rsrc;
    __device__ __forceinline__ void operator()(const pg8::f32x4 (&acc)[2][2][4][2], const pg8::Unit& u, int wr, int wc, int fr, int fq) const {
        const int col0 = u.pn * 128 + wc * 32 + 8 * fq;
#pragma unroll
        for (int ai = 0; ai < 2; ++ai)
#pragma unroll
            for (int m = 0; m < 4; ++m) { const size_t row = (size_t)(u.pm * 256 + ai * 128 + wr * 64 + m * 16 + fr);
                pg8::f32x4 a, b;
#pragma unroll
                for (int e = 0; e < 4; ++e) { a[e] = siluf_(acc[ai][0][m][0][e]) * acc[ai][1][m][0][e]; b[e] = siluf_(acc[ai][0][m][1][e]) * acc[ai][1][m][1][e]; }
                __builtin_amdgcn_raw_buffer_store_b128(EpiInA::pack8(a, b), rsrc, (unsigned)((row * 512 + col0) * 2), 0, 16  ); }
    }
};
struct EpiMoe2 {
    static constexpr bool PERM = true, CHAIN = false;
    bf16* Y;
    __device__ __forceinline__ void operator()(const pg8::f32x4 (&acc)[2][2][4][2], const pg8::Unit& u, int wr, int wc, int fr, int fq) const {
        const int col0 = u.pn * 256 + wc * 32 + 8 * fq;
#pragma unroll
        for (int ai = 0; ai < 2; ++ai)
#pragma unroll
            for (int m = 0; m < 4; ++m) { const size_t row = (size_t)(u.pm * 256 + ai * 128 + wr * 64 + m * 16 + fr);
#pragma unroll
                for (int bj = 0; bj < 2; ++bj) *(pg8::u32x4*)(Y + row * 1024 + col0 + bj * 128) = EpiInA::pack8(acc[ai][bj][m][0], acc[ai][bj][m][1]); }
    }
};
__device__ __forceinline__ void phase_moe12(const P& p, char* smem) {
    int *ub, *sb_; expert_tables(p, smem, 4, ub, sb_);
    unsigned* ready = p.ctl + 3072;
    const int G_ = (int)gridDim.x, vcu = (G_ % 8 == 0) ? ((int)blockIdx.x % 8) * (G_ / 8) + (int)blockIdx.x / 8 : (int)blockIdx.x;
    { ExpertSched S{ub, sb_, p.ctl, p.list, p.T, (const char*)p.vb, (const char*)p.Wgu, 1024, 1024, (size_t)1024 * 1024 * 2, 4, (int)gridDim.x, vcu, true, 0, ready, 1};
      EpiMoe1 E{__builtin_amdgcn_make_buffer_rsrc((void*)p.H, 0, (int)((2 * (size_t)p.T + NEXP * 256) * 512 * 2), 0x00020000)};
      pg8::gemm_phase<EpiMoe1, ExpertSched, true, true>((PG8_LAS unsigned char*)smem, 1024, 1024, 1024, S, E); }
    { const int G = (int)gridDim.x, r1 = (ub[NEXP] % G);
      ExpertSched S{ub, sb_, p.ctl, p.list, p.T, (const char*)p.H, (const char*)p.Wd, 512, 512, (size_t)1024 * 512 * 2, 4, G, vcu, false, r1, ready, 2};
      EpiMoe2 E{p.Y};
      pg8::gemm_phase<EpiMoe2, ExpertSched, true, false>((PG8_LAS unsigned char*)smem, 512, 512, 512, S, E); }
}

namespace nsa {
using f32x16 = __attribute__((ext_vector_type(16))) float;
using bf16x8 = __attribute__((ext_vector_type(8))) short;
using s16x4 = __attribute__((ext_vector_type(4))) short;
using u32x4 = __attribute__((ext_vector_type(4))) unsigned;
typedef __attribute__((address_space(3))) char* lptr;
typedef __attribute__((address_space(3))) const char* lcptr;
constexpr int SLOT = 8192;
constexpr int NSLOT = 3;
constexpr int L_K = 0, L_V = NSLOT * SLOT, L_WS = 2 * NSLOT * SLOT, L_OST = L_WS + 8 * 512, L_IMPD = L_OST + 8 * 4096, L_IMPC = L_IMPD + 64 * 64 * 4, L_SEL = L_IMPC + 64 * 68 * 4, L_END = L_SEL + 64 * 8;
constexpr float LOG2E = 1.4426950408889634f, NEGM = -1e30f, M0 = -1e20f, THR = 8.f;
__device__ __forceinline__ int crow(int r, int hi) { return (r & 3) + 8 * (r >> 2) + 4 * hi; }
__device__ __forceinline__ void glds16(const void* gsrc, unsigned lds_dst) { unsigned keep;
    asm volatile("s_mov_b32 %0, m0\n\ts_mov_b32 m0, %2\n\ts_nop 0\n\tglobal_load_lds_dwordx4 %1, off\n\ts_mov_b32 m0, %0" : "=&s"(keep) : "v"(gsrc), "s"(lds_dst) : "memory"); }
#define NSA_WAIT_BAR() asm volatile("s_waitcnt vmcnt(2) lgkmcnt(0)\n\ts_barrier" ::: "memory")
#define NSA_DRAIN_BAR() asm volatile("s_waitcnt vmcnt(0) lgkmcnt(0)\n\ts_barrier" ::: "memory")
#define NSA_LWAIT() asm volatile("s_waitcnt lgkmcnt(0)" ::: "memory")
__device__ __forceinline__ unsigned cvtpk(float lo, float hi) { typedef float f2 __attribute__((ext_vector_type(2))); typedef __bf16 b2 __attribute__((ext_vector_type(2))); f2 v = {lo, hi}; b2 b = __builtin_convertvector(v, b2); return __builtin_bit_cast(unsigned, b); }
__device__ __forceinline__ float xhalf_max(float m) { auto rr = __builtin_amdgcn_permlane32_swap(__float_as_uint(m), __float_as_uint(m), false, false); return fmaxf(__uint_as_float(rr[0]), __uint_as_float(rr[1])); }
__device__ __forceinline__ float xhalf_sum(float m) { auto rr = __builtin_amdgcn_permlane32_swap(__float_as_uint(m), __float_as_uint(m), false, false); return __uint_as_float(rr[0]) + __uint_as_float(rr[1]); }
__device__ __forceinline__ void qkt(f32x16& p0, f32x16& p1, lcptr Kslot, const bf16x8* qr, int r32, int hi) {
    lcptr kb = Kslot + hi * 1024 + r32 * 16;
    p0 = f32x16{}; p1 = f32x16{};
#pragma unroll
    for (int d0 = 0; d0 < 4; ++d0) {
        const bf16x8 b0 = *(const __attribute__((address_space(3))) bf16x8*)(kb + d0 * 2048);
        const bf16x8 b1 = *(const __attribute__((address_space(3))) bf16x8*)(kb + d0 * 2048 + 512);
        p0 = __builtin_amdgcn_mfma_f32_32x32x16_bf16(b0, qr[d0], p0, 0, 0, 0); p1 = __builtin_amdgcn_mfma_f32_32x32x16_bf16(b1, qr[d0], p1, 0, 0, 0); }
}
__device__ __forceinline__ void pv(f32x16* o, int vb, bf16x8 pa0, bf16x8 pa1, bf16x8 pa2, bf16x8 pa3) {
#pragma unroll
    for (int d0 = 0; d0 < 2; ++d0) { s16x4 lo[4], hi[4];
#pragma unroll
        for (int ks = 0; ks < 4; ++ks) {
            asm volatile("ds_read_b64_tr_b16 %0,%1 offset:%c2" : "=&v"(lo[ks]) : "v"(vb), "i"(d0 * 4096 + ks * 1024) : "memory");
            asm volatile("ds_read_b64_tr_b16 %0,%1 offset:%c2" : "=&v"(hi[ks]) : "v"(vb), "i"(d0 * 4096 + ks * 1024 + 512) : "memory"); }
        asm volatile("s_waitcnt lgkmcnt(0)" ::: "memory"); __builtin_amdgcn_sched_barrier(0);
#define NSA_PK(k) (bf16x8){lo[k][0], lo[k][1], lo[k][2], lo[k][3], hi[k][0], hi[k][1], hi[k][2], hi[k][3]}
        o[d0] = __builtin_amdgcn_mfma_f32_32x32x16_bf16(pa0, NSA_PK(0), o[d0], 0, 0, 0);
        o[d0] = __builtin_amdgcn_mfma_f32_32x32x16_bf16(pa1, NSA_PK(1), o[d0], 0, 0, 0);
        o[d0] = __builtin_amdgcn_mfma_f32_32x32x16_bf16(pa2, NSA_PK(2), o[d0], 0, 0, 0);
        o[d0] = __builtin_amdgcn_mfma_f32_32x32x16_bf16(pa3, NSA_PK(3), o[d0], 0, 0, 0);
#undef NSA_PK
    }
}
__device__ __forceinline__ float rowmax32(const f32x16& p0, const f32x16& p1) {
    float a = fmaxf(p0[0], p1[0]);
#pragma unroll
    for (int r = 1; r < 16; ++r) a = fmaxf(a, fmaxf(p0[r], p1[r]));
    return xhalf_max(a);
}
struct Ctx {
    int w, lane, r32, hi, rs; unsigned lds0; lptr shm; const bf16* kt; const bf16* vt;
};
__device__ __forceinline__ void dma_kv(const Ctx& c, int tile, int slot) {
    const bf16* ksrc = c.kt + (size_t)tile * 64 * 64 + c.lane * 64 + c.w * 8;
    const bf16* vsrc = c.vt + (size_t)tile * 64 * 64 + (16 * (c.w & 3) + (c.lane >> 2)) * 64 + (c.w >> 2) * 32 + (c.lane & 3) * 8;
    glds16(ksrc, (unsigned)__builtin_amdgcn_readfirstlane(c.lds0 + L_K + slot * SLOT + c.w * 1024));
    glds16(vsrc, (unsigned)__builtin_amdgcn_readfirstlane(c.lds0 + L_V + slot * SLOT + c.w * 1024));
}
template <int ABL = 0> __device__ __forceinline__ void ring_begin(Ctx& c, int t0, int t1) { NSA_DRAIN_BAR(); if (!(ABL & 8)) { dma_kv(c, t0, 0); dma_kv(c, t1 >= 0 ? t1 : t0, 1); } c.rs = 0; }
template <int ABL = 0> __device__ __forceinline__ void ring_step(Ctx& c, int t2, int tcur) { if (!(ABL & 16)) NSA_WAIT_BAR(); int s2 = c.rs + 2; if (s2 >= NSLOT) s2 -= NSLOT; if (!(ABL & 8)) dma_kv(c, t2 >= 0 ? t2 : tcur, s2); }
__device__ __forceinline__ void ring_next(Ctx& c) { c.rs = (c.rs == NSLOT - 1) ? 0 : c.rs + 1; }
template <int ABL> __device__ __forceinline__ void softmax_pv(const Ctx& c, f32x16& p0, f32x16& p1, f32x16* o, float& m, float& l, int slot, bool on) {
    float a0 = fmaxf(fmaxf(p0[0], p0[1]), p1[0]), a1 = fmaxf(fmaxf(p0[2], p0[3]), p1[1]), a2 = fmaxf(fmaxf(p0[4], p0[5]), p1[2]), a3 = fmaxf(fmaxf(p0[6], p0[7]), p1[3]);
    a0 = fmaxf(fmaxf(a0, p0[8]), p0[9]); a1 = fmaxf(fmaxf(a1, p0[10]), p0[11]); a2 = fmaxf(fmaxf(a2, p0[12]), p0[13]); a3 = fmaxf(fmaxf(a3, p0[14]), p0[15]);
    a0 = fmaxf(fmaxf(a0, p1[4]), p1[5]); a1 = fmaxf(fmaxf(a1, p1[6]), p1[7]); a2 = fmaxf(fmaxf(a2, p1[8]), p1[9]); a3 = fmaxf(fmaxf(a3, p1[10]), p1[11]);
    a0 = fmaxf(fmaxf(a0, p1[12]), p1[13]); a1 = fmaxf(fmaxf(a1, p1[14]), p1[15]);
    float rm = xhalf_max(fmaxf(fmaxf(a0, a1), fmaxf(a2, a3)));
    rm = on ? rm : NEGM;
    volatile __attribute__((address_space(3))) float* wsf = (volatile __attribute__((address_space(3))) float*)(c.shm + L_WS + c.w * 512);
    bool resc = false;
    if (__any(rm > m + THR)) { const float mn = fmaxf(m, rm); const float f = __builtin_amdgcn_exp2f(m - mn); l *= f; m = mn; if (c.hi == 0) wsf[c.r32] = f; resc = true; }
    const float ms = on ? m : 1e30f;
    float s0 = 0.f, s1 = 0.f, s2 = 0.f, s3 = 0.f;
#pragma unroll
    for (int r = 0; r < 16; r += 2) {
        if (!(ABL & 2)) { p0[r] = __builtin_amdgcn_exp2f(p0[r] - ms); p0[r + 1] = __builtin_amdgcn_exp2f(p0[r + 1] - ms); p1[r] = __builtin_amdgcn_exp2f(p1[r] - ms); p1[r + 1] = __builtin_amdgcn_exp2f(p1[r + 1] - ms); }
        else { p0[r] -= ms; p0[r + 1] -= ms; p1[r] -= ms; p1[r + 1] -= ms; }
        s0 += p0[r]; s1 += p0[r + 1]; s2 += p1[r]; s3 += p1[r + 1]; }
    l += (s0 + s1) + (s2 + s3);
    if (resc) { NSA_LWAIT();
#pragma unroll
        for (int r = 0; r < 16; ++r) { const float f = wsf[crow(r, c.hi)]; o[0][r] *= f; o[1][r] *= f; } }
    u32x4 w0, w1, w2, w3;
    w0 = (u32x4){cvtpk(p0[0], p0[1]), cvtpk(p0[2], p0[3]), cvtpk(p0[4], p0[5]), cvtpk(p0[6], p0[7])};
    w1 = (u32x4){cvtpk(p0[8], p0[9]), cvtpk(p0[10], p0[11]), cvtpk(p0[12], p0[13]), cvtpk(p0[14], p0[15])};
    w2 = (u32x4){cvtpk(p1[0], p1[1]), cvtpk(p1[2], p1[3]), cvtpk(p1[4], p1[5]), cvtpk(p1[6], p1[7])};
    w3 = (u32x4){cvtpk(p1[8], p1[9]), cvtpk(p1[10], p1[11]), cvtpk(p1[12], p1[13]), cvtpk(p1[14], p1[15])};
    const int vb = (int)(c.lds0 + L_V + slot * SLOT) + ((c.lane >> 4) & 1) * 32 + (c.lane & 3) * 8 + (4 * c.hi + ((c.lane & 15) >> 2)) * 64;
    if (!(ABL & 1)) pv(o, vb, __builtin_bit_cast(bf16x8, w0), __builtin_bit_cast(bf16x8, w1), __builtin_bit_cast(bf16x8, w2), __builtin_bit_cast(bf16x8, w3));
    else { asm volatile("" :: "v"(w0), "v"(w1), "v"(w2), "v"(w3)); }
}
__device__ __forceinline__ void accum_branch(const Ctx& c, f32x16* oacc, const f32x16* o, float fac) {
    volatile __attribute__((address_space(3))) float* wsf = (volatile __attribute__((address_space(3))) float*)(c.shm + L_WS + c.w * 512);
    NSA_LWAIT(); if (c.hi == 0) wsf[64 + c.r32] = fac; NSA_LWAIT();
#pragma unroll
    for (int r = 0; r < 16; ++r) { const float f = wsf[64 + crow(r, c.hi)]; oacc[0][r] += o[0][r] * f; oacc[1][r] += o[1][r] * f; }
    NSA_LWAIT();
}
template <int ABL> __device__ __forceinline__ void nsa_unit(const P& p, char* smem, int b, int g, int jq) {
    const int tid = TIDX(); Ctx c; c.lane = tid & 63; c.w = __builtin_amdgcn_readfirstlane(tid >> 6); c.r32 = c.lane & 31; c.hi = c.lane >> 5;
    c.shm = (lptr)smem; c.lds0 = (unsigned)(size_t)c.shm;
    const int hh = c.r32 >> 3, tokl = 8 * c.w + (c.r32 & 7), stok = 64 * jq + tokl, h = g * 4 + hh; const size_t t = (size_t)b * S + stok;
    const size_t seg = kvseg(p), ho = (size_t)(b * 2 + g) * S * 64;
    bf16x8 qr[4];
#pragma unroll
    for (int d0 = 0; d0 < 4; ++d0) { const u32x4 raw = *(const u32x4*)(p.q + t * 512 + h * 64 + d0 * 16 + c.hi * 8); u32x4 sc;
#pragma unroll
        for (int e4 = 0; e4 < 4; ++e4) sc[e4] = cvtpk(__uint_as_float(raw[e4] << 16) * LOG2E, __uint_as_float(raw[e4] & 0xffff0000u) * LOG2E);
        qr[d0] = __builtin_bit_cast(bf16x8, sc); }
    const float g0 = p.gates[t * 24 + h * 3], g1 = p.gates[t * 24 + h * 3 + 1], g2 = p.gates[t * 24 + h * 3 + 2];
    f32x16 oacc[2], o[2], p0, p1; oacc[0] = f32x16{}; oacc[1] = f32x16{};
    __attribute__((address_space(3))) float* impD = (__attribute__((address_space(3))) float*)(c.shm + L_IMPD);
    __attribute__((address_space(3))) float* impC = (__attribute__((address_space(3))) float*)(c.shm + L_IMPC);
    __attribute__((address_space(3))) u64* selm = (__attribute__((address_space(3))) u64*)(c.shm + L_SEL);
    const int nv = stok >= 31 ? (stok - 31) / 16 + 1 : 0;
    const int nct = (4 * jq + 3 + 63) >> 6;
    c.kt = p.kcmp + (size_t)(b * 2 + g) * 256 * 64; c.vt = p.vcmp + (size_t)(b * 2 + g) * 256 * 64;
    float m = M0, l = 0.f;
    if (tid < 64) impC[tid * 68] = 0.f;
    ring_begin(c, 0, nct > 1 ? 1 : -1);
    for (int ct = 0; ct < ((ABL & 64) ? 0 : nct); ++ct) {
        ring_step(c, ct + 2 < nct ? ct + 2 : -1, ct);
        qkt(p0, p1, (lcptr)(c.shm + L_K + c.rs * SLOT), qr, c.r32, c.hi); ring_next(c);
#pragma unroll
        for (int r = 0; r < 16; ++r) { const int n = 64 * ct + crow(r, c.hi); p0[r] = n < nv ? p0[r] : NEGM; p1[r] = n + 32 < nv ? p1[r] : NEGM; }
        const float rm = rowmax32(p0, p1); const float mn = fmaxf(m, rm); float sacc = 0.f;
#pragma unroll
        for (int r = 0; r < 16; ++r) sacc += __builtin_amdgcn_exp2f(p0[r] - mn) + __builtin_amdgcn_exp2f(p1[r] - mn);
        l = l * __builtin_amdgcn_exp2f(m - mn) + sacc; m = mn;
    }
    l = xhalf_sum(l); const float il = l > 0.f ? 1.f / l : 0.f;
    o[0] = f32x16{}; o[1] = f32x16{};
    ring_begin(c, 0, nct > 1 ? 1 : -1);
    for (int ct = 0; ct < ((ABL & 64) ? 0 : nct); ++ct) {
        ring_step(c, ct + 2 < nct ? ct + 2 : -1, ct);
        qkt(p0, p1, (lcptr)(c.shm + L_K + c.rs * SLOT), qr, c.r32, c.hi);
#pragma unroll
        for (int r = 0; r < 16; ++r) { const int n = 64 * ct + crow(r, c.hi); p0[r] = n < nv ? __builtin_amdgcn_exp2f(p0[r] - m) * il : 0.f; p1[r] = n + 32 < nv ? __builtin_amdgcn_exp2f(p1[r] - m) * il : 0.f; }
#pragma unroll
        for (int hb = 0; hb < 2; ++hb)
#pragma unroll
            for (int rg = 0; rg < 4; ++rg) {
                const f32x16& pp = hb ? p1 : p0;
                float dsum = pp[4 * rg] + pp[4 * rg + 1] + pp[4 * rg + 2] + 0.5f * pp[4 * rg + 3], csum = 0.5f * pp[4 * rg + 3];
                dsum += __shfl_xor(dsum, 8); dsum += __shfl_xor(dsum, 16); csum += __shfl_xor(csum, 8); csum += __shfl_xor(csum, 16);
                const int j = 16 * ct + 8 * hb + 2 * rg + c.hi;
                if (c.r32 < 8) { impD[tokl * 64 + j] = dsum; impC[tokl * 68 + j + 1] = csum; }
            }
        u32x4 w0, w1, w2, w3;
        w0 = (u32x4){cvtpk(p0[0], p0[1]), cvtpk(p0[2], p0[3]), cvtpk(p0[4], p0[5]), cvtpk(p0[6], p0[7])};
        w1 = (u32x4){cvtpk(p0[8], p0[9]), cvtpk(p0[10], p0[11]), cvtpk(p0[12], p0[13]), cvtpk(p0[14], p0[15])};
        w2 = (u32x4){cvtpk(p1[0], p1[1]), cvtpk(p1[2], p1[3]), cvtpk(p1[4], p1[5]), cvtpk(p1[6], p1[7])};
        w3 = (u32x4){cvtpk(p1[8], p1[9]), cvtpk(p1[10], p1[11]), cvtpk(p1[12], p1[13]), cvtpk(p1[14], p1[15])};
        const int vb = (int)(c.lds0 + L_V + c.rs * SLOT) + ((c.lane >> 4) & 1) * 32 + (c.lane & 3) * 8 + (4 * c.hi + ((c.lane & 15) >> 2)) * 64;
        pv(o, vb, __builtin_bit_cast(bf16x8, w0), __builtin_bit_cast(bf16x8, w1), __builtin_bit_cast(bf16x8, w2), __builtin_bit_cast(bf16x8, w3));
        ring_next(c);
    }
    accum_branch(c, oacc, o, g0);
    NSA_LWAIT(); __builtin_amdgcn_s_barrier();
    {
#pragma unroll 1
        for (int tkk = 0; tkk < 8; ++tkk) { const int tk = 8 * c.w + tkk, j = c.lane; const bool valid = j <= jq;
            const float sc = (j == 0 || j == jq || j == jq - 1) ? 1e4f : impD[tk * 64 + j] + impC[tk * 68 + j];
            const unsigned key = valid ? ((__float_as_uint(sc) & ~63u) | (unsigned)(63 - j)) : 0u;
            int rank = 0;
            if (!(ABL & 32)) {
#pragma unroll
                for (int i = 0; i < 64; ++i) { const unsigned ki = (unsigned)__builtin_amdgcn_readlane((int)key, i); rank += (ki > key) ? 1 : 0; } }
            const u64 mk = __ballot(valid && rank < 16);
            if (j == 0) { selm[tk] = mk; p.sel[((size_t)b * S + 64 * jq + tk) * 2 + g] = mk; } }
    }
    NSA_LWAIT(); __builtin_amdgcn_s_barrier();
    const u64 mysel = selm[tokl];
    u64 uni = selm[c.lane];
#pragma unroll
    for (int x = 1; x < 64; x <<= 1) { const unsigned lo_ = __shfl_xor((unsigned)uni, x), hi_ = __shfl_xor((unsigned)(uni >> 32), x); uni |= (u64)lo_ | ((u64)hi_ << 32); }
    const unsigned ulo = __builtin_amdgcn_readfirstlane((unsigned)uni), uhi = __builtin_amdgcn_readfirstlane((unsigned)(uni >> 32));
    {
        c.kt = p.kv6 + 2 * seg + ho; c.vt = p.kv6 + 3 * seg + ho;
        u64 rem = (u64)ulo | ((u64)uhi << 32);
        m = M0; l = 0.f; o[0] = f32x16{}; o[1] = f32x16{};
        int j = __builtin_ctzll(rem); rem &= rem - 1;
        int j1 = rem ? __builtin_ctzll(rem) : -1; if (rem) rem &= rem - 1;
        ring_begin<ABL>(c, j, j1);
        for (;;) {
            const int j2 = rem ? __builtin_ctzll(rem) : -1; if (rem) rem &= rem - 1;
            ring_step<ABL>(c, j2, j);
            if (!(ABL & 4)) qkt(p0, p1, (lcptr)(c.shm + L_K + c.rs * SLOT), qr, c.r32, c.hi); else { asm volatile("" : "+v"(p0), "+v"(p1)); }
            const bool on = (mysel >> j) & 1ull;
            if (j == jq) {
#pragma unroll
                for (int r = 0; r < 16; ++r) { const int kr = crow(r, c.hi); p0[r] = (kr <= tokl) ? p0[r] : NEGM; p1[r] = (kr + 32 <= tokl) ? p1[r] : NEGM; } }
            softmax_pv<ABL>(c, p0, p1, o, m, l, c.rs, on); ring_next(c);
            if (j1 < 0) break; j = j1; j1 = j2;
        }
        l = xhalf_sum(l);
        accum_branch(c, oacc, o, g1 / l);
    }
    {
        c.kt = p.kv6 + 4 * seg + ho; c.vt = p.kv6 + 5 * seg + ho;
        const int j0 = jq >= 8 ? jq - 8 : 0;
        m = M0; l = 0.f; o[0] = f32x16{}; o[1] = f32x16{};
        ring_begin<ABL>(c, j0, j0 + 1 <= jq ? j0 + 1 : -1);
        for (int j = j0; j <= jq; ++j) {
            ring_step<ABL>(c, j + 2 <= jq ? j + 2 : -1, j);
            if (!(ABL & 4)) qkt(p0, p1, (lcptr)(c.shm + L_K + c.rs * SLOT), qr, c.r32, c.hi); else { asm volatile("" : "+v"(p0), "+v"(p1)); }
            const bool lowt = (jq >= 8 && j == jq - 8), diag = (j == jq);
            if (diag || lowt) {
#pragma unroll
                for (int r = 0; r < 16; ++r) { const int kr = crow(r, c.hi);
                    const bool v0 = diag ? (kr <= tokl) : (kr > tokl), v1 = diag ? (kr + 32 <= tokl) : (kr + 32 > tokl);
                    p0[r] = v0 ? p0[r] : NEGM; p1[r] = v1 ? p1[r] : NEGM; } }
            softmax_pv<ABL>(c, p0, p1, o, m, l, c.rs, true); ring_next(c);
        }
        l = xhalf_sum(l);
        accum_branch(c, oacc, o, g2 / l);
    }
    {
        __attribute__((address_space(3))) bf16* stg = (__attribute__((address_space(3))) bf16*)(c.shm + L_OST + c.w * 4096);
#pragma unroll
        for (int r = 0; r < 16; ++r) { const int orow = crow(r, c.hi);
#pragma unroll
            for (int d0 = 0; d0 < 2; ++d0) stg[orow * 64 + d0 * 32 + c.r32] = f2bf(oacc[d0][r]); }
        NSA_LWAIT();
#pragma unroll
        for (int i = 0; i < 4; ++i) { const int row = i * 8 + (c.lane >> 3), ch = c.lane & 7; const u32x4 v = *(const __attribute__((address_space(3))) u32x4*)(stg + row * 64 + ch * 8);
            const int rh = row >> 3, rt = 8 * c.w + (row & 7);
            *(u32x4*)(p.onsa + ((size_t)b * S + 64 * jq + rt) * 512 + (g * 4 + rh) * 64 + ch * 8) = v; }
    }
    NSA_DRAIN_BAR();
}
}
template <int ABL = 0> __device__ __forceinline__ void phase_nsa(const P& p, char* smem) {
    const int nunits = p.nb * 2 * 64;
    const int G = gridDim.x; int r = 0;
    for (int base = 0; base < nunits; base += G, ++r) {
        const int w = (r & 1) ? G - 1 - (int)blockIdx.x : (int)blockIdx.x, i = base + w; if (i >= nunits) continue;
        const int jq = 63 - i / (p.nb * 2), bg = i % (p.nb * 2); nsa::nsa_unit<ABL>(p, smem, bg >> 1, bg & 1, jq); }
}

namespace gla {
using nsa::f32x16; using nsa::bf16x8; using nsa::s16x4; using nsa::u32x4; using nsa::lptr; using nsa::lcptr; using nsa::crow; using nsa::cvtpk;
typedef unsigned u32x2 __attribute__((ext_vector_type(2)));
constexpr int L_KI = 0, L_QI = 8192, L_VI = 16384, L_SI = 32768, L_OST = 49152, L_TOT = L_OST + 64 * 132 * 4, L_END = L_TOT + 8 * 64 * 4 + 64 * 4;
__device__ __forceinline__ int koff(int row, int d) { return (d >> 3) * 1024 + row * 16 + (d & 7) * 2; }
__device__ __forceinline__ int voff(int row, int col) { return ((col >> 5) * 4 + (row >> 4)) * 1024 + (row & 15) * 64 + (col & 31) * 2; }
__device__ __forceinline__ bf16x8 trfrag(unsigned img, int ks, int cb, int lane) {
    const int hi = lane >> 5; const unsigned a = img + (cb * 4 + ks) * 1024 + ((lane >> 4) & 1) * 32 + (lane & 3) * 8 + (4 * hi + ((lane & 15) >> 2)) * 64;
    s16x4 lo, hh;
    asm volatile("ds_read_b64_tr_b16 %0,%1" : "=&v"(lo) : "v"(a) : "memory");
    asm volatile("ds_read_b64_tr_b16 %0,%1 offset:512" : "=&v"(hh) : "v"(a) : "memory");
    asm volatile("s_waitcnt lgkmcnt(0)" ::: "memory"); __builtin_amdgcn_sched_barrier(0);
    return (bf16x8){lo[0], lo[1], lo[2], lo[3], hh[0], hh[1], hh[2], hh[3]};
}
template <int GM> __device__ __forceinline__ void chunk_images(const P& p, lptr shm, int b, int h, int c, int tid) {
    const int d = tid & 63, tg = tid >> 6; const size_t t0 = (size_t)b * S + c * 64;
    bf16 kraw[8], qraw[8];
#pragma unroll
    for (int i = 0; i < 8; ++i) { kraw[i] = p.gk[(t0 + tg * 8 + i) * 256 + h * 64 + d]; qraw[i] = GM ? p.gq[(t0 + tg * 8 + i) * 256 + h * 64 + d] : (bf16)0; }
    if (GM == 1) {
        float bbv[8];
#pragma unroll
        for (int i = 0; i < 8; ++i) bbv[i] = p.gb[(t0 + tg * 8 + i) * 256 + h * 64 + d];
#pragma unroll
        for (int k = 0; k < 2; ++k) { const int idx = tid + k * 512, s = idx >> 4, e = (idx & 15) * 8; *(__attribute__((address_space(3))) u32x4*)(shm + L_VI + voff(s, e)) = *(const u32x4*)(p.gv + (t0 + s) * 512 + h * 128 + e); }
#pragma unroll
        for (int i = 0; i < 8; ++i) { const int t = tg * 8 + i; const float bb = bbv[i], kk = bf2f(kraw[i]), qq = bf2f(qraw[i]);
            *(__attribute__((address_space(3))) bf16*)(shm + L_KI + koff(t, d)) = f2bf(kk * __expf(-bb)); *(__attribute__((address_space(3))) bf16*)(shm + L_QI + koff(t, d)) = f2bf(qq * __expf(bb)); }
        __syncthreads();
        return;
    }
    __attribute__((address_space(3))) float* tot = (__attribute__((address_space(3))) float*)(shm + L_TOT);
    float wa[16];
#pragma unroll
    for (int r = 0; r < 16; ++r) wa[r] = p.w_a2[r * 256 + h * 64 + d];
    const float ba = p.b_a[h * 64 + d];
    __attribute__((address_space(3))) float* als = (__attribute__((address_space(3))) float*)(shm + L_OST);
    { const f32x4_t a4 = tid < 256 ? *(const f32x4_t*)(p.alow + t0 * 16 + tid * 4) : (f32x4_t){0.f, 0.f, 0.f, 0.f}; if (tid < 256) *(__attribute__((address_space(3))) f32x4_t*)(als + tid * 4) = a4; }
    __syncthreads();
    float loc[8]; float run = 0.f;
#pragma unroll
    for (int i = 0; i < 8; ++i) { const __attribute__((address_space(3))) float* al = als + (tg * 8 + i) * 16; float z = ba;
#pragma unroll
        for (int r = 0; r < 16; ++r) z += al[r] * wa[r];
        const float ls = fminf(z, 0.f) - __logf(1.f + __expf(-fabsf(z))); run += ls * (1.f / 16.f); loc[i] = run; }
    tot[tg * 64 + d] = run;
#pragma unroll
    for (int k = 0; k < 2; ++k) { const int idx = tid + k * 512, s = idx >> 4, e = (idx & 15) * 8; *(__attribute__((address_space(3))) u32x4*)(shm + L_VI + voff(s, e)) = *(const u32x4*)(p.gv + (t0 + s) * 512 + h * 128 + e); }
    __syncthreads();
    float pre = 0.f, all = 0.f;
#pragma unroll
    for (int g = 0; g < 8; ++g) { const float x = tot[g * 64 + d]; all += x; pre += g < tg ? x : 0.f; }
#pragma unroll
    for (int i = 0; i < 8; ++i) { const int t = tg * 8 + i; const float bb = pre + loc[i]; const float kk = bf2f(kraw[i]);
        p.gb[(t0 + t) * 256 + h * 64 + d] = bb;
        *(__attribute__((address_space(3))) bf16*)(shm + L_KI + voff(t, d)) = f2bf(kk * __expf(all - bb)); }
    if (tg == 0) p.gdec[((size_t)(b * 4 + h) * 64 + c) * 64 + d] = __expf(all);
    __syncthreads();
}
__device__ __forceinline__ void g1_chunk(const P& p, char* smem, int b, int h, int c) {
    const int tid = TIDX(), lane = tid & 63, w = __builtin_amdgcn_readfirstlane(tid >> 6), r32 = lane & 31, hi = lane >> 5;
    lptr shm = (lptr)smem; const unsigned l0 = (unsigned)(size_t)shm;
    chunk_images<0>(p, shm, b, h, c, tid);
    const int db = w & 1, eb = w >> 1; f32x16 acc = f32x16{};
#pragma unroll
    for (int ks = 0; ks < 4; ++ks) { const bf16x8 a = trfrag(l0 + L_KI, ks, db, lane), bq = trfrag(l0 + L_VI, ks, eb, lane); acc = __builtin_amdgcn_mfma_f32_32x32x16_bf16(a, bq, acc, 0, 0, 0); }
    float* U = p.gst + ((size_t)(b * 4 + h) * 64 + c) * (64 * 128);
#pragma unroll
    for (int r = 0; r < 16; ++r) U[(32 * db + crow(r, hi)) * 128 + 32 * eb + r32] = acc[r];
    __syncthreads();
}
__device__ __forceinline__ void g3_chunk(const P& p, char* smem, int b, int h, int c) {
    const int tid = TIDX(), lane = tid & 63, w = __builtin_amdgcn_readfirstlane(tid >> 6), r32 = lane & 31, hi = lane >> 5;
    lptr shm = (lptr)smem; const unsigned l0 = (unsigned)(size_t)shm; const size_t t0 = (size_t)b * S + c * 64;
    const float* St = p.gst + ((size_t)(b * 4 + h) * 64 + c) * (64 * 128);
    float4 sv[4];
#pragma unroll
    for (int k = 0; k < 4; ++k) sv[k] = *(const float4*)(St + (size_t)(tid + k * 512) * 4);
    const size_t go_ = (t0 + (tid >> 3)) * 512 + h * 128 + (tid & 7) * 16;
    const uint4 rs0 = *(const uint4*)(p.rs + go_), rs1 = *(const uint4*)(p.rs + go_ + 8);
    chunk_images<1>(p, shm, b, h, c, tid);
#pragma unroll
    for (int k = 0; k < 4; ++k) { const int idx = (tid + k * 512) * 4, dd = idx >> 7, e = idx & 127; u32x2 o; o.x = cvtpk(sv[k].x, sv[k].y); o.y = cvtpk(sv[k].z, sv[k].w);
        *(__attribute__((address_space(3))) u32x2*)(shm + L_SI + voff(dd, e)) = o; }
    __syncthreads();
    const int tb = w & 1, eb = w >> 1, trow = 32 * tb + r32;
    f32x16 p0 = f32x16{}, p1 = f32x16{}, o = f32x16{};
    {
        lcptr kb = (lcptr)(shm + L_KI) + hi * 1024 + r32 * 16; lcptr qb = (lcptr)(shm + L_QI) + hi * 1024 + trow * 16;
#pragma unroll
        for (int d0 = 0; d0 < 4; ++d0) {
            const bf16x8 b0 = *(const __attribute__((address_space(3))) bf16x8*)(kb + d0 * 2048), b1 = *(const __attribute__((address_space(3))) bf16x8*)(kb + d0 * 2048 + 512);
            const bf16x8 qf = *(const __attribute__((address_space(3))) bf16x8*)(qb + d0 * 2048);
            p0 = __builtin_amdgcn_mfma_f32_32x32x16_bf16(b0, qf, p0, 0, 0, 0); p1 = __builtin_amdgcn_mfma_f32_32x32x16_bf16(b1, qf, p1, 0, 0, 0); }
    }
#pragma unroll
    for (int r = 0; r < 16; ++r) { const int s = crow(r, hi); p0[r] = s <= trow ? p0[r] : 0.f; p1[r] = s + 32 <= trow ? p1[r] : 0.f; }
#pragma unroll
    for (int ds = 0; ds < 4; ++ds) {
        const u32x2 a0 = *(const __attribute__((address_space(3))) u32x2*)(shm + L_QI + (2 * ds) * 1024 + trow * 16 + 8 * hi), a1 = *(const __attribute__((address_space(3))) u32x2*)(shm + L_QI + (2 * ds + 1) * 1024 + trow * 16 + 8 * hi);
        const u32x4 aw = {a0.x, a0.y, a1.x, a1.y};
        const bf16x8 bq = trfrag(l0 + L_SI, ds, eb, lane);
        o = __builtin_amdgcn_mfma_f32_32x32x16_bf16(__builtin_bit_cast(bf16x8, aw), bq, o, 0, 0, 0); }
    {
        const u32x4 w0 = {cvtpk(p0[0], p0[1]), cvtpk(p0[2], p0[3]), cvtpk(p0[4], p0[5]), cvtpk(p0[6], p0[7])}, w1 = {cvtpk(p0[8], p0[9]), cvtpk(p0[10], p0[11]), cvtpk(p0[12], p0[13]), cvtpk(p0[14], p0[15])};
        const u32x4 w2 = {cvtpk(p1[0], p1[1]), cvtpk(p1[2], p1[3]), cvtpk(p1[4], p1[5]), cvtpk(p1[6], p1[7])}, w3 = {cvtpk(p1[8], p1[9]), cvtpk(p1[10], p1[11]), cvtpk(p1[12], p1[13]), cvtpk(p1[14], p1[15])};
        o = __builtin_amdgcn_mfma_f32_32x32x16_bf16(__builtin_bit_cast(bf16x8, w0), trfrag(l0 + L_VI, 0, eb, lane), o, 0, 0, 0);
        o = __builtin_amdgcn_mfma_f32_32x32x16_bf16(__builtin_bit_cast(bf16x8, w1), trfrag(l0 + L_VI, 1, eb, lane), o, 0, 0, 0);
        o = __builtin_amdgcn_mfma_f32_32x32x16_bf16(__builtin_bit_cast(bf16x8, w2), trfrag(l0 + L_VI, 2, eb, lane), o, 0, 0, 0);
        o = __builtin_amdgcn_mfma_f32_32x32x16_bf16(__builtin_bit_cast(bf16x8, w3), trfrag(l0 + L_VI, 3, eb, lane), o, 0, 0, 0);
    }
    __attribute__((address_space(3))) float* ost = (__attribute__((address_space(3))) float*)(shm + L_OST);
#pragma unroll
    for (int r = 0; r < 16; ++r) ost[(32 * tb + crow(r, hi)) * 132 + 32 * eb + r32] = o[r];
    __syncthreads();
    { const int t = tid >> 3, part = tid & 7; float v[16]; float ss = 0.f;
#pragma unroll
        for (int k = 0; k < 4; ++k) { const f32x4_t x = *(const __attribute__((address_space(3))) f32x4_t*)(ost + t * 132 + part * 16 + k * 4); v[4 * k] = x[0]; v[4 * k + 1] = x[1]; v[4 * k + 2] = x[2]; v[4 * k + 3] = x[3]; ss += x[0] * x[0] + x[1] * x[1] + x[2] * x[2] + x[3] * x[3]; }
        ss += __shfl_xor(ss, 1); ss += __shfl_xor(ss, 2); ss += __shfl_xor(ss, 4);
        const float rstd = rsqrtf(ss * (1.f / 128.f) + 1e-6f);
        const size_t go = (t0 + t) * 512 + h * 128 + part * 16;
        const uint4 r0 = rs0, r1 = rs1; const unsigned rw[8] = {r0.x, r0.y, r0.z, r0.w, r1.x, r1.y, r1.z, r1.w};
        unsigned ow[8];
#pragma unroll
        for (int k = 0; k < 8; ++k) { const float ga = p.norm_g[h * 128 + part * 16 + 2 * k], gb = p.norm_g[h * 128 + part * 16 + 2 * k + 1];
            ow[k] = pk2(v[2 * k] * rstd * ga * __uint_as_float(rw[k] << 16), v[2 * k + 1] * rstd * gb * __uint_as_float(rw[k] & 0xffff0000u)); }
        *(uint4*)(p.gla + go) = make_uint4(ow[0], ow[1], ow[2], ow[3]); *(uint4*)(p.gla + go + 8) = make_uint4(ow[4], ow[5], ow[6], ow[7]); }
    __syncthreads();
}
}
__device__ __forceinline__ void phase_gla1(const P& p, char* smem) {
    const int n = p.nb * 4 * 64;
    for (int i = blockIdx.x; i < n; i += gridDim.x) gla::g1_chunk(p, smem, i >> 8, (i >> 6) & 3, i & 63);
}
__device__ __forceinline__ void phase_gla2(const P& p) {
    const int n = p.nb * 4 * 8192;
    for (int idx = blockIdx.x * NT + TIDX(); idx < n; idx += gridDim.x * NT) {
        const int bh = idx >> 13, de = idx & 8191, d = de >> 7; float* U = p.gst + (size_t)bh * 64 * 8192 + de; const float* gd = p.gdec + (size_t)bh * 64 * 64 + d;
        float s = 0.f;
        for (int c0 = 0; c0 < 64; c0 += 8) { float tmp[8], g[8];
#pragma unroll
            for (int k = 0; k < 8; ++k) { tmp[k] = U[(size_t)(c0 + k) * 8192]; g[k] = gd[(c0 + k) * 64]; }
#pragma unroll
            for (int k = 0; k < 8; ++k) { U[(size_t)(c0 + k) * 8192] = s; s = g[k] * s + tmp[k]; } }
    }
}
__device__ __forceinline__ void phase_gla3(const P& p, char* smem) {
    const int n = p.nb * 4 * 64;
    for (int i = blockIdx.x; i < n; i += gridDim.x) gla::g3_chunk(p, smem, i >> 8, (i >> 6) & 3, i & 63);
}

struct CmpSched {
    const char* kc; const char* Wc1; float* Pc; int nM, G, c; size_t aseg, pseg;
    __device__ __forceinline__ bool next(int i, pg8::Unit& u) const {
        const int L = i * G + c, per = nM * 2 * 2; if (L >= 2 * per) return false;
        const int kv = L / per, r = L % per, ks = r & 1, pn = (r >> 1) & 1, pm = r >> 2;
        u.pm = pm; u.pn = pn; u.tag = kv * 2 + ks;
        u.A = kc + (size_t)kv * aseg + (size_t)pm * 256 * 1024 * 2 + ks * 512 * 2; u.B = Wc1 + ((size_t)kv * 512 + pn * 256) * 1024 * 2 + ks * 512 * 2; return true;
    }
    __device__ __forceinline__ unsigned arow(const pg8::Unit&, int r) const { return (unsigned)r * 2048u; }
    __device__ __forceinline__ void a_ready(const pg8::Unit&) const {}
    __device__ __forceinline__ void done(const pg8::Unit&) const {}
};
struct EpiCmp {
    static constexpr bool PERM = false, CHAIN = false;
    float* Pc; size_t pseg;
    __device__ __forceinline__ void operator()(const pg8::f32x4 (&acc)[2][2][4][2], const pg8::Unit& u, int wr, int wc, int fr, int fq) const {
        float* base = Pc + (size_t)u.tag * pseg; const int col0 = u.pn * 256 + wc * 32 + 4 * fq;
#pragma unroll
        for (int ai = 0; ai < 2; ++ai)
#pragma unroll
            for (int m = 0; m < 4; ++m) { float* rowp = base + (size_t)(u.pm * 256 + ai * 128 + wr * 64 + m * 16 + fr) * 512 + col0;
#pragma unroll
                for (int bj = 0; bj < 2; ++bj)
#pragma unroll
                    for (int n = 0; n < 2; ++n) *(pg8::f32x4*)(rowp + bj * 128 + n * 16) = acc[ai][bj][m][n]; }
    }
};
__device__ __forceinline__ void finish_b1p(const P& p);
__device__ __forceinline__ void phase_cmp1(const P& p, char* smem) {
    if (blockIdx.x == gridDim.x - 1) finish_b1p(p);
    const int nrows = p.nb * 2 * 256;
    CmpSched Sc{(const char*)p.kv6, (const char*)p.Wc1, p.pcmp, nrows / 256, (int)gridDim.x, (int)blockIdx.x, kvseg(p) * 2, (size_t)(nrows + 8) * 512};
    EpiCmp E{p.pcmp, (size_t)(nrows + 8) * 512};
    pg8::gemm_phase<EpiCmp, CmpSched, true, false>((PG8_LAS unsigned char*)smem, 512, 1024, 1024, Sc, E);
}
__device__ __forceinline__ void body_cmp2f(const P& p, int vb, char* smem) {
    const int tid = TIDX(); const int nrows = p.nb * 2 * 256, nvb1 = nrows / 16; const int kv = vb / nvb1, row0 = (vb % nvb1) * 16;
    const size_t pseg = (size_t)(nrows + 8) * 512; const float* P0 = p.pcmp + (size_t)(kv * 2) * pseg; const float* P1 = P0 + pseg;
    float* hs = (float*)smem;
    float* w2s = (float*)smem + 16 * 256;
    __syncthreads();
    { const float4* wsrc = (const float4*)(kv ? p.cw2_v : p.cw2_k);
#pragma unroll
      for (int k = 0; k < 8; ++k) ((float4*)w2s)[tid + k * 512] = wsrc[tid + k * 512]; }
#pragma unroll
    for (int k = 0; k < 8; ++k) { const int idx = tid + k * 512, rr = idx >> 8, n = idx & 255; const size_t m = (size_t)(row0 + rr);
        const float z = P0[m * 512 + n] + P1[m * 512 + n] + P0[(m + 1) * 512 + 256 + n] + P1[(m + 1) * 512 + 256 + n] + p.b1p[kv * 256 + n];
        hs[idx] = geluf_(z); }
    __syncthreads();
    const int rr = tid >> 5, i = tid & 31, row = row0 + rr;
    const float* h = hs + rr * 256; const float* b2 = kv ? p.cb2_v : p.cb2_k;
    float z1 = b2[i], z2 = b2[i + 32];
#pragma unroll 8
    for (int n = 0; n < 256; ++n) { const float hv = h[n]; z1 += hv * w2s[n * 64 + i]; z2 += hv * w2s[n * 64 + i + 32]; }
    bf16* dst = (kv ? p.vcmp : p.kcmp) + (size_t)row * 64;
    if (kv == 0) {
        const int bg = row >> 8, m = row & 255, b = bg >> 1; int sp = 16 * m + 31; if (sp > S - 1) sp = S - 1;
        const size_t t = (size_t)b * S + sp; const float c = p.cs[t * 64 + i], sn = p.cs[t * 64 + 32 + i];
        const float r1 = z1 * c - z2 * sn, r2 = z2 * c + z1 * sn; z1 = r1; z2 = r2;
    }
    dst[i] = f2bf(z1); dst[i + 32] = f2bf(z2);
}
__device__ __forceinline__ void phase_cmp2(const P& p, char* smem) {
    const int n = 2 * (p.nb * 2 * 256) / 16;
    for (int vb = blockIdx.x; vb < n; vb += gridDim.x) body_cmp2f(p, vb, smem);
}
__device__ __forceinline__ void prep_b1p(const P& p, char* smem) {
    if (blockIdx.x >= 64) return;
    const int tid = TIDX(), kv = blockIdx.x >> 5, part = blockIdx.x & 31, n = tid & 255, fh = tid >> 8;
    const float* pe = kv ? p.cpos_v : p.cpos_k; const float* w1 = kv ? p.cw1_v : p.cw1_k;
    const int f0 = part * 64 + fh * 32; float a = 0.f;
#pragma unroll
    for (int i = 0; i < 32; ++i) a += pe[f0 + i] * w1[(size_t)(f0 + i) * 256 + n];
    float* sc = (float*)(smem + LDS_MISC);
    __syncthreads();
    if (fh == 1) sc[n] = a;
    __syncthreads();
    if (fh == 0) p.b1p[512 + (kv * 32 + part) * 256 + n] = a + sc[n];
    __syncthreads();
}
__device__ __forceinline__ void finish_b1p(const P& p) {
    const int tid = TIDX(), kv = tid >> 8, n = tid & 255; float a = (kv ? p.cb1_v : p.cb1_k)[n];
    for (int part = 0; part < 32; ++part) a += p.b1p[512 + (kv * 32 + part) * 256 + n];
    p.b1p[kv * 256 + n] = a;
}
#define XB_TMO      128
#define XB_XCNT(j)  (256  + 64 * (j))
#define XB_XSUB(j)  (1280 + 64 * (j))
#define XB_XGEN(j)  (2304 + 64 * (j))
#define XB_TOP      3328
#define XB_TOPGEN   3392
#define XCD_BAR_WORDS 3456
#define XB_SPIN_CAP (1u << 18)
#define XLAS __attribute__((address_space(3)))
__device__ __forceinline__ unsigned xb_ld(unsigned* p)              { return __hip_atomic_load(p, __ATOMIC_RELAXED, __HIP_MEMORY_SCOPE_AGENT); }
__device__ __forceinline__ unsigned xb_add(unsigned* p, unsigned v) { return __hip_atomic_fetch_add(p, v, __ATOMIC_RELAXED, __HIP_MEMORY_SCOPE_AGENT); }
__device__ __forceinline__ unsigned xb_xcc_id() { return (unsigned)__builtin_amdgcn_s_getreg((3 << 11) | 20) & 0xFu; }
#define XB_SPIN(cond, bar) do { unsigned _sp = 0; while (cond) { __builtin_amdgcn_s_sleep(1); \
    if ((++_sp & 255u) == 0u) { if (xb_ld(&(bar)[XB_TMO])) break; if (_sp > XB_SPIN_CAP) { atomicAdd(&(bar)[XB_TMO], 1u); break; } } } } while (0)
struct XcdBarrier { unsigned* bar; unsigned x; volatile XLAS unsigned* st; };
__device__ __forceinline__ XcdBarrier xcd_barrier_post(unsigned* bar, volatile XLAS unsigned* st) {
    XcdBarrier b; b.bar = bar; b.x = xb_xcc_id(); b.st = st;
    if (TIDX() == 0) (void)xb_add(&bar[XB_XCNT(b.x)], 1u);
    return b;
}
__device__ __forceinline__ void xcd_barrier_complete(unsigned* bar, unsigned x, unsigned& nloc, unsigned& nx) {
    const unsigned G = gridDim.x * gridDim.y * gridDim.z;
    unsigned sum, cnt, mine, sp = 0u;
    for (;;) {
        sum = 0u; cnt = 0u; mine = 0u;
#pragma unroll
        for (unsigned j = 0; j < 16; ++j) { const unsigned c = xb_ld(&bar[XB_XCNT(j)]); sum += c; cnt += (c > 0u) ? 1u : 0u; mine = (j == x) ? c : mine; }
        if (sum == G) break;
        __builtin_amdgcn_s_sleep(1);
        if ((++sp & 255u) == 0u) { if (xb_ld(&bar[XB_TMO])) break; if (sp > XB_SPIN_CAP) { atomicAdd(&bar[XB_TMO], 1u); break; } }
    }
    nloc = mine > 0u ? mine : 1u; nx = cnt > 0u ? cnt : 1u;
}
__device__ __forceinline__ void xcd_barrier(const XcdBarrier& b) {
    asm volatile("s_waitcnt vmcnt(0)" ::: "memory");
    __syncthreads();
    if (TIDX() == 0) {
        unsigned* bar = b.bar;
        __builtin_amdgcn_s_waitcnt(0);
        unsigned nloc = b.st[0], nx = b.st[1];
        if (nloc == 0u) { xcd_barrier_complete(bar, b.x, nloc, nx); b.st[0] = nloc; b.st[1] = nx; }
        const unsigned old = xb_add(&bar[XB_XSUB(b.x)], 1u);
        const unsigned gen = old / nloc;
        if (old + 1u == (gen + 1u) * nloc) {
            __builtin_amdgcn_fence(__ATOMIC_RELEASE, "agent");
            asm volatile("s_waitcnt vmcnt(0)" ::: "memory");
            const unsigned og = xb_add(&bar[XB_TOP], 1u);
            const unsigned tg = og / nx;
            if (og + 1u == (tg + 1u) * nx) xb_add(&bar[XB_TOPGEN], 1u);
            else XB_SPIN(xb_ld(&bar[XB_TOPGEN]) == tg, bar);
            __builtin_amdgcn_fence(__ATOMIC_ACQUIRE, "agent");
            xb_add(&bar[XB_XGEN(b.x)], 1u);
            asm volatile("s_waitcnt vmcnt(0)" ::: "memory");
        } else {
            XB_SPIN(xb_ld(&bar[XB_XGEN(b.x)]) == gen, bar);
            __builtin_amdgcn_fence(__ATOMIC_ACQUIRE, "agent");
            asm volatile("s_waitcnt vmcnt(0)" ::: "memory");
        }
    }
    __syncthreads();
}

template <int ST> __device__ __forceinline__ void run_stage(const P& p, char* smem, int first, int stride) {
    const int nvb = stage_nvb(ST, p.T);
    for (int vb = first; vb < nvb; vb += stride) {
        if constexpr (ST == ST_RMS) body_rms(p, vb);
        else if constexpr (ST == ST_CS) body_cs(p, vb);
        else if constexpr (ST == ST_INPROJ) body_inproj(p, vb, smem);
        else if constexpr (ST == ST_CMP1) body_cmp1(p, vb, smem);
        else if constexpr (ST == ST_CMP2) body_cmp2(p, vb);
        else if constexpr (ST == ST_NSACMP) body_nsacmp(p, vb, smem);
        else if constexpr (ST == ST_NSAATT) body_nsaatt(p, vb);
        else if constexpr (ST == ST_GLAA) body_glaa(p, vb);
        else if constexpr (ST == ST_GLASCAN) body_glascan(p, vb, smem);
        else if constexpr (ST == ST_GLANORM) body_glanorm(p, vb);
        else if constexpr (ST == ST_PROJ) body_proj(p, vb, smem);
        else if constexpr (ST == ST_OUT) body_out(p, vb, smem);
        else if constexpr (ST == ST_ROUTE) body_route(p, vb, smem);
        else if constexpr (ST == ST_MOE1) body_moe1(p, vb, smem);
        else if constexpr (ST == ST_MOE2) body_moe2(p, vb, smem);
        else if constexpr (ST == ST_FINAL) body_final(p, vb, smem);
    }
}
template <int ST> __global__ void __launch_bounds__(NT) k_stage(P p) {
    extern __shared__ __attribute__((aligned(16))) char smem[];
    run_stage<ST>(p, smem, blockIdx.x, gridDim.x);
}
__global__ void __launch_bounds__(NT) k_mega(P p) {
    extern __shared__ __attribute__((aligned(16))) char smem[];
    cg::grid_group grid = cg::this_grid();
    const int b0 = blockIdx.x, G = gridDim.x;
    volatile XLAS unsigned* xst = (volatile XLAS unsigned*)((XLAS char*)smem + LDS_MISC + 3072);
    if (TIDX() < 4) xst[TIDX()] = 0u;
    __syncthreads();
    volatile unsigned long long* tsv = (volatile unsigned long long*)(p.ctl + 12288); int nts = 1;
    if (TSEL >= 0 && b0 == 0 && TIDX() == 0) tsv[0] = __builtin_amdgcn_s_memrealtime();
    const XcdBarrier xb = xcd_barrier_post(p.ctl + 4096, xst);
#define GSYNC() do { xcd_barrier(xb); if (TSEL >= 0 && b0 == 0 && TIDX() == 0) { tsv[nts] = __builtin_amdgcn_s_memrealtime(); } ++nts; } while (0)
#define DUPRUN(k, stmt) do { if (DUP == (k)) { stmt; GSYNC(); } } while (0)
    if (p.T < 0) grid.sync();
    phase_prep(p, smem); GSYNC();
    phase_inA(p, smem); GSYNC();                               DUPRUN(7, phase_inA(p, smem));
    phase_cmp1(p, smem); phase_gla1(p, smem); GSYNC();         DUPRUN(8, phase_cmp1(p, smem)); DUPRUN(4, phase_gla1(p, smem));
    phase_cmp2(p, smem); phase_gla2(p); GSYNC();               DUPRUN(9, phase_cmp2(p, smem));
    if (DUP >= 20 && DUP < 148) { P p2 = p; p2.onsa = (bf16*)p.pcmp; p2.sel = (u64*)((char*)p.pcmp + 16 * MiB_); phase_nsa<(DUP >= 20 && DUP < 148) ? DUP - 20 : 0>(p2, smem); GSYNC(); }
    phase_nsa(p, smem); phase_gla3(p, smem); GSYNC();          DUPRUN(1, phase_nsa(p, smem)); DUPRUN(2, phase_gla3(p, smem));
    phase_inB(p, smem); GSYNC();                               DUPRUN(11, phase_inB(p, smem));
    phase_proj(p, smem); GSYNC();                              DUPRUN(12, phase_proj(p, smem));
    phase_out(p, smem); GSYNC();                               DUPRUN(13, phase_out(p, smem));
    if (DUP == 17) { P p2 = p; p2.ctl = p.ctl + 8192; p2.vb = p.sa; p2.list = (int*)p.mixed; p2.tokslot = (int*)p.mixed + (1 << 20); p2.tokexp = (int*)p.mixed + (2 << 20); p2.tokw = (float*)p.mixed + (3 << 20);
        for (int vb = b0; vb < p.T / 64; vb += G) body_route3(p2, vb, smem);
        GSYNC(); }
    for (int vb = b0; vb < p.T / 64; vb += G) body_route3(p, vb, smem);
    GSYNC();
    phase_moe12(p, smem); GSYNC();
    if (DUP == 15) { GSYNC(); GSYNC(); GSYNC(); GSYNC(); GSYNC(); GSYNC(); GSYNC(); GSYNC(); GSYNC(); GSYNC(); }
    for (int vb = b0; vb < p.T / 8; vb += G) body_final_b(p, vb, smem);
    if (TSEL >= 0 && b0 == 0 && TIDX() == 0) { const unsigned long long tend = __builtin_amdgcn_s_memrealtime(); tsv[nts] = tend;
        const unsigned long long d = tsv[TSEL + 1] - tsv[TSEL]; while (__builtin_amdgcn_s_memrealtime() - tend < 4ull * d) __builtin_amdgcn_s_sleep(16); }
#undef DUPRUN
#undef GSYNC
}

enum Phase { PH_PREP = 0, PH_INA, PH_INB, PH_PROJ, PH_OUT, PH_MOE1, PH_MOE2, PH_NSA, PH_GLA1, PH_GLA2, PH_GLA3, PH_CMP1, PH_CMP2 };
template <int PH> __global__ void __launch_bounds__(NT) k_phase(P p) {
    extern __shared__ __attribute__((aligned(16))) char smem[];
    if constexpr (PH == PH_PREP) phase_prep(p, smem);
    else if constexpr (PH == PH_INA) phase_inA(p, smem);
    else if constexpr (PH == PH_INB) phase_inB(p, smem);
    else if constexpr (PH == PH_PROJ) phase_proj(p, smem);
    else if constexpr (PH == PH_OUT) phase_out(p, smem);
    else if constexpr (PH == PH_MOE1) phase_moe12(p, smem);
    else if constexpr (PH == PH_MOE2) { }
    else if constexpr (PH == PH_NSA) phase_nsa(p, smem);
    else if constexpr (PH == PH_GLA1) phase_gla1(p, smem);
    else if constexpr (PH == PH_GLA2) phase_gla2(p);
    else if constexpr (PH == PH_GLA3) phase_gla3(p, smem);
    else if constexpr (PH == PH_CMP1) phase_cmp1(p, smem);
    else if constexpr (PH == PH_CMP2) phase_cmp2(p, smem);
}
template <class TT> __device__ __forceinline__ float ldf(const TT* p, size_t i);
template <> __device__ __forceinline__ float ldf<bf16>(const bf16* p, size_t i) { return bf2f(p[i]); }
template <> __device__ __forceinline__ float ldf<float>(const float* p, size_t i) { return p[i]; }
template <class TT> __global__ void __launch_bounds__(256) k_compare(const TT* a, const TT* b, size_t n, float* err, int slot) {
    float num = 0.f, den = 0.f;
    for (size_t i = (size_t)blockIdx.x * 256 + TIDX(); i < n; i += (size_t)gridDim.x * 256) { const float x = ldf<TT>(a, i), y = ldf<TT>(b, i); const float d = x - y; num += (d == d) ? d * d : 1e30f; den += y * y; }
#pragma unroll
    for (int o = 1; o < 64; o <<= 1) { num += __shfl_xor(num, o); den += __shfl_xor(den, o); }
    if ((TIDX() & 63) == 0) { atomicAdd(err + 2 * slot, num); atomicAdd(err + 2 * slot + 1, den); }
}
__global__ void __launch_bounds__(256) k_compare_sel(const u64* a, const u64* b, size_t n, float* err, int slot) {
    float num = 0.f, den = 0.f;
    for (size_t i = (size_t)blockIdx.x * 256 + threadIdx.x; i < n; i += (size_t)gridDim.x * 256) { num += (a[i] != b[i]) ? 1.f : 0.f; den += 100.f; }
#pragma unroll
    for (int o = 1; o < 64; o <<= 1) { num += __shfl_xor(num, o); den += __shfl_xor(den, o); }
    if ((threadIdx.x & 63) == 0) { atomicAdd(err + 2 * slot, num); atomicAdd(err + 2 * slot + 1, den); }
}
__global__ void __launch_bounds__(256) k_report(float* out, size_t n, const float* err, int nslots, float tol) {
    int code = 0;
    for (int s = 0; s < nslots; ++s) { const float num = err[2 * s], den = err[2 * s + 1]; const bool bad = !(num <= tol * tol * den) || !(den > 0.f); if (bad) { code = s + 1; break; } }
    if (code == 0) return;
    const float f = 1.f + 0.1f * (float)code;
    for (size_t i = (size_t)blockIdx.x * 256 + TIDX(); i < n; i += (size_t)gridDim.x * 256) out[i] *= f;
}

static void set_inputs(P& p, void* const* d_in) {
    const float* const* in = (const float* const*)d_in;
    p.x = in[0]; p.pos = (const int*)d_in[1]; p.g_mix = in[2]; p.w_in = in[3];
    p.cpos_k = in[4]; p.cw1_k = in[5]; p.cb1_k = in[6]; p.cw2_k = in[7]; p.cb2_k = in[8];
    p.cpos_v = in[9]; p.cw1_v = in[10]; p.cb1_v = in[11]; p.cw2_v = in[12]; p.cb2_v = in[13];
    p.w_a2 = in[14]; p.b_a = in[15]; p.norm_g = in[16]; p.w_pn = in[17]; p.w_pg = in[18]; p.w_out = in[19];
    p.g_ffn = in[20]; p.w_grp = in[21]; p.b_grp = in[22]; p.w_exp = in[23]; p.b_exp = in[24]; p.w_gate = in[25]; p.w_up = in[26]; p.w_down = in[27]; p.g_final = in[28];
}
constexpr size_t MiB = 1u << 20;
static void layout_ref(P& p, char* small, char* act, char* scratch, float* out, int nb) {
    const size_t q = (MiB / 4) * nb;
    p.nb = nb; p.T = nb * S; p.out = out;
    p.ctl = (unsigned*)small; p.sel = (u64*)(small + q / 16 * 1); p.kcmp = (bf16*)(small + q / 2); p.vcmp = (bf16*)(small + q / 4 * 3);
    p.tokslot = (int*)(small + q); p.tokexp = (int*)(small + q + q / 8); p.tokw = (float*)(small + q + q / 4);
    p.alow = (float*)(small + 2 * q); p.gates = (float*)(small + 3 * q); p.cs = (float*)(small + 5 * q); p.hcmp = (float*)(small + 9 * q); p.list = (int*)(small + 13 * q);
    p.u = (bf16*)act; p.ocmp = (float*)act; p.mixed = (bf16*)act; p.vb = (bf16*)act;
    p.q = (bf16*)(act + 32 * q); p.kv6 = (bf16*)(act + 48 * q);
    p.gq = (bf16*)(act + 73 * q); p.gk = (bf16*)(act + 81 * q); p.gv = (bf16*)(act + 89 * q); p.rs = (bf16*)(act + 105 * q);
    p.H = (bf16*)(act + 32 * q);
    p.sa = (bf16*)(act + 123 * q); p.sb = (bf16*)(act + 155 * q); p.onsa = (bf16*)(act + 187 * q); p.gla = (bf16*)(act + 203 * q);
    p.Y = (bf16*)(act + 123 * q);
    p.ga = (float*)scratch; p.oraw = (float*)(scratch + 16 * q); p.h1 = (float*)(scratch + 48 * q);
    p.gst = (float*)(scratch + 16 * q); p.gdec = (float*)(small + 15 * q); p.gb = (float*)(act + 219 * q);
}
static void layout_compact(P& p, char* ws, float* out) {
    p.nb = NB; p.T = NB * S; p.out = out;
    char* small = ws; const size_t q = MiB;
    p.ctl = (unsigned*)small; p.sel = (u64*)(small + q / 16 * 1); p.kcmp = (bf16*)(small + q / 2); p.vcmp = (bf16*)(small + q / 4 * 3);
    p.tokslot = (int*)(small + q); p.tokexp = (int*)(small + q + q / 8); p.tokw = (float*)(small + q + q / 4);
    p.alow = (float*)(small + 2 * q); p.gates = (float*)(small + 3 * q); p.cs = (float*)(small + 5 * q); p.hcmp = (float*)(small + 9 * q); p.list = (int*)(small + 13 * q);
    p.u = (bf16*)(ws + 128 * MiB); p.vb = (bf16*)(ws + 128 * MiB);
    p.q = (bf16*)(ws + 160 * MiB); p.kv6 = (bf16*)(ws + 176 * MiB); p.gq = (bf16*)(ws + 201 * MiB); p.gk = (bf16*)(ws + 209 * MiB); p.gv = (bf16*)(ws + 217 * MiB); p.rs = (bf16*)(ws + 233 * MiB);
    p.ga = (float*)(ws + 249 * MiB); p.ocmp = (float*)(ws + 249 * MiB);
    p.sa = (bf16*)(ws + 160 * MiB); p.sb = (bf16*)(ws + 192 * MiB); p.mixed = (bf16*)(ws + 224 * MiB);
    p.H = (bf16*)(ws + 160 * MiB); p.Y = (bf16*)(ws + 48 * MiB);
    p.onsa = (bf16*)out; p.gla = (bf16*)((char*)out + 16 * MiB); p.oraw = (float*)((char*)out + 32 * MiB); p.h1 = out;
    p.gst = (float*)((char*)out + 32 * MiB); p.gdec = (float*)(small + 15 * q); p.pcmp = (float*)(ws + 249 * MiB); p.h1b = (bf16*)(ws + 249 * MiB); p.gb = (float*)(ws + 266 * MiB);
}
static void layout_weights(P& p, char* w) {
    p.wr = (float*)(w - 256 * 1024); p.b1p = (float*)(w - 100 * 1024);
    p.Wd = (bf16*)w; p.Wgu = (bf16*)(w + 32 * MiB); p.Wt_in = (bf16*)(w + 96 * MiB); p.Wc1 = (bf16*)(w + 106 * MiB);
    p.Wpn = (bf16*)(w + 108 * MiB); p.Wpg = (bf16*)(w + 109 * MiB); p.Wo = (bf16*)(w + 110 * MiB);
}

template <int ST> static void launch_stage(const P& p, hipStream_t stream) {
    static bool attr = false;
    if (!attr) { (void)hipFuncSetAttribute((const void*)k_stage<ST>, hipFuncAttributeMaxDynamicSharedMemorySize, LDS_BYTES); attr = true; }
    int nvb = stage_nvb(ST, p.T); if (nvb > 16384) nvb = 16384;
    hipLaunchKernelGGL(k_stage<ST>, dim3(nvb), dim3(NT), LDS_BYTES, stream, p);
}
template <int PH> static void launch_phase(const P& p, hipStream_t stream, int grid = 40) {
    static bool attr = false;
    if (!attr) { (void)hipFuncSetAttribute((const void*)k_phase<PH>, hipFuncAttributeMaxDynamicSharedMemorySize, LDS_BYTES); attr = true; }
    hipLaunchKernelGGL(k_phase<PH>, dim3(grid), dim3(NT), LDS_BYTES, stream, p);
}
template <class TT> static void compare(const TT* a, const TT* b, size_t n, float* err, int slot, hipStream_t stream) {
    hipLaunchKernelGGL(k_compare<TT>, dim3(1024), dim3(256), 0, stream, a, b, n, err, slot);
}
static void launch_mega(const P& p, hipStream_t stream) {
    static int grid = 0;
    if (!grid) {
        int dev = 0, cus = 0, per_cu = 0;
        (void)hipGetDevice(&dev); (void)hipDeviceGetAttribute(&cus, hipDeviceAttributeMultiprocessorCount, dev);
        (void)hipFuncSetAttribute((const void*)k_mega, hipFuncAttributeMaxDynamicSharedMemorySize, LDS_BYTES);
        (void)hipOccupancyMaxActiveBlocksPerMultiprocessor(&per_cu, (const void*)k_mega, NT, LDS_BYTES);
        if (per_cu < 1) per_cu = 1;
        grid = cus * per_cu;
    }
    (void)hipMemsetAsync((void*)p.ctl, 0, 64 * 1024, stream);
    P pp = p; void* args[] = {(void*)&pp};
    (void)hipLaunchCooperativeKernel((const void*)k_mega, dim3(grid), dim3(NT), args, LDS_BYTES, stream);
}

extern "C" void kernel_launch(void* const* d_in, const int* in_sizes, int n_in, void* d_out, int out_size, void* d_ws, size_t ws_size, hipStream_t stream) {
    char* ws = (char*)d_ws;
    P p{}; set_inputs(p, d_in); layout_ref(p, ws, ws + 16 * MiB, (char*)d_out, (float*)d_out, NB); p.h1 = (float*)d_out;
#if MODE == 0
    (void)hipMemsetAsync(d_ws, 0, 4096, stream);
    launch_stage<ST_RMS>(p, stream); launch_stage<ST_CS>(p, stream); launch_stage<ST_INPROJ>(p, stream);
    launch_stage<ST_CMP1>(p, stream); launch_stage<ST_CMP2>(p, stream); launch_stage<ST_NSACMP>(p, stream); launch_stage<ST_NSAATT>(p, stream);
    launch_stage<ST_GLAA>(p, stream); launch_stage<ST_GLASCAN>(p, stream); launch_stage<ST_GLANORM>(p, stream);
    launch_stage<ST_PROJ>(p, stream); launch_stage<ST_OUT>(p, stream); launch_stage<ST_ROUTE>(p, stream);
    launch_stage<ST_MOE1>(p, stream); launch_stage<ST_MOE2>(p, stream); launch_stage<ST_FINAL>(p, stream);
#elif MODE == 1
    { P c{}; set_inputs(c, d_in); layout_weights(c, ws + 16 * MiB); layout_compact(c, ws, (float*)d_out); launch_mega(c, stream); }
#else
    { P c{}; set_inputs(c, d_in); layout_weights(c, ws + 16 * MiB); layout_compact(c, ws, (float*)d_out); launch_mega(c, stream); }
    P r{}; set_inputs(r, d_in); layout_weights(r, ws + 16 * MiB);
    layout_ref(r, ws + 128 * MiB, ws + 132 * MiB, ws + 200 * MiB, (float*)(ws + 200 * MiB + 12 * MiB), 1);
    char* alt = ws + 228 * MiB; float* err = (float*)(ws + 128 * MiB + 8192);
    (void)hipMemsetAsync(ws + 128 * MiB, 0, 16384, stream);
    int slot = 0; const size_t T1 = S; const size_t ROWS1 = 2 * T1 + NEXP * 256;
    launch_stage<ST_RMS>(r, stream); launch_stage<ST_CS>(r, stream); launch_stage<ST_INPROJ>(r, stream);
    P f = r; { char* a = alt;
        f.u = (bf16*)a; a += T1 * 1024 * 2; f.cs = (float*)a; a += T1 * 64 * 4; f.q = (bf16*)a; a += T1 * 512 * 2; f.kv6 = (bf16*)a; a += 6 * (size_t)2 * S * 64 * 2 + 4096;
        f.gates = (float*)a; a += T1 * 24 * 4; f.gq = (bf16*)a; a += T1 * 256 * 2; f.gk = (bf16*)a; a += T1 * 256 * 2; f.gv = (bf16*)a; a += T1 * 512 * 2; f.alow = (float*)a; a += T1 * 16 * 4;
        f.rs = (bf16*)a; a += T1 * 512 * 2; f.sa = (bf16*)a; a += T1 * 1024 * 2; f.sb = (bf16*)a; a += T1 * 1024 * 2; }
    launch_phase<PH_PREP>(f, stream); launch_phase<PH_INA>(f, stream); launch_phase<PH_INB>(f, stream);
    compare<bf16>(f.q, r.q, T1 * 512, err, slot++, stream);
    compare<bf16>(f.kv6, r.kv6, 6 * (size_t)2 * S * 64, err, slot++, stream);
    compare<bf16>(f.sb, r.sb, T1 * 1024, err, slot++, stream);
    launch_stage<ST_CMP1>(r, stream); launch_stage<ST_CMP2>(r, stream);
    f = r; f.pcmp = (float*)alt; f.kcmp = (bf16*)(alt + 20 * MiB); f.vcmp = (bf16*)(alt + 21 * MiB); launch_phase<PH_CMP1>(f, stream); launch_phase<PH_CMP2>(f, stream);
    compare<bf16>(f.kcmp, r.kcmp, (size_t)2 * 255 * 64, err, slot++, stream); compare<bf16>(f.vcmp + 256 * 64, r.vcmp + 256 * 64, (size_t)255 * 64, err, slot++, stream);
    launch_stage<ST_NSACMP>(r, stream); launch_stage<ST_NSAATT>(r, stream);
    f = r; f.onsa = (bf16*)alt; f.sel = (u64*)(alt + 8 * MiB); launch_phase<PH_NSA>(f, stream);
    hipLaunchKernelGGL(k_compare_sel, dim3(64), dim3(256), 0, stream, (const u64*)f.sel, (const u64*)r.sel, T1 * 2, err, slot++);
    compare<bf16>(f.onsa, r.onsa, T1 * 512, err, slot++, stream);
    launch_stage<ST_GLAA>(r, stream); launch_stage<ST_GLASCAN>(r, stream); launch_stage<ST_GLANORM>(r, stream);
    f = r; f.gla = (bf16*)alt; f.gst = (float*)(alt + 8 * MiB); f.gdec = (float*)(alt + 18 * MiB); launch_phase<PH_GLA1>(f, stream); launch_phase<PH_GLA2>(f, stream); launch_phase<PH_GLA3>(f, stream);
    compare<bf16>(f.gla, r.gla, T1 * 512, err, slot++, stream);
    launch_stage<ST_PROJ>(r, stream);
    f = r; f.mixed = (bf16*)alt; launch_phase<PH_PROJ>(f, stream);
    compare<bf16>(f.mixed, r.mixed, T1 * 1024, err, slot++, stream);
    launch_stage<ST_OUT>(r, stream);
    f = r; f.h1b = (bf16*)alt; launch_phase<PH_OUT>(f, stream);
    launch_stage<ST_ROUTE>(r, stream);
    (void)hipMemsetAsync(r.H, 0, ROWS1 * 512 * 2, stream); (void)hipMemsetAsync(alt, 0, ROWS1 * 512 * 2, stream);
    (void)hipMemsetAsync(r.Y, 0, ROWS1 * 1024 * 2, stream); (void)hipMemsetAsync(alt + 17 * MiB, 0, ROWS1 * 1024 * 2, stream);
    launch_stage<ST_MOE1>(r, stream); launch_stage<ST_MOE2>(r, stream);
    f = r; f.H = (bf16*)alt; f.Y = (bf16*)(alt + 17 * MiB); launch_phase<PH_MOE1>(f, stream);
    compare<bf16>(f.H, r.H, ROWS1 * 512, err, slot++, stream);
    compare<bf16>(f.Y, r.Y, ROWS1 * 1024, err, slot++, stream);
    hipLaunchKernelGGL(k_report, dim3(1024), dim3(256), 0, stream, (float*)d_out, (size_t)NB * S * D, (const float*)err, slot, 0.02f);
#endif
}
```

```cpp
#include <hip/hip_runtime.h>
#include <hip/hip_cooperative_groups.h>
#include <stdint.h>
namespace cg = cooperative_groups;

#ifndef DUP
#define DUP 0
#endif
#ifndef TSEL
#define TSEL -1
#endif
#ifndef MODE
#define MODE 1
#endif

typedef unsigned short bf16;
typedef unsigned long long u64;

__device__ __forceinline__ int TIDX() { int t = threadIdx.x; asm volatile("" : "+v"(t)); return t; }
__device__ __forceinline__ float bf2f(bf16 v) { return __uint_as_float(((unsigned)v) << 16); }
__device__ __forceinline__ bf16 f2bf(float f) { unsigned u = __float_as_uint(f); return (bf16)((u + 0x7fffu + ((u >> 16) & 1u)) >> 16); }
__device__ __forceinline__ float sigmoidf_(float x) { return __builtin_amdgcn_rcpf(1.f + __expf(-x)); }
__device__ __forceinline__ float siluf_(float x) { return x * __builtin_amdgcn_rcpf(1.f + __expf(-x)); }
__device__ __forceinline__ float geluf_(float x) { const float u = 0.7978845608028654f * (x + 0.044715f * x * x * x); return x * __builtin_amdgcn_rcpf(1.f + __expf(-2.f * u)); }

constexpr int NB = 4, S = 4096, D = 1024;
constexpr int NT = 512;
constexpr int LDS_BYTES = 144 * 1024;
constexpr int LDS_MISC = 136 * 1024;
constexpr int INW = 4904;
constexpr int OFF_Q = 0, OFF_KV = 512, OFF_NG = 1280, OFF_GQ = 1304, OFF_GK = 1560, OFF_GV = 1816, OFF_GA = 2328, OFF_GR = 2344, OFF_MA = 2856, OFF_MB = 3880;
constexpr int NEXP = 32;
constexpr size_t MiB_ = 1u << 20;

struct P {
    const float* x; const int* pos; const float* g_mix; const float* w_in;
    const float *cpos_k, *cw1_k, *cb1_k, *cw2_k, *cb2_k, *cpos_v, *cw1_v, *cb1_v, *cw2_v, *cb2_v;
    const float *w_a2, *b_a, *norm_g, *w_pn, *w_pg, *w_out, *g_ffn, *w_grp, *b_grp, *w_exp, *b_exp, *w_gate, *w_up, *w_down, *g_final;
    float* out;
    unsigned* ctl;
    float* cs;
    bf16* u;
    bf16* q;
    bf16* kv6;
    float* gates;
    bf16 *gq, *gk, *gv;
    float* alow;
    bf16 *rs, *sa, *sb;
    unsigned char *sa8, *sb8;
    float* hcmp;
    bf16 *kcmp, *vcmp;
    u64* sel;
    float* ocmp;
    bf16* onsa;
    float* ga;
    float* oraw;
    bf16* gla;
    bf16* mixed;
    float* h1;
    bf16* h1b;
    bf16* vb;
    int* list;
    int* tokslot;
    int* tokexp;
    float* tokw;
    bf16* H;
    bf16* Y;
    float* gst;
    float* gdec;
    float* gb;
    float* pcmp;
    float* b1p;
    bf16 *wrh, *wrl;
    float* wr;
    bf16 *Wt_in, *Wc1, *Wpn, *Wpg, *Wo, *Wgu, *Wd;
    int nb, T;
};
__device__ __forceinline__ size_t kvseg(const P& p) { return (size_t)p.nb * 2 * S * 64; }

enum Stage { ST_RMS = 0, ST_CS, ST_INPROJ, ST_CMP1, ST_CMP2, ST_NSACMP, ST_NSAATT, ST_GLAA, ST_GLASCAN, ST_GLANORM, ST_PROJ, ST_OUT, ST_ROUTE, ST_MOE1, ST_MOE2, ST_FINAL, ST_COUNT };

__host__ __device__ inline int stage_nvb(int st, int T) {
    switch (st) {
        case ST_RMS: return T / 8;
        case ST_CS: return T * 32 / NT;
        case ST_INPROJ: return ((INW + NT - 1) / NT) * (T / 8);
        case ST_CMP1: return 2 * (T / S) * 2 * 256 / 8;
        case ST_CMP2: return 2 * (T / S) * 2 * 256 * 32 / NT;
        case ST_NSACMP: return T / 64 * 2 / 8;
        case ST_NSAATT: return T / 64 * 8 / 8;
        case ST_GLAA: return T / 2;
        case ST_GLASCAN: return (T / S) * 4 / 4;
        case ST_GLANORM: return T * 4 / NT;
        case ST_PROJ: return 2 * (T / 8);
        case ST_OUT: return 2 * (T / 8);
        case ST_ROUTE: return T / 8;
        case ST_MOE1: return (2 * T + NEXP * 256) / 8;
        case ST_MOE2: return 2 * ((2 * T + NEXP * 256) / 8);
        case ST_FINAL: return T / 8;
    }
    return 0;
}

__device__ __forceinline__ void body_rms(const P& p, int vb) {
    const int lane = TIDX() & 63, t = vb * 8 + (TIDX() >> 6);
    const float4* xr = (const float4*)(p.x + (size_t)t * D);
    float4 v[4]; float ss = 0.f;
#pragma unroll
    for (int j = 0; j < 4; ++j) { v[j] = xr[lane + 64 * j]; ss += v[j].x * v[j].x + v[j].y * v[j].y + v[j].z * v[j].z + v[j].w * v[j].w; }
#pragma unroll
    for (int o = 1; o < 64; o <<= 1) ss += __shfl_xor(ss, o);
    const float rstd = rsqrtf(ss * (1.f / D) + 1e-6f);
#pragma unroll
    for (int j = 0; j < 4; ++j) {
        const float4 g = ((const float4*)p.g_mix)[lane + 64 * j];
        ushort4 o; o.x = f2bf(v[j].x * rstd * g.x); o.y = f2bf(v[j].y * rstd * g.y); o.z = f2bf(v[j].z * rstd * g.z); o.w = f2bf(v[j].w * rstd * g.w);
        ((ushort4*)(p.u + (size_t)t * D))[lane + 64 * j] = o;
    }
}
__device__ __forceinline__ void rms2_load(const P& p, int vb, float4 (&v)[8]) {
    const int lane = TIDX() & 63, t = vb * 16 + (TIDX() >> 6) * 2;
    const float4* xr = (const float4*)(p.x + (size_t)t * D);
#pragma unroll
    for (int j = 0; j < 8; ++j) v[j] = xr[lane + 64 * j];
}
__device__ __forceinline__ void rms2_finish(const P& p, int vb, const float4 (&v)[8]) {
    const int lane = TIDX() & 63, t = vb * 16 + (TIDX() >> 6) * 2;
    float4 gv[4];
#pragma unroll
    for (int j = 0; j < 4; ++j) gv[j] = ((const float4*)p.g_mix)[lane + 64 * j];
    float s0 = 0.f, s1 = 0.f;
#pragma unroll
    for (int j = 0; j < 4; ++j) { s0 += v[j].x * v[j].x + v[j].y * v[j].y + v[j].z * v[j].z + v[j].w * v[j].w; s1 += v[4 + j].x * v[4 + j].x + v[4 + j].y * v[4 + j].y + v[4 + j].z * v[4 + j].z + v[4 + j].w * v[4 + j].w; }
#pragma unroll
    for (int o = 1; o < 64; o <<= 1) { s0 += __shfl_xor(s0, o); s1 += __shfl_xor(s1, o); }
    const float r0 = rsqrtf(s0 * (1.f / D) + 1e-6f), r1 = rsqrtf(s1 * (1.f / D) + 1e-6f);
#pragma unroll
    for (int j = 0; j < 4; ++j) {
        const float4 g = gv[j];
        ushort4 o; o.x = f2bf(v[j].x * r0 * g.x); o.y = f2bf(v[j].y * r0 * g.y); o.z = f2bf(v[j].z * r0 * g.z); o.w = f2bf(v[j].w * r0 * g.w);
        ((ushort4*)(p.u + (size_t)t * D))[lane + 64 * j] = o;
        ushort4 q; q.x = f2bf(v[4 + j].x * r1 * g.x); q.y = f2bf(v[4 + j].y * r1 * g.y); q.z = f2bf(v[4 + j].z * r1 * g.z); q.w = f2bf(v[4 + j].w * r1 * g.w);
        ((ushort4*)(p.u + (size_t)(t + 1) * D))[lane + 64 * j] = q;
    }
}
__device__ __forceinline__ void body_rms2(const P& p, int vb) { float4 v[8]; rms2_load(p, vb, v); rms2_finish(p, vb, v); }
__device__ __forceinline__ void cs_compute(const P& p, int vb, int posv) {
    const int idx = vb * NT + TIDX(); const int t = idx >> 5, i = idx & 31;
    const float inv = 1.0f / powf(10000.0f, (float)i / 32.0f);
    const float ang = (float)posv * inv;
    const double a = (double)ang; const double k = rint(a * 0.15915494309189535); const float r = (float)(a - k * 6.283185307179586);
    p.cs[(size_t)t * 64 + i] = cosf(r); p.cs[(size_t)t * 64 + 32 + i] = sinf(r);
}
__device__ __forceinline__ void body_cs(const P& p, int vb) { cs_compute(p, vb, p.pos[(vb * NT + TIDX()) >> 5]); }

template <int K, bool TWO, bool SAMEA, class AF1, class AF2, class Epi>
__device__ __forceinline__ void ngemm(float* lds, int m0, const float* W1, int ldw1, int n1, const float* W2, int ldw2, int n2, AF1 a1, AF2 a2, Epi epi) {
    const int tid = TIDX();
    for (int idx = tid; idx < 8 * K; idx += NT) { const int i = idx / K, k = idx % K; lds[idx] = a1(m0 + i, k); if (TWO && !SAMEA) lds[8 * K + idx] = a2(m0 + i, k); }
    __syncthreads();
    float acc1[8], acc2[8];
#pragma unroll
    for (int i = 0; i < 8; ++i) { acc1[i] = 0.f; acc2[i] = 0.f; }
    const float* w1 = W1 + n1; const float* w2 = TWO ? (W2 + n2) : w1;
    const float* l2 = (TWO && !SAMEA) ? lds + 8 * K : lds;
    for (int k = 0; k < K; k += 4) {
        float a[4], b[4];
#pragma unroll
        for (int kk = 0; kk < 4; ++kk) { a[kk] = w1[(size_t)(k + kk) * ldw1]; b[kk] = TWO ? w2[(size_t)(k + kk) * ldw2] : 0.f; }
#pragma unroll
        for (int i = 0; i < 8; ++i) {
            const float4 x1 = *(const float4*)(lds + i * K + k);
            acc1[i] += x1.x * a[0] + x1.y * a[1] + x1.z * a[2] + x1.w * a[3];
            if (TWO) { const float4 x2 = *(const float4*)(l2 + i * K + k); acc2[i] += x2.x * b[0] + x2.y * b[1] + x2.z * b[2] + x2.w * b[3]; }
        }
    }
#pragma unroll
    for (int i = 0; i < 8; ++i) epi(m0 + i, acc1[i], acc2[i]);
    __syncthreads();
}

__device__ __forceinline__ void store_z(const P& p, int t, int j, float z, float zp) {
    const int b = t / S, s = t % S;
    if (j < OFF_KV) {
        const int d = j & 63, i = d & 31; const float c = p.cs[(size_t)t * 64 + i], sn = p.cs[(size_t)t * 64 + 32 + i];
        const float r = (d < 32) ? (z * c - zp * sn) : (z * c + zp * sn);
        p.q[(size_t)t * 512 + j] = f2bf(r * 0.125f);
    } else if (j < OFF_NG) {
        const int seg = (j - OFF_KV) >> 7, cc = (j - OFF_KV) & 127, g = cc >> 6, d = cc & 63; float r = z;
        if (seg == 2 || seg == 4) { const int i = d & 31; const float c = p.cs[(size_t)t * 64 + i], sn = p.cs[(size_t)t * 64 + 32 + i]; r = (d < 32) ? (z * c - zp * sn) : (z * c + zp * sn); }
        p.kv6[(size_t)seg * kvseg(p) + ((size_t)(b * 2 + g) * S + s) * 64 + d] = f2bf(r);
    } else if (j < OFF_GQ) { p.gates[(size_t)t * 24 + (j - OFF_NG)] = sigmoidf_(z);
    } else if (j < OFF_GK) { p.gq[(size_t)t * 256 + (j - OFF_GQ)] = f2bf(z * 0.125f);
    } else if (j < OFF_GV) { p.gk[(size_t)t * 256 + (j - OFF_GK)] = f2bf(z);
    } else if (j < OFF_GA) { p.gv[(size_t)t * 512 + (j - OFF_GV)] = f2bf(z);
    } else if (j < OFF_GR) { p.alow[(size_t)t * 16 + (j - OFF_GA)] = z;
    } else if (j < OFF_MA) { p.rs[(size_t)t * 512 + (j - OFF_GR)] = f2bf(siluf_(z));
    } else if (j < OFF_MB) { p.sa[(size_t)t * 1024 + (j - OFF_MA)] = f2bf(sigmoidf_(z));
    } else { p.sb[(size_t)t * 1024 + (j - OFF_MB)] = f2bf(sigmoidf_(z)); }
}
__device__ __forceinline__ int rope_partner(int j) {
    int base;
    if (j < OFF_KV) base = 0; else if (j >= 768 && j < 896) base = 768; else if (j >= 1024 && j < 1152) base = 1024; else return -1;
    const int d = (j - base) & 63; return d < 32 ? j + 32 : j - 32;
}
__device__ __forceinline__ void body_inproj(const P& p, int vb, char* smem) {
    constexpr int NCB = (INW + NT - 1) / NT;
    const int bx = vb % NCB, by = vb / NCB;
    const int jr = bx * NT + TIDX(); const bool jv = jr < INW; const int j = jv ? jr : INW - 1;
    int jp = rope_partner(j); if (jp < 0) jp = j;
    ngemm<1024, true, true>((float*)smem, by * 8, p.w_in, INW, j, p.w_in, INW, jp,
        [&](int m, int k) { return bf2f(p.u[(size_t)m * D + k]); }, [&](int m, int k) { return 0.f; },
        [&](int m, float z, float zp) { if (jv) store_z(p, m, j, z, zp); });
}

__device__ __forceinline__ void body_cmp1(const P& p, int vb, char* smem) {
    const int nrows = p.nb * 2 * 256, ng = nrows / 8;
    const int kv = vb / ng, m0 = (vb % ng) * 8; const int n = TIDX() & 255; const bool act = TIDX() < 256;
    const bf16* src = p.kv6 + (size_t)kv * kvseg(p);
    const float* pe = kv ? p.cpos_v : p.cpos_k; const float* w1 = kv ? p.cw1_v : p.cw1_k; const float* b1 = kv ? p.cb1_v : p.cb1_k;
    float* dst = p.hcmp + (size_t)kv * nrows * 256;
    ngemm<2048, false, true>((float*)smem, m0, w1, 256, n, w1, 256, n,
        [&](int m, int k) { return bf2f(src[(size_t)m * 1024 + k]) + pe[k]; }, [&](int m, int k) { return 0.f; },
        [&](int m, float z, float) { if (act) dst[(size_t)m * 256 + n] = geluf_(z + b1[n]); });
}
__device__ __forceinline__ void body_cmp2(const P& p, int vb) {
    const int nrows = p.nb * 2 * 256;
    const int idx = vb * NT + TIDX();
    const int i = idx & 31, row = (idx >> 5) % nrows, kv = (idx >> 5) / nrows;
    const float* h = p.hcmp + ((size_t)kv * nrows + row) * 256; const float* w2 = kv ? p.cw2_v : p.cw2_k; const float* b2 = kv ? p.cb2_v : p.cb2_k;
    float z1 = b2[i], z2 = b2[i + 32];
    for (int n = 0; n < 256; ++n) { const float hv = h[n]; z1 += hv * w2[n * 64 + i]; z2 += hv * w2[n * 64 + i + 32]; }
    bf16* dst = (kv ? p.vcmp : p.kcmp) + (size_t)row * 64;
    if (kv == 0) {
        const int bg = row >> 8, m = row & 255, b = bg >> 1; int sp = 16 * m + 31; if (sp > S - 1) sp = S - 1;
        const size_t t = (size_t)b * S + sp; const float c = p.cs[t * 64 + i], sn = p.cs[t * 64 + 32 + i];
        const float r1 = z1 * c - z2 * sn, r2 = z2 * c + z1 * sn; z1 = r1; z2 = r2;
    }
    if ((row & 255) == 255) { z1 = 0.f; z2 = 0.f; }
    dst[i] = f2bf(z1); dst[i + 32] = f2bf(z2);
}

__device__ __forceinline__ void load_row64(const bf16* r, float* f) {
    const uint4* p4 = (const uint4*)r;
#pragma unroll
    for (int c = 0; c < 8; ++c) { const uint4 v = p4[c]; const unsigned w[4] = {v.x, v.y, v.z, v.w};
#pragma unroll
        for (int e = 0; e < 4; ++e) { f[c * 8 + e * 2] = __uint_as_float(w[e] << 16); f[c * 8 + e * 2 + 1] = __uint_as_float(w[e] & 0xffff0000u); } }
}
__device__ __forceinline__ float dot64(const float* a, const bf16* r) {
    const uint4* p4 = (const uint4*)r; float s = 0.f;
#pragma unroll
    for (int c = 0; c < 8; ++c) { const uint4 v = p4[c]; const unsigned w[4] = {v.x, v.y, v.z, v.w};
#pragma unroll
        for (int e = 0; e < 4; ++e) { s += a[c * 8 + e * 2] * __uint_as_float(w[e] << 16); s += a[c * 8 + e * 2 + 1] * __uint_as_float(w[e] & 0xffff0000u); } }
    return s;
}
__device__ __forceinline__ void axpy64(float* o, float a, const bf16* r) {
    const uint4* p4 = (const uint4*)r;
#pragma unroll
    for (int c = 0; c < 8; ++c) { const uint4 v = p4[c]; const unsigned w[4] = {v.x, v.y, v.z, v.w};
#pragma unroll
        for (int e = 0; e < 4; ++e) { o[c * 8 + e * 2] += a * __uint_as_float(w[e] << 16); o[c * 8 + e * 2 + 1] += a * __uint_as_float(w[e] & 0xffff0000u); } }
}
__device__ __forceinline__ void body_nsacmp(const P& p, int vb, char* smem) {
    const int wave = TIDX() >> 6, lane = TIDX() & 63, item = vb * 8 + wave;
    const int g = item & 1, t = (item >> 1) * 64 + lane;
    const int b = t / S, s = t % S; const int nv = s >= 31 ? (s - 31) / 16 + 1 : 0;
    float* my = (float*)smem + (size_t)wave * (64 * 65) + lane * 65;
    for (int j = 0; j < 64; ++j) my[j] = 0.f;
    const bf16* kc = p.kcmp + (size_t)(b * 2 + g) * 256 * 64; const bf16* vc = p.vcmp + (size_t)(b * 2 + g) * 256 * 64;
    for (int hh = 0; hh < 4; ++hh) {
        const int h = g * 4 + hh; float qv[64], o[64];
        load_row64(p.q + (size_t)t * 512 + h * 64, qv);
#pragma unroll
        for (int d = 0; d < 64; ++d) o[d] = 0.f;
        float m = -1e30f, l = 0.f;
        for (int n = 0; n < nv; ++n) { const float sc = dot64(qv, kc + n * 64); const float mn = fmaxf(m, sc); l = l * __expf(m - mn) + __expf(sc - mn); m = mn; }
        const float il = nv > 0 ? 1.f / l : 0.f;
        for (int n = 0; n < nv; ++n) {
            const float sc = dot64(qv, kc + n * 64); const float pn = __expf(sc - m) * il;
            axpy64(o, pn, vc + n * 64);
            const int j0 = n >> 2; if ((n & 3) != 3) my[j0] += pn; else { my[j0] += 0.5f * pn; my[j0 + 1] += 0.5f * pn; }
        }
#pragma unroll
        for (int d = 0; d < 64; ++d) p.ocmp[(size_t)t * 512 + h * 64 + d] = o[d];
    }
    const int cur = s >> 6; u64 mask = 0ull;
    for (int j = 0; j <= cur; ++j) {
        const float sj = (j == 0 || j == cur || j == cur - 1) ? 1e4f : my[j]; int rank = 0;
        for (int i = 0; i <= cur; ++i) { if (i == j) continue; const float si = (i == 0 || i == cur || i == cur - 1) ? 1e4f : my[i]; if (si > sj || (si == sj && i < j)) ++rank; }
        if (rank < 16) mask |= (1ull << j);
    }
    p.sel[(size_t)t * 2 + g] = mask;
}
__device__ __forceinline__ void body_nsaatt(const P& p, int vb) {
    const int wave = TIDX() >> 6, lane = TIDX() & 63, item = vb * 8 + wave;
    const int h = item & 7, t = (item >> 3) * 64 + lane, g = h >> 2;
    const int b = t / S, s = t % S, cur = s >> 6;
    const size_t seg = kvseg(p), ho = (size_t)(b * 2 + g) * S * 64;
    const bf16* ks = p.kv6 + 2 * seg + ho; const bf16* vs = p.kv6 + 3 * seg + ho; const bf16* kw = p.kv6 + 4 * seg + ho; const bf16* vw = p.kv6 + 5 * seg + ho;
    float qv[64], o[64];
    load_row64(p.q + (size_t)t * 512 + h * 64, qv);
    const float g0 = p.gates[(size_t)t * 24 + h * 3], g1 = p.gates[(size_t)t * 24 + h * 3 + 1], g2 = p.gates[(size_t)t * 24 + h * 3 + 2];
    float* accp = p.ocmp + (size_t)t * 512 + h * 64;
#pragma unroll
    for (int d = 0; d < 64; ++d) o[d] = 0.f;
    const u64 mask = p.sel[(size_t)t * 2 + g];
    float m = -1e30f, l = 0.f;
    for (int j = 0; j <= cur; ++j) {
        if (!((mask >> j) & 1ull)) continue;
        for (int kk = 0; kk < 64; ++kk) {
            const int key = j * 64 + kk; if (key > s) break;
            const float sc = dot64(qv, ks + (size_t)key * 64);
            if (sc > m) { const float f = __expf(m - sc); l *= f;
#pragma unroll
                for (int d = 0; d < 64; ++d) o[d] *= f;
                m = sc; }
            const float pe = __expf(sc - m); l += pe; axpy64(o, pe, vs + (size_t)key * 64);
        }
    }
    { const float f = g1 / l;
#pragma unroll
        for (int d = 0; d < 64; ++d) { accp[d] = g0 * accp[d] + f * o[d]; o[d] = 0.f; } }
    m = -1e30f; l = 0.f;
    for (int key = (s >= 511 ? s - 511 : 0); key <= s; ++key) {
        const float sc = dot64(qv, kw + (size_t)key * 64);
        if (sc > m) { const float f = __expf(m - sc); l *= f;
#pragma unroll
            for (int d = 0; d < 64; ++d) o[d] *= f;
            m = sc; }
        const float pe = __expf(sc - m); l += pe; axpy64(o, pe, vw + (size_t)key * 64);
    }
    { const float f = g2 / l;
#pragma unroll
        for (int d = 0; d < 64; ++d) p.onsa[(size_t)t * 512 + h * 64 + d] = f2bf(accp[d] + f * o[d]); }
}

__device__ __forceinline__ void body_glaa(const P& p, int vb) {
    const int c = TIDX() & 255, t = vb * 2 + (TIDX() >> 8); float z = p.b_a[c];
#pragma unroll
    for (int r = 0; r < 16; ++r) z += p.alow[(size_t)t * 16 + r] * p.w_a2[r * 256 + c];
    const float ls = fminf(z, 0.f) - log1pf(__expf(-fabsf(z)));
    p.ga[(size_t)t * 256 + c] = __expf(ls * (1.f / 16.f));
}
__device__ __forceinline__ void body_glascan(const P& p, int vb, char* smem) {
    const int sub = TIDX() >> 7, e = TIDX() & 127, bh = vb * 4 + sub, b = bh >> 2, h = bh & 3;
    float* sq = (float*)smem + sub * (3 * 32 * 64); float* sk = sq + 32 * 64; float* sg = sk + 32 * 64;
    float St[64];
#pragma unroll
    for (int d = 0; d < 64; ++d) St[d] = 0.f;
    for (int s0 = 0; s0 < S; s0 += 32) {
        __syncthreads();
        for (int i = e; i < 32 * 64; i += 128) { const int ss = i >> 6, d = i & 63; const size_t t = (size_t)b * S + s0 + ss;
            sq[i] = bf2f(p.gq[t * 256 + h * 64 + d]); sk[i] = bf2f(p.gk[t * 256 + h * 64 + d]); sg[i] = p.ga[t * 256 + h * 64 + d]; }
        __syncthreads();
        for (int ss = 0; ss < 32; ++ss) {
            const size_t t = (size_t)b * S + s0 + ss; const float v = bf2f(p.gv[t * 512 + h * 128 + e]); float o = 0.f;
#pragma unroll
            for (int d = 0; d < 64; ++d) { St[d] = sg[ss * 64 + d] * St[d] + sk[ss * 64 + d] * v; o += sq[ss * 64 + d] * St[d]; }
            p.oraw[t * 512 + h * 128 + e] = o;
        }
    }
    __syncthreads();
}
__device__ __forceinline__ void body_glanorm(const P& p, int vb) {
    const int idx = vb * NT + TIDX(); const int t = idx >> 2, h = idx & 3;
    const float* o = p.oraw + (size_t)t * 512 + h * 128; float ss = 0.f;
    for (int e = 0; e < 128; ++e) ss += o[e] * o[e];
    const float r = rsqrtf(ss * (1.f / 128.f) + 1e-6f);
    for (int e = 0; e < 128; ++e) p.gla[(size_t)t * 512 + h * 128 + e] = f2bf(o[e] * r * p.norm_g[h * 128 + e] * bf2f(p.rs[(size_t)t * 512 + h * 128 + e]));
}

__device__ __forceinline__ void body_proj(const P& p, int vb, char* smem) {
    const int n = (vb & 1) * NT + TIDX(), m0 = (vb >> 1) * 8;
    ngemm<512, true, false>((float*)smem, m0, p.w_pn, 1024, n, p.w_pg, 1024, n,
        [&](int m, int k) { return bf2f(p.onsa[(size_t)m * 512 + k]); }, [&](int m, int k) { return bf2f(p.gla[(size_t)m * 512 + k]); },
        [&](int m, float ya, float yb) { p.mixed[(size_t)m * 1024 + n] = f2bf(bf2f(p.sa[(size_t)m * 1024 + n]) * ya + bf2f(p.sb[(size_t)m * 1024 + n]) * yb); });
}
__device__ __forceinline__ void body_out(const P& p, int vb, char* smem) {
    const int n = (vb & 1) * NT + TIDX(), m0 = (vb >> 1) * 8;
    ngemm<1024, false, true>((float*)smem, m0, p.w_out, 1024, n, p.w_out, 1024, n,
        [&](int m, int k) { return bf2f(p.mixed[(size_t)m * 1024 + k]); }, [&](int m, int k) { return 0.f; },
        [&](int m, float z, float) { p.h1[(size_t)m * 1024 + n] = p.x[(size_t)m * 1024 + n] + z; });
}

__device__ __forceinline__ void body_route(const P& p, int vb, char* smem) {
    const int wave = TIDX() >> 6, lane = TIDX() & 63, t = vb * 8 + wave;
    const float4* hr = (const float4*)(p.h1 + (size_t)t * D);
    float v[16]; float ss = 0.f;
#pragma unroll
    for (int j = 0; j < 4; ++j) { const float4 a = hr[lane + 64 * j]; v[4 * j] = a.x; v[4 * j + 1] = a.y; v[4 * j + 2] = a.z; v[4 * j + 3] = a.w; ss += a.x * a.x + a.y * a.y + a.z * a.z + a.w * a.w; }
#pragma unroll
    for (int o = 1; o < 64; o <<= 1) ss += __shfl_xor(ss, o);
    const float rstd = rsqrtf(ss * (1.f / D) + 1e-6f);
#pragma unroll
    for (int j = 0; j < 4; ++j) {
        const float4 g = ((const float4*)p.g_ffn)[lane + 64 * j];
        v[4 * j] *= rstd * g.x; v[4 * j + 1] *= rstd * g.y; v[4 * j + 2] *= rstd * g.z; v[4 * j + 3] *= rstd * g.w;
        ushort4 o; o.x = f2bf(v[4 * j]); o.y = f2bf(v[4 * j + 1]); o.z = f2bf(v[4 * j + 2]); o.w = f2bf(v[4 * j + 3]);
        ((ushort4*)(p.vb + (size_t)t * D))[lane + 64 * j] = o;
    }
    float* sl = (float*)(smem + LDS_MISC) + wave * 40;
    for (int o = 0; o < 4; ++o) { float a = 0.f;
#pragma unroll
        for (int j = 0; j < 4; ++j)
#pragma unroll
            for (int e = 0; e < 4; ++e) a += v[4 * j + e] * p.w_grp[(size_t)(4 * (lane + 64 * j) + e) * 4 + o];
#pragma unroll
        for (int x = 1; x < 64; x <<= 1) a += __shfl_xor(a, x);
        if (lane == 0) sl[o] = a + p.b_grp[o]; }
    for (int o = 0; o < 32; ++o) { float a = 0.f;
#pragma unroll
        for (int j = 0; j < 4; ++j)
#pragma unroll
            for (int e = 0; e < 4; ++e) a += v[4 * j + e] * p.w_exp[(size_t)(4 * (lane + 64 * j) + e) * 32 + o];
#pragma unroll
        for (int x = 1; x < 64; x <<= 1) a += __shfl_xor(a, x);
        if (lane == 0) sl[4 + o] = a + p.b_exp[o]; }
    if (lane == 0) {
        int gs = 0; float gm = sl[0];
        for (int o = 1; o < 4; ++o) if (sl[o] > gm) { gm = sl[o]; gs = o; }
        float gsum = 0.f;
        for (int o = 0; o < 4; ++o) gsum += __expf(sl[o] - gm);
        const float pg = 1.f / gsum;
        const float* li = sl + 4 + gs * 8;
        int e0 = 0; float m0 = li[0];
        for (int e = 1; e < 8; ++e) if (li[e] > m0) { m0 = li[e]; e0 = e; }
        int e1 = -1; float m1 = -3e38f;
        for (int e = 0; e < 8; ++e) if (e != e0 && li[e] > m1) { m1 = li[e]; e1 = e; }
        const float p0 = 1.f, p1 = __expf(m1 - m0);
        const float w0 = pg * p0 / (p0 + p1), w1 = pg * p1 / (p0 + p1);
        const int x0 = gs * 8 + e0, x1 = gs * 8 + e1;
        const int s0 = (int)atomicAdd(&p.ctl[x0 * 32], 1u), s1 = (int)atomicAdd(&p.ctl[x1 * 32], 1u);
        p.list[(size_t)x0 * p.T + s0] = t; p.list[(size_t)x1 * p.T + s1] = t;
        p.tokexp[t * 2] = x0; p.tokexp[t * 2 + 1] = x1; p.tokslot[t * 2] = s0; p.tokslot[t * 2 + 1] = s1; p.tokw[t * 2] = w0; p.tokw[t * 2 + 1] = w1;
    }
}

__device__ __forceinline__ void body_route2(const P& p, int vb, char* smem) {
    const int tid = TIDX(), wave = tid >> 6, lane = tid & 63, t = vb * 8 + wave;
    const float4* hr = (const float4*)(p.h1 + (size_t)t * D);
    float4 v[4]; float ss = 0.f;
#pragma unroll
    for (int j = 0; j < 4; ++j) { v[j] = hr[lane + 64 * j]; ss += v[j].x * v[j].x + v[j].y * v[j].y + v[j].z * v[j].z + v[j].w * v[j].w; }
#pragma unroll
    for (int o = 1; o < 64; o <<= 1) ss += __shfl_xor(ss, o);
    const float rstd = rsqrtf(ss * (1.f / D) + 1e-6f);
#pragma unroll
    for (int j = 0; j < 4; ++j) {
        const float4 g = ((const float4*)p.g_ffn)[lane + 64 * j];
        v[j].x *= rstd * g.x; v[j].y *= rstd * g.y; v[j].z *= rstd * g.z; v[j].w *= rstd * g.w;
        ushort4 o; o.x = f2bf(v[j].x); o.y = f2bf(v[j].y); o.z = f2bf(v[j].z); o.w = f2bf(v[j].w);
        ((ushort4*)(p.vb + (size_t)t * D))[lane + 64 * j] = o;
    }
    float* sl = (float*)(smem + LDS_MISC) + wave * 40;
    float mine = 0.f;
#pragma unroll 4
    for (int o = 0; o < 36; ++o) { const float4* wrow = (const float4*)(p.wr + (size_t)o * 1024); float a = 0.f;
#pragma unroll
        for (int j = 0; j < 4; ++j) { const float4 w = wrow[lane + 64 * j]; a += v[j].x * w.x + v[j].y * w.y + v[j].z * w.z + v[j].w * w.w; }
#pragma unroll
        for (int x = 1; x < 64; x <<= 1) a += __shfl_xor(a, x);
        if (lane == o) mine = a; }
    if (lane < 36) sl[lane] = mine + (lane < 4 ? p.b_grp[lane] : p.b_exp[lane - 4]);
    asm volatile("s_waitcnt lgkmcnt(0)" ::: "memory");
    if (lane == 0) {
        int gs = 0; float gm = sl[0];
        for (int o = 1; o < 4; ++o) if (sl[o] > gm) { gm = sl[o]; gs = o; }
        float gsum = 0.f;
        for (int o = 0; o < 4; ++o) gsum += __expf(sl[o] - gm);
        const float pg = 1.f / gsum;
        const float* li = sl + 4 + gs * 8;
        int e0 = 0; float m0 = li[0];
        for (int e = 1; e < 8; ++e) if (li[e] > m0) { m0 = li[e]; e0 = e; }
        int e1 = -1; float m1 = -3e38f;
        for (int e = 0; e < 8; ++e) if (e != e0 && li[e] > m1) { m1 = li[e]; e1 = e; }
        const float p0 = 1.f, p1 = __expf(m1 - m0);
        const float w0 = pg * p0 / (p0 + p1), w1 = pg * p1 / (p0 + p1);
        const int x0 = gs * 8 + e0, x1 = gs * 8 + e1;
        const int s0 = (int)atomicAdd(&p.ctl[x0 * 32], 1u), s1 = (int)atomicAdd(&p.ctl[x1 * 32], 1u);
        p.list[(size_t)x0 * p.T + s0] = t; p.list[(size_t)x1 * p.T + s1] = t;
        p.tokexp[t * 2] = x0; p.tokexp[t * 2 + 1] = x1; p.tokslot[t * 2] = s0; p.tokslot[t * 2 + 1] = s1; p.tokw[t * 2] = w0; p.tokw[t * 2 + 1] = w1;
    }
}

__device__ __forceinline__ float tred8(float (&a)[8], int lane) {
    const bool b5 = lane & 32, b4 = lane & 16, b3 = lane & 8;
    float k4[4], k2[2], k1;
#pragma unroll
    for (int i = 0; i < 4; ++i) { const float snd = b5 ? a[i] : a[i + 4]; const float kp = b5 ? a[i + 4] : a[i]; k4[i] = kp + __shfl_xor(snd, 32); }
#pragma unroll
    for (int i = 0; i < 2; ++i) { const float snd = b4 ? k4[i] : k4[i + 2]; const float kp = b4 ? k4[i + 2] : k4[i]; k2[i] = kp + __shfl_xor(snd, 16); }
    { const float snd = b3 ? k2[0] : k2[1]; const float kp = b3 ? k2[1] : k2[0]; k1 = kp + __shfl_xor(snd, 8); }
    k1 += __shfl_xor(k1, 4); k1 += __shfl_xor(k1, 2); k1 += __shfl_xor(k1, 1);
    return k1;
}
__device__ __forceinline__ void body_route3(const P& p, int vb, char* smem) {
    const int tid = TIDX(), wave = tid >> 6, lane = tid & 63, t0 = vb * 64 + wave * 8;
    float4 v[8][4]; float ss[8];
#pragma unroll
    for (int tk = 0; tk < 8; ++tk) { const ushort4* hr = (const ushort4*)(p.h1b + (size_t)(t0 + tk) * D); float s = 0.f;
#pragma unroll
        for (int j = 0; j < 4; ++j) { const ushort4 hb = hr[lane + 64 * j]; v[tk][j] = make_float4(bf2f(hb.x), bf2f(hb.y), bf2f(hb.z), bf2f(hb.w)); s += v[tk][j].x * v[tk][j].x + v[tk][j].y * v[tk][j].y + v[tk][j].z * v[tk][j].z + v[tk][j].w * v[tk][j].w; }
        ss[tk] = s; }
    const float tot = tred8(ss, lane);
#pragma unroll
    for (int tk = 0; tk < 8; ++tk) { const float rstd = rsqrtf(__shfl(tot, tk * 8) * (1.f / D) + 1e-6f);
#pragma unroll
        for (int j = 0; j < 4; ++j) {
            const float4 g = ((const float4*)p.g_ffn)[lane + 64 * j];
            v[tk][j].x *= rstd * g.x; v[tk][j].y *= rstd * g.y; v[tk][j].z *= rstd * g.z; v[tk][j].w *= rstd * g.w;
            ushort4 o; o.x = f2bf(v[tk][j].x); o.y = f2bf(v[tk][j].y); o.z = f2bf(v[tk][j].z); o.w = f2bf(v[tk][j].w);
            ((ushort4*)(p.vb + (size_t)(t0 + tk) * D))[lane + 64 * j] = o; } }
    float* sl = (float*)smem + wave * (8 * 40);
    float* wl = (float*)smem + 4096;
    for (int o = 0; o < 36; ++o) {
        if (o == 0 || o == 18) { __syncthreads();
#pragma unroll
            for (int k = 0; k < 9; ++k) ((float4*)wl)[tid + k * 512] = ((const float4*)(p.wr + (size_t)o * 1024))[tid + k * 512];
            __syncthreads(); }
        const float4* wrow = (const float4*)(wl + (size_t)(o >= 18 ? o - 18 : o) * 1024); float a[8];
        float4 w[4];
#pragma unroll
        for (int j = 0; j < 4; ++j) w[j] = wrow[lane + 64 * j];
#pragma unroll
        for (int tk = 0; tk < 8; ++tk) { float s = 0.f;
#pragma unroll
            for (int j = 0; j < 4; ++j) s += v[tk][j].x * w[j].x + v[tk][j].y * w[j].y + v[tk][j].z * w[j].z + v[tk][j].w * w[j].w;
            a[tk] = s; }
        const float r = tred8(a, lane);
        if ((lane & 7) == 0) sl[(lane >> 3) * 40 + o] = r + (o < 4 ? p.b_grp[o] : p.b_exp[o - 4]); }
    asm volatile("s_waitcnt lgkmcnt(0)" ::: "memory");
    int* cntl = (int*)((float*)smem + 8 * 320); int* basel = cntl + 32;
    if (tid < 32) cntl[tid] = 0;
    __syncthreads();
    int x0 = 0, x1 = 0, l0 = 0, l1 = 0; float w0 = 0.f, w1 = 0.f;
    if (lane < 8) {
        const float* s8 = sl + lane * 40;
        int gs = 0; float gm = s8[0];
        for (int o = 1; o < 4; ++o) if (s8[o] > gm) { gm = s8[o]; gs = o; }
        float gsum = 0.f;
        for (int o = 0; o < 4; ++o) gsum += __expf(s8[o] - gm);
        const float pg = 1.f / gsum;
        const float* li = s8 + 4 + gs * 8;
        int e0 = 0; float m0 = li[0];
        for (int e = 1; e < 8; ++e) if (li[e] > m0) { m0 = li[e]; e0 = e; }
        int e1 = -1; float m1 = -3e38f;
        for (int e = 0; e < 8; ++e) if (e != e0 && li[e] > m1) { m1 = li[e]; e1 = e; }
        const float p0 = 1.f, p1 = __expf(m1 - m0);
        w0 = pg * p0 / (p0 + p1); w1 = pg * p1 / (p0 + p1);
        x0 = gs * 8 + e0; x1 = gs * 8 + e1;
        l0 = atomicAdd(&cntl[x0], 1); l1 = atomicAdd(&cntl[x1], 1);
    }
    __syncthreads();
    if (tid < 32) { const int c = cntl[tid]; basel[tid] = c > 0 ? (int)atomicAdd(&p.ctl[tid * 32], (unsigned)c) : 0; }
    __syncthreads();
    if (lane < 8) {
        const int t = t0 + lane; const int s0 = basel[x0] + l0, s1 = basel[x1] + l1;
        p.list[(size_t)x0 * p.T + s0] = t; p.list[(size_t)x1 * p.T + s1] = t;
        p.tokexp[t * 2] = x0; p.tokexp[t * 2 + 1] = x1; p.tokslot[t * 2] = s0; p.tokslot[t * 2 + 1] = s1; p.tokw[t * 2] = w0; p.tokw[t * 2 + 1] = w1;
    }
    __syncthreads();
}

__device__ __forceinline__ int* seg_bases(const P& p, char* smem) {
    int* sbase = (int*)(smem + LDS_MISC + 2048);
    __syncthreads();
    if (TIDX() < 64) { const int e = TIDX(); const int tl = e < NEXP ? (((int)p.ctl[e * 32] + 255) & ~255) : 0; int incl = tl;
#pragma unroll
        for (int o = 1; o < 64; o <<= 1) { const int v = __shfl_up(incl, o); if (e >= o) incl += v; }
        if (e <= NEXP) sbase[e] = incl - tl; }
    __syncthreads();
    return sbase;
}
__device__ __forceinline__ void body_moe1(const P& p, int vb, char* smem) {
    int* sbase = seg_bases(p, smem); int* stok = sbase + 40;
    const int r0 = vb * 8; if (r0 >= sbase[NEXP]) return;
    int e = 0; while (r0 >= sbase[e + 1]) ++e;
    const int cnt = (int)p.ctl[e * 32];
    if (TIDX() < 8) { const int sl = r0 + TIDX() - sbase[e]; stok[TIDX()] = p.list[(size_t)e * p.T + (sl < cnt ? sl : 0)]; }
    __syncthreads();
    const int n = TIDX();
    const float* wg = p.w_gate + (size_t)e * 1024 * 512; const float* wu = p.w_up + (size_t)e * 1024 * 512;
    ngemm<1024, true, true>((float*)smem, 0, wg, 512, n, wu, 512, n,
        [&](int m, int k) { return bf2f(p.vb[(size_t)stok[m] * D + k]); }, [&](int m, int k) { return 0.f; },
        [&](int m, float zg, float zu) { p.H[(size_t)(r0 + m) * 512 + n] = f2bf(siluf_(zg) * zu); });
}
__device__ __forceinline__ void body_moe2(const P& p, int vb, char* smem) {
    int* sbase = seg_bases(p, smem);
    const int r0 = (vb >> 1) * 8; if (r0 >= sbase[NEXP]) return;
    int e = 0; while (r0 >= sbase[e + 1]) ++e;
    const int n = (vb & 1) * NT + TIDX();
    const float* wd = p.w_down + (size_t)e * 512 * 1024;
    ngemm<512, false, true>((float*)smem, r0, wd, 1024, n, wd, 1024, n,
        [&](int m, int k) { return bf2f(p.H[(size_t)m * 512 + k]); }, [&](int m, int k) { return 0.f; },
        [&](int m, float z, float) { p.Y[(size_t)m * 1024 + n] = f2bf(z); });
}
__device__ __forceinline__ void body_final(const P& p, int vb, char* smem) {
    int* sbase = seg_bases(p, smem);
    const int lane = TIDX() & 63, t = vb * 8 + (TIDX() >> 6);
    const int r0 = sbase[p.tokexp[t * 2]] + p.tokslot[t * 2], r1 = sbase[p.tokexp[t * 2 + 1]] + p.tokslot[t * 2 + 1];
    const float w0 = p.tokw[t * 2], w1 = p.tokw[t * 2 + 1];
    const float4* hr = (const float4*)(p.h1 + (size_t)t * D);
    float4 v[4]; float ss = 0.f;
#pragma unroll
    for (int j = 0; j < 4; ++j) {
        float4 a = hr[lane + 64 * j];
        const ushort4 y0 = ((const ushort4*)(p.Y + (size_t)r0 * D))[lane + 64 * j], y1 = ((const ushort4*)(p.Y + (size_t)r1 * D))[lane + 64 * j];
        a.x += w0 * bf2f(y0.x) + w1 * bf2f(y1.x); a.y += w0 * bf2f(y0.y) + w1 * bf2f(y1.y); a.z += w0 * bf2f(y0.z) + w1 * bf2f(y1.z); a.w += w0 * bf2f(y0.w) + w1 * bf2f(y1.w);
        v[j] = a; ss += a.x * a.x + a.y * a.y + a.z * a.z + a.w * a.w;
    }
#pragma unroll
    for (int o = 1; o < 64; o <<= 1) ss += __shfl_xor(ss, o);
    const float rstd = rsqrtf(ss * (1.f / D) + 1e-6f);
#pragma unroll
    for (int j = 0; j < 4; ++j) {
        const float4 g = ((const float4*)p.g_final)[lane + 64 * j];
        float4 o; o.x = v[j].x * rstd * g.x; o.y = v[j].y * rstd * g.y; o.z = v[j].z * rstd * g.z; o.w = v[j].w * rstd * g.w;
        ((float4*)(p.out + (size_t)t * D))[lane + 64 * j] = o;
    }
}

__device__ __forceinline__ void body_final_b(const P& p, int vb, char* smem) {
    int* sbase = seg_bases(p, smem);
    const int lane = TIDX() & 63, t = vb * 8 + (TIDX() >> 6);
    const int r0 = sbase[p.tokexp[t * 2]] + p.tokslot[t * 2], r1 = sbase[p.tokexp[t * 2 + 1]] + p.tokslot[t * 2 + 1];
    const float w0 = p.tokw[t * 2], w1 = p.tokw[t * 2 + 1];
    float4 v[4]; float ss = 0.f;
#pragma unroll
    for (int j = 0; j < 4; ++j) {
        const ushort4 hb = ((const ushort4*)(p.h1b + (size_t)t * D))[lane + 64 * j];
        const ushort4 y0 = ((const ushort4*)(p.Y + (size_t)r0 * D))[lane + 64 * j], y1 = ((const ushort4*)(p.Y + (size_t)r1 * D))[lane + 64 * j];
        float4 a; a.x = bf2f(hb.x) + w0 * bf2f(y0.x) + w1 * bf2f(y1.x); a.y = bf2f(hb.y) + w0 * bf2f(y0.y) + w1 * bf2f(y1.y); a.z = bf2f(hb.z) + w0 * bf2f(y0.z) + w1 * bf2f(y1.z); a.w = bf2f(hb.w) + w0 * bf2f(y0.w) + w1 * bf2f(y1.w);
        v[j] = a; ss += a.x * a.x + a.y * a.y + a.z * a.z + a.w * a.w;
    }
#pragma unroll
    for (int o = 1; o < 64; o <<= 1) ss += __shfl_xor(ss, o);
    const float rstd = rsqrtf(ss * (1.f / D) + 1e-6f);
#pragma unroll
    for (int j = 0; j < 4; ++j) {
        const float4 g = ((const float4*)p.g_final)[lane + 64 * j];
        float4 o; o.x = v[j].x * rstd * g.x; o.y = v[j].y * rstd * g.y; o.z = v[j].z * rstd * g.z; o.w = v[j].w * rstd * g.w;
        ((float4*)(p.out + (size_t)t * D))[lane + 64 * j] = o;
    }
}

namespace pg8 {
#define PG8_LAS __attribute__((address_space(3)))
typedef short bf16x8 __attribute__((ext_vector_type(8)));
typedef float f32x4 __attribute__((ext_vector_type(4)));
typedef unsigned u32x4 __attribute__((ext_vector_type(4)));
typedef unsigned u32x2 __attribute__((ext_vector_type(2)));
constexpr int BM = 256, BK = 64, HALF = 128, HTB = HALF * BK * 2, STAGE_BYTES = 8 * HTB, NXCD = 8, WGM = 4;

__host__ __device__ __forceinline__ int lds_byte(int r, int c) { const int st = (r >> 4) * 2 + (c >> 5), rr = r & 15, cc = c & 31, ob = rr * 64 + cc * 2; return st * 1024 + (ob ^ (((ob >> 9) & 1) << 5)); }
__host__ __device__ __forceinline__ void stage_rc(int b, int& R, int& C) { const int st = b / 1024, sb = b % 1024, swz = sb ^ (((sb >> 9) & 1) << 5); R = (st >> 1) * 16 + swz / 64; C = (st & 1) * 32 + (swz % 64) / 2; }
__host__ __device__ __forceinline__ int perm32(int rho) { const int n = rho >> 4, i = rho & 15; return 8 * (i >> 2) + 4 * n + (i & 3); }

struct Unit { int pm, pn; const char* A; const char* B; int tag; };

struct TileOrder {
    int nM, nN, nwg, G, c;
    __device__ void init(int nM_, int nN_, int G_, int c_) { nM = nM_; nN = nN_; nwg = nM * nN; G = G_; c = c_; }
    __device__ bool next(int i, int& pm, int& pn) const {
        const long L = (long)i * G + c; if (L >= nwg) return false;
        int wgid = (int)L; { const int q = nwg / NXCD, r = nwg % NXCD, xcd = wgid % NXCD, off = wgid / NXCD; wgid = (xcd < r ? xcd * (q + 1) : r * (q + 1) + (xcd - r) * q) + off; }
        const int nig = WGM * nN, gid = wgid / nig, fm = gid * WGM, gsz = (nM - fm) < WGM ? (nM - fm) : WGM;
        pm = fm + ((wgid % nig) % gsz); pn = (wgid % nig) / gsz; return true;
    }
};
struct DenseSched {
    TileOrder o; const char* A; const char* B; int lda, ldb;
    __device__ void init(const void* A_, const void* B_, int M, int N, int lda_, int ldb_) { A = (const char*)A_; B = (const char*)B_; lda = lda_; ldb = ldb_; o.init(M / BM, N / BM, gridDim.x, blockIdx.x); }
    __device__ __forceinline__ bool next(int i, Unit& u) const { if (!o.next(i, u.pm, u.pn)) return false; u.A = A + (size_t)u.pm * BM * lda * 2; u.B = B + (size_t)u.pn * BM * ldb * 2; u.tag = 0; return true; }
    __device__ __forceinline__ unsigned arow(const Unit&, int r) const { return (unsigned)r * (unsigned)lda * 2u; }
    __device__ __forceinline__ void a_ready(const Unit&) const {}
    __device__ __forceinline__ void done(const Unit&) const {}
};

__device__ __forceinline__ unsigned cvt_pk_bf16(float lo, float hi) { unsigned r; asm volatile("v_cvt_pk_bf16_f32 %0, %1, %2" : "=v"(r) : "v"(lo), "v"(hi)); return r; }

template <class Epi, class Sched, bool ALIGN_EPI, bool GATHER, bool PRE = false>
__device__ __forceinline__ void gemm_phase(PG8_LAS unsigned char* lds, const int K, const int lda, const int ldb, const Sched& S, const Epi& E, const f32x4* pre = nullptr) {
    const int tid = TIDX(), wid = __builtin_amdgcn_readfirstlane(tid >> 6), lane = tid & 63, wr = wid >> 2, wc = wid & 3, fr = lane & 15, fq = lane >> 4;
    const int nt = K / BK;
    int sR[2], sC[2];
    unsigned voffA[2], voffB[2];
#pragma unroll
    for (int i = 0; i < 2; ++i) { stage_rc(tid * 16 + i * 8192, sR[i], sC[i]); const int Rb = Epi::PERM ? ((sR[i] & ~31) + perm32(sR[i] & 31)) : sR[i];
        voffA[i] = (unsigned)(sR[i] * lda + sC[i]) * 2u; voffB[i] = (unsigned)(Rb * ldb + sC[i]) * 2u; }
    unsigned gA[2][2], gN[2][2];
    const size_t kstep = (size_t)(BK * 2);
    const size_t hstepA = (size_t)HALF * lda * 2, hstepB = (size_t)HALF * ldb * 2;
    const unsigned ldsw = (unsigned)wid * 1024u;
    const int aoff = lds_byte(wr * 64 + fr, fq * 8), boff = lds_byte(wc * 32 + fr, fq * 8);
#define PG8_SA(b, h) (((b) * 2 + (h)) * HTB)
#define PG8_SB(b, h) ((4 + (b) * 2 + (h)) * HTB)
#define PG8_GLDS(bufoff, gptr, i_) __builtin_amdgcn_global_load_lds((const unsigned*)(gptr), (PG8_LAS unsigned*)(lds + (bufoff) + ldsw + (i_) * 8192), 16, 0, 0)
#define PG8_STAGE_B(bufoff, gbase) do { _Pragma("unroll") for (int _i = 0; _i < 2; ++_i) PG8_GLDS(bufoff, (const char*)(gbase) + voffB[_i], _i); } while (0)
#define PG8_STAGE_A(bufoff, gb, h, NX) do { _Pragma("unroll") for (int _i = 0; _i < 2; ++_i) { \
        if constexpr (GATHER) { const unsigned _o = (NX) ? gN[h][_i] : gA[h][_i]; PG8_GLDS(bufoff, (const char*)(gb) + _o, _i); } \
        else { PG8_GLDS(bufoff, (const char*)(gb) + (h) * hstepA + voffA[_i], _i); } } } while (0)
#define PG8_LDA(dst, b, h) do { _Pragma("unroll") for (int m = 0; m < 4; ++m) _Pragma("unroll") for (int k = 0; k < 2; ++k) dst[m][k] = *(const PG8_LAS bf16x8*)(lds + PG8_SA(b, h) + aoff + m * 2048 + k * 1024); } while (0)
#define PG8_LDB(dst, b, h) do { _Pragma("unroll") for (int n = 0; n < 2; ++n) _Pragma("unroll") for (int k = 0; k < 2; ++k) dst[n][k] = *(const PG8_LAS bf16x8*)(lds + PG8_SB(b, h) + boff + n * 2048 + k * 1024); } while (0)
#define PG8_MMA(ai, bj, At, Bt) do { __builtin_amdgcn_s_setprio(1); _Pragma("unroll") for (int m = 0; m < 4; ++m) _Pragma("unroll") for (int n = 0; n < 2; ++n) _Pragma("unroll") for (int k = 0; k < 2; ++k) \
        acc[ai][bj][m][n] = __builtin_amdgcn_mfma_f32_16x16x32_bf16(Bt[n][k], At[m][k], acc[ai][bj][m][n], 0, 0, 0); __builtin_amdgcn_s_setprio(0); } while (0)
#define PG8_WAIT_V(n) asm volatile("s_waitcnt vmcnt(" #n ")" ::: "memory")
#define PG8_WAIT_L(n) asm volatile("s_waitcnt lgkmcnt(" #n ")" ::: "memory")
#define PG8_BAR __builtin_amdgcn_s_barrier()
#define PG8_SCHED __builtin_amdgcn_sched_barrier(0)
#define PG8_GOFF(dst, u) do { if constexpr (GATHER) { _Pragma("unroll") for (int _h = 0; _h < 2; ++_h) _Pragma("unroll") for (int _i = 0; _i < 2; ++_i) dst[_h][_i] = S.arow(u, _h * HALF + sR[_i]) + (unsigned)sC[_i] * 2u; } } while (0)
    Unit cur, nxt; int ui = 0;
    if (!S.next(0, cur)) return;
    f32x4 acc[2][2][4][2];
#pragma unroll
    for (int a = 0; a < 2; ++a)
#pragma unroll
        for (int b = 0; b < 2; ++b)
#pragma unroll
            for (int m = 0; m < 4; ++m)
#pragma unroll
                for (int n = 0; n < 2; ++n) acc[a][b][m][n] = PRE ? pre[((a * 2 + b) * 4 + m) * 2 + n] : (f32x4){0.f, 0.f, 0.f, 0.f};
    bf16x8 At[4][2], B0[2][2], B1[2][2];
    const char* cA = cur.A; const char* cB = cur.B;
    S.a_ready(cur);
    PG8_GOFF(gA, cur);
    if constexpr (GATHER) { PG8_WAIT_V(0); }
    PG8_STAGE_B(PG8_SB(0, 0), cB); PG8_STAGE_B(PG8_SB(0, 1), cB + hstepB); PG8_STAGE_A(PG8_SA(0, 0), cA, 0, false); PG8_STAGE_A(PG8_SA(0, 1), cA, 1, false);
    if (wr == 1) PG8_BAR;
    PG8_WAIT_V(2); PG8_BAR;
    PG8_STAGE_B(PG8_SB(1, 0), cB + kstep); PG8_STAGE_A(PG8_SA(1, 0), cA + kstep, 0, false); PG8_STAGE_B(PG8_SB(1, 1), cB + hstepB + kstep);
    PG8_WAIT_V(6); PG8_BAR;
    for (;;) {
        const bool has_next = S.next(ui + 1, nxt);
        const char* nA = has_next ? nxt.A : cA; const char* nB = has_next ? nxt.B : cB;
        if constexpr (GATHER) { if (has_next) { PG8_GOFF(gN, nxt); } else {
#pragma unroll
            for (int _h = 0; _h < 2; ++_h)
#pragma unroll
                for (int _i = 0; _i < 2; ++_i) gN[_h][_i] = gA[_h][_i]; } }
        for (int t = 0; t < nt; t += 2) {
            const bool last = (t == nt - 2);
            if (last && has_next) S.a_ready(nxt);
            const char* a1 = cA + (size_t)(t + 1) * kstep;
            const char* a2 = last ? nA : cA + (size_t)(t + 2) * kstep; const char* b2 = last ? nB : cB + (size_t)(t + 2) * kstep;
            const char* a3 = a2 + kstep; const char* b3 = b2 + kstep;
            PG8_LDB(B0, 0, 0); PG8_LDB(B1, 0, 1); PG8_SCHED; PG8_LDA(At, 0, 0); PG8_STAGE_A(PG8_SA(1, 1), a1, 1, false);
            PG8_WAIT_V(8); PG8_WAIT_L(0); PG8_BAR; PG8_MMA(0, 0, At, B0); PG8_MMA(0, 1, At, B1); PG8_BAR; PG8_SCHED;
            PG8_LDA(At, 0, 1); PG8_STAGE_B(PG8_SB(0, 0), b2); PG8_STAGE_B(PG8_SB(0, 1), b2 + hstepB); PG8_STAGE_A(PG8_SA(0, 0), a2, 0, last);
            PG8_WAIT_V(8); PG8_WAIT_L(0); PG8_BAR; PG8_MMA(1, 0, At, B0); PG8_MMA(1, 1, At, B1); PG8_BAR; PG8_SCHED;
            PG8_LDB(B0, 1, 0); PG8_LDB(B1, 1, 1); PG8_SCHED; PG8_LDA(At, 1, 0); PG8_STAGE_A(PG8_SA(0, 1), a2, 1, last);
            PG8_WAIT_V(8); PG8_WAIT_L(0); PG8_BAR; PG8_MMA(0, 0, At, B0); PG8_MMA(0, 1, At, B1); PG8_BAR; PG8_SCHED;
            PG8_LDA(At, 1, 1); PG8_STAGE_B(PG8_SB(1, 0), b3); PG8_STAGE_B(PG8_SB(1, 1), b3 + hstepB); PG8_STAGE_A(PG8_SA(1, 0), a3, 0, last);
            PG8_WAIT_V(8); PG8_WAIT_L(0); PG8_BAR; PG8_MMA(1, 0, At, B0); PG8_MMA(1, 1, At, B1); PG8_BAR; PG8_SCHED;
        }
        if constexpr (ALIGN_EPI) { if (wr == 0) PG8_BAR; }
        E(acc, cur, wr, wc, fr, fq); S.done(cur);
        if (!has_next) break;
        if (!(Epi::CHAIN && !(cur.tag & 1))) {
#pragma unroll
        for (int a = 0; a < 2; ++a)
#pragma unroll
            for (int b = 0; b < 2; ++b)
#pragma unroll
                for (int m = 0; m < 4; ++m)
#pragma unroll
                    for (int n = 0; n < 2; ++n) acc[a][b][m][n] = (f32x4){0.f, 0.f, 0.f, 0.f};
        }
        cur = nxt; cA = nA; cB = nB; ++ui;
        if constexpr (GATHER) {
#pragma unroll
            for (int _h = 0; _h < 2; ++_h)
#pragma unroll
                for (int _i = 0; _i < 2; ++_i) gA[_h][_i] = gN[_h][_i]; }
        if constexpr (ALIGN_EPI) { if (wr == 1) PG8_BAR; }
    }
    PG8_WAIT_V(0);
    if constexpr (!ALIGN_EPI) { if (wr == 0) PG8_BAR; }
    PG8_BAR;
#undef PG8_SA
#undef PG8_SB
#undef PG8_GLDS
#undef PG8_STAGE_A
#undef PG8_STAGE_B
#undef PG8_LDA
#undef PG8_LDB
#undef PG8_MMA
#undef PG8_WAIT_V
#undef PG8_WAIT_L
#undef PG8_BAR
#undef PG8_SCHED
#undef PG8_GOFF
}
}

typedef float f32x4_t __attribute__((ext_vector_type(4)));
__device__ __forceinline__ int inproj_row(int j) {
    if (j < 512) { const int h = j >> 6, d = j & 63; return h * 64 + 2 * (d & 31) + (d >> 5); }
    if (j < 1280) { const int seg = (j - 512) >> 7, cc = (j - 512) & 127; int col = cc; if (seg == 2 || seg == 4) { const int g = cc >> 6, d = cc & 63; col = g * 64 + 2 * (d & 31) + (d >> 5); } return (2 + (seg >> 1)) * 256 + (seg & 1) * 128 + col; }
    if (j < 1304) return 11 * 256 + (j - 1280);
    if (j < 1560) return 5 * 256 + (j - 1304);
    if (j < 1816) return 6 * 256 + (j - 1560);
    if (j < 2328) return 7 * 256 + (j - 1816);
    if (j < 2344) return 11 * 256 + 32 + (j - 2328);
    if (j < 2856) return 9 * 256 + (j - 2344);
    if (j < 3880) return 12 * 256 + (j - 2856);
    return 16 * 256 + (j - 3880);
}
__device__ __forceinline__ unsigned pk2(float lo, float hi) { typedef float f2_ __attribute__((ext_vector_type(2))); typedef __bf16 b2_ __attribute__((ext_vector_type(2))); const f2_ v = {lo, hi}; const b2_ b = __builtin_convertvector(v, b2_); return __builtin_bit_cast(unsigned, b); }
template <class RM>
__device__ __forceinline__ void transpose_item(const float* W, int ldw, int N, bf16* WT, int ldt, float* scr, int k0, int n0, int lane, RM rm, const float* ksc = nullptr) {
    const int rr = lane >> 4, c4 = (lane & 15) * 4; const bool inb = n0 + c4 < N;
    f32x4_t v[16];
#pragma unroll
    for (int i = 0; i < 16; ++i) v[i] = inb ? __builtin_nontemporal_load((const f32x4_t*)(W + (size_t)(k0 + 8 * (i >> 1) + 2 * rr + (i & 1)) * ldw + n0 + c4)) : (f32x4_t){0.f, 0.f, 0.f, 0.f};
    if (ksc) {
        const float kl = ksc[k0 + lane];
#pragma unroll
        for (int i = 0; i < 16; ++i) v[i] *= __shfl(kl, 8 * (i >> 1) + 2 * rr + (i & 1)); }
    unsigned* sw = (unsigned*)scr;
#pragma unroll
    for (int m = 0; m < 8; ++m) { pg8::u32x4 w; w.x = pk2(v[2 * m].x, v[2 * m + 1].x); w.y = pk2(v[2 * m].y, v[2 * m + 1].y); w.z = pk2(v[2 * m].z, v[2 * m + 1].z); w.w = pk2(v[2 * m].w, v[2 * m + 1].w);
        *(pg8::u32x4*)(sw + (4 * m + rr) * 64 + (c4 ^ (m << 3))) = w; }
    asm volatile("s_waitcnt lgkmcnt(0)" ::: "memory");
    const int c = lane & 7;
#pragma unroll
    for (int j = 0; j < 8; ++j) { const int n = (lane >> 3) + 8 * j; const unsigned* s = sw + (4 * c) * 64 + (n ^ (c << 3));
        uint4 o; o.x = s[0]; o.y = s[64]; o.z = s[128]; o.w = s[192];
        const int row = (n0 + n < N) ? rm(n0 + n) : -1;
        if (row >= 0) __builtin_nontemporal_store(pg8::u32x4{o.x, o.y, o.z, o.w}, (pg8::u32x4*)(WT + (size_t)row * ldt + k0 + 8 * c)); }
    asm volatile("s_waitcnt lgkmcnt(0)" ::: "memory");
}
constexpr int PREP_I_WIN = 16 * 77, PREP_I_C1 = 4 * 64, PREP_I_PN = 128, PREP_I_PG = 128, PREP_I_WO = 256, PREP_I_EXP = 3 * 32 * 128;
constexpr int PREP_ITEMS = PREP_I_WIN + PREP_I_C1 + PREP_I_PN + PREP_I_PG + PREP_I_WO + PREP_I_EXP;
constexpr int PREP_EARLY = PREP_ITEMS - PREP_I_EXP;
#ifndef NCV
#define NCV 32
#endif
__device__ __forceinline__ void prep_item(const P& p, int it, float* scr, int lane) {
    if (it < PREP_I_WIN) { const int kb = it / 77, nb = it % 77; transpose_item(p.w_in, INW, INW, p.Wt_in, 1024, scr, kb * 64, nb * 64, lane, [](int n) { return inproj_row(n); }); return; }
    it -= PREP_I_WIN;
    if (it < PREP_I_C1) { const int mat = it >> 6, r = it & 63, kb = r >> 2, nb = r & 3, kv = mat >> 1, half = mat & 1;
        const float* W = (kv ? p.cw1_v : p.cw1_k) + (size_t)half * 1024 * 256;
        transpose_item(W, 256, 256, p.Wc1 + (size_t)kv * 512 * 1024, 1024, scr, kb * 64, nb * 64, lane, [half](int n) { return half * 256 + n; }); return; }
    it -= PREP_I_C1;
    if (it < PREP_I_PN) { transpose_item(p.w_pn, 1024, 1024, p.Wpn, 512, scr, (it >> 4) * 64, (it & 15) * 64, lane, [](int n) { return n; }); return; }
    it -= PREP_I_PN;
    if (it < PREP_I_PG) { transpose_item(p.w_pg, 1024, 1024, p.Wpg, 512, scr, (it >> 4) * 64, (it & 15) * 64, lane, [](int n) { return n; }); return; }
    it -= PREP_I_PG;
    if (it < PREP_I_WO) { transpose_item(p.w_out, 1024, 1024, p.Wo, 1024, scr, (it >> 4) * 64, (it & 15) * 64, lane, [](int n) { return n; }); return; }
    it -= PREP_I_WO;
    { const int which = it / (32 * 128), r = it % (32 * 128), e = r >> 7, r2 = r & 127;
        if (which == 0) transpose_item(p.w_gate + (size_t)e * 1024 * 512, 512, 512, p.Wgu + (size_t)e * 1024 * 1024, 1024, scr, (r2 >> 3) * 64, (r2 & 7) * 64, lane, [](int n) { return (n >> 7) * 256 + (n & 127); }, p.g_ffn);
        else if (which == 1) transpose_item(p.w_up + (size_t)e * 1024 * 512, 512, 512, p.Wgu + (size_t)e * 1024 * 1024, 1024, scr, (r2 >> 3) * 64, (r2 & 7) * 64, lane, [](int n) { return (n >> 7) * 256 + 128 + (n & 127); }, p.g_ffn);
        else transpose_item(p.w_down + (size_t)e * 512 * 1024, 1024, 1024, p.Wd + (size_t)e * 1024 * 512, 512, scr, (r2 >> 4) * 64, (r2 & 15) * 64, lane, [](int n) { return n; }); }
}
__device__ __forceinline__ void phase_prep_(const P& p, char* smem);
__device__ __forceinline__ void prep_b1p(const P& p, char* smem);
__device__ __forceinline__ void phase_prep(const P& p, char* smem) { prep_b1p(p, smem); phase_prep_(p, smem); }
__device__ __forceinline__ void phase_prep_(const P& p, char* smem) {
    const int wave = TIDX() >> 6, lane = TIDX() & 63;
    float* scr = (float*)smem + wave * (64 * 68);
    const int gw = blockIdx.x * 8 + wave, NGW = gridDim.x * 8;
    for (int it = gw; it < ((NCV > 0 && (int)gridDim.x > 2 * NCV) ? PREP_EARLY : PREP_ITEMS); it += NGW) prep_item(p, it, scr, lane);
    for (int i = blockIdx.x * NT + TIDX(); i < 216 * 128; i += gridDim.x * NT) { int r = i >> 7; r = r < 8 ? 24 + r : 40 + r; *(uint4*)(p.Wt_in + (size_t)(11 * 256 + r) * 1024 + (i & 127) * 8) = make_uint4(0, 0, 0, 0); }
    for (int i = blockIdx.x * NT + TIDX(); i < 36 * 1024; i += gridDim.x * NT) { const int o = i >> 10, k = i & 1023; p.wr[i] = o < 4 ? p.w_grp[k * 4 + o] : p.w_exp[k * 32 + (o - 4)]; }
    for (int i = blockIdx.x * NT + TIDX(); i < 48 * 1024; i += gridDim.x * NT) { const int o = i >> 10, k = i & 1023; const float wv = (o < 4 ? p.w_grp[k * 4 + o] : (o < 36 ? p.w_exp[k * 32 + (o - 4)] : 0.f)) * p.g_ffn[k];
        const bf16 hi = f2bf(wv); p.wrh[i] = hi; p.wrl[i] = f2bf(wv - bf2f(hi)); }
    {
        const int n_r = p.T / 16, n_c = p.T * 32 / NT; int vc = blockIdx.x;
        for (int vb = blockIdx.x; vb < n_r; vb += gridDim.x) { const bool hc = vc < n_c; const int posv = hc ? p.pos[(vc * NT + TIDX()) >> 5] : 0;
            float4 v[8]; rms2_load(p, vb, v); if (hc) { cs_compute(p, vc, posv); vc += gridDim.x; } rms2_finish(p, vb, v); }
        for (; vc < n_c; vc += gridDim.x) body_cs(p, vc);
    }
}

struct EpiInA {
    static constexpr bool PERM = true, CHAIN = false;
    P p;
    __device__ __forceinline__ static void rope4(const float* cs, int t, int i0, const pg8::f32x4& v0, const pg8::f32x4& v1, float sc, pg8::u32x2& lo, pg8::u32x2& hi) {
        const f32x4_t c = *(const f32x4_t*)(cs + (size_t)t * 64 + i0), s = *(const f32x4_t*)(cs + (size_t)t * 64 + 32 + i0);
        const float a0 = (v0[0] * c[0] - v0[1] * s[0]) * sc, b0 = (v0[1] * c[0] + v0[0] * s[0]) * sc;
        const float a1 = (v0[2] * c[1] - v0[3] * s[1]) * sc, b1 = (v0[3] * c[1] + v0[2] * s[1]) * sc;
        const float a2 = (v1[0] * c[2] - v1[1] * s[2]) * sc, b2 = (v1[1] * c[2] + v1[0] * s[2]) * sc;
        const float a3 = (v1[2] * c[3] - v1[3] * s[3]) * sc, b3 = (v1[3] * c[3] + v1[2] * s[3]) * sc;
        lo.x = pk2(a0, a1); lo.y = pk2(a2, a3); hi.x = pk2(b0, b1); hi.y = pk2(b2, b3);
    }
    __device__ __forceinline__ static pg8::u32x4 pack8(const pg8::f32x4& v0, const pg8::f32x4& v1) { pg8::u32x4 w; w.x = pk2(v0[0], v0[1]); w.y = pk2(v0[2], v0[3]); w.z = pk2(v1[0], v1[1]); w.w = pk2(v1[2], v1[3]); return w; }
    __device__ __forceinline__ void operator()(const pg8::f32x4 (&acc)[2][2][4][2], const pg8::Unit& u, int wr, int wc, int fr, int fq) const {
        const int pn = u.pn, c8 = wc * 32 + 8 * fq; const size_t seg = kvseg(p);
#pragma unroll
        for (int ai = 0; ai < 2; ++ai)
#pragma unroll
            for (int m = 0; m < 4; ++m) {
                const int t = u.pm * 256 + ai * 128 + wr * 64 + m * 16 + fr; const int b = t / S, s = t % S;
#pragma unroll
                for (int bj = 0; bj < 2; ++bj) {
                    const pg8::f32x4 v0 = acc[ai][bj][m][0], v1 = acc[ai][bj][m][1];
                    if (pn <= 1) {
                        const int cq = pn * 256 + bj * 128 + c8, h = cq >> 6, i0 = (cq & 63) >> 1; pg8::u32x2 lo, hi;
                        rope4(p.cs, t, i0, v0, v1, 0.125f, lo, hi);
                        bf16* dst = p.q + (size_t)t * 512 + h * 64 + i0; *(pg8::u32x2*)dst = lo; *(pg8::u32x2*)(dst + 32) = hi;
                    } else if (pn <= 4) {
                        const int sgi = (pn - 2) * 2 + bj, g = c8 >> 6; bf16* base = p.kv6 + (size_t)sgi * seg + ((size_t)(b * 2 + g) * S + s) * 64;
                        if (bj == 0 && pn >= 3) { const int i0 = (c8 & 63) >> 1; pg8::u32x2 lo, hi; rope4(p.cs, t, i0, v0, v1, 1.f, lo, hi); *(pg8::u32x2*)(base + i0) = lo; *(pg8::u32x2*)(base + 32 + i0) = hi; }
                        else *(pg8::u32x4*)(base + (c8 & 63)) = pack8(v0, v1);
                    } else if (pn == 5) { *(pg8::u32x4*)(p.gq + (size_t)t * 256 + bj * 128 + c8) = pack8(v0 * 0.125f, v1 * 0.125f);
                    } else if (pn == 6) { *(pg8::u32x4*)(p.gk + (size_t)t * 256 + bj * 128 + c8) = pack8(v0, v1);
                    } else if (pn <= 8) { *(pg8::u32x4*)(p.gv + (size_t)t * 512 + (pn - 7) * 256 + bj * 128 + c8) = pack8(v0, v1);
                    } else if (pn <= 10) {
                        pg8::f32x4 a, c;
#pragma unroll
                        for (int e = 0; e < 4; ++e) { a[e] = siluf_(v0[e]); c[e] = siluf_(v1[e]); }
                        *(pg8::u32x4*)(p.rs + (size_t)t * 512 + (pn - 9) * 256 + bj * 128 + c8) = pack8(a, c);
                    } else {
                        if (bj == 0) {
                            if (c8 < 24) { float* d = p.gates + (size_t)t * 24 + c8;
#pragma unroll
                                for (int e = 0; e < 4; ++e) { d[e] = sigmoidf_(v0[e]); d[4 + e] = sigmoidf_(v1[e]); } }
                            else if (c8 >= 32 && c8 < 48) { float* d = p.alow + (size_t)t * 16 + (c8 - 32);
#pragma unroll
                                for (int e = 0; e < 4; ++e) { d[e] = v0[e]; d[4 + e] = v1[e]; } }
                        }
                    }
                }
            }
    }
};
struct EpiSig {
    static constexpr bool PERM = true, CHAIN = false;
    unsigned char* sa; unsigned char* sb;
    __device__ __forceinline__ static unsigned q8(float x) { const float s = sigmoidf_(x) * 255.f + 0.5f; unsigned q = (unsigned)s; return q < 1u ? 1u : (q > 255u ? 255u : q); }
    __device__ __forceinline__ void operator()(const pg8::f32x4 (&acc)[2][2][4][2], const pg8::Unit& u, int wr, int wc, int fr, int fq) const {
        unsigned char* base = (u.pn < 4 ? sa : sb) + (u.pn & 3) * 256 + wc * 32 + 8 * fq;
#pragma unroll
        for (int ai = 0; ai < 2; ++ai)
#pragma unroll
            for (int m = 0; m < 4; ++m) { const int t = u.pm * 256 + ai * 128 + wr * 64 + m * 16 + fr;
#pragma unroll
                for (int bj = 0; bj < 2; ++bj) { pg8::u32x2 o;
                    o.x = q8(acc[ai][bj][m][0][0]) | (q8(acc[ai][bj][m][0][1]) << 8) | (q8(acc[ai][bj][m][0][2]) << 16) | (q8(acc[ai][bj][m][0][3]) << 24);
                    o.y = q8(acc[ai][bj][m][1][0]) | (q8(acc[ai][bj][m][1][1]) << 8) | (q8(acc[ai][bj][m][1][2]) << 16) | (q8(acc[ai][bj][m][1][3]) << 24);
                    *(pg8::u32x2*)(base + (size_t)t * 1024 + bj * 128) = o; } }
    }
};
struct EpiInAB {
    static constexpr bool PERM = true, CHAIN = false;
    EpiInA a; EpiSig s;
    __device__ __forceinline__ void operator()(const pg8::f32x4 (&acc)[2][2][4][2], const pg8::Unit& u, int wr, int wc, int fr, int fq) const {
        if (u.pn < 12) a(acc, u, wr, wc, fr, fq);
        else { pg8::Unit v = u; v.pn = u.pn - 12; s(acc, v, wr, wc, fr, fq); }
    }
};
__device__ __forceinline__ void phase_inA(const P& p, char* smem) {
    pg8::DenseSched S; S.init(p.u, p.Wt_in, p.T, 5120, 1024, 1024);
    EpiInAB E{EpiInA{p}, EpiSig{p.sa8, p.sb8}};
    pg8::gemm_phase<EpiInAB, pg8::DenseSched, true, false>((PG8_LAS unsigned char*)smem, 1024, 1024, 1024, S, E);
}
__device__ __forceinline__ void phase_inB(const P& p, char* smem) { }
struct EpiProj {
    static constexpr bool PERM = true, CHAIN = false;
    const bf16* g; bf16* mixed; int pass;
    __device__ __forceinline__ void operator()(const pg8::f32x4 (&acc)[2][2][4][2], const pg8::Unit& u, int wr, int wc, int fr, int fq) const {
        const int col0 = u.pn * 256 + wc * 32 + 8 * fq;
#pragma unroll
        for (int ai = 0; ai < 2; ++ai)
#pragma unroll
            for (int m = 0; m < 4; ++m) { const size_t t = (size_t)(u.pm * 256 + ai * 128 + wr * 64 + m * 16 + fr);
#pragma unroll
                for (int bj = 0; bj < 2; ++bj) { const size_t off = t * 1024 + col0 + bj * 128;
                    const uint4 gv = *(const uint4*)(g + off); const unsigned gw[4] = {gv.x, gv.y, gv.z, gv.w};
                    float r[8];
#pragma unroll
                    for (int e = 0; e < 4; ++e) { const float a = e < 2 ? acc[ai][bj][m][0][2 * e] : acc[ai][bj][m][1][2 * e - 4], b = e < 2 ? acc[ai][bj][m][0][2 * e + 1] : acc[ai][bj][m][1][2 * e - 3];
                        r[2 * e] = __uint_as_float(gw[e] << 16) * a; r[2 * e + 1] = __uint_as_float(gw[e] & 0xffff0000u) * b; }
                    if (pass) { const uint4 mv = *(const uint4*)(mixed + off); const unsigned mw[4] = {mv.x, mv.y, mv.z, mv.w};
#pragma unroll
                        for (int e = 0; e < 4; ++e) { r[2 * e] += __uint_as_float(mw[e] << 16); r[2 * e + 1] += __uint_as_float(mw[e] & 0xffff0000u); } }
                    uint4 o; o.x = pk2(r[0], r[1]); o.y = pk2(r[2], r[3]); o.z = pk2(r[4], r[5]); o.w = pk2(r[6], r[7]);
                    *(uint4*)(mixed + off) = o; } }
    }
};
struct EpiOut {
    static constexpr bool PERM = true, CHAIN = false;
    const float* x; bf16* h1b;
    __device__ __forceinline__ void operator()(const pg8::f32x4 (&acc)[2][2][4][2], const pg8::Unit& u, int wr, int wc, int fr, int fq) const {
        const int col0 = u.pn * 256 + wc * 32 + 8 * fq;
#pragma unroll
        for (int ai = 0; ai < 2; ++ai)
#pragma unroll
            for (int m = 0; m < 4; ++m) { const size_t off = (size_t)(u.pm * 256 + ai * 128 + wr * 64 + m * 16 + fr) * 1024 + col0;
#pragma unroll
                for (int bj = 0; bj < 2; ++bj) {
                    if (u.tag & 1) *(pg8::u32x4*)(h1b + off + bj * 128) = EpiInA::pack8(acc[ai][bj][m][0], acc[ai][bj][m][1]);
                    else { const pg8::f32x4 x0 = *(const pg8::f32x4*)(x + off + bj * 128), x1 = *(const pg8::f32x4*)(x + off + bj * 128 + 4);
                        *(pg8::u32x4*)(h1b + off + bj * 128) = EpiInA::pack8(x0 + acc[ai][bj][m][0], x1 + acc[ai][bj][m][1]); } } }
    }
};
struct ProjSched {
    pg8::TileOrder o; const char *A0, *A1, *B0, *B1;
    __device__ __forceinline__ bool next(int i, pg8::Unit& u) const {
        if (!o.next(i >> 1, u.pm, u.pn)) return false;
        const int part = i & 1; u.tag = part;
        u.A = (part ? A1 : A0) + (size_t)u.pm * 256 * 512 * 2; u.B = (part ? B1 : B0) + (size_t)u.pn * 256 * 512 * 2; return true;
    }
    __device__ __forceinline__ unsigned arow(const pg8::Unit&, int r) const { return (unsigned)r * 1024u; }
    __device__ __forceinline__ void a_ready(const pg8::Unit&) const {}
    __device__ __forceinline__ void done(const pg8::Unit&) const {}
};
struct EpiProj2 {
    static constexpr bool PERM = true, CHAIN = true;
    const unsigned char* sa; const unsigned char* sb; bf16* mixed;
    __device__ __forceinline__ static void unq(pg8::u32x2 w, float (&f)[8]) {
#pragma unroll
        for (int e = 0; e < 4; ++e) { f[e] = (float)((w.x >> (8 * e)) & 255u) * (1.f / 255.f); f[4 + e] = (float)((w.y >> (8 * e)) & 255u) * (1.f / 255.f); } }
    __device__ __forceinline__ void operator()(const pg8::f32x4 (&acc_)[2][2][4][2], const pg8::Unit& u, int wr, int wc, int fr, int fq) const {
        pg8::f32x4 (&acc)[2][2][4][2] = const_cast<pg8::f32x4 (&)[2][2][4][2]>(acc_);
        const int col0 = u.pn * 256 + wc * 32 + 8 * fq;
#pragma unroll
        for (int ai = 0; ai < 2; ++ai)
#pragma unroll
            for (int m = 0; m < 4; ++m) { const size_t t = (size_t)(u.pm * 256 + ai * 128 + wr * 64 + m * 16 + fr);
#pragma unroll
                for (int bj = 0; bj < 2; ++bj) { const size_t off = t * 1024 + col0 + bj * 128;
                    float fb[8]; unq(*(const pg8::u32x2*)(sb + off), fb);
                    if (u.tag == 0) {
                        float fa[8]; unq(*(const pg8::u32x2*)(sa + off), fa);
#pragma unroll
                        for (int e = 0; e < 4; ++e) { acc[ai][bj][m][0][e] *= fa[e] * __builtin_amdgcn_rcpf(fb[e]); acc[ai][bj][m][1][e] *= fa[4 + e] * __builtin_amdgcn_rcpf(fb[4 + e]); }
                    } else {
                        pg8::f32x4 r0, r1;
#pragma unroll
                        for (int e = 0; e < 4; ++e) { r0[e] = acc[ai][bj][m][0][e] * fb[e]; r1[e] = acc[ai][bj][m][1][e] * fb[4 + e]; }
                        *(pg8::u32x4*)(mixed + off) = EpiInA::pack8(r0, r1); } } }
    }
};
__device__ __forceinline__ void phase_proj(const P& p, char* smem) {
    ProjSched S; S.o.init(p.T / 256, 4, gridDim.x, blockIdx.x); S.A0 = (const char*)p.onsa; S.A1 = (const char*)p.gla; S.B0 = (const char*)p.Wpn; S.B1 = (const char*)p.Wpg;
    EpiProj2 E{p.sa8, p.sb8, p.mixed};
    pg8::gemm_phase<EpiProj2, ProjSched, true, false>((PG8_LAS unsigned char*)smem, 512, 512, 512, S, E);
}
struct OutSched {
    pg8::DenseSched d; bool pre;
    __device__ __forceinline__ bool next(int i, pg8::Unit& u) const { if (!d.next(i, u)) return false; u.tag = (pre && i == 0) ? 1 : 0; return true; }
    __device__ __forceinline__ unsigned arow(const pg8::Unit& u, int r) const { return d.arow(u, r); }
    __device__ __forceinline__ void a_ready(const pg8::Unit&) const {}
    __device__ __forceinline__ void done(const pg8::Unit&) const {}
};
__device__ __forceinline__ bool out_preload(const P& p, pg8::f32x4 (&xin)[32]) {
    pg8::TileOrder o; o.init(p.T / 256, 4, gridDim.x, blockIdx.x); int pm = 0, pn = 0; const bool has = o.next(0, pm, pn); if (!has) { pm = 0; pn = 0; }
    const int tid = TIDX(), wid = tid >> 6, lane = tid & 63, wr = wid >> 2, wc = wid & 3, fr = lane & 15, fq = lane >> 4;
    const int col0 = pn * 256 + wc * 32 + 8 * fq;
#pragma unroll
    for (int ai = 0; ai < 2; ++ai)
#pragma unroll
        for (int bj = 0; bj < 2; ++bj)
#pragma unroll
            for (int m = 0; m < 4; ++m) { const size_t off = (size_t)(pm * 256 + ai * 128 + wr * 64 + m * 16 + fr) * 1024 + col0 + bj * 128;
                xin[((ai * 2 + bj) * 4 + m) * 2 + 0] = *(const pg8::f32x4*)(p.x + off); xin[((ai * 2 + bj) * 4 + m) * 2 + 1] = *(const pg8::f32x4*)(p.x + off + 4); }
    return has;
}
__device__ __forceinline__ void phase_out(const P& p, char* smem) {
    OutSched S; S.d.init(p.mixed, p.Wo, p.T, 1024, 1024, 1024); S.pre = false; EpiOut E{p.x, p.h1b};
    pg8::gemm_phase<EpiOut, OutSched, true, false>((PG8_LAS unsigned char*)smem, 1024, 1024, 1024, S, E);
}
__device__ __forceinline__ void phase_out_pre(const P& p, char* smem, const pg8::f32x4 (&xin)[32]) {
    OutSched S; S.d.init(p.mixed, p.Wo, p.T, 1024, 1024, 1024); S.pre = true; EpiOut E{p.x, p.h1b};
    pg8::gemm_phase<EpiOut, OutSched, true, false, true>((PG8_LAS unsigned char*)smem, 1024, 1024, 1024, S, E, &xin[0]);
}

struct ExpertSched {
    const int* ub;
    const int* sb_;
    const unsigned* cnt; const int* list; int T;
    const char* A; const char* B; int lda, ldb; size_t bstride;
    int npn, G, c; bool gather;
    int r1;
    unsigned* ready; int role;
    __device__ __forceinline__ bool next(int i, pg8::Unit& u) const {
        int L = i * G + c;
        if (role == 2 && r1 > 0) { const int nl = G - r1, period = 2 * nl + r1;
            L = (c < r1) ? i * period + 2 * nl + c : (i >> 1) * period + (i & 1) * nl + (c - r1); }
        if (L >= ub[NEXP]) return false;
        int e = 0; while (L >= ub[e + 1]) ++e;
        const int rem = L - ub[e], tiles = (ub[e + 1] - ub[e]) / npn, pn = rem / tiles, pml = rem % tiles;
        u.pm = sb_[e] / 256 + pml; u.pn = pn; u.tag = e | (pml << 8);
        u.A = gather ? A : A + (size_t)u.pm * 256 * lda * 2; u.B = B + (size_t)e * bstride + (size_t)pn * 256 * ldb * 2; return true;
    }
    __device__ __forceinline__ unsigned arow(const pg8::Unit& u, int r) const {
        const int e = u.tag & 255, sl = (u.tag >> 8) * 256 + r; const int tok = list[(size_t)e * T + (sl < (int)cnt[e * 32] ? sl : 0)];
        return (unsigned)tok * (unsigned)lda * 2u;
    }
    __device__ __forceinline__ void a_ready(const pg8::Unit& u) const {
        if (role != 2) return;
        if (TIDX() < 64) { unsigned spins = 0;
            while ((unsigned)__builtin_amdgcn_readfirstlane((int)__hip_atomic_load(ready + u.pm, __ATOMIC_RELAXED, __HIP_MEMORY_SCOPE_AGENT)) < 32u) { __builtin_amdgcn_s_sleep(2); if (++spins > (1u << 22)) break; }
            __builtin_amdgcn_fence(__ATOMIC_ACQUIRE, "agent");
            asm volatile("s_waitcnt vmcnt(0)" ::: "memory"); }
        asm volatile("" ::: "memory"); __builtin_amdgcn_s_barrier(); asm volatile("" ::: "memory");
    }
    __device__ __forceinline__ void done(const pg8::Unit& u) const {
        if (role != 1) return;
        asm volatile("s_waitcnt vmcnt(0)" ::: "memory");
        if ((TIDX() & 63) == 0) __hip_atomic_fetch_add(ready + u.pm, 1u, __ATOMIC_RELAXED, __HIP_MEMORY_SCOPE_AGENT);
    }
};
__device__ __forceinline__ void expert_tables(const P& p, char* smem, int npn, int*& ub, int*& sb_) {
    ub = (int*)(smem + LDS_MISC + 1024); sb_ = ub + 40;
    __syncthreads();
    if (TIDX() < 64) {
        const int e = TIDX(); const int tl = e < NEXP ? ((int)p.ctl[e * 32] + 255) >> 8 : 0; int incl = tl;
#pragma unroll
        for (int o = 1; o < 64; o <<= 1) { const int v = __shfl_up(incl, o); if (e >= o) incl += v; }
        const int excl = incl - tl; if (e <= NEXP) { ub[e] = excl * npn; sb_[e] = excl * 256; } }
    __syncthreads();
}
struct EpiMoe1 {
    static constexpr bool PERM = true, CHAIN = false;
    __amdgpu_buffer_rsrc_t rsrc; const float* srs; int T;
    __device__ __forceinline__ void operator()(const pg8::f32x4 (&acc)[2][2][4][2], const pg8::Unit& u, int wr, int wc, int fr, int fq) const {
        const int col0 = u.pn * 128 + wc * 32 + 8 * fq; const float* sr = srs + (size_t)(u.tag & 255) * T + (u.tag >> 8) * 256;
        float rs[2][4];
#pragma unroll
        for (int ai = 0; ai < 2; ++ai)
#pragma unroll
            for (int m = 0; m < 4; ++m) rs[ai][m] = sr[ai * 128 + wr * 64 + m * 16 + fr];
#pragma unroll
        for (int ai = 0; ai < 2; ++ai)
#pragma unroll
            for (int m = 0; m < 4; ++m) { const size_t row = (size_t)(u.pm * 256 + ai * 128 + wr * 64 + m * 16 + fr); const float r = rs[ai][m];
                pg8::f32x4 a, b;
#pragma unroll
                for (int e = 0; e < 4; ++e) { a[e] = siluf_(acc[ai][0][m][0][e] * r) * (acc[ai][1][m][0][e] * r); b[e] = siluf_(acc[ai][0][m][1][e] * r) * (acc[ai][1][m][1][e] * r); }
                __builtin_amdgcn_raw_buffer_store_b128(EpiInA::pack8(a, b), rsrc, (unsigned)((row * 512 + col0) * 2), 0, 16  ); }
    }
};
struct EpiMoe2 {
    static constexpr bool PERM = true, CHAIN = false;
    bf16* Y;
    __device__ __forceinline__ void operator()(const pg8::f32x4 (&acc)[2][2][4][2], const pg8::Unit& u, int wr, int wc, int fr, int fq) const {
        const int col0 = u.pn * 256 + wc * 32 + 8 * fq;
#pragma unroll
        for (int ai = 0; ai < 2; ++ai)
#pragma unroll
            for (int m = 0; m < 4; ++m) { const size_t row = (size_t)(u.pm * 256 + ai * 128 + wr * 64 + m * 16 + fr);
#pragma unroll
                for (int bj = 0; bj < 2; ++bj) *(pg8::u32x4*)(Y + row * 1024 + col0 + bj * 128) = EpiInA::pack8(acc[ai][bj][m][0], acc[ai][bj][m][1]); }
    }
};
__device__ __forceinline__ void phase_moe12(const P& p, char* smem) {
    int *ub, *sb_; expert_tables(p, smem, 4, ub, sb_);
    unsigned* ready = p.ctl + 3072;
    const int G_ = (int)gridDim.x, vcu = (G_ % 8 == 0) ? ((int)blockIdx.x % 8) * (G_ / 8) + (int)blockIdx.x / 8 : (int)blockIdx.x;
    { ExpertSched S{ub, sb_, p.ctl, p.list, p.T, (const char*)p.h1b, (const char*)p.Wgu, 1024, 1024, (size_t)1024 * 1024 * 2, 4, (int)gridDim.x, vcu, true, 0, ready, 1};
      EpiMoe1 E{__builtin_amdgcn_make_buffer_rsrc((void*)p.H, 0, (int)((2 * (size_t)p.T + NEXP * 256) * 512 * 2), 0x00020000), p.hcmp, p.T};
      pg8::gemm_phase<EpiMoe1, ExpertSched, true, true>((PG8_LAS unsigned char*)smem, 1024, 1024, 1024, S, E); }
    { const int G = (int)gridDim.x, r1 = (ub[NEXP] % G);
      ExpertSched S{ub, sb_, p.ctl, p.list, p.T, (const char*)p.H, (const char*)p.Wd, 512, 512, (size_t)1024 * 512 * 2, 4, G, vcu, false, r1, ready, 2};
      EpiMoe2 E{p.Y};
      pg8::gemm_phase<EpiMoe2, ExpertSched, true, false>((PG8_LAS unsigned char*)smem, 512, 512, 512, S, E); }
}

namespace nsa {
using f32x16 = __attribute__((ext_vector_type(16))) float;
using bf16x8 = __attribute__((ext_vector_type(8))) short;
using s16x4 = __attribute__((ext_vector_type(4))) short;
using u32x4 = __attribute__((ext_vector_type(4))) unsigned;
typedef __attribute__((address_space(3))) char* lptr;
typedef __attribute__((address_space(3))) const char* lcptr;
constexpr int SLOT = 8192;
constexpr int NSLOT = 3;
constexpr int L_K = 0, L_V = NSLOT * SLOT, L_WS = 2 * NSLOT * SLOT, L_OST = L_WS + 8 * 512, L_IMPD = L_OST + 8 * 4096, L_IMPC = L_IMPD + 64 * 64 * 4, L_SEL = L_IMPC + 64 * 68 * 4, L_END = L_SEL + 64 * 8;
constexpr float LOG2E = 1.4426950408889634f, NEGM = -1e30f, M0 = -1e20f, THR = 8.f;
__device__ __forceinline__ int crow(int r, int hi) { return (r & 3) + 8 * (r >> 2) + 4 * hi; }
__device__ __forceinline__ void glds16(const void* gsrc, unsigned lds_dst) { unsigned keep;
    asm volatile("s_mov_b32 %0, m0\n\ts_mov_b32 m0, %2\n\ts_nop 0\n\tglobal_load_lds_dwordx4 %1, off\n\ts_mov_b32 m0, %0" : "=&s"(keep) : "v"(gsrc), "s"(lds_dst) : "memory"); }
#define NSA_WAIT_BAR() asm volatile("s_waitcnt vmcnt(2) lgkmcnt(0)\n\ts_barrier" ::: "memory")
#define NSA_DRAIN_BAR() asm volatile("s_waitcnt vmcnt(0) lgkmcnt(0)\n\ts_barrier" ::: "memory")
#define NSA_LWAIT() asm volatile("s_waitcnt lgkmcnt(0)" ::: "memory")
__device__ __forceinline__ unsigned cvtpk(float lo, float hi) { typedef float f2 __attribute__((ext_vector_type(2))); typedef __bf16 b2 __attribute__((ext_vector_type(2))); f2 v = {lo, hi}; b2 b = __builtin_convertvector(v, b2); return __builtin_bit_cast(unsigned, b); }
__device__ __forceinline__ float xhalf_max(float m) { auto rr = __builtin_amdgcn_permlane32_swap(__float_as_uint(m), __float_as_uint(m), false, false); return fmaxf(__uint_as_float(rr[0]), __uint_as_float(rr[1])); }
__device__ __forceinline__ float xhalf_sum(float m) { auto rr = __builtin_amdgcn_permlane32_swap(__float_as_uint(m), __float_as_uint(m), false, false); return __uint_as_float(rr[0]) + __uint_as_float(rr[1]); }
__device__ __forceinline__ void qkt(f32x16& p0, f32x16& p1, lcptr Kslot, const bf16x8* qr, int r32, int hi) {
    lcptr kb = Kslot + hi * 1024 + r32 * 16;
    p0 = f32x16{}; p1 = f32x16{};
#pragma unroll
    for (int d0 = 0; d0 < 4; ++d0) {
        const bf16x8 b0 = *(const __attribute__((address_space(3))) bf16x8*)(kb + d0 * 2048);
        const bf16x8 b1 = *(const __attribute__((address_space(3))) bf16x8*)(kb + d0 * 2048 + 512);
        p0 = __builtin_amdgcn_mfma_f32_32x32x16_bf16(b0, qr[d0], p0, 0, 0, 0); p1 = __builtin_amdgcn_mfma_f32_32x32x16_bf16(b1, qr[d0], p1, 0, 0, 0); }
}
__device__ __forceinline__ void pv(f32x16* o, int vb, bf16x8 pa0, bf16x8 pa1, bf16x8 pa2, bf16x8 pa3) {
#pragma unroll
    for (int d0 = 0; d0 < 2; ++d0) { s16x4 lo[4], hi[4];
#pragma unroll
        for (int ks = 0; ks < 4; ++ks) {
            asm volatile("ds_read_b64_tr_b16 %0,%1 offset:%c2" : "=&v"(lo[ks]) : "v"(vb), "i"(d0 * 4096 + ks * 1024) : "memory");
            asm volatile("ds_read_b64_tr_b16 %0,%1 offset:%c2" : "=&v"(hi[ks]) : "v"(vb), "i"(d0 * 4096 + ks * 1024 + 512) : "memory"); }
        asm volatile("s_waitcnt lgkmcnt(0)" ::: "memory"); __builtin_amdgcn_sched_barrier(0);
#define NSA_PK(k) (bf16x8){lo[k][0], lo[k][1], lo[k][2], lo[k][3], hi[k][0], hi[k][1], hi[k][2], hi[k][3]}
        o[d0] = __builtin_amdgcn_mfma_f32_32x32x16_bf16(pa0, NSA_PK(0), o[d0], 0, 0, 0);
        o[d0] = __builtin_amdgcn_mfma_f32_32x32x16_bf16(pa1, NSA_PK(1), o[d0], 0, 0, 0);
        o[d0] = __builtin_amdgcn_mfma_f32_32x32x16_bf16(pa2, NSA_PK(2), o[d0], 0, 0, 0);
        o[d0] = __builtin_amdgcn_mfma_f32_32x32x16_bf16(pa3, NSA_PK(3), o[d0], 0, 0, 0);
#undef NSA_PK
    }
}
__device__ __forceinline__ float rowmax32(const f32x16& p0, const f32x16& p1) {
    float a = fmaxf(p0[0], p1[0]);
#pragma unroll
    for (int r = 1; r < 16; ++r) a = fmaxf(a, fmaxf(p0[r], p1[r]));
    return xhalf_max(a);
}
struct Ctx {
    int w, lane, r32, hi, rs; unsigned lds0; lptr shm; const bf16* kt; const bf16* vt;
};
__device__ __forceinline__ void dma_kv(const Ctx& c, int tile, int slot) {
    const bf16* ksrc = c.kt + (size_t)tile * 64 * 64 + c.lane * 64 + c.w * 8;
    const bf16* vsrc = c.vt + (size_t)tile * 64 * 64 + (16 * (c.w & 3) + (c.lane >> 2)) * 64 + (c.w >> 2) * 32 + (c.lane & 3) * 8;
    glds16(ksrc, (unsigned)__builtin_amdgcn_readfirstlane(c.lds0 + L_K + slot * SLOT + c.w * 1024));
    glds16(vsrc, (unsigned)__builtin_amdgcn_readfirstlane(c.lds0 + L_V + slot * SLOT + c.w * 1024));
}
template <int ABL = 0> __device__ __forceinline__ void ring_begin(Ctx& c, int t0, int t1) { NSA_DRAIN_BAR(); if (!(ABL & 8)) { dma_kv(c, t0, 0); dma_kv(c, t1 >= 0 ? t1 : t0, 1); } c.rs = 0; }
template <int ABL = 0> __device__ __forceinline__ void ring_step(Ctx& c, int t2, int tcur) { if (!(ABL & 16)) NSA_WAIT_BAR(); int s2 = c.rs + 2; if (s2 >= NSLOT) s2 -= NSLOT; if (!(ABL & 8)) dma_kv(c, t2 >= 0 ? t2 : tcur, s2); }
__device__ __forceinline__ void ring_next(Ctx& c) { c.rs = (c.rs == NSLOT - 1) ? 0 : c.rs + 1; }
template <int ABL> __device__ __forceinline__ void softmax_pv(const Ctx& c, f32x16& p0, f32x16& p1, f32x16* o, float& m, float& l, int slot, bool on) {
    float a0 = fmaxf(fmaxf(p0[0], p0[1]), p1[0]), a1 = fmaxf(fmaxf(p0[2], p0[3]), p1[1]), a2 = fmaxf(fmaxf(p0[4], p0[5]), p1[2]), a3 = fmaxf(fmaxf(p0[6], p0[7]), p1[3]);
    a0 = fmaxf(fmaxf(a0, p0[8]), p0[9]); a1 = fmaxf(fmaxf(a1, p0[10]), p0[11]); a2 = fmaxf(fmaxf(a2, p0[12]), p0[13]); a3 = fmaxf(fmaxf(a3, p0[14]), p0[15]);
    a0 = fmaxf(fmaxf(a0, p1[4]), p1[5]); a1 = fmaxf(fmaxf(a1, p1[6]), p1[7]); a2 = fmaxf(fmaxf(a2, p1[8]), p1[9]); a3 = fmaxf(fmaxf(a3, p1[10]), p1[11]);
    a0 = fmaxf(fmaxf(a0, p1[12]), p1[13]); a1 = fmaxf(fmaxf(a1, p1[14]), p1[15]);
    float rm = xhalf_max(fmaxf(fmaxf(a0, a1), fmaxf(a2, a3)));
    rm = on ? rm : NEGM;
    volatile __attribute__((address_space(3))) float* wsf = (volatile __attribute__((address_space(3))) float*)(c.shm + L_WS + c.w * 512);
    bool resc = false;
    if (__any(rm > m + THR)) { const float mn = fmaxf(m, rm); const float f = __builtin_amdgcn_exp2f(m - mn); l *= f; m = mn; if (c.hi == 0) wsf[c.r32] = f; resc = true; }
    const float ms = on ? m : 1e30f;
    float s0 = 0.f, s1 = 0.f, s2 = 0.f, s3 = 0.f;
#pragma unroll
    for (int r = 0; r < 16; r += 2) {
        if (!(ABL & 2)) { p0[r] = __builtin_amdgcn_exp2f(p0[r] - ms); p0[r + 1] = __builtin_amdgcn_exp2f(p0[r + 1] - ms); p1[r] = __builtin_amdgcn_exp2f(p1[r] - ms); p1[r + 1] = __builtin_amdgcn_exp2f(p1[r + 1] - ms); }
        else { p0[r] -= ms; p0[r + 1] -= ms; p1[r] -= ms; p1[r + 1] -= ms; }
        s0 += p0[r]; s1 += p0[r + 1]; s2 += p1[r]; s3 += p1[r + 1]; }
    l += (s0 + s1) + (s2 + s3);
    if (resc) { NSA_LWAIT();
#pragma unroll
        for (int r = 0; r < 16; ++r) { const float f = wsf[crow(r, c.hi)]; o[0][r] *= f; o[1][r] *= f; } }
    u32x4 w0, w1, w2, w3;
    w0 = (u32x4){cvtpk(p0[0], p0[1]), cvtpk(p0[2], p0[3]), cvtpk(p0[4], p0[5]), cvtpk(p0[6], p0[7])};
    w1 = (u32x4){cvtpk(p0[8], p0[9]), cvtpk(p0[10], p0[11]), cvtpk(p0[12], p0[13]), cvtpk(p0[14], p0[15])};
    w2 = (u32x4){cvtpk(p1[0], p1[1]), cvtpk(p1[2], p1[3]), cvtpk(p1[4], p1[5]), cvtpk(p1[6], p1[7])};
    w3 = (u32x4){cvtpk(p1[8], p1[9]), cvtpk(p1[10], p1[11]), cvtpk(p1[12], p1[13]), cvtpk(p1[14], p1[15])};
    const int vb = (int)(c.lds0 + L_V + slot * SLOT) + ((c.lane >> 4) & 1) * 32 + (c.lane & 3) * 8 + (4 * c.hi + ((c.lane & 15) >> 2)) * 64;
    if (!(ABL & 1)) pv(o, vb, __builtin_bit_cast(bf16x8, w0), __builtin_bit_cast(bf16x8, w1), __builtin_bit_cast(bf16x8, w2), __builtin_bit_cast(bf16x8, w3));
    else { asm volatile("" :: "v"(w0), "v"(w1), "v"(w2), "v"(w3)); }
}
__device__ __forceinline__ void accum_branch(const Ctx& c, f32x16* oacc, const f32x16* o, float fac) {
    volatile __attribute__((address_space(3))) float* wsf = (volatile __attribute__((address_space(3))) float*)(c.shm + L_WS + c.w * 512);
    NSA_LWAIT(); if (c.hi == 0) wsf[64 + c.r32] = fac; NSA_LWAIT();
#pragma unroll
    for (int r = 0; r < 16; ++r) { const float f = wsf[64 + crow(r, c.hi)]; oacc[0][r] += o[0][r] * f; oacc[1][r] += o[1][r] * f; }
    NSA_LWAIT();
}
template <int ABL> __device__ __forceinline__ void nsa_unit(const P& p, char* smem, int b, int g, int jq) {
    const int tid = TIDX(); Ctx c; c.lane = tid & 63; c.w = __builtin_amdgcn_readfirstlane(tid >> 6); c.r32 = c.lane & 31; c.hi = c.lane >> 5;
    c.shm = (lptr)smem; c.lds0 = (unsigned)(size_t)c.shm;
    const int hh = c.r32 >> 3, tokl = 8 * c.w + (c.r32 & 7), stok = 64 * jq + tokl, h = g * 4 + hh; const size_t t = (size_t)b * S + stok;
    const size_t seg = kvseg(p), ho = (size_t)(b * 2 + g) * S * 64;
    bf16x8 qr[4];
#pragma unroll
    for (int d0 = 0; d0 < 4; ++d0) { const u32x4 raw = *(const u32x4*)(p.q + t * 512 + h * 64 + d0 * 16 + c.hi * 8); u32x4 sc;
#pragma unroll
        for (int e4 = 0; e4 < 4; ++e4) sc[e4] = cvtpk(__uint_as_float(raw[e4] << 16) * LOG2E, __uint_as_float(raw[e4] & 0xffff0000u) * LOG2E);
        qr[d0] = __builtin_bit_cast(bf16x8, sc); }
    const float g0 = p.gates[t * 24 + h * 3], g1 = p.gates[t * 24 + h * 3 + 1], g2 = p.gates[t * 24 + h * 3 + 2];
    f32x16 oacc[2], o[2], p0, p1; oacc[0] = f32x16{}; oacc[1] = f32x16{};
    __attribute__((address_space(3))) float* impD = (__attribute__((address_space(3))) float*)(c.shm + L_IMPD);
    __attribute__((address_space(3))) float* impC = (__attribute__((address_space(3))) float*)(c.shm + L_IMPC);
    __attribute__((address_space(3))) u64* selm = (__attribute__((address_space(3))) u64*)(c.shm + L_SEL);
    const int nv = stok >= 31 ? (stok - 31) / 16 + 1 : 0;
    const int nct = (4 * jq + 3 + 63) >> 6;
    c.kt = p.kcmp + (size_t)(b * 2 + g) * 256 * 64; c.vt = p.vcmp + (size_t)(b * 2 + g) * 256 * 64;
    float m = M0, l = 0.f;
    if (tid < 64) impC[tid * 68] = 0.f;
    ring_begin(c, 0, nct > 1 ? 1 : -1);
    for (int ct = 0; ct < ((ABL & 64) ? 0 : nct); ++ct) {
        ring_step(c, ct + 2 < nct ? ct + 2 : -1, ct);
        qkt(p0, p1, (lcptr)(c.shm + L_K + c.rs * SLOT), qr, c.r32, c.hi); ring_next(c);
#pragma unroll
        for (int r = 0; r < 16; ++r) { const int n = 64 * ct + crow(r, c.hi); p0[r] = n < nv ? p0[r] : NEGM; p1[r] = n + 32 < nv ? p1[r] : NEGM; }
        const float rm = rowmax32(p0, p1); const float mn = fmaxf(m, rm); float sacc = 0.f;
#pragma unroll
        for (int r = 0; r < 16; ++r) sacc += __builtin_amdgcn_exp2f(p0[r] - mn) + __builtin_amdgcn_exp2f(p1[r] - mn);
        l = l * __builtin_amdgcn_exp2f(m - mn) + sacc; m = mn;
    }
    l = xhalf_sum(l); const float il = l > 0.f ? 1.f / l : 0.f;
    o[0] = f32x16{}; o[1] = f32x16{};
    ring_begin(c, 0, nct > 1 ? 1 : -1);
    for (int ct = 0; ct < ((ABL & 64) ? 0 : nct); ++ct) {
        ring_step(c, ct + 2 < nct ? ct + 2 : -1, ct);
        qkt(p0, p1, (lcptr)(c.shm + L_K + c.rs * SLOT), qr, c.r32, c.hi);
#pragma unroll
        for (int r = 0; r < 16; ++r) { const int n = 64 * ct + crow(r, c.hi); p0[r] = n < nv ? __builtin_amdgcn_exp2f(p0[r] - m) * il : 0.f; p1[r] = n + 32 < nv ? __builtin_amdgcn_exp2f(p1[r] - m) * il : 0.f; }
#pragma unroll
        for (int hb = 0; hb < 2; ++hb)
#pragma unroll
            for (int rg = 0; rg < 4; ++rg) {
                const f32x16& pp = hb ? p1 : p0;
                float dsum = pp[4 * rg] + pp[4 * rg + 1] + pp[4 * rg + 2] + 0.5f * pp[4 * rg + 3], csum = 0.5f * pp[4 * rg + 3];
                dsum += __shfl_xor(dsum, 8); dsum += __shfl_xor(dsum, 16); csum += __shfl_xor(csum, 8); csum += __shfl_xor(csum, 16);
                const int j = 16 * ct + 8 * hb + 2 * rg + c.hi;
                if (c.r32 < 8) { impD[tokl * 64 + j] = dsum; impC[tokl * 68 + j + 1] = csum; }
            }
        u32x4 w0, w1, w2, w3;
        w0 = (u32x4){cvtpk(p0[0], p0[1]), cvtpk(p0[2], p0[3]), cvtpk(p0[4], p0[5]), cvtpk(p0[6], p0[7])};
        w1 = (u32x4){cvtpk(p0[8], p0[9]), cvtpk(p0[10], p0[11]), cvtpk(p0[12], p0[13]), cvtpk(p0[14], p0[15])};
        w2 = (u32x4){cvtpk(p1[0], p1[1]), cvtpk(p1[2], p1[3]), cvtpk(p1[4], p1[5]), cvtpk(p1[6], p1[7])};
        w3 = (u32x4){cvtpk(p1[8], p1[9]), cvtpk(p1[10], p1[11]), cvtpk(p1[12], p1[13]), cvtpk(p1[14], p1[15])};
        const int vb = (int)(c.lds0 + L_V + c.rs * SLOT) + ((c.lane >> 4) & 1) * 32 + (c.lane & 3) * 8 + (4 * c.hi + ((c.lane & 15) >> 2)) * 64;
        pv(o, vb, __builtin_bit_cast(bf16x8, w0), __builtin_bit_cast(bf16x8, w1), __builtin_bit_cast(bf16x8, w2), __builtin_bit_cast(bf16x8, w3));
        ring_next(c);
    }
    accum_branch(c, oacc, o, g0);
    NSA_LWAIT(); __builtin_amdgcn_s_barrier();
    {
#pragma unroll 1
        for (int tkk = 0; tkk < 8; ++tkk) { const int tk = 8 * c.w + tkk, j = c.lane; const bool valid = j <= jq;
            const float sc = (j == 0 || j == jq || j == jq - 1) ? 1e4f : impD[tk * 64 + j] + impC[tk * 68 + j];
            const unsigned key = valid ? ((__float_as_uint(sc) & ~63u) | (unsigned)(63 - j)) : 0u;
            int rank = 0;
            if (!(ABL & 32)) {
#pragma unroll
                for (int i = 0; i < 64; ++i) { const unsigned ki = (unsigned)__builtin_amdgcn_readlane((int)key, i); rank += (ki > key) ? 1 : 0; } }
            const u64 mk = __ballot(valid && rank < 16);
            if (j == 0) { selm[tk] = mk; p.sel[((size_t)b * S + 64 * jq + tk) * 2 + g] = mk; } }
    }
    NSA_LWAIT(); __builtin_amdgcn_s_barrier();
    const u64 mysel = selm[tokl];
    u64 uni = selm[c.lane];
#pragma unroll
    for (int x = 1; x < 64; x <<= 1) { const unsigned lo_ = __shfl_xor((unsigned)uni, x), hi_ = __shfl_xor((unsigned)(uni >> 32), x); uni |= (u64)lo_ | ((u64)hi_ << 32); }
    const unsigned ulo = __builtin_amdgcn_readfirstlane((unsigned)uni), uhi = __builtin_amdgcn_readfirstlane((unsigned)(uni >> 32));
    {
        c.kt = p.kv6 + 2 * seg + ho; c.vt = p.kv6 + 3 * seg + ho;
        u64 rem = (u64)ulo | ((u64)uhi << 32);
        m = M0; l = 0.f; o[0] = f32x16{}; o[1] = f32x16{};
        int j = __builtin_ctzll(rem); rem &= rem - 1;
        int j1 = rem ? __builtin_ctzll(rem) : -1; if (rem) rem &= rem - 1;
        ring_begin<ABL>(c, j, j1);
        for (;;) {
            const int j2 = rem ? __builtin_ctzll(rem) : -1; if (rem) rem &= rem - 1;
            ring_step<ABL>(c, j2, j);
            if (!(ABL & 4)) qkt(p0, p1, (lcptr)(c.shm + L_K + c.rs * SLOT), qr, c.r32, c.hi); else { asm volatile("" : "+v"(p0), "+v"(p1)); }
            const bool on = (mysel >> j) & 1ull;
            if (j == jq) {
#pragma unroll
                for (int r = 0; r < 16; ++r) { const int kr = crow(r, c.hi); p0[r] = (kr <= tokl) ? p0[r] : NEGM; p1[r] = (kr + 32 <= tokl) ? p1[r] : NEGM; } }
            softmax_pv<ABL>(c, p0, p1, o, m, l, c.rs, on); ring_next(c);
            if (j1 < 0) break; j = j1; j1 = j2;
        }
        l = xhalf_sum(l);
        accum_branch(c, oacc, o, g1 / l);
    }
    {
        c.kt = p.kv6 + 4 * seg + ho; c.vt = p.kv6 + 5 * seg + ho;
        const int j0 = jq >= 8 ? jq - 8 : 0;
        m = M0; l = 0.f; o[0] = f32x16{}; o[1] = f32x16{};
        ring_begin<ABL>(c, j0, j0 + 1 <= jq ? j0 + 1 : -1);
        for (int j = j0; j <= jq; ++j) {
            ring_step<ABL>(c, j + 2 <= jq ? j + 2 : -1, j);
            if (!(ABL & 4)) qkt(p0, p1, (lcptr)(c.shm + L_K + c.rs * SLOT), qr, c.r32, c.hi); else { asm volatile("" : "+v"(p0), "+v"(p1)); }
            const bool lowt = (jq >= 8 && j == jq - 8), diag = (j == jq);
            if (diag || lowt) {
#pragma unroll
                for (int r = 0; r < 16; ++r) { const int kr = crow(r, c.hi);
                    const bool v0 = diag ? (kr <= tokl) : (kr > tokl), v1 = diag ? (kr + 32 <= tokl) : (kr + 32 > tokl);
                    p0[r] = v0 ? p0[r] : NEGM; p1[r] = v1 ? p1[r] : NEGM; } }
            softmax_pv<ABL>(c, p0, p1, o, m, l, c.rs, true); ring_next(c);
        }
        l = xhalf_sum(l);
        accum_branch(c, oacc, o, g2 / l);
    }
    {
        __attribute__((address_space(3))) bf16* stg = (__attribute__((address_space(3))) bf16*)(c.shm + L_OST + c.w * 4096);
#pragma unroll
        for (int r = 0; r < 16; ++r) { const int orow = crow(r, c.hi);
#pragma unroll
            for (int d0 = 0; d0 < 2; ++d0) stg[orow * 64 + d0 * 32 + c.r32] = f2bf(oacc[d0][r]); }
        NSA_LWAIT();
#pragma unroll
        for (int i = 0; i < 4; ++i) { const int row = i * 8 + (c.lane >> 3), ch = c.lane & 7; const u32x4 v = *(const __attribute__((address_space(3))) u32x4*)(stg + row * 64 + ch * 8);
            const int rh = row >> 3, rt = 8 * c.w + (row & 7);
            *(u32x4*)(p.onsa + ((size_t)b * S + 64 * jq + rt) * 512 + (g * 4 + rh) * 64 + ch * 8) = v; }
    }
    NSA_DRAIN_BAR();
}
}
template <int ABL = 0> __device__ __forceinline__ void phase_nsa(const P& p, char* smem) {
    const int nunits = p.nb * 2 * 64;
    const int G = gridDim.x; int r = 0;
    for (int base = 0; base < nunits; base += G, ++r) {
        const int w = (r & 1) ? G - 1 - (int)blockIdx.x : (int)blockIdx.x, i = base + w; if (i >= nunits) continue;
        const int jq = 63 - i / (p.nb * 2), bg = i % (p.nb * 2); nsa::nsa_unit<ABL>(p, smem, bg >> 1, bg & 1, jq); }
}

namespace gla {
using nsa::f32x16; using nsa::bf16x8; using nsa::s16x4; using nsa::u32x4; using nsa::lptr; using nsa::lcptr; using nsa::crow; using nsa::cvtpk;
typedef unsigned u32x2 __attribute__((ext_vector_type(2)));
constexpr int L_KI = 0, L_QI = 8192, L_VI = 16384, L_SI = 32768, L_OST = 49152, L_TOT = L_OST + 64 * 132 * 4, L_END = L_TOT + 8 * 64 * 4 + 64 * 4;
__device__ __forceinline__ int koff(int row, int d) { return (d >> 3) * 1024 + row * 16 + (d & 7) * 2; }
__device__ __forceinline__ int voff(int row, int col) { return ((col >> 5) * 4 + (row >> 4)) * 1024 + (row & 15) * 64 + (col & 31) * 2; }
__device__ __forceinline__ bf16x8 trfrag(unsigned img, int ks, int cb, int lane) {
    const int hi = lane >> 5; const unsigned a = img + (cb * 4 + ks) * 1024 + ((lane >> 4) & 1) * 32 + (lane & 3) * 8 + (4 * hi + ((lane & 15) >> 2)) * 64;
    s16x4 lo, hh;
    asm volatile("ds_read_b64_tr_b16 %0,%1" : "=&v"(lo) : "v"(a) : "memory");
    asm volatile("ds_read_b64_tr_b16 %0,%1 offset:512" : "=&v"(hh) : "v"(a) : "memory");
    asm volatile("s_waitcnt lgkmcnt(0)" ::: "memory"); __builtin_amdgcn_sched_barrier(0);
    return (bf16x8){lo[0], lo[1], lo[2], lo[3], hh[0], hh[1], hh[2], hh[3]};
}
template <int GM> __device__ __forceinline__ void chunk_images(const P& p, lptr shm, int b, int h, int c, int tid) {
    const int d = tid & 63, tg = tid >> 6; const size_t t0 = (size_t)b * S + c * 64;
    bf16 kraw[8], qraw[8];
#pragma unroll
    for (int i = 0; i < 8; ++i) { kraw[i] = __builtin_nontemporal_load(p.gk + (t0 + tg * 8 + i) * 256 + h * 64 + d); qraw[i] = GM ? __builtin_nontemporal_load(p.gq + (t0 + tg * 8 + i) * 256 + h * 64 + d) : (bf16)0; }
    if (GM == 1) {
        float bbv[8];
#pragma unroll
        for (int i = 0; i < 8; ++i) bbv[i] = __builtin_nontemporal_load(p.gb + (t0 + tg * 8 + i) * 256 + h * 64 + d);
#pragma unroll
        for (int k = 0; k < 2; ++k) { const int idx = tid + k * 512, s = idx >> 4, e = (idx & 15) * 8; *(__attribute__((address_space(3))) u32x4*)(shm + L_VI + voff(s, e)) = __builtin_nontemporal_load((const u32x4*)(p.gv + (t0 + s) * 512 + h * 128 + e)); }
#pragma unroll
        for (int i = 0; i < 8; ++i) { const int t = tg * 8 + i; const float bb = bbv[i], kk = bf2f(kraw[i]), qq = bf2f(qraw[i]);
            *(__attribute__((address_space(3))) bf16*)(shm + L_KI + koff(t, d)) = f2bf(kk * __expf(-bb)); *(__attribute__((address_space(3))) bf16*)(shm + L_QI + koff(t, d)) = f2bf(qq * __expf(bb)); }
        __syncthreads();
        return;
    }
    __attribute__((address_space(3))) float* tot = (__attribute__((address_space(3))) float*)(shm + L_TOT);
    float wa[16];
#pragma unroll
    for (int r = 0; r < 16; ++r) wa[r] = p.w_a2[r * 256 + h * 64 + d];
    const float ba = p.b_a[h * 64 + d];
    __attribute__((address_space(3))) float* als = (__attribute__((address_space(3))) float*)(shm + L_OST);
    { const f32x4_t a4 = tid < 256 ? *(const f32x4_t*)(p.alow + t0 * 16 + tid * 4) : (f32x4_t){0.f, 0.f, 0.f, 0.f}; if (tid < 256) *(__attribute__((address_space(3))) f32x4_t*)(als + tid * 4) = a4; }
    __syncthreads();
    float loc[8]; float run = 0.f;
#pragma unroll
    for (int i = 0; i < 8; ++i) { const __attribute__((address_space(3))) float* al = als + (tg * 8 + i) * 16; float z = ba;
#pragma unroll
        for (int r = 0; r < 16; ++r) z += al[r] * wa[r];
        const float ls = fminf(z, 0.f) - __logf(1.f + __expf(-fabsf(z))); run += ls * (1.f / 16.f); loc[i] = run; }
    tot[tg * 64 + d] = run;
#pragma unroll
    for (int k = 0; k < 2; ++k) { const int idx = tid + k * 512, s = idx >> 4, e = (idx & 15) * 8; *(__attribute__((address_space(3))) u32x4*)(shm + L_VI + voff(s, e)) = __builtin_nontemporal_load((const u32x4*)(p.gv + (t0 + s) * 512 + h * 128 + e)); }
    __syncthreads();
    float pre = 0.f, all = 0.f;
#pragma unroll
    for (int g = 0; g < 8; ++g) { const float x = tot[g * 64 + d]; all += x; pre += g < tg ? x : 0.f; }
#pragma unroll
    for (int i = 0; i < 8; ++i) { const int t = tg * 8 + i; const float bb = pre + loc[i]; const float kk = bf2f(kraw[i]);
        p.gb[(t0 + t) * 256 + h * 64 + d] = bb;
        *(__attribute__((address_space(3))) bf16*)(shm + L_KI + voff(t, d)) = f2bf(kk * __expf(all - bb)); }
    if (tg == 0) p.gdec[((size_t)(b * 4 + h) * 64 + c) * 64 + d] = __expf(all);
    __syncthreads();
}
struct G1L { unsigned k[8]; u32x4 v0, v1; f32x4_t a4; float wa[16]; float ba; };
#define G1_BAR() do { asm volatile("s_waitcnt lgkmcnt(0)" ::: "memory"); __builtin_amdgcn_s_barrier(); asm volatile("" ::: "memory"); } while (0)
__device__ __forceinline__ void g1_load(const P& p, int b, int h, int c, int tid, G1L& L) {
    const int d = tid & 63, tg = tid >> 6; const size_t t0 = (size_t)b * S + c * 64;
#pragma unroll
    for (int i = 0; i < 8; ++i) L.k[i] = p.gk[(t0 + tg * 8 + i) * 256 + h * 64 + d];
    { const int s0 = tid >> 4, e = (tid & 15) * 8; L.v0 = *(const u32x4*)(p.gv + (t0 + s0) * 512 + h * 128 + e); L.v1 = *(const u32x4*)(p.gv + (t0 + s0 + 32) * 512 + h * 128 + e); }
    L.a4 = *(const f32x4_t*)(p.alow + t0 * 16 + (tid & 255) * 4);
#pragma unroll
    for (int r = 0; r < 16; ++r) L.wa[r] = p.w_a2[r * 256 + h * 64 + d];
    L.ba = p.b_a[h * 64 + d];
}
__device__ __forceinline__ void g1_compute(const P& p, char* smem, int b, int h, int c, const G1L& L) {
    const int tid = TIDX(), lane = tid & 63, w = __builtin_amdgcn_readfirstlane(tid >> 6), r32 = lane & 31, hi = lane >> 5;
    lptr shm = (lptr)smem; const unsigned l0 = (unsigned)(size_t)shm;
    const int d = tid & 63, tg = tid >> 6; const size_t t0 = (size_t)b * S + c * 64;
    __attribute__((address_space(3))) float* tot = (__attribute__((address_space(3))) float*)(shm + L_TOT);
    __attribute__((address_space(3))) float* als = (__attribute__((address_space(3))) float*)(shm + L_OST);
    if (tid < 256) *(__attribute__((address_space(3))) f32x4_t*)(als + tid * 4) = L.a4;
    { const int s0 = tid >> 4, e = (tid & 15) * 8; *(__attribute__((address_space(3))) u32x4*)(shm + L_VI + voff(s0, e)) = L.v0; *(__attribute__((address_space(3))) u32x4*)(shm + L_VI + voff(s0 + 32, e)) = L.v1; }
    G1_BAR();
    float loc[8]; float run = 0.f;
#pragma unroll
    for (int i = 0; i < 8; ++i) { const __attribute__((address_space(3))) float* al = als + (tg * 8 + i) * 16; float z = L.ba;
#pragma unroll
        for (int r = 0; r < 16; ++r) z += al[r] * L.wa[r];
        const float ls = fminf(z, 0.f) - __logf(1.f + __expf(-fabsf(z))); run += ls * (1.f / 16.f); loc[i] = run; }
    tot[tg * 64 + d] = run;
    G1_BAR();
    float pre = 0.f, all = 0.f;
#pragma unroll
    for (int g = 0; g < 8; ++g) { const float x = tot[g * 64 + d]; all += x; pre += g < tg ? x : 0.f; }
#pragma unroll
    for (int i = 0; i < 8; ++i) { const int t = tg * 8 + i; const float bb = pre + loc[i]; const float kk = __uint_as_float(L.k[i] << 16);
        p.gb[(t0 + t) * 256 + h * 64 + d] = bb;
        *(__attribute__((address_space(3))) bf16*)(shm + L_KI + voff(t, d)) = f2bf(kk * __expf(all - bb)); }
    if (tg == 0) p.gdec[((size_t)(b * 4 + h) * 64 + c) * 64 + d] = __expf(all);
    G1_BAR();
    const int db = w & 1, eb = w >> 1; f32x16 acc = f32x16{};
#pragma unroll
    for (int ks = 0; ks < 4; ++ks) { const bf16x8 a = trfrag(l0 + L_KI, ks, db, lane), bq = trfrag(l0 + L_VI, ks, eb, lane); acc = __builtin_amdgcn_mfma_f32_32x32x16_bf16(a, bq, acc, 0, 0, 0); }
    bf16* U = (bf16*)p.gst + ((size_t)(b * 4 + h) * 64 + c) * (64 * 128);
#pragma unroll
    for (int r = 0; r < 16; ++r) U[(32 * db + crow(r, hi)) * 128 + 32 * eb + r32] = f2bf(acc[r]);
    G1_BAR();
}
__device__ __forceinline__ void g1_chunk(const P& p, char* smem, int b, int h, int c) {
    const int tid = TIDX(), lane = tid & 63, w = __builtin_amdgcn_readfirstlane(tid >> 6), r32 = lane & 31, hi = lane >> 5;
    lptr shm = (lptr)smem; const unsigned l0 = (unsigned)(size_t)shm;
    chunk_images<0>(p, shm, b, h, c, tid);
    const int db = w & 1, eb = w >> 1; f32x16 acc = f32x16{};
#pragma unroll
    for (int ks = 0; ks < 4; ++ks) { const bf16x8 a = trfrag(l0 + L_KI, ks, db, lane), bq = trfrag(l0 + L_VI, ks, eb, lane); acc = __builtin_amdgcn_mfma_f32_32x32x16_bf16(a, bq, acc, 0, 0, 0); }
    bf16* U = (bf16*)p.gst + ((size_t)(b * 4 + h) * 64 + c) * (64 * 128);
#pragma unroll
    for (int r = 0; r < 16; ++r) U[(32 * db + crow(r, hi)) * 128 + 32 * eb + r32] = f2bf(acc[r]);
    __syncthreads();
}
__device__ __forceinline__ void g3_chunk(const P& p, char* smem, int b, int h, int c) {
    const int tid = TIDX(), lane = tid & 63, w = __builtin_amdgcn_readfirstlane(tid >> 6), r32 = lane & 31, hi = lane >> 5;
    lptr shm = (lptr)smem; const unsigned l0 = (unsigned)(size_t)shm; const size_t t0 = (size_t)b * S + c * 64;
    const bf16* St = (const bf16*)p.gst + ((size_t)(b * 4 + h) * 64 + c) * (64 * 128);
    u32x4 sv[2];
#pragma unroll
    for (int k = 0; k < 2; ++k) sv[k] = __builtin_nontemporal_load((const u32x4*)(St + (size_t)(tid + k * 512) * 8));
    const size_t go_ = (t0 + (tid >> 3)) * 512 + h * 128 + (tid & 7) * 16;
    const u32x4 rs0v = __builtin_nontemporal_load((const u32x4*)(p.rs + go_)), rs1v = __builtin_nontemporal_load((const u32x4*)(p.rs + go_ + 8)); const uint4 rs0 = make_uint4(rs0v.x, rs0v.y, rs0v.z, rs0v.w), rs1 = make_uint4(rs1v.x, rs1v.y, rs1v.z, rs1v.w);
    f32x4_t ngv[4];
#pragma unroll
    for (int k = 0; k < 4; ++k) ngv[k] = *(const f32x4_t*)(p.norm_g + h * 128 + (tid & 7) * 16 + 4 * k);
    chunk_images<1>(p, shm, b, h, c, tid);
#pragma unroll
    for (int k = 0; k < 2; ++k) { const int idx = (tid + k * 512) * 8, dd = idx >> 7, e = idx & 127; *(__attribute__((address_space(3))) u32x4*)(shm + L_SI + voff(dd, e)) = sv[k]; }
    __syncthreads();
    const int tb = w & 1, eb = w >> 1, trow = 32 * tb + r32;
    f32x16 p0 = f32x16{}, p1 = f32x16{}, o = f32x16{};
    {
        lcptr kb = (lcptr)(shm + L_KI) + hi * 1024 + r32 * 16; lcptr qb = (lcptr)(shm + L_QI) + hi * 1024 + trow * 16;
#pragma unroll
        for (int d0 = 0; d0 < 4; ++d0) {
            const bf16x8 b0 = *(const __attribute__((address_space(3))) bf16x8*)(kb + d0 * 2048), b1 = *(const __attribute__((address_space(3))) bf16x8*)(kb + d0 * 2048 + 512);
            const bf16x8 qf = *(const __attribute__((address_space(3))) bf16x8*)(qb + d0 * 2048);
            p0 = __builtin_amdgcn_mfma_f32_32x32x16_bf16(b0, qf, p0, 0, 0, 0); p1 = __builtin_amdgcn_mfma_f32_32x32x16_bf16(b1, qf, p1, 0, 0, 0); }
    }
#pragma unroll
    for (int r = 0; r < 16; ++r) { const int s = crow(r, hi); p0[r] = s <= trow ? p0[r] : 0.f; p1[r] = s + 32 <= trow ? p1[r] : 0.f; }
#pragma unroll
    for (int ds = 0; ds < 4; ++ds) {
        const u32x2 a0 = *(const __attribute__((address_space(3))) u32x2*)(shm + L_QI + (2 * ds) * 1024 + trow * 16 + 8 * hi), a1 = *(const __attribute__((address_space(3))) u32x2*)(shm + L_QI + (2 * ds + 1) * 1024 + trow * 16 + 8 * hi);
        const u32x4 aw = {a0.x, a0.y, a1.x, a1.y};
        const bf16x8 bq = trfrag(l0 + L_SI, ds, eb, lane);
        o = __builtin_amdgcn_mfma_f32_32x32x16_bf16(__builtin_bit_cast(bf16x8, aw), bq, o, 0, 0, 0); }
    {
        const u32x4 w0 = {cvtpk(p0[0], p0[1]), cvtpk(p0[2], p0[3]), cvtpk(p0[4], p0[5]), cvtpk(p0[6], p0[7])}, w1 = {cvtpk(p0[8], p0[9]), cvtpk(p0[10], p0[11]), cvtpk(p0[12], p0[13]), cvtpk(p0[14], p0[15])};
        const u32x4 w2 = {cvtpk(p1[0], p1[1]), cvtpk(p1[2], p1[3]), cvtpk(p1[4], p1[5]), cvtpk(p1[6], p1[7])}, w3 = {cvtpk(p1[8], p1[9]), cvtpk(p1[10], p1[11]), cvtpk(p1[12], p1[13]), cvtpk(p1[14], p1[15])};
        o = __builtin_amdgcn_mfma_f32_32x32x16_bf16(__builtin_bit_cast(bf16x8, w0), trfrag(l0 + L_VI, 0, eb, lane), o, 0, 0, 0);
        o = __builtin_amdgcn_mfma_f32_32x32x16_bf16(__builtin_bit_cast(bf16x8, w1), trfrag(l0 + L_VI, 1, eb, lane), o, 0, 0, 0);
        o = __builtin_amdgcn_mfma_f32_32x32x16_bf16(__builtin_bit_cast(bf16x8, w2), trfrag(l0 + L_VI, 2, eb, lane), o, 0, 0, 0);
        o = __builtin_amdgcn_mfma_f32_32x32x16_bf16(__builtin_bit_cast(bf16x8, w3), trfrag(l0 + L_VI, 3, eb, lane), o, 0, 0, 0);
    }
    __attribute__((address_space(3))) float* ost = (__attribute__((address_space(3))) float*)(shm + L_OST);
#pragma unroll
    for (int r = 0; r < 16; ++r) ost[(32 * tb + crow(r, hi)) * 132 + 32 * eb + r32] = o[r];
    __syncthreads();
    { const int t = tid >> 3, part = tid & 7; float v[16]; float ss = 0.f;
#pragma unroll
        for (int k = 0; k < 4; ++k) { const f32x4_t x = *(const __attribute__((address_space(3))) f32x4_t*)(ost + t * 132 + part * 16 + k * 4); v[4 * k] = x[0]; v[4 * k + 1] = x[1]; v[4 * k + 2] = x[2]; v[4 * k + 3] = x[3]; ss += x[0] * x[0] + x[1] * x[1] + x[2] * x[2] + x[3] * x[3]; }
        ss += __shfl_xor(ss, 1); ss += __shfl_xor(ss, 2); ss += __shfl_xor(ss, 4);
        const float rstd = rsqrtf(ss * (1.f / 128.f) + 1e-6f);
        const size_t go = (t0 + t) * 512 + h * 128 + part * 16;
        const uint4 r0 = rs0, r1 = rs1; const unsigned rw[8] = {r0.x, r0.y, r0.z, r0.w, r1.x, r1.y, r1.z, r1.w};
        unsigned ow[8];
#pragma unroll
        for (int k = 0; k < 8; ++k) { const float ga = ngv[k >> 1][(2 * k) & 3], gb = ngv[k >> 1][(2 * k + 1) & 3];
            ow[k] = pk2(v[2 * k] * rstd * ga * __uint_as_float(rw[k] << 16), v[2 * k + 1] * rstd * gb * __uint_as_float(rw[k] & 0xffff0000u)); }
        *(uint4*)(p.gla + go) = make_uint4(ow[0], ow[1], ow[2], ow[3]); *(uint4*)(p.gla + go + 8) = make_uint4(ow[4], ow[5], ow[6], ow[7]); }
    __syncthreads();
}
}
__device__ __forceinline__ void phase_gla1(const P& p, char* smem, int ncmp) {
    const int n = p.nb * 4 * 64, G = gridDim.x, c = blockIdx.x;
    int first, stride;
    if (ncmp > 0 && ncmp < G && ncmp <= n) { if (c < ncmp) { first = c; stride = n; } else { first = ncmp + (c - ncmp); stride = G - ncmp; } }
    else { first = c; stride = G; }
    const int cnt = first < n ? (n - 1 - first) / stride + 1 : 0;
    const int tid = TIDX();
    __syncthreads();
    if (cnt == 0) return;
    int cur = first;
    gla::G1L A; gla::g1_load(p, cur >> 8, (cur >> 6) & 3, cur & 63, tid, A);
    for (int k = 0; k < cnt; ++k) {
        const int nxt = k + 1 < cnt ? cur + stride : cur;
        gla::G1L B; gla::g1_load(p, nxt >> 8, (nxt >> 6) & 3, nxt & 63, tid, B);
        gla::g1_compute(p, smem, cur >> 8, (cur >> 6) & 3, cur & 63, A);
        A = B; cur = nxt;
    }
    __syncthreads();
}
__device__ __forceinline__ void phase_gla2(const P& p) {
    const int n2 = p.nb * 4 * 4096;
    if (TIDX() < 256)
    for (int idx = blockIdx.x * 256 + TIDX(); idx < n2; idx += gridDim.x * 256) {
        const int bh = idx >> 12, de = (idx & 4095) * 2, d = de >> 7; unsigned* U = (unsigned*)((bf16*)p.gst + (size_t)bh * 64 * 8192 + de); const float* gd = p.gdec + (size_t)bh * 64 * 64 + d;
        unsigned u[64]; float g[64];
#pragma unroll
        for (int c = 0; c < 64; ++c) { u[c] = U[(size_t)c * 4096]; g[c] = gd[c * 64]; }
        float s0 = 0.f, s1 = 0.f;
#pragma unroll
        for (int c = 0; c < 64; ++c) { const float t0 = __uint_as_float(u[c] << 16), t1 = __uint_as_float(u[c] & 0xffff0000u); U[(size_t)c * 4096] = pk2(s0, s1); s0 = g[c] * s0 + t0; s1 = g[c] * s1 + t1; }
    }
}
__device__ __forceinline__ void phase_gla3(const P& p, char* smem) {
    const int n = p.nb * 4 * 64;
    for (int i = blockIdx.x; i < n; i += gridDim.x) gla::g3_chunk(p, smem, i >> 8, (i >> 6) & 3, i & 63);
}

struct CmpSched {
    const char* kc; const char* Wc1; float* Pc; int nM, G, c; size_t aseg, pseg;
    __device__ __forceinline__ bool next(int i, pg8::Unit& u) const {
        const int L = i * G + c, per = nM * 2 * 2; if (L >= 2 * per) return false;
        const int kv = L / per, r = L % per, ks = r & 1, pn = (r >> 1) & 1, pm = r >> 2;
        u.pm = pm; u.pn = pn; u.tag = kv * 2 + ks;
        u.A = kc + (size_t)kv * aseg + (size_t)pm * 256 * 1024 * 2 + ks * 512 * 2; u.B = Wc1 + ((size_t)kv * 512 + pn * 256) * 1024 * 2 + ks * 512 * 2; return true;
    }
    __device__ __forceinline__ unsigned arow(const pg8::Unit&, int r) const { return (unsigned)r * 2048u; }
    __device__ __forceinline__ void a_ready(const pg8::Unit&) const {}
    __device__ __forceinline__ void done(const pg8::Unit&) const {}
};
struct EpiCmp {
    static constexpr bool PERM = false, CHAIN = false;
    float* Pc; size_t pseg;
    __device__ __forceinline__ void operator()(const pg8::f32x4 (&acc)[2][2][4][2], const pg8::Unit& u, int wr, int wc, int fr, int fq) const {
        float* base = Pc + (size_t)u.tag * pseg; const int col0 = u.pn * 256 + wc * 32 + 4 * fq;
#pragma unroll
        for (int ai = 0; ai < 2; ++ai)
#pragma unroll
            for (int m = 0; m < 4; ++m) { float* rowp = base + (size_t)(u.pm * 256 + ai * 128 + wr * 64 + m * 16 + fr) * 512 + col0;
#pragma unroll
                for (int bj = 0; bj < 2; ++bj)
#pragma unroll
                    for (int n = 0; n < 2; ++n) *(pg8::f32x4*)(rowp + bj * 128 + n * 16) = acc[ai][bj][m][n]; }
    }
};
__device__ __forceinline__ void finish_b1p(const P& p);
__device__ __forceinline__ void phase_cmp1(const P& p, char* smem) {
    if (blockIdx.x == gridDim.x - 1) finish_b1p(p);
    const int nrows = p.nb * 2 * 256;
    CmpSched Sc{(const char*)p.kv6, (const char*)p.Wc1, p.pcmp, nrows / 256, (int)gridDim.x, (int)blockIdx.x, kvseg(p) * 2, (size_t)(nrows + 8) * 512};
    EpiCmp E{p.pcmp, (size_t)(nrows + 8) * 512};
    pg8::gemm_phase<EpiCmp, CmpSched, true, false>((PG8_LAS unsigned char*)smem, 512, 1024, 1024, Sc, E);
}
__device__ __forceinline__ void body_cmp2f(const P& p, int vb, char* smem) {
    const int tid = TIDX(); const int nrows = p.nb * 2 * 256, nvb1 = nrows / 16; const int kv = vb / nvb1, row0 = (vb % nvb1) * 16;
    const size_t pseg = (size_t)(nrows + 8) * 512; const float* P0 = p.pcmp + (size_t)(kv * 2) * pseg; const float* P1 = P0 + pseg;
    typedef __attribute__((address_space(3))) char* lp_t;
    lp_t Ai = (lp_t)smem, Bi = Ai + 16 * 528;
    float* zs = (float*)(smem + 16 * 528 + 64 * 528);
    __syncthreads();
    { const float* wsrc = kv ? p.cw2_v : p.cw2_k;
#pragma unroll
      for (int q = 0; q < 16; ++q) { const int d = tid + q * 512, n = d & 63, k2 = d >> 6;
          *(__attribute__((address_space(3))) unsigned*)(Bi + n * 528 + k2 * 4) = pk2(wsrc[(2 * k2) * 64 + n], wsrc[(2 * k2 + 1) * 64 + n]); } }
#pragma unroll
    for (int q = 0; q < 4; ++q) { const int d = tid + q * 512, rr = d >> 7, n = (d & 127) * 2; const size_t m = (size_t)(row0 + rr);
        typedef float f2_ __attribute__((ext_vector_type(2)));
        const f2_ a0 = *(const f2_*)(P0 + m * 512 + n), a1 = *(const f2_*)(P1 + m * 512 + n), a2 = *(const f2_*)(P0 + (m + 1) * 512 + 256 + n), a3 = *(const f2_*)(P1 + (m + 1) * 512 + 256 + n), bb = *(const f2_*)(p.b1p + kv * 256 + n);
        *(__attribute__((address_space(3))) unsigned*)(Ai + rr * 528 + n * 2) = pk2(geluf_(a0.x + a1.x + a2.x + a3.x + bb.x), geluf_(a0.y + a1.y + a2.y + a3.y + bb.y)); }
    __syncthreads();
    if (tid < 256) { const int nb0 = tid >> 6, lane = tid & 63, fr = lane & 15, fq = lane >> 4;
        pg8::f32x4 acc = {0.f, 0.f, 0.f, 0.f};
#pragma unroll
        for (int ks = 0; ks < 8; ++ks) { const int ko = (ks * 32 + 8 * fq) * 2;
            const pg8::bf16x8 a = *(const __attribute__((address_space(3))) pg8::bf16x8*)(Ai + fr * 528 + ko), b = *(const __attribute__((address_space(3))) pg8::bf16x8*)(Bi + (16 * nb0 + fr) * 528 + ko);
            acc = __builtin_amdgcn_mfma_f32_16x16x32_bf16(a, b, acc, 0, 0, 0); }
#pragma unroll
        for (int r = 0; r < 4; ++r) zs[(fq * 4 + r) * 64 + 16 * nb0 + fr] = acc[r];
    }
    __syncthreads();
    const int rr = tid >> 5, i = tid & 31, row = row0 + rr;
    const float* b2 = kv ? p.cb2_v : p.cb2_k;
    float z1 = b2[i] + zs[rr * 64 + i], z2 = b2[i + 32] + zs[rr * 64 + i + 32];
    bf16* dst = (kv ? p.vcmp : p.kcmp) + (size_t)row * 64;
    if (kv == 0) {
        const int bg = row >> 8, m = row & 255, b = bg >> 1; int sp = 16 * m + 31; if (sp > S - 1) sp = S - 1;
        const size_t t = (size_t)b * S + sp; const float c = p.cs[t * 64 + i], sn = p.cs[t * 64 + 32 + i];
        const float r1 = z1 * c - z2 * sn, r2 = z2 * c + z1 * sn; z1 = r1; z2 = r2;
    }
    if ((row & 255) == 255) { z1 = 0.f; z2 = 0.f; }
    dst[i] = f2bf(z1); dst[i + 32] = f2bf(z2);
}
__device__ __forceinline__ void phase_cmp2(const P& p, char* smem) {
    const int n = 2 * (p.nb * 2 * 256) / 16;
    for (int vb = blockIdx.x; vb < n; vb += gridDim.x) body_cmp2f(p, vb, smem);
}
__device__ __forceinline__ void prep_b1p(const P& p, char* smem) {
    if (blockIdx.x >= 64) return;
    const int tid = TIDX(), kv = blockIdx.x >> 5, part = blockIdx.x & 31, n = tid & 255, fh = tid >> 8;
    const float* pe = kv ? p.cpos_v : p.cpos_k; const float* w1 = kv ? p.cw1_v : p.cw1_k;
    const int f0 = part * 64 + fh * 32; float a = 0.f;
#pragma unroll
    for (int i = 0; i < 32; ++i) a += pe[f0 + i] * w1[(size_t)(f0 + i) * 256 + n];
    float* sc = (float*)(smem + LDS_MISC);
    __syncthreads();
    if (fh == 1) sc[n] = a;
    __syncthreads();
    if (fh == 0) p.b1p[512 + (kv * 32 + part) * 256 + n] = a + sc[n];
    __syncthreads();
}
__device__ __forceinline__ void finish_b1p(const P& p) {
    const int tid = TIDX(), kv = tid >> 8, n = tid & 255; float a = (kv ? p.cb1_v : p.cb1_k)[n];
    for (int part = 0; part < 32; ++part) a += p.b1p[512 + (kv * 32 + part) * 256 + n];
    p.b1p[kv * 256 + n] = a;
}
struct FinPre { pg8::u32x2 hb[8][4]; int r0[8], r1[8]; float w0[8], w1[8]; pg8::f32x4 g[4]; };
__device__ __forceinline__ void final_preload(const P& p, const int* sbase, FinPre& f) {
    const int lane = TIDX() & 63, wave = TIDX() >> 6, G = gridDim.x;
#pragma unroll
    for (int k = 0; k < 8; ++k) { const int t = ((int)blockIdx.x + k * G) * 8 + wave;
        f.r0[k] = sbase[p.tokexp[t * 2]] + p.tokslot[t * 2]; f.r1[k] = sbase[p.tokexp[t * 2 + 1]] + p.tokslot[t * 2 + 1]; f.w0[k] = p.tokw[t * 2]; f.w1[k] = p.tokw[t * 2 + 1];
#pragma unroll
        for (int j = 0; j < 4; ++j) f.hb[k][j] = ((const pg8::u32x2*)(p.h1b + (size_t)t * D))[lane + 64 * j]; }
#pragma unroll
    for (int j = 0; j < 4; ++j) f.g[j] = ((const pg8::f32x4*)p.g_final)[lane + 64 * j];
}
__device__ __forceinline__ void final_compute(const P& p, const FinPre& f) {
    const int lane = TIDX() & 63, wave = TIDX() >> 6, G = gridDim.x;
#pragma unroll
    for (int k = 0; k < 8; ++k) { const int t = ((int)blockIdx.x + k * G) * 8 + wave; const float w0 = f.w0[k], w1 = f.w1[k];
        float4 v[4]; float ss = 0.f;
#pragma unroll
        for (int j = 0; j < 4; ++j) {
            const pg8::u32x2 hb = f.hb[k][j];
            const pg8::u32x2 y0 = ((const pg8::u32x2*)(p.Y + (size_t)f.r0[k] * D))[lane + 64 * j], y1 = ((const pg8::u32x2*)(p.Y + (size_t)f.r1[k] * D))[lane + 64 * j];
            float4 a;
            a.x = __uint_as_float(hb.x << 16) + w0 * __uint_as_float(y0.x << 16) + w1 * __uint_as_float(y1.x << 16);
            a.y = __uint_as_float(hb.x & 0xffff0000u) + w0 * __uint_as_float(y0.x & 0xffff0000u) + w1 * __uint_as_float(y1.x & 0xffff0000u);
            a.z = __uint_as_float(hb.y << 16) + w0 * __uint_as_float(y0.y << 16) + w1 * __uint_as_float(y1.y << 16);
            a.w = __uint_as_float(hb.y & 0xffff0000u) + w0 * __uint_as_float(y0.y & 0xffff0000u) + w1 * __uint_as_float(y1.y & 0xffff0000u);
            v[j] = a; ss += a.x * a.x + a.y * a.y + a.z * a.z + a.w * a.w;
        }
#pragma unroll
        for (int o = 1; o < 64; o <<= 1) ss += __shfl_xor(ss, o);
        const float rstd = rsqrtf(ss * (1.f / D) + 1e-6f);
#pragma unroll
        for (int j = 0; j < 4; ++j) {
            const pg8::f32x4 g = f.g[j];
            float4 o; o.x = v[j].x * rstd * g.x; o.y = v[j].y * rstd * g.y; o.z = v[j].z * rstd * g.z; o.w = v[j].w * rstd * g.w;
            ((float4*)(p.out + (size_t)t * D))[lane + 64 * j] = o;
        }
    }
}
#define XB_TMO      128
#define XB_XCNT(j)  (256  + 64 * (j))
#define XB_XSUB(j)  (1280 + 64 * (j))
#define XB_XGEN(j)  (2304 + 64 * (j))
#define XB_TOP      3328
#define XB_TOPGEN   3392
#define XCD_BAR_WORDS 3456
#define XB_SPIN_CAP (1u << 18)
#define XLAS __attribute__((address_space(3)))
__device__ __forceinline__ unsigned xb_ld(unsigned* p)              { return __hip_atomic_load(p, __ATOMIC_RELAXED, __HIP_MEMORY_SCOPE_AGENT); }
__device__ __forceinline__ unsigned xb_add(unsigned* p, unsigned v) { return __hip_atomic_fetch_add(p, v, __ATOMIC_RELAXED, __HIP_MEMORY_SCOPE_AGENT); }
__device__ __forceinline__ unsigned xb_xcc_id() { return (unsigned)__builtin_amdgcn_s_getreg((3 << 11) | 20) & 0xFu; }
#define XB_SPIN(cond, bar) do { unsigned _sp = 0; while (cond) { __builtin_amdgcn_s_sleep(1); \
    if ((++_sp & 255u) == 0u) { if (xb_ld(&(bar)[XB_TMO])) break; if (_sp > XB_SPIN_CAP) { atomicAdd(&(bar)[XB_TMO], 1u); break; } } } } while (0)
struct XcdBarrier { unsigned* bar; unsigned x; volatile XLAS unsigned* st; };
__device__ __forceinline__ XcdBarrier xcd_barrier_post(unsigned* bar, volatile XLAS unsigned* st) {
    XcdBarrier b; b.bar = bar; b.x = xb_xcc_id(); b.st = st;
    if (TIDX() == 0) (void)xb_add(&bar[XB_XCNT(b.x)], 1u);
    return b;
}
__device__ __forceinline__ void xcd_barrier_complete(unsigned* bar, unsigned x, unsigned& nloc, unsigned& nx) {
    const unsigned G = gridDim.x * gridDim.y * gridDim.z;
    unsigned sum, cnt, mine, sp = 0u;
    for (;;) {
        sum = 0u; cnt = 0u; mine = 0u;
#pragma unroll
        for (unsigned j = 0; j < 16; ++j) { const unsigned c = xb_ld(&bar[XB_XCNT(j)]); sum += c; cnt += (c > 0u) ? 1u : 0u; mine = (j == x) ? c : mine; }
        if (sum == G) break;
        __builtin_amdgcn_s_sleep(1);
        if ((++sp & 255u) == 0u) { if (xb_ld(&bar[XB_TMO])) break; if (sp > XB_SPIN_CAP) { atomicAdd(&bar[XB_TMO], 1u); break; } }
    }
    nloc = mine > 0u ? mine : 1u; nx = cnt > 0u ? cnt : 1u;
}
__device__ __forceinline__ void xcd_barrier(const XcdBarrier& b) {
    asm volatile("s_waitcnt vmcnt(0)" ::: "memory");
    __syncthreads();
    if (TIDX() == 0) {
        unsigned* bar = b.bar;
        __builtin_amdgcn_s_waitcnt(0);
        unsigned nloc = b.st[0], nx = b.st[1];
        if (nloc == 0u) { xcd_barrier_complete(bar, b.x, nloc, nx); b.st[0] = nloc; b.st[1] = nx; }
        const unsigned old = xb_add(&bar[XB_XSUB(b.x)], 1u);
        const unsigned gen = old / nloc;
        if (old + 1u == (gen + 1u) * nloc) {
            __builtin_amdgcn_fence(__ATOMIC_RELEASE, "agent");
            asm volatile("s_waitcnt vmcnt(0)" ::: "memory");
            const unsigned og = xb_add(&bar[XB_TOP], 1u);
            const unsigned tg = og / nx;
            if (og + 1u == (tg + 1u) * nx) xb_add(&bar[XB_TOPGEN], 1u);
            else XB_SPIN(xb_ld(&bar[XB_TOPGEN]) == tg, bar);
            __builtin_amdgcn_fence(__ATOMIC_ACQUIRE, "agent");
            xb_add(&bar[XB_XGEN(b.x)], 1u);
            asm volatile("s_waitcnt vmcnt(0)" ::: "memory");
        } else {
            XB_SPIN(xb_ld(&bar[XB_XGEN(b.x)]) == gen, bar);
            __builtin_amdgcn_fence(__ATOMIC_ACQUIRE, "agent");
            asm volatile("s_waitcnt vmcnt(0)" ::: "memory");
        }
    }
    __syncthreads();
}
__device__ __forceinline__ void xcd_barrier_fin(const XcdBarrier& b, const P& p, const int* sbase, FinPre& f) {
    asm volatile("s_waitcnt vmcnt(0)" ::: "memory");
    __syncthreads();
    if (TIDX() >= 64) final_preload(p, sbase, f);
    if (TIDX() == 0) {
        unsigned* bar = b.bar;
        __builtin_amdgcn_s_waitcnt(0);
        unsigned nloc = b.st[0], nx = b.st[1];
        if (nloc == 0u) { xcd_barrier_complete(bar, b.x, nloc, nx); b.st[0] = nloc; b.st[1] = nx; }
        const unsigned old = xb_add(&bar[XB_XSUB(b.x)], 1u);
        const unsigned gen = old / nloc;
        if (old + 1u == (gen + 1u) * nloc) {
            __builtin_amdgcn_fence(__ATOMIC_RELEASE, "agent");
            asm volatile("s_waitcnt vmcnt(0)" ::: "memory");
            const unsigned og = xb_add(&bar[XB_TOP], 1u);
            const unsigned tg = og / nx;
            if (og + 1u == (tg + 1u) * nx) xb_add(&bar[XB_TOPGEN], 1u);
            else XB_SPIN(xb_ld(&bar[XB_TOPGEN]) == tg, bar);
            __builtin_amdgcn_fence(__ATOMIC_ACQUIRE, "agent");
            xb_add(&bar[XB_XGEN(b.x)], 1u);
            asm volatile("s_waitcnt vmcnt(0)" ::: "memory");
        } else {
            XB_SPIN(xb_ld(&bar[XB_XGEN(b.x)]) == gen, bar);
            __builtin_amdgcn_fence(__ATOMIC_ACQUIRE, "agent");
            asm volatile("s_waitcnt vmcnt(0)" ::: "memory");
        }
    }
    if (TIDX() < 64) final_preload(p, sbase, f);
    __syncthreads();
}
__device__ __forceinline__ void xcd_barrier_pre(const XcdBarrier& b, const P& p, pg8::f32x4 (&xin)[32]) {
    asm volatile("s_waitcnt vmcnt(0)" ::: "memory");
    __syncthreads();
    if (TIDX() >= 64) (void)out_preload(p, xin);
    if (TIDX() == 0) {
        unsigned* bar = b.bar;
        __builtin_amdgcn_s_waitcnt(0);
        unsigned nloc = b.st[0], nx = b.st[1];
        if (nloc == 0u) { xcd_barrier_complete(bar, b.x, nloc, nx); b.st[0] = nloc; b.st[1] = nx; }
        const unsigned old = xb_add(&bar[XB_XSUB(b.x)], 1u);
        const unsigned gen = old / nloc;
        if (old + 1u == (gen + 1u) * nloc) {
            __builtin_amdgcn_fence(__ATOMIC_RELEASE, "agent");
            asm volatile("s_waitcnt vmcnt(0)" ::: "memory");
            const unsigned og = xb_add(&bar[XB_TOP], 1u);
            const unsigned tg = og / nx;
            if (og + 1u == (tg + 1u) * nx) xb_add(&bar[XB_TOPGEN], 1u);
            else XB_SPIN(xb_ld(&bar[XB_TOPGEN]) == tg, bar);
            __builtin_amdgcn_fence(__ATOMIC_ACQUIRE, "agent");
            xb_add(&bar[XB_XGEN(b.x)], 1u);
            asm volatile("s_waitcnt vmcnt(0)" ::: "memory");
        } else {
            XB_SPIN(xb_ld(&bar[XB_XGEN(b.x)]) == gen, bar);
            __builtin_amdgcn_fence(__ATOMIC_ACQUIRE, "agent");
            asm volatile("s_waitcnt vmcnt(0)" ::: "memory");
        }
    }
    if (TIDX() < 64) (void)out_preload(p, xin);
    __syncthreads();
}

__device__ __forceinline__ void body_route4(const P& p, int vb, char* smem) {
    const int tid = TIDX(), wave = tid >> 6, lane = tid & 63, t0 = vb * 64 + wave * 8;
    pg8::u32x2 raw[8][4]; float ss[8];
#pragma unroll
    for (int tk = 0; tk < 8; ++tk) { const pg8::u32x2* hr = (const pg8::u32x2*)(p.h1b + (size_t)(t0 + tk) * D);
#pragma unroll
        for (int j = 0; j < 4; ++j) raw[tk][j] = hr[lane + 64 * j]; }
#pragma unroll
    for (int tk = 0; tk < 8; ++tk) { float a = 0.f;
#pragma unroll
        for (int j = 0; j < 4; ++j) { const float x0 = __uint_as_float(raw[tk][j].x << 16), x1 = __uint_as_float(raw[tk][j].x & 0xffff0000u), x2 = __uint_as_float(raw[tk][j].y << 16), x3 = __uint_as_float(raw[tk][j].y & 0xffff0000u);
            a += x0 * x0 + x1 * x1 + x2 * x2 + x3 * x3; }
        ss[tk] = a; }
    const float tot = tred8(ss, lane);
    float* rsl = (float*)smem + 3072;
    float* sl = (float*)smem + wave * (8 * 40);
    __syncthreads();
    { const float mine = __shfl(tot, (lane & 7) * 8); if (lane < 8) rsl[wave * 8 + lane] = rsqrtf(mine * (1.f / D) + 1e-6f); }
    typedef __attribute__((address_space(3))) char* lp_t;
    lp_t Ah = (lp_t)smem + 16384, Wh = Ah + 2 * 64 * 528, Wl = Wh + 48 * 528;
    pg8::f32x4 acc0 = {0.f, 0.f, 0.f, 0.f}, acc1 = {0.f, 0.f, 0.f, 0.f};
    const int mb0 = wave & 3, nb0 = wave >> 2, fr = lane & 15, fq = lane >> 4;
    pg8::u32x4 wph[3], wpl[3];
#pragma unroll
    for (int k = 0; k < 3; ++k) { const int idx = tid + k * 512, row = idx >> 5, c16 = idx & 31; wph[k] = *(const pg8::u32x4*)(p.wrh + (size_t)row * 1024 + c16 * 8); wpl[k] = *(const pg8::u32x4*)(p.wrl + (size_t)row * 1024 + c16 * 8); }
#pragma unroll
    for (int c = 0; c < 4; ++c) {
        __syncthreads();
#pragma unroll
        for (int tk = 0; tk < 8; ++tk) *(__attribute__((address_space(3))) pg8::u32x2*)(Ah + (wave * 8 + tk) * 528 + lane * 8) = raw[tk][c];
#pragma unroll
        for (int k = 0; k < 3; ++k) { const int idx = tid + k * 512, row = idx >> 5, c16 = idx & 31;
            *(__attribute__((address_space(3))) pg8::u32x4*)(Wh + row * 528 + c16 * 16) = wph[k]; *(__attribute__((address_space(3))) pg8::u32x4*)(Wl + row * 528 + c16 * 16) = wpl[k]; }
        if (c < 3) {
#pragma unroll
            for (int k = 0; k < 3; ++k) { const int idx = tid + k * 512, row = idx >> 5, c16 = idx & 31; wph[k] = *(const pg8::u32x4*)(p.wrh + (size_t)row * 1024 + (c + 1) * 256 + c16 * 8); wpl[k] = *(const pg8::u32x4*)(p.wrl + (size_t)row * 1024 + (c + 1) * 256 + c16 * 8); } }
        asm volatile("s_waitcnt lgkmcnt(0)" ::: "memory"); __builtin_amdgcn_s_barrier(); asm volatile("" ::: "memory");
#pragma unroll
        for (int ks = 0; ks < 8; ++ks) { const int ko = (ks * 32 + 8 * fq) * 2;
            const pg8::bf16x8 ah = *(const __attribute__((address_space(3))) pg8::bf16x8*)(Ah + (16 * mb0 + fr) * 528 + ko);
            const pg8::bf16x8 bh = *(const __attribute__((address_space(3))) pg8::bf16x8*)(Wh + (16 * nb0 + fr) * 528 + ko), bl = *(const __attribute__((address_space(3))) pg8::bf16x8*)(Wl + (16 * nb0 + fr) * 528 + ko);
            acc0 = __builtin_amdgcn_mfma_f32_16x16x32_bf16(ah, bh, acc0, 0, 0, 0); acc0 = __builtin_amdgcn_mfma_f32_16x16x32_bf16(ah, bl, acc0, 0, 0, 0);
            if (wave < 4) { const pg8::bf16x8 ch = *(const __attribute__((address_space(3))) pg8::bf16x8*)(Wh + (32 + fr) * 528 + ko), cl = *(const __attribute__((address_space(3))) pg8::bf16x8*)(Wl + (32 + fr) * 528 + ko);
                acc1 = __builtin_amdgcn_mfma_f32_16x16x32_bf16(ah, ch, acc1, 0, 0, 0); acc1 = __builtin_amdgcn_mfma_f32_16x16x32_bf16(ah, cl, acc1, 0, 0, 0); } }
    }
    __syncthreads();
    {
        float* slall = (float*)smem;
#pragma unroll
        for (int r = 0; r < 4; ++r) { const int tok = 16 * mb0 + fq * 4 + r; const int o0 = 16 * nb0 + fr; const float rstd = rsl[tok];
            slall[(tok >> 3) * 320 + (tok & 7) * 40 + o0] = acc0[r] * rstd + (o0 < 4 ? p.b_grp[o0] : p.b_exp[o0 - 4]);
            if (wave < 4) { const int o1 = 32 + fr; if (o1 < 36) slall[(tok >> 3) * 320 + (tok & 7) * 40 + o1] = acc1[r] * rstd + p.b_exp[o1 - 4]; } }
    }
    __syncthreads();
    asm volatile("s_waitcnt lgkmcnt(0)" ::: "memory");
    int* cntl = (int*)((float*)smem + 8 * 320); int* basel = cntl + 32;
    if (tid < 32) cntl[tid] = 0;
    __syncthreads();
    int x0 = 0, x1 = 0, l0 = 0, l1 = 0; float w0 = 0.f, w1 = 0.f;
    if (lane < 8) {
        const float* s8 = sl + lane * 40;
        int gs = 0; float gm = s8[0];
        for (int o = 1; o < 4; ++o) if (s8[o] > gm) { gm = s8[o]; gs = o; }
        float gsum = 0.f;
        for (int o = 0; o < 4; ++o) gsum += __expf(s8[o] - gm);
        const float pg = 1.f / gsum;
        const float* li = s8 + 4 + gs * 8;
        int e0 = 0; float m0 = li[0];
        for (int e = 1; e < 8; ++e) if (li[e] > m0) { m0 = li[e]; e0 = e; }
        int e1 = -1; float m1 = -3e38f;
        for (int e = 0; e < 8; ++e) if (e != e0 && li[e] > m1) { m1 = li[e]; e1 = e; }
        const float p0 = 1.f, p1 = __expf(m1 - m0);
        w0 = pg * p0 / (p0 + p1); w1 = pg * p1 / (p0 + p1);
        x0 = gs * 8 + e0; x1 = gs * 8 + e1;
        l0 = atomicAdd(&cntl[x0], 1); l1 = atomicAdd(&cntl[x1], 1);
    }
    __syncthreads();
    if (tid < 32) { const int c = cntl[tid]; basel[tid] = c > 0 ? (int)atomicAdd(&p.ctl[tid * 32], (unsigned)c) : 0; }
    __syncthreads();
    if (lane < 8) {
        const int t = t0 + lane; const int s0 = basel[x0] + l0, s1 = basel[x1] + l1;
        p.list[(size_t)x0 * p.T + s0] = t; p.list[(size_t)x1 * p.T + s1] = t;
        { const float rstd = rsl[wave * 8 + lane]; p.hcmp[(size_t)x0 * p.T + s0] = rstd; p.hcmp[(size_t)x1 * p.T + s1] = rstd; }
        p.tokexp[t * 2] = x0; p.tokexp[t * 2 + 1] = x1; p.tokslot[t * 2] = s0; p.tokslot[t * 2 + 1] = s1; p.tokw[t * 2] = w0; p.tokw[t * 2 + 1] = w1;
    }
    __syncthreads();
}


template <int ST> __device__ __forceinline__ void run_stage(const P& p, char* smem, int first, int stride) {
    const int nvb = stage_nvb(ST, p.T);
    for (int vb = first; vb < nvb; vb += stride) {
        if constexpr (ST == ST_RMS) body_rms(p, vb);
        else if constexpr (ST == ST_CS) body_cs(p, vb);
        else if constexpr (ST == ST_INPROJ) body_inproj(p, vb, smem);
        else if constexpr (ST == ST_CMP1) body_cmp1(p, vb, smem);
        else if constexpr (ST == ST_CMP2) body_cmp2(p, vb);
        else if constexpr (ST == ST_NSACMP) body_nsacmp(p, vb, smem);
        else if constexpr (ST == ST_NSAATT) body_nsaatt(p, vb);
        else if constexpr (ST == ST_GLAA) body_glaa(p, vb);
        else if constexpr (ST == ST_GLASCAN) body_glascan(p, vb, smem);
        else if constexpr (ST == ST_GLANORM) body_glanorm(p, vb);
        else if constexpr (ST == ST_PROJ) body_proj(p, vb, smem);
        else if constexpr (ST == ST_OUT) body_out(p, vb, smem);
        else if constexpr (ST == ST_ROUTE) body_route(p, vb, smem);
        else if constexpr (ST == ST_MOE1) body_moe1(p, vb, smem);
        else if constexpr (ST == ST_MOE2) body_moe2(p, vb, smem);
        else if constexpr (ST == ST_FINAL) body_final(p, vb, smem);
    }
}
template <int ST> __global__ void __launch_bounds__(NT) k_stage(P p) {
    extern __shared__ __attribute__((aligned(16))) char smem[];
    run_stage<ST>(p, smem, blockIdx.x, gridDim.x);
}
__device__ __forceinline__ void phase3_fused(const P& p, char* smem) {
    const int tid = TIDX(), G = gridDim.x; const int nrows = p.nb * 2 * 256, nvb1 = nrows / 16, n2 = p.nb * 4 * 4096;
    if (2 * nvb1 != G || n2 > G * 256) { phase_cmp2(p, smem); phase_gla2(p); return; }
    const int vb = blockIdx.x, kv = vb / nvb1, row0 = (vb % nvb1) * 16;
    const size_t pseg = (size_t)(nrows + 8) * 512; const float* P0 = p.pcmp + (size_t)(kv * 2) * pseg; const float* P1 = P0 + pseg;
    typedef float f2_ __attribute__((ext_vector_type(2)));
    typedef __attribute__((address_space(3))) char* lp_t;
    lp_t Ai = (lp_t)smem, Bi = Ai + 16 * 528; float* zs = (float*)(smem + 16 * 528 + 64 * 528);
    float wlo[16], whi[16];
    { const float* wsrc = kv ? p.cw2_v : p.cw2_k;
#pragma unroll
      for (int q = 0; q < 16; ++q) { const int d = tid + q * 512, n = d & 63, k2 = d >> 6; wlo[q] = wsrc[(2 * k2) * 64 + n]; whi[q] = wsrc[(2 * k2 + 1) * 64 + n]; } }
    f2_ a0[4], a1[4], a2[4], a3[4], bb[4];
#pragma unroll
    for (int q = 0; q < 4; ++q) { const int d = tid + q * 512, rr = d >> 7, n = (d & 127) * 2; const size_t m = (size_t)(row0 + rr);
        a0[q] = *(const f2_*)(P0 + m * 512 + n); a1[q] = *(const f2_*)(P1 + m * 512 + n); a2[q] = *(const f2_*)(P0 + (m + 1) * 512 + 256 + n); a3[q] = *(const f2_*)(P1 + (m + 1) * 512 + 256 + n); bb[q] = *(const f2_*)(p.b1p + kv * 256 + n); }
    const int err = tid >> 5, ei = tid & 31, erow = row0 + err;
    const float* b2 = kv ? p.cb2_v : p.cb2_k; const float b2a = b2[ei], b2b = b2[ei + 32];
    float ec = 1.f, es = 0.f;
    if (kv == 0) { const int bg = erow >> 8, m = erow & 255, b = bg >> 1; int sp = 16 * m + 31; if (sp > S - 1) sp = S - 1; const size_t t = (size_t)b * S + sp; ec = p.cs[t * 64 + ei]; es = p.cs[t * 64 + 32 + ei]; }
    const int gidx = blockIdx.x * 256 + tid; const bool act = tid < 256 && gidx < n2;
    const int gbh = gidx >> 12, gde = (gidx & 4095) * 2, gd = gde >> 7; unsigned* U = (unsigned*)((bf16*)p.gst + (size_t)gbh * 64 * 8192 + gde); const float* gdp = p.gdec + (size_t)gbh * 64 * 64 + gd;
    unsigned u[64]; float g[64];
    if (act) {
#pragma unroll
        for (int c = 0; c < 64; ++c) { u[c] = U[(size_t)c * 4096]; g[c] = gdp[c * 64]; } }
    __syncthreads();
#pragma unroll
    for (int q = 0; q < 16; ++q) { const int d = tid + q * 512, n = d & 63, k2 = d >> 6; *(__attribute__((address_space(3))) unsigned*)(Bi + n * 528 + k2 * 4) = pk2(wlo[q], whi[q]); }
#pragma unroll
    for (int q = 0; q < 4; ++q) { const int d = tid + q * 512, rr = d >> 7, n = (d & 127) * 2;
        *(__attribute__((address_space(3))) unsigned*)(Ai + rr * 528 + n * 2) = pk2(geluf_(a0[q].x + a1[q].x + a2[q].x + a3[q].x + bb[q].x), geluf_(a0[q].y + a1[q].y + a2[q].y + a3[q].y + bb[q].y)); }
    __syncthreads();
    if (tid < 256) { const int nb0 = tid >> 6, lane = tid & 63, fr = lane & 15, fq = lane >> 4;
        pg8::f32x4 acc = {0.f, 0.f, 0.f, 0.f};
#pragma unroll
        for (int ks = 0; ks < 8; ++ks) { const int ko = (ks * 32 + 8 * fq) * 2;
            const pg8::bf16x8 a = *(const __attribute__((address_space(3))) pg8::bf16x8*)(Ai + fr * 528 + ko), b = *(const __attribute__((address_space(3))) pg8::bf16x8*)(Bi + (16 * nb0 + fr) * 528 + ko);
            acc = __builtin_amdgcn_mfma_f32_16x16x32_bf16(a, b, acc, 0, 0, 0); }
#pragma unroll
        for (int r = 0; r < 4; ++r) zs[(fq * 4 + r) * 64 + 16 * nb0 + fr] = acc[r];
    }
    __syncthreads();
    { float z1 = b2a + zs[err * 64 + ei], z2 = b2b + zs[err * 64 + ei + 32];
      bf16* dst = (kv ? p.vcmp : p.kcmp) + (size_t)erow * 64;
      if (kv == 0) { const float r1 = z1 * ec - z2 * es, r2 = z2 * ec + z1 * es; z1 = r1; z2 = r2; }
      if ((erow & 255) == 255) { z1 = 0.f; z2 = 0.f; }
      dst[ei] = f2bf(z1); dst[ei + 32] = f2bf(z2); }
    if (act) { float s0 = 0.f, s1 = 0.f;
#pragma unroll
        for (int c = 0; c < 64; ++c) { const float t0 = __uint_as_float(u[c] << 16), t1 = __uint_as_float(u[c] & 0xffff0000u); U[(size_t)c * 4096] = pk2(s0, s1); s0 = g[c] * s0 + t0; s1 = g[c] * s1 + t1; } }
}
__device__ unsigned g_ctl[16384];
__global__ void __launch_bounds__(NT) k_mega(P pin) {
    P p = pin; p.ctl = g_ctl;
    extern __shared__ __attribute__((aligned(16))) char smem[];
    cg::grid_group grid = cg::this_grid();
    const int b0 = blockIdx.x, G = gridDim.x;
    volatile XLAS unsigned* xst = (volatile XLAS unsigned*)((XLAS char*)smem + LDS_MISC + 3072);
    if (TIDX() < 4) xst[TIDX()] = 0u;
    __syncthreads();
    volatile unsigned long long* tsv = (volatile unsigned long long*)(p.ctl + 12288); int nts = 1;
    if (TSEL >= 0 && b0 == 0 && TIDX() == 0) tsv[0] = __builtin_amdgcn_s_memrealtime();
    const XcdBarrier xb = xcd_barrier_post(p.ctl + 4096, xst);
#define GSYNC() do { xcd_barrier(xb); if (TSEL >= 0 && b0 == 0 && TIDX() == 0) { tsv[nts] = __builtin_amdgcn_s_memrealtime(); } ++nts; } while (0)
#define DUPRUN(k, stmt) do { if (DUP == (k)) { stmt; GSYNC(); } } while (0)
    if (p.T < 0) grid.sync();
    phase_prep(p, smem); GSYNC();
    phase_inA(p, smem); GSYNC();                               DUPRUN(7, phase_inA(p, smem));
    phase_cmp1(p, smem); phase_gla1(p, smem, (p.nb * 2 * 256 / 256) * 8 < G ? (p.nb * 2 * 256 / 256) * 8 : 0); GSYNC();         DUPRUN(8, phase_cmp1(p, smem));
    phase3_fused(p, smem); GSYNC();
    if (DUP >= 20 && DUP < 148) { P p2 = p; p2.onsa = (bf16*)p.pcmp; p2.sel = (u64*)((char*)p.pcmp + 16 * MiB_); phase_nsa<(DUP >= 20 && DUP < 148) ? DUP - 20 : 0>(p2, smem); GSYNC(); }
    if (NCV > 0 && G > 2 * NCV) {
        const int Gp = G - NCV;
        if (b0 >= Gp) {
            const int wave = TIDX() >> 6, lane = TIDX() & 63; float* scr = (float*)smem + wave * (64 * 68);
            unsigned* tk = p.ctl + 8064; unsigned nxt = 0;
            if (lane == 0) nxt = __hip_atomic_fetch_add(tk, 2u, __ATOMIC_RELAXED, __HIP_MEMORY_SCOPE_AGENT);
            for (;;) {
                const int cur = __builtin_amdgcn_readfirstlane((int)nxt); if (cur >= PREP_I_EXP) break;
                if (lane == 0) nxt = __hip_atomic_fetch_add(tk, 2u, __ATOMIC_RELAXED, __HIP_MEMORY_SCOPE_AGENT);
                prep_item(p, PREP_EARLY + cur, scr, lane);
                if (cur + 1 < PREP_I_EXP) prep_item(p, PREP_EARLY + cur + 1, scr, lane);
            }
        } else {
            const int nunits = p.nb * 2 * 64; int r = 0, nmine = 0;
            for (int base = 0; base < nunits; base += Gp, ++r) {
                const int w = (r & 1) ? Gp - 1 - b0 : b0, i = base + w; if (i >= nunits) continue;
                const int jq = 63 - i / (p.nb * 2), bg = i % (p.nb * 2); nsa::nsa_unit<0>(p, smem, bg >> 1, bg & 1, jq); ++nmine; }
            const int nch = p.nb * 4 * 64, rounds = (nunits + Gp - 1) / Gp, nheavy = nunits - (rounds - 1) * Gp;
            const bool heavy = (rounds & 1) ? (b0 < nheavy) : (b0 >= Gp - nheavy); const int hidx = (rounds & 1) ? b0 : b0 - (Gp - nheavy);
            if (nheavy < Gp && rounds >= 2) {
                constexpr int HCH = 0;
                if (heavy) { for (int k = 0; k < HCH; ++k) { const int i = hidx * HCH + k; if (i < nch) gla::g3_chunk(p, smem, i >> 8, (i >> 6) & 3, i & 63); } }
                else { const int nl = Gp - nheavy, lidx = (rounds & 1) ? b0 - nheavy : b0; for (int i = HCH * nheavy + lidx; i < nch; i += nl) gla::g3_chunk(p, smem, i >> 8, (i >> 6) & 3, i & 63); }
            } else { for (int i = b0; i < nch; i += Gp) gla::g3_chunk(p, smem, i >> 8, (i >> 6) & 3, i & 63); }
        }
        GSYNC();
    } else { phase_nsa(p, smem); phase_gla3(p, smem); GSYNC(); }
    phase_proj(p, smem);
    { pg8::f32x4 xin[32]; xcd_barrier_pre(xb, p, xin); if (TSEL >= 0 && b0 == 0 && TIDX() == 0) { tsv[nts] = __builtin_amdgcn_s_memrealtime(); } ++nts; phase_out_pre(p, smem, xin); }
    GSYNC();
    if (DUP == 17) { P p2 = p; p2.ctl = p.ctl + 8192; p2.vb = p.sa; p2.list = (int*)p.mixed; p2.tokslot = (int*)p.mixed + (1 << 20); p2.tokexp = (int*)p.mixed + (2 << 20); p2.tokw = (float*)p.mixed + (3 << 20);
        for (int vb = b0; vb < p.T / 64; vb += G) body_route3(p2, vb, smem);
        GSYNC(); }
    for (int vb = b0; vb < p.T / 64; vb += G) body_route4(p, vb, smem);
    GSYNC();
    phase_moe12(p, smem);
    if (p.T / 8 == 8 * G) {
        const int* sbf = seg_bases(p, smem); FinPre fin;
        xcd_barrier_fin(xb, p, sbf, fin); if (TSEL >= 0 && b0 == 0 && TIDX() == 0) { tsv[nts] = __builtin_amdgcn_s_memrealtime(); } ++nts;
        final_compute(p, fin);
    } else {
    GSYNC();
    if (DUP == 15) { GSYNC(); GSYNC(); GSYNC(); GSYNC(); GSYNC(); GSYNC(); GSYNC(); GSYNC(); GSYNC(); GSYNC(); }
    for (int vb = b0; vb < p.T / 8; vb += G) body_final_b(p, vb, smem);
    }
    {
        __syncthreads();
        volatile XLAS unsigned* lastf = xst + 2;
        if (TIDX() == 0) { __threadfence(); lastf[0] = (__hip_atomic_fetch_add(&g_ctl[8000], 1u, __ATOMIC_RELAXED, __HIP_MEMORY_SCOPE_AGENT) == (unsigned)G - 1u) ? 1u : 0u; }
        __syncthreads();
        if (lastf[0]) { for (int i = TIDX(); i < 8192; i += NT) __hip_atomic_store(&g_ctl[i], 0u, __ATOMIC_RELAXED, __HIP_MEMORY_SCOPE_AGENT); }
    }
    if (TSEL >= 0 && b0 == 0 && TIDX() == 0) { const unsigned long long tend = __builtin_amdgcn_s_memrealtime(); tsv[nts] = tend;
        const unsigned long long d = tsv[TSEL + 1] - tsv[TSEL]; while (__builtin_amdgcn_s_memrealtime() - tend < 4ull * d) __builtin_amdgcn_s_sleep(16); }
#undef DUPRUN
#undef GSYNC
}

enum Phase { PH_PREP = 0, PH_INA, PH_INB, PH_PROJ, PH_OUT, PH_MOE1, PH_MOE2, PH_NSA, PH_GLA1, PH_GLA2, PH_GLA3, PH_CMP1, PH_CMP2 };
template <int PH> __global__ void __launch_bounds__(NT) k_phase(P p) {
    extern __shared__ __attribute__((aligned(16))) char smem[];
    if constexpr (PH == PH_PREP) phase_prep(p, smem);
    else if constexpr (PH == PH_INA) phase_inA(p, smem);
    else if constexpr (PH == PH_INB) phase_inB(p, smem);
    else if constexpr (PH == PH_PROJ) phase_proj(p, smem);
    else if constexpr (PH == PH_OUT) phase_out(p, smem);
    else if constexpr (PH == PH_MOE1) phase_moe12(p, smem);
    else if constexpr (PH == PH_MOE2) { }
    else if constexpr (PH == PH_NSA) phase_nsa(p, smem);
    else if constexpr (PH == PH_GLA1) phase_gla1(p, smem, 0);
    else if constexpr (PH == PH_GLA2) phase_gla2(p);
    else if constexpr (PH == PH_GLA3) phase_gla3(p, smem);
    else if constexpr (PH == PH_CMP1) phase_cmp1(p, smem);
    else if constexpr (PH == PH_CMP2) phase_cmp2(p, smem);
}
template <class TT> __device__ __forceinline__ float ldf(const TT* p, size_t i);
template <> __device__ __forceinline__ float ldf<bf16>(const bf16* p, size_t i) { return bf2f(p[i]); }
template <> __device__ __forceinline__ float ldf<float>(const float* p, size_t i) { return p[i]; }
template <class TT> __global__ void __launch_bounds__(256) k_compare(const TT* a, const TT* b, size_t n, float* err, int slot) {
    float num = 0.f, den = 0.f;
    for (size_t i = (size_t)blockIdx.x * 256 + TIDX(); i < n; i += (size_t)gridDim.x * 256) { const float x = ldf<TT>(a, i), y = ldf<TT>(b, i); const float d = x - y; num += (d == d) ? d * d : 1e30f; den += y * y; }
#pragma unroll
    for (int o = 1; o < 64; o <<= 1) { num += __shfl_xor(num, o); den += __shfl_xor(den, o); }
    if ((TIDX() & 63) == 0) { atomicAdd(err + 2 * slot, num); atomicAdd(err + 2 * slot + 1, den); }
}
__global__ void __launch_bounds__(256) k_compare_sel(const u64* a, const u64* b, size_t n, float* err, int slot) {
    float num = 0.f, den = 0.f;
    for (size_t i = (size_t)blockIdx.x * 256 + threadIdx.x; i < n; i += (size_t)gridDim.x * 256) { num += (a[i] != b[i]) ? 1.f : 0.f; den += 100.f; }
#pragma unroll
    for (int o = 1; o < 64; o <<= 1) { num += __shfl_xor(num, o); den += __shfl_xor(den, o); }
    if ((threadIdx.x & 63) == 0) { atomicAdd(err + 2 * slot, num); atomicAdd(err + 2 * slot + 1, den); }
}
__global__ void __launch_bounds__(256) k_report(float* out, size_t n, const float* err, int nslots, float tol) {
    int code = 0;
    for (int s = 0; s < nslots; ++s) { const float num = err[2 * s], den = err[2 * s + 1]; const bool bad = !(num <= tol * tol * den) || !(den > 0.f); if (bad) { code = s + 1; break; } }
    if (code == 0) return;
    const float f = 1.f + 0.1f * (float)code;
    for (size_t i = (size_t)blockIdx.x * 256 + TIDX(); i < n; i += (size_t)gridDim.x * 256) out[i] *= f;
}

static void set_inputs(P& p, void* const* d_in) {
    const float* const* in = (const float* const*)d_in;
    p.x = in[0]; p.pos = (const int*)d_in[1]; p.g_mix = in[2]; p.w_in = in[3];
    p.cpos_k = in[4]; p.cw1_k = in[5]; p.cb1_k = in[6]; p.cw2_k = in[7]; p.cb2_k = in[8];
    p.cpos_v = in[9]; p.cw1_v = in[10]; p.cb1_v = in[11]; p.cw2_v = in[12]; p.cb2_v = in[13];
    p.w_a2 = in[14]; p.b_a = in[15]; p.norm_g = in[16]; p.w_pn = in[17]; p.w_pg = in[18]; p.w_out = in[19];
    p.g_ffn = in[20]; p.w_grp = in[21]; p.b_grp = in[22]; p.w_exp = in[23]; p.b_exp = in[24]; p.w_gate = in[25]; p.w_up = in[26]; p.w_down = in[27]; p.g_final = in[28];
}
constexpr size_t MiB = 1u << 20;
static void layout_ref(P& p, char* small, char* act, char* scratch, float* out, int nb) {
    const size_t q = (MiB / 4) * nb;
    p.nb = nb; p.T = nb * S; p.out = out;
    p.ctl = (unsigned*)small; p.sel = (u64*)(small + q / 16 * 1); p.kcmp = (bf16*)(small + q / 2); p.vcmp = (bf16*)(small + q / 4 * 3);
    p.tokslot = (int*)(small + q); p.tokexp = (int*)(small + q + q / 8); p.tokw = (float*)(small + q + q / 4);
    p.alow = (float*)(small + 2 * q); p.gates = (float*)(small + 3 * q); p.cs = (float*)(small + 5 * q); p.hcmp = (float*)(small + 9 * q); p.list = (int*)(small + 13 * q);
    p.u = (bf16*)act; p.ocmp = (float*)act; p.mixed = (bf16*)act; p.vb = (bf16*)act;
    p.q = (bf16*)(act + 32 * q); p.kv6 = (bf16*)(act + 48 * q);
    p.gq = (bf16*)(act + 73 * q); p.gk = (bf16*)(act + 81 * q); p.gv = (bf16*)(act + 89 * q); p.rs = (bf16*)(act + 105 * q);
    p.H = (bf16*)(act + 32 * q);
    p.sa = (bf16*)(act + 123 * q); p.sb = (bf16*)(act + 155 * q); p.onsa = (bf16*)(act + 187 * q); p.gla = (bf16*)(act + 203 * q);
    p.Y = (bf16*)(act + 123 * q);
    p.ga = (float*)scratch; p.oraw = (float*)(scratch + 16 * q); p.h1 = (float*)(scratch + 48 * q);
    p.gst = (float*)(scratch + 16 * q); p.gdec = (float*)(small + 15 * q); p.gb = (float*)(act + 219 * q);
}
static void layout_compact(P& p, char* ws, float* out) {
    p.nb = NB; p.T = NB * S; p.out = out;
    char* small = ws; const size_t q = MiB;
    p.ctl = (unsigned*)small; p.sel = (u64*)(small + q / 16 * 1); p.kcmp = (bf16*)(small + q / 2); p.vcmp = (bf16*)(small + q / 4 * 3);
    p.tokslot = (int*)(small + q); p.tokexp = (int*)(small + q + q / 8); p.tokw = (float*)(small + q + q / 4);
    p.alow = (float*)(small + 2 * q); p.gates = (float*)(small + 3 * q); p.cs = (float*)(small + 5 * q); p.hcmp = (float*)(small + 9 * q); p.list = (int*)(small + 13 * q);
    p.u = (bf16*)(ws + 128 * MiB); p.vb = (bf16*)((char*)out + 32 * MiB);
    p.q = (bf16*)(ws + 160 * MiB); p.kv6 = (bf16*)(ws + 176 * MiB); p.gq = (bf16*)(ws + 201 * MiB); p.gk = (bf16*)(ws + 209 * MiB); p.gv = (bf16*)(ws + 217 * MiB); p.rs = (bf16*)(ws + 233 * MiB);
    p.ga = (float*)(ws + 249 * MiB); p.ocmp = (float*)(ws + 249 * MiB);
    p.sa = (bf16*)(ws + 160 * MiB); p.sb = (bf16*)(ws + 192 * MiB); p.mixed = (bf16*)(ws + 160 * MiB);
    p.sa8 = (unsigned char*)(ws + 249 * MiB); p.sb8 = (unsigned char*)(ws + 265 * MiB);
    p.H = (bf16*)(ws + 160 * MiB); p.Y = (bf16*)(ws + 200 * MiB);
    p.onsa = (bf16*)out; p.gla = (bf16*)((char*)out + 16 * MiB); p.oraw = (float*)((char*)out + 32 * MiB); p.h1 = out;
    p.gst = (float*)((char*)out + 32 * MiB); p.gdec = (float*)(small + 15 * q); p.pcmp = (float*)(ws + 128 * MiB); p.h1b = (bf16*)(ws + 128 * MiB); p.gb = (float*)((char*)out + 48 * MiB);
}
static void layout_weights(P& p, char* w) {
    p.wr = (float*)(w - 256 * 1024); p.b1p = (float*)(w - 100 * 1024); p.wrh = (bf16*)(w - 512 * 1024); p.wrl = (bf16*)(w - 384 * 1024);
    p.Wd = (bf16*)w; p.Wgu = (bf16*)(w + 32 * MiB); p.Wt_in = (bf16*)(w + 96 * MiB); p.Wc1 = (bf16*)(w + 106 * MiB);
    p.Wpn = (bf16*)(w + 108 * MiB); p.Wpg = (bf16*)(w + 109 * MiB); p.Wo = (bf16*)(w + 110 * MiB);
}

template <int ST> static void launch_stage(const P& p, hipStream_t stream) {
    static bool attr = false;
    if (!attr) { (void)hipFuncSetAttribute((const void*)k_stage<ST>, hipFuncAttributeMaxDynamicSharedMemorySize, LDS_BYTES); attr = true; }
    int nvb = stage_nvb(ST, p.T); if (nvb > 16384) nvb = 16384;
    hipLaunchKernelGGL(k_stage<ST>, dim3(nvb), dim3(NT), LDS_BYTES, stream, p);
}
template <int PH> static void launch_phase(const P& p, hipStream_t stream, int grid = 40) {
    static bool attr = false;
    if (!attr) { (void)hipFuncSetAttribute((const void*)k_phase<PH>, hipFuncAttributeMaxDynamicSharedMemorySize, LDS_BYTES); attr = true; }
    hipLaunchKernelGGL(k_phase<PH>, dim3(grid), dim3(NT), LDS_BYTES, stream, p);
}
template <class TT> static void compare(const TT* a, const TT* b, size_t n, float* err, int slot, hipStream_t stream) {
    hipLaunchKernelGGL(k_compare<TT>, dim3(1024), dim3(256), 0, stream, a, b, n, err, slot);
}
static void launch_mega(const P& p, hipStream_t stream) {
    static int grid = 0;
    if (!grid) {
        int dev = 0, cus = 0, per_cu = 0;
        (void)hipGetDevice(&dev); (void)hipDeviceGetAttribute(&cus, hipDeviceAttributeMultiprocessorCount, dev);
        (void)hipFuncSetAttribute((const void*)k_mega, hipFuncAttributeMaxDynamicSharedMemorySize, LDS_BYTES);
        (void)hipOccupancyMaxActiveBlocksPerMultiprocessor(&per_cu, (const void*)k_mega, NT, LDS_BYTES);
        if (per_cu < 1) per_cu = 1;
        grid = cus * per_cu;
    }
    P pp = p; void* args[] = {(void*)&pp};
    (void)hipLaunchCooperativeKernel((const void*)k_mega, dim3(grid), dim3(NT), args, LDS_BYTES, stream);
}

extern "C" void kernel_launch(void* const* d_in, const int* in_sizes, int n_in, void* d_out, int out_size, void* d_ws, size_t ws_size, hipStream_t stream) {
    char* ws = (char*)d_ws;
    P p{}; set_inputs(p, d_in); layout_ref(p, ws, ws + 16 * MiB, (char*)d_out, (float*)d_out, NB); p.h1 = (float*)d_out;
#if MODE == 0
    (void)hipMemsetAsync(d_ws, 0, 4096, stream);
    launch_stage<ST_RMS>(p, stream); launch_stage<ST_CS>(p, stream); launch_stage<ST_INPROJ>(p, stream);
    launch_stage<ST_CMP1>(p, stream); launch_stage<ST_CMP2>(p, stream); launch_stage<ST_NSACMP>(p, stream); launch_stage<ST_NSAATT>(p, stream);
    launch_stage<ST_GLAA>(p, stream); launch_stage<ST_GLASCAN>(p, stream); launch_stage<ST_GLANORM>(p, stream);
    launch_stage<ST_PROJ>(p, stream); launch_stage<ST_OUT>(p, stream); launch_stage<ST_ROUTE>(p, stream);
    launch_stage<ST_MOE1>(p, stream); launch_stage<ST_MOE2>(p, stream); launch_stage<ST_FINAL>(p, stream);
#elif MODE == 1
    { P c{}; set_inputs(c, d_in); layout_weights(c, ws + 16 * MiB); layout_compact(c, ws, (float*)d_out); launch_mega(c, stream); }
#else
    { P c{}; set_inputs(c, d_in); layout_weights(c, ws + 16 * MiB); layout_compact(c, ws, (float*)d_out); launch_mega(c, stream); }
    P r{}; set_inputs(r, d_in); layout_weights(r, ws + 16 * MiB);
    layout_ref(r, ws + 128 * MiB, ws + 132 * MiB, ws + 200 * MiB, (float*)(ws + 200 * MiB + 12 * MiB), 1);
    char* alt = ws + 228 * MiB; float* err = (float*)(ws + 128 * MiB + 8192);
    (void)hipMemsetAsync(ws + 128 * MiB, 0, 16384, stream);
    int slot = 0; const size_t T1 = S; const size_t ROWS1 = 2 * T1 + NEXP * 256;
    launch_stage<ST_RMS>(r, stream); launch_stage<ST_CS>(r, stream); launch_stage<ST_INPROJ>(r, stream);
    P f = r; { char* a = alt;
        f.u = (bf16*)a; a += T1 * 1024 * 2; f.cs = (float*)a; a += T1 * 64 * 4; f.q = (bf16*)a; a += T1 * 512 * 2; f.kv6 = (bf16*)a; a += 6 * (size_t)2 * S * 64 * 2 + 4096;
        f.gates = (float*)a; a += T1 * 24 * 4; f.gq = (bf16*)a; a += T1 * 256 * 2; f.gk = (bf16*)a; a += T1 * 256 * 2; f.gv = (bf16*)a; a += T1 * 512 * 2; f.alow = (float*)a; a += T1 * 16 * 4;
        f.rs = (bf16*)a; a += T1 * 512 * 2; f.sa = (bf16*)a; a += T1 * 1024 * 2; f.sb = (bf16*)a; a += T1 * 1024 * 2; }
    r.sa8 = (unsigned char*)(alt + 48 * MiB); r.sb8 = (unsigned char*)(alt + 52 * MiB); f.sa8 = r.sa8; f.sb8 = r.sb8;
    launch_phase<PH_PREP>(f, stream); launch_phase<PH_INA>(f, stream); launch_phase<PH_INB>(f, stream);
    compare<bf16>(f.q, r.q, T1 * 512, err, slot++, stream);
    compare<bf16>(f.kv6, r.kv6, 6 * (size_t)2 * S * 64, err, slot++, stream);
    launch_stage<ST_CMP1>(r, stream); launch_stage<ST_CMP2>(r, stream);
    f = r; f.pcmp = (float*)alt; f.kcmp = (bf16*)(alt + 20 * MiB); f.vcmp = (bf16*)(alt + 21 * MiB); launch_phase<PH_CMP1>(f, stream); launch_phase<PH_CMP2>(f, stream);
    compare<bf16>(f.kcmp, r.kcmp, (size_t)2 * 255 * 64, err, slot++, stream); compare<bf16>(f.vcmp + 256 * 64, r.vcmp + 256 * 64, (size_t)255 * 64, err, slot++, stream);
    launch_stage<ST_NSACMP>(r, stream); launch_stage<ST_NSAATT>(r, stream);
    f = r; f.onsa = (bf16*)alt; f.sel = (u64*)(alt + 8 * MiB); launch_phase<PH_NSA>(f, stream);
    hipLaunchKernelGGL(k_compare_sel, dim3(64), dim3(256), 0, stream, (const u64*)f.sel, (const u64*)r.sel, T1 * 2, err, slot++);
    compare<bf16>(f.onsa, r.onsa, T1 * 512, err, slot++, stream);
    launch_stage<ST_GLAA>(r, stream); launch_stage<ST_GLASCAN>(r, stream); launch_stage<ST_GLANORM>(r, stream);
    f = r; f.gla = (bf16*)alt; f.gst = (float*)(alt + 8 * MiB); f.gdec = (float*)(alt + 18 * MiB); launch_phase<PH_GLA1>(f, stream); launch_phase<PH_GLA2>(f, stream); launch_phase<PH_GLA3>(f, stream);
    compare<bf16>(f.gla, r.gla, T1 * 512, err, slot++, stream);
    launch_stage<ST_PROJ>(r, stream);
    f = r; f.mixed = (bf16*)alt; launch_phase<PH_PROJ>(f, stream);
    compare<bf16>(f.mixed, r.mixed, T1 * 1024, err, slot++, stream);
    launch_stage<ST_OUT>(r, stream);
    f = r; f.h1b = (bf16*)alt; launch_phase<PH_OUT>(f, stream);
    launch_stage<ST_ROUTE>(r, stream);
    (void)hipMemsetAsync(r.H, 0, ROWS1 * 512 * 2, stream); (void)hipMemsetAsync(alt, 0, ROWS1 * 512 * 2, stream);
    (void)hipMemsetAsync(r.Y, 0, ROWS1 * 1024 * 2, stream); (void)hipMemsetAsync(alt + 17 * MiB, 0, ROWS1 * 1024 * 2, stream);
    launch_stage<ST_MOE1>(r, stream); launch_stage<ST_MOE2>(r, stream);
    f = r; f.H = (bf16*)alt; f.Y = (bf16*)(alt + 17 * MiB); launch_phase<PH_MOE1>(f, stream);
    compare<bf16>(f.H, r.H, ROWS1 * 512, err, slot++, stream);
    compare<bf16>(f.Y, r.Y, ROWS1 * 1024, err, slot++, stream);
    hipLaunchKernelGGL(k_report, dim3(1024), dim3(256), 0, stream, (float*)d_out, (size_t)NB * S * D, (const float*)err, slot, 0.02f);
#endif
}
```
